# Optimizing an MI355X kernel written in HIP

```python
import math, functools
import jax, jax.numpy as jnp
from jax import lax
import numpy as np

D_MODEL = 1024
BATCH = 2
SEQ = 16384
DEPTH = 2

HEAD_DIM = 64
N_META = 16
BLOCK_Q = 128
PAD = BLOCK_Q - N_META
SEG_BLOCKS = 8
SUB = 64
RWKV_HEADS = 6
SB_HEADS = 5
FOX_HEADS = 5
RWKV_W = RWKV_HEADS * HEAD_DIM
SB_W = SB_HEADS * HEAD_DIM
FOX_W = FOX_HEADS * HEAD_DIM
DECAY_RANK = 64
ICLR_RANK = 64
N_BRANCH = 3
SHIFT_W = 3 * RWKV_W + DECAY_RANK + ICLR_RANK
REST_W = 3 * SB_W + 3 * FOX_W + FOX_HEADS + N_BRANCH * D_MODEL
D_IN = SHIFT_W + REST_W
N_GROUPS = 4
EXPERTS_PER_GROUP = 4
N_EXPERTS = N_GROUPS * EXPERTS_PER_GROUP
TOP_K = 2
D_EXPERT = 256
NORM_EPS = 1e-6
RWKV_LN_EPS = 64e-5
NEG_INF = -1e30

kernel_name = "hybrid_rwkv7_stickbreak_fox_hiermoe"


def rms_norm(x, g, eps=NORM_EPS):
    xf = x.astype(jnp.float32)
    y = xf * lax.rsqrt(jnp.mean(xf * xf, axis=-1, keepdims=True) + eps)
    return (y * g.astype(jnp.float32)).astype(x.dtype)


def token_shift(u, mu):
    prev = jnp.pad(u, ((0, 0), (1, 0), (0, 0)))[:, :-1]
    return u + (prev - u) * mu


def rwkv7_time_mix(r, k, v, wd, ad, w_up, w0, a_up, a0, k_k, k_a, r_k, ln_g, ln_b):
    dt = r.dtype
    f32 = jnp.float32
    B, L, _ = r.shape
    logw = -jax.nn.softplus(-(w0 + jnp.tanh(wd) @ w_up).astype(f32)) - 0.5
    decay = jnp.exp(-jnp.exp(logw))
    a = jax.nn.sigmoid((a0 + ad @ a_up).astype(f32))
    hs = lambda u: u.astype(f32).reshape(B, L, RWKV_HEADS, HEAD_DIM)
    r, k, v, decay, a = hs(r), hs(k), hs(v), hs(decay), hs(a)
    kk = k * k_k.astype(f32)
    kk = kk / jnp.maximum(jnp.sqrt(jnp.sum(kk * kk, axis=-1, keepdims=True)), 1e-12)
    k = k * (1.0 + (a - 1.0) * k_a.astype(f32))

    def step(S, inp):
        r_t, w_t, k_t, v_t, kk_t, a_t = inp
        sa = jnp.einsum('bhvk,bhk->bhv', S, -kk_t)
        S = (S * w_t[:, :, None, :]
             + sa[..., None] * (kk_t * a_t)[:, :, None, :]
             + v_t[..., None] * k_t[:, :, None, :])
        return S, jnp.einsum('bhvk,bhk->bhv', S, r_t)

    xs = (jnp.moveaxis(r, 1, 0), jnp.moveaxis(decay, 1, 0), jnp.moveaxis(k, 1, 0),
          jnp.moveaxis(v, 1, 0), jnp.moveaxis(kk, 1, 0), jnp.moveaxis(a, 1, 0))
    S0 = jnp.zeros((B, RWKV_HEADS, HEAD_DIM, HEAD_DIM), f32)
    _, y = lax.scan(step, S0, xs)
    y = jnp.moveaxis(y, 0, 1)
    mean = jnp.mean(y, axis=-1, keepdims=True)
    var = jnp.mean(jnp.square(y - mean), axis=-1, keepdims=True)
    y = (y - mean) * lax.rsqrt(var + RWKV_LN_EPS)
    y = y.reshape(B, L, RWKV_W) * ln_g.astype(f32) + ln_b.astype(f32)
    bonus = jnp.sum(r * k * r_k.astype(f32), axis=-1, keepdims=True) * v
    return (y + bonus.reshape(B, L, RWKV_W)).astype(dt)


def to_padded_heads(u, n_heads):
    B, L, _ = u.shape
    u = u.reshape(B, L, n_heads, HEAD_DIM).transpose(0, 2, 1, 3)
    return jnp.pad(u, ((0, 0), (0, 0), (PAD, 0), (0, 0)))


def from_padded_heads(o):
    B, H, T, d = o.shape
    return o[:, :, PAD:].transpose(0, 2, 1, 3).reshape(B, T - PAD, H * d)


def causal_sweep(block_fn, n_blocks):
    outs = []
    for b0 in range(0, n_blocks, SEG_BLOCKS):
        b1 = min(b0 + SEG_BLOCKS, n_blocks)
        outs.append(lax.map(functools.partial(block_fn, key_len=b1 * BLOCK_Q), jnp.arange(b0, b1)))
    return jnp.concatenate(outs, axis=0)


def stick_breaking_attention(q, k, v):
    B, H, T, d = q.shape
    scale = 1.0 / math.sqrt(d)
    f32 = jnp.float32

    def block(i, key_len):
        nsub = key_len // SUB
        kb, vb = k[:, :, :key_len], v[:, :, :key_len]
        q0 = i * BLOCK_Q
        qb = lax.dynamic_slice_in_dim(q, q0, BLOCK_Q, axis=2)
        z = jnp.einsum('bhqd,bhkd->bhqk', qb, kb, preferred_element_type=f32) * scale
        key_pos = jnp.arange(key_len)
        qpos = q0 + jnp.arange(BLOCK_Q)
        mask = (key_pos[None, :] < qpos[:, None]) & (key_pos[None, :] >= PAD)
        log_1mb = jnp.where(mask, jax.nn.log_sigmoid(-z), 0.0)
        lr = log_1mb.reshape(B, H, BLOCK_Q, nsub, SUB)
        j_in = jnp.arange(SUB)
        upper_in = (j_in[:, None] > j_in[None, :]).astype(f32)
        tail_in = jnp.einsum('bhqnj,js->bhqns', lr, upper_in)
        m_blk = jnp.arange(nsub)
        upper_blk = (m_blk[:, None] > m_blk[None, :]).astype(f32)
        later = jnp.einsum('bhqm,mn->bhqn', jnp.sum(lr, axis=-1), upper_blk)
        tail = (tail_in + later[..., None]).reshape(B, H, BLOCK_Q, key_len)
        A = jnp.where(mask, jnp.exp(jax.nn.log_sigmoid(z) + tail), 0.0)
        return jnp.einsum('bhqk,bhkd->bhqd', A.astype(v.dtype), vb)

    out = causal_sweep(block, T // BLOCK_Q)
    return out.transpose(1, 2, 0, 3, 4).reshape(B, H, T, d)


def forgetting_attention(q, k, v, logf_cum):
    B, H, T, d = q.shape
    scale = 1.0 / math.sqrt(d)

    def block(i, key_len):
        kb, vb, fk = k[:, :, :key_len], v[:, :, :key_len], logf_cum[:, :, :key_len]
        q0 = i * BLOCK_Q
        qb = lax.dynamic_slice_in_dim(q, q0, BLOCK_Q, axis=2)
        fq = lax.dynamic_slice_in_dim(logf_cum, q0, BLOCK_Q, axis=2)
        s = jnp.einsum('bhqd,bhkd->bhqk', qb, kb, preferred_element_type=jnp.float32) * scale
        s = s + fq[..., :, None] - fk[:, :, None, :]
        key_pos = jnp.arange(key_len)
        qpos = q0 + jnp.arange(BLOCK_Q)
        mask = (key_pos[None, :] <= qpos[:, None]) & (key_pos[None, :] >= PAD)
        p = jax.nn.softmax(jnp.where(mask, s, NEG_INF), axis=-1)
        return jnp.einsum('bhqk,bhkd->bhqd', p.astype(v.dtype), vb)

    out = causal_sweep(block, T // BLOCK_Q)
    return out.transpose(1, 2, 0, 3, 4).reshape(B, H, T, d)


def hybrid_mixer(n, w_in, rwkv_mu, rwkv_w_up, rwkv_w0, rwkv_a_up, rwkv_a0, rwkv_k_k, rwkv_k_a,
                 rwkv_r_k, rwkv_ln_g, rwkv_ln_b, fox_f_b, fox_q_g, fox_k_g,
                 w_p_rwkv, w_p_sb, w_p_fox, w_out):
    B, L, D = n.shape
    u = n @ w_in
    u_shift = token_shift(u[..., :SHIFT_W], rwkv_mu)
    u_rest = u[..., SHIFT_W:]
    r, k, v, wd, ad = jnp.split(
        u_shift, [RWKV_W, 2 * RWKV_W, 3 * RWKV_W, 3 * RWKV_W + DECAY_RANK], axis=-1)
    sbq, sbk, sbv, fq, fk, fv, f_logit, gates = jnp.split(
        u_rest, [SB_W, 2 * SB_W, 3 * SB_W, 3 * SB_W + FOX_W, 3 * SB_W + 2 * FOX_W,
                 3 * SB_W + 3 * FOX_W, 3 * SB_W + 3 * FOX_W + FOX_HEADS], axis=-1)

    y_a = rwkv7_time_mix(r, k, v, wd, ad, rwkv_w_up, rwkv_w0, rwkv_a_up, rwkv_a0,
                         rwkv_k_k, rwkv_k_a, rwkv_r_k, rwkv_ln_g, rwkv_ln_b)

    y_b = from_padded_heads(stick_breaking_attention(
        to_padded_heads(sbq, SB_HEADS), to_padded_heads(sbk, SB_HEADS), to_padded_heads(sbv, SB_HEADS)))

    fq = rms_norm(fq.reshape(B, L, FOX_HEADS, HEAD_DIM), fox_q_g).reshape(B, L, FOX_W)
    fk = rms_norm(fk.reshape(B, L, FOX_HEADS, HEAD_DIM), fox_k_g).reshape(B, L, FOX_W)
    logf = jax.nn.log_sigmoid((f_logit + fox_f_b).astype(jnp.float32))
    logf = jnp.pad(logf, ((0, 0), (PAD, 0), (0, 0)))
    logf_cum = jnp.cumsum(logf, axis=1).transpose(0, 2, 1)
    y_c = from_padded_heads(forgetting_attention(
        to_padded_heads(fq, FOX_HEADS), to_padded_heads(fk, FOX_HEADS),
        to_padded_heads(fv, FOX_HEADS), logf_cum))

    g = jax.nn.sigmoid(gates).reshape(B, L, N_BRANCH, D)
    merged = (g[:, :, 0] * (y_a @ w_p_rwkv)
              + g[:, :, 1] * (y_b @ w_p_sb)
              + g[:, :, 2] * (y_c @ w_p_fox))
    return merged @ w_out


def hierarchical_moe(n, wg, bg, we, be, w_gate, w_up, w_down):
    B, L, D = n.shape
    t = n.reshape(B * L, D)
    N = t.shape[0]
    lg = (t @ wg + bg).astype(jnp.float32)
    pg = jax.nn.softmax(lg, axis=-1)
    g_idx = jnp.argmax(lg, axis=-1)
    p_group = jnp.take_along_axis(pg, g_idx[:, None], axis=-1)
    le = (t @ we + be).astype(jnp.float32).reshape(N, N_GROUPS, EXPERTS_PER_GROUP)
    le_sel = jnp.take_along_axis(le, g_idx[:, None, None], axis=1)[:, 0]
    top_v, top_i = lax.top_k(le_sel, TOP_K)
    p_top = jax.nn.softmax(top_v, axis=-1)
    expert_id = g_idx[:, None] * EXPERTS_PER_GROUP + top_i
    combine = jnp.sum(jax.nn.one_hot(expert_id, N_EXPERTS, dtype=jnp.float32)
                      * (p_group * p_top)[..., None], axis=1).astype(t.dtype)
    y = jnp.zeros_like(t)
    for e in range(N_EXPERTS):
        he = jax.nn.silu(t @ w_gate[e]) * (t @ w_up[e])
        y = y + combine[:, e:e + 1] * (he @ w_down[e])
    return y.reshape(B, L, D)


def setup_inputs(seed: int = 0) -> dict:
    key = jax.random.key(seed)
    ks = jax.random.split(key, 32)
    f32 = jnp.float32
    nrm = lambda k, shape, s: jax.random.normal(k, shape, f32) * s
    unif = lambda k, shape, lo, hi: jax.random.uniform(k, shape, f32, lo, hi)
    return {
        "x": nrm(ks[0], (BATCH, SEQ, D_MODEL), 1.0),
        "meta_tokens": nrm(ks[1], (N_META, D_MODEL), 1.0),
        "norm1_g": 1.0 + nrm(ks[2], (DEPTH, D_MODEL), 0.02),
        "w_in": nrm(ks[3], (DEPTH, D_MODEL, D_IN), D_MODEL ** -0.5),
        "rwkv_mu": unif(ks[4], (DEPTH, SHIFT_W), 0.0, 1.0),
        "rwkv_w_up": nrm(ks[5], (DEPTH, DECAY_RANK, RWKV_W), 0.1),
        "rwkv_w0": unif(ks[6], (DEPTH, RWKV_W), -6.0, 1.0),
        "rwkv_a_up": nrm(ks[7], (DEPTH, ICLR_RANK, RWKV_W), 0.1),
        "rwkv_a0": nrm(ks[8], (DEPTH, RWKV_W), 0.5),
        "rwkv_k_k": 0.85 + nrm(ks[9], (DEPTH, RWKV_HEADS, HEAD_DIM), 0.05),
        "rwkv_k_a": 1.0 + nrm(ks[10], (DEPTH, RWKV_HEADS, HEAD_DIM), 0.05),
        "rwkv_r_k": nrm(ks[11], (DEPTH, RWKV_HEADS, HEAD_DIM), 0.1),
        "rwkv_ln_g": 1.0 + nrm(ks[12], (DEPTH, RWKV_W), 0.02),
        "rwkv_ln_b": nrm(ks[13], (DEPTH, RWKV_W), 0.02),
        "fox_f_b": unif(ks[14], (DEPTH, FOX_HEADS), 2.0, 6.0),
        "fox_q_g": 1.0 + nrm(ks[15], (DEPTH, HEAD_DIM), 0.02),
        "fox_k_g": 1.0 + nrm(ks[16], (DEPTH, HEAD_DIM), 0.02),
        "w_p_rwkv": nrm(ks[17], (DEPTH, RWKV_W, D_MODEL), RWKV_W ** -0.5),
        "w_p_sb": nrm(ks[18], (DEPTH, SB_W, D_MODEL), SB_W ** -0.5),
        "w_p_fox": nrm(ks[19], (DEPTH, FOX_W, D_MODEL), FOX_W ** -0.5),
        "w_out": nrm(ks[20], (DEPTH, D_MODEL, D_MODEL), D_MODEL ** -0.5),
        "norm2_g": 1.0 + nrm(ks[21], (DEPTH, D_MODEL), 0.02),
        "moe_wg": nrm(ks[22], (DEPTH, D_MODEL, N_GROUPS), D_MODEL ** -0.5),
        "moe_bg": nrm(ks[23], (DEPTH, N_GROUPS), 0.01),
        "moe_we": nrm(ks[24], (DEPTH, D_MODEL, N_EXPERTS), D_MODEL ** -0.5),
        "moe_be": nrm(ks[25], (DEPTH, N_EXPERTS), 0.01),
        "moe_w_gate": nrm(ks[26], (DEPTH, N_EXPERTS, D_MODEL, D_EXPERT), D_MODEL ** -0.5),
        "moe_w_up": nrm(ks[27], (DEPTH, N_EXPERTS, D_MODEL, D_EXPERT), D_MODEL ** -0.5),
        "moe_w_down": nrm(ks[28], (DEPTH, N_EXPERTS, D_EXPERT, D_MODEL), D_EXPERT ** -0.5),
    }


def reference(x, meta_tokens, norm1_g, w_in, rwkv_mu, rwkv_w_up, rwkv_w0, rwkv_a_up, rwkv_a0,
              rwkv_k_k, rwkv_k_a, rwkv_r_k, rwkv_ln_g, rwkv_ln_b, fox_f_b, fox_q_g, fox_k_g,
              w_p_rwkv, w_p_sb, w_p_fox, w_out, norm2_g, moe_wg, moe_bg, moe_we, moe_be,
              moe_w_gate, moe_w_up, moe_w_down):
    B = x.shape[0]
    meta = jnp.broadcast_to(meta_tokens[None].astype(x.dtype), (B, N_META, D_MODEL))
    h = jnp.concatenate([meta, x], axis=1)
    for l in range(DEPTH):
        h = h + hybrid_mixer(rms_norm(h, norm1_g[l]), w_in[l], rwkv_mu[l], rwkv_w_up[l],
                             rwkv_w0[l], rwkv_a_up[l], rwkv_a0[l], rwkv_k_k[l], rwkv_k_a[l],
                             rwkv_r_k[l], rwkv_ln_g[l], rwkv_ln_b[l], fox_f_b[l], fox_q_g[l],
                             fox_k_g[l], w_p_rwkv[l], w_p_sb[l], w_p_fox[l], w_out[l])
        h = h + hierarchical_moe(rms_norm(h, norm2_g[l]), moe_wg[l], moe_bg[l], moe_we[l],
                                 moe_be[l], moe_w_gate[l], moe_w_up[l], moe_w_down[l])
    return h[:, N_META:]
```

```cpp
#include <hip/hip_runtime.h>
#include <hip/hip_bf16.h>
#include <cstdio>
#include <cstdint>

#define GAS __attribute__((address_space(1)))
#define LAS __attribute__((address_space(3)))

namespace pg8 {
#define PG8_LAS __attribute__((address_space(3)))
typedef unsigned short bf16_t;
typedef short bf16x8 __attribute__((ext_vector_type(8)));
typedef float f32x4 __attribute__((ext_vector_type(4)));
typedef unsigned u32x4 __attribute__((ext_vector_type(4)));
constexpr int BM = 256, BK = 64, HALF = 128, HTB = HALF * BK * 2  , STAGE_BYTES = 8 * HTB, NXCD = 8, WGM = 8;

__host__ __device__ __forceinline__ int lds_byte(int r, int c) { const int st = (r >> 4) * 2 + (c >> 5), rr = r & 15, cc = c & 31, ob = rr * 64 + cc * 2; return st * 1024 + (ob ^ (((ob >> 9) & 1) << 5)); }
__host__ __device__ __forceinline__ void stage_rc(int b, int& R, int& C) { const int st = b / 1024, sb = b % 1024, swz = sb ^ (((sb >> 9) & 1) << 5); R = (st >> 1) * 16 + swz / 64; C = (st & 1) * 32 + (swz % 64) / 2; }
__host__ __device__ __forceinline__ int perm32(int rho) { const int n = rho >> 4, i = rho & 15; return 8 * (i >> 2) + 4 * n + (i & 3); }

struct Unit { int pm, pn; };
struct Gemm { const bf16_t* A; const bf16_t* Bt; int M, N, K; };

struct StaticOrder {
    int nM, nN, nwg, G, c;
    __host__ __device__ void init(int M, int N, int G_, int c_) { nM = M / BM; nN = N / BM; nwg = nM * nN; G = G_; c = c_; }
    __host__ __device__ bool next(int i, Unit& u) const {
        const long L = (long)i * G + c; if (L >= nwg) return false;
        int wgid = (int)L; { const int q = nwg / NXCD, r = nwg % NXCD, xcd = wgid % NXCD, off = wgid / NXCD; wgid = (xcd < r ? xcd * (q + 1) : r * (q + 1) + (xcd - r) * q) + off; }
        const int nig = WGM * nN, gid = wgid / nig, fm = gid * WGM, gsz = (nM - fm) < WGM ? (nM - fm) : WGM;
        u.pm = fm + ((wgid % nig) % gsz); u.pn = (wgid % nig) / gsz; return true;
    }
    __device__ __forceinline__ void a_ready(const Unit&) const {}
    __device__ __forceinline__ void done(const Unit&) const {}
};
__device__ __forceinline__ unsigned cvt_pk_bf16(float lo, float hi) { unsigned r; asm volatile("v_cvt_pk_bf16_f32 %0, %1, %2" : "=v"(r) : "v"(lo), "v"(hi)); return r; }
template <class Epi, class Sched, bool ALIGN_EPI = false, bool SP2 = false>
__device__ __forceinline__ void gemm_phase(PG8_LAS unsigned char* lds, const Gemm g, const Sched& S, const Epi& E) {
    int tid_ = threadIdx.x; asm volatile("" : "+v"(tid_));
    const int tid = tid_, wid = __builtin_amdgcn_readfirstlane(tid >> 6), lane = tid & 63, wr = wid >> 2, wc = wid & 3, fr = lane & 15, fq = lane >> 4;
    const int K = g.K, nt = K / BK;
    unsigned voffA[2], voffB[2];
#pragma unroll
    for (int i = 0; i < 2; ++i) { int R, C; stage_rc(tid * 16 + i * 8192, R, C); const int Rb = Epi::PERM ? ((R & ~31) + perm32(R & 31)) : R;
        voffA[i] = (unsigned)(R * K + C) * 2u; voffB[i] = (unsigned)(Rb * K + C) * 2u; }
    const size_t kstep = (size_t)(BK * 2);
    const size_t hstep = (size_t)HALF * K * 2;
    const size_t tstep = 2 * hstep;
    const unsigned ldsw = (unsigned)wid * 1024u;
    const int aoff = lds_byte(wr * 64 + fr, fq * 8), boff = lds_byte(wc * 32 + fr, fq * 8);
#define PG8_SA(b, h) (((b) * 2 + (h)) * HTB)
#define PG8_SB(b, h) ((4 + (b) * 2 + (h)) * HTB)
#define PG8_STAGE(bufoff, gbase, voff) do { _Pragma("unroll") for (int _i = 0; _i < 2; ++_i) \
        __builtin_amdgcn_global_load_lds((const unsigned*)((const char*)(gbase) + (voff)[_i]), (PG8_LAS unsigned*)(lds + (bufoff) + ldsw + _i * 8192), 16, 0, 0); } while (0)
#define PG8_LDA(dst, b, h) do { _Pragma("unroll") for (int m = 0; m < 4; ++m) _Pragma("unroll") for (int k = 0; k < 2; ++k) dst[m][k] = *(const PG8_LAS bf16x8*)(lds + PG8_SA(b, h) + aoff + m * 2048 + k * 1024); } while (0)
#define PG8_LDB(dst, b, h) do { _Pragma("unroll") for (int n = 0; n < 2; ++n) _Pragma("unroll") for (int k = 0; k < 2; ++k) dst[n][k] = *(const PG8_LAS bf16x8*)(lds + PG8_SB(b, h) + boff + n * 2048 + k * 1024); } while (0)
#define PG8_MMA(ai, bj, At, Bt) do { __builtin_amdgcn_s_setprio(1); _Pragma("unroll") for (int m = 0; m < 4; ++m) _Pragma("unroll") for (int n = 0; n < 2; ++n) _Pragma("unroll") for (int k = 0; k < 2; ++k) \
        acc[ai][bj][m][n] = __builtin_amdgcn_mfma_f32_16x16x32_bf16(Bt[n][k], At[m][k], acc[ai][bj][m][n], 0, 0, 0); __builtin_amdgcn_s_setprio(0); } while (0)
#define PG8_WAIT_V(n) asm volatile("s_waitcnt vmcnt(" #n ")" ::: "memory")
#define PG8_WAIT_L(n) asm volatile("s_waitcnt lgkmcnt(" #n ")" ::: "memory")
#define PG8_BAR __builtin_amdgcn_s_barrier()
#define PG8_SCHED __builtin_amdgcn_sched_barrier(0)
    Unit cur, nxt; int ui = 0;
    if (!S.next(0, cur)) return;
    f32x4 acc[2][2][4][2];
#pragma unroll
    for (int a = 0; a < 2; ++a)
#pragma unroll
        for (int b = 0; b < 2; ++b)
#pragma unroll
            for (int m = 0; m < 4; ++m)
#pragma unroll
                for (int n = 0; n < 2; ++n) acc[a][b][m][n] = (f32x4){0.f, 0.f, 0.f, 0.f};
    bf16x8 At[4][2], B0[2][2], B1[2][2];
    const char* cA = (const char*)g.A + (size_t)cur.pm * tstep; const char* cB = (const char*)g.Bt + (size_t)cur.pn * tstep;
    S.a_ready(cur);
    if constexpr (SP2) {
        PG8_STAGE(PG8_SB(0, 0), cB, voffB); PG8_STAGE(PG8_SB(0, 1), cB + hstep, voffB); PG8_STAGE(PG8_SA(0, 0), cA, voffA); PG8_STAGE(PG8_SA(0, 1), cA + hstep, voffA);
        if (wr == 1) PG8_BAR;
        PG8_WAIT_V(2); PG8_BAR;
        PG8_STAGE(PG8_SB(1, 0), cB + kstep, voffB); PG8_STAGE(PG8_SA(1, 0), cA + kstep, voffA); PG8_STAGE(PG8_SB(1, 1), cB + hstep + kstep, voffB);
        PG8_WAIT_V(6); PG8_BAR;
    } else {
        PG8_STAGE(PG8_SB(0, 0), cB, voffB); PG8_STAGE(PG8_SA(0, 0), cA, voffA); PG8_STAGE(PG8_SB(0, 1), cB + hstep, voffB); PG8_STAGE(PG8_SA(0, 1), cA + hstep, voffA);
        if (wr == 1) PG8_BAR;
        PG8_WAIT_V(4); PG8_BAR;
        PG8_STAGE(PG8_SB(1, 0), cB + kstep, voffB); PG8_STAGE(PG8_SA(1, 0), cA + kstep, voffA); PG8_STAGE(PG8_SB(1, 1), cB + hstep + kstep, voffB);
        PG8_WAIT_V(6); PG8_BAR;
    }
    for (;;) {
        const bool has_next = S.next(ui + 1, nxt);
        const char* nA = has_next ? (const char*)g.A + (size_t)nxt.pm * tstep : cA; const char* nB = has_next ? (const char*)g.Bt + (size_t)nxt.pn * tstep : cB;
        for (int t = 0; t < nt; t += 2) {
            const bool last = (t == nt - 2);
            const char* a1 = cA + (size_t)(t + 1) * kstep;
            const char* a2 = last ? nA : cA + (size_t)(t + 2) * kstep; const char* b2 = last ? nB : cB + (size_t)(t + 2) * kstep;
            const char* a3 = a2 + kstep; const char* b3 = b2 + kstep;
            if (last && has_next) S.a_ready(nxt);
            if constexpr (SP2) {
            PG8_LDB(B0, 0, 0); PG8_LDB(B1, 0, 1); PG8_SCHED; PG8_LDA(At, 0, 0); PG8_STAGE(PG8_SA(1, 1), a1 + hstep, voffA);
            PG8_WAIT_V(8); PG8_WAIT_L(0); PG8_BAR; PG8_MMA(0, 0, At, B0); PG8_MMA(0, 1, At, B1); PG8_BAR; PG8_SCHED;
            PG8_LDA(At, 0, 1); PG8_STAGE(PG8_SB(0, 0), b2, voffB); PG8_STAGE(PG8_SB(0, 1), b2 + hstep, voffB); PG8_STAGE(PG8_SA(0, 0), a2, voffA);
            PG8_WAIT_V(8); PG8_WAIT_L(0); PG8_BAR; PG8_MMA(1, 0, At, B0); PG8_MMA(1, 1, At, B1); PG8_BAR; PG8_SCHED;
            PG8_LDB(B0, 1, 0); PG8_LDB(B1, 1, 1); PG8_SCHED; PG8_LDA(At, 1, 0); PG8_STAGE(PG8_SA(0, 1), a2 + hstep, voffA);
            PG8_WAIT_V(8); PG8_WAIT_L(0); PG8_BAR; PG8_MMA(0, 0, At, B0); PG8_MMA(0, 1, At, B1); PG8_BAR; PG8_SCHED;
            PG8_LDA(At, 1, 1); PG8_STAGE(PG8_SB(1, 0), b3, voffB); PG8_STAGE(PG8_SB(1, 1), b3 + hstep, voffB); PG8_STAGE(PG8_SA(1, 0), a3, voffA);
            PG8_WAIT_V(8); PG8_WAIT_L(0); PG8_BAR; PG8_MMA(1, 0, At, B0); PG8_MMA(1, 1, At, B1); PG8_BAR; PG8_SCHED;
            } else {
            PG8_LDB(B0, 0, 0); PG8_SCHED; PG8_LDA(At, 0, 0); PG8_STAGE(PG8_SA(1, 1), a1 + hstep, voffA);
            PG8_WAIT_L(8); PG8_BAR; PG8_WAIT_L(0); PG8_MMA(0, 0, At, B0); PG8_BAR; PG8_SCHED;
            PG8_LDB(B1, 0, 1); PG8_STAGE(PG8_SB(0, 0), b2, voffB);
            PG8_BAR; PG8_WAIT_L(0); PG8_MMA(0, 1, At, B1); PG8_BAR;
            PG8_LDA(At, 0, 1); PG8_STAGE(PG8_SA(0, 0), a2, voffA);
            PG8_BAR; PG8_WAIT_L(0); PG8_MMA(1, 0, At, B0); PG8_BAR; PG8_SCHED;
            PG8_STAGE(PG8_SB(0, 1), b2 + hstep, voffB);
            PG8_WAIT_V(6); PG8_BAR; PG8_MMA(1, 1, At, B1); PG8_BAR;
            PG8_LDB(B0, 1, 0); PG8_SCHED; PG8_LDA(At, 1, 0); PG8_STAGE(PG8_SA(0, 1), a2 + hstep, voffA);
            PG8_WAIT_L(8); PG8_BAR; PG8_WAIT_L(0); PG8_MMA(0, 0, At, B0); PG8_BAR; PG8_SCHED;
            PG8_LDB(B1, 1, 1); PG8_STAGE(PG8_SB(1, 0), b3, voffB);
            PG8_BAR; PG8_WAIT_L(0); PG8_MMA(0, 1, At, B1); PG8_BAR;
            PG8_LDA(At, 1, 1); PG8_STAGE(PG8_SA(1, 0), a3, voffA);
            PG8_BAR; PG8_WAIT_L(0); PG8_MMA(1, 0, At, B0); PG8_BAR; PG8_SCHED;
            PG8_STAGE(PG8_SB(1, 1), b3 + hstep, voffB);
            PG8_WAIT_V(6); PG8_BAR; PG8_MMA(1, 1, At, B1); PG8_BAR;
            }
        }
        if constexpr (ALIGN_EPI) { if (wr == 0) PG8_BAR; }
        if constexpr (!Epi::AFTER_DRAIN) { E(acc, cur, wr, wc, fr, fq); S.done(cur); }
        if (!has_next) break;
#pragma unroll
        for (int a = 0; a < 2; ++a)
#pragma unroll
            for (int b = 0; b < 2; ++b)
#pragma unroll
                for (int m = 0; m < 4; ++m)
#pragma unroll
                    for (int n = 0; n < 2; ++n) acc[a][b][m][n] = (f32x4){0.f, 0.f, 0.f, 0.f};
        cur = nxt; cA = nA; cB = nB; ++ui;
        if constexpr (ALIGN_EPI) { if (wr == 1) PG8_BAR; }
    }
    PG8_WAIT_V(0);
    if constexpr (!ALIGN_EPI) { if (wr == 0) PG8_BAR; }
    PG8_BAR;
    if constexpr (Epi::AFTER_DRAIN) { E.fused(acc, cur, wr, wc, fr, fq, lds, wid, lane); S.done(cur); }
#undef PG8_SA
#undef PG8_SB
#undef PG8_STAGE
#undef PG8_LDA
#undef PG8_LDB
#undef PG8_MMA
#undef PG8_WAIT_V
#undef PG8_WAIT_L
#undef PG8_BAR
#undef PG8_SCHED
}
}

constexpr int D = 1024, NB = 2, SEQ = 16384, NMETA = 16, LTOK = SEQ + NMETA  , PADR = 112, T = PADR + LTOK  ;
constexpr int M = NB * T;
constexpr int DEPTH = 2, HD = 64, RW_H = 6, SB_H = 5, FX_H = 5, RW_W = 384, SHIFT_W = 1280, D_IN = 6277;
constexpr int QKV_W = 1920;
constexpr int N1 = 3328;
constexpr int FCOL = 3200, GCOL = 3205;
constexpr int NEXP = 16, DEXP = 256;
constexpr int MS = 70144;
constexpr int LCH = 32, LPADDED = 16416;
constexpr int KBP = 16896;
constexpr float C2 = 0.125f * 1.4426950408889634f;
constexpr float LOG2E = 1.4426950408889634f;
constexpr int NWAVES = 8, NTHR = 512;

constexpr size_t MiB = 1u << 20;
constexpr size_t WS_CTL = 0, CTL_ZERO_BYTES = 65536;
constexpr size_t WS_HM = 1 * MiB;
constexpr size_t WS_LOGF = WS_HM + 131072;
constexpr size_t WS_KB2 = WS_LOGF + (size_t)M * 32;
constexpr size_t WS_TOK = WS_KB2 + (size_t)10 * KBP * 4;
constexpr size_t WS_SLOT = WS_TOK + (size_t)M * 32;
constexpr size_t WS_CWS = WS_SLOT + (size_t)M * 8;
constexpr size_t WS_WGCNT = WS_CWS + (size_t)MS * 4;
constexpr size_t WS_SMALL_END = WS_WGCNT + 256 * 16 * 4;
static_assert(WS_SMALL_END <= 8 * MiB, "small buffers");
constexpr size_t WS_WIN = 8 * MiB;
constexpr size_t WS_WG = WS_WIN + (size_t)N1 * 1024 * 2;
constexpr size_t WS_WP = WS_WG + (size_t)3072 * 1024 * 2;
constexpr size_t WS_WO = WS_WP + (size_t)3072 * 384 * 2;
constexpr size_t WS_WGU = WS_WO + (size_t)1024 * 1024 * 2;
constexpr size_t WS_WD = WS_WGU + (size_t)8192 * 1024 * 2;
constexpr size_t WS_W_END = WS_WD + (size_t)16384 * 256 * 2;
static_assert(WS_W_END <= 49 * MiB, "weights");
constexpr size_t WS_A = 49 * MiB;
constexpr size_t WS_BIG = 115 * MiB;
constexpr size_t WS_USH = WS_BIG;
constexpr size_t WS_YCAT = WS_BIG;
constexpr size_t WS_QKV = WS_BIG + 82 * MiB;
constexpr size_t WS_RW = WS_BIG + 204 * MiB;
constexpr size_t WS_BN = WS_BIG + 349 * MiB;
constexpr size_t WS_GATES = WS_BIG + 82 * MiB;
constexpr size_t WS_MERGED = WS_BIG + 276 * MiB;
constexpr size_t WS_AS = WS_BIG;
constexpr size_t WS_HS = WS_BIG + 137 * MiB;
constexpr size_t WS_Y = WS_BIG + 172 * MiB;
constexpr size_t WS_END = WS_BIG + 374 * MiB;
static_assert((size_t)(M + 256) * 1280 * 2 <= 82 * MiB && (size_t)3 * M * 384 * 2 <= 82 * MiB && (size_t)(M + 256) * 1920 * 2 <= 122 * MiB, "big map 1");
static_assert((size_t)12 * LPADDED * 768 <= 145 * MiB && (size_t)M * 384 * 2 <= 25 * MiB && (size_t)M * 3072 * 2 <= 194 * MiB && (size_t)M * 2048 <= 65 * MiB, "big map 2");
static_assert((size_t)MS * 2048 <= 137 * MiB && (size_t)MS * 512 <= 35 * MiB && WS_END <= 489 * MiB, "big map 3");

constexpr int CW_BAR = 0;
constexpr int CW_QUEUE = 4096;
constexpr int CW_ECNT = 4352;
static_assert((CW_ECNT + 128) * 4 <= (int)CTL_ZERO_BYTES, "ctl");

constexpr int RING_BYTES = 131072, MISC_OFF = RING_BYTES, LDS_BYTES = 147456;

typedef unsigned short bf16_t;
typedef float f32x4 __attribute__((ext_vector_type(4)));
typedef float f32x2 __attribute__((ext_vector_type(2)));
typedef float f32x16 __attribute__((ext_vector_type(16)));
typedef unsigned u32x4 __attribute__((ext_vector_type(4)));
typedef unsigned u32x2 __attribute__((ext_vector_type(2)));
typedef short bf16x8 __attribute__((ext_vector_type(8)));
typedef short s16x4 __attribute__((ext_vector_type(4)));
typedef _Float16 f16x4 __attribute__((ext_vector_type(4)));
typedef __bf16 bf16x2_t __attribute__((ext_vector_type(2)));

__device__ __forceinline__ unsigned pk2(float lo, float hi) { f32x2 v = {lo, hi}; bf16x2_t b = __builtin_convertvector(v, bf16x2_t); return __builtin_bit_cast(unsigned, b); }
__device__ __forceinline__ unsigned short f2bf(float f) { return (unsigned short)(pk2(f, 0.f) & 0xffffu); }
__device__ __forceinline__ float bf_lo(unsigned u) { return __uint_as_float(u << 16); }
__device__ __forceinline__ float bf_hi(unsigned u) { return __uint_as_float(u & 0xffff0000u); }
__device__ __forceinline__ float bf2f(unsigned short h) { return __uint_as_float((unsigned)h << 16); }
__device__ __forceinline__ float wave_sum(float v) {
#pragma unroll
    for (int o = 1; o < 64; o <<= 1) v += __shfl_xor(v, o);
    return v;
}
__device__ __forceinline__ float fast_exp(float x) { return __builtin_amdgcn_exp2f(x * LOG2E); }
__device__ __forceinline__ float fast_log(float x) { return __builtin_amdgcn_logf(x) * 0.6931471805599453f; }
__device__ __forceinline__ float softplus_f(float z) { return fmaxf(z, 0.f) + fast_log(1.f + fast_exp(-fabsf(z))); }

#define XB_TMO      128
#define XB_XCNT(j)  (256  + 64 * (j))
#define XB_XSUB(j)  (1280 + 64 * (j))
#define XB_XGEN(j)  (2304 + 64 * (j))
#define XB_TOP      3328
#define XB_TOPGEN   3392
#define XCD_BAR_WORDS 3456
#define XB_SPIN_CAP (1u << 20)
__device__ __forceinline__ unsigned xb_ld(unsigned* p)              { return __hip_atomic_load(p, __ATOMIC_RELAXED, __HIP_MEMORY_SCOPE_AGENT); }
__device__ __forceinline__ unsigned xb_add(unsigned* p, unsigned v) { return __hip_atomic_fetch_add(p, v, __ATOMIC_RELAXED, __HIP_MEMORY_SCOPE_AGENT); }
__device__ __forceinline__ unsigned xb_xcc_id() { return (unsigned)__builtin_amdgcn_s_getreg((3 << 11) | 20) & 0xFu; }
#define XB_SPIN(cond, bar) do { unsigned _sp = 0; while (cond) { __builtin_amdgcn_s_sleep(1); \
    if ((++_sp & 255u) == 0u) { if (xb_ld(&(bar)[XB_TMO])) break; if (_sp > XB_SPIN_CAP) { atomicAdd(&(bar)[XB_TMO], 1u); break; } } } } while (0)

struct XcdBarrier {
    unsigned* bar; unsigned x;
    volatile LAS unsigned* st;
};

__device__ __forceinline__ XcdBarrier xcd_barrier_post(unsigned* bar, volatile LAS unsigned* st) {
    XcdBarrier b; b.bar = bar; b.x = xb_xcc_id(); b.st = st;
    if (threadIdx.x == 0) (void)xb_add(&bar[XB_XCNT(b.x)], 1u);
    return b;
}
__device__ __forceinline__ void xcd_barrier_complete(unsigned* bar, unsigned x, unsigned& nloc, unsigned& nx) {
    const unsigned G = gridDim.x * gridDim.y * gridDim.z;
    unsigned sum, cnt, mine, sp = 0u;
    for (;;) {
        sum = 0u; cnt = 0u; mine = 0u;
#pragma unroll
        for (unsigned j = 0; j < 16; ++j) { const unsigned c = xb_ld(&bar[XB_XCNT(j)]); sum += c; cnt += (c > 0u) ? 1u : 0u; mine = (j == x) ? c : mine; }
        if (sum == G) break;
        __builtin_amdgcn_s_sleep(1);
        if ((++sp & 255u) == 0u) { if (xb_ld(&bar[XB_TMO])) break; if (sp > XB_SPIN_CAP) { atomicAdd(&bar[XB_TMO], 1u); break; } }
    }
    nloc = mine > 0u ? mine : 1u; nx = cnt > 0u ? cnt : 1u;
}

__device__ __forceinline__ void xcd_barrier(const XcdBarrier& b) {
    asm volatile("s_waitcnt vmcnt(0)" ::: "memory");
    __syncthreads();
    if (threadIdx.x == 0) {
        unsigned* bar = b.bar;
        __builtin_amdgcn_s_waitcnt(0);
        unsigned nloc = b.st[0], nx = b.st[1];
        if (nloc == 0u) { xcd_barrier_complete(bar, b.x, nloc, nx); b.st[0] = nloc; b.st[1] = nx; }
        const unsigned old = xb_add(&bar[XB_XSUB(b.x)], 1u);
        const unsigned gen = old / nloc;
        if (old + 1u == (gen + 1u) * nloc) {
            __builtin_amdgcn_fence(__ATOMIC_RELEASE, "agent");
            asm volatile("s_waitcnt vmcnt(0)" ::: "memory");
            const unsigned og = xb_add(&bar[XB_TOP], 1u);
            const unsigned tg = og / nx;
            if (og + 1u == (tg + 1u) * nx) xb_add(&bar[XB_TOPGEN], 1u);
            else XB_SPIN(xb_ld(&bar[XB_TOPGEN]) == tg, bar);
            __builtin_amdgcn_fence(__ATOMIC_ACQUIRE, "agent");
            xb_add(&bar[XB_XGEN(b.x)], 1u);
            asm volatile("s_waitcnt vmcnt(0)" ::: "memory");
        } else {
            XB_SPIN(xb_ld(&bar[XB_XGEN(b.x)]) == gen, bar);
            __builtin_amdgcn_fence(__ATOMIC_ACQUIRE, "agent");
            asm volatile("s_waitcnt vmcnt(0)" ::: "memory");
        }
    }
    __syncthreads();
}

struct Args { const float* in[29]; float* out; unsigned char* ws; };
enum { I_X = 0, I_META, I_N1G, I_WIN, I_MU, I_WUP, I_W0, I_AUP, I_A0, I_KK, I_KA, I_RK, I_LNG, I_LNB, I_FB, I_QG, I_KG, I_WPR, I_WPS, I_WPF, I_WOUT, I_N2G, I_MWG, I_MBG, I_MWE, I_MBE, I_MGATE, I_MUP, I_MDOWN };
struct Frame { LAS unsigned char* lds; volatile LAS unsigned* MISC; int tid, lane, wave; };

__device__ __forceinline__ float* hrow(const Args& a, int b, int l) {
    return l < NMETA ? (float*)(a.ws + WS_HM) + (size_t)(b * NMETA + l) * D : a.out + ((size_t)b * SEQ + (l - NMETA)) * D;
}
#define LDS_WAIT() asm volatile("s_waitcnt lgkmcnt(0)" ::: "memory")

__device__ __forceinline__ void tr_item(const float* W, int ldw, int sc0, int nvalid, int k0, int kvalid, bf16_t* WT, int Kd, int r0, LAS float* scr, int lane) {
#pragma unroll 8
    for (int i = 0; i < 32; ++i) { const int kk = 2 * i + (lane >> 5), n = lane & 31; float v = 0.f;
        if (n < nvalid && k0 + kk < kvalid) v = W[(size_t)(k0 + kk) * ldw + sc0 + n];
        scr[kk * 33 + n] = v; }
    LDS_WAIT();
    const int c = lane & 7;
#pragma unroll
    for (int j = 0; j < 4; ++j) { const int n = (lane >> 3) + 8 * j; const LAS float* s = scr + (8 * c) * 33 + n;
        u32x4 o; o.x = pk2(s[0 * 33], s[1 * 33]); o.y = pk2(s[2 * 33], s[3 * 33]); o.z = pk2(s[4 * 33], s[5 * 33]); o.w = pk2(s[6 * 33], s[7 * 33]);
        *(u32x4*)(WT + (size_t)(r0 + n) * Kd + k0 + 8 * c) = o; }
    LDS_WAIT();
}
__device__ __forceinline__ void phase_wconv(const Args& a, Frame& F, int layer) {
    LAS float* scr = (LAS float*)(F.lds + F.wave * 8448);
    const int gw = blockIdx.x * NWAVES + F.wave, NGW = gridDim.x * NWAVES;
    constexpr int C1 = 16 * 104, C2_ = C1 + 16 * 96, C3 = C2_ + 6 * 96, C4 = C3 + 16 * 32, C5 = C4 + 16 * 256, C6 = C5 + 4 * 512;
    unsigned char* ws = a.ws;
    for (int it = gw; it < C6; it += NGW) {
        if (it < C1) { const int kb = it / 104, nb = it % 104, r0 = nb * 32;
            tr_item(a.in[I_WIN] + (size_t)layer * D * D_IN, D_IN, r0, r0 < FCOL ? 32 : 0, kb * 64, 1024, (bf16_t*)(ws + WS_WIN), 1024, r0, scr, F.lane); }
        else if (it < C2_) { const int r = it - C1, kb = r / 96, nb = r % 96, r0 = nb * 32;
            tr_item(a.in[I_WIN] + (size_t)layer * D * D_IN, D_IN, GCOL + r0, 32, kb * 64, 1024, (bf16_t*)(ws + WS_WG), 1024, r0, scr, F.lane); }
        else if (it < C3) { const int r = it - C2_, kb = r / 96, nb = r % 96, r0 = nb * 32, br = r0 >> 10;
            const float* W = (br == 0 ? a.in[I_WPR] + (size_t)layer * 384 * D : br == 1 ? a.in[I_WPS] + (size_t)layer * 320 * D : a.in[I_WPF] + (size_t)layer * 320 * D);
            tr_item(W, D, r0 & 1023, 32, kb * 64, br == 0 ? 384 : 320, (bf16_t*)(ws + WS_WP), 384, r0, scr, F.lane); }
        else if (it < C4) { const int r = it - C3, kb = r / 32, nb = r % 32, r0 = nb * 32;
            tr_item(a.in[I_WOUT] + (size_t)layer * D * D, D, r0, 32, kb * 64, 1024, (bf16_t*)(ws + WS_WO), 1024, r0, scr, F.lane); }
        else if (it < C5) { const int r = it - C4, kb = r / 256, nb = r % 256, r0 = nb * 32, e = r0 >> 9, rr = r0 & 511, j = rr >> 8, q = rr & 255;
            const float* W = (q >= 128 ? a.in[I_MUP] : a.in[I_MGATE]) + ((size_t)layer * NEXP + e) * D * DEXP;
            tr_item(W, DEXP, j * 128 + (q & 127), 32, kb * 64, 1024, (bf16_t*)(ws + WS_WGU), 1024, r0, scr, F.lane); }
        else { const int r = it - C5, kb = r / 512, nb = r % 512, r0 = nb * 32, e = r0 >> 10;
            tr_item(a.in[I_MDOWN] + ((size_t)layer * NEXP + e) * DEXP * D, D, r0 & 1023, 32, kb * 64, 256, (bf16_t*)(ws + WS_WD), 256, r0, scr, F.lane); }
    }
}

__device__ __forceinline__ void add_y_row(f32x4 (&v)[4], const bf16_t* Y, int slot, int lane) {
    const u32x2* y = (const u32x2*)(Y + (size_t)slot * D) + lane;
#pragma unroll
    for (int j = 0; j < 4; ++j) { const u32x2 t = y[64 * j]; v[j].x += bf_lo(t.x); v[j].y += bf_hi(t.x); v[j].z += bf_lo(t.y); v[j].w += bf_hi(t.y); }
}
template <int MODE>
__device__ __forceinline__ void phase_norm(const Args& a, Frame& F, int layer) {
    const int lane = F.lane;
    LAS float* wl = (LAS float*)F.lds;
    LAS int* lcnt = (LAS int*)(F.lds + 20 * 4096);
    unsigned char* ws = a.ws;
    if (MODE == 1) {
        const float* win = a.in[I_WIN] + (size_t)layer * D * D_IN;
        for (int idx = F.tid; idx < 5 * 1024; idx += NTHR) { const int k = idx / 5, j = idx % 5; wl[j * 1024 + k] = win[(size_t)k * D_IN + FCOL + j]; }
    }
    if (MODE == 2) {
        const float* wg = a.in[I_MWG] + (size_t)layer * D * 4; const float* we = a.in[I_MWE] + (size_t)layer * D * 16;
        for (int idx = F.tid; idx < 4 * 1024; idx += NTHR) { const int k = idx >> 2, j = idx & 3; wl[j * 1024 + k] = wg[idx]; }
        for (int idx = F.tid; idx < 16 * 1024; idx += NTHR) { const int k = idx >> 4, j = idx & 15; wl[(4 + j) * 1024 + k] = we[idx]; }
        if (F.tid < 16) lcnt[F.tid] = 0;
    }
    __syncthreads();
    const int gw = blockIdx.x * NWAVES + F.wave, NGW = gridDim.x * NWAVES;
    const float* gsrc = (MODE == 2 ? a.in[I_N2G] : a.in[I_N1G]) + layer * D;
    f32x4 gv[4];
#pragma unroll
    for (int j = 0; j < 4; ++j) gv[j] = (MODE == 0) ? (f32x4){0.f, 0.f, 0.f, 0.f} : *(const f32x4*)(gsrc + 4 * lane + 256 * j);
    bf16_t* A = (bf16_t*)(ws + WS_A);
    const bf16_t* Y = (const bf16_t*)(ws + WS_Y);
    const int* SLOT = (const int*)(ws + WS_SLOT);
    for (int m = gw; m < M; m += NGW) {
        const int b = m / T, p = m - b * T, l = p - PADR;
        if (l < 0) {
            if (MODE == 1) {
                u32x2* o = (u32x2*)(A + (size_t)m * D) + lane;
#pragma unroll
                for (int j = 0; j < 4; ++j) o[64 * j] = (u32x2){0u, 0u};
                if (lane < 8) ((float*)(ws + WS_LOGF))[(size_t)m * 8 + lane] = 0.f;
            }
            continue;
        }
        if (MODE == 0 && l < NMETA) continue;
        float* hp = hrow(a, b, l);
        const float* src = hp;
        if (MODE == 1 && layer == 0) src = (l < NMETA) ? a.in[I_META] + (size_t)l * D : a.in[I_X] + ((size_t)b * SEQ + (l - NMETA)) * D;
        f32x4 v[4];
#pragma unroll
        for (int j = 0; j < 4; ++j) v[j] = *(const f32x4*)(src + 4 * lane + 256 * j);
        if (MODE == 0 || (MODE == 1 && layer > 0)) {
            const int s0 = SLOT[2 * m], s1 = SLOT[2 * m + 1];
            add_y_row(v, Y, s0, lane); add_y_row(v, Y, s1, lane);
        }
        if (MODE == 0 || MODE == 1) {
#pragma unroll
            for (int j = 0; j < 4; ++j) *(f32x4*)(hp + 4 * lane + 256 * j) = v[j];
        }
        if (MODE == 0) continue;
        float ss = 0.f;
#pragma unroll
        for (int j = 0; j < 4; ++j) ss += (v[j].x * v[j].x + v[j].y * v[j].y) + (v[j].z * v[j].z + v[j].w * v[j].w);
        const float r = 1.0f / sqrtf(wave_sum(ss) * (1.0f / D) + 1e-6f);
#pragma unroll
        for (int j = 0; j < 4; ++j) v[j] = v[j] * r * gv[j];
        u32x2* o = (u32x2*)(A + (size_t)m * D) + lane;
#pragma unroll
        for (int j = 0; j < 4; ++j) o[64 * j] = (u32x2){pk2(v[j].x, v[j].y), pk2(v[j].z, v[j].w)};
        if (MODE == 1) {
            float dsum[5];
#pragma unroll
            for (int q = 0; q < 5; ++q) { float d = 0.f;
#pragma unroll
                for (int j = 0; j < 4; ++j) { const f32x4 w = *(const LAS f32x4*)(wl + q * 1024 + 4 * lane + 256 * j); d += (v[j].x * w.x + v[j].y * w.y) + (v[j].z * w.z + v[j].w * w.w); }
                dsum[q] = wave_sum(d); }
            float mine = dsum[0];
            mine = lane == 1 ? dsum[1] : mine; mine = lane == 2 ? dsum[2] : mine; mine = lane == 3 ? dsum[3] : mine; mine = lane == 4 ? dsum[4] : mine;
            if (lane < 8) { float lf = 0.f;
                if (lane < 5) { const float xx = mine + a.in[I_FB][layer * 5 + lane]; lf = fminf(xx, 0.f) - fast_log(1.f + fast_exp(-fabsf(xx))); }
                ((float*)(ws + WS_LOGF))[(size_t)m * 8 + lane] = lf; }
        }
        if (MODE == 2) {
            float ds[20];
#pragma unroll
            for (int q = 0; q < 20; ++q) { float d = 0.f;
#pragma unroll
                for (int j = 0; j < 4; ++j) { const f32x4 w = *(const LAS f32x4*)(wl + q * 1024 + 4 * lane + 256 * j); d += (v[j].x * w.x + v[j].y * w.y) + (v[j].z * w.z + v[j].w * w.w); }
                ds[q] = wave_sum(d); }
            const float* bg = a.in[I_MBG] + layer * 4; const float* be = a.in[I_MBE] + layer * 16;
            float lg0 = ds[0] + bg[0], lg1 = ds[1] + bg[1], lg2 = ds[2] + bg[2], lg3 = ds[3] + bg[3];
            int g = 0; float mx = lg0;
            if (lg1 > mx) { mx = lg1; g = 1; } if (lg2 > mx) { mx = lg2; g = 2; } if (lg3 > mx) { mx = lg3; g = 3; }
            const float den = fast_exp(lg0 - mx) + fast_exp(lg1 - mx) + fast_exp(lg2 - mx) + fast_exp(lg3 - mx);
            const float pgrp = 1.0f / den;
            float s0 = g == 0 ? ds[4] : g == 1 ? ds[8] : g == 2 ? ds[12] : ds[16];
            float s1 = g == 0 ? ds[5] : g == 1 ? ds[9] : g == 2 ? ds[13] : ds[17];
            float s2 = g == 0 ? ds[6] : g == 1 ? ds[10] : g == 2 ? ds[14] : ds[18];
            float s3 = g == 0 ? ds[7] : g == 1 ? ds[11] : g == 2 ? ds[15] : ds[19];
            s0 += be[g * 4 + 0]; s1 += be[g * 4 + 1]; s2 += be[g * 4 + 2]; s3 += be[g * 4 + 3];
            int i0 = 0; float v0 = s0;
            if (s1 > v0) { v0 = s1; i0 = 1; } if (s2 > v0) { v0 = s2; i0 = 2; } if (s3 > v0) { v0 = s3; i0 = 3; }
            int i1 = -1; float v1 = -3.0e38f;
            if (i0 != 0 && s0 > v1) { v1 = s0; i1 = 0; } if (i0 != 1 && s1 > v1) { v1 = s1; i1 = 1; } if (i0 != 2 && s2 > v1) { v1 = s2; i1 = 2; } if (i0 != 3 && s3 > v1) { v1 = s3; i1 = 3; }
            const float e1 = fast_exp(v1 - v0), pt0 = 1.0f / (1.0f + e1), pt1 = e1 * pt0;
            if (lane == 0) {
                const int ea = g * 4 + i0, eb = g * 4 + i1;
                const int la = atomicAdd((int*)&lcnt[ea], 1), lb = atomicAdd((int*)&lcnt[eb], 1);
                int* tk = (int*)(ws + WS_TOK) + (size_t)m * 8;
                tk[0] = ea; tk[1] = eb; tk[2] = __float_as_int(pgrp * pt0); tk[3] = __float_as_int(pgrp * pt1); tk[4] = la; tk[5] = lb;
            }
        }
    }
    __syncthreads();
    if (MODE == 2 && F.tid < 16) {
        const int c = lcnt[F.tid];
        ((int*)(ws + WS_WGCNT))[blockIdx.x * 16 + F.tid] = c;
        atomicAdd((int*)(ws + WS_CTL) + CW_ECNT + 64 * layer + F.tid, c);
    }
    __syncthreads();
}

__device__ __forceinline__ void phase_route(const Args& a, Frame& F, int layer) {
    unsigned char* ws = a.ws;
    LAS int* tbl = (LAS int*)F.lds;
    if (F.tid < 16) {
        const int* cnt = (const int*)(ws + WS_CTL) + CW_ECNT + 64 * layer;
        int base = 0;
        for (int e = 0; e < F.tid; ++e) base += ((__hip_atomic_load(cnt + e, __ATOMIC_RELAXED, __HIP_MEMORY_SCOPE_AGENT) + 255) >> 8) << 8;
        const int* wc = (const int*)(ws + WS_WGCNT);
        for (int w = 0; w < (int)blockIdx.x; ++w) base += wc[w * 16 + F.tid];
        tbl[F.tid] = base;
    }
    __syncthreads();
    const int gw = blockIdx.x * NWAVES + F.wave, NGW = gridDim.x * NWAVES, lane = F.lane;
    const bf16_t* A = (const bf16_t*)(ws + WS_A); bf16_t* AS = (bf16_t*)(ws + WS_AS);
    for (int m = gw; m < M; m += NGW) {
        const int b = m / T, p = m - b * T, l = p - PADR;
        if (l < 0) continue;
        const int* tk = (const int*)(ws + WS_TOK) + (size_t)m * 8;
        const int ea = tk[0], eb = tk[1], sa = tbl[ea] + tk[4], sb = tbl[eb] + tk[5];
        const u32x4* src = (const u32x4*)(A + (size_t)m * D) + lane;
        const u32x4 x0 = src[0], x1 = src[64];
        u32x4* d0 = (u32x4*)(AS + (size_t)sa * D) + lane; u32x4* d1 = (u32x4*)(AS + (size_t)sb * D) + lane;
        d0[0] = x0; d0[64] = x1; d1[0] = x0; d1[64] = x1;
        if (lane == 0) { int* sl = (int*)(ws + WS_SLOT) + 2 * m; sl[0] = sa; sl[1] = sb;
            float* cw = (float*)(ws + WS_CWS); cw[sa] = __int_as_float(tk[2]); cw[sb] = __int_as_float(tk[3]); }
    }
    __syncthreads();
}

__device__ __forceinline__ void phase_prep(const Args& a, Frame& F, int layer) {
    unsigned char* ws = a.ws;
    LAS float* xs = (LAS float*)F.lds;
    const int wave = F.wave, lane = F.lane, tid = F.tid;
    const int m0 = blockIdx.x * 129;
    const bf16_t* USH = (const bf16_t*)(ws + WS_USH);
    bf16_t* QKV = (bf16_t*)(ws + WS_QKV);
    if (blockIdx.x < 10 && wave == 7) {
        const int bh = blockIdx.x, b = bh / 5, h = bh % 5;
        const float* LOGF = (const float*)(ws + WS_LOGF);
        float* kb = (float*)(ws + WS_KB2) + (size_t)bh * KBP;
        float carry = 0.f;
        for (int l0 = 0; l0 < LTOK; l0 += 64) {
            const int l = l0 + lane;
            float v = (l < LTOK) ? LOGF[(size_t)(b * T + PADR + l) * 8 + h] : 0.f;
#pragma unroll
            for (int o = 1; o < 64; o <<= 1) { const float t = __shfl_up(v, o); if (lane >= o) v += t; }
            const float c = carry + v;
            if (l < LTOK) kb[PADR + l] = -c * LOG2E;
            carry += __shfl(v, 63);
        }
        for (int p = lane; p < PADR; p += 64) kb[p] = 0.f;
        for (int p = T + lane; p < KBP; p += 64) kb[p] = 0.f;
    }
    float w0j = 0.f, a0j = 0.f, kkj = 0.f, kaj = 0.f, rkj = 0.f;
    const int jch = wave * 64 + lane;
    const float* WU = a.in[I_WUP] + (size_t)layer * 64 * RW_W + (wave < 6 ? jch : 0); const float* AU = a.in[I_AUP] + (size_t)layer * 64 * RW_W + (wave < 6 ? jch : 0);
    if (wave < 6) {
        w0j = a.in[I_W0][layer * RW_W + jch]; a0j = a.in[I_A0][layer * RW_W + jch];
        kkj = a.in[I_KK][layer * RW_W + jch]; kaj = a.in[I_KA][layer * RW_W + jch]; rkj = a.in[I_RK][layer * RW_W + jch];
    }
    const float* mu = a.in[I_MU] + layer * SHIFT_W;
    const float gq = a.in[I_QG][layer * 64 + lane] * C2, gk = a.in[I_KG][layer * 64 + lane];
    _Float16* RW = (_Float16*)(ws + WS_RW);
    bf16_t* BN = (bf16_t*)(ws + WS_BN);
    for (int t0 = 0; t0 < 129; t0 += 16) {
        const int nt = (129 - t0) < 16 ? (129 - t0) : 16;
        for (int item = tid; item < nt * 160; item += NTHR) {
            const int tok = item / 160, ch = item - tok * 160, m = m0 + t0 + tok;
            const u32x4 u = *(const u32x4*)(USH + (size_t)m * SHIFT_W + ch * 8);
            u32x4 pv = (u32x4){0u, 0u, 0u, 0u};
            if (m > 0) pv = *(const u32x4*)(USH + (size_t)(m - 1) * SHIFT_W + ch * 8);
            const f32x4 mu0 = *(const f32x4*)(mu + ch * 8), mu1 = *(const f32x4*)(mu + ch * 8 + 4);
            float x[8];
            { float uu, pp;
              uu = bf_lo(u.x); pp = bf_lo(pv.x); x[0] = uu + (pp - uu) * mu0.x;  uu = bf_hi(u.x); pp = bf_hi(pv.x); x[1] = uu + (pp - uu) * mu0.y;
              uu = bf_lo(u.y); pp = bf_lo(pv.y); x[2] = uu + (pp - uu) * mu0.z;  uu = bf_hi(u.y); pp = bf_hi(pv.y); x[3] = uu + (pp - uu) * mu0.w;
              uu = bf_lo(u.z); pp = bf_lo(pv.z); x[4] = uu + (pp - uu) * mu1.x;  uu = bf_hi(u.z); pp = bf_hi(pv.z); x[5] = uu + (pp - uu) * mu1.y;
              uu = bf_lo(u.w); pp = bf_lo(pv.w); x[6] = uu + (pp - uu) * mu1.z;  uu = bf_hi(u.w); pp = bf_hi(pv.w); x[7] = uu + (pp - uu) * mu1.w; }
            if (ch >= 144 && ch < 152) {
#pragma unroll
                for (int q = 0; q < 8; ++q) { const float e = fast_exp(-2.f * fabsf(x[q])); const float th = (1.f - e) / (1.f + e); x[q] = x[q] < 0.f ? -th : th; }
            }
            LAS f32x4* d = (LAS f32x4*)(xs + tok * SHIFT_W + ch * 8);
            d[0] = (f32x4){x[0], x[1], x[2], x[3]}; d[1] = (f32x4){x[4], x[5], x[6], x[7]};
        }
        __syncthreads();
        if (wave < 6) {
            LAS float* wlb = xs + 16 * SHIFT_W;
            LAS float* alb = wlb + 16 * RW_W;
            {
                const float* wp = WU; asm volatile("" : "+v"(wp) :: "memory");
                float wv[64];
#pragma unroll
                for (int i = 0; i < 64; ++i) wv[i] = wp[i * RW_W];
#pragma unroll 1
                for (int tok = 0; tok < nt; ++tok) { const LAS float* xr = xs + tok * SHIFT_W + 1152; float acc = w0j;
#pragma unroll
                    for (int i = 0; i < 64; i += 4) { const f32x4 t4 = *(const LAS f32x4*)(xr + i); acc += t4.x * wv[i] + t4.y * wv[i + 1] + t4.z * wv[i + 2] + t4.w * wv[i + 3]; }
                    wlb[tok * RW_W + jch] = acc; }
            }
            {
                const float* wp = AU; asm volatile("" : "+v"(wp) :: "memory");
                float wv[64];
#pragma unroll
                for (int i = 0; i < 64; ++i) wv[i] = wp[i * RW_W];
#pragma unroll 1
                for (int tok = 0; tok < nt; ++tok) { const LAS float* xr = xs + tok * SHIFT_W + 1216; float acc = a0j;
#pragma unroll
                    for (int i = 0; i < 64; i += 4) { const f32x4 t4 = *(const LAS f32x4*)(xr + i); acc += t4.x * wv[i] + t4.y * wv[i + 1] + t4.z * wv[i + 2] + t4.w * wv[i + 3]; }
                    alb[tok * RW_W + jch] = acc; }
            }
            asm volatile("" ::: "memory");
#pragma unroll 1
            for (int tok = 0; tok < nt; ++tok) {
                const int m = m0 + t0 + tok, b = m / T, p = m - b * T, l = p - PADR;
                if (l < 0) continue;
                const LAS float* xr = xs + tok * SHIFT_W;
                const float r = xr[jch], k = xr[384 + jch], v = xr[768 + jch];
                const float logw = -softplus_f(-wlb[tok * RW_W + jch]) - 0.5f;
                const float xw = fast_exp(logw);
                const float om = xw < 0.02f ? xw * (1.f - 0.5f * xw + xw * xw * (1.f / 6.f)) : 1.f - fast_exp(-xw);
                const float av = 1.f / (1.f + fast_exp(-alb[tok * RW_W + jch]));
                const float kkr = k * kkj;
                const float nrm = sqrtf(wave_sum(kkr * kkr));
                const float kk = kkr / fmaxf(nrm, 1e-12f);
                const float kp = k * (1.f + (av - 1.f) * kaj);
                const float bb = kk * av;
                const float coef = wave_sum(r * kp * rkj);
                _Float16* o = RW + ((size_t)(b * RW_H + wave) * LPADDED + l) * 384 + lane;
                o[0] = (_Float16)kk; o[64] = (_Float16)om; o[128] = (_Float16)bb; o[192] = (_Float16)kp; o[256] = (_Float16)r; o[320] = (_Float16)v;
                BN[(size_t)m * RW_W + jch] = f2bf(coef * v);
            }
        } else {
            for (int it = wave - 6; it < nt * 10; it += 2) {
                const int tok = it / 10, hq = it - tok * 10, which = hq / 5, head = hq - which * 5;
                const int m = m0 + t0 + tok, b = m / T, p = m - b * T;
                if (p < PADR) continue;
                bf16_t* q = QKV + (size_t)m * QKV_W + 960 + which * 320 + head * 64 + lane;
                const float x = bf2f(*q);
                const float ss = wave_sum(x * x);
                const float y = x * (1.0f / sqrtf(ss * (1.0f / 64.f) + 1e-6f)) * (which == 0 ? gq : gk);
                *q = f2bf(y);
            }
        }
        __syncthreads();
    }
}

template <int CTRL> __device__ __forceinline__ float dpp_f(float x) { return __int_as_float(__builtin_amdgcn_update_dpp(0, __float_as_int(x), CTRL, 0xF, 0xF, false)); }
__device__ __forceinline__ float allred16(float p) { p += dpp_f<0x128>(p); p += dpp_f<0x124>(p); p += dpp_f<0x122>(p); p += dpp_f<0x121>(p); return p; }

__device__ __forceinline__ void rwkv_scan(const Args& a, Frame& F, int wgi) {
    const int bh = wgi >> 2, q4 = wgi & 3, b = bh / RW_H, h = bh % RW_H;
    const int tid = F.tid, wave = F.wave, lane = F.lane;
    const unsigned char* rw = a.ws + WS_RW + (size_t)bh * LPADDED * 768;
    LAS unsigned char* ring = F.lds;
    LAS float* ybuf = (LAS float*)(F.lds + 49152);
    bf16_t* y0 = (bf16_t*)(a.ws + WS_YCAT);
    constexpr int NCH = (LTOK + LCH - 1) / LCH;
    const int tl = tid - 256;
    float s0 = 0.f, s1 = 0.f, s2 = 0.f, s3 = 0.f;
    const int i16 = lane & 15, g = lane >> 4, rloc = 4 * wave + g;
    if (wave >= 4) {
        const int np = LCH * 48;
#pragma unroll
        for (int k = 0; k < 6; ++k) { const int pc = tl + 256 * k; if (pc < np) *(LAS u32x4*)(ring + pc * 16) = *(const u32x4*)(rw + (size_t)pc * 16); }
    }
    __syncthreads();
    for (int c = 0; c < NCH; ++c) {
        const int nst = (LTOK - c * LCH) < LCH ? (LTOK - c * LCH) : LCH;
        if (wave >= 4) {
            if (c > 0) {
                const LAS float* yb = ybuf + ((c - 1) & 1) * 512;
                for (int idx = tl; idx < LCH * 8; idx += 256) { const int t = idx >> 3, pr = idx & 7; const int l = (c - 1) * LCH + t;
                    if (l < LTOK) *(unsigned*)(y0 + (size_t)(b * T + PADR + l) * RW_W + h * 64 + q4 * 16 + 2 * pr) = pk2(yb[t * 16 + 2 * pr], yb[t * 16 + 2 * pr + 1]); }
            }
            if (c + 1 < NCH) {
                const int n1 = (LTOK - (c + 1) * LCH) < LCH ? (LTOK - (c + 1) * LCH) : LCH; const int np = n1 * 48;
                const unsigned char* src = rw + (size_t)(c + 1) * LCH * 768; LAS unsigned char* dst = ring + ((c + 1) & 1) * 24576;
                u32x4 tmp[6];
#pragma unroll
                for (int k = 0; k < 6; ++k) { const int pc = tl + 256 * k; if (pc < np) tmp[k] = *(const u32x4*)(src + (size_t)pc * 16); }
#pragma unroll
                for (int k = 0; k < 6; ++k) { const int pc = tl + 256 * k; if (pc < np) *(LAS u32x4*)(dst + pc * 16) = tmp[k]; }
            }
        } else {
            const LAS unsigned char* base = ring + (c & 1) * 24576 + i16 * 8;
            const LAS unsigned char* vb = ring + (c & 1) * 24576 + 640 + (q4 * 16 + rloc) * 2;
            LAS float* yb = ybuf + (c & 1) * 512 + rloc;
            for (int t = 0; t < nst; ++t) {
                const f16x4 kk = *(const LAS f16x4*)(base + t * 768);
                const f16x4 om = *(const LAS f16x4*)(base + t * 768 + 128);
                const f16x4 bb = *(const LAS f16x4*)(base + t * 768 + 256);
                const f16x4 kv = *(const LAS f16x4*)(base + t * 768 + 384);
                const f16x4 rr = *(const LAS f16x4*)(base + t * 768 + 512);
                const float vf = (float)*(const LAS _Float16*)(vb + t * 768);
                float p = s0 * (float)kk.x + s1 * (float)kk.y + s2 * (float)kk.z + s3 * (float)kk.w;
                p = allred16(p);
                const float sa = -p;
                s0 = s0 - s0 * (float)om.x; s1 = s1 - s1 * (float)om.y; s2 = s2 - s2 * (float)om.z; s3 = s3 - s3 * (float)om.w;
                s0 += sa * (float)bb.x; s1 += sa * (float)bb.y; s2 += sa * (float)bb.z; s3 += sa * (float)bb.w;
                s0 += vf * (float)kv.x; s1 += vf * (float)kv.y; s2 += vf * (float)kv.z; s3 += vf * (float)kv.w;
                float y = s0 * (float)rr.x + s1 * (float)rr.y + s2 * (float)rr.z + s3 * (float)rr.w;
                y = allred16(y);
                if (i16 == 0) yb[t * 16] = y;
            }
        }
        __syncthreads();
    }
    if (wave >= 4) {
        const int c = NCH;
        const LAS float* yb = ybuf + ((c - 1) & 1) * 512;
        for (int idx = tl; idx < LCH * 8; idx += 256) { const int t = idx >> 3, pr = idx & 7; const int l = (c - 1) * LCH + t;
            if (l < LTOK) *(unsigned*)(y0 + (size_t)(b * T + PADR + l) * RW_W + h * 64 + q4 * 16 + 2 * pr) = pk2(yb[t * 16 + 2 * pr], yb[t * 16 + 2 * pr + 1]); }
    }
    __syncthreads();
}

__device__ __forceinline__ int crow(int r, int hi) { return (r & 3) + 8 * (r >> 2) + 4 * hi; }
__device__ __forceinline__ void glds16(const void* gsrc, unsigned lds_dst) { unsigned keep;
    asm volatile("s_mov_b32 %0, m0\n\ts_mov_b32 m0, %2\n\ts_nop 0\n\tglobal_load_lds_dwordx4 %1, off\n\ts_mov_b32 m0, %0" : "=&s"(keep) : "v"(gsrc), "s"(lds_dst) : "memory"); }
typedef LAS const char* lds_cptr;
constexpr int FX_K = 0, FX_V = 16384, FX_WS = 32768, FX_OST = 34816, FX_FLG = 67584;

__device__ __forceinline__ void fx_pv(f32x16* o, int vb, bf16x8 pa0, bf16x8 pa1, bf16x8 pa2, bf16x8 pa3) {
#pragma unroll
    for (int d0 = 0; d0 < 2; ++d0) { s16x4 lo[4], hi[4];
#pragma unroll
        for (int ks = 0; ks < 4; ++ks) {
            asm volatile("ds_read_b64_tr_b16 %0,%1 offset:%c2" : "=&v"(lo[ks]) : "v"(vb), "i"(d0 * 4096 + ks * 1024) : "memory");
            asm volatile("ds_read_b64_tr_b16 %0,%1 offset:%c2" : "=&v"(hi[ks]) : "v"(vb), "i"(d0 * 4096 + ks * 1024 + 512) : "memory"); }
        asm volatile("s_waitcnt lgkmcnt(0)" ::: "memory"); __builtin_amdgcn_sched_barrier(0);
#define FX_PK(k) (bf16x8){lo[k][0], lo[k][1], lo[k][2], lo[k][3], hi[k][0], hi[k][1], hi[k][2], hi[k][3]}
        o[d0] = __builtin_amdgcn_mfma_f32_32x32x16_bf16(pa0, FX_PK(0), o[d0], 0, 0, 0);
        o[d0] = __builtin_amdgcn_mfma_f32_32x32x16_bf16(pa1, FX_PK(1), o[d0], 0, 0, 0);
        o[d0] = __builtin_amdgcn_mfma_f32_32x32x16_bf16(pa2, FX_PK(2), o[d0], 0, 0, 0);
        o[d0] = __builtin_amdgcn_mfma_f32_32x32x16_bf16(pa3, FX_PK(3), o[d0], 0, 0, 0);
#undef FX_PK
    }
}
__device__ __forceinline__ float halves_max(float m) { auto rr = __builtin_amdgcn_permlane32_swap(__float_as_uint(m), __float_as_uint(m), false, false); return fmaxf(__uint_as_float(rr[0]), __uint_as_float(rr[1])); }
__device__ __forceinline__ float halves_sum(float m) { auto rr = __builtin_amdgcn_permlane32_swap(__float_as_uint(m), __float_as_uint(m), false, false); return __uint_as_float(rr[0]) + __uint_as_float(rr[1]); }

__device__ __forceinline__ void fox_unit(const Args& a, Frame& F, int b, int h, int qb, float bound) {
    const int tid = F.tid, lane = F.lane, wave = F.wave, r32 = lane & 31, hi = lane >> 5;
    LAS unsigned char* lds = F.lds;
    const bf16_t* QKV = (const bf16_t*)(a.ws + WS_QKV);
    const size_t rowbase = (size_t)b * T;
    const int p0 = qb * 256;
    const bf16_t* Qw = QKV + (rowbase + p0 + wave * 32) * QKV_W + 960 + h * 64;
    const bf16_t* Kh = QKV + rowbase * QKV_W + 1280 + h * 64;
    const bf16_t* Vh = QKV + rowbase * QKV_W + 1600 + h * 64;
    const float* kbias = (const float*)(a.ws + WS_KB2) + (size_t)(b * FX_H + h) * KBP;
    const unsigned lds0 = (unsigned)(uintptr_t)lds;
    bf16x8 qr[4];
#pragma unroll
    for (int d0 = 0; d0 < 4; ++d0) qr[d0] = *(const bf16x8*)(Qw + (size_t)r32 * QKV_W + d0 * 16 + hi * 8);
    const int qp = p0 + wave * 32 + r32;
    const bool qvalid = (qp >= PADR) && (qp < T);
    const int plast = (p0 + 255) < (T - 1) ? (p0 + 255) : (T - 1);
    const int jlast = plast >> 6, jfirst = PADR >> 6;
    const int jw = (p0 + wave * 32 + 31) >> 6;
    const bf16_t* ksrc = Kh + (size_t)lane * QKV_W + wave * 8;
    const bf16_t* vsrc = Vh + (size_t)(16 * (wave & 3) + (lane >> 2)) * QKV_W + (wave >> 2) * 32 + (lane & 3) * 8;
    const unsigned kdst = lds0 + FX_K + wave * 1024, vdst = lds0 + FX_V + wave * 1024;
#define FX_DMA(j, slot) do { glds16(ksrc + (size_t)(j) * 64 * QKV_W, (unsigned)__builtin_amdgcn_readfirstlane(kdst + (slot) * 8192)); \
                             glds16(vsrc + (size_t)(j) * 64 * QKV_W, (unsigned)__builtin_amdgcn_readfirstlane(vdst + (slot) * 8192)); } while (0)
    const int vb0 = (int)(lds0 + FX_V) + ((lane >> 4) & 1) * 32 + (lane & 3) * 8 + (4 * hi + ((lane & 15) >> 2)) * 64;
    const lds_cptr kp0 = (lds_cptr)lds + FX_K + hi * 1024 + r32 * 16;
    LAS float* wsf = (LAS float*)(lds + FX_WS) + wave * 64;
    LAS float* flg = (LAS float*)(lds + FX_FLG);
    float m_run = -1.0e30f, l_run = 0.f;
    f32x16 o[2]; o[0] = f32x16{}; o[1] = f32x16{};
    int slot = 0; bool stop = false;
    FX_DMA(jlast, 0);
    for (int j = jlast; j >= jfirst; --j) {
        if (stop) break;
        if (j > jfirst) { FX_DMA(j - 1, slot ^ 1); asm volatile("s_waitcnt vmcnt(2) lgkmcnt(0)\n\ts_barrier" ::: "memory"); }
        else asm volatile("s_waitcnt vmcnt(0) lgkmcnt(0)\n\ts_barrier" ::: "memory");
        if (j <= jw) {
            f32x16 s0v = f32x16{}, s1v = f32x16{};
            const lds_cptr kp = kp0 + slot * 8192;
#pragma unroll
            for (int d0 = 0; d0 < 4; ++d0) {
                const bf16x8 b0 = *(const LAS bf16x8*)(kp + d0 * 2048);
                const bf16x8 b1 = *(const LAS bf16x8*)(kp + d0 * 2048 + 512);
                s0v = __builtin_amdgcn_mfma_f32_32x32x16_bf16(b0, qr[d0], s0v, 0, 0, 0);
                s1v = __builtin_amdgcn_mfma_f32_32x32x16_bf16(b1, qr[d0], s1v, 0, 0, 0);
            }
            const float* kbj = kbias + 64 * j + 4 * hi;
#pragma unroll
            for (int g = 0; g < 4; ++g) { const f32x4 t0 = *(const f32x4*)(kbj + 8 * g), t1 = *(const f32x4*)(kbj + 32 + 8 * g);
                s0v[4 * g] += t0.x; s0v[4 * g + 1] += t0.y; s0v[4 * g + 2] += t0.z; s0v[4 * g + 3] += t0.w;
                s1v[4 * g] += t1.x; s1v[4 * g + 1] += t1.y; s1v[4 * g + 2] += t1.z; s1v[4 * g + 3] += t1.w; }
            if ((64 * j + 63 > p0 + wave * 32) || (64 * j < PADR)) {
#pragma unroll
                for (int r = 0; r < 16; ++r) { const int key = 64 * j + crow(r, hi);
                    if (key > qp || key < PADR) s0v[r] = -INFINITY;
                    if (key + 32 > qp || key + 32 < PADR) s1v[r] = -INFINITY; }
            }
            float rm = fmaxf(s0v[0], s1v[0]);
#pragma unroll
            for (int r = 1; r < 16; ++r) rm = fmaxf(rm, fmaxf(s0v[r], s1v[r]));
            rm = halves_max(rm);
            const float m_new = fmaxf(m_run, rm);
            const float f = __builtin_amdgcn_exp2f(m_run - m_new);
            m_run = m_new;
            float rs = 0.f;
#pragma unroll
            for (int r = 0; r < 16; ++r) { s0v[r] = __builtin_amdgcn_exp2f(s0v[r] - m_new); s1v[r] = __builtin_amdgcn_exp2f(s1v[r] - m_new); rs += s0v[r] + s1v[r]; }
            rs = halves_sum(rs);
            l_run = l_run * f + rs;
            if (!__all(f == 1.0f)) {
                if (hi == 0) wsf[r32] = f;
                LDS_WAIT();
#pragma unroll
                for (int d_ = 0; d_ < 2; ++d_)
#pragma unroll
                    for (int r = 0; r < 16; ++r) o[d_][r] *= wsf[crow(r, hi)];
            }
            u32x4 pw0, pw1, pw2, pw3;
            pw0 = (u32x4){pk2(s0v[0], s0v[1]), pk2(s0v[2], s0v[3]), pk2(s0v[4], s0v[5]), pk2(s0v[6], s0v[7])};
            pw1 = (u32x4){pk2(s0v[8], s0v[9]), pk2(s0v[10], s0v[11]), pk2(s0v[12], s0v[13]), pk2(s0v[14], s0v[15])};
            pw2 = (u32x4){pk2(s1v[0], s1v[1]), pk2(s1v[2], s1v[3]), pk2(s1v[4], s1v[5]), pk2(s1v[6], s1v[7])};
            pw3 = (u32x4){pk2(s1v[8], s1v[9]), pk2(s1v[10], s1v[11]), pk2(s1v[12], s1v[13]), pk2(s1v[14], s1v[15])};
            fx_pv(o, vb0 + slot * 8192, __builtin_bit_cast(bf16x8, pw0), __builtin_bit_cast(bf16x8, pw1), __builtin_bit_cast(bf16x8, pw2), __builtin_bit_cast(bf16x8, pw3));
        }
        float mm = qvalid ? m_run : 3.0e38f;
#pragma unroll
        for (int off = 1; off < 64; off <<= 1) mm = fminf(mm, __shfl_xor(mm, off));
        if (lane == 0) flg[(j & 1) * 8 + wave] = mm;
        asm volatile("s_waitcnt lgkmcnt(0)\n\ts_barrier" ::: "memory");
        if (j > jfirst) {
            const f32x4 fa = *(const LAS f32x4*)(flg + (j & 1) * 8), fb = *(const LAS f32x4*)(flg + (j & 1) * 8 + 4);
            const float mmin = fminf(fminf(fminf(fa.x, fa.y), fminf(fa.z, fa.w)), fminf(fminf(fb.x, fb.y), fminf(fb.z, fb.w)));
            const float kbmax = kbias[64 * (j - 1) + 63];
            stop = (bound + kbmax - mmin) < -150.0f;
        }
        slot ^= 1;
    }
    asm volatile("s_waitcnt vmcnt(0) lgkmcnt(0)\n\ts_barrier" ::: "memory");
    if (hi == 0) wsf[32 + r32] = l_run;
    LDS_WAIT();
    float rli[16];
#pragma unroll
    for (int r = 0; r < 16; ++r) rli[r] = __builtin_amdgcn_rcpf(wsf[32 + crow(r, hi)]);
    bf16_t* Ow = (bf16_t*)(a.ws + WS_YCAT) + (size_t)2 * M * RW_W + (rowbase + p0 + wave * 32) * RW_W + h * 64;
    {
        LAS bf16_t* stg = (LAS bf16_t*)(lds + FX_OST) + wave * 2048;
#pragma unroll
        for (int r = 0; r < 16; ++r) { const int orow = crow(r, hi);
#pragma unroll
            for (int d0 = 0; d0 < 2; ++d0) stg[orow * 64 + d0 * 32 + r32] = f2bf(o[d0][r] * rli[r]); }
        LDS_WAIT();
#pragma unroll
        for (int i = 0; i < 4; ++i) { const int row = i * 8 + (lane >> 3), ch = lane & 7; const u32x4 v = *(const LAS u32x4*)(stg + row * 64 + ch * 8);
            const int pr = p0 + wave * 32 + row;
            if (pr >= PADR && pr < T) *(u32x4*)(Ow + (size_t)row * RW_W + ch * 8) = v; }
    }
    asm volatile("s_waitcnt lgkmcnt(0)\n\ts_barrier" ::: "memory");
#undef FX_DMA
}

__device__ __forceinline__ void sb_unit(const Args& a, Frame& F, int b, int h, int qblk) {
    const int lane = F.lane, wave = F.wave;
    const bf16_t* QKV = (const bf16_t*)(a.ws + WS_QKV);
    const size_t rowbase = (size_t)b * T;
    const int plo = qblk * 512 + wave * 64, p = plo + lane;
    const bool valid = (p >= PADR) && (p < T);
    int phi = plo + 63; if (phi > T - 1) phi = T - 1;
    if (phi < PADR || plo >= T) return;
    float q[64], o[64];
    {
        const u32x4* qp = (const u32x4*)(QKV + (rowbase + (valid ? p : PADR)) * QKV_W + h * 64);
#pragma unroll
        for (int c = 0; c < 8; ++c) { const u32x4 t = qp[c];
            q[8 * c + 0] = bf_lo(t.x) * 0.125f; q[8 * c + 1] = bf_hi(t.x) * 0.125f; q[8 * c + 2] = bf_lo(t.y) * 0.125f; q[8 * c + 3] = bf_hi(t.y) * 0.125f;
            q[8 * c + 4] = bf_lo(t.z) * 0.125f; q[8 * c + 5] = bf_hi(t.z) * 0.125f; q[8 * c + 6] = bf_lo(t.w) * 0.125f; q[8 * c + 7] = bf_hi(t.w) * 0.125f; }
    }
#pragma unroll
    for (int d = 0; d < 64; ++d) o[d] = 0.f;
    float R = 0.f;
    for (int s = phi - 1; s >= PADR; --s) {
        const int srow = __builtin_amdgcn_readfirstlane(s);
        const u32x4* kp = (const u32x4*)(QKV + (rowbase + srow) * QKV_W + 320 + h * 64);
        const u32x4* vp = (const u32x4*)(QKV + (rowbase + srow) * QKV_W + 640 + h * 64);
        float z0 = 0.f, z1 = 0.f;
#pragma unroll
        for (int c = 0; c < 8; ++c) { const u32x4 t = kp[c];
            z0 += q[8 * c + 0] * bf_lo(t.x); z1 += q[8 * c + 1] * bf_hi(t.x); z0 += q[8 * c + 2] * bf_lo(t.y); z1 += q[8 * c + 3] * bf_hi(t.y);
            z0 += q[8 * c + 4] * bf_lo(t.z); z1 += q[8 * c + 5] * bf_hi(t.z); z0 += q[8 * c + 6] * bf_lo(t.w); z1 += q[8 * c + 7] * bf_hi(t.w); }
        const float z = z0 + z1;
        const bool act = valid && (s < p);
        const float l1 = -softplus_f(z);
        const float aw = act ? __builtin_amdgcn_exp2f((z + l1 + R) * LOG2E) : 0.f;
        R += act ? l1 : 0.f;
#pragma unroll
        for (int c = 0; c < 8; ++c) { const u32x4 t = vp[c];
            o[8 * c + 0] += aw * bf_lo(t.x); o[8 * c + 1] += aw * bf_hi(t.x); o[8 * c + 2] += aw * bf_lo(t.y); o[8 * c + 3] += aw * bf_hi(t.y);
            o[8 * c + 4] += aw * bf_lo(t.z); o[8 * c + 5] += aw * bf_hi(t.z); o[8 * c + 6] += aw * bf_lo(t.w); o[8 * c + 7] += aw * bf_hi(t.w); }
        if (s <= plo && __all(!valid || R < -104.0f)) break;
    }
    if (valid) {
        u32x4* op = (u32x4*)((bf16_t*)(a.ws + WS_YCAT) + (size_t)M * RW_W + (rowbase + p) * RW_W + h * 64);
#pragma unroll
        for (int c = 0; c < 8; ++c) op[c] = (u32x4){pk2(o[8 * c], o[8 * c + 1]), pk2(o[8 * c + 2], o[8 * c + 3]), pk2(o[8 * c + 4], o[8 * c + 5]), pk2(o[8 * c + 6], o[8 * c + 7])};
    }
}

constexpr int N_FX_UNITS = 65 * 10, N_SB_UNITS = 33 * 10, N_RW_WG = 48;
__device__ __forceinline__ void phase_mix(const Args& a, Frame& F, int layer) {
    float gqm = fabsf(a.in[I_QG][layer * 64 + F.lane]), gkm = fabsf(a.in[I_KG][layer * 64 + F.lane]);
#pragma unroll
    for (int off = 1; off < 64; off <<= 1) { gqm = fmaxf(gqm, __shfl_xor(gqm, off)); gkm = fmaxf(gkm, __shfl_xor(gkm, off)); }
    const float bound = 64.0f * C2 * gqm * gkm * 1.02f + 0.5f;
    if (blockIdx.x < N_RW_WG) rwkv_scan(a, F, blockIdx.x);
    unsigned* head = (unsigned*)(a.ws + WS_CTL) + CW_QUEUE + 64 * layer;
    for (;;) {
        if (F.tid == 0) F.MISC[16] = __hip_atomic_fetch_add(head, 1u, __ATOMIC_RELAXED, __HIP_MEMORY_SCOPE_AGENT);
        __syncthreads();
        const int u = (int)F.MISC[16];
        __syncthreads();
        if (u >= N_FX_UNITS + N_SB_UNITS) break;
        if (u < N_FX_UNITS) { const int qb = 64 - u / 10, bh = u % 10; fox_unit(a, F, bh / FX_H, bh % FX_H, qb, bound); }
        else { const int v = u - N_FX_UNITS; const int qblk = 32 - v / 10, bh = v % 10; sb_unit(a, F, bh / SB_H, bh % SB_H, qblk); }
    }
}

__device__ __forceinline__ void phase_post(const Args& a, Frame& F, int layer) {
    const int gw = blockIdx.x * NWAVES + F.wave, NGW = gridDim.x * NWAVES, lane = F.lane;
    bf16_t* Y0 = (bf16_t*)(a.ws + WS_YCAT); const bf16_t* BN = (const bf16_t*)(a.ws + WS_BN);
    for (int it = gw; it < M * RW_H; it += NGW) {
        const int m = it / RW_H, hh = it - m * RW_H;
        const int b = m / T, p = m - b * T;
        bf16_t* yp = Y0 + (size_t)m * RW_W + hh * 64 + lane;
        if (p < PADR) { *yp = 0; continue; }
        const float y = bf2f(*yp);
        const float mean = wave_sum(y) * (1.f / 64.f);
        const float d = y - mean;
        const float var = wave_sum(d * d) * (1.f / 64.f);
        const float o = d * (1.0f / sqrtf(var + 64e-5f)) * a.in[I_LNG][layer * RW_W + hh * 64 + lane] + a.in[I_LNB][layer * RW_W + hh * 64 + lane] + bf2f(BN[(size_t)m * RW_W + hh * 64 + lane]);
        *yp = f2bf(o);
    }
    for (int it = gw; it < 2 * M; it += NGW) {
        const int sl = it / M, m = it - sl * M; const int b = m / T, p = m - b * T;
        bf16_t* row = Y0 + (size_t)(sl + 1) * M * RW_W + (size_t)m * RW_W;
        if (p < PADR) { for (int c = lane; c < RW_W / 2; c += 64) ((unsigned*)row)[c] = 0u; }
        else if (lane < 32) ((unsigned*)(row + 320))[lane] = 0u;
    }
}

struct EpiInproj { static constexpr bool PERM = true, AFTER_DRAIN = false; bf16_t* ush; bf16_t* qkv;
    __device__ __forceinline__ void operator()(const f32x4 (&acc)[2][2][4][2], const pg8::Unit& u, int wr, int wc, int fr, int fq) const {
        asm volatile("" : "+v"(fr), "+v"(fq));
        const int row0 = u.pm * 256 + wr * 64 + fr, colt = u.pn * 256 + wc * 32 + 8 * fq;
#pragma unroll
        for (int ai = 0; ai < 2; ++ai)
#pragma unroll
            for (int m = 0; m < 4; ++m) { const size_t row = (size_t)(row0 + ai * 128 + m * 16);
#pragma unroll
                for (int bj = 0; bj < 2; ++bj) { const int col = colt + bj * 128; const f32x4 v0 = acc[ai][bj][m][0], v1 = acc[ai][bj][m][1];
                    u32x4 w; w.x = pk2(v0[0], v0[1]); w.y = pk2(v0[2], v0[3]); w.z = pk2(v1[0], v1[1]); w.w = pk2(v1[2], v1[3]);
                    if (col < SHIFT_W) *(u32x4*)(ush + row * SHIFT_W + col) = w;
                    else if (col < SHIFT_W + QKV_W) *(u32x4*)(qkv + row * QKV_W + (col - SHIFT_W)) = w; } }
    }
};
struct EpiGates { static constexpr bool PERM = true, AFTER_DRAIN = false; bf16_t* gates;
    __device__ __forceinline__ void operator()(const f32x4 (&acc)[2][2][4][2], const pg8::Unit& u, int wr, int wc, int fr, int fq) const {
        asm volatile("" : "+v"(fr), "+v"(fq));
        const int row0 = u.pm * 256 + wr * 64 + fr, colt = u.pn * 256 + wc * 32 + 8 * fq;
#pragma unroll
        for (int ai = 0; ai < 2; ++ai)
#pragma unroll
            for (int m = 0; m < 4; ++m) { const size_t row = (size_t)(row0 + ai * 128 + m * 16);
#pragma unroll
                for (int bj = 0; bj < 2; ++bj) { const int col = colt + bj * 128; f32x4 v0 = acc[ai][bj][m][0], v1 = acc[ai][bj][m][1];
#pragma unroll
                    for (int q = 0; q < 4; ++q) { v0[q] = __builtin_amdgcn_rcpf(1.f + __builtin_amdgcn_exp2f(-v0[q] * LOG2E)); v1[q] = __builtin_amdgcn_rcpf(1.f + __builtin_amdgcn_exp2f(-v1[q] * LOG2E)); }
                    u32x4 w; w.x = pk2(v0[0], v0[1]); w.y = pk2(v0[2], v0[3]); w.z = pk2(v1[0], v1[1]); w.w = pk2(v1[2], v1[3]);
                    *(u32x4*)(gates + row * 3072 + col) = w; } }
    }
};
struct EpiMerge { static constexpr bool PERM = true, AFTER_DRAIN = false; const bf16_t* gates; bf16_t* merged;
    __device__ __forceinline__ void operator()(const f32x4 (&acc)[2][2][4][2], const pg8::Unit& u, int wr, int wc, int fr, int fq) const {
        asm volatile("" : "+v"(fr), "+v"(fq));
        const int br = u.pn >> 2, pn = u.pn & 3, pm = u.pm - br * 129;
        const int row0 = pm * 256 + wr * 64 + fr, colt = pn * 256 + wc * 32 + 8 * fq;
#pragma unroll
        for (int ai = 0; ai < 2; ++ai)
#pragma unroll
            for (int m = 0; m < 4; ++m) { const size_t row = (size_t)(row0 + ai * 128 + m * 16);
#pragma unroll
                for (int bj = 0; bj < 2; ++bj) { const int col = colt + bj * 128; const f32x4 v0 = acc[ai][bj][m][0], v1 = acc[ai][bj][m][1];
                    const u32x4 g = *(const u32x4*)(gates + row * 3072 + br * 1024 + col);
                    u32x4* mp = (u32x4*)(merged + row * D + col);
                    u32x4 o = (u32x4){0u, 0u, 0u, 0u};
                    if (br > 0) o = *mp;
                    u32x4 w;
                    w.x = pk2(bf_lo(g.x) * v0[0] + bf_lo(o.x), bf_hi(g.x) * v0[1] + bf_hi(o.x));
                    w.y = pk2(bf_lo(g.y) * v0[2] + bf_lo(o.y), bf_hi(g.y) * v0[3] + bf_hi(o.y));
                    w.z = pk2(bf_lo(g.z) * v1[0] + bf_lo(o.z), bf_hi(g.z) * v1[1] + bf_hi(o.z));
                    w.w = pk2(bf_lo(g.w) * v1[2] + bf_lo(o.w), bf_hi(g.w) * v1[3] + bf_hi(o.w));
                    *mp = w; }
                __builtin_amdgcn_sched_barrier(0); }
    }
};
struct MergeOrder { int G, c;
    __device__ __forceinline__ bool next(int i, pg8::Unit& u) const { const int it = i / 3, br = i - 3 * it; const long tau = (long)it * G + c; if (tau >= 516) return false;
        const int t = (int)tau; u.pm = br * 129 + (t >> 2); u.pn = br * 4 + (t & 3); return true; }
    __device__ __forceinline__ void a_ready(const pg8::Unit&) const {}
    __device__ __forceinline__ void done(const pg8::Unit&) const {}
};
struct EpiOut { static constexpr bool PERM = true, AFTER_DRAIN = false; const Args* a;
    __device__ __forceinline__ void operator()(const f32x4 (&acc)[2][2][4][2], const pg8::Unit& u, int wr, int wc, int fr, int fq) const {
        asm volatile("" : "+v"(fr), "+v"(fq));
        const int row0 = u.pm * 256 + wr * 64 + fr, colt = u.pn * 256 + wc * 32 + 8 * fq;
#pragma unroll
        for (int ai = 0; ai < 2; ++ai)
#pragma unroll
            for (int m = 0; m < 4; ++m) { const int row = row0 + ai * 128 + m * 16; const int b = row / T, p = row - b * T, l = p - PADR;
                if (l < 0) continue;
                float* hp = hrow(*a, b, l);
#pragma unroll
                for (int bj = 0; bj < 2; ++bj) { const int col = colt + bj * 128; f32x4* h4 = (f32x4*)(hp + col);
                    h4[0] = h4[0] + acc[ai][bj][m][0]; h4[1] = h4[1] + acc[ai][bj][m][1]; } }
    }
};
struct MoeOrder { const volatile LAS int* tb; int ntile, npt, G, c;
    __device__ __forceinline__ bool next(int i, pg8::Unit& u) const { const long L = (long)i * G + c; if (L >= (long)ntile * npt) return false;
        const int tau = (int)(L / npt), j = (int)(L - (long)tau * npt); int e = 0;
#pragma unroll
        for (int k = 1; k < 16; ++k) e += (tau >= tb[k]) ? 1 : 0;
        u.pm = tau; u.pn = __builtin_amdgcn_readfirstlane(e) * npt + j; return true; }
    __device__ __forceinline__ void a_ready(const pg8::Unit&) const {}
    __device__ __forceinline__ void done(const pg8::Unit&) const {}
};
struct EpiMoeUp { static constexpr bool PERM = true, AFTER_DRAIN = false; bf16_t* hs;
    __device__ __forceinline__ void operator()(const f32x4 (&acc)[2][2][4][2], const pg8::Unit& u, int wr, int wc, int fr, int fq) const {
        asm volatile("" : "+v"(fr), "+v"(fq));
        const int row0 = u.pm * 256 + wr * 64 + fr, col = (u.pn & 1) * 128 + wc * 32 + 8 * fq;
#pragma unroll
        for (int ai = 0; ai < 2; ++ai)
#pragma unroll
            for (int m = 0; m < 4; ++m) { const size_t row = (size_t)(row0 + ai * 128 + m * 16); float r[8];
#pragma unroll
                for (int n = 0; n < 2; ++n)
#pragma unroll
                    for (int q = 0; q < 4; ++q) { const float gte = acc[ai][0][m][n][q], up = acc[ai][1][m][n][q]; r[4 * n + q] = gte * __builtin_amdgcn_rcpf(1.f + __builtin_amdgcn_exp2f(-gte * LOG2E)) * up; }
                u32x4 w; w.x = pk2(r[0], r[1]); w.y = pk2(r[2], r[3]); w.z = pk2(r[4], r[5]); w.w = pk2(r[6], r[7]);
                *(u32x4*)(hs + row * DEXP + col) = w; }
    }
};
struct EpiMoeDown { static constexpr bool PERM = true, AFTER_DRAIN = false; bf16_t* y; const float* cws;
    __device__ __forceinline__ void operator()(const f32x4 (&acc)[2][2][4][2], const pg8::Unit& u, int wr, int wc, int fr, int fq) const {
        asm volatile("" : "+v"(fr), "+v"(fq));
        const int row0 = u.pm * 256 + wr * 64 + fr, colt = (u.pn & 3) * 256 + wc * 32 + 8 * fq;
#pragma unroll
        for (int ai = 0; ai < 2; ++ai)
#pragma unroll
            for (int m = 0; m < 4; ++m) { const size_t row = (size_t)(row0 + ai * 128 + m * 16); const float cw = cws[row];
#pragma unroll
                for (int bj = 0; bj < 2; ++bj) { const int col = colt + bj * 128; const f32x4 v0 = acc[ai][bj][m][0] * cw, v1 = acc[ai][bj][m][1] * cw;
                    u32x4 w; w.x = pk2(v0[0], v0[1]); w.y = pk2(v0[2], v0[3]); w.z = pk2(v1[0], v1[1]); w.w = pk2(v1[2], v1[3]);
                    *(u32x4*)(y + row * D + col) = w; }
                __builtin_amdgcn_sched_barrier(0); }
    }
};

#ifndef PH_MASK
#define PH_MASK 0xFFFF
#endif
#define PH(k) ((PH_MASK >> (k)) & 1)
#define FRESH() do { asm volatile("" : "+v"(F.tid)); F.lane = F.tid & 63; F.wave = __builtin_amdgcn_readfirstlane(F.tid >> 6); } while (0)
__global__ void __launch_bounds__(NTHR, 2) hybrid_fwd(Args a) {
    extern __shared__ __attribute__((aligned(16))) unsigned char lds_raw[];
    Frame F;
    F.lds = (LAS unsigned char*)lds_raw;
    F.MISC = (volatile LAS unsigned*)(F.lds + MISC_OFF);
    F.tid = threadIdx.x; F.lane = F.tid & 63; F.wave = __builtin_amdgcn_readfirstlane(F.tid >> 6);
    for (int u = F.tid; u < (LDS_BYTES - MISC_OFF) / 4; u += NTHR) ((LAS unsigned*)(F.lds + MISC_OFF))[u] = 0u;
    __syncthreads();
    unsigned char* ws = a.ws;
    XcdBarrier bar = xcd_barrier_post((unsigned*)(ws + WS_CTL) + CW_BAR, F.MISC + 8);
    const int G = (int)gridDim.x, c = (int)blockIdx.x;
    PG8_LAS unsigned char* ring = (PG8_LAS unsigned char*)F.lds;

    for (int layer = 0; layer < DEPTH; ++layer) {
        FRESH(); if (PH(0)) phase_wconv(a, F, layer);
        __syncthreads();
        FRESH(); if (PH(1)) phase_norm<1>(a, F, layer);
        xcd_barrier(bar);
        if (PH(2)) {
            pg8::Gemm g{(const bf16_t*)(ws + WS_A), (const bf16_t*)(ws + WS_WIN), M, N1, D}; pg8::StaticOrder S; S.init(M, N1, G, c);
            EpiInproj E{(bf16_t*)(ws + WS_USH), (bf16_t*)(ws + WS_QKV)};
            pg8::gemm_phase<EpiInproj, pg8::StaticOrder, true, true>(ring, g, S, E);
        }
        xcd_barrier(bar);
        FRESH(); if (PH(3)) phase_prep(a, F, layer);
        xcd_barrier(bar);
        FRESH(); if (PH(4)) phase_mix(a, F, layer);
        xcd_barrier(bar);
        FRESH(); if (PH(5)) phase_post(a, F, layer);
        if (PH(6)) {
            pg8::Gemm g{(const bf16_t*)(ws + WS_A), (const bf16_t*)(ws + WS_WG), M, 3072, D}; pg8::StaticOrder S; S.init(M, 3072, G, c);
            EpiGates E{(bf16_t*)(ws + WS_GATES)};
            pg8::gemm_phase<EpiGates, pg8::StaticOrder, true, true>(ring, g, S, E);
        }
        xcd_barrier(bar);
        if (PH(7)) {
            int kdim = RW_W; asm volatile("" : "+s"(kdim));
            pg8::Gemm g{(const bf16_t*)(ws + WS_YCAT), (const bf16_t*)(ws + WS_WP), 3 * M, 3072, kdim}; MergeOrder S{G, c};
            EpiMerge E{(const bf16_t*)(ws + WS_GATES), (bf16_t*)(ws + WS_MERGED)};
            pg8::gemm_phase<EpiMerge, MergeOrder, false, true>(ring, g, S, E);
        }
        xcd_barrier(bar);
        if (PH(8)) {
            pg8::Gemm g{(const bf16_t*)(ws + WS_MERGED), (const bf16_t*)(ws + WS_WO), M, D, D}; pg8::StaticOrder S; S.init(M, D, G, c);
            EpiOut E{&a};
            pg8::gemm_phase<EpiOut, pg8::StaticOrder, true, true>(ring, g, S, E);
        }
        xcd_barrier(bar);
        FRESH(); if (PH(9)) phase_norm<2>(a, F, layer);
        xcd_barrier(bar);
        FRESH(); if (PH(10)) phase_route(a, F, layer);
        xcd_barrier(bar);
        volatile LAS int* tb = (volatile LAS int*)(F.MISC + 32);
        if (F.tid <= 16) { const int* cnt = (const int*)(ws + WS_CTL) + CW_ECNT + 64 * layer; int t = 0;
            for (int e = 0; e < F.tid; ++e) t += (__hip_atomic_load(cnt + e, __ATOMIC_RELAXED, __HIP_MEMORY_SCOPE_AGENT) + 255) >> 8;
            tb[F.tid] = t; }
        __syncthreads();
        const int ntile = tb[16];
        if (PH(11)) {
            pg8::Gemm g{(const bf16_t*)(ws + WS_AS), (const bf16_t*)(ws + WS_WGU), MS, 8192, D}; MoeOrder S{tb, ntile, 2, G, c};
            EpiMoeUp E{(bf16_t*)(ws + WS_HS)};
            pg8::gemm_phase<EpiMoeUp, MoeOrder, true, true>(ring, g, S, E);
        }
        xcd_barrier(bar);
        if (PH(12)) {
            int kdim = DEXP; asm volatile("" : "+s"(kdim));
            pg8::Gemm g{(const bf16_t*)(ws + WS_HS), (const bf16_t*)(ws + WS_WD), MS, 16384, kdim}; MoeOrder S{tb, ntile, 4, G, c};
            EpiMoeDown E{(bf16_t*)(ws + WS_Y), (const float*)(ws + WS_CWS)};
            pg8::gemm_phase<EpiMoeDown, MoeOrder, true, true>(ring, g, S, E);
        }
        xcd_barrier(bar);
    }
    FRESH(); if (PH(13)) phase_norm<0>(a, F, DEPTH - 1);
}

extern "C" void kernel_launch(void* const* d_in, const int* in_sizes, int n_in, void* d_out, int out_size, void* d_ws, size_t ws_size, hipStream_t stream) {
    static int ready = 0;
    if (ready == 0) {
        if (n_in != 29 || out_size != NB * SEQ * D || ws_size < WS_END) { fprintf(stderr, "kernel_launch: unexpected problem shape (n_in %d, out %d, ws %zu < %zu)\n", n_in, out_size, ws_size, (size_t)WS_END); ready = -1; return; }
        if (hipFuncSetAttribute((const void*)hybrid_fwd, hipFuncAttributeMaxDynamicSharedMemorySize, LDS_BYTES) != hipSuccess) { fprintf(stderr, "kernel_launch: hipFuncSetAttribute failed\n"); ready = -1; return; }
        int per_cu = 0;
        if (hipOccupancyMaxActiveBlocksPerMultiprocessor(&per_cu, (const void*)hybrid_fwd, NTHR, LDS_BYTES) != hipSuccess || per_cu < 1) fprintf(stderr, "kernel_launch: occupancy query says %d\n", per_cu);
        (void)hipGetLastError();
        ready = 1;
    }
    if (ready < 0) return;
    (void)in_sizes;
    if (hipMemsetAsync((char*)d_ws + WS_CTL, 0, CTL_ZERO_BYTES, stream) != hipSuccess) return;
    Args a{};
    for (int i = 0; i < 29; ++i) a.in[i] = (const float*)d_in[i];
    a.out = (float*)d_out; a.ws = (unsigned char*)d_ws;
    hipLaunchKernelGGL(hybrid_fwd, dim3(256), dim3(NTHR), LDS_BYTES, stream, a);
}
```

```cpp
#include <hip/hip_runtime.h>
#include <hip/hip_bf16.h>
#include <cstdio>
#include <cstdint>

#define GAS __attribute__((address_space(1)))
#define LAS __attribute__((address_space(3)))

namespace pg8 {
#define PG8_LAS __attribute__((address_space(3)))
typedef unsigned short bf16_t;
typedef short bf16x8 __attribute__((ext_vector_type(8)));
typedef float f32x4 __attribute__((ext_vector_type(4)));
typedef unsigned u32x4 __attribute__((ext_vector_type(4)));
constexpr int BM = 256, BK = 64, HALF = 128, HTB = HALF * BK * 2  , STAGE_BYTES = 8 * HTB, NXCD = 8, WGM = 8;

__host__ __device__ __forceinline__ int lds_byte(int r, int c) { const int st = (r >> 4) * 2 + (c >> 5), rr = r & 15, cc = c & 31, ob = rr * 64 + cc * 2; return st * 1024 + (ob ^ (((ob >> 9) & 1) << 5)); }
__host__ __device__ __forceinline__ void stage_rc(int b, int& R, int& C) { const int st = b / 1024, sb = b % 1024, swz = sb ^ (((sb >> 9) & 1) << 5); R = (st >> 1) * 16 + swz / 64; C = (st & 1) * 32 + (swz % 64) / 2; }
__host__ __device__ __forceinline__ int perm32(int rho) { const int n = rho >> 4, i = rho & 15; return 8 * (i >> 2) + 4 * n + (i & 3); }

struct Unit { int pm, pn; };
struct Gemm { const bf16_t* A; const bf16_t* Bt; int M, N, K; };

struct StaticOrder {
    int nM, nN, nwg, G, c, rep;
    __host__ __device__ void init(int M, int N, int G_, int c_, int rep_ = 1) { nM = M / BM; nN = N / BM; nwg = nM * nN; G = G_; c = c_; rep = rep_; }
    __host__ __device__ bool next(int i, Unit& u) const {
        const long L = (long)i * G + c; if (L >= (long)nwg * rep) return false;
        int wgid = (int)(L % nwg); { const int q = nwg / NXCD, r = nwg % NXCD, xcd = wgid % NXCD, off = wgid / NXCD; wgid = (xcd < r ? xcd * (q + 1) : r * (q + 1) + (xcd - r) * q) + off; }
        const int nig = WGM * nN, gid = wgid / nig, fm = gid * WGM, gsz = (nM - fm) < WGM ? (nM - fm) : WGM;
        u.pm = fm + ((wgid % nig) % gsz); u.pn = (wgid % nig) / gsz; return true;
    }
    __device__ __forceinline__ void a_ready(const Unit&) const {}
    __device__ __forceinline__ void done(const Unit&) const {}
};
__device__ __forceinline__ unsigned cvt_pk_bf16(float lo, float hi) { unsigned r; asm volatile("v_cvt_pk_bf16_f32 %0, %1, %2" : "=v"(r) : "v"(lo), "v"(hi)); return r; }
template <class Epi, class Sched, bool ALIGN_EPI = false, bool SP2 = false>
__device__ __forceinline__ void gemm_phase(PG8_LAS unsigned char* lds, const Gemm g, const Sched& S, const Epi& E) {
    int tid_ = threadIdx.x; asm volatile("" : "+v"(tid_));
    const int tid = tid_, wid = __builtin_amdgcn_readfirstlane(tid >> 6), lane = tid & 63, wr = wid >> 2, wc = wid & 3, fr = lane & 15, fq = lane >> 4;
    const int K = g.K, nt = K / BK;
    unsigned voffA[2], voffB[2];
#pragma unroll
    for (int i = 0; i < 2; ++i) { int R, C; stage_rc(tid * 16 + i * 8192, R, C); const int Rb = Epi::PERM ? ((R & ~31) + perm32(R & 31)) : R;
        voffA[i] = (unsigned)(R * K + C) * 2u; voffB[i] = (unsigned)(Rb * K + C) * 2u; }
    const size_t kstep = (size_t)(BK * 2);
    const size_t hstep = (size_t)HALF * K * 2;
    const size_t tstep = 2 * hstep;
    const unsigned ldsw = (unsigned)wid * 1024u;
    const int aoff = lds_byte(wr * 64 + fr, fq * 8), boff = lds_byte(wc * 32 + fr, fq * 8);
#define PG8_SA(b, h) (((b) * 2 + (h)) * HTB)
#define PG8_SB(b, h) ((4 + (b) * 2 + (h)) * HTB)
#define PG8_STAGE(bufoff, gbase, voff) do { _Pragma("unroll") for (int _i = 0; _i < 2; ++_i) \
        __builtin_amdgcn_global_load_lds((const unsigned*)((const char*)(gbase) + (voff)[_i]), (PG8_LAS unsigned*)(lds + (bufoff) + ldsw + _i * 8192), 16, 0, 0); } while (0)
#define PG8_LDA(dst, b, h) do { _Pragma("unroll") for (int m = 0; m < 4; ++m) _Pragma("unroll") for (int k = 0; k < 2; ++k) dst[m][k] = *(const PG8_LAS bf16x8*)(lds + PG8_SA(b, h) + aoff + m * 2048 + k * 1024); } while (0)
#define PG8_LDB(dst, b, h) do { _Pragma("unroll") for (int n = 0; n < 2; ++n) _Pragma("unroll") for (int k = 0; k < 2; ++k) dst[n][k] = *(const PG8_LAS bf16x8*)(lds + PG8_SB(b, h) + boff + n * 2048 + k * 1024); } while (0)
#define PG8_MMA(ai, bj, At, Bt) do { __builtin_amdgcn_s_setprio(1); _Pragma("unroll") for (int m = 0; m < 4; ++m) _Pragma("unroll") for (int n = 0; n < 2; ++n) _Pragma("unroll") for (int k = 0; k < 2; ++k) \
        acc[ai][bj][m][n] = __builtin_amdgcn_mfma_f32_16x16x32_bf16(Bt[n][k], At[m][k], acc[ai][bj][m][n], 0, 0, 0); __builtin_amdgcn_s_setprio(0); } while (0)
#define PG8_WAIT_V(n) asm volatile("s_waitcnt vmcnt(" #n ")" ::: "memory")
#define PG8_WAIT_L(n) asm volatile("s_waitcnt lgkmcnt(" #n ")" ::: "memory")
#define PG8_BAR __builtin_amdgcn_s_barrier()
#define PG8_SCHED __builtin_amdgcn_sched_barrier(0)
    Unit cur, nxt; int ui = 0;
    if (!S.next(0, cur)) return;
    f32x4 acc[2][2][4][2];
#pragma unroll
    for (int a = 0; a < 2; ++a)
#pragma unroll
        for (int b = 0; b < 2; ++b)
#pragma unroll
            for (int m = 0; m < 4; ++m)
#pragma unroll
                for (int n = 0; n < 2; ++n) acc[a][b][m][n] = (f32x4){0.f, 0.f, 0.f, 0.f};
    bf16x8 At[4][2], B0[2][2], B1[2][2];
    const char* cA = (const char*)g.A + (size_t)cur.pm * tstep; const char* cB = (const char*)g.Bt + (size_t)cur.pn * tstep;
    S.a_ready(cur);
    if constexpr (SP2) {
        PG8_STAGE(PG8_SB(0, 0), cB, voffB); PG8_STAGE(PG8_SB(0, 1), cB + hstep, voffB); PG8_STAGE(PG8_SA(0, 0), cA, voffA); PG8_STAGE(PG8_SA(0, 1), cA + hstep, voffA);
        if (wr == 1) PG8_BAR;
        PG8_WAIT_V(2); PG8_BAR;
        PG8_STAGE(PG8_SB(1, 0), cB + kstep, voffB); PG8_STAGE(PG8_SA(1, 0), cA + kstep, voffA); PG8_STAGE(PG8_SB(1, 1), cB + hstep + kstep, voffB);
        PG8_WAIT_V(6); PG8_BAR;
    } else {
        PG8_STAGE(PG8_SB(0, 0), cB, voffB); PG8_STAGE(PG8_SA(0, 0), cA, voffA); PG8_STAGE(PG8_SB(0, 1), cB + hstep, voffB); PG8_STAGE(PG8_SA(0, 1), cA + hstep, voffA);
        if (wr == 1) PG8_BAR;
        PG8_WAIT_V(4); PG8_BAR;
        PG8_STAGE(PG8_SB(1, 0), cB + kstep, voffB); PG8_STAGE(PG8_SA(1, 0), cA + kstep, voffA); PG8_STAGE(PG8_SB(1, 1), cB + hstep + kstep, voffB);
        PG8_WAIT_V(6); PG8_BAR;
    }
    for (;;) {
        const bool has_next = S.next(ui + 1, nxt);
        const char* nA = has_next ? (const char*)g.A + (size_t)nxt.pm * tstep : cA; const char* nB = has_next ? (const char*)g.Bt + (size_t)nxt.pn * tstep : cB;
        for (int t = 0; t < nt; t += 2) {
            const bool last = (t == nt - 2);
            const char* a1 = cA + (size_t)(t + 1) * kstep;
            const char* a2 = last ? nA : cA + (size_t)(t + 2) * kstep; const char* b2 = last ? nB : cB + (size_t)(t + 2) * kstep;
            const char* a3 = a2 + kstep; const char* b3 = b2 + kstep;
            if (last && has_next) S.a_ready(nxt);
            if constexpr (SP2) {
            PG8_LDB(B0, 0, 0); PG8_LDB(B1, 0, 1); PG8_SCHED; PG8_LDA(At, 0, 0); PG8_STAGE(PG8_SA(1, 1), a1 + hstep, voffA);
            PG8_WAIT_V(8); PG8_WAIT_L(0); PG8_BAR; PG8_MMA(0, 0, At, B0); PG8_MMA(0, 1, At, B1); PG8_BAR; PG8_SCHED;
            PG8_LDA(At, 0, 1); PG8_STAGE(PG8_SB(0, 0), b2, voffB); PG8_STAGE(PG8_SB(0, 1), b2 + hstep, voffB); PG8_STAGE(PG8_SA(0, 0), a2, voffA);
            PG8_WAIT_V(8); PG8_WAIT_L(0); PG8_BAR; PG8_MMA(1, 0, At, B0); PG8_MMA(1, 1, At, B1); PG8_BAR; PG8_SCHED;
            PG8_LDB(B0, 1, 0); PG8_LDB(B1, 1, 1); PG8_SCHED; PG8_LDA(At, 1, 0); PG8_STAGE(PG8_SA(0, 1), a2 + hstep, voffA);
            PG8_WAIT_V(8); PG8_WAIT_L(0); PG8_BAR; PG8_MMA(0, 0, At, B0); PG8_MMA(0, 1, At, B1); PG8_BAR; PG8_SCHED;
            PG8_LDA(At, 1, 1); PG8_STAGE(PG8_SB(1, 0), b3, voffB); PG8_STAGE(PG8_SB(1, 1), b3 + hstep, voffB); PG8_STAGE(PG8_SA(1, 0), a3, voffA);
            PG8_WAIT_V(8); PG8_WAIT_L(0); PG8_BAR; PG8_MMA(1, 0, At, B0); PG8_MMA(1, 1, At, B1); PG8_BAR; PG8_SCHED;
            } else {
            PG8_LDB(B0, 0, 0); PG8_SCHED; PG8_LDA(At, 0, 0); PG8_STAGE(PG8_SA(1, 1), a1 + hstep, voffA);
            PG8_WAIT_L(8); PG8_BAR; PG8_WAIT_L(0); PG8_MMA(0, 0, At, B0); PG8_BAR; PG8_SCHED;
            PG8_LDB(B1, 0, 1); PG8_STAGE(PG8_SB(0, 0), b2, voffB);
            PG8_BAR; PG8_WAIT_L(0); PG8_MMA(0, 1, At, B1); PG8_BAR;
            PG8_LDA(At, 0, 1); PG8_STAGE(PG8_SA(0, 0), a2, voffA);
            PG8_BAR; PG8_WAIT_L(0); PG8_MMA(1, 0, At, B0); PG8_BAR; PG8_SCHED;
            PG8_STAGE(PG8_SB(0, 1), b2 + hstep, voffB);
            PG8_WAIT_V(6); PG8_BAR; PG8_MMA(1, 1, At, B1); PG8_BAR;
            PG8_LDB(B0, 1, 0); PG8_SCHED; PG8_LDA(At, 1, 0); PG8_STAGE(PG8_SA(0, 1), a2 + hstep, voffA);
            PG8_WAIT_L(8); PG8_BAR; PG8_WAIT_L(0); PG8_MMA(0, 0, At, B0); PG8_BAR; PG8_SCHED;
            PG8_LDB(B1, 1, 1); PG8_STAGE(PG8_SB(1, 0), b3, voffB);
            PG8_BAR; PG8_WAIT_L(0); PG8_MMA(0, 1, At, B1); PG8_BAR;
            PG8_LDA(At, 1, 1); PG8_STAGE(PG8_SA(1, 0), a3, voffA);
            PG8_BAR; PG8_WAIT_L(0); PG8_MMA(1, 0, At, B0); PG8_BAR; PG8_SCHED;
            PG8_STAGE(PG8_SB(1, 1), b3 + hstep, voffB);
            PG8_WAIT_V(6); PG8_BAR; PG8_MMA(1, 1, At, B1); PG8_BAR;
            }
        }
        if constexpr (ALIGN_EPI) { if (wr == 0) PG8_BAR; }
        if constexpr (!Epi::AFTER_DRAIN) { E(acc, cur, wr, wc, fr, fq); S.done(cur); }
        if (!has_next) break;
#pragma unroll
        for (int a = 0; a < 2; ++a)
#pragma unroll
            for (int b = 0; b < 2; ++b)
#pragma unroll
                for (int m = 0; m < 4; ++m)
#pragma unroll
                    for (int n = 0; n < 2; ++n) acc[a][b][m][n] = (f32x4){0.f, 0.f, 0.f, 0.f};
        cur = nxt; cA = nA; cB = nB; ++ui;
        if constexpr (ALIGN_EPI) { if (wr == 1) PG8_BAR; }
    }
    PG8_WAIT_V(0);
    if constexpr (!ALIGN_EPI) { if (wr == 0) PG8_BAR; }
    PG8_BAR;
    if constexpr (Epi::AFTER_DRAIN) { E.fused(acc, cur, wr, wc, fr, fq, lds, wid, lane); S.done(cur); }
#undef PG8_SA
#undef PG8_SB
#undef PG8_STAGE
#undef PG8_LDA
#undef PG8_LDB
#undef PG8_MMA
#undef PG8_WAIT_V
#undef PG8_WAIT_L
#undef PG8_BAR
#undef PG8_SCHED
}
}

constexpr int D = 1024, NB = 2, SEQ = 16384, NMETA = 16, LTOK = SEQ + NMETA  , PADR = 112, T = PADR + LTOK  ;
constexpr int M = NB * T;
constexpr int DEPTH = 2, HD = 64, RW_H = 6, SB_H = 5, FX_H = 5, RW_W = 384, SHIFT_W = 1280, D_IN = 6277;
constexpr int QKV_W = 1920;
constexpr int N1 = 3328;
constexpr int FCOL = 3200, GCOL = 3205;
constexpr int NEXP = 16, DEXP = 256;
constexpr int MS = 70144;
constexpr int LCH = 32, LPADDED = 16416;
constexpr int KBP = 16896;
constexpr float C2 = 0.125f * 1.4426950408889634f;
constexpr float LOG2E = 1.4426950408889634f;
constexpr int NWAVES = 8, NTHR = 512;

constexpr size_t MiB = 1u << 20;
constexpr size_t WS_CTL = 0, CTL_ZERO_BYTES = 65536;
constexpr size_t WS_HM = 1 * MiB;
constexpr size_t WS_LOGF = WS_HM + 131072;
constexpr size_t WS_KB2 = WS_LOGF + (size_t)M * 32;
constexpr size_t WS_TOK = WS_KB2 + (size_t)10 * KBP * 4;
constexpr size_t WS_SLOT = WS_TOK + (size_t)M * 32;
constexpr size_t WS_CWS = WS_SLOT + (size_t)M * 8;
constexpr size_t WS_WGCNT = WS_CWS + (size_t)MS * 4;
constexpr size_t WS_SMALL_END = WS_WGCNT + 256 * 16 * 4;
static_assert(WS_SMALL_END <= 8 * MiB, "small buffers");
constexpr size_t WS_WIN = 8 * MiB;
constexpr size_t WS_WG = WS_WIN + (size_t)N1 * 1024 * 2;
constexpr size_t WS_WP = WS_WG + (size_t)3072 * 1024 * 2;
constexpr size_t WS_WO = WS_WP + (size_t)3072 * 384 * 2;
constexpr size_t WS_WGU = WS_WO + (size_t)1024 * 1024 * 2;
constexpr size_t WS_WD = WS_WGU + (size_t)8192 * 1024 * 2;
constexpr size_t WS_W_END = WS_WD + (size_t)16384 * 256 * 2;
static_assert(WS_W_END <= 49 * MiB, "weights");
constexpr size_t WS_A = 49 * MiB;
constexpr size_t WS_BIG = 115 * MiB;
constexpr size_t WS_USH = WS_BIG;
constexpr size_t WS_YCAT = WS_BIG;
constexpr size_t WS_QKV = WS_BIG + 82 * MiB;
constexpr size_t WS_RW = WS_BIG + 204 * MiB;
constexpr size_t WS_BN = WS_BIG + 349 * MiB;
constexpr size_t WS_GATES = WS_BIG + 82 * MiB;
constexpr size_t WS_MERGED = WS_BIG + 276 * MiB;
constexpr size_t WS_AS = WS_BIG;
constexpr size_t WS_HS = WS_BIG + 137 * MiB;
constexpr size_t WS_Y = WS_BIG + 172 * MiB;
constexpr size_t WS_END = WS_BIG + 374 * MiB;
static_assert((size_t)(M + 256) * 1280 * 2 <= 82 * MiB && (size_t)3 * M * 384 * 2 <= 82 * MiB && (size_t)(M + 256) * 1920 * 2 <= 122 * MiB, "big map 1");
static_assert((size_t)12 * LPADDED * 768 <= 145 * MiB && (size_t)M * 384 * 2 <= 25 * MiB && (size_t)M * 3072 * 2 <= 194 * MiB && (size_t)M * 2048 <= 65 * MiB, "big map 2");
static_assert((size_t)MS * 2048 <= 137 * MiB && (size_t)MS * 512 <= 35 * MiB && WS_END <= 489 * MiB, "big map 3");

constexpr int CW_BAR = 0;
constexpr int CW_QUEUE = 4096;
constexpr int CW_ECNT = 4352;
static_assert((CW_ECNT + 128) * 4 <= (int)CTL_ZERO_BYTES, "ctl");

constexpr int RING_BYTES = 131072, MISC_OFF = RING_BYTES, LDS_BYTES = 147456;

typedef unsigned short bf16_t;
typedef float f32x4 __attribute__((ext_vector_type(4)));
typedef float f32x2 __attribute__((ext_vector_type(2)));
typedef float f32x16 __attribute__((ext_vector_type(16)));
typedef unsigned u32x4 __attribute__((ext_vector_type(4)));
typedef unsigned u32x2 __attribute__((ext_vector_type(2)));
typedef short bf16x8 __attribute__((ext_vector_type(8)));
typedef short s16x4 __attribute__((ext_vector_type(4)));
typedef _Float16 f16x4 __attribute__((ext_vector_type(4)));
typedef __bf16 bf16x2_t __attribute__((ext_vector_type(2)));

__device__ __forceinline__ unsigned pk2(float lo, float hi) { f32x2 v = {lo, hi}; bf16x2_t b = __builtin_convertvector(v, bf16x2_t); return __builtin_bit_cast(unsigned, b); }
__device__ __forceinline__ unsigned short f2bf(float f) { return (unsigned short)(pk2(f, 0.f) & 0xffffu); }
__device__ __forceinline__ float bf_lo(unsigned u) { return __uint_as_float(u << 16); }
__device__ __forceinline__ float bf_hi(unsigned u) { return __uint_as_float(u & 0xffff0000u); }
__device__ __forceinline__ float bf2f(unsigned short h) { return __uint_as_float((unsigned)h << 16); }
__device__ __forceinline__ float wave_sum(float v) {
#pragma unroll
    for (int o = 1; o < 64; o <<= 1) v += __shfl_xor(v, o);
    return v;
}
__device__ __forceinline__ float fast_exp(float x) { return __builtin_amdgcn_exp2f(x * LOG2E); }
__device__ __forceinline__ float fast_log(float x) { return __builtin_amdgcn_logf(x) * 0.6931471805599453f; }
__device__ __forceinline__ float softplus_f(float z) { return fmaxf(z, 0.f) + fast_log(1.f + fast_exp(-fabsf(z))); }

#define XB_TMO      128
#define XB_XCNT(j)  (256  + 64 * (j))
#define XB_XSUB(j)  (1280 + 64 * (j))
#define XB_XGEN(j)  (2304 + 64 * (j))
#define XB_TOP      3328
#define XB_TOPGEN   3392
#define XCD_BAR_WORDS 3456
#define XB_SPIN_CAP (1u << 20)
__device__ __forceinline__ unsigned xb_ld(unsigned* p)              { return __hip_atomic_load(p, __ATOMIC_RELAXED, __HIP_MEMORY_SCOPE_AGENT); }
__device__ __forceinline__ unsigned xb_add(unsigned* p, unsigned v) { return __hip_atomic_fetch_add(p, v, __ATOMIC_RELAXED, __HIP_MEMORY_SCOPE_AGENT); }
__device__ __forceinline__ unsigned xb_xcc_id() { return (unsigned)__builtin_amdgcn_s_getreg((3 << 11) | 20) & 0xFu; }
#define XB_SPIN(cond, bar) do { unsigned _sp = 0; while (cond) { __builtin_amdgcn_s_sleep(1); \
    if ((++_sp & 255u) == 0u) { if (xb_ld(&(bar)[XB_TMO])) break; if (_sp > XB_SPIN_CAP) { atomicAdd(&(bar)[XB_TMO], 1u); break; } } } } while (0)

struct XcdBarrier {
    unsigned* bar; unsigned x;
    volatile LAS unsigned* st;
};

__device__ __forceinline__ XcdBarrier xcd_barrier_post(unsigned* bar, volatile LAS unsigned* st) {
    XcdBarrier b; b.bar = bar; b.x = xb_xcc_id(); b.st = st;
    if (threadIdx.x == 0) (void)xb_add(&bar[XB_XCNT(b.x)], 1u);
    return b;
}
__device__ __forceinline__ void xcd_barrier_complete(unsigned* bar, unsigned x, unsigned& nloc, unsigned& nx) {
    const unsigned G = gridDim.x * gridDim.y * gridDim.z;
    unsigned sum, cnt, mine, sp = 0u;
    for (;;) {
        sum = 0u; cnt = 0u; mine = 0u;
#pragma unroll
        for (unsigned j = 0; j < 16; ++j) { const unsigned c = xb_ld(&bar[XB_XCNT(j)]); sum += c; cnt += (c > 0u) ? 1u : 0u; mine = (j == x) ? c : mine; }
        if (sum == G) break;
        __builtin_amdgcn_s_sleep(1);
        if ((++sp & 255u) == 0u) { if (xb_ld(&bar[XB_TMO])) break; if (sp > XB_SPIN_CAP) { atomicAdd(&bar[XB_TMO], 1u); break; } }
    }
    nloc = mine > 0u ? mine : 1u; nx = cnt > 0u ? cnt : 1u;
}

__device__ __forceinline__ void xcd_barrier(const XcdBarrier& b) {
    asm volatile("s_waitcnt vmcnt(0)" ::: "memory");
    __syncthreads();
    if (threadIdx.x == 0) {
        unsigned* bar = b.bar;
        __builtin_amdgcn_s_waitcnt(0);
        unsigned nloc = b.st[0], nx = b.st[1];
        if (nloc == 0u) { xcd_barrier_complete(bar, b.x, nloc, nx); b.st[0] = nloc; b.st[1] = nx; }
        const unsigned old = xb_add(&bar[XB_XSUB(b.x)], 1u);
        const unsigned gen = old / nloc;
        if (old + 1u == (gen + 1u) * nloc) {
            __builtin_amdgcn_fence(__ATOMIC_RELEASE, "agent");
            asm volatile("s_waitcnt vmcnt(0)" ::: "memory");
            const unsigned og = xb_add(&bar[XB_TOP], 1u);
            const unsigned tg = og / nx;
            if (og + 1u == (tg + 1u) * nx) xb_add(&bar[XB_TOPGEN], 1u);
            else XB_SPIN(xb_ld(&bar[XB_TOPGEN]) == tg, bar);
            __builtin_amdgcn_fence(__ATOMIC_ACQUIRE, "agent");
            xb_add(&bar[XB_XGEN(b.x)], 1u);
            asm volatile("s_waitcnt vmcnt(0)" ::: "memory");
        } else {
            XB_SPIN(xb_ld(&bar[XB_XGEN(b.x)]) == gen, bar);
            __builtin_amdgcn_fence(__ATOMIC_ACQUIRE, "agent");
            asm volatile("s_waitcnt vmcnt(0)" ::: "memory");
        }
    }
    __syncthreads();
}

struct Args { const float* in[29]; float* out; unsigned char* ws; };
enum { I_X = 0, I_META, I_N1G, I_WIN, I_MU, I_WUP, I_W0, I_AUP, I_A0, I_KK, I_KA, I_RK, I_LNG, I_LNB, I_FB, I_QG, I_KG, I_WPR, I_WPS, I_WPF, I_WOUT, I_N2G, I_MWG, I_MBG, I_MWE, I_MBE, I_MGATE, I_MUP, I_MDOWN };
struct ArgsL { volatile LAS unsigned* tab; float* out; unsigned char* ws;
    __device__ __forceinline__ const float* in(int i) const { const unsigned lo = tab[2 * i], hi = tab[2 * i + 1];
        return (const float*)(((unsigned long long)(unsigned)__builtin_amdgcn_readfirstlane((int)hi) << 32) | (unsigned long long)(unsigned)__builtin_amdgcn_readfirstlane((int)lo)); }
};
struct Frame { LAS unsigned char* lds; volatile LAS unsigned* MISC; int tid, lane, wave; };

__device__ __forceinline__ float* hrow(const ArgsL& a, int b, int l) {
    return l < NMETA ? (float*)(a.ws + WS_HM) + (size_t)(b * NMETA + l) * D : a.out + ((size_t)b * SEQ + (l - NMETA)) * D;
}
#define LDS_WAIT() asm volatile("s_waitcnt lgkmcnt(0)" ::: "memory")

__device__ __forceinline__ void tr_item(const float* W, int ldw, int sc0, int nvalid, int k0, int kvalid, bf16_t* WT, int Kd, int r0, LAS float* scr, int lane) {
#pragma unroll 8
    for (int i = 0; i < 32; ++i) { const int kk = 2 * i + (lane >> 5), n = lane & 31; float v = 0.f;
        if (n < nvalid && k0 + kk < kvalid) v = W[(size_t)(k0 + kk) * ldw + sc0 + n];
        scr[kk * 33 + n] = v; }
    LDS_WAIT();
    const int c = lane & 7;
#pragma unroll
    for (int j = 0; j < 4; ++j) { const int n = (lane >> 3) + 8 * j; const LAS float* s = scr + (8 * c) * 33 + n;
        u32x4 o; o.x = pk2(s[0 * 33], s[1 * 33]); o.y = pk2(s[2 * 33], s[3 * 33]); o.z = pk2(s[4 * 33], s[5 * 33]); o.w = pk2(s[6 * 33], s[7 * 33]);
        *(u32x4*)(WT + (size_t)(r0 + n) * Kd + k0 + 8 * c) = o; }
    LDS_WAIT();
}
__device__ __forceinline__ void phase_wconv(const ArgsL& a, Frame& F, int layer) {
    LAS float* scr = (LAS float*)(F.lds + F.wave * 8448);
    const int gw = blockIdx.x * NWAVES + F.wave, NGW = gridDim.x * NWAVES;
    constexpr int C1 = 16 * 104, C2_ = C1 + 16 * 96, C3 = C2_ + 6 * 96, C4 = C3 + 16 * 32, C5 = C4 + 16 * 256, C6 = C5 + 4 * 512;
    unsigned char* ws = a.ws;
    for (int it = gw; it < C6; it += NGW) {
        if (it < C1) { const int kb = it / 104, nb = it % 104, r0 = nb * 32;
            tr_item(a.in(I_WIN) + (size_t)layer * D * D_IN, D_IN, r0, r0 < FCOL ? 32 : 0, kb * 64, 1024, (bf16_t*)(ws + WS_WIN), 1024, r0, scr, F.lane); }
        else if (it < C2_) { const int r = it - C1, kb = r / 96, nb = r % 96, r0 = nb * 32;
            tr_item(a.in(I_WIN) + (size_t)layer * D * D_IN, D_IN, GCOL + r0, 32, kb * 64, 1024, (bf16_t*)(ws + WS_WG), 1024, r0, scr, F.lane); }
        else if (it < C3) { const int r = it - C2_, kb = r / 96, nb = r % 96, r0 = nb * 32, br = r0 >> 10;
            const float* W = (br == 0 ? a.in(I_WPR) + (size_t)layer * 384 * D : br == 1 ? a.in(I_WPS) + (size_t)layer * 320 * D : a.in(I_WPF) + (size_t)layer * 320 * D);
            tr_item(W, D, r0 & 1023, 32, kb * 64, br == 0 ? 384 : 320, (bf16_t*)(ws + WS_WP), 384, r0, scr, F.lane); }
        else if (it < C4) { const int r = it - C3, kb = r / 32, nb = r % 32, r0 = nb * 32;
            tr_item(a.in(I_WOUT) + (size_t)layer * D * D, D, r0, 32, kb * 64, 1024, (bf16_t*)(ws + WS_WO), 1024, r0, scr, F.lane); }
        else if (it < C5) { const int r = it - C4, kb = r / 256, nb = r % 256, r0 = nb * 32, e = r0 >> 9, rr = r0 & 511, j = rr >> 8, q = rr & 255;
            const float* W = (q >= 128 ? a.in(I_MUP) : a.in(I_MGATE)) + ((size_t)layer * NEXP + e) * D * DEXP;
            tr_item(W, DEXP, j * 128 + (q & 127), 32, kb * 64, 1024, (bf16_t*)(ws + WS_WGU), 1024, r0, scr, F.lane); }
        else { const int r = it - C5, kb = r / 512, nb = r % 512, r0 = nb * 32, e = r0 >> 10;
            tr_item(a.in(I_MDOWN) + ((size_t)layer * NEXP + e) * DEXP * D, D, r0 & 1023, 32, kb * 64, 256, (bf16_t*)(ws + WS_WD), 256, r0, scr, F.lane); }
    }
}

__device__ __forceinline__ void add_y_row(f32x4 (&v)[4], const bf16_t* Y, int slot, int lane) {
    const u32x2* y = (const u32x2*)(Y + (size_t)slot * D) + lane;
#pragma unroll
    for (int j = 0; j < 4; ++j) { const u32x2 t = y[64 * j]; v[j].x += bf_lo(t.x); v[j].y += bf_hi(t.x); v[j].z += bf_lo(t.y); v[j].w += bf_hi(t.y); }
}
template <int MODE>
__device__ __forceinline__ void phase_norm(const ArgsL& a, Frame& F, int layer) {
    const int lane = F.lane;
    LAS float* wl = (LAS float*)F.lds;
    LAS int* lcnt = (LAS int*)(F.lds + 20 * 4096);
    unsigned char* ws = a.ws;
    if (MODE == 1) {
        const float* win = a.in(I_WIN) + (size_t)layer * D * D_IN;
        for (int idx = F.tid; idx < 5 * 1024; idx += NTHR) { const int k = idx / 5, j = idx % 5; wl[j * 1024 + k] = win[(size_t)k * D_IN + FCOL + j]; }
    }
    if (MODE == 2) {
        const float* wg = a.in(I_MWG) + (size_t)layer * D * 4; const float* we = a.in(I_MWE) + (size_t)layer * D * 16;
        for (int idx = F.tid; idx < 4 * 1024; idx += NTHR) { const int k = idx >> 2, j = idx & 3; wl[j * 1024 + k] = wg[idx]; }
        for (int idx = F.tid; idx < 16 * 1024; idx += NTHR) { const int k = idx >> 4, j = idx & 15; wl[(4 + j) * 1024 + k] = we[idx]; }
        if (F.tid < 16) lcnt[F.tid] = 0;
    }
    __syncthreads();
    const int gw = blockIdx.x * NWAVES + F.wave, NGW = gridDim.x * NWAVES;
    const float* gsrc = (MODE == 2 ? a.in(I_N2G) : a.in(I_N1G)) + layer * D;
    f32x4 gv[4];
#pragma unroll
    for (int j = 0; j < 4; ++j) gv[j] = (MODE == 0) ? (f32x4){0.f, 0.f, 0.f, 0.f} : *(const f32x4*)(gsrc + 4 * lane + 256 * j);
    bf16_t* A = (bf16_t*)(ws + WS_A);
    const bf16_t* Y = (const bf16_t*)(ws + WS_Y);
    const int* SLOT = (const int*)(ws + WS_SLOT);
    for (int m = gw; m < M; m += NGW) {
        const int b = m / T, p = m - b * T, l = p - PADR;
        if (l < 0) {
            if (MODE == 1) {
                u32x2* o = (u32x2*)(A + (size_t)m * D) + lane;
#pragma unroll
                for (int j = 0; j < 4; ++j) o[64 * j] = (u32x2){0u, 0u};
                if (lane < 8) ((float*)(ws + WS_LOGF))[(size_t)m * 8 + lane] = 0.f;
            }
            continue;
        }
        if (MODE == 0 && l < NMETA) continue;
        float* hp = hrow(a, b, l);
        const float* src = hp;
        if (MODE == 1 && layer == 0) src = (l < NMETA) ? a.in(I_META) + (size_t)l * D : a.in(I_X) + ((size_t)b * SEQ + (l - NMETA)) * D;
        f32x4 v[4];
#pragma unroll
        for (int j = 0; j < 4; ++j) v[j] = *(const f32x4*)(src + 4 * lane + 256 * j);
        if (MODE == 0 || (MODE == 1 && layer > 0)) {
            const int s0 = SLOT[2 * m], s1 = SLOT[2 * m + 1];
            add_y_row(v, Y, s0, lane); add_y_row(v, Y, s1, lane);
        }
        if (MODE == 0 || MODE == 1) {
#pragma unroll
            for (int j = 0; j < 4; ++j) *(f32x4*)(hp + 4 * lane + 256 * j) = v[j];
        }
        if (MODE == 0) continue;
        float ss = 0.f;
#pragma unroll
        for (int j = 0; j < 4; ++j) ss += (v[j].x * v[j].x + v[j].y * v[j].y) + (v[j].z * v[j].z + v[j].w * v[j].w);
        const float r = 1.0f / sqrtf(wave_sum(ss) * (1.0f / D) + 1e-6f);
#pragma unroll
        for (int j = 0; j < 4; ++j) v[j] = v[j] * r * gv[j];
        u32x2* o = (u32x2*)(A + (size_t)m * D) + lane;
#pragma unroll
        for (int j = 0; j < 4; ++j) o[64 * j] = (u32x2){pk2(v[j].x, v[j].y), pk2(v[j].z, v[j].w)};
        if (MODE == 1) {
            float dsum[5];
#pragma unroll
            for (int q = 0; q < 5; ++q) { float d = 0.f;
#pragma unroll
                for (int j = 0; j < 4; ++j) { const f32x4 w = *(const LAS f32x4*)(wl + q * 1024 + 4 * lane + 256 * j); d += (v[j].x * w.x + v[j].y * w.y) + (v[j].z * w.z + v[j].w * w.w); }
                dsum[q] = wave_sum(d); }
            float mine = dsum[0];
            mine = lane == 1 ? dsum[1] : mine; mine = lane == 2 ? dsum[2] : mine; mine = lane == 3 ? dsum[3] : mine; mine = lane == 4 ? dsum[4] : mine;
            if (lane < 8) { float lf = 0.f;
                if (lane < 5) { const float xx = mine + a.in(I_FB)[layer * 5 + lane]; lf = fminf(xx, 0.f) - fast_log(1.f + fast_exp(-fabsf(xx))); }
                ((float*)(ws + WS_LOGF))[(size_t)m * 8 + lane] = lf; }
        }
        if (MODE == 2) {
            float ds[20];
#pragma unroll
            for (int q = 0; q < 20; ++q) { float d = 0.f;
#pragma unroll
                for (int j = 0; j < 4; ++j) { const f32x4 w = *(const LAS f32x4*)(wl + q * 1024 + 4 * lane + 256 * j); d += (v[j].x * w.x + v[j].y * w.y) + (v[j].z * w.z + v[j].w * w.w); }
                ds[q] = wave_sum(d); }
            const float* bg = a.in(I_MBG) + layer * 4; const float* be = a.in(I_MBE) + layer * 16;
            float lg0 = ds[0] + bg[0], lg1 = ds[1] + bg[1], lg2 = ds[2] + bg[2], lg3 = ds[3] + bg[3];
            int g = 0; float mx = lg0;
            if (lg1 > mx) { mx = lg1; g = 1; } if (lg2 > mx) { mx = lg2; g = 2; } if (lg3 > mx) { mx = lg3; g = 3; }
            const float den = fast_exp(lg0 - mx) + fast_exp(lg1 - mx) + fast_exp(lg2 - mx) + fast_exp(lg3 - mx);
            const float pgrp = 1.0f / den;
            float s0 = g == 0 ? ds[4] : g == 1 ? ds[8] : g == 2 ? ds[12] : ds[16];
            float s1 = g == 0 ? ds[5] : g == 1 ? ds[9] : g == 2 ? ds[13] : ds[17];
            float s2 = g == 0 ? ds[6] : g == 1 ? ds[10] : g == 2 ? ds[14] : ds[18];
            float s3 = g == 0 ? ds[7] : g == 1 ? ds[11] : g == 2 ? ds[15] : ds[19];
            s0 += be[g * 4 + 0]; s1 += be[g * 4 + 1]; s2 += be[g * 4 + 2]; s3 += be[g * 4 + 3];
            int i0 = 0; float v0 = s0;
            if (s1 > v0) { v0 = s1; i0 = 1; } if (s2 > v0) { v0 = s2; i0 = 2; } if (s3 > v0) { v0 = s3; i0 = 3; }
            int i1 = -1; float v1 = -3.0e38f;
            if (i0 != 0 && s0 > v1) { v1 = s0; i1 = 0; } if (i0 != 1 && s1 > v1) { v1 = s1; i1 = 1; } if (i0 != 2 && s2 > v1) { v1 = s2; i1 = 2; } if (i0 != 3 && s3 > v1) { v1 = s3; i1 = 3; }
            const float e1 = fast_exp(v1 - v0), pt0 = 1.0f / (1.0f + e1), pt1 = e1 * pt0;
            if (lane == 0) {
                const int ea = g * 4 + i0, eb = g * 4 + i1;
                const int la = atomicAdd((int*)&lcnt[ea], 1), lb = atomicAdd((int*)&lcnt[eb], 1);
                int* tk = (int*)(ws + WS_TOK) + (size_t)m * 8;
                tk[0] = ea; tk[1] = eb; tk[2] = __float_as_int(pgrp * pt0); tk[3] = __float_as_int(pgrp * pt1); tk[4] = la; tk[5] = lb;
            }
        }
    }
    __syncthreads();
    if (MODE == 2 && F.tid < 16) {
        const int c = lcnt[F.tid];
        ((int*)(ws + WS_WGCNT))[blockIdx.x * 16 + F.tid] = c;
        atomicAdd((int*)(ws + WS_CTL) + CW_ECNT + 64 * layer + F.tid, c);
    }
    __syncthreads();
}

__device__ __forceinline__ void phase_route(const ArgsL& a, Frame& F, int layer) {
    unsigned char* ws = a.ws;
    LAS int* tbl = (LAS int*)F.lds;
    if (F.tid < 16) {
        const int* cnt = (const int*)(ws + WS_CTL) + CW_ECNT + 64 * layer;
        int base = 0;
        for (int e = 0; e < F.tid; ++e) base += ((__hip_atomic_load(cnt + e, __ATOMIC_RELAXED, __HIP_MEMORY_SCOPE_AGENT) + 255) >> 8) << 8;
        const int* wc = (const int*)(ws + WS_WGCNT);
        for (int w = 0; w < (int)blockIdx.x; ++w) base += wc[w * 16 + F.tid];
        tbl[F.tid] = base;
    }
    __syncthreads();
    const int gw = blockIdx.x * NWAVES + F.wave, NGW = gridDim.x * NWAVES, lane = F.lane;
    const bf16_t* A = (const bf16_t*)(ws + WS_A); bf16_t* AS = (bf16_t*)(ws + WS_AS);
    for (int m = gw; m < M; m += NGW) {
        const int b = m / T, p = m - b * T, l = p - PADR;
        if (l < 0) continue;
        const int* tk = (const int*)(ws + WS_TOK) + (size_t)m * 8;
        const int ea = tk[0], eb = tk[1], sa = tbl[ea] + tk[4], sb = tbl[eb] + tk[5];
        const u32x4* src = (const u32x4*)(A + (size_t)m * D) + lane;
        const u32x4 x0 = src[0], x1 = src[64];
        u32x4* d0 = (u32x4*)(AS + (size_t)sa * D) + lane; u32x4* d1 = (u32x4*)(AS + (size_t)sb * D) + lane;
        d0[0] = x0; d0[64] = x1; d1[0] = x0; d1[64] = x1;
        if (lane == 0) { int* sl = (int*)(ws + WS_SLOT) + 2 * m; sl[0] = sa; sl[1] = sb;
            float* cw = (float*)(ws + WS_CWS); cw[sa] = __int_as_float(tk[2]); cw[sb] = __int_as_float(tk[3]); }
    }
    __syncthreads();
}

__device__ __forceinline__ void phase_prep(const ArgsL& a, Frame& F, int layer) {
    unsigned char* ws = a.ws;
    LAS float* xs = (LAS float*)F.lds;
    const int wave = F.wave, lane = F.lane, tid = F.tid;
    const int m0 = blockIdx.x * 129;
    const bf16_t* USH = (const bf16_t*)(ws + WS_USH);
    bf16_t* QKV = (bf16_t*)(ws + WS_QKV);
    if (blockIdx.x < 10) {
        const int bh = blockIdx.x, b = bh / 5, h = bh % 5;
        const float* LOGF = (const float*)(ws + WS_LOGF) + (size_t)(b * T + PADR) * 8 + h;
        float* kb = (float*)(ws + WS_KB2) + (size_t)bh * KBP;
        LAS float* wtot = (LAS float*)F.lds;
        float v[33];
        const int l0 = tid * 33;
#pragma unroll
        for (int i = 0; i < 33; ++i) v[i] = (l0 + i < LTOK) ? LOGF[(size_t)(l0 + i) * 8] : 0.f;
#pragma unroll
        for (int i = 1; i < 33; ++i) v[i] += v[i - 1];
        float incl = v[32];
#pragma unroll
        for (int o = 1; o < 64; o <<= 1) { const float t = __shfl_up(incl, o); if (lane >= o) incl += t; }
        if (lane == 63) wtot[wave] = incl;
        __syncthreads();
        float off = incl - v[32];
        for (int w = 0; w < wave; ++w) off += wtot[w];
#pragma unroll
        for (int i = 0; i < 33; ++i) if (l0 + i < LTOK) kb[PADR + l0 + i] = -(off + v[i]) * LOG2E;
        for (int p = tid; p < PADR; p += NTHR) kb[p] = 0.f;
        for (int p = T + tid; p < KBP; p += NTHR) kb[p] = 0.f;
        __syncthreads();
    }
    float w0j = 0.f, a0j = 0.f, kkj = 0.f, kaj = 0.f, rkj = 0.f;
    const int jch = wave * 64 + lane;
    const float* WU = a.in(I_WUP) + (size_t)layer * 64 * RW_W + (wave < 6 ? jch : 0); const float* AU = a.in(I_AUP) + (size_t)layer * 64 * RW_W + (wave < 6 ? jch : 0);
    if (wave < 6) {
        w0j = a.in(I_W0)[layer * RW_W + jch]; a0j = a.in(I_A0)[layer * RW_W + jch];
        kkj = a.in(I_KK)[layer * RW_W + jch]; kaj = a.in(I_KA)[layer * RW_W + jch]; rkj = a.in(I_RK)[layer * RW_W + jch];
    }
    const float* mu = a.in(I_MU) + layer * SHIFT_W;
    const float gq = a.in(I_QG)[layer * 64 + lane] * C2, gk = a.in(I_KG)[layer * 64 + lane];
    _Float16* RW = (_Float16*)(ws + WS_RW);
    bf16_t* BN = (bf16_t*)(ws + WS_BN);
    for (int t0 = 0; t0 < 129; t0 += 16) {
        const int nt = (129 - t0) < 16 ? (129 - t0) : 16;
        for (int item = tid; item < nt * 160; item += NTHR) {
            const int tok = item / 160, ch = item - tok * 160, m = m0 + t0 + tok;
            const u32x4 u = *(const u32x4*)(USH + (size_t)m * SHIFT_W + ch * 8);
            u32x4 pv = (u32x4){0u, 0u, 0u, 0u};
            if (m > 0) pv = *(const u32x4*)(USH + (size_t)(m - 1) * SHIFT_W + ch * 8);
            const f32x4 mu0 = *(const f32x4*)(mu + ch * 8), mu1 = *(const f32x4*)(mu + ch * 8 + 4);
            float x[8];
            { float uu, pp;
              uu = bf_lo(u.x); pp = bf_lo(pv.x); x[0] = uu + (pp - uu) * mu0.x;  uu = bf_hi(u.x); pp = bf_hi(pv.x); x[1] = uu + (pp - uu) * mu0.y;
              uu = bf_lo(u.y); pp = bf_lo(pv.y); x[2] = uu + (pp - uu) * mu0.z;  uu = bf_hi(u.y); pp = bf_hi(pv.y); x[3] = uu + (pp - uu) * mu0.w;
              uu = bf_lo(u.z); pp = bf_lo(pv.z); x[4] = uu + (pp - uu) * mu1.x;  uu = bf_hi(u.z); pp = bf_hi(pv.z); x[5] = uu + (pp - uu) * mu1.y;
              uu = bf_lo(u.w); pp = bf_lo(pv.w); x[6] = uu + (pp - uu) * mu1.z;  uu = bf_hi(u.w); pp = bf_hi(pv.w); x[7] = uu + (pp - uu) * mu1.w; }
            if (ch >= 144 && ch < 152) {
#pragma unroll
                for (int q = 0; q < 8; ++q) { const float e = fast_exp(-2.f * fabsf(x[q])); const float th = (1.f - e) / (1.f + e); x[q] = x[q] < 0.f ? -th : th; }
            }
            LAS f32x4* d = (LAS f32x4*)(xs + tok * SHIFT_W + ch * 8);
            d[0] = (f32x4){x[0], x[1], x[2], x[3]}; d[1] = (f32x4){x[4], x[5], x[6], x[7]};
        }
        __syncthreads();
        if (wave < 6) {
            LAS float* wlb = xs + 16 * SHIFT_W;
            LAS float* alb = wlb + 16 * RW_W;
            {
                const float* wp = WU; asm volatile("" : "+v"(wp) :: "memory");
                float wv[64];
#pragma unroll
                for (int i = 0; i < 64; ++i) wv[i] = wp[i * RW_W];
#pragma unroll 1
                for (int tok = 0; tok < nt; ++tok) { const LAS float* xr = xs + tok * SHIFT_W + 1152; float acc = w0j;
#pragma unroll
                    for (int i = 0; i < 64; i += 4) { const f32x4 t4 = *(const LAS f32x4*)(xr + i); acc += t4.x * wv[i] + t4.y * wv[i + 1] + t4.z * wv[i + 2] + t4.w * wv[i + 3]; }
                    wlb[tok * RW_W + jch] = acc; }
            }
            {
                const float* wp = AU; asm volatile("" : "+v"(wp) :: "memory");
                float wv[64];
#pragma unroll
                for (int i = 0; i < 64; ++i) wv[i] = wp[i * RW_W];
#pragma unroll 1
                for (int tok = 0; tok < nt; ++tok) { const LAS float* xr = xs + tok * SHIFT_W + 1216; float acc = a0j;
#pragma unroll
                    for (int i = 0; i < 64; i += 4) { const f32x4 t4 = *(const LAS f32x4*)(xr + i); acc += t4.x * wv[i] + t4.y * wv[i + 1] + t4.z * wv[i + 2] + t4.w * wv[i + 3]; }
                    alb[tok * RW_W + jch] = acc; }
            }
            asm volatile("" ::: "memory");
#pragma unroll 1
            for (int tok = 0; tok < nt; ++tok) {
                const int m = m0 + t0 + tok, b = m / T, p = m - b * T, l = p - PADR;
                if (l < 0) continue;
                const LAS float* xr = xs + tok * SHIFT_W;
                const float r = xr[jch], k = xr[384 + jch], v = xr[768 + jch];
                const float logw = -softplus_f(-wlb[tok * RW_W + jch]) - 0.5f;
                const float xw = fast_exp(logw);
                const float om = xw < 0.02f ? xw * (1.f - 0.5f * xw + xw * xw * (1.f / 6.f)) : 1.f - fast_exp(-xw);
                const float av = 1.f / (1.f + fast_exp(-alb[tok * RW_W + jch]));
                const float kkr = k * kkj;
                const float nrm = sqrtf(wave_sum(kkr * kkr));
                const float kk = kkr / fmaxf(nrm, 1e-12f);
                const float kp = k * (1.f + (av - 1.f) * kaj);
                const float bb = kk * av;
                const float coef = wave_sum(r * kp * rkj);
                _Float16* o = RW + ((size_t)(b * RW_H + wave) * LPADDED + l) * 384 + lane;
                o[0] = (_Float16)kk; o[64] = (_Float16)(-om); o[128] = (_Float16)(-bb); o[192] = (_Float16)kp; o[256] = (_Float16)r; o[320] = (_Float16)v;
                BN[(size_t)m * RW_W + jch] = f2bf(coef * v);
            }
        } else {
            for (int it = wave - 6; it < nt * 10; it += 2) {
                const int tok = it / 10, hq = it - tok * 10, which = hq / 5, head = hq - which * 5;
                const int m = m0 + t0 + tok, b = m / T, p = m - b * T;
                if (p < PADR) continue;
                bf16_t* q = QKV + (size_t)m * QKV_W + 960 + which * 320 + head * 64 + lane;
                const float x = bf2f(*q);
                const float ss = wave_sum(x * x);
                const float y = x * (1.0f / sqrtf(ss * (1.0f / 64.f) + 1e-6f)) * (which == 0 ? gq : gk);
                *q = f2bf(y);
            }
        }
        __syncthreads();
    }
}

template <int CTRL> __device__ __forceinline__ float dpp_f(float x) { return __int_as_float(__builtin_amdgcn_update_dpp(0, __float_as_int(x), CTRL, 0xF, 0xF, false)); }
__device__ __forceinline__ float allred16(float p) { p += dpp_f<0x128>(p); p += dpp_f<0x124>(p); p += dpp_f<0x122>(p); p += dpp_f<0x121>(p); return p; }

constexpr int SCH = 16;
static_assert(LTOK % SCH == 0, "whole chunks");
__device__ __forceinline__ void rwkv_scan(const ArgsL& a, Frame& F, int wgi, int dry = 0) {
    const int bh = wgi >> 3, q8 = wgi & 7, b = bh / RW_H, h = bh % RW_H;
    const int tid = F.tid, wave = F.wave, lane = F.lane;
    const unsigned char* rw = a.ws + WS_RW + (size_t)bh * LPADDED * 768;
    LAS float* ring = (LAS float*)F.lds;
    LAS float* ypart = (LAS float*)(F.lds + 49152);
    LAS unsigned char* stg = F.lds + 81920;
    bf16_t* y0 = (bf16_t*)(a.ws + WS_YCAT);
    constexpr int NCH = LTOK / SCH;
    const int tl = tid - 256, lw = wave - 4;
    float s0 = 0.f, s1 = 0.f;
    const int i32 = lane & 31, rsel = lane >> 5, rloc = 2 * wave + rsel;
#define RW_BAR() asm volatile("s_waitcnt lgkmcnt(0)\n\ts_barrier" ::: "memory")
#define RW_ISSUE(cc) do { const unsigned char* src_ = rw + (size_t)(cc) * SCH * 768 + (size_t)tl * 16; LAS unsigned char* d_ = stg + ((cc) & 3) * 12288 + lw * 1024; \
        _Pragma("unroll") for (int k_ = 0; k_ < 3; ++k_) __builtin_amdgcn_global_load_lds((const unsigned*)(src_ + k_ * 4096), (LAS unsigned*)(d_ + k_ * 4096), 16, 0, 0); } while (0)
#define RW_CONVERT(cc) do { const LAS unsigned char* s_ = stg + ((cc) & 3) * 12288 + tl * 16; LAS float* dst_ = ring + ((cc) & 1) * 6144 + tl * 8; \
        _Pragma("unroll") for (int k_ = 0; k_ < 3; ++k_) { const u32x4 t_ = *(const LAS u32x4*)(s_ + k_ * 4096); LAS f32x4* d_ = (LAS f32x4*)(dst_ + k_ * 2048); \
            const f16x4 lo_ = __builtin_bit_cast(f16x4, (u32x2){t_.x, t_.y}), hi_ = __builtin_bit_cast(f16x4, (u32x2){t_.z, t_.w}); \
            d_[0] = (f32x4){(float)lo_.x, (float)lo_.y, (float)lo_.z, (float)lo_.w}; d_[1] = (f32x4){(float)hi_.x, (float)hi_.y, (float)hi_.z, (float)hi_.w}; } } while (0)
#define RW_STORE_Y(cc) do { if (tl < 64) { const LAS float* yb_ = ypart + ((cc) & 1) * 4096; const int t_ = tl >> 2, pr_ = tl & 3; const int l_ = (cc) * SCH + t_; \
        const LAS f32x4* q_ = (const LAS f32x4*)(yb_ + t_ * 256 + pr_ * 64); f32x4 sa_ = q_[0], sb_ = q_[8]; \
        _Pragma("unroll") for (int k_ = 1; k_ < 8; ++k_) { sa_ = sa_ + q_[k_]; sb_ = sb_ + q_[8 + k_]; } \
        *(unsigned*)(y0 + (size_t)(b * T + PADR + l_) * RW_W + h * 64 + q8 * 8 + 2 * pr_) = pk2((sa_.x + sa_.y) + (sa_.z + sa_.w), (sb_.x + sb_.y) + (sb_.z + sb_.w)); } } while (0)
    if (wave >= 4) {
        RW_ISSUE(0); asm volatile("s_waitcnt vmcnt(0)" ::: "memory"); RW_CONVERT(0);
        RW_ISSUE(1); RW_ISSUE(2);
    }
    RW_BAR();
    for (int c = 0; c < NCH; ++c) {
        if (wave >= 4) {
            if (c + 2 < NCH) { asm volatile("s_waitcnt vmcnt(3)" ::: "memory"); RW_CONVERT(c + 1); }
            else if (c + 1 < NCH) { asm volatile("s_waitcnt vmcnt(0)" ::: "memory"); RW_CONVERT(c + 1); }
            if (c > 0 && !dry) RW_STORE_Y(c - 1);
            if (c + 3 < NCH) RW_ISSUE(c + 3);
        } else if (!dry) {
            const LAS float* base = ring + (c & 1) * 6144 + i32 * 2;
            const LAS float* vb = ring + (c & 1) * 6144 + 320 + q8 * 8 + rloc;
            LAS float* yp = ypart + (c & 1) * 4096 + rloc * 32 + i32;
            f32x2 KK[3], OM[3], BB[3], KV[3], RR[3]; float VF[3];
            const unsigned ba = (unsigned)(uintptr_t)base, va = (unsigned)(uintptr_t)vb, ya = (unsigned)(uintptr_t)yp;
#define RW_FETCH(tt, sl) asm volatile("ds_read_b64 %0, %6 offset:%c8\n\tds_read_b64 %1, %6 offset:%c9\n\tds_read_b64 %2, %6 offset:%c10\n\tds_read_b64 %3, %6 offset:%c11\n\tds_read_b64 %4, %6 offset:%c12\n\tds_read_b32 %5, %7 offset:%c8" \
                : "=&v"(KK[sl]), "=&v"(OM[sl]), "=&v"(BB[sl]), "=&v"(KV[sl]), "=&v"(RR[sl]), "=&v"(VF[sl]) : "v"(ba), "v"(va), "i"((tt) * 1536), "i"((tt) * 1536 + 256), "i"((tt) * 1536 + 512), "i"((tt) * 1536 + 768), "i"((tt) * 1536 + 1024) : "memory")
#define RW_WAIT(n, sl) asm volatile("s_waitcnt lgkmcnt(%c6)" : "+v"(KK[sl]), "+v"(OM[sl]), "+v"(BB[sl]), "+v"(KV[sl]), "+v"(RR[sl]), "+v"(VF[sl]) : "i"(n) : "memory")
            RW_FETCH(0, 0); RW_FETCH(1, 1);
#pragma unroll
            for (int t = 0; t < SCH; ++t) {
                constexpr int dummy = 0; (void)dummy;
                const int sl = t % 3;
                if (t + 2 < SCH) RW_FETCH(t + 2, (t + 2) % 3);
                if (t == 0) RW_WAIT(12, sl); else if (t == 1) RW_WAIT(13, sl); else if (t <= 13) RW_WAIT(14, sl); else if (t == 14) RW_WAIT(8, sl); else RW_WAIT(2, sl);
                const f32x2 kk = KK[sl], om = OM[sl], bb = BB[sl], kv = KV[sl], rr = RR[sl]; const float vf = VF[sl];
                float p = s0 * kk.x; p = __builtin_fmaf(s1, kk.y, p);
                p = allred16(p);
                { auto sw = __builtin_amdgcn_permlane16_swap(__float_as_uint(p), __float_as_uint(p), false, false); p = __uint_as_float(sw[0]) + __uint_as_float(sw[1]); }
                s0 = __builtin_fmaf(s0, om.x, s0); asm("" : "+v"(s0), "+v"(s1)); s1 = __builtin_fmaf(s1, om.y, s1);
                s0 = __builtin_fmaf(p, bb.x, s0);  asm("" : "+v"(s0), "+v"(s1)); s1 = __builtin_fmaf(p, bb.y, s1);
                s0 = __builtin_fmaf(vf, kv.x, s0); asm("" : "+v"(s0), "+v"(s1)); s1 = __builtin_fmaf(vf, kv.y, s1);
                float y = s0 * rr.x; y = __builtin_fmaf(s1, rr.y, y);
                asm volatile("ds_write_b32 %0, %1 offset:%c2" :: "v"(ya), "v"(y), "i"(t * 1024) : "memory");
            }
#undef RW_FETCH
#undef RW_WAIT
        }
        RW_BAR();
    }
    if (wave >= 4 && !dry) RW_STORE_Y(NCH - 1);
    asm volatile("s_waitcnt vmcnt(0) lgkmcnt(0)\n\ts_barrier" ::: "memory");
#undef RW_STORE_Y
#undef RW_ISSUE
#undef RW_CONVERT
#undef RW_BAR
}

__device__ __forceinline__ int crow(int r, int hi) { return (r & 3) + 8 * (r >> 2) + 4 * hi; }
__device__ __forceinline__ void glds16(const void* gsrc, unsigned lds_dst) { unsigned keep;
    asm volatile("s_mov_b32 %0, m0\n\ts_mov_b32 m0, %2\n\ts_nop 0\n\tglobal_load_lds_dwordx4 %1, off\n\ts_mov_b32 m0, %0" : "=&s"(keep) : "v"(gsrc), "s"(lds_dst) : "memory"); }
typedef LAS const char* lds_cptr;
constexpr int FX_K = 0, FX_V = 16384, FX_WS = 32768, FX_OST = 34816, FX_FLG = 67584;

__device__ __forceinline__ void fx_pv(f32x16* o, int vb, bf16x8 pa0, bf16x8 pa1, bf16x8 pa2, bf16x8 pa3) {
#pragma unroll
    for (int d0 = 0; d0 < 2; ++d0) { s16x4 lo[4], hi[4];
#pragma unroll
        for (int ks = 0; ks < 4; ++ks) {
            asm volatile("ds_read_b64_tr_b16 %0,%1 offset:%c2" : "=&v"(lo[ks]) : "v"(vb), "i"(d0 * 4096 + ks * 1024) : "memory");
            asm volatile("ds_read_b64_tr_b16 %0,%1 offset:%c2" : "=&v"(hi[ks]) : "v"(vb), "i"(d0 * 4096 + ks * 1024 + 512) : "memory"); }
        asm volatile("s_waitcnt lgkmcnt(0)" ::: "memory"); __builtin_amdgcn_sched_barrier(0);
#define FX_PK(k) (bf16x8){lo[k][0], lo[k][1], lo[k][2], lo[k][3], hi[k][0], hi[k][1], hi[k][2], hi[k][3]}
        o[d0] = __builtin_amdgcn_mfma_f32_32x32x16_bf16(pa0, FX_PK(0), o[d0], 0, 0, 0);
        o[d0] = __builtin_amdgcn_mfma_f32_32x32x16_bf16(pa1, FX_PK(1), o[d0], 0, 0, 0);
        o[d0] = __builtin_amdgcn_mfma_f32_32x32x16_bf16(pa2, FX_PK(2), o[d0], 0, 0, 0);
        o[d0] = __builtin_amdgcn_mfma_f32_32x32x16_bf16(pa3, FX_PK(3), o[d0], 0, 0, 0);
#undef FX_PK
    }
}
__device__ __forceinline__ float halves_max(float m) { auto rr = __builtin_amdgcn_permlane32_swap(__float_as_uint(m), __float_as_uint(m), false, false); return fmaxf(__uint_as_float(rr[0]), __uint_as_float(rr[1])); }
__device__ __forceinline__ float halves_sum(float m) { auto rr = __builtin_amdgcn_permlane32_swap(__float_as_uint(m), __float_as_uint(m), false, false); return __uint_as_float(rr[0]) + __uint_as_float(rr[1]); }

template <int KIND>
__device__ __forceinline__ void attn_unit(const ArgsL& a, Frame& F, int b, int h, int qb, float bound) {
    const int lane = F.lane, wave = F.wave, r32 = lane & 31, hi = lane >> 5;
    LAS unsigned char* lds = F.lds;
    const bf16_t* QKV = (const bf16_t*)(a.ws + WS_QKV);
    const size_t rowbase = (size_t)b * T;
    const int p0 = qb * 256;
    constexpr int QC = KIND ? 0 : 960, KC = KIND ? 320 : 1280, VC = KIND ? 640 : 1600;
    const bf16_t* Qw = QKV + (rowbase + p0 + wave * 32) * QKV_W + QC + h * 64;
    const bf16_t* Kh = QKV + rowbase * QKV_W + KC + h * 64;
    const bf16_t* Vh = QKV + rowbase * QKV_W + VC + h * 64;
    const float* kbias = (const float*)(a.ws + WS_KB2) + (size_t)(b * FX_H + h) * KBP;
    const unsigned lds0 = (unsigned)(uintptr_t)lds;
    bf16x8 qr[4];
#pragma unroll
    for (int d0 = 0; d0 < 4; ++d0) qr[d0] = *(const bf16x8*)(Qw + (size_t)r32 * QKV_W + d0 * 16 + hi * 8);
    const int qp = p0 + wave * 32 + r32;
    const bool qvalid = (qp >= PADR) && (qp < T);
    const int plast = (p0 + 255) < (T - 1) ? (p0 + 255) : (T - 1);
    const int jlast = plast >> 6, jfirst = PADR >> 6;
    const int jw = (p0 + wave * 32 + 31) >> 6;
    const bf16_t* ksrc = Kh + (size_t)lane * QKV_W + wave * 8;
    const bf16_t* vsrc = Vh + (size_t)(16 * (wave & 3) + (lane >> 2)) * QKV_W + (wave >> 2) * 32 + (lane & 3) * 8;
    const unsigned kdst = lds0 + FX_K + wave * 1024, vdst = lds0 + FX_V + wave * 1024;
#define FX_DMA(j, slot) do { glds16(ksrc + (size_t)(j) * 64 * QKV_W, (unsigned)__builtin_amdgcn_readfirstlane(kdst + (slot) * 8192)); \
                             glds16(vsrc + (size_t)(j) * 64 * QKV_W, (unsigned)__builtin_amdgcn_readfirstlane(vdst + (slot) * 8192)); } while (0)
    const int vb0 = (int)(lds0 + FX_V) + ((lane >> 4) & 1) * 32 + (lane & 3) * 8 + (4 * hi + ((lane & 15) >> 2)) * 64;
    const lds_cptr kp0 = (lds_cptr)lds + FX_K + hi * 1024 + r32 * 16;
    LAS float* wsf = (LAS float*)(lds + FX_WS) + wave * 64;
    LAS float* flg = (LAS float*)(lds + FX_FLG);
    float m_run = KIND ? 0.f : -1.0e30f, l_run = 0.f;
    f32x16 o[2]; o[0] = f32x16{}; o[1] = f32x16{};
    int slot = 0; bool stop = false;
    FX_DMA(jlast, 0);
    for (int j = jlast; j >= jfirst; --j) {
        if (stop) break;
        if (j > jfirst) { FX_DMA(j - 1, slot ^ 1); asm volatile("s_waitcnt vmcnt(2) lgkmcnt(0)\n\ts_barrier" ::: "memory"); }
        else asm volatile("s_waitcnt vmcnt(0) lgkmcnt(0)\n\ts_barrier" ::: "memory");
        if (j <= jw) {
            f32x16 s0v = f32x16{}, s1v = f32x16{};
            const lds_cptr kp = kp0 + slot * 8192;
#pragma unroll
            for (int d0 = 0; d0 < 4; ++d0) {
                const bf16x8 b0 = *(const LAS bf16x8*)(kp + d0 * 2048);
                const bf16x8 b1 = *(const LAS bf16x8*)(kp + d0 * 2048 + 512);
                s0v = __builtin_amdgcn_mfma_f32_32x32x16_bf16(b0, qr[d0], s0v, 0, 0, 0);
                s1v = __builtin_amdgcn_mfma_f32_32x32x16_bf16(b1, qr[d0], s1v, 0, 0, 0);
            }
            const bool edge = (64 * j + 63 >= p0 + wave * 32) || (64 * j < PADR);
            if constexpr (KIND == 0) {
                const float* kbj = kbias + 64 * j + 4 * hi;
#pragma unroll
                for (int g = 0; g < 4; ++g) { const f32x4 t0 = *(const f32x4*)(kbj + 8 * g), t1 = *(const f32x4*)(kbj + 32 + 8 * g);
                    s0v[4 * g] += t0.x; s0v[4 * g + 1] += t0.y; s0v[4 * g + 2] += t0.z; s0v[4 * g + 3] += t0.w;
                    s1v[4 * g] += t1.x; s1v[4 * g + 1] += t1.y; s1v[4 * g + 2] += t1.z; s1v[4 * g + 3] += t1.w; }
                if (edge) {
#pragma unroll
                    for (int r = 0; r < 16; ++r) { const int key = 64 * j + crow(r, hi);
                        if (key > qp || key < PADR) s0v[r] = -INFINITY;
                        if (key + 32 > qp || key + 32 < PADR) s1v[r] = -INFINITY; }
                }
                float rm = fmaxf(s0v[0], s1v[0]);
#pragma unroll
                for (int r = 1; r < 16; ++r) rm = fmaxf(rm, fmaxf(s0v[r], s1v[r]));
                rm = halves_max(rm);
                const float m_new = fmaxf(m_run, rm);
                const float f = __builtin_amdgcn_exp2f(m_run - m_new);
                m_run = m_new;
                float rs = 0.f;
#pragma unroll
                for (int r = 0; r < 16; ++r) { s0v[r] = __builtin_amdgcn_exp2f(s0v[r] - m_new); s1v[r] = __builtin_amdgcn_exp2f(s1v[r] - m_new); rs += s0v[r] + s1v[r]; }
                rs = halves_sum(rs);
                l_run = l_run * f + rs;
                if (!__all(f == 1.0f)) {
                    if (hi == 0) wsf[r32] = f;
                    LDS_WAIT();
#pragma unroll
                    for (int d_ = 0; d_ < 2; ++d_)
#pragma unroll
                        for (int r = 0; r < 16; ++r) o[d_][r] *= wsf[crow(r, hi)];
                }
            } else {
                f32x16 l0, l1;
#pragma unroll
                for (int r = 0; r < 16; ++r) {
                    const float z0 = s0v[r], z1 = s1v[r];
                    float a0 = -(fmaxf(z0, 0.f) + __builtin_amdgcn_logf(1.f + __builtin_amdgcn_exp2f(-fabsf(z0))));
                    float a1 = -(fmaxf(z1, 0.f) + __builtin_amdgcn_logf(1.f + __builtin_amdgcn_exp2f(-fabsf(z1))));
                    if (edge) { const int key = 64 * j + crow(r, hi);
                        if (key >= qp || key < PADR) { a0 = 0.f; s0v[r] = -INFINITY; }
                        if (key + 32 >= qp || key + 32 < PADR) { a1 = 0.f; s1v[r] = -INFINITY; } }
                    l0[r] = a0; l1[r] = a1;
                }
                float A[8], SA[9], SO[9];
#pragma unroll
                for (int g = 0; g < 4; ++g) { A[g] = (l0[4 * g] + l0[4 * g + 1]) + (l0[4 * g + 2] + l0[4 * g + 3]); A[4 + g] = (l1[4 * g] + l1[4 * g + 1]) + (l1[4 * g + 2] + l1[4 * g + 3]); }
                SA[8] = 0.f; SO[8] = 0.f;
#pragma unroll
                for (int g = 7; g >= 0; --g) SA[g] = A[g] + SA[g + 1];
#pragma unroll
                for (int g = 0; g < 8; ++g) { auto rr = __builtin_amdgcn_permlane32_swap(__float_as_uint(SA[g]), __float_as_uint(SA[g]), false, false); SO[g] = __uint_as_float(hi ? rr[0] : rr[1]); }
                const float R = m_run;
#pragma unroll
                for (int g = 0; g < 8; ++g) {
                    const float E = SA[g + 1] + (hi ? SO[g + 1] : SO[g]) + R;
                    if (g < 4) { float t = E;
                        s0v[4 * g + 3] = __builtin_amdgcn_exp2f(s0v[4 * g + 3] + l0[4 * g + 3] + t); t += l0[4 * g + 3];
                        s0v[4 * g + 2] = __builtin_amdgcn_exp2f(s0v[4 * g + 2] + l0[4 * g + 2] + t); t += l0[4 * g + 2];
                        s0v[4 * g + 1] = __builtin_amdgcn_exp2f(s0v[4 * g + 1] + l0[4 * g + 1] + t); t += l0[4 * g + 1];
                        s0v[4 * g + 0] = __builtin_amdgcn_exp2f(s0v[4 * g + 0] + l0[4 * g + 0] + t);
                    } else { const int q = g - 4; float t = E;
                        s1v[4 * q + 3] = __builtin_amdgcn_exp2f(s1v[4 * q + 3] + l1[4 * q + 3] + t); t += l1[4 * q + 3];
                        s1v[4 * q + 2] = __builtin_amdgcn_exp2f(s1v[4 * q + 2] + l1[4 * q + 2] + t); t += l1[4 * q + 2];
                        s1v[4 * q + 1] = __builtin_amdgcn_exp2f(s1v[4 * q + 1] + l1[4 * q + 1] + t); t += l1[4 * q + 1];
                        s1v[4 * q + 0] = __builtin_amdgcn_exp2f(s1v[4 * q + 0] + l1[4 * q + 0] + t);
                    }
                }
                m_run = R + SA[0] + SO[0];
            }
            u32x4 pw0, pw1, pw2, pw3;
            pw0 = (u32x4){pk2(s0v[0], s0v[1]), pk2(s0v[2], s0v[3]), pk2(s0v[4], s0v[5]), pk2(s0v[6], s0v[7])};
            pw1 = (u32x4){pk2(s0v[8], s0v[9]), pk2(s0v[10], s0v[11]), pk2(s0v[12], s0v[13]), pk2(s0v[14], s0v[15])};
            pw2 = (u32x4){pk2(s1v[0], s1v[1]), pk2(s1v[2], s1v[3]), pk2(s1v[4], s1v[5]), pk2(s1v[6], s1v[7])};
            pw3 = (u32x4){pk2(s1v[8], s1v[9]), pk2(s1v[10], s1v[11]), pk2(s1v[12], s1v[13]), pk2(s1v[14], s1v[15])};
            fx_pv(o, vb0 + slot * 8192, __builtin_bit_cast(bf16x8, pw0), __builtin_bit_cast(bf16x8, pw1), __builtin_bit_cast(bf16x8, pw2), __builtin_bit_cast(bf16x8, pw3));
        }
        float mm = qvalid ? m_run : (KIND ? -3.0e38f : 3.0e38f);
#pragma unroll
        for (int off = 1; off < 64; off <<= 1) { const float t = __shfl_xor(mm, off); mm = KIND ? fmaxf(mm, t) : fminf(mm, t); }
        if (lane == 0) flg[(j & 1) * 8 + wave] = mm;
        asm volatile("s_waitcnt lgkmcnt(0)\n\ts_barrier" ::: "memory");
        if (j > jfirst) {
            const f32x4 fa = *(const LAS f32x4*)(flg + (j & 1) * 8), fb = *(const LAS f32x4*)(flg + (j & 1) * 8 + 4);
            if constexpr (KIND == 0) {
                const float mmin = fminf(fminf(fminf(fa.x, fa.y), fminf(fa.z, fa.w)), fminf(fminf(fb.x, fb.y), fminf(fb.z, fb.w)));
                const float kbmax = kbias[64 * (j - 1) + 63];
                stop = (bound + kbmax - mmin) < -150.0f;
            } else {
                const float mmax = fmaxf(fmaxf(fmaxf(fa.x, fa.y), fmaxf(fa.z, fa.w)), fmaxf(fmaxf(fb.x, fb.y), fmaxf(fb.z, fb.w)));
                stop = mmax < -150.0f;
            }
        }
        slot ^= 1;
    }
    asm volatile("s_waitcnt vmcnt(0) lgkmcnt(0)\n\ts_barrier" ::: "memory");
    float rli[16];
    if constexpr (KIND == 0) {
        if (hi == 0) wsf[32 + r32] = l_run;
        LDS_WAIT();
#pragma unroll
        for (int r = 0; r < 16; ++r) rli[r] = __builtin_amdgcn_rcpf(wsf[32 + crow(r, hi)]);
    } else {
#pragma unroll
        for (int r = 0; r < 16; ++r) rli[r] = 1.0f;
    }
    bf16_t* Ow = (bf16_t*)(a.ws + WS_YCAT) + (size_t)(KIND ? 1 : 2) * M * RW_W + (rowbase + p0 + wave * 32) * RW_W + h * 64;
    {
        LAS bf16_t* stg = (LAS bf16_t*)(lds + FX_OST) + wave * 2048;
#pragma unroll
        for (int r = 0; r < 16; ++r) { const int orow = crow(r, hi);
#pragma unroll
            for (int d0 = 0; d0 < 2; ++d0) stg[orow * 64 + d0 * 32 + r32] = f2bf(o[d0][r] * rli[r]); }
        LDS_WAIT();
#pragma unroll
        for (int i = 0; i < 4; ++i) { const int row = i * 8 + (lane >> 3), ch = lane & 7; const u32x4 v = *(const LAS u32x4*)(stg + row * 64 + ch * 8);
            const int pr = p0 + wave * 32 + row;
            if (pr >= PADR && pr < T) *(u32x4*)(Ow + (size_t)row * RW_W + ch * 8) = v; }
    }
    asm volatile("s_waitcnt lgkmcnt(0)\n\ts_barrier" ::: "memory");
#undef FX_DMA
}

constexpr int N_FX_UNITS = 65 * 10, N_SB_UNITS = 65 * 10, N_RW_WG = 96;
#ifndef REP_SCAN
#define REP_SCAN 1
#endif
#ifndef REP_SCAN_DRY
#define REP_SCAN_DRY 0
#endif
#ifndef REP_FOX
#define REP_FOX 1
#endif
#ifndef REP_SB
#define REP_SB 1
#endif
__device__ __forceinline__ void phase_mix(const ArgsL& a, Frame& F, int layer) {
    if (blockIdx.x < N_RW_WG) { int nr = REP_SCAN; asm volatile("" : "+s"(nr)); for (int r = 0; r < nr; ++r) rwkv_scan(a, F, blockIdx.x, (r + 1 < nr) ? REP_SCAN_DRY : 0); }
    float gqm = fabsf(a.in(I_QG)[layer * 64 + F.lane]), gkm = fabsf(a.in(I_KG)[layer * 64 + F.lane]);
#pragma unroll
    for (int off = 1; off < 64; off <<= 1) { gqm = fmaxf(gqm, __shfl_xor(gqm, off)); gkm = fmaxf(gkm, __shfl_xor(gkm, off)); }
    const float bound = 64.0f * C2 * gqm * gkm * 1.02f + 0.5f;
    unsigned* head = (unsigned*)(a.ws + WS_CTL) + CW_QUEUE + 64 * layer;
    for (;;) {
        if (F.tid == 0) F.MISC[16] = __hip_atomic_fetch_add(head, 1u, __ATOMIC_RELAXED, __HIP_MEMORY_SCOPE_AGENT);
        __syncthreads();
        const int u = (int)F.MISC[16];
        __syncthreads();
        if (u >= N_FX_UNITS + N_SB_UNITS) break;
        if (u < N_FX_UNITS) { const int qb = 64 - u / 10, bh = u % 10; int nr = REP_FOX; asm volatile("" : "+s"(nr)); for (int r = 0; r < nr; ++r) attn_unit<0>(a, F, bh / FX_H, bh % FX_H, qb, bound); }
        else { const int v = u - N_FX_UNITS; const int qb = 64 - v / 10, bh = v % 10; int nr = REP_SB; asm volatile("" : "+s"(nr)); for (int r = 0; r < nr; ++r) attn_unit<1>(a, F, bh / SB_H, bh % SB_H, qb, bound); }
    }
}

__device__ __forceinline__ void phase_post(const ArgsL& a, Frame& F, int layer) {
    const int gw = blockIdx.x * NWAVES + F.wave, NGW = gridDim.x * NWAVES, lane = F.lane;
    bf16_t* Y0 = (bf16_t*)(a.ws + WS_YCAT); const bf16_t* BN = (const bf16_t*)(a.ws + WS_BN);
    for (int it = gw; it < M * RW_H; it += NGW) {
        const int m = it / RW_H, hh = it - m * RW_H;
        const int b = m / T, p = m - b * T;
        bf16_t* yp = Y0 + (size_t)m * RW_W + hh * 64 + lane;
        if (p < PADR) { *yp = 0; continue; }
        const float y = bf2f(*yp);
        const float mean = wave_sum(y) * (1.f / 64.f);
        const float d = y - mean;
        const float var = wave_sum(d * d) * (1.f / 64.f);
        const float o = d * (1.0f / sqrtf(var + 64e-5f)) * a.in(I_LNG)[layer * RW_W + hh * 64 + lane] + a.in(I_LNB)[layer * RW_W + hh * 64 + lane] + bf2f(BN[(size_t)m * RW_W + hh * 64 + lane]);
        *yp = f2bf(o);
    }
    for (int it = gw; it < 2 * M; it += NGW) {
        const int sl = it / M, m = it - sl * M; const int b = m / T, p = m - b * T;
        bf16_t* row = Y0 + (size_t)(sl + 1) * M * RW_W + (size_t)m * RW_W;
        if (p < PADR) { for (int c = lane; c < RW_W / 2; c += 64) ((unsigned*)row)[c] = 0u; }
        else if (lane < 32) ((unsigned*)(row + 320))[lane] = 0u;
    }
}

struct EpiInproj { static constexpr bool PERM = true, AFTER_DRAIN = false; bf16_t* ush; bf16_t* qkv;
    __device__ __forceinline__ void operator()(const f32x4 (&acc)[2][2][4][2], const pg8::Unit& u, int wr, int wc, int fr, int fq) const {
        asm volatile("" : "+v"(fr), "+v"(fq));
        const int row0 = u.pm * 256 + wr * 64 + fr, colt = u.pn * 256 + wc * 32 + 8 * fq;
#pragma unroll
        for (int ai = 0; ai < 2; ++ai)
#pragma unroll
            for (int m = 0; m < 4; ++m) { const size_t row = (size_t)(row0 + ai * 128 + m * 16);
#pragma unroll
                for (int bj = 0; bj < 2; ++bj) { const int col = colt + bj * 128; const f32x4 v0 = acc[ai][bj][m][0], v1 = acc[ai][bj][m][1];
                    const float sc = (col >= SHIFT_W && col < SHIFT_W + 320) ? C2 : 1.0f;
                    u32x4 w; w.x = pk2(v0[0] * sc, v0[1] * sc); w.y = pk2(v0[2] * sc, v0[3] * sc); w.z = pk2(v1[0] * sc, v1[1] * sc); w.w = pk2(v1[2] * sc, v1[3] * sc);
                    if (col < SHIFT_W) *(u32x4*)(ush + row * SHIFT_W + col) = w;
                    else if (col < SHIFT_W + QKV_W) *(u32x4*)(qkv + row * QKV_W + (col - SHIFT_W)) = w; } }
    }
};
struct EpiGates { static constexpr bool PERM = true, AFTER_DRAIN = false; bf16_t* gates;
    __device__ __forceinline__ void operator()(const f32x4 (&acc)[2][2][4][2], const pg8::Unit& u, int wr, int wc, int fr, int fq) const {
        asm volatile("" : "+v"(fr), "+v"(fq));
        const int row0 = u.pm * 256 + wr * 64 + fr, colt = u.pn * 256 + wc * 32 + 8 * fq;
#pragma unroll
        for (int ai = 0; ai < 2; ++ai)
#pragma unroll
            for (int m = 0; m < 4; ++m) { const size_t row = (size_t)(row0 + ai * 128 + m * 16);
#pragma unroll
                for (int bj = 0; bj < 2; ++bj) { const int col = colt + bj * 128; f32x4 v0 = acc[ai][bj][m][0], v1 = acc[ai][bj][m][1];
#pragma unroll
                    for (int q = 0; q < 4; ++q) { v0[q] = __builtin_amdgcn_rcpf(1.f + __builtin_amdgcn_exp2f(-v0[q] * LOG2E)); v1[q] = __builtin_amdgcn_rcpf(1.f + __builtin_amdgcn_exp2f(-v1[q] * LOG2E)); }
                    u32x4 w; w.x = pk2(v0[0], v0[1]); w.y = pk2(v0[2], v0[3]); w.z = pk2(v1[0], v1[1]); w.w = pk2(v1[2], v1[3]);
                    *(u32x4*)(gates + row * 3072 + col) = w; } }
    }
};
struct EpiMerge { static constexpr bool PERM = true, AFTER_DRAIN = false; const bf16_t* gates; bf16_t* merged;
    __device__ __forceinline__ void operator()(const f32x4 (&acc)[2][2][4][2], const pg8::Unit& u, int wr, int wc, int fr, int fq) const {
        asm volatile("" : "+v"(fr), "+v"(fq));
        const int br = u.pn >> 2, pn = u.pn & 3, pm = u.pm - br * 129;
        const int row0 = pm * 256 + wr * 64 + fr, colt = pn * 256 + wc * 32 + 8 * fq;
#pragma unroll
        for (int ai = 0; ai < 2; ++ai)
#pragma unroll
            for (int m = 0; m < 4; ++m) { const size_t row = (size_t)(row0 + ai * 128 + m * 16);
#pragma unroll
                for (int bj = 0; bj < 2; ++bj) { const int col = colt + bj * 128; const f32x4 v0 = acc[ai][bj][m][0], v1 = acc[ai][bj][m][1];
                    const u32x4 g = *(const u32x4*)(gates + row * 3072 + br * 1024 + col);
                    u32x4* mp = (u32x4*)(merged + row * D + col);
                    u32x4 o = (u32x4){0u, 0u, 0u, 0u};
                    if (br > 0) o = *mp;
                    u32x4 w;
                    w.x = pk2(bf_lo(g.x) * v0[0] + bf_lo(o.x), bf_hi(g.x) * v0[1] + bf_hi(o.x));
                    w.y = pk2(bf_lo(g.y) * v0[2] + bf_lo(o.y), bf_hi(g.y) * v0[3] + bf_hi(o.y));
                    w.z = pk2(bf_lo(g.z) * v1[0] + bf_lo(o.z), bf_hi(g.z) * v1[1] + bf_hi(o.z));
                    w.w = pk2(bf_lo(g.w) * v1[2] + bf_lo(o.w), bf_hi(g.w) * v1[3] + bf_hi(o.w));
                    *mp = w; }
                __builtin_amdgcn_sched_barrier(0); }
    }
};
struct MergeOrder { int G, c, ntau;
    __device__ __forceinline__ bool next(int i, pg8::Unit& u) const { const int it = i / 3, br = i - 3 * it; const long tau = (long)it * G + c; if (tau >= ntau) return false;
        const int t = (int)(tau % 516); u.pm = br * 129 + (t >> 2); u.pn = br * 4 + (t & 3); return true; }
    __device__ __forceinline__ void a_ready(const pg8::Unit&) const {}
    __device__ __forceinline__ void done(const pg8::Unit&) const {}
};
struct EpiOut { static constexpr bool PERM = true, AFTER_DRAIN = false; ArgsL a;
    __device__ __forceinline__ void operator()(const f32x4 (&acc)[2][2][4][2], const pg8::Unit& u, int wr, int wc, int fr, int fq) const {
        asm volatile("" : "+v"(fr), "+v"(fq));
        const int row0 = u.pm * 256 + wr * 64 + fr, colt = u.pn * 256 + wc * 32 + 8 * fq;
#pragma unroll
        for (int ai = 0; ai < 2; ++ai)
#pragma unroll
            for (int m = 0; m < 4; ++m) { const int row = row0 + ai * 128 + m * 16; const int b = row / T, p = row - b * T, l = p - PADR;
                if (l < 0) continue;
                float* hp = hrow(a, b, l);
#pragma unroll
                for (int bj = 0; bj < 2; ++bj) { const int col = colt + bj * 128; f32x4* h4 = (f32x4*)(hp + col);
                    h4[0] = h4[0] + acc[ai][bj][m][0]; h4[1] = h4[1] + acc[ai][bj][m][1]; } }
    }
};
struct MoeOrder { const volatile LAS int* tb; int ntile, npt, G, c, rep;
    __device__ __forceinline__ bool next(int i, pg8::Unit& u) const { long L = (long)i * G + c; if (L >= (long)ntile * npt * rep) return false; L %= (long)ntile * npt;
        const int tau = (int)(L / npt), j = (int)(L - (long)tau * npt); int e = 0;
#pragma unroll
        for (int k = 1; k < 16; ++k) e += (tau >= tb[k]) ? 1 : 0;
        u.pm = tau; u.pn = __builtin_amdgcn_readfirstlane(e) * npt + j; return true; }
    __device__ __forceinline__ void a_ready(const pg8::Unit&) const {}
    __device__ __forceinline__ void done(const pg8::Unit&) const {}
};
struct EpiMoeUp { static constexpr bool PERM = true, AFTER_DRAIN = false; bf16_t* hs;
    __device__ __forceinline__ void operator()(const f32x4 (&acc)[2][2][4][2], const pg8::Unit& u, int wr, int wc, int fr, int fq) const {
        asm volatile("" : "+v"(fr), "+v"(fq));
        const int row0 = u.pm * 256 + wr * 64 + fr, col = (u.pn & 1) * 128 + wc * 32 + 8 * fq;
#pragma unroll
        for (int ai = 0; ai < 2; ++ai)
#pragma unroll
            for (int m = 0; m < 4; ++m) { const size_t row = (size_t)(row0 + ai * 128 + m * 16); float r[8];
#pragma unroll
                for (int n = 0; n < 2; ++n)
#pragma unroll
                    for (int q = 0; q < 4; ++q) { const float gte = acc[ai][0][m][n][q], up = acc[ai][1][m][n][q]; r[4 * n + q] = gte * __builtin_amdgcn_rcpf(1.f + __builtin_amdgcn_exp2f(-gte * LOG2E)) * up; }
                u32x4 w; w.x = pk2(r[0], r[1]); w.y = pk2(r[2], r[3]); w.z = pk2(r[4], r[5]); w.w = pk2(r[6], r[7]);
                *(u32x4*)(hs + row * DEXP + col) = w; }
    }
};
struct EpiMoeDown { static constexpr bool PERM = true, AFTER_DRAIN = false; bf16_t* y; const float* cws;
    __device__ __forceinline__ void operator()(const f32x4 (&acc)[2][2][4][2], const pg8::Unit& u, int wr, int wc, int fr, int fq) const {
        asm volatile("" : "+v"(fr), "+v"(fq));
        const int row0 = u.pm * 256 + wr * 64 + fr, colt = (u.pn & 3) * 256 + wc * 32 + 8 * fq;
#pragma unroll
        for (int ai = 0; ai < 2; ++ai)
#pragma unroll
            for (int m = 0; m < 4; ++m) { const size_t row = (size_t)(row0 + ai * 128 + m * 16); const float cw = cws[row];
#pragma unroll
                for (int bj = 0; bj < 2; ++bj) { const int col = colt + bj * 128; const f32x4 v0 = acc[ai][bj][m][0] * cw, v1 = acc[ai][bj][m][1] * cw;
                    u32x4 w; w.x = pk2(v0[0], v0[1]); w.y = pk2(v0[2], v0[3]); w.z = pk2(v1[0], v1[1]); w.w = pk2(v1[2], v1[3]);
                    *(u32x4*)(y + row * D + col) = w; }
                __builtin_amdgcn_sched_barrier(0); }
    }
};

#ifndef PH_MASK
#define PH_MASK 0xFFFF
#endif
#define PH(k) ((PH_MASK >> (k)) & 1)
#ifndef PROBE_DUP
#define PROBE_DUP 0
#endif
#define DUPN(bit) (((PROBE_DUP >> (bit)) & 1) ? 2 : 1)
#define FRESH() do { asm volatile("" : "+v"(F.tid)); F.lane = F.tid & 63; F.wave = __builtin_amdgcn_readfirstlane(F.tid >> 6); } while (0)
__global__ void __launch_bounds__(NTHR, 2) hybrid_fwd(Args ka) {
    extern __shared__ __attribute__((aligned(16))) unsigned char lds_raw[];
    Frame F;
    F.lds = (LAS unsigned char*)lds_raw;
    F.MISC = (volatile LAS unsigned*)(F.lds + MISC_OFF);
    F.tid = threadIdx.x; F.lane = F.tid & 63; F.wave = __builtin_amdgcn_readfirstlane(F.tid >> 6);
    for (int u = F.tid; u < (LDS_BYTES - MISC_OFF) / 4; u += NTHR) ((LAS unsigned*)(F.lds + MISC_OFF))[u] = 0u;
    __syncthreads();
    if (F.tid < 29) { const unsigned long long p = (unsigned long long)ka.in[F.tid]; F.MISC[64 + 2 * F.tid] = (unsigned)p; F.MISC[65 + 2 * F.tid] = (unsigned)(p >> 32); }
    __syncthreads();
    ArgsL a; a.tab = F.MISC + 64; a.out = ka.out; a.ws = ka.ws;
    unsigned char* ws = a.ws;
    XcdBarrier bar = xcd_barrier_post((unsigned*)(ws + WS_CTL) + CW_BAR, F.MISC + 8);
    const int G = (int)gridDim.x, c = (int)blockIdx.x;
    PG8_LAS unsigned char* ring = (PG8_LAS unsigned char*)F.lds;

    for (int layer = 0; layer < DEPTH; ++layer) {
        for (int rep = 0; rep < DUPN(8); ++rep) { FRESH(); if (PH(0)) phase_wconv(a, F, layer); }
        __syncthreads();
        FRESH(); if (PH(1)) phase_norm<1>(a, F, layer);
        xcd_barrier(bar);
        if (PH(2)) {
            pg8::Gemm g{(const bf16_t*)(ws + WS_A), (const bf16_t*)(ws + WS_WIN), M, N1, D}; pg8::StaticOrder S; S.init(M, N1, G, c, DUPN(3));
            EpiInproj E{(bf16_t*)(ws + WS_USH), (bf16_t*)(ws + WS_QKV)};
            pg8::gemm_phase<EpiInproj, pg8::StaticOrder, true, true>(ring, g, S, E);
        }
        xcd_barrier(bar);
        FRESH(); if (PH(3)) phase_prep(a, F, layer);
        xcd_barrier(bar);
        FRESH(); if (PH(4)) phase_mix(a, F, layer);
        xcd_barrier(bar);
        FRESH(); if (PH(5)) phase_post(a, F, layer);
        if (PH(6)) {
            pg8::Gemm g{(const bf16_t*)(ws + WS_A), (const bf16_t*)(ws + WS_WG), M, 3072, D}; pg8::StaticOrder S; S.init(M, 3072, G, c, DUPN(4));
            EpiGates E{(bf16_t*)(ws + WS_GATES)};
            pg8::gemm_phase<EpiGates, pg8::StaticOrder, true, true>(ring, g, S, E);
        }
        xcd_barrier(bar);
        if (PH(7)) {
            int kdim = RW_W; asm volatile("" : "+s"(kdim));
            pg8::Gemm g{(const bf16_t*)(ws + WS_YCAT), (const bf16_t*)(ws + WS_WP), 3 * M, 3072, kdim}; MergeOrder S{G, c, 516 * DUPN(5)};
            EpiMerge E{(const bf16_t*)(ws + WS_GATES), (bf16_t*)(ws + WS_MERGED)};
            pg8::gemm_phase<EpiMerge, MergeOrder, false, true>(ring, g, S, E);
        }
        xcd_barrier(bar);
        if (PH(8)) {
            pg8::Gemm g{(const bf16_t*)(ws + WS_MERGED), (const bf16_t*)(ws + WS_WO), M, D, D}; pg8::StaticOrder S; S.init(M, D, G, c, 1);
            EpiOut E{a};
            pg8::gemm_phase<EpiOut, pg8::StaticOrder, true, true>(ring, g, S, E);
        }
        xcd_barrier(bar);
        FRESH(); if (PH(9)) phase_norm<2>(a, F, layer);
        xcd_barrier(bar);
        for (int rep = 0; rep < DUPN(7); ++rep) { FRESH(); if (PH(10)) phase_route(a, F, layer); }
        xcd_barrier(bar);
        volatile LAS int* tb = (volatile LAS int*)(F.MISC + 32);
        if (F.tid <= 16) { const int* cnt = (const int*)(ws + WS_CTL) + CW_ECNT + 64 * layer; int t = 0;
            for (int e = 0; e < F.tid; ++e) t += (__hip_atomic_load(cnt + e, __ATOMIC_RELAXED, __HIP_MEMORY_SCOPE_AGENT) + 255) >> 8;
            tb[F.tid] = t; }
        __syncthreads();
        const int ntile = tb[16];
        if (PH(11)) {
            pg8::Gemm g{(const bf16_t*)(ws + WS_AS), (const bf16_t*)(ws + WS_WGU), MS, 8192, D}; MoeOrder S{tb, ntile, 2, G, c, DUPN(6)};
            EpiMoeUp E{(bf16_t*)(ws + WS_HS)};
            pg8::gemm_phase<EpiMoeUp, MoeOrder, true, true>(ring, g, S, E);
        }
        xcd_barrier(bar);
        if (PH(12)) {
            int kdim = DEXP; asm volatile("" : "+s"(kdim));
            pg8::Gemm g{(const bf16_t*)(ws + WS_HS), (const bf16_t*)(ws + WS_WD), MS, 16384, kdim}; MoeOrder S{tb, ntile, 4, G, c, DUPN(6)};
            EpiMoeDown E{(bf16_t*)(ws + WS_Y), (const float*)(ws + WS_CWS)};
            pg8::gemm_phase<EpiMoeDown, MoeOrder, true, true>(ring, g, S, E);
        }
        xcd_barrier(bar);
    }
    FRESH(); if (PH(13)) phase_norm<0>(a, F, DEPTH - 1);
}

extern "C" void kernel_launch(void* const* d_in, const int* in_sizes, int n_in, void* d_out, int out_size, void* d_ws, size_t ws_size, hipStream_t stream) {
    static int ready = 0;
    if (ready == 0) {
        if (n_in != 29 || out_size != NB * SEQ * D || ws_size < WS_END) { fprintf(stderr, "kernel_launch: unexpected problem shape (n_in %d, out %d, ws %zu < %zu)\n", n_in, out_size, ws_size, (size_t)WS_END); ready = -1; return; }
        if (hipFuncSetAttribute((const void*)hybrid_fwd, hipFuncAttributeMaxDynamicSharedMemorySize, LDS_BYTES) != hipSuccess) { fprintf(stderr, "kernel_launch: hipFuncSetAttribute failed\n"); ready = -1; return; }
        int per_cu = 0;
        if (hipOccupancyMaxActiveBlocksPerMultiprocessor(&per_cu, (const void*)hybrid_fwd, NTHR, LDS_BYTES) != hipSuccess || per_cu < 1) fprintf(stderr, "kernel_launch: occupancy query says %d\n", per_cu);
        (void)hipGetLastError();
        ready = 1;
    }
    if (ready < 0) return;
    (void)in_sizes;
    if (hipMemsetAsync((char*)d_ws + WS_CTL, 0, CTL_ZERO_BYTES, stream) != hipSuccess) return;
    Args a{};
    for (int i = 0; i < 29; ++i) a.in[i] = (const float*)d_in[i];
    a.out = (float*)d_out; a.ws = (unsigned char*)d_ws;
    hipLaunchKernelGGL(hybrid_fwd, dim3(256), dim3(NTHR), LDS_BYTES, stream, a);
}
```

```cpp
#include <hip/hip_runtime.h>
#include <hip/hip_bf16.h>
#include <cstdio>
#include <cstdint>

#define GAS __attribute__((address_space(1)))
#define LAS __attribute__((address_space(3)))

namespace pg8 {
#define PG8_LAS __attribute__((address_space(3)))
typedef unsigned short bf16_t;
typedef short bf16x8 __attribute__((ext_vector_type(8)));
typedef float f32x4 __attribute__((ext_vector_type(4)));
typedef unsigned u32x4 __attribute__((ext_vector_type(4)));
constexpr int BM = 256, BK = 64, HALF = 128, HTB = HALF * BK * 2  , STAGE_BYTES = 8 * HTB, NXCD = 8, WGM = 8;

__host__ __device__ __forceinline__ int lds_byte(int r, int c) { const int st = (r >> 4) * 2 + (c >> 5), rr = r & 15, cc = c & 31, ob = rr * 64 + cc * 2; return st * 1024 + (ob ^ (((ob >> 9) & 1) << 5)); }
__host__ __device__ __forceinline__ void stage_rc(int b, int& R, int& C) { const int st = b / 1024, sb = b % 1024, swz = sb ^ (((sb >> 9) & 1) << 5); R = (st >> 1) * 16 + swz / 64; C = (st & 1) * 32 + (swz % 64) / 2; }
__host__ __device__ __forceinline__ int perm32(int rho) { const int n = rho >> 4, i = rho & 15; return 8 * (i >> 2) + 4 * n + (i & 3); }

struct Unit { int pm, pn; };
struct Gemm { const bf16_t* A; const bf16_t* Bt; int M, N, K; };

struct StaticOrder {
    int nM, nN, nwg, G, c, rep;
    __host__ __device__ void init(int M, int N, int G_, int c_, int rep_ = 1) { nM = M / BM; nN = N / BM; nwg = nM * nN; G = G_; c = c_; rep = rep_; }
    __host__ __device__ bool next(int i, Unit& u) const {
        const long L = (long)i * G + c; if (L >= (long)nwg * rep) return false;
        int wgid = (int)(L % nwg); { const int q = nwg / NXCD, r = nwg % NXCD, xcd = wgid % NXCD, off = wgid / NXCD; wgid = (xcd < r ? xcd * (q + 1) : r * (q + 1) + (xcd - r) * q) + off; }
        const int nig = WGM * nN, gid = wgid / nig, fm = gid * WGM, gsz = (nM - fm) < WGM ? (nM - fm) : WGM;
        u.pm = fm + ((wgid % nig) % gsz); u.pn = (wgid % nig) / gsz; return true;
    }
    __device__ __forceinline__ void a_ready(const Unit&) const {}
    __device__ __forceinline__ void done(const Unit&) const {}
};
__device__ __forceinline__ unsigned cvt_pk_bf16(float lo, float hi) { unsigned r; asm volatile("v_cvt_pk_bf16_f32 %0, %1, %2" : "=v"(r) : "v"(lo), "v"(hi)); return r; }
template <class Epi, class Sched, bool ALIGN_EPI = false, bool SP2 = false>
__device__ __forceinline__ void gemm_phase(PG8_LAS unsigned char* lds, const Gemm g, const Sched& S, const Epi& E) {
    int tid_ = threadIdx.x; asm volatile("" : "+v"(tid_));
    const int tid = tid_, wid = __builtin_amdgcn_readfirstlane(tid >> 6), lane = tid & 63, wr = wid >> 2, wc = wid & 3, fr = lane & 15, fq = lane >> 4;
    const int K = g.K, nt = K / BK;
    unsigned voffA[2], voffB[2];
#pragma unroll
    for (int i = 0; i < 2; ++i) { int R, C; stage_rc(tid * 16 + i * 8192, R, C); const int Rb = Epi::PERM ? ((R & ~31) + perm32(R & 31)) : R;
        voffA[i] = (unsigned)(R * K + C) * 2u; voffB[i] = (unsigned)(Rb * K + C) * 2u; }
    const size_t kstep = (size_t)(BK * 2);
    const size_t hstep = (size_t)HALF * K * 2;
    const size_t tstep = 2 * hstep;
    const unsigned ldsw = (unsigned)wid * 1024u;
    const int aoff = lds_byte(wr * 64 + fr, fq * 8), boff = lds_byte(wc * 32 + fr, fq * 8);
#define PG8_SA(b, h) (((b) * 2 + (h)) * HTB)
#define PG8_SB(b, h) ((4 + (b) * 2 + (h)) * HTB)
#define PG8_STAGE(bufoff, gbase, voff) do { _Pragma("unroll") for (int _i = 0; _i < 2; ++_i) \
        __builtin_amdgcn_global_load_lds((const unsigned*)((const char*)(gbase) + (voff)[_i]), (PG8_LAS unsigned*)(lds + (bufoff) + ldsw + _i * 8192), 16, 0, 0); } while (0)
#define PG8_LDA(dst, b, h) do { _Pragma("unroll") for (int m = 0; m < 4; ++m) _Pragma("unroll") for (int k = 0; k < 2; ++k) dst[m][k] = *(const PG8_LAS bf16x8*)(lds + PG8_SA(b, h) + aoff + m * 2048 + k * 1024); } while (0)
#define PG8_LDB(dst, b, h) do { _Pragma("unroll") for (int n = 0; n < 2; ++n) _Pragma("unroll") for (int k = 0; k < 2; ++k) dst[n][k] = *(const PG8_LAS bf16x8*)(lds + PG8_SB(b, h) + boff + n * 2048 + k * 1024); } while (0)
#define PG8_MMA(ai, bj, At, Bt) do { __builtin_amdgcn_s_setprio(1); _Pragma("unroll") for (int m = 0; m < 4; ++m) _Pragma("unroll") for (int n = 0; n < 2; ++n) _Pragma("unroll") for (int k = 0; k < 2; ++k) \
        acc[ai][bj][m][n] = __builtin_amdgcn_mfma_f32_16x16x32_bf16(Bt[n][k], At[m][k], acc[ai][bj][m][n], 0, 0, 0); __builtin_amdgcn_s_setprio(0); } while (0)
#define PG8_WAIT_V(n) asm volatile("s_waitcnt vmcnt(" #n ")" ::: "memory")
#define PG8_WAIT_L(n) asm volatile("s_waitcnt lgkmcnt(" #n ")" ::: "memory")
#define PG8_BAR __builtin_amdgcn_s_barrier()
#define PG8_SCHED __builtin_amdgcn_sched_barrier(0)
    Unit cur, nxt; int ui = 0;
    if (!S.next(0, cur)) return;
    f32x4 acc[2][2][4][2];
#pragma unroll
    for (int a = 0; a < 2; ++a)
#pragma unroll
        for (int b = 0; b < 2; ++b)
#pragma unroll
            for (int m = 0; m < 4; ++m)
#pragma unroll
                for (int n = 0; n < 2; ++n) acc[a][b][m][n] = (f32x4){0.f, 0.f, 0.f, 0.f};
    bf16x8 At[4][2], B0[2][2], B1[2][2];
    const char* cA = (const char*)g.A + (size_t)cur.pm * tstep; const char* cB = (const char*)g.Bt + (size_t)cur.pn * tstep;
    S.a_ready(cur);
    if constexpr (SP2) {
        PG8_STAGE(PG8_SB(0, 0), cB, voffB); PG8_STAGE(PG8_SB(0, 1), cB + hstep, voffB); PG8_STAGE(PG8_SA(0, 0), cA, voffA); PG8_STAGE(PG8_SA(0, 1), cA + hstep, voffA);
        if (wr == 1) PG8_BAR;
        PG8_WAIT_V(2); PG8_BAR;
        PG8_STAGE(PG8_SB(1, 0), cB + kstep, voffB); PG8_STAGE(PG8_SA(1, 0), cA + kstep, voffA); PG8_STAGE(PG8_SB(1, 1), cB + hstep + kstep, voffB);
        PG8_WAIT_V(6); PG8_BAR;
    } else {
        PG8_STAGE(PG8_SB(0, 0), cB, voffB); PG8_STAGE(PG8_SA(0, 0), cA, voffA); PG8_STAGE(PG8_SB(0, 1), cB + hstep, voffB); PG8_STAGE(PG8_SA(0, 1), cA + hstep, voffA);
        if (wr == 1) PG8_BAR;
        PG8_WAIT_V(4); PG8_BAR;
        PG8_STAGE(PG8_SB(1, 0), cB + kstep, voffB); PG8_STAGE(PG8_SA(1, 0), cA + kstep, voffA); PG8_STAGE(PG8_SB(1, 1), cB + hstep + kstep, voffB);
        PG8_WAIT_V(6); PG8_BAR;
    }
    for (;;) {
        const bool has_next = S.next(ui + 1, nxt);
        const char* nA = has_next ? (const char*)g.A + (size_t)nxt.pm * tstep : cA; const char* nB = has_next ? (const char*)g.Bt + (size_t)nxt.pn * tstep : cB;
        for (int t = 0; t < nt; t += 2) {
            const bool last = (t == nt - 2);
            const char* a1 = cA + (size_t)(t + 1) * kstep;
            const char* a2 = last ? nA : cA + (size_t)(t + 2) * kstep; const char* b2 = last ? nB : cB + (size_t)(t + 2) * kstep;
            const char* a3 = a2 + kstep; const char* b3 = b2 + kstep;
            if (last && has_next) S.a_ready(nxt);
            if constexpr (SP2) {
            PG8_LDB(B0, 0, 0); PG8_LDB(B1, 0, 1); PG8_SCHED; PG8_LDA(At, 0, 0); PG8_STAGE(PG8_SA(1, 1), a1 + hstep, voffA);
            PG8_WAIT_V(8); PG8_WAIT_L(0); PG8_BAR; PG8_MMA(0, 0, At, B0); PG8_MMA(0, 1, At, B1); PG8_BAR; PG8_SCHED;
            PG8_LDA(At, 0, 1); PG8_STAGE(PG8_SB(0, 0), b2, voffB); PG8_STAGE(PG8_SB(0, 1), b2 + hstep, voffB); PG8_STAGE(PG8_SA(0, 0), a2, voffA);
            PG8_WAIT_V(8); PG8_WAIT_L(0); PG8_BAR; PG8_MMA(1, 0, At, B0); PG8_MMA(1, 1, At, B1); PG8_BAR; PG8_SCHED;
            PG8_LDB(B0, 1, 0); PG8_LDB(B1, 1, 1); PG8_SCHED; PG8_LDA(At, 1, 0); PG8_STAGE(PG8_SA(0, 1), a2 + hstep, voffA);
            PG8_WAIT_V(8); PG8_WAIT_L(0); PG8_BAR; PG8_MMA(0, 0, At, B0); PG8_MMA(0, 1, At, B1); PG8_BAR; PG8_SCHED;
            PG8_LDA(At, 1, 1); PG8_STAGE(PG8_SB(1, 0), b3, voffB); PG8_STAGE(PG8_SB(1, 1), b3 + hstep, voffB); PG8_STAGE(PG8_SA(1, 0), a3, voffA);
            PG8_WAIT_V(8); PG8_WAIT_L(0); PG8_BAR; PG8_MMA(1, 0, At, B0); PG8_MMA(1, 1, At, B1); PG8_BAR; PG8_SCHED;
            } else {
            PG8_LDB(B0, 0, 0); PG8_SCHED; PG8_LDA(At, 0, 0); PG8_STAGE(PG8_SA(1, 1), a1 + hstep, voffA);
            PG8_WAIT_L(8); PG8_BAR; PG8_WAIT_L(0); PG8_MMA(0, 0, At, B0); PG8_BAR; PG8_SCHED;
            PG8_LDB(B1, 0, 1); PG8_STAGE(PG8_SB(0, 0), b2, voffB);
            PG8_BAR; PG8_WAIT_L(0); PG8_MMA(0, 1, At, B1); PG8_BAR;
            PG8_LDA(At, 0, 1); PG8_STAGE(PG8_SA(0, 0), a2, voffA);
            PG8_BAR; PG8_WAIT_L(0); PG8_MMA(1, 0, At, B0); PG8_BAR; PG8_SCHED;
            PG8_STAGE(PG8_SB(0, 1), b2 + hstep, voffB);
            PG8_WAIT_V(6); PG8_BAR; PG8_MMA(1, 1, At, B1); PG8_BAR;
            PG8_LDB(B0, 1, 0); PG8_SCHED; PG8_LDA(At, 1, 0); PG8_STAGE(PG8_SA(0, 1), a2 + hstep, voffA);
            PG8_WAIT_L(8); PG8_BAR; PG8_WAIT_L(0); PG8_MMA(0, 0, At, B0); PG8_BAR; PG8_SCHED;
            PG8_LDB(B1, 1, 1); PG8_STAGE(PG8_SB(1, 0), b3, voffB);
            PG8_BAR; PG8_WAIT_L(0); PG8_MMA(0, 1, At, B1); PG8_BAR;
            PG8_LDA(At, 1, 1); PG8_STAGE(PG8_SA(1, 0), a3, voffA);
            PG8_BAR; PG8_WAIT_L(0); PG8_MMA(1, 0, At, B0); PG8_BAR; PG8_SCHED;
            PG8_STAGE(PG8_SB(1, 1), b3 + hstep, voffB);
            PG8_WAIT_V(6); PG8_BAR; PG8_MMA(1, 1, At, B1); PG8_BAR;
            }
        }
        if constexpr (ALIGN_EPI) { if (wr == 0) PG8_BAR; }
        if constexpr (!Epi::AFTER_DRAIN) { E(acc, cur, wr, wc, fr, fq); S.done(cur); }
        if (!has_next) break;
#pragma unroll
        for (int a = 0; a < 2; ++a)
#pragma unroll
            for (int b = 0; b < 2; ++b)
#pragma unroll
                for (int m = 0; m < 4; ++m)
#pragma unroll
                    for (int n = 0; n < 2; ++n) acc[a][b][m][n] = (f32x4){0.f, 0.f, 0.f, 0.f};
        cur = nxt; cA = nA; cB = nB; ++ui;
        if constexpr (ALIGN_EPI) { if (wr == 1) PG8_BAR; }
    }
    PG8_WAIT_V(0);
    if constexpr (!ALIGN_EPI) { if (wr == 0) PG8_BAR; }
    PG8_BAR;
    if constexpr (Epi::AFTER_DRAIN) { E.fused(acc, cur, wr, wc, fr, fq, lds, wid, lane); S.done(cur); }
#undef PG8_SA
#undef PG8_SB
#undef PG8_STAGE
#undef PG8_LDA
#undef PG8_LDB
#undef PG8_MMA
#undef PG8_WAIT_V
#undef PG8_WAIT_L
#undef PG8_BAR
#undef PG8_SCHED
}
}

constexpr int D = 1024, NB = 2, SEQ = 16384, NMETA = 16, LTOK = SEQ + NMETA  , PADR = 112, T = PADR + LTOK  ;
constexpr int M = NB * T;
constexpr int DEPTH = 2, HD = 64, RW_H = 6, SB_H = 5, FX_H = 5, RW_W = 384, SHIFT_W = 1280, D_IN = 6277;
constexpr int QKV_W = 1920;
constexpr int N1 = 3328;
constexpr int FCOL = 3200, GCOL = 3205;
constexpr int NEXP = 16, DEXP = 256;
constexpr int MS = 70144;
constexpr int LCH = 32, LPADDED = 16416;
constexpr int KBP = 16896;
constexpr float C2 = 0.125f * 1.4426950408889634f;
constexpr float LOG2E = 1.4426950408889634f;
constexpr int NWAVES = 8, NTHR = 512;

constexpr size_t MiB = 1u << 20;
constexpr size_t WS_CTL = 0, CTL_ZERO_BYTES = 65536;
constexpr size_t WS_HM = 1 * MiB;
constexpr size_t WS_LOGF = WS_HM + 131072;
constexpr size_t WS_KB2 = WS_LOGF + (size_t)M * 32;
constexpr size_t WS_TOK = WS_KB2 + (size_t)10 * KBP * 4;
constexpr size_t WS_SLOT = WS_TOK + (size_t)M * 32;
constexpr size_t WS_CWS = WS_SLOT + (size_t)M * 8;
constexpr size_t WS_WGCNT = WS_CWS + (size_t)MS * 4;
constexpr size_t WS_SMALL_END = WS_WGCNT + 256 * 16 * 4;
static_assert(WS_SMALL_END <= 8 * MiB, "small buffers");
constexpr size_t WS_WIN = 8 * MiB;
constexpr size_t WS_WG = WS_WIN + (size_t)N1 * 1024 * 2;
constexpr size_t WS_WP = WS_WG + (size_t)3072 * 1024 * 2;
constexpr size_t WS_WO = WS_WP + (size_t)3072 * 384 * 2;
constexpr size_t WS_WGU = WS_WO + (size_t)1024 * 1024 * 2;
constexpr size_t WS_WD = WS_WGU + (size_t)8192 * 1024 * 2;
constexpr size_t WS_W_END = WS_WD + (size_t)16384 * 256 * 2;
static_assert(WS_W_END <= 49 * MiB, "weights");
constexpr size_t WS_A = 49 * MiB;
constexpr size_t WS_BIG = 115 * MiB;
constexpr size_t WS_USH = WS_BIG;
constexpr size_t WS_YCAT = WS_BIG;
constexpr size_t WS_QKV = WS_BIG + 82 * MiB;
constexpr size_t WS_RW = WS_BIG + 204 * MiB;
constexpr size_t WS_BN = WS_BIG + 349 * MiB;
constexpr size_t WS_GATES = WS_BIG + 82 * MiB;
constexpr size_t WS_MERGED = WS_BIG + 276 * MiB;
constexpr size_t WS_AS = WS_BIG;
constexpr size_t WS_HS = WS_BIG + 137 * MiB;
constexpr size_t WS_Y = WS_BIG + 172 * MiB;
constexpr size_t WS_END = WS_BIG + 374 * MiB;
static_assert((size_t)(M + 256) * 1280 * 2 <= 82 * MiB && (size_t)3 * M * 384 * 2 <= 82 * MiB && (size_t)(M + 256) * 1920 * 2 <= 122 * MiB, "big map 1");
static_assert((size_t)12 * LPADDED * 768 <= 145 * MiB && (size_t)M * 384 * 2 <= 25 * MiB && (size_t)M * 3072 * 2 <= 194 * MiB && (size_t)M * 2048 <= 65 * MiB, "big map 2");
static_assert((size_t)MS * 2048 <= 137 * MiB && (size_t)MS * 512 <= 35 * MiB && WS_END <= 489 * MiB, "big map 3");

constexpr int CW_BAR = 0;
constexpr int CW_QUEUE = 4096;
constexpr int CW_ECNT = 4352;
static_assert((CW_ECNT + 128) * 4 <= (int)CTL_ZERO_BYTES, "ctl");

constexpr int RING_BYTES = 131072, MISC_OFF = RING_BYTES, LDS_BYTES = 147456;

typedef unsigned short bf16_t;
typedef float f32x4 __attribute__((ext_vector_type(4)));
typedef float f32x2 __attribute__((ext_vector_type(2)));
typedef float f32x16 __attribute__((ext_vector_type(16)));
typedef unsigned u32x4 __attribute__((ext_vector_type(4)));
typedef unsigned u32x2 __attribute__((ext_vector_type(2)));
typedef short bf16x8 __attribute__((ext_vector_type(8)));
typedef short s16x4 __attribute__((ext_vector_type(4)));
typedef _Float16 f16x4 __attribute__((ext_vector_type(4)));
typedef __bf16 bf16x2_t __attribute__((ext_vector_type(2)));

__device__ __forceinline__ unsigned pk2(float lo, float hi) { f32x2 v = {lo, hi}; bf16x2_t b = __builtin_convertvector(v, bf16x2_t); return __builtin_bit_cast(unsigned, b); }
__device__ __forceinline__ unsigned short f2bf(float f) { return (unsigned short)(pk2(f, 0.f) & 0xffffu); }
__device__ __forceinline__ float bf_lo(unsigned u) { return __uint_as_float(u << 16); }
__device__ __forceinline__ float bf_hi(unsigned u) { return __uint_as_float(u & 0xffff0000u); }
__device__ __forceinline__ float bf2f(unsigned short h) { return __uint_as_float((unsigned)h << 16); }
__device__ __forceinline__ float wave_sum(float v) {
#pragma unroll
    for (int o = 1; o < 64; o <<= 1) v += __shfl_xor(v, o);
    return v;
}
__device__ __forceinline__ float fast_exp(float x) { return __builtin_amdgcn_exp2f(x * LOG2E); }
__device__ __forceinline__ float fast_log(float x) { return __builtin_amdgcn_logf(x) * 0.6931471805599453f; }
__device__ __forceinline__ float softplus_f(float z) { return fmaxf(z, 0.f) + fast_log(1.f + fast_exp(-fabsf(z))); }

#define XB_TMO      128
#define XB_XCNT(j)  (256  + 64 * (j))
#define XB_XSUB(j)  (1280 + 64 * (j))
#define XB_XGEN(j)  (2304 + 64 * (j))
#define XB_TOP      3328
#define XB_TOPGEN   3392
#define XCD_BAR_WORDS 3456
#define XB_SPIN_CAP (1u << 20)
__device__ __forceinline__ unsigned xb_ld(unsigned* p)              { return __hip_atomic_load(p, __ATOMIC_RELAXED, __HIP_MEMORY_SCOPE_AGENT); }
__device__ __forceinline__ unsigned xb_add(unsigned* p, unsigned v) { return __hip_atomic_fetch_add(p, v, __ATOMIC_RELAXED, __HIP_MEMORY_SCOPE_AGENT); }
__device__ __forceinline__ unsigned xb_xcc_id() { return (unsigned)__builtin_amdgcn_s_getreg((3 << 11) | 20) & 0xFu; }
#define XB_SPIN(cond, bar) do { unsigned _sp = 0; while (cond) { __builtin_amdgcn_s_sleep(1); \
    if ((++_sp & 255u) == 0u) { if (xb_ld(&(bar)[XB_TMO])) break; if (_sp > XB_SPIN_CAP) { atomicAdd(&(bar)[XB_TMO], 1u); break; } } } } while (0)

struct XcdBarrier {
    unsigned* bar; unsigned x;
    volatile LAS unsigned* st;
};

__device__ __forceinline__ XcdBarrier xcd_barrier_post(unsigned* bar, volatile LAS unsigned* st) {
    XcdBarrier b; b.bar = bar; b.x = xb_xcc_id(); b.st = st;
    if (threadIdx.x == 0) (void)xb_add(&bar[XB_XCNT(b.x)], 1u);
    return b;
}
__device__ __forceinline__ void xcd_barrier_complete(unsigned* bar, unsigned x, unsigned& nloc, unsigned& nx) {
    const unsigned G = gridDim.x * gridDim.y * gridDim.z;
    unsigned sum, cnt, mine, sp = 0u;
    for (;;) {
        sum = 0u; cnt = 0u; mine = 0u;
#pragma unroll
        for (unsigned j = 0; j < 16; ++j) { const unsigned c = xb_ld(&bar[XB_XCNT(j)]); sum += c; cnt += (c > 0u) ? 1u : 0u; mine = (j == x) ? c : mine; }
        if (sum == G) break;
        __builtin_amdgcn_s_sleep(1);
        if ((++sp & 255u) == 0u) { if (xb_ld(&bar[XB_TMO])) break; if (sp > XB_SPIN_CAP) { atomicAdd(&bar[XB_TMO], 1u); break; } }
    }
    nloc = mine > 0u ? mine : 1u; nx = cnt > 0u ? cnt : 1u;
}

__device__ __forceinline__ void xcd_barrier(const XcdBarrier& b) {
    asm volatile("s_waitcnt vmcnt(0)" ::: "memory");
    __syncthreads();
    if (threadIdx.x == 0) {
        unsigned* bar = b.bar;
        __builtin_amdgcn_s_waitcnt(0);
        unsigned nloc = b.st[0], nx = b.st[1];
        if (nloc == 0u) { xcd_barrier_complete(bar, b.x, nloc, nx); b.st[0] = nloc; b.st[1] = nx; }
        const unsigned old = xb_add(&bar[XB_XSUB(b.x)], 1u);
        const unsigned gen = old / nloc;
        if (old + 1u == (gen + 1u) * nloc) {
            __builtin_amdgcn_fence(__ATOMIC_RELEASE, "agent");
            asm volatile("s_waitcnt vmcnt(0)" ::: "memory");
            const unsigned og = xb_add(&bar[XB_TOP], 1u);
            const unsigned tg = og / nx;
            if (og + 1u == (tg + 1u) * nx) xb_add(&bar[XB_TOPGEN], 1u);
            else XB_SPIN(xb_ld(&bar[XB_TOPGEN]) == tg, bar);
            __builtin_amdgcn_fence(__ATOMIC_ACQUIRE, "agent");
            xb_add(&bar[XB_XGEN(b.x)], 1u);
            asm volatile("s_waitcnt vmcnt(0)" ::: "memory");
        } else {
            XB_SPIN(xb_ld(&bar[XB_XGEN(b.x)]) == gen, bar);
            __builtin_amdgcn_fence(__ATOMIC_ACQUIRE, "agent");
            asm volatile("s_waitcnt vmcnt(0)" ::: "memory");
        }
    }
    __syncthreads();
}

struct Args { const float* in[29]; float* out; unsigned char* ws; };
enum { I_X = 0, I_META, I_N1G, I_WIN, I_MU, I_WUP, I_W0, I_AUP, I_A0, I_KK, I_KA, I_RK, I_LNG, I_LNB, I_FB, I_QG, I_KG, I_WPR, I_WPS, I_WPF, I_WOUT, I_N2G, I_MWG, I_MBG, I_MWE, I_MBE, I_MGATE, I_MUP, I_MDOWN };
struct ArgsL { volatile LAS unsigned* tab; float* out; unsigned char* ws;
    __device__ __forceinline__ const float* in(int i) const { const unsigned lo = tab[2 * i], hi = tab[2 * i + 1];
        return (const float*)(((unsigned long long)(unsigned)__builtin_amdgcn_readfirstlane((int)hi) << 32) | (unsigned long long)(unsigned)__builtin_amdgcn_readfirstlane((int)lo)); }
};
struct Frame { LAS unsigned char* lds; volatile LAS unsigned* MISC; int tid, lane, wave, bx; };

__device__ __forceinline__ float* hrow(const ArgsL& a, int b, int l) {
    return l < NMETA ? (float*)(a.ws + WS_HM) + (size_t)(b * NMETA + l) * D : a.out + ((size_t)b * SEQ + (l - NMETA)) * D;
}
#define LDS_WAIT() asm volatile("s_waitcnt lgkmcnt(0)" ::: "memory")

__device__ __forceinline__ void tr_item(const float* W, int ldw, int sc0, int nvalid, int k0, int kvalid, bf16_t* WT, int Kd, int r0, LAS float* scr, int lane) {
    float tv[32];
#pragma unroll
    for (int i = 0; i < 32; ++i) { const int kk = 2 * i + (lane >> 5), n = lane & 31; tv[i] = 0.f;
        if (n < nvalid && k0 + kk < kvalid) tv[i] = W[(size_t)(k0 + kk) * ldw + sc0 + n]; }
#pragma unroll
    for (int i = 0; i < 32; ++i) { const int kk = 2 * i + (lane >> 5), n = lane & 31; scr[kk * 33 + n] = tv[i]; }
    LDS_WAIT();
    const int c = lane & 7;
#pragma unroll
    for (int j = 0; j < 4; ++j) { const int n = (lane >> 3) + 8 * j; const LAS float* s = scr + (8 * c) * 33 + n;
        u32x4 o; o.x = pk2(s[0 * 33], s[1 * 33]); o.y = pk2(s[2 * 33], s[3 * 33]); o.z = pk2(s[4 * 33], s[5 * 33]); o.w = pk2(s[6 * 33], s[7 * 33]);
        *(u32x4*)(WT + (size_t)(r0 + n) * Kd + k0 + 8 * c) = o; }
    LDS_WAIT();
}
__device__ __forceinline__ void phase_wconv(const ArgsL& a, Frame& F, int layer) {
    LAS float* scr = (LAS float*)(F.lds + F.wave * 8448);
    const int gw = F.bx * NWAVES + F.wave, NGW = gridDim.x * NWAVES;
    constexpr int C1 = 16 * 104, C2_ = C1 + 16 * 96, C3 = C2_ + 6 * 96, C4 = C3 + 16 * 32, C5 = C4 + 16 * 256, C6 = C5 + 4 * 512;
    unsigned char* ws = a.ws;
    for (int it = gw; it < C6; it += NGW) {
        if (it < C1) { const int kb = it / 104, nb = it % 104, r0 = nb * 32;
            tr_item(a.in(I_WIN) + (size_t)layer * D * D_IN, D_IN, r0, r0 < FCOL ? 32 : 0, kb * 64, 1024, (bf16_t*)(ws + WS_WIN), 1024, r0, scr, F.lane); }
        else if (it < C2_) { const int r = it - C1, kb = r / 96, nb = r % 96, r0 = nb * 32;
            tr_item(a.in(I_WIN) + (size_t)layer * D * D_IN, D_IN, GCOL + r0, 32, kb * 64, 1024, (bf16_t*)(ws + WS_WG), 1024, r0, scr, F.lane); }
        else if (it < C3) { const int r = it - C2_, kb = r / 96, nb = r % 96, r0 = nb * 32, br = r0 >> 10;
            const float* W = (br == 0 ? a.in(I_WPR) + (size_t)layer * 384 * D : br == 1 ? a.in(I_WPS) + (size_t)layer * 320 * D : a.in(I_WPF) + (size_t)layer * 320 * D);
            tr_item(W, D, r0 & 1023, 32, kb * 64, br == 0 ? 384 : 320, (bf16_t*)(ws + WS_WP), 384, r0, scr, F.lane); }
        else if (it < C4) { const int r = it - C3, kb = r / 32, nb = r % 32, r0 = nb * 32;
            tr_item(a.in(I_WOUT) + (size_t)layer * D * D, D, r0, 32, kb * 64, 1024, (bf16_t*)(ws + WS_WO), 1024, r0, scr, F.lane); }
        else if (it < C5) { const int r = it - C4, kb = r / 256, nb = r % 256, r0 = nb * 32, e = r0 >> 9, rr = r0 & 511, j = rr >> 8, q = rr & 255;
            const float* W = (q >= 128 ? a.in(I_MUP) : a.in(I_MGATE)) + ((size_t)layer * NEXP + e) * D * DEXP;
            tr_item(W, DEXP, j * 128 + (q & 127), 32, kb * 64, 1024, (bf16_t*)(ws + WS_WGU), 1024, r0, scr, F.lane); }
        else { const int r = it - C5, kb = r / 512, nb = r % 512, r0 = nb * 32, e = r0 >> 10;
            tr_item(a.in(I_MDOWN) + ((size_t)layer * NEXP + e) * DEXP * D, D, r0 & 1023, 32, kb * 64, 256, (bf16_t*)(ws + WS_WD), 256, r0, scr, F.lane); }
    }
}

__device__ __forceinline__ void add_y_row(f32x4 (&v)[4], const bf16_t* Y, int slot, int lane) {
    const u32x2* y = (const u32x2*)(Y + (size_t)slot * D) + lane;
#pragma unroll
    for (int j = 0; j < 4; ++j) { const u32x2 t = y[64 * j]; v[j].x += bf_lo(t.x); v[j].y += bf_hi(t.x); v[j].z += bf_lo(t.y); v[j].w += bf_hi(t.y); }
}
template <int MODE>
__device__ __forceinline__ void phase_norm(const ArgsL& a, Frame& F, int layer) {
    const int lane = F.lane;
    LAS float* wl = (LAS float*)F.lds;
    LAS int* lcnt = (LAS int*)(F.lds + 20 * 4096);
    unsigned char* ws = a.ws;
    if (MODE == 1) {
        const float* win = a.in(I_WIN) + (size_t)layer * D * D_IN;
        for (int idx = F.tid; idx < 5 * 1024; idx += NTHR) { const int k = idx / 5, j = idx % 5; wl[j * 1024 + k] = win[(size_t)k * D_IN + FCOL + j]; }
    }
    if (MODE == 2) {
        const float* wg = a.in(I_MWG) + (size_t)layer * D * 4; const float* we = a.in(I_MWE) + (size_t)layer * D * 16;
        for (int idx = F.tid; idx < 4 * 1024; idx += NTHR) { const int k = idx >> 2, j = idx & 3; wl[j * 1024 + k] = wg[idx]; }
        for (int idx = F.tid; idx < 16 * 1024; idx += NTHR) { const int k = idx >> 4, j = idx & 15; wl[(4 + j) * 1024 + k] = we[idx]; }
        if (F.tid < 16) lcnt[F.tid] = 0;
    }
    __syncthreads();
    const int gw = F.bx * NWAVES + F.wave, NGW = gridDim.x * NWAVES;
    const float* gsrc = (MODE == 2 ? a.in(I_N2G) : a.in(I_N1G)) + layer * D;
    f32x4 gv[4];
#pragma unroll
    for (int j = 0; j < 4; ++j) gv[j] = (MODE == 0) ? (f32x4){0.f, 0.f, 0.f, 0.f} : *(const f32x4*)(gsrc + 4 * lane + 256 * j);
    bf16_t* A = (bf16_t*)(ws + WS_A);
    const bf16_t* Y = (const bf16_t*)(ws + WS_Y);
    const int* SLOT = (const int*)(ws + WS_SLOT);
    constexpr bool COMB0 = (MODE == 0);
    const bool comb = COMB0 || (MODE == 1 && layer > 0);
    f32x4 vn[4]; u32x2 yan[4], ybn[4];
#pragma unroll
    for (int j = 0; j < 4; ++j) { vn[j] = (f32x4){0.f, 0.f, 0.f, 0.f}; yan[j] = (u32x2){0u, 0u}; ybn[j] = (u32x2){0u, 0u}; }
#define NRM_VALID(mm) ((mm) < M && ((mm) % T) - PADR >= (MODE == 0 ? NMETA : 0))
#define NRM_SRC(mm, bb_, ll_) ((MODE == 1 && layer == 0) ? ((ll_) < NMETA ? a.in(I_META) + (size_t)(ll_) * D : a.in(I_X) + ((size_t)(bb_) * SEQ + ((ll_) - NMETA)) * D) : (const float*)hrow(a, bb_, ll_))
#define NRM_LOAD(mm, s0_, s1_) do { if (NRM_VALID(mm)) { const int bb_ = (mm) / T, ll_ = (mm) - bb_ * T - PADR; const float* src_ = NRM_SRC(mm, bb_, ll_); \
        _Pragma("unroll") for (int j = 0; j < 4; ++j) vn[j] = *(const f32x4*)(src_ + 4 * lane + 256 * j); \
        if (comb) { const u32x2* y0_ = (const u32x2*)(Y + (size_t)(s0_) * D) + lane; const u32x2* y1_ = (const u32x2*)(Y + (size_t)(s1_) * D) + lane; \
            _Pragma("unroll") for (int j = 0; j < 4; ++j) { yan[j] = y0_[64 * j]; ybn[j] = y1_[64 * j]; } } } } while (0)
    int sa1 = 0, sb1 = 0, sa2 = 0, sb2 = 0;
    if (comb) { if (NRM_VALID(gw)) { sa1 = SLOT[2 * gw]; sb1 = SLOT[2 * gw + 1]; } if (NRM_VALID(gw + NGW)) { sa2 = SLOT[2 * (gw + NGW)]; sb2 = SLOT[2 * (gw + NGW) + 1]; } }
    NRM_LOAD(gw, sa1, sb1);
    for (int m = gw; m < M; m += NGW) {
        f32x4 v[4]; u32x2 ya[4], yb[4];
#pragma unroll
        for (int j = 0; j < 4; ++j) { v[j] = vn[j]; ya[j] = yan[j]; yb[j] = ybn[j]; }
        int sa3 = 0, sb3 = 0;
        if (comb && NRM_VALID(m + 2 * NGW)) { sa3 = SLOT[2 * (m + 2 * NGW)]; sb3 = SLOT[2 * (m + 2 * NGW) + 1]; }
        NRM_LOAD(m + NGW, sa2, sb2);
        sa2 = sa3; sb2 = sb3;
        const int b = m / T, p = m - b * T, l = p - PADR;
        if (l < 0) {
            if (MODE == 1) {
                u32x2* o = (u32x2*)(A + (size_t)m * D) + lane;
#pragma unroll
                for (int j = 0; j < 4; ++j) o[64 * j] = (u32x2){0u, 0u};
                if (lane < 8) ((float*)(ws + WS_LOGF))[(size_t)m * 8 + lane] = 0.f;
            }
            continue;
        }
        if (MODE == 0 && l < NMETA) continue;
        float* hp = hrow(a, b, l);
        if (comb) {
#pragma unroll
            for (int j = 0; j < 4; ++j) { v[j].x += bf_lo(ya[j].x) + bf_lo(yb[j].x); v[j].y += bf_hi(ya[j].x) + bf_hi(yb[j].x); v[j].z += bf_lo(ya[j].y) + bf_lo(yb[j].y); v[j].w += bf_hi(ya[j].y) + bf_hi(yb[j].y); }
        }
        if (MODE == 0 || MODE == 1) {
#pragma unroll
            for (int j = 0; j < 4; ++j) *(f32x4*)(hp + 4 * lane + 256 * j) = v[j];
        }
        if (MODE == 0) continue;
        float ss = 0.f;
#pragma unroll
        for (int j = 0; j < 4; ++j) ss += (v[j].x * v[j].x + v[j].y * v[j].y) + (v[j].z * v[j].z + v[j].w * v[j].w);
        const float r = 1.0f / sqrtf(wave_sum(ss) * (1.0f / D) + 1e-6f);
#pragma unroll
        for (int j = 0; j < 4; ++j) v[j] = v[j] * r * gv[j];
        u32x2* o = (u32x2*)(A + (size_t)m * D) + lane;
#pragma unroll
        for (int j = 0; j < 4; ++j) o[64 * j] = (u32x2){pk2(v[j].x, v[j].y), pk2(v[j].z, v[j].w)};
        if (MODE == 1) {
            float dsum[5];
#pragma unroll
            for (int q = 0; q < 5; ++q) { float d = 0.f;
#pragma unroll
                for (int j = 0; j < 4; ++j) { const f32x4 w = *(const LAS f32x4*)(wl + q * 1024 + 4 * lane + 256 * j); d += (v[j].x * w.x + v[j].y * w.y) + (v[j].z * w.z + v[j].w * w.w); }
                dsum[q] = wave_sum(d); }
            float mine = dsum[0];
            mine = lane == 1 ? dsum[1] : mine; mine = lane == 2 ? dsum[2] : mine; mine = lane == 3 ? dsum[3] : mine; mine = lane == 4 ? dsum[4] : mine;
            if (lane < 8) { float lf = 0.f;
                if (lane < 5) { const float xx = mine + a.in(I_FB)[layer * 5 + lane]; lf = fminf(xx, 0.f) - fast_log(1.f + fast_exp(-fabsf(xx))); }
                ((float*)(ws + WS_LOGF))[(size_t)m * 8 + lane] = lf; }
        }
        if (MODE == 2) {
            float ds[20];
#pragma unroll
            for (int q = 0; q < 20; ++q) { float d = 0.f;
#pragma unroll
                for (int j = 0; j < 4; ++j) { const f32x4 w = *(const LAS f32x4*)(wl + q * 1024 + 4 * lane + 256 * j); d += (v[j].x * w.x + v[j].y * w.y) + (v[j].z * w.z + v[j].w * w.w); }
                ds[q] = wave_sum(d); }
            const float* bg = a.in(I_MBG) + layer * 4; const float* be = a.in(I_MBE) + layer * 16;
            float lg0 = ds[0] + bg[0], lg1 = ds[1] + bg[1], lg2 = ds[2] + bg[2], lg3 = ds[3] + bg[3];
            int g = 0; float mx = lg0;
            if (lg1 > mx) { mx = lg1; g = 1; } if (lg2 > mx) { mx = lg2; g = 2; } if (lg3 > mx) { mx = lg3; g = 3; }
            const float den = fast_exp(lg0 - mx) + fast_exp(lg1 - mx) + fast_exp(lg2 - mx) + fast_exp(lg3 - mx);
            const float pgrp = 1.0f / den;
            float s0 = g == 0 ? ds[4] : g == 1 ? ds[8] : g == 2 ? ds[12] : ds[16];
            float s1 = g == 0 ? ds[5] : g == 1 ? ds[9] : g == 2 ? ds[13] : ds[17];
            float s2 = g == 0 ? ds[6] : g == 1 ? ds[10] : g == 2 ? ds[14] : ds[18];
            float s3 = g == 0 ? ds[7] : g == 1 ? ds[11] : g == 2 ? ds[15] : ds[19];
            s0 += be[g * 4 + 0]; s1 += be[g * 4 + 1]; s2 += be[g * 4 + 2]; s3 += be[g * 4 + 3];
            int i0 = 0; float v0 = s0;
            if (s1 > v0) { v0 = s1; i0 = 1; } if (s2 > v0) { v0 = s2; i0 = 2; } if (s3 > v0) { v0 = s3; i0 = 3; }
            int i1 = -1; float v1 = -3.0e38f;
            if (i0 != 0 && s0 > v1) { v1 = s0; i1 = 0; } if (i0 != 1 && s1 > v1) { v1 = s1; i1 = 1; } if (i0 != 2 && s2 > v1) { v1 = s2; i1 = 2; } if (i0 != 3 && s3 > v1) { v1 = s3; i1 = 3; }
            const float e1 = fast_exp(v1 - v0), pt0 = 1.0f / (1.0f + e1), pt1 = e1 * pt0;
            if (lane == 0) {
                const int ea = g * 4 + i0, eb = g * 4 + i1;
                const int la = atomicAdd((int*)&lcnt[ea], 1), lb = atomicAdd((int*)&lcnt[eb], 1);
                int* tk = (int*)(ws + WS_TOK) + (size_t)m * 8;
                tk[0] = ea; tk[1] = eb; tk[2] = __float_as_int(pgrp * pt0); tk[3] = __float_as_int(pgrp * pt1); tk[4] = la; tk[5] = lb;
            }
        }
    }
    __syncthreads();
#undef NRM_LOAD
#undef NRM_SRC
#undef NRM_VALID
    if (MODE == 2 && F.tid < 16) {
        const int c = lcnt[F.tid];
        ((int*)(ws + WS_WGCNT))[F.bx * 16 + F.tid] = c;
        atomicAdd((int*)(ws + WS_CTL) + CW_ECNT + 64 * layer + F.tid, c);
    }
    __syncthreads();
}

__device__ __forceinline__ void phase_route(const ArgsL& a, Frame& F, int layer) {
    unsigned char* ws = a.ws;
    LAS int* tbl = (LAS int*)F.lds;
    LAS int* part = tbl + 16;
    {
        const int e = F.tid & 15, q = F.tid >> 4; const int* wc = (const int*)(ws + WS_WGCNT); int acc = 0;
#pragma unroll
        for (int i = 0; i < 8; ++i) { const int w = q + 32 * i; if (w < (int)F.bx) acc += wc[w * 16 + e]; }
        part[q * 16 + e] = acc;
    }
    __syncthreads();
    if (F.tid < 16) {
        const int* cnt = (const int*)(ws + WS_CTL) + CW_ECNT + 64 * layer;
        int cv[16];
#pragma unroll
        for (int e = 0; e < 16; ++e) cv[e] = __hip_atomic_load(cnt + e, __ATOMIC_RELAXED, __HIP_MEMORY_SCOPE_AGENT);
        int base = 0;
#pragma unroll
        for (int e = 0; e < 16; ++e) if (e < F.tid) base += ((cv[e] + 255) >> 8) << 8;
#pragma unroll
        for (int q = 0; q < 32; ++q) base += part[q * 16 + F.tid];
        tbl[F.tid] = base;
    }
    __syncthreads();
    const int gw = F.bx * NWAVES + F.wave, NGW = gridDim.x * NWAVES, lane = F.lane;
    const bf16_t* A = (const bf16_t*)(ws + WS_A); bf16_t* AS = (bf16_t*)(ws + WS_AS);
    for (int m = gw; m < M; m += NGW) {
        const int b = m / T, p = m - b * T, l = p - PADR;
        if (l < 0) continue;
        const int* tk = (const int*)(ws + WS_TOK) + (size_t)m * 8;
        const int ea = tk[0], eb = tk[1], sa = tbl[ea] + tk[4], sb = tbl[eb] + tk[5];
        const u32x4* src = (const u32x4*)(A + (size_t)m * D) + lane;
        const u32x4 x0 = src[0], x1 = src[64];
        u32x4* d0 = (u32x4*)(AS + (size_t)sa * D) + lane; u32x4* d1 = (u32x4*)(AS + (size_t)sb * D) + lane;
        d0[0] = x0; d0[64] = x1; d1[0] = x0; d1[64] = x1;
        if (lane == 0) { int* sl = (int*)(ws + WS_SLOT) + 2 * m; sl[0] = sa; sl[1] = sb;
            float* cw = (float*)(ws + WS_CWS); cw[sa] = __int_as_float(tk[2]); cw[sb] = __int_as_float(tk[3]); }
    }
    __syncthreads();
}

__device__ __forceinline__ void phase_prep(const ArgsL& a, Frame& F, int layer) {
    unsigned char* ws = a.ws;
    LAS float* xs = (LAS float*)F.lds;
    const int wave = F.wave, lane = F.lane, tid = F.tid;
    const int m0 = F.bx * 129;
    const bf16_t* USH = (const bf16_t*)(ws + WS_USH);
    bf16_t* QKV = (bf16_t*)(ws + WS_QKV);
    if (F.bx < 10) {
        const int bh = F.bx, b = bh / 5, h = bh % 5;
        const float* LOGF = (const float*)(ws + WS_LOGF) + (size_t)(b * T + PADR) * 8 + h;
        float* kb = (float*)(ws + WS_KB2) + (size_t)bh * KBP;
        LAS float* wtot = (LAS float*)F.lds;
        float v[33];
        const int l0 = tid * 33;
#pragma unroll
        for (int i = 0; i < 33; ++i) v[i] = (l0 + i < LTOK) ? LOGF[(size_t)(l0 + i) * 8] : 0.f;
#pragma unroll
        for (int i = 1; i < 33; ++i) v[i] += v[i - 1];
        float incl = v[32];
#pragma unroll
        for (int o = 1; o < 64; o <<= 1) { const float t = __shfl_up(incl, o); if (lane >= o) incl += t; }
        if (lane == 63) wtot[wave] = incl;
        __syncthreads();
        float off = incl - v[32];
        for (int w = 0; w < wave; ++w) off += wtot[w];
#pragma unroll
        for (int i = 0; i < 33; ++i) if (l0 + i < LTOK) kb[PADR + l0 + i] = -(off + v[i]) * LOG2E;
        for (int p = tid; p < PADR; p += NTHR) kb[p] = 0.f;
        for (int p = T + tid; p < KBP; p += NTHR) kb[p] = 0.f;
        __syncthreads();
    }
    float w0j = 0.f, a0j = 0.f, kkj = 0.f, kaj = 0.f, rkj = 0.f;
    const int jch = wave * 64 + lane;
    const float* WU = a.in(I_WUP) + (size_t)layer * 64 * RW_W + (wave < 6 ? jch : 0); const float* AU = a.in(I_AUP) + (size_t)layer * 64 * RW_W + (wave < 6 ? jch : 0);
    if (wave < 6) {
        w0j = a.in(I_W0)[layer * RW_W + jch]; a0j = a.in(I_A0)[layer * RW_W + jch];
        kkj = a.in(I_KK)[layer * RW_W + jch]; kaj = a.in(I_KA)[layer * RW_W + jch]; rkj = a.in(I_RK)[layer * RW_W + jch];
    }
    const float* mu = a.in(I_MU) + layer * SHIFT_W;
    const float gq = a.in(I_QG)[layer * 64 + lane] * C2, gk = a.in(I_KG)[layer * 64 + lane];
    _Float16* RW = (_Float16*)(ws + WS_RW);
    bf16_t* BN = (bf16_t*)(ws + WS_BN);
    for (int t0 = 0; t0 < 129; t0 += 16) {
        const int nt = (129 - t0) < 16 ? (129 - t0) : 16;
        for (int item = tid; item < nt * 160; item += NTHR) {
            const int tok = item / 160, ch = item - tok * 160, m = m0 + t0 + tok;
            const u32x4 u = *(const u32x4*)(USH + (size_t)m * SHIFT_W + ch * 8);
            u32x4 pv = (u32x4){0u, 0u, 0u, 0u};
            if (m > 0) pv = *(const u32x4*)(USH + (size_t)(m - 1) * SHIFT_W + ch * 8);
            const f32x4 mu0 = *(const f32x4*)(mu + ch * 8), mu1 = *(const f32x4*)(mu + ch * 8 + 4);
            float x[8];
            { float uu, pp;
              uu = bf_lo(u.x); pp = bf_lo(pv.x); x[0] = uu + (pp - uu) * mu0.x;  uu = bf_hi(u.x); pp = bf_hi(pv.x); x[1] = uu + (pp - uu) * mu0.y;
              uu = bf_lo(u.y); pp = bf_lo(pv.y); x[2] = uu + (pp - uu) * mu0.z;  uu = bf_hi(u.y); pp = bf_hi(pv.y); x[3] = uu + (pp - uu) * mu0.w;
              uu = bf_lo(u.z); pp = bf_lo(pv.z); x[4] = uu + (pp - uu) * mu1.x;  uu = bf_hi(u.z); pp = bf_hi(pv.z); x[5] = uu + (pp - uu) * mu1.y;
              uu = bf_lo(u.w); pp = bf_lo(pv.w); x[6] = uu + (pp - uu) * mu1.z;  uu = bf_hi(u.w); pp = bf_hi(pv.w); x[7] = uu + (pp - uu) * mu1.w; }
            if (ch >= 144 && ch < 152) {
#pragma unroll
                for (int q = 0; q < 8; ++q) { const float e = fast_exp(-2.f * fabsf(x[q])); const float th = (1.f - e) / (1.f + e); x[q] = x[q] < 0.f ? -th : th; }
            }
            LAS f32x4* d = (LAS f32x4*)(xs + tok * SHIFT_W + ch * 8);
            d[0] = (f32x4){x[0], x[1], x[2], x[3]}; d[1] = (f32x4){x[4], x[5], x[6], x[7]};
        }
        __syncthreads();
        if (wave < 6) {
            LAS float* wlb = xs + 16 * SHIFT_W;
            LAS float* alb = wlb + 16 * RW_W;
            {
                const float* wp = WU; asm volatile("" : "+v"(wp) :: "memory");
                float wv[64];
#pragma unroll
                for (int i = 0; i < 64; ++i) wv[i] = wp[i * RW_W];
#pragma unroll 1
                for (int tok = 0; tok < nt; ++tok) { const LAS float* xr = xs + tok * SHIFT_W + 1152; float acc = w0j;
#pragma unroll
                    for (int i = 0; i < 64; i += 4) { const f32x4 t4 = *(const LAS f32x4*)(xr + i); acc += t4.x * wv[i] + t4.y * wv[i + 1] + t4.z * wv[i + 2] + t4.w * wv[i + 3]; }
                    wlb[tok * RW_W + jch] = acc; }
            }
            {
                const float* wp = AU; asm volatile("" : "+v"(wp) :: "memory");
                float wv[64];
#pragma unroll
                for (int i = 0; i < 64; ++i) wv[i] = wp[i * RW_W];
#pragma unroll 1
                for (int tok = 0; tok < nt; ++tok) { const LAS float* xr = xs + tok * SHIFT_W + 1216; float acc = a0j;
#pragma unroll
                    for (int i = 0; i < 64; i += 4) { const f32x4 t4 = *(const LAS f32x4*)(xr + i); acc += t4.x * wv[i] + t4.y * wv[i + 1] + t4.z * wv[i + 2] + t4.w * wv[i + 3]; }
                    alb[tok * RW_W + jch] = acc; }
            }
            asm volatile("" ::: "memory");
#pragma unroll 1
            for (int tok = 0; tok < nt; ++tok) {
                const int m = m0 + t0 + tok, b = m / T, p = m - b * T, l = p - PADR;
                if (l < 0) continue;
                const LAS float* xr = xs + tok * SHIFT_W;
                const float r = xr[jch], k = xr[384 + jch], v = xr[768 + jch];
                const float logw = -softplus_f(-wlb[tok * RW_W + jch]) - 0.5f;
                const float xw = fast_exp(logw);
                const float om = xw < 0.02f ? xw * (1.f - 0.5f * xw + xw * xw * (1.f / 6.f)) : 1.f - fast_exp(-xw);
                const float av = 1.f / (1.f + fast_exp(-alb[tok * RW_W + jch]));
                const float kkr = k * kkj;
                const float nrm = sqrtf(wave_sum(kkr * kkr));
                const float kk = kkr / fmaxf(nrm, 1e-12f);
                const float kp = k * (1.f + (av - 1.f) * kaj);
                const float bb = kk * av;
                const float coef = wave_sum(r * kp * rkj);
                _Float16* o = RW + ((size_t)(b * RW_H + wave) * LPADDED + l) * 384 + lane;
                o[0] = (_Float16)kk; o[64] = (_Float16)(-om); o[128] = (_Float16)(-bb); o[192] = (_Float16)kp; o[256] = (_Float16)r; o[320] = (_Float16)v;
                BN[(size_t)m * RW_W + jch] = f2bf(coef * v);
            }
        } else {
            for (int it = wave - 6; it < nt * 10; it += 2) {
                const int tok = it / 10, hq = it - tok * 10, which = hq / 5, head = hq - which * 5;
                const int m = m0 + t0 + tok, b = m / T, p = m - b * T;
                if (p < PADR) continue;
                bf16_t* q = QKV + (size_t)m * QKV_W + 960 + which * 320 + head * 64 + lane;
                const float x = bf2f(*q);
                const float ss = wave_sum(x * x);
                const float y = x * (1.0f / sqrtf(ss * (1.0f / 64.f) + 1e-6f)) * (which == 0 ? gq : gk);
                *q = f2bf(y);
            }
        }
        __syncthreads();
    }
}

template <int CTRL> __device__ __forceinline__ float dpp_f(float x) { return __int_as_float(__builtin_amdgcn_update_dpp(0, __float_as_int(x), CTRL, 0xF, 0xF, false)); }
__device__ __forceinline__ float allred16(float p) { p += dpp_f<0x128>(p); p += dpp_f<0x124>(p); p += dpp_f<0x122>(p); p += dpp_f<0x121>(p); return p; }

constexpr int SCH = 16;
static_assert(LTOK % SCH == 0, "whole chunks");
__device__ __forceinline__ void rwkv_scan(const ArgsL& a, Frame& F, int wgi, int dry = 0) {
    const int bh = wgi >> 4, q8 = wgi & 15, b = bh / RW_H, h = bh % RW_H;
    const int tid = F.tid, wave = F.wave, lane = F.lane;
    const unsigned char* rw = a.ws + WS_RW + (size_t)bh * LPADDED * 768;
    LAS float* ring = (LAS float*)F.lds;
    LAS float* ypart = (LAS float*)(F.lds + 49152);
    LAS unsigned char* stg = F.lds + 81920;
    bf16_t* y0 = (bf16_t*)(a.ws + WS_YCAT);
    constexpr int NCH = LTOK / SCH;
    const bool isld = (wave & 2) != 0; const int lw = (wave & 1) + ((wave >> 2) << 1), tl = lw * 64 + lane;
    float s0 = 0.f, s1 = 0.f;
    const int i32 = lane & 31, rsel = lane >> 5, rloc = 2 * wave + rsel;
#define RW_BAR() asm volatile("s_waitcnt lgkmcnt(0)\n\ts_barrier" ::: "memory")
#define RW_ISSUE(cc) do { const unsigned char* src_ = rw + (size_t)(cc) * SCH * 768 + (size_t)tl * 16; LAS unsigned char* d_ = stg + ((cc) & 3) * 12288 + lw * 1024; \
        _Pragma("unroll") for (int k_ = 0; k_ < 3; ++k_) __builtin_amdgcn_global_load_lds((const unsigned*)(src_ + k_ * 4096), (LAS unsigned*)(d_ + k_ * 4096), 16, 0, 0); } while (0)
#define RW_CONVERT(cc) do { const LAS unsigned char* s_ = stg + ((cc) & 3) * 12288 + tl * 16; LAS float* rb_ = ring + ((cc) & 1) * 6144; \
        _Pragma("unroll") for (int k_ = 0; k_ < 3; ++k_) { const int pc_ = tl + 256 * k_; const int t_ = pc_ / 48, q_ = pc_ - t_ * 48, vec_ = q_ >> 3, e0_ = (q_ & 7) * 8; \
            const u32x4 w_ = *(const LAS u32x4*)(s_ + k_ * 4096); \
            const f16x4 lo_ = __builtin_bit_cast(f16x4, (u32x2){w_.x, w_.y}), hi_ = __builtin_bit_cast(f16x4, (u32x2){w_.z, w_.w}); \
            const float f0 = (float)lo_.x, f1 = (float)lo_.y, f2 = (float)lo_.z, f3 = (float)lo_.w, f4 = (float)hi_.x, f5 = (float)hi_.y, f6 = (float)hi_.z, f7 = (float)hi_.w; \
            if (vec_ < 4) { LAS float* d_ = rb_ + t_ * 384 + (vec_ >> 1) * 128 + (e0_ >> 1) * 4 + (vec_ & 1) * 2; \
                *(LAS f32x2*)(d_) = (f32x2){f0, f1}; *(LAS f32x2*)(d_ + 4) = (f32x2){f2, f3}; *(LAS f32x2*)(d_ + 8) = (f32x2){f4, f5}; *(LAS f32x2*)(d_ + 12) = (f32x2){f6, f7}; } \
            else { LAS f32x4* d_ = (LAS f32x4*)(rb_ + t_ * 384 + (vec_ == 4 ? 256 : 320) + e0_); d_[0] = (f32x4){f0, f1, f2, f3}; d_[1] = (f32x4){f4, f5, f6, f7}; } } } while (0)
#define RW_STORE_Y(cc) do { if (tl < 32) { const LAS float* yb_ = ypart + ((cc) & 1) * 4096; const int t_ = tl >> 1, pr_ = tl & 1; const int l_ = (cc) * SCH + t_; \
        const LAS f32x4* q_ = (const LAS f32x4*)(yb_ + t_ * 128 + pr_ * 64); f32x4 sa_ = q_[0], sb_ = q_[8]; \
        _Pragma("unroll") for (int k_ = 1; k_ < 8; ++k_) { sa_ = sa_ + q_[k_]; sb_ = sb_ + q_[8 + k_]; } \
        *(unsigned*)(y0 + (size_t)(b * T + PADR + l_) * RW_W + h * 64 + q8 * 4 + 2 * pr_) = pk2((sa_.x + sa_.y) + (sa_.z + sa_.w), (sb_.x + sb_.y) + (sb_.z + sb_.w)); } } while (0)
    if (isld) {
        RW_ISSUE(0); asm volatile("s_waitcnt vmcnt(0)" ::: "memory"); RW_CONVERT(0);
        RW_ISSUE(1); RW_ISSUE(2);
    }
    RW_BAR();
    for (int c = 0; c < NCH; ++c) {
        if (isld) {
            if (c + 2 < NCH) { asm volatile("s_waitcnt vmcnt(3)" ::: "memory"); RW_CONVERT(c + 1); }
            else if (c + 1 < NCH) { asm volatile("s_waitcnt vmcnt(0)" ::: "memory"); RW_CONVERT(c + 1); }
            if (c > 0 && !dry) RW_STORE_Y(c - 1);
            if (c + 3 < NCH) RW_ISSUE(c + 3);
        } else if (dry != 1 && wave < 2) {
            const unsigned ba = (unsigned)(uintptr_t)(ring + (c & 1) * 6144) + i32 * 16, ca = (unsigned)(uintptr_t)(ring + (c & 1) * 6144) + 1024 + i32 * 8,
                           va = (unsigned)(uintptr_t)(ring + (c & 1) * 6144) + 1280 + (q8 * 4 + rloc) * 4, ya = (unsigned)(uintptr_t)(ypart + (c & 1) * 4096 + rloc * 32 + i32);
            f32x4 OA[4], OB[4]; f32x2 OC[4]; float OV[4];
            OC[3] = (f32x2){0.f, 0.f};
#define RW_FETCH(tt, sl) asm volatile("ds_read_b128 %0, %4 offset:%c7\n\tds_read_b128 %1, %4 offset:%c8\n\tds_read_b64 %2, %5 offset:%c7\n\tds_read_b32 %3, %6 offset:%c7" \
                : "=&v"(OA[sl]), "=&v"(OB[sl]), "=&v"(OC[sl]), "=&v"(OV[sl]) : "v"(ba), "v"(ca), "v"(va), "i"((tt) * 1536), "i"((tt) * 1536 + 512) : "memory")
            RW_FETCH(0, 0); RW_FETCH(1, 1);
            float p, p2, y;
#define RW_STEP(t, WAITN, YL1, YL2, YW, FETCHL) asm volatile( \
                "s_waitcnt lgkmcnt(" WAITN ")\n\t" \
                "v_mul_f32 %[p], %[s0], %[kk0]\n\t" \
                "v_fmac_f32 %[p], %[s1], %[kk1]\n\t" \
                YL1 "\n\t" YL2 "\n\t" \
                XL8 "\n\t" \
                "v_fmac_f32 %[s0], %[s0], %[om0]\n\t" \
                "v_fmac_f32 %[s1], %[s1], %[om1]\n\t" \
                XL4 "\n\t" \
                "v_fmac_f32 %[s0], %[vf], %[kv0]\n\t" \
                "v_fmac_f32 %[s1], %[vf], %[kv1]\n\t" \
                XL2 "\n\t" \
                YW "\n\t" \
                FETCHL \
                : [p] "=&v"(p), [p2] "=&v"(p2), [y] "=&v"(y), [s0] "+v"(s0), [s1] "+v"(s1), [nA] "=&v"(OA[((t) + 2) & 3]), [nB] "=&v"(OB[((t) + 2) & 3]), [nC] "=&v"(OC[((t) + 2) & 3]), [nV] "=&v"(OV[((t) + 2) & 3]) \
                : [kk0] "v"(OA[(t) & 3].x), [kk1] "v"(OA[(t) & 3].y), [om0] "v"(OA[(t) & 3].z), [om1] "v"(OA[(t) & 3].w), [bb0] "v"(OB[(t) & 3].x), [bb1] "v"(OB[(t) & 3].y), [kv0] "v"(OB[(t) & 3].z), [kv1] "v"(OB[(t) & 3].w), \
                  [vf] "v"(OV[(t) & 3]), [rp0] "v"(OC[((t) + 3) & 3].x), [rp1] "v"(OC[((t) + 3) & 3].y), [ba] "v"(ba), [ca] "v"(ca), [va] "v"(va), [ya] "v"(ya), \
                  [oa] "i"(((t) + 2) * 1536), [ob] "i"(((t) + 2) * 1536 + 512), [oy] "i"(((t) - 1) * 512) : "memory")
#define RW_YL1 "v_mul_f32 %[y], %[s0], %[rp0]"
#define RW_YL2 "v_fmac_f32 %[y], %[s1], %[rp1]"
#define RW_YW  "ds_write_b32 %[ya], %[y] offset:%c[oy]"
#define RW_NOP "s_nop 0"
#define RW_TAIL_F "ds_read_b128 %[nA], %[ba] offset:%c[oa]\n\t" \
                XL1 "\n\t" \
                "ds_read_b128 %[nB], %[ba] offset:%c[ob]\n\t" \
                "ds_read_b64 %[nC], %[ca] offset:%c[oa]\n\t" \
                "v_mov_b32 %[p2], %[p]\n\t" \
                "ds_read_b32 %[nV], %[va] offset:%c[oa]\n\t" \
                "s_nop 0\n\t" \
                XSW "\n\t" \
                "v_add_f32 %[p], %[p], %[p2]\n\t" \
                "v_fmac_f32 %[s0], %[p], %[bb0]\n\t" \
                "v_fmac_f32 %[s1], %[p], %[bb1]"
#define RW_TAIL_N "s_nop 0\n\t" \
                XL1 "\n\t" \
                "s_nop 1\n\t" \
                "v_mov_b32 %[p2], %[p]\n\t" \
                "s_nop 1\n\t" \
                XSW "\n\t" \
                "v_add_f32 %[p], %[p], %[p2]\n\t" \
                "v_fmac_f32 %[s0], %[p], %[bb0]\n\t" \
                "v_fmac_f32 %[s1], %[p], %[bb1]"
#define RW_ALLSTEPS() do { \
            RW_STEP(0, "4", RW_NOP, RW_NOP, RW_NOP, RW_TAIL_F); \
            RW_STEP(1, "4", RW_YL1, RW_YL2, RW_YW, RW_TAIL_F); \
            RW_STEP(2, "5", RW_YL1, RW_YL2, RW_YW, RW_TAIL_F);  RW_STEP(3, "5", RW_YL1, RW_YL2, RW_YW, RW_TAIL_F);  RW_STEP(4, "5", RW_YL1, RW_YL2, RW_YW, RW_TAIL_F); \
            RW_STEP(5, "5", RW_YL1, RW_YL2, RW_YW, RW_TAIL_F);  RW_STEP(6, "5", RW_YL1, RW_YL2, RW_YW, RW_TAIL_F);  RW_STEP(7, "5", RW_YL1, RW_YL2, RW_YW, RW_TAIL_F); \
            RW_STEP(8, "5", RW_YL1, RW_YL2, RW_YW, RW_TAIL_F);  RW_STEP(9, "5", RW_YL1, RW_YL2, RW_YW, RW_TAIL_F);  RW_STEP(10, "5", RW_YL1, RW_YL2, RW_YW, RW_TAIL_F); \
            RW_STEP(11, "5", RW_YL1, RW_YL2, RW_YW, RW_TAIL_F); RW_STEP(12, "5", RW_YL1, RW_YL2, RW_YW, RW_TAIL_F); RW_STEP(13, "5", RW_YL1, RW_YL2, RW_YW, RW_TAIL_F); \
            RW_STEP(14, "5", RW_YL1, RW_YL2, RW_YW, RW_TAIL_N); \
            RW_STEP(15, "1", RW_YL1, RW_YL2, RW_YW, RW_TAIL_N); \
            asm volatile("v_mul_f32 %[y], %[s0], %[r0]\n\tv_fmac_f32 %[y], %[s1], %[r1]\n\tds_write_b32 %[ya], %[y] offset:7680" : [y] "=&v"(y) : [s0] "v"(s0), [s1] "v"(s1), [r0] "v"(OC[3].x), [r1] "v"(OC[3].y), [ya] "v"(ya) : "memory"); \
 } while (0)
#ifdef SCAN_PROBE_NOXL
            if (dry == 2) {
#define XL8 "v_add_f32 %[p], %[p], %[p]"
#define XL4 "v_add_f32 %[p], %[p], %[p]"
#define XL2 "v_add_f32 %[p], %[p], %[p]"
#define XL1 "v_add_f32 %[p], %[p], %[p]"
#define XSW "v_add_f32 %[p], %[p], %[p2]"
                RW_ALLSTEPS();
#undef XL8
#undef XL4
#undef XL2
#undef XL1
#undef XSW
            } else
#endif
            {
#define XL8 "v_add_f32_dpp %[p], %[p], %[p] row_ror:8 row_mask:0xf bank_mask:0xf bound_ctrl:1"
#define XL4 "v_add_f32_dpp %[p], %[p], %[p] row_ror:4 row_mask:0xf bank_mask:0xf bound_ctrl:1"
#define XL2 "v_add_f32_dpp %[p], %[p], %[p] row_ror:2 row_mask:0xf bank_mask:0xf bound_ctrl:1"
#define XL1 "v_add_f32_dpp %[p], %[p], %[p] row_ror:1 row_mask:0xf bank_mask:0xf bound_ctrl:1"
#define XSW "v_permlane16_swap_b32 %[p], %[p2]"
                RW_ALLSTEPS();
            }
#undef RW_ALLSTEPS
#undef RW_STEP
#undef XL8
#undef XL4
#undef XL2
#undef XL1
#undef XSW
#undef RW_YL1
#undef RW_YL2
#undef RW_YW
#undef RW_NOP
#undef RW_TAIL_F
#undef RW_TAIL_N
#undef RW_FETCH
        }
        RW_BAR();
    }
    if (isld && !dry) RW_STORE_Y(NCH - 1);
    asm volatile("s_waitcnt vmcnt(0) lgkmcnt(0)\n\ts_barrier" ::: "memory");
#undef RW_STORE_Y
#undef RW_ISSUE
#undef RW_CONVERT
#undef RW_BAR
}

__device__ __forceinline__ int crow(int r, int hi) { return (r & 3) + 8 * (r >> 2) + 4 * hi; }
__device__ __forceinline__ void glds16(const void* gsrc, unsigned lds_dst) { unsigned keep;
    asm volatile("s_mov_b32 %0, m0\n\ts_mov_b32 m0, %2\n\ts_nop 0\n\tglobal_load_lds_dwordx4 %1, off\n\ts_mov_b32 m0, %0" : "=&s"(keep) : "v"(gsrc), "s"(lds_dst) : "memory"); }
typedef LAS const char* lds_cptr;
constexpr int FX_K = 0, FX_V = 16384, FX_WS = 32768, FX_OST = 34816, FX_FLG = 67584;

__device__ __forceinline__ void fx_pv(f32x16* o, int vb, bf16x8 pa0, bf16x8 pa1, bf16x8 pa2, bf16x8 pa3) {
#pragma unroll
    for (int d0 = 0; d0 < 2; ++d0) { s16x4 lo[4], hi[4];
#pragma unroll
        for (int ks = 0; ks < 4; ++ks) {
            asm volatile("ds_read_b64_tr_b16 %0,%1 offset:%c2" : "=&v"(lo[ks]) : "v"(vb), "i"(d0 * 4096 + ks * 1024) : "memory");
            asm volatile("ds_read_b64_tr_b16 %0,%1 offset:%c2" : "=&v"(hi[ks]) : "v"(vb), "i"(d0 * 4096 + ks * 1024 + 512) : "memory"); }
        asm volatile("s_waitcnt lgkmcnt(0)" ::: "memory"); __builtin_amdgcn_sched_barrier(0);
#define FX_PK(k) (bf16x8){lo[k][0], lo[k][1], lo[k][2], lo[k][3], hi[k][0], hi[k][1], hi[k][2], hi[k][3]}
        o[d0] = __builtin_amdgcn_mfma_f32_32x32x16_bf16(pa0, FX_PK(0), o[d0], 0, 0, 0);
        o[d0] = __builtin_amdgcn_mfma_f32_32x32x16_bf16(pa1, FX_PK(1), o[d0], 0, 0, 0);
        o[d0] = __builtin_amdgcn_mfma_f32_32x32x16_bf16(pa2, FX_PK(2), o[d0], 0, 0, 0);
        o[d0] = __builtin_amdgcn_mfma_f32_32x32x16_bf16(pa3, FX_PK(3), o[d0], 0, 0, 0);
#undef FX_PK
    }
}
__device__ __forceinline__ float halves_max(float m) { auto rr = __builtin_amdgcn_permlane32_swap(__float_as_uint(m), __float_as_uint(m), false, false); return fmaxf(__uint_as_float(rr[0]), __uint_as_float(rr[1])); }
__device__ __forceinline__ float halves_sum(float m) { auto rr = __builtin_amdgcn_permlane32_swap(__float_as_uint(m), __float_as_uint(m), false, false); return __uint_as_float(rr[0]) + __uint_as_float(rr[1]); }

template <int KIND>
__device__ __forceinline__ void attn_unit(const ArgsL& a, Frame& F, int b, int h, int qb, float bound) {
    const int lane = F.lane, wave = F.wave, r32 = lane & 31, hi = lane >> 5;
    LAS unsigned char* lds = F.lds;
    const bf16_t* QKV = (const bf16_t*)(a.ws + WS_QKV);
    const size_t rowbase = (size_t)b * T;
    const int p0 = qb * 256;
    constexpr int QC = KIND ? 0 : 960, KC = KIND ? 320 : 1280, VC = KIND ? 640 : 1600;
    const bf16_t* Qw = QKV + (rowbase + p0 + wave * 32) * QKV_W + QC + h * 64;
    const bf16_t* Kh = QKV + rowbase * QKV_W + KC + h * 64;
    const bf16_t* Vh = QKV + rowbase * QKV_W + VC + h * 64;
    const float* kbias = (const float*)(a.ws + WS_KB2) + (size_t)(b * FX_H + h) * KBP;
    const unsigned lds0 = (unsigned)(uintptr_t)lds;
    bf16x8 qr[4];
#pragma unroll
    for (int d0 = 0; d0 < 4; ++d0) qr[d0] = *(const bf16x8*)(Qw + (size_t)r32 * QKV_W + d0 * 16 + hi * 8);
    const int qp = p0 + wave * 32 + r32;
    const bool qvalid = (qp >= PADR) && (qp < T);
    const int plast = (p0 + 255) < (T - 1) ? (p0 + 255) : (T - 1);
    const int jlast = plast >> 6, jfirst = PADR >> 6;
    const int jw = (p0 + wave * 32 + 31) >> 6;
    const bf16_t* ksrc = Kh + (size_t)lane * QKV_W + wave * 8;
    const bf16_t* vsrc = Vh + (size_t)(16 * (wave & 3) + (lane >> 2)) * QKV_W + (wave >> 2) * 32 + (lane & 3) * 8;
    const unsigned kdst = lds0 + FX_K + wave * 1024, vdst = lds0 + FX_V + wave * 1024;
#define FX_DMA(j, slot) do { glds16(ksrc + (size_t)(j) * 64 * QKV_W, (unsigned)__builtin_amdgcn_readfirstlane(kdst + (slot) * 8192)); \
                             glds16(vsrc + (size_t)(j) * 64 * QKV_W, (unsigned)__builtin_amdgcn_readfirstlane(vdst + (slot) * 8192)); } while (0)
    const int vb0 = (int)(lds0 + FX_V) + ((lane >> 4) & 1) * 32 + (lane & 3) * 8 + (4 * hi + ((lane & 15) >> 2)) * 64;
    const lds_cptr kp0 = (lds_cptr)lds + FX_K + hi * 1024 + r32 * 16;
    LAS float* wsf = (LAS float*)(lds + FX_WS) + wave * 64;
    LAS float* flg = (LAS float*)(lds + FX_FLG);
    float m_run = KIND ? 0.f : -1.0e30f, l_run = 0.f;
    f32x16 o[2]; o[0] = f32x16{}; o[1] = f32x16{};
    int slot = 0; bool stop = false;
    FX_DMA(jlast, 0);
    for (int j = jlast; j >= jfirst; --j) {
        if (stop) break;
        if (j > jfirst) { FX_DMA(j - 1, slot ^ 1); asm volatile("s_waitcnt vmcnt(2) lgkmcnt(0)\n\ts_barrier" ::: "memory"); }
        else asm volatile("s_waitcnt vmcnt(0) lgkmcnt(0)\n\ts_barrier" ::: "memory");
        if (j <= jw) {
            f32x16 s0v = f32x16{}, s1v = f32x16{};
            const lds_cptr kp = kp0 + slot * 8192;
#pragma unroll
            for (int d0 = 0; d0 < 4; ++d0) {
                const bf16x8 b0 = *(const LAS bf16x8*)(kp + d0 * 2048);
                const bf16x8 b1 = *(const LAS bf16x8*)(kp + d0 * 2048 + 512);
                s0v = __builtin_amdgcn_mfma_f32_32x32x16_bf16(b0, qr[d0], s0v, 0, 0, 0);
                s1v = __builtin_amdgcn_mfma_f32_32x32x16_bf16(b1, qr[d0], s1v, 0, 0, 0);
            }
            const bool edge = (64 * j + 63 >= p0 + wave * 32) || (64 * j < PADR);
            if constexpr (KIND == 0) {
                const float* kbj = kbias + 64 * j + 4 * hi;
#pragma unroll
                for (int g = 0; g < 4; ++g) { const f32x4 t0 = *(const f32x4*)(kbj + 8 * g), t1 = *(const f32x4*)(kbj + 32 + 8 * g);
                    s0v[4 * g] += t0.x; s0v[4 * g + 1] += t0.y; s0v[4 * g + 2] += t0.z; s0v[4 * g + 3] += t0.w;
                    s1v[4 * g] += t1.x; s1v[4 * g + 1] += t1.y; s1v[4 * g + 2] += t1.z; s1v[4 * g + 3] += t1.w; }
                if (edge) {
#pragma unroll
                    for (int r = 0; r < 16; ++r) { const int key = 64 * j + crow(r, hi);
                        if (key > qp || key < PADR) s0v[r] = -INFINITY;
                        if (key + 32 > qp || key + 32 < PADR) s1v[r] = -INFINITY; }
                }
                float rm = fmaxf(s0v[0], s1v[0]);
#pragma unroll
                for (int r = 1; r < 16; ++r) rm = fmaxf(rm, fmaxf(s0v[r], s1v[r]));
                rm = halves_max(rm);
                const float m_new = fmaxf(m_run, rm);
                const float f = __builtin_amdgcn_exp2f(m_run - m_new);
                m_run = m_new;
                float rs = 0.f;
#pragma unroll
                for (int r = 0; r < 16; ++r) { s0v[r] = __builtin_amdgcn_exp2f(s0v[r] - m_new); s1v[r] = __builtin_amdgcn_exp2f(s1v[r] - m_new); rs += s0v[r] + s1v[r]; }
                rs = halves_sum(rs);
                l_run = l_run * f + rs;
                if (!__all(f == 1.0f)) {
                    if (hi == 0) wsf[r32] = f;
                    LDS_WAIT();
#pragma unroll
                    for (int d_ = 0; d_ < 2; ++d_)
#pragma unroll
                        for (int r = 0; r < 16; ++r) o[d_][r] *= wsf[crow(r, hi)];
                }
            } else {
                f32x16 l0, l1;
#pragma unroll
                for (int r = 0; r < 16; ++r) {
                    const float z0 = s0v[r], z1 = s1v[r];
                    float a0 = -(fmaxf(z0, 0.f) + __builtin_amdgcn_logf(1.f + __builtin_amdgcn_exp2f(-fabsf(z0))));
                    float a1 = -(fmaxf(z1, 0.f) + __builtin_amdgcn_logf(1.f + __builtin_amdgcn_exp2f(-fabsf(z1))));
                    if (edge) { const int key = 64 * j + crow(r, hi);
                        if (key >= qp || key < PADR) { a0 = 0.f; s0v[r] = -INFINITY; }
                        if (key + 32 >= qp || key + 32 < PADR) { a1 = 0.f; s1v[r] = -INFINITY; } }
                    l0[r] = a0; l1[r] = a1;
                }
                float A[8], SA[9], SO[9];
#pragma unroll
                for (int g = 0; g < 4; ++g) { A[g] = (l0[4 * g] + l0[4 * g + 1]) + (l0[4 * g + 2] + l0[4 * g + 3]); A[4 + g] = (l1[4 * g] + l1[4 * g + 1]) + (l1[4 * g + 2] + l1[4 * g + 3]); }
                SA[8] = 0.f; SO[8] = 0.f;
#pragma unroll
                for (int g = 7; g >= 0; --g) SA[g] = A[g] + SA[g + 1];
#pragma unroll
                for (int g = 0; g < 8; ++g) { auto rr = __builtin_amdgcn_permlane32_swap(__float_as_uint(SA[g]), __float_as_uint(SA[g]), false, false); SO[g] = __uint_as_float(hi ? rr[0] : rr[1]); }
                const float R = m_run;
#pragma unroll
                for (int g = 0; g < 8; ++g) {
                    const float E = SA[g + 1] + (hi ? SO[g + 1] : SO[g]) + R;
                    if (g < 4) { float t = E;
                        s0v[4 * g + 3] = __builtin_amdgcn_exp2f(s0v[4 * g + 3] + l0[4 * g + 3] + t); t += l0[4 * g + 3];
                        s0v[4 * g + 2] = __builtin_amdgcn_exp2f(s0v[4 * g + 2] + l0[4 * g + 2] + t); t += l0[4 * g + 2];
                        s0v[4 * g + 1] = __builtin_amdgcn_exp2f(s0v[4 * g + 1] + l0[4 * g + 1] + t); t += l0[4 * g + 1];
                        s0v[4 * g + 0] = __builtin_amdgcn_exp2f(s0v[4 * g + 0] + l0[4 * g + 0] + t);
                    } else { const int q = g - 4; float t = E;
                        s1v[4 * q + 3] = __builtin_amdgcn_exp2f(s1v[4 * q + 3] + l1[4 * q + 3] + t); t += l1[4 * q + 3];
                        s1v[4 * q + 2] = __builtin_amdgcn_exp2f(s1v[4 * q + 2] + l1[4 * q + 2] + t); t += l1[4 * q + 2];
                        s1v[4 * q + 1] = __builtin_amdgcn_exp2f(s1v[4 * q + 1] + l1[4 * q + 1] + t); t += l1[4 * q + 1];
                        s1v[4 * q + 0] = __builtin_amdgcn_exp2f(s1v[4 * q + 0] + l1[4 * q + 0] + t);
                    }
                }
                m_run = R + SA[0] + SO[0];
            }
            u32x4 pw0, pw1, pw2, pw3;
            pw0 = (u32x4){pk2(s0v[0], s0v[1]), pk2(s0v[2], s0v[3]), pk2(s0v[4], s0v[5]), pk2(s0v[6], s0v[7])};
            pw1 = (u32x4){pk2(s0v[8], s0v[9]), pk2(s0v[10], s0v[11]), pk2(s0v[12], s0v[13]), pk2(s0v[14], s0v[15])};
            pw2 = (u32x4){pk2(s1v[0], s1v[1]), pk2(s1v[2], s1v[3]), pk2(s1v[4], s1v[5]), pk2(s1v[6], s1v[7])};
            pw3 = (u32x4){pk2(s1v[8], s1v[9]), pk2(s1v[10], s1v[11]), pk2(s1v[12], s1v[13]), pk2(s1v[14], s1v[15])};
            fx_pv(o, vb0 + slot * 8192, __builtin_bit_cast(bf16x8, pw0), __builtin_bit_cast(bf16x8, pw1), __builtin_bit_cast(bf16x8, pw2), __builtin_bit_cast(bf16x8, pw3));
        }
        float mm = qvalid ? m_run : (KIND ? -3.0e38f : 3.0e38f);
#pragma unroll
        for (int off = 1; off < 64; off <<= 1) { const float t = __shfl_xor(mm, off); mm = KIND ? fmaxf(mm, t) : fminf(mm, t); }
        if (lane == 0) flg[(j & 1) * 8 + wave] = mm;
        asm volatile("s_waitcnt lgkmcnt(0)\n\ts_barrier" ::: "memory");
        if (j > jfirst) {
            const f32x4 fa = *(const LAS f32x4*)(flg + (j & 1) * 8), fb = *(const LAS f32x4*)(flg + (j & 1) * 8 + 4);
            if constexpr (KIND == 0) {
                const float mmin = fminf(fminf(fminf(fa.x, fa.y), fminf(fa.z, fa.w)), fminf(fminf(fb.x, fb.y), fminf(fb.z, fb.w)));
                const float kbmax = kbias[64 * (j - 1) + 63];
                stop = (bound + kbmax - mmin) < -150.0f;
            } else {
                const float mmax = fmaxf(fmaxf(fmaxf(fa.x, fa.y), fmaxf(fa.z, fa.w)), fmaxf(fmaxf(fb.x, fb.y), fmaxf(fb.z, fb.w)));
                stop = mmax < -150.0f;
            }
        }
        slot ^= 1;
    }
    asm volatile("s_waitcnt vmcnt(0) lgkmcnt(0)\n\ts_barrier" ::: "memory");
    float rli[16];
    if constexpr (KIND == 0) {
        if (hi == 0) wsf[32 + r32] = l_run;
        LDS_WAIT();
#pragma unroll
        for (int r = 0; r < 16; ++r) rli[r] = __builtin_amdgcn_rcpf(wsf[32 + crow(r, hi)]);
    } else {
#pragma unroll
        for (int r = 0; r < 16; ++r) rli[r] = 1.0f;
    }
    bf16_t* Ow = (bf16_t*)(a.ws + WS_YCAT) + (size_t)(KIND ? 1 : 2) * M * RW_W + (rowbase + p0 + wave * 32) * RW_W + h * 64;
    {
        LAS bf16_t* stg = (LAS bf16_t*)(lds + FX_OST) + wave * 2048;
#pragma unroll
        for (int r = 0; r < 16; ++r) { const int orow = crow(r, hi);
#pragma unroll
            for (int d0 = 0; d0 < 2; ++d0) stg[orow * 64 + d0 * 32 + r32] = f2bf(o[d0][r] * rli[r]); }
        LDS_WAIT();
#pragma unroll
        for (int i = 0; i < 4; ++i) { const int row = i * 8 + (lane >> 3), ch = lane & 7; const u32x4 v = *(const LAS u32x4*)(stg + row * 64 + ch * 8);
            const int pr = p0 + wave * 32 + row;
            if (pr >= PADR && pr < T) *(u32x4*)(Ow + (size_t)row * RW_W + ch * 8) = v; }
    }
    asm volatile("s_waitcnt lgkmcnt(0)\n\ts_barrier" ::: "memory");
#undef FX_DMA
}

constexpr int N_FX_UNITS = 65 * 10, N_SB_UNITS = 65 * 10, N_RW_WG = 192;
#ifndef REP_SCAN
#define REP_SCAN 1
#endif
#ifndef REP_SCAN_DRY
#define REP_SCAN_DRY 0
#endif
#ifndef REP_FOX
#define REP_FOX 1
#endif
#ifndef REP_SB
#define REP_SB 1
#endif
__device__ __forceinline__ void phase_mix(const ArgsL& a, Frame& F, int layer) {
    if (F.bx < N_RW_WG) { int nr = REP_SCAN; asm volatile("" : "+s"(nr)); for (int r = 0; r < nr; ++r) rwkv_scan(a, F, F.bx, (r + 1 < nr) ? REP_SCAN_DRY : 0); }
    float gqm = fabsf(a.in(I_QG)[layer * 64 + F.lane]), gkm = fabsf(a.in(I_KG)[layer * 64 + F.lane]);
#pragma unroll
    for (int off = 1; off < 64; off <<= 1) { gqm = fmaxf(gqm, __shfl_xor(gqm, off)); gkm = fmaxf(gkm, __shfl_xor(gkm, off)); }
    const float bound = 64.0f * C2 * gqm * gkm * 1.02f + 0.5f;
    unsigned* head = (unsigned*)(a.ws + WS_CTL) + CW_QUEUE + 64 * layer;
    for (;;) {
        if (F.tid == 0) F.MISC[16] = __hip_atomic_fetch_add(head, 1u, __ATOMIC_RELAXED, __HIP_MEMORY_SCOPE_AGENT);
        __syncthreads();
        const int u = (int)F.MISC[16];
        __syncthreads();
        if (u >= N_FX_UNITS + N_SB_UNITS) break;
        if (u < N_FX_UNITS) { const int qb = 64 - u / 10, bh = u % 10; int nr = REP_FOX; asm volatile("" : "+s"(nr)); for (int r = 0; r < nr; ++r) attn_unit<0>(a, F, bh / FX_H, bh % FX_H, qb, bound); }
        else { const int v = u - N_FX_UNITS; const int qb = 64 - v / 10, bh = v % 10; int nr = REP_SB; asm volatile("" : "+s"(nr)); for (int r = 0; r < nr; ++r) attn_unit<1>(a, F, bh / SB_H, bh % SB_H, qb, bound); }
    }
}

__device__ __forceinline__ void phase_post(const ArgsL& a, Frame& F, int layer) {
    const int gw = F.bx * NWAVES + F.wave, NGW = gridDim.x * NWAVES, lane = F.lane;
    bf16_t* Y0 = (bf16_t*)(a.ws + WS_YCAT); const bf16_t* BN = (const bf16_t*)(a.ws + WS_BN);
    float lg[6], lb[6];
    { const float* g = a.in(I_LNG) + layer * RW_W + lane; const float* bb = a.in(I_LNB) + layer * RW_W + lane;
#pragma unroll
      for (int hh = 0; hh < 6; ++hh) { lg[hh] = g[hh * 64]; lb[hh] = bb[hh * 64]; } }
    unsigned short yv[6], bv[6], yn[6], bn[6];
    int m = gw;
    if (m < M) {
#pragma unroll
        for (int hh = 0; hh < 6; ++hh) { yv[hh] = Y0[(size_t)m * RW_W + hh * 64 + lane]; bv[hh] = BN[(size_t)m * RW_W + hh * 64 + lane]; }
    }
    for (; m < M; m += NGW) {
        const int mn = m + NGW;
        if (mn < M) {
#pragma unroll
            for (int hh = 0; hh < 6; ++hh) { yn[hh] = Y0[(size_t)mn * RW_W + hh * 64 + lane]; bn[hh] = BN[(size_t)mn * RW_W + hh * 64 + lane]; }
        }
        const int b = m / T, p = m - b * T;
        bf16_t* yp = Y0 + (size_t)m * RW_W + lane;
        if (p < PADR) {
#pragma unroll
            for (int hh = 0; hh < 6; ++hh) yp[hh * 64] = 0;
        } else {
#pragma unroll
            for (int hh = 0; hh < 6; ++hh) {
                const float y = bf2f(yv[hh]);
                const float mean = wave_sum(y) * (1.f / 64.f);
                const float d = y - mean;
                const float var = wave_sum(d * d) * (1.f / 64.f);
                yp[hh * 64] = f2bf(d * (1.0f / sqrtf(var + 64e-5f)) * lg[hh] + lb[hh] + bf2f(bv[hh]));
            }
        }
#pragma unroll
        for (int hh = 0; hh < 6; ++hh) { yv[hh] = yn[hh]; bv[hh] = bn[hh]; }
    }
    for (int it = gw; it < 2 * M; it += NGW) {
        const int sl = it / M, m2 = it - sl * M; const int b = m2 / T, p = m2 - b * T;
        bf16_t* row = Y0 + (size_t)(sl + 1) * M * RW_W + (size_t)m2 * RW_W;
        if (p < PADR) { for (int c = lane; c < RW_W / 2; c += 64) ((unsigned*)row)[c] = 0u; }
        else if (lane < 32) ((unsigned*)(row + 320))[lane] = 0u;
    }
}

struct EpiInproj { static constexpr bool PERM = true, AFTER_DRAIN = false; bf16_t* ush; bf16_t* qkv;
    __device__ __forceinline__ void operator()(const f32x4 (&acc)[2][2][4][2], const pg8::Unit& u, int wr, int wc, int fr, int fq) const {
        asm volatile("" : "+v"(fr), "+v"(fq));
        const int row0 = u.pm * 256 + wr * 64 + fr, colt = u.pn * 256 + wc * 32 + 8 * fq;
#pragma unroll
        for (int ai = 0; ai < 2; ++ai)
#pragma unroll
            for (int m = 0; m < 4; ++m) { const size_t row = (size_t)(row0 + ai * 128 + m * 16);
#pragma unroll
                for (int bj = 0; bj < 2; ++bj) { const int col = colt + bj * 128; const f32x4 v0 = acc[ai][bj][m][0], v1 = acc[ai][bj][m][1];
                    const float sc = (col >= SHIFT_W && col < SHIFT_W + 320) ? C2 : 1.0f;
                    u32x4 w; w.x = pk2(v0[0] * sc, v0[1] * sc); w.y = pk2(v0[2] * sc, v0[3] * sc); w.z = pk2(v1[0] * sc, v1[1] * sc); w.w = pk2(v1[2] * sc, v1[3] * sc);
                    if (col < SHIFT_W) *(u32x4*)(ush + row * SHIFT_W + col) = w;
                    else if (col < SHIFT_W + QKV_W) *(u32x4*)(qkv + row * QKV_W + (col - SHIFT_W)) = w; } }
    }
};
struct EpiGates { static constexpr bool PERM = true, AFTER_DRAIN = false; bf16_t* gates;
    __device__ __forceinline__ void operator()(const f32x4 (&acc)[2][2][4][2], const pg8::Unit& u, int wr, int wc, int fr, int fq) const {
        asm volatile("" : "+v"(fr), "+v"(fq));
        const int row0 = u.pm * 256 + wr * 64 + fr, colt = u.pn * 256 + wc * 32 + 8 * fq;
#pragma unroll
        for (int ai = 0; ai < 2; ++ai)
#pragma unroll
            for (int m = 0; m < 4; ++m) { const size_t row = (size_t)(row0 + ai * 128 + m * 16);
#pragma unroll
                for (int bj = 0; bj < 2; ++bj) { const int col = colt + bj * 128; f32x4 v0 = acc[ai][bj][m][0], v1 = acc[ai][bj][m][1];
#pragma unroll
                    for (int q = 0; q < 4; ++q) { v0[q] = __builtin_amdgcn_rcpf(1.f + __builtin_amdgcn_exp2f(-v0[q] * LOG2E)); v1[q] = __builtin_amdgcn_rcpf(1.f + __builtin_amdgcn_exp2f(-v1[q] * LOG2E)); }
                    u32x4 w; w.x = pk2(v0[0], v0[1]); w.y = pk2(v0[2], v0[3]); w.z = pk2(v1[0], v1[1]); w.w = pk2(v1[2], v1[3]);
                    *(u32x4*)(gates + row * 3072 + col) = w; } }
    }
};
struct EpiMerge { static constexpr bool PERM = true, AFTER_DRAIN = false; const bf16_t* gates; bf16_t* merged;
    __device__ __forceinline__ void operator()(const f32x4 (&acc)[2][2][4][2], const pg8::Unit& u, int wr, int wc, int fr, int fq) const {
        asm volatile("" : "+v"(fr), "+v"(fq));
        const int br = u.pn >> 2, pn = u.pn & 3, pm = u.pm - br * 129;
        const int row0 = pm * 256 + wr * 64 + fr, colt = pn * 256 + wc * 32 + 8 * fq;
#pragma unroll
        for (int ai = 0; ai < 2; ++ai)
#pragma unroll
            for (int m = 0; m < 4; ++m) { const size_t row = (size_t)(row0 + ai * 128 + m * 16);
#pragma unroll
                for (int bj = 0; bj < 2; ++bj) { const int col = colt + bj * 128; const f32x4 v0 = acc[ai][bj][m][0], v1 = acc[ai][bj][m][1];
                    const u32x4 g = *(const u32x4*)(gates + row * 3072 + br * 1024 + col);
                    u32x4* mp = (u32x4*)(merged + row * D + col);
                    u32x4 o = (u32x4){0u, 0u, 0u, 0u};
                    if (br > 0) o = *mp;
                    u32x4 w;
                    w.x = pk2(bf_lo(g.x) * v0[0] + bf_lo(o.x), bf_hi(g.x) * v0[1] + bf_hi(o.x));
                    w.y = pk2(bf_lo(g.y) * v0[2] + bf_lo(o.y), bf_hi(g.y) * v0[3] + bf_hi(o.y));
                    w.z = pk2(bf_lo(g.z) * v1[0] + bf_lo(o.z), bf_hi(g.z) * v1[1] + bf_hi(o.z));
                    w.w = pk2(bf_lo(g.w) * v1[2] + bf_lo(o.w), bf_hi(g.w) * v1[3] + bf_hi(o.w));
                    *mp = w; }
                __builtin_amdgcn_sched_barrier(0); }
    }
};
struct MergeOrder { int G, c, ntau;
    __device__ __forceinline__ bool next(int i, pg8::Unit& u) const { const int it = i / 3, br = i - 3 * it; const long tau = (long)it * G + c; if (tau >= ntau) return false;
        const int t = (int)(tau % 516); u.pm = br * 129 + (t >> 2); u.pn = br * 4 + (t & 3); return true; }
    __device__ __forceinline__ void a_ready(const pg8::Unit&) const {}
    __device__ __forceinline__ void done(const pg8::Unit&) const {}
};
struct EpiOut { static constexpr bool PERM = true, AFTER_DRAIN = false; ArgsL a;
    __device__ __forceinline__ void operator()(const f32x4 (&acc)[2][2][4][2], const pg8::Unit& u, int wr, int wc, int fr, int fq) const {
        asm volatile("" : "+v"(fr), "+v"(fq));
        const int row0 = u.pm * 256 + wr * 64 + fr, colt = u.pn * 256 + wc * 32 + 8 * fq;
#pragma unroll
        for (int ai = 0; ai < 2; ++ai)
#pragma unroll
            for (int m = 0; m < 4; ++m) { const int row = row0 + ai * 128 + m * 16; const int b = row / T, p = row - b * T, l = p - PADR;
                if (l < 0) continue;
                float* hp = hrow(a, b, l);
#pragma unroll
                for (int bj = 0; bj < 2; ++bj) { const int col = colt + bj * 128; f32x4* h4 = (f32x4*)(hp + col);
                    h4[0] = h4[0] + acc[ai][bj][m][0]; h4[1] = h4[1] + acc[ai][bj][m][1]; } }
    }
};
struct MoeOrder { const volatile LAS int* tb; int ntile, npt, G, c, rep;
    __device__ __forceinline__ bool next(int i, pg8::Unit& u) const { long L = (long)i * G + c; if (L >= (long)ntile * npt * rep) return false; L %= (long)ntile * npt;
        const int tau = (int)(L / npt), j = (int)(L - (long)tau * npt); int e = 0;
#pragma unroll
        for (int k = 1; k < 16; ++k) e += (tau >= tb[k]) ? 1 : 0;
        u.pm = tau; u.pn = __builtin_amdgcn_readfirstlane(e) * npt + j; return true; }
    __device__ __forceinline__ void a_ready(const pg8::Unit&) const {}
    __device__ __forceinline__ void done(const pg8::Unit&) const {}
};
struct EpiMoeUp { static constexpr bool PERM = true, AFTER_DRAIN = false; bf16_t* hs;
    __device__ __forceinline__ void operator()(const f32x4 (&acc)[2][2][4][2], const pg8::Unit& u, int wr, int wc, int fr, int fq) const {
        asm volatile("" : "+v"(fr), "+v"(fq));
        const int row0 = u.pm * 256 + wr * 64 + fr, col = (u.pn & 1) * 128 + wc * 32 + 8 * fq;
#pragma unroll
        for (int ai = 0; ai < 2; ++ai)
#pragma unroll
            for (int m = 0; m < 4; ++m) { const size_t row = (size_t)(row0 + ai * 128 + m * 16); float r[8];
#pragma unroll
                for (int n = 0; n < 2; ++n)
#pragma unroll
                    for (int q = 0; q < 4; ++q) { const float gte = acc[ai][0][m][n][q], up = acc[ai][1][m][n][q]; r[4 * n + q] = gte * __builtin_amdgcn_rcpf(1.f + __builtin_amdgcn_exp2f(-gte * LOG2E)) * up; }
                u32x4 w; w.x = pk2(r[0], r[1]); w.y = pk2(r[2], r[3]); w.z = pk2(r[4], r[5]); w.w = pk2(r[6], r[7]);
                *(u32x4*)(hs + row * DEXP + col) = w; }
    }
};
struct EpiMoeDown { static constexpr bool PERM = true, AFTER_DRAIN = false; bf16_t* y; const float* cws;
    __device__ __forceinline__ void operator()(const f32x4 (&acc)[2][2][4][2], const pg8::Unit& u, int wr, int wc, int fr, int fq) const {
        asm volatile("" : "+v"(fr), "+v"(fq));
        const int row0 = u.pm * 256 + wr * 64 + fr, colt = (u.pn & 3) * 256 + wc * 32 + 8 * fq;
#pragma unroll
        for (int ai = 0; ai < 2; ++ai)
#pragma unroll
            for (int m = 0; m < 4; ++m) { const size_t row = (size_t)(row0 + ai * 128 + m * 16); const float cw = cws[row];
#pragma unroll
                for (int bj = 0; bj < 2; ++bj) { const int col = colt + bj * 128; const f32x4 v0 = acc[ai][bj][m][0] * cw, v1 = acc[ai][bj][m][1] * cw;
                    u32x4 w; w.x = pk2(v0[0], v0[1]); w.y = pk2(v0[2], v0[3]); w.z = pk2(v1[0], v1[1]); w.w = pk2(v1[2], v1[3]);
                    *(u32x4*)(y + row * D + col) = w; }
                __builtin_amdgcn_sched_barrier(0); }
    }
};

#ifndef PH_MASK
#define PH_MASK 0xFFFF
#endif
#define PH(k) ((PH_MASK >> (k)) & 1)
#ifndef PROBE_DUP
#define PROBE_DUP 0
#endif
#define DUPN(bit) (((PROBE_DUP >> (bit)) & 1) ? 2 : 1)
#define FRESH() do { asm volatile("" : "+v"(F.tid)); F.lane = F.tid & 63; F.wave = __builtin_amdgcn_readfirstlane(F.tid >> 6); { int bx_ = (int)blockIdx.x; asm volatile("" : "+s"(bx_)); F.bx = bx_; } } while (0)
__global__ void __launch_bounds__(NTHR, 2) hybrid_fwd(Args ka) {
    extern __shared__ __attribute__((aligned(16))) unsigned char lds_raw[];
    Frame F;
    F.lds = (LAS unsigned char*)lds_raw;
    F.MISC = (volatile LAS unsigned*)(F.lds + MISC_OFF);
    F.tid = threadIdx.x; F.lane = F.tid & 63; F.wave = __builtin_amdgcn_readfirstlane(F.tid >> 6); F.bx = (int)blockIdx.x;
    for (int u = F.tid; u < (LDS_BYTES - MISC_OFF) / 4; u += NTHR) ((LAS unsigned*)(F.lds + MISC_OFF))[u] = 0u;
    __syncthreads();
    if (F.tid < 29) { const unsigned long long p = (unsigned long long)ka.in[F.tid]; F.MISC[64 + 2 * F.tid] = (unsigned)p; F.MISC[65 + 2 * F.tid] = (unsigned)(p >> 32); }
    __syncthreads();
    ArgsL a; a.tab = F.MISC + 64; a.out = ka.out; a.ws = ka.ws;
    unsigned char* ws = a.ws;
    XcdBarrier bar = xcd_barrier_post((unsigned*)(ws + WS_CTL) + CW_BAR, F.MISC + 8);
    const int G = (int)gridDim.x, c = (int)blockIdx.x;
    PG8_LAS unsigned char* ring = (PG8_LAS unsigned char*)F.lds;

    for (int layer = 0; layer < DEPTH; ++layer) {
        for (int rep = 0; rep < DUPN(8); ++rep) { FRESH(); if (PH(0)) phase_wconv(a, F, layer); }
        __syncthreads();
        FRESH(); if (PH(1)) phase_norm<1>(a, F, layer);
        xcd_barrier(bar);
        if (PH(2)) {
            pg8::Gemm g{(const bf16_t*)(ws + WS_A), (const bf16_t*)(ws + WS_WIN), M, N1, D}; pg8::StaticOrder S; S.init(M, N1, G, c, DUPN(3));
            EpiInproj E{(bf16_t*)(ws + WS_USH), (bf16_t*)(ws + WS_QKV)};
            pg8::gemm_phase<EpiInproj, pg8::StaticOrder, true, true>(ring, g, S, E);
        }
        xcd_barrier(bar);
        FRESH(); if (PH(3)) phase_prep(a, F, layer);
        xcd_barrier(bar);
        FRESH(); if (PH(4)) phase_mix(a, F, layer);
        xcd_barrier(bar);
        FRESH(); if (PH(5)) phase_post(a, F, layer);
        if (PH(6)) {
            pg8::Gemm g{(const bf16_t*)(ws + WS_A), (const bf16_t*)(ws + WS_WG), M, 3072, D}; pg8::StaticOrder S; S.init(M, 3072, G, c, DUPN(4));
            EpiGates E{(bf16_t*)(ws + WS_GATES)};
            pg8::gemm_phase<EpiGates, pg8::StaticOrder, true, true>(ring, g, S, E);
        }
        xcd_barrier(bar);
        if (PH(7)) {
            int kdim = RW_W; asm volatile("" : "+s"(kdim));
            pg8::Gemm g{(const bf16_t*)(ws + WS_YCAT), (const bf16_t*)(ws + WS_WP), 3 * M, 3072, kdim}; MergeOrder S{G, c, 516 * DUPN(5)};
            EpiMerge E{(const bf16_t*)(ws + WS_GATES), (bf16_t*)(ws + WS_MERGED)};
            pg8::gemm_phase<EpiMerge, MergeOrder, false, true>(ring, g, S, E);
        }
        xcd_barrier(bar);
        if (PH(8)) {
            pg8::Gemm g{(const bf16_t*)(ws + WS_MERGED), (const bf16_t*)(ws + WS_WO), M, D, D}; pg8::StaticOrder S; S.init(M, D, G, c, 1);
            EpiOut E{a};
            pg8::gemm_phase<EpiOut, pg8::StaticOrder, true, true>(ring, g, S, E);
        }
        xcd_barrier(bar);
        FRESH(); if (PH(9)) phase_norm<2>(a, F, layer);
        xcd_barrier(bar);
        for (int rep = 0; rep < DUPN(7); ++rep) { FRESH(); if (PH(10)) phase_route(a, F, layer); }
        xcd_barrier(bar);
        volatile LAS int* tb = (volatile LAS int*)(F.MISC + 32);
        if (F.tid <= 16) { const int* cnt = (const int*)(ws + WS_CTL) + CW_ECNT + 64 * layer; int t = 0;
            for (int e = 0; e < F.tid; ++e) t += (__hip_atomic_load(cnt + e, __ATOMIC_RELAXED, __HIP_MEMORY_SCOPE_AGENT) + 255) >> 8;
            tb[F.tid] = t; }
        __syncthreads();
        const int ntile = tb[16];
        if (PH(11)) {
            pg8::Gemm g{(const bf16_t*)(ws + WS_AS), (const bf16_t*)(ws + WS_WGU), MS, 8192, D}; MoeOrder S{tb, ntile, 2, G, c, DUPN(6)};
            EpiMoeUp E{(bf16_t*)(ws + WS_HS)};
            pg8::gemm_phase<EpiMoeUp, MoeOrder, true, true>(ring, g, S, E);
        }
        xcd_barrier(bar);
        if (PH(12)) {
            int kdim = DEXP; asm volatile("" : "+s"(kdim));
            pg8::Gemm g{(const bf16_t*)(ws + WS_HS), (const bf16_t*)(ws + WS_WD), MS, 16384, kdim}; MoeOrder S{tb, ntile, 4, G, c, DUPN(6)};
            EpiMoeDown E{(bf16_t*)(ws + WS_Y), (const float*)(ws + WS_CWS)};
            pg8::gemm_phase<EpiMoeDown, MoeOrder, true, true>(ring, g, S, E);
        }
        xcd_barrier(bar);
    }
    FRESH(); if (PH(13)) phase_norm<0>(a, F, DEPTH - 1);
#ifdef CLOCK_PROBE
    if (blockIdx.x == 0 && F.wave == 0) {
        float c0 = 1.f, c1 = 2.f, c2 = 3.f, c3 = 4.f, c4 = 5.f, c5 = 6.f, c6 = 7.f, c7 = 8.f;
        for (int i = 0; i < CLOCK_PROBE; ++i) {
            asm volatile("v_fma_f32 %0, %0, %0, %0\n\tv_fma_f32 %1, %1, %1, %1\n\tv_fma_f32 %2, %2, %2, %2\n\tv_fma_f32 %3, %3, %3, %3\n\tv_fma_f32 %4, %4, %4, %4\n\tv_fma_f32 %5, %5, %5, %5\n\tv_fma_f32 %6, %6, %6, %6\n\tv_fma_f32 %7, %7, %7, %7"
                         : "+v"(c0), "+v"(c1), "+v"(c2), "+v"(c3), "+v"(c4), "+v"(c5), "+v"(c6), "+v"(c7));
        }
        asm volatile("" :: "v"(c0), "v"(c1), "v"(c2), "v"(c3), "v"(c4), "v"(c5), "v"(c6), "v"(c7));
    }
#endif
}

extern "C" void kernel_launch(void* const* d_in, const int* in_sizes, int n_in, void* d_out, int out_size, void* d_ws, size_t ws_size, hipStream_t stream) {
    static int ready = 0;
    if (ready == 0) {
        if (n_in != 29 || out_size != NB * SEQ * D || ws_size < WS_END) { fprintf(stderr, "kernel_launch: unexpected problem shape (n_in %d, out %d, ws %zu < %zu)\n", n_in, out_size, ws_size, (size_t)WS_END); ready = -1; return; }
        if (hipFuncSetAttribute((const void*)hybrid_fwd, hipFuncAttributeMaxDynamicSharedMemorySize, LDS_BYTES) != hipSuccess) { fprintf(stderr, "kernel_launch: hipFuncSetAttribute failed\n"); ready = -1; return; }
        int per_cu = 0;
        if (hipOccupancyMaxActiveBlocksPerMultiprocessor(&per_cu, (const void*)hybrid_fwd, NTHR, LDS_BYTES) != hipSuccess || per_cu < 1) fprintf(stderr, "kernel_launch: occupancy query says %d\n", per_cu);
        (void)hipGetLastError();
        ready = 1;
    }
    if (ready < 0) return;
    (void)in_sizes;
    if (hipMemsetAsync((char*)d_ws + WS_CTL, 0, CTL_ZERO_BYTES, stream) != hipSuccess) return;
    Args a{};
    for (int i = 0; i < 29; ++i) a.in[i] = (const float*)d_in[i];
    a.out = (float*)d_out; a.ws = (unsigned char*)d_ws;
    hipLaunchKernelGGL(hybrid_fwd, dim3(256), dim3(NTHR), LDS_BYTES, stream, a);
}
```

```cpp
#include <hip/hip_runtime.h>
#include <hip/hip_bf16.h>
#include <cstdio>
#include <cstdint>

#define GAS __attribute__((address_space(1)))
#define LAS __attribute__((address_space(3)))

namespace pg8 {
#define PG8_LAS __attribute__((address_space(3)))
typedef unsigned short bf16_t;
typedef short bf16x8 __attribute__((ext_vector_type(8)));
typedef float f32x4 __attribute__((ext_vector_type(4)));
typedef unsigned u32x4 __attribute__((ext_vector_type(4)));
constexpr int BM = 256, BK = 64, HALF = 128, HTB = HALF * BK * 2  , STAGE_BYTES = 8 * HTB, NXCD = 8, WGM = 8;

__host__ __device__ __forceinline__ int lds_byte(int r, int c) { const int st = (r >> 4) * 2 + (c >> 5), rr = r & 15, cc = c & 31, ob = rr * 64 + cc * 2; return st * 1024 + (ob ^ (((ob >> 9) & 1) << 5)); }
__host__ __device__ __forceinline__ void stage_rc(int b, int& R, int& C) { const int st = b / 1024, sb = b % 1024, swz = sb ^ (((sb >> 9) & 1) << 5); R = (st >> 1) * 16 + swz / 64; C = (st & 1) * 32 + (swz % 64) / 2; }
__host__ __device__ __forceinline__ int perm32(int rho) { const int n = rho >> 4, i = rho & 15; return 8 * (i >> 2) + 4 * n + (i & 3); }

struct Unit { int pm, pn; };
struct Gemm { const bf16_t* A; const bf16_t* Bt; int M, N, K; };

struct StaticOrder {
    int nM, nN, nwg, G, c, rep;
    __host__ __device__ void init(int M, int N, int G_, int c_, int rep_ = 1) { nM = M / BM; nN = N / BM; nwg = nM * nN; G = G_; c = c_; rep = rep_; }
    __host__ __device__ bool next(int i, Unit& u) const {
        const long L = (long)i * G + c; if (L >= (long)nwg * rep) return false;
        int wgid = (int)(L % nwg); { const int q = nwg / NXCD, r = nwg % NXCD, xcd = wgid % NXCD, off = wgid / NXCD; wgid = (xcd < r ? xcd * (q + 1) : r * (q + 1) + (xcd - r) * q) + off; }
        const int nig = WGM * nN, gid = wgid / nig, fm = gid * WGM, gsz = (nM - fm) < WGM ? (nM - fm) : WGM;
        u.pm = fm + ((wgid % nig) % gsz); u.pn = (wgid % nig) / gsz; return true;
    }
    __device__ __forceinline__ void a_ready(const Unit&) const {}
    __device__ __forceinline__ void done(const Unit&) const {}
};
__device__ __forceinline__ unsigned cvt_pk_bf16(float lo, float hi) { unsigned r; asm volatile("v_cvt_pk_bf16_f32 %0, %1, %2" : "=v"(r) : "v"(lo), "v"(hi)); return r; }
template <class Epi, class Sched, bool ALIGN_EPI = false, bool SP2 = false>
__device__ __forceinline__ void gemm_phase(PG8_LAS unsigned char* lds, const Gemm g, const Sched& S, const Epi& E) {
    int tid_ = threadIdx.x; asm volatile("" : "+v"(tid_));
    const int tid = tid_, wid = __builtin_amdgcn_readfirstlane(tid >> 6), lane = tid & 63, wr = wid >> 2, wc = wid & 3, fr = lane & 15, fq = lane >> 4;
    const int K = g.K, nt = K / BK;
    unsigned voffA[2], voffB[2];
#pragma unroll
    for (int i = 0; i < 2; ++i) { int R, C; stage_rc(tid * 16 + i * 8192, R, C); const int Rb = Epi::PERM ? ((R & ~31) + perm32(R & 31)) : R;
        voffA[i] = (unsigned)(R * K + C) * 2u; voffB[i] = (unsigned)(Rb * K + C) * 2u; }
    const size_t kstep = (size_t)(BK * 2);
    const size_t hstep = (size_t)HALF * K * 2;
    const size_t tstep = 2 * hstep;
    const unsigned ldsw = (unsigned)wid * 1024u;
    const int aoff = lds_byte(wr * 64 + fr, fq * 8), boff = lds_byte(wc * 32 + fr, fq * 8);
#define PG8_SA(b, h) (((b) * 2 + (h)) * HTB)
#define PG8_SB(b, h) ((4 + (b) * 2 + (h)) * HTB)
#define PG8_STAGE(bufoff, gbase, voff) do { _Pragma("unroll") for (int _i = 0; _i < 2; ++_i) \
        __builtin_amdgcn_global_load_lds((const unsigned*)((const char*)(gbase) + (voff)[_i]), (PG8_LAS unsigned*)(lds + (bufoff) + ldsw + _i * 8192), 16, 0, 0); } while (0)
#define PG8_LDA(dst, b, h) do { _Pragma("unroll") for (int m = 0; m < 4; ++m) _Pragma("unroll") for (int k = 0; k < 2; ++k) dst[m][k] = *(const PG8_LAS bf16x8*)(lds + PG8_SA(b, h) + aoff + m * 2048 + k * 1024); } while (0)
#define PG8_LDB(dst, b, h) do { _Pragma("unroll") for (int n = 0; n < 2; ++n) _Pragma("unroll") for (int k = 0; k < 2; ++k) dst[n][k] = *(const PG8_LAS bf16x8*)(lds + PG8_SB(b, h) + boff + n * 2048 + k * 1024); } while (0)
#define PG8_MMA(ai, bj, At, Bt) do { __builtin_amdgcn_s_setprio(1); _Pragma("unroll") for (int m = 0; m < 4; ++m) _Pragma("unroll") for (int n = 0; n < 2; ++n) _Pragma("unroll") for (int k = 0; k < 2; ++k) \
        acc[ai][bj][m][n] = __builtin_amdgcn_mfma_f32_16x16x32_bf16(Bt[n][k], At[m][k], acc[ai][bj][m][n], 0, 0, 0); __builtin_amdgcn_s_setprio(0); } while (0)
#define PG8_WAIT_V(n) asm volatile("s_waitcnt vmcnt(" #n ")" ::: "memory")
#define PG8_WAIT_L(n) asm volatile("s_waitcnt lgkmcnt(" #n ")" ::: "memory")
#define PG8_BAR __builtin_amdgcn_s_barrier()
#define PG8_SCHED __builtin_amdgcn_sched_barrier(0)
    Unit cur, nxt; int ui = 0;
    if (!S.next(0, cur)) return;
    f32x4 acc[2][2][4][2];
#pragma unroll
    for (int a = 0; a < 2; ++a)
#pragma unroll
        for (int b = 0; b < 2; ++b)
#pragma unroll
            for (int m = 0; m < 4; ++m)
#pragma unroll
                for (int n = 0; n < 2; ++n) acc[a][b][m][n] = (f32x4){0.f, 0.f, 0.f, 0.f};
    bf16x8 At[4][2], B0[2][2], B1[2][2];
    const char* cA = (const char*)g.A + (size_t)cur.pm * tstep; const char* cB = (const char*)g.Bt + (size_t)cur.pn * tstep;
    S.a_ready(cur);
    if constexpr (SP2) {
        PG8_STAGE(PG8_SB(0, 0), cB, voffB); PG8_STAGE(PG8_SB(0, 1), cB + hstep, voffB); PG8_STAGE(PG8_SA(0, 0), cA, voffA); PG8_STAGE(PG8_SA(0, 1), cA + hstep, voffA);
        if (wr == 1) PG8_BAR;
        PG8_WAIT_V(2); PG8_BAR;
        PG8_STAGE(PG8_SB(1, 0), cB + kstep, voffB); PG8_STAGE(PG8_SA(1, 0), cA + kstep, voffA); PG8_STAGE(PG8_SB(1, 1), cB + hstep + kstep, voffB);
        PG8_WAIT_V(6); PG8_BAR;
    } else {
        PG8_STAGE(PG8_SB(0, 0), cB, voffB); PG8_STAGE(PG8_SA(0, 0), cA, voffA); PG8_STAGE(PG8_SB(0, 1), cB + hstep, voffB); PG8_STAGE(PG8_SA(0, 1), cA + hstep, voffA);
        if (wr == 1) PG8_BAR;
        PG8_WAIT_V(4); PG8_BAR;
        PG8_STAGE(PG8_SB(1, 0), cB + kstep, voffB); PG8_STAGE(PG8_SA(1, 0), cA + kstep, voffA); PG8_STAGE(PG8_SB(1, 1), cB + hstep + kstep, voffB);
        PG8_WAIT_V(6); PG8_BAR;
    }
    for (;;) {
        const bool has_next = S.next(ui + 1, nxt);
        const char* nA = has_next ? (const char*)g.A + (size_t)nxt.pm * tstep : cA; const char* nB = has_next ? (const char*)g.Bt + (size_t)nxt.pn * tstep : cB;
        for (int t = 0; t < nt; t += 2) {
            const bool last = (t == nt - 2);
            const char* a1 = cA + (size_t)(t + 1) * kstep;
            const char* a2 = last ? nA : cA + (size_t)(t + 2) * kstep; const char* b2 = last ? nB : cB + (size_t)(t + 2) * kstep;
            const char* a3 = a2 + kstep; const char* b3 = b2 + kstep;
            if (last && has_next) S.a_ready(nxt);
            if constexpr (SP2) {
            PG8_LDB(B0, 0, 0); PG8_LDB(B1, 0, 1); PG8_SCHED; PG8_LDA(At, 0, 0); PG8_STAGE(PG8_SA(1, 1), a1 + hstep, voffA);
            PG8_WAIT_V(8); PG8_WAIT_L(0); PG8_BAR; PG8_MMA(0, 0, At, B0); PG8_MMA(0, 1, At, B1); PG8_BAR; PG8_SCHED;
            PG8_LDA(At, 0, 1); PG8_STAGE(PG8_SB(0, 0), b2, voffB); PG8_STAGE(PG8_SB(0, 1), b2 + hstep, voffB); PG8_STAGE(PG8_SA(0, 0), a2, voffA);
            PG8_WAIT_V(8); PG8_WAIT_L(0); PG8_BAR; PG8_MMA(1, 0, At, B0); PG8_MMA(1, 1, At, B1); PG8_BAR; PG8_SCHED;
            PG8_LDB(B0, 1, 0); PG8_LDB(B1, 1, 1); PG8_SCHED; PG8_LDA(At, 1, 0); PG8_STAGE(PG8_SA(0, 1), a2 + hstep, voffA);
            PG8_WAIT_V(8); PG8_WAIT_L(0); PG8_BAR; PG8_MMA(0, 0, At, B0); PG8_MMA(0, 1, At, B1); PG8_BAR; PG8_SCHED;
            PG8_LDA(At, 1, 1); PG8_STAGE(PG8_SB(1, 0), b3, voffB); PG8_STAGE(PG8_SB(1, 1), b3 + hstep, voffB); PG8_STAGE(PG8_SA(1, 0), a3, voffA);
            PG8_WAIT_V(8); PG8_WAIT_L(0); PG8_BAR; PG8_MMA(1, 0, At, B0); PG8_MMA(1, 1, At, B1); PG8_BAR; PG8_SCHED;
            } else {
            PG8_LDB(B0, 0, 0); PG8_SCHED; PG8_LDA(At, 0, 0); PG8_STAGE(PG8_SA(1, 1), a1 + hstep, voffA);
            PG8_WAIT_L(8); PG8_BAR; PG8_WAIT_L(0); PG8_MMA(0, 0, At, B0); PG8_BAR; PG8_SCHED;
            PG8_LDB(B1, 0, 1); PG8_STAGE(PG8_SB(0, 0), b2, voffB);
            PG8_BAR; PG8_WAIT_L(0); PG8_MMA(0, 1, At, B1); PG8_BAR;
            PG8_LDA(At, 0, 1); PG8_STAGE(PG8_SA(0, 0), a2, voffA);
            PG8_BAR; PG8_WAIT_L(0); PG8_MMA(1, 0, At, B0); PG8_BAR; PG8_SCHED;
            PG8_STAGE(PG8_SB(0, 1), b2 + hstep, voffB);
            PG8_WAIT_V(6); PG8_BAR; PG8_MMA(1, 1, At, B1); PG8_BAR;
            PG8_LDB(B0, 1, 0); PG8_SCHED; PG8_LDA(At, 1, 0); PG8_STAGE(PG8_SA(0, 1), a2 + hstep, voffA);
            PG8_WAIT_L(8); PG8_BAR; PG8_WAIT_L(0); PG8_MMA(0, 0, At, B0); PG8_BAR; PG8_SCHED;
            PG8_LDB(B1, 1, 1); PG8_STAGE(PG8_SB(1, 0), b3, voffB);
            PG8_BAR; PG8_WAIT_L(0); PG8_MMA(0, 1, At, B1); PG8_BAR;
            PG8_LDA(At, 1, 1); PG8_STAGE(PG8_SA(1, 0), a3, voffA);
            PG8_BAR; PG8_WAIT_L(0); PG8_MMA(1, 0, At, B0); PG8_BAR; PG8_SCHED;
            PG8_STAGE(PG8_SB(1, 1), b3 + hstep, voffB);
            PG8_WAIT_V(6); PG8_BAR; PG8_MMA(1, 1, At, B1); PG8_BAR;
            }
        }
        if constexpr (ALIGN_EPI) { if (wr == 0) PG8_BAR; }
        if constexpr (!Epi::AFTER_DRAIN) { E(acc, cur, wr, wc, fr, fq); S.done(cur); }
        if (!has_next) break;
#pragma unroll
        for (int a = 0; a < 2; ++a)
#pragma unroll
            for (int b = 0; b < 2; ++b)
#pragma unroll
                for (int m = 0; m < 4; ++m)
#pragma unroll
                    for (int n = 0; n < 2; ++n) acc[a][b][m][n] = (f32x4){0.f, 0.f, 0.f, 0.f};
        cur = nxt; cA = nA; cB = nB; ++ui;
        if constexpr (ALIGN_EPI) { if (wr == 1) PG8_BAR; }
    }
    PG8_WAIT_V(0);
    if constexpr (!ALIGN_EPI) { if (wr == 0) PG8_BAR; }
    PG8_BAR;
    if constexpr (Epi::AFTER_DRAIN) { E.fused(acc, cur, wr, wc, fr, fq, lds, wid, lane); S.done(cur); }
#undef PG8_SA
#undef PG8_SB
#undef PG8_STAGE
#undef PG8_LDA
#undef PG8_LDB
#undef PG8_MMA
#undef PG8_WAIT_V
#undef PG8_WAIT_L
#undef PG8_BAR
#undef PG8_SCHED
}
}

constexpr int D = 1024, NB = 2, SEQ = 16384, NMETA = 16, LTOK = SEQ + NMETA  , PADR = 112, T = PADR + LTOK  ;
constexpr int M = NB * T;
constexpr int DEPTH = 2, HD = 64, RW_H = 6, SB_H = 5, FX_H = 5, RW_W = 384, SHIFT_W = 1280, D_IN = 6277;
constexpr int QKV_W = 1920;
constexpr int N1 = 3328;
constexpr int FCOL = 3200, GCOL = 3205;
constexpr int NEXP = 16, DEXP = 256;
constexpr int MS = 70144;
constexpr int LCH = 32, LPADDED = 16448;
constexpr int KBP = 16896;
constexpr float C2 = 0.125f * 1.4426950408889634f;
constexpr float LOG2E = 1.4426950408889634f;
constexpr int NWAVES = 8, NTHR = 512;

constexpr size_t MiB = 1u << 20;
constexpr size_t WS_CTL = 0, CTL_ZERO_BYTES = 65536;
constexpr size_t WS_HM = 1 * MiB;
constexpr size_t WS_LOGF = WS_HM + 131072;
constexpr size_t WS_KB2 = WS_LOGF + (size_t)M * 32;
constexpr size_t WS_TOK = WS_KB2 + (size_t)10 * KBP * 4;
constexpr size_t WS_SLOT = WS_TOK + (size_t)M * 32;
constexpr size_t WS_CWS = WS_SLOT + (size_t)M * 8;
constexpr size_t WS_WGCNT = WS_CWS + (size_t)MS * 4;
constexpr size_t WS_SMALL_END = WS_WGCNT + 256 * 16 * 4;
static_assert(WS_SMALL_END <= 8 * MiB, "small buffers");
constexpr size_t WS_WIN = 8 * MiB;
constexpr size_t WS_WG = WS_WIN + (size_t)N1 * 1024 * 2;
constexpr size_t WS_WP = WS_WG + (size_t)3072 * 1024 * 2;
constexpr size_t WS_WO = WS_WP + (size_t)3072 * 384 * 2;
constexpr size_t WS_WGU = WS_WO + (size_t)1024 * 1024 * 2;
constexpr size_t WS_WD = WS_WGU + (size_t)8192 * 1024 * 2;
constexpr size_t WS_W_END = WS_WD + (size_t)16384 * 256 * 2;
static_assert(WS_W_END <= 49 * MiB, "weights");
constexpr size_t WS_A = 49 * MiB;
constexpr size_t WS_BIG = 115 * MiB;
constexpr size_t WS_USH = WS_BIG;
constexpr size_t WS_YCAT = WS_BIG;
constexpr size_t WS_QKV = WS_BIG + 82 * MiB;
constexpr size_t WS_RW = WS_BIG + 204 * MiB;
constexpr size_t WS_BN = WS_BIG + 349 * MiB;
constexpr size_t WS_GATES = WS_BIG + 82 * MiB;
constexpr size_t WS_MERGED = WS_BIG + 276 * MiB;
constexpr size_t WS_AS = WS_BIG;
constexpr size_t WS_HS = WS_BIG + 137 * MiB;
constexpr size_t WS_Y = WS_BIG + 172 * MiB;
constexpr size_t WS_END = WS_BIG + 374 * MiB;
static_assert((size_t)(M + 256) * 1280 * 2 <= 82 * MiB && (size_t)3 * M * 384 * 2 <= 82 * MiB && (size_t)(M + 256) * 1920 * 2 <= 122 * MiB, "big map 1");
static_assert((size_t)12 * LPADDED * 768 <= 145 * MiB && (size_t)M * 384 * 2 <= 25 * MiB && (size_t)M * 3072 * 2 <= 194 * MiB && (size_t)M * 2048 <= 65 * MiB, "big map 2");
static_assert((size_t)MS * 2048 <= 137 * MiB && (size_t)MS * 512 <= 35 * MiB && WS_END <= 489 * MiB, "big map 3");

constexpr int CW_BAR = 0;
constexpr int CW_QUEUE = 4096;
constexpr int CW_ECNT = 4352;
static_assert((CW_ECNT + 128) * 4 <= (int)CTL_ZERO_BYTES, "ctl");

constexpr int RING_BYTES = 131072, MISC_OFF = RING_BYTES, LDS_BYTES = 147456;

typedef unsigned short bf16_t;
typedef float f32x4 __attribute__((ext_vector_type(4)));
typedef float f32x2 __attribute__((ext_vector_type(2)));
typedef float f32x16 __attribute__((ext_vector_type(16)));
typedef unsigned u32x4 __attribute__((ext_vector_type(4)));
typedef unsigned u32x2 __attribute__((ext_vector_type(2)));
typedef short bf16x8 __attribute__((ext_vector_type(8)));
typedef short s16x4 __attribute__((ext_vector_type(4)));
typedef _Float16 f16x4 __attribute__((ext_vector_type(4)));
typedef __bf16 bf16x2_t __attribute__((ext_vector_type(2)));

__device__ __forceinline__ unsigned pk2(float lo, float hi) { f32x2 v = {lo, hi}; bf16x2_t b = __builtin_convertvector(v, bf16x2_t); return __builtin_bit_cast(unsigned, b); }
__device__ __forceinline__ unsigned short f2bf(float f) { return (unsigned short)(pk2(f, 0.f) & 0xffffu); }
__device__ __forceinline__ float bf_lo(unsigned u) { return __uint_as_float(u << 16); }
__device__ __forceinline__ float bf_hi(unsigned u) { return __uint_as_float(u & 0xffff0000u); }
__device__ __forceinline__ float bf2f(unsigned short h) { return __uint_as_float((unsigned)h << 16); }
template <int CTRL> __device__ __forceinline__ float dpp_f(float x) { return __int_as_float(__builtin_amdgcn_update_dpp(0, __float_as_int(x), CTRL, 0xF, 0xF, false)); }
__device__ __forceinline__ float allred16(float p) { p += dpp_f<0x128>(p); p += dpp_f<0x124>(p); p += dpp_f<0x122>(p); p += dpp_f<0x121>(p); return p; }
__device__ __forceinline__ float wave_sum(float v) {
    v = allred16(v);
    { auto sw = __builtin_amdgcn_permlane16_swap(__float_as_uint(v), __float_as_uint(v), false, false); v = __uint_as_float(sw[0]) + __uint_as_float(sw[1]); }
    { auto sw = __builtin_amdgcn_permlane32_swap(__float_as_uint(v), __float_as_uint(v), false, false); v = __uint_as_float(sw[0]) + __uint_as_float(sw[1]); }
    return v;
}
__device__ __forceinline__ float fast_exp(float x) { return __builtin_amdgcn_exp2f(x * LOG2E); }
__device__ __forceinline__ float fast_log(float x) { return __builtin_amdgcn_logf(x) * 0.6931471805599453f; }
__device__ __forceinline__ float softplus_f(float z) { return fmaxf(z, 0.f) + fast_log(1.f + fast_exp(-fabsf(z))); }

#define XB_TMO      128
#define XB_XCNT(j)  (256  + 64 * (j))
#define XB_XSUB(j)  (1280 + 64 * (j))
#define XB_XGEN(j)  (2304 + 64 * (j))
#define XB_TOP      3328
#define XB_TOPGEN   3392
#define XCD_BAR_WORDS 3456
#define XB_SPIN_CAP (1u << 20)
__device__ __forceinline__ unsigned xb_ld(unsigned* p)              { return __hip_atomic_load(p, __ATOMIC_RELAXED, __HIP_MEMORY_SCOPE_AGENT); }
__device__ __forceinline__ unsigned xb_add(unsigned* p, unsigned v) { return __hip_atomic_fetch_add(p, v, __ATOMIC_RELAXED, __HIP_MEMORY_SCOPE_AGENT); }
__device__ __forceinline__ unsigned xb_xcc_id() { return (unsigned)__builtin_amdgcn_s_getreg((3 << 11) | 20) & 0xFu; }
#define XB_SPIN(cond, bar) do { unsigned _sp = 0; while (cond) { __builtin_amdgcn_s_sleep(1); \
    if ((++_sp & 255u) == 0u) { if (xb_ld(&(bar)[XB_TMO])) break; if (_sp > XB_SPIN_CAP) { atomicAdd(&(bar)[XB_TMO], 1u); break; } } } } while (0)

struct XcdBarrier {
    unsigned* bar; unsigned x;
    volatile LAS unsigned* st;
};

__device__ __forceinline__ XcdBarrier xcd_barrier_post(unsigned* bar, volatile LAS unsigned* st) {
    XcdBarrier b; b.bar = bar; b.x = xb_xcc_id(); b.st = st;
    if (threadIdx.x == 0) (void)xb_add(&bar[XB_XCNT(b.x)], 1u);
    return b;
}
__device__ __forceinline__ void xcd_barrier_complete(unsigned* bar, unsigned x, unsigned& nloc, unsigned& nx) {
    const unsigned G = gridDim.x * gridDim.y * gridDim.z;
    unsigned sum, cnt, mine, sp = 0u;
    for (;;) {
        sum = 0u; cnt = 0u; mine = 0u;
#pragma unroll
        for (unsigned j = 0; j < 16; ++j) { const unsigned c = xb_ld(&bar[XB_XCNT(j)]); sum += c; cnt += (c > 0u) ? 1u : 0u; mine = (j == x) ? c : mine; }
        if (sum == G) break;
        __builtin_amdgcn_s_sleep(1);
        if ((++sp & 255u) == 0u) { if (xb_ld(&bar[XB_TMO])) break; if (sp > XB_SPIN_CAP) { atomicAdd(&bar[XB_TMO], 1u); break; } }
    }
    nloc = mine > 0u ? mine : 1u; nx = cnt > 0u ? cnt : 1u;
}

__device__ __forceinline__ void xcd_barrier(const XcdBarrier& b) {
    asm volatile("s_waitcnt vmcnt(0)" ::: "memory");
    __syncthreads();
    if (threadIdx.x == 0) {
        unsigned* bar = b.bar;
        __builtin_amdgcn_s_waitcnt(0);
        unsigned nloc = b.st[0], nx = b.st[1];
        if (nloc == 0u) { xcd_barrier_complete(bar, b.x, nloc, nx); b.st[0] = nloc; b.st[1] = nx; }
        const unsigned old = xb_add(&bar[XB_XSUB(b.x)], 1u);
        const unsigned gen = old / nloc;
        if (old + 1u == (gen + 1u) * nloc) {
            __builtin_amdgcn_fence(__ATOMIC_RELEASE, "agent");
            asm volatile("s_waitcnt vmcnt(0)" ::: "memory");
            const unsigned og = xb_add(&bar[XB_TOP], 1u);
            const unsigned tg = og / nx;
            if (og + 1u == (tg + 1u) * nx) xb_add(&bar[XB_TOPGEN], 1u);
            else XB_SPIN(xb_ld(&bar[XB_TOPGEN]) == tg, bar);
            __builtin_amdgcn_fence(__ATOMIC_ACQUIRE, "agent");
            xb_add(&bar[XB_XGEN(b.x)], 1u);
            asm volatile("s_waitcnt vmcnt(0)" ::: "memory");
        } else {
            XB_SPIN(xb_ld(&bar[XB_XGEN(b.x)]) == gen, bar);
            __builtin_amdgcn_fence(__ATOMIC_ACQUIRE, "agent");
            asm volatile("s_waitcnt vmcnt(0)" ::: "memory");
        }
    }
    __syncthreads();
}

struct Args { const float* in[29]; float* out; unsigned char* ws; };
enum { I_X = 0, I_META, I_N1G, I_WIN, I_MU, I_WUP, I_W0, I_AUP, I_A0, I_KK, I_KA, I_RK, I_LNG, I_LNB, I_FB, I_QG, I_KG, I_WPR, I_WPS, I_WPF, I_WOUT, I_N2G, I_MWG, I_MBG, I_MWE, I_MBE, I_MGATE, I_MUP, I_MDOWN };
struct ArgsL { volatile LAS unsigned* tab; float* out; unsigned char* ws;
    __device__ __forceinline__ const float* in(int i) const { const unsigned lo = tab[2 * i], hi = tab[2 * i + 1];
        return (const float*)(((unsigned long long)(unsigned)__builtin_amdgcn_readfirstlane((int)hi) << 32) | (unsigned long long)(unsigned)__builtin_amdgcn_readfirstlane((int)lo)); }
};
struct Frame { LAS unsigned char* lds; volatile LAS unsigned* MISC; int tid, lane, wave, bx; };

__device__ __forceinline__ float* hrow(const ArgsL& a, int b, int l) {
    return l < NMETA ? (float*)(a.ws + WS_HM) + (size_t)(b * NMETA + l) * D : a.out + ((size_t)b * SEQ + (l - NMETA)) * D;
}
#define LDS_WAIT() asm volatile("s_waitcnt lgkmcnt(0)" ::: "memory")

__device__ __forceinline__ void tr_item(const float* W, int ldw, int sc0, int nvalid, int k0, int kvalid, bf16_t* WT, int Kd, int r0, LAS float* scr, int lane) {
    float tv[32];
#pragma unroll
    for (int i = 0; i < 32; ++i) { const int kk = 2 * i + (lane >> 5), n = lane & 31; tv[i] = 0.f;
        if (n < nvalid && k0 + kk < kvalid) tv[i] = W[(size_t)(k0 + kk) * ldw + sc0 + n]; }
#pragma unroll
    for (int i = 0; i < 32; ++i) { const int kk = 2 * i + (lane >> 5), n = lane & 31; scr[kk * 33 + n] = tv[i]; }
    LDS_WAIT();
    const int c = lane & 7;
#pragma unroll
    for (int j = 0; j < 4; ++j) { const int n = (lane >> 3) + 8 * j; const LAS float* s = scr + (8 * c) * 33 + n;
        u32x4 o; o.x = pk2(s[0 * 33], s[1 * 33]); o.y = pk2(s[2 * 33], s[3 * 33]); o.z = pk2(s[4 * 33], s[5 * 33]); o.w = pk2(s[6 * 33], s[7 * 33]);
        *(u32x4*)(WT + (size_t)(r0 + n) * Kd + k0 + 8 * c) = o; }
    LDS_WAIT();
}
__device__ __forceinline__ void phase_wconv(const ArgsL& a, Frame& F, int layer) {
    LAS float* scr = (LAS float*)(F.lds + F.wave * 8448);
    const int gw = F.bx * NWAVES + F.wave, NGW = gridDim.x * NWAVES;
    constexpr int C1 = 16 * 104, C2_ = C1 + 16 * 96, C3 = C2_ + 6 * 96, C4 = C3 + 16 * 32, C5 = C4 + 16 * 256, C6 = C5 + 4 * 512;
    unsigned char* ws = a.ws;
    for (int it = gw; it < C6; it += NGW) {
        if (it < C1) { const int kb = it / 104, nb = it % 104, r0 = nb * 32;
            tr_item(a.in(I_WIN) + (size_t)layer * D * D_IN, D_IN, r0, r0 < FCOL ? 32 : 0, kb * 64, 1024, (bf16_t*)(ws + WS_WIN), 1024, r0, scr, F.lane); }
        else if (it < C2_) { const int r = it - C1, kb = r / 96, nb = r % 96, r0 = nb * 32;
            tr_item(a.in(I_WIN) + (size_t)layer * D * D_IN, D_IN, GCOL + r0, 32, kb * 64, 1024, (bf16_t*)(ws + WS_WG), 1024, r0, scr, F.lane); }
        else if (it < C3) { const int r = it - C2_, kb = r / 96, nb = r % 96, r0 = nb * 32, br = r0 >> 10;
            const float* W = (br == 0 ? a.in(I_WPR) + (size_t)layer * 384 * D : br == 1 ? a.in(I_WPS) + (size_t)layer * 320 * D : a.in(I_WPF) + (size_t)layer * 320 * D);
            tr_item(W, D, r0 & 1023, 32, kb * 64, br == 0 ? 384 : 320, (bf16_t*)(ws + WS_WP), 384, r0, scr, F.lane); }
        else if (it < C4) { const int r = it - C3, kb = r / 32, nb = r % 32, r0 = nb * 32;
            tr_item(a.in(I_WOUT) + (size_t)layer * D * D, D, r0, 32, kb * 64, 1024, (bf16_t*)(ws + WS_WO), 1024, r0, scr, F.lane); }
        else if (it < C5) { const int r = it - C4, kb = r / 256, nb = r % 256, r0 = nb * 32, e = r0 >> 9, rr = r0 & 511, j = rr >> 8, q = rr & 255;
            const float* W = (q >= 128 ? a.in(I_MUP) : a.in(I_MGATE)) + ((size_t)layer * NEXP + e) * D * DEXP;
            tr_item(W, DEXP, j * 128 + (q & 127), 32, kb * 64, 1024, (bf16_t*)(ws + WS_WGU), 1024, r0, scr, F.lane); }
        else { const int r = it - C5, kb = r / 512, nb = r % 512, r0 = nb * 32, e = r0 >> 10;
            tr_item(a.in(I_MDOWN) + ((size_t)layer * NEXP + e) * DEXP * D, D, r0 & 1023, 32, kb * 64, 256, (bf16_t*)(ws + WS_WD), 256, r0, scr, F.lane); }
    }
}

__device__ __forceinline__ void add_y_row(f32x4 (&v)[4], const bf16_t* Y, int slot, int lane) {
    const u32x2* y = (const u32x2*)(Y + (size_t)slot * D) + lane;
#pragma unroll
    for (int j = 0; j < 4; ++j) { const u32x2 t = y[64 * j]; v[j].x += bf_lo(t.x); v[j].y += bf_hi(t.x); v[j].z += bf_lo(t.y); v[j].w += bf_hi(t.y); }
}
template <int MODE>
__device__ __forceinline__ void phase_norm(const ArgsL& a, Frame& F, int layer) {
    const int lane = F.lane;
    LAS float* wl = (LAS float*)F.lds;
    LAS int* lcnt = (LAS int*)(F.lds + 20 * 4096);
    unsigned char* ws = a.ws;
    if (MODE == 1) {
        const float* win = a.in(I_WIN) + (size_t)layer * D * D_IN;
        for (int idx = F.tid; idx < 5 * 1024; idx += NTHR) { const int k = idx / 5, j = idx % 5; wl[j * 1024 + k] = win[(size_t)k * D_IN + FCOL + j]; }
    }
    if (MODE == 2) {
        const float* wg = a.in(I_MWG) + (size_t)layer * D * 4; const float* we = a.in(I_MWE) + (size_t)layer * D * 16;
        for (int idx = F.tid; idx < 4 * 1024; idx += NTHR) { const int k = idx >> 2, j = idx & 3; wl[j * 1024 + k] = wg[idx]; }
        for (int idx = F.tid; idx < 16 * 1024; idx += NTHR) { const int k = idx >> 4, j = idx & 15; wl[(4 + j) * 1024 + k] = we[idx]; }
        if (F.tid < 16) lcnt[F.tid] = 0;
    }
    __syncthreads();
    const int gw = F.bx * NWAVES + F.wave, NGW = gridDim.x * NWAVES;
    const float* gsrc = (MODE == 2 ? a.in(I_N2G) : a.in(I_N1G)) + layer * D;
    f32x4 gv[4];
#pragma unroll
    for (int j = 0; j < 4; ++j) gv[j] = (MODE == 0) ? (f32x4){0.f, 0.f, 0.f, 0.f} : *(const f32x4*)(gsrc + 4 * lane + 256 * j);
    bf16_t* A = (bf16_t*)(ws + WS_A);
    const bf16_t* Y = (const bf16_t*)(ws + WS_Y);
    const int* SLOT = (const int*)(ws + WS_SLOT);
    constexpr bool COMB0 = (MODE == 0);
    const bool comb = COMB0 || (MODE == 1 && layer > 0);
    f32x4 vn[4]; u32x2 yan[4], ybn[4];
#pragma unroll
    for (int j = 0; j < 4; ++j) { vn[j] = (f32x4){0.f, 0.f, 0.f, 0.f}; yan[j] = (u32x2){0u, 0u}; ybn[j] = (u32x2){0u, 0u}; }
#define NRM_VALID(mm) ((mm) < M && ((mm) % T) - PADR >= (MODE == 0 ? NMETA : 0))
#define NRM_SRC(mm, bb_, ll_) ((MODE == 1 && layer == 0) ? ((ll_) < NMETA ? a.in(I_META) + (size_t)(ll_) * D : a.in(I_X) + ((size_t)(bb_) * SEQ + ((ll_) - NMETA)) * D) : (const float*)hrow(a, bb_, ll_))
#define NRM_LOAD(mm, s0_, s1_) do { if (NRM_VALID(mm)) { const int bb_ = (mm) / T, ll_ = (mm) - bb_ * T - PADR; const float* src_ = NRM_SRC(mm, bb_, ll_); \
        _Pragma("unroll") for (int j = 0; j < 4; ++j) vn[j] = *(const f32x4*)(src_ + 4 * lane + 256 * j); \
        if (comb) { const u32x2* y0_ = (const u32x2*)(Y + (size_t)(s0_) * D) + lane; const u32x2* y1_ = (const u32x2*)(Y + (size_t)(s1_) * D) + lane; \
            _Pragma("unroll") for (int j = 0; j < 4; ++j) { yan[j] = y0_[64 * j]; ybn[j] = y1_[64 * j]; } } } } while (0)
    int sa1 = 0, sb1 = 0, sa2 = 0, sb2 = 0;
    if (comb) { if (NRM_VALID(gw)) { sa1 = SLOT[2 * gw]; sb1 = SLOT[2 * gw + 1]; } if (NRM_VALID(gw + NGW)) { sa2 = SLOT[2 * (gw + NGW)]; sb2 = SLOT[2 * (gw + NGW) + 1]; } }
    NRM_LOAD(gw, sa1, sb1);
    for (int m = gw; m < M; m += NGW) {
        f32x4 v[4]; u32x2 ya[4], yb[4];
#pragma unroll
        for (int j = 0; j < 4; ++j) { v[j] = vn[j]; ya[j] = yan[j]; yb[j] = ybn[j]; }
        int sa3 = 0, sb3 = 0;
        if (comb && NRM_VALID(m + 2 * NGW)) { sa3 = SLOT[2 * (m + 2 * NGW)]; sb3 = SLOT[2 * (m + 2 * NGW) + 1]; }
        NRM_LOAD(m + NGW, sa2, sb2);
        sa2 = sa3; sb2 = sb3;
        const int b = m / T, p = m - b * T, l = p - PADR;
        if (l < 0) {
            if (MODE == 1) {
                u32x2* o = (u32x2*)(A + (size_t)m * D) + lane;
#pragma unroll
                for (int j = 0; j < 4; ++j) o[64 * j] = (u32x2){0u, 0u};
                if (lane < 8) ((float*)(ws + WS_LOGF))[(size_t)m * 8 + lane] = 0.f;
            }
            continue;
        }
        if (MODE == 0 && l < NMETA) continue;
        float* hp = hrow(a, b, l);
        if (comb) {
#pragma unroll
            for (int j = 0; j < 4; ++j) { v[j].x += bf_lo(ya[j].x) + bf_lo(yb[j].x); v[j].y += bf_hi(ya[j].x) + bf_hi(yb[j].x); v[j].z += bf_lo(ya[j].y) + bf_lo(yb[j].y); v[j].w += bf_hi(ya[j].y) + bf_hi(yb[j].y); }
        }
        if (MODE == 0 || MODE == 1) {
#pragma unroll
            for (int j = 0; j < 4; ++j) *(f32x4*)(hp + 4 * lane + 256 * j) = v[j];
        }
        if (MODE == 0) continue;
        float ss = 0.f;
#pragma unroll
        for (int j = 0; j < 4; ++j) ss += (v[j].x * v[j].x + v[j].y * v[j].y) + (v[j].z * v[j].z + v[j].w * v[j].w);
        const float r = 1.0f / sqrtf(wave_sum(ss) * (1.0f / D) + 1e-6f);
#pragma unroll
        for (int j = 0; j < 4; ++j) v[j] = v[j] * r * gv[j];
        u32x2* o = (u32x2*)(A + (size_t)m * D) + lane;
#pragma unroll
        for (int j = 0; j < 4; ++j) o[64 * j] = (u32x2){pk2(v[j].x, v[j].y), pk2(v[j].z, v[j].w)};
        if (MODE == 1) {
            float dsum[5];
#pragma unroll
            for (int q = 0; q < 5; ++q) { float d = 0.f;
#pragma unroll
                for (int j = 0; j < 4; ++j) { const f32x4 w = *(const LAS f32x4*)(wl + q * 1024 + 4 * lane + 256 * j); d += (v[j].x * w.x + v[j].y * w.y) + (v[j].z * w.z + v[j].w * w.w); }
                dsum[q] = wave_sum(d); }
            float mine = dsum[0];
            mine = lane == 1 ? dsum[1] : mine; mine = lane == 2 ? dsum[2] : mine; mine = lane == 3 ? dsum[3] : mine; mine = lane == 4 ? dsum[4] : mine;
            if (lane < 8) { float lf = 0.f;
                if (lane < 5) { const float xx = mine + a.in(I_FB)[layer * 5 + lane]; lf = fminf(xx, 0.f) - fast_log(1.f + fast_exp(-fabsf(xx))); }
                ((float*)(ws + WS_LOGF))[(size_t)m * 8 + lane] = lf; }
        }
        if (MODE == 2) {
            float ds[20];
#pragma unroll
            for (int q = 0; q < 20; ++q) { float d = 0.f;
#pragma unroll
                for (int j = 0; j < 4; ++j) { const f32x4 w = *(const LAS f32x4*)(wl + q * 1024 + 4 * lane + 256 * j); d += (v[j].x * w.x + v[j].y * w.y) + (v[j].z * w.z + v[j].w * w.w); }
                ds[q] = wave_sum(d); }
            const float* bg = a.in(I_MBG) + layer * 4; const float* be = a.in(I_MBE) + layer * 16;
            float lg0 = ds[0] + bg[0], lg1 = ds[1] + bg[1], lg2 = ds[2] + bg[2], lg3 = ds[3] + bg[3];
            int g = 0; float mx = lg0;
            if (lg1 > mx) { mx = lg1; g = 1; } if (lg2 > mx) { mx = lg2; g = 2; } if (lg3 > mx) { mx = lg3; g = 3; }
            const float den = fast_exp(lg0 - mx) + fast_exp(lg1 - mx) + fast_exp(lg2 - mx) + fast_exp(lg3 - mx);
            const float pgrp = 1.0f / den;
            float s0 = g == 0 ? ds[4] : g == 1 ? ds[8] : g == 2 ? ds[12] : ds[16];
            float s1 = g == 0 ? ds[5] : g == 1 ? ds[9] : g == 2 ? ds[13] : ds[17];
            float s2 = g == 0 ? ds[6] : g == 1 ? ds[10] : g == 2 ? ds[14] : ds[18];
            float s3 = g == 0 ? ds[7] : g == 1 ? ds[11] : g == 2 ? ds[15] : ds[19];
            s0 += be[g * 4 + 0]; s1 += be[g * 4 + 1]; s2 += be[g * 4 + 2]; s3 += be[g * 4 + 3];
            int i0 = 0; float v0 = s0;
            if (s1 > v0) { v0 = s1; i0 = 1; } if (s2 > v0) { v0 = s2; i0 = 2; } if (s3 > v0) { v0 = s3; i0 = 3; }
            int i1 = -1; float v1 = -3.0e38f;
            if (i0 != 0 && s0 > v1) { v1 = s0; i1 = 0; } if (i0 != 1 && s1 > v1) { v1 = s1; i1 = 1; } if (i0 != 2 && s2 > v1) { v1 = s2; i1 = 2; } if (i0 != 3 && s3 > v1) { v1 = s3; i1 = 3; }
            const float e1 = fast_exp(v1 - v0), pt0 = 1.0f / (1.0f + e1), pt1 = e1 * pt0;
            if (lane == 0) {
                const int ea = g * 4 + i0, eb = g * 4 + i1;
                const int la = atomicAdd((int*)&lcnt[ea], 1), lb = atomicAdd((int*)&lcnt[eb], 1);
                int* tk = (int*)(ws + WS_TOK) + (size_t)m * 8;
                tk[0] = ea; tk[1] = eb; tk[2] = __float_as_int(pgrp * pt0); tk[3] = __float_as_int(pgrp * pt1); tk[4] = la; tk[5] = lb;
            }
        }
    }
    __syncthreads();
#undef NRM_LOAD
#undef NRM_SRC
#undef NRM_VALID
    if (MODE == 2 && F.tid < 16) {
        const int c = lcnt[F.tid];
        ((int*)(ws + WS_WGCNT))[F.bx * 16 + F.tid] = c;
        atomicAdd((int*)(ws + WS_CTL) + CW_ECNT + 64 * layer + F.tid, c);
    }
    __syncthreads();
}

__device__ __forceinline__ void phase_route(const ArgsL& a, Frame& F, int layer) {
    unsigned char* ws = a.ws;
    LAS int* tbl = (LAS int*)F.lds;
    LAS int* part = tbl + 16;
    {
        const int e = F.tid & 15, q = F.tid >> 4; const int* wc = (const int*)(ws + WS_WGCNT); int acc = 0;
#pragma unroll
        for (int i = 0; i < 8; ++i) { const int w = q + 32 * i; if (w < (int)F.bx) acc += wc[w * 16 + e]; }
        part[q * 16 + e] = acc;
    }
    __syncthreads();
    if (F.tid < 16) {
        const int* cnt = (const int*)(ws + WS_CTL) + CW_ECNT + 64 * layer;
        int cv[16];
#pragma unroll
        for (int e = 0; e < 16; ++e) cv[e] = __hip_atomic_load(cnt + e, __ATOMIC_RELAXED, __HIP_MEMORY_SCOPE_AGENT);
        int base = 0;
#pragma unroll
        for (int e = 0; e < 16; ++e) if (e < F.tid) base += ((cv[e] + 255) >> 8) << 8;
#pragma unroll
        for (int q = 0; q < 32; ++q) base += part[q * 16 + F.tid];
        tbl[F.tid] = base;
    }
    __syncthreads();
    const int gw = F.bx * NWAVES + F.wave, NGW = gridDim.x * NWAVES, lane = F.lane;
    const bf16_t* A = (const bf16_t*)(ws + WS_A); bf16_t* AS = (bf16_t*)(ws + WS_AS);
    for (int m = gw; m < M; m += NGW) {
        const int b = m / T, p = m - b * T, l = p - PADR;
        if (l < 0) continue;
        const int* tk = (const int*)(ws + WS_TOK) + (size_t)m * 8;
        const int ea = tk[0], eb = tk[1], sa = tbl[ea] + tk[4], sb = tbl[eb] + tk[5];
        const u32x4* src = (const u32x4*)(A + (size_t)m * D) + lane;
        const u32x4 x0 = src[0], x1 = src[64];
        u32x4* d0 = (u32x4*)(AS + (size_t)sa * D) + lane; u32x4* d1 = (u32x4*)(AS + (size_t)sb * D) + lane;
        d0[0] = x0; d0[64] = x1; d1[0] = x0; d1[64] = x1;
        if (lane == 0) { int* sl = (int*)(ws + WS_SLOT) + 2 * m; sl[0] = sa; sl[1] = sb;
            float* cw = (float*)(ws + WS_CWS); cw[sa] = __int_as_float(tk[2]); cw[sb] = __int_as_float(tk[3]); }
    }
    __syncthreads();
}

__device__ __forceinline__ void phase_prep(const ArgsL& a, Frame& F, int layer) {
    unsigned char* ws = a.ws;
    LAS float* xs = (LAS float*)F.lds;
    const int wave = F.wave, lane = F.lane, tid = F.tid;
    const int m0 = F.bx * 129;
    const bf16_t* USH = (const bf16_t*)(ws + WS_USH);
    bf16_t* QKV = (bf16_t*)(ws + WS_QKV);
    if (F.bx < 10) {
        const int bh = F.bx, b = bh / 5, h = bh % 5;
        const float* LOGF = (const float*)(ws + WS_LOGF) + (size_t)(b * T + PADR) * 8 + h;
        float* kb = (float*)(ws + WS_KB2) + (size_t)bh * KBP;
        LAS float* wtot = (LAS float*)F.lds;
        float v[33];
        const int l0 = tid * 33;
#pragma unroll
        for (int i = 0; i < 33; ++i) v[i] = (l0 + i < LTOK) ? LOGF[(size_t)(l0 + i) * 8] : 0.f;
#pragma unroll
        for (int i = 1; i < 33; ++i) v[i] += v[i - 1];
        float incl = v[32];
#pragma unroll
        for (int o = 1; o < 64; o <<= 1) { const float t = __shfl_up(incl, o); if (lane >= o) incl += t; }
        if (lane == 63) wtot[wave] = incl;
        __syncthreads();
        float off = incl - v[32];
        for (int w = 0; w < wave; ++w) off += wtot[w];
#pragma unroll
        for (int i = 0; i < 33; ++i) if (l0 + i < LTOK) kb[PADR + l0 + i] = -(off + v[i]) * LOG2E;
        for (int p = tid; p < PADR; p += NTHR) kb[p] = 0.f;
        for (int p = T + tid; p < KBP; p += NTHR) kb[p] = 0.f;
        __syncthreads();
    }
    if (F.bx >= 16 && F.bx < 28) {
        unsigned* z = (unsigned*)(ws + WS_RW + ((size_t)(F.bx - 16) * LPADDED + LTOK) * 768);
        for (int i = tid; i < (LPADDED - LTOK) * 192; i += NTHR) z[i] = 0u;
    }
    float w0j = 0.f, a0j = 0.f, kkj = 0.f, kaj = 0.f, rkj = 0.f;
    const int jch = wave * 64 + lane;
    const float* WU = a.in(I_WUP) + (size_t)layer * 64 * RW_W + (wave < 6 ? jch : 0); const float* AU = a.in(I_AUP) + (size_t)layer * 64 * RW_W + (wave < 6 ? jch : 0);
    if (wave < 6) {
        w0j = a.in(I_W0)[layer * RW_W + jch]; a0j = a.in(I_A0)[layer * RW_W + jch];
        kkj = a.in(I_KK)[layer * RW_W + jch]; kaj = a.in(I_KA)[layer * RW_W + jch]; rkj = a.in(I_RK)[layer * RW_W + jch];
    }
    const float* mu = a.in(I_MU) + layer * SHIFT_W;
    const float gq = a.in(I_QG)[layer * 64 + lane] * C2, gk = a.in(I_KG)[layer * 64 + lane];
    _Float16* RW = (_Float16*)(ws + WS_RW);
    bf16_t* BN = (bf16_t*)(ws + WS_BN);
    for (int t0 = 0; t0 < 129; t0 += 16) {
        const int nt = (129 - t0) < 16 ? (129 - t0) : 16;
        {
            u32x4 uu4[5], pp4[5];
#pragma unroll
            for (int q5 = 0; q5 < 5; ++q5) { const int item = tid + q5 * NTHR; uu4[q5] = (u32x4){0u, 0u, 0u, 0u}; pp4[q5] = (u32x4){0u, 0u, 0u, 0u};
                if (item < nt * 160) { const int tok = item / 160, ch = item - tok * 160, m = m0 + t0 + tok;
                    uu4[q5] = *(const u32x4*)(USH + (size_t)m * SHIFT_W + ch * 8);
                    if (m > 0) pp4[q5] = *(const u32x4*)(USH + (size_t)(m - 1) * SHIFT_W + ch * 8); } }
#pragma unroll
            for (int q5 = 0; q5 < 5; ++q5) { const int item = tid + q5 * NTHR;
                if (item < nt * 160) { const int tok = item / 160, ch = item - tok * 160;
                    const u32x4 u = uu4[q5], pv = pp4[q5];
                    const f32x4 mu0 = *(const f32x4*)(mu + ch * 8), mu1 = *(const f32x4*)(mu + ch * 8 + 4);
                    float x[8];
                    { float uu, pp;
                      uu = bf_lo(u.x); pp = bf_lo(pv.x); x[0] = uu + (pp - uu) * mu0.x;  uu = bf_hi(u.x); pp = bf_hi(pv.x); x[1] = uu + (pp - uu) * mu0.y;
                      uu = bf_lo(u.y); pp = bf_lo(pv.y); x[2] = uu + (pp - uu) * mu0.z;  uu = bf_hi(u.y); pp = bf_hi(pv.y); x[3] = uu + (pp - uu) * mu0.w;
                      uu = bf_lo(u.z); pp = bf_lo(pv.z); x[4] = uu + (pp - uu) * mu1.x;  uu = bf_hi(u.z); pp = bf_hi(pv.z); x[5] = uu + (pp - uu) * mu1.y;
                      uu = bf_lo(u.w); pp = bf_lo(pv.w); x[6] = uu + (pp - uu) * mu1.z;  uu = bf_hi(u.w); pp = bf_hi(pv.w); x[7] = uu + (pp - uu) * mu1.w; }
                    if (ch >= 144 && ch < 152) {
#pragma unroll
                        for (int q = 0; q < 8; ++q) { const float e = fast_exp(-2.f * fabsf(x[q])); const float th = (1.f - e) / (1.f + e); x[q] = x[q] < 0.f ? -th : th; }
                    }
                    LAS f32x4* d = (LAS f32x4*)(xs + tok * SHIFT_W + ch * 8);
                    d[0] = (f32x4){x[0], x[1], x[2], x[3]}; d[1] = (f32x4){x[4], x[5], x[6], x[7]}; } }
        }
        __syncthreads();
        if (wave < 6) {
            LAS float* wlb = xs + 16 * SHIFT_W;
            LAS float* alb = wlb + 16 * RW_W;
            {
                const float* wp = WU; asm volatile("" : "+v"(wp) :: "memory");
                float wv[64];
#pragma unroll
                for (int i = 0; i < 64; ++i) wv[i] = wp[i * RW_W];
#pragma unroll 1
                for (int tok = 0; tok < nt; ++tok) { const LAS float* xr = xs + tok * SHIFT_W + 1152; float acc = w0j;
#pragma unroll
                    for (int i = 0; i < 64; i += 4) { const f32x4 t4 = *(const LAS f32x4*)(xr + i); acc += t4.x * wv[i] + t4.y * wv[i + 1] + t4.z * wv[i + 2] + t4.w * wv[i + 3]; }
                    wlb[tok * RW_W + jch] = acc; }
            }
            {
                const float* wp = AU; asm volatile("" : "+v"(wp) :: "memory");
                float wv[64];
#pragma unroll
                for (int i = 0; i < 64; ++i) wv[i] = wp[i * RW_W];
#pragma unroll 1
                for (int tok = 0; tok < nt; ++tok) { const LAS float* xr = xs + tok * SHIFT_W + 1216; float acc = a0j;
#pragma unroll
                    for (int i = 0; i < 64; i += 4) { const f32x4 t4 = *(const LAS f32x4*)(xr + i); acc += t4.x * wv[i] + t4.y * wv[i + 1] + t4.z * wv[i + 2] + t4.w * wv[i + 3]; }
                    alb[tok * RW_W + jch] = acc; }
            }
            asm volatile("" ::: "memory");
#pragma unroll 1
            for (int tok = 0; tok < nt; ++tok) {
                const int m = m0 + t0 + tok, b = m / T, p = m - b * T, l = p - PADR;
                if (l < 0) continue;
                const LAS float* xr = xs + tok * SHIFT_W;
                const float r = xr[jch], k = xr[384 + jch], v = xr[768 + jch];
                const float logw = -softplus_f(-wlb[tok * RW_W + jch]) - 0.5f;
                const float xw = fast_exp(logw);
                const float om = xw < 0.02f ? xw * (1.f - 0.5f * xw + xw * xw * (1.f / 6.f)) : 1.f - fast_exp(-xw);
                const float av = 1.f / (1.f + fast_exp(-alb[tok * RW_W + jch]));
                const float kkr = k * kkj;
                const float nrm = sqrtf(wave_sum(kkr * kkr));
                const float kk = kkr / fmaxf(nrm, 1e-12f);
                const float kp = k * (1.f + (av - 1.f) * kaj);
                const float bb = kk * av;
                const float coef = wave_sum(r * kp * rkj);
                _Float16* o = RW + ((size_t)(b * RW_H + wave) * LPADDED + l) * 384 + lane;
                o[0] = (_Float16)kk; o[64] = (_Float16)(-om); o[128] = (_Float16)(-bb); o[192] = (_Float16)kp; o[256] = (_Float16)r; o[320] = (_Float16)v;
                BN[(size_t)m * RW_W + jch] = f2bf(coef * v);
            }
        } else {
            const int which = wave - 6;
            const float gsc = which == 0 ? gq : gk;
#pragma unroll 2
            for (int tok = 0; tok < nt; ++tok) {
                const int m = m0 + t0 + tok, b = m / T, p = m - b * T;
                if (p < PADR) continue;
                bf16_t* q = QKV + (size_t)m * QKV_W + 960 + which * 320 + lane;
                unsigned short xv[5];
#pragma unroll
                for (int hd = 0; hd < 5; ++hd) xv[hd] = q[hd * 64];
#pragma unroll
                for (int hd = 0; hd < 5; ++hd) { const float x = bf2f(xv[hd]); const float ss = wave_sum(x * x);
                    q[hd * 64] = f2bf(x * (1.0f / sqrtf(ss * (1.0f / 64.f) + 1e-6f)) * gsc); }
            }
        }
        __syncthreads();
    }
}


constexpr int SCH = 16;
static_assert(LTOK % SCH == 0, "whole chunks");
__device__ __forceinline__ void rwkv_scan(const ArgsL& a, Frame& F, int wgi, int dry = 0) {
    const int bh = wgi >> 4, q8 = wgi & 15, b = bh / RW_H, h = bh % RW_H;
    const int tid = F.tid, wave = F.wave, lane = F.lane;
    const unsigned char* rw = a.ws + WS_RW + (size_t)bh * LPADDED * 768;
    LAS float* ring = (LAS float*)F.lds;
    LAS float* ypart = (LAS float*)(F.lds + 49152);
    LAS unsigned char* stg = F.lds + 81920;
    bf16_t* y0 = (bf16_t*)(a.ws + WS_YCAT);
    constexpr int NCH = LTOK / SCH;
    const bool isld = (wave & 2) != 0; const int lw = (wave & 1) + ((wave >> 2) << 1), tl = lw * 64 + lane;
    float s0 = 0.f, s1 = 0.f;
    const int i32 = lane & 31, rsel = lane >> 5, rloc = 2 * wave + rsel;
#define RW_BAR() asm volatile("s_waitcnt lgkmcnt(0)\n\ts_barrier" ::: "memory")
#define RW_ISSUE(cc) do { const unsigned char* src_ = rw + (size_t)(cc) * SCH * 768 + (size_t)tl * 16; LAS unsigned char* d_ = stg + ((cc) & 3) * 12288 + lw * 1024; \
        _Pragma("unroll") for (int k_ = 0; k_ < 3; ++k_) __builtin_amdgcn_global_load_lds((const unsigned*)(src_ + k_ * 4096), (LAS unsigned*)(d_ + k_ * 4096), 16, 0, 0); } while (0)
#define RW_CONVERT(cc) do { const LAS unsigned char* s_ = stg + ((cc) & 3) * 12288 + tl * 16; LAS float* rb_ = ring + ((cc) & 1) * 6144; \
        _Pragma("unroll") for (int k_ = 0; k_ < 3; ++k_) { const int pc_ = tl + 256 * k_; const int t_ = pc_ / 48, q_ = pc_ - t_ * 48, vec_ = q_ >> 3, e0_ = (q_ & 7) * 8; \
            const u32x4 w_ = *(const LAS u32x4*)(s_ + k_ * 4096); \
            const f16x4 lo_ = __builtin_bit_cast(f16x4, (u32x2){w_.x, w_.y}), hi_ = __builtin_bit_cast(f16x4, (u32x2){w_.z, w_.w}); \
            const float f0 = (float)lo_.x, f1 = (float)lo_.y, f2 = (float)lo_.z, f3 = (float)lo_.w, f4 = (float)hi_.x, f5 = (float)hi_.y, f6 = (float)hi_.z, f7 = (float)hi_.w; \
            if (vec_ < 4) { LAS float* d_ = rb_ + t_ * 384 + (vec_ >> 1) * 128 + (e0_ >> 1) * 4 + (vec_ & 1) * 2; \
                *(LAS f32x2*)(d_) = (f32x2){f0, f1}; *(LAS f32x2*)(d_ + 4) = (f32x2){f2, f3}; *(LAS f32x2*)(d_ + 8) = (f32x2){f4, f5}; *(LAS f32x2*)(d_ + 12) = (f32x2){f6, f7}; } \
            else { LAS f32x4* d_ = (LAS f32x4*)(rb_ + t_ * 384 + (vec_ == 4 ? 256 : 320) + e0_); d_[0] = (f32x4){f0, f1, f2, f3}; d_[1] = (f32x4){f4, f5, f6, f7}; } } } while (0)
#define RW_STORE_Y(cc) do { if (tl < 32) { const LAS float* yb_ = ypart + ((cc) & 1) * 4096; const int t_ = tl >> 1, pr_ = tl & 1; const int l_ = (cc) * SCH + t_; \
        const LAS f32x4* q_ = (const LAS f32x4*)(yb_ + t_ * 128 + pr_ * 64); f32x4 sa_ = q_[0], sb_ = q_[8]; \
        _Pragma("unroll") for (int k_ = 1; k_ < 8; ++k_) { sa_ = sa_ + q_[k_]; sb_ = sb_ + q_[8 + k_]; } \
        *(unsigned*)(y0 + (size_t)(b * T + PADR + l_) * RW_W + h * 64 + q8 * 4 + 2 * pr_) = pk2((sa_.x + sa_.y) + (sa_.z + sa_.w), (sb_.x + sb_.y) + (sb_.z + sb_.w)); } } while (0)
    if (isld) {
        RW_ISSUE(0); asm volatile("s_waitcnt vmcnt(0)" ::: "memory"); RW_CONVERT(0);
        RW_ISSUE(1); RW_ISSUE(2);
    }
    RW_BAR();
    for (int c = 0; c < NCH; ++c) {
        if (isld) {
            if (c + 2 < NCH) { asm volatile("s_waitcnt vmcnt(3)" ::: "memory"); RW_CONVERT(c + 1); }
            else if (c + 1 < NCH) { asm volatile("s_waitcnt vmcnt(0)" ::: "memory"); RW_CONVERT(c + 1); }
            if (c > 0 && !dry) RW_STORE_Y(c - 1);
            if (c + 3 < NCH) RW_ISSUE(c + 3);
        } else if (dry != 1 && wave < 2) {
            const unsigned ba = (unsigned)(uintptr_t)(ring + (c & 1) * 6144) + i32 * 16, ca = (unsigned)(uintptr_t)(ring + (c & 1) * 6144) + 1024 + i32 * 8,
                           va = (unsigned)(uintptr_t)(ring + (c & 1) * 6144) + 1280 + (q8 * 4 + rloc) * 4, ya = (unsigned)(uintptr_t)(ypart + (c & 1) * 4096 + rloc * 32 + i32);
            f32x4 OA[4], OB[4]; f32x2 OC[4]; float OV[4];
            OC[3] = (f32x2){0.f, 0.f};
#define RW_FETCH(tt, sl) asm volatile("ds_read_b128 %0, %4 offset:%c7\n\tds_read_b128 %1, %4 offset:%c8\n\tds_read_b64 %2, %5 offset:%c7\n\tds_read_b32 %3, %6 offset:%c7" \
                : "=&v"(OA[sl]), "=&v"(OB[sl]), "=&v"(OC[sl]), "=&v"(OV[sl]) : "v"(ba), "v"(ca), "v"(va), "i"((tt) * 1536), "i"((tt) * 1536 + 512) : "memory")
            RW_FETCH(0, 0); RW_FETCH(1, 1);
            float p, p2, y;
#define RW_STEP(t, WAITN, YL1, YL2, YW, FETCHL) asm volatile( \
                "s_waitcnt lgkmcnt(" WAITN ")\n\t" \
                "v_mul_f32 %[p], %[s0], %[kk0]\n\t" \
                "v_fmac_f32 %[p], %[s1], %[kk1]\n\t" \
                YL1 "\n\t" YL2 "\n\t" \
                XL8 "\n\t" \
                "v_fmac_f32 %[s0], %[s0], %[om0]\n\t" \
                "v_fmac_f32 %[s1], %[s1], %[om1]\n\t" \
                XL4 "\n\t" \
                "v_fmac_f32 %[s0], %[vf], %[kv0]\n\t" \
                "v_fmac_f32 %[s1], %[vf], %[kv1]\n\t" \
                XL2 "\n\t" \
                YW "\n\t" \
                FETCHL \
                : [p] "=&v"(p), [p2] "=&v"(p2), [y] "=&v"(y), [s0] "+v"(s0), [s1] "+v"(s1), [nA] "=&v"(OA[((t) + 2) & 3]), [nB] "=&v"(OB[((t) + 2) & 3]), [nC] "=&v"(OC[((t) + 2) & 3]), [nV] "=&v"(OV[((t) + 2) & 3]) \
                : [kk0] "v"(OA[(t) & 3].x), [kk1] "v"(OA[(t) & 3].y), [om0] "v"(OA[(t) & 3].z), [om1] "v"(OA[(t) & 3].w), [bb0] "v"(OB[(t) & 3].x), [bb1] "v"(OB[(t) & 3].y), [kv0] "v"(OB[(t) & 3].z), [kv1] "v"(OB[(t) & 3].w), \
                  [vf] "v"(OV[(t) & 3]), [rp0] "v"(OC[((t) + 3) & 3].x), [rp1] "v"(OC[((t) + 3) & 3].y), [ba] "v"(ba), [ca] "v"(ca), [va] "v"(va), [ya] "v"(ya), \
                  [oa] "i"(((t) + 2) * 1536), [ob] "i"(((t) + 2) * 1536 + 512), [oy] "i"(((t) - 1) * 512) : "memory")
#define RW_YL1 "v_mul_f32 %[y], %[s0], %[rp0]"
#define RW_YL2 "v_fmac_f32 %[y], %[s1], %[rp1]"
#define RW_YW  "ds_write_b32 %[ya], %[y] offset:%c[oy]"
#define RW_NOP "s_nop 0"
#define RW_TAIL_F "ds_read_b128 %[nA], %[ba] offset:%c[oa]\n\t" \
                XL1 "\n\t" \
                "ds_read_b128 %[nB], %[ba] offset:%c[ob]\n\t" \
                "ds_read_b64 %[nC], %[ca] offset:%c[oa]\n\t" \
                "v_mov_b32 %[p2], %[p]\n\t" \
                "ds_read_b32 %[nV], %[va] offset:%c[oa]\n\t" \
                "s_nop 0\n\t" \
                XSW "\n\t" \
                "v_add_f32 %[p], %[p], %[p2]\n\t" \
                "v_fmac_f32 %[s0], %[p], %[bb0]\n\t" \
                "v_fmac_f32 %[s1], %[p], %[bb1]"
#define RW_TAIL_N "s_nop 0\n\t" \
                XL1 "\n\t" \
                "s_nop 1\n\t" \
                "v_mov_b32 %[p2], %[p]\n\t" \
                "s_nop 1\n\t" \
                XSW "\n\t" \
                "v_add_f32 %[p], %[p], %[p2]\n\t" \
                "v_fmac_f32 %[s0], %[p], %[bb0]\n\t" \
                "v_fmac_f32 %[s1], %[p], %[bb1]"
#define RW_ALLSTEPS() do { \
            RW_STEP(0, "4", RW_NOP, RW_NOP, RW_NOP, RW_TAIL_F); \
            RW_STEP(1, "4", RW_YL1, RW_YL2, RW_YW, RW_TAIL_F); \
            RW_STEP(2, "5", RW_YL1, RW_YL2, RW_YW, RW_TAIL_F);  RW_STEP(3, "5", RW_YL1, RW_YL2, RW_YW, RW_TAIL_F);  RW_STEP(4, "5", RW_YL1, RW_YL2, RW_YW, RW_TAIL_F); \
            RW_STEP(5, "5", RW_YL1, RW_YL2, RW_YW, RW_TAIL_F);  RW_STEP(6, "5", RW_YL1, RW_YL2, RW_YW, RW_TAIL_F);  RW_STEP(7, "5", RW_YL1, RW_YL2, RW_YW, RW_TAIL_F); \
            RW_STEP(8, "5", RW_YL1, RW_YL2, RW_YW, RW_TAIL_F);  RW_STEP(9, "5", RW_YL1, RW_YL2, RW_YW, RW_TAIL_F);  RW_STEP(10, "5", RW_YL1, RW_YL2, RW_YW, RW_TAIL_F); \
            RW_STEP(11, "5", RW_YL1, RW_YL2, RW_YW, RW_TAIL_F); RW_STEP(12, "5", RW_YL1, RW_YL2, RW_YW, RW_TAIL_F); RW_STEP(13, "5", RW_YL1, RW_YL2, RW_YW, RW_TAIL_F); \
            RW_STEP(14, "5", RW_YL1, RW_YL2, RW_YW, RW_TAIL_N); \
            RW_STEP(15, "1", RW_YL1, RW_YL2, RW_YW, RW_TAIL_N); \
            asm volatile("v_mul_f32 %[y], %[s0], %[r0]\n\tv_fmac_f32 %[y], %[s1], %[r1]\n\tds_write_b32 %[ya], %[y] offset:7680" : [y] "=&v"(y) : [s0] "v"(s0), [s1] "v"(s1), [r0] "v"(OC[3].x), [r1] "v"(OC[3].y), [ya] "v"(ya) : "memory"); \
 } while (0)
#ifdef SCAN_PROBE_NOXL
            if (dry == 2) {
#define XL8 "v_add_f32 %[p], %[p], %[p]"
#define XL4 "v_add_f32 %[p], %[p], %[p]"
#define XL2 "v_add_f32 %[p], %[p], %[p]"
#define XL1 "v_add_f32 %[p], %[p], %[p]"
#define XSW "v_add_f32 %[p], %[p], %[p2]"
                RW_ALLSTEPS();
#undef XL8
#undef XL4
#undef XL2
#undef XL1
#undef XSW
            } else
#endif
            {
#define XL8 "v_add_f32_dpp %[p], %[p], %[p] row_ror:8 row_mask:0xf bank_mask:0xf bound_ctrl:1"
#define XL4 "v_add_f32_dpp %[p], %[p], %[p] row_ror:4 row_mask:0xf bank_mask:0xf bound_ctrl:1"
#define XL2 "v_add_f32_dpp %[p], %[p], %[p] row_ror:2 row_mask:0xf bank_mask:0xf bound_ctrl:1"
#define XL1 "v_add_f32_dpp %[p], %[p], %[p] row_ror:1 row_mask:0xf bank_mask:0xf bound_ctrl:1"
#define XSW "v_permlane16_swap_b32 %[p], %[p2]"
                RW_ALLSTEPS();
            }
#undef RW_ALLSTEPS
#undef RW_STEP
#undef XL8
#undef XL4
#undef XL2
#undef XL1
#undef XSW
#undef RW_YL1
#undef RW_YL2
#undef RW_YW
#undef RW_NOP
#undef RW_TAIL_F
#undef RW_TAIL_N
#undef RW_FETCH
        }
        RW_BAR();
    }
    if (isld && !dry) RW_STORE_Y(NCH - 1);
    asm volatile("s_waitcnt vmcnt(0) lgkmcnt(0)\n\ts_barrier" ::: "memory");
#undef RW_STORE_Y
#undef RW_ISSUE
#undef RW_CONVERT
#undef RW_BAR
}

__device__ __forceinline__ int crow(int r, int hi) { return (r & 3) + 8 * (r >> 2) + 4 * hi; }
__device__ __forceinline__ void glds16(const void* gsrc, unsigned lds_dst) { unsigned keep;
    asm volatile("s_mov_b32 %0, m0\n\ts_mov_b32 m0, %2\n\ts_nop 0\n\tglobal_load_lds_dwordx4 %1, off\n\ts_mov_b32 m0, %0" : "=&s"(keep) : "v"(gsrc), "s"(lds_dst) : "memory"); }
typedef LAS const char* lds_cptr;
constexpr int FX_K = 0, FX_V = 16384, FX_WS = 32768, FX_OST = 34816, FX_FLG = 67584;

__device__ __forceinline__ void fx_pv(f32x16* o, int vb, bf16x8 pa0, bf16x8 pa1, bf16x8 pa2, bf16x8 pa3) {
#pragma unroll
    for (int d0 = 0; d0 < 2; ++d0) { s16x4 lo[4], hi[4];
#pragma unroll
        for (int ks = 0; ks < 4; ++ks) {
            asm volatile("ds_read_b64_tr_b16 %0,%1 offset:%c2" : "=&v"(lo[ks]) : "v"(vb), "i"(d0 * 4096 + ks * 1024) : "memory");
            asm volatile("ds_read_b64_tr_b16 %0,%1 offset:%c2" : "=&v"(hi[ks]) : "v"(vb), "i"(d0 * 4096 + ks * 1024 + 512) : "memory"); }
        asm volatile("s_waitcnt lgkmcnt(0)" ::: "memory"); __builtin_amdgcn_sched_barrier(0);
#define FX_PK(k) (bf16x8){lo[k][0], lo[k][1], lo[k][2], lo[k][3], hi[k][0], hi[k][1], hi[k][2], hi[k][3]}
        o[d0] = __builtin_amdgcn_mfma_f32_32x32x16_bf16(pa0, FX_PK(0), o[d0], 0, 0, 0);
        o[d0] = __builtin_amdgcn_mfma_f32_32x32x16_bf16(pa1, FX_PK(1), o[d0], 0, 0, 0);
        o[d0] = __builtin_amdgcn_mfma_f32_32x32x16_bf16(pa2, FX_PK(2), o[d0], 0, 0, 0);
        o[d0] = __builtin_amdgcn_mfma_f32_32x32x16_bf16(pa3, FX_PK(3), o[d0], 0, 0, 0);
#undef FX_PK
    }
}
__device__ __forceinline__ float halves_max(float m) { auto rr = __builtin_amdgcn_permlane32_swap(__float_as_uint(m), __float_as_uint(m), false, false); return fmaxf(__uint_as_float(rr[0]), __uint_as_float(rr[1])); }
__device__ __forceinline__ float halves_sum(float m) { auto rr = __builtin_amdgcn_permlane32_swap(__float_as_uint(m), __float_as_uint(m), false, false); return __uint_as_float(rr[0]) + __uint_as_float(rr[1]); }

template <int KIND>
__device__ __forceinline__ void attn_unit(const ArgsL& a, Frame& F, int b, int h, int qb, float bound) {
    const int lane = F.lane, wave = F.wave, r32 = lane & 31, hi = lane >> 5;
    LAS unsigned char* lds = F.lds;
    const bf16_t* QKV = (const bf16_t*)(a.ws + WS_QKV);
    const size_t rowbase = (size_t)b * T;
    const int p0 = qb * 256;
    constexpr int QC = KIND ? 0 : 960, KC = KIND ? 320 : 1280, VC = KIND ? 640 : 1600;
    const bf16_t* Qw = QKV + (rowbase + p0 + wave * 32) * QKV_W + QC + h * 64;
    const bf16_t* Kh = QKV + rowbase * QKV_W + KC + h * 64;
    const bf16_t* Vh = QKV + rowbase * QKV_W + VC + h * 64;
    const float* kbias = (const float*)(a.ws + WS_KB2) + (size_t)(b * FX_H + h) * KBP;
    const unsigned lds0 = (unsigned)(uintptr_t)lds;
    bf16x8 qr[4];
#pragma unroll
    for (int d0 = 0; d0 < 4; ++d0) qr[d0] = *(const bf16x8*)(Qw + (size_t)r32 * QKV_W + d0 * 16 + hi * 8);
    const int qp = p0 + wave * 32 + r32;
    const bool qvalid = (qp >= PADR) && (qp < T);
    const int plast = (p0 + 255) < (T - 1) ? (p0 + 255) : (T - 1);
    const int jlast = plast >> 6, jfirst = PADR >> 6;
    const int jw = (p0 + wave * 32 + 31) >> 6;
    const bf16_t* ksrc = Kh + (size_t)lane * QKV_W + wave * 8;
    const bf16_t* vsrc = Vh + (size_t)(16 * (wave & 3) + (lane >> 2)) * QKV_W + (wave >> 2) * 32 + (lane & 3) * 8;
    const unsigned kdst = lds0 + FX_K + wave * 1024, vdst = lds0 + FX_V + wave * 1024;
#define FX_DMA(j, slot) do { glds16(ksrc + (size_t)(j) * 64 * QKV_W, (unsigned)__builtin_amdgcn_readfirstlane(kdst + (slot) * 8192)); \
                             glds16(vsrc + (size_t)(j) * 64 * QKV_W, (unsigned)__builtin_amdgcn_readfirstlane(vdst + (slot) * 8192)); } while (0)
    const int vb0 = (int)(lds0 + FX_V) + ((lane >> 4) & 1) * 32 + (lane & 3) * 8 + (4 * hi + ((lane & 15) >> 2)) * 64;
    const lds_cptr kp0 = (lds_cptr)lds + FX_K + hi * 1024 + r32 * 16;
    LAS float* wsf = (LAS float*)(lds + FX_WS) + wave * 64;
    LAS float* flg = (LAS float*)(lds + FX_FLG);
    float m_run = KIND ? 0.f : -1.0e30f, l_run = 0.f;
    f32x16 o[2]; o[0] = f32x16{}; o[1] = f32x16{};
    int slot = 0; bool stop = false;
    FX_DMA(jlast, 0);
    for (int j = jlast; j >= jfirst; --j) {
        if (stop) break;
        if (j > jfirst) { FX_DMA(j - 1, slot ^ 1); asm volatile("s_waitcnt vmcnt(2) lgkmcnt(0)\n\ts_barrier" ::: "memory"); }
        else asm volatile("s_waitcnt vmcnt(0) lgkmcnt(0)\n\ts_barrier" ::: "memory");
        if (j <= jw) {
            f32x16 s0v = f32x16{}, s1v = f32x16{};
            const lds_cptr kp = kp0 + slot * 8192;
#pragma unroll
            for (int d0 = 0; d0 < 4; ++d0) {
                const bf16x8 b0 = *(const LAS bf16x8*)(kp + d0 * 2048);
                const bf16x8 b1 = *(const LAS bf16x8*)(kp + d0 * 2048 + 512);
                s0v = __builtin_amdgcn_mfma_f32_32x32x16_bf16(b0, qr[d0], s0v, 0, 0, 0);
                s1v = __builtin_amdgcn_mfma_f32_32x32x16_bf16(b1, qr[d0], s1v, 0, 0, 0);
            }
            const bool edge = (64 * j + 63 >= p0 + wave * 32) || (64 * j < PADR);
            if constexpr (KIND == 0) {
                const float* kbj = kbias + 64 * j + 4 * hi;
#pragma unroll
                for (int g = 0; g < 4; ++g) { const f32x4 t0 = *(const f32x4*)(kbj + 8 * g), t1 = *(const f32x4*)(kbj + 32 + 8 * g);
                    s0v[4 * g] += t0.x; s0v[4 * g + 1] += t0.y; s0v[4 * g + 2] += t0.z; s0v[4 * g + 3] += t0.w;
                    s1v[4 * g] += t1.x; s1v[4 * g + 1] += t1.y; s1v[4 * g + 2] += t1.z; s1v[4 * g + 3] += t1.w; }
                if (edge) {
#pragma unroll
                    for (int r = 0; r < 16; ++r) { const int key = 64 * j + crow(r, hi);
                        if (key > qp || key < PADR) s0v[r] = -INFINITY;
                        if (key + 32 > qp || key + 32 < PADR) s1v[r] = -INFINITY; }
                }
                float rm = fmaxf(s0v[0], s1v[0]);
#pragma unroll
                for (int r = 1; r < 16; ++r) rm = fmaxf(rm, fmaxf(s0v[r], s1v[r]));
                rm = halves_max(rm);
                const float m_new = fmaxf(m_run, rm);
                const float f = __builtin_amdgcn_exp2f(m_run - m_new);
                m_run = m_new;
                float rs = 0.f;
#pragma unroll
                for (int r = 0; r < 16; ++r) { s0v[r] = __builtin_amdgcn_exp2f(s0v[r] - m_new); s1v[r] = __builtin_amdgcn_exp2f(s1v[r] - m_new); rs += s0v[r] + s1v[r]; }
                rs = halves_sum(rs);
                l_run = l_run * f + rs;
                if (!__all(f == 1.0f)) {
                    if (hi == 0) wsf[r32] = f;
                    LDS_WAIT();
#pragma unroll
                    for (int d_ = 0; d_ < 2; ++d_)
#pragma unroll
                        for (int r = 0; r < 16; ++r) o[d_][r] *= wsf[crow(r, hi)];
                }
            } else {
                f32x16 l0, l1;
#pragma unroll
                for (int r = 0; r < 16; ++r) {
                    const float z0 = s0v[r], z1 = s1v[r];
                    float a0 = -(fmaxf(z0, 0.f) + __builtin_amdgcn_logf(1.f + __builtin_amdgcn_exp2f(-fabsf(z0))));
                    float a1 = -(fmaxf(z1, 0.f) + __builtin_amdgcn_logf(1.f + __builtin_amdgcn_exp2f(-fabsf(z1))));
                    if (edge) { const int key = 64 * j + crow(r, hi);
                        if (key >= qp || key < PADR) { a0 = 0.f; s0v[r] = -INFINITY; }
                        if (key + 32 >= qp || key + 32 < PADR) { a1 = 0.f; s1v[r] = -INFINITY; } }
                    l0[r] = a0; l1[r] = a1;
                }
                float A[8], SA[9], SO[9];
#pragma unroll
                for (int g = 0; g < 4; ++g) { A[g] = (l0[4 * g] + l0[4 * g + 1]) + (l0[4 * g + 2] + l0[4 * g + 3]); A[4 + g] = (l1[4 * g] + l1[4 * g + 1]) + (l1[4 * g + 2] + l1[4 * g + 3]); }
                SA[8] = 0.f; SO[8] = 0.f;
#pragma unroll
                for (int g = 7; g >= 0; --g) SA[g] = A[g] + SA[g + 1];
#pragma unroll
                for (int g = 0; g < 8; ++g) { auto rr = __builtin_amdgcn_permlane32_swap(__float_as_uint(SA[g]), __float_as_uint(SA[g]), false, false); SO[g] = __uint_as_float(hi ? rr[0] : rr[1]); }
                const float R = m_run;
#pragma unroll
                for (int g = 0; g < 8; ++g) {
                    const float E = SA[g + 1] + (hi ? SO[g + 1] : SO[g]) + R;
                    if (g < 4) { float t = E;
                        s0v[4 * g + 3] = __builtin_amdgcn_exp2f(s0v[4 * g + 3] + l0[4 * g + 3] + t); t += l0[4 * g + 3];
                        s0v[4 * g + 2] = __builtin_amdgcn_exp2f(s0v[4 * g + 2] + l0[4 * g + 2] + t); t += l0[4 * g + 2];
                        s0v[4 * g + 1] = __builtin_amdgcn_exp2f(s0v[4 * g + 1] + l0[4 * g + 1] + t); t += l0[4 * g + 1];
                        s0v[4 * g + 0] = __builtin_amdgcn_exp2f(s0v[4 * g + 0] + l0[4 * g + 0] + t);
                    } else { const int q = g - 4; float t = E;
                        s1v[4 * q + 3] = __builtin_amdgcn_exp2f(s1v[4 * q + 3] + l1[4 * q + 3] + t); t += l1[4 * q + 3];
                        s1v[4 * q + 2] = __builtin_amdgcn_exp2f(s1v[4 * q + 2] + l1[4 * q + 2] + t); t += l1[4 * q + 2];
                        s1v[4 * q + 1] = __builtin_amdgcn_exp2f(s1v[4 * q + 1] + l1[4 * q + 1] + t); t += l1[4 * q + 1];
                        s1v[4 * q + 0] = __builtin_amdgcn_exp2f(s1v[4 * q + 0] + l1[4 * q + 0] + t);
                    }
                }
                m_run = R + SA[0] + SO[0];
            }
            u32x4 pw0, pw1, pw2, pw3;
            pw0 = (u32x4){pk2(s0v[0], s0v[1]), pk2(s0v[2], s0v[3]), pk2(s0v[4], s0v[5]), pk2(s0v[6], s0v[7])};
            pw1 = (u32x4){pk2(s0v[8], s0v[9]), pk2(s0v[10], s0v[11]), pk2(s0v[12], s0v[13]), pk2(s0v[14], s0v[15])};
            pw2 = (u32x4){pk2(s1v[0], s1v[1]), pk2(s1v[2], s1v[3]), pk2(s1v[4], s1v[5]), pk2(s1v[6], s1v[7])};
            pw3 = (u32x4){pk2(s1v[8], s1v[9]), pk2(s1v[10], s1v[11]), pk2(s1v[12], s1v[13]), pk2(s1v[14], s1v[15])};
            fx_pv(o, vb0 + slot * 8192, __builtin_bit_cast(bf16x8, pw0), __builtin_bit_cast(bf16x8, pw1), __builtin_bit_cast(bf16x8, pw2), __builtin_bit_cast(bf16x8, pw3));
        }
        float mm = qvalid ? m_run : (KIND ? -3.0e38f : 3.0e38f);
#pragma unroll
        for (int off = 1; off < 64; off <<= 1) { const float t = __shfl_xor(mm, off); mm = KIND ? fmaxf(mm, t) : fminf(mm, t); }
        if (lane == 0) flg[(j & 1) * 8 + wave] = mm;
        asm volatile("s_waitcnt lgkmcnt(0)\n\ts_barrier" ::: "memory");
        if (j > jfirst) {
            const f32x4 fa = *(const LAS f32x4*)(flg + (j & 1) * 8), fb = *(const LAS f32x4*)(flg + (j & 1) * 8 + 4);
            if constexpr (KIND == 0) {
                const float mmin = fminf(fminf(fminf(fa.x, fa.y), fminf(fa.z, fa.w)), fminf(fminf(fb.x, fb.y), fminf(fb.z, fb.w)));
                const float kbmax = kbias[64 * (j - 1) + 63];
                stop = (bound + kbmax - mmin) < -150.0f;
            } else {
                const float mmax = fmaxf(fmaxf(fmaxf(fa.x, fa.y), fmaxf(fa.z, fa.w)), fmaxf(fmaxf(fb.x, fb.y), fmaxf(fb.z, fb.w)));
                stop = mmax < -150.0f;
            }
        }
        slot ^= 1;
    }
    asm volatile("s_waitcnt vmcnt(0) lgkmcnt(0)\n\ts_barrier" ::: "memory");
    float rli[16];
    if constexpr (KIND == 0) {
        if (hi == 0) wsf[32 + r32] = l_run;
        LDS_WAIT();
#pragma unroll
        for (int r = 0; r < 16; ++r) rli[r] = __builtin_amdgcn_rcpf(wsf[32 + crow(r, hi)]);
    } else {
#pragma unroll
        for (int r = 0; r < 16; ++r) rli[r] = 1.0f;
    }
    bf16_t* Ow = (bf16_t*)(a.ws + WS_YCAT) + (size_t)(KIND ? 1 : 2) * M * RW_W + (rowbase + p0 + wave * 32) * RW_W + h * 64;
    {
        LAS bf16_t* stg = (LAS bf16_t*)(lds + FX_OST) + wave * 2048;
#pragma unroll
        for (int r = 0; r < 16; ++r) { const int orow = crow(r, hi);
#pragma unroll
            for (int d0 = 0; d0 < 2; ++d0) stg[orow * 64 + d0 * 32 + r32] = f2bf(o[d0][r] * rli[r]); }
        LDS_WAIT();
#pragma unroll
        for (int i = 0; i < 4; ++i) { const int row = i * 8 + (lane >> 3), ch = lane & 7; const u32x4 v = *(const LAS u32x4*)(stg + row * 64 + ch * 8);
            const int pr = p0 + wave * 32 + row;
            if (pr >= PADR && pr < T) *(u32x4*)(Ow + (size_t)row * RW_W + ch * 8) = v; }
    }
    asm volatile("s_waitcnt lgkmcnt(0)\n\ts_barrier" ::: "memory");
#undef FX_DMA
}


constexpr int CK = 64, NCK = 257, CKB = 40960;
static_assert(LPADDED == CK * NCK, "padded steps");
__device__ __forceinline__ int swz(int row, int chunk) { return row * 128 + ((chunk ^ (row & 7)) << 4); }
__device__ __forceinline__ void ck_mm(f32x16& acc, LAS unsigned char* A, LAS unsigned char* Bt, int m0, int n0, int r32, int hi) {
#pragma unroll
    for (int ks = 0; ks < 4; ++ks) {
        const bf16x8 av = *(const LAS bf16x8*)(A + swz(m0 + r32, 2 * ks + hi));
        const bf16x8 bv = *(const LAS bf16x8*)(Bt + swz(n0 + r32, 2 * ks + hi));
        acc = __builtin_amdgcn_mfma_f32_32x32x16_bf16(av, bv, acc, 0, 0, 0);
    }
}
__device__ __forceinline__ void ck_store_t(LAS unsigned char* dst, const f32x16& acc, int m0, int n0, int r32, int hi) {
#pragma unroll
    for (int g = 0; g < 4; ++g) { const u32x2 w = {pk2(acc[4 * g], acc[4 * g + 1]), pk2(acc[4 * g + 2], acc[4 * g + 3])};
        *(LAS u32x2*)(dst + swz(n0 + r32, (m0 >> 3) + g) + hi * 8) = w; }
}
constexpr int CA_KAP = 0, CA_BET = 8192, CA_CHI = 16384, CA_RHO = 24576, CA_VMT = 32768, CA_BHT = 40960, CA_KHT = 49152, CA_AK = 57344, CA_RB = 65536, CA_RK = 73728,
              CA_AB = 81920  , CA_RHS = 98304  , CA_G64 = MISC_OFF + 2048  , CA_SCR = MISC_OFF + 4096  ;

__device__ __forceinline__ void phase_chunkA(const ArgsL& a, Frame& F) {
    const int wave = F.wave;
    LAS unsigned char* L = F.lds;
    for (int id = F.bx; id < 12 * NCK; id += (int)gridDim.x) {
        int tid = F.tid, lane, r32, hi;
#define CK_FRESH() do { asm volatile("" : "+v"(tid)); lane = tid & 63; r32 = lane & 31; hi = lane >> 5; } while (0)
        CK_FRESH();
        const int bh = id / NCK, c = id - bh * NCK;
        unsigned char* blk = a.ws + WS_RW + ((size_t)bh * LPADDED + (size_t)c * CK) * 768;
        {
            const int k = tid & 63, tq = tid >> 6;
            const _Float16* src = (const _Float16*)blk + (size_t)(tq * 8) * 384 + k;
            float kk[8], w[8], bb[8], kp[8], rr[8], vv[8];
#pragma unroll
            for (int e = 0; e < 8; ++e) { kk[e] = (float)src[e * 384]; w[e] = 1.f + (float)src[e * 384 + 64]; bb[e] = -(float)src[e * 384 + 128];
                kp[e] = (float)src[e * 384 + 192]; rr[e] = (float)src[e * 384 + 256]; vv[e] = (float)src[e * 384 + 320]; }
            float g[8]; g[0] = w[0];
#pragma unroll
            for (int e = 1; e < 8; ++e) g[e] = g[e - 1] * w[e];
            LAS float* scr = (LAS float*)(L + CA_SCR);
            scr[tq * 64 + k] = g[7];
            __syncthreads();
            float pre = 1.f, tot = 1.f;
#pragma unroll
            for (int q = 0; q < 8; ++q) { const float s = scr[q * 64 + k]; if (q < tq) pre *= s; tot *= s; }
            if (tq == 0) ((LAS float*)(L + CA_G64))[k] = tot;
            unsigned bh4[4], kh4[4], vm4[4];
            float Gp = pre;
#pragma unroll
            for (int e = 0; e < 8; ++e) {
                const int t = tq * 8 + e; const float G = pre * g[e], iG = __builtin_amdgcn_rcpf(G);
                const float kap = kk[e] * Gp, bet = bb[e] * iG, chi = kp[e] * iG, rho = rr[e] * G;
                const int o = swz(t, k >> 3) + (k & 7) * 2;
                *(LAS unsigned short*)(L + CA_KAP + o) = f2bf(kap); *(LAS unsigned short*)(L + CA_BET + o) = f2bf(bet);
                *(LAS unsigned short*)(L + CA_CHI + o) = f2bf(chi); *(LAS unsigned short*)(L + CA_RHO + o) = f2bf(rho);
                ((LAS float*)(L + CA_RHS))[t * 128 + k] = kap;
                const float bhv = bet * tot, khv = chi * tot;
                if (e & 1) { bh4[e >> 1] |= (unsigned)f2bf(bhv) << 16; kh4[e >> 1] |= (unsigned)f2bf(khv) << 16; vm4[e >> 1] |= (unsigned)f2bf(vv[e]) << 16; }
                else { bh4[e >> 1] = f2bf(bhv); kh4[e >> 1] = f2bf(khv); vm4[e >> 1] = f2bf(vv[e]); }
                Gp = G;
            }
            *(LAS u32x4*)(L + CA_BHT + swz(k, tq)) = (u32x4){bh4[0], bh4[1], bh4[2], bh4[3]};
            *(LAS u32x4*)(L + CA_KHT + swz(k, tq)) = (u32x4){kh4[0], kh4[1], kh4[2], kh4[3]};
            *(LAS u32x4*)(L + CA_VMT + swz(k, tq)) = (u32x4){vm4[0], vm4[1], vm4[2], vm4[3]};
        }
        __syncthreads();
        CK_FRESH();
        {
            const int p = wave & 3, nb = wave >> 2;
            LAS unsigned char* Am = L + ((p & 1) ? CA_CHI : CA_BET);
            LAS unsigned char* Bm = L + ((p & 2) ? CA_RHO : CA_KAP);
#pragma unroll
            for (int mb = 0; mb < 2; ++mb) {
                f32x16 acc = f32x16{};
                if (!(mb == 1 && nb == 0)) ck_mm(acc, Am, Bm, mb * 32, nb * 32, r32, hi);
                const int t = nb * 32 + r32;
#pragma unroll
                for (int i = 0; i < 16; ++i) { const int j = mb * 32 + crow(i, hi); const bool keep = (p & 2) ? (j <= t) : (j < t); if (!keep) acc[i] = 0.f; }
                if (p == 0) {
#pragma unroll
                    for (int gq = 0; gq < 4; ++gq) *(LAS f32x4*)(L + CA_AB + (t * 64 + mb * 32 + 8 * gq + 4 * hi) * 4) = (f32x4){acc[4 * gq], acc[4 * gq + 1], acc[4 * gq + 2], acc[4 * gq + 3]};
                } else ck_store_t(L + (p == 1 ? CA_AK : p == 2 ? CA_RB : CA_RK), acc, mb * 32, nb * 32, r32, hi);
            }
        }
        __syncthreads();
        CK_FRESH();
        if (wave < 4) {
            const int mb = wave >> 1, nb = wave & 1;
            f32x16 acc = f32x16{};
            ck_mm(acc, L + CA_AK, L + CA_VMT, mb * 32, nb * 32, r32, hi);
#pragma unroll
            for (int i = 0; i < 16; ++i) ((LAS float*)(L + CA_RHS))[(mb * 32 + crow(i, hi)) * 128 + 64 + nb * 32 + r32] = acc[i];
        }
        __syncthreads();
        CK_FRESH();
        if (wave < 2) {
            unsigned abv = (unsigned)(uintptr_t)(L + CA_AB); asm volatile("" : "+v"(abv));
            const LAS float* ab = (const LAS float*)(uintptr_t)abv;
            const LAS float* rhs = (const LAS float*)(L + CA_RHS) + wave * 64 + lane;
            float x[64];
#pragma unroll
            for (int t = 0; t < 64; ++t) {
                float s0 = rhs[t * 128], s1 = 0.f, s2 = 0.f, s3 = 0.f;
#pragma unroll
                for (int j4 = 0; j4 < (t + 3) / 4; ++j4) { const f32x4 av = *(const LAS f32x4*)(ab + t * 64 + 4 * j4);
                    if (4 * j4 + 0 < t) s0 -= av.x * x[4 * j4 + 0];
                    if (4 * j4 + 1 < t) s1 -= av.y * x[4 * j4 + 1];
                    if (4 * j4 + 2 < t) s2 -= av.z * x[4 * j4 + 2];
                    if (4 * j4 + 3 < t) s3 -= av.w * x[4 * j4 + 3]; }
                x[t] = (s0 + s1) + (s2 + s3);
                asm volatile("" : "+v"(x[t])); __builtin_amdgcn_sched_barrier(0);
            }
            LAS unsigned char* dst = L + (wave == 0 ? CA_KAP : CA_BET);
#pragma unroll
            for (int ch = 0; ch < 8; ++ch)
                *(LAS u32x4*)(dst + swz(lane, ch)) = (u32x4){pk2(-x[8 * ch], -x[8 * ch + 1]), pk2(-x[8 * ch + 2], -x[8 * ch + 3]), pk2(-x[8 * ch + 4], -x[8 * ch + 5]), pk2(-x[8 * ch + 6], -x[8 * ch + 7])};
        }
        __syncthreads();
        CK_FRESH();
        {
            const int ty = wave >> 1;
            LAS unsigned char* nW1 = L + CA_KAP; LAS unsigned char* nW2 = L + CA_BET;
#pragma unroll
            for (int qq = 0; qq < 2; ++qq) {
                const int q = (wave & 1) * 2 + qq, qa = q >> 1, qb = q & 1;
                f32x16 acc = f32x16{};
                if (ty == 0) {
                    const int t = qa * 32 + r32;
#pragma unroll
                    for (int gq = 0; gq < 4; ++gq) { const u32x2 rv = *(const LAS u32x2*)(L + CA_RHO + swz(t, qb * 4 + gq) + hi * 8);
                        acc[4 * gq] = bf_lo(rv.x); acc[4 * gq + 1] = bf_hi(rv.x); acc[4 * gq + 2] = bf_lo(rv.y); acc[4 * gq + 3] = bf_hi(rv.y); }
                    ck_mm(acc, nW1, L + CA_RB, qb * 32, qa * 32, r32, hi);
                } else if (ty == 1) {
                    ck_mm(acc, nW1, L + CA_BHT, qb * 32, qa * 32, r32, hi);
                    if (qa == qb) { const float g64 = ((const LAS float*)(L + CA_G64))[qa * 32 + r32];
#pragma unroll
                        for (int i = 0; i < 16; ++i) if (crow(i, hi) == r32) acc[i] += g64; }
                } else if (ty == 2) {
                    ck_mm(acc, L + CA_KHT, L + CA_VMT, qb * 32, qa * 32, r32, hi);
                    ck_mm(acc, L + CA_BHT, nW2, qb * 32, qa * 32, r32, hi);
                } else {
                    ck_mm(acc, L + CA_RK, L + CA_VMT, qb * 32, qa * 32, r32, hi);
                    ck_mm(acc, L + CA_RB, nW2, qb * 32, qa * 32, r32, hi);
                }
                if (ty < 2) {
                    unsigned char* o = blk + (ty == 0 ? 8192 : 0) + (size_t)(((qa * 2 + qb) * 2) * 1024) + lane * 16;
#pragma unroll
                    for (int ks = 0; ks < 2; ++ks)
                        *(u32x4*)(o + ks * 1024) = (u32x4){pk2(acc[8 * ks], acc[8 * ks + 1]), pk2(acc[8 * ks + 2], acc[8 * ks + 3]), pk2(acc[8 * ks + 4], acc[8 * ks + 5]), pk2(acc[8 * ks + 6], acc[8 * ks + 7])};
                } else if (ty == 2) {
                    float* o = (float*)(blk + 16384 + (qa * 2 + qb) * 4096) + lane;
#pragma unroll
                    for (int i = 0; i < 16; ++i) o[i * 64] = acc[i];
                } else {
                    bf16_t* o = (bf16_t*)(blk + 32768 + (qa * 2 + qb) * 2048) + lane;
#pragma unroll
                    for (int i = 0; i < 16; ++i) o[i * 64] = f2bf(acc[i]);
                }
            }
        }
        __syncthreads();
    }
}

__device__ __forceinline__ void rwkv_chunkB(const ArgsL& a, Frame& F, int bh) {
    const int lane = F.lane, wave = F.wave, r32 = lane & 31, hi = lane >> 5;
    const int b = bh / RW_H, h = bh % RW_H;
    LAS unsigned char* L = F.lds;
    const unsigned char* base = a.ws + WS_RW + (size_t)bh * LPADDED * 768;
    bf16_t* y0 = (bf16_t*)(a.ws + WS_YCAT);
    const bool isld = (wave >= 2 && wave < 7); const int lw = wave - 2;
#define CB_ISSUE(cc) do { const unsigned char* s_ = base + (size_t)(cc) * CK * 768 + (size_t)lw * 1024 + lane * 16; LAS unsigned char* d_ = L + ((cc) % 3) * CKB + lw * 1024; \
        _Pragma("unroll") for (int r_ = 0; r_ < 8; ++r_) __builtin_amdgcn_global_load_lds((const unsigned*)(s_ + r_ * 5120), (LAS unsigned*)(d_ + r_ * 5120), 16, 0, 0); } while (0)
    if (isld) { CB_ISSUE(0); CB_ISSUE(1); asm volatile("s_waitcnt vmcnt(8)" ::: "memory"); }
    asm volatile("s_waitcnt lgkmcnt(0)\n\ts_barrier" ::: "memory");
    f32x16 Z0 = f32x16{}, Z1 = f32x16{};
    for (int c = 0; c < NCK; ++c) {
        if (isld) {
            if (c + 2 < NCK) CB_ISSUE(c + 2);
            if (c + 2 < NCK) asm volatile("s_waitcnt vmcnt(8)" ::: "memory"); else asm volatile("s_waitcnt vmcnt(0)" ::: "memory");
        } else if (wave < 2) {
            const LAS unsigned char* S = L + (c % 3) * CKB;
            const int vb = wave;
            bf16x8 zf[2][2];
#pragma unroll
            for (int ks = 0; ks < 2; ++ks) {
                zf[0][ks] = __builtin_bit_cast(bf16x8, (u32x4){pk2(Z0[8 * ks], Z0[8 * ks + 1]), pk2(Z0[8 * ks + 2], Z0[8 * ks + 3]), pk2(Z0[8 * ks + 4], Z0[8 * ks + 5]), pk2(Z0[8 * ks + 6], Z0[8 * ks + 7])});
                zf[1][ks] = __builtin_bit_cast(bf16x8, (u32x4){pk2(Z1[8 * ks], Z1[8 * ks + 1]), pk2(Z1[8 * ks + 2], Z1[8 * ks + 3]), pk2(Z1[8 * ks + 4], Z1[8 * ks + 5]), pk2(Z1[8 * ks + 6], Z1[8 * ks + 7])});
            }
#pragma unroll
            for (int tb = 0; tb < 2; ++tb) {
                f32x16 acc;
                const LAS bf16_t* yt = (const LAS bf16_t*)(S + 32768 + (vb * 2 + tb) * 2048) + lane;
#pragma unroll
                for (int i = 0; i < 16; ++i) acc[i] = bf2f(yt[i * 64]);
#pragma unroll
                for (int kb2 = 0; kb2 < 2; ++kb2)
#pragma unroll
                    for (int ks = 0; ks < 2; ++ks) { const bf16x8 pa = *(const LAS bf16x8*)(S + 8192 + ((tb * 2 + kb2) * 2 + ks) * 1024 + lane * 16);
                        acc = __builtin_amdgcn_mfma_f32_32x32x16_bf16(pa, zf[kb2][ks], acc, 0, 0, 0); }
#pragma unroll
                for (int i = 0; i < 16; ++i) { const int l = c * CK + tb * 32 + crow(i, hi);
                    if (l < LTOK) y0[(size_t)(b * T + PADR + l) * RW_W + h * 64 + vb * 32 + r32] = f2bf(acc[i]); }
            }
            f32x16 N0, N1;
            { const LAS float* n0 = (const LAS float*)(S + 16384 + (vb * 2 + 0) * 4096) + lane; const LAS float* n1 = (const LAS float*)(S + 16384 + (vb * 2 + 1) * 4096) + lane;
#pragma unroll
              for (int i = 0; i < 16; ++i) { N0[i] = n0[i * 64]; N1[i] = n1[i * 64]; } }
#pragma unroll
            for (int kb2 = 0; kb2 < 2; ++kb2)
#pragma unroll
                for (int ks = 0; ks < 2; ++ks) {
                    const bf16x8 m0 = *(const LAS bf16x8*)(S + ((0 * 2 + kb2) * 2 + ks) * 1024 + lane * 16);
                    const bf16x8 m1 = *(const LAS bf16x8*)(S + ((1 * 2 + kb2) * 2 + ks) * 1024 + lane * 16);
                    N0 = __builtin_amdgcn_mfma_f32_32x32x16_bf16(m0, zf[kb2][ks], N0, 0, 0, 0);
                    N1 = __builtin_amdgcn_mfma_f32_32x32x16_bf16(m1, zf[kb2][ks], N1, 0, 0, 0);
                }
            Z0 = N0; Z1 = N1;
        }
        asm volatile("s_waitcnt lgkmcnt(0)\n\ts_barrier" ::: "memory");
    }
    asm volatile("s_waitcnt vmcnt(0) lgkmcnt(0)\n\ts_barrier" ::: "memory");
#undef CB_ISSUE
}

constexpr int N_FX_UNITS = 65 * 10, N_SB_UNITS = 65 * 10, N_RW_WG = 192;
#ifndef REP_SCAN
#define REP_SCAN 1
#endif
#ifndef REP_SCAN_DRY
#define REP_SCAN_DRY 0
#endif
#ifndef REP_FOX
#define REP_FOX 1
#endif
#ifndef REP_SB
#define REP_SB 1
#endif
__device__ __forceinline__ void phase_mix(const ArgsL& a, Frame& F, int layer) {
#ifdef SEQ_SCAN
    if (F.bx < N_RW_WG) { int nr = REP_SCAN; asm volatile("" : "+s"(nr)); for (int r = 0; r < nr; ++r) rwkv_scan(a, F, F.bx, (r + 1 < nr) ? REP_SCAN_DRY : 0); }
#else
    if (F.bx < 12) rwkv_chunkB(a, F, F.bx);
#endif
    float gqm = fabsf(a.in(I_QG)[layer * 64 + F.lane]), gkm = fabsf(a.in(I_KG)[layer * 64 + F.lane]);
#pragma unroll
    for (int off = 1; off < 64; off <<= 1) { gqm = fmaxf(gqm, __shfl_xor(gqm, off)); gkm = fmaxf(gkm, __shfl_xor(gkm, off)); }
    const float bound = 64.0f * C2 * gqm * gkm * 1.02f + 0.5f;
    unsigned* head = (unsigned*)(a.ws + WS_CTL) + CW_QUEUE + 64 * layer;
    for (;;) {
        if (F.tid == 0) F.MISC[16] = __hip_atomic_fetch_add(head, 1u, __ATOMIC_RELAXED, __HIP_MEMORY_SCOPE_AGENT);
        __syncthreads();
        const int u = (int)F.MISC[16];
        __syncthreads();
        if (u >= N_FX_UNITS + N_SB_UNITS) break;
        if (u < N_FX_UNITS) { const int qb = 64 - u / 10, bh = u % 10; int nr = REP_FOX; asm volatile("" : "+s"(nr)); for (int r = 0; r < nr; ++r) attn_unit<0>(a, F, bh / FX_H, bh % FX_H, qb, bound); }
        else { const int v = u - N_FX_UNITS; const int qb = 64 - v / 10, bh = v % 10; int nr = REP_SB; asm volatile("" : "+s"(nr)); for (int r = 0; r < nr; ++r) attn_unit<1>(a, F, bh / SB_H, bh % SB_H, qb, bound); }
    }
}

__device__ __forceinline__ void phase_post(const ArgsL& a, Frame& F, int layer) {
    const int gw = F.bx * NWAVES + F.wave, NGW = gridDim.x * NWAVES, lane = F.lane;
    bf16_t* Y0 = (bf16_t*)(a.ws + WS_YCAT); const bf16_t* BN = (const bf16_t*)(a.ws + WS_BN);
    float lg[6], lb[6];
    { const float* g = a.in(I_LNG) + layer * RW_W + lane; const float* bb = a.in(I_LNB) + layer * RW_W + lane;
#pragma unroll
      for (int hh = 0; hh < 6; ++hh) { lg[hh] = g[hh * 64]; lb[hh] = bb[hh * 64]; } }
    unsigned short yv[6], bv[6], yn[6], bn[6];
    int m = gw;
    if (m < M) {
#pragma unroll
        for (int hh = 0; hh < 6; ++hh) { yv[hh] = Y0[(size_t)m * RW_W + hh * 64 + lane]; bv[hh] = BN[(size_t)m * RW_W + hh * 64 + lane]; }
    }
    for (; m < M; m += NGW) {
        const int mn = m + NGW;
        if (mn < M) {
#pragma unroll
            for (int hh = 0; hh < 6; ++hh) { yn[hh] = Y0[(size_t)mn * RW_W + hh * 64 + lane]; bn[hh] = BN[(size_t)mn * RW_W + hh * 64 + lane]; }
        }
        const int b = m / T, p = m - b * T;
        bf16_t* yp = Y0 + (size_t)m * RW_W + lane;
        if (p < PADR) {
#pragma unroll
            for (int hh = 0; hh < 6; ++hh) yp[hh * 64] = 0;
        } else {
#pragma unroll
            for (int hh = 0; hh < 6; ++hh) {
                const float y = bf2f(yv[hh]);
                const float mean = wave_sum(y) * (1.f / 64.f);
                const float d = y - mean;
                const float var = wave_sum(d * d) * (1.f / 64.f);
                yp[hh * 64] = f2bf(d * (1.0f / sqrtf(var + 64e-5f)) * lg[hh] + lb[hh] + bf2f(bv[hh]));
            }
        }
#pragma unroll
        for (int hh = 0; hh < 6; ++hh) { yv[hh] = yn[hh]; bv[hh] = bn[hh]; }
    }
    for (int it = gw; it < 2 * M; it += NGW) {
        const int sl = it / M, m2 = it - sl * M; const int b = m2 / T, p = m2 - b * T;
        bf16_t* row = Y0 + (size_t)(sl + 1) * M * RW_W + (size_t)m2 * RW_W;
        if (p < PADR) { for (int c = lane; c < RW_W / 2; c += 64) ((unsigned*)row)[c] = 0u; }
        else if (lane < 32) ((unsigned*)(row + 320))[lane] = 0u;
    }
}

struct EpiInproj { static constexpr bool PERM = true, AFTER_DRAIN = false; bf16_t* ush; bf16_t* qkv;
    __device__ __forceinline__ void operator()(const f32x4 (&acc)[2][2][4][2], const pg8::Unit& u, int wr, int wc, int fr, int fq) const {
        asm volatile("" : "+v"(fr), "+v"(fq));
        const int row0 = u.pm * 256 + wr * 64 + fr, colt = u.pn * 256 + wc * 32 + 8 * fq;
#pragma unroll
        for (int ai = 0; ai < 2; ++ai)
#pragma unroll
            for (int m = 0; m < 4; ++m) { const size_t row = (size_t)(row0 + ai * 128 + m * 16);
#pragma unroll
                for (int bj = 0; bj < 2; ++bj) { const int col = colt + bj * 128; const f32x4 v0 = acc[ai][bj][m][0], v1 = acc[ai][bj][m][1];
                    const float sc = (col >= SHIFT_W && col < SHIFT_W + 320) ? C2 : 1.0f;
                    u32x4 w; w.x = pk2(v0[0] * sc, v0[1] * sc); w.y = pk2(v0[2] * sc, v0[3] * sc); w.z = pk2(v1[0] * sc, v1[1] * sc); w.w = pk2(v1[2] * sc, v1[3] * sc);
                    if (col < SHIFT_W) *(u32x4*)(ush + row * SHIFT_W + col) = w;
                    else if (col < SHIFT_W + QKV_W) *(u32x4*)(qkv + row * QKV_W + (col - SHIFT_W)) = w; } }
    }
};
struct EpiGates { static constexpr bool PERM = true, AFTER_DRAIN = false; bf16_t* gates;
    __device__ __forceinline__ void operator()(const f32x4 (&acc)[2][2][4][2], const pg8::Unit& u, int wr, int wc, int fr, int fq) const {
        asm volatile("" : "+v"(fr), "+v"(fq));
        const int row0 = u.pm * 256 + wr * 64 + fr, colt = u.pn * 256 + wc * 32 + 8 * fq;
#pragma unroll
        for (int ai = 0; ai < 2; ++ai)
#pragma unroll
            for (int m = 0; m < 4; ++m) { const size_t row = (size_t)(row0 + ai * 128 + m * 16);
#pragma unroll
                for (int bj = 0; bj < 2; ++bj) { const int col = colt + bj * 128; f32x4 v0 = acc[ai][bj][m][0], v1 = acc[ai][bj][m][1];
#pragma unroll
                    for (int q = 0; q < 4; ++q) { v0[q] = __builtin_amdgcn_rcpf(1.f + __builtin_amdgcn_exp2f(-v0[q] * LOG2E)); v1[q] = __builtin_amdgcn_rcpf(1.f + __builtin_amdgcn_exp2f(-v1[q] * LOG2E)); }
                    u32x4 w; w.x = pk2(v0[0], v0[1]); w.y = pk2(v0[2], v0[3]); w.z = pk2(v1[0], v1[1]); w.w = pk2(v1[2], v1[3]);
                    *(u32x4*)(gates + row * 3072 + col) = w; } }
    }
};
struct EpiMerge { static constexpr bool PERM = true, AFTER_DRAIN = false; const bf16_t* gates; bf16_t* merged;
    __device__ __forceinline__ void operator()(const f32x4 (&acc)[2][2][4][2], const pg8::Unit& u, int wr, int wc, int fr, int fq) const {
        asm volatile("" : "+v"(fr), "+v"(fq));
        const int br = u.pn >> 2, pn = u.pn & 3, pm = u.pm - br * 129;
        const int row0 = pm * 256 + wr * 64 + fr, colt = pn * 256 + wc * 32 + 8 * fq;
#pragma unroll
        for (int ai = 0; ai < 2; ++ai)
#pragma unroll
            for (int m = 0; m < 4; ++m) { const size_t row = (size_t)(row0 + ai * 128 + m * 16);
#pragma unroll
                for (int bj = 0; bj < 2; ++bj) { const int col = colt + bj * 128; const f32x4 v0 = acc[ai][bj][m][0], v1 = acc[ai][bj][m][1];
                    const u32x4 g = *(const u32x4*)(gates + row * 3072 + br * 1024 + col);
                    u32x4* mp = (u32x4*)(merged + row * D + col);
                    u32x4 o = (u32x4){0u, 0u, 0u, 0u};
                    if (br > 0) o = *mp;
                    u32x4 w;
                    w.x = pk2(bf_lo(g.x) * v0[0] + bf_lo(o.x), bf_hi(g.x) * v0[1] + bf_hi(o.x));
                    w.y = pk2(bf_lo(g.y) * v0[2] + bf_lo(o.y), bf_hi(g.y) * v0[3] + bf_hi(o.y));
                    w.z = pk2(bf_lo(g.z) * v1[0] + bf_lo(o.z), bf_hi(g.z) * v1[1] + bf_hi(o.z));
                    w.w = pk2(bf_lo(g.w) * v1[2] + bf_lo(o.w), bf_hi(g.w) * v1[3] + bf_hi(o.w));
                    *mp = w; }
                __builtin_amdgcn_sched_barrier(0); }
    }
};
struct MergeOrder { int G, c, ntau;
    __device__ __forceinline__ bool next(int i, pg8::Unit& u) const { const int it = i / 3, br = i - 3 * it; const long tau = (long)it * G + c; if (tau >= ntau) return false;
        const int t = (int)(tau % 516); u.pm = br * 129 + (t >> 2); u.pn = br * 4 + (t & 3); return true; }
    __device__ __forceinline__ void a_ready(const pg8::Unit&) const {}
    __device__ __forceinline__ void done(const pg8::Unit&) const {}
};
struct EpiOut { static constexpr bool PERM = true, AFTER_DRAIN = false; ArgsL a;
    __device__ __forceinline__ void operator()(const f32x4 (&acc)[2][2][4][2], const pg8::Unit& u, int wr, int wc, int fr, int fq) const {
        asm volatile("" : "+v"(fr), "+v"(fq));
        const int row0 = u.pm * 256 + wr * 64 + fr, colt = u.pn * 256 + wc * 32 + 8 * fq;
#pragma unroll
        for (int ai = 0; ai < 2; ++ai)
#pragma unroll
            for (int m = 0; m < 4; ++m) { const int row = row0 + ai * 128 + m * 16; const int b = row / T, p = row - b * T, l = p - PADR;
                if (l < 0) continue;
                float* hp = hrow(a, b, l);
#pragma unroll
                for (int bj = 0; bj < 2; ++bj) { const int col = colt + bj * 128; f32x4* h4 = (f32x4*)(hp + col);
                    h4[0] = h4[0] + acc[ai][bj][m][0]; h4[1] = h4[1] + acc[ai][bj][m][1]; } }
    }
};
struct MoeOrder { const volatile LAS int* tb; int ntile, npt, G, c, rep;
    __device__ __forceinline__ bool next(int i, pg8::Unit& u) const { long L = (long)i * G + c; if (L >= (long)ntile * npt * rep) return false; L %= (long)ntile * npt;
        const int tau = (int)(L / npt), j = (int)(L - (long)tau * npt); int e = 0;
#pragma unroll
        for (int k = 1; k < 16; ++k) e += (tau >= tb[k]) ? 1 : 0;
        u.pm = tau; u.pn = __builtin_amdgcn_readfirstlane(e) * npt + j; return true; }
    __device__ __forceinline__ void a_ready(const pg8::Unit&) const {}
    __device__ __forceinline__ void done(const pg8::Unit&) const {}
};
struct EpiMoeUp { static constexpr bool PERM = true, AFTER_DRAIN = false; bf16_t* hs;
    __device__ __forceinline__ void operator()(const f32x4 (&acc)[2][2][4][2], const pg8::Unit& u, int wr, int wc, int fr, int fq) const {
        asm volatile("" : "+v"(fr), "+v"(fq));
        const int row0 = u.pm * 256 + wr * 64 + fr, col = (u.pn & 1) * 128 + wc * 32 + 8 * fq;
#pragma unroll
        for (int ai = 0; ai < 2; ++ai)
#pragma unroll
            for (int m = 0; m < 4; ++m) { const size_t row = (size_t)(row0 + ai * 128 + m * 16); float r[8];
#pragma unroll
                for (int n = 0; n < 2; ++n)
#pragma unroll
                    for (int q = 0; q < 4; ++q) { const float gte = acc[ai][0][m][n][q], up = acc[ai][1][m][n][q]; r[4 * n + q] = gte * __builtin_amdgcn_rcpf(1.f + __builtin_amdgcn_exp2f(-gte * LOG2E)) * up; }
                u32x4 w; w.x = pk2(r[0], r[1]); w.y = pk2(r[2], r[3]); w.z = pk2(r[4], r[5]); w.w = pk2(r[6], r[7]);
                *(u32x4*)(hs + row * DEXP + col) = w; }
    }
};
struct EpiMoeDown { static constexpr bool PERM = true, AFTER_DRAIN = false; bf16_t* y; const float* cws;
    __device__ __forceinline__ void operator()(const f32x4 (&acc)[2][2][4][2], const pg8::Unit& u, int wr, int wc, int fr, int fq) const {
        asm volatile("" : "+v"(fr), "+v"(fq));
        const int row0 = u.pm * 256 + wr * 64 + fr, colt = (u.pn & 3) * 256 + wc * 32 + 8 * fq;
#pragma unroll
        for (int ai = 0; ai < 2; ++ai)
#pragma unroll
            for (int m = 0; m < 4; ++m) { const size_t row = (size_t)(row0 + ai * 128 + m * 16); const float cw = cws[row];
#pragma unroll
                for (int bj = 0; bj < 2; ++bj) { const int col = colt + bj * 128; const f32x4 v0 = acc[ai][bj][m][0] * cw, v1 = acc[ai][bj][m][1] * cw;
                    u32x4 w; w.x = pk2(v0[0], v0[1]); w.y = pk2(v0[2], v0[3]); w.z = pk2(v1[0], v1[1]); w.w = pk2(v1[2], v1[3]);
                    *(u32x4*)(y + row * D + col) = w; }
                __builtin_amdgcn_sched_barrier(0); }
    }
};

#ifndef PH_MASK
#define PH_MASK 0xFFFF
#endif
#define PH(k) ((PH_MASK >> (k)) & 1)
#ifndef PROBE_DUP
#define PROBE_DUP 0
#endif
#define DUPN(bit) (((PROBE_DUP >> (bit)) & 1) ? 2 : 1)
#define FRESH() do { asm volatile("" : "+v"(F.tid)); F.lane = F.tid & 63; F.wave = __builtin_amdgcn_readfirstlane(F.tid >> 6); { int bx_ = (int)blockIdx.x; asm volatile("" : "+s"(bx_)); F.bx = bx_; } { unsigned char* w_ = a.ws; asm volatile("" : "+s"(w_)); a.ws = w_; } } while (0)
__global__ void __launch_bounds__(NTHR, 2) hybrid_fwd(Args ka) {
    extern __shared__ __attribute__((aligned(16))) unsigned char lds_raw[];
    Frame F;
    F.lds = (LAS unsigned char*)lds_raw;
    F.MISC = (volatile LAS unsigned*)(F.lds + MISC_OFF);
    F.tid = threadIdx.x; F.lane = F.tid & 63; F.wave = __builtin_amdgcn_readfirstlane(F.tid >> 6); F.bx = (int)blockIdx.x;
    for (int u = F.tid; u < (LDS_BYTES - MISC_OFF) / 4; u += NTHR) ((LAS unsigned*)(F.lds + MISC_OFF))[u] = 0u;
    __syncthreads();
    if (F.tid < 29) { const unsigned long long p = (unsigned long long)ka.in[F.tid]; F.MISC[64 + 2 * F.tid] = (unsigned)p; F.MISC[65 + 2 * F.tid] = (unsigned)(p >> 32); }
    __syncthreads();
    ArgsL a; a.tab = F.MISC + 64; a.out = ka.out; a.ws = ka.ws;
    XcdBarrier bar = xcd_barrier_post((unsigned*)(a.ws + WS_CTL) + CW_BAR, F.MISC + 8);
    const int G = (int)gridDim.x, c = (int)blockIdx.x;
    PG8_LAS unsigned char* ring = (PG8_LAS unsigned char*)F.lds;

    for (int layer = 0; layer < DEPTH; ++layer) {
        for (int rep = 0; rep < DUPN(8); ++rep) { FRESH(); if (PH(0)) phase_wconv(a, F, layer); }
        __syncthreads();
        FRESH(); if (PH(1)) phase_norm<1>(a, F, layer);
        xcd_barrier(bar);
        FRESH(); if (PH(2)) {
            pg8::Gemm g{(const bf16_t*)(a.ws + WS_A), (const bf16_t*)(a.ws + WS_WIN), M, N1, D}; pg8::StaticOrder S; S.init(M, N1, G, c, DUPN(3));
            EpiInproj E{(bf16_t*)(a.ws + WS_USH), (bf16_t*)(a.ws + WS_QKV)};
            pg8::gemm_phase<EpiInproj, pg8::StaticOrder, true, true>(ring, g, S, E);
        }
        xcd_barrier(bar);
        FRESH(); if (PH(3)) phase_prep(a, F, layer);
        xcd_barrier(bar);
#ifndef SEQ_SCAN
        FRESH(); if (PH(4)) phase_chunkA(a, F);
        xcd_barrier(bar);
#endif
        FRESH(); if (PH(4)) phase_mix(a, F, layer);
        xcd_barrier(bar);
        FRESH(); if (PH(5)) phase_post(a, F, layer);
        FRESH(); if (PH(6)) {
            pg8::Gemm g{(const bf16_t*)(a.ws + WS_A), (const bf16_t*)(a.ws + WS_WG), M, 3072, D}; pg8::StaticOrder S; S.init(M, 3072, G, c, DUPN(4));
            EpiGates E{(bf16_t*)(a.ws + WS_GATES)};
            pg8::gemm_phase<EpiGates, pg8::StaticOrder, true, true>(ring, g, S, E);
        }
        xcd_barrier(bar);
        FRESH(); if (PH(7)) {
            int kdim = RW_W; asm volatile("" : "+s"(kdim));
            pg8::Gemm g{(const bf16_t*)(a.ws + WS_YCAT), (const bf16_t*)(a.ws + WS_WP), 3 * M, 3072, kdim}; MergeOrder S{G, c, 516 * DUPN(5)};
            EpiMerge E{(const bf16_t*)(a.ws + WS_GATES), (bf16_t*)(a.ws + WS_MERGED)};
            pg8::gemm_phase<EpiMerge, MergeOrder, false, true>(ring, g, S, E);
        }
        xcd_barrier(bar);
        FRESH(); if (PH(8)) {
            pg8::Gemm g{(const bf16_t*)(a.ws + WS_MERGED), (const bf16_t*)(a.ws + WS_WO), M, D, D}; pg8::StaticOrder S; S.init(M, D, G, c, 1);
            EpiOut E{a};
            pg8::gemm_phase<EpiOut, pg8::StaticOrder, true, true>(ring, g, S, E);
        }
        xcd_barrier(bar);
        FRESH(); if (PH(9)) phase_norm<2>(a, F, layer);
        xcd_barrier(bar);
        for (int rep = 0; rep < DUPN(7); ++rep) { FRESH(); if (PH(10)) phase_route(a, F, layer); }
        xcd_barrier(bar);
        volatile LAS int* tb = (volatile LAS int*)(F.MISC + 32);
        if (F.tid <= 16) { const int* cnt = (const int*)(a.ws + WS_CTL) + CW_ECNT + 64 * layer; int t = 0;
            for (int e = 0; e < F.tid; ++e) t += (__hip_atomic_load(cnt + e, __ATOMIC_RELAXED, __HIP_MEMORY_SCOPE_AGENT) + 255) >> 8;
            tb[F.tid] = t; }
        __syncthreads();
        const int ntile = tb[16];
        FRESH(); if (PH(11)) {
            pg8::Gemm g{(const bf16_t*)(a.ws + WS_AS), (const bf16_t*)(a.ws + WS_WGU), MS, 8192, D}; MoeOrder S{tb, ntile, 2, G, c, DUPN(6)};
            EpiMoeUp E{(bf16_t*)(a.ws + WS_HS)};
            pg8::gemm_phase<EpiMoeUp, MoeOrder, true, true>(ring, g, S, E);
        }
        xcd_barrier(bar);
        FRESH(); if (PH(12)) {
            int kdim = DEXP; asm volatile("" : "+s"(kdim));
            pg8::Gemm g{(const bf16_t*)(a.ws + WS_HS), (const bf16_t*)(a.ws + WS_WD), MS, 16384, kdim}; MoeOrder S{tb, ntile, 4, G, c, DUPN(6)};
            EpiMoeDown E{(bf16_t*)(a.ws + WS_Y), (const float*)(a.ws + WS_CWS)};
            pg8::gemm_phase<EpiMoeDown, MoeOrder, true, true>(ring, g, S, E);
        }
        xcd_barrier(bar);
    }
    FRESH(); if (PH(13)) phase_norm<0>(a, F, DEPTH - 1);
#ifdef CLOCK_PROBE
    if (blockIdx.x == 0 && F.wave == 0) {
        float c0 = 1.f, c1 = 2.f, c2 = 3.f, c3 = 4.f, c4 = 5.f, c5 = 6.f, c6 = 7.f, c7 = 8.f;
        for (int i = 0; i < CLOCK_PROBE; ++i) {
            asm volatile("v_fma_f32 %0, %0, %0, %0\n\tv_fma_f32 %1, %1, %1, %1\n\tv_fma_f32 %2, %2, %2, %2\n\tv_fma_f32 %3, %3, %3, %3\n\tv_fma_f32 %4, %4, %4, %4\n\tv_fma_f32 %5, %5, %5, %5\n\tv_fma_f32 %6, %6, %6, %6\n\tv_fma_f32 %7, %7, %7, %7"
                         : "+v"(c0), "+v"(c1), "+v"(c2), "+v"(c3), "+v"(c4), "+v"(c5), "+v"(c6), "+v"(c7));
        }
        asm volatile("" :: "v"(c0), "v"(c1), "v"(c2), "v"(c3), "v"(c4), "v"(c5), "v"(c6), "v"(c7));
    }
#endif
}

extern "C" void kernel_launch(void* const* d_in, const int* in_sizes, int n_in, void* d_out, int out_size, void* d_ws, size_t ws_size, hipStream_t stream) {
    static int ready = 0;
    if (ready == 0) {
        if (n_in != 29 || out_size != NB * SEQ * D || ws_size < WS_END) { fprintf(stderr, "kernel_launch: unexpected problem shape (n_in %d, out %d, ws %zu < %zu)\n", n_in, out_size, ws_size, (size_t)WS_END); ready = -1; return; }
        if (hipFuncSetAttribute((const void*)hybrid_fwd, hipFuncAttributeMaxDynamicSharedMemorySize, LDS_BYTES) != hipSuccess) { fprintf(stderr, "kernel_launch: hipFuncSetAttribute failed\n"); ready = -1; return; }
        int per_cu = 0;
        if (hipOccupancyMaxActiveBlocksPerMultiprocessor(&per_cu, (const void*)hybrid_fwd, NTHR, LDS_BYTES) != hipSuccess || per_cu < 1) fprintf(stderr, "kernel_launch: occupancy query says %d\n", per_cu);
        (void)hipGetLastError();
        ready = 1;
    }
    if (ready < 0) return;
    (void)in_sizes;
    if (hipMemsetAsync((char*)d_ws + WS_CTL, 0, CTL_ZERO_BYTES, stream) != hipSuccess) return;
    Args a{};
    for (int i = 0; i < 29; ++i) a.in[i] = (const float*)d_in[i];
    a.out = (float*)d_out; a.ws = (unsigned char*)d_ws;
    hipLaunchKernelGGL(hybrid_fwd, dim3(256), dim3(NTHR), LDS_BYTES, stream, a);
}
```

```cpp
#include <hip/hip_runtime.h>
#include <hip/hip_bf16.h>
#include <cstdio>
#include <cstdint>

#define GAS __attribute__((address_space(1)))
#define LAS __attribute__((address_space(3)))

namespace pg8 {
#define PG8_LAS __attribute__((address_space(3)))
typedef unsigned short bf16_t;
typedef short bf16x8 __attribute__((ext_vector_type(8)));
typedef float f32x4 __attribute__((ext_vector_type(4)));
typedef unsigned u32x4 __attribute__((ext_vector_type(4)));
constexpr int BM = 256, BK = 64, HALF = 128, HTB = HALF * BK * 2  , STAGE_BYTES = 8 * HTB, NXCD = 8, WGM = 8;

__host__ __device__ __forceinline__ int lds_byte(int r, int c) { const int st = (r >> 4) * 2 + (c >> 5), rr = r & 15, cc = c & 31, ob = rr * 64 + cc * 2; return st * 1024 + (ob ^ (((ob >> 9) & 1) << 5)); }
__host__ __device__ __forceinline__ void stage_rc(int b, int& R, int& C) { const int st = b / 1024, sb = b % 1024, swz = sb ^ (((sb >> 9) & 1) << 5); R = (st >> 1) * 16 + swz / 64; C = (st & 1) * 32 + (swz % 64) / 2; }
__host__ __device__ __forceinline__ int perm32(int rho) { const int n = rho >> 4, i = rho & 15; return 8 * (i >> 2) + 4 * n + (i & 3); }

struct Unit { int pm, pn; };
struct Gemm { const bf16_t* A; const bf16_t* Bt; int M, N, K; };

struct StaticOrder {
    int nM, nN, nwg, G, c, rep;
    __host__ __device__ void init(int M, int N, int G_, int c_, int rep_ = 1) { nM = M / BM; nN = N / BM; nwg = nM * nN; G = G_; c = c_; rep = rep_; }
    __host__ __device__ bool next(int i, Unit& u) const {
        const long L = (long)i * G + c; if (L >= (long)nwg * rep) return false;
        int wgid = (int)(L % nwg); { const int q = nwg / NXCD, r = nwg % NXCD, xcd = wgid % NXCD, off = wgid / NXCD; wgid = (xcd < r ? xcd * (q + 1) : r * (q + 1) + (xcd - r) * q) + off; }
        const int nig = WGM * nN, gid = wgid / nig, fm = gid * WGM, gsz = (nM - fm) < WGM ? (nM - fm) : WGM;
        u.pm = fm + ((wgid % nig) % gsz); u.pn = (wgid % nig) / gsz; return true;
    }
    __device__ __forceinline__ void a_ready(const Unit&) const {}
    __device__ __forceinline__ void done(const Unit&) const {}
};
__device__ __forceinline__ unsigned cvt_pk_bf16(float lo, float hi) { unsigned r; asm volatile("v_cvt_pk_bf16_f32 %0, %1, %2" : "=v"(r) : "v"(lo), "v"(hi)); return r; }
template <class Epi, class Sched, bool ALIGN_EPI = false, bool SP2 = false>
__device__ __forceinline__ void gemm_phase(PG8_LAS unsigned char* lds, const Gemm g, const Sched& S, const Epi& E) {
    int tid_ = threadIdx.x; asm volatile("" : "+v"(tid_));
    const int tid = tid_, wid = __builtin_amdgcn_readfirstlane(tid >> 6), lane = tid & 63, wr = wid >> 2, wc = wid & 3, fr = lane & 15, fq = lane >> 4;
    const int K = g.K, nt = K / BK;
    unsigned voffA[2], voffB[2];
#pragma unroll
    for (int i = 0; i < 2; ++i) { int R, C; stage_rc(tid * 16 + i * 8192, R, C); const int Rb = Epi::PERM ? ((R & ~31) + perm32(R & 31)) : R;
        voffA[i] = (unsigned)(R * K + C) * 2u; voffB[i] = (unsigned)(Rb * K + C) * 2u; }
    const size_t kstep = (size_t)(BK * 2);
    const size_t hstep = (size_t)HALF * K * 2;
    const size_t tstep = 2 * hstep;
    const unsigned ldsw = (unsigned)wid * 1024u;
    const int aoff = lds_byte(wr * 64 + fr, fq * 8), boff = lds_byte(wc * 32 + fr, fq * 8);
#define PG8_SA(b, h) (((b) * 2 + (h)) * HTB)
#define PG8_SB(b, h) ((4 + (b) * 2 + (h)) * HTB)
#define PG8_STAGE(bufoff, gbase, voff) do { _Pragma("unroll") for (int _i = 0; _i < 2; ++_i) \
        __builtin_amdgcn_global_load_lds((const unsigned*)((const char*)(gbase) + (voff)[_i]), (PG8_LAS unsigned*)(lds + (bufoff) + ldsw + _i * 8192), 16, 0, 0); } while (0)
#define PG8_LDA(dst, b, h) do { _Pragma("unroll") for (int m = 0; m < 4; ++m) _Pragma("unroll") for (int k = 0; k < 2; ++k) dst[m][k] = *(const PG8_LAS bf16x8*)(lds + PG8_SA(b, h) + aoff + m * 2048 + k * 1024); } while (0)
#define PG8_LDB(dst, b, h) do { _Pragma("unroll") for (int n = 0; n < 2; ++n) _Pragma("unroll") for (int k = 0; k < 2; ++k) dst[n][k] = *(const PG8_LAS bf16x8*)(lds + PG8_SB(b, h) + boff + n * 2048 + k * 1024); } while (0)
#define PG8_MMA(ai, bj, At, Bt) do { __builtin_amdgcn_s_setprio(1); _Pragma("unroll") for (int m = 0; m < 4; ++m) _Pragma("unroll") for (int n = 0; n < 2; ++n) _Pragma("unroll") for (int k = 0; k < 2; ++k) \
        acc[ai][bj][m][n] = __builtin_amdgcn_mfma_f32_16x16x32_bf16(Bt[n][k], At[m][k], acc[ai][bj][m][n], 0, 0, 0); __builtin_amdgcn_s_setprio(0); } while (0)
#define PG8_WAIT_V(n) asm volatile("s_waitcnt vmcnt(" #n ")" ::: "memory")
#define PG8_WAIT_L(n) asm volatile("s_waitcnt lgkmcnt(" #n ")" ::: "memory")
#define PG8_BAR __builtin_amdgcn_s_barrier()
#define PG8_SCHED __builtin_amdgcn_sched_barrier(0)
    Unit cur, nxt; int ui = 0;
    if (!S.next(0, cur)) return;
    f32x4 acc[2][2][4][2];
#pragma unroll
    for (int a = 0; a < 2; ++a)
#pragma unroll
        for (int b = 0; b < 2; ++b)
#pragma unroll
            for (int m = 0; m < 4; ++m)
#pragma unroll
                for (int n = 0; n < 2; ++n) acc[a][b][m][n] = (f32x4){0.f, 0.f, 0.f, 0.f};
    bf16x8 At[4][2], B0[2][2], B1[2][2];
    const char* cA = (const char*)g.A + (size_t)cur.pm * tstep; const char* cB = (const char*)g.Bt + (size_t)cur.pn * tstep;
    S.a_ready(cur);
    if constexpr (SP2) {
        PG8_STAGE(PG8_SB(0, 0), cB, voffB); PG8_STAGE(PG8_SB(0, 1), cB + hstep, voffB); PG8_STAGE(PG8_SA(0, 0), cA, voffA); PG8_STAGE(PG8_SA(0, 1), cA + hstep, voffA);
        if (wr == 1) PG8_BAR;
        PG8_WAIT_V(2); PG8_BAR;
        PG8_STAGE(PG8_SB(1, 0), cB + kstep, voffB); PG8_STAGE(PG8_SA(1, 0), cA + kstep, voffA); PG8_STAGE(PG8_SB(1, 1), cB + hstep + kstep, voffB);
        PG8_WAIT_V(6); PG8_BAR;
    } else {
        PG8_STAGE(PG8_SB(0, 0), cB, voffB); PG8_STAGE(PG8_SA(0, 0), cA, voffA); PG8_STAGE(PG8_SB(0, 1), cB + hstep, voffB); PG8_STAGE(PG8_SA(0, 1), cA + hstep, voffA);
        if (wr == 1) PG8_BAR;
        PG8_WAIT_V(4); PG8_BAR;
        PG8_STAGE(PG8_SB(1, 0), cB + kstep, voffB); PG8_STAGE(PG8_SA(1, 0), cA + kstep, voffA); PG8_STAGE(PG8_SB(1, 1), cB + hstep + kstep, voffB);
        PG8_WAIT_V(6); PG8_BAR;
    }
    for (;;) {
        const bool has_next = S.next(ui + 1, nxt);
        const char* nA = has_next ? (const char*)g.A + (size_t)nxt.pm * tstep : cA; const char* nB = has_next ? (const char*)g.Bt + (size_t)nxt.pn * tstep : cB;
        for (int t = 0; t < nt; t += 2) {
            const bool last = (t == nt - 2);
            const char* a1 = cA + (size_t)(t + 1) * kstep;
            const char* a2 = last ? nA : cA + (size_t)(t + 2) * kstep; const char* b2 = last ? nB : cB + (size_t)(t + 2) * kstep;
            const char* a3 = a2 + kstep; const char* b3 = b2 + kstep;
            if (last && has_next) S.a_ready(nxt);
            if constexpr (SP2) {
            PG8_LDB(B0, 0, 0); PG8_LDB(B1, 0, 1); PG8_SCHED; PG8_LDA(At, 0, 0); PG8_STAGE(PG8_SA(1, 1), a1 + hstep, voffA);
            PG8_WAIT_V(8); PG8_WAIT_L(0); PG8_BAR; PG8_MMA(0, 0, At, B0); PG8_MMA(0, 1, At, B1); PG8_BAR; PG8_SCHED;
            PG8_LDA(At, 0, 1); PG8_STAGE(PG8_SB(0, 0), b2, voffB); PG8_STAGE(PG8_SB(0, 1), b2 + hstep, voffB); PG8_STAGE(PG8_SA(0, 0), a2, voffA);
            PG8_WAIT_V(8); PG8_WAIT_L(0); PG8_BAR; PG8_MMA(1, 0, At, B0); PG8_MMA(1, 1, At, B1); PG8_BAR; PG8_SCHED;
            PG8_LDB(B0, 1, 0); PG8_LDB(B1, 1, 1); PG8_SCHED; PG8_LDA(At, 1, 0); PG8_STAGE(PG8_SA(0, 1), a2 + hstep, voffA);
            PG8_WAIT_V(8); PG8_WAIT_L(0); PG8_BAR; PG8_MMA(0, 0, At, B0); PG8_MMA(0, 1, At, B1); PG8_BAR; PG8_SCHED;
            PG8_LDA(At, 1, 1); PG8_STAGE(PG8_SB(1, 0), b3, voffB); PG8_STAGE(PG8_SB(1, 1), b3 + hstep, voffB); PG8_STAGE(PG8_SA(1, 0), a3, voffA);
            PG8_WAIT_V(8); PG8_WAIT_L(0); PG8_BAR; PG8_MMA(1, 0, At, B0); PG8_MMA(1, 1, At, B1); PG8_BAR; PG8_SCHED;
            } else {
            PG8_LDB(B0, 0, 0); PG8_SCHED; PG8_LDA(At, 0, 0); PG8_STAGE(PG8_SA(1, 1), a1 + hstep, voffA);
            PG8_WAIT_L(8); PG8_BAR; PG8_WAIT_L(0); PG8_MMA(0, 0, At, B0); PG8_BAR; PG8_SCHED;
            PG8_LDB(B1, 0, 1); PG8_STAGE(PG8_SB(0, 0), b2, voffB);
            PG8_BAR; PG8_WAIT_L(0); PG8_MMA(0, 1, At, B1); PG8_BAR;
            PG8_LDA(At, 0, 1); PG8_STAGE(PG8_SA(0, 0), a2, voffA);
            PG8_BAR; PG8_WAIT_L(0); PG8_MMA(1, 0, At, B0); PG8_BAR; PG8_SCHED;
            PG8_STAGE(PG8_SB(0, 1), b2 + hstep, voffB);
            PG8_WAIT_V(6); PG8_BAR; PG8_MMA(1, 1, At, B1); PG8_BAR;
            PG8_LDB(B0, 1, 0); PG8_SCHED; PG8_LDA(At, 1, 0); PG8_STAGE(PG8_SA(0, 1), a2 + hstep, voffA);
            PG8_WAIT_L(8); PG8_BAR; PG8_WAIT_L(0); PG8_MMA(0, 0, At, B0); PG8_BAR; PG8_SCHED;
            PG8_LDB(B1, 1, 1); PG8_STAGE(PG8_SB(1, 0), b3, voffB);
            PG8_BAR; PG8_WAIT_L(0); PG8_MMA(0, 1, At, B1); PG8_BAR;
            PG8_LDA(At, 1, 1); PG8_STAGE(PG8_SA(1, 0), a3, voffA);
            PG8_BAR; PG8_WAIT_L(0); PG8_MMA(1, 0, At, B0); PG8_BAR; PG8_SCHED;
            PG8_STAGE(PG8_SB(1, 1), b3 + hstep, voffB);
            PG8_WAIT_V(6); PG8_BAR; PG8_MMA(1, 1, At, B1); PG8_BAR;
            }
        }
        if constexpr (ALIGN_EPI) { if (wr == 0) PG8_BAR; }
        if constexpr (!Epi::AFTER_DRAIN) { E(acc, cur, wr, wc, fr, fq); S.done(cur); }
        if (!has_next) break;
#pragma unroll
        for (int a = 0; a < 2; ++a)
#pragma unroll
            for (int b = 0; b < 2; ++b)
#pragma unroll
                for (int m = 0; m < 4; ++m)
#pragma unroll
                    for (int n = 0; n < 2; ++n) acc[a][b][m][n] = (f32x4){0.f, 0.f, 0.f, 0.f};
        cur = nxt; cA = nA; cB = nB; ++ui;
        if constexpr (ALIGN_EPI) { if (wr == 1) PG8_BAR; }
    }
    PG8_WAIT_V(0);
    if constexpr (!ALIGN_EPI) { if (wr == 0) PG8_BAR; }
    PG8_BAR;
    if constexpr (Epi::AFTER_DRAIN) { E.fused(acc, cur, wr, wc, fr, fq, lds, wid, lane); S.done(cur); }
#undef PG8_SA
#undef PG8_SB
#undef PG8_STAGE
#undef PG8_LDA
#undef PG8_LDB
#undef PG8_MMA
#undef PG8_WAIT_V
#undef PG8_WAIT_L
#undef PG8_BAR
#undef PG8_SCHED
}
}

constexpr int D = 1024, NB = 2, SEQ = 16384, NMETA = 16, LTOK = SEQ + NMETA  , PADR = 112, T = PADR + LTOK  ;
constexpr int M = NB * T;
constexpr int DEPTH = 2, HD = 64, RW_H = 6, SB_H = 5, FX_H = 5, RW_W = 384, SHIFT_W = 1280, D_IN = 6277;
constexpr int QKV_W = 1920;
constexpr int N1 = 3328;
constexpr int FCOL = 3200, GCOL = 3205;
constexpr int NEXP = 16, DEXP = 256;
constexpr int MS = 70144;
constexpr int LCH = 32, LPADDED = 16448;
constexpr int KBP = 16896;
constexpr float C2 = 0.125f * 1.4426950408889634f;
constexpr float LOG2E = 1.4426950408889634f;
constexpr int NWAVES = 8, NTHR = 512;

constexpr size_t MiB = 1u << 20;
constexpr size_t WS_CTL = 0, CTL_ZERO_BYTES = 65536;
constexpr size_t WS_HM = 1 * MiB;
constexpr size_t WS_LOGF = WS_HM + 131072;
constexpr size_t WS_KB2 = WS_LOGF + (size_t)M * 32;
constexpr size_t WS_TOK = WS_KB2 + (size_t)10 * KBP * 4;
constexpr size_t WS_SLOT = WS_TOK + (size_t)M * 32;
constexpr size_t WS_CWS = WS_SLOT + (size_t)M * 8;
constexpr size_t WS_WGCNT = WS_CWS + (size_t)MS * 4;
constexpr size_t WS_SMALL_END = WS_WGCNT + 256 * 16 * 4;
static_assert(WS_SMALL_END <= 8 * MiB, "small buffers");
constexpr size_t WS_WIN = 8 * MiB;
constexpr size_t WS_WG = WS_WIN + (size_t)N1 * 1024 * 2;
constexpr size_t WS_WP = WS_WG + (size_t)3072 * 1024 * 2;
constexpr size_t WS_WO = WS_WP + (size_t)3072 * 384 * 2;
constexpr size_t WS_WGU = WS_WO + (size_t)1024 * 1024 * 2;
constexpr size_t WS_WD = WS_WGU + (size_t)8192 * 1024 * 2;
constexpr size_t WS_W_END = WS_WD + (size_t)16384 * 256 * 2;
static_assert(WS_W_END <= 49 * MiB, "weights");
constexpr size_t WS_A = 49 * MiB;
constexpr size_t WS_BIG = 115 * MiB;
constexpr size_t WS_USH = WS_BIG;
constexpr size_t WS_YCAT = WS_BIG;
constexpr size_t WS_QKV = WS_BIG + 82 * MiB;
constexpr size_t WS_RW = WS_BIG + 204 * MiB;
constexpr size_t WS_BN = WS_BIG + 349 * MiB;
constexpr size_t WS_GATES = WS_BIG + 82 * MiB;
constexpr size_t WS_MERGED = WS_BIG + 276 * MiB;
constexpr size_t WS_AS = WS_BIG;
constexpr size_t WS_HS = WS_BIG + 137 * MiB;
constexpr size_t WS_Y = WS_BIG + 172 * MiB;
constexpr size_t WS_END = WS_BIG + 374 * MiB;
static_assert((size_t)(M + 256) * 1280 * 2 <= 82 * MiB && (size_t)3 * M * 384 * 2 <= 82 * MiB && (size_t)(M + 256) * 1920 * 2 <= 122 * MiB, "big map 1");
static_assert((size_t)12 * LPADDED * 768 <= 145 * MiB && (size_t)M * 384 * 2 <= 25 * MiB && (size_t)M * 3072 * 2 <= 194 * MiB && (size_t)M * 2048 <= 65 * MiB, "big map 2");
static_assert((size_t)MS * 2048 <= 137 * MiB && (size_t)MS * 512 <= 35 * MiB && WS_END <= 489 * MiB, "big map 3");

constexpr int CW_BAR = 0;
constexpr int CW_QUEUE = 4096;
constexpr int CW_ECNT = 4352;
static_assert((CW_ECNT + 128) * 4 <= (int)CTL_ZERO_BYTES, "ctl");

constexpr int RING_BYTES = 131072, MISC_OFF = RING_BYTES, LDS_BYTES = 147456;

typedef unsigned short bf16_t;
typedef float f32x4 __attribute__((ext_vector_type(4)));
typedef float f32x2 __attribute__((ext_vector_type(2)));
typedef float f32x16 __attribute__((ext_vector_type(16)));
typedef unsigned u32x4 __attribute__((ext_vector_type(4)));
typedef unsigned u32x2 __attribute__((ext_vector_type(2)));
typedef short bf16x8 __attribute__((ext_vector_type(8)));
typedef short s16x4 __attribute__((ext_vector_type(4)));
typedef _Float16 f16x4 __attribute__((ext_vector_type(4)));
typedef __bf16 bf16x2_t __attribute__((ext_vector_type(2)));

__device__ __forceinline__ unsigned pk2(float lo, float hi) { f32x2 v = {lo, hi}; bf16x2_t b = __builtin_convertvector(v, bf16x2_t); return __builtin_bit_cast(unsigned, b); }
__device__ __forceinline__ unsigned short f2bf(float f) { return (unsigned short)(pk2(f, 0.f) & 0xffffu); }
__device__ __forceinline__ float bf_lo(unsigned u) { return __uint_as_float(u << 16); }
__device__ __forceinline__ float bf_hi(unsigned u) { return __uint_as_float(u & 0xffff0000u); }
__device__ __forceinline__ float bf2f(unsigned short h) { return __uint_as_float((unsigned)h << 16); }
template <int CTRL> __device__ __forceinline__ float dpp_f(float x) { return __int_as_float(__builtin_amdgcn_update_dpp(0, __float_as_int(x), CTRL, 0xF, 0xF, false)); }
__device__ __forceinline__ float allred16(float p) { p += dpp_f<0x128>(p); p += dpp_f<0x124>(p); p += dpp_f<0x122>(p); p += dpp_f<0x121>(p); return p; }
__device__ __forceinline__ float wave_sum(float v) {
    v = allred16(v);
    { auto sw = __builtin_amdgcn_permlane16_swap(__float_as_uint(v), __float_as_uint(v), false, false); v = __uint_as_float(sw[0]) + __uint_as_float(sw[1]); }
    { auto sw = __builtin_amdgcn_permlane32_swap(__float_as_uint(v), __float_as_uint(v), false, false); v = __uint_as_float(sw[0]) + __uint_as_float(sw[1]); }
    return v;
}
__device__ __forceinline__ float fast_exp(float x) { return __builtin_amdgcn_exp2f(x * LOG2E); }
__device__ __forceinline__ float fast_log(float x) { return __builtin_amdgcn_logf(x) * 0.6931471805599453f; }
__device__ __forceinline__ float softplus_f(float z) { return fmaxf(z, 0.f) + fast_log(1.f + fast_exp(-fabsf(z))); }

#define XB_TMO      128
#define XB_XCNT(j)  (256  + 64 * (j))
#define XB_XSUB(j)  (1280 + 64 * (j))
#define XB_XGEN(j)  (2304 + 64 * (j))
#define XB_TOP      3328
#define XB_TOPGEN   3392
#define XCD_BAR_WORDS 3456
#define XB_SPIN_CAP (1u << 20)
__device__ __forceinline__ unsigned xb_ld(unsigned* p)              { return __hip_atomic_load(p, __ATOMIC_RELAXED, __HIP_MEMORY_SCOPE_AGENT); }
__device__ __forceinline__ unsigned xb_add(unsigned* p, unsigned v) { return __hip_atomic_fetch_add(p, v, __ATOMIC_RELAXED, __HIP_MEMORY_SCOPE_AGENT); }
__device__ __forceinline__ unsigned xb_xcc_id() { return (unsigned)__builtin_amdgcn_s_getreg((3 << 11) | 20) & 0xFu; }
#define XB_SPIN(cond, bar) do { unsigned _sp = 0; while (cond) { __builtin_amdgcn_s_sleep(1); \
    if ((++_sp & 255u) == 0u) { if (xb_ld(&(bar)[XB_TMO])) break; if (_sp > XB_SPIN_CAP) { atomicAdd(&(bar)[XB_TMO], 1u); break; } } } } while (0)

struct XcdBarrier {
    unsigned* bar; unsigned x;
    volatile LAS unsigned* st;
};

__device__ __forceinline__ XcdBarrier xcd_barrier_post(unsigned* bar, volatile LAS unsigned* st) {
    XcdBarrier b; b.bar = bar; b.x = xb_xcc_id(); b.st = st;
    if (threadIdx.x == 0) (void)xb_add(&bar[XB_XCNT(b.x)], 1u);
    return b;
}
__device__ __forceinline__ void xcd_barrier_complete(unsigned* bar, unsigned x, unsigned& nloc, unsigned& nx) {
    const unsigned G = gridDim.x * gridDim.y * gridDim.z;
    unsigned sum, cnt, mine, sp = 0u;
    for (;;) {
        sum = 0u; cnt = 0u; mine = 0u;
#pragma unroll
        for (unsigned j = 0; j < 16; ++j) { const unsigned c = xb_ld(&bar[XB_XCNT(j)]); sum += c; cnt += (c > 0u) ? 1u : 0u; mine = (j == x) ? c : mine; }
        if (sum == G) break;
        __builtin_amdgcn_s_sleep(1);
        if ((++sp & 255u) == 0u) { if (xb_ld(&bar[XB_TMO])) break; if (sp > XB_SPIN_CAP) { atomicAdd(&bar[XB_TMO], 1u); break; } }
    }
    nloc = mine > 0u ? mine : 1u; nx = cnt > 0u ? cnt : 1u;
}

__device__ __forceinline__ void xcd_barrier(const XcdBarrier& b) {
    asm volatile("s_waitcnt vmcnt(0)" ::: "memory");
    __syncthreads();
    if (threadIdx.x == 0) {
        unsigned* bar = b.bar;
        __builtin_amdgcn_s_waitcnt(0);
        unsigned nloc = b.st[0], nx = b.st[1];
        if (nloc == 0u) { xcd_barrier_complete(bar, b.x, nloc, nx); b.st[0] = nloc; b.st[1] = nx; }
        const unsigned old = xb_add(&bar[XB_XSUB(b.x)], 1u);
        const unsigned gen = old / nloc;
        if (old + 1u == (gen + 1u) * nloc) {
            __builtin_amdgcn_fence(__ATOMIC_RELEASE, "agent");
            asm volatile("s_waitcnt vmcnt(0)" ::: "memory");
            const unsigned og = xb_add(&bar[XB_TOP], 1u);
            const unsigned tg = og / nx;
            if (og + 1u == (tg + 1u) * nx) xb_add(&bar[XB_TOPGEN], 1u);
            else XB_SPIN(xb_ld(&bar[XB_TOPGEN]) == tg, bar);
            __builtin_amdgcn_fence(__ATOMIC_ACQUIRE, "agent");
            xb_add(&bar[XB_XGEN(b.x)], 1u);
            asm volatile("s_waitcnt vmcnt(0)" ::: "memory");
        } else {
            XB_SPIN(xb_ld(&bar[XB_XGEN(b.x)]) == gen, bar);
            __builtin_amdgcn_fence(__ATOMIC_ACQUIRE, "agent");
            asm volatile("s_waitcnt vmcnt(0)" ::: "memory");
        }
    }
    __syncthreads();
}

struct Args { const float* in[29]; float* out; unsigned char* ws; };
enum { I_X = 0, I_META, I_N1G, I_WIN, I_MU, I_WUP, I_W0, I_AUP, I_A0, I_KK, I_KA, I_RK, I_LNG, I_LNB, I_FB, I_QG, I_KG, I_WPR, I_WPS, I_WPF, I_WOUT, I_N2G, I_MWG, I_MBG, I_MWE, I_MBE, I_MGATE, I_MUP, I_MDOWN };
struct ArgsL { volatile LAS unsigned* tab; float* out; unsigned char* ws;
    __device__ __forceinline__ const float* in(int i) const { const unsigned lo = tab[2 * i], hi = tab[2 * i + 1];
        return (const float*)(((unsigned long long)(unsigned)__builtin_amdgcn_readfirstlane((int)hi) << 32) | (unsigned long long)(unsigned)__builtin_amdgcn_readfirstlane((int)lo)); }
};
struct Frame { LAS unsigned char* lds; volatile LAS unsigned* MISC; int tid, lane, wave, bx; };

__device__ __forceinline__ float* hrow(const ArgsL& a, int b, int l) {
    return l < NMETA ? (float*)(a.ws + WS_HM) + (size_t)(b * NMETA + l) * D : a.out + ((size_t)b * SEQ + (l - NMETA)) * D;
}
#define LDS_WAIT() asm volatile("s_waitcnt lgkmcnt(0)" ::: "memory")

__device__ __forceinline__ void tr_item(const float* W, int ldw, int sc0, int nvalid, int k0, int kvalid, bf16_t* WT, int Kd, int r0, LAS float* scr, int lane) {
    float tv[32];
#pragma unroll
    for (int i = 0; i < 32; ++i) { const int kk = 2 * i + (lane >> 5), n = lane & 31; tv[i] = 0.f;
        if (n < nvalid && k0 + kk < kvalid) tv[i] = W[(size_t)(k0 + kk) * ldw + sc0 + n]; }
#pragma unroll
    for (int i = 0; i < 32; ++i) { const int kk = 2 * i + (lane >> 5), n = lane & 31; scr[kk * 33 + n] = tv[i]; }
    LDS_WAIT();
    const int c = lane & 7;
#pragma unroll
    for (int j = 0; j < 4; ++j) { const int n = (lane >> 3) + 8 * j; const LAS float* s = scr + (8 * c) * 33 + n;
        u32x4 o; o.x = pk2(s[0 * 33], s[1 * 33]); o.y = pk2(s[2 * 33], s[3 * 33]); o.z = pk2(s[4 * 33], s[5 * 33]); o.w = pk2(s[6 * 33], s[7 * 33]);
        *(u32x4*)(WT + (size_t)(r0 + n) * Kd + k0 + 8 * c) = o; }
    LDS_WAIT();
}
__device__ __forceinline__ void phase_wconv(const ArgsL& a, Frame& F, int layer) {
    LAS float* scr = (LAS float*)(F.lds + F.wave * 8448);
    const int gw = F.bx * NWAVES + F.wave, NGW = gridDim.x * NWAVES;
    constexpr int C1 = 16 * 104, C2_ = C1 + 16 * 96, C3 = C2_ + 6 * 96, C4 = C3 + 16 * 32, C5 = C4 + 16 * 256, C6 = C5 + 4 * 512;
    unsigned char* ws = a.ws;
    for (int it = gw; it < C6; it += NGW) {
        if (it < C1) { const int kb = it / 104, nb = it % 104, r0 = nb * 32;
            tr_item(a.in(I_WIN) + (size_t)layer * D * D_IN, D_IN, r0, r0 < FCOL ? 32 : 0, kb * 64, 1024, (bf16_t*)(ws + WS_WIN), 1024, r0, scr, F.lane); }
        else if (it < C2_) { const int r = it - C1, kb = r / 96, nb = r % 96, r0 = nb * 32;
            tr_item(a.in(I_WIN) + (size_t)layer * D * D_IN, D_IN, GCOL + r0, 32, kb * 64, 1024, (bf16_t*)(ws + WS_WG), 1024, r0, scr, F.lane); }
        else if (it < C3) { const int r = it - C2_, kb = r / 96, nb = r % 96, r0 = nb * 32, br = r0 >> 10;
            const float* W = (br == 0 ? a.in(I_WPR) + (size_t)layer * 384 * D : br == 1 ? a.in(I_WPS) + (size_t)layer * 320 * D : a.in(I_WPF) + (size_t)layer * 320 * D);
            tr_item(W, D, r0 & 1023, 32, kb * 64, br == 0 ? 384 : 320, (bf16_t*)(ws + WS_WP), 384, r0, scr, F.lane); }
        else if (it < C4) { const int r = it - C3, kb = r / 32, nb = r % 32, r0 = nb * 32;
            tr_item(a.in(I_WOUT) + (size_t)layer * D * D, D, r0, 32, kb * 64, 1024, (bf16_t*)(ws + WS_WO), 1024, r0, scr, F.lane); }
        else if (it < C5) { const int r = it - C4, kb = r / 256, nb = r % 256, r0 = nb * 32, e = r0 >> 9, rr = r0 & 511, j = rr >> 8, q = rr & 255;
            const float* W = (q >= 128 ? a.in(I_MUP) : a.in(I_MGATE)) + ((size_t)layer * NEXP + e) * D * DEXP;
            tr_item(W, DEXP, j * 128 + (q & 127), 32, kb * 64, 1024, (bf16_t*)(ws + WS_WGU), 1024, r0, scr, F.lane); }
        else { const int r = it - C5, kb = r / 512, nb = r % 512, r0 = nb * 32, e = r0 >> 10;
            tr_item(a.in(I_MDOWN) + ((size_t)layer * NEXP + e) * DEXP * D, D, r0 & 1023, 32, kb * 64, 256, (bf16_t*)(ws + WS_WD), 256, r0, scr, F.lane); }
    }
}

__device__ __forceinline__ void add_y_row(f32x4 (&v)[4], const bf16_t* Y, int slot, int lane) {
    const u32x2* y = (const u32x2*)(Y + (size_t)slot * D) + lane;
#pragma unroll
    for (int j = 0; j < 4; ++j) { const u32x2 t = y[64 * j]; v[j].x += bf_lo(t.x); v[j].y += bf_hi(t.x); v[j].z += bf_lo(t.y); v[j].w += bf_hi(t.y); }
}
template <int MODE>
__device__ __forceinline__ void phase_norm(const ArgsL& a, Frame& F, int layer, const bool dry = false) {
    const int lane = F.lane;
    LAS float* wl = (LAS float*)F.lds;
    LAS int* lcnt = (LAS int*)(F.lds + 20 * 4096);
    unsigned char* ws = a.ws;
    if (MODE == 1) {
        const float* win = a.in(I_WIN) + (size_t)layer * D * D_IN;
        for (int idx = F.tid; idx < 5 * 1024; idx += NTHR) { const int j = idx >> 10, k = idx & 1023; wl[j * 1024 + k] = win[(size_t)k * D_IN + FCOL + j]; }
    }
    if (MODE == 2) {
        const float* wg = a.in(I_MWG) + (size_t)layer * D * 4; const float* we = a.in(I_MWE) + (size_t)layer * D * 16;
        for (int idx = F.tid; idx < 4 * 1024; idx += NTHR) { const int j = idx >> 10, k = idx & 1023; wl[j * 1024 + k] = wg[k * 4 + j]; }
        for (int idx = F.tid; idx < 16 * 1024; idx += NTHR) { const int j = idx >> 10, k = idx & 1023; wl[(4 + j) * 1024 + k] = we[k * 16 + j]; }
        if (F.tid < 16) lcnt[F.tid] = 0;
    }
    __syncthreads();
    const int gw = F.bx * NWAVES + F.wave, NGW = gridDim.x * NWAVES;
    const float* gsrc = (MODE == 2 ? a.in(I_N2G) : a.in(I_N1G)) + layer * D;
    f32x4 gv[4];
#pragma unroll
    for (int j = 0; j < 4; ++j) gv[j] = (MODE == 0) ? (f32x4){0.f, 0.f, 0.f, 0.f} : *(const f32x4*)(gsrc + 4 * lane + 256 * j);
    bf16_t* A = (bf16_t*)(ws + WS_A);
    const bf16_t* Y = (const bf16_t*)(ws + WS_Y);
    const int* SLOT = (const int*)(ws + WS_SLOT);
    constexpr bool COMB0 = (MODE == 0);
    const bool comb = COMB0 || (MODE == 1 && layer > 0);
    f32x4 vn[4]; u32x2 yan[4], ybn[4];
#pragma unroll
    for (int j = 0; j < 4; ++j) { vn[j] = (f32x4){0.f, 0.f, 0.f, 0.f}; yan[j] = (u32x2){0u, 0u}; ybn[j] = (u32x2){0u, 0u}; }
#define NRM_VALID(mm) ((mm) < M && ((mm) % T) - PADR >= (MODE == 0 ? NMETA : 0))
#define NRM_SRC(mm, bb_, ll_) ((MODE == 1 && layer == 0) ? ((ll_) < NMETA ? a.in(I_META) + (size_t)(ll_) * D : a.in(I_X) + ((size_t)(bb_) * SEQ + ((ll_) - NMETA)) * D) : (const float*)hrow(a, bb_, ll_))
#define NRM_LOAD(mm, s0_, s1_) do { if (NRM_VALID(mm)) { const int bb_ = (mm) / T, ll_ = (mm) - bb_ * T - PADR; const float* src_ = NRM_SRC(mm, bb_, ll_); \
        _Pragma("unroll") for (int j = 0; j < 4; ++j) vn[j] = *(const f32x4*)(src_ + 4 * lane + 256 * j); \
        if (comb) { const u32x2* y0_ = (const u32x2*)(Y + (size_t)(s0_) * D) + lane; const u32x2* y1_ = (const u32x2*)(Y + (size_t)(s1_) * D) + lane; \
            _Pragma("unroll") for (int j = 0; j < 4; ++j) { yan[j] = y0_[64 * j]; ybn[j] = y1_[64 * j]; } } } } while (0)
    int sa1 = 0, sb1 = 0, sa2 = 0, sb2 = 0;
    if (comb) { if (NRM_VALID(gw)) { sa1 = SLOT[2 * gw]; sb1 = SLOT[2 * gw + 1]; } if (NRM_VALID(gw + NGW)) { sa2 = SLOT[2 * (gw + NGW)]; sb2 = SLOT[2 * (gw + NGW) + 1]; } }
    NRM_LOAD(gw, sa1, sb1);
    for (int m = gw; m < M; m += NGW) {
        f32x4 v[4]; u32x2 ya[4], yb[4];
#pragma unroll
        for (int j = 0; j < 4; ++j) { v[j] = vn[j]; ya[j] = yan[j]; yb[j] = ybn[j]; }
        int sa3 = 0, sb3 = 0;
        if (comb && NRM_VALID(m + 2 * NGW)) { sa3 = SLOT[2 * (m + 2 * NGW)]; sb3 = SLOT[2 * (m + 2 * NGW) + 1]; }
        NRM_LOAD(m + NGW, sa2, sb2);
        sa2 = sa3; sb2 = sb3;
        const int b = m / T, p = m - b * T, l = p - PADR;
        if (l < 0) {
            if (MODE == 1 && !dry) {
                u32x2* o = (u32x2*)(A + (size_t)m * D) + lane;
#pragma unroll
                for (int j = 0; j < 4; ++j) o[64 * j] = (u32x2){0u, 0u};
                if (lane < 8) ((float*)(ws + WS_LOGF))[(size_t)m * 8 + lane] = 0.f;
            }
            continue;
        }
        if (MODE == 0 && l < NMETA) continue;
        float* hp = hrow(a, b, l);
        if (comb) {
#pragma unroll
            for (int j = 0; j < 4; ++j) { v[j].x += bf_lo(ya[j].x) + bf_lo(yb[j].x); v[j].y += bf_hi(ya[j].x) + bf_hi(yb[j].x); v[j].z += bf_lo(ya[j].y) + bf_lo(yb[j].y); v[j].w += bf_hi(ya[j].y) + bf_hi(yb[j].y); }
        }
        if ((MODE == 0 || MODE == 1) && !dry) {
#pragma unroll
            for (int j = 0; j < 4; ++j) *(f32x4*)(hp + 4 * lane + 256 * j) = v[j];
        }
        if (MODE == 0) continue;
        float ss = 0.f;
#pragma unroll
        for (int j = 0; j < 4; ++j) ss += (v[j].x * v[j].x + v[j].y * v[j].y) + (v[j].z * v[j].z + v[j].w * v[j].w);
        const float r = 1.0f / sqrtf(wave_sum(ss) * (1.0f / D) + 1e-6f);
#pragma unroll
        for (int j = 0; j < 4; ++j) v[j] = v[j] * r * gv[j];
        u32x2* o = (u32x2*)(A + (size_t)m * D) + lane;
        if (!dry) {
#pragma unroll
        for (int j = 0; j < 4; ++j) o[64 * j] = (u32x2){pk2(v[j].x, v[j].y), pk2(v[j].z, v[j].w)}; }
        else { float sink = v[0].x + v[1].y + v[2].z + v[3].w; asm volatile("" :: "v"(sink)); }
        if (MODE == 1) {
            float dsum[5];
#pragma unroll
            for (int q = 0; q < 5; ++q) { float d = 0.f;
#pragma unroll
                for (int j = 0; j < 4; ++j) { const f32x4 w = *(const LAS f32x4*)(wl + q * 1024 + 4 * lane + 256 * j); d += (v[j].x * w.x + v[j].y * w.y) + (v[j].z * w.z + v[j].w * w.w); }
                dsum[q] = wave_sum(d); }
            float mine = dsum[0];
            mine = lane == 1 ? dsum[1] : mine; mine = lane == 2 ? dsum[2] : mine; mine = lane == 3 ? dsum[3] : mine; mine = lane == 4 ? dsum[4] : mine;
            if (lane < 8 && !dry) { float lf = 0.f;
                if (lane < 5) { const float xx = mine + a.in(I_FB)[layer * 5 + lane]; lf = fminf(xx, 0.f) - fast_log(1.f + fast_exp(-fabsf(xx))); }
                ((float*)(ws + WS_LOGF))[(size_t)m * 8 + lane] = lf; }
        }
        if (MODE == 2) {
            float ds[20];
#pragma unroll
            for (int q = 0; q < 20; ++q) { float d = 0.f;
#pragma unroll
                for (int j = 0; j < 4; ++j) { const f32x4 w = *(const LAS f32x4*)(wl + q * 1024 + 4 * lane + 256 * j); d += (v[j].x * w.x + v[j].y * w.y) + (v[j].z * w.z + v[j].w * w.w); }
                ds[q] = wave_sum(d); }
            const float* bg = a.in(I_MBG) + layer * 4; const float* be = a.in(I_MBE) + layer * 16;
            float lg0 = ds[0] + bg[0], lg1 = ds[1] + bg[1], lg2 = ds[2] + bg[2], lg3 = ds[3] + bg[3];
            int g = 0; float mx = lg0;
            if (lg1 > mx) { mx = lg1; g = 1; } if (lg2 > mx) { mx = lg2; g = 2; } if (lg3 > mx) { mx = lg3; g = 3; }
            const float den = fast_exp(lg0 - mx) + fast_exp(lg1 - mx) + fast_exp(lg2 - mx) + fast_exp(lg3 - mx);
            const float pgrp = 1.0f / den;
            float s0 = g == 0 ? ds[4] : g == 1 ? ds[8] : g == 2 ? ds[12] : ds[16];
            float s1 = g == 0 ? ds[5] : g == 1 ? ds[9] : g == 2 ? ds[13] : ds[17];
            float s2 = g == 0 ? ds[6] : g == 1 ? ds[10] : g == 2 ? ds[14] : ds[18];
            float s3 = g == 0 ? ds[7] : g == 1 ? ds[11] : g == 2 ? ds[15] : ds[19];
            s0 += be[g * 4 + 0]; s1 += be[g * 4 + 1]; s2 += be[g * 4 + 2]; s3 += be[g * 4 + 3];
            int i0 = 0; float v0 = s0;
            if (s1 > v0) { v0 = s1; i0 = 1; } if (s2 > v0) { v0 = s2; i0 = 2; } if (s3 > v0) { v0 = s3; i0 = 3; }
            int i1 = -1; float v1 = -3.0e38f;
            if (i0 != 0 && s0 > v1) { v1 = s0; i1 = 0; } if (i0 != 1 && s1 > v1) { v1 = s1; i1 = 1; } if (i0 != 2 && s2 > v1) { v1 = s2; i1 = 2; } if (i0 != 3 && s3 > v1) { v1 = s3; i1 = 3; }
            const float e1 = fast_exp(v1 - v0), pt0 = 1.0f / (1.0f + e1), pt1 = e1 * pt0;
            if (dry) { float sink = pgrp * pt0 + pt1; asm volatile("" :: "v"(sink)); }
            if (lane == 0 && !dry) {
                const int ea = g * 4 + i0, eb = g * 4 + i1;
                const int la = atomicAdd((int*)&lcnt[ea], 1), lb = atomicAdd((int*)&lcnt[eb], 1);
                int* tk = (int*)(ws + WS_TOK) + (size_t)m * 8;
                tk[0] = ea; tk[1] = eb; tk[2] = __float_as_int(pgrp * pt0); tk[3] = __float_as_int(pgrp * pt1); tk[4] = la; tk[5] = lb;
            }
        }
    }
    __syncthreads();
#undef NRM_LOAD
#undef NRM_SRC
#undef NRM_VALID
    if (MODE == 2 && F.tid < 16 && !dry) {
        const int c = lcnt[F.tid];
        ((int*)(ws + WS_WGCNT))[F.bx * 16 + F.tid] = c;
        atomicAdd((int*)(ws + WS_CTL) + CW_ECNT + 64 * layer + F.tid, c);
    }
    __syncthreads();
}

__device__ __forceinline__ void phase_route(const ArgsL& a, Frame& F, int layer) {
    unsigned char* ws = a.ws;
    LAS int* tbl = (LAS int*)F.lds;
    LAS int* part = tbl + 16;
    {
        const int e = F.tid & 15, q = F.tid >> 4; const int* wc = (const int*)(ws + WS_WGCNT); int acc = 0;
#pragma unroll
        for (int i = 0; i < 8; ++i) { const int w = q + 32 * i; if (w < (int)F.bx) acc += wc[w * 16 + e]; }
        part[q * 16 + e] = acc;
    }
    __syncthreads();
    if (F.tid < 16) {
        const int* cnt = (const int*)(ws + WS_CTL) + CW_ECNT + 64 * layer;
        int cv[16];
#pragma unroll
        for (int e = 0; e < 16; ++e) cv[e] = __hip_atomic_load(cnt + e, __ATOMIC_RELAXED, __HIP_MEMORY_SCOPE_AGENT);
        int base = 0;
#pragma unroll
        for (int e = 0; e < 16; ++e) if (e < F.tid) base += ((cv[e] + 255) >> 8) << 8;
#pragma unroll
        for (int q = 0; q < 32; ++q) base += part[q * 16 + F.tid];
        tbl[F.tid] = base;
    }
    __syncthreads();
    const int gw = F.bx * NWAVES + F.wave, NGW = gridDim.x * NWAVES, lane = F.lane;
    const bf16_t* A = (const bf16_t*)(ws + WS_A); bf16_t* AS = (bf16_t*)(ws + WS_AS);
    for (int m = gw; m < M; m += NGW) {
        const int b = m / T, p = m - b * T, l = p - PADR;
        if (l < 0) continue;
        const int* tk = (const int*)(ws + WS_TOK) + (size_t)m * 8;
        const int ea = tk[0], eb = tk[1], sa = tbl[ea] + tk[4], sb = tbl[eb] + tk[5];
        const u32x4* src = (const u32x4*)(A + (size_t)m * D) + lane;
        const u32x4 x0 = src[0], x1 = src[64];
        u32x4* d0 = (u32x4*)(AS + (size_t)sa * D) + lane; u32x4* d1 = (u32x4*)(AS + (size_t)sb * D) + lane;
        d0[0] = x0; d0[64] = x1; d1[0] = x0; d1[64] = x1;
        if (lane == 0) { int* sl = (int*)(ws + WS_SLOT) + 2 * m; sl[0] = sa; sl[1] = sb;
            float* cw = (float*)(ws + WS_CWS); cw[sa] = __int_as_float(tk[2]); cw[sb] = __int_as_float(tk[3]); }
    }
    __syncthreads();
}

__device__ __forceinline__ void phase_prep(const ArgsL& a, Frame& F, int layer, const bool dry = false) {
    unsigned char* ws = a.ws;
    LAS float* xs = (LAS float*)F.lds;
    const int wave = F.wave, lane = F.lane, tid = F.tid;
    const int m0 = F.bx * 129;
    const bf16_t* USH = (const bf16_t*)(ws + WS_USH);
    bf16_t* QKV = (bf16_t*)(ws + WS_QKV);
    if (F.bx < 10) {
        const int bh = F.bx, b = bh / 5, h = bh % 5;
        const float* LOGF = (const float*)(ws + WS_LOGF) + (size_t)(b * T + PADR) * 8 + h;
        float* kb = (float*)(ws + WS_KB2) + (size_t)bh * KBP;
        LAS float* wtot = (LAS float*)F.lds;
        float v[33];
        const int l0 = tid * 33;
#pragma unroll
        for (int i = 0; i < 33; ++i) v[i] = (l0 + i < LTOK) ? LOGF[(size_t)(l0 + i) * 8] : 0.f;
#pragma unroll
        for (int i = 1; i < 33; ++i) v[i] += v[i - 1];
        float incl = v[32];
#pragma unroll
        for (int o = 1; o < 64; o <<= 1) { const float t = __shfl_up(incl, o); if (lane >= o) incl += t; }
        if (lane == 63) wtot[wave] = incl;
        __syncthreads();
        float off = incl - v[32];
        for (int w = 0; w < wave; ++w) off += wtot[w];
#pragma unroll
        for (int i = 0; i < 33; ++i) if (l0 + i < LTOK && !dry) kb[PADR + l0 + i] = -(off + v[i]) * LOG2E;
        for (int p = tid; p < PADR; p += NTHR) kb[p] = 0.f;
        for (int p = T + tid; p < KBP; p += NTHR) kb[p] = 0.f;
        __syncthreads();
    }
    if (F.bx >= 16 && F.bx < 28) {
        unsigned* z = (unsigned*)(ws + WS_RW + ((size_t)(F.bx - 16) * LPADDED + LTOK) * 768);
        for (int i = tid; i < (LPADDED - LTOK) * 192; i += NTHR) z[i] = 0u;
    }
    float w0j = 0.f, a0j = 0.f, kkj = 0.f, kaj = 0.f, rkj = 0.f;
    const int jch = wave * 64 + lane;
    const float* WU = a.in(I_WUP) + (size_t)layer * 64 * RW_W + (wave < 6 ? jch : 0); const float* AU = a.in(I_AUP) + (size_t)layer * 64 * RW_W + (wave < 6 ? jch : 0);
    if (wave < 6) {
        w0j = a.in(I_W0)[layer * RW_W + jch]; a0j = a.in(I_A0)[layer * RW_W + jch];
        kkj = a.in(I_KK)[layer * RW_W + jch]; kaj = a.in(I_KA)[layer * RW_W + jch]; rkj = a.in(I_RK)[layer * RW_W + jch];
    }
    float wvv[64], avv[64];
    if (wave < 6) {
        const float* wp_ = WU; const float* ap_ = AU;
#pragma unroll
        for (int i = 0; i < 64; ++i) { wvv[i] = *wp_; avv[i] = *ap_; wp_ += RW_W; ap_ += RW_W; asm volatile("" : "+v"(wp_), "+v"(ap_)); }
    } else {
#pragma unroll
        for (int i = 0; i < 64; ++i) { wvv[i] = 0.f; avv[i] = 0.f; }
    }
    const float* mu = a.in(I_MU) + layer * SHIFT_W;
    const float gq = a.in(I_QG)[layer * 64 + lane] * C2, gk = a.in(I_KG)[layer * 64 + lane];
    _Float16* RW = (_Float16*)(ws + WS_RW);
    bf16_t* BN = (bf16_t*)(ws + WS_BN);
    for (int t0 = 0; t0 < 129; t0 += 16) {
        const int nt = (129 - t0) < 16 ? (129 - t0) : 16;
        {
            int tid = F.tid; asm volatile("" : "+v"(tid));
            u32x4 uu4[5], pp4[5];
#pragma unroll
            for (int q5 = 0; q5 < 5; ++q5) { const int item = tid + q5 * NTHR; uu4[q5] = (u32x4){0u, 0u, 0u, 0u}; pp4[q5] = (u32x4){0u, 0u, 0u, 0u};
                if (item < nt * 160) { const int tok = item / 160, ch = item - tok * 160, m = m0 + t0 + tok;
                    uu4[q5] = *(const u32x4*)(USH + (size_t)m * SHIFT_W + ch * 8);
                    if (m > 0) pp4[q5] = *(const u32x4*)(USH + (size_t)(m - 1) * SHIFT_W + ch * 8); } }
#pragma unroll
            for (int q5 = 0; q5 < 5; ++q5) { const int item = tid + q5 * NTHR;
                if (item < nt * 160) { const int tok = item / 160, ch = item - tok * 160;
                    const u32x4 u = uu4[q5], pv = pp4[q5];
                    const f32x4 mu0 = *(const f32x4*)(mu + ch * 8), mu1 = *(const f32x4*)(mu + ch * 8 + 4);
                    float x[8];
                    { float uu, pp;
                      uu = bf_lo(u.x); pp = bf_lo(pv.x); x[0] = uu + (pp - uu) * mu0.x;  uu = bf_hi(u.x); pp = bf_hi(pv.x); x[1] = uu + (pp - uu) * mu0.y;
                      uu = bf_lo(u.y); pp = bf_lo(pv.y); x[2] = uu + (pp - uu) * mu0.z;  uu = bf_hi(u.y); pp = bf_hi(pv.y); x[3] = uu + (pp - uu) * mu0.w;
                      uu = bf_lo(u.z); pp = bf_lo(pv.z); x[4] = uu + (pp - uu) * mu1.x;  uu = bf_hi(u.z); pp = bf_hi(pv.z); x[5] = uu + (pp - uu) * mu1.y;
                      uu = bf_lo(u.w); pp = bf_lo(pv.w); x[6] = uu + (pp - uu) * mu1.z;  uu = bf_hi(u.w); pp = bf_hi(pv.w); x[7] = uu + (pp - uu) * mu1.w; }
                    if (ch >= 144 && ch < 152) {
#pragma unroll
                        for (int q = 0; q < 8; ++q) { const float e = fast_exp(-2.f * fabsf(x[q])); const float th = (1.f - e) / (1.f + e); x[q] = x[q] < 0.f ? -th : th; }
                    }
                    LAS f32x4* d = (LAS f32x4*)(xs + tok * SHIFT_W + ch * 8);
                    d[0] = (f32x4){x[0], x[1], x[2], x[3]}; d[1] = (f32x4){x[4], x[5], x[6], x[7]}; } }
        }
        __syncthreads();
        if (wave < 6) {
#pragma unroll 1
            for (int tok = 0; tok < nt; ++tok) {
                const int m = m0 + t0 + tok, b = m / T, p = m - b * T, l = p - PADR;
                if (l < 0) continue;
                const LAS float* xr = xs + tok * SHIFT_W;
                float w0a = w0j, w1a = 0.f, a0a = a0j, a1a = 0.f;
#pragma unroll
                for (int i = 0; i < 64; i += 4) { if ((i & 15) == 0) __builtin_amdgcn_sched_barrier(0);       const f32x4 t4 = *(const LAS f32x4*)(xr + 1152 + i), d4 = *(const LAS f32x4*)(xr + 1216 + i);
                    w0a += t4.x * wvv[i]; w1a += t4.y * wvv[i + 1]; w0a += t4.z * wvv[i + 2]; w1a += t4.w * wvv[i + 3];
                    a0a += d4.x * avv[i]; a1a += d4.y * avv[i + 1]; a0a += d4.z * avv[i + 2]; a1a += d4.w * avv[i + 3]; }
                const float wlv = w0a + w1a, alv = a0a + a1a;
                const float r = xr[jch], k = xr[384 + jch], v = xr[768 + jch];
                const float logw = -softplus_f(-wlv) - 0.5f;
                const float xw = fast_exp(logw);
                const float om = xw < 0.02f ? xw * (1.f - 0.5f * xw + xw * xw * (1.f / 6.f)) : 1.f - fast_exp(-xw);
                const float av = 1.f / (1.f + fast_exp(-alv));
                const float kkr = k * kkj;
                const float nrm = sqrtf(wave_sum(kkr * kkr));
                const float kk = kkr / fmaxf(nrm, 1e-12f);
                const float kp = k * (1.f + (av - 1.f) * kaj);
                const float bb = kk * av;
                const float coef = wave_sum(r * kp * rkj);
                _Float16* o = RW + ((size_t)(b * RW_H + wave) * LPADDED + l) * 384 + lane;
                if (dry) { float sink = kk + om + bb + kp + coef; asm volatile("" :: "v"(sink)); continue; }
                o[0] = (_Float16)kk; o[64] = (_Float16)(-om); o[128] = (_Float16)(-bb); o[192] = (_Float16)kp; o[256] = (_Float16)r; o[320] = (_Float16)v;
                BN[(size_t)m * RW_W + jch] = f2bf(coef * v);
            }
        } else {
            const int which = wave - 6;
            const float gsc = which == 0 ? gq : gk;
#pragma unroll 1
            for (int th = 0; th < 16; th += 8) {
                unsigned short xv[8][5];
#pragma unroll
                for (int t8 = 0; t8 < 8; ++t8) { const int tok = th + t8, m = m0 + t0 + tok; const int p = m % T;
                    const bf16_t* q = QKV + (size_t)m * QKV_W + 960 + which * 320 + lane;
#pragma unroll
                    for (int hd = 0; hd < 5; ++hd) xv[t8][hd] = (tok < nt && p >= PADR) ? q[hd * 64] : (unsigned short)0; }
#pragma unroll
                for (int t8 = 0; t8 < 8; ++t8) { const int tok = th + t8, m = m0 + t0 + tok; const int p = m % T;
                    bf16_t* q = QKV + (size_t)m * QKV_W + 960 + which * 320 + lane;
                    if (tok < nt && p >= PADR) {
#pragma unroll
                        for (int hd = 0; hd < 5; ++hd) { const float x = bf2f(xv[t8][hd]); const float ss = wave_sum(x * x);
                            const unsigned short r_ = f2bf(x * (1.0f / sqrtf(ss * (1.0f / 64.f) + 1e-6f)) * gsc); if (!dry) q[hd * 64] = r_; else asm volatile("" :: "v"(r_)); } } }
            }
        }
        __syncthreads();
    }
}


constexpr int SCH = 16;
static_assert(LTOK % SCH == 0, "whole chunks");
__device__ __forceinline__ void rwkv_scan(const ArgsL& a, Frame& F, int wgi, int dry = 0) {
    const int bh = wgi >> 4, q8 = wgi & 15, b = bh / RW_H, h = bh % RW_H;
    const int tid = F.tid, wave = F.wave, lane = F.lane;
    const unsigned char* rw = a.ws + WS_RW + (size_t)bh * LPADDED * 768;
    LAS float* ring = (LAS float*)F.lds;
    LAS float* ypart = (LAS float*)(F.lds + 49152);
    LAS unsigned char* stg = F.lds + 81920;
    bf16_t* y0 = (bf16_t*)(a.ws + WS_YCAT);
    constexpr int NCH = LTOK / SCH;
    const bool isld = (wave & 2) != 0; const int lw = (wave & 1) + ((wave >> 2) << 1), tl = lw * 64 + lane;
    float s0 = 0.f, s1 = 0.f;
    const int i32 = lane & 31, rsel = lane >> 5, rloc = 2 * wave + rsel;
#define RW_BAR() asm volatile("s_waitcnt lgkmcnt(0)\n\ts_barrier" ::: "memory")
#define RW_ISSUE(cc) do { const unsigned char* src_ = rw + (size_t)(cc) * SCH * 768 + (size_t)tl * 16; LAS unsigned char* d_ = stg + ((cc) & 3) * 12288 + lw * 1024; \
        _Pragma("unroll") for (int k_ = 0; k_ < 3; ++k_) __builtin_amdgcn_global_load_lds((const unsigned*)(src_ + k_ * 4096), (LAS unsigned*)(d_ + k_ * 4096), 16, 0, 0); } while (0)
#define RW_CONVERT(cc) do { const LAS unsigned char* s_ = stg + ((cc) & 3) * 12288 + tl * 16; LAS float* rb_ = ring + ((cc) & 1) * 6144; \
        _Pragma("unroll") for (int k_ = 0; k_ < 3; ++k_) { const int pc_ = tl + 256 * k_; const int t_ = pc_ / 48, q_ = pc_ - t_ * 48, vec_ = q_ >> 3, e0_ = (q_ & 7) * 8; \
            const u32x4 w_ = *(const LAS u32x4*)(s_ + k_ * 4096); \
            const f16x4 lo_ = __builtin_bit_cast(f16x4, (u32x2){w_.x, w_.y}), hi_ = __builtin_bit_cast(f16x4, (u32x2){w_.z, w_.w}); \
            const float f0 = (float)lo_.x, f1 = (float)lo_.y, f2 = (float)lo_.z, f3 = (float)lo_.w, f4 = (float)hi_.x, f5 = (float)hi_.y, f6 = (float)hi_.z, f7 = (float)hi_.w; \
            if (vec_ < 4) { LAS float* d_ = rb_ + t_ * 384 + (vec_ >> 1) * 128 + (e0_ >> 1) * 4 + (vec_ & 1) * 2; \
                *(LAS f32x2*)(d_) = (f32x2){f0, f1}; *(LAS f32x2*)(d_ + 4) = (f32x2){f2, f3}; *(LAS f32x2*)(d_ + 8) = (f32x2){f4, f5}; *(LAS f32x2*)(d_ + 12) = (f32x2){f6, f7}; } \
            else { LAS f32x4* d_ = (LAS f32x4*)(rb_ + t_ * 384 + (vec_ == 4 ? 256 : 320) + e0_); d_[0] = (f32x4){f0, f1, f2, f3}; d_[1] = (f32x4){f4, f5, f6, f7}; } } } while (0)
#define RW_STORE_Y(cc) do { if (tl < 32) { const LAS float* yb_ = ypart + ((cc) & 1) * 4096; const int t_ = tl >> 1, pr_ = tl & 1; const int l_ = (cc) * SCH + t_; \
        const LAS f32x4* q_ = (const LAS f32x4*)(yb_ + t_ * 128 + pr_ * 64); f32x4 sa_ = q_[0], sb_ = q_[8]; \
        _Pragma("unroll") for (int k_ = 1; k_ < 8; ++k_) { sa_ = sa_ + q_[k_]; sb_ = sb_ + q_[8 + k_]; } \
        *(unsigned*)(y0 + (size_t)(b * T + PADR + l_) * RW_W + h * 64 + q8 * 4 + 2 * pr_) = pk2((sa_.x + sa_.y) + (sa_.z + sa_.w), (sb_.x + sb_.y) + (sb_.z + sb_.w)); } } while (0)
    if (isld) {
        RW_ISSUE(0); asm volatile("s_waitcnt vmcnt(0)" ::: "memory"); RW_CONVERT(0);
        RW_ISSUE(1); RW_ISSUE(2);
    }
    RW_BAR();
    for (int c = 0; c < NCH; ++c) {
        if (isld) {
            if (c + 2 < NCH) { asm volatile("s_waitcnt vmcnt(3)" ::: "memory"); RW_CONVERT(c + 1); }
            else if (c + 1 < NCH) { asm volatile("s_waitcnt vmcnt(0)" ::: "memory"); RW_CONVERT(c + 1); }
            if (c > 0 && !dry) RW_STORE_Y(c - 1);
            if (c + 3 < NCH) RW_ISSUE(c + 3);
        } else if (dry != 1 && wave < 2) {
            const unsigned ba = (unsigned)(uintptr_t)(ring + (c & 1) * 6144) + i32 * 16, ca = (unsigned)(uintptr_t)(ring + (c & 1) * 6144) + 1024 + i32 * 8,
                           va = (unsigned)(uintptr_t)(ring + (c & 1) * 6144) + 1280 + (q8 * 4 + rloc) * 4, ya = (unsigned)(uintptr_t)(ypart + (c & 1) * 4096 + rloc * 32 + i32);
            f32x4 OA[4], OB[4]; f32x2 OC[4]; float OV[4];
            OC[3] = (f32x2){0.f, 0.f};
#define RW_FETCH(tt, sl) asm volatile("ds_read_b128 %0, %4 offset:%c7\n\tds_read_b128 %1, %4 offset:%c8\n\tds_read_b64 %2, %5 offset:%c7\n\tds_read_b32 %3, %6 offset:%c7" \
                : "=&v"(OA[sl]), "=&v"(OB[sl]), "=&v"(OC[sl]), "=&v"(OV[sl]) : "v"(ba), "v"(ca), "v"(va), "i"((tt) * 1536), "i"((tt) * 1536 + 512) : "memory")
            RW_FETCH(0, 0); RW_FETCH(1, 1);
            float p, p2, y;
#define RW_STEP(t, WAITN, YL1, YL2, YW, FETCHL) asm volatile( \
                "s_waitcnt lgkmcnt(" WAITN ")\n\t" \
                "v_mul_f32 %[p], %[s0], %[kk0]\n\t" \
                "v_fmac_f32 %[p], %[s1], %[kk1]\n\t" \
                YL1 "\n\t" YL2 "\n\t" \
                XL8 "\n\t" \
                "v_fmac_f32 %[s0], %[s0], %[om0]\n\t" \
                "v_fmac_f32 %[s1], %[s1], %[om1]\n\t" \
                XL4 "\n\t" \
                "v_fmac_f32 %[s0], %[vf], %[kv0]\n\t" \
                "v_fmac_f32 %[s1], %[vf], %[kv1]\n\t" \
                XL2 "\n\t" \
                YW "\n\t" \
                FETCHL \
                : [p] "=&v"(p), [p2] "=&v"(p2), [y] "=&v"(y), [s0] "+v"(s0), [s1] "+v"(s1), [nA] "=&v"(OA[((t) + 2) & 3]), [nB] "=&v"(OB[((t) + 2) & 3]), [nC] "=&v"(OC[((t) + 2) & 3]), [nV] "=&v"(OV[((t) + 2) & 3]) \
                : [kk0] "v"(OA[(t) & 3].x), [kk1] "v"(OA[(t) & 3].y), [om0] "v"(OA[(t) & 3].z), [om1] "v"(OA[(t) & 3].w), [bb0] "v"(OB[(t) & 3].x), [bb1] "v"(OB[(t) & 3].y), [kv0] "v"(OB[(t) & 3].z), [kv1] "v"(OB[(t) & 3].w), \
                  [vf] "v"(OV[(t) & 3]), [rp0] "v"(OC[((t) + 3) & 3].x), [rp1] "v"(OC[((t) + 3) & 3].y), [ba] "v"(ba), [ca] "v"(ca), [va] "v"(va), [ya] "v"(ya), \
                  [oa] "i"(((t) + 2) * 1536), [ob] "i"(((t) + 2) * 1536 + 512), [oy] "i"(((t) - 1) * 512) : "memory")
#define RW_YL1 "v_mul_f32 %[y], %[s0], %[rp0]"
#define RW_YL2 "v_fmac_f32 %[y], %[s1], %[rp1]"
#define RW_YW  "ds_write_b32 %[ya], %[y] offset:%c[oy]"
#define RW_NOP "s_nop 0"
#define RW_TAIL_F "ds_read_b128 %[nA], %[ba] offset:%c[oa]\n\t" \
                XL1 "\n\t" \
                "ds_read_b128 %[nB], %[ba] offset:%c[ob]\n\t" \
                "ds_read_b64 %[nC], %[ca] offset:%c[oa]\n\t" \
                "v_mov_b32 %[p2], %[p]\n\t" \
                "ds_read_b32 %[nV], %[va] offset:%c[oa]\n\t" \
                "s_nop 0\n\t" \
                XSW "\n\t" \
                "v_add_f32 %[p], %[p], %[p2]\n\t" \
                "v_fmac_f32 %[s0], %[p], %[bb0]\n\t" \
                "v_fmac_f32 %[s1], %[p], %[bb1]"
#define RW_TAIL_N "s_nop 0\n\t" \
                XL1 "\n\t" \
                "s_nop 1\n\t" \
                "v_mov_b32 %[p2], %[p]\n\t" \
                "s_nop 1\n\t" \
                XSW "\n\t" \
                "v_add_f32 %[p], %[p], %[p2]\n\t" \
                "v_fmac_f32 %[s0], %[p], %[bb0]\n\t" \
                "v_fmac_f32 %[s1], %[p], %[bb1]"
#define RW_ALLSTEPS() do { \
            RW_STEP(0, "4", RW_NOP, RW_NOP, RW_NOP, RW_TAIL_F); \
            RW_STEP(1, "4", RW_YL1, RW_YL2, RW_YW, RW_TAIL_F); \
            RW_STEP(2, "5", RW_YL1, RW_YL2, RW_YW, RW_TAIL_F);  RW_STEP(3, "5", RW_YL1, RW_YL2, RW_YW, RW_TAIL_F);  RW_STEP(4, "5", RW_YL1, RW_YL2, RW_YW, RW_TAIL_F); \
            RW_STEP(5, "5", RW_YL1, RW_YL2, RW_YW, RW_TAIL_F);  RW_STEP(6, "5", RW_YL1, RW_YL2, RW_YW, RW_TAIL_F);  RW_STEP(7, "5", RW_YL1, RW_YL2, RW_YW, RW_TAIL_F); \
            RW_STEP(8, "5", RW_YL1, RW_YL2, RW_YW, RW_TAIL_F);  RW_STEP(9, "5", RW_YL1, RW_YL2, RW_YW, RW_TAIL_F);  RW_STEP(10, "5", RW_YL1, RW_YL2, RW_YW, RW_TAIL_F); \
            RW_STEP(11, "5", RW_YL1, RW_YL2, RW_YW, RW_TAIL_F); RW_STEP(12, "5", RW_YL1, RW_YL2, RW_YW, RW_TAIL_F); RW_STEP(13, "5", RW_YL1, RW_YL2, RW_YW, RW_TAIL_F); \
            RW_STEP(14, "5", RW_YL1, RW_YL2, RW_YW, RW_TAIL_N); \
            RW_STEP(15, "1", RW_YL1, RW_YL2, RW_YW, RW_TAIL_N); \
            asm volatile("v_mul_f32 %[y], %[s0], %[r0]\n\tv_fmac_f32 %[y], %[s1], %[r1]\n\tds_write_b32 %[ya], %[y] offset:7680" : [y] "=&v"(y) : [s0] "v"(s0), [s1] "v"(s1), [r0] "v"(OC[3].x), [r1] "v"(OC[3].y), [ya] "v"(ya) : "memory"); \
 } while (0)
#ifdef SCAN_PROBE_NOXL
            if (dry == 2) {
#define XL8 "v_add_f32 %[p], %[p], %[p]"
#define XL4 "v_add_f32 %[p], %[p], %[p]"
#define XL2 "v_add_f32 %[p], %[p], %[p]"
#define XL1 "v_add_f32 %[p], %[p], %[p]"
#define XSW "v_add_f32 %[p], %[p], %[p2]"
                RW_ALLSTEPS();
#undef XL8
#undef XL4
#undef XL2
#undef XL1
#undef XSW
            } else
#endif
            {
#define XL8 "v_add_f32_dpp %[p], %[p], %[p] row_ror:8 row_mask:0xf bank_mask:0xf bound_ctrl:1"
#define XL4 "v_add_f32_dpp %[p], %[p], %[p] row_ror:4 row_mask:0xf bank_mask:0xf bound_ctrl:1"
#define XL2 "v_add_f32_dpp %[p], %[p], %[p] row_ror:2 row_mask:0xf bank_mask:0xf bound_ctrl:1"
#define XL1 "v_add_f32_dpp %[p], %[p], %[p] row_ror:1 row_mask:0xf bank_mask:0xf bound_ctrl:1"
#define XSW "v_permlane16_swap_b32 %[p], %[p2]"
                RW_ALLSTEPS();
            }
#undef RW_ALLSTEPS
#undef RW_STEP
#undef XL8
#undef XL4
#undef XL2
#undef XL1
#undef XSW
#undef RW_YL1
#undef RW_YL2
#undef RW_YW
#undef RW_NOP
#undef RW_TAIL_F
#undef RW_TAIL_N
#undef RW_FETCH
        }
        RW_BAR();
    }
    if (isld && !dry) RW_STORE_Y(NCH - 1);
    asm volatile("s_waitcnt vmcnt(0) lgkmcnt(0)\n\ts_barrier" ::: "memory");
#undef RW_STORE_Y
#undef RW_ISSUE
#undef RW_CONVERT
#undef RW_BAR
}

__device__ __forceinline__ int crow(int r, int hi) { return (r & 3) + 8 * (r >> 2) + 4 * hi; }
__device__ __forceinline__ void glds16(const void* gsrc, unsigned lds_dst) { unsigned keep;
    asm volatile("s_mov_b32 %0, m0\n\ts_mov_b32 m0, %2\n\ts_nop 0\n\tglobal_load_lds_dwordx4 %1, off\n\ts_mov_b32 m0, %0" : "=&s"(keep) : "v"(gsrc), "s"(lds_dst) : "memory"); }
typedef LAS const char* lds_cptr;
constexpr int FX_K = 0, FX_V = 16384, FX_WS = 32768, FX_OST = 34816, FX_FLG = 67584;

__device__ __forceinline__ void fx_pv(f32x16* o, int vb, bf16x8 pa0, bf16x8 pa1, bf16x8 pa2, bf16x8 pa3) {
#pragma unroll
    for (int d0 = 0; d0 < 2; ++d0) { s16x4 lo[4], hi[4];
#pragma unroll
        for (int ks = 0; ks < 4; ++ks) {
            asm volatile("ds_read_b64_tr_b16 %0,%1 offset:%c2" : "=&v"(lo[ks]) : "v"(vb), "i"(d0 * 4096 + ks * 1024) : "memory");
            asm volatile("ds_read_b64_tr_b16 %0,%1 offset:%c2" : "=&v"(hi[ks]) : "v"(vb), "i"(d0 * 4096 + ks * 1024 + 512) : "memory"); }
        asm volatile("s_waitcnt lgkmcnt(0)" ::: "memory"); __builtin_amdgcn_sched_barrier(0);
#define FX_PK(k) (bf16x8){lo[k][0], lo[k][1], lo[k][2], lo[k][3], hi[k][0], hi[k][1], hi[k][2], hi[k][3]}
        o[d0] = __builtin_amdgcn_mfma_f32_32x32x16_bf16(pa0, FX_PK(0), o[d0], 0, 0, 0);
        o[d0] = __builtin_amdgcn_mfma_f32_32x32x16_bf16(pa1, FX_PK(1), o[d0], 0, 0, 0);
        o[d0] = __builtin_amdgcn_mfma_f32_32x32x16_bf16(pa2, FX_PK(2), o[d0], 0, 0, 0);
        o[d0] = __builtin_amdgcn_mfma_f32_32x32x16_bf16(pa3, FX_PK(3), o[d0], 0, 0, 0);
#undef FX_PK
    }
}
__device__ __forceinline__ float halves_max(float m) { auto rr = __builtin_amdgcn_permlane32_swap(__float_as_uint(m), __float_as_uint(m), false, false); return fmaxf(__uint_as_float(rr[0]), __uint_as_float(rr[1])); }
__device__ __forceinline__ float halves_sum(float m) { auto rr = __builtin_amdgcn_permlane32_swap(__float_as_uint(m), __float_as_uint(m), false, false); return __uint_as_float(rr[0]) + __uint_as_float(rr[1]); }

template <int KIND>
__device__ __forceinline__ void attn_unit(const ArgsL& a, Frame& F, int b, int h, int qb, float bound) {
    const int lane = F.lane, wave = F.wave, r32 = lane & 31, hi = lane >> 5;
    LAS unsigned char* lds = F.lds;
    const bf16_t* QKV = (const bf16_t*)(a.ws + WS_QKV);
    const size_t rowbase = (size_t)b * T;
    const int p0 = qb * 256;
    constexpr int QC = KIND ? 0 : 960, KC = KIND ? 320 : 1280, VC = KIND ? 640 : 1600;
    const bf16_t* Qw = QKV + (rowbase + p0 + wave * 32) * QKV_W + QC + h * 64;
    const bf16_t* Kh = QKV + rowbase * QKV_W + KC + h * 64;
    const bf16_t* Vh = QKV + rowbase * QKV_W + VC + h * 64;
    const float* kbias = (const float*)(a.ws + WS_KB2) + (size_t)(b * FX_H + h) * KBP;
    const unsigned lds0 = (unsigned)(uintptr_t)lds;
    bf16x8 qr[4];
#pragma unroll
    for (int d0 = 0; d0 < 4; ++d0) qr[d0] = *(const bf16x8*)(Qw + (size_t)r32 * QKV_W + d0 * 16 + hi * 8);
    const int qp = p0 + wave * 32 + r32;
    const bool qvalid = (qp >= PADR) && (qp < T);
    const int plast = (p0 + 255) < (T - 1) ? (p0 + 255) : (T - 1);
    const int jlast = plast >> 6, jfirst = PADR >> 6;
    const int jw = (p0 + wave * 32 + 31) >> 6;
    const bf16_t* ksrc = Kh + (size_t)lane * QKV_W + wave * 8;
    const bf16_t* vsrc = Vh + (size_t)(16 * (wave & 3) + (lane >> 2)) * QKV_W + (wave >> 2) * 32 + (lane & 3) * 8;
    const unsigned kdst = lds0 + FX_K + wave * 1024, vdst = lds0 + FX_V + wave * 1024;
#define FX_DMA(j, slot) do { glds16(ksrc + (size_t)(j) * 64 * QKV_W, (unsigned)__builtin_amdgcn_readfirstlane(kdst + (slot) * 8192)); \
                             glds16(vsrc + (size_t)(j) * 64 * QKV_W, (unsigned)__builtin_amdgcn_readfirstlane(vdst + (slot) * 8192)); } while (0)
    const int vb0 = (int)(lds0 + FX_V) + ((lane >> 4) & 1) * 32 + (lane & 3) * 8 + (4 * hi + ((lane & 15) >> 2)) * 64;
    const lds_cptr kp0 = (lds_cptr)lds + FX_K + hi * 1024 + r32 * 16;
    LAS float* wsf = (LAS float*)(lds + FX_WS) + wave * 64;
    LAS float* flg = (LAS float*)(lds + FX_FLG);
    float m_run = KIND ? 0.f : -1.0e30f, l_run = 0.f;
    f32x16 o[2]; o[0] = f32x16{}; o[1] = f32x16{};
    int slot = 0; bool stop = false;
    FX_DMA(jlast, 0);
    for (int j = jlast; j >= jfirst; --j) {
        if (stop) break;
        if (j > jfirst) { FX_DMA(j - 1, slot ^ 1); asm volatile("s_waitcnt vmcnt(2) lgkmcnt(0)\n\ts_barrier" ::: "memory"); }
        else asm volatile("s_waitcnt vmcnt(0) lgkmcnt(0)\n\ts_barrier" ::: "memory");
        if (j <= jw) {
            f32x16 s0v = f32x16{}, s1v = f32x16{};
            const lds_cptr kp = kp0 + slot * 8192;
#pragma unroll
            for (int d0 = 0; d0 < 4; ++d0) {
                const bf16x8 b0 = *(const LAS bf16x8*)(kp + d0 * 2048);
                const bf16x8 b1 = *(const LAS bf16x8*)(kp + d0 * 2048 + 512);
                s0v = __builtin_amdgcn_mfma_f32_32x32x16_bf16(b0, qr[d0], s0v, 0, 0, 0);
                s1v = __builtin_amdgcn_mfma_f32_32x32x16_bf16(b1, qr[d0], s1v, 0, 0, 0);
            }
            const bool edge = (64 * j + 63 >= p0 + wave * 32) || (64 * j < PADR);
            if constexpr (KIND == 0) {
                const float* kbj = kbias + 64 * j + 4 * hi;
#pragma unroll
                for (int g = 0; g < 4; ++g) { const f32x4 t0 = *(const f32x4*)(kbj + 8 * g), t1 = *(const f32x4*)(kbj + 32 + 8 * g);
                    s0v[4 * g] += t0.x; s0v[4 * g + 1] += t0.y; s0v[4 * g + 2] += t0.z; s0v[4 * g + 3] += t0.w;
                    s1v[4 * g] += t1.x; s1v[4 * g + 1] += t1.y; s1v[4 * g + 2] += t1.z; s1v[4 * g + 3] += t1.w; }
                if (edge) {
#pragma unroll
                    for (int r = 0; r < 16; ++r) { const int key = 64 * j + crow(r, hi);
                        if (key > qp || key < PADR) s0v[r] = -INFINITY;
                        if (key + 32 > qp || key + 32 < PADR) s1v[r] = -INFINITY; }
                }
                float rm = fmaxf(s0v[0], s1v[0]);
#pragma unroll
                for (int r = 1; r < 16; ++r) rm = fmaxf(rm, fmaxf(s0v[r], s1v[r]));
                rm = halves_max(rm);
                const float m_new = fmaxf(m_run, rm);
                const float f = __builtin_amdgcn_exp2f(m_run - m_new);
                m_run = m_new;
                float rs = 0.f;
#pragma unroll
                for (int r = 0; r < 16; ++r) { s0v[r] = __builtin_amdgcn_exp2f(s0v[r] - m_new); s1v[r] = __builtin_amdgcn_exp2f(s1v[r] - m_new); rs += s0v[r] + s1v[r]; }
                rs = halves_sum(rs);
                l_run = l_run * f + rs;
                if (!__all(f == 1.0f)) {
                    if (hi == 0) wsf[r32] = f;
                    LDS_WAIT();
#pragma unroll
                    for (int d_ = 0; d_ < 2; ++d_)
#pragma unroll
                        for (int r = 0; r < 16; ++r) o[d_][r] *= wsf[crow(r, hi)];
                }
            } else {
                f32x16 l0, l1;
#pragma unroll
                for (int r = 0; r < 16; ++r) {
                    const float z0 = s0v[r], z1 = s1v[r];
                    float a0 = -(fmaxf(z0, 0.f) + __builtin_amdgcn_logf(1.f + __builtin_amdgcn_exp2f(-fabsf(z0))));
                    float a1 = -(fmaxf(z1, 0.f) + __builtin_amdgcn_logf(1.f + __builtin_amdgcn_exp2f(-fabsf(z1))));
                    if (edge) { const int key = 64 * j + crow(r, hi);
                        if (key >= qp || key < PADR) { a0 = 0.f; s0v[r] = -INFINITY; }
                        if (key + 32 >= qp || key + 32 < PADR) { a1 = 0.f; s1v[r] = -INFINITY; } }
                    l0[r] = a0; l1[r] = a1;
                }
                float A[8], SA[9], SO[9];
#pragma unroll
                for (int g = 0; g < 4; ++g) { A[g] = (l0[4 * g] + l0[4 * g + 1]) + (l0[4 * g + 2] + l0[4 * g + 3]); A[4 + g] = (l1[4 * g] + l1[4 * g + 1]) + (l1[4 * g + 2] + l1[4 * g + 3]); }
                SA[8] = 0.f; SO[8] = 0.f;
#pragma unroll
                for (int g = 7; g >= 0; --g) SA[g] = A[g] + SA[g + 1];
#pragma unroll
                for (int g = 0; g < 8; ++g) { auto rr = __builtin_amdgcn_permlane32_swap(__float_as_uint(SA[g]), __float_as_uint(SA[g]), false, false); SO[g] = __uint_as_float(hi ? rr[0] : rr[1]); }
                const float R = m_run;
#pragma unroll
                for (int g = 0; g < 8; ++g) {
                    const float E = SA[g + 1] + (hi ? SO[g + 1] : SO[g]) + R;
                    if (g < 4) { float t = E;
                        s0v[4 * g + 3] = __builtin_amdgcn_exp2f(s0v[4 * g + 3] + l0[4 * g + 3] + t); t += l0[4 * g + 3];
                        s0v[4 * g + 2] = __builtin_amdgcn_exp2f(s0v[4 * g + 2] + l0[4 * g + 2] + t); t += l0[4 * g + 2];
                        s0v[4 * g + 1] = __builtin_amdgcn_exp2f(s0v[4 * g + 1] + l0[4 * g + 1] + t); t += l0[4 * g + 1];
                        s0v[4 * g + 0] = __builtin_amdgcn_exp2f(s0v[4 * g + 0] + l0[4 * g + 0] + t);
                    } else { const int q = g - 4; float t = E;
                        s1v[4 * q + 3] = __builtin_amdgcn_exp2f(s1v[4 * q + 3] + l1[4 * q + 3] + t); t += l1[4 * q + 3];
                        s1v[4 * q + 2] = __builtin_amdgcn_exp2f(s1v[4 * q + 2] + l1[4 * q + 2] + t); t += l1[4 * q + 2];
                        s1v[4 * q + 1] = __builtin_amdgcn_exp2f(s1v[4 * q + 1] + l1[4 * q + 1] + t); t += l1[4 * q + 1];
                        s1v[4 * q + 0] = __builtin_amdgcn_exp2f(s1v[4 * q + 0] + l1[4 * q + 0] + t);
                    }
                }
                m_run = R + SA[0] + SO[0];
            }
            u32x4 pw0, pw1, pw2, pw3;
            pw0 = (u32x4){pk2(s0v[0], s0v[1]), pk2(s0v[2], s0v[3]), pk2(s0v[4], s0v[5]), pk2(s0v[6], s0v[7])};
            pw1 = (u32x4){pk2(s0v[8], s0v[9]), pk2(s0v[10], s0v[11]), pk2(s0v[12], s0v[13]), pk2(s0v[14], s0v[15])};
            pw2 = (u32x4){pk2(s1v[0], s1v[1]), pk2(s1v[2], s1v[3]), pk2(s1v[4], s1v[5]), pk2(s1v[6], s1v[7])};
            pw3 = (u32x4){pk2(s1v[8], s1v[9]), pk2(s1v[10], s1v[11]), pk2(s1v[12], s1v[13]), pk2(s1v[14], s1v[15])};
            fx_pv(o, vb0 + slot * 8192, __builtin_bit_cast(bf16x8, pw0), __builtin_bit_cast(bf16x8, pw1), __builtin_bit_cast(bf16x8, pw2), __builtin_bit_cast(bf16x8, pw3));
        }
        float mm = qvalid ? m_run : (KIND ? -3.0e38f : 3.0e38f);
#pragma unroll
        for (int off = 1; off < 64; off <<= 1) { const float t = __shfl_xor(mm, off); mm = KIND ? fmaxf(mm, t) : fminf(mm, t); }
        if (lane == 0) flg[(j & 1) * 8 + wave] = mm;
        asm volatile("s_waitcnt lgkmcnt(0)\n\ts_barrier" ::: "memory");
        if (j > jfirst) {
            const f32x4 fa = *(const LAS f32x4*)(flg + (j & 1) * 8), fb = *(const LAS f32x4*)(flg + (j & 1) * 8 + 4);
            if constexpr (KIND == 0) {
                const float mmin = fminf(fminf(fminf(fa.x, fa.y), fminf(fa.z, fa.w)), fminf(fminf(fb.x, fb.y), fminf(fb.z, fb.w)));
                const float kbmax = kbias[64 * (j - 1) + 63];
                stop = (bound + kbmax - mmin) < -150.0f;
            } else {
                const float mmax = fmaxf(fmaxf(fmaxf(fa.x, fa.y), fmaxf(fa.z, fa.w)), fmaxf(fmaxf(fb.x, fb.y), fmaxf(fb.z, fb.w)));
                stop = mmax < -150.0f;
            }
        }
        slot ^= 1;
    }
    asm volatile("s_waitcnt vmcnt(0) lgkmcnt(0)\n\ts_barrier" ::: "memory");
    float rli[16];
    if constexpr (KIND == 0) {
        if (hi == 0) wsf[32 + r32] = l_run;
        LDS_WAIT();
#pragma unroll
        for (int r = 0; r < 16; ++r) rli[r] = __builtin_amdgcn_rcpf(wsf[32 + crow(r, hi)]);
    } else {
#pragma unroll
        for (int r = 0; r < 16; ++r) rli[r] = 1.0f;
    }
    bf16_t* Ow = (bf16_t*)(a.ws + WS_YCAT) + (size_t)(KIND ? 1 : 2) * M * RW_W + (rowbase + p0 + wave * 32) * RW_W + h * 64;
    {
        LAS bf16_t* stg = (LAS bf16_t*)(lds + FX_OST) + wave * 2048;
#pragma unroll
        for (int r = 0; r < 16; ++r) { const int orow = crow(r, hi);
#pragma unroll
            for (int d0 = 0; d0 < 2; ++d0) stg[orow * 64 + d0 * 32 + r32] = f2bf(o[d0][r] * rli[r]); }
        LDS_WAIT();
#pragma unroll
        for (int i = 0; i < 4; ++i) { const int row = i * 8 + (lane >> 3), ch = lane & 7; const u32x4 v = *(const LAS u32x4*)(stg + row * 64 + ch * 8);
            const int pr = p0 + wave * 32 + row;
            if (pr >= PADR && pr < T) *(u32x4*)(Ow + (size_t)row * RW_W + ch * 8) = v; }
    }
    asm volatile("s_waitcnt lgkmcnt(0)\n\ts_barrier" ::: "memory");
#undef FX_DMA
}


constexpr int CK = 64, NCK = 257, CKB = 40960;
static_assert(LPADDED == CK * NCK, "padded steps");
__device__ __forceinline__ int swz(int row, int chunk) { return row * 128 + ((chunk ^ (row & 7)) << 4); }
__device__ __forceinline__ void ck_mm(f32x16& acc, LAS unsigned char* A, LAS unsigned char* Bt, int m0, int n0, int r32, int hi) {
#pragma unroll
    for (int ks = 0; ks < 4; ++ks) {
        const bf16x8 av = *(const LAS bf16x8*)(A + swz(m0 + r32, 2 * ks + hi));
        const bf16x8 bv = *(const LAS bf16x8*)(Bt + swz(n0 + r32, 2 * ks + hi));
        acc = __builtin_amdgcn_mfma_f32_32x32x16_bf16(av, bv, acc, 0, 0, 0);
    }
}
__device__ __forceinline__ void ck_store_t(LAS unsigned char* dst, const f32x16& acc, int m0, int n0, int r32, int hi) {
#pragma unroll
    for (int g = 0; g < 4; ++g) { const u32x2 w = {pk2(acc[4 * g], acc[4 * g + 1]), pk2(acc[4 * g + 2], acc[4 * g + 3])};
        *(LAS u32x2*)(dst + swz(n0 + r32, (m0 >> 3) + g) + hi * 8) = w; }
}
constexpr int CA_KAP = 0, CA_BET = 8192, CA_CHI = 16384, CA_RHO = 24576, CA_VMT = 32768, CA_BHT = 40960, CA_KHT = 49152, CA_AK = 57344, CA_RB = 65536, CA_RK = 73728,
              CA_AB = 81920  , CA_RHS = 98304  , CA_G64 = MISC_OFF + 2048  , CA_SCR = MISC_OFF + 4096  ;

#ifndef CA_STAGES
#define CA_STAGES 15
#endif
__device__ __forceinline__ void phase_chunkA(const ArgsL& a, Frame& F, const bool dry = false) {
    const int wave = F.wave;
    LAS unsigned char* L = F.lds;
    u32x4 pre6[6];
    for (int id = F.bx; id < 12 * NCK; id += (int)gridDim.x) {
        int tid = F.tid, lane, r32, hi;
#define CK_FRESH() do { asm volatile("" : "+v"(tid)); lane = tid & 63; r32 = lane & 31; hi = lane >> 5; } while (0)
        CK_FRESH();
        const int bh = id / NCK, c = id - bh * NCK;
        unsigned char* blk = a.ws + WS_RW + ((size_t)bh * LPADDED + (size_t)c * CK) * 768;
        {
            if (id == F.bx) {
#pragma unroll
                for (int q6 = 0; q6 < 6; ++q6) pre6[q6] = *(const u32x4*)(blk + (size_t)(tid + q6 * NTHR) * 16);
            }
#pragma unroll
            for (int q6 = 0; q6 < 6; ++q6) *(LAS u32x4*)(L + CA_AB + (tid + q6 * NTHR) * 16) = pre6[q6];
            __syncthreads();
            const int k = tid & 63, tq = tid >> 6;
            const LAS _Float16* src = (const LAS _Float16*)(L + CA_AB) + (tq * 8) * 384 + k;
            float kk[8], w[8], bb[8], kp[8], rr[8], vv[8];
#pragma unroll
            for (int e = 0; e < 8; ++e) { kk[e] = (float)src[e * 384]; w[e] = 1.f + (float)src[e * 384 + 64]; bb[e] = -(float)src[e * 384 + 128];
                kp[e] = (float)src[e * 384 + 192]; rr[e] = (float)src[e * 384 + 256]; vv[e] = (float)src[e * 384 + 320]; }
            float g[8]; g[0] = w[0];
#pragma unroll
            for (int e = 1; e < 8; ++e) g[e] = g[e - 1] * w[e];
            LAS float* scr = (LAS float*)(L + CA_SCR);
            scr[tq * 64 + k] = g[7];
            __syncthreads();
            {
                const int idn = id + (int)gridDim.x;
                if (idn < 12 * NCK) { const int bhn = idn / NCK, cn = idn - bhn * NCK; const unsigned char* bn_ = a.ws + WS_RW + ((size_t)bhn * LPADDED + (size_t)cn * CK) * 768;
#pragma unroll
                    for (int q6 = 0; q6 < 6; ++q6) pre6[q6] = *(const u32x4*)(bn_ + (size_t)(tid + q6 * NTHR) * 16); }
            }
            float pre = 1.f, tot = 1.f;
#pragma unroll
            for (int q = 0; q < 8; ++q) { const float s = scr[q * 64 + k]; if (q < tq) pre *= s; tot *= s; }
            if (tq == 0) ((LAS float*)(L + CA_G64))[k] = tot;
            unsigned bh4[4], kh4[4], vm4[4];
            float Gp = pre;
#pragma unroll
            for (int e = 0; e < 8; ++e) {
                const int t = tq * 8 + e; const float G = pre * g[e], iG = __builtin_amdgcn_rcpf(G);
                const float kap = kk[e] * Gp, bet = bb[e] * iG, chi = kp[e] * iG, rho = rr[e] * G;
                const int o = swz(t, k >> 3) + (k & 7) * 2;
                *(LAS unsigned short*)(L + CA_KAP + o) = f2bf(kap); *(LAS unsigned short*)(L + CA_BET + o) = f2bf(bet);
                *(LAS unsigned short*)(L + CA_CHI + o) = f2bf(chi); *(LAS unsigned short*)(L + CA_RHO + o) = f2bf(rho);
                ((LAS float*)(L + CA_RHS))[t * 128 + k] = kap;
                const float bhv = bet * tot, khv = chi * tot;
                if (e & 1) { bh4[e >> 1] |= (unsigned)f2bf(bhv) << 16; kh4[e >> 1] |= (unsigned)f2bf(khv) << 16; vm4[e >> 1] |= (unsigned)f2bf(vv[e]) << 16; }
                else { bh4[e >> 1] = f2bf(bhv); kh4[e >> 1] = f2bf(khv); vm4[e >> 1] = f2bf(vv[e]); }
                Gp = G;
            }
            *(LAS u32x4*)(L + CA_BHT + swz(k, tq)) = (u32x4){bh4[0], bh4[1], bh4[2], bh4[3]};
            *(LAS u32x4*)(L + CA_KHT + swz(k, tq)) = (u32x4){kh4[0], kh4[1], kh4[2], kh4[3]};
            *(LAS u32x4*)(L + CA_VMT + swz(k, tq)) = (u32x4){vm4[0], vm4[1], vm4[2], vm4[3]};
        }
        __syncthreads();
        CK_FRESH();
        if (!dry || (CA_STAGES & 2)) {
            const int p = wave & 3, nb = wave >> 2;
            LAS unsigned char* Am = L + ((p & 1) ? CA_CHI : CA_BET);
            LAS unsigned char* Bm = L + ((p & 2) ? CA_RHO : CA_KAP);
#pragma unroll
            for (int mb = 0; mb < 2; ++mb) {
                f32x16 acc = f32x16{};
                if (!(mb == 1 && nb == 0)) ck_mm(acc, Am, Bm, mb * 32, nb * 32, r32, hi);
                const int t = nb * 32 + r32;
#pragma unroll
                for (int i = 0; i < 16; ++i) { const int j = mb * 32 + crow(i, hi); const bool keep = (p & 2) ? (j <= t) : (j < t); if (!keep) acc[i] = 0.f; }
                if (p == 0) {
#pragma unroll
                    for (int gq = 0; gq < 4; ++gq) { LAS float* ab_ = (LAS float*)(L + CA_AB) + t * 64 + (mb * 8 + 2 * gq + hi);
                        ab_[0] = acc[4 * gq]; ab_[16] = acc[4 * gq + 1]; ab_[32] = acc[4 * gq + 2]; ab_[48] = acc[4 * gq + 3]; }
                } else ck_store_t(L + (p == 1 ? CA_AK : p == 2 ? CA_RB : CA_RK), acc, mb * 32, nb * 32, r32, hi);
            }
        }
        __syncthreads();
        CK_FRESH();
        if (wave < 4 && (!dry || (CA_STAGES & 2))) {
            const int mb = wave >> 1, nb = wave & 1;
            f32x16 acc = f32x16{};
            ck_mm(acc, L + CA_AK, L + CA_VMT, mb * 32, nb * 32, r32, hi);
#pragma unroll
            for (int i = 0; i < 16; ++i) ((LAS float*)(L + CA_RHS))[(mb * 32 + crow(i, hi)) * 128 + 64 + nb * 32 + r32] = acc[i];
        }
        __syncthreads();
        CK_FRESH();
        if (!dry || (CA_STAGES & 4)) {
            const int col = tid >> 2, p = tid & 3;
            unsigned abv = (unsigned)(uintptr_t)(L + CA_AB) + p * 64; asm volatile("" : "+v"(abv));
            const LAS float* ab = (const LAS float*)(uintptr_t)abv;
            const LAS float* rhs = (const LAS float*)(L + CA_RHS) + col;
            float xo[16];
#pragma unroll
            for (int i = 0; i < 16; ++i) xo[i] = 0.f;
#pragma unroll
            for (int tg = 0; tg < 64; tg += 4) {
                f32x4 av[4][4]; float rv[4];
#pragma unroll
                for (int r = 0; r < 4; ++r) { rv[r] = rhs[(tg + r) * 128];
#pragma unroll
                    for (int i4 = 0; i4 < (tg + r + 15) / 16; ++i4) av[r][i4] = *(const LAS f32x4*)(ab + (tg + r) * 64 + 4 * i4); }
#pragma unroll
                for (int r = 0; r < 4; ++r) { const int t = tg + r;
                    float s0 = (p == 0) ? rv[r] : 0.f, s1 = 0.f;
#pragma unroll
                    for (int i4 = 0; i4 < (t + 15) / 16; ++i4) {
                        s0 -= av[r][i4].x * xo[4 * i4]; s1 -= av[r][i4].y * xo[4 * i4 + 1]; s0 -= av[r][i4].z * xo[4 * i4 + 2]; s1 -= av[r][i4].w * xo[4 * i4 + 3]; }
                    float sx = s0 + s1;
                    sx += dpp_f<0xB1>(sx);
                    sx += dpp_f<0x4E>(sx);
                    if ((t & 3) == p) xo[t >> 2] = sx;
                    asm volatile("" : "+v"(xo[t >> 2]));
                }
                __builtin_amdgcn_sched_barrier(0);
            }
            LAS unsigned char* dst = L + (col < 64 ? CA_KAP : CA_BET);
            const int rowc = col & 63;
#pragma unroll
            for (int i = 0; i < 16; ++i) { const int tt = 4 * i + p; *(LAS unsigned short*)(dst + swz(rowc, tt >> 3) + (tt & 7) * 2) = f2bf(-xo[i]); }
        }
        __syncthreads();
        CK_FRESH();
        if (!dry || (CA_STAGES & 8)) {
            const int ty = wave >> 1;
            LAS unsigned char* nW1 = L + CA_KAP; LAS unsigned char* nW2 = L + CA_BET;
#pragma unroll
            for (int qq = 0; qq < 2; ++qq) {
                const int q = (wave & 1) * 2 + qq, qa = q >> 1, qb = q & 1;
                f32x16 acc = f32x16{};
                if (ty == 0) {
                    const int t = qa * 32 + r32;
#pragma unroll
                    for (int gq = 0; gq < 4; ++gq) { const u32x2 rv = *(const LAS u32x2*)(L + CA_RHO + swz(t, qb * 4 + gq) + hi * 8);
                        acc[4 * gq] = bf_lo(rv.x); acc[4 * gq + 1] = bf_hi(rv.x); acc[4 * gq + 2] = bf_lo(rv.y); acc[4 * gq + 3] = bf_hi(rv.y); }
                    ck_mm(acc, nW1, L + CA_RB, qb * 32, qa * 32, r32, hi);
                } else if (ty == 1) {
                    ck_mm(acc, nW1, L + CA_BHT, qb * 32, qa * 32, r32, hi);
                    if (qa == qb) { const float g64 = ((const LAS float*)(L + CA_G64))[qa * 32 + r32];
#pragma unroll
                        for (int i = 0; i < 16; ++i) if (crow(i, hi) == r32) acc[i] += g64; }
                } else if (ty == 2) {
                    ck_mm(acc, L + CA_KHT, L + CA_VMT, qb * 32, qa * 32, r32, hi);
                    ck_mm(acc, L + CA_BHT, nW2, qb * 32, qa * 32, r32, hi);
                } else {
                    ck_mm(acc, L + CA_RK, L + CA_VMT, qb * 32, qa * 32, r32, hi);
                    ck_mm(acc, L + CA_RB, nW2, qb * 32, qa * 32, r32, hi);
                }
                if (dry) { float sink = acc[0] + acc[5] + acc[10] + acc[15]; asm volatile("" :: "v"(sink)); }
                else if (ty < 2) {
                    unsigned char* o = blk + (ty == 0 ? 8192 : 0) + (size_t)(((qa * 2 + qb) * 2) * 1024) + lane * 16;
#pragma unroll
                    for (int ks = 0; ks < 2; ++ks)
                        *(u32x4*)(o + ks * 1024) = (u32x4){pk2(acc[8 * ks], acc[8 * ks + 1]), pk2(acc[8 * ks + 2], acc[8 * ks + 3]), pk2(acc[8 * ks + 4], acc[8 * ks + 5]), pk2(acc[8 * ks + 6], acc[8 * ks + 7])};
                } else if (ty == 2) {
                    float* o = (float*)(blk + 16384 + (qa * 2 + qb) * 4096) + lane;
#pragma unroll
                    for (int i = 0; i < 16; ++i) o[i * 64] = acc[i];
                } else {
                    bf16_t* o = (bf16_t*)(blk + 32768 + (qa * 2 + qb) * 2048) + lane;
#pragma unroll
                    for (int i = 0; i < 16; ++i) o[i * 64] = f2bf(acc[i]);
                }
            }
        }
        __syncthreads();
    }
}

__device__ __forceinline__ void rwkv_chunkB(const ArgsL& a, Frame& F, int bh) {
    const int lane = F.lane, wave = F.wave, r32 = lane & 31, hi = lane >> 5;
    const int b = bh / RW_H, h = bh % RW_H;
    LAS unsigned char* L = F.lds;
    const unsigned char* base = a.ws + WS_RW + (size_t)bh * LPADDED * 768;
    bf16_t* y0 = (bf16_t*)(a.ws + WS_YCAT);
    const bool isld = (wave >= 2 && wave < 7); const int lw = wave - 2;
#define CB_ISSUE(cc) do { const unsigned char* s_ = base + (size_t)(cc) * CK * 768 + (size_t)lw * 1024 + lane * 16; LAS unsigned char* d_ = L + ((cc) % 3) * CKB + lw * 1024; \
        _Pragma("unroll") for (int r_ = 0; r_ < 8; ++r_) __builtin_amdgcn_global_load_lds((const unsigned*)(s_ + r_ * 5120), (LAS unsigned*)(d_ + r_ * 5120), 16, 0, 0); } while (0)
    if (isld) { CB_ISSUE(0); CB_ISSUE(1); asm volatile("s_waitcnt vmcnt(8)" ::: "memory"); }
    asm volatile("s_waitcnt lgkmcnt(0)\n\ts_barrier" ::: "memory");
    f32x16 Z0 = f32x16{}, Z1 = f32x16{};
    for (int c = 0; c < NCK; ++c) {
        if (isld) {
            if (c + 2 < NCK) CB_ISSUE(c + 2);
            if (c + 2 < NCK) asm volatile("s_waitcnt vmcnt(8)" ::: "memory"); else asm volatile("s_waitcnt vmcnt(0)" ::: "memory");
        } else if (wave < 2) {
            const LAS unsigned char* S = L + (c % 3) * CKB;
            const int vb = wave;
            bf16x8 zf[2][2];
#pragma unroll
            for (int ks = 0; ks < 2; ++ks) {
                zf[0][ks] = __builtin_bit_cast(bf16x8, (u32x4){pk2(Z0[8 * ks], Z0[8 * ks + 1]), pk2(Z0[8 * ks + 2], Z0[8 * ks + 3]), pk2(Z0[8 * ks + 4], Z0[8 * ks + 5]), pk2(Z0[8 * ks + 6], Z0[8 * ks + 7])});
                zf[1][ks] = __builtin_bit_cast(bf16x8, (u32x4){pk2(Z1[8 * ks], Z1[8 * ks + 1]), pk2(Z1[8 * ks + 2], Z1[8 * ks + 3]), pk2(Z1[8 * ks + 4], Z1[8 * ks + 5]), pk2(Z1[8 * ks + 6], Z1[8 * ks + 7])});
            }
#pragma unroll
            for (int tb = 0; tb < 2; ++tb) {
                f32x16 acc;
                const LAS bf16_t* yt = (const LAS bf16_t*)(S + 32768 + (vb * 2 + tb) * 2048) + lane;
#pragma unroll
                for (int i = 0; i < 16; ++i) acc[i] = bf2f(yt[i * 64]);
#pragma unroll
                for (int kb2 = 0; kb2 < 2; ++kb2)
#pragma unroll
                    for (int ks = 0; ks < 2; ++ks) { const bf16x8 pa = *(const LAS bf16x8*)(S + 8192 + ((tb * 2 + kb2) * 2 + ks) * 1024 + lane * 16);
                        acc = __builtin_amdgcn_mfma_f32_32x32x16_bf16(pa, zf[kb2][ks], acc, 0, 0, 0); }
#pragma unroll
                for (int i = 0; i < 16; ++i) { const int l = c * CK + tb * 32 + crow(i, hi);
                    if (l < LTOK) y0[(size_t)(b * T + PADR + l) * RW_W + h * 64 + vb * 32 + r32] = f2bf(acc[i]); }
            }
            f32x16 N0, N1;
            { const LAS float* n0 = (const LAS float*)(S + 16384 + (vb * 2 + 0) * 4096) + lane; const LAS float* n1 = (const LAS float*)(S + 16384 + (vb * 2 + 1) * 4096) + lane;
#pragma unroll
              for (int i = 0; i < 16; ++i) { N0[i] = n0[i * 64]; N1[i] = n1[i * 64]; } }
#pragma unroll
            for (int kb2 = 0; kb2 < 2; ++kb2)
#pragma unroll
                for (int ks = 0; ks < 2; ++ks) {
                    const bf16x8 m0 = *(const LAS bf16x8*)(S + ((0 * 2 + kb2) * 2 + ks) * 1024 + lane * 16);
                    const bf16x8 m1 = *(const LAS bf16x8*)(S + ((1 * 2 + kb2) * 2 + ks) * 1024 + lane * 16);
                    N0 = __builtin_amdgcn_mfma_f32_32x32x16_bf16(m0, zf[kb2][ks], N0, 0, 0, 0);
                    N1 = __builtin_amdgcn_mfma_f32_32x32x16_bf16(m1, zf[kb2][ks], N1, 0, 0, 0);
                }
            Z0 = N0; Z1 = N1;
        }
        asm volatile("s_waitcnt lgkmcnt(0)\n\ts_barrier" ::: "memory");
    }
    asm volatile("s_waitcnt vmcnt(0) lgkmcnt(0)\n\ts_barrier" ::: "memory");
#undef CB_ISSUE
}

constexpr int N_FX_UNITS = 65 * 10, N_SB_UNITS = 65 * 10, N_RW_WG = 192;
#ifndef REP_SCAN
#define REP_SCAN 1
#endif
#ifndef REP_SCAN_DRY
#define REP_SCAN_DRY 0
#endif
#ifndef REP_FOX
#define REP_FOX 1
#endif
#ifndef REP_SB
#define REP_SB 1
#endif
__device__ __forceinline__ void phase_mix(const ArgsL& a, Frame& F, int layer) {
#ifdef SEQ_SCAN
    if (F.bx < N_RW_WG) { int nr = REP_SCAN; asm volatile("" : "+s"(nr)); for (int r = 0; r < nr; ++r) rwkv_scan(a, F, F.bx, (r + 1 < nr) ? REP_SCAN_DRY : 0); }
#else
    if (F.bx < 12) rwkv_chunkB(a, F, F.bx);
#endif
    float gqm = fabsf(a.in(I_QG)[layer * 64 + F.lane]), gkm = fabsf(a.in(I_KG)[layer * 64 + F.lane]);
#pragma unroll
    for (int off = 1; off < 64; off <<= 1) { gqm = fmaxf(gqm, __shfl_xor(gqm, off)); gkm = fmaxf(gkm, __shfl_xor(gkm, off)); }
    const float bound = 64.0f * C2 * gqm * gkm * 1.02f + 0.5f;
    unsigned* head = (unsigned*)(a.ws + WS_CTL) + CW_QUEUE + 64 * layer;
    for (;;) {
        if (F.tid == 0) F.MISC[16] = __hip_atomic_fetch_add(head, 1u, __ATOMIC_RELAXED, __HIP_MEMORY_SCOPE_AGENT);
        __syncthreads();
        const int u = (int)F.MISC[16];
        __syncthreads();
        if (u >= N_FX_UNITS + N_SB_UNITS) break;
        if (u < N_FX_UNITS) { const int qb = 64 - u / 10, bh = u % 10; int nr = REP_FOX; asm volatile("" : "+s"(nr)); for (int r = 0; r < nr; ++r) attn_unit<0>(a, F, bh / FX_H, bh % FX_H, qb, bound); }
        else { const int v = u - N_FX_UNITS; const int qb = 64 - v / 10, bh = v % 10; int nr = REP_SB; asm volatile("" : "+s"(nr)); for (int r = 0; r < nr; ++r) attn_unit<1>(a, F, bh / SB_H, bh % SB_H, qb, bound); }
    }
}

__device__ __forceinline__ void phase_post(const ArgsL& a, Frame& F, int layer, const bool dry = false) {
    const int gw = F.bx * NWAVES + F.wave, NGW = gridDim.x * NWAVES, lane = F.lane;
    bf16_t* Y0 = (bf16_t*)(a.ws + WS_YCAT); const bf16_t* BN = (const bf16_t*)(a.ws + WS_BN);
    float lg[6], lb[6];
    { const float* g = a.in(I_LNG) + layer * RW_W + lane; const float* bb = a.in(I_LNB) + layer * RW_W + lane;
#pragma unroll
      for (int hh = 0; hh < 6; ++hh) { lg[hh] = g[hh * 64]; lb[hh] = bb[hh * 64]; } }
    unsigned short yv[6], bv[6], yn[6], bn[6];
    int m = gw;
    if (m < M) {
#pragma unroll
        for (int hh = 0; hh < 6; ++hh) { yv[hh] = Y0[(size_t)m * RW_W + hh * 64 + lane]; bv[hh] = BN[(size_t)m * RW_W + hh * 64 + lane]; }
    }
    for (; m < M; m += NGW) {
        const int mn = m + NGW;
        if (mn < M) {
#pragma unroll
            for (int hh = 0; hh < 6; ++hh) { yn[hh] = Y0[(size_t)mn * RW_W + hh * 64 + lane]; bn[hh] = BN[(size_t)mn * RW_W + hh * 64 + lane]; }
        }
        const int b = m / T, p = m - b * T;
        bf16_t* yp = Y0 + (size_t)m * RW_W + lane;
        if (p < PADR) {
            if (!dry) {
#pragma unroll
            for (int hh = 0; hh < 6; ++hh) yp[hh * 64] = 0; }
        } else {
#pragma unroll
            for (int hh = 0; hh < 6; ++hh) {
                const float y = bf2f(yv[hh]);
                const float mean = wave_sum(y) * (1.f / 64.f);
                const float d = y - mean;
                const float var = wave_sum(d * d) * (1.f / 64.f);
                const unsigned short r_ = f2bf(d * (1.0f / sqrtf(var + 64e-5f)) * lg[hh] + lb[hh] + bf2f(bv[hh])); if (!dry) yp[hh * 64] = r_; else asm volatile("" :: "v"(r_));
            }
        }
#pragma unroll
        for (int hh = 0; hh < 6; ++hh) { yv[hh] = yn[hh]; bv[hh] = bn[hh]; }
    }
    if (!dry) for (int it = gw; it < 2 * M; it += NGW) {
        const int sl = it / M, m2 = it - sl * M; const int b = m2 / T, p = m2 - b * T;
        bf16_t* row = Y0 + (size_t)(sl + 1) * M * RW_W + (size_t)m2 * RW_W;
        if (p < PADR) { for (int c = lane; c < RW_W / 2; c += 64) ((unsigned*)row)[c] = 0u; }
        else if (lane < 32) ((unsigned*)(row + 320))[lane] = 0u;
    }
}

struct EpiInproj { static constexpr bool PERM = true, AFTER_DRAIN = false; bf16_t* ush; bf16_t* qkv;
    __device__ __forceinline__ void operator()(const f32x4 (&acc)[2][2][4][2], const pg8::Unit& u, int wr, int wc, int fr, int fq) const {
        asm volatile("" : "+v"(fr), "+v"(fq));
        const int row0 = u.pm * 256 + wr * 64 + fr, colt = u.pn * 256 + wc * 32 + 8 * fq;
#pragma unroll
        for (int ai = 0; ai < 2; ++ai)
#pragma unroll
            for (int m = 0; m < 4; ++m) { const size_t row = (size_t)(row0 + ai * 128 + m * 16);
#pragma unroll
                for (int bj = 0; bj < 2; ++bj) { const int col = colt + bj * 128; const f32x4 v0 = acc[ai][bj][m][0], v1 = acc[ai][bj][m][1];
                    const float sc = (col >= SHIFT_W && col < SHIFT_W + 320) ? C2 : 1.0f;
                    u32x4 w; w.x = pk2(v0[0] * sc, v0[1] * sc); w.y = pk2(v0[2] * sc, v0[3] * sc); w.z = pk2(v1[0] * sc, v1[1] * sc); w.w = pk2(v1[2] * sc, v1[3] * sc);
                    if (col < SHIFT_W) *(u32x4*)(ush + row * SHIFT_W + col) = w;
                    else if (col < SHIFT_W + QKV_W) *(u32x4*)(qkv + row * QKV_W + (col - SHIFT_W)) = w; } }
    }
};
struct EpiGates { static constexpr bool PERM = true, AFTER_DRAIN = false; bf16_t* gates;
    __device__ __forceinline__ void operator()(const f32x4 (&acc)[2][2][4][2], const pg8::Unit& u, int wr, int wc, int fr, int fq) const {
        asm volatile("" : "+v"(fr), "+v"(fq));
        const int row0 = u.pm * 256 + wr * 64 + fr, colt = u.pn * 256 + wc * 32 + 8 * fq;
#pragma unroll
        for (int ai = 0; ai < 2; ++ai)
#pragma unroll
            for (int m = 0; m < 4; ++m) { const size_t row = (size_t)(row0 + ai * 128 + m * 16);
#pragma unroll
                for (int bj = 0; bj < 2; ++bj) { const int col = colt + bj * 128; f32x4 v0 = acc[ai][bj][m][0], v1 = acc[ai][bj][m][1];
#pragma unroll
                    for (int q = 0; q < 4; ++q) { v0[q] = __builtin_amdgcn_rcpf(1.f + __builtin_amdgcn_exp2f(-v0[q] * LOG2E)); v1[q] = __builtin_amdgcn_rcpf(1.f + __builtin_amdgcn_exp2f(-v1[q] * LOG2E)); }
                    u32x4 w; w.x = pk2(v0[0], v0[1]); w.y = pk2(v0[2], v0[3]); w.z = pk2(v1[0], v1[1]); w.w = pk2(v1[2], v1[3]);
                    *(u32x4*)(gates + row * 3072 + col) = w; } }
    }
};
struct EpiMerge { static constexpr bool PERM = true, AFTER_DRAIN = false; const bf16_t* gates; bf16_t* merged;
    __device__ __forceinline__ void operator()(const f32x4 (&acc)[2][2][4][2], const pg8::Unit& u, int wr, int wc, int fr, int fq) const {
        asm volatile("" : "+v"(fr), "+v"(fq));
        const int br = u.pn >> 2, pn = u.pn & 3, pm = u.pm - br * 129;
        const int row0 = pm * 256 + wr * 64 + fr, colt = pn * 256 + wc * 32 + 8 * fq;
#pragma unroll
        for (int ai = 0; ai < 2; ++ai)
#pragma unroll
            for (int m = 0; m < 4; ++m) { const size_t row = (size_t)(row0 + ai * 128 + m * 16);
#pragma unroll
                for (int bj = 0; bj < 2; ++bj) { const int col = colt + bj * 128; const f32x4 v0 = acc[ai][bj][m][0], v1 = acc[ai][bj][m][1];
                    const u32x4 g = *(const u32x4*)(gates + row * 3072 + br * 1024 + col);
                    u32x4* mp = (u32x4*)(merged + row * D + col);
                    u32x4 o = (u32x4){0u, 0u, 0u, 0u};
                    if (br > 0) o = *mp;
                    u32x4 w;
                    w.x = pk2(bf_lo(g.x) * v0[0] + bf_lo(o.x), bf_hi(g.x) * v0[1] + bf_hi(o.x));
                    w.y = pk2(bf_lo(g.y) * v0[2] + bf_lo(o.y), bf_hi(g.y) * v0[3] + bf_hi(o.y));
                    w.z = pk2(bf_lo(g.z) * v1[0] + bf_lo(o.z), bf_hi(g.z) * v1[1] + bf_hi(o.z));
                    w.w = pk2(bf_lo(g.w) * v1[2] + bf_lo(o.w), bf_hi(g.w) * v1[3] + bf_hi(o.w));
                    *mp = w; }
                __builtin_amdgcn_sched_barrier(0); }
    }
};
struct MergeOrder { int G, c, ntau;
    __device__ __forceinline__ bool next(int i, pg8::Unit& u) const { const int it = i / 3, br = i - 3 * it; const long tau = (long)it * G + c; if (tau >= ntau) return false;
        const int t = (int)(tau % 516); u.pm = br * 129 + (t >> 2); u.pn = br * 4 + (t & 3); return true; }
    __device__ __forceinline__ void a_ready(const pg8::Unit&) const {}
    __device__ __forceinline__ void done(const pg8::Unit&) const {}
};
struct EpiOut { static constexpr bool PERM = true, AFTER_DRAIN = false; ArgsL a;
    __device__ __forceinline__ void operator()(const f32x4 (&acc)[2][2][4][2], const pg8::Unit& u, int wr, int wc, int fr, int fq) const {
        asm volatile("" : "+v"(fr), "+v"(fq));
        const int row0 = u.pm * 256 + wr * 64 + fr, colt = u.pn * 256 + wc * 32 + 8 * fq;
#pragma unroll
        for (int ai = 0; ai < 2; ++ai)
#pragma unroll
            for (int m = 0; m < 4; ++m) { const int row = row0 + ai * 128 + m * 16; const int b = row / T, p = row - b * T, l = p - PADR;
                if (l < 0) continue;
                float* hp = hrow(a, b, l);
#pragma unroll
                for (int bj = 0; bj < 2; ++bj) { const int col = colt + bj * 128; f32x4* h4 = (f32x4*)(hp + col);
                    h4[0] = h4[0] + acc[ai][bj][m][0]; h4[1] = h4[1] + acc[ai][bj][m][1]; } }
    }
};
struct MoeOrder { const volatile LAS int* tb; int ntile, npt, G, c, rep;
    __device__ __forceinline__ bool next(int i, pg8::Unit& u) const { long L = (long)i * G + c; if (L >= (long)ntile * npt * rep) return false; L %= (long)ntile * npt;
        const int tau = (int)(L / npt), j = (int)(L - (long)tau * npt); int e = 0;
#pragma unroll
        for (int k = 1; k < 16; ++k) e += (tau >= tb[k]) ? 1 : 0;
        u.pm = tau; u.pn = __builtin_amdgcn_readfirstlane(e) * npt + j; return true; }
    __device__ __forceinline__ void a_ready(const pg8::Unit&) const {}
    __device__ __forceinline__ void done(const pg8::Unit&) const {}
};
struct EpiMoeUp { static constexpr bool PERM = true, AFTER_DRAIN = false; bf16_t* hs;
    __device__ __forceinline__ void operator()(const f32x4 (&acc)[2][2][4][2], const pg8::Unit& u, int wr, int wc, int fr, int fq) const {
        asm volatile("" : "+v"(fr), "+v"(fq));
        const int row0 = u.pm * 256 + wr * 64 + fr, col = (u.pn & 1) * 128 + wc * 32 + 8 * fq;
#pragma unroll
        for (int ai = 0; ai < 2; ++ai)
#pragma unroll
            for (int m = 0; m < 4; ++m) { const size_t row = (size_t)(row0 + ai * 128 + m * 16); float r[8];
#pragma unroll
                for (int n = 0; n < 2; ++n)
#pragma unroll
                    for (int q = 0; q < 4; ++q) { const float gte = acc[ai][0][m][n][q], up = acc[ai][1][m][n][q]; r[4 * n + q] = gte * __builtin_amdgcn_rcpf(1.f + __builtin_amdgcn_exp2f(-gte * LOG2E)) * up; }
                u32x4 w; w.x = pk2(r[0], r[1]); w.y = pk2(r[2], r[3]); w.z = pk2(r[4], r[5]); w.w = pk2(r[6], r[7]);
                *(u32x4*)(hs + row * DEXP + col) = w; }
    }
};
struct EpiMoeDown { static constexpr bool PERM = true, AFTER_DRAIN = false; bf16_t* y; const float* cws;
    __device__ __forceinline__ void operator()(const f32x4 (&acc)[2][2][4][2], const pg8::Unit& u, int wr, int wc, int fr, int fq) const {
        asm volatile("" : "+v"(fr), "+v"(fq));
        const int row0 = u.pm * 256 + wr * 64 + fr, colt = (u.pn & 3) * 256 + wc * 32 + 8 * fq;
#pragma unroll
        for (int ai = 0; ai < 2; ++ai)
#pragma unroll
            for (int m = 0; m < 4; ++m) { const size_t row = (size_t)(row0 + ai * 128 + m * 16); const float cw = cws[row];
#pragma unroll
                for (int bj = 0; bj < 2; ++bj) { const int col = colt + bj * 128; const f32x4 v0 = acc[ai][bj][m][0] * cw, v1 = acc[ai][bj][m][1] * cw;
                    u32x4 w; w.x = pk2(v0[0], v0[1]); w.y = pk2(v0[2], v0[3]); w.z = pk2(v1[0], v1[1]); w.w = pk2(v1[2], v1[3]);
                    *(u32x4*)(y + row * D + col) = w; }
                __builtin_amdgcn_sched_barrier(0); }
    }
};

#ifndef PH_MASK
#define PH_MASK 0xFFFF
#endif
#define PH(k) ((PH_MASK >> (k)) & 1)
#ifndef PROBE_DUP
#define PROBE_DUP 0
#endif
#define DUPN(bit) (((PROBE_DUP >> (bit)) & 1) ? 2 : 1)
#ifndef PROBE_THIN
#define PROBE_THIN 0
#endif
#define THIN(bit) ((PROBE_THIN >> (bit)) & 1)
#define FRESH() do { asm volatile("" : "+v"(F.tid)); F.lane = F.tid & 63; F.wave = __builtin_amdgcn_readfirstlane(F.tid >> 6); { int bx_ = (int)blockIdx.x; asm volatile("" : "+s"(bx_)); F.bx = bx_; } { unsigned char* w_ = a.ws; asm volatile("" : "+s"(w_)); a.ws = w_; } } while (0)
__global__ void __launch_bounds__(NTHR, 2) hybrid_fwd(Args ka) {
    extern __shared__ __attribute__((aligned(16))) unsigned char lds_raw[];
    Frame F;
    F.lds = (LAS unsigned char*)lds_raw;
    F.MISC = (volatile LAS unsigned*)(F.lds + MISC_OFF);
    F.tid = threadIdx.x; F.lane = F.tid & 63; F.wave = __builtin_amdgcn_readfirstlane(F.tid >> 6); F.bx = (int)blockIdx.x;
    for (int u = F.tid; u < (LDS_BYTES - MISC_OFF) / 4; u += NTHR) ((LAS unsigned*)(F.lds + MISC_OFF))[u] = 0u;
    __syncthreads();
    if (F.tid < 29) { const unsigned long long p = (unsigned long long)ka.in[F.tid]; F.MISC[64 + 2 * F.tid] = (unsigned)p; F.MISC[65 + 2 * F.tid] = (unsigned)(p >> 32); }
    __syncthreads();
    ArgsL a; a.tab = F.MISC + 64; a.out = ka.out; a.ws = ka.ws;
    XcdBarrier bar = xcd_barrier_post((unsigned*)(a.ws + WS_CTL) + CW_BAR, F.MISC + 8);
    const int G = (int)gridDim.x, c = (int)blockIdx.x;
    PG8_LAS unsigned char* ring = (PG8_LAS unsigned char*)F.lds;

#ifdef PROF_K
    volatile LAS unsigned* tsl = F.MISC + 2048; int nts = 0;
    if (blockIdx.x == 0 && F.tid == 0) tsl[nts] = (unsigned)__builtin_amdgcn_s_memrealtime();
    ++nts;
#define BARX() do { xcd_barrier(bar); if (blockIdx.x == 0 && F.tid == 0) tsl[nts] = (unsigned)__builtin_amdgcn_s_memrealtime(); ++nts; } while (0)
#else
#define BARX() xcd_barrier(bar)
#endif
    for (int layer = 0; layer < DEPTH; ++layer) {
        for (int rep = 0; rep < DUPN(8); ++rep) { FRESH(); if (PH(0)) phase_wconv(a, F, layer); }
        __syncthreads();
        if (THIN(0)) { FRESH(); phase_norm<1>(a, F, layer, true); }
        FRESH(); if (PH(1)) phase_norm<1>(a, F, layer);
        BARX();
        FRESH(); if (PH(2)) {
            pg8::Gemm g{(const bf16_t*)(a.ws + WS_A), (const bf16_t*)(a.ws + WS_WIN), M, N1, D}; pg8::StaticOrder S; S.init(M, N1, G, c, DUPN(3));
            EpiInproj E{(bf16_t*)(a.ws + WS_USH), (bf16_t*)(a.ws + WS_QKV)};
            pg8::gemm_phase<EpiInproj, pg8::StaticOrder, true, true>(ring, g, S, E);
        }
        BARX();
        if (THIN(1)) { FRESH(); phase_prep(a, F, layer, true); }
        FRESH(); if (PH(3)) phase_prep(a, F, layer);
        BARX();
#ifndef SEQ_SCAN
        if (THIN(2)) { FRESH(); phase_chunkA(a, F, true); }
        FRESH(); if (PH(4)) phase_chunkA(a, F);
        BARX();
#endif
        FRESH(); if (PH(4)) phase_mix(a, F, layer);
        BARX();
        if (THIN(3)) { FRESH(); phase_post(a, F, layer, true); }
        FRESH(); if (PH(5)) phase_post(a, F, layer);
        FRESH(); if (PH(6)) {
            pg8::Gemm g{(const bf16_t*)(a.ws + WS_A), (const bf16_t*)(a.ws + WS_WG), M, 3072, D}; pg8::StaticOrder S; S.init(M, 3072, G, c, DUPN(4));
            EpiGates E{(bf16_t*)(a.ws + WS_GATES)};
            pg8::gemm_phase<EpiGates, pg8::StaticOrder, true, true>(ring, g, S, E);
        }
        BARX();
        FRESH(); if (PH(7)) {
            int kdim = RW_W; asm volatile("" : "+s"(kdim));
            pg8::Gemm g{(const bf16_t*)(a.ws + WS_YCAT), (const bf16_t*)(a.ws + WS_WP), 3 * M, 3072, kdim}; MergeOrder S{G, c, 516 * DUPN(5)};
            EpiMerge E{(const bf16_t*)(a.ws + WS_GATES), (bf16_t*)(a.ws + WS_MERGED)};
            pg8::gemm_phase<EpiMerge, MergeOrder, false, true>(ring, g, S, E);
        }
        BARX();
        FRESH(); if (PH(8)) {
            pg8::Gemm g{(const bf16_t*)(a.ws + WS_MERGED), (const bf16_t*)(a.ws + WS_WO), M, D, D}; pg8::StaticOrder S; S.init(M, D, G, c, 1);
            EpiOut E{a};
            pg8::gemm_phase<EpiOut, pg8::StaticOrder, true, true>(ring, g, S, E);
        }
        BARX();
        if (THIN(4)) { FRESH(); phase_norm<2>(a, F, layer, true); }
        FRESH(); if (PH(9)) phase_norm<2>(a, F, layer);
        BARX();
        for (int rep = 0; rep < DUPN(7); ++rep) { FRESH(); if (PH(10)) phase_route(a, F, layer); }
        BARX();
        volatile LAS int* tb = (volatile LAS int*)(F.MISC + 32);
        if (F.tid <= 16) { const int* cnt = (const int*)(a.ws + WS_CTL) + CW_ECNT + 64 * layer; int t = 0;
            for (int e = 0; e < F.tid; ++e) t += (__hip_atomic_load(cnt + e, __ATOMIC_RELAXED, __HIP_MEMORY_SCOPE_AGENT) + 255) >> 8;
            tb[F.tid] = t; }
        __syncthreads();
        const int ntile = tb[16];
        FRESH(); if (PH(11)) {
            pg8::Gemm g{(const bf16_t*)(a.ws + WS_AS), (const bf16_t*)(a.ws + WS_WGU), MS, 8192, D}; MoeOrder S{tb, ntile, 2, G, c, DUPN(6)};
            EpiMoeUp E{(bf16_t*)(a.ws + WS_HS)};
            pg8::gemm_phase<EpiMoeUp, MoeOrder, true, true>(ring, g, S, E);
        }
        BARX();
        FRESH(); if (PH(12)) {
            int kdim = DEXP; asm volatile("" : "+s"(kdim));
            pg8::Gemm g{(const bf16_t*)(a.ws + WS_HS), (const bf16_t*)(a.ws + WS_WD), MS, 16384, kdim}; MoeOrder S{tb, ntile, 4, G, c, DUPN(6)};
            EpiMoeDown E{(bf16_t*)(a.ws + WS_Y), (const float*)(a.ws + WS_CWS)};
            pg8::gemm_phase<EpiMoeDown, MoeOrder, true, true>(ring, g, S, E);
        }
        BARX();
    }
    if (THIN(5)) { FRESH(); phase_norm<0>(a, F, DEPTH - 1, true); }
    FRESH(); if (PH(13)) phase_norm<0>(a, F, DEPTH - 1);
#ifdef PROF_K
    BARX();
    if (blockIdx.x == 0) {
        __syncthreads();
        float us;
        if (PROF_K < 0) us = 100.f;
        else if (PROF_K == 12) us = (float)(tsl[25] - tsl[24]) * 0.01f;
        else if (PROF_K == 13) us = (float)(tsl[25] - tsl[0]) * 0.01f;
        else us = ((float)(tsl[1 + PROF_K] - tsl[PROF_K]) + (float)(tsl[13 + PROF_K] - tsl[12 + PROF_K])) * 0.01f;
        us = 4.f * rintf(us * 0.25f);
        for (int i = F.tid; i < 16384; i += NTHR) a.out[i] = us;
    }
#endif
#ifdef CLOCK_PROBE
    if (blockIdx.x == 0 && F.wave == 0) {
        float c0 = 1.f, c1 = 2.f, c2 = 3.f, c3 = 4.f, c4 = 5.f, c5 = 6.f, c6 = 7.f, c7 = 8.f;
        for (int i = 0; i < CLOCK_PROBE; ++i) {
            asm volatile("v_fma_f32 %0, %0, %0, %0\n\tv_fma_f32 %1, %1, %1, %1\n\tv_fma_f32 %2, %2, %2, %2\n\tv_fma_f32 %3, %3, %3, %3\n\tv_fma_f32 %4, %4, %4, %4\n\tv_fma_f32 %5, %5, %5, %5\n\tv_fma_f32 %6, %6, %6, %6\n\tv_fma_f32 %7, %7, %7, %7"
                         : "+v"(c0), "+v"(c1), "+v"(c2), "+v"(c3), "+v"(c4), "+v"(c5), "+v"(c6), "+v"(c7));
        }
        asm volatile("" :: "v"(c0), "v"(c1), "v"(c2), "v"(c3), "v"(c4), "v"(c5), "v"(c6), "v"(c7));
    }
#endif
}

extern "C" void kernel_launch(void* const* d_in, const int* in_sizes, int n_in, void* d_out, int out_size, void* d_ws, size_t ws_size, hipStream_t stream) {
    static int ready = 0;
    if (ready == 0) {
        if (n_in != 29 || out_size != NB * SEQ * D || ws_size < WS_END) { fprintf(stderr, "kernel_launch: unexpected problem shape (n_in %d, out %d, ws %zu < %zu)\n", n_in, out_size, ws_size, (size_t)WS_END); ready = -1; return; }
        if (hipFuncSetAttribute((const void*)hybrid_fwd, hipFuncAttributeMaxDynamicSharedMemorySize, LDS_BYTES) != hipSuccess) { fprintf(stderr, "kernel_launch: hipFuncSetAttribute failed\n"); ready = -1; return; }
        int per_cu = 0;
        if (hipOccupancyMaxActiveBlocksPerMultiprocessor(&per_cu, (const void*)hybrid_fwd, NTHR, LDS_BYTES) != hipSuccess || per_cu < 1) fprintf(stderr, "kernel_launch: occupancy query says %d\n", per_cu);
        (void)hipGetLastError();
        ready = 1;
    }
    if (ready < 0) return;
    (void)in_sizes;
    if (hipMemsetAsync((char*)d_ws + WS_CTL, 0, CTL_ZERO_BYTES, stream) != hipSuccess) return;
    Args a{};
    for (int i = 0; i < 29; ++i) a.in[i] = (const float*)d_in[i];
    a.out = (float*)d_out; a.ws = (unsigned char*)d_ws;
    hipLaunchKernelGGL(hybrid_fwd, dim3(256), dim3(NTHR), LDS_BYTES, stream, a);
}
```

```cpp
#include <hip/hip_runtime.h>
#include <hip/hip_bf16.h>
#include <cstdio>
#include <cstdint>

#define GAS __attribute__((address_space(1)))
#define LAS __attribute__((address_space(3)))

namespace pg8 {
#define PG8_LAS __attribute__((address_space(3)))
typedef unsigned short bf16_t;
typedef short bf16x8 __attribute__((ext_vector_type(8)));
typedef float f32x4 __attribute__((ext_vector_type(4)));
typedef unsigned u32x4 __attribute__((ext_vector_type(4)));
constexpr int BM = 256, BK = 64, HALF = 128, HTB = HALF * BK * 2  , STAGE_BYTES = 8 * HTB, NXCD = 8, WGM = 8;

__host__ __device__ __forceinline__ int lds_byte(int r, int c) { const int st = (r >> 4) * 2 + (c >> 5), rr = r & 15, cc = c & 31, ob = rr * 64 + cc * 2; return st * 1024 + (ob ^ (((ob >> 9) & 1) << 5)); }
__host__ __device__ __forceinline__ void stage_rc(int b, int& R, int& C) { const int st = b / 1024, sb = b % 1024, swz = sb ^ (((sb >> 9) & 1) << 5); R = (st >> 1) * 16 + swz / 64; C = (st & 1) * 32 + (swz % 64) / 2; }
__host__ __device__ __forceinline__ int perm32(int rho) { const int n = rho >> 4, i = rho & 15; return 8 * (i >> 2) + 4 * n + (i & 3); }

struct Unit { int pm, pn; };
struct Gemm { const bf16_t* A; const bf16_t* Bt; int M, N, K; };

struct StaticOrder {
    int nM, nN, nwg, G, c, rep;
    __host__ __device__ void init(int M, int N, int G_, int c_, int rep_ = 1) { nM = M / BM; nN = N / BM; nwg = nM * nN; G = G_; c = c_; rep = rep_; }
    __host__ __device__ bool next(int i, Unit& u) const {
        const long L = (long)i * G + c; if (L >= (long)nwg * rep) return false;
        int wgid = (int)(L % nwg); { const int q = nwg / NXCD, r = nwg % NXCD, xcd = wgid % NXCD, off = wgid / NXCD; wgid = (xcd < r ? xcd * (q + 1) : r * (q + 1) + (xcd - r) * q) + off; }
        const int nig = WGM * nN, gid = wgid / nig, fm = gid * WGM, gsz = (nM - fm) < WGM ? (nM - fm) : WGM;
        u.pm = fm + ((wgid % nig) % gsz); u.pn = (wgid % nig) / gsz; return true;
    }
    __device__ __forceinline__ void a_ready(const Unit&) const {}
    __device__ __forceinline__ void done(const Unit&) const {}
};
__device__ __forceinline__ unsigned cvt_pk_bf16(float lo, float hi) { unsigned r; asm volatile("v_cvt_pk_bf16_f32 %0, %1, %2" : "=v"(r) : "v"(lo), "v"(hi)); return r; }
template <class Epi, class Sched, bool ALIGN_EPI = false, bool SP2 = false>
__device__ __forceinline__ void gemm_phase(PG8_LAS unsigned char* lds, const Gemm g, const Sched& S, const Epi& E) {
    int tid_ = threadIdx.x; asm volatile("" : "+v"(tid_));
    const int tid = tid_, wid = __builtin_amdgcn_readfirstlane(tid >> 6), lane = tid & 63, wr = wid >> 2, wc = wid & 3, fr = lane & 15, fq = lane >> 4;
    const int K = g.K, nt = K / BK;
    unsigned voffA[2], voffB[2];
#pragma unroll
    for (int i = 0; i < 2; ++i) { int R, C; stage_rc(tid * 16 + i * 8192, R, C); const int Rb = Epi::PERM ? ((R & ~31) + perm32(R & 31)) : R;
        voffA[i] = (unsigned)(R * K + C) * 2u; voffB[i] = (unsigned)(Rb * K + C) * 2u; }
    const size_t kstep = (size_t)(BK * 2);
    const size_t hstep = (size_t)HALF * K * 2;
    const size_t tstep = 2 * hstep;
    const unsigned ldsw = (unsigned)wid * 1024u;
    const int aoff = lds_byte(wr * 64 + fr, fq * 8), boff = lds_byte(wc * 32 + fr, fq * 8);
#define PG8_SA(b, h) (((b) * 2 + (h)) * HTB)
#define PG8_SB(b, h) ((4 + (b) * 2 + (h)) * HTB)
#define PG8_STAGE(bufoff, gbase, voff) do { _Pragma("unroll") for (int _i = 0; _i < 2; ++_i) \
        __builtin_amdgcn_global_load_lds((const unsigned*)((const char*)(gbase) + (voff)[_i]), (PG8_LAS unsigned*)(lds + (bufoff) + ldsw + _i * 8192), 16, 0, 0); } while (0)
#define PG8_LDA(dst, b, h) do { _Pragma("unroll") for (int m = 0; m < 4; ++m) _Pragma("unroll") for (int k = 0; k < 2; ++k) dst[m][k] = *(const PG8_LAS bf16x8*)(lds + PG8_SA(b, h) + aoff + m * 2048 + k * 1024); } while (0)
#define PG8_LDB(dst, b, h) do { _Pragma("unroll") for (int n = 0; n < 2; ++n) _Pragma("unroll") for (int k = 0; k < 2; ++k) dst[n][k] = *(const PG8_LAS bf16x8*)(lds + PG8_SB(b, h) + boff + n * 2048 + k * 1024); } while (0)
#define PG8_MMA(ai, bj, At, Bt) do { __builtin_amdgcn_s_setprio(1); _Pragma("unroll") for (int m = 0; m < 4; ++m) _Pragma("unroll") for (int n = 0; n < 2; ++n) _Pragma("unroll") for (int k = 0; k < 2; ++k) \
        acc[ai][bj][m][n] = __builtin_amdgcn_mfma_f32_16x16x32_bf16(Bt[n][k], At[m][k], acc[ai][bj][m][n], 0, 0, 0); __builtin_amdgcn_s_setprio(0); } while (0)
#define PG8_WAIT_V(n) asm volatile("s_waitcnt vmcnt(" #n ")" ::: "memory")
#define PG8_WAIT_L(n) asm volatile("s_waitcnt lgkmcnt(" #n ")" ::: "memory")
#define PG8_BAR __builtin_amdgcn_s_barrier()
#define PG8_SCHED __builtin_amdgcn_sched_barrier(0)
    Unit cur, nxt; int ui = 0;
    if (!S.next(0, cur)) return;
    f32x4 acc[2][2][4][2];
#pragma unroll
    for (int a = 0; a < 2; ++a)
#pragma unroll
        for (int b = 0; b < 2; ++b)
#pragma unroll
            for (int m = 0; m < 4; ++m)
#pragma unroll
                for (int n = 0; n < 2; ++n) acc[a][b][m][n] = (f32x4){0.f, 0.f, 0.f, 0.f};
    bf16x8 At[4][2], B0[2][2], B1[2][2];
    const char* cA = (const char*)g.A + (size_t)cur.pm * tstep; const char* cB = (const char*)g.Bt + (size_t)cur.pn * tstep;
    S.a_ready(cur);
    if constexpr (SP2) {
        PG8_STAGE(PG8_SB(0, 0), cB, voffB); PG8_STAGE(PG8_SB(0, 1), cB + hstep, voffB); PG8_STAGE(PG8_SA(0, 0), cA, voffA); PG8_STAGE(PG8_SA(0, 1), cA + hstep, voffA);
        if (wr == 1) PG8_BAR;
        PG8_WAIT_V(2); PG8_BAR;
        PG8_STAGE(PG8_SB(1, 0), cB + kstep, voffB); PG8_STAGE(PG8_SA(1, 0), cA + kstep, voffA); PG8_STAGE(PG8_SB(1, 1), cB + hstep + kstep, voffB);
        PG8_WAIT_V(6); PG8_BAR;
    } else {
        PG8_STAGE(PG8_SB(0, 0), cB, voffB); PG8_STAGE(PG8_SA(0, 0), cA, voffA); PG8_STAGE(PG8_SB(0, 1), cB + hstep, voffB); PG8_STAGE(PG8_SA(0, 1), cA + hstep, voffA);
        if (wr == 1) PG8_BAR;
        PG8_WAIT_V(4); PG8_BAR;
        PG8_STAGE(PG8_SB(1, 0), cB + kstep, voffB); PG8_STAGE(PG8_SA(1, 0), cA + kstep, voffA); PG8_STAGE(PG8_SB(1, 1), cB + hstep + kstep, voffB);
        PG8_WAIT_V(6); PG8_BAR;
    }
    for (;;) {
        const bool has_next = S.next(ui + 1, nxt);
        const char* nA = has_next ? (const char*)g.A + (size_t)nxt.pm * tstep : cA; const char* nB = has_next ? (const char*)g.Bt + (size_t)nxt.pn * tstep : cB;
        for (int t = 0; t < nt; t += 2) {
            const bool last = (t == nt - 2);
            const char* a1 = cA + (size_t)(t + 1) * kstep;
            const char* a2 = last ? nA : cA + (size_t)(t + 2) * kstep; const char* b2 = last ? nB : cB + (size_t)(t + 2) * kstep;
            const char* a3 = a2 + kstep; const char* b3 = b2 + kstep;
            if (last && has_next) S.a_ready(nxt);
            if constexpr (SP2) {
            PG8_LDB(B0, 0, 0); PG8_LDB(B1, 0, 1); PG8_SCHED; PG8_LDA(At, 0, 0); PG8_STAGE(PG8_SA(1, 1), a1 + hstep, voffA);
            PG8_WAIT_V(8); PG8_WAIT_L(0); PG8_BAR; PG8_MMA(0, 0, At, B0); PG8_MMA(0, 1, At, B1); PG8_BAR; PG8_SCHED;
            PG8_LDA(At, 0, 1); PG8_STAGE(PG8_SB(0, 0), b2, voffB); PG8_STAGE(PG8_SB(0, 1), b2 + hstep, voffB); PG8_STAGE(PG8_SA(0, 0), a2, voffA);
            PG8_WAIT_V(8); PG8_WAIT_L(0); PG8_BAR; PG8_MMA(1, 0, At, B0); PG8_MMA(1, 1, At, B1); PG8_BAR; PG8_SCHED;
            PG8_LDB(B0, 1, 0); PG8_LDB(B1, 1, 1); PG8_SCHED; PG8_LDA(At, 1, 0); PG8_STAGE(PG8_SA(0, 1), a2 + hstep, voffA);
            PG8_WAIT_V(8); PG8_WAIT_L(0); PG8_BAR; PG8_MMA(0, 0, At, B0); PG8_MMA(0, 1, At, B1); PG8_BAR; PG8_SCHED;
            PG8_LDA(At, 1, 1); PG8_STAGE(PG8_SB(1, 0), b3, voffB); PG8_STAGE(PG8_SB(1, 1), b3 + hstep, voffB); PG8_STAGE(PG8_SA(1, 0), a3, voffA);
            PG8_WAIT_V(8); PG8_WAIT_L(0); PG8_BAR; PG8_MMA(1, 0, At, B0); PG8_MMA(1, 1, At, B1); PG8_BAR; PG8_SCHED;
            } else {
            PG8_LDB(B0, 0, 0); PG8_SCHED; PG8_LDA(At, 0, 0); PG8_STAGE(PG8_SA(1, 1), a1 + hstep, voffA);
            PG8_WAIT_L(8); PG8_BAR; PG8_WAIT_L(0); PG8_MMA(0, 0, At, B0); PG8_BAR; PG8_SCHED;
            PG8_LDB(B1, 0, 1); PG8_STAGE(PG8_SB(0, 0), b2, voffB);
            PG8_BAR; PG8_WAIT_L(0); PG8_MMA(0, 1, At, B1); PG8_BAR;
            PG8_LDA(At, 0, 1); PG8_STAGE(PG8_SA(0, 0), a2, voffA);
            PG8_BAR; PG8_WAIT_L(0); PG8_MMA(1, 0, At, B0); PG8_BAR; PG8_SCHED;
            PG8_STAGE(PG8_SB(0, 1), b2 + hstep, voffB);
            PG8_WAIT_V(6); PG8_BAR; PG8_MMA(1, 1, At, B1); PG8_BAR;
            PG8_LDB(B0, 1, 0); PG8_SCHED; PG8_LDA(At, 1, 0); PG8_STAGE(PG8_SA(0, 1), a2 + hstep, voffA);
            PG8_WAIT_L(8); PG8_BAR; PG8_WAIT_L(0); PG8_MMA(0, 0, At, B0); PG8_BAR; PG8_SCHED;
            PG8_LDB(B1, 1, 1); PG8_STAGE(PG8_SB(1, 0), b3, voffB);
            PG8_BAR; PG8_WAIT_L(0); PG8_MMA(0, 1, At, B1); PG8_BAR;
            PG8_LDA(At, 1, 1); PG8_STAGE(PG8_SA(1, 0), a3, voffA);
            PG8_BAR; PG8_WAIT_L(0); PG8_MMA(1, 0, At, B0); PG8_BAR; PG8_SCHED;
            PG8_STAGE(PG8_SB(1, 1), b3 + hstep, voffB);
            PG8_WAIT_V(6); PG8_BAR; PG8_MMA(1, 1, At, B1); PG8_BAR;
            }
        }
        if constexpr (ALIGN_EPI) { if (wr == 0) PG8_BAR; }
        if constexpr (!Epi::AFTER_DRAIN) { E(acc, cur, wr, wc, fr, fq); S.done(cur); }
        if (!has_next) break;
#pragma unroll
        for (int a = 0; a < 2; ++a)
#pragma unroll
            for (int b = 0; b < 2; ++b)
#pragma unroll
                for (int m = 0; m < 4; ++m)
#pragma unroll
                    for (int n = 0; n < 2; ++n) acc[a][b][m][n] = (f32x4){0.f, 0.f, 0.f, 0.f};
        cur = nxt; cA = nA; cB = nB; ++ui;
        if constexpr (ALIGN_EPI) { if (wr == 1) PG8_BAR; }
    }
    PG8_WAIT_V(0);
    if constexpr (!ALIGN_EPI) { if (wr == 0) PG8_BAR; }
    PG8_BAR;
    if constexpr (Epi::AFTER_DRAIN) { E.fused(acc, cur, wr, wc, fr, fq, lds, wid, lane); S.done(cur); }
#undef PG8_SA
#undef PG8_SB
#undef PG8_STAGE
#undef PG8_LDA
#undef PG8_LDB
#undef PG8_MMA
#undef PG8_WAIT_V
#undef PG8_WAIT_L
#undef PG8_BAR
#undef PG8_SCHED
}
}

constexpr int D = 1024, NB = 2, SEQ = 16384, NMETA = 16, LTOK = SEQ + NMETA  , PADR = 112, T = PADR + LTOK  ;
constexpr int M = NB * T;
constexpr int DEPTH = 2, HD = 64, RW_H = 6, SB_H = 5, FX_H = 5, RW_W = 384, SHIFT_W = 1280, D_IN = 6277;
constexpr int QKV_W = 1920;
constexpr int N1 = 3328;
constexpr int FCOL = 3200, GCOL = 3205;
constexpr int NEXP = 16, DEXP = 256;
constexpr int MS = 70144;
constexpr int LCH = 32, LPADDED = 16448;
constexpr int KBP = 16896;
constexpr float C2 = 0.125f * 1.4426950408889634f;
constexpr float LOG2E = 1.4426950408889634f;
constexpr int NWAVES = 8, NTHR = 512;

constexpr size_t MiB = 1u << 20;
constexpr size_t WS_CTL = 0, CTL_ZERO_BYTES = 65536;
constexpr size_t WS_HM = 1 * MiB;
constexpr size_t WS_LOGF = WS_HM + 131072;
constexpr size_t WS_KB2 = WS_LOGF + (size_t)M * 32;
constexpr size_t WS_TOK = WS_KB2 + (size_t)10 * KBP * 4;
constexpr size_t WS_SLOT = WS_TOK + (size_t)M * 32;
constexpr size_t WS_CWS = WS_SLOT + (size_t)M * 8;
constexpr size_t WS_WGCNT = WS_CWS + (size_t)MS * 4;
constexpr size_t WS_SMALL_END = WS_WGCNT + 256 * 16 * 4;
static_assert(WS_SMALL_END <= 8 * MiB, "small buffers");
constexpr size_t WS_WIN = 8 * MiB;
constexpr size_t WS_WG = WS_WIN + (size_t)N1 * 1024 * 2;
constexpr size_t WS_WP = WS_WG + (size_t)3072 * 1024 * 2;
constexpr size_t WS_WO = WS_WP + (size_t)3072 * 384 * 2;
constexpr size_t WS_WGU = WS_WO + (size_t)1024 * 1024 * 2;
constexpr size_t WS_WD = WS_WGU + (size_t)8192 * 1024 * 2;
constexpr size_t WS_W_END = WS_WD + (size_t)16384 * 256 * 2;
static_assert(WS_W_END <= 49 * MiB, "weights");
constexpr size_t WS_A = 49 * MiB;
constexpr size_t WS_BIG = 115 * MiB;
constexpr size_t WS_USH = WS_BIG;
constexpr size_t WS_YCAT = WS_BIG;
constexpr size_t WS_QKV = WS_BIG + 82 * MiB;
constexpr size_t WS_RW = WS_BIG + 204 * MiB;
constexpr size_t WS_BN = WS_BIG + 349 * MiB;
constexpr size_t WS_GATES = WS_BIG + 82 * MiB;
constexpr size_t WS_MERGED = WS_BIG + 276 * MiB;
constexpr size_t WS_AS = WS_BIG;
constexpr size_t WS_HS = WS_BIG + 137 * MiB;
constexpr size_t WS_Y = WS_BIG + 172 * MiB;
constexpr size_t WS_END = WS_BIG + 374 * MiB;
static_assert((size_t)(M + 256) * 1280 * 2 <= 82 * MiB && (size_t)3 * M * 384 * 2 <= 82 * MiB && (size_t)(M + 256) * 1920 * 2 <= 122 * MiB, "big map 1");
static_assert((size_t)12 * LPADDED * 768 <= 145 * MiB && (size_t)M * 384 * 2 <= 25 * MiB && (size_t)M * 3072 * 2 <= 194 * MiB && (size_t)M * 2048 <= 65 * MiB, "big map 2");
static_assert((size_t)MS * 2048 <= 137 * MiB && (size_t)MS * 512 <= 35 * MiB && WS_END <= 489 * MiB, "big map 3");

constexpr int CW_BAR = 0;
constexpr int CW_QUEUE = 4096;
constexpr int CW_ECNT = 4352;
static_assert((CW_ECNT + 128) * 4 <= (int)CTL_ZERO_BYTES, "ctl");

constexpr int RING_BYTES = 131072, MISC_OFF = RING_BYTES, LDS_BYTES = 147456;

typedef unsigned short bf16_t;
typedef float f32x4 __attribute__((ext_vector_type(4)));
typedef float f32x2 __attribute__((ext_vector_type(2)));
typedef float f32x16 __attribute__((ext_vector_type(16)));
typedef unsigned u32x4 __attribute__((ext_vector_type(4)));
typedef unsigned u32x2 __attribute__((ext_vector_type(2)));
typedef short bf16x8 __attribute__((ext_vector_type(8)));
typedef short s16x4 __attribute__((ext_vector_type(4)));
typedef _Float16 f16x4 __attribute__((ext_vector_type(4)));
typedef __bf16 bf16x2_t __attribute__((ext_vector_type(2)));

__device__ __forceinline__ unsigned pk2(float lo, float hi) { f32x2 v = {lo, hi}; bf16x2_t b = __builtin_convertvector(v, bf16x2_t); return __builtin_bit_cast(unsigned, b); }
__device__ __forceinline__ unsigned short f2bf(float f) { return (unsigned short)(pk2(f, 0.f) & 0xffffu); }
__device__ __forceinline__ float bf_lo(unsigned u) { return __uint_as_float(u << 16); }
__device__ __forceinline__ float bf_hi(unsigned u) { return __uint_as_float(u & 0xffff0000u); }
__device__ __forceinline__ float bf2f(unsigned short h) { return __uint_as_float((unsigned)h << 16); }
template <int CTRL> __device__ __forceinline__ float dpp_f(float x) { return __int_as_float(__builtin_amdgcn_update_dpp(0, __float_as_int(x), CTRL, 0xF, 0xF, false)); }
__device__ __forceinline__ float allred16(float p) { p += dpp_f<0x128>(p); p += dpp_f<0x124>(p); p += dpp_f<0x122>(p); p += dpp_f<0x121>(p); return p; }
__device__ __forceinline__ float wave_sum(float v) {
    v = allred16(v);
    { auto sw = __builtin_amdgcn_permlane16_swap(__float_as_uint(v), __float_as_uint(v), false, false); v = __uint_as_float(sw[0]) + __uint_as_float(sw[1]); }
    { auto sw = __builtin_amdgcn_permlane32_swap(__float_as_uint(v), __float_as_uint(v), false, false); v = __uint_as_float(sw[0]) + __uint_as_float(sw[1]); }
    return v;
}
__device__ __forceinline__ float fast_exp(float x) { return __builtin_amdgcn_exp2f(x * LOG2E); }
__device__ __forceinline__ float fast_log(float x) { return __builtin_amdgcn_logf(x) * 0.6931471805599453f; }
__device__ __forceinline__ float softplus_f(float z) { return fmaxf(z, 0.f) + fast_log(1.f + fast_exp(-fabsf(z))); }

#define XB_TMO      128
#define XB_XCNT(j)  (256  + 64 * (j))
#define XB_XSUB(j)  (1280 + 64 * (j))
#define XB_XGEN(j)  (2304 + 64 * (j))
#define XB_TOP      3328
#define XB_TOPGEN   3392
#define XCD_BAR_WORDS 3456
#define XB_SPIN_CAP (1u << 20)
__device__ __forceinline__ unsigned xb_ld(unsigned* p)              { return __hip_atomic_load(p, __ATOMIC_RELAXED, __HIP_MEMORY_SCOPE_AGENT); }
__device__ __forceinline__ unsigned xb_add(unsigned* p, unsigned v) { return __hip_atomic_fetch_add(p, v, __ATOMIC_RELAXED, __HIP_MEMORY_SCOPE_AGENT); }
__device__ __forceinline__ unsigned xb_xcc_id() { return (unsigned)__builtin_amdgcn_s_getreg((3 << 11) | 20) & 0xFu; }
#define XB_SPIN(cond, bar) do { unsigned _sp = 0; while (cond) { __builtin_amdgcn_s_sleep(1); \
    if ((++_sp & 255u) == 0u) { if (xb_ld(&(bar)[XB_TMO])) break; if (_sp > XB_SPIN_CAP) { atomicAdd(&(bar)[XB_TMO], 1u); break; } } } } while (0)

struct XcdBarrier {
    unsigned* bar; unsigned x;
    volatile LAS unsigned* st;
};

__device__ __forceinline__ XcdBarrier xcd_barrier_post(unsigned* bar, volatile LAS unsigned* st) {
    XcdBarrier b; b.bar = bar; b.x = xb_xcc_id(); b.st = st;
    if (threadIdx.x == 0) (void)xb_add(&bar[XB_XCNT(b.x)], 1u);
    return b;
}
__device__ __forceinline__ void xcd_barrier_complete(unsigned* bar, unsigned x, unsigned& nloc, unsigned& nx) {
    const unsigned G = gridDim.x * gridDim.y * gridDim.z;
    unsigned sum, cnt, mine, sp = 0u;
    for (;;) {
        sum = 0u; cnt = 0u; mine = 0u;
#pragma unroll
        for (unsigned j = 0; j < 16; ++j) { const unsigned c = xb_ld(&bar[XB_XCNT(j)]); sum += c; cnt += (c > 0u) ? 1u : 0u; mine = (j == x) ? c : mine; }
        if (sum == G) break;
        __builtin_amdgcn_s_sleep(1);
        if ((++sp & 255u) == 0u) { if (xb_ld(&bar[XB_TMO])) break; if (sp > XB_SPIN_CAP) { atomicAdd(&bar[XB_TMO], 1u); break; } }
    }
    nloc = mine > 0u ? mine : 1u; nx = cnt > 0u ? cnt : 1u;
}

__device__ __forceinline__ void xcd_barrier(const XcdBarrier& b) {
    asm volatile("s_waitcnt vmcnt(0)" ::: "memory");
    __syncthreads();
    if (threadIdx.x == 0) {
        unsigned* bar = b.bar;
        __builtin_amdgcn_s_waitcnt(0);
        unsigned nloc = b.st[0], nx = b.st[1];
        if (nloc == 0u) { xcd_barrier_complete(bar, b.x, nloc, nx); b.st[0] = nloc; b.st[1] = nx; }
        const unsigned old = xb_add(&bar[XB_XSUB(b.x)], 1u);
        const unsigned gen = old / nloc;
        if (old + 1u == (gen + 1u) * nloc) {
            __builtin_amdgcn_fence(__ATOMIC_RELEASE, "agent");
            asm volatile("s_waitcnt vmcnt(0)" ::: "memory");
            const unsigned og = xb_add(&bar[XB_TOP], 1u);
            const unsigned tg = og / nx;
            if (og + 1u == (tg + 1u) * nx) xb_add(&bar[XB_TOPGEN], 1u);
            else XB_SPIN(xb_ld(&bar[XB_TOPGEN]) == tg, bar);
            __builtin_amdgcn_fence(__ATOMIC_ACQUIRE, "agent");
            xb_add(&bar[XB_XGEN(b.x)], 1u);
            asm volatile("s_waitcnt vmcnt(0)" ::: "memory");
        } else {
            XB_SPIN(xb_ld(&bar[XB_XGEN(b.x)]) == gen, bar);
            __builtin_amdgcn_fence(__ATOMIC_ACQUIRE, "agent");
            asm volatile("s_waitcnt vmcnt(0)" ::: "memory");
        }
    }
    __syncthreads();
}

struct Args { const float* in[29]; float* out; unsigned char* ws; };
enum { I_X = 0, I_META, I_N1G, I_WIN, I_MU, I_WUP, I_W0, I_AUP, I_A0, I_KK, I_KA, I_RK, I_LNG, I_LNB, I_FB, I_QG, I_KG, I_WPR, I_WPS, I_WPF, I_WOUT, I_N2G, I_MWG, I_MBG, I_MWE, I_MBE, I_MGATE, I_MUP, I_MDOWN };
struct ArgsL { volatile LAS unsigned* tab; float* out; unsigned char* ws;
    __device__ __forceinline__ const float* in(int i) const { const unsigned lo = tab[2 * i], hi = tab[2 * i + 1];
        return (const float*)(((unsigned long long)(unsigned)__builtin_amdgcn_readfirstlane((int)hi) << 32) | (unsigned long long)(unsigned)__builtin_amdgcn_readfirstlane((int)lo)); }
};
struct Frame { LAS unsigned char* lds; volatile LAS unsigned* MISC; int tid, lane, wave, bx; };

__device__ __forceinline__ float* hrow(const ArgsL& a, int b, int l) {
    return l < NMETA ? (float*)(a.ws + WS_HM) + (size_t)(b * NMETA + l) * D : a.out + ((size_t)b * SEQ + (l - NMETA)) * D;
}
#define LDS_WAIT() asm volatile("s_waitcnt lgkmcnt(0)" ::: "memory")

__device__ __forceinline__ void tr_item(const float* W, int ldw, int sc0, int nvalid, int k0, int kvalid, bf16_t* WT, int Kd, int r0, LAS float* scr, int lane) {
    float tv[32];
#pragma unroll
    for (int i = 0; i < 32; ++i) { const int kk = 2 * i + (lane >> 5), n = lane & 31; tv[i] = 0.f;
        if (n < nvalid && k0 + kk < kvalid) tv[i] = W[(size_t)(k0 + kk) * ldw + sc0 + n]; }
#pragma unroll
    for (int i = 0; i < 32; ++i) { const int kk = 2 * i + (lane >> 5), n = lane & 31; scr[kk * 33 + n] = tv[i]; }
    LDS_WAIT();
    const int c = lane & 7;
#pragma unroll
    for (int j = 0; j < 4; ++j) { const int n = (lane >> 3) + 8 * j; const LAS float* s = scr + (8 * c) * 33 + n;
        u32x4 o; o.x = pk2(s[0 * 33], s[1 * 33]); o.y = pk2(s[2 * 33], s[3 * 33]); o.z = pk2(s[4 * 33], s[5 * 33]); o.w = pk2(s[6 * 33], s[7 * 33]);
        *(u32x4*)(WT + (size_t)(r0 + n) * Kd + k0 + 8 * c) = o; }
    LDS_WAIT();
}
__device__ __forceinline__ void phase_wconv(const ArgsL& a, Frame& F, int layer) {
    LAS float* scr = (LAS float*)(F.lds + F.wave * 8448);
    const int gw = F.bx * NWAVES + F.wave, NGW = gridDim.x * NWAVES;
    constexpr int C1 = 16 * 104, C2_ = C1 + 16 * 96, C3 = C2_ + 6 * 96, C4 = C3 + 16 * 32, C5 = C4 + 16 * 256, C6 = C5 + 4 * 512;
    unsigned char* ws = a.ws;
    for (int it = gw; it < C6; it += NGW) {
        if (it < C1) { const int kb = it / 104, nb = it % 104, r0 = nb * 32;
            tr_item(a.in(I_WIN) + (size_t)layer * D * D_IN, D_IN, r0, r0 < FCOL ? 32 : 0, kb * 64, 1024, (bf16_t*)(ws + WS_WIN), 1024, r0, scr, F.lane); }
        else if (it < C2_) { const int r = it - C1, kb = r / 96, nb = r % 96, r0 = nb * 32;
            tr_item(a.in(I_WIN) + (size_t)layer * D * D_IN, D_IN, GCOL + r0, 32, kb * 64, 1024, (bf16_t*)(ws + WS_WG), 1024, r0, scr, F.lane); }
        else if (it < C3) { const int r = it - C2_, kb = r / 96, nb = r % 96, r0 = nb * 32, br = r0 >> 10;
            const float* W = (br == 0 ? a.in(I_WPR) + (size_t)layer * 384 * D : br == 1 ? a.in(I_WPS) + (size_t)layer * 320 * D : a.in(I_WPF) + (size_t)layer * 320 * D);
            tr_item(W, D, r0 & 1023, 32, kb * 64, br == 0 ? 384 : 320, (bf16_t*)(ws + WS_WP), 384, r0, scr, F.lane); }
        else if (it < C4) { const int r = it - C3, kb = r / 32, nb = r % 32, r0 = nb * 32;
            tr_item(a.in(I_WOUT) + (size_t)layer * D * D, D, r0, 32, kb * 64, 1024, (bf16_t*)(ws + WS_WO), 1024, r0, scr, F.lane); }
        else if (it < C5) { const int r = it - C4, kb = r / 256, nb = r % 256, r0 = nb * 32, e = r0 >> 9, rr = r0 & 511, j = rr >> 8, q = rr & 255;
            const float* W = (q >= 128 ? a.in(I_MUP) : a.in(I_MGATE)) + ((size_t)layer * NEXP + e) * D * DEXP;
            tr_item(W, DEXP, j * 128 + (q & 127), 32, kb * 64, 1024, (bf16_t*)(ws + WS_WGU), 1024, r0, scr, F.lane); }
        else { const int r = it - C5, kb = r / 512, nb = r % 512, r0 = nb * 32, e = r0 >> 10;
            tr_item(a.in(I_MDOWN) + ((size_t)layer * NEXP + e) * DEXP * D, D, r0 & 1023, 32, kb * 64, 256, (bf16_t*)(ws + WS_WD), 256, r0, scr, F.lane); }
    }
}

__device__ __forceinline__ void add_y_row(f32x4 (&v)[4], const bf16_t* Y, int slot, int lane) {
    const u32x2* y = (const u32x2*)(Y + (size_t)slot * D) + lane;
#pragma unroll
    for (int j = 0; j < 4; ++j) { const u32x2 t = y[64 * j]; v[j].x += bf_lo(t.x); v[j].y += bf_hi(t.x); v[j].z += bf_lo(t.y); v[j].w += bf_hi(t.y); }
}
template <int MODE>
__device__ __forceinline__ void phase_norm(const ArgsL& a, Frame& F, int layer, const bool dry = false) {
    const int lane = F.lane;
    LAS float* wl = (LAS float*)F.lds;
    LAS int* lcnt = (LAS int*)(F.lds + 20 * 4096);
    unsigned char* ws = a.ws;
    if (MODE == 1) {
        const float* win = a.in(I_WIN) + (size_t)layer * D * D_IN;
        for (int idx = F.tid; idx < 5 * 1024; idx += NTHR) { const int j = idx >> 10, k = idx & 1023; wl[j * 1024 + k] = win[(size_t)k * D_IN + FCOL + j]; }
    }
    if (MODE == 2) {
        const float* wg = a.in(I_MWG) + (size_t)layer * D * 4; const float* we = a.in(I_MWE) + (size_t)layer * D * 16;
        for (int idx = F.tid; idx < 4 * 1024; idx += NTHR) { const int j = idx >> 10, k = idx & 1023; wl[j * 1024 + k] = wg[k * 4 + j]; }
        for (int idx = F.tid; idx < 16 * 1024; idx += NTHR) { const int j = idx >> 10, k = idx & 1023; wl[(4 + j) * 1024 + k] = we[k * 16 + j]; }
        if (F.tid < 16) lcnt[F.tid] = 0;
    }
    __syncthreads();
    const int gw = F.bx * NWAVES + F.wave, NGW = gridDim.x * NWAVES;
    const float* gsrc = (MODE == 2 ? a.in(I_N2G) : a.in(I_N1G)) + layer * D;
    f32x4 gv[4];
#pragma unroll
    for (int j = 0; j < 4; ++j) gv[j] = (MODE == 0) ? (f32x4){0.f, 0.f, 0.f, 0.f} : *(const f32x4*)(gsrc + 4 * lane + 256 * j);
    bf16_t* A = (bf16_t*)(ws + WS_A);
    const bf16_t* Y = (const bf16_t*)(ws + WS_Y);
    const int* SLOT = (const int*)(ws + WS_SLOT);
    constexpr bool COMB0 = (MODE == 0);
    const bool comb = COMB0 || (MODE == 1 && layer > 0);
    f32x4 vn[4]; u32x2 yan[4], ybn[4];
#pragma unroll
    for (int j = 0; j < 4; ++j) { vn[j] = (f32x4){0.f, 0.f, 0.f, 0.f}; yan[j] = (u32x2){0u, 0u}; ybn[j] = (u32x2){0u, 0u}; }
#define NRM_VALID(mm) ((mm) < M && ((mm) % T) - PADR >= (MODE == 0 ? NMETA : 0))
#define NRM_SRC(mm, bb_, ll_) ((MODE == 1 && layer == 0) ? ((ll_) < NMETA ? a.in(I_META) + (size_t)(ll_) * D : a.in(I_X) + ((size_t)(bb_) * SEQ + ((ll_) - NMETA)) * D) : (const float*)hrow(a, bb_, ll_))
#define NRM_LOAD(mm, s0_, s1_) do { if (NRM_VALID(mm)) { const int bb_ = (mm) / T, ll_ = (mm) - bb_ * T - PADR; const float* src_ = NRM_SRC(mm, bb_, ll_); \
        _Pragma("unroll") for (int j = 0; j < 4; ++j) vn[j] = *(const f32x4*)(src_ + 4 * lane + 256 * j); \
        if (comb) { const u32x2* y0_ = (const u32x2*)(Y + (size_t)(s0_) * D) + lane; const u32x2* y1_ = (const u32x2*)(Y + (size_t)(s1_) * D) + lane; \
            _Pragma("unroll") for (int j = 0; j < 4; ++j) { yan[j] = y0_[64 * j]; ybn[j] = y1_[64 * j]; } } } } while (0)
    int sa1 = 0, sb1 = 0, sa2 = 0, sb2 = 0;
    if (comb) { if (NRM_VALID(gw)) { sa1 = SLOT[2 * gw]; sb1 = SLOT[2 * gw + 1]; } if (NRM_VALID(gw + NGW)) { sa2 = SLOT[2 * (gw + NGW)]; sb2 = SLOT[2 * (gw + NGW) + 1]; } }
    NRM_LOAD(gw, sa1, sb1);
    for (int m = gw; m < M; m += NGW) {
        f32x4 v[4]; u32x2 ya[4], yb[4];
#pragma unroll
        for (int j = 0; j < 4; ++j) { v[j] = vn[j]; ya[j] = yan[j]; yb[j] = ybn[j]; }
        int sa3 = 0, sb3 = 0;
        if (comb && NRM_VALID(m + 2 * NGW)) { sa3 = SLOT[2 * (m + 2 * NGW)]; sb3 = SLOT[2 * (m + 2 * NGW) + 1]; }
        NRM_LOAD(m + NGW, sa2, sb2);
        sa2 = sa3; sb2 = sb3;
        const int b = m / T, p = m - b * T, l = p - PADR;
        if (l < 0) {
            if (MODE == 1 && !dry) {
                u32x2* o = (u32x2*)(A + (size_t)m * D) + lane;
#pragma unroll
                for (int j = 0; j < 4; ++j) o[64 * j] = (u32x2){0u, 0u};
                if (lane < 8) ((float*)(ws + WS_LOGF))[(size_t)m * 8 + lane] = 0.f;
            }
            continue;
        }
        if (MODE == 0 && l < NMETA) continue;
        float* hp = hrow(a, b, l);
        if (comb) {
#pragma unroll
            for (int j = 0; j < 4; ++j) { v[j].x += bf_lo(ya[j].x) + bf_lo(yb[j].x); v[j].y += bf_hi(ya[j].x) + bf_hi(yb[j].x); v[j].z += bf_lo(ya[j].y) + bf_lo(yb[j].y); v[j].w += bf_hi(ya[j].y) + bf_hi(yb[j].y); }
        }
        if ((MODE == 0 || MODE == 1) && !dry) {
#pragma unroll
            for (int j = 0; j < 4; ++j) *(f32x4*)(hp + 4 * lane + 256 * j) = v[j];
        }
        if (MODE == 0) continue;
        float ss = 0.f;
#pragma unroll
        for (int j = 0; j < 4; ++j) ss += (v[j].x * v[j].x + v[j].y * v[j].y) + (v[j].z * v[j].z + v[j].w * v[j].w);
        const float r = 1.0f / sqrtf(wave_sum(ss) * (1.0f / D) + 1e-6f);
#pragma unroll
        for (int j = 0; j < 4; ++j) v[j] = v[j] * r * gv[j];
        u32x2* o = (u32x2*)(A + (size_t)m * D) + lane;
        if (!dry) {
#pragma unroll
        for (int j = 0; j < 4; ++j) o[64 * j] = (u32x2){pk2(v[j].x, v[j].y), pk2(v[j].z, v[j].w)}; }
        else { float sink = v[0].x + v[1].y + v[2].z + v[3].w; asm volatile("" :: "v"(sink)); }
        if (MODE == 1) {
            float dsum[5];
#pragma unroll
            for (int q = 0; q < 5; ++q) { float d = 0.f;
#pragma unroll
                for (int j = 0; j < 4; ++j) { const f32x4 w = *(const LAS f32x4*)(wl + q * 1024 + 4 * lane + 256 * j); d += (v[j].x * w.x + v[j].y * w.y) + (v[j].z * w.z + v[j].w * w.w); }
                dsum[q] = wave_sum(d); }
            float mine = dsum[0];
            mine = lane == 1 ? dsum[1] : mine; mine = lane == 2 ? dsum[2] : mine; mine = lane == 3 ? dsum[3] : mine; mine = lane == 4 ? dsum[4] : mine;
            if (lane < 8 && !dry) { float lf = 0.f;
                if (lane < 5) { const float xx = mine + a.in(I_FB)[layer * 5 + lane]; lf = fminf(xx, 0.f) - fast_log(1.f + fast_exp(-fabsf(xx))); }
                ((float*)(ws + WS_LOGF))[(size_t)m * 8 + lane] = lf; }
        }
        if (MODE == 2) {
            float ds[20];
#pragma unroll
            for (int q = 0; q < 20; ++q) { float d = 0.f;
#pragma unroll
                for (int j = 0; j < 4; ++j) { const f32x4 w = *(const LAS f32x4*)(wl + q * 1024 + 4 * lane + 256 * j); d += (v[j].x * w.x + v[j].y * w.y) + (v[j].z * w.z + v[j].w * w.w); }
                ds[q] = wave_sum(d); }
            const float* bg = a.in(I_MBG) + layer * 4; const float* be = a.in(I_MBE) + layer * 16;
            float lg0 = ds[0] + bg[0], lg1 = ds[1] + bg[1], lg2 = ds[2] + bg[2], lg3 = ds[3] + bg[3];
            int g = 0; float mx = lg0;
            if (lg1 > mx) { mx = lg1; g = 1; } if (lg2 > mx) { mx = lg2; g = 2; } if (lg3 > mx) { mx = lg3; g = 3; }
            const float den = fast_exp(lg0 - mx) + fast_exp(lg1 - mx) + fast_exp(lg2 - mx) + fast_exp(lg3 - mx);
            const float pgrp = 1.0f / den;
            float s0 = g == 0 ? ds[4] : g == 1 ? ds[8] : g == 2 ? ds[12] : ds[16];
            float s1 = g == 0 ? ds[5] : g == 1 ? ds[9] : g == 2 ? ds[13] : ds[17];
            float s2 = g == 0 ? ds[6] : g == 1 ? ds[10] : g == 2 ? ds[14] : ds[18];
            float s3 = g == 0 ? ds[7] : g == 1 ? ds[11] : g == 2 ? ds[15] : ds[19];
            s0 += be[g * 4 + 0]; s1 += be[g * 4 + 1]; s2 += be[g * 4 + 2]; s3 += be[g * 4 + 3];
            int i0 = 0; float v0 = s0;
            if (s1 > v0) { v0 = s1; i0 = 1; } if (s2 > v0) { v0 = s2; i0 = 2; } if (s3 > v0) { v0 = s3; i0 = 3; }
            int i1 = -1; float v1 = -3.0e38f;
            if (i0 != 0 && s0 > v1) { v1 = s0; i1 = 0; } if (i0 != 1 && s1 > v1) { v1 = s1; i1 = 1; } if (i0 != 2 && s2 > v1) { v1 = s2; i1 = 2; } if (i0 != 3 && s3 > v1) { v1 = s3; i1 = 3; }
            const float e1 = fast_exp(v1 - v0), pt0 = 1.0f / (1.0f + e1), pt1 = e1 * pt0;
            if (dry) { float sink = pgrp * pt0 + pt1; asm volatile("" :: "v"(sink)); }
            if (lane == 0 && !dry) {
                const int ea = g * 4 + i0, eb = g * 4 + i1;
                const int la = atomicAdd((int*)&lcnt[ea], 1), lb = atomicAdd((int*)&lcnt[eb], 1);
                int* tk = (int*)(ws + WS_TOK) + (size_t)m * 8;
                tk[0] = ea; tk[1] = eb; tk[2] = __float_as_int(pgrp * pt0); tk[3] = __float_as_int(pgrp * pt1); tk[4] = la; tk[5] = lb;
            }
        }
    }
    __syncthreads();
#undef NRM_LOAD
#undef NRM_SRC
#undef NRM_VALID
    if (MODE == 2 && F.tid < 16 && !dry) {
        const int c = lcnt[F.tid];
        ((int*)(ws + WS_WGCNT))[F.bx * 16 + F.tid] = c;
        atomicAdd((int*)(ws + WS_CTL) + CW_ECNT + 64 * layer + F.tid, c);
    }
    __syncthreads();
}

__device__ __forceinline__ void phase_route(const ArgsL& a, Frame& F, int layer) {
    unsigned char* ws = a.ws;
    LAS int* tbl = (LAS int*)F.lds;
    LAS int* part = tbl + 16;
    {
        const int e = F.tid & 15, q = F.tid >> 4; const int* wc = (const int*)(ws + WS_WGCNT); int acc = 0;
#pragma unroll
        for (int i = 0; i < 8; ++i) { const int w = q + 32 * i; if (w < (int)F.bx) acc += wc[w * 16 + e]; }
        part[q * 16 + e] = acc;
    }
    __syncthreads();
    if (F.tid < 16) {
        const int* cnt = (const int*)(ws + WS_CTL) + CW_ECNT + 64 * layer;
        int cv[16];
#pragma unroll
        for (int e = 0; e < 16; ++e) cv[e] = __hip_atomic_load(cnt + e, __ATOMIC_RELAXED, __HIP_MEMORY_SCOPE_AGENT);
        int base = 0;
#pragma unroll
        for (int e = 0; e < 16; ++e) if (e < F.tid) base += ((cv[e] + 255) >> 8) << 8;
#pragma unroll
        for (int q = 0; q < 32; ++q) base += part[q * 16 + F.tid];
        tbl[F.tid] = base;
    }
    __syncthreads();
    const int gw = F.bx * NWAVES + F.wave, NGW = gridDim.x * NWAVES, lane = F.lane;
    const bf16_t* A = (const bf16_t*)(ws + WS_A); bf16_t* AS = (bf16_t*)(ws + WS_AS);
    for (int m = gw; m < M; m += NGW) {
        const int b = m / T, p = m - b * T, l = p - PADR;
        if (l < 0) continue;
        const int* tk = (const int*)(ws + WS_TOK) + (size_t)m * 8;
        const int ea = tk[0], eb = tk[1], sa = tbl[ea] + tk[4], sb = tbl[eb] + tk[5];
        const u32x4* src = (const u32x4*)(A + (size_t)m * D) + lane;
        const u32x4 x0 = src[0], x1 = src[64];
        u32x4* d0 = (u32x4*)(AS + (size_t)sa * D) + lane; u32x4* d1 = (u32x4*)(AS + (size_t)sb * D) + lane;
        d0[0] = x0; d0[64] = x1; d1[0] = x0; d1[64] = x1;
        if (lane == 0) { int* sl = (int*)(ws + WS_SLOT) + 2 * m; sl[0] = sa; sl[1] = sb;
            float* cw = (float*)(ws + WS_CWS); cw[sa] = __int_as_float(tk[2]); cw[sb] = __int_as_float(tk[3]); }
    }
    __syncthreads();
}

__device__ __forceinline__ void phase_prep(const ArgsL& a, Frame& F, int layer, const bool dry = false) {
    unsigned char* ws = a.ws;
    LAS float* xs = (LAS float*)F.lds;
    const int wave = F.wave, lane = F.lane, tid = F.tid;
    const int m0 = F.bx * 129;
    const bf16_t* USH = (const bf16_t*)(ws + WS_USH);
    bf16_t* QKV = (bf16_t*)(ws + WS_QKV);
    if (F.bx < 10) {
        const int bh = F.bx, b = bh / 5, h = bh % 5;
        const float* LOGF = (const float*)(ws + WS_LOGF) + (size_t)(b * T + PADR) * 8 + h;
        float* kb = (float*)(ws + WS_KB2) + (size_t)bh * KBP;
        LAS float* wtot = (LAS float*)F.lds;
        float v[33];
        const int l0 = tid * 33;
#pragma unroll
        for (int i = 0; i < 33; ++i) v[i] = (l0 + i < LTOK) ? LOGF[(size_t)(l0 + i) * 8] : 0.f;
#pragma unroll
        for (int i = 1; i < 33; ++i) v[i] += v[i - 1];
        float incl = v[32];
#pragma unroll
        for (int o = 1; o < 64; o <<= 1) { const float t = __shfl_up(incl, o); if (lane >= o) incl += t; }
        if (lane == 63) wtot[wave] = incl;
        __syncthreads();
        float off = incl - v[32];
        for (int w = 0; w < wave; ++w) off += wtot[w];
#pragma unroll
        for (int i = 0; i < 33; ++i) if (l0 + i < LTOK && !dry) kb[PADR + l0 + i] = -(off + v[i]) * LOG2E;
        for (int p = tid; p < PADR; p += NTHR) kb[p] = 0.f;
        for (int p = T + tid; p < KBP; p += NTHR) kb[p] = 0.f;
        __syncthreads();
    }
    if (F.bx >= 16 && F.bx < 28) {
        unsigned* z = (unsigned*)(ws + WS_RW + ((size_t)(F.bx - 16) * LPADDED + LTOK) * 768);
        for (int i = tid; i < (LPADDED - LTOK) * 192; i += NTHR) z[i] = 0u;
    }
    float w0j = 0.f, a0j = 0.f, kkj = 0.f, kaj = 0.f, rkj = 0.f;
    const int jch = wave * 64 + lane;
    const float* WU = a.in(I_WUP) + (size_t)layer * 64 * RW_W + (wave < 6 ? jch : 0); const float* AU = a.in(I_AUP) + (size_t)layer * 64 * RW_W + (wave < 6 ? jch : 0);
    if (wave < 6) {
        w0j = a.in(I_W0)[layer * RW_W + jch]; a0j = a.in(I_A0)[layer * RW_W + jch];
        kkj = a.in(I_KK)[layer * RW_W + jch]; kaj = a.in(I_KA)[layer * RW_W + jch]; rkj = a.in(I_RK)[layer * RW_W + jch];
    }
    float wvv[64], avv[64];
    if (wave < 6) {
        const float* wp_ = WU; const float* ap_ = AU;
#pragma unroll
        for (int i = 0; i < 64; ++i) { wvv[i] = *wp_; avv[i] = *ap_; wp_ += RW_W; ap_ += RW_W; asm volatile("" : "+v"(wp_), "+v"(ap_)); }
    } else {
#pragma unroll
        for (int i = 0; i < 64; ++i) { wvv[i] = 0.f; avv[i] = 0.f; }
    }
    const float* mu = a.in(I_MU) + layer * SHIFT_W;
    const float gq = a.in(I_QG)[layer * 64 + lane] * C2, gk = a.in(I_KG)[layer * 64 + lane];
    _Float16* RW = (_Float16*)(ws + WS_RW);
    bf16_t* BN = (bf16_t*)(ws + WS_BN);
    for (int t0 = 0; t0 < 129; t0 += 16) {
        const int nt = (129 - t0) < 16 ? (129 - t0) : 16;
        {
            int tid = F.tid; asm volatile("" : "+v"(tid));
            u32x4 uu4[5], pp4[5];
#pragma unroll
            for (int q5 = 0; q5 < 5; ++q5) { const int item = tid + q5 * NTHR; uu4[q5] = (u32x4){0u, 0u, 0u, 0u}; pp4[q5] = (u32x4){0u, 0u, 0u, 0u};
                if (item < nt * 160) { const int tok = item / 160, ch = item - tok * 160, m = m0 + t0 + tok;
                    uu4[q5] = *(const u32x4*)(USH + (size_t)m * SHIFT_W + ch * 8);
                    if (m > 0) pp4[q5] = *(const u32x4*)(USH + (size_t)(m - 1) * SHIFT_W + ch * 8); } }
#pragma unroll
            for (int q5 = 0; q5 < 5; ++q5) { const int item = tid + q5 * NTHR;
                if (item < nt * 160) { const int tok = item / 160, ch = item - tok * 160;
                    const u32x4 u = uu4[q5], pv = pp4[q5];
                    const f32x4 mu0 = *(const f32x4*)(mu + ch * 8), mu1 = *(const f32x4*)(mu + ch * 8 + 4);
                    float x[8];
                    { float uu, pp;
                      uu = bf_lo(u.x); pp = bf_lo(pv.x); x[0] = uu + (pp - uu) * mu0.x;  uu = bf_hi(u.x); pp = bf_hi(pv.x); x[1] = uu + (pp - uu) * mu0.y;
                      uu = bf_lo(u.y); pp = bf_lo(pv.y); x[2] = uu + (pp - uu) * mu0.z;  uu = bf_hi(u.y); pp = bf_hi(pv.y); x[3] = uu + (pp - uu) * mu0.w;
                      uu = bf_lo(u.z); pp = bf_lo(pv.z); x[4] = uu + (pp - uu) * mu1.x;  uu = bf_hi(u.z); pp = bf_hi(pv.z); x[5] = uu + (pp - uu) * mu1.y;
                      uu = bf_lo(u.w); pp = bf_lo(pv.w); x[6] = uu + (pp - uu) * mu1.z;  uu = bf_hi(u.w); pp = bf_hi(pv.w); x[7] = uu + (pp - uu) * mu1.w; }
                    if (ch >= 144 && ch < 152) {
#pragma unroll
                        for (int q = 0; q < 8; ++q) { const float e = fast_exp(-2.f * fabsf(x[q])); const float th = (1.f - e) / (1.f + e); x[q] = x[q] < 0.f ? -th : th; }
                    }
                    LAS f32x4* d = (LAS f32x4*)(xs + tok * SHIFT_W + ch * 8);
                    d[0] = (f32x4){x[0], x[1], x[2], x[3]}; d[1] = (f32x4){x[4], x[5], x[6], x[7]}; } }
        }
        __syncthreads();
        if (wave < 6) {
#pragma unroll 1
            for (int tok = 0; tok < nt; ++tok) {
                const int m = m0 + t0 + tok, b = m / T, p = m - b * T, l = p - PADR;
                if (l < 0) continue;
                const LAS float* xr = xs + tok * SHIFT_W;
                float w0a = w0j, w1a = 0.f, a0a = a0j, a1a = 0.f;
#pragma unroll
                for (int i = 0; i < 64; i += 4) { if ((i & 15) == 0) __builtin_amdgcn_sched_barrier(0);       const f32x4 t4 = *(const LAS f32x4*)(xr + 1152 + i), d4 = *(const LAS f32x4*)(xr + 1216 + i);
                    w0a += t4.x * wvv[i]; w1a += t4.y * wvv[i + 1]; w0a += t4.z * wvv[i + 2]; w1a += t4.w * wvv[i + 3];
                    a0a += d4.x * avv[i]; a1a += d4.y * avv[i + 1]; a0a += d4.z * avv[i + 2]; a1a += d4.w * avv[i + 3]; }
                const float wlv = w0a + w1a, alv = a0a + a1a;
                const float r = xr[jch], k = xr[384 + jch], v = xr[768 + jch];
                const float logw = -softplus_f(-wlv) - 0.5f;
                const float xw = fast_exp(logw);
                const float om = xw < 0.02f ? xw * (1.f - 0.5f * xw + xw * xw * (1.f / 6.f)) : 1.f - fast_exp(-xw);
                const float av = 1.f / (1.f + fast_exp(-alv));
                const float kkr = k * kkj;
                const float nrm = sqrtf(wave_sum(kkr * kkr));
                const float kk = kkr / fmaxf(nrm, 1e-12f);
                const float kp = k * (1.f + (av - 1.f) * kaj);
                const float bb = kk * av;
                const float coef = wave_sum(r * kp * rkj);
                _Float16* o = RW + ((size_t)(b * RW_H + wave) * LPADDED + l) * 384 + lane;
                if (dry) { float sink = kk + om + bb + kp + coef; asm volatile("" :: "v"(sink)); continue; }
                o[0] = (_Float16)kk; o[64] = (_Float16)(-om); o[128] = (_Float16)(-bb); o[192] = (_Float16)kp; o[256] = (_Float16)r; o[320] = (_Float16)v;
                BN[(size_t)m * RW_W + jch] = f2bf(coef * v);
            }
        } else {
            const int which = wave - 6;
            const float gsc = which == 0 ? gq : gk;
#pragma unroll 1
            for (int th = 0; th < 16; th += 8) {
                unsigned short xv[8][5];
#pragma unroll
                for (int t8 = 0; t8 < 8; ++t8) { const int tok = th + t8, m = m0 + t0 + tok; const int p = m % T;
                    const bf16_t* q = QKV + (size_t)m * QKV_W + 960 + which * 320 + lane;
#pragma unroll
                    for (int hd = 0; hd < 5; ++hd) xv[t8][hd] = (tok < nt && p >= PADR) ? q[hd * 64] : (unsigned short)0; }
#pragma unroll
                for (int t8 = 0; t8 < 8; ++t8) { const int tok = th + t8, m = m0 + t0 + tok; const int p = m % T;
                    bf16_t* q = QKV + (size_t)m * QKV_W + 960 + which * 320 + lane;
                    if (tok < nt && p >= PADR) {
#pragma unroll
                        for (int hd = 0; hd < 5; ++hd) { const float x = bf2f(xv[t8][hd]); const float ss = wave_sum(x * x);
                            const unsigned short r_ = f2bf(x * (1.0f / sqrtf(ss * (1.0f / 64.f) + 1e-6f)) * gsc); if (!dry) q[hd * 64] = r_; else asm volatile("" :: "v"(r_)); } } }
            }
        }
        __syncthreads();
    }
}


constexpr int SCH = 16;
static_assert(LTOK % SCH == 0, "whole chunks");
__device__ __forceinline__ void rwkv_scan(const ArgsL& a, Frame& F, int wgi, int dry = 0) {
    const int bh = wgi >> 4, q8 = wgi & 15, b = bh / RW_H, h = bh % RW_H;
    const int tid = F.tid, wave = F.wave, lane = F.lane;
    const unsigned char* rw = a.ws + WS_RW + (size_t)bh * LPADDED * 768;
    LAS float* ring = (LAS float*)F.lds;
    LAS float* ypart = (LAS float*)(F.lds + 49152);
    LAS unsigned char* stg = F.lds + 81920;
    bf16_t* y0 = (bf16_t*)(a.ws + WS_YCAT);
    constexpr int NCH = LTOK / SCH;
    const bool isld = (wave & 2) != 0; const int lw = (wave & 1) + ((wave >> 2) << 1), tl = lw * 64 + lane;
    float s0 = 0.f, s1 = 0.f;
    const int i32 = lane & 31, rsel = lane >> 5, rloc = 2 * wave + rsel;
#define RW_BAR() asm volatile("s_waitcnt lgkmcnt(0)\n\ts_barrier" ::: "memory")
#define RW_ISSUE(cc) do { const unsigned char* src_ = rw + (size_t)(cc) * SCH * 768 + (size_t)tl * 16; LAS unsigned char* d_ = stg + ((cc) & 3) * 12288 + lw * 1024; \
        _Pragma("unroll") for (int k_ = 0; k_ < 3; ++k_) __builtin_amdgcn_global_load_lds((const unsigned*)(src_ + k_ * 4096), (LAS unsigned*)(d_ + k_ * 4096), 16, 0, 0); } while (0)
#define RW_CONVERT(cc) do { const LAS unsigned char* s_ = stg + ((cc) & 3) * 12288 + tl * 16; LAS float* rb_ = ring + ((cc) & 1) * 6144; \
        _Pragma("unroll") for (int k_ = 0; k_ < 3; ++k_) { const int pc_ = tl + 256 * k_; const int t_ = pc_ / 48, q_ = pc_ - t_ * 48, vec_ = q_ >> 3, e0_ = (q_ & 7) * 8; \
            const u32x4 w_ = *(const LAS u32x4*)(s_ + k_ * 4096); \
            const f16x4 lo_ = __builtin_bit_cast(f16x4, (u32x2){w_.x, w_.y}), hi_ = __builtin_bit_cast(f16x4, (u32x2){w_.z, w_.w}); \
            const float f0 = (float)lo_.x, f1 = (float)lo_.y, f2 = (float)lo_.z, f3 = (float)lo_.w, f4 = (float)hi_.x, f5 = (float)hi_.y, f6 = (float)hi_.z, f7 = (float)hi_.w; \
            if (vec_ < 4) { LAS float* d_ = rb_ + t_ * 384 + (vec_ >> 1) * 128 + (e0_ >> 1) * 4 + (vec_ & 1) * 2; \
                *(LAS f32x2*)(d_) = (f32x2){f0, f1}; *(LAS f32x2*)(d_ + 4) = (f32x2){f2, f3}; *(LAS f32x2*)(d_ + 8) = (f32x2){f4, f5}; *(LAS f32x2*)(d_ + 12) = (f32x2){f6, f7}; } \
            else { LAS f32x4* d_ = (LAS f32x4*)(rb_ + t_ * 384 + (vec_ == 4 ? 256 : 320) + e0_); d_[0] = (f32x4){f0, f1, f2, f3}; d_[1] = (f32x4){f4, f5, f6, f7}; } } } while (0)
#define RW_STORE_Y(cc) do { if (tl < 32) { const LAS float* yb_ = ypart + ((cc) & 1) * 4096; const int t_ = tl >> 1, pr_ = tl & 1; const int l_ = (cc) * SCH + t_; \
        const LAS f32x4* q_ = (const LAS f32x4*)(yb_ + t_ * 128 + pr_ * 64); f32x4 sa_ = q_[0], sb_ = q_[8]; \
        _Pragma("unroll") for (int k_ = 1; k_ < 8; ++k_) { sa_ = sa_ + q_[k_]; sb_ = sb_ + q_[8 + k_]; } \
        *(unsigned*)(y0 + (size_t)(b * T + PADR + l_) * RW_W + h * 64 + q8 * 4 + 2 * pr_) = pk2((sa_.x + sa_.y) + (sa_.z + sa_.w), (sb_.x + sb_.y) + (sb_.z + sb_.w)); } } while (0)
    if (isld) {
        RW_ISSUE(0); asm volatile("s_waitcnt vmcnt(0)" ::: "memory"); RW_CONVERT(0);
        RW_ISSUE(1); RW_ISSUE(2);
    }
    RW_BAR();
    for (int c = 0; c < NCH; ++c) {
        if (isld) {
            if (c + 2 < NCH) { asm volatile("s_waitcnt vmcnt(3)" ::: "memory"); RW_CONVERT(c + 1); }
            else if (c + 1 < NCH) { asm volatile("s_waitcnt vmcnt(0)" ::: "memory"); RW_CONVERT(c + 1); }
            if (c > 0 && !dry) RW_STORE_Y(c - 1);
            if (c + 3 < NCH) RW_ISSUE(c + 3);
        } else if (dry != 1 && wave < 2) {
            const unsigned ba = (unsigned)(uintptr_t)(ring + (c & 1) * 6144) + i32 * 16, ca = (unsigned)(uintptr_t)(ring + (c & 1) * 6144) + 1024 + i32 * 8,
                           va = (unsigned)(uintptr_t)(ring + (c & 1) * 6144) + 1280 + (q8 * 4 + rloc) * 4, ya = (unsigned)(uintptr_t)(ypart + (c & 1) * 4096 + rloc * 32 + i32);
            f32x4 OA[4], OB[4]; f32x2 OC[4]; float OV[4];
            OC[3] = (f32x2){0.f, 0.f};
#define RW_FETCH(tt, sl) asm volatile("ds_read_b128 %0, %4 offset:%c7\n\tds_read_b128 %1, %4 offset:%c8\n\tds_read_b64 %2, %5 offset:%c7\n\tds_read_b32 %3, %6 offset:%c7" \
                : "=&v"(OA[sl]), "=&v"(OB[sl]), "=&v"(OC[sl]), "=&v"(OV[sl]) : "v"(ba), "v"(ca), "v"(va), "i"((tt) * 1536), "i"((tt) * 1536 + 512) : "memory")
            RW_FETCH(0, 0); RW_FETCH(1, 1);
            float p, p2, y;
#define RW_STEP(t, WAITN, YL1, YL2, YW, FETCHL) asm volatile( \
                "s_waitcnt lgkmcnt(" WAITN ")\n\t" \
                "v_mul_f32 %[p], %[s0], %[kk0]\n\t" \
                "v_fmac_f32 %[p], %[s1], %[kk1]\n\t" \
                YL1 "\n\t" YL2 "\n\t" \
                XL8 "\n\t" \
                "v_fmac_f32 %[s0], %[s0], %[om0]\n\t" \
                "v_fmac_f32 %[s1], %[s1], %[om1]\n\t" \
                XL4 "\n\t" \
                "v_fmac_f32 %[s0], %[vf], %[kv0]\n\t" \
                "v_fmac_f32 %[s1], %[vf], %[kv1]\n\t" \
                XL2 "\n\t" \
                YW "\n\t" \
                FETCHL \
                : [p] "=&v"(p), [p2] "=&v"(p2), [y] "=&v"(y), [s0] "+v"(s0), [s1] "+v"(s1), [nA] "=&v"(OA[((t) + 2) & 3]), [nB] "=&v"(OB[((t) + 2) & 3]), [nC] "=&v"(OC[((t) + 2) & 3]), [nV] "=&v"(OV[((t) + 2) & 3]) \
                : [kk0] "v"(OA[(t) & 3].x), [kk1] "v"(OA[(t) & 3].y), [om0] "v"(OA[(t) & 3].z), [om1] "v"(OA[(t) & 3].w), [bb0] "v"(OB[(t) & 3].x), [bb1] "v"(OB[(t) & 3].y), [kv0] "v"(OB[(t) & 3].z), [kv1] "v"(OB[(t) & 3].w), \
                  [vf] "v"(OV[(t) & 3]), [rp0] "v"(OC[((t) + 3) & 3].x), [rp1] "v"(OC[((t) + 3) & 3].y), [ba] "v"(ba), [ca] "v"(ca), [va] "v"(va), [ya] "v"(ya), \
                  [oa] "i"(((t) + 2) * 1536), [ob] "i"(((t) + 2) * 1536 + 512), [oy] "i"(((t) - 1) * 512) : "memory")
#define RW_YL1 "v_mul_f32 %[y], %[s0], %[rp0]"
#define RW_YL2 "v_fmac_f32 %[y], %[s1], %[rp1]"
#define RW_YW  "ds_write_b32 %[ya], %[y] offset:%c[oy]"
#define RW_NOP "s_nop 0"
#define RW_TAIL_F "ds_read_b128 %[nA], %[ba] offset:%c[oa]\n\t" \
                XL1 "\n\t" \
                "ds_read_b128 %[nB], %[ba] offset:%c[ob]\n\t" \
                "ds_read_b64 %[nC], %[ca] offset:%c[oa]\n\t" \
                "v_mov_b32 %[p2], %[p]\n\t" \
                "ds_read_b32 %[nV], %[va] offset:%c[oa]\n\t" \
                "s_nop 0\n\t" \
                XSW "\n\t" \
                "v_add_f32 %[p], %[p], %[p2]\n\t" \
                "v_fmac_f32 %[s0], %[p], %[bb0]\n\t" \
                "v_fmac_f32 %[s1], %[p], %[bb1]"
#define RW_TAIL_N "s_nop 0\n\t" \
                XL1 "\n\t" \
                "s_nop 1\n\t" \
                "v_mov_b32 %[p2], %[p]\n\t" \
                "s_nop 1\n\t" \
                XSW "\n\t" \
                "v_add_f32 %[p], %[p], %[p2]\n\t" \
                "v_fmac_f32 %[s0], %[p], %[bb0]\n\t" \
                "v_fmac_f32 %[s1], %[p], %[bb1]"
#define RW_ALLSTEPS() do { \
            RW_STEP(0, "4", RW_NOP, RW_NOP, RW_NOP, RW_TAIL_F); \
            RW_STEP(1, "4", RW_YL1, RW_YL2, RW_YW, RW_TAIL_F); \
            RW_STEP(2, "5", RW_YL1, RW_YL2, RW_YW, RW_TAIL_F);  RW_STEP(3, "5", RW_YL1, RW_YL2, RW_YW, RW_TAIL_F);  RW_STEP(4, "5", RW_YL1, RW_YL2, RW_YW, RW_TAIL_F); \
            RW_STEP(5, "5", RW_YL1, RW_YL2, RW_YW, RW_TAIL_F);  RW_STEP(6, "5", RW_YL1, RW_YL2, RW_YW, RW_TAIL_F);  RW_STEP(7, "5", RW_YL1, RW_YL2, RW_YW, RW_TAIL_F); \
            RW_STEP(8, "5", RW_YL1, RW_YL2, RW_YW, RW_TAIL_F);  RW_STEP(9, "5", RW_YL1, RW_YL2, RW_YW, RW_TAIL_F);  RW_STEP(10, "5", RW_YL1, RW_YL2, RW_YW, RW_TAIL_F); \
            RW_STEP(11, "5", RW_YL1, RW_YL2, RW_YW, RW_TAIL_F); RW_STEP(12, "5", RW_YL1, RW_YL2, RW_YW, RW_TAIL_F); RW_STEP(13, "5", RW_YL1, RW_YL2, RW_YW, RW_TAIL_F); \
            RW_STEP(14, "5", RW_YL1, RW_YL2, RW_YW, RW_TAIL_N); \
            RW_STEP(15, "1", RW_YL1, RW_YL2, RW_YW, RW_TAIL_N); \
            asm volatile("v_mul_f32 %[y], %[s0], %[r0]\n\tv_fmac_f32 %[y], %[s1], %[r1]\n\tds_write_b32 %[ya], %[y] offset:7680" : [y] "=&v"(y) : [s0] "v"(s0), [s1] "v"(s1), [r0] "v"(OC[3].x), [r1] "v"(OC[3].y), [ya] "v"(ya) : "memory"); \
 } while (0)
#ifdef SCAN_PROBE_NOXL
            if (dry == 2) {
#define XL8 "v_add_f32 %[p], %[p], %[p]"
#define XL4 "v_add_f32 %[p], %[p], %[p]"
#define XL2 "v_add_f32 %[p], %[p], %[p]"
#define XL1 "v_add_f32 %[p], %[p], %[p]"
#define XSW "v_add_f32 %[p], %[p], %[p2]"
                RW_ALLSTEPS();
#undef XL8
#undef XL4
#undef XL2
#undef XL1
#undef XSW
            } else
#endif
            {
#define XL8 "v_add_f32_dpp %[p], %[p], %[p] row_ror:8 row_mask:0xf bank_mask:0xf bound_ctrl:1"
#define XL4 "v_add_f32_dpp %[p], %[p], %[p] row_ror:4 row_mask:0xf bank_mask:0xf bound_ctrl:1"
#define XL2 "v_add_f32_dpp %[p], %[p], %[p] row_ror:2 row_mask:0xf bank_mask:0xf bound_ctrl:1"
#define XL1 "v_add_f32_dpp %[p], %[p], %[p] row_ror:1 row_mask:0xf bank_mask:0xf bound_ctrl:1"
#define XSW "v_permlane16_swap_b32 %[p], %[p2]"
                RW_ALLSTEPS();
            }
#undef RW_ALLSTEPS
#undef RW_STEP
#undef XL8
#undef XL4
#undef XL2
#undef XL1
#undef XSW
#undef RW_YL1
#undef RW_YL2
#undef RW_YW
#undef RW_NOP
#undef RW_TAIL_F
#undef RW_TAIL_N
#undef RW_FETCH
        }
        RW_BAR();
    }
    if (isld && !dry) RW_STORE_Y(NCH - 1);
    asm volatile("s_waitcnt vmcnt(0) lgkmcnt(0)\n\ts_barrier" ::: "memory");
#undef RW_STORE_Y
#undef RW_ISSUE
#undef RW_CONVERT
#undef RW_BAR
}

__device__ __forceinline__ int crow(int r, int hi) { return (r & 3) + 8 * (r >> 2) + 4 * hi; }
__device__ __forceinline__ void glds16(const void* gsrc, unsigned lds_dst) { unsigned keep;
    asm volatile("s_mov_b32 %0, m0\n\ts_mov_b32 m0, %2\n\ts_nop 0\n\tglobal_load_lds_dwordx4 %1, off\n\ts_mov_b32 m0, %0" : "=&s"(keep) : "v"(gsrc), "s"(lds_dst) : "memory"); }
__device__ __forceinline__ void glds4(const void* gsrc, unsigned lds_dst) { unsigned keep;
    asm volatile("s_mov_b32 %0, m0\n\ts_mov_b32 m0, %2\n\ts_nop 0\n\tglobal_load_lds_dword %1, off\n\ts_mov_b32 m0, %0" : "=&s"(keep) : "v"(gsrc), "s"(lds_dst) : "memory"); }
typedef LAS const char* lds_cptr;
constexpr int FX_K = 0, FX_V = 16384, FX_WS = 32768, FX_OST = 34816, FX_FLG = 67584, FX_KB = 67840  ;

__device__ __forceinline__ void fx_pv(f32x16* o, int vb, bf16x8 pa0, bf16x8 pa1, bf16x8 pa2, bf16x8 pa3) {
#pragma unroll
    for (int d0 = 0; d0 < 2; ++d0) { s16x4 lo[4], hi[4];
#pragma unroll
        for (int ks = 0; ks < 4; ++ks) {
            asm volatile("ds_read_b64_tr_b16 %0,%1 offset:%c2" : "=&v"(lo[ks]) : "v"(vb), "i"(d0 * 4096 + ks * 1024) : "memory");
            asm volatile("ds_read_b64_tr_b16 %0,%1 offset:%c2" : "=&v"(hi[ks]) : "v"(vb), "i"(d0 * 4096 + ks * 1024 + 512) : "memory"); }
        asm volatile("s_waitcnt lgkmcnt(0)" ::: "memory"); __builtin_amdgcn_sched_barrier(0);
#define FX_PK(k) (bf16x8){lo[k][0], lo[k][1], lo[k][2], lo[k][3], hi[k][0], hi[k][1], hi[k][2], hi[k][3]}
        o[d0] = __builtin_amdgcn_mfma_f32_32x32x16_bf16(pa0, FX_PK(0), o[d0], 0, 0, 0);
        o[d0] = __builtin_amdgcn_mfma_f32_32x32x16_bf16(pa1, FX_PK(1), o[d0], 0, 0, 0);
        o[d0] = __builtin_amdgcn_mfma_f32_32x32x16_bf16(pa2, FX_PK(2), o[d0], 0, 0, 0);
        o[d0] = __builtin_amdgcn_mfma_f32_32x32x16_bf16(pa3, FX_PK(3), o[d0], 0, 0, 0);
#undef FX_PK
    }
}
__device__ __forceinline__ float halves_max(float m) { auto rr = __builtin_amdgcn_permlane32_swap(__float_as_uint(m), __float_as_uint(m), false, false); return fmaxf(__uint_as_float(rr[0]), __uint_as_float(rr[1])); }
__device__ __forceinline__ float halves_sum(float m) { auto rr = __builtin_amdgcn_permlane32_swap(__float_as_uint(m), __float_as_uint(m), false, false); return __uint_as_float(rr[0]) + __uint_as_float(rr[1]); }

template <int KIND>
__device__ __forceinline__ void attn_unit(const ArgsL& a, Frame& F, int b, int h, int qb, float bound) {
    const int lane = F.lane, wave = F.wave, r32 = lane & 31, hi = lane >> 5;
    LAS unsigned char* lds = F.lds;
    const bf16_t* QKV = (const bf16_t*)(a.ws + WS_QKV);
    const size_t rowbase = (size_t)b * T;
    const int p0 = qb * 256;
    constexpr int QC = KIND ? 0 : 960, KC = KIND ? 320 : 1280, VC = KIND ? 640 : 1600;
    const bf16_t* Qw = QKV + (rowbase + p0 + wave * 32) * QKV_W + QC + h * 64;
    const bf16_t* Kh = QKV + rowbase * QKV_W + KC + h * 64;
    const bf16_t* Vh = QKV + rowbase * QKV_W + VC + h * 64;
    const float* kbias = (const float*)(a.ws + WS_KB2) + (size_t)(b * FX_H + h) * KBP;
    const unsigned lds0 = (unsigned)(uintptr_t)lds;
    bf16x8 qr[4];
#pragma unroll
    for (int d0 = 0; d0 < 4; ++d0) qr[d0] = *(const bf16x8*)(Qw + (size_t)r32 * QKV_W + d0 * 16 + hi * 8);
    const int qp = p0 + wave * 32 + r32;
    const bool qvalid = (qp >= PADR) && (qp < T);
    const int plast = (p0 + 255) < (T - 1) ? (p0 + 255) : (T - 1);
    const int jlast = plast >> 6, jfirst = PADR >> 6;
    const int jw = (p0 + wave * 32 + 31) >> 6;
    const bf16_t* ksrc = Kh + (size_t)lane * QKV_W + wave * 8;
    const bf16_t* vsrc = Vh + (size_t)(16 * (wave & 3) + (lane >> 2)) * QKV_W + (wave >> 2) * 32 + (lane & 3) * 8;
    const unsigned kdst = lds0 + FX_K + wave * 1024, vdst = lds0 + FX_V + wave * 1024;
#define FX_DMA(j, slot) do { glds16(ksrc + (size_t)(j) * 64 * QKV_W, (unsigned)__builtin_amdgcn_readfirstlane(kdst + (slot) * 8192)); \
                             glds16(vsrc + (size_t)(j) * 64 * QKV_W, (unsigned)__builtin_amdgcn_readfirstlane(vdst + (slot) * 8192)); \
                             if (KIND == 0) glds4(kbias + 64 * (j) + lane, (unsigned)__builtin_amdgcn_readfirstlane(lds0 + FX_KB + (slot) * 2048 + wave * 256)); } while (0)
    const int vb0 = (int)(lds0 + FX_V) + ((lane >> 4) & 1) * 32 + (lane & 3) * 8 + (4 * hi + ((lane & 15) >> 2)) * 64;
    const lds_cptr kp0 = (lds_cptr)lds + FX_K + hi * 1024 + r32 * 16;
    LAS float* wsf = (LAS float*)(lds + FX_WS) + wave * 64;
    LAS float* flg = (LAS float*)(lds + FX_FLG);
    float m_run = KIND ? 0.f : -1.0e30f, l_run = 0.f;
    f32x16 o[2]; o[0] = f32x16{}; o[1] = f32x16{};
    asm volatile("" : "+v"(qr[0]), "+v"(qr[1]), "+v"(qr[2]), "+v"(qr[3]));
    int slot = 0; bool stop = false;
    FX_DMA(jlast, 0);
    for (int j = jlast; j >= jfirst; --j) {
        if (stop) break;
        if (j > jfirst) { FX_DMA(j - 1, slot ^ 1); if (KIND == 0) asm volatile("s_waitcnt vmcnt(3) lgkmcnt(0)\n\ts_barrier" ::: "memory"); else asm volatile("s_waitcnt vmcnt(2) lgkmcnt(0)\n\ts_barrier" ::: "memory"); }
        else asm volatile("s_waitcnt vmcnt(0) lgkmcnt(0)\n\ts_barrier" ::: "memory");
        if (j <= jw) {
            f32x16 s0v = f32x16{}, s1v = f32x16{};
            const lds_cptr kp = kp0 + slot * 8192;
#pragma unroll
            for (int d0 = 0; d0 < 4; ++d0) {
                const bf16x8 b0 = *(const LAS bf16x8*)(kp + d0 * 2048);
                const bf16x8 b1 = *(const LAS bf16x8*)(kp + d0 * 2048 + 512);
                s0v = __builtin_amdgcn_mfma_f32_32x32x16_bf16(b0, qr[d0], s0v, 0, 0, 0);
                s1v = __builtin_amdgcn_mfma_f32_32x32x16_bf16(b1, qr[d0], s1v, 0, 0, 0);
            }
            const bool edge = (64 * j + 63 >= p0 + wave * 32) || (64 * j < PADR);
            if constexpr (KIND == 0) {
                const LAS float* kbj = (const LAS float*)(lds + FX_KB + slot * 2048 + wave * 256) + 4 * hi;
#pragma unroll
                for (int g = 0; g < 4; ++g) { const f32x4 t0 = *(const LAS f32x4*)(kbj + 8 * g), t1 = *(const LAS f32x4*)(kbj + 32 + 8 * g);
                    s0v[4 * g] += t0.x; s0v[4 * g + 1] += t0.y; s0v[4 * g + 2] += t0.z; s0v[4 * g + 3] += t0.w;
                    s1v[4 * g] += t1.x; s1v[4 * g + 1] += t1.y; s1v[4 * g + 2] += t1.z; s1v[4 * g + 3] += t1.w; }
                if (edge) {
#pragma unroll
                    for (int r = 0; r < 16; ++r) { const int key = 64 * j + crow(r, hi);
                        if (key > qp || key < PADR) s0v[r] = -INFINITY;
                        if (key + 32 > qp || key + 32 < PADR) s1v[r] = -INFINITY; }
                }
                float rm = fmaxf(s0v[0], s1v[0]);
#pragma unroll
                for (int r = 1; r < 16; ++r) rm = fmaxf(rm, fmaxf(s0v[r], s1v[r]));
                rm = halves_max(rm);
                const float m_new = fmaxf(m_run, rm);
                const float f = __builtin_amdgcn_exp2f(m_run - m_new);
                m_run = m_new;
                float rs = 0.f;
#pragma unroll
                for (int r = 0; r < 16; ++r) { s0v[r] = __builtin_amdgcn_exp2f(s0v[r] - m_new); s1v[r] = __builtin_amdgcn_exp2f(s1v[r] - m_new); rs += s0v[r] + s1v[r]; }
                rs = halves_sum(rs);
                l_run = l_run * f + rs;
                if (!__all(f == 1.0f)) {
                    if (hi == 0) wsf[r32] = f;
                    LDS_WAIT();
#pragma unroll
                    for (int d_ = 0; d_ < 2; ++d_)
#pragma unroll
                        for (int r = 0; r < 16; ++r) o[d_][r] *= wsf[crow(r, hi)];
                }
            } else {
                f32x16 l0, l1;
#pragma unroll
                for (int r = 0; r < 16; ++r) {
                    const float z0 = s0v[r], z1 = s1v[r];
                    float a0 = -(fmaxf(z0, 0.f) + __builtin_amdgcn_logf(1.f + __builtin_amdgcn_exp2f(-fabsf(z0))));
                    float a1 = -(fmaxf(z1, 0.f) + __builtin_amdgcn_logf(1.f + __builtin_amdgcn_exp2f(-fabsf(z1))));
                    if (edge) { const int key = 64 * j + crow(r, hi);
                        if (key >= qp || key < PADR) { a0 = 0.f; s0v[r] = -INFINITY; }
                        if (key + 32 >= qp || key + 32 < PADR) { a1 = 0.f; s1v[r] = -INFINITY; } }
                    l0[r] = a0; l1[r] = a1;
                }
                float A[8], SA[9], SO[9];
#pragma unroll
                for (int g = 0; g < 4; ++g) { A[g] = (l0[4 * g] + l0[4 * g + 1]) + (l0[4 * g + 2] + l0[4 * g + 3]); A[4 + g] = (l1[4 * g] + l1[4 * g + 1]) + (l1[4 * g + 2] + l1[4 * g + 3]); }
                SA[8] = 0.f; SO[8] = 0.f;
#pragma unroll
                for (int g = 7; g >= 0; --g) SA[g] = A[g] + SA[g + 1];
#pragma unroll
                for (int g = 0; g < 8; ++g) { auto rr = __builtin_amdgcn_permlane32_swap(__float_as_uint(SA[g]), __float_as_uint(SA[g]), false, false); SO[g] = __uint_as_float(hi ? rr[0] : rr[1]); }
                const float R = m_run;
#pragma unroll
                for (int g = 0; g < 8; ++g) {
                    const float E = SA[g + 1] + (hi ? SO[g + 1] : SO[g]) + R;
                    if (g < 4) { float t = E;
                        s0v[4 * g + 3] = __builtin_amdgcn_exp2f(s0v[4 * g + 3] + l0[4 * g + 3] + t); t += l0[4 * g + 3];
                        s0v[4 * g + 2] = __builtin_amdgcn_exp2f(s0v[4 * g + 2] + l0[4 * g + 2] + t); t += l0[4 * g + 2];
                        s0v[4 * g + 1] = __builtin_amdgcn_exp2f(s0v[4 * g + 1] + l0[4 * g + 1] + t); t += l0[4 * g + 1];
                        s0v[4 * g + 0] = __builtin_amdgcn_exp2f(s0v[4 * g + 0] + l0[4 * g + 0] + t);
                    } else { const int q = g - 4; float t = E;
                        s1v[4 * q + 3] = __builtin_amdgcn_exp2f(s1v[4 * q + 3] + l1[4 * q + 3] + t); t += l1[4 * q + 3];
                        s1v[4 * q + 2] = __builtin_amdgcn_exp2f(s1v[4 * q + 2] + l1[4 * q + 2] + t); t += l1[4 * q + 2];
                        s1v[4 * q + 1] = __builtin_amdgcn_exp2f(s1v[4 * q + 1] + l1[4 * q + 1] + t); t += l1[4 * q + 1];
                        s1v[4 * q + 0] = __builtin_amdgcn_exp2f(s1v[4 * q + 0] + l1[4 * q + 0] + t);
                    }
                }
                m_run = R + SA[0] + SO[0];
            }
            u32x4 pw0, pw1, pw2, pw3;
            pw0 = (u32x4){pk2(s0v[0], s0v[1]), pk2(s0v[2], s0v[3]), pk2(s0v[4], s0v[5]), pk2(s0v[6], s0v[7])};
            pw1 = (u32x4){pk2(s0v[8], s0v[9]), pk2(s0v[10], s0v[11]), pk2(s0v[12], s0v[13]), pk2(s0v[14], s0v[15])};
            pw2 = (u32x4){pk2(s1v[0], s1v[1]), pk2(s1v[2], s1v[3]), pk2(s1v[4], s1v[5]), pk2(s1v[6], s1v[7])};
            pw3 = (u32x4){pk2(s1v[8], s1v[9]), pk2(s1v[10], s1v[11]), pk2(s1v[12], s1v[13]), pk2(s1v[14], s1v[15])};
            fx_pv(o, vb0 + slot * 8192, __builtin_bit_cast(bf16x8, pw0), __builtin_bit_cast(bf16x8, pw1), __builtin_bit_cast(bf16x8, pw2), __builtin_bit_cast(bf16x8, pw3));
        }
        float mm = qvalid ? m_run : (KIND ? -3.0e38f : 3.0e38f);
#pragma unroll
        for (int off = 1; off < 64; off <<= 1) { const float t = __shfl_xor(mm, off); mm = KIND ? fmaxf(mm, t) : fminf(mm, t); }
        if (lane == 0) flg[(j & 1) * 8 + wave] = mm;
        asm volatile("s_waitcnt lgkmcnt(0)\n\ts_barrier" ::: "memory");
        if (j > jfirst) {
            const f32x4 fa = *(const LAS f32x4*)(flg + (j & 1) * 8), fb = *(const LAS f32x4*)(flg + (j & 1) * 8 + 4);
            if constexpr (KIND == 0) {
                const float mmin = fminf(fminf(fminf(fa.x, fa.y), fminf(fa.z, fa.w)), fminf(fminf(fb.x, fb.y), fminf(fb.z, fb.w)));
                const float kbmax = *(const LAS float*)(lds + FX_KB + slot * 2048 + wave * 256);
                stop = (bound + kbmax - mmin) < -150.0f;
            } else {
                const float mmax = fmaxf(fmaxf(fmaxf(fa.x, fa.y), fmaxf(fa.z, fa.w)), fmaxf(fmaxf(fb.x, fb.y), fmaxf(fb.z, fb.w)));
                stop = mmax < -150.0f;
            }
        }
        slot ^= 1;
    }
    asm volatile("s_waitcnt vmcnt(0) lgkmcnt(0)\n\ts_barrier" ::: "memory");
    float rli[16];
    if constexpr (KIND == 0) {
        if (hi == 0) wsf[32 + r32] = l_run;
        LDS_WAIT();
#pragma unroll
        for (int r = 0; r < 16; ++r) rli[r] = __builtin_amdgcn_rcpf(wsf[32 + crow(r, hi)]);
    } else {
#pragma unroll
        for (int r = 0; r < 16; ++r) rli[r] = 1.0f;
    }
    bf16_t* Ow = (bf16_t*)(a.ws + WS_YCAT) + (size_t)(KIND ? 1 : 2) * M * RW_W + (rowbase + p0 + wave * 32) * RW_W + h * 64;
    {
        LAS bf16_t* stg = (LAS bf16_t*)(lds + FX_OST) + wave * 2048;
#pragma unroll
        for (int r = 0; r < 16; ++r) { const int orow = crow(r, hi);
#pragma unroll
            for (int d0 = 0; d0 < 2; ++d0) stg[orow * 64 + d0 * 32 + r32] = f2bf(o[d0][r] * rli[r]); }
        LDS_WAIT();
#pragma unroll
        for (int i = 0; i < 4; ++i) { const int row = i * 8 + (lane >> 3), ch = lane & 7; const u32x4 v = *(const LAS u32x4*)(stg + row * 64 + ch * 8);
            const int pr = p0 + wave * 32 + row;
            if (pr >= PADR && pr < T) *(u32x4*)(Ow + (size_t)row * RW_W + ch * 8) = v; }
    }
    asm volatile("s_waitcnt lgkmcnt(0)\n\ts_barrier" ::: "memory");
#undef FX_DMA
}


constexpr int CK = 64, NCK = 257, CKB = 40960;
static_assert(LPADDED == CK * NCK, "padded steps");
__device__ __forceinline__ int swz(int row, int chunk) { return row * 128 + ((chunk ^ (row & 7)) << 4); }
__device__ __forceinline__ void ck_mm(f32x16& acc, LAS unsigned char* A, LAS unsigned char* Bt, int m0, int n0, int r32, int hi) {
#pragma unroll
    for (int ks = 0; ks < 4; ++ks) {
        const bf16x8 av = *(const LAS bf16x8*)(A + swz(m0 + r32, 2 * ks + hi));
        const bf16x8 bv = *(const LAS bf16x8*)(Bt + swz(n0 + r32, 2 * ks + hi));
        acc = __builtin_amdgcn_mfma_f32_32x32x16_bf16(av, bv, acc, 0, 0, 0);
    }
}
__device__ __forceinline__ void ck_store_t(LAS unsigned char* dst, const f32x16& acc, int m0, int n0, int r32, int hi) {
#pragma unroll
    for (int g = 0; g < 4; ++g) { const u32x2 w = {pk2(acc[4 * g], acc[4 * g + 1]), pk2(acc[4 * g + 2], acc[4 * g + 3])};
        *(LAS u32x2*)(dst + swz(n0 + r32, (m0 >> 3) + g) + hi * 8) = w; }
}
constexpr int CA_KAP = 0, CA_BET = 8192, CA_CHI = 16384, CA_RHO = 24576, CA_VMT = 32768, CA_BHT = 40960, CA_KHT = 49152, CA_AK = 57344, CA_RB = 65536, CA_RK = 73728,
              CA_AB = 81920  , CA_RHS = 98304  , CA_G64 = MISC_OFF + 2048  , CA_SCR = MISC_OFF + 4096  ;

#ifndef CA_STAGES
#define CA_STAGES 15
#endif
__device__ __forceinline__ void phase_chunkA(const ArgsL& a, Frame& F, const bool dry = false) {
    const int wave = F.wave;
    LAS unsigned char* L = F.lds;
    u32x4 pre6[6];
    for (int id = F.bx; id < 12 * NCK; id += (int)gridDim.x) {
        int tid = F.tid, lane, r32, hi;
#define CK_FRESH() do { asm volatile("" : "+v"(tid)); lane = tid & 63; r32 = lane & 31; hi = lane >> 5; } while (0)
        CK_FRESH();
        const int bh = id / NCK, c = id - bh * NCK;
        unsigned char* blk = a.ws + WS_RW + ((size_t)bh * LPADDED + (size_t)c * CK) * 768;
        {
            if (id == F.bx) {
#pragma unroll
                for (int q6 = 0; q6 < 6; ++q6) pre6[q6] = *(const u32x4*)(blk + (size_t)(tid + q6 * NTHR) * 16);
            }
#pragma unroll
            for (int q6 = 0; q6 < 6; ++q6) *(LAS u32x4*)(L + CA_AB + (tid + q6 * NTHR) * 16) = pre6[q6];
            __syncthreads();
            const int k = tid & 63, tq = tid >> 6;
            const LAS _Float16* src = (const LAS _Float16*)(L + CA_AB) + (tq * 8) * 384 + k;
            float kk[8], w[8], bb[8], kp[8], rr[8], vv[8];
#pragma unroll
            for (int e = 0; e < 8; ++e) { kk[e] = (float)src[e * 384]; w[e] = 1.f + (float)src[e * 384 + 64]; bb[e] = -(float)src[e * 384 + 128];
                kp[e] = (float)src[e * 384 + 192]; rr[e] = (float)src[e * 384 + 256]; vv[e] = (float)src[e * 384 + 320]; }
            float g[8]; g[0] = w[0];
#pragma unroll
            for (int e = 1; e < 8; ++e) g[e] = g[e - 1] * w[e];
            LAS float* scr = (LAS float*)(L + CA_SCR);
            scr[tq * 64 + k] = g[7];
            __syncthreads();
            {
                const int idn = id + (int)gridDim.x;
                if (idn < 12 * NCK) { const int bhn = idn / NCK, cn = idn - bhn * NCK; const unsigned char* bn_ = a.ws + WS_RW + ((size_t)bhn * LPADDED + (size_t)cn * CK) * 768;
#pragma unroll
                    for (int q6 = 0; q6 < 6; ++q6) pre6[q6] = *(const u32x4*)(bn_ + (size_t)(tid + q6 * NTHR) * 16); }
            }
            float pre = 1.f, tot = 1.f;
#pragma unroll
            for (int q = 0; q < 8; ++q) { const float s = scr[q * 64 + k]; if (q < tq) pre *= s; tot *= s; }
            if (tq == 0) ((LAS float*)(L + CA_G64))[k] = tot;
            unsigned bh4[4], kh4[4], vm4[4];
            float Gp = pre;
#pragma unroll
            for (int e = 0; e < 8; ++e) {
                const int t = tq * 8 + e; const float G = pre * g[e], iG = __builtin_amdgcn_rcpf(G);
                const float kap = kk[e] * Gp, bet = bb[e] * iG, chi = kp[e] * iG, rho = rr[e] * G;
                const int o = swz(t, k >> 3) + (k & 7) * 2;
                *(LAS unsigned short*)(L + CA_KAP + o) = f2bf(kap); *(LAS unsigned short*)(L + CA_BET + o) = f2bf(bet);
                *(LAS unsigned short*)(L + CA_CHI + o) = f2bf(chi); *(LAS unsigned short*)(L + CA_RHO + o) = f2bf(rho);
                ((LAS float*)(L + CA_RHS))[t * 128 + k] = kap;
                const float bhv = bet * tot, khv = chi * tot;
                if (e & 1) { bh4[e >> 1] |= (unsigned)f2bf(bhv) << 16; kh4[e >> 1] |= (unsigned)f2bf(khv) << 16; vm4[e >> 1] |= (unsigned)f2bf(vv[e]) << 16; }
                else { bh4[e >> 1] = f2bf(bhv); kh4[e >> 1] = f2bf(khv); vm4[e >> 1] = f2bf(vv[e]); }
                Gp = G;
            }
            *(LAS u32x4*)(L + CA_BHT + swz(k, tq)) = (u32x4){bh4[0], bh4[1], bh4[2], bh4[3]};
            *(LAS u32x4*)(L + CA_KHT + swz(k, tq)) = (u32x4){kh4[0], kh4[1], kh4[2], kh4[3]};
            *(LAS u32x4*)(L + CA_VMT + swz(k, tq)) = (u32x4){vm4[0], vm4[1], vm4[2], vm4[3]};
        }
        __syncthreads();
        CK_FRESH();
        if (!dry || (CA_STAGES & 2)) {
            const int p = wave & 3, nb = wave >> 2;
            LAS unsigned char* Am = L + ((p & 1) ? CA_CHI : CA_BET);
            LAS unsigned char* Bm = L + ((p & 2) ? CA_RHO : CA_KAP);
#pragma unroll
            for (int mb = 0; mb < 2; ++mb) {
                f32x16 acc = f32x16{};
                if (!(mb == 1 && nb == 0)) ck_mm(acc, Am, Bm, mb * 32, nb * 32, r32, hi);
                const int t = nb * 32 + r32;
#pragma unroll
                for (int i = 0; i < 16; ++i) { const int j = mb * 32 + crow(i, hi); const bool keep = (p & 2) ? (j <= t) : (j < t); if (!keep) acc[i] = 0.f; }
                if (p == 0) {
#pragma unroll
                    for (int gq = 0; gq < 4; ++gq) { LAS float* ab_ = (LAS float*)(L + CA_AB) + t * 64 + (mb * 8 + 2 * gq + hi);
                        ab_[0] = acc[4 * gq]; ab_[16] = acc[4 * gq + 1]; ab_[32] = acc[4 * gq + 2]; ab_[48] = acc[4 * gq + 3]; }
                } else ck_store_t(L + (p == 1 ? CA_AK : p == 2 ? CA_RB : CA_RK), acc, mb * 32, nb * 32, r32, hi);
            }
        }
        __syncthreads();
        CK_FRESH();
        if (wave < 4 && (!dry || (CA_STAGES & 2))) {
            const int mb = wave >> 1, nb = wave & 1;
            f32x16 acc = f32x16{};
            ck_mm(acc, L + CA_AK, L + CA_VMT, mb * 32, nb * 32, r32, hi);
#pragma unroll
            for (int i = 0; i < 16; ++i) ((LAS float*)(L + CA_RHS))[(mb * 32 + crow(i, hi)) * 128 + 64 + nb * 32 + r32] = acc[i];
        }
        __syncthreads();
        CK_FRESH();
        if (!dry || (CA_STAGES & 4)) {
            const int col = tid >> 2, p = tid & 3;
            unsigned abv = (unsigned)(uintptr_t)(L + CA_AB) + p * 64; asm volatile("" : "+v"(abv));
            const LAS float* ab = (const LAS float*)(uintptr_t)abv;
            const LAS float* rhs = (const LAS float*)(L + CA_RHS) + col;
            float xo[16];
#pragma unroll
            for (int i = 0; i < 16; ++i) xo[i] = 0.f;
#pragma unroll
            for (int tg = 0; tg < 64; tg += 4) {
                f32x4 av[4][4]; float rv[4];
#pragma unroll
                for (int r = 0; r < 4; ++r) { rv[r] = rhs[(tg + r) * 128];
#pragma unroll
                    for (int i4 = 0; i4 < (tg + r + 15) / 16; ++i4) av[r][i4] = *(const LAS f32x4*)(ab + (tg + r) * 64 + 4 * i4); }
#pragma unroll
                for (int r = 0; r < 4; ++r) { const int t = tg + r;
                    float s0 = (p == 0) ? rv[r] : 0.f, s1 = 0.f;
#pragma unroll
                    for (int i4 = 0; i4 < (t + 15) / 16; ++i4) {
                        s0 -= av[r][i4].x * xo[4 * i4]; s1 -= av[r][i4].y * xo[4 * i4 + 1]; s0 -= av[r][i4].z * xo[4 * i4 + 2]; s1 -= av[r][i4].w * xo[4 * i4 + 3]; }
                    float sx = s0 + s1;
                    sx += dpp_f<0xB1>(sx);
                    sx += dpp_f<0x4E>(sx);
                    if ((t & 3) == p) xo[t >> 2] = sx;
                    asm volatile("" : "+v"(xo[t >> 2]));
                }
                __builtin_amdgcn_sched_barrier(0);
            }
            LAS unsigned char* dst = L + (col < 64 ? CA_KAP : CA_BET);
            const int rowc = col & 63;
#pragma unroll
            for (int i = 0; i < 16; ++i) { const int tt = 4 * i + p; *(LAS unsigned short*)(dst + swz(rowc, tt >> 3) + (tt & 7) * 2) = f2bf(-xo[i]); }
        }
        __syncthreads();
        CK_FRESH();
        if (!dry || (CA_STAGES & 8)) {
            const int ty = wave >> 1;
            LAS unsigned char* nW1 = L + CA_KAP; LAS unsigned char* nW2 = L + CA_BET;
#pragma unroll
            for (int qq = 0; qq < 2; ++qq) {
                const int q = (wave & 1) * 2 + qq, qa = q >> 1, qb = q & 1;
                f32x16 acc = f32x16{};
                if (ty == 0) {
                    const int t = qa * 32 + r32;
#pragma unroll
                    for (int gq = 0; gq < 4; ++gq) { const u32x2 rv = *(const LAS u32x2*)(L + CA_RHO + swz(t, qb * 4 + gq) + hi * 8);
                        acc[4 * gq] = bf_lo(rv.x); acc[4 * gq + 1] = bf_hi(rv.x); acc[4 * gq + 2] = bf_lo(rv.y); acc[4 * gq + 3] = bf_hi(rv.y); }
                    ck_mm(acc, nW1, L + CA_RB, qb * 32, qa * 32, r32, hi);
                } else if (ty == 1) {
                    ck_mm(acc, nW1, L + CA_BHT, qb * 32, qa * 32, r32, hi);
                    if (qa == qb) { const float g64 = ((const LAS float*)(L + CA_G64))[qa * 32 + r32];
#pragma unroll
                        for (int i = 0; i < 16; ++i) if (crow(i, hi) == r32) acc[i] += g64; }
                } else if (ty == 2) {
                    ck_mm(acc, L + CA_KHT, L + CA_VMT, qb * 32, qa * 32, r32, hi);
                    ck_mm(acc, L + CA_BHT, nW2, qb * 32, qa * 32, r32, hi);
                } else {
                    ck_mm(acc, L + CA_RK, L + CA_VMT, qb * 32, qa * 32, r32, hi);
                    ck_mm(acc, L + CA_RB, nW2, qb * 32, qa * 32, r32, hi);
                }
                if (dry) { float sink = acc[0] + acc[5] + acc[10] + acc[15]; asm volatile("" :: "v"(sink)); }
                else if (ty < 2) {
                    unsigned char* o = blk + (ty == 0 ? 8192 : 0) + (size_t)(((qa * 2 + qb) * 2) * 1024) + lane * 16;
#pragma unroll
                    for (int ks = 0; ks < 2; ++ks)
                        *(u32x4*)(o + ks * 1024) = (u32x4){pk2(acc[8 * ks], acc[8 * ks + 1]), pk2(acc[8 * ks + 2], acc[8 * ks + 3]), pk2(acc[8 * ks + 4], acc[8 * ks + 5]), pk2(acc[8 * ks + 6], acc[8 * ks + 7])};
                } else if (ty == 2) {
                    float* o = (float*)(blk + 16384 + (qa * 2 + qb) * 4096) + lane;
#pragma unroll
                    for (int i = 0; i < 16; ++i) o[i * 64] = acc[i];
                } else {
                    bf16_t* o = (bf16_t*)(blk + 32768 + (qa * 2 + qb) * 2048) + lane;
#pragma unroll
                    for (int i = 0; i < 16; ++i) o[i * 64] = f2bf(acc[i]);
                }
            }
        }
        __syncthreads();
    }
}

__device__ __forceinline__ void rwkv_chunkB(const ArgsL& a, Frame& F, int bh) {
    const int lane = F.lane, wave = F.wave, r32 = lane & 31, hi = lane >> 5;
    const int b = bh / RW_H, h = bh % RW_H;
    LAS unsigned char* L = F.lds;
    const unsigned char* base = a.ws + WS_RW + (size_t)bh * LPADDED * 768;
    bf16_t* y0 = (bf16_t*)(a.ws + WS_YCAT);
    const bool isld = (wave >= 2 && wave < 7); const int lw = wave - 2;
#define CB_ISSUE(cc) do { const unsigned char* s_ = base + (size_t)(cc) * CK * 768 + (size_t)lw * 1024 + lane * 16; LAS unsigned char* d_ = L + ((cc) % 3) * CKB + lw * 1024; \
        _Pragma("unroll") for (int r_ = 0; r_ < 8; ++r_) __builtin_amdgcn_global_load_lds((const unsigned*)(s_ + r_ * 5120), (LAS unsigned*)(d_ + r_ * 5120), 16, 0, 0); } while (0)
    if (isld) { CB_ISSUE(0); CB_ISSUE(1); asm volatile("s_waitcnt vmcnt(8)" ::: "memory"); }
    asm volatile("s_waitcnt lgkmcnt(0)\n\ts_barrier" ::: "memory");
    f32x16 Z0 = f32x16{}, Z1 = f32x16{};
    for (int c = 0; c < NCK; ++c) {
        if (isld) {
            if (c + 2 < NCK) CB_ISSUE(c + 2);
            if (c + 2 < NCK) asm volatile("s_waitcnt vmcnt(8)" ::: "memory"); else asm volatile("s_waitcnt vmcnt(0)" ::: "memory");
        } else if (wave < 2) {
            const LAS unsigned char* S = L + (c % 3) * CKB;
            const int vb = wave;
            bf16x8 zf[2][2];
#pragma unroll
            for (int ks = 0; ks < 2; ++ks) {
                zf[0][ks] = __builtin_bit_cast(bf16x8, (u32x4){pk2(Z0[8 * ks], Z0[8 * ks + 1]), pk2(Z0[8 * ks + 2], Z0[8 * ks + 3]), pk2(Z0[8 * ks + 4], Z0[8 * ks + 5]), pk2(Z0[8 * ks + 6], Z0[8 * ks + 7])});
                zf[1][ks] = __builtin_bit_cast(bf16x8, (u32x4){pk2(Z1[8 * ks], Z1[8 * ks + 1]), pk2(Z1[8 * ks + 2], Z1[8 * ks + 3]), pk2(Z1[8 * ks + 4], Z1[8 * ks + 5]), pk2(Z1[8 * ks + 6], Z1[8 * ks + 7])});
            }
#pragma unroll
            for (int tb = 0; tb < 2; ++tb) {
                f32x16 acc;
                const LAS bf16_t* yt = (const LAS bf16_t*)(S + 32768 + (vb * 2 + tb) * 2048) + lane;
#pragma unroll
                for (int i = 0; i < 16; ++i) acc[i] = bf2f(yt[i * 64]);
#pragma unroll
                for (int kb2 = 0; kb2 < 2; ++kb2)
#pragma unroll
                    for (int ks = 0; ks < 2; ++ks) { const bf16x8 pa = *(const LAS bf16x8*)(S + 8192 + ((tb * 2 + kb2) * 2 + ks) * 1024 + lane * 16);
                        acc = __builtin_amdgcn_mfma_f32_32x32x16_bf16(pa, zf[kb2][ks], acc, 0, 0, 0); }
#pragma unroll
                for (int i = 0; i < 16; ++i) { const int l = c * CK + tb * 32 + crow(i, hi);
                    if (l < LTOK) y0[(size_t)(b * T + PADR + l) * RW_W + h * 64 + vb * 32 + r32] = f2bf(acc[i]); }
            }
            f32x16 N0, N1;
            { const LAS float* n0 = (const LAS float*)(S + 16384 + (vb * 2 + 0) * 4096) + lane; const LAS float* n1 = (const LAS float*)(S + 16384 + (vb * 2 + 1) * 4096) + lane;
#pragma unroll
              for (int i = 0; i < 16; ++i) { N0[i] = n0[i * 64]; N1[i] = n1[i * 64]; } }
#pragma unroll
            for (int kb2 = 0; kb2 < 2; ++kb2)
#pragma unroll
                for (int ks = 0; ks < 2; ++ks) {
                    const bf16x8 m0 = *(const LAS bf16x8*)(S + ((0 * 2 + kb2) * 2 + ks) * 1024 + lane * 16);
                    const bf16x8 m1 = *(const LAS bf16x8*)(S + ((1 * 2 + kb2) * 2 + ks) * 1024 + lane * 16);
                    N0 = __builtin_amdgcn_mfma_f32_32x32x16_bf16(m0, zf[kb2][ks], N0, 0, 0, 0);
                    N1 = __builtin_amdgcn_mfma_f32_32x32x16_bf16(m1, zf[kb2][ks], N1, 0, 0, 0);
                }
            Z0 = N0; Z1 = N1;
        }
        asm volatile("s_waitcnt lgkmcnt(0)\n\ts_barrier" ::: "memory");
    }
    asm volatile("s_waitcnt vmcnt(0) lgkmcnt(0)\n\ts_barrier" ::: "memory");
#undef CB_ISSUE
}

constexpr int N_FX_UNITS = 65 * 10, N_SB_UNITS = 65 * 10, N_RW_WG = 192;
#ifndef REP_SCAN
#define REP_SCAN 1
#endif
#ifndef REP_SCAN_DRY
#define REP_SCAN_DRY 0
#endif
#ifndef REP_FOX
#define REP_FOX 1
#endif
#ifndef REP_SB
#define REP_SB 1
#endif
__device__ __forceinline__ void phase_mix(const ArgsL& a, Frame& F, int layer) {
#ifdef SEQ_SCAN
    if (F.bx < N_RW_WG) { int nr = REP_SCAN; asm volatile("" : "+s"(nr)); for (int r = 0; r < nr; ++r) rwkv_scan(a, F, F.bx, (r + 1 < nr) ? REP_SCAN_DRY : 0); }
#else
    if (F.bx < 12) rwkv_chunkB(a, F, F.bx);
#endif
    float gqm = fabsf(a.in(I_QG)[layer * 64 + F.lane]), gkm = fabsf(a.in(I_KG)[layer * 64 + F.lane]);
#pragma unroll
    for (int off = 1; off < 64; off <<= 1) { gqm = fmaxf(gqm, __shfl_xor(gqm, off)); gkm = fmaxf(gkm, __shfl_xor(gkm, off)); }
    const float bound = 64.0f * C2 * gqm * gkm * 1.02f + 0.5f;
    unsigned* head = (unsigned*)(a.ws + WS_CTL) + CW_QUEUE + 64 * layer;
    for (;;) {
        if (F.tid == 0) F.MISC[16] = __hip_atomic_fetch_add(head, 1u, __ATOMIC_RELAXED, __HIP_MEMORY_SCOPE_AGENT);
        __syncthreads();
        const int u = (int)F.MISC[16];
        __syncthreads();
        if (u >= N_FX_UNITS + N_SB_UNITS) break;
        if (u < N_FX_UNITS) { const int qb = 64 - u / 10, bh = u % 10; int nr = REP_FOX; asm volatile("" : "+s"(nr)); for (int r = 0; r < nr; ++r) attn_unit<0>(a, F, bh / FX_H, bh % FX_H, qb, bound); }
        else { const int v = u - N_FX_UNITS; const int qb = 64 - v / 10, bh = v % 10; int nr = REP_SB; asm volatile("" : "+s"(nr)); for (int r = 0; r < nr; ++r) attn_unit<1>(a, F, bh / SB_H, bh % SB_H, qb, bound); }
    }
}

__device__ __forceinline__ void phase_post(const ArgsL& a, Frame& F, int layer, const bool dry = false) {
    const int gw = F.bx * NWAVES + F.wave, NGW = gridDim.x * NWAVES, lane = F.lane;
    bf16_t* Y0 = (bf16_t*)(a.ws + WS_YCAT); const bf16_t* BN = (const bf16_t*)(a.ws + WS_BN);
    float lg[6], lb[6];
    { const float* g = a.in(I_LNG) + layer * RW_W + lane; const float* bb = a.in(I_LNB) + layer * RW_W + lane;
#pragma unroll
      for (int hh = 0; hh < 6; ++hh) { lg[hh] = g[hh * 64]; lb[hh] = bb[hh * 64]; } }
    unsigned short yv[6], bv[6], yn[6], bn[6];
    int m = gw;
    if (m < M) {
#pragma unroll
        for (int hh = 0; hh < 6; ++hh) { yv[hh] = Y0[(size_t)m * RW_W + hh * 64 + lane]; bv[hh] = BN[(size_t)m * RW_W + hh * 64 + lane]; }
    }
    for (; m < M; m += NGW) {
        const int mn = m + NGW;
        if (mn < M) {
#pragma unroll
            for (int hh = 0; hh < 6; ++hh) { yn[hh] = Y0[(size_t)mn * RW_W + hh * 64 + lane]; bn[hh] = BN[(size_t)mn * RW_W + hh * 64 + lane]; }
        }
        const int b = m / T, p = m - b * T;
        bf16_t* yp = Y0 + (size_t)m * RW_W + lane;
        if (p < PADR) {
            if (!dry) {
#pragma unroll
            for (int hh = 0; hh < 6; ++hh) yp[hh * 64] = 0; }
        } else {
#pragma unroll
            for (int hh = 0; hh < 6; ++hh) {
                const float y = bf2f(yv[hh]);
                const float mean = wave_sum(y) * (1.f / 64.f);
                const float d = y - mean;
                const float var = wave_sum(d * d) * (1.f / 64.f);
                const unsigned short r_ = f2bf(d * (1.0f / sqrtf(var + 64e-5f)) * lg[hh] + lb[hh] + bf2f(bv[hh])); if (!dry) yp[hh * 64] = r_; else asm volatile("" :: "v"(r_));
            }
        }
#pragma unroll
        for (int hh = 0; hh < 6; ++hh) { yv[hh] = yn[hh]; bv[hh] = bn[hh]; }
    }
    if (!dry) for (int it = gw; it < 2 * M; it += NGW) {
        const int sl = it / M, m2 = it - sl * M; const int b = m2 / T, p = m2 - b * T;
        bf16_t* row = Y0 + (size_t)(sl + 1) * M * RW_W + (size_t)m2 * RW_W;
        if (p < PADR) { for (int c = lane; c < RW_W / 2; c += 64) ((unsigned*)row)[c] = 0u; }
        else if (lane < 32) ((unsigned*)(row + 320))[lane] = 0u;
    }
}

struct EpiInproj { static constexpr bool PERM = true, AFTER_DRAIN = false; bf16_t* ush; bf16_t* qkv;
    __device__ __forceinline__ void operator()(const f32x4 (&acc)[2][2][4][2], const pg8::Unit& u, int wr, int wc, int fr, int fq) const {
        asm volatile("" : "+v"(fr), "+v"(fq));
        const int row0 = u.pm * 256 + wr * 64 + fr, colt = u.pn * 256 + wc * 32 + 8 * fq;
#pragma unroll
        for (int ai = 0; ai < 2; ++ai)
#pragma unroll
            for (int m = 0; m < 4; ++m) { const size_t row = (size_t)(row0 + ai * 128 + m * 16);
#pragma unroll
                for (int bj = 0; bj < 2; ++bj) { const int col = colt + bj * 128; const f32x4 v0 = acc[ai][bj][m][0], v1 = acc[ai][bj][m][1];
                    const float sc = (col >= SHIFT_W && col < SHIFT_W + 320) ? C2 : 1.0f;
                    u32x4 w; w.x = pk2(v0[0] * sc, v0[1] * sc); w.y = pk2(v0[2] * sc, v0[3] * sc); w.z = pk2(v1[0] * sc, v1[1] * sc); w.w = pk2(v1[2] * sc, v1[3] * sc);
                    if (col < SHIFT_W) *(u32x4*)(ush + row * SHIFT_W + col) = w;
                    else if (col < SHIFT_W + QKV_W) *(u32x4*)(qkv + row * QKV_W + (col - SHIFT_W)) = w; } }
    }
};
struct EpiGates { static constexpr bool PERM = true, AFTER_DRAIN = false; bf16_t* gates;
    __device__ __forceinline__ void operator()(const f32x4 (&acc)[2][2][4][2], const pg8::Unit& u, int wr, int wc, int fr, int fq) const {
        asm volatile("" : "+v"(fr), "+v"(fq));
        const int row0 = u.pm * 256 + wr * 64 + fr, colt = u.pn * 256 + wc * 32 + 8 * fq;
#pragma unroll
        for (int ai = 0; ai < 2; ++ai)
#pragma unroll
            for (int m = 0; m < 4; ++m) { const size_t row = (size_t)(row0 + ai * 128 + m * 16);
#pragma unroll
                for (int bj = 0; bj < 2; ++bj) { const int col = colt + bj * 128; f32x4 v0 = acc[ai][bj][m][0], v1 = acc[ai][bj][m][1];
#pragma unroll
                    for (int q = 0; q < 4; ++q) { v0[q] = __builtin_amdgcn_rcpf(1.f + __builtin_amdgcn_exp2f(-v0[q] * LOG2E)); v1[q] = __builtin_amdgcn_rcpf(1.f + __builtin_amdgcn_exp2f(-v1[q] * LOG2E)); }
                    u32x4 w; w.x = pk2(v0[0], v0[1]); w.y = pk2(v0[2], v0[3]); w.z = pk2(v1[0], v1[1]); w.w = pk2(v1[2], v1[3]);
                    *(u32x4*)(gates + row * 3072 + col) = w; } }
    }
};
struct EpiMerge { static constexpr bool PERM = true, AFTER_DRAIN = false; const bf16_t* gates; bf16_t* merged;
    __device__ __forceinline__ void operator()(const f32x4 (&acc)[2][2][4][2], const pg8::Unit& u, int wr, int wc, int fr, int fq) const {
        asm volatile("" : "+v"(fr), "+v"(fq));
        const int br = u.pn >> 2, pn = u.pn & 3, pm = u.pm - br * 129;
        const int row0 = pm * 256 + wr * 64 + fr, colt = pn * 256 + wc * 32 + 8 * fq;
#pragma unroll
        for (int ai = 0; ai < 2; ++ai)
#pragma unroll
            for (int m = 0; m < 4; ++m) { const size_t row = (size_t)(row0 + ai * 128 + m * 16);
#pragma unroll
                for (int bj = 0; bj < 2; ++bj) { const int col = colt + bj * 128; const f32x4 v0 = acc[ai][bj][m][0], v1 = acc[ai][bj][m][1];
                    const u32x4 g = *(const u32x4*)(gates + row * 3072 + br * 1024 + col);
                    u32x4* mp = (u32x4*)(merged + row * D + col);
                    u32x4 o = (u32x4){0u, 0u, 0u, 0u};
                    if (br > 0) o = *mp;
                    u32x4 w;
                    w.x = pk2(bf_lo(g.x) * v0[0] + bf_lo(o.x), bf_hi(g.x) * v0[1] + bf_hi(o.x));
                    w.y = pk2(bf_lo(g.y) * v0[2] + bf_lo(o.y), bf_hi(g.y) * v0[3] + bf_hi(o.y));
                    w.z = pk2(bf_lo(g.z) * v1[0] + bf_lo(o.z), bf_hi(g.z) * v1[1] + bf_hi(o.z));
                    w.w = pk2(bf_lo(g.w) * v1[2] + bf_lo(o.w), bf_hi(g.w) * v1[3] + bf_hi(o.w));
                    *mp = w; }
                __builtin_amdgcn_sched_barrier(0); }
    }
};
struct MergeOrder { int G, c, ntau;
    __device__ __forceinline__ bool next(int i, pg8::Unit& u) const { const int it = i / 3, br = i - 3 * it; const long tau = (long)it * G + c; if (tau >= ntau) return false;
        const int t = (int)(tau % 516); u.pm = br * 129 + (t >> 2); u.pn = br * 4 + (t & 3); return true; }
    __device__ __forceinline__ void a_ready(const pg8::Unit&) const {}
    __device__ __forceinline__ void done(const pg8::Unit&) const {}
};
struct EpiOut { static constexpr bool PERM = true, AFTER_DRAIN = false; ArgsL a;
    __device__ __forceinline__ void operator()(const f32x4 (&acc)[2][2][4][2], const pg8::Unit& u, int wr, int wc, int fr, int fq) const {
        asm volatile("" : "+v"(fr), "+v"(fq));
        const int row0 = u.pm * 256 + wr * 64 + fr, colt = u.pn * 256 + wc * 32 + 8 * fq;
#pragma unroll
        for (int ai = 0; ai < 2; ++ai)
#pragma unroll
            for (int m = 0; m < 4; ++m) { const int row = row0 + ai * 128 + m * 16; const int b = row / T, p = row - b * T, l = p - PADR;
                if (l < 0) continue;
                float* hp = hrow(a, b, l);
#pragma unroll
                for (int bj = 0; bj < 2; ++bj) { const int col = colt + bj * 128; f32x4* h4 = (f32x4*)(hp + col);
                    h4[0] = h4[0] + acc[ai][bj][m][0]; h4[1] = h4[1] + acc[ai][bj][m][1]; } }
    }
};
struct MoeOrder { const volatile LAS int* tb; int ntile, npt, G, c, rep;
    __device__ __forceinline__ bool next(int i, pg8::Unit& u) const { long L = (long)i * G + c; if (L >= (long)ntile * npt * rep) return false; L %= (long)ntile * npt;
        const int tau = (int)(L / npt), j = (int)(L - (long)tau * npt); int e = 0;
#pragma unroll
        for (int k = 1; k < 16; ++k) e += (tau >= tb[k]) ? 1 : 0;
        u.pm = tau; u.pn = __builtin_amdgcn_readfirstlane(e) * npt + j; return true; }
    __device__ __forceinline__ void a_ready(const pg8::Unit&) const {}
    __device__ __forceinline__ void done(const pg8::Unit&) const {}
};
struct EpiMoeUp { static constexpr bool PERM = true, AFTER_DRAIN = false; bf16_t* hs;
    __device__ __forceinline__ void operator()(const f32x4 (&acc)[2][2][4][2], const pg8::Unit& u, int wr, int wc, int fr, int fq) const {
        asm volatile("" : "+v"(fr), "+v"(fq));
        const int row0 = u.pm * 256 + wr * 64 + fr, col = (u.pn & 1) * 128 + wc * 32 + 8 * fq;
#pragma unroll
        for (int ai = 0; ai < 2; ++ai)
#pragma unroll
            for (int m = 0; m < 4; ++m) { const size_t row = (size_t)(row0 + ai * 128 + m * 16); float r[8];
#pragma unroll
                for (int n = 0; n < 2; ++n)
#pragma unroll
                    for (int q = 0; q < 4; ++q) { const float gte = acc[ai][0][m][n][q], up = acc[ai][1][m][n][q]; r[4 * n + q] = gte * __builtin_amdgcn_rcpf(1.f + __builtin_amdgcn_exp2f(-gte * LOG2E)) * up; }
                u32x4 w; w.x = pk2(r[0], r[1]); w.y = pk2(r[2], r[3]); w.z = pk2(r[4], r[5]); w.w = pk2(r[6], r[7]);
                *(u32x4*)(hs + row * DEXP + col) = w; }
    }
};
struct EpiMoeDown { static constexpr bool PERM = true, AFTER_DRAIN = false; bf16_t* y; const float* cws;
    __device__ __forceinline__ void operator()(const f32x4 (&acc)[2][2][4][2], const pg8::Unit& u, int wr, int wc, int fr, int fq) const {
        asm volatile("" : "+v"(fr), "+v"(fq));
        const int row0 = u.pm * 256 + wr * 64 + fr, colt = (u.pn & 3) * 256 + wc * 32 + 8 * fq;
#pragma unroll
        for (int ai = 0; ai < 2; ++ai)
#pragma unroll
            for (int m = 0; m < 4; ++m) { const size_t row = (size_t)(row0 + ai * 128 + m * 16); const float cw = cws[row];
#pragma unroll
                for (int bj = 0; bj < 2; ++bj) { const int col = colt + bj * 128; const f32x4 v0 = acc[ai][bj][m][0] * cw, v1 = acc[ai][bj][m][1] * cw;
                    u32x4 w; w.x = pk2(v0[0], v0[1]); w.y = pk2(v0[2], v0[3]); w.z = pk2(v1[0], v1[1]); w.w = pk2(v1[2], v1[3]);
                    *(u32x4*)(y + row * D + col) = w; }
                __builtin_amdgcn_sched_barrier(0); }
    }
};

#ifndef PH_MASK
#define PH_MASK 0xFFFF
#endif
#define PH(k) ((PH_MASK >> (k)) & 1)
#ifndef PROBE_DUP
#define PROBE_DUP 0
#endif
#define DUPN(bit) (((PROBE_DUP >> (bit)) & 1) ? 2 : 1)
#ifndef PROBE_THIN
#define PROBE_THIN 0
#endif
#define THIN(bit) ((PROBE_THIN >> (bit)) & 1)
#define FRESH() do { asm volatile("" : "+v"(F.tid)); F.lane = F.tid & 63; F.wave = __builtin_amdgcn_readfirstlane(F.tid >> 6); { int bx_ = (int)blockIdx.x; asm volatile("" : "+s"(bx_)); F.bx = bx_; } { unsigned char* w_ = a.ws; asm volatile("" : "+s"(w_)); a.ws = w_; } } while (0)
__global__ void __launch_bounds__(NTHR, 2) hybrid_fwd(Args ka) {
    extern __shared__ __attribute__((aligned(16))) unsigned char lds_raw[];
    Frame F;
    F.lds = (LAS unsigned char*)lds_raw;
    F.MISC = (volatile LAS unsigned*)(F.lds + MISC_OFF);
    F.tid = threadIdx.x; F.lane = F.tid & 63; F.wave = __builtin_amdgcn_readfirstlane(F.tid >> 6); F.bx = (int)blockIdx.x;
    for (int u = F.tid; u < (LDS_BYTES - MISC_OFF) / 4; u += NTHR) ((LAS unsigned*)(F.lds + MISC_OFF))[u] = 0u;
    __syncthreads();
    if (F.tid < 29) { const unsigned long long p = (unsigned long long)ka.in[F.tid]; F.MISC[64 + 2 * F.tid] = (unsigned)p; F.MISC[65 + 2 * F.tid] = (unsigned)(p >> 32); }
    __syncthreads();
    ArgsL a; a.tab = F.MISC + 64; a.out = ka.out; a.ws = ka.ws;
    XcdBarrier bar = xcd_barrier_post((unsigned*)(a.ws + WS_CTL) + CW_BAR, F.MISC + 8);
    const int G = (int)gridDim.x, c = (int)blockIdx.x;
    PG8_LAS unsigned char* ring = (PG8_LAS unsigned char*)F.lds;

#ifdef PROF_K
    volatile LAS unsigned* tsl = F.MISC + 2048; int nts = 0;
    if (blockIdx.x == 0 && F.tid == 0) tsl[nts] = (unsigned)__builtin_amdgcn_s_memrealtime();
    ++nts;
#define BARX() do { xcd_barrier(bar); if (blockIdx.x == 0 && F.tid == 0) tsl[nts] = (unsigned)__builtin_amdgcn_s_memrealtime(); ++nts; } while (0)
#else
#define BARX() xcd_barrier(bar)
#endif
    for (int layer = 0; layer < DEPTH; ++layer) {
        for (int rep = 0; rep < DUPN(8); ++rep) { FRESH(); if (PH(0)) phase_wconv(a, F, layer); }
        __syncthreads();
        if (THIN(0)) { FRESH(); phase_norm<1>(a, F, layer, true); }
        FRESH(); if (PH(1)) phase_norm<1>(a, F, layer);
        BARX();
        FRESH(); if (PH(2)) {
            pg8::Gemm g{(const bf16_t*)(a.ws + WS_A), (const bf16_t*)(a.ws + WS_WIN), M, N1, D}; pg8::StaticOrder S; S.init(M, N1, G, c, DUPN(3));
            EpiInproj E{(bf16_t*)(a.ws + WS_USH), (bf16_t*)(a.ws + WS_QKV)};
            pg8::gemm_phase<EpiInproj, pg8::StaticOrder, true, true>(ring, g, S, E);
        }
        BARX();
        if (THIN(1)) { FRESH(); phase_prep(a, F, layer, true); }
        FRESH(); if (PH(3)) phase_prep(a, F, layer);
        BARX();
#ifndef SEQ_SCAN
        if (THIN(2)) { FRESH(); phase_chunkA(a, F, true); }
        FRESH(); if (PH(4)) phase_chunkA(a, F);
        BARX();
#endif
        FRESH(); if (PH(4)) phase_mix(a, F, layer);
        BARX();
        if (THIN(3)) { FRESH(); phase_post(a, F, layer, true); }
        FRESH(); if (PH(5)) phase_post(a, F, layer);
        FRESH(); if (PH(6)) {
            pg8::Gemm g{(const bf16_t*)(a.ws + WS_A), (const bf16_t*)(a.ws + WS_WG), M, 3072, D}; pg8::StaticOrder S; S.init(M, 3072, G, c, DUPN(4));
            EpiGates E{(bf16_t*)(a.ws + WS_GATES)};
            pg8::gemm_phase<EpiGates, pg8::StaticOrder, true, true>(ring, g, S, E);
        }
        BARX();
        FRESH(); if (PH(7)) {
            int kdim = RW_W; asm volatile("" : "+s"(kdim));
            pg8::Gemm g{(const bf16_t*)(a.ws + WS_YCAT), (const bf16_t*)(a.ws + WS_WP), 3 * M, 3072, kdim}; MergeOrder S{G, c, 516 * DUPN(5)};
            EpiMerge E{(const bf16_t*)(a.ws + WS_GATES), (bf16_t*)(a.ws + WS_MERGED)};
            pg8::gemm_phase<EpiMerge, MergeOrder, false, true>(ring, g, S, E);
        }
        BARX();
        FRESH(); if (PH(8)) {
            pg8::Gemm g{(const bf16_t*)(a.ws + WS_MERGED), (const bf16_t*)(a.ws + WS_WO), M, D, D}; pg8::StaticOrder S; S.init(M, D, G, c, 1);
            EpiOut E{a};
            pg8::gemm_phase<EpiOut, pg8::StaticOrder, true, true>(ring, g, S, E);
        }
        BARX();
        if (THIN(4)) { FRESH(); phase_norm<2>(a, F, layer, true); }
        FRESH(); if (PH(9)) phase_norm<2>(a, F, layer);
        BARX();
        for (int rep = 0; rep < DUPN(7); ++rep) { FRESH(); if (PH(10)) phase_route(a, F, layer); }
        BARX();
        volatile LAS int* tb = (volatile LAS int*)(F.MISC + 32);
        if (F.tid <= 16) { const int* cnt = (const int*)(a.ws + WS_CTL) + CW_ECNT + 64 * layer; int t = 0;
            for (int e = 0; e < F.tid; ++e) t += (__hip_atomic_load(cnt + e, __ATOMIC_RELAXED, __HIP_MEMORY_SCOPE_AGENT) + 255) >> 8;
            tb[F.tid] = t; }
        __syncthreads();
        const int ntile = tb[16];
        FRESH(); if (PH(11)) {
            pg8::Gemm g{(const bf16_t*)(a.ws + WS_AS), (const bf16_t*)(a.ws + WS_WGU), MS, 8192, D}; MoeOrder S{tb, ntile, 2, G, c, DUPN(6)};
            EpiMoeUp E{(bf16_t*)(a.ws + WS_HS)};
            pg8::gemm_phase<EpiMoeUp, MoeOrder, true, true>(ring, g, S, E);
        }
        BARX();
        FRESH(); if (PH(12)) {
            int kdim = DEXP; asm volatile("" : "+s"(kdim));
            pg8::Gemm g{(const bf16_t*)(a.ws + WS_HS), (const bf16_t*)(a.ws + WS_WD), MS, 16384, kdim}; MoeOrder S{tb, ntile, 4, G, c, DUPN(6)};
            EpiMoeDown E{(bf16_t*)(a.ws + WS_Y), (const float*)(a.ws + WS_CWS)};
            pg8::gemm_phase<EpiMoeDown, MoeOrder, true, true>(ring, g, S, E);
        }
        BARX();
    }
    if (THIN(5)) { FRESH(); phase_norm<0>(a, F, DEPTH - 1, true); }
    FRESH(); if (PH(13)) phase_norm<0>(a, F, DEPTH - 1);
#ifdef PROF_K
    BARX();
    if (blockIdx.x == 0) {
        __syncthreads();
        float us;
        if (PROF_K < 0) us = 100.f;
        else if (PROF_K == 12) us = (float)(tsl[25] - tsl[24]) * 0.01f;
        else if (PROF_K == 13) us = (float)(tsl[25] - tsl[0]) * 0.01f;
        else us = ((float)(tsl[1 + PROF_K] - tsl[PROF_K]) + (float)(tsl[13 + PROF_K] - tsl[12 + PROF_K])) * 0.01f;
        us = 4.f * rintf(us * 0.25f);
        for (int i = F.tid; i < 16384; i += NTHR) a.out[i] = us;
    }
#endif
#ifdef CLOCK_PROBE
    if (blockIdx.x == 0 && F.wave == 0) {
        float c0 = 1.f, c1 = 2.f, c2 = 3.f, c3 = 4.f, c4 = 5.f, c5 = 6.f, c6 = 7.f, c7 = 8.f;
        for (int i = 0; i < CLOCK_PROBE; ++i) {
            asm volatile("v_fma_f32 %0, %0, %0, %0\n\tv_fma_f32 %1, %1, %1, %1\n\tv_fma_f32 %2, %2, %2, %2\n\tv_fma_f32 %3, %3, %3, %3\n\tv_fma_f32 %4, %4, %4, %4\n\tv_fma_f32 %5, %5, %5, %5\n\tv_fma_f32 %6, %6, %6, %6\n\tv_fma_f32 %7, %7, %7, %7"
                         : "+v"(c0), "+v"(c1), "+v"(c2), "+v"(c3), "+v"(c4), "+v"(c5), "+v"(c6), "+v"(c7));
        }
        asm volatile("" :: "v"(c0), "v"(c1), "v"(c2), "v"(c3), "v"(c4), "v"(c5), "v"(c6), "v"(c7));
    }
#endif
}

extern "C" void kernel_launch(void* const* d_in, const int* in_sizes, int n_in, void* d_out, int out_size, void* d_ws, size_t ws_size, hipStream_t stream) {
    static int ready = 0;
    if (ready == 0) {
        if (n_in != 29 || out_size != NB * SEQ * D || ws_size < WS_END) { fprintf(stderr, "kernel_launch: unexpected problem shape (n_in %d, out %d, ws %zu < %zu)\n", n_in, out_size, ws_size, (size_t)WS_END); ready = -1; return; }
        if (hipFuncSetAttribute((const void*)hybrid_fwd, hipFuncAttributeMaxDynamicSharedMemorySize, LDS_BYTES) != hipSuccess) { fprintf(stderr, "kernel_launch: hipFuncSetAttribute failed\n"); ready = -1; return; }
        int per_cu = 0;
        if (hipOccupancyMaxActiveBlocksPerMultiprocessor(&per_cu, (const void*)hybrid_fwd, NTHR, LDS_BYTES) != hipSuccess || per_cu < 1) fprintf(stderr, "kernel_launch: occupancy query says %d\n", per_cu);
        (void)hipGetLastError();
        ready = 1;
    }
    if (ready < 0) return;
    (void)in_sizes;
    if (hipMemsetAsync((char*)d_ws + WS_CTL, 0, CTL_ZERO_BYTES, stream) != hipSuccess) return;
    Args a{};
    for (int i = 0; i < 29; ++i) a.in[i] = (const float*)d_in[i];
    a.out = (float*)d_out; a.ws = (unsigned char*)d_ws;
    hipLaunchKernelGGL(hybrid_fwd, dim3(256), dim3(NTHR), LDS_BYTES, stream, a);
}
```

```cpp
#include <hip/hip_runtime.h>
#include <hip/hip_bf16.h>
#include <cstdio>
#include <cstdint>

#define GAS __attribute__((address_space(1)))
#define LAS __attribute__((address_space(3)))

namespace pg8 {
#define PG8_LAS __attribute__((address_space(3)))
typedef unsigned short bf16_t;
typedef short bf16x8 __attribute__((ext_vector_type(8)));
typedef float f32x4 __attribute__((ext_vector_type(4)));
typedef unsigned u32x4 __attribute__((ext_vector_type(4)));
constexpr int BM = 256, BK = 64, HALF = 128, HTB = HALF * BK * 2  , STAGE_BYTES = 8 * HTB, NXCD = 8, WGM = 8;

__host__ __device__ __forceinline__ int lds_byte(int r, int c) { const int st = (r >> 4) * 2 + (c >> 5), rr = r & 15, cc = c & 31, ob = rr * 64 + cc * 2; return st * 1024 + (ob ^ (((ob >> 9) & 1) << 5)); }
__host__ __device__ __forceinline__ void stage_rc(int b, int& R, int& C) { const int st = b / 1024, sb = b % 1024, swz = sb ^ (((sb >> 9) & 1) << 5); R = (st >> 1) * 16 + swz / 64; C = (st & 1) * 32 + (swz % 64) / 2; }
__host__ __device__ __forceinline__ int perm32(int rho) { const int n = rho >> 4, i = rho & 15; return 8 * (i >> 2) + 4 * n + (i & 3); }

struct Unit { int pm, pn; };
struct Gemm { const bf16_t* A; const bf16_t* Bt; int M, N, K; };

struct StaticOrder {
    int nM, nN, nwg, G, c, rep;
    __host__ __device__ void init(int M, int N, int G_, int c_, int rep_ = 1) { nM = M / BM; nN = N / BM; nwg = nM * nN; G = G_; c = c_; rep = rep_; }
    __host__ __device__ bool next(int i, Unit& u) const {
        const long L = (long)i * G + c; if (L >= (long)nwg * rep) return false;
        int wgid = (int)(L % nwg); { const int q = nwg / NXCD, r = nwg % NXCD, xcd = wgid % NXCD, off = wgid / NXCD; wgid = (xcd < r ? xcd * (q + 1) : r * (q + 1) + (xcd - r) * q) + off; }
        const int nig = WGM * nN, gid = wgid / nig, fm = gid * WGM, gsz = (nM - fm) < WGM ? (nM - fm) : WGM;
        u.pm = fm + ((wgid % nig) % gsz); u.pn = (wgid % nig) / gsz; return true;
    }
    __device__ __forceinline__ void a_ready(const Unit&) const {}
    __device__ __forceinline__ void done(const Unit&) const {}
};
__device__ __forceinline__ unsigned cvt_pk_bf16(float lo, float hi) { unsigned r; asm volatile("v_cvt_pk_bf16_f32 %0, %1, %2" : "=v"(r) : "v"(lo), "v"(hi)); return r; }
template <class Epi, class Sched, bool ALIGN_EPI = false, bool SP2 = false>
__device__ __forceinline__ void gemm_phase(PG8_LAS unsigned char* lds, const Gemm g, const Sched& S, const Epi& E) {
    int tid_ = threadIdx.x; asm volatile("" : "+v"(tid_));
    const int tid = tid_, wid = __builtin_amdgcn_readfirstlane(tid >> 6), lane = tid & 63, wr = wid >> 2, wc = wid & 3, fr = lane & 15, fq = lane >> 4;
    const int K = g.K, nt = K / BK;
    unsigned voffA[2], voffB[2];
#pragma unroll
    for (int i = 0; i < 2; ++i) { int R, C; stage_rc(tid * 16 + i * 8192, R, C); const int Rb = Epi::PERM ? ((R & ~31) + perm32(R & 31)) : R;
        voffA[i] = (unsigned)(R * K + C) * 2u; voffB[i] = (unsigned)(Rb * K + C) * 2u; }
    const size_t kstep = (size_t)(BK * 2);
    const size_t hstep = (size_t)HALF * K * 2;
    const size_t tstep = 2 * hstep;
    const unsigned ldsw = (unsigned)wid * 1024u;
    const int aoff = lds_byte(wr * 64 + fr, fq * 8), boff = lds_byte(wc * 32 + fr, fq * 8);
#define PG8_SA(b, h) (((b) * 2 + (h)) * HTB)
#define PG8_SB(b, h) ((4 + (b) * 2 + (h)) * HTB)
#define PG8_STAGE(bufoff, gbase, voff) do { _Pragma("unroll") for (int _i = 0; _i < 2; ++_i) \
        __builtin_amdgcn_global_load_lds((const unsigned*)((const char*)(gbase) + (voff)[_i]), (PG8_LAS unsigned*)(lds + (bufoff) + ldsw + _i * 8192), 16, 0, 0); } while (0)
#define PG8_LDA(dst, b, h) do { _Pragma("unroll") for (int m = 0; m < 4; ++m) _Pragma("unroll") for (int k = 0; k < 2; ++k) dst[m][k] = *(const PG8_LAS bf16x8*)(lds + PG8_SA(b, h) + aoff + m * 2048 + k * 1024); } while (0)
#define PG8_LDB(dst, b, h) do { _Pragma("unroll") for (int n = 0; n < 2; ++n) _Pragma("unroll") for (int k = 0; k < 2; ++k) dst[n][k] = *(const PG8_LAS bf16x8*)(lds + PG8_SB(b, h) + boff + n * 2048 + k * 1024); } while (0)
#define PG8_MMA(ai, bj, At, Bt) do { __builtin_amdgcn_s_setprio(1); _Pragma("unroll") for (int m = 0; m < 4; ++m) _Pragma("unroll") for (int n = 0; n < 2; ++n) _Pragma("unroll") for (int k = 0; k < 2; ++k) \
        acc[ai][bj][m][n] = __builtin_amdgcn_mfma_f32_16x16x32_bf16(Bt[n][k], At[m][k], acc[ai][bj][m][n], 0, 0, 0); __builtin_amdgcn_s_setprio(0); } while (0)
#define PG8_WAIT_V(n) asm volatile("s_waitcnt vmcnt(" #n ")" ::: "memory")
#define PG8_WAIT_L(n) asm volatile("s_waitcnt lgkmcnt(" #n ")" ::: "memory")
#define PG8_BAR __builtin_amdgcn_s_barrier()
#define PG8_SCHED __builtin_amdgcn_sched_barrier(0)
    Unit cur, nxt; int ui = 0;
    if (!S.next(0, cur)) return;
    f32x4 acc[2][2][4][2];
#pragma unroll
    for (int a = 0; a < 2; ++a)
#pragma unroll
        for (int b = 0; b < 2; ++b)
#pragma unroll
            for (int m = 0; m < 4; ++m)
#pragma unroll
                for (int n = 0; n < 2; ++n) acc[a][b][m][n] = (f32x4){0.f, 0.f, 0.f, 0.f};
    bf16x8 At[4][2], B0[2][2], B1[2][2];
    const char* cA = (const char*)g.A + (size_t)cur.pm * tstep; const char* cB = (const char*)g.Bt + (size_t)cur.pn * tstep;
    S.a_ready(cur);
    if constexpr (SP2) {
        PG8_STAGE(PG8_SB(0, 0), cB, voffB); PG8_STAGE(PG8_SB(0, 1), cB + hstep, voffB); PG8_STAGE(PG8_SA(0, 0), cA, voffA); PG8_STAGE(PG8_SA(0, 1), cA + hstep, voffA);
        if (wr == 1) PG8_BAR;
        PG8_WAIT_V(2); PG8_BAR;
        PG8_STAGE(PG8_SB(1, 0), cB + kstep, voffB); PG8_STAGE(PG8_SA(1, 0), cA + kstep, voffA); PG8_STAGE(PG8_SB(1, 1), cB + hstep + kstep, voffB);
        PG8_WAIT_V(6); PG8_BAR;
    } else {
        PG8_STAGE(PG8_SB(0, 0), cB, voffB); PG8_STAGE(PG8_SA(0, 0), cA, voffA); PG8_STAGE(PG8_SB(0, 1), cB + hstep, voffB); PG8_STAGE(PG8_SA(0, 1), cA + hstep, voffA);
        if (wr == 1) PG8_BAR;
        PG8_WAIT_V(4); PG8_BAR;
        PG8_STAGE(PG8_SB(1, 0), cB + kstep, voffB); PG8_STAGE(PG8_SA(1, 0), cA + kstep, voffA); PG8_STAGE(PG8_SB(1, 1), cB + hstep + kstep, voffB);
        PG8_WAIT_V(6); PG8_BAR;
    }
    for (;;) {
        const bool has_next = S.next(ui + 1, nxt);
        const char* nA = has_next ? (const char*)g.A + (size_t)nxt.pm * tstep : cA; const char* nB = has_next ? (const char*)g.Bt + (size_t)nxt.pn * tstep : cB;
        for (int t = 0; t < nt; t += 2) {
            const bool last = (t == nt - 2);
            const char* a1 = cA + (size_t)(t + 1) * kstep;
            const char* a2 = last ? nA : cA + (size_t)(t + 2) * kstep; const char* b2 = last ? nB : cB + (size_t)(t + 2) * kstep;
            const char* a3 = a2 + kstep; const char* b3 = b2 + kstep;
            if (last && has_next) S.a_ready(nxt);
            if constexpr (SP2) {
            PG8_LDB(B0, 0, 0); PG8_LDB(B1, 0, 1); PG8_SCHED; PG8_LDA(At, 0, 0); PG8_STAGE(PG8_SA(1, 1), a1 + hstep, voffA);
            PG8_WAIT_V(8); PG8_WAIT_L(0); PG8_BAR; PG8_MMA(0, 0, At, B0); PG8_MMA(0, 1, At, B1); PG8_BAR; PG8_SCHED;
            PG8_LDA(At, 0, 1); PG8_STAGE(PG8_SB(0, 0), b2, voffB); PG8_STAGE(PG8_SB(0, 1), b2 + hstep, voffB); PG8_STAGE(PG8_SA(0, 0), a2, voffA);
            PG8_WAIT_V(8); PG8_WAIT_L(0); PG8_BAR; PG8_MMA(1, 0, At, B0); PG8_MMA(1, 1, At, B1); PG8_BAR; PG8_SCHED;
            PG8_LDB(B0, 1, 0); PG8_LDB(B1, 1, 1); PG8_SCHED; PG8_LDA(At, 1, 0); PG8_STAGE(PG8_SA(0, 1), a2 + hstep, voffA);
            PG8_WAIT_V(8); PG8_WAIT_L(0); PG8_BAR; PG8_MMA(0, 0, At, B0); PG8_MMA(0, 1, At, B1); PG8_BAR; PG8_SCHED;
            PG8_LDA(At, 1, 1); PG8_STAGE(PG8_SB(1, 0), b3, voffB); PG8_STAGE(PG8_SB(1, 1), b3 + hstep, voffB); PG8_STAGE(PG8_SA(1, 0), a3, voffA);
            PG8_WAIT_V(8); PG8_WAIT_L(0); PG8_BAR; PG8_MMA(1, 0, At, B0); PG8_MMA(1, 1, At, B1); PG8_BAR; PG8_SCHED;
            } else {
            PG8_LDB(B0, 0, 0); PG8_SCHED; PG8_LDA(At, 0, 0); PG8_STAGE(PG8_SA(1, 1), a1 + hstep, voffA);
            PG8_WAIT_L(8); PG8_BAR; PG8_WAIT_L(0); PG8_MMA(0, 0, At, B0); PG8_BAR; PG8_SCHED;
            PG8_LDB(B1, 0, 1); PG8_STAGE(PG8_SB(0, 0), b2, voffB);
            PG8_BAR; PG8_WAIT_L(0); PG8_MMA(0, 1, At, B1); PG8_BAR;
            PG8_LDA(At, 0, 1); PG8_STAGE(PG8_SA(0, 0), a2, voffA);
            PG8_BAR; PG8_WAIT_L(0); PG8_MMA(1, 0, At, B0); PG8_BAR; PG8_SCHED;
            PG8_STAGE(PG8_SB(0, 1), b2 + hstep, voffB);
            PG8_WAIT_V(6); PG8_BAR; PG8_MMA(1, 1, At, B1); PG8_BAR;
            PG8_LDB(B0, 1, 0); PG8_SCHED; PG8_LDA(At, 1, 0); PG8_STAGE(PG8_SA(0, 1), a2 + hstep, voffA);
            PG8_WAIT_L(8); PG8_BAR; PG8_WAIT_L(0); PG8_MMA(0, 0, At, B0); PG8_BAR; PG8_SCHED;
            PG8_LDB(B1, 1, 1); PG8_STAGE(PG8_SB(1, 0), b3, voffB);
            PG8_BAR; PG8_WAIT_L(0); PG8_MMA(0, 1, At, B1); PG8_BAR;
            PG8_LDA(At, 1, 1); PG8_STAGE(PG8_SA(1, 0), a3, voffA);
            PG8_BAR; PG8_WAIT_L(0); PG8_MMA(1, 0, At, B0); PG8_BAR; PG8_SCHED;
            PG8_STAGE(PG8_SB(1, 1), b3 + hstep, voffB);
            PG8_WAIT_V(6); PG8_BAR; PG8_MMA(1, 1, At, B1); PG8_BAR;
            }
        }
        if constexpr (ALIGN_EPI) { if (wr == 0) PG8_BAR; }
        if constexpr (!Epi::AFTER_DRAIN) { E(acc, cur, wr, wc, fr, fq); S.done(cur); }
        if (!has_next) break;
#pragma unroll
        for (int a = 0; a < 2; ++a)
#pragma unroll
            for (int b = 0; b < 2; ++b)
#pragma unroll
                for (int m = 0; m < 4; ++m)
#pragma unroll
                    for (int n = 0; n < 2; ++n) acc[a][b][m][n] = (f32x4){0.f, 0.f, 0.f, 0.f};
        cur = nxt; cA = nA; cB = nB; ++ui;
        if constexpr (ALIGN_EPI) { if (wr == 1) PG8_BAR; }
    }
    PG8_WAIT_V(0);
    if constexpr (!ALIGN_EPI) { if (wr == 0) PG8_BAR; }
    PG8_BAR;
    if constexpr (Epi::AFTER_DRAIN) { E.fused(acc, cur, wr, wc, fr, fq, lds, wid, lane); S.done(cur); }
#undef PG8_SA
#undef PG8_SB
#undef PG8_STAGE
#undef PG8_LDA
#undef PG8_LDB
#undef PG8_MMA
#undef PG8_WAIT_V
#undef PG8_WAIT_L
#undef PG8_BAR
#undef PG8_SCHED
}
}

constexpr int D = 1024, NB = 2, SEQ = 16384, NMETA = 16, LTOK = SEQ + NMETA  , PADR = 112, T = PADR + LTOK  ;
constexpr int M = NB * T;
constexpr int DEPTH = 2, HD = 64, RW_H = 6, SB_H = 5, FX_H = 5, RW_W = 384, SHIFT_W = 1280, D_IN = 6277;
constexpr int QKV_W = 1920;
constexpr int N1 = 3328;
constexpr int FCOL = 3200, GCOL = 3205;
constexpr int NEXP = 16, DEXP = 256;
constexpr int MS = 70144;
constexpr int LCH = 32, LPADDED = 16448;
constexpr int KBP = 16896;
constexpr float C2 = 0.125f * 1.4426950408889634f;
constexpr float LOG2E = 1.4426950408889634f;
constexpr int NWAVES = 8, NTHR = 512;

constexpr size_t MiB = 1u << 20;
constexpr size_t WS_CTL = 0, CTL_ZERO_BYTES = 65536;
constexpr size_t WS_HM = 1 * MiB;
constexpr size_t WS_LOGF = WS_HM + 131072;
constexpr size_t WS_KB2 = WS_LOGF + (size_t)M * 32;
constexpr size_t WS_TOK = WS_KB2 + (size_t)10 * KBP * 4;
constexpr size_t WS_SLOT = WS_TOK + (size_t)M * 32;
constexpr size_t WS_CWS = WS_SLOT + (size_t)M * 8;
constexpr size_t WS_WGCNT = WS_CWS + (size_t)MS * 4;
constexpr size_t WS_SMALL_END = WS_WGCNT + 256 * 16 * 4;
static_assert(WS_SMALL_END <= 8 * MiB, "small buffers");
constexpr size_t WS_WIN = 8 * MiB;
constexpr size_t WS_WG = WS_WIN + (size_t)N1 * 1024 * 2;
constexpr size_t WS_WP = WS_WG + (size_t)3072 * 1024 * 2;
constexpr size_t WS_WO = WS_WP + (size_t)3072 * 384 * 2;
constexpr size_t WS_WGU = WS_WO + (size_t)1024 * 1024 * 2;
constexpr size_t WS_WD = WS_WGU + (size_t)8192 * 1024 * 2;
constexpr size_t WS_W_END = WS_WD + (size_t)16384 * 256 * 2;
static_assert(WS_W_END <= 49 * MiB, "weights");
constexpr size_t WS_A = 49 * MiB;
constexpr size_t WS_BIG = 115 * MiB;
constexpr size_t WS_USH = WS_BIG;
constexpr size_t WS_YCAT = WS_BIG;
constexpr size_t WS_QKV = WS_BIG + 82 * MiB;
constexpr size_t WS_RW = WS_BIG + 204 * MiB;
constexpr size_t WS_BN = WS_BIG + 349 * MiB;
constexpr size_t WS_GATES = WS_BIG + 82 * MiB;
constexpr size_t WS_MERGED = WS_BIG + 276 * MiB;
constexpr size_t WS_AS = WS_BIG;
constexpr size_t WS_HS = WS_BIG + 137 * MiB;
constexpr size_t WS_Y = WS_BIG + 172 * MiB;
constexpr size_t WS_END = WS_BIG + 374 * MiB;
static_assert((size_t)(M + 256) * 1280 * 2 <= 82 * MiB && (size_t)3 * M * 384 * 2 <= 82 * MiB && (size_t)(M + 256) * 1920 * 2 <= 122 * MiB, "big map 1");
static_assert((size_t)12 * LPADDED * 768 <= 145 * MiB && (size_t)M * 384 * 2 <= 25 * MiB && (size_t)M * 3072 * 2 <= 194 * MiB && (size_t)M * 2048 <= 65 * MiB, "big map 2");
static_assert((size_t)MS * 2048 <= 137 * MiB && (size_t)MS * 512 <= 35 * MiB && WS_END <= 489 * MiB, "big map 3");

constexpr int CW_BAR = 0;
constexpr int CW_QUEUE = 4096;
constexpr int CW_ECNT = 4352;
static_assert((CW_ECNT + 128) * 4 <= (int)CTL_ZERO_BYTES, "ctl");

constexpr int RING_BYTES = 131072, MISC_OFF = RING_BYTES, LDS_BYTES = 147456;

typedef unsigned short bf16_t;
typedef float f32x4 __attribute__((ext_vector_type(4)));
typedef float f32x2 __attribute__((ext_vector_type(2)));
typedef float f32x16 __attribute__((ext_vector_type(16)));
typedef unsigned u32x4 __attribute__((ext_vector_type(4)));
typedef unsigned u32x2 __attribute__((ext_vector_type(2)));
typedef short bf16x8 __attribute__((ext_vector_type(8)));
typedef short s16x4 __attribute__((ext_vector_type(4)));
typedef _Float16 f16x4 __attribute__((ext_vector_type(4)));
typedef __bf16 bf16x2_t __attribute__((ext_vector_type(2)));

__device__ __forceinline__ unsigned pk2(float lo, float hi) { f32x2 v = {lo, hi}; bf16x2_t b = __builtin_convertvector(v, bf16x2_t); return __builtin_bit_cast(unsigned, b); }
__device__ __forceinline__ unsigned short f2bf(float f) { return (unsigned short)(pk2(f, 0.f) & 0xffffu); }
__device__ __forceinline__ float bf_lo(unsigned u) { return __uint_as_float(u << 16); }
__device__ __forceinline__ float bf_hi(unsigned u) { return __uint_as_float(u & 0xffff0000u); }
__device__ __forceinline__ float bf2f(unsigned short h) { return __uint_as_float((unsigned)h << 16); }
template <int CTRL> __device__ __forceinline__ float dpp_f(float x) { return __int_as_float(__builtin_amdgcn_update_dpp(0, __float_as_int(x), CTRL, 0xF, 0xF, false)); }
__device__ __forceinline__ float allred16(float p) { p += dpp_f<0x128>(p); p += dpp_f<0x124>(p); p += dpp_f<0x122>(p); p += dpp_f<0x121>(p); return p; }
__device__ __forceinline__ float wave_sum(float v) {
    v = allred16(v);
    { auto sw = __builtin_amdgcn_permlane16_swap(__float_as_uint(v), __float_as_uint(v), false, false); v = __uint_as_float(sw[0]) + __uint_as_float(sw[1]); }
    { auto sw = __builtin_amdgcn_permlane32_swap(__float_as_uint(v), __float_as_uint(v), false, false); v = __uint_as_float(sw[0]) + __uint_as_float(sw[1]); }
    return v;
}
__device__ __forceinline__ float fast_exp(float x) { return __builtin_amdgcn_exp2f(x * LOG2E); }
__device__ __forceinline__ float fast_log(float x) { return __builtin_amdgcn_logf(x) * 0.6931471805599453f; }
__device__ __forceinline__ float softplus_f(float z) { return fmaxf(z, 0.f) + fast_log(1.f + fast_exp(-fabsf(z))); }

#define XB_TMO      128
#define XB_XCNT(j)  (256  + 64 * (j))
#define XB_XSUB(j)  (1280 + 64 * (j))
#define XB_XGEN(j)  (2304 + 64 * (j))
#define XB_TOP      3328
#define XB_TOPGEN   3392
#define XCD_BAR_WORDS 3456
#define XB_SPIN_CAP (1u << 20)
__device__ __forceinline__ unsigned xb_ld(unsigned* p)              { return __hip_atomic_load(p, __ATOMIC_RELAXED, __HIP_MEMORY_SCOPE_AGENT); }
__device__ __forceinline__ unsigned xb_add(unsigned* p, unsigned v) { return __hip_atomic_fetch_add(p, v, __ATOMIC_RELAXED, __HIP_MEMORY_SCOPE_AGENT); }
__device__ __forceinline__ unsigned xb_xcc_id() { return (unsigned)__builtin_amdgcn_s_getreg((3 << 11) | 20) & 0xFu; }
#define XB_SPIN(cond, bar) do { unsigned _sp = 0; while (cond) { __builtin_amdgcn_s_sleep(1); \
    if ((++_sp & 255u) == 0u) { if (xb_ld(&(bar)[XB_TMO])) break; if (_sp > XB_SPIN_CAP) { atomicAdd(&(bar)[XB_TMO], 1u); break; } } } } while (0)

struct XcdBarrier {
    unsigned* bar; unsigned x;
    volatile LAS unsigned* st;
};

__device__ __forceinline__ XcdBarrier xcd_barrier_post(unsigned* bar, volatile LAS unsigned* st) {
    XcdBarrier b; b.bar = bar; b.x = xb_xcc_id(); b.st = st;
    if (threadIdx.x == 0) (void)xb_add(&bar[XB_XCNT(b.x)], 1u);
    return b;
}
__device__ __forceinline__ void xcd_barrier_complete(unsigned* bar, unsigned x, unsigned& nloc, unsigned& nx) {
    const unsigned G = gridDim.x * gridDim.y * gridDim.z;
    unsigned sum, cnt, mine, sp = 0u;
    for (;;) {
        sum = 0u; cnt = 0u; mine = 0u;
#pragma unroll
        for (unsigned j = 0; j < 16; ++j) { const unsigned c = xb_ld(&bar[XB_XCNT(j)]); sum += c; cnt += (c > 0u) ? 1u : 0u; mine = (j == x) ? c : mine; }
        if (sum == G) break;
        __builtin_amdgcn_s_sleep(1);
        if ((++sp & 255u) == 0u) { if (xb_ld(&bar[XB_TMO])) break; if (sp > XB_SPIN_CAP) { atomicAdd(&bar[XB_TMO], 1u); break; } }
    }
    nloc = mine > 0u ? mine : 1u; nx = cnt > 0u ? cnt : 1u;
}

__device__ __forceinline__ void xcd_barrier(const XcdBarrier& b) {
    asm volatile("s_waitcnt vmcnt(0)" ::: "memory");
    __syncthreads();
    if (threadIdx.x == 0) {
        unsigned* bar = b.bar;
        __builtin_amdgcn_s_waitcnt(0);
        unsigned nloc = b.st[0], nx = b.st[1];
        if (nloc == 0u) { xcd_barrier_complete(bar, b.x, nloc, nx); b.st[0] = nloc; b.st[1] = nx; }
        const unsigned old = xb_add(&bar[XB_XSUB(b.x)], 1u);
        const unsigned gen = old / nloc;
        if (old + 1u == (gen + 1u) * nloc) {
            __builtin_amdgcn_fence(__ATOMIC_RELEASE, "agent");
            asm volatile("s_waitcnt vmcnt(0)" ::: "memory");
            const unsigned og = xb_add(&bar[XB_TOP], 1u);
            const unsigned tg = og / nx;
            if (og + 1u == (tg + 1u) * nx) xb_add(&bar[XB_TOPGEN], 1u);
            else XB_SPIN(xb_ld(&bar[XB_TOPGEN]) == tg, bar);
            __builtin_amdgcn_fence(__ATOMIC_ACQUIRE, "agent");
            xb_add(&bar[XB_XGEN(b.x)], 1u);
            asm volatile("s_waitcnt vmcnt(0)" ::: "memory");
        } else {
            XB_SPIN(xb_ld(&bar[XB_XGEN(b.x)]) == gen, bar);
            __builtin_amdgcn_fence(__ATOMIC_ACQUIRE, "agent");
            asm volatile("s_waitcnt vmcnt(0)" ::: "memory");
        }
    }
    __syncthreads();
}

struct Args { const float* in[29]; float* out; unsigned char* ws; };
enum { I_X = 0, I_META, I_N1G, I_WIN, I_MU, I_WUP, I_W0, I_AUP, I_A0, I_KK, I_KA, I_RK, I_LNG, I_LNB, I_FB, I_QG, I_KG, I_WPR, I_WPS, I_WPF, I_WOUT, I_N2G, I_MWG, I_MBG, I_MWE, I_MBE, I_MGATE, I_MUP, I_MDOWN };
struct ArgsL { volatile LAS unsigned* tab; float* out; unsigned char* ws;
    __device__ __forceinline__ const float* in(int i) const { const unsigned lo = tab[2 * i], hi = tab[2 * i + 1];
        return (const float*)(((unsigned long long)(unsigned)__builtin_amdgcn_readfirstlane((int)hi) << 32) | (unsigned long long)(unsigned)__builtin_amdgcn_readfirstlane((int)lo)); }
};
struct Frame { LAS unsigned char* lds; volatile LAS unsigned* MISC; int tid, lane, wave, bx; };

__device__ __forceinline__ float* hrow(const ArgsL& a, int b, int l) {
    return l < NMETA ? (float*)(a.ws + WS_HM) + (size_t)(b * NMETA + l) * D : a.out + ((size_t)b * SEQ + (l - NMETA)) * D;
}
#define LDS_WAIT() asm volatile("s_waitcnt lgkmcnt(0)" ::: "memory")

__device__ __forceinline__ void tr_item(const float* W, int ldw, int sc0, int nvalid, int k0, int kvalid, bf16_t* WT, int Kd, int r0, LAS float* scr, int lane) {
    float tv[32];
#pragma unroll
    for (int i = 0; i < 32; ++i) { const int kk = 2 * i + (lane >> 5), n = lane & 31; tv[i] = 0.f;
        if (n < nvalid && k0 + kk < kvalid) tv[i] = W[(size_t)(k0 + kk) * ldw + sc0 + n]; }
#pragma unroll
    for (int i = 0; i < 32; ++i) { const int kk = 2 * i + (lane >> 5), n = lane & 31; scr[kk * 33 + n] = tv[i]; }
    LDS_WAIT();
    const int c = lane & 7;
#pragma unroll
    for (int j = 0; j < 4; ++j) { const int n = (lane >> 3) + 8 * j; const LAS float* s = scr + (8 * c) * 33 + n;
        u32x4 o; o.x = pk2(s[0 * 33], s[1 * 33]); o.y = pk2(s[2 * 33], s[3 * 33]); o.z = pk2(s[4 * 33], s[5 * 33]); o.w = pk2(s[6 * 33], s[7 * 33]);
        *(u32x4*)(WT + (size_t)(r0 + n) * Kd + k0 + 8 * c) = o; }
    LDS_WAIT();
}
__device__ __forceinline__ void phase_wconv(const ArgsL& a, Frame& F, int layer) {
    LAS float* scr = (LAS float*)(F.lds + F.wave * 8448);
    const int gw = F.bx * NWAVES + F.wave, NGW = gridDim.x * NWAVES;
    constexpr int C1 = 16 * 104, C2_ = C1 + 16 * 96, C3 = C2_ + 6 * 96, C4 = C3 + 16 * 32, C5 = C4 + 16 * 256, C6 = C5 + 4 * 512;
    unsigned char* ws = a.ws;
    for (int it = gw; it < C6; it += NGW) {
        if (it < C1) { const int kb = it / 104, nb = it % 104, r0 = nb * 32;
            tr_item(a.in(I_WIN) + (size_t)layer * D * D_IN, D_IN, r0, r0 < FCOL ? 32 : 0, kb * 64, 1024, (bf16_t*)(ws + WS_WIN), 1024, r0, scr, F.lane); }
        else if (it < C2_) { const int r = it - C1, kb = r / 96, nb = r % 96, r0 = nb * 32;
            tr_item(a.in(I_WIN) + (size_t)layer * D * D_IN, D_IN, GCOL + r0, 32, kb * 64, 1024, (bf16_t*)(ws + WS_WG), 1024, r0, scr, F.lane); }
        else if (it < C3) { const int r = it - C2_, kb = r / 96, nb = r % 96, r0 = nb * 32, br = r0 >> 10;
            const float* W = (br == 0 ? a.in(I_WPR) + (size_t)layer * 384 * D : br == 1 ? a.in(I_WPS) + (size_t)layer * 320 * D : a.in(I_WPF) + (size_t)layer * 320 * D);
            tr_item(W, D, r0 & 1023, 32, kb * 64, br == 0 ? 384 : 320, (bf16_t*)(ws + WS_WP), 384, r0, scr, F.lane); }
        else if (it < C4) { const int r = it - C3, kb = r / 32, nb = r % 32, r0 = nb * 32;
            tr_item(a.in(I_WOUT) + (size_t)layer * D * D, D, r0, 32, kb * 64, 1024, (bf16_t*)(ws + WS_WO), 1024, r0, scr, F.lane); }
        else if (it < C5) { const int r = it - C4, kb = r / 256, nb = r % 256, r0 = nb * 32, e = r0 >> 9, rr = r0 & 511, j = rr >> 8, q = rr & 255;
            const float* W = (q >= 128 ? a.in(I_MUP) : a.in(I_MGATE)) + ((size_t)layer * NEXP + e) * D * DEXP;
            tr_item(W, DEXP, j * 128 + (q & 127), 32, kb * 64, 1024, (bf16_t*)(ws + WS_WGU), 1024, r0, scr, F.lane); }
        else { const int r = it - C5, kb = r / 512, nb = r % 512, r0 = nb * 32, e = r0 >> 10;
            tr_item(a.in(I_MDOWN) + ((size_t)layer * NEXP + e) * DEXP * D, D, r0 & 1023, 32, kb * 64, 256, (bf16_t*)(ws + WS_WD), 256, r0, scr, F.lane); }
    }
}

__device__ __forceinline__ void add_y_row(f32x4 (&v)[4], const bf16_t* Y, int slot, int lane) {
    const u32x2* y = (const u32x2*)(Y + (size_t)slot * D) + lane;
#pragma unroll
    for (int j = 0; j < 4; ++j) { const u32x2 t = y[64 * j]; v[j].x += bf_lo(t.x); v[j].y += bf_hi(t.x); v[j].z += bf_lo(t.y); v[j].w += bf_hi(t.y); }
}
template <int MODE>
__device__ __forceinline__ void phase_norm(const ArgsL& a, Frame& F, int layer, const bool dry = false) {
    const int lane = F.lane;
    LAS float* wl = (LAS float*)F.lds;
    LAS int* lcnt = (LAS int*)(F.lds + 20 * 4096);
    unsigned char* ws = a.ws;
    if (MODE == 1) {
        const float* win = a.in(I_WIN) + (size_t)layer * D * D_IN;
        for (int idx = F.tid; idx < 5 * 1024; idx += NTHR) { const int j = idx >> 10, k = idx & 1023; wl[j * 1024 + k] = win[(size_t)k * D_IN + FCOL + j]; }
    }
    if (MODE == 2) {
        const float* wg = a.in(I_MWG) + (size_t)layer * D * 4; const float* we = a.in(I_MWE) + (size_t)layer * D * 16;
        for (int idx = F.tid; idx < 4 * 1024; idx += NTHR) { const int j = idx >> 10, k = idx & 1023; wl[j * 1024 + k] = wg[k * 4 + j]; }
        for (int idx = F.tid; idx < 16 * 1024; idx += NTHR) { const int j = idx >> 10, k = idx & 1023; wl[(4 + j) * 1024 + k] = we[k * 16 + j]; }
        if (F.tid < 16) lcnt[F.tid] = 0;
    }
    __syncthreads();
    const int gw = F.bx * NWAVES + F.wave, NGW = gridDim.x * NWAVES;
    const float* gsrc = (MODE == 2 ? a.in(I_N2G) : a.in(I_N1G)) + layer * D;
    f32x4 gv[4];
#pragma unroll
    for (int j = 0; j < 4; ++j) gv[j] = (MODE == 0) ? (f32x4){0.f, 0.f, 0.f, 0.f} : *(const f32x4*)(gsrc + 4 * lane + 256 * j);
    bf16_t* A = (bf16_t*)(ws + WS_A);
    const bf16_t* Y = (const bf16_t*)(ws + WS_Y);
    const int* SLOT = (const int*)(ws + WS_SLOT);
    constexpr bool COMB0 = (MODE == 0);
    const bool comb = COMB0 || (MODE == 1 && layer > 0);
    f32x4 vn[4]; u32x2 yan[4], ybn[4];
#pragma unroll
    for (int j = 0; j < 4; ++j) { vn[j] = (f32x4){0.f, 0.f, 0.f, 0.f}; yan[j] = (u32x2){0u, 0u}; ybn[j] = (u32x2){0u, 0u}; }
#define NRM_VALID(mm) ((mm) < M && ((mm) % T) - PADR >= (MODE == 0 ? NMETA : 0))
#define NRM_SRC(mm, bb_, ll_) ((MODE == 1 && layer == 0) ? ((ll_) < NMETA ? a.in(I_META) + (size_t)(ll_) * D : a.in(I_X) + ((size_t)(bb_) * SEQ + ((ll_) - NMETA)) * D) : (const float*)hrow(a, bb_, ll_))
#define NRM_LOAD(mm, s0_, s1_) do { if (NRM_VALID(mm)) { const int bb_ = (mm) / T, ll_ = (mm) - bb_ * T - PADR; const float* src_ = NRM_SRC(mm, bb_, ll_); \
        _Pragma("unroll") for (int j = 0; j < 4; ++j) vn[j] = *(const f32x4*)(src_ + 4 * lane + 256 * j); \
        if (comb) { const u32x2* y0_ = (const u32x2*)(Y + (size_t)(s0_) * D) + lane; const u32x2* y1_ = (const u32x2*)(Y + (size_t)(s1_) * D) + lane; \
            _Pragma("unroll") for (int j = 0; j < 4; ++j) { yan[j] = y0_[64 * j]; ybn[j] = y1_[64 * j]; } } } } while (0)
    int sa1 = 0, sb1 = 0, sa2 = 0, sb2 = 0;
    if (comb) { if (NRM_VALID(gw)) { sa1 = SLOT[2 * gw]; sb1 = SLOT[2 * gw + 1]; } if (NRM_VALID(gw + NGW)) { sa2 = SLOT[2 * (gw + NGW)]; sb2 = SLOT[2 * (gw + NGW) + 1]; } }
    NRM_LOAD(gw, sa1, sb1);
    for (int m = gw; m < M; m += NGW) {
        f32x4 v[4]; u32x2 ya[4], yb[4];
#pragma unroll
        for (int j = 0; j < 4; ++j) { v[j] = vn[j]; ya[j] = yan[j]; yb[j] = ybn[j]; }
        int sa3 = 0, sb3 = 0;
        if (comb && NRM_VALID(m + 2 * NGW)) { sa3 = SLOT[2 * (m + 2 * NGW)]; sb3 = SLOT[2 * (m + 2 * NGW) + 1]; }
        NRM_LOAD(m + NGW, sa2, sb2);
        sa2 = sa3; sb2 = sb3;
        const int b = m / T, p = m - b * T, l = p - PADR;
        if (l < 0) {
            if (MODE == 1 && !dry) {
                u32x2* o = (u32x2*)(A + (size_t)m * D) + lane;
#pragma unroll
                for (int j = 0; j < 4; ++j) o[64 * j] = (u32x2){0u, 0u};
                if (lane < 8) ((float*)(ws + WS_LOGF))[(size_t)m * 8 + lane] = 0.f;
            }
            continue;
        }
        if (MODE == 0 && l < NMETA) continue;
        float* hp = hrow(a, b, l);
        if (comb) {
#pragma unroll
            for (int j = 0; j < 4; ++j) { v[j].x += bf_lo(ya[j].x) + bf_lo(yb[j].x); v[j].y += bf_hi(ya[j].x) + bf_hi(yb[j].x); v[j].z += bf_lo(ya[j].y) + bf_lo(yb[j].y); v[j].w += bf_hi(ya[j].y) + bf_hi(yb[j].y); }
        }
        if ((MODE == 0 || MODE == 1) && !dry) {
#pragma unroll
            for (int j = 0; j < 4; ++j) *(f32x4*)(hp + 4 * lane + 256 * j) = v[j];
        }
        if (MODE == 0) continue;
        float ss = 0.f;
#pragma unroll
        for (int j = 0; j < 4; ++j) ss += (v[j].x * v[j].x + v[j].y * v[j].y) + (v[j].z * v[j].z + v[j].w * v[j].w);
        const float r = 1.0f / sqrtf(wave_sum(ss) * (1.0f / D) + 1e-6f);
#pragma unroll
        for (int j = 0; j < 4; ++j) v[j] = v[j] * r * gv[j];
        u32x2* o = (u32x2*)(A + (size_t)m * D) + lane;
        if (!dry) {
#pragma unroll
        for (int j = 0; j < 4; ++j) o[64 * j] = (u32x2){pk2(v[j].x, v[j].y), pk2(v[j].z, v[j].w)}; }
        else { float sink = v[0].x + v[1].y + v[2].z + v[3].w; asm volatile("" :: "v"(sink)); }
        if (MODE == 1) {
            float dsum[5];
#pragma unroll
            for (int q = 0; q < 5; ++q) { float d = 0.f;
#pragma unroll
                for (int j = 0; j < 4; ++j) { const f32x4 w = *(const LAS f32x4*)(wl + q * 1024 + 4 * lane + 256 * j); d += (v[j].x * w.x + v[j].y * w.y) + (v[j].z * w.z + v[j].w * w.w); }
                dsum[q] = wave_sum(d); }
            float mine = dsum[0];
            mine = lane == 1 ? dsum[1] : mine; mine = lane == 2 ? dsum[2] : mine; mine = lane == 3 ? dsum[3] : mine; mine = lane == 4 ? dsum[4] : mine;
            if (lane < 8 && !dry) { float lf = 0.f;
                if (lane < 5) { const float xx = mine + a.in(I_FB)[layer * 5 + lane]; lf = fminf(xx, 0.f) - fast_log(1.f + fast_exp(-fabsf(xx))); }
                ((float*)(ws + WS_LOGF))[(size_t)m * 8 + lane] = lf; }
        }
        if (MODE == 2) {
            float ds[20];
#pragma unroll
            for (int q = 0; q < 20; ++q) { float d = 0.f;
#pragma unroll
                for (int j = 0; j < 4; ++j) { const f32x4 w = *(const LAS f32x4*)(wl + q * 1024 + 4 * lane + 256 * j); d += (v[j].x * w.x + v[j].y * w.y) + (v[j].z * w.z + v[j].w * w.w); }
                ds[q] = wave_sum(d); }
            const float* bg = a.in(I_MBG) + layer * 4; const float* be = a.in(I_MBE) + layer * 16;
            float lg0 = ds[0] + bg[0], lg1 = ds[1] + bg[1], lg2 = ds[2] + bg[2], lg3 = ds[3] + bg[3];
            int g = 0; float mx = lg0;
            if (lg1 > mx) { mx = lg1; g = 1; } if (lg2 > mx) { mx = lg2; g = 2; } if (lg3 > mx) { mx = lg3; g = 3; }
            const float den = fast_exp(lg0 - mx) + fast_exp(lg1 - mx) + fast_exp(lg2 - mx) + fast_exp(lg3 - mx);
            const float pgrp = 1.0f / den;
            float s0 = g == 0 ? ds[4] : g == 1 ? ds[8] : g == 2 ? ds[12] : ds[16];
            float s1 = g == 0 ? ds[5] : g == 1 ? ds[9] : g == 2 ? ds[13] : ds[17];
            float s2 = g == 0 ? ds[6] : g == 1 ? ds[10] : g == 2 ? ds[14] : ds[18];
            float s3 = g == 0 ? ds[7] : g == 1 ? ds[11] : g == 2 ? ds[15] : ds[19];
            s0 += be[g * 4 + 0]; s1 += be[g * 4 + 1]; s2 += be[g * 4 + 2]; s3 += be[g * 4 + 3];
            int i0 = 0; float v0 = s0;
            if (s1 > v0) { v0 = s1; i0 = 1; } if (s2 > v0) { v0 = s2; i0 = 2; } if (s3 > v0) { v0 = s3; i0 = 3; }
            int i1 = -1; float v1 = -3.0e38f;
            if (i0 != 0 && s0 > v1) { v1 = s0; i1 = 0; } if (i0 != 1 && s1 > v1) { v1 = s1; i1 = 1; } if (i0 != 2 && s2 > v1) { v1 = s2; i1 = 2; } if (i0 != 3 && s3 > v1) { v1 = s3; i1 = 3; }
            const float e1 = fast_exp(v1 - v0), pt0 = 1.0f / (1.0f + e1), pt1 = e1 * pt0;
            if (dry) { float sink = pgrp * pt0 + pt1; asm volatile("" :: "v"(sink)); }
            if (lane == 0 && !dry) {
                const int ea = g * 4 + i0, eb = g * 4 + i1;
                const int la = atomicAdd((int*)&lcnt[ea], 1), lb = atomicAdd((int*)&lcnt[eb], 1);
                int* tk = (int*)(ws + WS_TOK) + (size_t)m * 8;
                tk[0] = ea; tk[1] = eb; tk[2] = __float_as_int(pgrp * pt0); tk[3] = __float_as_int(pgrp * pt1); tk[4] = la; tk[5] = lb;
            }
        }
    }
    __syncthreads();
#undef NRM_LOAD
#undef NRM_SRC
#undef NRM_VALID
    if (MODE == 2 && F.tid < 16 && !dry) {
        const int c = lcnt[F.tid];
        ((int*)(ws + WS_WGCNT))[F.bx * 16 + F.tid] = c;
        atomicAdd((int*)(ws + WS_CTL) + CW_ECNT + 64 * layer + F.tid, c);
    }
    __syncthreads();
}

__device__ __forceinline__ void phase_route(const ArgsL& a, Frame& F, int layer) {
    unsigned char* ws = a.ws;
    LAS int* tbl = (LAS int*)F.lds;
    LAS int* part = tbl + 16;
    {
        const int e = F.tid & 15, q = F.tid >> 4; const int* wc = (const int*)(ws + WS_WGCNT); int acc = 0;
#pragma unroll
        for (int i = 0; i < 8; ++i) { const int w = q + 32 * i; if (w < (int)F.bx) acc += wc[w * 16 + e]; }
        part[q * 16 + e] = acc;
    }
    __syncthreads();
    if (F.tid < 16) {
        const int* cnt = (const int*)(ws + WS_CTL) + CW_ECNT + 64 * layer;
        int cv[16];
#pragma unroll
        for (int e = 0; e < 16; ++e) cv[e] = __hip_atomic_load(cnt + e, __ATOMIC_RELAXED, __HIP_MEMORY_SCOPE_AGENT);
        int base = 0;
#pragma unroll
        for (int e = 0; e < 16; ++e) if (e < F.tid) base += ((cv[e] + 255) >> 8) << 8;
#pragma unroll
        for (int q = 0; q < 32; ++q) base += part[q * 16 + F.tid];
        tbl[F.tid] = base;
    }
    __syncthreads();
    const int gw = F.bx * NWAVES + F.wave, NGW = gridDim.x * NWAVES, lane = F.lane;
    const bf16_t* A = (const bf16_t*)(ws + WS_A); bf16_t* AS = (bf16_t*)(ws + WS_AS);
    int tn[6] = {0, 0, 0, 0, 0, 0}; u32x4 xn0 = {0u, 0u, 0u, 0u}, xn1 = {0u, 0u, 0u, 0u};
#define RT_LOAD(mm) do { if ((mm) < M && ((mm) % T) >= PADR) { const int* tk_ = (const int*)(ws + WS_TOK) + (size_t)(mm) * 8; \
        _Pragma("unroll") for (int q_ = 0; q_ < 6; ++q_) tn[q_] = tk_[q_]; \
        const u32x4* src_ = (const u32x4*)(A + (size_t)(mm) * D) + lane; xn0 = src_[0]; xn1 = src_[64]; } } while (0)
    RT_LOAD(gw);
    for (int m = gw; m < M; m += NGW) {
        int tk[6];
#pragma unroll
        for (int q = 0; q < 6; ++q) tk[q] = tn[q];
        const u32x4 x0 = xn0, x1 = xn1;
        RT_LOAD(m + NGW);
        const int b = m / T, p = m - b * T, l = p - PADR;
        if (l < 0) continue;
        const int ea = tk[0], eb = tk[1], sa = tbl[ea] + tk[4], sb = tbl[eb] + tk[5];
        u32x4* d0 = (u32x4*)(AS + (size_t)sa * D) + lane; u32x4* d1 = (u32x4*)(AS + (size_t)sb * D) + lane;
        d0[0] = x0; d0[64] = x1; d1[0] = x0; d1[64] = x1;
        if (lane == 0) { int* sl = (int*)(ws + WS_SLOT) + 2 * m; sl[0] = sa; sl[1] = sb;
            float* cw = (float*)(ws + WS_CWS); cw[sa] = __int_as_float(tk[2]); cw[sb] = __int_as_float(tk[3]); }
    }
#undef RT_LOAD
    __syncthreads();
}

__device__ __forceinline__ void phase_prep(const ArgsL& a, Frame& F, int layer, const bool dry = false) {
    unsigned char* ws = a.ws;
    LAS float* xs = (LAS float*)F.lds;
    const int wave = F.wave, lane = F.lane, tid = F.tid;
    const int m0 = F.bx * 129;
    const bf16_t* USH = (const bf16_t*)(ws + WS_USH);
    bf16_t* QKV = (bf16_t*)(ws + WS_QKV);
    if (F.bx < 10) {
        const int bh = F.bx, b = bh / 5, h = bh % 5;
        const float* LOGF = (const float*)(ws + WS_LOGF) + (size_t)(b * T + PADR) * 8 + h;
        float* kb = (float*)(ws + WS_KB2) + (size_t)bh * KBP;
        LAS float* wtot = (LAS float*)F.lds;
        float v[33];
        const int l0 = tid * 33;
#pragma unroll
        for (int i = 0; i < 33; ++i) v[i] = (l0 + i < LTOK) ? LOGF[(size_t)(l0 + i) * 8] : 0.f;
#pragma unroll
        for (int i = 1; i < 33; ++i) v[i] += v[i - 1];
        float incl = v[32];
#pragma unroll
        for (int o = 1; o < 64; o <<= 1) { const float t = __shfl_up(incl, o); if (lane >= o) incl += t; }
        if (lane == 63) wtot[wave] = incl;
        __syncthreads();
        float off = incl - v[32];
        for (int w = 0; w < wave; ++w) off += wtot[w];
#pragma unroll
        for (int i = 0; i < 33; ++i) if (l0 + i < LTOK && !dry) kb[PADR + l0 + i] = -(off + v[i]) * LOG2E;
        for (int p = tid; p < PADR; p += NTHR) kb[p] = 0.f;
        for (int p = T + tid; p < KBP; p += NTHR) kb[p] = 0.f;
        __syncthreads();
    }
    if (F.bx >= 16 && F.bx < 28) {
        unsigned* z = (unsigned*)(ws + WS_RW + ((size_t)(F.bx - 16) * LPADDED + LTOK) * 768);
        for (int i = tid; i < (LPADDED - LTOK) * 192; i += NTHR) z[i] = 0u;
    }
    float w0j = 0.f, a0j = 0.f, kkj = 0.f, kaj = 0.f, rkj = 0.f;
    const int jch = wave * 64 + lane;
    const float* WU = a.in(I_WUP) + (size_t)layer * 64 * RW_W + (wave < 6 ? jch : 0); const float* AU = a.in(I_AUP) + (size_t)layer * 64 * RW_W + (wave < 6 ? jch : 0);
    if (wave < 6) {
        w0j = a.in(I_W0)[layer * RW_W + jch]; a0j = a.in(I_A0)[layer * RW_W + jch];
        kkj = a.in(I_KK)[layer * RW_W + jch]; kaj = a.in(I_KA)[layer * RW_W + jch]; rkj = a.in(I_RK)[layer * RW_W + jch];
    }
    float wvv[64], avv[64];
    if (wave < 6) {
        const float* wp_ = WU; const float* ap_ = AU;
#pragma unroll
        for (int i = 0; i < 64; ++i) { wvv[i] = *wp_; avv[i] = *ap_; wp_ += RW_W; ap_ += RW_W; asm volatile("" : "+v"(wp_), "+v"(ap_)); }
    } else {
#pragma unroll
        for (int i = 0; i < 64; ++i) { wvv[i] = 0.f; avv[i] = 0.f; }
    }
    const float* mu = a.in(I_MU) + layer * SHIFT_W;
    const float gq = a.in(I_QG)[layer * 64 + lane] * C2, gk = a.in(I_KG)[layer * 64 + lane];
    _Float16* RW = (_Float16*)(ws + WS_RW);
    bf16_t* BN = (bf16_t*)(ws + WS_BN);
    for (int t0 = 0; t0 < 129; t0 += 16) {
        const int nt = (129 - t0) < 16 ? (129 - t0) : 16;
        {
            int tid = F.tid; asm volatile("" : "+v"(tid));
            u32x4 uu4[5], pp4[5];
#pragma unroll
            for (int q5 = 0; q5 < 5; ++q5) { const int item = tid + q5 * NTHR; uu4[q5] = (u32x4){0u, 0u, 0u, 0u}; pp4[q5] = (u32x4){0u, 0u, 0u, 0u};
                if (item < nt * 160) { const int tok = item / 160, ch = item - tok * 160, m = m0 + t0 + tok;
                    uu4[q5] = *(const u32x4*)(USH + (size_t)m * SHIFT_W + ch * 8);
                    if (m > 0) pp4[q5] = *(const u32x4*)(USH + (size_t)(m - 1) * SHIFT_W + ch * 8); } }
#pragma unroll
            for (int q5 = 0; q5 < 5; ++q5) { const int item = tid + q5 * NTHR;
                if (item < nt * 160) { const int tok = item / 160, ch = item - tok * 160;
                    const u32x4 u = uu4[q5], pv = pp4[q5];
                    const f32x4 mu0 = *(const f32x4*)(mu + ch * 8), mu1 = *(const f32x4*)(mu + ch * 8 + 4);
                    float x[8];
                    { float uu, pp;
                      uu = bf_lo(u.x); pp = bf_lo(pv.x); x[0] = uu + (pp - uu) * mu0.x;  uu = bf_hi(u.x); pp = bf_hi(pv.x); x[1] = uu + (pp - uu) * mu0.y;
                      uu = bf_lo(u.y); pp = bf_lo(pv.y); x[2] = uu + (pp - uu) * mu0.z;  uu = bf_hi(u.y); pp = bf_hi(pv.y); x[3] = uu + (pp - uu) * mu0.w;
                      uu = bf_lo(u.z); pp = bf_lo(pv.z); x[4] = uu + (pp - uu) * mu1.x;  uu = bf_hi(u.z); pp = bf_hi(pv.z); x[5] = uu + (pp - uu) * mu1.y;
                      uu = bf_lo(u.w); pp = bf_lo(pv.w); x[6] = uu + (pp - uu) * mu1.z;  uu = bf_hi(u.w); pp = bf_hi(pv.w); x[7] = uu + (pp - uu) * mu1.w; }
                    if (ch >= 144 && ch < 152) {
#pragma unroll
                        for (int q = 0; q < 8; ++q) { const float e = fast_exp(-2.f * fabsf(x[q])); const float th = (1.f - e) / (1.f + e); x[q] = x[q] < 0.f ? -th : th; }
                    }
                    LAS f32x4* d = (LAS f32x4*)(xs + tok * SHIFT_W + ch * 8);
                    d[0] = (f32x4){x[0], x[1], x[2], x[3]}; d[1] = (f32x4){x[4], x[5], x[6], x[7]}; } }
        }
        __syncthreads();
        if (wave < 6) {
#pragma unroll 1
            for (int tok = 0; tok < nt; ++tok) {
                const int m = m0 + t0 + tok, b = m / T, p = m - b * T, l = p - PADR;
                if (l < 0) continue;
                const LAS float* xr = xs + tok * SHIFT_W;
                float w0a = w0j, w1a = 0.f, a0a = a0j, a1a = 0.f;
#pragma unroll
                for (int i = 0; i < 64; i += 4) { if ((i & 15) == 0) __builtin_amdgcn_sched_barrier(0);       const f32x4 t4 = *(const LAS f32x4*)(xr + 1152 + i), d4 = *(const LAS f32x4*)(xr + 1216 + i);
                    w0a += t4.x * wvv[i]; w1a += t4.y * wvv[i + 1]; w0a += t4.z * wvv[i + 2]; w1a += t4.w * wvv[i + 3];
                    a0a += d4.x * avv[i]; a1a += d4.y * avv[i + 1]; a0a += d4.z * avv[i + 2]; a1a += d4.w * avv[i + 3]; }
                const float wlv = w0a + w1a, alv = a0a + a1a;
                const float r = xr[jch], k = xr[384 + jch], v = xr[768 + jch];
                const float logw = -softplus_f(-wlv) - 0.5f;
                const float xw = fast_exp(logw);
                const float om = xw < 0.02f ? xw * (1.f - 0.5f * xw + xw * xw * (1.f / 6.f)) : 1.f - fast_exp(-xw);
                const float av = 1.f / (1.f + fast_exp(-alv));
                const float kkr = k * kkj;
                const float nrm = sqrtf(wave_sum(kkr * kkr));
                const float kk = kkr / fmaxf(nrm, 1e-12f);
                const float kp = k * (1.f + (av - 1.f) * kaj);
                const float bb = kk * av;
                const float coef = wave_sum(r * kp * rkj);
                _Float16* o = RW + ((size_t)(b * RW_H + wave) * LPADDED + l) * 384 + lane;
                if (dry) { float sink = kk + om + bb + kp + coef; asm volatile("" :: "v"(sink)); continue; }
                o[0] = (_Float16)kk; o[64] = (_Float16)(-om); o[128] = (_Float16)(-bb); o[192] = (_Float16)kp; o[256] = (_Float16)r; o[320] = (_Float16)v;
                BN[(size_t)m * RW_W + jch] = f2bf(coef * v);
            }
        } else {
            const int which = wave - 6;
            const float gsc = which == 0 ? gq : gk;
#pragma unroll 1
            for (int th = 0; th < 16; th += 8) {
                unsigned short xv[8][5];
#pragma unroll
                for (int t8 = 0; t8 < 8; ++t8) { const int tok = th + t8, m = m0 + t0 + tok; const int p = m % T;
                    const bf16_t* q = QKV + (size_t)m * QKV_W + 960 + which * 320 + lane;
#pragma unroll
                    for (int hd = 0; hd < 5; ++hd) xv[t8][hd] = (tok < nt && p >= PADR) ? q[hd * 64] : (unsigned short)0; }
#pragma unroll
                for (int t8 = 0; t8 < 8; ++t8) { const int tok = th + t8, m = m0 + t0 + tok; const int p = m % T;
                    bf16_t* q = QKV + (size_t)m * QKV_W + 960 + which * 320 + lane;
                    if (tok < nt && p >= PADR) {
#pragma unroll
                        for (int hd = 0; hd < 5; ++hd) { const float x = bf2f(xv[t8][hd]); const float ss = wave_sum(x * x);
                            const unsigned short r_ = f2bf(x * (1.0f / sqrtf(ss * (1.0f / 64.f) + 1e-6f)) * gsc); if (!dry) q[hd * 64] = r_; else asm volatile("" :: "v"(r_)); } } }
            }
        }
        __syncthreads();
    }
}


constexpr int SCH = 16;
static_assert(LTOK % SCH == 0, "whole chunks");
__device__ __forceinline__ void rwkv_scan(const ArgsL& a, Frame& F, int wgi, int dry = 0) {
    const int bh = wgi >> 4, q8 = wgi & 15, b = bh / RW_H, h = bh % RW_H;
    const int tid = F.tid, wave = F.wave, lane = F.lane;
    const unsigned char* rw = a.ws + WS_RW + (size_t)bh * LPADDED * 768;
    LAS float* ring = (LAS float*)F.lds;
    LAS float* ypart = (LAS float*)(F.lds + 49152);
    LAS unsigned char* stg = F.lds + 81920;
    bf16_t* y0 = (bf16_t*)(a.ws + WS_YCAT);
    constexpr int NCH = LTOK / SCH;
    const bool isld = (wave & 2) != 0; const int lw = (wave & 1) + ((wave >> 2) << 1), tl = lw * 64 + lane;
    float s0 = 0.f, s1 = 0.f;
    const int i32 = lane & 31, rsel = lane >> 5, rloc = 2 * wave + rsel;
#define RW_BAR() asm volatile("s_waitcnt lgkmcnt(0)\n\ts_barrier" ::: "memory")
#define RW_ISSUE(cc) do { const unsigned char* src_ = rw + (size_t)(cc) * SCH * 768 + (size_t)tl * 16; LAS unsigned char* d_ = stg + ((cc) & 3) * 12288 + lw * 1024; \
        _Pragma("unroll") for (int k_ = 0; k_ < 3; ++k_) __builtin_amdgcn_global_load_lds((const unsigned*)(src_ + k_ * 4096), (LAS unsigned*)(d_ + k_ * 4096), 16, 0, 0); } while (0)
#define RW_CONVERT(cc) do { const LAS unsigned char* s_ = stg + ((cc) & 3) * 12288 + tl * 16; LAS float* rb_ = ring + ((cc) & 1) * 6144; \
        _Pragma("unroll") for (int k_ = 0; k_ < 3; ++k_) { const int pc_ = tl + 256 * k_; const int t_ = pc_ / 48, q_ = pc_ - t_ * 48, vec_ = q_ >> 3, e0_ = (q_ & 7) * 8; \
            const u32x4 w_ = *(const LAS u32x4*)(s_ + k_ * 4096); \
            const f16x4 lo_ = __builtin_bit_cast(f16x4, (u32x2){w_.x, w_.y}), hi_ = __builtin_bit_cast(f16x4, (u32x2){w_.z, w_.w}); \
            const float f0 = (float)lo_.x, f1 = (float)lo_.y, f2 = (float)lo_.z, f3 = (float)lo_.w, f4 = (float)hi_.x, f5 = (float)hi_.y, f6 = (float)hi_.z, f7 = (float)hi_.w; \
            if (vec_ < 4) { LAS float* d_ = rb_ + t_ * 384 + (vec_ >> 1) * 128 + (e0_ >> 1) * 4 + (vec_ & 1) * 2; \
                *(LAS f32x2*)(d_) = (f32x2){f0, f1}; *(LAS f32x2*)(d_ + 4) = (f32x2){f2, f3}; *(LAS f32x2*)(d_ + 8) = (f32x2){f4, f5}; *(LAS f32x2*)(d_ + 12) = (f32x2){f6, f7}; } \
            else { LAS f32x4* d_ = (LAS f32x4*)(rb_ + t_ * 384 + (vec_ == 4 ? 256 : 320) + e0_); d_[0] = (f32x4){f0, f1, f2, f3}; d_[1] = (f32x4){f4, f5, f6, f7}; } } } while (0)
#define RW_STORE_Y(cc) do { if (tl < 32) { const LAS float* yb_ = ypart + ((cc) & 1) * 4096; const int t_ = tl >> 1, pr_ = tl & 1; const int l_ = (cc) * SCH + t_; \
        const LAS f32x4* q_ = (const LAS f32x4*)(yb_ + t_ * 128 + pr_ * 64); f32x4 sa_ = q_[0], sb_ = q_[8]; \
        _Pragma("unroll") for (int k_ = 1; k_ < 8; ++k_) { sa_ = sa_ + q_[k_]; sb_ = sb_ + q_[8 + k_]; } \
        *(unsigned*)(y0 + (size_t)(b * T + PADR + l_) * RW_W + h * 64 + q8 * 4 + 2 * pr_) = pk2((sa_.x + sa_.y) + (sa_.z + sa_.w), (sb_.x + sb_.y) + (sb_.z + sb_.w)); } } while (0)
    if (isld) {
        RW_ISSUE(0); asm volatile("s_waitcnt vmcnt(0)" ::: "memory"); RW_CONVERT(0);
        RW_ISSUE(1); RW_ISSUE(2);
    }
    RW_BAR();
    for (int c = 0; c < NCH; ++c) {
        if (isld) {
            if (c + 2 < NCH) { asm volatile("s_waitcnt vmcnt(3)" ::: "memory"); RW_CONVERT(c + 1); }
            else if (c + 1 < NCH) { asm volatile("s_waitcnt vmcnt(0)" ::: "memory"); RW_CONVERT(c + 1); }
            if (c > 0 && !dry) RW_STORE_Y(c - 1);
            if (c + 3 < NCH) RW_ISSUE(c + 3);
        } else if (dry != 1 && wave < 2) {
            const unsigned ba = (unsigned)(uintptr_t)(ring + (c & 1) * 6144) + i32 * 16, ca = (unsigned)(uintptr_t)(ring + (c & 1) * 6144) + 1024 + i32 * 8,
                           va = (unsigned)(uintptr_t)(ring + (c & 1) * 6144) + 1280 + (q8 * 4 + rloc) * 4, ya = (unsigned)(uintptr_t)(ypart + (c & 1) * 4096 + rloc * 32 + i32);
            f32x4 OA[4], OB[4]; f32x2 OC[4]; float OV[4];
            OC[3] = (f32x2){0.f, 0.f};
#define RW_FETCH(tt, sl) asm volatile("ds_read_b128 %0, %4 offset:%c7\n\tds_read_b128 %1, %4 offset:%c8\n\tds_read_b64 %2, %5 offset:%c7\n\tds_read_b32 %3, %6 offset:%c7" \
                : "=&v"(OA[sl]), "=&v"(OB[sl]), "=&v"(OC[sl]), "=&v"(OV[sl]) : "v"(ba), "v"(ca), "v"(va), "i"((tt) * 1536), "i"((tt) * 1536 + 512) : "memory")
            RW_FETCH(0, 0); RW_FETCH(1, 1);
            float p, p2, y;
#define RW_STEP(t, WAITN, YL1, YL2, YW, FETCHL) asm volatile( \
                "s_waitcnt lgkmcnt(" WAITN ")\n\t" \
                "v_mul_f32 %[p], %[s0], %[kk0]\n\t" \
                "v_fmac_f32 %[p], %[s1], %[kk1]\n\t" \
                YL1 "\n\t" YL2 "\n\t" \
                XL8 "\n\t" \
                "v_fmac_f32 %[s0], %[s0], %[om0]\n\t" \
                "v_fmac_f32 %[s1], %[s1], %[om1]\n\t" \
                XL4 "\n\t" \
                "v_fmac_f32 %[s0], %[vf], %[kv0]\n\t" \
                "v_fmac_f32 %[s1], %[vf], %[kv1]\n\t" \
                XL2 "\n\t" \
                YW "\n\t" \
                FETCHL \
                : [p] "=&v"(p), [p2] "=&v"(p2), [y] "=&v"(y), [s0] "+v"(s0), [s1] "+v"(s1), [nA] "=&v"(OA[((t) + 2) & 3]), [nB] "=&v"(OB[((t) + 2) & 3]), [nC] "=&v"(OC[((t) + 2) & 3]), [nV] "=&v"(OV[((t) + 2) & 3]) \
                : [kk0] "v"(OA[(t) & 3].x), [kk1] "v"(OA[(t) & 3].y), [om0] "v"(OA[(t) & 3].z), [om1] "v"(OA[(t) & 3].w), [bb0] "v"(OB[(t) & 3].x), [bb1] "v"(OB[(t) & 3].y), [kv0] "v"(OB[(t) & 3].z), [kv1] "v"(OB[(t) & 3].w), \
                  [vf] "v"(OV[(t) & 3]), [rp0] "v"(OC[((t) + 3) & 3].x), [rp1] "v"(OC[((t) + 3) & 3].y), [ba] "v"(ba), [ca] "v"(ca), [va] "v"(va), [ya] "v"(ya), \
                  [oa] "i"(((t) + 2) * 1536), [ob] "i"(((t) + 2) * 1536 + 512), [oy] "i"(((t) - 1) * 512) : "memory")
#define RW_YL1 "v_mul_f32 %[y], %[s0], %[rp0]"
#define RW_YL2 "v_fmac_f32 %[y], %[s1], %[rp1]"
#define RW_YW  "ds_write_b32 %[ya], %[y] offset:%c[oy]"
#define RW_NOP "s_nop 0"
#define RW_TAIL_F "ds_read_b128 %[nA], %[ba] offset:%c[oa]\n\t" \
                XL1 "\n\t" \
                "ds_read_b128 %[nB], %[ba] offset:%c[ob]\n\t" \
                "ds_read_b64 %[nC], %[ca] offset:%c[oa]\n\t" \
                "v_mov_b32 %[p2], %[p]\n\t" \
                "ds_read_b32 %[nV], %[va] offset:%c[oa]\n\t" \
                "s_nop 0\n\t" \
                XSW "\n\t" \
                "v_add_f32 %[p], %[p], %[p2]\n\t" \
                "v_fmac_f32 %[s0], %[p], %[bb0]\n\t" \
                "v_fmac_f32 %[s1], %[p], %[bb1]"
#define RW_TAIL_N "s_nop 0\n\t" \
                XL1 "\n\t" \
                "s_nop 1\n\t" \
                "v_mov_b32 %[p2], %[p]\n\t" \
                "s_nop 1\n\t" \
                XSW "\n\t" \
                "v_add_f32 %[p], %[p], %[p2]\n\t" \
                "v_fmac_f32 %[s0], %[p], %[bb0]\n\t" \
                "v_fmac_f32 %[s1], %[p], %[bb1]"
#define RW_ALLSTEPS() do { \
            RW_STEP(0, "4", RW_NOP, RW_NOP, RW_NOP, RW_TAIL_F); \
            RW_STEP(1, "4", RW_YL1, RW_YL2, RW_YW, RW_TAIL_F); \
            RW_STEP(2, "5", RW_YL1, RW_YL2, RW_YW, RW_TAIL_F);  RW_STEP(3, "5", RW_YL1, RW_YL2, RW_YW, RW_TAIL_F);  RW_STEP(4, "5", RW_YL1, RW_YL2, RW_YW, RW_TAIL_F); \
            RW_STEP(5, "5", RW_YL1, RW_YL2, RW_YW, RW_TAIL_F);  RW_STEP(6, "5", RW_YL1, RW_YL2, RW_YW, RW_TAIL_F);  RW_STEP(7, "5", RW_YL1, RW_YL2, RW_YW, RW_TAIL_F); \
            RW_STEP(8, "5", RW_YL1, RW_YL2, RW_YW, RW_TAIL_F);  RW_STEP(9, "5", RW_YL1, RW_YL2, RW_YW, RW_TAIL_F);  RW_STEP(10, "5", RW_YL1, RW_YL2, RW_YW, RW_TAIL_F); \
            RW_STEP(11, "5", RW_YL1, RW_YL2, RW_YW, RW_TAIL_F); RW_STEP(12, "5", RW_YL1, RW_YL2, RW_YW, RW_TAIL_F); RW_STEP(13, "5", RW_YL1, RW_YL2, RW_YW, RW_TAIL_F); \
            RW_STEP(14, "5", RW_YL1, RW_YL2, RW_YW, RW_TAIL_N); \
            RW_STEP(15, "1", RW_YL1, RW_YL2, RW_YW, RW_TAIL_N); \
            asm volatile("v_mul_f32 %[y], %[s0], %[r0]\n\tv_fmac_f32 %[y], %[s1], %[r1]\n\tds_write_b32 %[ya], %[y] offset:7680" : [y] "=&v"(y) : [s0] "v"(s0), [s1] "v"(s1), [r0] "v"(OC[3].x), [r1] "v"(OC[3].y), [ya] "v"(ya) : "memory"); \
 } while (0)
#ifdef SCAN_PROBE_NOXL
            if (dry == 2) {
#define XL8 "v_add_f32 %[p], %[p], %[p]"
#define XL4 "v_add_f32 %[p], %[p], %[p]"
#define XL2 "v_add_f32 %[p], %[p], %[p]"
#define XL1 "v_add_f32 %[p], %[p], %[p]"
#define XSW "v_add_f32 %[p], %[p], %[p2]"
                RW_ALLSTEPS();
#undef XL8
#undef XL4
#undef XL2
#undef XL1
#undef XSW
            } else
#endif
            {
#define XL8 "v_add_f32_dpp %[p], %[p], %[p] row_ror:8 row_mask:0xf bank_mask:0xf bound_ctrl:1"
#define XL4 "v_add_f32_dpp %[p], %[p], %[p] row_ror:4 row_mask:0xf bank_mask:0xf bound_ctrl:1"
#define XL2 "v_add_f32_dpp %[p], %[p], %[p] row_ror:2 row_mask:0xf bank_mask:0xf bound_ctrl:1"
#define XL1 "v_add_f32_dpp %[p], %[p], %[p] row_ror:1 row_mask:0xf bank_mask:0xf bound_ctrl:1"
#define XSW "v_permlane16_swap_b32 %[p], %[p2]"
                RW_ALLSTEPS();
            }
#undef RW_ALLSTEPS
#undef RW_STEP
#undef XL8
#undef XL4
#undef XL2
#undef XL1
#undef XSW
#undef RW_YL1
#undef RW_YL2
#undef RW_YW
#undef RW_NOP
#undef RW_TAIL_F
#undef RW_TAIL_N
#undef RW_FETCH
        }
        RW_BAR();
    }
    if (isld && !dry) RW_STORE_Y(NCH - 1);
    asm volatile("s_waitcnt vmcnt(0) lgkmcnt(0)\n\ts_barrier" ::: "memory");
#undef RW_STORE_Y
#undef RW_ISSUE
#undef RW_CONVERT
#undef RW_BAR
}

__device__ __forceinline__ int crow(int r, int hi) { return (r & 3) + 8 * (r >> 2) + 4 * hi; }
__device__ __forceinline__ void glds16(const void* gsrc, unsigned lds_dst) { unsigned keep;
    asm volatile("s_mov_b32 %0, m0\n\ts_mov_b32 m0, %2\n\ts_nop 0\n\tglobal_load_lds_dwordx4 %1, off\n\ts_mov_b32 m0, %0" : "=&s"(keep) : "v"(gsrc), "s"(lds_dst) : "memory"); }
__device__ __forceinline__ void glds4(const void* gsrc, unsigned lds_dst) { unsigned keep;
    asm volatile("s_mov_b32 %0, m0\n\ts_mov_b32 m0, %2\n\ts_nop 0\n\tglobal_load_lds_dword %1, off\n\ts_mov_b32 m0, %0" : "=&s"(keep) : "v"(gsrc), "s"(lds_dst) : "memory"); }
typedef LAS const char* lds_cptr;
constexpr int FX_K = 0, FX_V = 16384, FX_WS = 32768, FX_OST = 34816, FX_FLG = 67584, FX_KB = 67840  ;

__device__ __forceinline__ void fx_pv(f32x16* o, int vb, bf16x8 pa0, bf16x8 pa1, bf16x8 pa2, bf16x8 pa3) {
#pragma unroll
    for (int d0 = 0; d0 < 2; ++d0) { s16x4 lo[4], hi[4];
#pragma unroll
        for (int ks = 0; ks < 4; ++ks) {
            asm volatile("ds_read_b64_tr_b16 %0,%1 offset:%c2" : "=&v"(lo[ks]) : "v"(vb), "i"(d0 * 4096 + ks * 1024) : "memory");
            asm volatile("ds_read_b64_tr_b16 %0,%1 offset:%c2" : "=&v"(hi[ks]) : "v"(vb), "i"(d0 * 4096 + ks * 1024 + 512) : "memory"); }
        asm volatile("s_waitcnt lgkmcnt(0)" ::: "memory"); __builtin_amdgcn_sched_barrier(0);
#define FX_PK(k) (bf16x8){lo[k][0], lo[k][1], lo[k][2], lo[k][3], hi[k][0], hi[k][1], hi[k][2], hi[k][3]}
        o[d0] = __builtin_amdgcn_mfma_f32_32x32x16_bf16(pa0, FX_PK(0), o[d0], 0, 0, 0);
        o[d0] = __builtin_amdgcn_mfma_f32_32x32x16_bf16(pa1, FX_PK(1), o[d0], 0, 0, 0);
        o[d0] = __builtin_amdgcn_mfma_f32_32x32x16_bf16(pa2, FX_PK(2), o[d0], 0, 0, 0);
        o[d0] = __builtin_amdgcn_mfma_f32_32x32x16_bf16(pa3, FX_PK(3), o[d0], 0, 0, 0);
#undef FX_PK
    }
}
__device__ __forceinline__ float halves_max(float m) { auto rr = __builtin_amdgcn_permlane32_swap(__float_as_uint(m), __float_as_uint(m), false, false); return fmaxf(__uint_as_float(rr[0]), __uint_as_float(rr[1])); }
__device__ __forceinline__ float halves_sum(float m) { auto rr = __builtin_amdgcn_permlane32_swap(__float_as_uint(m), __float_as_uint(m), false, false); return __uint_as_float(rr[0]) + __uint_as_float(rr[1]); }

template <int KIND>
__device__ __forceinline__ void attn_unit(const ArgsL& a, Frame& F, int b, int h, int qb, float bound) {
    const int lane = F.lane, wave = F.wave, r32 = lane & 31, hi = lane >> 5;
    LAS unsigned char* lds = F.lds;
    const bf16_t* QKV = (const bf16_t*)(a.ws + WS_QKV);
    const size_t rowbase = (size_t)b * T;
    const int p0 = qb * 256;
    constexpr int QC = KIND ? 0 : 960, KC = KIND ? 320 : 1280, VC = KIND ? 640 : 1600;
    const bf16_t* Qw = QKV + (rowbase + p0 + wave * 32) * QKV_W + QC + h * 64;
    const bf16_t* Kh = QKV + rowbase * QKV_W + KC + h * 64;
    const bf16_t* Vh = QKV + rowbase * QKV_W + VC + h * 64;
    const float* kbias = (const float*)(a.ws + WS_KB2) + (size_t)(b * FX_H + h) * KBP;
    const unsigned lds0 = (unsigned)(uintptr_t)lds;
    bf16x8 qr[4];
#pragma unroll
    for (int d0 = 0; d0 < 4; ++d0) qr[d0] = *(const bf16x8*)(Qw + (size_t)r32 * QKV_W + d0 * 16 + hi * 8);
    const int qp = p0 + wave * 32 + r32;
    const bool qvalid = (qp >= PADR) && (qp < T);
    const int plast = (p0 + 255) < (T - 1) ? (p0 + 255) : (T - 1);
    const int jlast = plast >> 6, jfirst = PADR >> 6;
    const int jw = (p0 + wave * 32 + 31) >> 6;
    const bf16_t* ksrc = Kh + (size_t)lane * QKV_W + wave * 8;
    const bf16_t* vsrc = Vh + (size_t)(16 * (wave & 3) + (lane >> 2)) * QKV_W + (wave >> 2) * 32 + (lane & 3) * 8;
    const unsigned kdst = lds0 + FX_K + wave * 1024, vdst = lds0 + FX_V + wave * 1024;
#define FX_DMA(j, slot) do { glds16(ksrc + (size_t)(j) * 64 * QKV_W, (unsigned)__builtin_amdgcn_readfirstlane(kdst + (slot) * 8192)); \
                             glds16(vsrc + (size_t)(j) * 64 * QKV_W, (unsigned)__builtin_amdgcn_readfirstlane(vdst + (slot) * 8192)); \
                             if (KIND == 0) glds4(kbias + 64 * (j) + lane, (unsigned)__builtin_amdgcn_readfirstlane(lds0 + FX_KB + (slot) * 2048 + wave * 256)); } while (0)
    const int vb0 = (int)(lds0 + FX_V) + ((lane >> 4) & 1) * 32 + (lane & 3) * 8 + (4 * hi + ((lane & 15) >> 2)) * 64;
    const lds_cptr kp0 = (lds_cptr)lds + FX_K + hi * 1024 + r32 * 16;
    LAS float* wsf = (LAS float*)(lds + FX_WS) + wave * 64;
    LAS float* flg = (LAS float*)(lds + FX_FLG);
    float m_run = KIND ? 0.f : -1.0e30f, l_run = 0.f;
    f32x16 o[2]; o[0] = f32x16{}; o[1] = f32x16{};
    asm volatile("" : "+v"(qr[0]), "+v"(qr[1]), "+v"(qr[2]), "+v"(qr[3]));
    int slot = 0; bool stop = false;
    FX_DMA(jlast, 0);
    for (int j = jlast; j >= jfirst; --j) {
        if (stop) break;
        if (j > jfirst) { FX_DMA(j - 1, slot ^ 1); if (KIND == 0) asm volatile("s_waitcnt vmcnt(3) lgkmcnt(0)\n\ts_barrier" ::: "memory"); else asm volatile("s_waitcnt vmcnt(2) lgkmcnt(0)\n\ts_barrier" ::: "memory"); }
        else asm volatile("s_waitcnt vmcnt(0) lgkmcnt(0)\n\ts_barrier" ::: "memory");
        if (j <= jw) {
            f32x16 s0v = f32x16{}, s1v = f32x16{};
            const lds_cptr kp = kp0 + slot * 8192;
#pragma unroll
            for (int d0 = 0; d0 < 4; ++d0) {
                const bf16x8 b0 = *(const LAS bf16x8*)(kp + d0 * 2048);
                const bf16x8 b1 = *(const LAS bf16x8*)(kp + d0 * 2048 + 512);
                s0v = __builtin_amdgcn_mfma_f32_32x32x16_bf16(b0, qr[d0], s0v, 0, 0, 0);
                s1v = __builtin_amdgcn_mfma_f32_32x32x16_bf16(b1, qr[d0], s1v, 0, 0, 0);
            }
            const bool edge = (64 * j + 63 >= p0 + wave * 32) || (64 * j < PADR);
            if constexpr (KIND == 0) {
                const LAS float* kbj = (const LAS float*)(lds + FX_KB + slot * 2048 + wave * 256) + 4 * hi;
#pragma unroll
                for (int g = 0; g < 4; ++g) { const f32x4 t0 = *(const LAS f32x4*)(kbj + 8 * g), t1 = *(const LAS f32x4*)(kbj + 32 + 8 * g);
                    s0v[4 * g] += t0.x; s0v[4 * g + 1] += t0.y; s0v[4 * g + 2] += t0.z; s0v[4 * g + 3] += t0.w;
                    s1v[4 * g] += t1.x; s1v[4 * g + 1] += t1.y; s1v[4 * g + 2] += t1.z; s1v[4 * g + 3] += t1.w; }
                if (edge) {
#pragma unroll
                    for (int r = 0; r < 16; ++r) { const int key = 64 * j + crow(r, hi);
                        if (key > qp || key < PADR) s0v[r] = -INFINITY;
                        if (key + 32 > qp || key + 32 < PADR) s1v[r] = -INFINITY; }
                }
                float rm = fmaxf(s0v[0], s1v[0]);
#pragma unroll
                for (int r = 1; r < 16; ++r) rm = fmaxf(rm, fmaxf(s0v[r], s1v[r]));
                rm = halves_max(rm);
                const float m_new = fmaxf(m_run, rm);
                const float f = __builtin_amdgcn_exp2f(m_run - m_new);
                m_run = m_new;
                float rs = 0.f;
#pragma unroll
                for (int r = 0; r < 16; ++r) { s0v[r] = __builtin_amdgcn_exp2f(s0v[r] - m_new); s1v[r] = __builtin_amdgcn_exp2f(s1v[r] - m_new); rs += s0v[r] + s1v[r]; }
                rs = halves_sum(rs);
                l_run = l_run * f + rs;
                if (!__all(f == 1.0f)) {
                    if (hi == 0) wsf[r32] = f;
                    LDS_WAIT();
#pragma unroll
                    for (int d_ = 0; d_ < 2; ++d_)
#pragma unroll
                        for (int r = 0; r < 16; ++r) o[d_][r] *= wsf[crow(r, hi)];
                }
            } else {
                f32x16 l0, l1;
#pragma unroll
                for (int r = 0; r < 16; ++r) {
                    const float z0 = s0v[r], z1 = s1v[r];
                    float a0 = -(fmaxf(z0, 0.f) + __builtin_amdgcn_logf(1.f + __builtin_amdgcn_exp2f(-fabsf(z0))));
                    float a1 = -(fmaxf(z1, 0.f) + __builtin_amdgcn_logf(1.f + __builtin_amdgcn_exp2f(-fabsf(z1))));
                    if (edge) { const int key = 64 * j + crow(r, hi);
                        if (key >= qp || key < PADR) { a0 = 0.f; s0v[r] = -INFINITY; }
                        if (key + 32 >= qp || key + 32 < PADR) { a1 = 0.f; s1v[r] = -INFINITY; } }
                    l0[r] = a0; l1[r] = a1;
                }
                float A[8], SA[9], SO[9];
#pragma unroll
                for (int g = 0; g < 4; ++g) { A[g] = (l0[4 * g] + l0[4 * g + 1]) + (l0[4 * g + 2] + l0[4 * g + 3]); A[4 + g] = (l1[4 * g] + l1[4 * g + 1]) + (l1[4 * g + 2] + l1[4 * g + 3]); }
                SA[8] = 0.f; SO[8] = 0.f;
#pragma unroll
                for (int g = 7; g >= 0; --g) SA[g] = A[g] + SA[g + 1];
#pragma unroll
                for (int g = 0; g < 8; ++g) { auto rr = __builtin_amdgcn_permlane32_swap(__float_as_uint(SA[g]), __float_as_uint(SA[g]), false, false); SO[g] = __uint_as_float(hi ? rr[0] : rr[1]); }
                const float R = m_run;
#pragma unroll
                for (int g = 0; g < 8; ++g) {
                    const float E = SA[g + 1] + (hi ? SO[g + 1] : SO[g]) + R;
                    if (g < 4) { float t = E;
                        s0v[4 * g + 3] = __builtin_amdgcn_exp2f(s0v[4 * g + 3] + l0[4 * g + 3] + t); t += l0[4 * g + 3];
                        s0v[4 * g + 2] = __builtin_amdgcn_exp2f(s0v[4 * g + 2] + l0[4 * g + 2] + t); t += l0[4 * g + 2];
                        s0v[4 * g + 1] = __builtin_amdgcn_exp2f(s0v[4 * g + 1] + l0[4 * g + 1] + t); t += l0[4 * g + 1];
                        s0v[4 * g + 0] = __builtin_amdgcn_exp2f(s0v[4 * g + 0] + l0[4 * g + 0] + t);
                    } else { const int q = g - 4; float t = E;
                        s1v[4 * q + 3] = __builtin_amdgcn_exp2f(s1v[4 * q + 3] + l1[4 * q + 3] + t); t += l1[4 * q + 3];
                        s1v[4 * q + 2] = __builtin_amdgcn_exp2f(s1v[4 * q + 2] + l1[4 * q + 2] + t); t += l1[4 * q + 2];
                        s1v[4 * q + 1] = __builtin_amdgcn_exp2f(s1v[4 * q + 1] + l1[4 * q + 1] + t); t += l1[4 * q + 1];
                        s1v[4 * q + 0] = __builtin_amdgcn_exp2f(s1v[4 * q + 0] + l1[4 * q + 0] + t);
                    }
                }
                m_run = R + SA[0] + SO[0];
            }
            u32x4 pw0, pw1, pw2, pw3;
            pw0 = (u32x4){pk2(s0v[0], s0v[1]), pk2(s0v[2], s0v[3]), pk2(s0v[4], s0v[5]), pk2(s0v[6], s0v[7])};
            pw1 = (u32x4){pk2(s0v[8], s0v[9]), pk2(s0v[10], s0v[11]), pk2(s0v[12], s0v[13]), pk2(s0v[14], s0v[15])};
            pw2 = (u32x4){pk2(s1v[0], s1v[1]), pk2(s1v[2], s1v[3]), pk2(s1v[4], s1v[5]), pk2(s1v[6], s1v[7])};
            pw3 = (u32x4){pk2(s1v[8], s1v[9]), pk2(s1v[10], s1v[11]), pk2(s1v[12], s1v[13]), pk2(s1v[14], s1v[15])};
            fx_pv(o, vb0 + slot * 8192, __builtin_bit_cast(bf16x8, pw0), __builtin_bit_cast(bf16x8, pw1), __builtin_bit_cast(bf16x8, pw2), __builtin_bit_cast(bf16x8, pw3));
        }
        float mm = qvalid ? m_run : (KIND ? -3.0e38f : 3.0e38f);
#pragma unroll
        for (int off = 1; off < 64; off <<= 1) { const float t = __shfl_xor(mm, off); mm = KIND ? fmaxf(mm, t) : fminf(mm, t); }
        if (lane == 0) flg[(j & 1) * 8 + wave] = mm;
        asm volatile("s_waitcnt lgkmcnt(0)\n\ts_barrier" ::: "memory");
        if (j > jfirst) {
            const f32x4 fa = *(const LAS f32x4*)(flg + (j & 1) * 8), fb = *(const LAS f32x4*)(flg + (j & 1) * 8 + 4);
            if constexpr (KIND == 0) {
                const float mmin = fminf(fminf(fminf(fa.x, fa.y), fminf(fa.z, fa.w)), fminf(fminf(fb.x, fb.y), fminf(fb.z, fb.w)));
                const float kbmax = *(const LAS float*)(lds + FX_KB + slot * 2048 + wave * 256);
                stop = (bound + kbmax - mmin) < -150.0f;
            } else {
                const float mmax = fmaxf(fmaxf(fmaxf(fa.x, fa.y), fmaxf(fa.z, fa.w)), fmaxf(fmaxf(fb.x, fb.y), fmaxf(fb.z, fb.w)));
                stop = mmax < -150.0f;
            }
        }
        slot ^= 1;
    }
    asm volatile("s_waitcnt vmcnt(0) lgkmcnt(0)\n\ts_barrier" ::: "memory");
    float rli[16];
    if constexpr (KIND == 0) {
        if (hi == 0) wsf[32 + r32] = l_run;
        LDS_WAIT();
#pragma unroll
        for (int r = 0; r < 16; ++r) rli[r] = __builtin_amdgcn_rcpf(wsf[32 + crow(r, hi)]);
    } else {
#pragma unroll
        for (int r = 0; r < 16; ++r) rli[r] = 1.0f;
    }
    bf16_t* Ow = (bf16_t*)(a.ws + WS_YCAT) + (size_t)(KIND ? 1 : 2) * M * RW_W + (rowbase + p0 + wave * 32) * RW_W + h * 64;
    {
        LAS bf16_t* stg = (LAS bf16_t*)(lds + FX_OST) + wave * 2048;
#pragma unroll
        for (int r = 0; r < 16; ++r) { const int orow = crow(r, hi);
#pragma unroll
            for (int d0 = 0; d0 < 2; ++d0) stg[orow * 64 + d0 * 32 + r32] = f2bf(o[d0][r] * rli[r]); }
        LDS_WAIT();
#pragma unroll
        for (int i = 0; i < 4; ++i) { const int row = i * 8 + (lane >> 3), ch = lane & 7; const u32x4 v = *(const LAS u32x4*)(stg + row * 64 + ch * 8);
            const int pr = p0 + wave * 32 + row;
            if (pr >= PADR && pr < T) *(u32x4*)(Ow + (size_t)row * RW_W + ch * 8) = v; }
    }
    asm volatile("s_waitcnt lgkmcnt(0)\n\ts_barrier" ::: "memory");
#undef FX_DMA
}


constexpr int CK = 64, NCK = 257, CKB = 40960;
static_assert(LPADDED == CK * NCK, "padded steps");
__device__ __forceinline__ int swz(int row, int chunk) { return row * 128 + ((chunk ^ (row & 7)) << 4); }
__device__ __forceinline__ void ck_mm(f32x16& acc, LAS unsigned char* A, LAS unsigned char* Bt, int m0, int n0, int r32, int hi) {
#pragma unroll
    for (int ks = 0; ks < 4; ++ks) {
        const bf16x8 av = *(const LAS bf16x8*)(A + swz(m0 + r32, 2 * ks + hi));
        const bf16x8 bv = *(const LAS bf16x8*)(Bt + swz(n0 + r32, 2 * ks + hi));
        acc = __builtin_amdgcn_mfma_f32_32x32x16_bf16(av, bv, acc, 0, 0, 0);
    }
}
__device__ __forceinline__ void ck_store_t(LAS unsigned char* dst, const f32x16& acc, int m0, int n0, int r32, int hi) {
#pragma unroll
    for (int g = 0; g < 4; ++g) { const u32x2 w = {pk2(acc[4 * g], acc[4 * g + 1]), pk2(acc[4 * g + 2], acc[4 * g + 3])};
        *(LAS u32x2*)(dst + swz(n0 + r32, (m0 >> 3) + g) + hi * 8) = w; }
}
constexpr int CA_KAP = 0, CA_BET = 8192, CA_CHI = 16384, CA_RHO = 24576, CA_VMT = 32768, CA_BHT = 40960, CA_KHT = 49152, CA_AK = 57344, CA_RB = 65536, CA_RK = 73728,
              CA_AB = 81920  , CA_RHS = 98304  , CA_G64 = MISC_OFF + 2048  , CA_SCR = MISC_OFF + 4096  ;

#ifndef CA_STAGES
#define CA_STAGES 15
#endif
__device__ __forceinline__ void phase_chunkA(const ArgsL& a, Frame& F, const bool dry = false) {
    const int wave = F.wave;
    LAS unsigned char* L = F.lds;
    u32x4 pre6[6];
    for (int id = F.bx; id < 12 * NCK; id += (int)gridDim.x) {
        int tid = F.tid, lane, r32, hi;
#define CK_FRESH() do { asm volatile("" : "+v"(tid)); lane = tid & 63; r32 = lane & 31; hi = lane >> 5; } while (0)
        CK_FRESH();
        const int bh = id / NCK, c = id - bh * NCK;
        unsigned char* blk = a.ws + WS_RW + ((size_t)bh * LPADDED + (size_t)c * CK) * 768;
        {
            if (id == F.bx) {
#pragma unroll
                for (int q6 = 0; q6 < 6; ++q6) pre6[q6] = *(const u32x4*)(blk + (size_t)(tid + q6 * NTHR) * 16);
            }
#pragma unroll
            for (int q6 = 0; q6 < 6; ++q6) *(LAS u32x4*)(L + CA_AB + (tid + q6 * NTHR) * 16) = pre6[q6];
            __syncthreads();
            const int k = tid & 63, tq = tid >> 6;
            const LAS _Float16* src = (const LAS _Float16*)(L + CA_AB) + (tq * 8) * 384 + k;
            float kk[8], w[8], bb[8], kp[8], rr[8], vv[8];
#pragma unroll
            for (int e = 0; e < 8; ++e) { kk[e] = (float)src[e * 384]; w[e] = 1.f + (float)src[e * 384 + 64]; bb[e] = -(float)src[e * 384 + 128];
                kp[e] = (float)src[e * 384 + 192]; rr[e] = (float)src[e * 384 + 256]; vv[e] = (float)src[e * 384 + 320]; }
            float g[8]; g[0] = w[0];
#pragma unroll
            for (int e = 1; e < 8; ++e) g[e] = g[e - 1] * w[e];
            LAS float* scr = (LAS float*)(L + CA_SCR);
            scr[tq * 64 + k] = g[7];
            __syncthreads();
            {
                const int idn = id + (int)gridDim.x;
                if (idn < 12 * NCK) { const int bhn = idn / NCK, cn = idn - bhn * NCK; const unsigned char* bn_ = a.ws + WS_RW + ((size_t)bhn * LPADDED + (size_t)cn * CK) * 768;
#pragma unroll
                    for (int q6 = 0; q6 < 6; ++q6) pre6[q6] = *(const u32x4*)(bn_ + (size_t)(tid + q6 * NTHR) * 16); }
            }
            float pre = 1.f, tot = 1.f;
#pragma unroll
            for (int q = 0; q < 8; ++q) { const float s = scr[q * 64 + k]; if (q < tq) pre *= s; tot *= s; }
            if (tq == 0) ((LAS float*)(L + CA_G64))[k] = tot;
            unsigned bh4[4], kh4[4], vm4[4];
            float Gp = pre;
#pragma unroll
            for (int e = 0; e < 8; ++e) {
                const int t = tq * 8 + e; const float G = pre * g[e], iG = __builtin_amdgcn_rcpf(G);
                const float kap = kk[e] * Gp, bet = bb[e] * iG, chi = kp[e] * iG, rho = rr[e] * G;
                const int o = swz(t, k >> 3) + (k & 7) * 2;
                *(LAS unsigned short*)(L + CA_KAP + o) = f2bf(kap); *(LAS unsigned short*)(L + CA_BET + o) = f2bf(bet);
                *(LAS unsigned short*)(L + CA_CHI + o) = f2bf(chi); *(LAS unsigned short*)(L + CA_RHO + o) = f2bf(rho);
                ((LAS float*)(L + CA_RHS))[t * 128 + k] = kap;
                const float bhv = bet * tot, khv = chi * tot;
                if (e & 1) { bh4[e >> 1] |= (unsigned)f2bf(bhv) << 16; kh4[e >> 1] |= (unsigned)f2bf(khv) << 16; vm4[e >> 1] |= (unsigned)f2bf(vv[e]) << 16; }
                else { bh4[e >> 1] = f2bf(bhv); kh4[e >> 1] = f2bf(khv); vm4[e >> 1] = f2bf(vv[e]); }
                Gp = G;
            }
            *(LAS u32x4*)(L + CA_BHT + swz(k, tq)) = (u32x4){bh4[0], bh4[1], bh4[2], bh4[3]};
            *(LAS u32x4*)(L + CA_KHT + swz(k, tq)) = (u32x4){kh4[0], kh4[1], kh4[2], kh4[3]};
            *(LAS u32x4*)(L + CA_VMT + swz(k, tq)) = (u32x4){vm4[0], vm4[1], vm4[2], vm4[3]};
        }
        __syncthreads();
        CK_FRESH();
        if (!dry || (CA_STAGES & 2)) {
            const int p = wave & 3, nb = wave >> 2;
            LAS unsigned char* Am = L + ((p & 1) ? CA_CHI : CA_BET);
            LAS unsigned char* Bm = L + ((p & 2) ? CA_RHO : CA_KAP);
#pragma unroll
            for (int mb = 0; mb < 2; ++mb) {
                f32x16 acc = f32x16{};
                if (!(mb == 1 && nb == 0)) ck_mm(acc, Am, Bm, mb * 32, nb * 32, r32, hi);
                const int t = nb * 32 + r32;
#pragma unroll
                for (int i = 0; i < 16; ++i) { const int j = mb * 32 + crow(i, hi); const bool keep = (p & 2) ? (j <= t) : (j < t); if (!keep) acc[i] = 0.f; }
                if (p == 0) {
#pragma unroll
                    for (int gq = 0; gq < 4; ++gq) { LAS float* ab_ = (LAS float*)(L + CA_AB) + t * 64 + (mb * 8 + 2 * gq + hi);
                        ab_[0] = acc[4 * gq]; ab_[16] = acc[4 * gq + 1]; ab_[32] = acc[4 * gq + 2]; ab_[48] = acc[4 * gq + 3]; }
                } else ck_store_t(L + (p == 1 ? CA_AK : p == 2 ? CA_RB : CA_RK), acc, mb * 32, nb * 32, r32, hi);
            }
        }
        __syncthreads();
        CK_FRESH();
        if (wave < 4 && (!dry || (CA_STAGES & 2))) {
            const int mb = wave >> 1, nb = wave & 1;
            f32x16 acc = f32x16{};
            ck_mm(acc, L + CA_AK, L + CA_VMT, mb * 32, nb * 32, r32, hi);
#pragma unroll
            for (int i = 0; i < 16; ++i) ((LAS float*)(L + CA_RHS))[(mb * 32 + crow(i, hi)) * 128 + 64 + nb * 32 + r32] = acc[i];
        }
        __syncthreads();
        CK_FRESH();
        if (!dry || (CA_STAGES & 4)) {
            const int col = tid >> 2, p = tid & 3;
            unsigned abv = (unsigned)(uintptr_t)(L + CA_AB) + p * 64; asm volatile("" : "+v"(abv));
            const LAS float* ab = (const LAS float*)(uintptr_t)abv;
            const LAS float* rhs = (const LAS float*)(L + CA_RHS) + col;
            float xo[16];
#pragma unroll
            for (int i = 0; i < 16; ++i) xo[i] = 0.f;
#pragma unroll
            for (int tg = 0; tg < 64; tg += 4) {
                f32x4 av[4][4]; float rv[4];
#pragma unroll
                for (int r = 0; r < 4; ++r) { rv[r] = rhs[(tg + r) * 128];
#pragma unroll
                    for (int i4 = 0; i4 < (tg + r + 15) / 16; ++i4) av[r][i4] = *(const LAS f32x4*)(ab + (tg + r) * 64 + 4 * i4); }
#pragma unroll
                for (int r = 0; r < 4; ++r) { const int t = tg + r;
                    float s0 = (p == 0) ? rv[r] : 0.f, s1 = 0.f;
#pragma unroll
                    for (int i4 = 0; i4 < (t + 15) / 16; ++i4) {
                        s0 -= av[r][i4].x * xo[4 * i4]; s1 -= av[r][i4].y * xo[4 * i4 + 1]; s0 -= av[r][i4].z * xo[4 * i4 + 2]; s1 -= av[r][i4].w * xo[4 * i4 + 3]; }
                    float sx = s0 + s1;
                    sx += dpp_f<0xB1>(sx);
                    sx += dpp_f<0x4E>(sx);
                    if ((t & 3) == p) xo[t >> 2] = sx;
                    asm volatile("" : "+v"(xo[t >> 2]));
                }
                __builtin_amdgcn_sched_barrier(0);
            }
            LAS unsigned char* dst = L + (col < 64 ? CA_KAP : CA_BET);
            const int rowc = col & 63;
#pragma unroll
            for (int i = 0; i < 16; ++i) { const int tt = 4 * i + p; *(LAS unsigned short*)(dst + swz(rowc, tt >> 3) + (tt & 7) * 2) = f2bf(-xo[i]); }
        }
        __syncthreads();
        CK_FRESH();
        if (!dry || (CA_STAGES & 8)) {
            const int ty = wave >> 1;
            LAS unsigned char* nW1 = L + CA_KAP; LAS unsigned char* nW2 = L + CA_BET;
#pragma unroll
            for (int qq = 0; qq < 2; ++qq) {
                const int q = (wave & 1) * 2 + qq, qa = q >> 1, qb = q & 1;
                f32x16 acc = f32x16{};
                if (ty == 0) {
                    const int t = qa * 32 + r32;
#pragma unroll
                    for (int gq = 0; gq < 4; ++gq) { const u32x2 rv = *(const LAS u32x2*)(L + CA_RHO + swz(t, qb * 4 + gq) + hi * 8);
                        acc[4 * gq] = bf_lo(rv.x); acc[4 * gq + 1] = bf_hi(rv.x); acc[4 * gq + 2] = bf_lo(rv.y); acc[4 * gq + 3] = bf_hi(rv.y); }
                    ck_mm(acc, nW1, L + CA_RB, qb * 32, qa * 32, r32, hi);
                } else if (ty == 1) {
                    ck_mm(acc, nW1, L + CA_BHT, qb * 32, qa * 32, r32, hi);
                    if (qa == qb) { const float g64 = ((const LAS float*)(L + CA_G64))[qa * 32 + r32];
#pragma unroll
                        for (int i = 0; i < 16; ++i) if (crow(i, hi) == r32) acc[i] += g64; }
                } else if (ty == 2) {
                    ck_mm(acc, L + CA_KHT, L + CA_VMT, qb * 32, qa * 32, r32, hi);
                    ck_mm(acc, L + CA_BHT, nW2, qb * 32, qa * 32, r32, hi);
                } else {
                    ck_mm(acc, L + CA_RK, L + CA_VMT, qb * 32, qa * 32, r32, hi);
                    ck_mm(acc, L + CA_RB, nW2, qb * 32, qa * 32, r32, hi);
                }
                if (dry) { float sink = acc[0] + acc[5] + acc[10] + acc[15]; asm volatile("" :: "v"(sink)); }
                else if (ty < 2) {
                    unsigned char* o = blk + (ty == 0 ? 8192 : 0) + (size_t)(((qa * 2 + qb) * 2) * 1024) + lane * 16;
#pragma unroll
                    for (int ks = 0; ks < 2; ++ks)
                        *(u32x4*)(o + ks * 1024) = (u32x4){pk2(acc[8 * ks], acc[8 * ks + 1]), pk2(acc[8 * ks + 2], acc[8 * ks + 3]), pk2(acc[8 * ks + 4], acc[8 * ks + 5]), pk2(acc[8 * ks + 6], acc[8 * ks + 7])};
                } else if (ty == 2) {
                    unsigned char* o = blk + 16384 + (qa * 2 + qb) * 4096 + lane * 16;
#pragma unroll
                    for (int g = 0; g < 4; ++g) *(f32x4*)(o + g * 1024) = (f32x4){acc[4 * g], acc[4 * g + 1], acc[4 * g + 2], acc[4 * g + 3]};
                } else {
                    unsigned char* o = blk + 32768 + (qa * 2 + qb) * 2048 + lane * 8;
#pragma unroll
                    for (int g = 0; g < 4; ++g) *(u32x2*)(o + g * 512) = (u32x2){pk2(acc[4 * g], acc[4 * g + 1]), pk2(acc[4 * g + 2], acc[4 * g + 3])};
                }
            }
        }
        __syncthreads();
    }
}

__device__ __forceinline__ void rwkv_chunkB(const ArgsL& a, Frame& F, int bh) {
    const int lane = F.lane, wave = F.wave, r32 = lane & 31, hi = lane >> 5;
    const int b = bh / RW_H, h = bh % RW_H;
    LAS unsigned char* L = F.lds;
    const unsigned char* base = a.ws + WS_RW + (size_t)bh * LPADDED * 768;
    bf16_t* y0 = (bf16_t*)(a.ws + WS_YCAT);
    const bool isld = (wave >= 2 && wave < 7); const int lw = wave - 2;
    LAS unsigned char* yimg0 = L + 3 * CKB; LAS unsigned char* yimg1 = L + MISC_OFF + 8192;
#define CB_ISSUE(cc) do { const unsigned char* s_ = base + (size_t)(cc) * CK * 768 + (size_t)lw * 1024 + lane * 16; LAS unsigned char* d_ = L + ((cc) % 3) * CKB + lw * 1024; \
        _Pragma("unroll") for (int r_ = 0; r_ < 8; ++r_) __builtin_amdgcn_global_load_lds((const unsigned*)(s_ + r_ * 5120), (LAS unsigned*)(d_ + r_ * 5120), 16, 0, 0); } while (0)
#define CB_YOUT(cc) do { const LAS unsigned char* im_ = ((cc) & 1) ? yimg1 : yimg0; \
        _Pragma("unroll") for (int r_ = 0; r_ < 8; ++r_) { const int t_ = r_ * 8 + (lane >> 3), l_ = (cc) * CK + t_; const u32x4 v_ = *(const LAS u32x4*)(im_ + t_ * 128 + (lane & 7) * 16); \
            if (l_ < LTOK) *(u32x4*)(y0 + (size_t)(b * T + PADR + l_) * RW_W + h * 64 + (lane & 7) * 8) = v_; } } while (0)
    if (isld) { CB_ISSUE(0); CB_ISSUE(1); asm volatile("s_waitcnt vmcnt(8)" ::: "memory"); }
    asm volatile("s_waitcnt lgkmcnt(0)\n\ts_barrier" ::: "memory");
    f32x16 Z0 = f32x16{}, Z1 = f32x16{};
    for (int c = 0; c < NCK; ++c) {
        if (isld) {
            if (c + 2 < NCK) CB_ISSUE(c + 2);
            if (c + 2 < NCK) asm volatile("s_waitcnt vmcnt(8)" ::: "memory"); else asm volatile("s_waitcnt vmcnt(0)" ::: "memory");
        } else if (wave == 7) {
            if (c > 0) CB_YOUT(c - 1);
        } else if (wave < 2) {
            const LAS unsigned char* S = L + (c % 3) * CKB;
            LAS unsigned char* yim = (c & 1) ? yimg1 : yimg0;
            const int vb = wave;
            bf16x8 zf[2][2];
#pragma unroll
            for (int ks = 0; ks < 2; ++ks) {
                zf[0][ks] = __builtin_bit_cast(bf16x8, (u32x4){pk2(Z0[8 * ks], Z0[8 * ks + 1]), pk2(Z0[8 * ks + 2], Z0[8 * ks + 3]), pk2(Z0[8 * ks + 4], Z0[8 * ks + 5]), pk2(Z0[8 * ks + 6], Z0[8 * ks + 7])});
                zf[1][ks] = __builtin_bit_cast(bf16x8, (u32x4){pk2(Z1[8 * ks], Z1[8 * ks + 1]), pk2(Z1[8 * ks + 2], Z1[8 * ks + 3]), pk2(Z1[8 * ks + 4], Z1[8 * ks + 5]), pk2(Z1[8 * ks + 6], Z1[8 * ks + 7])});
            }
#pragma unroll
            for (int tb = 0; tb < 2; ++tb) {
                f32x16 acc;
                const LAS unsigned char* yt = S + 32768 + (vb * 2 + tb) * 2048 + lane * 8;
#pragma unroll
                for (int g = 0; g < 4; ++g) { const u32x2 w = *(const LAS u32x2*)(yt + g * 512); acc[4 * g] = bf_lo(w.x); acc[4 * g + 1] = bf_hi(w.x); acc[4 * g + 2] = bf_lo(w.y); acc[4 * g + 3] = bf_hi(w.y); }
#pragma unroll
                for (int kb2 = 0; kb2 < 2; ++kb2)
#pragma unroll
                    for (int ks = 0; ks < 2; ++ks) { const bf16x8 pa = *(const LAS bf16x8*)(S + 8192 + ((tb * 2 + kb2) * 2 + ks) * 1024 + lane * 16);
                        acc = __builtin_amdgcn_mfma_f32_32x32x16_bf16(pa, zf[kb2][ks], acc, 0, 0, 0); }
#pragma unroll
                for (int i = 0; i < 16; ++i) *(LAS unsigned short*)(yim + (tb * 32 + crow(i, hi)) * 128 + (vb * 32 + r32) * 2) = f2bf(acc[i]);
            }
            f32x16 N0, N1;
            { const LAS unsigned char* n0 = S + 16384 + (vb * 2 + 0) * 4096 + lane * 16; const LAS unsigned char* n1 = S + 16384 + (vb * 2 + 1) * 4096 + lane * 16;
#pragma unroll
              for (int g = 0; g < 4; ++g) { const f32x4 u0 = *(const LAS f32x4*)(n0 + g * 1024), u1 = *(const LAS f32x4*)(n1 + g * 1024);
                  N0[4 * g] = u0.x; N0[4 * g + 1] = u0.y; N0[4 * g + 2] = u0.z; N0[4 * g + 3] = u0.w; N1[4 * g] = u1.x; N1[4 * g + 1] = u1.y; N1[4 * g + 2] = u1.z; N1[4 * g + 3] = u1.w; } }
#pragma unroll
            for (int kb2 = 0; kb2 < 2; ++kb2)
#pragma unroll
                for (int ks = 0; ks < 2; ++ks) {
                    const bf16x8 m0 = *(const LAS bf16x8*)(S + ((0 * 2 + kb2) * 2 + ks) * 1024 + lane * 16);
                    const bf16x8 m1 = *(const LAS bf16x8*)(S + ((1 * 2 + kb2) * 2 + ks) * 1024 + lane * 16);
                    N0 = __builtin_amdgcn_mfma_f32_32x32x16_bf16(m0, zf[kb2][ks], N0, 0, 0, 0);
                    N1 = __builtin_amdgcn_mfma_f32_32x32x16_bf16(m1, zf[kb2][ks], N1, 0, 0, 0);
                }
            Z0 = N0; Z1 = N1;
        }
        asm volatile("s_waitcnt lgkmcnt(0)\n\ts_barrier" ::: "memory");
    }
    if (wave == 7) CB_YOUT(NCK - 1);
    asm volatile("s_waitcnt vmcnt(0) lgkmcnt(0)\n\ts_barrier" ::: "memory");
#undef CB_ISSUE
#undef CB_YOUT
}

constexpr int N_FX_UNITS = 65 * 10, N_SB_UNITS = 65 * 10, N_RW_WG = 192;
#ifndef REP_SCAN
#define REP_SCAN 1
#endif
#ifndef REP_SCAN_DRY
#define REP_SCAN_DRY 0
#endif
#ifndef REP_FOX
#define REP_FOX 1
#endif
#ifndef REP_SB
#define REP_SB 1
#endif
__device__ __forceinline__ void phase_mix(const ArgsL& a, Frame& F, int layer) {
#ifdef SEQ_SCAN
    if (F.bx < N_RW_WG) { int nr = REP_SCAN; asm volatile("" : "+s"(nr)); for (int r = 0; r < nr; ++r) rwkv_scan(a, F, F.bx, (r + 1 < nr) ? REP_SCAN_DRY : 0); }
#else
#ifndef REP_CHB
#define REP_CHB 1
#endif
    if (F.bx < 12) { int nr = REP_CHB; asm volatile("" : "+s"(nr)); for (int r = 0; r < nr; ++r) rwkv_chunkB(a, F, F.bx); }
#endif
    float gqm = fabsf(a.in(I_QG)[layer * 64 + F.lane]), gkm = fabsf(a.in(I_KG)[layer * 64 + F.lane]);
#pragma unroll
    for (int off = 1; off < 64; off <<= 1) { gqm = fmaxf(gqm, __shfl_xor(gqm, off)); gkm = fmaxf(gkm, __shfl_xor(gkm, off)); }
    const float bound = 64.0f * C2 * gqm * gkm * 1.02f + 0.5f;
    unsigned* head = (unsigned*)(a.ws + WS_CTL) + CW_QUEUE + 64 * layer;
    for (;;) {
        if (F.tid == 0) F.MISC[16] = __hip_atomic_fetch_add(head, 1u, __ATOMIC_RELAXED, __HIP_MEMORY_SCOPE_AGENT);
        __syncthreads();
        const int u = (int)F.MISC[16];
        __syncthreads();
        if (u >= N_FX_UNITS + N_SB_UNITS) break;
        if (u < N_FX_UNITS) { const int qb = 64 - u / 10, bh = u % 10; int nr = REP_FOX; asm volatile("" : "+s"(nr)); for (int r = 0; r < nr; ++r) attn_unit<0>(a, F, bh / FX_H, bh % FX_H, qb, bound); }
        else { const int v = u - N_FX_UNITS; const int qb = 64 - v / 10, bh = v % 10; int nr = REP_SB; asm volatile("" : "+s"(nr)); for (int r = 0; r < nr; ++r) attn_unit<1>(a, F, bh / SB_H, bh % SB_H, qb, bound); }
    }
}

__device__ __forceinline__ void phase_post(const ArgsL& a, Frame& F, int layer, const bool dry = false) {
    const int gw = F.bx * NWAVES + F.wave, NGW = gridDim.x * NWAVES, lane = F.lane;
    bf16_t* Y0 = (bf16_t*)(a.ws + WS_YCAT); const bf16_t* BN = (const bf16_t*)(a.ws + WS_BN);
    float lg[6], lb[6];
    { const float* g = a.in(I_LNG) + layer * RW_W + lane; const float* bb = a.in(I_LNB) + layer * RW_W + lane;
#pragma unroll
      for (int hh = 0; hh < 6; ++hh) { lg[hh] = g[hh * 64]; lb[hh] = bb[hh * 64]; } }
    unsigned short yv[6], bv[6], yn[6], bn[6];
    int m = gw;
    if (m < M) {
#pragma unroll
        for (int hh = 0; hh < 6; ++hh) { yv[hh] = Y0[(size_t)m * RW_W + hh * 64 + lane]; bv[hh] = BN[(size_t)m * RW_W + hh * 64 + lane]; }
    }
    for (; m < M; m += NGW) {
        const int mn = m + NGW;
        if (mn < M) {
#pragma unroll
            for (int hh = 0; hh < 6; ++hh) { yn[hh] = Y0[(size_t)mn * RW_W + hh * 64 + lane]; bn[hh] = BN[(size_t)mn * RW_W + hh * 64 + lane]; }
        }
        const int b = m / T, p = m - b * T;
        bf16_t* yp = Y0 + (size_t)m * RW_W + lane;
        if (p < PADR) {
            if (!dry) {
#pragma unroll
            for (int hh = 0; hh < 6; ++hh) yp[hh * 64] = 0; }
        } else {
#pragma unroll
            for (int hh = 0; hh < 6; ++hh) {
                const float y = bf2f(yv[hh]);
                const float mean = wave_sum(y) * (1.f / 64.f);
                const float d = y - mean;
                const float var = wave_sum(d * d) * (1.f / 64.f);
                const unsigned short r_ = f2bf(d * (1.0f / sqrtf(var + 64e-5f)) * lg[hh] + lb[hh] + bf2f(bv[hh])); if (!dry) yp[hh * 64] = r_; else asm volatile("" :: "v"(r_));
            }
        }
#pragma unroll
        for (int hh = 0; hh < 6; ++hh) { yv[hh] = yn[hh]; bv[hh] = bn[hh]; }
    }
    if (!dry) for (int it = gw; it < 2 * M; it += NGW) {
        const int sl = it / M, m2 = it - sl * M; const int b = m2 / T, p = m2 - b * T;
        bf16_t* row = Y0 + (size_t)(sl + 1) * M * RW_W + (size_t)m2 * RW_W;
        if (p < PADR) { for (int c = lane; c < RW_W / 2; c += 64) ((unsigned*)row)[c] = 0u; }
        else if (lane < 32) ((unsigned*)(row + 320))[lane] = 0u;
    }
}

struct EpiInproj { static constexpr bool PERM = true, AFTER_DRAIN = false; bf16_t* ush; bf16_t* qkv;
    __device__ __forceinline__ void operator()(const f32x4 (&acc)[2][2][4][2], const pg8::Unit& u, int wr, int wc, int fr, int fq) const {
        asm volatile("" : "+v"(fr), "+v"(fq));
        const int row0 = u.pm * 256 + wr * 64 + fr, colt = u.pn * 256 + wc * 32 + 8 * fq;
#pragma unroll
        for (int ai = 0; ai < 2; ++ai)
#pragma unroll
            for (int m = 0; m < 4; ++m) { const size_t row = (size_t)(row0 + ai * 128 + m * 16);
#pragma unroll
                for (int bj = 0; bj < 2; ++bj) { const int col = colt + bj * 128; const f32x4 v0 = acc[ai][bj][m][0], v1 = acc[ai][bj][m][1];
                    const float sc = (col >= SHIFT_W && col < SHIFT_W + 320) ? C2 : 1.0f;
                    u32x4 w; w.x = pk2(v0[0] * sc, v0[1] * sc); w.y = pk2(v0[2] * sc, v0[3] * sc); w.z = pk2(v1[0] * sc, v1[1] * sc); w.w = pk2(v1[2] * sc, v1[3] * sc);
                    if (col < SHIFT_W) *(u32x4*)(ush + row * SHIFT_W + col) = w;
                    else if (col < SHIFT_W + QKV_W) *(u32x4*)(qkv + row * QKV_W + (col - SHIFT_W)) = w; } }
    }
};
struct EpiGates { static constexpr bool PERM = true, AFTER_DRAIN = false; bf16_t* gates;
    __device__ __forceinline__ void operator()(const f32x4 (&acc)[2][2][4][2], const pg8::Unit& u, int wr, int wc, int fr, int fq) const {
        asm volatile("" : "+v"(fr), "+v"(fq));
        const int row0 = u.pm * 256 + wr * 64 + fr, colt = u.pn * 256 + wc * 32 + 8 * fq;
#pragma unroll
        for (int ai = 0; ai < 2; ++ai)
#pragma unroll
            for (int m = 0; m < 4; ++m) { const size_t row = (size_t)(row0 + ai * 128 + m * 16);
#pragma unroll
                for (int bj = 0; bj < 2; ++bj) { const int col = colt + bj * 128; f32x4 v0 = acc[ai][bj][m][0], v1 = acc[ai][bj][m][1];
#pragma unroll
                    for (int q = 0; q < 4; ++q) { v0[q] = __builtin_amdgcn_rcpf(1.f + __builtin_amdgcn_exp2f(-v0[q] * LOG2E)); v1[q] = __builtin_amdgcn_rcpf(1.f + __builtin_amdgcn_exp2f(-v1[q] * LOG2E)); }
                    u32x4 w; w.x = pk2(v0[0], v0[1]); w.y = pk2(v0[2], v0[3]); w.z = pk2(v1[0], v1[1]); w.w = pk2(v1[2], v1[3]);
                    *(u32x4*)(gates + row * 3072 + col) = w; } }
    }
};
struct EpiMerge { static constexpr bool PERM = true, AFTER_DRAIN = false; const bf16_t* gates; bf16_t* merged;
    __device__ __forceinline__ void operator()(const f32x4 (&acc)[2][2][4][2], const pg8::Unit& u, int wr, int wc, int fr, int fq) const {
        asm volatile("" : "+v"(fr), "+v"(fq));
        const int br = u.pn >> 2, pn = u.pn & 3, pm = u.pm - br * 129;
        const int row0 = pm * 256 + wr * 64 + fr, colt = pn * 256 + wc * 32 + 8 * fq;
        u32x4 gn[2], on[2];
#define MRG_LOAD(q) do { const size_t row_ = (size_t)(row0 + ((q) >> 2) * 128 + ((q) & 3) * 16); \
            _Pragma("unroll") for (int bj = 0; bj < 2; ++bj) { const int col_ = colt + bj * 128; gn[bj] = *(const u32x4*)(gates + row_ * 3072 + br * 1024 + col_); \
                on[bj] = (u32x4){0u, 0u, 0u, 0u}; if (br > 0) on[bj] = *(const u32x4*)(merged + row_ * D + col_); } } while (0)
        MRG_LOAD(0);
#pragma unroll
        for (int q = 0; q < 8; ++q) {
            const int ai = q >> 2, m = q & 3; const size_t row = (size_t)(row0 + ai * 128 + m * 16);
            u32x4 g[2], o[2];
#pragma unroll
            for (int bj = 0; bj < 2; ++bj) { g[bj] = gn[bj]; o[bj] = on[bj]; }
            if (q < 7) MRG_LOAD(q + 1);
#pragma unroll
            for (int bj = 0; bj < 2; ++bj) { const int col = colt + bj * 128; const f32x4 v0 = acc[ai][bj][m][0], v1 = acc[ai][bj][m][1];
                u32x4 w;
                w.x = pk2(bf_lo(g[bj].x) * v0[0] + bf_lo(o[bj].x), bf_hi(g[bj].x) * v0[1] + bf_hi(o[bj].x));
                w.y = pk2(bf_lo(g[bj].y) * v0[2] + bf_lo(o[bj].y), bf_hi(g[bj].y) * v0[3] + bf_hi(o[bj].y));
                w.z = pk2(bf_lo(g[bj].z) * v1[0] + bf_lo(o[bj].z), bf_hi(g[bj].z) * v1[1] + bf_hi(o[bj].z));
                w.w = pk2(bf_lo(g[bj].w) * v1[2] + bf_lo(o[bj].w), bf_hi(g[bj].w) * v1[3] + bf_hi(o[bj].w));
                *(u32x4*)(merged + row * D + col) = w; }
            __builtin_amdgcn_sched_barrier(0);
        }
#undef MRG_LOAD
    }
};
struct MergeOrder { int G, c, ntau;
    __device__ __forceinline__ bool next(int i, pg8::Unit& u) const { const int it = i / 3, br = i - 3 * it; const long tau = (long)it * G + c; if (tau >= ntau) return false;
        const int t = (int)(tau % 516); u.pm = br * 129 + (t >> 2); u.pn = br * 4 + (t & 3); return true; }
    __device__ __forceinline__ void a_ready(const pg8::Unit&) const {}
    __device__ __forceinline__ void done(const pg8::Unit&) const {}
};
struct EpiOut { static constexpr bool PERM = true, AFTER_DRAIN = false; ArgsL a;
    __device__ __forceinline__ void operator()(const f32x4 (&acc)[2][2][4][2], const pg8::Unit& u, int wr, int wc, int fr, int fq) const {
        asm volatile("" : "+v"(fr), "+v"(fq));
        const int row0 = u.pm * 256 + wr * 64 + fr, colt = u.pn * 256 + wc * 32 + 8 * fq;
        f32x4 hn[4]; float* hpn = nullptr;
#define OUT_LOAD(q) do { const int row_ = row0 + ((q) >> 2) * 128 + ((q) & 3) * 16; const int b_ = row_ / T, l_ = row_ - b_ * T - PADR; hpn = nullptr; \
            if (l_ >= 0) { hpn = hrow(a, b_, l_) + colt; hn[0] = *(const f32x4*)(hpn); hn[1] = *(const f32x4*)(hpn + 4); hn[2] = *(const f32x4*)(hpn + 128); hn[3] = *(const f32x4*)(hpn + 132); } } while (0)
        OUT_LOAD(0);
#pragma unroll
        for (int q = 0; q < 8; ++q) {
            const int ai = q >> 2, m = q & 3;
            float* hp = hpn; f32x4 h0 = hn[0], h1 = hn[1], h2 = hn[2], h3 = hn[3];
            if (q < 7) OUT_LOAD(q + 1);
            if (hp) { *(f32x4*)(hp) = h0 + acc[ai][0][m][0]; *(f32x4*)(hp + 4) = h1 + acc[ai][0][m][1]; *(f32x4*)(hp + 128) = h2 + acc[ai][1][m][0]; *(f32x4*)(hp + 132) = h3 + acc[ai][1][m][1]; }
            __builtin_amdgcn_sched_barrier(0);
        }
#undef OUT_LOAD
    }
};
struct MoeOrder { const volatile LAS int* tb; int ntile, npt, G, c, rep;
    __device__ __forceinline__ bool next(int i, pg8::Unit& u) const { long L = (long)i * G + c; if (L >= (long)ntile * npt * rep) return false; L %= (long)ntile * npt;
        const int tau = (int)(L / npt), j = (int)(L - (long)tau * npt); int e = 0;
#pragma unroll
        for (int k = 1; k < 16; ++k) e += (tau >= tb[k]) ? 1 : 0;
        u.pm = tau; u.pn = __builtin_amdgcn_readfirstlane(e) * npt + j; return true; }
    __device__ __forceinline__ void a_ready(const pg8::Unit&) const {}
    __device__ __forceinline__ void done(const pg8::Unit&) const {}
};
struct EpiMoeUp { static constexpr bool PERM = true, AFTER_DRAIN = false; bf16_t* hs;
    __device__ __forceinline__ void operator()(const f32x4 (&acc)[2][2][4][2], const pg8::Unit& u, int wr, int wc, int fr, int fq) const {
        asm volatile("" : "+v"(fr), "+v"(fq));
        const int row0 = u.pm * 256 + wr * 64 + fr, col = (u.pn & 1) * 128 + wc * 32 + 8 * fq;
#pragma unroll
        for (int ai = 0; ai < 2; ++ai)
#pragma unroll
            for (int m = 0; m < 4; ++m) { const size_t row = (size_t)(row0 + ai * 128 + m * 16); float r[8];
#pragma unroll
                for (int n = 0; n < 2; ++n)
#pragma unroll
                    for (int q = 0; q < 4; ++q) { const float gte = acc[ai][0][m][n][q], up = acc[ai][1][m][n][q]; r[4 * n + q] = gte * __builtin_amdgcn_rcpf(1.f + __builtin_amdgcn_exp2f(-gte * LOG2E)) * up; }
                u32x4 w; w.x = pk2(r[0], r[1]); w.y = pk2(r[2], r[3]); w.z = pk2(r[4], r[5]); w.w = pk2(r[6], r[7]);
                *(u32x4*)(hs + row * DEXP + col) = w; }
    }
};
struct EpiMoeDown { static constexpr bool PERM = true, AFTER_DRAIN = false; bf16_t* y; const float* cws;
    __device__ __forceinline__ void operator()(const f32x4 (&acc)[2][2][4][2], const pg8::Unit& u, int wr, int wc, int fr, int fq) const {
        asm volatile("" : "+v"(fr), "+v"(fq));
        const int row0 = u.pm * 256 + wr * 64 + fr, colt = (u.pn & 3) * 256 + wc * 32 + 8 * fq;
        float cw[8];
#pragma unroll
        for (int q = 0; q < 8; ++q) cw[q] = cws[row0 + (q >> 2) * 128 + (q & 3) * 16];
#pragma unroll
        for (int ai = 0; ai < 2; ++ai)
#pragma unroll
            for (int m = 0; m < 4; ++m) { const size_t row = (size_t)(row0 + ai * 128 + m * 16); const float cwv = cw[ai * 4 + m];
#pragma unroll
                for (int bj = 0; bj < 2; ++bj) { const int col = colt + bj * 128; const f32x4 v0 = acc[ai][bj][m][0] * cwv, v1 = acc[ai][bj][m][1] * cwv;
                    u32x4 w; w.x = pk2(v0[0], v0[1]); w.y = pk2(v0[2], v0[3]); w.z = pk2(v1[0], v1[1]); w.w = pk2(v1[2], v1[3]);
                    *(u32x4*)(y + row * D + col) = w; } }
    }
};

#ifndef PH_MASK
#define PH_MASK 0xFFFF
#endif
#define PH(k) ((PH_MASK >> (k)) & 1)
#ifndef PROBE_DUP
#define PROBE_DUP 0
#endif
#define DUPN(bit) (((PROBE_DUP >> (bit)) & 1) ? 2 : 1)
#ifndef PROBE_THIN
#define PROBE_THIN 0
#endif
#define THIN(bit) ((PROBE_THIN >> (bit)) & 1)
#define FRESH() do { asm volatile("" : "+v"(F.tid)); F.lane = F.tid & 63; F.wave = __builtin_amdgcn_readfirstlane(F.tid >> 6); { int bx_ = (int)blockIdx.x; asm volatile("" : "+s"(bx_)); F.bx = bx_; } { unsigned char* w_ = a.ws; asm volatile("" : "+s"(w_)); a.ws = w_; } } while (0)
__global__ void __launch_bounds__(NTHR, 2) hybrid_fwd(Args ka) {
    extern __shared__ __attribute__((aligned(16))) unsigned char lds_raw[];
    Frame F;
    F.lds = (LAS unsigned char*)lds_raw;
    F.MISC = (volatile LAS unsigned*)(F.lds + MISC_OFF);
    F.tid = threadIdx.x; F.lane = F.tid & 63; F.wave = __builtin_amdgcn_readfirstlane(F.tid >> 6); F.bx = (int)blockIdx.x;
    for (int u = F.tid; u < (LDS_BYTES - MISC_OFF) / 4; u += NTHR) ((LAS unsigned*)(F.lds + MISC_OFF))[u] = 0u;
    __syncthreads();
    if (F.tid < 29) { const unsigned long long p = (unsigned long long)ka.in[F.tid]; F.MISC[64 + 2 * F.tid] = (unsigned)p; F.MISC[65 + 2 * F.tid] = (unsigned)(p >> 32); }
    __syncthreads();
    ArgsL a; a.tab = F.MISC + 64; a.out = ka.out; a.ws = ka.ws;
    XcdBarrier bar = xcd_barrier_post((unsigned*)(a.ws + WS_CTL) + CW_BAR, F.MISC + 8);
    const int G = (int)gridDim.x, c = (int)blockIdx.x;
    PG8_LAS unsigned char* ring = (PG8_LAS unsigned char*)F.lds;

#ifdef PROF_K
    volatile LAS unsigned* tsl = F.MISC + 1536; int nts = 0;
    if (blockIdx.x == 0 && F.tid == 0) tsl[nts] = (unsigned)__builtin_amdgcn_s_memrealtime();
    ++nts;
#define BARX() do { xcd_barrier(bar); if (blockIdx.x == 0 && F.tid == 0) tsl[nts] = (unsigned)__builtin_amdgcn_s_memrealtime(); ++nts; } while (0)
#else
#define BARX() xcd_barrier(bar)
#endif
    for (int layer = 0; layer < DEPTH; ++layer) {
        for (int rep = 0; rep < DUPN(8); ++rep) { FRESH(); if (PH(0)) phase_wconv(a, F, layer); }
        __syncthreads();
        if (THIN(0)) { FRESH(); phase_norm<1>(a, F, layer, true); }
        FRESH(); if (PH(1)) phase_norm<1>(a, F, layer);
        BARX();
        FRESH(); if (PH(2)) {
            pg8::Gemm g{(const bf16_t*)(a.ws + WS_A), (const bf16_t*)(a.ws + WS_WIN), M, N1, D}; pg8::StaticOrder S; S.init(M, N1, G, c, DUPN(3));
            EpiInproj E{(bf16_t*)(a.ws + WS_USH), (bf16_t*)(a.ws + WS_QKV)};
            pg8::gemm_phase<EpiInproj, pg8::StaticOrder, true, true>(ring, g, S, E);
        }
        BARX();
        if (THIN(1)) { FRESH(); phase_prep(a, F, layer, true); }
        FRESH(); if (PH(3)) phase_prep(a, F, layer);
        BARX();
#ifndef SEQ_SCAN
        if (THIN(2)) { FRESH(); phase_chunkA(a, F, true); }
        FRESH(); if (PH(4)) phase_chunkA(a, F);
        BARX();
#endif
        FRESH(); if (PH(4)) phase_mix(a, F, layer);
        BARX();
        if (THIN(3)) { FRESH(); phase_post(a, F, layer, true); }
        FRESH(); if (PH(5)) phase_post(a, F, layer);
        FRESH(); if (PH(6)) {
            pg8::Gemm g{(const bf16_t*)(a.ws + WS_A), (const bf16_t*)(a.ws + WS_WG), M, 3072, D}; pg8::StaticOrder S; S.init(M, 3072, G, c, DUPN(4));
            EpiGates E{(bf16_t*)(a.ws + WS_GATES)};
            pg8::gemm_phase<EpiGates, pg8::StaticOrder, true, true>(ring, g, S, E);
        }
        BARX();
        FRESH(); if (PH(7)) {
            int kdim = RW_W; asm volatile("" : "+s"(kdim));
            pg8::Gemm g{(const bf16_t*)(a.ws + WS_YCAT), (const bf16_t*)(a.ws + WS_WP), 3 * M, 3072, kdim}; MergeOrder S{G, c, 516 * DUPN(5)};
            EpiMerge E{(const bf16_t*)(a.ws + WS_GATES), (bf16_t*)(a.ws + WS_MERGED)};
            pg8::gemm_phase<EpiMerge, MergeOrder, false, true>(ring, g, S, E);
        }
        BARX();
        FRESH(); if (PH(8)) {
            pg8::Gemm g{(const bf16_t*)(a.ws + WS_MERGED), (const bf16_t*)(a.ws + WS_WO), M, D, D}; pg8::StaticOrder S; S.init(M, D, G, c, 1);
            EpiOut E{a};
            pg8::gemm_phase<EpiOut, pg8::StaticOrder, true, true>(ring, g, S, E);
        }
        BARX();
        if (THIN(4)) { FRESH(); phase_norm<2>(a, F, layer, true); }
        FRESH(); if (PH(9)) phase_norm<2>(a, F, layer);
        BARX();
        for (int rep = 0; rep < DUPN(7); ++rep) { FRESH(); if (PH(10)) phase_route(a, F, layer); }
        BARX();
        volatile LAS int* tb = (volatile LAS int*)(F.MISC + 32);
        if (F.tid <= 16) { const int* cnt = (const int*)(a.ws + WS_CTL) + CW_ECNT + 64 * layer; int t = 0;
            for (int e = 0; e < F.tid; ++e) t += (__hip_atomic_load(cnt + e, __ATOMIC_RELAXED, __HIP_MEMORY_SCOPE_AGENT) + 255) >> 8;
            tb[F.tid] = t; }
        __syncthreads();
        const int ntile = tb[16];
        FRESH(); if (PH(11)) {
            pg8::Gemm g{(const bf16_t*)(a.ws + WS_AS), (const bf16_t*)(a.ws + WS_WGU), MS, 8192, D}; MoeOrder S{tb, ntile, 2, G, c, DUPN(6)};
            EpiMoeUp E{(bf16_t*)(a.ws + WS_HS)};
            pg8::gemm_phase<EpiMoeUp, MoeOrder, true, true>(ring, g, S, E);
        }
        BARX();
        FRESH(); if (PH(12)) {
            int kdim = DEXP; asm volatile("" : "+s"(kdim));
            pg8::Gemm g{(const bf16_t*)(a.ws + WS_HS), (const bf16_t*)(a.ws + WS_WD), MS, 16384, kdim}; MoeOrder S{tb, ntile, 4, G, c, DUPN(6)};
            EpiMoeDown E{(bf16_t*)(a.ws + WS_Y), (const float*)(a.ws + WS_CWS)};
            pg8::gemm_phase<EpiMoeDown, MoeOrder, true, true>(ring, g, S, E);
        }
        BARX();
    }
    if (THIN(5)) { FRESH(); phase_norm<0>(a, F, DEPTH - 1, true); }
    FRESH(); if (PH(13)) phase_norm<0>(a, F, DEPTH - 1);
#ifdef PROF_K
    BARX();
    if (blockIdx.x == 0) {
        __syncthreads();
        float us;
        if (PROF_K < 0) us = 100.f;
        else if (PROF_K == 12) us = (float)(tsl[25] - tsl[24]) * 0.01f;
        else if (PROF_K == 13) us = (float)(tsl[25] - tsl[0]) * 0.01f;
        else us = ((float)(tsl[1 + PROF_K] - tsl[PROF_K]) + (float)(tsl[13 + PROF_K] - tsl[12 + PROF_K])) * 0.01f;
        us = 4.f * rintf(us * 0.25f);
        for (int i = F.tid; i < 16384; i += NTHR) a.out[i] = us;
    }
#endif
#ifdef CLOCK_PROBE
    if (blockIdx.x == 0 && F.wave == 0) {
        float c0 = 1.f, c1 = 2.f, c2 = 3.f, c3 = 4.f, c4 = 5.f, c5 = 6.f, c6 = 7.f, c7 = 8.f;
        for (int i = 0; i < CLOCK_PROBE; ++i) {
            asm volatile("v_fma_f32 %0, %0, %0, %0\n\tv_fma_f32 %1, %1, %1, %1\n\tv_fma_f32 %2, %2, %2, %2\n\tv_fma_f32 %3, %3, %3, %3\n\tv_fma_f32 %4, %4, %4, %4\n\tv_fma_f32 %5, %5, %5, %5\n\tv_fma_f32 %6, %6, %6, %6\n\tv_fma_f32 %7, %7, %7, %7"
                         : "+v"(c0), "+v"(c1), "+v"(c2), "+v"(c3), "+v"(c4), "+v"(c5), "+v"(c6), "+v"(c7));
        }
        asm volatile("" :: "v"(c0), "v"(c1), "v"(c2), "v"(c3), "v"(c4), "v"(c5), "v"(c6), "v"(c7));
    }
#endif
}

extern "C" void kernel_launch(void* const* d_in, const int* in_sizes, int n_in, void* d_out, int out_size, void* d_ws, size_t ws_size, hipStream_t stream) {
    static int ready = 0;
    if (ready == 0) {
        if (n_in != 29 || out_size != NB * SEQ * D || ws_size < WS_END) { fprintf(stderr, "kernel_launch: unexpected problem shape (n_in %d, out %d, ws %zu < %zu)\n", n_in, out_size, ws_size, (size_t)WS_END); ready = -1; return; }
        if (hipFuncSetAttribute((const void*)hybrid_fwd, hipFuncAttributeMaxDynamicSharedMemorySize, LDS_BYTES) != hipSuccess) { fprintf(stderr, "kernel_launch: hipFuncSetAttribute failed\n"); ready = -1; return; }
        int per_cu = 0;
        if (hipOccupancyMaxActiveBlocksPerMultiprocessor(&per_cu, (const void*)hybrid_fwd, NTHR, LDS_BYTES) != hipSuccess || per_cu < 1) fprintf(stderr, "kernel_launch: occupancy query says %d\n", per_cu);
        (void)hipGetLastError();
        ready = 1;
    }
    if (ready < 0) return;
    (void)in_sizes;
    if (hipMemsetAsync((char*)d_ws + WS_CTL, 0, CTL_ZERO_BYTES, stream) != hipSuccess) return;
    Args a{};
    for (int i = 0; i < 29; ++i) a.in[i] = (const float*)d_in[i];
    a.out = (float*)d_out; a.ws = (unsigned char*)d_ws;
    hipLaunchKernelGGL(hybrid_fwd, dim3(256), dim3(NTHR), LDS_BYTES, stream, a);
}
```

```cpp
#include <hip/hip_runtime.h>
#include <hip/hip_bf16.h>
#include <cstdio>
#include <cstdint>

#define GAS __attribute__((address_space(1)))
#define LAS __attribute__((address_space(3)))

namespace pg8 {
#define PG8_LAS __attribute__((address_space(3)))
typedef unsigned short bf16_t;
typedef short bf16x8 __attribute__((ext_vector_type(8)));
typedef float f32x4 __attribute__((ext_vector_type(4)));
typedef unsigned u32x4 __attribute__((ext_vector_type(4)));
constexpr int BM = 256, BK = 64, HALF = 128, HTB = HALF * BK * 2  , STAGE_BYTES = 8 * HTB, NXCD = 8, WGM = 8;

__host__ __device__ __forceinline__ int lds_byte(int r, int c) { const int st = (r >> 4) * 2 + (c >> 5), rr = r & 15, cc = c & 31, ob = rr * 64 + cc * 2; return st * 1024 + (ob ^ (((ob >> 9) & 1) << 5)); }
__host__ __device__ __forceinline__ void stage_rc(int b, int& R, int& C) { const int st = b / 1024, sb = b % 1024, swz = sb ^ (((sb >> 9) & 1) << 5); R = (st >> 1) * 16 + swz / 64; C = (st & 1) * 32 + (swz % 64) / 2; }
__host__ __device__ __forceinline__ int perm32(int rho) { const int n = rho >> 4, i = rho & 15; return 8 * (i >> 2) + 4 * n + (i & 3); }

struct Unit { int pm, pn; };
struct Gemm { const bf16_t* A; const bf16_t* Bt; int M, N, K; };

struct StaticOrder {
    int nM, nN, nwg, G, c, rep;
    __host__ __device__ void init(int M, int N, int G_, int c_, int rep_ = 1) { nM = M / BM; nN = N / BM; nwg = nM * nN; G = G_; c = c_; rep = rep_; }
    __host__ __device__ bool next(int i, Unit& u) const {
        const long L = (long)i * G + c; if (L >= (long)nwg * rep) return false;
        int wgid = (int)(L % nwg); { const int q = nwg / NXCD, r = nwg % NXCD, xcd = wgid % NXCD, off = wgid / NXCD; wgid = (xcd < r ? xcd * (q + 1) : r * (q + 1) + (xcd - r) * q) + off; }
        const int nig = WGM * nN, gid = wgid / nig, fm = gid * WGM, gsz = (nM - fm) < WGM ? (nM - fm) : WGM;
        u.pm = fm + ((wgid % nig) % gsz); u.pn = (wgid % nig) / gsz; return true;
    }
    __device__ __forceinline__ void a_ready(const Unit&) const {}
    __device__ __forceinline__ void done(const Unit&) const {}
};
__device__ __forceinline__ unsigned cvt_pk_bf16(float lo, float hi) { unsigned r; asm volatile("v_cvt_pk_bf16_f32 %0, %1, %2" : "=v"(r) : "v"(lo), "v"(hi)); return r; }
template <class Epi, class Sched, bool ALIGN_EPI = false, bool SP2 = false>
__device__ __forceinline__ void gemm_phase(PG8_LAS unsigned char* lds, const Gemm g, const Sched& S, const Epi& E) {
    int tid_ = threadIdx.x; asm volatile("" : "+v"(tid_));
    const int tid = tid_, wid = __builtin_amdgcn_readfirstlane(tid >> 6), lane = tid & 63, wr = wid >> 2, wc = wid & 3, fr = lane & 15, fq = lane >> 4;
    const int K = g.K, nt = K / BK;
    unsigned voffA[2], voffB[2];
#pragma unroll
    for (int i = 0; i < 2; ++i) { int R, C; stage_rc(tid * 16 + i * 8192, R, C); const int Rb = Epi::PERM ? ((R & ~31) + perm32(R & 31)) : R;
        voffA[i] = (unsigned)(R * K + C) * 2u; voffB[i] = (unsigned)(Rb * K + C) * 2u; }
    const size_t kstep = (size_t)(BK * 2);
    const size_t hstep = (size_t)HALF * K * 2;
    const size_t tstep = 2 * hstep;
    const unsigned ldsw = (unsigned)wid * 1024u;
    const int aoff = lds_byte(wr * 64 + fr, fq * 8), boff = lds_byte(wc * 32 + fr, fq * 8);
#define PG8_SA(b, h) (((b) * 2 + (h)) * HTB)
#define PG8_SB(b, h) ((4 + (b) * 2 + (h)) * HTB)
#define PG8_STAGE(bufoff, gbase, voff) do { _Pragma("unroll") for (int _i = 0; _i < 2; ++_i) \
        __builtin_amdgcn_global_load_lds((const unsigned*)((const char*)(gbase) + (voff)[_i]), (PG8_LAS unsigned*)(lds + (bufoff) + ldsw + _i * 8192), 16, 0, 0); } while (0)
#define PG8_LDA(dst, b, h) do { _Pragma("unroll") for (int m = 0; m < 4; ++m) _Pragma("unroll") for (int k = 0; k < 2; ++k) dst[m][k] = *(const PG8_LAS bf16x8*)(lds + PG8_SA(b, h) + aoff + m * 2048 + k * 1024); } while (0)
#define PG8_LDB(dst, b, h) do { _Pragma("unroll") for (int n = 0; n < 2; ++n) _Pragma("unroll") for (int k = 0; k < 2; ++k) dst[n][k] = *(const PG8_LAS bf16x8*)(lds + PG8_SB(b, h) + boff + n * 2048 + k * 1024); } while (0)
#define PG8_MMA(ai, bj, At, Bt) do { __builtin_amdgcn_s_setprio(1); _Pragma("unroll") for (int m = 0; m < 4; ++m) _Pragma("unroll") for (int n = 0; n < 2; ++n) _Pragma("unroll") for (int k = 0; k < 2; ++k) \
        acc[ai][bj][m][n] = __builtin_amdgcn_mfma_f32_16x16x32_bf16(Bt[n][k], At[m][k], acc[ai][bj][m][n], 0, 0, 0); __builtin_amdgcn_s_setprio(0); } while (0)
#define PG8_WAIT_V(n) asm volatile("s_waitcnt vmcnt(" #n ")" ::: "memory")
#define PG8_WAIT_L(n) asm volatile("s_waitcnt lgkmcnt(" #n ")" ::: "memory")
#define PG8_BAR __builtin_amdgcn_s_barrier()
#define PG8_SCHED __builtin_amdgcn_sched_barrier(0)
    Unit cur, nxt; int ui = 0;
    if (!S.next(0, cur)) return;
    f32x4 acc[2][2][4][2];
#pragma unroll
    for (int a = 0; a < 2; ++a)
#pragma unroll
        for (int b = 0; b < 2; ++b)
#pragma unroll
            for (int m = 0; m < 4; ++m)
#pragma unroll
                for (int n = 0; n < 2; ++n) acc[a][b][m][n] = (f32x4){0.f, 0.f, 0.f, 0.f};
    bf16x8 At[4][2], B0[2][2], B1[2][2];
    const char* cA = (const char*)g.A + (size_t)cur.pm * tstep; const char* cB = (const char*)g.Bt + (size_t)cur.pn * tstep;
    S.a_ready(cur);
    if constexpr (SP2) {
        PG8_STAGE(PG8_SB(0, 0), cB, voffB); PG8_STAGE(PG8_SB(0, 1), cB + hstep, voffB); PG8_STAGE(PG8_SA(0, 0), cA, voffA); PG8_STAGE(PG8_SA(0, 1), cA + hstep, voffA);
        if (wr == 1) PG8_BAR;
        PG8_WAIT_V(2); PG8_BAR;
        PG8_STAGE(PG8_SB(1, 0), cB + kstep, voffB); PG8_STAGE(PG8_SA(1, 0), cA + kstep, voffA); PG8_STAGE(PG8_SB(1, 1), cB + hstep + kstep, voffB);
        PG8_WAIT_V(6); PG8_BAR;
    } else {
        PG8_STAGE(PG8_SB(0, 0), cB, voffB); PG8_STAGE(PG8_SA(0, 0), cA, voffA); PG8_STAGE(PG8_SB(0, 1), cB + hstep, voffB); PG8_STAGE(PG8_SA(0, 1), cA + hstep, voffA);
        if (wr == 1) PG8_BAR;
        PG8_WAIT_V(4); PG8_BAR;
        PG8_STAGE(PG8_SB(1, 0), cB + kstep, voffB); PG8_STAGE(PG8_SA(1, 0), cA + kstep, voffA); PG8_STAGE(PG8_SB(1, 1), cB + hstep + kstep, voffB);
        PG8_WAIT_V(6); PG8_BAR;
    }
    for (;;) {
        const bool has_next = S.next(ui + 1, nxt);
        const char* nA = has_next ? (const char*)g.A + (size_t)nxt.pm * tstep : cA; const char* nB = has_next ? (const char*)g.Bt + (size_t)nxt.pn * tstep : cB;
        for (int t = 0; t < nt; t += 2) {
            const bool last = (t == nt - 2);
            const char* a1 = cA + (size_t)(t + 1) * kstep;
            const char* a2 = last ? nA : cA + (size_t)(t + 2) * kstep; const char* b2 = last ? nB : cB + (size_t)(t + 2) * kstep;
            const char* a3 = a2 + kstep; const char* b3 = b2 + kstep;
            if (last && has_next) S.a_ready(nxt);
            if constexpr (SP2) {
            PG8_LDB(B0, 0, 0); PG8_LDB(B1, 0, 1); PG8_SCHED; PG8_LDA(At, 0, 0); PG8_STAGE(PG8_SA(1, 1), a1 + hstep, voffA);
            PG8_WAIT_V(8); PG8_WAIT_L(0); PG8_BAR; PG8_MMA(0, 0, At, B0); PG8_MMA(0, 1, At, B1); PG8_BAR; PG8_SCHED;
            PG8_LDA(At, 0, 1); PG8_STAGE(PG8_SB(0, 0), b2, voffB); PG8_STAGE(PG8_SB(0, 1), b2 + hstep, voffB); PG8_STAGE(PG8_SA(0, 0), a2, voffA);
            PG8_WAIT_V(8); PG8_WAIT_L(0); PG8_BAR; PG8_MMA(1, 0, At, B0); PG8_MMA(1, 1, At, B1); PG8_BAR; PG8_SCHED;
            PG8_LDB(B0, 1, 0); PG8_LDB(B1, 1, 1); PG8_SCHED; PG8_LDA(At, 1, 0); PG8_STAGE(PG8_SA(0, 1), a2 + hstep, voffA);
            PG8_WAIT_V(8); PG8_WAIT_L(0); PG8_BAR; PG8_MMA(0, 0, At, B0); PG8_MMA(0, 1, At, B1); PG8_BAR; PG8_SCHED;
            PG8_LDA(At, 1, 1); PG8_STAGE(PG8_SB(1, 0), b3, voffB); PG8_STAGE(PG8_SB(1, 1), b3 + hstep, voffB); PG8_STAGE(PG8_SA(1, 0), a3, voffA);
            PG8_WAIT_V(8); PG8_WAIT_L(0); PG8_BAR; PG8_MMA(1, 0, At, B0); PG8_MMA(1, 1, At, B1); PG8_BAR; PG8_SCHED;
            } else {
            PG8_LDB(B0, 0, 0); PG8_SCHED; PG8_LDA(At, 0, 0); PG8_STAGE(PG8_SA(1, 1), a1 + hstep, voffA);
            PG8_WAIT_L(8); PG8_BAR; PG8_WAIT_L(0); PG8_MMA(0, 0, At, B0); PG8_BAR; PG8_SCHED;
            PG8_LDB(B1, 0, 1); PG8_STAGE(PG8_SB(0, 0), b2, voffB);
            PG8_BAR; PG8_WAIT_L(0); PG8_MMA(0, 1, At, B1); PG8_BAR;
            PG8_LDA(At, 0, 1); PG8_STAGE(PG8_SA(0, 0), a2, voffA);
            PG8_BAR; PG8_WAIT_L(0); PG8_MMA(1, 0, At, B0); PG8_BAR; PG8_SCHED;
            PG8_STAGE(PG8_SB(0, 1), b2 + hstep, voffB);
            PG8_WAIT_V(6); PG8_BAR; PG8_MMA(1, 1, At, B1); PG8_BAR;
            PG8_LDB(B0, 1, 0); PG8_SCHED; PG8_LDA(At, 1, 0); PG8_STAGE(PG8_SA(0, 1), a2 + hstep, voffA);
            PG8_WAIT_L(8); PG8_BAR; PG8_WAIT_L(0); PG8_MMA(0, 0, At, B0); PG8_BAR; PG8_SCHED;
            PG8_LDB(B1, 1, 1); PG8_STAGE(PG8_SB(1, 0), b3, voffB);
            PG8_BAR; PG8_WAIT_L(0); PG8_MMA(0, 1, At, B1); PG8_BAR;
            PG8_LDA(At, 1, 1); PG8_STAGE(PG8_SA(1, 0), a3, voffA);
            PG8_BAR; PG8_WAIT_L(0); PG8_MMA(1, 0, At, B0); PG8_BAR; PG8_SCHED;
            PG8_STAGE(PG8_SB(1, 1), b3 + hstep, voffB);
            PG8_WAIT_V(6); PG8_BAR; PG8_MMA(1, 1, At, B1); PG8_BAR;
            }
        }
        if constexpr (ALIGN_EPI) { if (wr == 0) PG8_BAR; }
        if constexpr (!Epi::AFTER_DRAIN) { E(acc, cur, wr, wc, fr, fq); S.done(cur); }
        if (!has_next) break;
#pragma unroll
        for (int a = 0; a < 2; ++a)
#pragma unroll
            for (int b = 0; b < 2; ++b)
#pragma unroll
                for (int m = 0; m < 4; ++m)
#pragma unroll
                    for (int n = 0; n < 2; ++n) acc[a][b][m][n] = (f32x4){0.f, 0.f, 0.f, 0.f};
        cur = nxt; cA = nA; cB = nB; ++ui;
        if constexpr (ALIGN_EPI) { if (wr == 1) PG8_BAR; }
    }
    PG8_WAIT_V(0);
    if constexpr (!ALIGN_EPI) { if (wr == 0) PG8_BAR; }
    PG8_BAR;
    if constexpr (Epi::AFTER_DRAIN) { E.fused(acc, cur, wr, wc, fr, fq, lds, wid, lane); S.done(cur); }
#undef PG8_SA
#undef PG8_SB
#undef PG8_STAGE
#undef PG8_LDA
#undef PG8_LDB
#undef PG8_MMA
#undef PG8_WAIT_V
#undef PG8_WAIT_L
#undef PG8_BAR
#undef PG8_SCHED
}
}

constexpr int D = 1024, NB = 2, SEQ = 16384, NMETA = 16, LTOK = SEQ + NMETA  , PADR = 112, T = PADR + LTOK  ;
constexpr int M = NB * T;
constexpr int DEPTH = 2, HD = 64, RW_H = 6, SB_H = 5, FX_H = 5, RW_W = 384, SHIFT_W = 1280, D_IN = 6277;
constexpr int QKV_W = 1920;
constexpr int N1 = 3328;
constexpr int FCOL = 3200, GCOL = 3205;
constexpr int NEXP = 16, DEXP = 256;
constexpr int MS = 70144;
constexpr int LCH = 32, LPADDED = 16448;
constexpr int KBP = 16896;
constexpr float C2 = 0.125f * 1.4426950408889634f;
constexpr float LOG2E = 1.4426950408889634f;
constexpr int NWAVES = 8, NTHR = 512;

constexpr size_t MiB = 1u << 20;
constexpr size_t WS_CTL = 0, CTL_ZERO_BYTES = 65536;
constexpr size_t WS_HM = 1 * MiB;
constexpr size_t WS_LOGF = WS_HM + 131072;
constexpr size_t WS_KB2 = WS_LOGF + (size_t)M * 32;
constexpr size_t WS_TOK = WS_KB2 + (size_t)10 * KBP * 4;
constexpr size_t WS_SLOT = WS_TOK + (size_t)M * 32;
constexpr size_t WS_CWS = WS_SLOT + (size_t)M * 8;
constexpr size_t WS_WGCNT = WS_CWS + (size_t)MS * 4;
constexpr size_t WS_SMALL_END = WS_WGCNT + 256 * 16 * 4;
static_assert(WS_SMALL_END <= 8 * MiB, "small buffers");
constexpr size_t WS_WIN = 8 * MiB;
constexpr size_t WS_WG = WS_WIN + (size_t)N1 * 1024 * 2;
constexpr size_t WS_WP = WS_WG + (size_t)3072 * 1024 * 2;
constexpr size_t WS_WO = WS_WP + (size_t)3072 * 384 * 2;
constexpr size_t WS_WGU = WS_WO + (size_t)1024 * 1024 * 2;
constexpr size_t WS_WD = WS_WGU + (size_t)8192 * 1024 * 2;
constexpr size_t WS_W_END = WS_WD + (size_t)16384 * 256 * 2;
static_assert(WS_W_END <= 49 * MiB, "weights");
constexpr size_t WS_HB = 49 * MiB;
constexpr size_t WS_BIG = 115 * MiB;
constexpr size_t WS_USH = WS_BIG;
constexpr size_t WS_YCAT = WS_BIG;
constexpr size_t WS_QKV = WS_BIG + 82 * MiB;
constexpr size_t WS_RW = WS_BIG + 204 * MiB;
constexpr size_t WS_BN = WS_BIG + 349 * MiB;
constexpr size_t WS_GATES = WS_BIG + 82 * MiB;
constexpr size_t WS_MERGED = WS_BIG + 276 * MiB;
constexpr size_t WS_AS = WS_BIG;
constexpr size_t WS_HS = WS_BIG + 137 * MiB;
constexpr size_t WS_Y = WS_BIG + 172 * MiB;
constexpr size_t WS_END = WS_BIG + 374 * MiB;
static_assert((size_t)(M + 256) * 1280 * 2 <= 82 * MiB && (size_t)3 * M * 384 * 2 <= 82 * MiB && (size_t)(M + 256) * 1920 * 2 <= 122 * MiB, "big map 1");
static_assert((size_t)12 * LPADDED * 768 <= 145 * MiB && (size_t)M * 384 * 2 <= 25 * MiB && (size_t)M * 3072 * 2 <= 194 * MiB && (size_t)M * 2048 <= 65 * MiB, "big map 2");
static_assert((size_t)MS * 2048 <= 137 * MiB && (size_t)MS * 512 <= 35 * MiB && WS_END <= 489 * MiB, "big map 3");

constexpr int CW_BAR = 0;
constexpr int CW_QUEUE = 4096;
constexpr int CW_ECNT = 4352;
static_assert((CW_ECNT + 128) * 4 <= (int)CTL_ZERO_BYTES, "ctl");

constexpr int RING_BYTES = 131072, MISC_OFF = RING_BYTES, LDS_BYTES = 147456;

typedef unsigned short bf16_t;
typedef float f32x4 __attribute__((ext_vector_type(4)));
typedef float f32x2 __attribute__((ext_vector_type(2)));
typedef float f32x16 __attribute__((ext_vector_type(16)));
typedef unsigned u32x4 __attribute__((ext_vector_type(4)));
typedef unsigned u32x2 __attribute__((ext_vector_type(2)));
typedef short bf16x8 __attribute__((ext_vector_type(8)));
typedef short s16x4 __attribute__((ext_vector_type(4)));
typedef _Float16 f16x4 __attribute__((ext_vector_type(4)));
typedef __bf16 bf16x2_t __attribute__((ext_vector_type(2)));

__device__ __forceinline__ unsigned pk2(float lo, float hi) { f32x2 v = {lo, hi}; bf16x2_t b = __builtin_convertvector(v, bf16x2_t); return __builtin_bit_cast(unsigned, b); }
__device__ __forceinline__ unsigned short f2bf(float f) { return (unsigned short)(pk2(f, 0.f) & 0xffffu); }
__device__ __forceinline__ float bf_lo(unsigned u) { return __uint_as_float(u << 16); }
__device__ __forceinline__ float bf_hi(unsigned u) { return __uint_as_float(u & 0xffff0000u); }
__device__ __forceinline__ float bf2f(unsigned short h) { return __uint_as_float((unsigned)h << 16); }
template <int CTRL> __device__ __forceinline__ float dpp_f(float x) { return __int_as_float(__builtin_amdgcn_update_dpp(0, __float_as_int(x), CTRL, 0xF, 0xF, false)); }
__device__ __forceinline__ float allred16(float p) { p += dpp_f<0x128>(p); p += dpp_f<0x124>(p); p += dpp_f<0x122>(p); p += dpp_f<0x121>(p); return p; }
__device__ __forceinline__ float wave_sum(float v) {
    v = allred16(v);
    { auto sw = __builtin_amdgcn_permlane16_swap(__float_as_uint(v), __float_as_uint(v), false, false); v = __uint_as_float(sw[0]) + __uint_as_float(sw[1]); }
    { auto sw = __builtin_amdgcn_permlane32_swap(__float_as_uint(v), __float_as_uint(v), false, false); v = __uint_as_float(sw[0]) + __uint_as_float(sw[1]); }
    return v;
}
__device__ __forceinline__ float fast_exp(float x) { return __builtin_amdgcn_exp2f(x * LOG2E); }
__device__ __forceinline__ float fast_log(float x) { return __builtin_amdgcn_logf(x) * 0.6931471805599453f; }
__device__ __forceinline__ float softplus_f(float z) { return fmaxf(z, 0.f) + fast_log(1.f + fast_exp(-fabsf(z))); }

#define XB_TMO      128
#define XB_XCNT(j)  (256  + 64 * (j))
#define XB_XSUB(j)  (1280 + 64 * (j))
#define XB_XGEN(j)  (2304 + 64 * (j))
#define XB_TOP      3328
#define XB_TOPGEN   3392
#define XCD_BAR_WORDS 3456
#define XB_SPIN_CAP (1u << 20)
__device__ __forceinline__ unsigned xb_ld(unsigned* p)              { return __hip_atomic_load(p, __ATOMIC_RELAXED, __HIP_MEMORY_SCOPE_AGENT); }
__device__ __forceinline__ unsigned xb_add(unsigned* p, unsigned v) { return __hip_atomic_fetch_add(p, v, __ATOMIC_RELAXED, __HIP_MEMORY_SCOPE_AGENT); }
__device__ __forceinline__ unsigned xb_xcc_id() { return (unsigned)__builtin_amdgcn_s_getreg((3 << 11) | 20) & 0xFu; }
#define XB_SPIN(cond, bar) do { unsigned _sp = 0; while (cond) { __builtin_amdgcn_s_sleep(1); \
    if ((++_sp & 255u) == 0u) { if (xb_ld(&(bar)[XB_TMO])) break; if (_sp > XB_SPIN_CAP) { atomicAdd(&(bar)[XB_TMO], 1u); break; } } } } while (0)

struct XcdBarrier {
    unsigned* bar; unsigned x;
    volatile LAS unsigned* st;
};

__device__ __forceinline__ XcdBarrier xcd_barrier_post(unsigned* bar, volatile LAS unsigned* st) {
    XcdBarrier b; b.bar = bar; b.x = xb_xcc_id(); b.st = st;
    if (threadIdx.x == 0) (void)xb_add(&bar[XB_XCNT(b.x)], 1u);
    return b;
}
__device__ __forceinline__ void xcd_barrier_complete(unsigned* bar, unsigned x, unsigned& nloc, unsigned& nx) {
    const unsigned G = gridDim.x * gridDim.y * gridDim.z;
    unsigned sum, cnt, mine, sp = 0u;
    for (;;) {
        sum = 0u; cnt = 0u; mine = 0u;
#pragma unroll
        for (unsigned j = 0; j < 16; ++j) { const unsigned c = xb_ld(&bar[XB_XCNT(j)]); sum += c; cnt += (c > 0u) ? 1u : 0u; mine = (j == x) ? c : mine; }
        if (sum == G) break;
        __builtin_amdgcn_s_sleep(1);
        if ((++sp & 255u) == 0u) { if (xb_ld(&bar[XB_TMO])) break; if (sp > XB_SPIN_CAP) { atomicAdd(&bar[XB_TMO], 1u); break; } }
    }
    nloc = mine > 0u ? mine : 1u; nx = cnt > 0u ? cnt : 1u;
}

__device__ __forceinline__ void xcd_barrier(const XcdBarrier& b) {
    asm volatile("s_waitcnt vmcnt(0)" ::: "memory");
    __syncthreads();
    if (threadIdx.x == 0) {
        unsigned* bar = b.bar;
        __builtin_amdgcn_s_waitcnt(0);
        unsigned nloc = b.st[0], nx = b.st[1];
        if (nloc == 0u) { xcd_barrier_complete(bar, b.x, nloc, nx); b.st[0] = nloc; b.st[1] = nx; }
        const unsigned old = xb_add(&bar[XB_XSUB(b.x)], 1u);
        const unsigned gen = old / nloc;
        if (old + 1u == (gen + 1u) * nloc) {
            __builtin_amdgcn_fence(__ATOMIC_RELEASE, "agent");
            asm volatile("s_waitcnt vmcnt(0)" ::: "memory");
            const unsigned og = xb_add(&bar[XB_TOP], 1u);
            const unsigned tg = og / nx;
            if (og + 1u == (tg + 1u) * nx) xb_add(&bar[XB_TOPGEN], 1u);
            else XB_SPIN(xb_ld(&bar[XB_TOPGEN]) == tg, bar);
            __builtin_amdgcn_fence(__ATOMIC_ACQUIRE, "agent");
            xb_add(&bar[XB_XGEN(b.x)], 1u);
            asm volatile("s_waitcnt vmcnt(0)" ::: "memory");
        } else {
            XB_SPIN(xb_ld(&bar[XB_XGEN(b.x)]) == gen, bar);
            __builtin_amdgcn_fence(__ATOMIC_ACQUIRE, "agent");
            asm volatile("s_waitcnt vmcnt(0)" ::: "memory");
        }
    }
    __syncthreads();
}

struct Args { const float* in[29]; float* out; unsigned char* ws; };
enum { I_X = 0, I_META, I_N1G, I_WIN, I_MU, I_WUP, I_W0, I_AUP, I_A0, I_KK, I_KA, I_RK, I_LNG, I_LNB, I_FB, I_QG, I_KG, I_WPR, I_WPS, I_WPF, I_WOUT, I_N2G, I_MWG, I_MBG, I_MWE, I_MBE, I_MGATE, I_MUP, I_MDOWN };
struct ArgsL { volatile LAS unsigned* tab; float* out; unsigned char* ws;
    __device__ __forceinline__ const float* in(int i) const { const unsigned lo = tab[2 * i], hi = tab[2 * i + 1];
        return (const float*)(((unsigned long long)(unsigned)__builtin_amdgcn_readfirstlane((int)hi) << 32) | (unsigned long long)(unsigned)__builtin_amdgcn_readfirstlane((int)lo)); }
};
struct Frame { LAS unsigned char* lds; volatile LAS unsigned* MISC; int tid, lane, wave, bx; };

__device__ __forceinline__ float* hrow(const ArgsL& a, int b, int l) {
    return l < NMETA ? (float*)(a.ws + WS_HM) + (size_t)(b * NMETA + l) * D : a.out + ((size_t)b * SEQ + (l - NMETA)) * D;
}
#define LDS_WAIT() asm volatile("s_waitcnt lgkmcnt(0)" ::: "memory")
#define HB_PTR(a) ((bf16_t*)((a).ws + WS_HB))
#define A_PTR(a) ((bf16_t*)((a).out))

__device__ __forceinline__ void tr_item(const float* W, int ldw, int sc0, int nvalid, int k0, int kvalid, bf16_t* WT, int Kd, int r0, LAS float* scr, int lane) {
    float tv[32];
#pragma unroll
    for (int i = 0; i < 32; ++i) { const int kk = 2 * i + (lane >> 5), n = lane & 31; tv[i] = 0.f;
        if (n < nvalid && k0 + kk < kvalid) tv[i] = W[(size_t)(k0 + kk) * ldw + sc0 + n]; }
#pragma unroll
    for (int i = 0; i < 32; ++i) { const int kk = 2 * i + (lane >> 5), n = lane & 31; scr[kk * 33 + n] = tv[i]; }
    LDS_WAIT();
    const int c = lane & 7;
#pragma unroll
    for (int j = 0; j < 4; ++j) { const int n = (lane >> 3) + 8 * j; const LAS float* s = scr + (8 * c) * 33 + n;
        u32x4 o; o.x = pk2(s[0 * 33], s[1 * 33]); o.y = pk2(s[2 * 33], s[3 * 33]); o.z = pk2(s[4 * 33], s[5 * 33]); o.w = pk2(s[6 * 33], s[7 * 33]);
        *(u32x4*)(WT + (size_t)(r0 + n) * Kd + k0 + 8 * c) = o; }
    LDS_WAIT();
}
__device__ __forceinline__ void phase_wconv(const ArgsL& a, Frame& F, int layer) {
    LAS float* scr = (LAS float*)(F.lds + F.wave * 8448);
    const int gw = F.bx * NWAVES + F.wave, NGW = gridDim.x * NWAVES;
    constexpr int C1 = 16 * 104, C2_ = C1 + 16 * 96, C3 = C2_ + 6 * 96, C4 = C3 + 16 * 32, C5 = C4 + 16 * 256, C6 = C5 + 4 * 512;
    unsigned char* ws = a.ws;
    for (int it = gw; it < C6; it += NGW) {
        if (it < C1) { const int kb = it / 104, nb = it % 104, r0 = nb * 32;
            tr_item(a.in(I_WIN) + (size_t)layer * D * D_IN, D_IN, r0, r0 < FCOL ? 32 : 0, kb * 64, 1024, (bf16_t*)(ws + WS_WIN), 1024, r0, scr, F.lane); }
        else if (it < C2_) { const int r = it - C1, kb = r / 96, nb = r % 96, r0 = nb * 32;
            tr_item(a.in(I_WIN) + (size_t)layer * D * D_IN, D_IN, GCOL + r0, 32, kb * 64, 1024, (bf16_t*)(ws + WS_WG), 1024, r0, scr, F.lane); }
        else if (it < C3) { const int r = it - C2_, kb = r / 96, nb = r % 96, r0 = nb * 32, br = r0 >> 10;
            const float* W = (br == 0 ? a.in(I_WPR) + (size_t)layer * 384 * D : br == 1 ? a.in(I_WPS) + (size_t)layer * 320 * D : a.in(I_WPF) + (size_t)layer * 320 * D);
            tr_item(W, D, r0 & 1023, 32, kb * 64, br == 0 ? 384 : 320, (bf16_t*)(ws + WS_WP), 384, r0, scr, F.lane); }
        else if (it < C4) { const int r = it - C3, kb = r / 32, nb = r % 32, r0 = nb * 32;
            tr_item(a.in(I_WOUT) + (size_t)layer * D * D, D, r0, 32, kb * 64, 1024, (bf16_t*)(ws + WS_WO), 1024, r0, scr, F.lane); }
        else if (it < C5) { const int r = it - C4, kb = r / 256, nb = r % 256, r0 = nb * 32, e = r0 >> 9, rr = r0 & 511, j = rr >> 8, q = rr & 255;
            const float* W = (q >= 128 ? a.in(I_MUP) : a.in(I_MGATE)) + ((size_t)layer * NEXP + e) * D * DEXP;
            tr_item(W, DEXP, j * 128 + (q & 127), 32, kb * 64, 1024, (bf16_t*)(ws + WS_WGU), 1024, r0, scr, F.lane); }
        else { const int r = it - C5, kb = r / 512, nb = r % 512, r0 = nb * 32, e = r0 >> 10;
            tr_item(a.in(I_MDOWN) + ((size_t)layer * NEXP + e) * DEXP * D, D, r0 & 1023, 32, kb * 64, 256, (bf16_t*)(ws + WS_WD), 256, r0, scr, F.lane); }
    }
}

__device__ __forceinline__ void add_y_row(f32x4 (&v)[4], const bf16_t* Y, int slot, int lane) {
    const u32x2* y = (const u32x2*)(Y + (size_t)slot * D) + lane;
#pragma unroll
    for (int j = 0; j < 4; ++j) { const u32x2 t = y[64 * j]; v[j].x += bf_lo(t.x); v[j].y += bf_hi(t.x); v[j].z += bf_lo(t.y); v[j].w += bf_hi(t.y); }
}
template <int MODE>
__device__ __forceinline__ void phase_norm(const ArgsL& a, Frame& F, int layer, const bool dry = false) {
    const int lane = F.lane;
    LAS float* wl = (LAS float*)F.lds;
    LAS int* lcnt = (LAS int*)(F.lds + 20 * 4096);
    unsigned char* ws = a.ws;
    if (MODE == 1) {
        const float* win = a.in(I_WIN) + (size_t)layer * D * D_IN;
        for (int idx = F.tid; idx < 5 * 1024; idx += NTHR) { const int j = idx >> 10, k = idx & 1023; wl[j * 1024 + k] = win[(size_t)k * D_IN + FCOL + j]; }
    }
    if (MODE == 2) {
        const float* wg = a.in(I_MWG) + (size_t)layer * D * 4; const float* we = a.in(I_MWE) + (size_t)layer * D * 16;
        for (int idx = F.tid; idx < 4 * 1024; idx += NTHR) { const int j = idx >> 10, k = idx & 1023; wl[j * 1024 + k] = wg[k * 4 + j]; }
        for (int idx = F.tid; idx < 16 * 1024; idx += NTHR) { const int j = idx >> 10, k = idx & 1023; wl[(4 + j) * 1024 + k] = we[k * 16 + j]; }
        if (F.tid < 16) lcnt[F.tid] = 0;
    }
    __syncthreads();
    const int gw = F.bx * NWAVES + F.wave, NGW = gridDim.x * NWAVES;
    const float* gsrc = (MODE == 2 ? a.in(I_N2G) : a.in(I_N1G)) + layer * D;
    f32x4 gv[4];
#pragma unroll
    for (int j = 0; j < 4; ++j) gv[j] = (MODE == 0) ? (f32x4){0.f, 0.f, 0.f, 0.f} : *(const f32x4*)(gsrc + 4 * lane + 256 * j);
    bf16_t* A = A_PTR(a); bf16_t* HB = HB_PTR(a);
    const bf16_t* Y = (const bf16_t*)(ws + WS_Y);
    const int* SLOT = (const int*)(ws + WS_SLOT);
    constexpr bool COMB0 = (MODE == 0);
    const bool comb = COMB0 || (MODE == 1 && layer > 0);
    f32x4 vn[4]; u32x2 yan[4], ybn[4];
#pragma unroll
    for (int j = 0; j < 4; ++j) { vn[j] = (f32x4){0.f, 0.f, 0.f, 0.f}; yan[j] = (u32x2){0u, 0u}; ybn[j] = (u32x2){0u, 0u}; }
#define NRM_VALID(mm) ((mm) < M && ((mm) % T) - PADR >= (MODE == 0 ? NMETA : 0))
#define NRM_LOAD(mm, s0_, s1_) do { if (NRM_VALID(mm)) { const int bb_ = (mm) / T, ll_ = (mm) - bb_ * T - PADR; \
        if (MODE == 1 && layer == 0) { const float* src_ = (ll_ < NMETA) ? a.in(I_META) + (size_t)ll_ * D : a.in(I_X) + ((size_t)bb_ * SEQ + (ll_ - NMETA)) * D; \
            _Pragma("unroll") for (int j = 0; j < 4; ++j) vn[j] = *(const f32x4*)(src_ + 4 * lane + 256 * j); } \
        else { const u32x2* hs_ = (const u32x2*)(HB + (size_t)(mm) * D) + lane; \
            _Pragma("unroll") for (int j = 0; j < 4; ++j) { const u32x2 t_ = hs_[64 * j]; vn[j] = (f32x4){bf_lo(t_.x), bf_hi(t_.x), bf_lo(t_.y), bf_hi(t_.y)}; } } \
        if (comb) { const u32x2* y0_ = (const u32x2*)(Y + (size_t)(s0_) * D) + lane; const u32x2* y1_ = (const u32x2*)(Y + (size_t)(s1_) * D) + lane; \
            _Pragma("unroll") for (int j = 0; j < 4; ++j) { yan[j] = y0_[64 * j]; ybn[j] = y1_[64 * j]; } } } } while (0)
    int sa1 = 0, sb1 = 0, sa2 = 0, sb2 = 0;
    if (comb) { if (NRM_VALID(gw)) { sa1 = SLOT[2 * gw]; sb1 = SLOT[2 * gw + 1]; } if (NRM_VALID(gw + NGW)) { sa2 = SLOT[2 * (gw + NGW)]; sb2 = SLOT[2 * (gw + NGW) + 1]; } }
    NRM_LOAD(gw, sa1, sb1);
    for (int m = gw; m < M; m += NGW) {
        f32x4 v[4]; u32x2 ya[4], yb[4];
#pragma unroll
        for (int j = 0; j < 4; ++j) { v[j] = vn[j]; ya[j] = yan[j]; yb[j] = ybn[j]; }
        int sa3 = 0, sb3 = 0;
        if (comb && NRM_VALID(m + 2 * NGW)) { sa3 = SLOT[2 * (m + 2 * NGW)]; sb3 = SLOT[2 * (m + 2 * NGW) + 1]; }
        NRM_LOAD(m + NGW, sa2, sb2);
        sa2 = sa3; sb2 = sb3;
        const int b = m / T, p = m - b * T, l = p - PADR;
        if (l < 0) {
            if (MODE == 1 && !dry) {
                u32x2* o = (u32x2*)(A + (size_t)m * D) + lane;
#pragma unroll
                for (int j = 0; j < 4; ++j) o[64 * j] = (u32x2){0u, 0u};
                if (lane < 8) ((float*)(ws + WS_LOGF))[(size_t)m * 8 + lane] = 0.f;
            }
            continue;
        }
        if (MODE == 0 && l < NMETA) continue;
        if (comb) {
#pragma unroll
            for (int j = 0; j < 4; ++j) { v[j].x += bf_lo(ya[j].x) + bf_lo(yb[j].x); v[j].y += bf_hi(ya[j].x) + bf_hi(yb[j].x); v[j].z += bf_lo(ya[j].y) + bf_lo(yb[j].y); v[j].w += bf_hi(ya[j].y) + bf_hi(yb[j].y); }
        }
        if (MODE == 0 && !dry) { float* op = a.out + ((size_t)b * SEQ + (l - NMETA)) * D;
#pragma unroll
            for (int j = 0; j < 4; ++j) *(f32x4*)(op + 4 * lane + 256 * j) = v[j]; }
        if (MODE == 1 && !dry) { u32x2* hd = (u32x2*)(HB + (size_t)m * D) + lane;
#pragma unroll
            for (int j = 0; j < 4; ++j) hd[64 * j] = (u32x2){pk2(v[j].x, v[j].y), pk2(v[j].z, v[j].w)};
        }
        if (MODE == 0) continue;
        float ss = 0.f;
#pragma unroll
        for (int j = 0; j < 4; ++j) ss += (v[j].x * v[j].x + v[j].y * v[j].y) + (v[j].z * v[j].z + v[j].w * v[j].w);
        const float r = 1.0f / sqrtf(wave_sum(ss) * (1.0f / D) + 1e-6f);
#pragma unroll
        for (int j = 0; j < 4; ++j) v[j] = v[j] * r * gv[j];
        u32x2* o = (u32x2*)(A + (size_t)m * D) + lane;
        if (!dry) {
#pragma unroll
        for (int j = 0; j < 4; ++j) o[64 * j] = (u32x2){pk2(v[j].x, v[j].y), pk2(v[j].z, v[j].w)}; }
        else { float sink = v[0].x + v[1].y + v[2].z + v[3].w; asm volatile("" :: "v"(sink)); }
        if (MODE == 1) {
            float dsum[5];
#pragma unroll
            for (int q = 0; q < 5; ++q) { float d = 0.f;
#pragma unroll
                for (int j = 0; j < 4; ++j) { const f32x4 w = *(const LAS f32x4*)(wl + q * 1024 + 4 * lane + 256 * j); d += (v[j].x * w.x + v[j].y * w.y) + (v[j].z * w.z + v[j].w * w.w); }
                dsum[q] = wave_sum(d); }
            float mine = dsum[0];
            mine = lane == 1 ? dsum[1] : mine; mine = lane == 2 ? dsum[2] : mine; mine = lane == 3 ? dsum[3] : mine; mine = lane == 4 ? dsum[4] : mine;
            if (lane < 8 && !dry) { float lf = 0.f;
                if (lane < 5) { const float xx = mine + a.in(I_FB)[layer * 5 + lane]; lf = fminf(xx, 0.f) - fast_log(1.f + fast_exp(-fabsf(xx))); }
                ((float*)(ws + WS_LOGF))[(size_t)m * 8 + lane] = lf; }
        }
        if (MODE == 2) {
            float ds[20];
#pragma unroll
            for (int q = 0; q < 20; ++q) { float d = 0.f;
#pragma unroll
                for (int j = 0; j < 4; ++j) { const f32x4 w = *(const LAS f32x4*)(wl + q * 1024 + 4 * lane + 256 * j); d += (v[j].x * w.x + v[j].y * w.y) + (v[j].z * w.z + v[j].w * w.w); }
                ds[q] = wave_sum(d); }
            const float* bg = a.in(I_MBG) + layer * 4; const float* be = a.in(I_MBE) + layer * 16;
            float lg0 = ds[0] + bg[0], lg1 = ds[1] + bg[1], lg2 = ds[2] + bg[2], lg3 = ds[3] + bg[3];
            int g = 0; float mx = lg0;
            if (lg1 > mx) { mx = lg1; g = 1; } if (lg2 > mx) { mx = lg2; g = 2; } if (lg3 > mx) { mx = lg3; g = 3; }
            const float den = fast_exp(lg0 - mx) + fast_exp(lg1 - mx) + fast_exp(lg2 - mx) + fast_exp(lg3 - mx);
            const float pgrp = 1.0f / den;
            float s0 = g == 0 ? ds[4] : g == 1 ? ds[8] : g == 2 ? ds[12] : ds[16];
            float s1 = g == 0 ? ds[5] : g == 1 ? ds[9] : g == 2 ? ds[13] : ds[17];
            float s2 = g == 0 ? ds[6] : g == 1 ? ds[10] : g == 2 ? ds[14] : ds[18];
            float s3 = g == 0 ? ds[7] : g == 1 ? ds[11] : g == 2 ? ds[15] : ds[19];
            s0 += be[g * 4 + 0]; s1 += be[g * 4 + 1]; s2 += be[g * 4 + 2]; s3 += be[g * 4 + 3];
            int i0 = 0; float v0 = s0;
            if (s1 > v0) { v0 = s1; i0 = 1; } if (s2 > v0) { v0 = s2; i0 = 2; } if (s3 > v0) { v0 = s3; i0 = 3; }
            int i1 = -1; float v1 = -3.0e38f;
            if (i0 != 0 && s0 > v1) { v1 = s0; i1 = 0; } if (i0 != 1 && s1 > v1) { v1 = s1; i1 = 1; } if (i0 != 2 && s2 > v1) { v1 = s2; i1 = 2; } if (i0 != 3 && s3 > v1) { v1 = s3; i1 = 3; }
            const float e1 = fast_exp(v1 - v0), pt0 = 1.0f / (1.0f + e1), pt1 = e1 * pt0;
            if (dry) { float sink = pgrp * pt0 + pt1; asm volatile("" :: "v"(sink)); }
            if (lane == 0 && !dry) {
                const int ea = g * 4 + i0, eb = g * 4 + i1;
                const int la = atomicAdd((int*)&lcnt[ea], 1), lb = atomicAdd((int*)&lcnt[eb], 1);
                int* tk = (int*)(ws + WS_TOK) + (size_t)m * 8;
                tk[0] = ea; tk[1] = eb; tk[2] = __float_as_int(pgrp * pt0); tk[3] = __float_as_int(pgrp * pt1); tk[4] = la; tk[5] = lb;
            }
        }
    }
    __syncthreads();
#undef NRM_LOAD
#undef NRM_VALID
    if (MODE == 2 && F.tid < 16 && !dry) {
        const int c = lcnt[F.tid];
        ((int*)(ws + WS_WGCNT))[F.bx * 16 + F.tid] = c;
        atomicAdd((int*)(ws + WS_CTL) + CW_ECNT + 64 * layer + F.tid, c);
    }
    __syncthreads();
}

__device__ __forceinline__ void phase_route(const ArgsL& a, Frame& F, int layer) {
    unsigned char* ws = a.ws;
    LAS int* tbl = (LAS int*)F.lds;
    LAS int* part = tbl + 16;
    {
        const int e = F.tid & 15, q = F.tid >> 4; const int* wc = (const int*)(ws + WS_WGCNT); int acc = 0;
#pragma unroll
        for (int i = 0; i < 8; ++i) { const int w = q + 32 * i; if (w < (int)F.bx) acc += wc[w * 16 + e]; }
        part[q * 16 + e] = acc;
    }
    __syncthreads();
    if (F.tid < 16) {
        const int* cnt = (const int*)(ws + WS_CTL) + CW_ECNT + 64 * layer;
        int cv[16];
#pragma unroll
        for (int e = 0; e < 16; ++e) cv[e] = __hip_atomic_load(cnt + e, __ATOMIC_RELAXED, __HIP_MEMORY_SCOPE_AGENT);
        int base = 0;
#pragma unroll
        for (int e = 0; e < 16; ++e) if (e < F.tid) base += ((cv[e] + 255) >> 8) << 8;
#pragma unroll
        for (int q = 0; q < 32; ++q) base += part[q * 16 + F.tid];
        tbl[F.tid] = base;
    }
    __syncthreads();
    const int gw = F.bx * NWAVES + F.wave, NGW = gridDim.x * NWAVES, lane = F.lane;
    const bf16_t* A = A_PTR(a); bf16_t* AS = (bf16_t*)(ws + WS_AS);
    int tn[6] = {0, 0, 0, 0, 0, 0}; u32x4 xn0 = {0u, 0u, 0u, 0u}, xn1 = {0u, 0u, 0u, 0u};
#define RT_LOAD(mm) do { if ((mm) < M && ((mm) % T) >= PADR) { const int* tk_ = (const int*)(ws + WS_TOK) + (size_t)(mm) * 8; \
        _Pragma("unroll") for (int q_ = 0; q_ < 6; ++q_) tn[q_] = tk_[q_]; \
        const u32x4* src_ = (const u32x4*)(A + (size_t)(mm) * D) + lane; xn0 = src_[0]; xn1 = src_[64]; } } while (0)
    RT_LOAD(gw);
    for (int m = gw; m < M; m += NGW) {
        int tk[6];
#pragma unroll
        for (int q = 0; q < 6; ++q) tk[q] = tn[q];
        const u32x4 x0 = xn0, x1 = xn1;
        RT_LOAD(m + NGW);
        const int b = m / T, p = m - b * T, l = p - PADR;
        if (l < 0) continue;
        const int ea = tk[0], eb = tk[1], sa = tbl[ea] + tk[4], sb = tbl[eb] + tk[5];
        u32x4* d0 = (u32x4*)(AS + (size_t)sa * D) + lane; u32x4* d1 = (u32x4*)(AS + (size_t)sb * D) + lane;
        d0[0] = x0; d0[64] = x1; d1[0] = x0; d1[64] = x1;
        if (lane == 0) { int* sl = (int*)(ws + WS_SLOT) + 2 * m; sl[0] = sa; sl[1] = sb;
            float* cw = (float*)(ws + WS_CWS); cw[sa] = __int_as_float(tk[2]); cw[sb] = __int_as_float(tk[3]); }
    }
#undef RT_LOAD
    __syncthreads();
}

__device__ __forceinline__ void phase_prep(const ArgsL& a, Frame& F, int layer, const bool dry = false) {
    unsigned char* ws = a.ws;
    LAS float* xs = (LAS float*)F.lds;
    const int wave = F.wave, lane = F.lane, tid = F.tid;
    const int m0 = F.bx * 129;
    const bf16_t* USH = (const bf16_t*)(ws + WS_USH);
    bf16_t* QKV = (bf16_t*)(ws + WS_QKV);
    if (F.bx < 10) {
        const int bh = F.bx, b = bh / 5, h = bh % 5;
        const float* LOGF = (const float*)(ws + WS_LOGF) + (size_t)(b * T + PADR) * 8 + h;
        float* kb = (float*)(ws + WS_KB2) + (size_t)bh * KBP;
        LAS float* wtot = (LAS float*)F.lds;
        float v[33];
        const int l0 = tid * 33;
#pragma unroll
        for (int i = 0; i < 33; ++i) v[i] = (l0 + i < LTOK) ? LOGF[(size_t)(l0 + i) * 8] : 0.f;
#pragma unroll
        for (int i = 1; i < 33; ++i) v[i] += v[i - 1];
        float incl = v[32];
#pragma unroll
        for (int o = 1; o < 64; o <<= 1) { const float t = __shfl_up(incl, o); if (lane >= o) incl += t; }
        if (lane == 63) wtot[wave] = incl;
        __syncthreads();
        float off = incl - v[32];
        for (int w = 0; w < wave; ++w) off += wtot[w];
#pragma unroll
        for (int i = 0; i < 33; ++i) if (l0 + i < LTOK && !dry) kb[PADR + l0 + i] = -(off + v[i]) * LOG2E;
        for (int p = tid; p < PADR; p += NTHR) kb[p] = 0.f;
        for (int p = T + tid; p < KBP; p += NTHR) kb[p] = 0.f;
        __syncthreads();
    }
    if (F.bx >= 16 && F.bx < 28) {
        unsigned* z = (unsigned*)(ws + WS_RW + ((size_t)(F.bx - 16) * LPADDED + LTOK) * 768);
        for (int i = tid; i < (LPADDED - LTOK) * 192; i += NTHR) z[i] = 0u;
    }
    float w0j = 0.f, a0j = 0.f, kkj = 0.f, kaj = 0.f, rkj = 0.f;
    const int jch = wave * 64 + lane;
    const float* WU = a.in(I_WUP) + (size_t)layer * 64 * RW_W + (wave < 6 ? jch : 0); const float* AU = a.in(I_AUP) + (size_t)layer * 64 * RW_W + (wave < 6 ? jch : 0);
    if (wave < 6) {
        w0j = a.in(I_W0)[layer * RW_W + jch]; a0j = a.in(I_A0)[layer * RW_W + jch];
        kkj = a.in(I_KK)[layer * RW_W + jch]; kaj = a.in(I_KA)[layer * RW_W + jch]; rkj = a.in(I_RK)[layer * RW_W + jch];
    }
    float wvv[64], avv[64];
    if (wave < 6) {
        const float* wp_ = WU; const float* ap_ = AU;
#pragma unroll
        for (int i = 0; i < 64; ++i) { wvv[i] = *wp_; avv[i] = *ap_; wp_ += RW_W; ap_ += RW_W; asm volatile("" : "+v"(wp_), "+v"(ap_)); }
    } else {
#pragma unroll
        for (int i = 0; i < 64; ++i) { wvv[i] = 0.f; avv[i] = 0.f; }
    }
    const float* mu = a.in(I_MU) + layer * SHIFT_W;
    const float gq = a.in(I_QG)[layer * 64 + lane] * C2, gk = a.in(I_KG)[layer * 64 + lane];
    _Float16* RW = (_Float16*)(ws + WS_RW);
    bf16_t* BN = (bf16_t*)(ws + WS_BN);
    for (int t0 = 0; t0 < 129; t0 += 16) {
        const int nt = (129 - t0) < 16 ? (129 - t0) : 16;
        {
            int tid = F.tid; asm volatile("" : "+v"(tid));
            u32x4 uu4[5], pp4[5];
#pragma unroll
            for (int q5 = 0; q5 < 5; ++q5) { const int item = tid + q5 * NTHR; uu4[q5] = (u32x4){0u, 0u, 0u, 0u}; pp4[q5] = (u32x4){0u, 0u, 0u, 0u};
                if (item < nt * 160) { const int tok = item / 160, ch = item - tok * 160, m = m0 + t0 + tok;
                    uu4[q5] = *(const u32x4*)(USH + (size_t)m * SHIFT_W + ch * 8);
                    if (m > 0) pp4[q5] = *(const u32x4*)(USH + (size_t)(m - 1) * SHIFT_W + ch * 8); } }
#pragma unroll
            for (int q5 = 0; q5 < 5; ++q5) { const int item = tid + q5 * NTHR;
                if (item < nt * 160) { const int tok = item / 160, ch = item - tok * 160;
                    const u32x4 u = uu4[q5], pv = pp4[q5];
                    const f32x4 mu0 = *(const f32x4*)(mu + ch * 8), mu1 = *(const f32x4*)(mu + ch * 8 + 4);
                    float x[8];
                    { float uu, pp;
                      uu = bf_lo(u.x); pp = bf_lo(pv.x); x[0] = uu + (pp - uu) * mu0.x;  uu = bf_hi(u.x); pp = bf_hi(pv.x); x[1] = uu + (pp - uu) * mu0.y;
                      uu = bf_lo(u.y); pp = bf_lo(pv.y); x[2] = uu + (pp - uu) * mu0.z;  uu = bf_hi(u.y); pp = bf_hi(pv.y); x[3] = uu + (pp - uu) * mu0.w;
                      uu = bf_lo(u.z); pp = bf_lo(pv.z); x[4] = uu + (pp - uu) * mu1.x;  uu = bf_hi(u.z); pp = bf_hi(pv.z); x[5] = uu + (pp - uu) * mu1.y;
                      uu = bf_lo(u.w); pp = bf_lo(pv.w); x[6] = uu + (pp - uu) * mu1.z;  uu = bf_hi(u.w); pp = bf_hi(pv.w); x[7] = uu + (pp - uu) * mu1.w; }
                    if (ch >= 144 && ch < 152) {
#pragma unroll
                        for (int q = 0; q < 8; ++q) { const float e = fast_exp(-2.f * fabsf(x[q])); const float th = (1.f - e) / (1.f + e); x[q] = x[q] < 0.f ? -th : th; }
                    }
                    LAS f32x4* d = (LAS f32x4*)(xs + tok * SHIFT_W + ch * 8);
                    d[0] = (f32x4){x[0], x[1], x[2], x[3]}; d[1] = (f32x4){x[4], x[5], x[6], x[7]}; } }
        }
        __syncthreads();
        if (wave < 6) {
#pragma unroll 1
            for (int tok = 0; tok < nt; ++tok) {
                const int m = m0 + t0 + tok, b = m / T, p = m - b * T, l = p - PADR;
                if (l < 0) continue;
                const LAS float* xr = xs + tok * SHIFT_W;
                float w0a = w0j, w1a = 0.f, a0a = a0j, a1a = 0.f;
#pragma unroll
                for (int i = 0; i < 64; i += 4) { if ((i & 15) == 0) __builtin_amdgcn_sched_barrier(0);       const f32x4 t4 = *(const LAS f32x4*)(xr + 1152 + i), d4 = *(const LAS f32x4*)(xr + 1216 + i);
                    w0a += t4.x * wvv[i]; w1a += t4.y * wvv[i + 1]; w0a += t4.z * wvv[i + 2]; w1a += t4.w * wvv[i + 3];
                    a0a += d4.x * avv[i]; a1a += d4.y * avv[i + 1]; a0a += d4.z * avv[i + 2]; a1a += d4.w * avv[i + 3]; }
                const float wlv = w0a + w1a, alv = a0a + a1a;
                const float r = xr[jch], k = xr[384 + jch], v = xr[768 + jch];
                const float logw = -softplus_f(-wlv) - 0.5f;
                const float xw = fast_exp(logw);
                const float om = xw < 0.02f ? xw * (1.f - 0.5f * xw + xw * xw * (1.f / 6.f)) : 1.f - fast_exp(-xw);
                const float av = 1.f / (1.f + fast_exp(-alv));
                const float kkr = k * kkj;
                const float nrm = sqrtf(wave_sum(kkr * kkr));
                const float kk = kkr / fmaxf(nrm, 1e-12f);
                const float kp = k * (1.f + (av - 1.f) * kaj);
                const float bb = kk * av;
                const float coef = wave_sum(r * kp * rkj);
                _Float16* o = RW + ((size_t)(b * RW_H + wave) * LPADDED + l) * 384 + lane;
                if (dry) { float sink = kk + om + bb + kp + coef; asm volatile("" :: "v"(sink)); continue; }
                o[0] = (_Float16)kk; o[64] = (_Float16)(-om); o[128] = (_Float16)(-bb); o[192] = (_Float16)kp; o[256] = (_Float16)r; o[320] = (_Float16)v;
                BN[(size_t)m * RW_W + jch] = f2bf(coef * v);
            }
        } else {
            const int which = wave - 6;
            const float gsc = which == 0 ? gq : gk;
#pragma unroll 1
            for (int th = 0; th < 16; th += 8) {
                unsigned short xv[8][5];
#pragma unroll
                for (int t8 = 0; t8 < 8; ++t8) { const int tok = th + t8, m = m0 + t0 + tok; const int p = m % T;
                    const bf16_t* q = QKV + (size_t)m * QKV_W + 960 + which * 320 + lane;
#pragma unroll
                    for (int hd = 0; hd < 5; ++hd) xv[t8][hd] = (tok < nt && p >= PADR) ? q[hd * 64] : (unsigned short)0; }
#pragma unroll
                for (int t8 = 0; t8 < 8; ++t8) { const int tok = th + t8, m = m0 + t0 + tok; const int p = m % T;
                    bf16_t* q = QKV + (size_t)m * QKV_W + 960 + which * 320 + lane;
                    if (tok < nt && p >= PADR) {
#pragma unroll
                        for (int hd = 0; hd < 5; ++hd) { const float x = bf2f(xv[t8][hd]); const float ss = wave_sum(x * x);
                            const unsigned short r_ = f2bf(x * (1.0f / sqrtf(ss * (1.0f / 64.f) + 1e-6f)) * gsc); if (!dry) q[hd * 64] = r_; else asm volatile("" :: "v"(r_)); } } }
            }
        }
        __syncthreads();
    }
}


constexpr int SCH = 16;
static_assert(LTOK % SCH == 0, "whole chunks");
__device__ __forceinline__ void rwkv_scan(const ArgsL& a, Frame& F, int wgi, int dry = 0) {
    const int bh = wgi >> 4, q8 = wgi & 15, b = bh / RW_H, h = bh % RW_H;
    const int tid = F.tid, wave = F.wave, lane = F.lane;
    const unsigned char* rw = a.ws + WS_RW + (size_t)bh * LPADDED * 768;
    LAS float* ring = (LAS float*)F.lds;
    LAS float* ypart = (LAS float*)(F.lds + 49152);
    LAS unsigned char* stg = F.lds + 81920;
    bf16_t* y0 = (bf16_t*)(a.ws + WS_YCAT);
    constexpr int NCH = LTOK / SCH;
    const bool isld = (wave & 2) != 0; const int lw = (wave & 1) + ((wave >> 2) << 1), tl = lw * 64 + lane;
    float s0 = 0.f, s1 = 0.f;
    const int i32 = lane & 31, rsel = lane >> 5, rloc = 2 * wave + rsel;
#define RW_BAR() asm volatile("s_waitcnt lgkmcnt(0)\n\ts_barrier" ::: "memory")
#define RW_ISSUE(cc) do { const unsigned char* src_ = rw + (size_t)(cc) * SCH * 768 + (size_t)tl * 16; LAS unsigned char* d_ = stg + ((cc) & 3) * 12288 + lw * 1024; \
        _Pragma("unroll") for (int k_ = 0; k_ < 3; ++k_) __builtin_amdgcn_global_load_lds((const unsigned*)(src_ + k_ * 4096), (LAS unsigned*)(d_ + k_ * 4096), 16, 0, 0); } while (0)
#define RW_CONVERT(cc) do { const LAS unsigned char* s_ = stg + ((cc) & 3) * 12288 + tl * 16; LAS float* rb_ = ring + ((cc) & 1) * 6144; \
        _Pragma("unroll") for (int k_ = 0; k_ < 3; ++k_) { const int pc_ = tl + 256 * k_; const int t_ = pc_ / 48, q_ = pc_ - t_ * 48, vec_ = q_ >> 3, e0_ = (q_ & 7) * 8; \
            const u32x4 w_ = *(const LAS u32x4*)(s_ + k_ * 4096); \
            const f16x4 lo_ = __builtin_bit_cast(f16x4, (u32x2){w_.x, w_.y}), hi_ = __builtin_bit_cast(f16x4, (u32x2){w_.z, w_.w}); \
            const float f0 = (float)lo_.x, f1 = (float)lo_.y, f2 = (float)lo_.z, f3 = (float)lo_.w, f4 = (float)hi_.x, f5 = (float)hi_.y, f6 = (float)hi_.z, f7 = (float)hi_.w; \
            if (vec_ < 4) { LAS float* d_ = rb_ + t_ * 384 + (vec_ >> 1) * 128 + (e0_ >> 1) * 4 + (vec_ & 1) * 2; \
                *(LAS f32x2*)(d_) = (f32x2){f0, f1}; *(LAS f32x2*)(d_ + 4) = (f32x2){f2, f3}; *(LAS f32x2*)(d_ + 8) = (f32x2){f4, f5}; *(LAS f32x2*)(d_ + 12) = (f32x2){f6, f7}; } \
            else { LAS f32x4* d_ = (LAS f32x4*)(rb_ + t_ * 384 + (vec_ == 4 ? 256 : 320) + e0_); d_[0] = (f32x4){f0, f1, f2, f3}; d_[1] = (f32x4){f4, f5, f6, f7}; } } } while (0)
#define RW_STORE_Y(cc) do { if (tl < 32) { const LAS float* yb_ = ypart + ((cc) & 1) * 4096; const int t_ = tl >> 1, pr_ = tl & 1; const int l_ = (cc) * SCH + t_; \
        const LAS f32x4* q_ = (const LAS f32x4*)(yb_ + t_ * 128 + pr_ * 64); f32x4 sa_ = q_[0], sb_ = q_[8]; \
        _Pragma("unroll") for (int k_ = 1; k_ < 8; ++k_) { sa_ = sa_ + q_[k_]; sb_ = sb_ + q_[8 + k_]; } \
        *(unsigned*)(y0 + (size_t)(b * T + PADR + l_) * RW_W + h * 64 + q8 * 4 + 2 * pr_) = pk2((sa_.x + sa_.y) + (sa_.z + sa_.w), (sb_.x + sb_.y) + (sb_.z + sb_.w)); } } while (0)
    if (isld) {
        RW_ISSUE(0); asm volatile("s_waitcnt vmcnt(0)" ::: "memory"); RW_CONVERT(0);
        RW_ISSUE(1); RW_ISSUE(2);
    }
    RW_BAR();
    for (int c = 0; c < NCH; ++c) {
        if (isld) {
            if (c + 2 < NCH) { asm volatile("s_waitcnt vmcnt(3)" ::: "memory"); RW_CONVERT(c + 1); }
            else if (c + 1 < NCH) { asm volatile("s_waitcnt vmcnt(0)" ::: "memory"); RW_CONVERT(c + 1); }
            if (c > 0 && !dry) RW_STORE_Y(c - 1);
            if (c + 3 < NCH) RW_ISSUE(c + 3);
        } else if (dry != 1 && wave < 2) {
            const unsigned ba = (unsigned)(uintptr_t)(ring + (c & 1) * 6144) + i32 * 16, ca = (unsigned)(uintptr_t)(ring + (c & 1) * 6144) + 1024 + i32 * 8,
                           va = (unsigned)(uintptr_t)(ring + (c & 1) * 6144) + 1280 + (q8 * 4 + rloc) * 4, ya = (unsigned)(uintptr_t)(ypart + (c & 1) * 4096 + rloc * 32 + i32);
            f32x4 OA[4], OB[4]; f32x2 OC[4]; float OV[4];
            OC[3] = (f32x2){0.f, 0.f};
#define RW_FETCH(tt, sl) asm volatile("ds_read_b128 %0, %4 offset:%c7\n\tds_read_b128 %1, %4 offset:%c8\n\tds_read_b64 %2, %5 offset:%c7\n\tds_read_b32 %3, %6 offset:%c7" \
                : "=&v"(OA[sl]), "=&v"(OB[sl]), "=&v"(OC[sl]), "=&v"(OV[sl]) : "v"(ba), "v"(ca), "v"(va), "i"((tt) * 1536), "i"((tt) * 1536 + 512) : "memory")
            RW_FETCH(0, 0); RW_FETCH(1, 1);
            float p, p2, y;
#define RW_STEP(t, WAITN, YL1, YL2, YW, FETCHL) asm volatile( \
                "s_waitcnt lgkmcnt(" WAITN ")\n\t" \
                "v_mul_f32 %[p], %[s0], %[kk0]\n\t" \
                "v_fmac_f32 %[p], %[s1], %[kk1]\n\t" \
                YL1 "\n\t" YL2 "\n\t" \
                XL8 "\n\t" \
                "v_fmac_f32 %[s0], %[s0], %[om0]\n\t" \
                "v_fmac_f32 %[s1], %[s1], %[om1]\n\t" \
                XL4 "\n\t" \
                "v_fmac_f32 %[s0], %[vf], %[kv0]\n\t" \
                "v_fmac_f32 %[s1], %[vf], %[kv1]\n\t" \
                XL2 "\n\t" \
                YW "\n\t" \
                FETCHL \
                : [p] "=&v"(p), [p2] "=&v"(p2), [y] "=&v"(y), [s0] "+v"(s0), [s1] "+v"(s1), [nA] "=&v"(OA[((t) + 2) & 3]), [nB] "=&v"(OB[((t) + 2) & 3]), [nC] "=&v"(OC[((t) + 2) & 3]), [nV] "=&v"(OV[((t) + 2) & 3]) \
                : [kk0] "v"(OA[(t) & 3].x), [kk1] "v"(OA[(t) & 3].y), [om0] "v"(OA[(t) & 3].z), [om1] "v"(OA[(t) & 3].w), [bb0] "v"(OB[(t) & 3].x), [bb1] "v"(OB[(t) & 3].y), [kv0] "v"(OB[(t) & 3].z), [kv1] "v"(OB[(t) & 3].w), \
                  [vf] "v"(OV[(t) & 3]), [rp0] "v"(OC[((t) + 3) & 3].x), [rp1] "v"(OC[((t) + 3) & 3].y), [ba] "v"(ba), [ca] "v"(ca), [va] "v"(va), [ya] "v"(ya), \
                  [oa] "i"(((t) + 2) * 1536), [ob] "i"(((t) + 2) * 1536 + 512), [oy] "i"(((t) - 1) * 512) : "memory")
#define RW_YL1 "v_mul_f32 %[y], %[s0], %[rp0]"
#define RW_YL2 "v_fmac_f32 %[y], %[s1], %[rp1]"
#define RW_YW  "ds_write_b32 %[ya], %[y] offset:%c[oy]"
#define RW_NOP "s_nop 0"
#define RW_TAIL_F "ds_read_b128 %[nA], %[ba] offset:%c[oa]\n\t" \
                XL1 "\n\t" \
                "ds_read_b128 %[nB], %[ba] offset:%c[ob]\n\t" \
                "ds_read_b64 %[nC], %[ca] offset:%c[oa]\n\t" \
                "v_mov_b32 %[p2], %[p]\n\t" \
                "ds_read_b32 %[nV], %[va] offset:%c[oa]\n\t" \
                "s_nop 0\n\t" \
                XSW "\n\t" \
                "v_add_f32 %[p], %[p], %[p2]\n\t" \
                "v_fmac_f32 %[s0], %[p], %[bb0]\n\t" \
                "v_fmac_f32 %[s1], %[p], %[bb1]"
#define RW_TAIL_N "s_nop 0\n\t" \
                XL1 "\n\t" \
                "s_nop 1\n\t" \
                "v_mov_b32 %[p2], %[p]\n\t" \
                "s_nop 1\n\t" \
                XSW "\n\t" \
                "v_add_f32 %[p], %[p], %[p2]\n\t" \
                "v_fmac_f32 %[s0], %[p], %[bb0]\n\t" \
                "v_fmac_f32 %[s1], %[p], %[bb1]"
#define RW_ALLSTEPS() do { \
            RW_STEP(0, "4", RW_NOP, RW_NOP, RW_NOP, RW_TAIL_F); \
            RW_STEP(1, "4", RW_YL1, RW_YL2, RW_YW, RW_TAIL_F); \
            RW_STEP(2, "5", RW_YL1, RW_YL2, RW_YW, RW_TAIL_F);  RW_STEP(3, "5", RW_YL1, RW_YL2, RW_YW, RW_TAIL_F);  RW_STEP(4, "5", RW_YL1, RW_YL2, RW_YW, RW_TAIL_F); \
            RW_STEP(5, "5", RW_YL1, RW_YL2, RW_YW, RW_TAIL_F);  RW_STEP(6, "5", RW_YL1, RW_YL2, RW_YW, RW_TAIL_F);  RW_STEP(7, "5", RW_YL1, RW_YL2, RW_YW, RW_TAIL_F); \
            RW_STEP(8, "5", RW_YL1, RW_YL2, RW_YW, RW_TAIL_F);  RW_STEP(9, "5", RW_YL1, RW_YL2, RW_YW, RW_TAIL_F);  RW_STEP(10, "5", RW_YL1, RW_YL2, RW_YW, RW_TAIL_F); \
            RW_STEP(11, "5", RW_YL1, RW_YL2, RW_YW, RW_TAIL_F); RW_STEP(12, "5", RW_YL1, RW_YL2, RW_YW, RW_TAIL_F); RW_STEP(13, "5", RW_YL1, RW_YL2, RW_YW, RW_TAIL_F); \
            RW_STEP(14, "5", RW_YL1, RW_YL2, RW_YW, RW_TAIL_N); \
            RW_STEP(15, "1", RW_YL1, RW_YL2, RW_YW, RW_TAIL_N); \
            asm volatile("v_mul_f32 %[y], %[s0], %[r0]\n\tv_fmac_f32 %[y], %[s1], %[r1]\n\tds_write_b32 %[ya], %[y] offset:7680" : [y] "=&v"(y) : [s0] "v"(s0), [s1] "v"(s1), [r0] "v"(OC[3].x), [r1] "v"(OC[3].y), [ya] "v"(ya) : "memory"); \
 } while (0)
#ifdef SCAN_PROBE_NOXL
            if (dry == 2) {
#define XL8 "v_add_f32 %[p], %[p], %[p]"
#define XL4 "v_add_f32 %[p], %[p], %[p]"
#define XL2 "v_add_f32 %[p], %[p], %[p]"
#define XL1 "v_add_f32 %[p], %[p], %[p]"
#define XSW "v_add_f32 %[p], %[p], %[p2]"
                RW_ALLSTEPS();
#undef XL8
#undef XL4
#undef XL2
#undef XL1
#undef XSW
            } else
#endif
            {
#define XL8 "v_add_f32_dpp %[p], %[p], %[p] row_ror:8 row_mask:0xf bank_mask:0xf bound_ctrl:1"
#define XL4 "v_add_f32_dpp %[p], %[p], %[p] row_ror:4 row_mask:0xf bank_mask:0xf bound_ctrl:1"
#define XL2 "v_add_f32_dpp %[p], %[p], %[p] row_ror:2 row_mask:0xf bank_mask:0xf bound_ctrl:1"
#define XL1 "v_add_f32_dpp %[p], %[p], %[p] row_ror:1 row_mask:0xf bank_mask:0xf bound_ctrl:1"
#define XSW "v_permlane16_swap_b32 %[p], %[p2]"
                RW_ALLSTEPS();
            }
#undef RW_ALLSTEPS
#undef RW_STEP
#undef XL8
#undef XL4
#undef XL2
#undef XL1
#undef XSW
#undef RW_YL1
#undef RW_YL2
#undef RW_YW
#undef RW_NOP
#undef RW_TAIL_F
#undef RW_TAIL_N
#undef RW_FETCH
        }
        RW_BAR();
    }
    if (isld && !dry) RW_STORE_Y(NCH - 1);
    asm volatile("s_waitcnt vmcnt(0) lgkmcnt(0)\n\ts_barrier" ::: "memory");
#undef RW_STORE_Y
#undef RW_ISSUE
#undef RW_CONVERT
#undef RW_BAR
}

__device__ __forceinline__ int crow(int r, int hi) { return (r & 3) + 8 * (r >> 2) + 4 * hi; }
__device__ __forceinline__ void glds16(const void* gsrc, unsigned lds_dst) { unsigned keep;
    asm volatile("s_mov_b32 %0, m0\n\ts_mov_b32 m0, %2\n\ts_nop 0\n\tglobal_load_lds_dwordx4 %1, off\n\ts_mov_b32 m0, %0" : "=&s"(keep) : "v"(gsrc), "s"(lds_dst) : "memory"); }
__device__ __forceinline__ void glds4(const void* gsrc, unsigned lds_dst) { unsigned keep;
    asm volatile("s_mov_b32 %0, m0\n\ts_mov_b32 m0, %2\n\ts_nop 0\n\tglobal_load_lds_dword %1, off\n\ts_mov_b32 m0, %0" : "=&s"(keep) : "v"(gsrc), "s"(lds_dst) : "memory"); }
typedef LAS const char* lds_cptr;
constexpr int FX_K = 0, FX_V = 24576, FX_WS = 49152, FX_OST = 51200, FX_FLG = 83968, FX_KB = 84224  ;

__device__ __forceinline__ void fx_pv(f32x16* o, int vb, bf16x8 pa0, bf16x8 pa1, bf16x8 pa2, bf16x8 pa3) {
#pragma unroll
    for (int d0 = 0; d0 < 2; ++d0) { s16x4 lo[4], hi[4];
#pragma unroll
        for (int ks = 0; ks < 4; ++ks) {
            asm volatile("ds_read_b64_tr_b16 %0,%1 offset:%c2" : "=&v"(lo[ks]) : "v"(vb), "i"(d0 * 4096 + ks * 1024) : "memory");
            asm volatile("ds_read_b64_tr_b16 %0,%1 offset:%c2" : "=&v"(hi[ks]) : "v"(vb), "i"(d0 * 4096 + ks * 1024 + 512) : "memory"); }
        asm volatile("s_waitcnt lgkmcnt(0)" ::: "memory"); __builtin_amdgcn_sched_barrier(0);
#define FX_PK(k) (bf16x8){lo[k][0], lo[k][1], lo[k][2], lo[k][3], hi[k][0], hi[k][1], hi[k][2], hi[k][3]}
        o[d0] = __builtin_amdgcn_mfma_f32_32x32x16_bf16(pa0, FX_PK(0), o[d0], 0, 0, 0);
        o[d0] = __builtin_amdgcn_mfma_f32_32x32x16_bf16(pa1, FX_PK(1), o[d0], 0, 0, 0);
        o[d0] = __builtin_amdgcn_mfma_f32_32x32x16_bf16(pa2, FX_PK(2), o[d0], 0, 0, 0);
        o[d0] = __builtin_amdgcn_mfma_f32_32x32x16_bf16(pa3, FX_PK(3), o[d0], 0, 0, 0);
#undef FX_PK
    }
}
__device__ __forceinline__ float halves_max(float m) { auto rr = __builtin_amdgcn_permlane32_swap(__float_as_uint(m), __float_as_uint(m), false, false); return fmaxf(__uint_as_float(rr[0]), __uint_as_float(rr[1])); }
__device__ __forceinline__ float halves_sum(float m) { auto rr = __builtin_amdgcn_permlane32_swap(__float_as_uint(m), __float_as_uint(m), false, false); return __uint_as_float(rr[0]) + __uint_as_float(rr[1]); }

template <int KIND>
__device__ __forceinline__ void attn_unit(const ArgsL& a, Frame& F, int b, int h, int qb, float bound) {
    const int lane = F.lane, wave = F.wave, r32 = lane & 31, hi = lane >> 5;
    LAS unsigned char* lds = F.lds;
    const bf16_t* QKV = (const bf16_t*)(a.ws + WS_QKV);
    const size_t rowbase = (size_t)b * T;
    const int p0 = qb * 256;
    constexpr int QC = KIND ? 0 : 960, KC = KIND ? 320 : 1280, VC = KIND ? 640 : 1600;
    const bf16_t* Qw = QKV + (rowbase + p0 + wave * 32) * QKV_W + QC + h * 64;
    const bf16_t* Kh = QKV + rowbase * QKV_W + KC + h * 64;
    const bf16_t* Vh = QKV + rowbase * QKV_W + VC + h * 64;
    const float* kbias = (const float*)(a.ws + WS_KB2) + (size_t)(b * FX_H + h) * KBP;
    const unsigned lds0 = (unsigned)(uintptr_t)lds;
    bf16x8 qr[4];
#pragma unroll
    for (int d0 = 0; d0 < 4; ++d0) qr[d0] = *(const bf16x8*)(Qw + (size_t)r32 * QKV_W + d0 * 16 + hi * 8);
    const int qp = p0 + wave * 32 + r32;
    const bool qvalid = (qp >= PADR) && (qp < T);
    const int plast = (p0 + 255) < (T - 1) ? (p0 + 255) : (T - 1);
    const int jlast = plast >> 6, jfirst = PADR >> 6;
    const int jw = (p0 + wave * 32 + 31) >> 6;
    const bf16_t* ksrc = Kh + (size_t)lane * QKV_W + wave * 8;
    const bf16_t* vsrc = Vh + (size_t)(16 * (wave & 3) + (lane >> 2)) * QKV_W + (wave >> 2) * 32 + (lane & 3) * 8;
    const unsigned kdst = lds0 + FX_K + wave * 1024, vdst = lds0 + FX_V + wave * 1024;
#define FX_DMA(j, slot) do { glds16(ksrc + (size_t)(j) * 64 * QKV_W, (unsigned)__builtin_amdgcn_readfirstlane(kdst + (slot) * 8192)); \
                             glds16(vsrc + (size_t)(j) * 64 * QKV_W, (unsigned)__builtin_amdgcn_readfirstlane(vdst + (slot) * 8192)); \
                             if (KIND == 0) glds4(kbias + 64 * (j) + lane, (unsigned)__builtin_amdgcn_readfirstlane(lds0 + FX_KB + (slot) * 2048 + wave * 256)); } while (0)
    const int vb0 = (int)(lds0 + FX_V) + ((lane >> 4) & 1) * 32 + (lane & 3) * 8 + (4 * hi + ((lane & 15) >> 2)) * 64;
    const lds_cptr kp0 = (lds_cptr)lds + FX_K + hi * 1024 + r32 * 16;
    LAS float* wsf = (LAS float*)(lds + FX_WS) + wave * 64;
    LAS float* flg = (LAS float*)(lds + FX_FLG);
    float m_run = KIND ? 0.f : -1.0e30f, l_run = 0.f;
    f32x16 o[2]; o[0] = f32x16{}; o[1] = f32x16{};
    asm volatile("" : "+v"(qr[0]), "+v"(qr[1]), "+v"(qr[2]), "+v"(qr[3]));
    int slot = 0;
    FX_DMA(jlast, 0);
    if (jlast > jfirst) FX_DMA(jlast - 1, 1);
    for (int j = jlast; j >= jfirst; --j) {
        if (j > jfirst) { if (KIND == 0) asm volatile("s_waitcnt vmcnt(3) lgkmcnt(0)\n\ts_barrier" ::: "memory"); else asm volatile("s_waitcnt vmcnt(2) lgkmcnt(0)\n\ts_barrier" ::: "memory"); }
        else asm volatile("s_waitcnt vmcnt(0) lgkmcnt(0)\n\ts_barrier" ::: "memory");
        if (j < jlast) {
            const LAS float* fl = flg + ((j + 1) & 1) * 16;
            const f32x4 fa = *(const LAS f32x4*)(fl), fb = *(const LAS f32x4*)(fl + 4);
            bool stop;
            if constexpr (KIND == 0) {
                const float mmin = fminf(fminf(fminf(fa.x, fa.y), fminf(fa.z, fa.w)), fminf(fminf(fb.x, fb.y), fminf(fb.z, fb.w)));
                stop = (bound + fl[8] - mmin) < -150.0f;
            } else {
                const float mmax = fmaxf(fmaxf(fmaxf(fa.x, fa.y), fmaxf(fa.z, fa.w)), fmaxf(fmaxf(fb.x, fb.y), fmaxf(fb.z, fb.w)));
                stop = mmax < -150.0f;
            }
            if (stop) break;
        }
        { const int s2 = slot + 2 >= 3 ? slot - 1 : slot + 2; if (j - 2 >= jfirst) FX_DMA(j - 2, s2); }
        if (j <= jw) {
            f32x16 s0v = f32x16{}, s1v = f32x16{};
            const lds_cptr kp = kp0 + slot * 8192;
#pragma unroll
            for (int d0 = 0; d0 < 4; ++d0) {
                const bf16x8 b0 = *(const LAS bf16x8*)(kp + d0 * 2048);
                const bf16x8 b1 = *(const LAS bf16x8*)(kp + d0 * 2048 + 512);
                s0v = __builtin_amdgcn_mfma_f32_32x32x16_bf16(b0, qr[d0], s0v, 0, 0, 0);
                s1v = __builtin_amdgcn_mfma_f32_32x32x16_bf16(b1, qr[d0], s1v, 0, 0, 0);
            }
            const bool edge = (64 * j + 63 >= p0 + wave * 32) || (64 * j < PADR);
            if constexpr (KIND == 0) {
                const LAS float* kbj = (const LAS float*)(lds + FX_KB + slot * 2048 + wave * 256) + 4 * hi;
#pragma unroll
                for (int g = 0; g < 4; ++g) { const f32x4 t0 = *(const LAS f32x4*)(kbj + 8 * g), t1 = *(const LAS f32x4*)(kbj + 32 + 8 * g);
                    s0v[4 * g] += t0.x; s0v[4 * g + 1] += t0.y; s0v[4 * g + 2] += t0.z; s0v[4 * g + 3] += t0.w;
                    s1v[4 * g] += t1.x; s1v[4 * g + 1] += t1.y; s1v[4 * g + 2] += t1.z; s1v[4 * g + 3] += t1.w; }
                if (edge) {
#pragma unroll
                    for (int r = 0; r < 16; ++r) { const int key = 64 * j + crow(r, hi);
                        if (key > qp || key < PADR) s0v[r] = -INFINITY;
                        if (key + 32 > qp || key + 32 < PADR) s1v[r] = -INFINITY; }
                }
                float rm = fmaxf(s0v[0], s1v[0]);
#pragma unroll
                for (int r = 1; r < 16; ++r) rm = fmaxf(rm, fmaxf(s0v[r], s1v[r]));
                rm = halves_max(rm);
                const float m_new = fmaxf(m_run, rm);
                const float f = __builtin_amdgcn_exp2f(m_run - m_new);
                m_run = m_new;
                float rs = 0.f;
#pragma unroll
                for (int r = 0; r < 16; ++r) { s0v[r] = __builtin_amdgcn_exp2f(s0v[r] - m_new); s1v[r] = __builtin_amdgcn_exp2f(s1v[r] - m_new); rs += s0v[r] + s1v[r]; }
                rs = halves_sum(rs);
                l_run = l_run * f + rs;
                if (!__all(f == 1.0f)) {
                    if (hi == 0) wsf[r32] = f;
                    LDS_WAIT();
#pragma unroll
                    for (int d_ = 0; d_ < 2; ++d_)
#pragma unroll
                        for (int r = 0; r < 16; ++r) o[d_][r] *= wsf[crow(r, hi)];
                }
            } else {
                f32x16 l0, l1;
#pragma unroll
                for (int r = 0; r < 16; ++r) {
                    const float z0 = s0v[r], z1 = s1v[r];
                    float a0 = -(fmaxf(z0, 0.f) + __builtin_amdgcn_logf(1.f + __builtin_amdgcn_exp2f(-fabsf(z0))));
                    float a1 = -(fmaxf(z1, 0.f) + __builtin_amdgcn_logf(1.f + __builtin_amdgcn_exp2f(-fabsf(z1))));
                    if (edge) { const int key = 64 * j + crow(r, hi);
                        if (key >= qp || key < PADR) { a0 = 0.f; s0v[r] = -INFINITY; }
                        if (key + 32 >= qp || key + 32 < PADR) { a1 = 0.f; s1v[r] = -INFINITY; } }
                    l0[r] = a0; l1[r] = a1;
                }
                float A[8], SA[9], SO[9];
#pragma unroll
                for (int g = 0; g < 4; ++g) { A[g] = (l0[4 * g] + l0[4 * g + 1]) + (l0[4 * g + 2] + l0[4 * g + 3]); A[4 + g] = (l1[4 * g] + l1[4 * g + 1]) + (l1[4 * g + 2] + l1[4 * g + 3]); }
                SA[8] = 0.f; SO[8] = 0.f;
#pragma unroll
                for (int g = 7; g >= 0; --g) SA[g] = A[g] + SA[g + 1];
#pragma unroll
                for (int g = 0; g < 8; ++g) { auto rr = __builtin_amdgcn_permlane32_swap(__float_as_uint(SA[g]), __float_as_uint(SA[g]), false, false); SO[g] = __uint_as_float(hi ? rr[0] : rr[1]); }
                const float R = m_run;
#pragma unroll
                for (int g = 0; g < 8; ++g) {
                    const float E = SA[g + 1] + (hi ? SO[g + 1] : SO[g]) + R;
                    if (g < 4) { float t = E;
                        s0v[4 * g + 3] = __builtin_amdgcn_exp2f(s0v[4 * g + 3] + l0[4 * g + 3] + t); t += l0[4 * g + 3];
                        s0v[4 * g + 2] = __builtin_amdgcn_exp2f(s0v[4 * g + 2] + l0[4 * g + 2] + t); t += l0[4 * g + 2];
                        s0v[4 * g + 1] = __builtin_amdgcn_exp2f(s0v[4 * g + 1] + l0[4 * g + 1] + t); t += l0[4 * g + 1];
                        s0v[4 * g + 0] = __builtin_amdgcn_exp2f(s0v[4 * g + 0] + l0[4 * g + 0] + t);
                    } else { const int q = g - 4; float t = E;
                        s1v[4 * q + 3] = __builtin_amdgcn_exp2f(s1v[4 * q + 3] + l1[4 * q + 3] + t); t += l1[4 * q + 3];
                        s1v[4 * q + 2] = __builtin_amdgcn_exp2f(s1v[4 * q + 2] + l1[4 * q + 2] + t); t += l1[4 * q + 2];
                        s1v[4 * q + 1] = __builtin_amdgcn_exp2f(s1v[4 * q + 1] + l1[4 * q + 1] + t); t += l1[4 * q + 1];
                        s1v[4 * q + 0] = __builtin_amdgcn_exp2f(s1v[4 * q + 0] + l1[4 * q + 0] + t);
                    }
                }
                m_run = R + SA[0] + SO[0];
            }
            u32x4 pw0, pw1, pw2, pw3;
            pw0 = (u32x4){pk2(s0v[0], s0v[1]), pk2(s0v[2], s0v[3]), pk2(s0v[4], s0v[5]), pk2(s0v[6], s0v[7])};
            pw1 = (u32x4){pk2(s0v[8], s0v[9]), pk2(s0v[10], s0v[11]), pk2(s0v[12], s0v[13]), pk2(s0v[14], s0v[15])};
            pw2 = (u32x4){pk2(s1v[0], s1v[1]), pk2(s1v[2], s1v[3]), pk2(s1v[4], s1v[5]), pk2(s1v[6], s1v[7])};
            pw3 = (u32x4){pk2(s1v[8], s1v[9]), pk2(s1v[10], s1v[11]), pk2(s1v[12], s1v[13]), pk2(s1v[14], s1v[15])};
            fx_pv(o, vb0 + slot * 8192, __builtin_bit_cast(bf16x8, pw0), __builtin_bit_cast(bf16x8, pw1), __builtin_bit_cast(bf16x8, pw2), __builtin_bit_cast(bf16x8, pw3));
        }
        float mm = qvalid ? m_run : (KIND ? -3.0e38f : 3.0e38f);
        if constexpr (KIND == 0) { mm = fminf(mm, dpp_f<0x128>(mm)); mm = fminf(mm, dpp_f<0x124>(mm)); mm = fminf(mm, dpp_f<0x122>(mm)); mm = fminf(mm, dpp_f<0x121>(mm));
            { auto sw = __builtin_amdgcn_permlane16_swap(__float_as_uint(mm), __float_as_uint(mm), false, false); mm = fminf(__uint_as_float(sw[0]), __uint_as_float(sw[1])); }
            { auto sw = __builtin_amdgcn_permlane32_swap(__float_as_uint(mm), __float_as_uint(mm), false, false); mm = fminf(__uint_as_float(sw[0]), __uint_as_float(sw[1])); } }
        else { mm = fmaxf(mm, dpp_f<0x128>(mm)); mm = fmaxf(mm, dpp_f<0x124>(mm)); mm = fmaxf(mm, dpp_f<0x122>(mm)); mm = fmaxf(mm, dpp_f<0x121>(mm));
            { auto sw = __builtin_amdgcn_permlane16_swap(__float_as_uint(mm), __float_as_uint(mm), false, false); mm = fmaxf(__uint_as_float(sw[0]), __uint_as_float(sw[1])); }
            { auto sw = __builtin_amdgcn_permlane32_swap(__float_as_uint(mm), __float_as_uint(mm), false, false); mm = fmaxf(__uint_as_float(sw[0]), __uint_as_float(sw[1])); } }
        if (lane == 0) { flg[(j & 1) * 16 + wave] = mm;
            if (KIND == 0 && wave == 0) flg[(j & 1) * 16 + 8] = *(const LAS float*)(lds + FX_KB + slot * 2048); }
        slot = slot == 2 ? 0 : slot + 1;
    }
    asm volatile("s_waitcnt vmcnt(0) lgkmcnt(0)\n\ts_barrier" ::: "memory");
    float rli[16];
    if constexpr (KIND == 0) {
        if (hi == 0) wsf[32 + r32] = l_run;
        LDS_WAIT();
#pragma unroll
        for (int r = 0; r < 16; ++r) rli[r] = __builtin_amdgcn_rcpf(wsf[32 + crow(r, hi)]);
    } else {
#pragma unroll
        for (int r = 0; r < 16; ++r) rli[r] = 1.0f;
    }
    bf16_t* Ow = (bf16_t*)(a.ws + WS_YCAT) + (size_t)(KIND ? 1 : 2) * M * RW_W + (rowbase + p0 + wave * 32) * RW_W + h * 64;
    {
        LAS bf16_t* stg = (LAS bf16_t*)(lds + FX_OST) + wave * 2048;
#pragma unroll
        for (int r = 0; r < 16; ++r) { const int orow = crow(r, hi);
#pragma unroll
            for (int d0 = 0; d0 < 2; ++d0) stg[orow * 64 + d0 * 32 + r32] = f2bf(o[d0][r] * rli[r]); }
        LDS_WAIT();
#pragma unroll
        for (int i = 0; i < 4; ++i) { const int row = i * 8 + (lane >> 3), ch = lane & 7; const u32x4 v = *(const LAS u32x4*)(stg + row * 64 + ch * 8);
            const int pr = p0 + wave * 32 + row;
            if (pr >= PADR && pr < T) *(u32x4*)(Ow + (size_t)row * RW_W + ch * 8) = v; }
    }
    asm volatile("s_waitcnt lgkmcnt(0)\n\ts_barrier" ::: "memory");
#undef FX_DMA
}


constexpr int CK = 64, NCK = 257, CKB = 40960;
static_assert(LPADDED == CK * NCK, "padded steps");
__device__ __forceinline__ int swz(int row, int chunk) { return row * 128 + ((chunk ^ (row & 7)) << 4); }
__device__ __forceinline__ void ck_mm(f32x16& acc, LAS unsigned char* A, LAS unsigned char* Bt, int m0, int n0, int r32, int hi) {
#pragma unroll
    for (int ks = 0; ks < 4; ++ks) {
        const bf16x8 av = *(const LAS bf16x8*)(A + swz(m0 + r32, 2 * ks + hi));
        const bf16x8 bv = *(const LAS bf16x8*)(Bt + swz(n0 + r32, 2 * ks + hi));
        acc = __builtin_amdgcn_mfma_f32_32x32x16_bf16(av, bv, acc, 0, 0, 0);
    }
}
__device__ __forceinline__ void ck_store_t(LAS unsigned char* dst, const f32x16& acc, int m0, int n0, int r32, int hi) {
#pragma unroll
    for (int g = 0; g < 4; ++g) { const u32x2 w = {pk2(acc[4 * g], acc[4 * g + 1]), pk2(acc[4 * g + 2], acc[4 * g + 3])};
        *(LAS u32x2*)(dst + swz(n0 + r32, (m0 >> 3) + g) + hi * 8) = w; }
}
constexpr int CA_KAP = 0, CA_BET = 8192, CA_CHI = 16384, CA_RHO = 24576, CA_VMT = 32768, CA_BHT = 40960, CA_KHT = 49152, CA_AK = 57344, CA_RB = 65536, CA_RK = 73728,
              CA_AB = 81920  , CA_RHS = 98304  , CA_G64 = MISC_OFF + 2048  , CA_SCR = MISC_OFF + 4096  ;

#ifndef CA_STAGES
#define CA_STAGES 15
#endif
__device__ __forceinline__ void phase_chunkA(const ArgsL& a, Frame& F, const bool dry = false) {
    const int wave = F.wave;
    LAS unsigned char* L = F.lds;
    u32x4 pre6[6];
    for (int id = F.bx; id < 12 * NCK; id += (int)gridDim.x) {
        int tid = F.tid, lane, r32, hi;
#define CK_FRESH() do { asm volatile("" : "+v"(tid)); lane = tid & 63; r32 = lane & 31; hi = lane >> 5; } while (0)
        CK_FRESH();
        const int bh = id / NCK, c = id - bh * NCK;
        unsigned char* blk = a.ws + WS_RW + ((size_t)bh * LPADDED + (size_t)c * CK) * 768;
        {
            if (id == F.bx) {
#pragma unroll
                for (int q6 = 0; q6 < 6; ++q6) pre6[q6] = *(const u32x4*)(blk + (size_t)(tid + q6 * NTHR) * 16);
            }
#pragma unroll
            for (int q6 = 0; q6 < 6; ++q6) *(LAS u32x4*)(L + CA_AB + (tid + q6 * NTHR) * 16) = pre6[q6];
            __syncthreads();
            const int k = tid & 63, tq = tid >> 6;
            const LAS _Float16* src = (const LAS _Float16*)(L + CA_AB) + (tq * 8) * 384 + k;
            float kk[8], w[8], bb[8], kp[8], rr[8], vv[8];
#pragma unroll
            for (int e = 0; e < 8; ++e) { kk[e] = (float)src[e * 384]; w[e] = 1.f + (float)src[e * 384 + 64]; bb[e] = -(float)src[e * 384 + 128];
                kp[e] = (float)src[e * 384 + 192]; rr[e] = (float)src[e * 384 + 256]; vv[e] = (float)src[e * 384 + 320]; }
            float g[8]; g[0] = w[0];
#pragma unroll
            for (int e = 1; e < 8; ++e) g[e] = g[e - 1] * w[e];
            LAS float* scr = (LAS float*)(L + CA_SCR);
            scr[tq * 64 + k] = g[7];
            __syncthreads();
            {
                const int idn = id + (int)gridDim.x;
                if (idn < 12 * NCK) { const int bhn = idn / NCK, cn = idn - bhn * NCK; const unsigned char* bn_ = a.ws + WS_RW + ((size_t)bhn * LPADDED + (size_t)cn * CK) * 768;
#pragma unroll
                    for (int q6 = 0; q6 < 6; ++q6) pre6[q6] = *(const u32x4*)(bn_ + (size_t)(tid + q6 * NTHR) * 16); }
            }
            float pre = 1.f, tot = 1.f;
#pragma unroll
            for (int q = 0; q < 8; ++q) { const float s = scr[q * 64 + k]; if (q < tq) pre *= s; tot *= s; }
            if (tq == 0) ((LAS float*)(L + CA_G64))[k] = tot;
            unsigned bh4[4], kh4[4], vm4[4];
            float Gp = pre;
#pragma unroll
            for (int e = 0; e < 8; ++e) {
                const int t = tq * 8 + e; const float G = pre * g[e], iG = __builtin_amdgcn_rcpf(G);
                const float kap = kk[e] * Gp, bet = bb[e] * iG, chi = kp[e] * iG, rho = rr[e] * G;
                const int o = swz(t, k >> 3) + (k & 7) * 2;
                *(LAS unsigned short*)(L + CA_KAP + o) = f2bf(kap); *(LAS unsigned short*)(L + CA_BET + o) = f2bf(bet);
                *(LAS unsigned short*)(L + CA_CHI + o) = f2bf(chi); *(LAS unsigned short*)(L + CA_RHO + o) = f2bf(rho);
                ((LAS float*)(L + CA_RHS))[t * 128 + k] = kap;
                const float bhv = bet * tot, khv = chi * tot;
                if (e & 1) { bh4[e >> 1] |= (unsigned)f2bf(bhv) << 16; kh4[e >> 1] |= (unsigned)f2bf(khv) << 16; vm4[e >> 1] |= (unsigned)f2bf(vv[e]) << 16; }
                else { bh4[e >> 1] = f2bf(bhv); kh4[e >> 1] = f2bf(khv); vm4[e >> 1] = f2bf(vv[e]); }
                Gp = G;
            }
            *(LAS u32x4*)(L + CA_BHT + swz(k, tq)) = (u32x4){bh4[0], bh4[1], bh4[2], bh4[3]};
            *(LAS u32x4*)(L + CA_KHT + swz(k, tq)) = (u32x4){kh4[0], kh4[1], kh4[2], kh4[3]};
            *(LAS u32x4*)(L + CA_VMT + swz(k, tq)) = (u32x4){vm4[0], vm4[1], vm4[2], vm4[3]};
        }
        __syncthreads();
        CK_FRESH();
        if (!dry || (CA_STAGES & 2)) {
            const int p = wave & 3, nb = wave >> 2;
            LAS unsigned char* Am = L + ((p & 1) ? CA_CHI : CA_BET);
            LAS unsigned char* Bm = L + ((p & 2) ? CA_RHO : CA_KAP);
#pragma unroll
            for (int mb = 0; mb < 2; ++mb) {
                f32x16 acc = f32x16{};
                if (!(mb == 1 && nb == 0)) ck_mm(acc, Am, Bm, mb * 32, nb * 32, r32, hi);
                const int t = nb * 32 + r32;
#pragma unroll
                for (int i = 0; i < 16; ++i) { const int j = mb * 32 + crow(i, hi); const bool keep = (p & 2) ? (j <= t) : (j < t); if (!keep) acc[i] = 0.f; }
                if (p == 0) {
#pragma unroll
                    for (int gq = 0; gq < 4; ++gq) { LAS float* ab_ = (LAS float*)(L + CA_AB) + t * 64 + (mb * 8 + 2 * gq + hi);
                        ab_[0] = acc[4 * gq]; ab_[16] = acc[4 * gq + 1]; ab_[32] = acc[4 * gq + 2]; ab_[48] = acc[4 * gq + 3]; }
                } else ck_store_t(L + (p == 1 ? CA_AK : p == 2 ? CA_RB : CA_RK), acc, mb * 32, nb * 32, r32, hi);
            }
        }
        __syncthreads();
        CK_FRESH();
        if (wave < 4 && (!dry || (CA_STAGES & 2))) {
            const int mb = wave >> 1, nb = wave & 1;
            f32x16 acc = f32x16{};
            ck_mm(acc, L + CA_AK, L + CA_VMT, mb * 32, nb * 32, r32, hi);
#pragma unroll
            for (int i = 0; i < 16; ++i) ((LAS float*)(L + CA_RHS))[(mb * 32 + crow(i, hi)) * 128 + 64 + nb * 32 + r32] = acc[i];
        }
        __syncthreads();
        CK_FRESH();
        if (!dry || (CA_STAGES & 4)) {
            const int col = tid >> 2, p = tid & 3;
            unsigned abv = (unsigned)(uintptr_t)(L + CA_AB) + p * 64; asm volatile("" : "+v"(abv));
            const LAS float* ab = (const LAS float*)(uintptr_t)abv;
            const LAS float* rhs = (const LAS float*)(L + CA_RHS) + col;
            float xo[16];
#pragma unroll
            for (int i = 0; i < 16; ++i) xo[i] = 0.f;
#pragma unroll
            for (int tg = 0; tg < 64; tg += 4) {
                f32x4 av[4][4]; float rv[4];
#pragma unroll
                for (int r = 0; r < 4; ++r) { rv[r] = rhs[(tg + r) * 128];
#pragma unroll
                    for (int i4 = 0; i4 < (tg + r + 15) / 16; ++i4) av[r][i4] = *(const LAS f32x4*)(ab + (tg + r) * 64 + 4 * i4); }
#pragma unroll
                for (int r = 0; r < 4; ++r) { const int t = tg + r;
                    float s0 = (p == 0) ? rv[r] : 0.f, s1 = 0.f;
#pragma unroll
                    for (int i4 = 0; i4 < (t + 15) / 16; ++i4) {
                        s0 -= av[r][i4].x * xo[4 * i4]; s1 -= av[r][i4].y * xo[4 * i4 + 1]; s0 -= av[r][i4].z * xo[4 * i4 + 2]; s1 -= av[r][i4].w * xo[4 * i4 + 3]; }
                    float sx = s0 + s1;
                    sx += dpp_f<0xB1>(sx);
                    sx += dpp_f<0x4E>(sx);
                    if ((t & 3) == p) xo[t >> 2] = sx;
                    asm volatile("" : "+v"(xo[t >> 2]));
                }
                __builtin_amdgcn_sched_barrier(0);
            }
            LAS unsigned char* dst = L + (col < 64 ? CA_KAP : CA_BET);
            const int rowc = col & 63;
#pragma unroll
            for (int i = 0; i < 16; ++i) { const int tt = 4 * i + p; *(LAS unsigned short*)(dst + swz(rowc, tt >> 3) + (tt & 7) * 2) = f2bf(-xo[i]); }
        }
        __syncthreads();
        CK_FRESH();
        if (!dry || (CA_STAGES & 8)) {
            const int ty = wave >> 1;
            LAS unsigned char* nW1 = L + CA_KAP; LAS unsigned char* nW2 = L + CA_BET;
#pragma unroll
            for (int qq = 0; qq < 2; ++qq) {
                const int q = (wave & 1) * 2 + qq, qa = q >> 1, qb = q & 1;
                f32x16 acc = f32x16{};
                if (ty == 0) {
                    const int t = qa * 32 + r32;
#pragma unroll
                    for (int gq = 0; gq < 4; ++gq) { const u32x2 rv = *(const LAS u32x2*)(L + CA_RHO + swz(t, qb * 4 + gq) + hi * 8);
                        acc[4 * gq] = bf_lo(rv.x); acc[4 * gq + 1] = bf_hi(rv.x); acc[4 * gq + 2] = bf_lo(rv.y); acc[4 * gq + 3] = bf_hi(rv.y); }
                    ck_mm(acc, nW1, L + CA_RB, qb * 32, qa * 32, r32, hi);
                } else if (ty == 1) {
                    ck_mm(acc, nW1, L + CA_BHT, qb * 32, qa * 32, r32, hi);
                    if (qa == qb) { const float g64 = ((const LAS float*)(L + CA_G64))[qa * 32 + r32];
#pragma unroll
                        for (int i = 0; i < 16; ++i) if (crow(i, hi) == r32) acc[i] += g64; }
                } else if (ty == 2) {
                    ck_mm(acc, L + CA_KHT, L + CA_VMT, qb * 32, qa * 32, r32, hi);
                    ck_mm(acc, L + CA_BHT, nW2, qb * 32, qa * 32, r32, hi);
                } else {
                    ck_mm(acc, L + CA_RK, L + CA_VMT, qb * 32, qa * 32, r32, hi);
                    ck_mm(acc, L + CA_RB, nW2, qb * 32, qa * 32, r32, hi);
                }
                if (dry) { float sink = acc[0] + acc[5] + acc[10] + acc[15]; asm volatile("" :: "v"(sink)); }
                else if (ty < 2) {
                    unsigned char* o = blk + (ty == 0 ? 8192 : 0) + (size_t)(((qa * 2 + qb) * 2) * 1024) + lane * 16;
#pragma unroll
                    for (int ks = 0; ks < 2; ++ks)
                        *(u32x4*)(o + ks * 1024) = (u32x4){pk2(acc[8 * ks], acc[8 * ks + 1]), pk2(acc[8 * ks + 2], acc[8 * ks + 3]), pk2(acc[8 * ks + 4], acc[8 * ks + 5]), pk2(acc[8 * ks + 6], acc[8 * ks + 7])};
                } else if (ty == 2) {
                    unsigned char* o = blk + 16384 + (qa * 2 + qb) * 4096 + lane * 16;
#pragma unroll
                    for (int g = 0; g < 4; ++g) *(f32x4*)(o + g * 1024) = (f32x4){acc[4 * g], acc[4 * g + 1], acc[4 * g + 2], acc[4 * g + 3]};
                } else {
                    unsigned char* o = blk + 32768 + (qa * 2 + qb) * 2048 + lane * 8;
#pragma unroll
                    for (int g = 0; g < 4; ++g) *(u32x2*)(o + g * 512) = (u32x2){pk2(acc[4 * g], acc[4 * g + 1]), pk2(acc[4 * g + 2], acc[4 * g + 3])};
                }
            }
        }
        __syncthreads();
    }
}

__device__ __forceinline__ void rwkv_chunkB(const ArgsL& a, Frame& F, int bh) {
    const int lane = F.lane, wave = F.wave, r32 = lane & 31, hi = lane >> 5;
    const int b = bh / RW_H, h = bh % RW_H;
    LAS unsigned char* L = F.lds;
    const unsigned char* base = a.ws + WS_RW + (size_t)bh * LPADDED * 768;
    bf16_t* y0 = (bf16_t*)(a.ws + WS_YCAT);
    const bool isld = (wave & 2) != 0; const int lw = (wave & 1) + ((wave >> 2) << 1);
    LAS unsigned char* yimg0 = L + 3 * CKB; LAS unsigned char* yimg1 = L + MISC_OFF + 8192;
#define CB_ISSUE(cc) do { const unsigned char* s_ = base + (size_t)(cc) * CK * 768 + (size_t)lw * 1024 + lane * 16; LAS unsigned char* d_ = L + ((cc) % 3) * CKB + lw * 1024; \
        _Pragma("unroll") for (int r_ = 0; r_ < 10; ++r_) __builtin_amdgcn_global_load_lds((const unsigned*)(s_ + r_ * 4096), (LAS unsigned*)(d_ + r_ * 4096), 16, 0, 0); } while (0)
#define CB_YOUT(cc) do { const LAS unsigned char* im_ = ((cc) & 1) ? yimg1 : yimg0; \
        _Pragma("unroll") for (int r_ = 0; r_ < 8; ++r_) { const int t_ = r_ * 8 + (lane >> 3), l_ = (cc) * CK + t_; const u32x4 v_ = *(const LAS u32x4*)(im_ + t_ * 128 + (lane & 7) * 16); \
            if (l_ < LTOK) *(u32x4*)(y0 + (size_t)(b * T + PADR + l_) * RW_W + h * 64 + (lane & 7) * 8) = v_; } } while (0)
    if (isld) { CB_ISSUE(0); CB_ISSUE(1); asm volatile("s_waitcnt vmcnt(10)" ::: "memory"); }
    asm volatile("s_waitcnt lgkmcnt(0)\n\ts_barrier" ::: "memory");
    f32x16 Z0 = f32x16{}, Z1 = f32x16{};
    for (int c = 0; c < NCK; ++c) {
        if (isld) {
            if (wave == 6 && c > 0) CB_YOUT(c - 1);
            if (c + 2 < NCK) CB_ISSUE(c + 2);
            if (c + 2 < NCK) asm volatile("s_waitcnt vmcnt(10)" ::: "memory"); else asm volatile("s_waitcnt vmcnt(0)" ::: "memory");
        } else if (wave < 2) {
            const LAS unsigned char* S = L + (c % 3) * CKB;
            LAS unsigned char* yim = (c & 1) ? yimg1 : yimg0;
            const int vb = wave;
            bf16x8 zf[2][2];
#pragma unroll
            for (int ks = 0; ks < 2; ++ks) {
                zf[0][ks] = __builtin_bit_cast(bf16x8, (u32x4){pk2(Z0[8 * ks], Z0[8 * ks + 1]), pk2(Z0[8 * ks + 2], Z0[8 * ks + 3]), pk2(Z0[8 * ks + 4], Z0[8 * ks + 5]), pk2(Z0[8 * ks + 6], Z0[8 * ks + 7])});
                zf[1][ks] = __builtin_bit_cast(bf16x8, (u32x4){pk2(Z1[8 * ks], Z1[8 * ks + 1]), pk2(Z1[8 * ks + 2], Z1[8 * ks + 3]), pk2(Z1[8 * ks + 4], Z1[8 * ks + 5]), pk2(Z1[8 * ks + 6], Z1[8 * ks + 7])});
            }
#pragma unroll
            for (int tb = 0; tb < 2; ++tb) {
                f32x16 acc;
                const LAS unsigned char* yt = S + 32768 + (vb * 2 + tb) * 2048 + lane * 8;
#pragma unroll
                for (int g = 0; g < 4; ++g) { const u32x2 w = *(const LAS u32x2*)(yt + g * 512); acc[4 * g] = bf_lo(w.x); acc[4 * g + 1] = bf_hi(w.x); acc[4 * g + 2] = bf_lo(w.y); acc[4 * g + 3] = bf_hi(w.y); }
#pragma unroll
                for (int kb2 = 0; kb2 < 2; ++kb2)
#pragma unroll
                    for (int ks = 0; ks < 2; ++ks) { const bf16x8 pa = *(const LAS bf16x8*)(S + 8192 + ((tb * 2 + kb2) * 2 + ks) * 1024 + lane * 16);
                        acc = __builtin_amdgcn_mfma_f32_32x32x16_bf16(pa, zf[kb2][ks], acc, 0, 0, 0); }
#pragma unroll
                for (int i = 0; i < 16; ++i) *(LAS unsigned short*)(yim + (tb * 32 + crow(i, hi)) * 128 + (vb * 32 + r32) * 2) = f2bf(acc[i]);
            }
            f32x16 N0, N1;
            { const LAS unsigned char* n0 = S + 16384 + (vb * 2 + 0) * 4096 + lane * 16; const LAS unsigned char* n1 = S + 16384 + (vb * 2 + 1) * 4096 + lane * 16;
#pragma unroll
              for (int g = 0; g < 4; ++g) { const f32x4 u0 = *(const LAS f32x4*)(n0 + g * 1024), u1 = *(const LAS f32x4*)(n1 + g * 1024);
                  N0[4 * g] = u0.x; N0[4 * g + 1] = u0.y; N0[4 * g + 2] = u0.z; N0[4 * g + 3] = u0.w; N1[4 * g] = u1.x; N1[4 * g + 1] = u1.y; N1[4 * g + 2] = u1.z; N1[4 * g + 3] = u1.w; } }
#pragma unroll
            for (int kb2 = 0; kb2 < 2; ++kb2)
#pragma unroll
                for (int ks = 0; ks < 2; ++ks) {
                    const bf16x8 m0 = *(const LAS bf16x8*)(S + ((0 * 2 + kb2) * 2 + ks) * 1024 + lane * 16);
                    const bf16x8 m1 = *(const LAS bf16x8*)(S + ((1 * 2 + kb2) * 2 + ks) * 1024 + lane * 16);
                    N0 = __builtin_amdgcn_mfma_f32_32x32x16_bf16(m0, zf[kb2][ks], N0, 0, 0, 0);
                    N1 = __builtin_amdgcn_mfma_f32_32x32x16_bf16(m1, zf[kb2][ks], N1, 0, 0, 0);
                }
            Z0 = N0; Z1 = N1;
        }
        asm volatile("s_waitcnt lgkmcnt(0)\n\ts_barrier" ::: "memory");
    }
    if (wave == 6) CB_YOUT(NCK - 1);
    asm volatile("s_waitcnt vmcnt(0) lgkmcnt(0)\n\ts_barrier" ::: "memory");
#undef CB_ISSUE
#undef CB_YOUT
}

constexpr int N_FX_UNITS = 65 * 10, N_SB_UNITS = 65 * 10, N_RW_WG = 192;
#ifndef REP_SCAN
#define REP_SCAN 1
#endif
#ifndef REP_SCAN_DRY
#define REP_SCAN_DRY 0
#endif
#ifndef REP_FOX
#define REP_FOX 1
#endif
#ifndef REP_SB
#define REP_SB 1
#endif
__device__ __forceinline__ void phase_mix(const ArgsL& a, Frame& F, int layer) {
#ifdef SEQ_SCAN
    if (F.bx < N_RW_WG) { int nr = REP_SCAN; asm volatile("" : "+s"(nr)); for (int r = 0; r < nr; ++r) rwkv_scan(a, F, F.bx, (r + 1 < nr) ? REP_SCAN_DRY : 0); }
#else
#ifndef REP_CHB
#define REP_CHB 1
#endif
    if (F.bx < 12) { int nr = REP_CHB; asm volatile("" : "+s"(nr)); for (int r = 0; r < nr; ++r) rwkv_chunkB(a, F, F.bx); }
#endif
    float gqm = fabsf(a.in(I_QG)[layer * 64 + F.lane]), gkm = fabsf(a.in(I_KG)[layer * 64 + F.lane]);
#pragma unroll
    for (int off = 1; off < 64; off <<= 1) { gqm = fmaxf(gqm, __shfl_xor(gqm, off)); gkm = fmaxf(gkm, __shfl_xor(gkm, off)); }
    const float bound = 64.0f * C2 * gqm * gkm * 1.02f + 0.5f;
    unsigned* head = (unsigned*)(a.ws + WS_CTL) + CW_QUEUE + 64 * layer;
    for (;;) {
        if (F.tid == 0) F.MISC[16] = __hip_atomic_fetch_add(head, 1u, __ATOMIC_RELAXED, __HIP_MEMORY_SCOPE_AGENT);
        __syncthreads();
        const int u = (int)F.MISC[16];
        __syncthreads();
        if (u >= N_FX_UNITS + N_SB_UNITS) break;
        if (u < N_FX_UNITS) { const int qb = 64 - u / 10, bh = u % 10; int nr = REP_FOX; asm volatile("" : "+s"(nr)); for (int r = 0; r < nr; ++r) attn_unit<0>(a, F, bh / FX_H, bh % FX_H, qb, bound); }
        else { const int v = u - N_FX_UNITS; const int qb = 64 - v / 10, bh = v % 10; int nr = REP_SB; asm volatile("" : "+s"(nr)); for (int r = 0; r < nr; ++r) attn_unit<1>(a, F, bh / SB_H, bh % SB_H, qb, bound); }
    }
}

__device__ __forceinline__ void phase_post(const ArgsL& a, Frame& F, int layer, const bool dry = false) {
    const int gw = F.bx * NWAVES + F.wave, NGW = gridDim.x * NWAVES, lane = F.lane;
    bf16_t* Y0 = (bf16_t*)(a.ws + WS_YCAT); const bf16_t* BN = (const bf16_t*)(a.ws + WS_BN);
    float lg[6], lb[6];
    { const float* g = a.in(I_LNG) + layer * RW_W + lane; const float* bb = a.in(I_LNB) + layer * RW_W + lane;
#pragma unroll
      for (int hh = 0; hh < 6; ++hh) { lg[hh] = g[hh * 64]; lb[hh] = bb[hh * 64]; } }
    unsigned short yv[6], bv[6], yn[6], bn[6];
    int m = gw;
    if (m < M) {
#pragma unroll
        for (int hh = 0; hh < 6; ++hh) { yv[hh] = Y0[(size_t)m * RW_W + hh * 64 + lane]; bv[hh] = BN[(size_t)m * RW_W + hh * 64 + lane]; }
    }
    for (; m < M; m += NGW) {
        const int mn = m + NGW;
        if (mn < M) {
#pragma unroll
            for (int hh = 0; hh < 6; ++hh) { yn[hh] = Y0[(size_t)mn * RW_W + hh * 64 + lane]; bn[hh] = BN[(size_t)mn * RW_W + hh * 64 + lane]; }
        }
        const int b = m / T, p = m - b * T;
        bf16_t* yp = Y0 + (size_t)m * RW_W + lane;
        if (p < PADR) {
            if (!dry) {
#pragma unroll
            for (int hh = 0; hh < 6; ++hh) yp[hh * 64] = 0; }
        } else {
#pragma unroll
            for (int hh = 0; hh < 6; ++hh) {
                const float y = bf2f(yv[hh]);
                const float mean = wave_sum(y) * (1.f / 64.f);
                const float d = y - mean;
                const float var = wave_sum(d * d) * (1.f / 64.f);
                const unsigned short r_ = f2bf(d * (1.0f / sqrtf(var + 64e-5f)) * lg[hh] + lb[hh] + bf2f(bv[hh])); if (!dry) yp[hh * 64] = r_; else asm volatile("" :: "v"(r_));
            }
        }
#pragma unroll
        for (int hh = 0; hh < 6; ++hh) { yv[hh] = yn[hh]; bv[hh] = bn[hh]; }
    }
    if (!dry) for (int it = gw; it < 2 * M; it += NGW) {
        const int sl = it / M, m2 = it - sl * M; const int b = m2 / T, p = m2 - b * T;
        bf16_t* row = Y0 + (size_t)(sl + 1) * M * RW_W + (size_t)m2 * RW_W;
        if (p < PADR) { for (int c = lane; c < RW_W / 2; c += 64) ((unsigned*)row)[c] = 0u; }
        else if (lane < 32) ((unsigned*)(row + 320))[lane] = 0u;
    }
}

struct EpiInproj { static constexpr bool PERM = true, AFTER_DRAIN = false; bf16_t* ush; bf16_t* qkv;
    __device__ __forceinline__ void operator()(const f32x4 (&acc)[2][2][4][2], const pg8::Unit& u, int wr, int wc, int fr, int fq) const {
        asm volatile("" : "+v"(fr), "+v"(fq));
        const int row0 = u.pm * 256 + wr * 64 + fr, colt = u.pn * 256 + wc * 32 + 8 * fq;
#pragma unroll
        for (int ai = 0; ai < 2; ++ai)
#pragma unroll
            for (int m = 0; m < 4; ++m) { const size_t row = (size_t)(row0 + ai * 128 + m * 16);
#pragma unroll
                for (int bj = 0; bj < 2; ++bj) { const int col = colt + bj * 128; const f32x4 v0 = acc[ai][bj][m][0], v1 = acc[ai][bj][m][1];
                    const float sc = (col >= SHIFT_W && col < SHIFT_W + 320) ? C2 : 1.0f;
                    u32x4 w; w.x = pk2(v0[0] * sc, v0[1] * sc); w.y = pk2(v0[2] * sc, v0[3] * sc); w.z = pk2(v1[0] * sc, v1[1] * sc); w.w = pk2(v1[2] * sc, v1[3] * sc);
                    if (col < SHIFT_W) *(u32x4*)(ush + row * SHIFT_W + col) = w;
                    else if (col < SHIFT_W + QKV_W) *(u32x4*)(qkv + row * QKV_W + (col - SHIFT_W)) = w; } }
    }
};
struct EpiGates { static constexpr bool PERM = true, AFTER_DRAIN = false; bf16_t* gates;
    __device__ __forceinline__ void operator()(const f32x4 (&acc)[2][2][4][2], const pg8::Unit& u, int wr, int wc, int fr, int fq) const {
        asm volatile("" : "+v"(fr), "+v"(fq));
        const int row0 = u.pm * 256 + wr * 64 + fr, colt = u.pn * 256 + wc * 32 + 8 * fq;
#pragma unroll
        for (int ai = 0; ai < 2; ++ai)
#pragma unroll
            for (int m = 0; m < 4; ++m) { const size_t row = (size_t)(row0 + ai * 128 + m * 16);
#pragma unroll
                for (int bj = 0; bj < 2; ++bj) { const int col = colt + bj * 128; f32x4 v0 = acc[ai][bj][m][0], v1 = acc[ai][bj][m][1];
#pragma unroll
                    for (int q = 0; q < 4; ++q) { v0[q] = __builtin_amdgcn_rcpf(1.f + __builtin_amdgcn_exp2f(-v0[q] * LOG2E)); v1[q] = __builtin_amdgcn_rcpf(1.f + __builtin_amdgcn_exp2f(-v1[q] * LOG2E)); }
                    u32x4 w; w.x = pk2(v0[0], v0[1]); w.y = pk2(v0[2], v0[3]); w.z = pk2(v1[0], v1[1]); w.w = pk2(v1[2], v1[3]);
                    *(u32x4*)(gates + row * 3072 + col) = w; } }
    }
};
struct EpiMerge { static constexpr bool PERM = true, AFTER_DRAIN = false; const bf16_t* gates; bf16_t* merged;
    __device__ __forceinline__ void operator()(const f32x4 (&acc)[2][2][4][2], const pg8::Unit& u, int wr, int wc, int fr, int fq) const {
        asm volatile("" : "+v"(fr), "+v"(fq));
        const int br = u.pn >> 2, pn = u.pn & 3, pm = u.pm - br * 129;
        const int row0 = pm * 256 + wr * 64 + fr, colt = pn * 256 + wc * 32 + 8 * fq;
        u32x4 gn[2], on[2];
#define MRG_LOAD(q) do { const size_t row_ = (size_t)(row0 + ((q) >> 2) * 128 + ((q) & 3) * 16); \
            _Pragma("unroll") for (int bj = 0; bj < 2; ++bj) { const int col_ = colt + bj * 128; gn[bj] = *(const u32x4*)(gates + row_ * 3072 + br * 1024 + col_); \
                on[bj] = (u32x4){0u, 0u, 0u, 0u}; if (br > 0) on[bj] = *(const u32x4*)(merged + row_ * D + col_); } } while (0)
        MRG_LOAD(0);
#pragma unroll
        for (int q = 0; q < 8; ++q) {
            const int ai = q >> 2, m = q & 3; const size_t row = (size_t)(row0 + ai * 128 + m * 16);
            u32x4 g[2], o[2];
#pragma unroll
            for (int bj = 0; bj < 2; ++bj) { g[bj] = gn[bj]; o[bj] = on[bj]; }
            if (q < 7) MRG_LOAD(q + 1);
#pragma unroll
            for (int bj = 0; bj < 2; ++bj) { const int col = colt + bj * 128; const f32x4 v0 = acc[ai][bj][m][0], v1 = acc[ai][bj][m][1];
                u32x4 w;
                w.x = pk2(bf_lo(g[bj].x) * v0[0] + bf_lo(o[bj].x), bf_hi(g[bj].x) * v0[1] + bf_hi(o[bj].x));
                w.y = pk2(bf_lo(g[bj].y) * v0[2] + bf_lo(o[bj].y), bf_hi(g[bj].y) * v0[3] + bf_hi(o[bj].y));
                w.z = pk2(bf_lo(g[bj].z) * v1[0] + bf_lo(o[bj].z), bf_hi(g[bj].z) * v1[1] + bf_hi(o[bj].z));
                w.w = pk2(bf_lo(g[bj].w) * v1[2] + bf_lo(o[bj].w), bf_hi(g[bj].w) * v1[3] + bf_hi(o[bj].w));
                *(u32x4*)(merged + row * D + col) = w; }
            __builtin_amdgcn_sched_barrier(0);
        }
#undef MRG_LOAD
    }
};
struct MergeOrder { int G, c, ntau;
    __device__ __forceinline__ bool next(int i, pg8::Unit& u) const { const int it = i / 3, br = i - 3 * it; const long tau = (long)it * G + c; if (tau >= ntau) return false;
        const int t = (int)(tau % 516); u.pm = br * 129 + (t >> 2); u.pn = br * 4 + (t & 3); return true; }
    __device__ __forceinline__ void a_ready(const pg8::Unit&) const {}
    __device__ __forceinline__ void done(const pg8::Unit&) const {}
};
struct EpiOut { static constexpr bool PERM = true, AFTER_DRAIN = false; bf16_t* hb;
    __device__ __forceinline__ void operator()(const f32x4 (&acc)[2][2][4][2], const pg8::Unit& u, int wr, int wc, int fr, int fq) const {
        asm volatile("" : "+v"(fr), "+v"(fq));
        const int row0 = u.pm * 256 + wr * 64 + fr, colt = u.pn * 256 + wc * 32 + 8 * fq;
        u32x4 hn[2];
#define OUT_LOAD(q) do { const bf16_t* p_ = hb + (size_t)(row0 + ((q) >> 2) * 128 + ((q) & 3) * 16) * D + colt; hn[0] = *(const u32x4*)(p_); hn[1] = *(const u32x4*)(p_ + 128); } while (0)
        OUT_LOAD(0);
#pragma unroll
        for (int q = 0; q < 8; ++q) {
            const int ai = q >> 2, m = q & 3;
            bf16_t* hp = hb + (size_t)(row0 + ai * 128 + m * 16) * D + colt; const u32x4 h0 = hn[0], h1 = hn[1];
            if (q < 7) OUT_LOAD(q + 1);
#pragma unroll
            for (int bj = 0; bj < 2; ++bj) { const u32x4 hh = bj ? h1 : h0; const f32x4 v0 = acc[ai][bj][m][0], v1 = acc[ai][bj][m][1];
                u32x4 w; w.x = pk2(bf_lo(hh.x) + v0[0], bf_hi(hh.x) + v0[1]); w.y = pk2(bf_lo(hh.y) + v0[2], bf_hi(hh.y) + v0[3]);
                w.z = pk2(bf_lo(hh.z) + v1[0], bf_hi(hh.z) + v1[1]); w.w = pk2(bf_lo(hh.w) + v1[2], bf_hi(hh.w) + v1[3]);
                *(u32x4*)(hp + bj * 128) = w; }
            __builtin_amdgcn_sched_barrier(0);
        }
#undef OUT_LOAD
    }
};
struct MoeOrder { const volatile LAS int* tb; int ntile, npt, G, c, rep;
    __device__ __forceinline__ bool next(int i, pg8::Unit& u) const { long L = (long)i * G + c; if (L >= (long)ntile * npt * rep) return false; L %= (long)ntile * npt;
        const int tau = (int)(L / npt), j = (int)(L - (long)tau * npt); int e = 0;
#pragma unroll
        for (int k = 1; k < 16; ++k) e += (tau >= tb[k]) ? 1 : 0;
        u.pm = tau; u.pn = __builtin_amdgcn_readfirstlane(e) * npt + j; return true; }
    __device__ __forceinline__ void a_ready(const pg8::Unit&) const {}
    __device__ __forceinline__ void done(const pg8::Unit&) const {}
};
struct EpiMoeUp { static constexpr bool PERM = true, AFTER_DRAIN = false; bf16_t* hs;
    __device__ __forceinline__ void operator()(const f32x4 (&acc)[2][2][4][2], const pg8::Unit& u, int wr, int wc, int fr, int fq) const {
        asm volatile("" : "+v"(fr), "+v"(fq));
        const int row0 = u.pm * 256 + wr * 64 + fr, col = (u.pn & 1) * 128 + wc * 32 + 8 * fq;
#pragma unroll
        for (int ai = 0; ai < 2; ++ai)
#pragma unroll
            for (int m = 0; m < 4; ++m) { const size_t row = (size_t)(row0 + ai * 128 + m * 16); float r[8];
#pragma unroll
                for (int n = 0; n < 2; ++n)
#pragma unroll
                    for (int q = 0; q < 4; ++q) { const float gte = acc[ai][0][m][n][q], up = acc[ai][1][m][n][q]; r[4 * n + q] = gte * __builtin_amdgcn_rcpf(1.f + __builtin_amdgcn_exp2f(-gte * LOG2E)) * up; }
                u32x4 w; w.x = pk2(r[0], r[1]); w.y = pk2(r[2], r[3]); w.z = pk2(r[4], r[5]); w.w = pk2(r[6], r[7]);
                *(u32x4*)(hs + row * DEXP + col) = w; }
    }
};
struct EpiMoeDown { static constexpr bool PERM = true, AFTER_DRAIN = false; bf16_t* y; const float* cws;
    __device__ __forceinline__ void operator()(const f32x4 (&acc)[2][2][4][2], const pg8::Unit& u, int wr, int wc, int fr, int fq) const {
        asm volatile("" : "+v"(fr), "+v"(fq));
        const int row0 = u.pm * 256 + wr * 64 + fr, colt = (u.pn & 3) * 256 + wc * 32 + 8 * fq;
        float cw[8];
#pragma unroll
        for (int q = 0; q < 8; ++q) cw[q] = cws[row0 + (q >> 2) * 128 + (q & 3) * 16];
#pragma unroll
        for (int ai = 0; ai < 2; ++ai)
#pragma unroll
            for (int m = 0; m < 4; ++m) { const size_t row = (size_t)(row0 + ai * 128 + m * 16); const float cwv = cw[ai * 4 + m];
#pragma unroll
                for (int bj = 0; bj < 2; ++bj) { const int col = colt + bj * 128; const f32x4 v0 = acc[ai][bj][m][0] * cwv, v1 = acc[ai][bj][m][1] * cwv;
                    u32x4 w; w.x = pk2(v0[0], v0[1]); w.y = pk2(v0[2], v0[3]); w.z = pk2(v1[0], v1[1]); w.w = pk2(v1[2], v1[3]);
                    *(u32x4*)(y + row * D + col) = w; } }
    }
};


#ifndef PH_MASK
#define PH_MASK 0xFFFF
#endif
#define PH(k) ((PH_MASK >> (k)) & 1)
#ifndef PROBE_DUP
#define PROBE_DUP 0
#endif
#define DUPN(bit) (((PROBE_DUP >> (bit)) & 1) ? 2 : 1)
#ifndef PROBE_THIN
#define PROBE_THIN 0
#endif
#define THIN(bit) ((PROBE_THIN >> (bit)) & 1)
#define FRESH() do { asm volatile("" : "+v"(F.tid)); F.lane = F.tid & 63; F.wave = __builtin_amdgcn_readfirstlane(F.tid >> 6); { int bx_ = (int)blockIdx.x; asm volatile("" : "+s"(bx_)); F.bx = bx_; } { unsigned char* w_ = a.ws; asm volatile("" : "+s"(w_)); a.ws = w_; } } while (0)
__global__ void __launch_bounds__(NTHR, 2) hybrid_fwd(Args ka) {
    extern __shared__ __attribute__((aligned(16))) unsigned char lds_raw[];
    Frame F;
    F.lds = (LAS unsigned char*)lds_raw;
    F.MISC = (volatile LAS unsigned*)(F.lds + MISC_OFF);
    F.tid = threadIdx.x; F.lane = F.tid & 63; F.wave = __builtin_amdgcn_readfirstlane(F.tid >> 6); F.bx = (int)blockIdx.x;
    for (int u = F.tid; u < (LDS_BYTES - MISC_OFF) / 4; u += NTHR) ((LAS unsigned*)(F.lds + MISC_OFF))[u] = 0u;
    __syncthreads();
    if (F.tid < 29) { const unsigned long long p = (unsigned long long)ka.in[F.tid]; F.MISC[64 + 2 * F.tid] = (unsigned)p; F.MISC[65 + 2 * F.tid] = (unsigned)(p >> 32); }
    __syncthreads();
    ArgsL a; a.tab = F.MISC + 64; a.out = ka.out; a.ws = ka.ws;
    XcdBarrier bar = xcd_barrier_post((unsigned*)(a.ws + WS_CTL) + CW_BAR, F.MISC + 8);
    const int G = (int)gridDim.x, c = (int)blockIdx.x;
    PG8_LAS unsigned char* ring = (PG8_LAS unsigned char*)F.lds;

#ifdef PROF_K
    volatile LAS unsigned* tsl = F.MISC + 1536; int nts = 0;
    if (blockIdx.x == 0 && F.tid == 0) tsl[nts] = (unsigned)__builtin_amdgcn_s_memrealtime();
    ++nts;
#define BARX() do { xcd_barrier(bar); if (blockIdx.x == 0 && F.tid == 0) tsl[nts] = (unsigned)__builtin_amdgcn_s_memrealtime(); ++nts; } while (0)
#else
#define BARX() xcd_barrier(bar)
#endif
    for (int layer = 0; layer < DEPTH; ++layer) {
        for (int rep = 0; rep < DUPN(8); ++rep) { FRESH(); if (PH(0)) phase_wconv(a, F, layer); }
        __syncthreads();
        if (THIN(0)) { FRESH(); phase_norm<1>(a, F, layer, true); }
        FRESH(); if (PH(1)) phase_norm<1>(a, F, layer);
        BARX();
        FRESH(); if (PH(2)) {
            pg8::Gemm g{(const bf16_t*)A_PTR(a), (const bf16_t*)(a.ws + WS_WIN), M, N1, D}; pg8::StaticOrder S; S.init(M, N1, G, c, DUPN(3));
            EpiInproj E{(bf16_t*)(a.ws + WS_USH), (bf16_t*)(a.ws + WS_QKV)};
            pg8::gemm_phase<EpiInproj, pg8::StaticOrder, true, true>(ring, g, S, E);
        }
        BARX();
        if (THIN(1)) { FRESH(); phase_prep(a, F, layer, true); }
        FRESH(); if (PH(3)) phase_prep(a, F, layer);
        BARX();
#ifndef SEQ_SCAN
        if (THIN(2)) { FRESH(); phase_chunkA(a, F, true); }
        FRESH(); if (PH(4)) phase_chunkA(a, F);
        BARX();
#endif
        FRESH(); if (PH(4)) phase_mix(a, F, layer);
        BARX();
        if (THIN(3)) { FRESH(); phase_post(a, F, layer, true); }
        FRESH(); if (PH(5)) phase_post(a, F, layer);
        FRESH(); if (PH(6)) {
            pg8::Gemm g{(const bf16_t*)A_PTR(a), (const bf16_t*)(a.ws + WS_WG), M, 3072, D}; pg8::StaticOrder S; S.init(M, 3072, G, c, DUPN(4));
            EpiGates E{(bf16_t*)(a.ws + WS_GATES)};
            pg8::gemm_phase<EpiGates, pg8::StaticOrder, true, true>(ring, g, S, E);
        }
        BARX();
        FRESH(); if (PH(7)) {
            int kdim = RW_W; asm volatile("" : "+s"(kdim));
            pg8::Gemm g{(const bf16_t*)(a.ws + WS_YCAT), (const bf16_t*)(a.ws + WS_WP), 3 * M, 3072, kdim}; MergeOrder S{G, c, 516 * DUPN(5)};
            EpiMerge E{(const bf16_t*)(a.ws + WS_GATES), (bf16_t*)(a.ws + WS_MERGED)};
            pg8::gemm_phase<EpiMerge, MergeOrder, false, true>(ring, g, S, E);
        }
        BARX();
        FRESH(); if (PH(8)) {
            pg8::Gemm g{(const bf16_t*)(a.ws + WS_MERGED), (const bf16_t*)(a.ws + WS_WO), M, D, D}; pg8::StaticOrder S; S.init(M, D, G, c, 1);
            EpiOut E{HB_PTR(a)};
            pg8::gemm_phase<EpiOut, pg8::StaticOrder, true, true>(ring, g, S, E);
        }
        BARX();
        if (THIN(4)) { FRESH(); phase_norm<2>(a, F, layer, true); }
        FRESH(); if (PH(9)) phase_norm<2>(a, F, layer);
        BARX();
        for (int rep = 0; rep < DUPN(7); ++rep) { FRESH(); if (PH(10)) phase_route(a, F, layer); }
        BARX();
        volatile LAS int* tb = (volatile LAS int*)(F.MISC + 32);
        if (F.tid <= 16) { const int* cnt = (const int*)(a.ws + WS_CTL) + CW_ECNT + 64 * layer; int t = 0;
            for (int e = 0; e < F.tid; ++e) t += (__hip_atomic_load(cnt + e, __ATOMIC_RELAXED, __HIP_MEMORY_SCOPE_AGENT) + 255) >> 8;
            tb[F.tid] = t; }
        __syncthreads();
        const int ntile = tb[16];
        FRESH(); if (PH(11)) {
            pg8::Gemm g{(const bf16_t*)(a.ws + WS_AS), (const bf16_t*)(a.ws + WS_WGU), MS, 8192, D}; MoeOrder S{tb, ntile, 2, G, c, DUPN(6)};
            EpiMoeUp E{(bf16_t*)(a.ws + WS_HS)};
            pg8::gemm_phase<EpiMoeUp, MoeOrder, true, true>(ring, g, S, E);
        }
        BARX();
        FRESH(); if (PH(12)) {
            int kdim = DEXP; asm volatile("" : "+s"(kdim));
            pg8::Gemm g{(const bf16_t*)(a.ws + WS_HS), (const bf16_t*)(a.ws + WS_WD), MS, 16384, kdim}; MoeOrder S{tb, ntile, 4, G, c, DUPN(6)};
            EpiMoeDown E{(bf16_t*)(a.ws + WS_Y), (const float*)(a.ws + WS_CWS)};
            pg8::gemm_phase<EpiMoeDown, MoeOrder, true, true>(ring, g, S, E);
        }
        BARX();
    }
    if (THIN(5)) { FRESH(); phase_norm<0>(a, F, DEPTH - 1, true); }
    FRESH(); if (PH(13)) phase_norm<0>(a, F, DEPTH - 1);
#ifdef PROF_K
    BARX();
    if (blockIdx.x == 0) {
        __syncthreads();
        float us;
        if (PROF_K < 0) us = 100.f;
        else if (PROF_K == 12) us = (float)(tsl[25] - tsl[24]) * 0.01f;
        else if (PROF_K == 13) us = (float)(tsl[25] - tsl[0]) * 0.01f;
        else us = ((float)(tsl[1 + PROF_K] - tsl[PROF_K]) + (float)(tsl[13 + PROF_K] - tsl[12 + PROF_K])) * 0.01f;
        us = 4.f * rintf(us * 0.25f);
        for (int i = F.tid; i < 16384; i += NTHR) a.out[i] = us;
    }
#endif
#ifdef CLOCK_PROBE
    if (blockIdx.x == 0 && F.wave == 0) {
        float c0 = 1.f, c1 = 2.f, c2 = 3.f, c3 = 4.f, c4 = 5.f, c5 = 6.f, c6 = 7.f, c7 = 8.f;
        for (int i = 0; i < CLOCK_PROBE; ++i) {
            asm volatile("v_fma_f32 %0, %0, %0, %0\n\tv_fma_f32 %1, %1, %1, %1\n\tv_fma_f32 %2, %2, %2, %2\n\tv_fma_f32 %3, %3, %3, %3\n\tv_fma_f32 %4, %4, %4, %4\n\tv_fma_f32 %5, %5, %5, %5\n\tv_fma_f32 %6, %6, %6, %6\n\tv_fma_f32 %7, %7, %7, %7"
                         : "+v"(c0), "+v"(c1), "+v"(c2), "+v"(c3), "+v"(c4), "+v"(c5), "+v"(c6), "+v"(c7));
        }
        asm volatile("" :: "v"(c0), "v"(c1), "v"(c2), "v"(c3), "v"(c4), "v"(c5), "v"(c6), "v"(c7));
    }
#endif
}

extern "C" void kernel_launch(void* const* d_in, const int* in_sizes, int n_in, void* d_out, int out_size, void* d_ws, size_t ws_size, hipStream_t stream) {
    static int ready = 0;
    if (ready == 0) {
        if (n_in != 29 || out_size != NB * SEQ * D || ws_size < WS_END) { fprintf(stderr, "kernel_launch: unexpected problem shape (n_in %d, out %d, ws %zu < %zu)\n", n_in, out_size, ws_size, (size_t)WS_END); ready = -1; return; }
        if (hipFuncSetAttribute((const void*)hybrid_fwd, hipFuncAttributeMaxDynamicSharedMemorySize, LDS_BYTES) != hipSuccess) { fprintf(stderr, "kernel_launch: hipFuncSetAttribute failed\n"); ready = -1; return; }
        int per_cu = 0;
        if (hipOccupancyMaxActiveBlocksPerMultiprocessor(&per_cu, (const void*)hybrid_fwd, NTHR, LDS_BYTES) != hipSuccess || per_cu < 1) fprintf(stderr, "kernel_launch: occupancy query says %d\n", per_cu);
        (void)hipGetLastError();
        ready = 1;
    }
    if (ready < 0) return;
    (void)in_sizes;
    if (hipMemsetAsync((char*)d_ws + WS_CTL, 0, CTL_ZERO_BYTES, stream) != hipSuccess) return;
    Args a{};
    for (int i = 0; i < 29; ++i) a.in[i] = (const float*)d_in[i];
    a.out = (float*)d_out; a.ws = (unsigned char*)d_ws;
    hipLaunchKernelGGL(hybrid_fwd, dim3(256), dim3(NTHR), LDS_BYTES, stream, a);
}
```

```cpp
#include <hip/hip_runtime.h>
#include <hip/hip_bf16.h>
#include <cstdio>
#include <cstdint>

#define GAS __attribute__((address_space(1)))
#define LAS __attribute__((address_space(3)))

namespace pg8 {
#define PG8_LAS __attribute__((address_space(3)))
typedef unsigned short bf16_t;
typedef short bf16x8 __attribute__((ext_vector_type(8)));
typedef float f32x4 __attribute__((ext_vector_type(4)));
typedef unsigned u32x4 __attribute__((ext_vector_type(4)));
constexpr int BM = 256, BK = 64, HALF = 128, HTB = HALF * BK * 2  , STAGE_BYTES = 8 * HTB, NXCD = 8, WGM = 8;

__host__ __device__ __forceinline__ int lds_byte(int r, int c) { const int st = (r >> 4) * 2 + (c >> 5), rr = r & 15, cc = c & 31, ob = rr * 64 + cc * 2; return st * 1024 + (ob ^ (((ob >> 9) & 1) << 5)); }
__host__ __device__ __forceinline__ void stage_rc(int b, int& R, int& C) { const int st = b / 1024, sb = b % 1024, swz = sb ^ (((sb >> 9) & 1) << 5); R = (st >> 1) * 16 + swz / 64; C = (st & 1) * 32 + (swz % 64) / 2; }
__host__ __device__ __forceinline__ int perm32(int rho) { const int n = rho >> 4, i = rho & 15; return 8 * (i >> 2) + 4 * n + (i & 3); }

struct Unit { int pm, pn; };
struct Gemm { const bf16_t* A; const bf16_t* Bt; int M, N, K; };

struct StaticOrder {
    int nM, nN, nwg, G, c, rep;
    __host__ __device__ void init(int M, int N, int G_, int c_, int rep_ = 1) { nM = M / BM; nN = N / BM; nwg = nM * nN; G = G_; c = c_; rep = rep_; }
    __host__ __device__ bool next(int i, Unit& u) const {
        const long L = (long)i * G + c; if (L >= (long)nwg * rep) return false;
        int wgid = (int)(L % nwg); { const int q = nwg / NXCD, r = nwg % NXCD, xcd = wgid % NXCD, off = wgid / NXCD; wgid = (xcd < r ? xcd * (q + 1) : r * (q + 1) + (xcd - r) * q) + off; }
        const int nig = WGM * nN, gid = wgid / nig, fm = gid * WGM, gsz = (nM - fm) < WGM ? (nM - fm) : WGM;
        u.pm = fm + ((wgid % nig) % gsz); u.pn = (wgid % nig) / gsz; return true;
    }
    __device__ __forceinline__ void a_ready(const Unit&) const {}
    __device__ __forceinline__ void done(const Unit&) const {}
};
__device__ __forceinline__ unsigned cvt_pk_bf16(float lo, float hi) { unsigned r; asm volatile("v_cvt_pk_bf16_f32 %0, %1, %2" : "=v"(r) : "v"(lo), "v"(hi)); return r; }
template <class Epi, class Sched, bool ALIGN_EPI = false, bool SP2 = false>
__device__ __forceinline__ void gemm_phase(PG8_LAS unsigned char* lds, const Gemm g, const Sched& S, const Epi& E) {
    int tid_ = threadIdx.x; asm volatile("" : "+v"(tid_));
    const int tid = tid_, wid = __builtin_amdgcn_readfirstlane(tid >> 6), lane = tid & 63, wr = wid >> 2, wc = wid & 3, fr = lane & 15, fq = lane >> 4;
    const int K = g.K, nt = K / BK;
    unsigned voffA[2], voffB[2];
#pragma unroll
    for (int i = 0; i < 2; ++i) { int R, C; stage_rc(tid * 16 + i * 8192, R, C); const int Rb = Epi::PERM ? ((R & ~31) + perm32(R & 31)) : R;
        voffA[i] = (unsigned)(R * K + C) * 2u; voffB[i] = (unsigned)(Rb * K + C) * 2u; }
    const size_t kstep = (size_t)(BK * 2);
    const size_t hstep = (size_t)HALF * K * 2;
    const size_t tstep = 2 * hstep;
    const unsigned ldsw = (unsigned)wid * 1024u;
    const int aoff = lds_byte(wr * 64 + fr, fq * 8), boff = lds_byte(wc * 32 + fr, fq * 8);
#define PG8_SA(b, h) (((b) * 2 + (h)) * HTB)
#define PG8_SB(b, h) ((4 + (b) * 2 + (h)) * HTB)
#define PG8_STAGE(bufoff, gbase, voff) do { _Pragma("unroll") for (int _i = 0; _i < 2; ++_i) \
        __builtin_amdgcn_global_load_lds((const unsigned*)((const char*)(gbase) + (voff)[_i]), (PG8_LAS unsigned*)(lds + (bufoff) + ldsw + _i * 8192), 16, 0, 0); } while (0)
#define PG8_LDA(dst, b, h) do { _Pragma("unroll") for (int m = 0; m < 4; ++m) _Pragma("unroll") for (int k = 0; k < 2; ++k) dst[m][k] = *(const PG8_LAS bf16x8*)(lds + PG8_SA(b, h) + aoff + m * 2048 + k * 1024); } while (0)
#define PG8_LDB(dst, b, h) do { _Pragma("unroll") for (int n = 0; n < 2; ++n) _Pragma("unroll") for (int k = 0; k < 2; ++k) dst[n][k] = *(const PG8_LAS bf16x8*)(lds + PG8_SB(b, h) + boff + n * 2048 + k * 1024); } while (0)
#define PG8_MMA(ai, bj, At, Bt) do { __builtin_amdgcn_s_setprio(1); _Pragma("unroll") for (int m = 0; m < 4; ++m) _Pragma("unroll") for (int n = 0; n < 2; ++n) _Pragma("unroll") for (int k = 0; k < 2; ++k) \
        acc[ai][bj][m][n] = __builtin_amdgcn_mfma_f32_16x16x32_bf16(Bt[n][k], At[m][k], acc[ai][bj][m][n], 0, 0, 0); __builtin_amdgcn_s_setprio(0); } while (0)
#define PG8_WAIT_V(n) asm volatile("s_waitcnt vmcnt(" #n ")" ::: "memory")
#define PG8_WAIT_L(n) asm volatile("s_waitcnt lgkmcnt(" #n ")" ::: "memory")
#define PG8_BAR __builtin_amdgcn_s_barrier()
#define PG8_SCHED __builtin_amdgcn_sched_barrier(0)
    Unit cur, nxt; int ui = 0;
    if (!S.next(0, cur)) return;
    f32x4 acc[2][2][4][2];
#pragma unroll
    for (int a = 0; a < 2; ++a)
#pragma unroll
        for (int b = 0; b < 2; ++b)
#pragma unroll
            for (int m = 0; m < 4; ++m)
#pragma unroll
                for (int n = 0; n < 2; ++n) acc[a][b][m][n] = (f32x4){0.f, 0.f, 0.f, 0.f};
    bf16x8 At[4][2], B0[2][2], B1[2][2];
    const char* cA = (const char*)g.A + (size_t)cur.pm * tstep; const char* cB = (const char*)g.Bt + (size_t)cur.pn * tstep;
    S.a_ready(cur);
    if constexpr (SP2) {
        PG8_STAGE(PG8_SB(0, 0), cB, voffB); PG8_STAGE(PG8_SB(0, 1), cB + hstep, voffB); PG8_STAGE(PG8_SA(0, 0), cA, voffA); PG8_STAGE(PG8_SA(0, 1), cA + hstep, voffA);
        if (wr == 1) PG8_BAR;
        PG8_WAIT_V(2); PG8_BAR;
        PG8_STAGE(PG8_SB(1, 0), cB + kstep, voffB); PG8_STAGE(PG8_SA(1, 0), cA + kstep, voffA); PG8_STAGE(PG8_SB(1, 1), cB + hstep + kstep, voffB);
        PG8_WAIT_V(6); PG8_BAR;
    } else {
        PG8_STAGE(PG8_SB(0, 0), cB, voffB); PG8_STAGE(PG8_SA(0, 0), cA, voffA); PG8_STAGE(PG8_SB(0, 1), cB + hstep, voffB); PG8_STAGE(PG8_SA(0, 1), cA + hstep, voffA);
        if (wr == 1) PG8_BAR;
        PG8_WAIT_V(4); PG8_BAR;
        PG8_STAGE(PG8_SB(1, 0), cB + kstep, voffB); PG8_STAGE(PG8_SA(1, 0), cA + kstep, voffA); PG8_STAGE(PG8_SB(1, 1), cB + hstep + kstep, voffB);
        PG8_WAIT_V(6); PG8_BAR;
    }
    for (;;) {
        const bool has_next = S.next(ui + 1, nxt);
        const char* nA = has_next ? (const char*)g.A + (size_t)nxt.pm * tstep : cA; const char* nB = has_next ? (const char*)g.Bt + (size_t)nxt.pn * tstep : cB;
        for (int t = 0; t < nt; t += 2) {
            const bool last = (t == nt - 2);
            const char* a1 = cA + (size_t)(t + 1) * kstep;
            const char* a2 = last ? nA : cA + (size_t)(t + 2) * kstep; const char* b2 = last ? nB : cB + (size_t)(t + 2) * kstep;
            const char* a3 = a2 + kstep; const char* b3 = b2 + kstep;
            if (last && has_next) S.a_ready(nxt);
            if constexpr (SP2) {
            PG8_LDB(B0, 0, 0); PG8_LDB(B1, 0, 1); PG8_SCHED; PG8_LDA(At, 0, 0); PG8_STAGE(PG8_SA(1, 1), a1 + hstep, voffA);
            PG8_WAIT_V(8); PG8_WAIT_L(0); PG8_BAR; PG8_MMA(0, 0, At, B0); PG8_MMA(0, 1, At, B1); PG8_BAR; PG8_SCHED;
            PG8_LDA(At, 0, 1); PG8_STAGE(PG8_SB(0, 0), b2, voffB); PG8_STAGE(PG8_SB(0, 1), b2 + hstep, voffB); PG8_STAGE(PG8_SA(0, 0), a2, voffA);
            PG8_WAIT_V(8); PG8_WAIT_L(0); PG8_BAR; PG8_MMA(1, 0, At, B0); PG8_MMA(1, 1, At, B1); PG8_BAR; PG8_SCHED;
            PG8_LDB(B0, 1, 0); PG8_LDB(B1, 1, 1); PG8_SCHED; PG8_LDA(At, 1, 0); PG8_STAGE(PG8_SA(0, 1), a2 + hstep, voffA);
            PG8_WAIT_V(8); PG8_WAIT_L(0); PG8_BAR; PG8_MMA(0, 0, At, B0); PG8_MMA(0, 1, At, B1); PG8_BAR; PG8_SCHED;
            PG8_LDA(At, 1, 1); PG8_STAGE(PG8_SB(1, 0), b3, voffB); PG8_STAGE(PG8_SB(1, 1), b3 + hstep, voffB); PG8_STAGE(PG8_SA(1, 0), a3, voffA);
            PG8_WAIT_V(8); PG8_WAIT_L(0); PG8_BAR; PG8_MMA(1, 0, At, B0); PG8_MMA(1, 1, At, B1); PG8_BAR; PG8_SCHED;
            } else {
            PG8_LDB(B0, 0, 0); PG8_SCHED; PG8_LDA(At, 0, 0); PG8_STAGE(PG8_SA(1, 1), a1 + hstep, voffA);
            PG8_WAIT_L(8); PG8_BAR; PG8_WAIT_L(0); PG8_MMA(0, 0, At, B0); PG8_BAR; PG8_SCHED;
            PG8_LDB(B1, 0, 1); PG8_STAGE(PG8_SB(0, 0), b2, voffB);
            PG8_BAR; PG8_WAIT_L(0); PG8_MMA(0, 1, At, B1); PG8_BAR;
            PG8_LDA(At, 0, 1); PG8_STAGE(PG8_SA(0, 0), a2, voffA);
            PG8_BAR; PG8_WAIT_L(0); PG8_MMA(1, 0, At, B0); PG8_BAR; PG8_SCHED;
            PG8_STAGE(PG8_SB(0, 1), b2 + hstep, voffB);
            PG8_WAIT_V(6); PG8_BAR; PG8_MMA(1, 1, At, B1); PG8_BAR;
            PG8_LDB(B0, 1, 0); PG8_SCHED; PG8_LDA(At, 1, 0); PG8_STAGE(PG8_SA(0, 1), a2 + hstep, voffA);
            PG8_WAIT_L(8); PG8_BAR; PG8_WAIT_L(0); PG8_MMA(0, 0, At, B0); PG8_BAR; PG8_SCHED;
            PG8_LDB(B1, 1, 1); PG8_STAGE(PG8_SB(1, 0), b3, voffB);
            PG8_BAR; PG8_WAIT_L(0); PG8_MMA(0, 1, At, B1); PG8_BAR;
            PG8_LDA(At, 1, 1); PG8_STAGE(PG8_SA(1, 0), a3, voffA);
            PG8_BAR; PG8_WAIT_L(0); PG8_MMA(1, 0, At, B0); PG8_BAR; PG8_SCHED;
            PG8_STAGE(PG8_SB(1, 1), b3 + hstep, voffB);
            PG8_WAIT_V(6); PG8_BAR; PG8_MMA(1, 1, At, B1); PG8_BAR;
            }
        }
        if constexpr (ALIGN_EPI) { if (wr == 0) PG8_BAR; }
        if constexpr (!Epi::AFTER_DRAIN) { E(acc, cur, wr, wc, fr, fq); S.done(cur); }
        if (!has_next) break;
#pragma unroll
        for (int a = 0; a < 2; ++a)
#pragma unroll
            for (int b = 0; b < 2; ++b)
#pragma unroll
                for (int m = 0; m < 4; ++m)
#pragma unroll
                    for (int n = 0; n < 2; ++n) acc[a][b][m][n] = (f32x4){0.f, 0.f, 0.f, 0.f};
        cur = nxt; cA = nA; cB = nB; ++ui;
        if constexpr (ALIGN_EPI) { if (wr == 1) PG8_BAR; }
    }
    PG8_WAIT_V(0);
    if constexpr (!ALIGN_EPI) { if (wr == 0) PG8_BAR; }
    PG8_BAR;
    if constexpr (Epi::AFTER_DRAIN) { E.fused(acc, cur, wr, wc, fr, fq, lds, wid, lane); S.done(cur); }
#undef PG8_SA
#undef PG8_SB
#undef PG8_STAGE
#undef PG8_LDA
#undef PG8_LDB
#undef PG8_MMA
#undef PG8_WAIT_V
#undef PG8_WAIT_L
#undef PG8_BAR
#undef PG8_SCHED
}
}

constexpr int D = 1024, NB = 2, SEQ = 16384, NMETA = 16, LTOK = SEQ + NMETA  , PADR = 112, T = PADR + LTOK  ;
constexpr int M = NB * T;
constexpr int DEPTH = 2, HD = 64, RW_H = 6, SB_H = 5, FX_H = 5, RW_W = 384, SHIFT_W = 1280, D_IN = 6277;
constexpr int QKV_W = 1920;
constexpr int N1 = 3328;
constexpr int FCOL = 3200, GCOL = 3205;
constexpr int NEXP = 16, DEXP = 256;
constexpr int MS = 70144;
constexpr int LCH = 32, LPADDED = 16448;
constexpr int KBP = 16896;
constexpr float C2 = 0.125f * 1.4426950408889634f;
constexpr float LOG2E = 1.4426950408889634f;
constexpr int NWAVES = 8, NTHR = 512;

constexpr size_t MiB = 1u << 20;
constexpr size_t WS_CTL = 0, CTL_ZERO_BYTES = 65536;
constexpr size_t WS_HM = 1 * MiB;
constexpr size_t WS_LOGF = WS_HM + 131072;
constexpr size_t WS_KB2 = WS_LOGF + (size_t)M * 32;
constexpr size_t WS_TOK = WS_KB2 + (size_t)10 * KBP * 4;
constexpr size_t WS_SLOT = WS_TOK + (size_t)M * 32;
constexpr size_t WS_CWS = WS_SLOT + (size_t)M * 8;
constexpr size_t WS_WGCNT = WS_CWS + (size_t)MS * 4;
constexpr size_t WS_SMALL_END = WS_WGCNT + 256 * 16 * 4;
static_assert(WS_SMALL_END <= 8 * MiB, "small buffers");
constexpr size_t WS_WIN = 8 * MiB;
constexpr size_t WS_WG = WS_WIN + (size_t)N1 * 1024 * 2;
constexpr size_t WS_WP = WS_WG + (size_t)3072 * 1024 * 2;
constexpr size_t WS_WO = WS_WP + (size_t)3072 * 384 * 2;
constexpr size_t WS_WGU = WS_WO + (size_t)1024 * 1024 * 2;
constexpr size_t WS_WD = WS_WGU + (size_t)8192 * 1024 * 2;
constexpr size_t WS_W_END = WS_WD + (size_t)16384 * 256 * 2;
static_assert(WS_W_END <= 49 * MiB, "weights");
constexpr size_t WS_HB = 49 * MiB;
constexpr size_t WS_BIG = 115 * MiB;
constexpr size_t WS_USH = WS_BIG;
constexpr size_t WS_YCAT = WS_BIG;
constexpr size_t WS_QKV = WS_BIG + 82 * MiB;
constexpr size_t WS_RW = WS_BIG + 204 * MiB;
constexpr size_t WS_BN = WS_BIG + 349 * MiB;
constexpr size_t WS_GATES = WS_BIG + 82 * MiB;
constexpr size_t WS_MERGED = WS_BIG + 276 * MiB;
constexpr size_t WS_AS = WS_BIG;
constexpr size_t WS_HS = WS_BIG + 137 * MiB;
constexpr size_t WS_Y = WS_BIG + 172 * MiB;
constexpr size_t WS_END = WS_BIG + 374 * MiB;
static_assert((size_t)(M + 256) * 1280 * 2 <= 82 * MiB && (size_t)3 * M * 384 * 2 <= 82 * MiB && (size_t)(M + 256) * 1920 * 2 <= 122 * MiB, "big map 1");
static_assert((size_t)12 * LPADDED * 768 <= 145 * MiB && (size_t)M * 384 * 2 <= 25 * MiB && (size_t)M * 3072 * 2 <= 194 * MiB && (size_t)M * 2048 <= 65 * MiB, "big map 2");
static_assert((size_t)MS * 2048 <= 137 * MiB && (size_t)MS * 512 <= 35 * MiB && WS_END <= 489 * MiB, "big map 3");

constexpr int CW_BAR = 0;
constexpr int CW_QUEUE = 4096;
constexpr int CW_ECNT = 4352;
static_assert((CW_ECNT + 128) * 4 <= (int)CTL_ZERO_BYTES, "ctl");

constexpr int RING_BYTES = 131072, MISC_OFF = RING_BYTES, LDS_BYTES = 147456;

typedef unsigned short bf16_t;
typedef float f32x4 __attribute__((ext_vector_type(4)));
typedef float f32x2 __attribute__((ext_vector_type(2)));
typedef float f32x16 __attribute__((ext_vector_type(16)));
typedef unsigned u32x4 __attribute__((ext_vector_type(4)));
typedef unsigned u32x2 __attribute__((ext_vector_type(2)));
typedef short bf16x8 __attribute__((ext_vector_type(8)));
typedef short s16x4 __attribute__((ext_vector_type(4)));
typedef _Float16 f16x4 __attribute__((ext_vector_type(4)));
typedef __bf16 bf16x2_t __attribute__((ext_vector_type(2)));

__device__ __forceinline__ unsigned pk2(float lo, float hi) { f32x2 v = {lo, hi}; bf16x2_t b = __builtin_convertvector(v, bf16x2_t); return __builtin_bit_cast(unsigned, b); }
__device__ __forceinline__ unsigned short f2bf(float f) { return (unsigned short)(pk2(f, 0.f) & 0xffffu); }
__device__ __forceinline__ float bf_lo(unsigned u) { return __uint_as_float(u << 16); }
__device__ __forceinline__ float bf_hi(unsigned u) { return __uint_as_float(u & 0xffff0000u); }
__device__ __forceinline__ float bf2f(unsigned short h) { return __uint_as_float((unsigned)h << 16); }
template <int CTRL> __device__ __forceinline__ float dpp_f(float x) { return __int_as_float(__builtin_amdgcn_update_dpp(0, __float_as_int(x), CTRL, 0xF, 0xF, false)); }
__device__ __forceinline__ float allred16(float p) { p += dpp_f<0x128>(p); p += dpp_f<0x124>(p); p += dpp_f<0x122>(p); p += dpp_f<0x121>(p); return p; }
__device__ __forceinline__ float wave_sum(float v) {
    v = allred16(v);
    { auto sw = __builtin_amdgcn_permlane16_swap(__float_as_uint(v), __float_as_uint(v), false, false); v = __uint_as_float(sw[0]) + __uint_as_float(sw[1]); }
    { auto sw = __builtin_amdgcn_permlane32_swap(__float_as_uint(v), __float_as_uint(v), false, false); v = __uint_as_float(sw[0]) + __uint_as_float(sw[1]); }
    return v;
}
__device__ __forceinline__ float fast_exp(float x) { return __builtin_amdgcn_exp2f(x * LOG2E); }
__device__ __forceinline__ float fast_log(float x) { return __builtin_amdgcn_logf(x) * 0.6931471805599453f; }
__device__ __forceinline__ float softplus_f(float z) { return fmaxf(z, 0.f) + fast_log(1.f + fast_exp(-fabsf(z))); }

#define XB_TMO      128
#define XB_XCNT(j)  (256  + 64 * (j))
#define XB_XSUB(j)  (1280 + 64 * (j))
#define XB_XGEN(j)  (2304 + 64 * (j))
#define XB_TOP      3328
#define XB_TOPGEN   3392
#define XCD_BAR_WORDS 3456
#define XB_SPIN_CAP (1u << 20)
__device__ __forceinline__ unsigned xb_ld(unsigned* p)              { return __hip_atomic_load(p, __ATOMIC_RELAXED, __HIP_MEMORY_SCOPE_AGENT); }
__device__ __forceinline__ unsigned xb_add(unsigned* p, unsigned v) { return __hip_atomic_fetch_add(p, v, __ATOMIC_RELAXED, __HIP_MEMORY_SCOPE_AGENT); }
__device__ __forceinline__ unsigned xb_xcc_id() { return (unsigned)__builtin_amdgcn_s_getreg((3 << 11) | 20) & 0xFu; }
#define XB_SPIN(cond, bar) do { unsigned _sp = 0; while (cond) { __builtin_amdgcn_s_sleep(1); \
    if ((++_sp & 255u) == 0u) { if (xb_ld(&(bar)[XB_TMO])) break; if (_sp > XB_SPIN_CAP) { atomicAdd(&(bar)[XB_TMO], 1u); break; } } } } while (0)

struct XcdBarrier {
    unsigned* bar; unsigned x;
    volatile LAS unsigned* st;
};

__device__ __forceinline__ XcdBarrier xcd_barrier_post(unsigned* bar, volatile LAS unsigned* st) {
    XcdBarrier b; b.bar = bar; b.x = xb_xcc_id(); b.st = st;
    if (threadIdx.x == 0) (void)xb_add(&bar[XB_XCNT(b.x)], 1u);
    return b;
}
__device__ __forceinline__ void xcd_barrier_complete(unsigned* bar, unsigned x, unsigned& nloc, unsigned& nx) {
    const unsigned G = gridDim.x * gridDim.y * gridDim.z;
    unsigned sum, cnt, mine, sp = 0u;
    for (;;) {
        sum = 0u; cnt = 0u; mine = 0u;
#pragma unroll
        for (unsigned j = 0; j < 16; ++j) { const unsigned c = xb_ld(&bar[XB_XCNT(j)]); sum += c; cnt += (c > 0u) ? 1u : 0u; mine = (j == x) ? c : mine; }
        if (sum == G) break;
        __builtin_amdgcn_s_sleep(1);
        if ((++sp & 255u) == 0u) { if (xb_ld(&bar[XB_TMO])) break; if (sp > XB_SPIN_CAP) { atomicAdd(&bar[XB_TMO], 1u); break; } }
    }
    nloc = mine > 0u ? mine : 1u; nx = cnt > 0u ? cnt : 1u;
}

__device__ __forceinline__ void xcd_barrier(const XcdBarrier& b) {
    asm volatile("s_waitcnt vmcnt(0)" ::: "memory");
    __syncthreads();
    if (threadIdx.x == 0) {
        unsigned* bar = b.bar;
        __builtin_amdgcn_s_waitcnt(0);
        unsigned nloc = b.st[0], nx = b.st[1];
        if (nloc == 0u) { xcd_barrier_complete(bar, b.x, nloc, nx); b.st[0] = nloc; b.st[1] = nx; }
        const unsigned old = xb_add(&bar[XB_XSUB(b.x)], 1u);
        const unsigned gen = old / nloc;
        if (old + 1u == (gen + 1u) * nloc) {
            __builtin_amdgcn_fence(__ATOMIC_RELEASE, "agent");
            asm volatile("s_waitcnt vmcnt(0)" ::: "memory");
            const unsigned og = xb_add(&bar[XB_TOP], 1u);
            const unsigned tg = og / nx;
            if (og + 1u == (tg + 1u) * nx) xb_add(&bar[XB_TOPGEN], 1u);
            else XB_SPIN(xb_ld(&bar[XB_TOPGEN]) == tg, bar);
            __builtin_amdgcn_fence(__ATOMIC_ACQUIRE, "agent");
            xb_add(&bar[XB_XGEN(b.x)], 1u);
            asm volatile("s_waitcnt vmcnt(0)" ::: "memory");
        } else {
            XB_SPIN(xb_ld(&bar[XB_XGEN(b.x)]) == gen, bar);
            __builtin_amdgcn_fence(__ATOMIC_ACQUIRE, "agent");
            asm volatile("s_waitcnt vmcnt(0)" ::: "memory");
        }
    }
    __syncthreads();
}

struct Args { const float* in[29]; float* out; unsigned char* ws; };
enum { I_X = 0, I_META, I_N1G, I_WIN, I_MU, I_WUP, I_W0, I_AUP, I_A0, I_KK, I_KA, I_RK, I_LNG, I_LNB, I_FB, I_QG, I_KG, I_WPR, I_WPS, I_WPF, I_WOUT, I_N2G, I_MWG, I_MBG, I_MWE, I_MBE, I_MGATE, I_MUP, I_MDOWN };
struct ArgsL { volatile LAS unsigned* tab; float* out; unsigned char* ws;
    __device__ __forceinline__ const float* in(int i) const { const unsigned lo = tab[2 * i], hi = tab[2 * i + 1];
        return (const float*)(((unsigned long long)(unsigned)__builtin_amdgcn_readfirstlane((int)hi) << 32) | (unsigned long long)(unsigned)__builtin_amdgcn_readfirstlane((int)lo)); }
};
struct Frame { LAS unsigned char* lds; volatile LAS unsigned* MISC; int tid, lane, wave, bx; };

__device__ __forceinline__ float* hrow(const ArgsL& a, int b, int l) {
    return l < NMETA ? (float*)(a.ws + WS_HM) + (size_t)(b * NMETA + l) * D : a.out + ((size_t)b * SEQ + (l - NMETA)) * D;
}
#define LDS_WAIT() asm volatile("s_waitcnt lgkmcnt(0)" ::: "memory")
#define HB_PTR(a) ((bf16_t*)((a).ws + WS_HB))
#define A_PTR(a) ((bf16_t*)((a).out))

__device__ __forceinline__ void tr_item(const float* W, int ldw, int sc0, int nvalid, int k0, int kvalid, bf16_t* WT, int Kd, int r0, LAS float* scr, int lane) {
    float tv[32];
#pragma unroll
    for (int i = 0; i < 32; ++i) { const int kk = 2 * i + (lane >> 5), n = lane & 31; tv[i] = 0.f;
        if (n < nvalid && k0 + kk < kvalid) tv[i] = W[(size_t)(k0 + kk) * ldw + sc0 + n]; }
#pragma unroll
    for (int i = 0; i < 32; ++i) { const int kk = 2 * i + (lane >> 5), n = lane & 31; scr[kk * 33 + n] = tv[i]; }
    LDS_WAIT();
    const int c = lane & 7;
#pragma unroll
    for (int j = 0; j < 4; ++j) { const int n = (lane >> 3) + 8 * j; const LAS float* s = scr + (8 * c) * 33 + n;
        u32x4 o; o.x = pk2(s[0 * 33], s[1 * 33]); o.y = pk2(s[2 * 33], s[3 * 33]); o.z = pk2(s[4 * 33], s[5 * 33]); o.w = pk2(s[6 * 33], s[7 * 33]);
        *(u32x4*)(WT + (size_t)(r0 + n) * Kd + k0 + 8 * c) = o; }
    LDS_WAIT();
}
__device__ __forceinline__ void phase_wconv(const ArgsL& a, Frame& F, int layer) {
    LAS float* scr = (LAS float*)(F.lds + F.wave * 8448);
    const int gw = F.bx * NWAVES + F.wave, NGW = gridDim.x * NWAVES;
    constexpr int C1 = 16 * 104, C2_ = C1 + 16 * 96, C3 = C2_ + 6 * 96, C4 = C3 + 16 * 32, C5 = C4 + 16 * 256, C6 = C5 + 4 * 512;
    unsigned char* ws = a.ws;
    for (int it = gw; it < C6; it += NGW) {
        if (it < C1) { const int kb = it / 104, nb = it % 104, r0 = nb * 32;
            tr_item(a.in(I_WIN) + (size_t)layer * D * D_IN, D_IN, r0, r0 < FCOL ? 32 : 0, kb * 64, 1024, (bf16_t*)(ws + WS_WIN), 1024, r0, scr, F.lane); }
        else if (it < C2_) { const int r = it - C1, kb = r / 96, nb = r % 96, r0 = nb * 32;
            tr_item(a.in(I_WIN) + (size_t)layer * D * D_IN, D_IN, GCOL + r0, 32, kb * 64, 1024, (bf16_t*)(ws + WS_WG), 1024, r0, scr, F.lane); }
        else if (it < C3) { const int r = it - C2_, kb = r / 96, nb = r % 96, r0 = nb * 32, br = r0 >> 10;
            const float* W = (br == 0 ? a.in(I_WPR) + (size_t)layer * 384 * D : br == 1 ? a.in(I_WPS) + (size_t)layer * 320 * D : a.in(I_WPF) + (size_t)layer * 320 * D);
            tr_item(W, D, r0 & 1023, 32, kb * 64, br == 0 ? 384 : 320, (bf16_t*)(ws + WS_WP), 384, r0, scr, F.lane); }
        else if (it < C4) { const int r = it - C3, kb = r / 32, nb = r % 32, r0 = nb * 32;
            tr_item(a.in(I_WOUT) + (size_t)layer * D * D, D, r0, 32, kb * 64, 1024, (bf16_t*)(ws + WS_WO), 1024, r0, scr, F.lane); }
        else if (it < C5) { const int r = it - C4, kb = r / 256, nb = r % 256, r0 = nb * 32, e = r0 >> 9, rr = r0 & 511, j = rr >> 8, q = rr & 255;
            const float* W = (q >= 128 ? a.in(I_MUP) : a.in(I_MGATE)) + ((size_t)layer * NEXP + e) * D * DEXP;
            tr_item(W, DEXP, j * 128 + (q & 127), 32, kb * 64, 1024, (bf16_t*)(ws + WS_WGU), 1024, r0, scr, F.lane); }
        else { const int r = it - C5, kb = r / 512, nb = r % 512, r0 = nb * 32, e = r0 >> 10;
            tr_item(a.in(I_MDOWN) + ((size_t)layer * NEXP + e) * DEXP * D, D, r0 & 1023, 32, kb * 64, 256, (bf16_t*)(ws + WS_WD), 256, r0, scr, F.lane); }
    }
}

__device__ __forceinline__ void add_y_row(f32x4 (&v)[4], const bf16_t* Y, int slot, int lane) {
    const u32x2* y = (const u32x2*)(Y + (size_t)slot * D) + lane;
#pragma unroll
    for (int j = 0; j < 4; ++j) { const u32x2 t = y[64 * j]; v[j].x += bf_lo(t.x); v[j].y += bf_hi(t.x); v[j].z += bf_lo(t.y); v[j].w += bf_hi(t.y); }
}
template <int MODE>
__device__ __forceinline__ void phase_norm(const ArgsL& a, Frame& F, int layer, const bool dry = false) {
    const int lane = F.lane;
    LAS float* wl = (LAS float*)F.lds;
    LAS int* lcnt = (LAS int*)(F.lds + 20 * 4096);
    unsigned char* ws = a.ws;
    if (MODE == 1) {
        const float* win = a.in(I_WIN) + (size_t)layer * D * D_IN;
        for (int idx = F.tid; idx < 5 * 1024; idx += NTHR) { const int j = idx >> 10, k = idx & 1023; wl[j * 1024 + k] = win[(size_t)k * D_IN + FCOL + j]; }
    }
    if (MODE == 2) {
        const float* wg = a.in(I_MWG) + (size_t)layer * D * 4; const float* we = a.in(I_MWE) + (size_t)layer * D * 16;
        for (int idx = F.tid; idx < 4 * 1024; idx += NTHR) { const int j = idx >> 10, k = idx & 1023; wl[j * 1024 + k] = wg[k * 4 + j]; }
        for (int idx = F.tid; idx < 16 * 1024; idx += NTHR) { const int j = idx >> 10, k = idx & 1023; wl[(4 + j) * 1024 + k] = we[k * 16 + j]; }
        if (F.tid < 16) lcnt[F.tid] = 0;
    }
    __syncthreads();
    const int gw = F.bx * NWAVES + F.wave, NGW = gridDim.x * NWAVES;
    const float* gsrc = (MODE == 2 ? a.in(I_N2G) : a.in(I_N1G)) + layer * D;
    f32x4 gv[4];
#pragma unroll
    for (int j = 0; j < 4; ++j) gv[j] = (MODE == 0) ? (f32x4){0.f, 0.f, 0.f, 0.f} : *(const f32x4*)(gsrc + 4 * lane + 256 * j);
    bf16_t* A = A_PTR(a); bf16_t* HB = HB_PTR(a);
    const bf16_t* Y = (const bf16_t*)(ws + WS_Y);
    const int* SLOT = (const int*)(ws + WS_SLOT);
    constexpr bool COMB0 = (MODE == 0);
    const bool comb = COMB0 || (MODE == 1 && layer > 0);
    f32x4 vn[4]; u32x2 yan[4], ybn[4];
#pragma unroll
    for (int j = 0; j < 4; ++j) { vn[j] = (f32x4){0.f, 0.f, 0.f, 0.f}; yan[j] = (u32x2){0u, 0u}; ybn[j] = (u32x2){0u, 0u}; }
#define NRM_VALID(mm) ((mm) < M && ((mm) % T) - PADR >= (MODE == 0 ? NMETA : 0))
#define NRM_LOAD(mm, s0_, s1_) do { if (NRM_VALID(mm)) { const int bb_ = (mm) / T, ll_ = (mm) - bb_ * T - PADR; \
        if (MODE == 1 && layer == 0) { const float* src_ = (ll_ < NMETA) ? a.in(I_META) + (size_t)ll_ * D : a.in(I_X) + ((size_t)bb_ * SEQ + (ll_ - NMETA)) * D; \
            _Pragma("unroll") for (int j = 0; j < 4; ++j) vn[j] = *(const f32x4*)(src_ + 4 * lane + 256 * j); } \
        else { const u32x2* hs_ = (const u32x2*)(HB + (size_t)(mm) * D) + lane; \
            _Pragma("unroll") for (int j = 0; j < 4; ++j) { const u32x2 t_ = hs_[64 * j]; vn[j] = (f32x4){bf_lo(t_.x), bf_hi(t_.x), bf_lo(t_.y), bf_hi(t_.y)}; } } \
        if (comb) { const u32x2* y0_ = (const u32x2*)(Y + (size_t)(s0_) * D) + lane; const u32x2* y1_ = (const u32x2*)(Y + (size_t)(s1_) * D) + lane; \
            _Pragma("unroll") for (int j = 0; j < 4; ++j) { yan[j] = y0_[64 * j]; ybn[j] = y1_[64 * j]; } } } } while (0)
    int sa1 = 0, sb1 = 0, sa2 = 0, sb2 = 0;
    if (comb) { if (NRM_VALID(gw)) { sa1 = SLOT[2 * gw]; sb1 = SLOT[2 * gw + 1]; } if (NRM_VALID(gw + NGW)) { sa2 = SLOT[2 * (gw + NGW)]; sb2 = SLOT[2 * (gw + NGW) + 1]; } }
    NRM_LOAD(gw, sa1, sb1);
    for (int m = gw; m < M; m += NGW) {
        f32x4 v[4]; u32x2 ya[4], yb[4];
#pragma unroll
        for (int j = 0; j < 4; ++j) { v[j] = vn[j]; ya[j] = yan[j]; yb[j] = ybn[j]; }
        int sa3 = 0, sb3 = 0;
        if (comb && NRM_VALID(m + 2 * NGW)) { sa3 = SLOT[2 * (m + 2 * NGW)]; sb3 = SLOT[2 * (m + 2 * NGW) + 1]; }
        NRM_LOAD(m + NGW, sa2, sb2);
        sa2 = sa3; sb2 = sb3;
        const int b = m / T, p = m - b * T, l = p - PADR;
        if (l < 0) {
            if (MODE == 1 && !dry) {
                u32x2* o = (u32x2*)(A + (size_t)m * D) + lane;
#pragma unroll
                for (int j = 0; j < 4; ++j) o[64 * j] = (u32x2){0u, 0u};
                if (lane < 8) ((float*)(ws + WS_LOGF))[(size_t)m * 8 + lane] = 0.f;
            }
            continue;
        }
        if (MODE == 0 && l < NMETA) continue;
        if (comb) {
#pragma unroll
            for (int j = 0; j < 4; ++j) { v[j].x += bf_lo(ya[j].x) + bf_lo(yb[j].x); v[j].y += bf_hi(ya[j].x) + bf_hi(yb[j].x); v[j].z += bf_lo(ya[j].y) + bf_lo(yb[j].y); v[j].w += bf_hi(ya[j].y) + bf_hi(yb[j].y); }
        }
        if (MODE == 0 && !dry) { float* op = a.out + ((size_t)b * SEQ + (l - NMETA)) * D;
#pragma unroll
            for (int j = 0; j < 4; ++j) *(f32x4*)(op + 4 * lane + 256 * j) = v[j]; }
        if (MODE == 1 && !dry) { u32x2* hd = (u32x2*)(HB + (size_t)m * D) + lane;
#pragma unroll
            for (int j = 0; j < 4; ++j) hd[64 * j] = (u32x2){pk2(v[j].x, v[j].y), pk2(v[j].z, v[j].w)};
        }
        if (MODE == 0) continue;
        float ss = 0.f;
#pragma unroll
        for (int j = 0; j < 4; ++j) ss += (v[j].x * v[j].x + v[j].y * v[j].y) + (v[j].z * v[j].z + v[j].w * v[j].w);
        const float r = 1.0f / sqrtf(wave_sum(ss) * (1.0f / D) + 1e-6f);
#pragma unroll
        for (int j = 0; j < 4; ++j) v[j] = v[j] * r * gv[j];
        u32x2* o = (u32x2*)(A + (size_t)m * D) + lane;
        if (!dry) {
#pragma unroll
        for (int j = 0; j < 4; ++j) o[64 * j] = (u32x2){pk2(v[j].x, v[j].y), pk2(v[j].z, v[j].w)}; }
        else { float sink = v[0].x + v[1].y + v[2].z + v[3].w; asm volatile("" :: "v"(sink)); }
        if (MODE == 1) {
            float dsum[5];
#pragma unroll
            for (int q = 0; q < 5; ++q) { float d = 0.f;
#pragma unroll
                for (int j = 0; j < 4; ++j) { const f32x4 w = *(const LAS f32x4*)(wl + q * 1024 + 4 * lane + 256 * j); d += (v[j].x * w.x + v[j].y * w.y) + (v[j].z * w.z + v[j].w * w.w); }
                dsum[q] = wave_sum(d); }
            float mine = dsum[0];
            mine = lane == 1 ? dsum[1] : mine; mine = lane == 2 ? dsum[2] : mine; mine = lane == 3 ? dsum[3] : mine; mine = lane == 4 ? dsum[4] : mine;
            if (lane < 8 && !dry) { float lf = 0.f;
                if (lane < 5) { const float xx = mine + a.in(I_FB)[layer * 5 + lane]; lf = fminf(xx, 0.f) - fast_log(1.f + fast_exp(-fabsf(xx))); }
                ((float*)(ws + WS_LOGF))[(size_t)m * 8 + lane] = lf; }
        }
        if (MODE == 2) {
            float ds[20];
#pragma unroll
            for (int q = 0; q < 20; ++q) { float d = 0.f;
#pragma unroll
                for (int j = 0; j < 4; ++j) { const f32x4 w = *(const LAS f32x4*)(wl + q * 1024 + 4 * lane + 256 * j); d += (v[j].x * w.x + v[j].y * w.y) + (v[j].z * w.z + v[j].w * w.w); }
                ds[q] = wave_sum(d); }
            const float* bg = a.in(I_MBG) + layer * 4; const float* be = a.in(I_MBE) + layer * 16;
            float lg0 = ds[0] + bg[0], lg1 = ds[1] + bg[1], lg2 = ds[2] + bg[2], lg3 = ds[3] + bg[3];
            int g = 0; float mx = lg0;
            if (lg1 > mx) { mx = lg1; g = 1; } if (lg2 > mx) { mx = lg2; g = 2; } if (lg3 > mx) { mx = lg3; g = 3; }
            const float den = fast_exp(lg0 - mx) + fast_exp(lg1 - mx) + fast_exp(lg2 - mx) + fast_exp(lg3 - mx);
            const float pgrp = 1.0f / den;
            float s0 = g == 0 ? ds[4] : g == 1 ? ds[8] : g == 2 ? ds[12] : ds[16];
            float s1 = g == 0 ? ds[5] : g == 1 ? ds[9] : g == 2 ? ds[13] : ds[17];
            float s2 = g == 0 ? ds[6] : g == 1 ? ds[10] : g == 2 ? ds[14] : ds[18];
            float s3 = g == 0 ? ds[7] : g == 1 ? ds[11] : g == 2 ? ds[15] : ds[19];
            s0 += be[g * 4 + 0]; s1 += be[g * 4 + 1]; s2 += be[g * 4 + 2]; s3 += be[g * 4 + 3];
            int i0 = 0; float v0 = s0;
            if (s1 > v0) { v0 = s1; i0 = 1; } if (s2 > v0) { v0 = s2; i0 = 2; } if (s3 > v0) { v0 = s3; i0 = 3; }
            int i1 = -1; float v1 = -3.0e38f;
            if (i0 != 0 && s0 > v1) { v1 = s0; i1 = 0; } if (i0 != 1 && s1 > v1) { v1 = s1; i1 = 1; } if (i0 != 2 && s2 > v1) { v1 = s2; i1 = 2; } if (i0 != 3 && s3 > v1) { v1 = s3; i1 = 3; }
            const float e1 = fast_exp(v1 - v0), pt0 = 1.0f / (1.0f + e1), pt1 = e1 * pt0;
            if (dry) { float sink = pgrp * pt0 + pt1; asm volatile("" :: "v"(sink)); }
            if (lane == 0 && !dry) {
                const int ea = g * 4 + i0, eb = g * 4 + i1;
                const int la = atomicAdd((int*)&lcnt[ea], 1), lb = atomicAdd((int*)&lcnt[eb], 1);
                int* tk = (int*)(ws + WS_TOK) + (size_t)m * 8;
                tk[0] = ea; tk[1] = eb; tk[2] = __float_as_int(pgrp * pt0); tk[3] = __float_as_int(pgrp * pt1); tk[4] = la; tk[5] = lb;
            }
        }
    }
    __syncthreads();
#undef NRM_LOAD
#undef NRM_VALID
    if (MODE == 2 && F.tid < 16 && !dry) {
        const int c = lcnt[F.tid];
        ((int*)(ws + WS_WGCNT))[F.bx * 16 + F.tid] = c;
        atomicAdd((int*)(ws + WS_CTL) + CW_ECNT + 64 * layer + F.tid, c);
    }
    __syncthreads();
}

__device__ __forceinline__ void phase_route(const ArgsL& a, Frame& F, int layer) {
    unsigned char* ws = a.ws;
    LAS int* tbl = (LAS int*)F.lds;
    LAS int* part = tbl + 16;
    {
        const int e = F.tid & 15, q = F.tid >> 4; const int* wc = (const int*)(ws + WS_WGCNT); int acc = 0;
#pragma unroll
        for (int i = 0; i < 8; ++i) { const int w = q + 32 * i; if (w < (int)F.bx) acc += wc[w * 16 + e]; }
        part[q * 16 + e] = acc;
    }
    __syncthreads();
    if (F.tid < 16) {
        const int* cnt = (const int*)(ws + WS_CTL) + CW_ECNT + 64 * layer;
        int cv[16];
#pragma unroll
        for (int e = 0; e < 16; ++e) cv[e] = __hip_atomic_load(cnt + e, __ATOMIC_RELAXED, __HIP_MEMORY_SCOPE_AGENT);
        int base = 0;
#pragma unroll
        for (int e = 0; e < 16; ++e) if (e < F.tid) base += ((cv[e] + 255) >> 8) << 8;
#pragma unroll
        for (int q = 0; q < 32; ++q) base += part[q * 16 + F.tid];
        tbl[F.tid] = base;
    }
    __syncthreads();
    const int gw = F.bx * NWAVES + F.wave, NGW = gridDim.x * NWAVES, lane = F.lane;
    const bf16_t* A = A_PTR(a); bf16_t* AS = (bf16_t*)(ws + WS_AS);
    int tn[6] = {0, 0, 0, 0, 0, 0}; u32x4 xn0 = {0u, 0u, 0u, 0u}, xn1 = {0u, 0u, 0u, 0u};
#define RT_LOAD(mm) do { if ((mm) < M && ((mm) % T) >= PADR) { const int* tk_ = (const int*)(ws + WS_TOK) + (size_t)(mm) * 8; \
        _Pragma("unroll") for (int q_ = 0; q_ < 6; ++q_) tn[q_] = tk_[q_]; \
        const u32x4* src_ = (const u32x4*)(A + (size_t)(mm) * D) + lane; xn0 = src_[0]; xn1 = src_[64]; } } while (0)
    RT_LOAD(gw);
    for (int m = gw; m < M; m += NGW) {
        int tk[6];
#pragma unroll
        for (int q = 0; q < 6; ++q) tk[q] = tn[q];
        const u32x4 x0 = xn0, x1 = xn1;
        RT_LOAD(m + NGW);
        const int b = m / T, p = m - b * T, l = p - PADR;
        if (l < 0) continue;
        const int ea = tk[0], eb = tk[1], sa = tbl[ea] + tk[4], sb = tbl[eb] + tk[5];
        u32x4* d0 = (u32x4*)(AS + (size_t)sa * D) + lane; u32x4* d1 = (u32x4*)(AS + (size_t)sb * D) + lane;
        d0[0] = x0; d0[64] = x1; d1[0] = x0; d1[64] = x1;
        if (lane == 0) { int* sl = (int*)(ws + WS_SLOT) + 2 * m; sl[0] = sa; sl[1] = sb;
            float* cw = (float*)(ws + WS_CWS); cw[sa] = __int_as_float(tk[2]); cw[sb] = __int_as_float(tk[3]); }
    }
#undef RT_LOAD
    __syncthreads();
}

#ifndef PR_STAGES
#define PR_STAGES 15
#endif
__device__ __forceinline__ void phase_prep(const ArgsL& a, Frame& F, int layer, const bool dry = false) {
    unsigned char* ws = a.ws;
    LAS float* xs = (LAS float*)F.lds;
    const int wave = F.wave, lane = F.lane, tid = F.tid;
    const int m0 = F.bx * 129;
    const bf16_t* USH = (const bf16_t*)(ws + WS_USH);
    bf16_t* QKV = (bf16_t*)(ws + WS_QKV);
    if (F.bx < 10 && (!dry || (PR_STAGES & 8))) {
        const int bh = F.bx, b = bh / 5, h = bh % 5;
        const float* LOGF = (const float*)(ws + WS_LOGF) + (size_t)(b * T + PADR) * 8 + h;
        float* kb = (float*)(ws + WS_KB2) + (size_t)bh * KBP;
        LAS float* wtot = (LAS float*)F.lds;
        float v[33];
        const int l0 = tid * 33;
#pragma unroll
        for (int i = 0; i < 33; ++i) v[i] = (l0 + i < LTOK) ? LOGF[(size_t)(l0 + i) * 8] : 0.f;
#pragma unroll
        for (int i = 1; i < 33; ++i) v[i] += v[i - 1];
        float incl = v[32];
#pragma unroll
        for (int o = 1; o < 64; o <<= 1) { const float t = __shfl_up(incl, o); if (lane >= o) incl += t; }
        if (lane == 63) wtot[wave] = incl;
        __syncthreads();
        float off = incl - v[32];
        for (int w = 0; w < wave; ++w) off += wtot[w];
#pragma unroll
        for (int i = 0; i < 33; ++i) if (l0 + i < LTOK && !dry) kb[PADR + l0 + i] = -(off + v[i]) * LOG2E;
        for (int p = tid; p < PADR; p += NTHR) kb[p] = 0.f;
        for (int p = T + tid; p < KBP; p += NTHR) kb[p] = 0.f;
        __syncthreads();
    }
    if (F.bx >= 16 && F.bx < 28) {
        unsigned* z = (unsigned*)(ws + WS_RW + ((size_t)(F.bx - 16) * LPADDED + LTOK) * 768);
        for (int i = tid; i < (LPADDED - LTOK) * 192; i += NTHR) z[i] = 0u;
    }
    const int r16 = lane & 15, q4 = lane >> 4, hh = wave < 6 ? wave : 0;
    bf16x8 bw[2][4][2];
    float cw0[4], ca0[4], ckk[4], cka[4], crk[4];
    {
        const float* WUp = a.in(I_WUP) + (size_t)layer * 64 * RW_W + hh * 64 + r16; const float* AUp = a.in(I_AUP) + (size_t)layer * 64 * RW_W + hh * 64 + r16;
#pragma unroll
        for (int mtx = 0; mtx < 2; ++mtx)
#pragma unroll
            for (int blk = 0; blk < 4; ++blk)
#pragma unroll
                for (int ks = 0; ks < 2; ++ks) { const float* p_ = (mtx ? AUp : WUp) + (size_t)(32 * ks + 8 * q4) * RW_W + blk * 16;
                    const float f0 = p_[0], f1 = p_[RW_W], f2 = p_[2 * RW_W], f3 = p_[3 * RW_W], f4 = p_[4 * RW_W], f5 = p_[5 * RW_W], f6 = p_[6 * RW_W], f7 = p_[7 * RW_W];
                    bw[mtx][blk][ks] = __builtin_bit_cast(bf16x8, (u32x4){pk2(f0, f1), pk2(f2, f3), pk2(f4, f5), pk2(f6, f7)}); }
#pragma unroll
        for (int blk = 0; blk < 4; ++blk) { const int ch = layer * RW_W + hh * 64 + blk * 16 + r16;
            cw0[blk] = a.in(I_W0)[ch]; ca0[blk] = a.in(I_A0)[ch]; ckk[blk] = a.in(I_KK)[ch]; cka[blk] = a.in(I_KA)[ch]; crk[blk] = a.in(I_RK)[ch]; }
    }
    const float* mu = a.in(I_MU) + layer * SHIFT_W;
    f32x4 gq4 = *(const f32x4*)(a.in(I_QG) + layer * 64 + (lane & 15) * 4) * C2; const f32x4 gk4 = *(const f32x4*)(a.in(I_KG) + layer * 64 + (lane & 15) * 4);
    _Float16* RW = (_Float16*)(ws + WS_RW);
    bf16_t* BN = (bf16_t*)(ws + WS_BN);
    for (int t0 = 0; t0 < 129; t0 += 16) {
        const int nt = (129 - t0) < 16 ? (129 - t0) : 16;
        if (!dry || (PR_STAGES & 1)) {
            int tid = F.tid; asm volatile("" : "+v"(tid));
            u32x4 uu4[5], pp4[5];
#pragma unroll
            for (int q5 = 0; q5 < 5; ++q5) { const int item = tid + q5 * NTHR; uu4[q5] = (u32x4){0u, 0u, 0u, 0u}; pp4[q5] = (u32x4){0u, 0u, 0u, 0u};
                if (item < nt * 160) { const int tok = item / 160, ch = item - tok * 160, m = m0 + t0 + tok;
                    uu4[q5] = *(const u32x4*)(USH + (size_t)m * SHIFT_W + ch * 8);
                    if (m > 0) pp4[q5] = *(const u32x4*)(USH + (size_t)(m - 1) * SHIFT_W + ch * 8); } }
#pragma unroll
            for (int q5 = 0; q5 < 5; ++q5) { const int item = tid + q5 * NTHR;
                if (item < nt * 160) { const int tok = item / 160, ch = item - tok * 160;
                    const u32x4 u = uu4[q5], pv = pp4[q5];
                    const f32x4 mu0 = *(const f32x4*)(mu + ch * 8), mu1 = *(const f32x4*)(mu + ch * 8 + 4);
                    float x[8];
                    { float uu, pp;
                      uu = bf_lo(u.x); pp = bf_lo(pv.x); x[0] = uu + (pp - uu) * mu0.x;  uu = bf_hi(u.x); pp = bf_hi(pv.x); x[1] = uu + (pp - uu) * mu0.y;
                      uu = bf_lo(u.y); pp = bf_lo(pv.y); x[2] = uu + (pp - uu) * mu0.z;  uu = bf_hi(u.y); pp = bf_hi(pv.y); x[3] = uu + (pp - uu) * mu0.w;
                      uu = bf_lo(u.z); pp = bf_lo(pv.z); x[4] = uu + (pp - uu) * mu1.x;  uu = bf_hi(u.z); pp = bf_hi(pv.z); x[5] = uu + (pp - uu) * mu1.y;
                      uu = bf_lo(u.w); pp = bf_lo(pv.w); x[6] = uu + (pp - uu) * mu1.z;  uu = bf_hi(u.w); pp = bf_hi(pv.w); x[7] = uu + (pp - uu) * mu1.w; }
                    if (ch >= 144 && ch < 152) {
#pragma unroll
                        for (int q = 0; q < 8; ++q) { const float e = fast_exp(-2.f * fabsf(x[q])); const float th = (1.f - e) / (1.f + e); x[q] = x[q] < 0.f ? -th : th; }
                    }
                    LAS f32x4* d = (LAS f32x4*)(xs + tok * SHIFT_W + ch * 8);
                    d[0] = (f32x4){x[0], x[1], x[2], x[3]}; d[1] = (f32x4){x[4], x[5], x[6], x[7]}; } }
        }
        __syncthreads();
        if (wave < 6) { if (!dry || (PR_STAGES & 2)) {
            f32x4 acc[2][4];
#pragma unroll
            for (int mtx = 0; mtx < 2; ++mtx) {
                bf16x8 af[2];
#pragma unroll
                for (int ks = 0; ks < 2; ++ks) { const LAS float* xp = xs + r16 * SHIFT_W + 1152 + 64 * mtx + 32 * ks + 8 * q4;
                    const f32x4 u0 = *(const LAS f32x4*)xp, u1 = *(const LAS f32x4*)(xp + 4);
                    af[ks] = __builtin_bit_cast(bf16x8, (u32x4){pk2(u0.x, u0.y), pk2(u0.z, u0.w), pk2(u1.x, u1.y), pk2(u1.z, u1.w)}); }
#pragma unroll
                for (int blk = 0; blk < 4; ++blk) { f32x4 c4 = {0.f, 0.f, 0.f, 0.f};
                    c4 = __builtin_amdgcn_mfma_f32_16x16x32_bf16(af[0], bw[mtx][blk][0], c4, 0, 0, 0);
                    c4 = __builtin_amdgcn_mfma_f32_16x16x32_bf16(af[1], bw[mtx][blk][1], c4, 0, 0, 0);
                    acc[mtx][blk] = c4; }
            }
#pragma unroll
            for (int i = 0; i < 4; ++i) {
                const int tok = 4 * q4 + i, m = m0 + t0 + tok, b = m / T, p = m - b * T, l = p - PADR;
                const bool ok = (tok < nt) && (l >= 0);
                const LAS float* xr = xs + (tok < 16 ? tok : 0) * SHIFT_W + hh * 64 + r16;
                float kkr[4], kpv[4], avv4[4], omv[4], rv4[4], vv4[4];
                float ssq = 0.f, cf = 0.f;
#pragma unroll
                for (int blk = 0; blk < 4; ++blk) {
                    const float wlv = cw0[blk] + acc[0][blk][i], alv = ca0[blk] + acc[1][blk][i];
                    const float r = xr[blk * 16], k = xr[384 + blk * 16], v = xr[768 + blk * 16];
                    const float logw = -softplus_f(-wlv) - 0.5f;
                    const float xw = fast_exp(logw);
                    omv[blk] = xw < 0.02f ? xw * (1.f - 0.5f * xw + xw * xw * (1.f / 6.f)) : 1.f - fast_exp(-xw);
                    const float av = 1.f / (1.f + fast_exp(-alv));
                    kkr[blk] = k * ckk[blk]; kpv[blk] = k * (1.f + (av - 1.f) * cka[blk]); avv4[blk] = av; rv4[blk] = r; vv4[blk] = v;
                    ssq += kkr[blk] * kkr[blk]; cf += r * kpv[blk] * crk[blk];
                }
                ssq = allred16(ssq); cf = allred16(cf);
                const float inv = 1.0f / fmaxf(sqrtf(ssq), 1e-12f);
                if (ok && !dry) {
                    _Float16* o = RW + ((size_t)(b * RW_H + hh) * LPADDED + l) * 384 + r16;
#pragma unroll
                    for (int blk = 0; blk < 4; ++blk) { const float kk = kkr[blk] * inv, bb = kk * avv4[blk];
                        o[blk * 16] = (_Float16)kk; o[64 + blk * 16] = (_Float16)(-omv[blk]); o[128 + blk * 16] = (_Float16)(-bb); o[192 + blk * 16] = (_Float16)kpv[blk];
                        o[256 + blk * 16] = (_Float16)rv4[blk]; o[320 + blk * 16] = (_Float16)vv4[blk];
                        BN[(size_t)m * RW_W + hh * 64 + blk * 16 + r16] = f2bf(cf * vv4[blk]); }
                } else { float sink = ssq + cf + inv + omv[0] + kpv[1]; asm volatile("" :: "v"(sink)); }
            } }
        }
        if (!dry || (PR_STAGES & 4)) {
            const int it4 = lane >> 4, e4 = lane & 15;
            u32x2 xv[5]; bf16_t* qp5[5]; bool okv[5];
#pragma unroll
            for (int ps = 0; ps < 5; ++ps) { const int item = (ps * 8 + wave) * 4 + it4, tok = item / 10, hq = item - tok * 10;
                const int m = m0 + t0 + tok, p = m % T;
                okv[ps] = (tok < nt) && (p >= PADR);
                qp5[ps] = QKV + (size_t)m * QKV_W + 960 + hq * 64 + e4 * 4;
                xv[ps] = okv[ps] ? *(const u32x2*)qp5[ps] : (u32x2){0u, 0u}; }
#pragma unroll
            for (int ps = 0; ps < 5; ++ps) { const int item = (ps * 8 + wave) * 4 + it4, hq = item % 10;
                const float x0 = bf_lo(xv[ps].x), x1 = bf_hi(xv[ps].x), x2 = bf_lo(xv[ps].y), x3 = bf_hi(xv[ps].y);
                const float ss = allred16((x0 * x0 + x1 * x1) + (x2 * x2 + x3 * x3));
                const float rs = 1.0f / sqrtf(ss * (1.0f / 64.f) + 1e-6f);
                const f32x4 gg = hq < 5 ? gq4 : gk4;
                const u32x2 w = {pk2(x0 * rs * gg.x, x1 * rs * gg.y), pk2(x2 * rs * gg.z, x3 * rs * gg.w)};
                if (okv[ps] && !dry) *(u32x2*)qp5[ps] = w; else asm volatile("" :: "v"(w.x), "v"(w.y)); }
        }
        __syncthreads();
    }
}


constexpr int SCH = 16;
static_assert(LTOK % SCH == 0, "whole chunks");
__device__ __forceinline__ void rwkv_scan(const ArgsL& a, Frame& F, int wgi, int dry = 0) {
    const int bh = wgi >> 4, q8 = wgi & 15, b = bh / RW_H, h = bh % RW_H;
    const int tid = F.tid, wave = F.wave, lane = F.lane;
    const unsigned char* rw = a.ws + WS_RW + (size_t)bh * LPADDED * 768;
    LAS float* ring = (LAS float*)F.lds;
    LAS float* ypart = (LAS float*)(F.lds + 49152);
    LAS unsigned char* stg = F.lds + 81920;
    bf16_t* y0 = (bf16_t*)(a.ws + WS_YCAT);
    constexpr int NCH = LTOK / SCH;
    const bool isld = (wave & 2) != 0; const int lw = (wave & 1) + ((wave >> 2) << 1), tl = lw * 64 + lane;
    float s0 = 0.f, s1 = 0.f;
    const int i32 = lane & 31, rsel = lane >> 5, rloc = 2 * wave + rsel;
#define RW_BAR() asm volatile("s_waitcnt lgkmcnt(0)\n\ts_barrier" ::: "memory")
#define RW_ISSUE(cc) do { const unsigned char* src_ = rw + (size_t)(cc) * SCH * 768 + (size_t)tl * 16; LAS unsigned char* d_ = stg + ((cc) & 3) * 12288 + lw * 1024; \
        _Pragma("unroll") for (int k_ = 0; k_ < 3; ++k_) __builtin_amdgcn_global_load_lds((const unsigned*)(src_ + k_ * 4096), (LAS unsigned*)(d_ + k_ * 4096), 16, 0, 0); } while (0)
#define RW_CONVERT(cc) do { const LAS unsigned char* s_ = stg + ((cc) & 3) * 12288 + tl * 16; LAS float* rb_ = ring + ((cc) & 1) * 6144; \
        _Pragma("unroll") for (int k_ = 0; k_ < 3; ++k_) { const int pc_ = tl + 256 * k_; const int t_ = pc_ / 48, q_ = pc_ - t_ * 48, vec_ = q_ >> 3, e0_ = (q_ & 7) * 8; \
            const u32x4 w_ = *(const LAS u32x4*)(s_ + k_ * 4096); \
            const f16x4 lo_ = __builtin_bit_cast(f16x4, (u32x2){w_.x, w_.y}), hi_ = __builtin_bit_cast(f16x4, (u32x2){w_.z, w_.w}); \
            const float f0 = (float)lo_.x, f1 = (float)lo_.y, f2 = (float)lo_.z, f3 = (float)lo_.w, f4 = (float)hi_.x, f5 = (float)hi_.y, f6 = (float)hi_.z, f7 = (float)hi_.w; \
            if (vec_ < 4) { LAS float* d_ = rb_ + t_ * 384 + (vec_ >> 1) * 128 + (e0_ >> 1) * 4 + (vec_ & 1) * 2; \
                *(LAS f32x2*)(d_) = (f32x2){f0, f1}; *(LAS f32x2*)(d_ + 4) = (f32x2){f2, f3}; *(LAS f32x2*)(d_ + 8) = (f32x2){f4, f5}; *(LAS f32x2*)(d_ + 12) = (f32x2){f6, f7}; } \
            else { LAS f32x4* d_ = (LAS f32x4*)(rb_ + t_ * 384 + (vec_ == 4 ? 256 : 320) + e0_); d_[0] = (f32x4){f0, f1, f2, f3}; d_[1] = (f32x4){f4, f5, f6, f7}; } } } while (0)
#define RW_STORE_Y(cc) do { if (tl < 32) { const LAS float* yb_ = ypart + ((cc) & 1) * 4096; const int t_ = tl >> 1, pr_ = tl & 1; const int l_ = (cc) * SCH + t_; \
        const LAS f32x4* q_ = (const LAS f32x4*)(yb_ + t_ * 128 + pr_ * 64); f32x4 sa_ = q_[0], sb_ = q_[8]; \
        _Pragma("unroll") for (int k_ = 1; k_ < 8; ++k_) { sa_ = sa_ + q_[k_]; sb_ = sb_ + q_[8 + k_]; } \
        *(unsigned*)(y0 + (size_t)(b * T + PADR + l_) * RW_W + h * 64 + q8 * 4 + 2 * pr_) = pk2((sa_.x + sa_.y) + (sa_.z + sa_.w), (sb_.x + sb_.y) + (sb_.z + sb_.w)); } } while (0)
    if (isld) {
        RW_ISSUE(0); asm volatile("s_waitcnt vmcnt(0)" ::: "memory"); RW_CONVERT(0);
        RW_ISSUE(1); RW_ISSUE(2);
    }
    RW_BAR();
    for (int c = 0; c < NCH; ++c) {
        if (isld) {
            if (c + 2 < NCH) { asm volatile("s_waitcnt vmcnt(3)" ::: "memory"); RW_CONVERT(c + 1); }
            else if (c + 1 < NCH) { asm volatile("s_waitcnt vmcnt(0)" ::: "memory"); RW_CONVERT(c + 1); }
            if (c > 0 && !dry) RW_STORE_Y(c - 1);
            if (c + 3 < NCH) RW_ISSUE(c + 3);
        } else if (dry != 1 && wave < 2) {
            const unsigned ba = (unsigned)(uintptr_t)(ring + (c & 1) * 6144) + i32 * 16, ca = (unsigned)(uintptr_t)(ring + (c & 1) * 6144) + 1024 + i32 * 8,
                           va = (unsigned)(uintptr_t)(ring + (c & 1) * 6144) + 1280 + (q8 * 4 + rloc) * 4, ya = (unsigned)(uintptr_t)(ypart + (c & 1) * 4096 + rloc * 32 + i32);
            f32x4 OA[4], OB[4]; f32x2 OC[4]; float OV[4];
            OC[3] = (f32x2){0.f, 0.f};
#define RW_FETCH(tt, sl) asm volatile("ds_read_b128 %0, %4 offset:%c7\n\tds_read_b128 %1, %4 offset:%c8\n\tds_read_b64 %2, %5 offset:%c7\n\tds_read_b32 %3, %6 offset:%c7" \
                : "=&v"(OA[sl]), "=&v"(OB[sl]), "=&v"(OC[sl]), "=&v"(OV[sl]) : "v"(ba), "v"(ca), "v"(va), "i"((tt) * 1536), "i"((tt) * 1536 + 512) : "memory")
            RW_FETCH(0, 0); RW_FETCH(1, 1);
            float p, p2, y;
#define RW_STEP(t, WAITN, YL1, YL2, YW, FETCHL) asm volatile( \
                "s_waitcnt lgkmcnt(" WAITN ")\n\t" \
                "v_mul_f32 %[p], %[s0], %[kk0]\n\t" \
                "v_fmac_f32 %[p], %[s1], %[kk1]\n\t" \
                YL1 "\n\t" YL2 "\n\t" \
                XL8 "\n\t" \
                "v_fmac_f32 %[s0], %[s0], %[om0]\n\t" \
                "v_fmac_f32 %[s1], %[s1], %[om1]\n\t" \
                XL4 "\n\t" \
                "v_fmac_f32 %[s0], %[vf], %[kv0]\n\t" \
                "v_fmac_f32 %[s1], %[vf], %[kv1]\n\t" \
                XL2 "\n\t" \
                YW "\n\t" \
                FETCHL \
                : [p] "=&v"(p), [p2] "=&v"(p2), [y] "=&v"(y), [s0] "+v"(s0), [s1] "+v"(s1), [nA] "=&v"(OA[((t) + 2) & 3]), [nB] "=&v"(OB[((t) + 2) & 3]), [nC] "=&v"(OC[((t) + 2) & 3]), [nV] "=&v"(OV[((t) + 2) & 3]) \
                : [kk0] "v"(OA[(t) & 3].x), [kk1] "v"(OA[(t) & 3].y), [om0] "v"(OA[(t) & 3].z), [om1] "v"(OA[(t) & 3].w), [bb0] "v"(OB[(t) & 3].x), [bb1] "v"(OB[(t) & 3].y), [kv0] "v"(OB[(t) & 3].z), [kv1] "v"(OB[(t) & 3].w), \
                  [vf] "v"(OV[(t) & 3]), [rp0] "v"(OC[((t) + 3) & 3].x), [rp1] "v"(OC[((t) + 3) & 3].y), [ba] "v"(ba), [ca] "v"(ca), [va] "v"(va), [ya] "v"(ya), \
                  [oa] "i"(((t) + 2) * 1536), [ob] "i"(((t) + 2) * 1536 + 512), [oy] "i"(((t) - 1) * 512) : "memory")
#define RW_YL1 "v_mul_f32 %[y], %[s0], %[rp0]"
#define RW_YL2 "v_fmac_f32 %[y], %[s1], %[rp1]"
#define RW_YW  "ds_write_b32 %[ya], %[y] offset:%c[oy]"
#define RW_NOP "s_nop 0"
#define RW_TAIL_F "ds_read_b128 %[nA], %[ba] offset:%c[oa]\n\t" \
                XL1 "\n\t" \
                "ds_read_b128 %[nB], %[ba] offset:%c[ob]\n\t" \
                "ds_read_b64 %[nC], %[ca] offset:%c[oa]\n\t" \
                "v_mov_b32 %[p2], %[p]\n\t" \
                "ds_read_b32 %[nV], %[va] offset:%c[oa]\n\t" \
                "s_nop 0\n\t" \
                XSW "\n\t" \
                "v_add_f32 %[p], %[p], %[p2]\n\t" \
                "v_fmac_f32 %[s0], %[p], %[bb0]\n\t" \
                "v_fmac_f32 %[s1], %[p], %[bb1]"
#define RW_TAIL_N "s_nop 0\n\t" \
                XL1 "\n\t" \
                "s_nop 1\n\t" \
                "v_mov_b32 %[p2], %[p]\n\t" \
                "s_nop 1\n\t" \
                XSW "\n\t" \
                "v_add_f32 %[p], %[p], %[p2]\n\t" \
                "v_fmac_f32 %[s0], %[p], %[bb0]\n\t" \
                "v_fmac_f32 %[s1], %[p], %[bb1]"
#define RW_ALLSTEPS() do { \
            RW_STEP(0, "4", RW_NOP, RW_NOP, RW_NOP, RW_TAIL_F); \
            RW_STEP(1, "4", RW_YL1, RW_YL2, RW_YW, RW_TAIL_F); \
            RW_STEP(2, "5", RW_YL1, RW_YL2, RW_YW, RW_TAIL_F);  RW_STEP(3, "5", RW_YL1, RW_YL2, RW_YW, RW_TAIL_F);  RW_STEP(4, "5", RW_YL1, RW_YL2, RW_YW, RW_TAIL_F); \
            RW_STEP(5, "5", RW_YL1, RW_YL2, RW_YW, RW_TAIL_F);  RW_STEP(6, "5", RW_YL1, RW_YL2, RW_YW, RW_TAIL_F);  RW_STEP(7, "5", RW_YL1, RW_YL2, RW_YW, RW_TAIL_F); \
            RW_STEP(8, "5", RW_YL1, RW_YL2, RW_YW, RW_TAIL_F);  RW_STEP(9, "5", RW_YL1, RW_YL2, RW_YW, RW_TAIL_F);  RW_STEP(10, "5", RW_YL1, RW_YL2, RW_YW, RW_TAIL_F); \
            RW_STEP(11, "5", RW_YL1, RW_YL2, RW_YW, RW_TAIL_F); RW_STEP(12, "5", RW_YL1, RW_YL2, RW_YW, RW_TAIL_F); RW_STEP(13, "5", RW_YL1, RW_YL2, RW_YW, RW_TAIL_F); \
            RW_STEP(14, "5", RW_YL1, RW_YL2, RW_YW, RW_TAIL_N); \
            RW_STEP(15, "1", RW_YL1, RW_YL2, RW_YW, RW_TAIL_N); \
            asm volatile("v_mul_f32 %[y], %[s0], %[r0]\n\tv_fmac_f32 %[y], %[s1], %[r1]\n\tds_write_b32 %[ya], %[y] offset:7680" : [y] "=&v"(y) : [s0] "v"(s0), [s1] "v"(s1), [r0] "v"(OC[3].x), [r1] "v"(OC[3].y), [ya] "v"(ya) : "memory"); \
 } while (0)
#ifdef SCAN_PROBE_NOXL
            if (dry == 2) {
#define XL8 "v_add_f32 %[p], %[p], %[p]"
#define XL4 "v_add_f32 %[p], %[p], %[p]"
#define XL2 "v_add_f32 %[p], %[p], %[p]"
#define XL1 "v_add_f32 %[p], %[p], %[p]"
#define XSW "v_add_f32 %[p], %[p], %[p2]"
                RW_ALLSTEPS();
#undef XL8
#undef XL4
#undef XL2
#undef XL1
#undef XSW
            } else
#endif
            {
#define XL8 "v_add_f32_dpp %[p], %[p], %[p] row_ror:8 row_mask:0xf bank_mask:0xf bound_ctrl:1"
#define XL4 "v_add_f32_dpp %[p], %[p], %[p] row_ror:4 row_mask:0xf bank_mask:0xf bound_ctrl:1"
#define XL2 "v_add_f32_dpp %[p], %[p], %[p] row_ror:2 row_mask:0xf bank_mask:0xf bound_ctrl:1"
#define XL1 "v_add_f32_dpp %[p], %[p], %[p] row_ror:1 row_mask:0xf bank_mask:0xf bound_ctrl:1"
#define XSW "v_permlane16_swap_b32 %[p], %[p2]"
                RW_ALLSTEPS();
            }
#undef RW_ALLSTEPS
#undef RW_STEP
#undef XL8
#undef XL4
#undef XL2
#undef XL1
#undef XSW
#undef RW_YL1
#undef RW_YL2
#undef RW_YW
#undef RW_NOP
#undef RW_TAIL_F
#undef RW_TAIL_N
#undef RW_FETCH
        }
        RW_BAR();
    }
    if (isld && !dry) RW_STORE_Y(NCH - 1);
    asm volatile("s_waitcnt vmcnt(0) lgkmcnt(0)\n\ts_barrier" ::: "memory");
#undef RW_STORE_Y
#undef RW_ISSUE
#undef RW_CONVERT
#undef RW_BAR
}

__device__ __forceinline__ int crow(int r, int hi) { return (r & 3) + 8 * (r >> 2) + 4 * hi; }
__device__ __forceinline__ void glds16(const void* gsrc, unsigned lds_dst) { unsigned keep;
    asm volatile("s_mov_b32 %0, m0\n\ts_mov_b32 m0, %2\n\ts_nop 0\n\tglobal_load_lds_dwordx4 %1, off\n\ts_mov_b32 m0, %0" : "=&s"(keep) : "v"(gsrc), "s"(lds_dst) : "memory"); }
__device__ __forceinline__ void glds4(const void* gsrc, unsigned lds_dst) { unsigned keep;
    asm volatile("s_mov_b32 %0, m0\n\ts_mov_b32 m0, %2\n\ts_nop 0\n\tglobal_load_lds_dword %1, off\n\ts_mov_b32 m0, %0" : "=&s"(keep) : "v"(gsrc), "s"(lds_dst) : "memory"); }
typedef LAS const char* lds_cptr;
constexpr int FX_K = 0, FX_V = 24576, FX_WS = 49152, FX_OST = 51200, FX_FLG = 83968, FX_KB = 84224  ;

__device__ __forceinline__ void fx_pv(f32x16* o, int vb, bf16x8 pa0, bf16x8 pa1, bf16x8 pa2, bf16x8 pa3) {
#pragma unroll
    for (int d0 = 0; d0 < 2; ++d0) { s16x4 lo[4], hi[4];
#pragma unroll
        for (int ks = 0; ks < 4; ++ks) {
            asm volatile("ds_read_b64_tr_b16 %0,%1 offset:%c2" : "=&v"(lo[ks]) : "v"(vb), "i"(d0 * 4096 + ks * 1024) : "memory");
            asm volatile("ds_read_b64_tr_b16 %0,%1 offset:%c2" : "=&v"(hi[ks]) : "v"(vb), "i"(d0 * 4096 + ks * 1024 + 512) : "memory"); }
        asm volatile("s_waitcnt lgkmcnt(0)" ::: "memory"); __builtin_amdgcn_sched_barrier(0);
#define FX_PK(k) (bf16x8){lo[k][0], lo[k][1], lo[k][2], lo[k][3], hi[k][0], hi[k][1], hi[k][2], hi[k][3]}
        o[d0] = __builtin_amdgcn_mfma_f32_32x32x16_bf16(pa0, FX_PK(0), o[d0], 0, 0, 0);
        o[d0] = __builtin_amdgcn_mfma_f32_32x32x16_bf16(pa1, FX_PK(1), o[d0], 0, 0, 0);
        o[d0] = __builtin_amdgcn_mfma_f32_32x32x16_bf16(pa2, FX_PK(2), o[d0], 0, 0, 0);
        o[d0] = __builtin_amdgcn_mfma_f32_32x32x16_bf16(pa3, FX_PK(3), o[d0], 0, 0, 0);
#undef FX_PK
    }
}
__device__ __forceinline__ float halves_max(float m) { auto rr = __builtin_amdgcn_permlane32_swap(__float_as_uint(m), __float_as_uint(m), false, false); return fmaxf(__uint_as_float(rr[0]), __uint_as_float(rr[1])); }
__device__ __forceinline__ float halves_sum(float m) { auto rr = __builtin_amdgcn_permlane32_swap(__float_as_uint(m), __float_as_uint(m), false, false); return __uint_as_float(rr[0]) + __uint_as_float(rr[1]); }

template <int KIND>
__device__ __forceinline__ void attn_unit(const ArgsL& a, Frame& F, int b, int h, int qb, float bound) {
    const int lane = F.lane, wave = F.wave, r32 = lane & 31, hi = lane >> 5;
    LAS unsigned char* lds = F.lds;
    const bf16_t* QKV = (const bf16_t*)(a.ws + WS_QKV);
    const size_t rowbase = (size_t)b * T;
    const int p0 = qb * 256;
    constexpr int QC = KIND ? 0 : 960, KC = KIND ? 320 : 1280, VC = KIND ? 640 : 1600;
    const bf16_t* Qw = QKV + (rowbase + p0 + wave * 32) * QKV_W + QC + h * 64;
    const bf16_t* Kh = QKV + rowbase * QKV_W + KC + h * 64;
    const bf16_t* Vh = QKV + rowbase * QKV_W + VC + h * 64;
    const float* kbias = (const float*)(a.ws + WS_KB2) + (size_t)(b * FX_H + h) * KBP;
    const unsigned lds0 = (unsigned)(uintptr_t)lds;
    bf16x8 qr[4];
#pragma unroll
    for (int d0 = 0; d0 < 4; ++d0) qr[d0] = *(const bf16x8*)(Qw + (size_t)r32 * QKV_W + d0 * 16 + hi * 8);
    const int qp = p0 + wave * 32 + r32;
    const bool qvalid = (qp >= PADR) && (qp < T);
    const int plast = (p0 + 255) < (T - 1) ? (p0 + 255) : (T - 1);
    const int jlast = plast >> 6, jfirst = PADR >> 6;
    const int jw = (p0 + wave * 32 + 31) >> 6;
    const bf16_t* ksrc = Kh + (size_t)lane * QKV_W + wave * 8;
    const bf16_t* vsrc = Vh + (size_t)(16 * (wave & 3) + (lane >> 2)) * QKV_W + (wave >> 2) * 32 + (lane & 3) * 8;
    const unsigned kdst = lds0 + FX_K + wave * 1024, vdst = lds0 + FX_V + wave * 1024;
#define FX_DMA(j, slot) do { glds16(ksrc + (size_t)(j) * 64 * QKV_W, (unsigned)__builtin_amdgcn_readfirstlane(kdst + (slot) * 8192)); \
                             glds16(vsrc + (size_t)(j) * 64 * QKV_W, (unsigned)__builtin_amdgcn_readfirstlane(vdst + (slot) * 8192)); \
                             if (KIND == 0) glds4(kbias + 64 * (j) + lane, (unsigned)__builtin_amdgcn_readfirstlane(lds0 + FX_KB + (slot) * 2048 + wave * 256)); } while (0)
    const int vb0 = (int)(lds0 + FX_V) + ((lane >> 4) & 1) * 32 + (lane & 3) * 8 + (4 * hi + ((lane & 15) >> 2)) * 64;
    const lds_cptr kp0 = (lds_cptr)lds + FX_K + hi * 1024 + r32 * 16;
    LAS float* wsf = (LAS float*)(lds + FX_WS) + wave * 64;
    LAS float* flg = (LAS float*)(lds + FX_FLG);
    float m_run = KIND ? 0.f : -1.0e30f, l_run = 0.f;
    f32x16 o[2]; o[0] = f32x16{}; o[1] = f32x16{};
    asm volatile("" : "+v"(qr[0]), "+v"(qr[1]), "+v"(qr[2]), "+v"(qr[3]));
    int slot = 0;
    FX_DMA(jlast, 0);
    if (jlast > jfirst) FX_DMA(jlast - 1, 1);
    for (int j = jlast; j >= jfirst; --j) {
        if (j > jfirst) { if (KIND == 0) asm volatile("s_waitcnt vmcnt(3) lgkmcnt(0)\n\ts_barrier" ::: "memory"); else asm volatile("s_waitcnt vmcnt(2) lgkmcnt(0)\n\ts_barrier" ::: "memory"); }
        else asm volatile("s_waitcnt vmcnt(0) lgkmcnt(0)\n\ts_barrier" ::: "memory");
        if (j < jlast) {
            const LAS float* fl = flg + ((j + 1) & 1) * 16;
            const f32x4 fa = *(const LAS f32x4*)(fl), fb = *(const LAS f32x4*)(fl + 4);
            bool stop;
            if constexpr (KIND == 0) {
                const float mmin = fminf(fminf(fminf(fa.x, fa.y), fminf(fa.z, fa.w)), fminf(fminf(fb.x, fb.y), fminf(fb.z, fb.w)));
                stop = (bound + fl[8] - mmin) < -150.0f;
            } else {
                const float mmax = fmaxf(fmaxf(fmaxf(fa.x, fa.y), fmaxf(fa.z, fa.w)), fmaxf(fmaxf(fb.x, fb.y), fmaxf(fb.z, fb.w)));
                stop = mmax < -150.0f;
            }
            if (stop) break;
        }
        { const int s2 = slot + 2 >= 3 ? slot - 1 : slot + 2; if (j - 2 >= jfirst) FX_DMA(j - 2, s2); }
        if (j <= jw) {
            f32x16 s0v = f32x16{}, s1v = f32x16{};
            const lds_cptr kp = kp0 + slot * 8192;
#pragma unroll
            for (int d0 = 0; d0 < 4; ++d0) {
                const bf16x8 b0 = *(const LAS bf16x8*)(kp + d0 * 2048);
                const bf16x8 b1 = *(const LAS bf16x8*)(kp + d0 * 2048 + 512);
                s0v = __builtin_amdgcn_mfma_f32_32x32x16_bf16(b0, qr[d0], s0v, 0, 0, 0);
                s1v = __builtin_amdgcn_mfma_f32_32x32x16_bf16(b1, qr[d0], s1v, 0, 0, 0);
            }
            const bool edge = (64 * j + 63 >= p0 + wave * 32) || (64 * j < PADR);
            if constexpr (KIND == 0) {
                const LAS float* kbj = (const LAS float*)(lds + FX_KB + slot * 2048 + wave * 256) + 4 * hi;
#pragma unroll
                for (int g = 0; g < 4; ++g) { const f32x4 t0 = *(const LAS f32x4*)(kbj + 8 * g), t1 = *(const LAS f32x4*)(kbj + 32 + 8 * g);
                    s0v[4 * g] += t0.x; s0v[4 * g + 1] += t0.y; s0v[4 * g + 2] += t0.z; s0v[4 * g + 3] += t0.w;
                    s1v[4 * g] += t1.x; s1v[4 * g + 1] += t1.y; s1v[4 * g + 2] += t1.z; s1v[4 * g + 3] += t1.w; }
                if (edge) {
#pragma unroll
                    for (int r = 0; r < 16; ++r) { const int key = 64 * j + crow(r, hi);
                        if (key > qp || key < PADR) s0v[r] = -INFINITY;
                        if (key + 32 > qp || key + 32 < PADR) s1v[r] = -INFINITY; }
                }
                float rm = fmaxf(s0v[0], s1v[0]);
#pragma unroll
                for (int r = 1; r < 16; ++r) rm = fmaxf(rm, fmaxf(s0v[r], s1v[r]));
                rm = halves_max(rm);
                const float m_new = fmaxf(m_run, rm);
                const float f = __builtin_amdgcn_exp2f(m_run - m_new);
                m_run = m_new;
                float rs = 0.f;
#pragma unroll
                for (int r = 0; r < 16; ++r) { s0v[r] = __builtin_amdgcn_exp2f(s0v[r] - m_new); s1v[r] = __builtin_amdgcn_exp2f(s1v[r] - m_new); rs += s0v[r] + s1v[r]; }
                rs = halves_sum(rs);
                l_run = l_run * f + rs;
                if (!__all(f == 1.0f)) {
                    if (hi == 0) wsf[r32] = f;
                    LDS_WAIT();
#pragma unroll
                    for (int d_ = 0; d_ < 2; ++d_)
#pragma unroll
                        for (int r = 0; r < 16; ++r) o[d_][r] *= wsf[crow(r, hi)];
                }
            } else {
                f32x16 l0, l1;
#pragma unroll
                for (int r = 0; r < 16; ++r) {
                    const float z0 = s0v[r], z1 = s1v[r];
                    float a0 = -(fmaxf(z0, 0.f) + __builtin_amdgcn_logf(1.f + __builtin_amdgcn_exp2f(-fabsf(z0))));
                    float a1 = -(fmaxf(z1, 0.f) + __builtin_amdgcn_logf(1.f + __builtin_amdgcn_exp2f(-fabsf(z1))));
                    if (edge) { const int key = 64 * j + crow(r, hi);
                        if (key >= qp || key < PADR) { a0 = 0.f; s0v[r] = -INFINITY; }
                        if (key + 32 >= qp || key + 32 < PADR) { a1 = 0.f; s1v[r] = -INFINITY; } }
                    l0[r] = a0; l1[r] = a1;
                }
                float A[8], SA[9], SO[9];
#pragma unroll
                for (int g = 0; g < 4; ++g) { A[g] = (l0[4 * g] + l0[4 * g + 1]) + (l0[4 * g + 2] + l0[4 * g + 3]); A[4 + g] = (l1[4 * g] + l1[4 * g + 1]) + (l1[4 * g + 2] + l1[4 * g + 3]); }
                SA[8] = 0.f; SO[8] = 0.f;
#pragma unroll
                for (int g = 7; g >= 0; --g) SA[g] = A[g] + SA[g + 1];
#pragma unroll
                for (int g = 0; g < 8; ++g) { auto rr = __builtin_amdgcn_permlane32_swap(__float_as_uint(SA[g]), __float_as_uint(SA[g]), false, false); SO[g] = __uint_as_float(hi ? rr[0] : rr[1]); }
                const float R = m_run;
#pragma unroll
                for (int g = 0; g < 8; ++g) {
                    const float E = SA[g + 1] + (hi ? SO[g + 1] : SO[g]) + R;
                    if (g < 4) { float t = E;
                        s0v[4 * g + 3] = __builtin_amdgcn_exp2f(s0v[4 * g + 3] + l0[4 * g + 3] + t); t += l0[4 * g + 3];
                        s0v[4 * g + 2] = __builtin_amdgcn_exp2f(s0v[4 * g + 2] + l0[4 * g + 2] + t); t += l0[4 * g + 2];
                        s0v[4 * g + 1] = __builtin_amdgcn_exp2f(s0v[4 * g + 1] + l0[4 * g + 1] + t); t += l0[4 * g + 1];
                        s0v[4 * g + 0] = __builtin_amdgcn_exp2f(s0v[4 * g + 0] + l0[4 * g + 0] + t);
                    } else { const int q = g - 4; float t = E;
                        s1v[4 * q + 3] = __builtin_amdgcn_exp2f(s1v[4 * q + 3] + l1[4 * q + 3] + t); t += l1[4 * q + 3];
                        s1v[4 * q + 2] = __builtin_amdgcn_exp2f(s1v[4 * q + 2] + l1[4 * q + 2] + t); t += l1[4 * q + 2];
                        s1v[4 * q + 1] = __builtin_amdgcn_exp2f(s1v[4 * q + 1] + l1[4 * q + 1] + t); t += l1[4 * q + 1];
                        s1v[4 * q + 0] = __builtin_amdgcn_exp2f(s1v[4 * q + 0] + l1[4 * q + 0] + t);
                    }
                }
                m_run = R + SA[0] + SO[0];
            }
            u32x4 pw0, pw1, pw2, pw3;
            pw0 = (u32x4){pk2(s0v[0], s0v[1]), pk2(s0v[2], s0v[3]), pk2(s0v[4], s0v[5]), pk2(s0v[6], s0v[7])};
            pw1 = (u32x4){pk2(s0v[8], s0v[9]), pk2(s0v[10], s0v[11]), pk2(s0v[12], s0v[13]), pk2(s0v[14], s0v[15])};
            pw2 = (u32x4){pk2(s1v[0], s1v[1]), pk2(s1v[2], s1v[3]), pk2(s1v[4], s1v[5]), pk2(s1v[6], s1v[7])};
            pw3 = (u32x4){pk2(s1v[8], s1v[9]), pk2(s1v[10], s1v[11]), pk2(s1v[12], s1v[13]), pk2(s1v[14], s1v[15])};
            fx_pv(o, vb0 + slot * 8192, __builtin_bit_cast(bf16x8, pw0), __builtin_bit_cast(bf16x8, pw1), __builtin_bit_cast(bf16x8, pw2), __builtin_bit_cast(bf16x8, pw3));
        }
        float mm = qvalid ? m_run : (KIND ? -3.0e38f : 3.0e38f);
        if constexpr (KIND == 0) { mm = fminf(mm, dpp_f<0x128>(mm)); mm = fminf(mm, dpp_f<0x124>(mm)); mm = fminf(mm, dpp_f<0x122>(mm)); mm = fminf(mm, dpp_f<0x121>(mm));
            { auto sw = __builtin_amdgcn_permlane16_swap(__float_as_uint(mm), __float_as_uint(mm), false, false); mm = fminf(__uint_as_float(sw[0]), __uint_as_float(sw[1])); }
            { auto sw = __builtin_amdgcn_permlane32_swap(__float_as_uint(mm), __float_as_uint(mm), false, false); mm = fminf(__uint_as_float(sw[0]), __uint_as_float(sw[1])); } }
        else { mm = fmaxf(mm, dpp_f<0x128>(mm)); mm = fmaxf(mm, dpp_f<0x124>(mm)); mm = fmaxf(mm, dpp_f<0x122>(mm)); mm = fmaxf(mm, dpp_f<0x121>(mm));
            { auto sw = __builtin_amdgcn_permlane16_swap(__float_as_uint(mm), __float_as_uint(mm), false, false); mm = fmaxf(__uint_as_float(sw[0]), __uint_as_float(sw[1])); }
            { auto sw = __builtin_amdgcn_permlane32_swap(__float_as_uint(mm), __float_as_uint(mm), false, false); mm = fmaxf(__uint_as_float(sw[0]), __uint_as_float(sw[1])); } }
        if (lane == 0) { flg[(j & 1) * 16 + wave] = mm;
            if (KIND == 0 && wave == 0) flg[(j & 1) * 16 + 8] = *(const LAS float*)(lds + FX_KB + slot * 2048); }
        slot = slot == 2 ? 0 : slot + 1;
    }
    asm volatile("s_waitcnt vmcnt(0) lgkmcnt(0)\n\ts_barrier" ::: "memory");
    float rli[16];
    if constexpr (KIND == 0) {
        if (hi == 0) wsf[32 + r32] = l_run;
        LDS_WAIT();
#pragma unroll
        for (int r = 0; r < 16; ++r) rli[r] = __builtin_amdgcn_rcpf(wsf[32 + crow(r, hi)]);
    } else {
#pragma unroll
        for (int r = 0; r < 16; ++r) rli[r] = 1.0f;
    }
    bf16_t* Ow = (bf16_t*)(a.ws + WS_YCAT) + (size_t)(KIND ? 1 : 2) * M * RW_W + (rowbase + p0 + wave * 32) * RW_W + h * 64;
    {
        LAS bf16_t* stg = (LAS bf16_t*)(lds + FX_OST) + wave * 2048;
#pragma unroll
        for (int r = 0; r < 16; ++r) { const int orow = crow(r, hi);
#pragma unroll
            for (int d0 = 0; d0 < 2; ++d0) stg[orow * 64 + d0 * 32 + r32] = f2bf(o[d0][r] * rli[r]); }
        LDS_WAIT();
#pragma unroll
        for (int i = 0; i < 4; ++i) { const int row = i * 8 + (lane >> 3), ch = lane & 7; const u32x4 v = *(const LAS u32x4*)(stg + row * 64 + ch * 8);
            const int pr = p0 + wave * 32 + row;
            if (pr >= PADR && pr < T) *(u32x4*)(Ow + (size_t)row * RW_W + ch * 8) = v; }
    }
    asm volatile("s_waitcnt lgkmcnt(0)\n\ts_barrier" ::: "memory");
#undef FX_DMA
}


constexpr int CK = 64, NCK = 257, CKB = 40960;
static_assert(LPADDED == CK * NCK, "padded steps");
__device__ __forceinline__ int swz(int row, int chunk) { return row * 128 + ((chunk ^ (row & 7)) << 4); }
__device__ __forceinline__ void ck_mm(f32x16& acc, LAS unsigned char* A, LAS unsigned char* Bt, int m0, int n0, int r32, int hi) {
#pragma unroll
    for (int ks = 0; ks < 4; ++ks) {
        const bf16x8 av = *(const LAS bf16x8*)(A + swz(m0 + r32, 2 * ks + hi));
        const bf16x8 bv = *(const LAS bf16x8*)(Bt + swz(n0 + r32, 2 * ks + hi));
        acc = __builtin_amdgcn_mfma_f32_32x32x16_bf16(av, bv, acc, 0, 0, 0);
    }
}
__device__ __forceinline__ void ck_store_t(LAS unsigned char* dst, const f32x16& acc, int m0, int n0, int r32, int hi) {
#pragma unroll
    for (int g = 0; g < 4; ++g) { const u32x2 w = {pk2(acc[4 * g], acc[4 * g + 1]), pk2(acc[4 * g + 2], acc[4 * g + 3])};
        *(LAS u32x2*)(dst + swz(n0 + r32, (m0 >> 3) + g) + hi * 8) = w; }
}
constexpr int CA_KAP = 0, CA_BET = 8192, CA_CHI = 16384, CA_RHO = 24576, CA_VMT = 32768, CA_BHT = 40960, CA_KHT = 49152, CA_AK = 57344, CA_RB = 65536, CA_RK = 73728,
              CA_AB = 81920  , CA_RHS = 98304  , CA_G64 = MISC_OFF + 2048  , CA_SCR = MISC_OFF + 4096  ;

#ifndef CA_STAGES
#define CA_STAGES 15
#endif
__device__ __forceinline__ void phase_chunkA(const ArgsL& a, Frame& F, const bool dry = false) {
    const int wave = F.wave;
    LAS unsigned char* L = F.lds;
    u32x4 pre6[6];
    for (int id = F.bx; id < 12 * NCK; id += (int)gridDim.x) {
        int tid = F.tid, lane, r32, hi;
#define CK_FRESH() do { asm volatile("" : "+v"(tid)); lane = tid & 63; r32 = lane & 31; hi = lane >> 5; } while (0)
        CK_FRESH();
        const int bh = id / NCK, c = id - bh * NCK;
        unsigned char* blk = a.ws + WS_RW + ((size_t)bh * LPADDED + (size_t)c * CK) * 768;
        {
            if (id == F.bx) {
#pragma unroll
                for (int q6 = 0; q6 < 6; ++q6) pre6[q6] = *(const u32x4*)(blk + (size_t)(tid + q6 * NTHR) * 16);
            }
#pragma unroll
            for (int q6 = 0; q6 < 6; ++q6) *(LAS u32x4*)(L + CA_AB + (tid + q6 * NTHR) * 16) = pre6[q6];
            __syncthreads();
            const int k = tid & 63, tq = tid >> 6;
            const LAS _Float16* src = (const LAS _Float16*)(L + CA_AB) + (tq * 8) * 384 + k;
            float kk[8], w[8], bb[8], kp[8], rr[8], vv[8];
#pragma unroll
            for (int e = 0; e < 8; ++e) { kk[e] = (float)src[e * 384]; w[e] = 1.f + (float)src[e * 384 + 64]; bb[e] = -(float)src[e * 384 + 128];
                kp[e] = (float)src[e * 384 + 192]; rr[e] = (float)src[e * 384 + 256]; vv[e] = (float)src[e * 384 + 320]; }
            float g[8]; g[0] = w[0];
#pragma unroll
            for (int e = 1; e < 8; ++e) g[e] = g[e - 1] * w[e];
            LAS float* scr = (LAS float*)(L + CA_SCR);
            scr[tq * 64 + k] = g[7];
            __syncthreads();
            {
                const int idn = id + (int)gridDim.x;
                if (idn < 12 * NCK) { const int bhn = idn / NCK, cn = idn - bhn * NCK; const unsigned char* bn_ = a.ws + WS_RW + ((size_t)bhn * LPADDED + (size_t)cn * CK) * 768;
#pragma unroll
                    for (int q6 = 0; q6 < 6; ++q6) pre6[q6] = *(const u32x4*)(bn_ + (size_t)(tid + q6 * NTHR) * 16); }
            }
            float pre = 1.f, tot = 1.f;
#pragma unroll
            for (int q = 0; q < 8; ++q) { const float s = scr[q * 64 + k]; if (q < tq) pre *= s; tot *= s; }
            if (tq == 0) ((LAS float*)(L + CA_G64))[k] = tot;
            unsigned bh4[4], kh4[4], vm4[4];
            float Gp = pre;
#pragma unroll
            for (int e = 0; e < 8; ++e) {
                const int t = tq * 8 + e; const float G = pre * g[e], iG = __builtin_amdgcn_rcpf(G);
                const float kap = kk[e] * Gp, bet = bb[e] * iG, chi = kp[e] * iG, rho = rr[e] * G;
                const int o = swz(t, k >> 3) + (k & 7) * 2;
                *(LAS unsigned short*)(L + CA_KAP + o) = f2bf(kap); *(LAS unsigned short*)(L + CA_BET + o) = f2bf(bet);
                *(LAS unsigned short*)(L + CA_CHI + o) = f2bf(chi); *(LAS unsigned short*)(L + CA_RHO + o) = f2bf(rho);
                ((LAS float*)(L + CA_RHS))[t * 128 + k] = kap;
                const float bhv = bet * tot, khv = chi * tot;
                if (e & 1) { bh4[e >> 1] |= (unsigned)f2bf(bhv) << 16; kh4[e >> 1] |= (unsigned)f2bf(khv) << 16; vm4[e >> 1] |= (unsigned)f2bf(vv[e]) << 16; }
                else { bh4[e >> 1] = f2bf(bhv); kh4[e >> 1] = f2bf(khv); vm4[e >> 1] = f2bf(vv[e]); }
                Gp = G;
            }
            *(LAS u32x4*)(L + CA_BHT + swz(k, tq)) = (u32x4){bh4[0], bh4[1], bh4[2], bh4[3]};
            *(LAS u32x4*)(L + CA_KHT + swz(k, tq)) = (u32x4){kh4[0], kh4[1], kh4[2], kh4[3]};
            *(LAS u32x4*)(L + CA_VMT + swz(k, tq)) = (u32x4){vm4[0], vm4[1], vm4[2], vm4[3]};
        }
        __syncthreads();
        CK_FRESH();
        if (!dry || (CA_STAGES & 2)) {
            const int p = wave & 3, nb = wave >> 2;
            LAS unsigned char* Am = L + ((p & 1) ? CA_CHI : CA_BET);
            LAS unsigned char* Bm = L + ((p & 2) ? CA_RHO : CA_KAP);
#pragma unroll
            for (int mb = 0; mb < 2; ++mb) {
                f32x16 acc = f32x16{};
                if (!(mb == 1 && nb == 0)) ck_mm(acc, Am, Bm, mb * 32, nb * 32, r32, hi);
                const int t = nb * 32 + r32;
#pragma unroll
                for (int i = 0; i < 16; ++i) { const int j = mb * 32 + crow(i, hi); const bool keep = (p & 2) ? (j <= t) : (j < t); if (!keep) acc[i] = 0.f; }
                if (p == 0) {
#pragma unroll
                    for (int gq = 0; gq < 4; ++gq) { LAS float* ab_ = (LAS float*)(L + CA_AB) + t * 64 + (mb * 8 + 2 * gq + hi);
                        ab_[0] = acc[4 * gq]; ab_[16] = acc[4 * gq + 1]; ab_[32] = acc[4 * gq + 2]; ab_[48] = acc[4 * gq + 3]; }
                } else ck_store_t(L + (p == 1 ? CA_AK : p == 2 ? CA_RB : CA_RK), acc, mb * 32, nb * 32, r32, hi);
            }
        }
        __syncthreads();
        CK_FRESH();
        if (wave < 4 && (!dry || (CA_STAGES & 2))) {
            const int mb = wave >> 1, nb = wave & 1;
            f32x16 acc = f32x16{};
            ck_mm(acc, L + CA_AK, L + CA_VMT, mb * 32, nb * 32, r32, hi);
#pragma unroll
            for (int i = 0; i < 16; ++i) ((LAS float*)(L + CA_RHS))[(mb * 32 + crow(i, hi)) * 128 + 64 + nb * 32 + r32] = acc[i];
        }
        __syncthreads();
        CK_FRESH();
        if (!dry || (CA_STAGES & 4)) {
            const int col = tid >> 2, p = tid & 3;
            unsigned abv = (unsigned)(uintptr_t)(L + CA_AB) + p * 64; asm volatile("" : "+v"(abv));
            const LAS float* ab = (const LAS float*)(uintptr_t)abv;
            const LAS float* rhs = (const LAS float*)(L + CA_RHS) + col;
            float xo[16];
#pragma unroll
            for (int i = 0; i < 16; ++i) xo[i] = 0.f;
#pragma unroll
            for (int tg = 0; tg < 64; tg += 4) {
                f32x4 av[4][4]; float rv[4];
#pragma unroll
                for (int r = 0; r < 4; ++r) { rv[r] = rhs[(tg + r) * 128];
#pragma unroll
                    for (int i4 = 0; i4 < (tg + r + 15) / 16; ++i4) av[r][i4] = *(const LAS f32x4*)(ab + (tg + r) * 64 + 4 * i4); }
#pragma unroll
                for (int r = 0; r < 4; ++r) { const int t = tg + r;
                    float s0 = (p == 0) ? rv[r] : 0.f, s1 = 0.f;
#pragma unroll
                    for (int i4 = 0; i4 < (t + 15) / 16; ++i4) {
                        s0 -= av[r][i4].x * xo[4 * i4]; s1 -= av[r][i4].y * xo[4 * i4 + 1]; s0 -= av[r][i4].z * xo[4 * i4 + 2]; s1 -= av[r][i4].w * xo[4 * i4 + 3]; }
                    float sx = s0 + s1;
                    sx += dpp_f<0xB1>(sx);
                    sx += dpp_f<0x4E>(sx);
                    if ((t & 3) == p) xo[t >> 2] = sx;
                    asm volatile("" : "+v"(xo[t >> 2]));
                }
                __builtin_amdgcn_sched_barrier(0);
            }
            LAS unsigned char* dst = L + (col < 64 ? CA_KAP : CA_BET);
            const int rowc = col & 63;
#pragma unroll
            for (int i = 0; i < 16; ++i) { const int tt = 4 * i + p; *(LAS unsigned short*)(dst + swz(rowc, tt >> 3) + (tt & 7) * 2) = f2bf(-xo[i]); }
        }
        __syncthreads();
        CK_FRESH();
        if (!dry || (CA_STAGES & 8)) {
            const int ty = wave >> 1;
            LAS unsigned char* nW1 = L + CA_KAP; LAS unsigned char* nW2 = L + CA_BET;
#pragma unroll
            for (int qq = 0; qq < 2; ++qq) {
                const int q = (wave & 1) * 2 + qq, qa = q >> 1, qb = q & 1;
                f32x16 acc = f32x16{};
                if (ty == 0) {
                    const int t = qa * 32 + r32;
#pragma unroll
                    for (int gq = 0; gq < 4; ++gq) { const u32x2 rv = *(const LAS u32x2*)(L + CA_RHO + swz(t, qb * 4 + gq) + hi * 8);
                        acc[4 * gq] = bf_lo(rv.x); acc[4 * gq + 1] = bf_hi(rv.x); acc[4 * gq + 2] = bf_lo(rv.y); acc[4 * gq + 3] = bf_hi(rv.y); }
                    ck_mm(acc, nW1, L + CA_RB, qb * 32, qa * 32, r32, hi);
                } else if (ty == 1) {
                    ck_mm(acc, nW1, L + CA_BHT, qb * 32, qa * 32, r32, hi);
                    if (qa == qb) { const float g64 = ((const LAS float*)(L + CA_G64))[qa * 32 + r32];
#pragma unroll
                        for (int i = 0; i < 16; ++i) if (crow(i, hi) == r32) acc[i] += g64; }
                } else if (ty == 2) {
                    ck_mm(acc, L + CA_KHT, L + CA_VMT, qb * 32, qa * 32, r32, hi);
                    ck_mm(acc, L + CA_BHT, nW2, qb * 32, qa * 32, r32, hi);
                } else {
                    ck_mm(acc, L + CA_RK, L + CA_VMT, qb * 32, qa * 32, r32, hi);
                    ck_mm(acc, L + CA_RB, nW2, qb * 32, qa * 32, r32, hi);
                }
                if (dry) { float sink = acc[0] + acc[5] + acc[10] + acc[15]; asm volatile("" :: "v"(sink)); }
                else if (ty < 2) {
                    unsigned char* o = blk + (ty == 0 ? 8192 : 0) + (size_t)(((qa * 2 + qb) * 2) * 1024) + lane * 16;
#pragma unroll
                    for (int ks = 0; ks < 2; ++ks)
                        *(u32x4*)(o + ks * 1024) = (u32x4){pk2(acc[8 * ks], acc[8 * ks + 1]), pk2(acc[8 * ks + 2], acc[8 * ks + 3]), pk2(acc[8 * ks + 4], acc[8 * ks + 5]), pk2(acc[8 * ks + 6], acc[8 * ks + 7])};
                } else if (ty == 2) {
                    unsigned char* o = blk + 16384 + (qa * 2 + qb) * 4096 + lane * 16;
#pragma unroll
                    for (int g = 0; g < 4; ++g) *(f32x4*)(o + g * 1024) = (f32x4){acc[4 * g], acc[4 * g + 1], acc[4 * g + 2], acc[4 * g + 3]};
                } else {
                    unsigned char* o = blk + 32768 + (qa * 2 + qb) * 2048 + lane * 8;
#pragma unroll
                    for (int g = 0; g < 4; ++g) *(u32x2*)(o + g * 512) = (u32x2){pk2(acc[4 * g], acc[4 * g + 1]), pk2(acc[4 * g + 2], acc[4 * g + 3])};
                }
            }
        }
        __syncthreads();
    }
}

__device__ __forceinline__ void rwkv_chunkB(const ArgsL& a, Frame& F, int bh) {
    const int lane = F.lane, wave = F.wave, r32 = lane & 31, hi = lane >> 5;
    const int b = bh / RW_H, h = bh % RW_H;
    LAS unsigned char* L = F.lds;
    const unsigned char* base = a.ws + WS_RW + (size_t)bh * LPADDED * 768;
    bf16_t* y0 = (bf16_t*)(a.ws + WS_YCAT);
    const bool isld = (wave & 2) != 0; const int lw = (wave & 1) + ((wave >> 2) << 1);
    LAS unsigned char* yimg0 = L + 3 * CKB; LAS unsigned char* yimg1 = L + MISC_OFF + 8192;
#define CB_ISSUE(cc) do { const unsigned char* s_ = base + (size_t)(cc) * CK * 768 + (size_t)lw * 1024 + lane * 16; LAS unsigned char* d_ = L + ((cc) % 3) * CKB + lw * 1024; \
        _Pragma("unroll") for (int r_ = 0; r_ < 10; ++r_) __builtin_amdgcn_global_load_lds((const unsigned*)(s_ + r_ * 4096), (LAS unsigned*)(d_ + r_ * 4096), 16, 0, 0); } while (0)
#define CB_YOUT(cc) do { const LAS unsigned char* im_ = ((cc) & 1) ? yimg1 : yimg0; \
        _Pragma("unroll") for (int r_ = 0; r_ < 8; ++r_) { const int t_ = r_ * 8 + (lane >> 3), l_ = (cc) * CK + t_; const u32x4 v_ = *(const LAS u32x4*)(im_ + t_ * 128 + (lane & 7) * 16); \
            if (l_ < LTOK) *(u32x4*)(y0 + (size_t)(b * T + PADR + l_) * RW_W + h * 64 + (lane & 7) * 8) = v_; } } while (0)
    if (isld) { CB_ISSUE(0); CB_ISSUE(1); asm volatile("s_waitcnt vmcnt(10)" ::: "memory"); }
    asm volatile("s_waitcnt lgkmcnt(0)\n\ts_barrier" ::: "memory");
    f32x16 Z0 = f32x16{}, Z1 = f32x16{};
    for (int c = 0; c < NCK; ++c) {
        if (isld) {
            if (wave == 6 && c > 0) CB_YOUT(c - 1);
            if (c + 2 < NCK) CB_ISSUE(c + 2);
            if (c + 2 < NCK) asm volatile("s_waitcnt vmcnt(10)" ::: "memory"); else asm volatile("s_waitcnt vmcnt(0)" ::: "memory");
        } else if (wave < 2) {
            const LAS unsigned char* S = L + (c % 3) * CKB;
            LAS unsigned char* yim = (c & 1) ? yimg1 : yimg0;
            const int vb = wave;
            bf16x8 zf[2][2];
#pragma unroll
            for (int ks = 0; ks < 2; ++ks) {
                zf[0][ks] = __builtin_bit_cast(bf16x8, (u32x4){pk2(Z0[8 * ks], Z0[8 * ks + 1]), pk2(Z0[8 * ks + 2], Z0[8 * ks + 3]), pk2(Z0[8 * ks + 4], Z0[8 * ks + 5]), pk2(Z0[8 * ks + 6], Z0[8 * ks + 7])});
                zf[1][ks] = __builtin_bit_cast(bf16x8, (u32x4){pk2(Z1[8 * ks], Z1[8 * ks + 1]), pk2(Z1[8 * ks + 2], Z1[8 * ks + 3]), pk2(Z1[8 * ks + 4], Z1[8 * ks + 5]), pk2(Z1[8 * ks + 6], Z1[8 * ks + 7])});
            }
#pragma unroll
            for (int tb = 0; tb < 2; ++tb) {
                f32x16 acc;
                const LAS unsigned char* yt = S + 32768 + (vb * 2 + tb) * 2048 + lane * 8;
#pragma unroll
                for (int g = 0; g < 4; ++g) { const u32x2 w = *(const LAS u32x2*)(yt + g * 512); acc[4 * g] = bf_lo(w.x); acc[4 * g + 1] = bf_hi(w.x); acc[4 * g + 2] = bf_lo(w.y); acc[4 * g + 3] = bf_hi(w.y); }
#pragma unroll
                for (int kb2 = 0; kb2 < 2; ++kb2)
#pragma unroll
                    for (int ks = 0; ks < 2; ++ks) { const bf16x8 pa = *(const LAS bf16x8*)(S + 8192 + ((tb * 2 + kb2) * 2 + ks) * 1024 + lane * 16);
                        acc = __builtin_amdgcn_mfma_f32_32x32x16_bf16(pa, zf[kb2][ks], acc, 0, 0, 0); }
#pragma unroll
                for (int i = 0; i < 16; ++i) *(LAS unsigned short*)(yim + (tb * 32 + crow(i, hi)) * 128 + (vb * 32 + r32) * 2) = f2bf(acc[i]);
            }
            f32x16 N0, N1;
            { const LAS unsigned char* n0 = S + 16384 + (vb * 2 + 0) * 4096 + lane * 16; const LAS unsigned char* n1 = S + 16384 + (vb * 2 + 1) * 4096 + lane * 16;
#pragma unroll
              for (int g = 0; g < 4; ++g) { const f32x4 u0 = *(const LAS f32x4*)(n0 + g * 1024), u1 = *(const LAS f32x4*)(n1 + g * 1024);
                  N0[4 * g] = u0.x; N0[4 * g + 1] = u0.y; N0[4 * g + 2] = u0.z; N0[4 * g + 3] = u0.w; N1[4 * g] = u1.x; N1[4 * g + 1] = u1.y; N1[4 * g + 2] = u1.z; N1[4 * g + 3] = u1.w; } }
#pragma unroll
            for (int kb2 = 0; kb2 < 2; ++kb2)
#pragma unroll
                for (int ks = 0; ks < 2; ++ks) {
                    const bf16x8 m0 = *(const LAS bf16x8*)(S + ((0 * 2 + kb2) * 2 + ks) * 1024 + lane * 16);
                    const bf16x8 m1 = *(const LAS bf16x8*)(S + ((1 * 2 + kb2) * 2 + ks) * 1024 + lane * 16);
                    N0 = __builtin_amdgcn_mfma_f32_32x32x16_bf16(m0, zf[kb2][ks], N0, 0, 0, 0);
                    N1 = __builtin_amdgcn_mfma_f32_32x32x16_bf16(m1, zf[kb2][ks], N1, 0, 0, 0);
                }
            Z0 = N0; Z1 = N1;
        }
        asm volatile("s_waitcnt lgkmcnt(0)\n\ts_barrier" ::: "memory");
    }
    if (wave == 6) CB_YOUT(NCK - 1);
    asm volatile("s_waitcnt vmcnt(0) lgkmcnt(0)\n\ts_barrier" ::: "memory");
#undef CB_ISSUE
#undef CB_YOUT
}

constexpr int N_FX_UNITS = 65 * 10, N_SB_UNITS = 65 * 10, N_RW_WG = 192;
#ifndef REP_SCAN
#define REP_SCAN 1
#endif
#ifndef REP_SCAN_DRY
#define REP_SCAN_DRY 0
#endif
#ifndef REP_FOX
#define REP_FOX 1
#endif
#ifndef REP_SB
#define REP_SB 1
#endif
__device__ __forceinline__ void phase_mix(const ArgsL& a, Frame& F, int layer) {
#ifdef SEQ_SCAN
    if (F.bx < N_RW_WG) { int nr = REP_SCAN; asm volatile("" : "+s"(nr)); for (int r = 0; r < nr; ++r) rwkv_scan(a, F, F.bx, (r + 1 < nr) ? REP_SCAN_DRY : 0); }
#else
#ifndef REP_CHB
#define REP_CHB 1
#endif
    if (F.bx < 12) { int nr = REP_CHB; asm volatile("" : "+s"(nr)); for (int r = 0; r < nr; ++r) rwkv_chunkB(a, F, F.bx); }
#endif
    float gqm = fabsf(a.in(I_QG)[layer * 64 + F.lane]), gkm = fabsf(a.in(I_KG)[layer * 64 + F.lane]);
#pragma unroll
    for (int off = 1; off < 64; off <<= 1) { gqm = fmaxf(gqm, __shfl_xor(gqm, off)); gkm = fmaxf(gkm, __shfl_xor(gkm, off)); }
    const float bound = 64.0f * C2 * gqm * gkm * 1.02f + 0.5f;
    unsigned* head = (unsigned*)(a.ws + WS_CTL) + CW_QUEUE + 64 * layer;
    for (;;) {
        if (F.tid == 0) F.MISC[16] = __hip_atomic_fetch_add(head, 1u, __ATOMIC_RELAXED, __HIP_MEMORY_SCOPE_AGENT);
        __syncthreads();
        const int u = (int)F.MISC[16];
        __syncthreads();
        if (u >= N_FX_UNITS + N_SB_UNITS) break;
        if (u < N_FX_UNITS) { const int qb = 64 - u / 10, bh = u % 10; int nr = REP_FOX; asm volatile("" : "+s"(nr)); for (int r = 0; r < nr; ++r) attn_unit<0>(a, F, bh / FX_H, bh % FX_H, qb, bound); }
        else { const int v = u - N_FX_UNITS; const int qb = 64 - v / 10, bh = v % 10; int nr = REP_SB; asm volatile("" : "+s"(nr)); for (int r = 0; r < nr; ++r) attn_unit<1>(a, F, bh / SB_H, bh % SB_H, qb, bound); }
    }
}

__device__ __forceinline__ void phase_post(const ArgsL& a, Frame& F, int layer, const bool dry = false) {
    const int gw = F.bx * NWAVES + F.wave, NGW = gridDim.x * NWAVES, lane = F.lane;
    bf16_t* Y0 = (bf16_t*)(a.ws + WS_YCAT); const bf16_t* BN = (const bf16_t*)(a.ws + WS_BN);
    float lg[6], lb[6];
    { const float* g = a.in(I_LNG) + layer * RW_W + lane; const float* bb = a.in(I_LNB) + layer * RW_W + lane;
#pragma unroll
      for (int hh = 0; hh < 6; ++hh) { lg[hh] = g[hh * 64]; lb[hh] = bb[hh * 64]; } }
    unsigned short yv[6], bv[6], yn[6], bn[6];
    int m = gw;
    if (m < M) {
#pragma unroll
        for (int hh = 0; hh < 6; ++hh) { yv[hh] = Y0[(size_t)m * RW_W + hh * 64 + lane]; bv[hh] = BN[(size_t)m * RW_W + hh * 64 + lane]; }
    }
    for (; m < M; m += NGW) {
        const int mn = m + NGW;
        if (mn < M) {
#pragma unroll
            for (int hh = 0; hh < 6; ++hh) { yn[hh] = Y0[(size_t)mn * RW_W + hh * 64 + lane]; bn[hh] = BN[(size_t)mn * RW_W + hh * 64 + lane]; }
        }
        const int b = m / T, p = m - b * T;
        bf16_t* yp = Y0 + (size_t)m * RW_W + lane;
        if (p < PADR) {
            if (!dry) {
#pragma unroll
            for (int hh = 0; hh < 6; ++hh) yp[hh * 64] = 0; }
        } else {
#pragma unroll
            for (int hh = 0; hh < 6; ++hh) {
                const float y = bf2f(yv[hh]);
                const float mean = wave_sum(y) * (1.f / 64.f);
                const float d = y - mean;
                const float var = wave_sum(d * d) * (1.f / 64.f);
                const unsigned short r_ = f2bf(d * (1.0f / sqrtf(var + 64e-5f)) * lg[hh] + lb[hh] + bf2f(bv[hh])); if (!dry) yp[hh * 64] = r_; else asm volatile("" :: "v"(r_));
            }
        }
#pragma unroll
        for (int hh = 0; hh < 6; ++hh) { yv[hh] = yn[hh]; bv[hh] = bn[hh]; }
    }
    if (!dry) for (int it = gw; it < 2 * M; it += NGW) {
        const int sl = it / M, m2 = it - sl * M; const int b = m2 / T, p = m2 - b * T;
        bf16_t* row = Y0 + (size_t)(sl + 1) * M * RW_W + (size_t)m2 * RW_W;
        if (p < PADR) { for (int c = lane; c < RW_W / 2; c += 64) ((unsigned*)row)[c] = 0u; }
        else if (lane < 32) ((unsigned*)(row + 320))[lane] = 0u;
    }
}

struct EpiInproj { static constexpr bool PERM = true, AFTER_DRAIN = false; bf16_t* ush; bf16_t* qkv;
    __device__ __forceinline__ void operator()(const f32x4 (&acc)[2][2][4][2], const pg8::Unit& u, int wr, int wc, int fr, int fq) const {
        asm volatile("" : "+v"(fr), "+v"(fq));
        const int row0 = u.pm * 256 + wr * 64 + fr, colt = u.pn * 256 + wc * 32 + 8 * fq;
#pragma unroll
        for (int ai = 0; ai < 2; ++ai)
#pragma unroll
            for (int m = 0; m < 4; ++m) { const size_t row = (size_t)(row0 + ai * 128 + m * 16);
#pragma unroll
                for (int bj = 0; bj < 2; ++bj) { const int col = colt + bj * 128; const f32x4 v0 = acc[ai][bj][m][0], v1 = acc[ai][bj][m][1];
                    const float sc = (col >= SHIFT_W && col < SHIFT_W + 320) ? C2 : 1.0f;
                    u32x4 w; w.x = pk2(v0[0] * sc, v0[1] * sc); w.y = pk2(v0[2] * sc, v0[3] * sc); w.z = pk2(v1[0] * sc, v1[1] * sc); w.w = pk2(v1[2] * sc, v1[3] * sc);
                    if (col < SHIFT_W) *(u32x4*)(ush + row * SHIFT_W + col) = w;
                    else if (col < SHIFT_W + QKV_W) *(u32x4*)(qkv + row * QKV_W + (col - SHIFT_W)) = w; } }
    }
};
struct EpiGates { static constexpr bool PERM = true, AFTER_DRAIN = false; bf16_t* gates;
    __device__ __forceinline__ void operator()(const f32x4 (&acc)[2][2][4][2], const pg8::Unit& u, int wr, int wc, int fr, int fq) const {
        asm volatile("" : "+v"(fr), "+v"(fq));
        const int row0 = u.pm * 256 + wr * 64 + fr, colt = u.pn * 256 + wc * 32 + 8 * fq;
#pragma unroll
        for (int ai = 0; ai < 2; ++ai)
#pragma unroll
            for (int m = 0; m < 4; ++m) { const size_t row = (size_t)(row0 + ai * 128 + m * 16);
#pragma unroll
                for (int bj = 0; bj < 2; ++bj) { const int col = colt + bj * 128; f32x4 v0 = acc[ai][bj][m][0], v1 = acc[ai][bj][m][1];
#pragma unroll
                    for (int q = 0; q < 4; ++q) { v0[q] = __builtin_amdgcn_rcpf(1.f + __builtin_amdgcn_exp2f(-v0[q] * LOG2E)); v1[q] = __builtin_amdgcn_rcpf(1.f + __builtin_amdgcn_exp2f(-v1[q] * LOG2E)); }
                    u32x4 w; w.x = pk2(v0[0], v0[1]); w.y = pk2(v0[2], v0[3]); w.z = pk2(v1[0], v1[1]); w.w = pk2(v1[2], v1[3]);
                    *(u32x4*)(gates + row * 3072 + col) = w; } }
    }
};
struct EpiMerge { static constexpr bool PERM = true, AFTER_DRAIN = false; const bf16_t* gates; bf16_t* merged;
    __device__ __forceinline__ void operator()(const f32x4 (&acc)[2][2][4][2], const pg8::Unit& u, int wr, int wc, int fr, int fq) const {
        asm volatile("" : "+v"(fr), "+v"(fq));
        const int br = u.pn >> 2, pn = u.pn & 3, pm = u.pm - br * 129;
        const int row0 = pm * 256 + wr * 64 + fr, colt = pn * 256 + wc * 32 + 8 * fq;
        u32x4 gn[2], on[2];
#define MRG_LOAD(q) do { const size_t row_ = (size_t)(row0 + ((q) >> 2) * 128 + ((q) & 3) * 16); \
            _Pragma("unroll") for (int bj = 0; bj < 2; ++bj) { const int col_ = colt + bj * 128; gn[bj] = *(const u32x4*)(gates + row_ * 3072 + br * 1024 + col_); \
                on[bj] = (u32x4){0u, 0u, 0u, 0u}; if (br > 0) on[bj] = *(const u32x4*)(merged + row_ * D + col_); } } while (0)
        MRG_LOAD(0);
#pragma unroll
        for (int q = 0; q < 8; ++q) {
            const int ai = q >> 2, m = q & 3; const size_t row = (size_t)(row0 + ai * 128 + m * 16);
            u32x4 g[2], o[2];
#pragma unroll
            for (int bj = 0; bj < 2; ++bj) { g[bj] = gn[bj]; o[bj] = on[bj]; }
            if (q < 7) MRG_LOAD(q + 1);
#pragma unroll
            for (int bj = 0; bj < 2; ++bj) { const int col = colt + bj * 128; const f32x4 v0 = acc[ai][bj][m][0], v1 = acc[ai][bj][m][1];
                u32x4 w;
                w.x = pk2(bf_lo(g[bj].x) * v0[0] + bf_lo(o[bj].x), bf_hi(g[bj].x) * v0[1] + bf_hi(o[bj].x));
                w.y = pk2(bf_lo(g[bj].y) * v0[2] + bf_lo(o[bj].y), bf_hi(g[bj].y) * v0[3] + bf_hi(o[bj].y));
                w.z = pk2(bf_lo(g[bj].z) * v1[0] + bf_lo(o[bj].z), bf_hi(g[bj].z) * v1[1] + bf_hi(o[bj].z));
                w.w = pk2(bf_lo(g[bj].w) * v1[2] + bf_lo(o[bj].w), bf_hi(g[bj].w) * v1[3] + bf_hi(o[bj].w));
                *(u32x4*)(merged + row * D + col) = w; }
            __builtin_amdgcn_sched_barrier(0);
        }
#undef MRG_LOAD
    }
};
struct MergeOrder { int G, c, ntau;
    __device__ __forceinline__ bool next(int i, pg8::Unit& u) const { const int it = i / 3, br = i - 3 * it; const long tau = (long)it * G + c; if (tau >= ntau) return false;
        const int t = (int)(tau % 516); u.pm = br * 129 + (t >> 2); u.pn = br * 4 + (t & 3); return true; }
    __device__ __forceinline__ void a_ready(const pg8::Unit&) const {}
    __device__ __forceinline__ void done(const pg8::Unit&) const {}
};
struct EpiOut { static constexpr bool PERM = true, AFTER_DRAIN = false; bf16_t* hb;
    __device__ __forceinline__ void operator()(const f32x4 (&acc)[2][2][4][2], const pg8::Unit& u, int wr, int wc, int fr, int fq) const {
        asm volatile("" : "+v"(fr), "+v"(fq));
        const int row0 = u.pm * 256 + wr * 64 + fr, colt = u.pn * 256 + wc * 32 + 8 * fq;
        u32x4 hn[2];
#define OUT_LOAD(q) do { const bf16_t* p_ = hb + (size_t)(row0 + ((q) >> 2) * 128 + ((q) & 3) * 16) * D + colt; hn[0] = *(const u32x4*)(p_); hn[1] = *(const u32x4*)(p_ + 128); } while (0)
        OUT_LOAD(0);
#pragma unroll
        for (int q = 0; q < 8; ++q) {
            const int ai = q >> 2, m = q & 3;
            bf16_t* hp = hb + (size_t)(row0 + ai * 128 + m * 16) * D + colt; const u32x4 h0 = hn[0], h1 = hn[1];
            if (q < 7) OUT_LOAD(q + 1);
#pragma unroll
            for (int bj = 0; bj < 2; ++bj) { const u32x4 hh = bj ? h1 : h0; const f32x4 v0 = acc[ai][bj][m][0], v1 = acc[ai][bj][m][1];
                u32x4 w; w.x = pk2(bf_lo(hh.x) + v0[0], bf_hi(hh.x) + v0[1]); w.y = pk2(bf_lo(hh.y) + v0[2], bf_hi(hh.y) + v0[3]);
                w.z = pk2(bf_lo(hh.z) + v1[0], bf_hi(hh.z) + v1[1]); w.w = pk2(bf_lo(hh.w) + v1[2], bf_hi(hh.w) + v1[3]);
                *(u32x4*)(hp + bj * 128) = w; }
            __builtin_amdgcn_sched_barrier(0);
        }
#undef OUT_LOAD
    }
};
struct MoeOrder { const volatile LAS int* tb; int ntile, npt, G, c, rep;
    __device__ __forceinline__ bool next(int i, pg8::Unit& u) const { long L = (long)i * G + c; if (L >= (long)ntile * npt * rep) return false; L %= (long)ntile * npt;
        const int tau = (int)(L / npt), j = (int)(L - (long)tau * npt); int e = 0;
#pragma unroll
        for (int k = 1; k < 16; ++k) e += (tau >= tb[k]) ? 1 : 0;
        u.pm = tau; u.pn = __builtin_amdgcn_readfirstlane(e) * npt + j; return true; }
    __device__ __forceinline__ void a_ready(const pg8::Unit&) const {}
    __device__ __forceinline__ void done(const pg8::Unit&) const {}
};
struct EpiMoeUp { static constexpr bool PERM = true, AFTER_DRAIN = false; bf16_t* hs;
    __device__ __forceinline__ void operator()(const f32x4 (&acc)[2][2][4][2], const pg8::Unit& u, int wr, int wc, int fr, int fq) const {
        asm volatile("" : "+v"(fr), "+v"(fq));
        const int row0 = u.pm * 256 + wr * 64 + fr, col = (u.pn & 1) * 128 + wc * 32 + 8 * fq;
#pragma unroll
        for (int ai = 0; ai < 2; ++ai)
#pragma unroll
            for (int m = 0; m < 4; ++m) { const size_t row = (size_t)(row0 + ai * 128 + m * 16); float r[8];
#pragma unroll
                for (int n = 0; n < 2; ++n)
#pragma unroll
                    for (int q = 0; q < 4; ++q) { const float gte = acc[ai][0][m][n][q], up = acc[ai][1][m][n][q]; r[4 * n + q] = gte * __builtin_amdgcn_rcpf(1.f + __builtin_amdgcn_exp2f(-gte * LOG2E)) * up; }
                u32x4 w; w.x = pk2(r[0], r[1]); w.y = pk2(r[2], r[3]); w.z = pk2(r[4], r[5]); w.w = pk2(r[6], r[7]);
                *(u32x4*)(hs + row * DEXP + col) = w; }
    }
};
struct EpiMoeDown { static constexpr bool PERM = true, AFTER_DRAIN = false; bf16_t* y; const float* cws;
    __device__ __forceinline__ void operator()(const f32x4 (&acc)[2][2][4][2], const pg8::Unit& u, int wr, int wc, int fr, int fq) const {
        asm volatile("" : "+v"(fr), "+v"(fq));
        const int row0 = u.pm * 256 + wr * 64 + fr, colt = (u.pn & 3) * 256 + wc * 32 + 8 * fq;
        float cw[8];
#pragma unroll
        for (int q = 0; q < 8; ++q) cw[q] = cws[row0 + (q >> 2) * 128 + (q & 3) * 16];
#pragma unroll
        for (int ai = 0; ai < 2; ++ai)
#pragma unroll
            for (int m = 0; m < 4; ++m) { const size_t row = (size_t)(row0 + ai * 128 + m * 16); const float cwv = cw[ai * 4 + m];
#pragma unroll
                for (int bj = 0; bj < 2; ++bj) { const int col = colt + bj * 128; const f32x4 v0 = acc[ai][bj][m][0] * cwv, v1 = acc[ai][bj][m][1] * cwv;
                    u32x4 w; w.x = pk2(v0[0], v0[1]); w.y = pk2(v0[2], v0[3]); w.z = pk2(v1[0], v1[1]); w.w = pk2(v1[2], v1[3]);
                    *(u32x4*)(y + row * D + col) = w; } }
    }
};


#ifndef PH_MASK
#define PH_MASK 0xFFFF
#endif
#define PH(k) ((PH_MASK >> (k)) & 1)
#ifndef PROBE_DUP
#define PROBE_DUP 0
#endif
#define DUPN(bit) (((PROBE_DUP >> (bit)) & 1) ? 2 : 1)
#ifndef PROBE_THIN
#define PROBE_THIN 0
#endif
#define THIN(bit) ((PROBE_THIN >> (bit)) & 1)
#define FRESH() do { asm volatile("" : "+v"(F.tid)); F.lane = F.tid & 63; F.wave = __builtin_amdgcn_readfirstlane(F.tid >> 6); { int bx_ = (int)blockIdx.x; asm volatile("" : "+s"(bx_)); F.bx = bx_; } { unsigned char* w_ = a.ws; asm volatile("" : "+s"(w_)); a.ws = w_; } } while (0)
__global__ void __launch_bounds__(NTHR, 2) hybrid_fwd(Args ka) {
    extern __shared__ __attribute__((aligned(16))) unsigned char lds_raw[];
    Frame F;
    F.lds = (LAS unsigned char*)lds_raw;
    F.MISC = (volatile LAS unsigned*)(F.lds + MISC_OFF);
    F.tid = threadIdx.x; F.lane = F.tid & 63; F.wave = __builtin_amdgcn_readfirstlane(F.tid >> 6); F.bx = (int)blockIdx.x;
    for (int u = F.tid; u < (LDS_BYTES - MISC_OFF) / 4; u += NTHR) ((LAS unsigned*)(F.lds + MISC_OFF))[u] = 0u;
    __syncthreads();
    if (F.tid < 29) { const unsigned long long p = (unsigned long long)ka.in[F.tid]; F.MISC[64 + 2 * F.tid] = (unsigned)p; F.MISC[65 + 2 * F.tid] = (unsigned)(p >> 32); }
    __syncthreads();
    ArgsL a; a.tab = F.MISC + 64; a.out = ka.out; a.ws = ka.ws;
    XcdBarrier bar = xcd_barrier_post((unsigned*)(a.ws + WS_CTL) + CW_BAR, F.MISC + 8);
    const int G = (int)gridDim.x, c = (int)blockIdx.x;
    PG8_LAS unsigned char* ring = (PG8_LAS unsigned char*)F.lds;

#ifdef PROF_K
    volatile LAS unsigned* tsl = F.MISC + 1536; int nts = 0;
    if (blockIdx.x == 0 && F.tid == 0) tsl[nts] = (unsigned)__builtin_amdgcn_s_memrealtime();
    ++nts;
#define BARX() do { xcd_barrier(bar); if (blockIdx.x == 0 && F.tid == 0) tsl[nts] = (unsigned)__builtin_amdgcn_s_memrealtime(); ++nts; } while (0)
#else
#define BARX() xcd_barrier(bar)
#endif
    for (int layer = 0; layer < DEPTH; ++layer) {
        for (int rep = 0; rep < DUPN(8); ++rep) { FRESH(); if (PH(0)) phase_wconv(a, F, layer); }
        __syncthreads();
        if (THIN(0)) { FRESH(); phase_norm<1>(a, F, layer, true); }
        FRESH(); if (PH(1)) phase_norm<1>(a, F, layer);
        BARX();
        FRESH(); if (PH(2)) {
            pg8::Gemm g{(const bf16_t*)A_PTR(a), (const bf16_t*)(a.ws + WS_WIN), M, N1, D}; pg8::StaticOrder S; S.init(M, N1, G, c, DUPN(3));
            EpiInproj E{(bf16_t*)(a.ws + WS_USH), (bf16_t*)(a.ws + WS_QKV)};
            pg8::gemm_phase<EpiInproj, pg8::StaticOrder, true, true>(ring, g, S, E);
        }
        BARX();
        if (THIN(1)) { FRESH(); phase_prep(a, F, layer, true); }
        FRESH(); if (PH(3)) phase_prep(a, F, layer);
        BARX();
#ifndef SEQ_SCAN
        if (THIN(2)) { FRESH(); phase_chunkA(a, F, true); }
        FRESH(); if (PH(4)) phase_chunkA(a, F);
        BARX();
#endif
        FRESH(); if (PH(4)) phase_mix(a, F, layer);
        BARX();
        if (THIN(3)) { FRESH(); phase_post(a, F, layer, true); }
        FRESH(); if (PH(5)) phase_post(a, F, layer);
        FRESH(); if (PH(6)) {
            pg8::Gemm g{(const bf16_t*)A_PTR(a), (const bf16_t*)(a.ws + WS_WG), M, 3072, D}; pg8::StaticOrder S; S.init(M, 3072, G, c, DUPN(4));
            EpiGates E{(bf16_t*)(a.ws + WS_GATES)};
            pg8::gemm_phase<EpiGates, pg8::StaticOrder, true, true>(ring, g, S, E);
        }
        BARX();
        FRESH(); if (PH(7)) {
            int kdim = RW_W; asm volatile("" : "+s"(kdim));
            pg8::Gemm g{(const bf16_t*)(a.ws + WS_YCAT), (const bf16_t*)(a.ws + WS_WP), 3 * M, 3072, kdim}; MergeOrder S{G, c, 516 * DUPN(5)};
            EpiMerge E{(const bf16_t*)(a.ws + WS_GATES), (bf16_t*)(a.ws + WS_MERGED)};
            pg8::gemm_phase<EpiMerge, MergeOrder, false, true>(ring, g, S, E);
        }
        BARX();
        FRESH(); if (PH(8)) {
            pg8::Gemm g{(const bf16_t*)(a.ws + WS_MERGED), (const bf16_t*)(a.ws + WS_WO), M, D, D}; pg8::StaticOrder S; S.init(M, D, G, c, 1);
            EpiOut E{HB_PTR(a)};
            pg8::gemm_phase<EpiOut, pg8::StaticOrder, true, true>(ring, g, S, E);
        }
        BARX();
        if (THIN(4)) { FRESH(); phase_norm<2>(a, F, layer, true); }
        FRESH(); if (PH(9)) phase_norm<2>(a, F, layer);
        BARX();
        for (int rep = 0; rep < DUPN(7); ++rep) { FRESH(); if (PH(10)) phase_route(a, F, layer); }
        BARX();
        volatile LAS int* tb = (volatile LAS int*)(F.MISC + 32);
        if (F.tid <= 16) { const int* cnt = (const int*)(a.ws + WS_CTL) + CW_ECNT + 64 * layer; int t = 0;
            for (int e = 0; e < F.tid; ++e) t += (__hip_atomic_load(cnt + e, __ATOMIC_RELAXED, __HIP_MEMORY_SCOPE_AGENT) + 255) >> 8;
            tb[F.tid] = t; }
        __syncthreads();
        const int ntile = tb[16];
        FRESH(); if (PH(11)) {
            pg8::Gemm g{(const bf16_t*)(a.ws + WS_AS), (const bf16_t*)(a.ws + WS_WGU), MS, 8192, D}; MoeOrder S{tb, ntile, 2, G, c, DUPN(6)};
            EpiMoeUp E{(bf16_t*)(a.ws + WS_HS)};
            pg8::gemm_phase<EpiMoeUp, MoeOrder, true, true>(ring, g, S, E);
        }
        BARX();
        FRESH(); if (PH(12)) {
            int kdim = DEXP; asm volatile("" : "+s"(kdim));
            pg8::Gemm g{(const bf16_t*)(a.ws + WS_HS), (const bf16_t*)(a.ws + WS_WD), MS, 16384, kdim}; MoeOrder S{tb, ntile, 4, G, c, DUPN(6)};
            EpiMoeDown E{(bf16_t*)(a.ws + WS_Y), (const float*)(a.ws + WS_CWS)};
            pg8::gemm_phase<EpiMoeDown, MoeOrder, true, true>(ring, g, S, E);
        }
        BARX();
    }
    if (THIN(5)) { FRESH(); phase_norm<0>(a, F, DEPTH - 1, true); }
    FRESH(); if (PH(13)) phase_norm<0>(a, F, DEPTH - 1);
#ifdef PROF_K
    BARX();
    if (blockIdx.x == 0) {
        __syncthreads();
        float us;
        if (PROF_K < 0) us = 100.f;
        else if (PROF_K == 12) us = (float)(tsl[25] - tsl[24]) * 0.01f;
        else if (PROF_K == 13) us = (float)(tsl[25] - tsl[0]) * 0.01f;
        else us = ((float)(tsl[1 + PROF_K] - tsl[PROF_K]) + (float)(tsl[13 + PROF_K] - tsl[12 + PROF_K])) * 0.01f;
        us = 4.f * rintf(us * 0.25f);
        for (int i = F.tid; i < 16384; i += NTHR) a.out[i] = us;
    }
#endif
#ifdef CLOCK_PROBE
    if (blockIdx.x == 0 && F.wave == 0) {
        float c0 = 1.f, c1 = 2.f, c2 = 3.f, c3 = 4.f, c4 = 5.f, c5 = 6.f, c6 = 7.f, c7 = 8.f;
        for (int i = 0; i < CLOCK_PROBE; ++i) {
            asm volatile("v_fma_f32 %0, %0, %0, %0\n\tv_fma_f32 %1, %1, %1, %1\n\tv_fma_f32 %2, %2, %2, %2\n\tv_fma_f32 %3, %3, %3, %3\n\tv_fma_f32 %4, %4, %4, %4\n\tv_fma_f32 %5, %5, %5, %5\n\tv_fma_f32 %6, %6, %6, %6\n\tv_fma_f32 %7, %7, %7, %7"
                         : "+v"(c0), "+v"(c1), "+v"(c2), "+v"(c3), "+v"(c4), "+v"(c5), "+v"(c6), "+v"(c7));
        }
        asm volatile("" :: "v"(c0), "v"(c1), "v"(c2), "v"(c3), "v"(c4), "v"(c5), "v"(c6), "v"(c7));
    }
#endif
}

extern "C" void kernel_launch(void* const* d_in, const int* in_sizes, int n_in, void* d_out, int out_size, void* d_ws, size_t ws_size, hipStream_t stream) {
    static int ready = 0;
    if (ready == 0) {
        if (n_in != 29 || out_size != NB * SEQ * D || ws_size < WS_END) { fprintf(stderr, "kernel_launch: unexpected problem shape (n_in %d, out %d, ws %zu < %zu)\n", n_in, out_size, ws_size, (size_t)WS_END); ready = -1; return; }
        if (hipFuncSetAttribute((const void*)hybrid_fwd, hipFuncAttributeMaxDynamicSharedMemorySize, LDS_BYTES) != hipSuccess) { fprintf(stderr, "kernel_launch: hipFuncSetAttribute failed\n"); ready = -1; return; }
        int per_cu = 0;
        if (hipOccupancyMaxActiveBlocksPerMultiprocessor(&per_cu, (const void*)hybrid_fwd, NTHR, LDS_BYTES) != hipSuccess || per_cu < 1) fprintf(stderr, "kernel_launch: occupancy query says %d\n", per_cu);
        (void)hipGetLastError();
        ready = 1;
    }
    if (ready < 0) return;
    (void)in_sizes;
    if (hipMemsetAsync((char*)d_ws + WS_CTL, 0, CTL_ZERO_BYTES, stream) != hipSuccess) return;
    Args a{};
    for (int i = 0; i < 29; ++i) a.in[i] = (const float*)d_in[i];
    a.out = (float*)d_out; a.ws = (unsigned char*)d_ws;
    hipLaunchKernelGGL(hybrid_fwd, dim3(256), dim3(NTHR), LDS_BYTES, stream, a);
}
```

```cpp
#include <hip/hip_runtime.h>
#include <hip/hip_bf16.h>
#include <cstdio>
#include <cstdint>

#define GAS __attribute__((address_space(1)))
#define LAS __attribute__((address_space(3)))

namespace pg8 {
#define PG8_LAS __attribute__((address_space(3)))
typedef unsigned short bf16_t;
typedef short bf16x8 __attribute__((ext_vector_type(8)));
typedef float f32x4 __attribute__((ext_vector_type(4)));
typedef unsigned u32x4 __attribute__((ext_vector_type(4)));
constexpr int BM = 256, BK = 64, HALF = 128, HTB = HALF * BK * 2  , STAGE_BYTES = 8 * HTB, NXCD = 8, WGM = 8;

__host__ __device__ __forceinline__ int lds_byte(int r, int c) { const int st = (r >> 4) * 2 + (c >> 5), rr = r & 15, cc = c & 31, ob = rr * 64 + cc * 2; return st * 1024 + (ob ^ (((ob >> 9) & 1) << 5)); }
__host__ __device__ __forceinline__ void stage_rc(int b, int& R, int& C) { const int st = b / 1024, sb = b % 1024, swz = sb ^ (((sb >> 9) & 1) << 5); R = (st >> 1) * 16 + swz / 64; C = (st & 1) * 32 + (swz % 64) / 2; }
__host__ __device__ __forceinline__ int perm32(int rho) { const int n = rho >> 4, i = rho & 15; return 8 * (i >> 2) + 4 * n + (i & 3); }

struct Unit { int pm, pn; };
struct Gemm { const bf16_t* A; const bf16_t* Bt; int M, N, K; };

struct StaticOrder {
    int nM, nN, nwg, G, c, rep;
    __host__ __device__ void init(int M, int N, int G_, int c_, int rep_ = 1) { nM = M / BM; nN = N / BM; nwg = nM * nN; G = G_; c = c_; rep = rep_; }
    __host__ __device__ bool next(int i, Unit& u) const {
        const long L = (long)i * G + c; if (L >= (long)nwg * rep) return false;
        int wgid = (int)(L % nwg); { const int q = nwg / NXCD, r = nwg % NXCD, xcd = wgid % NXCD, off = wgid / NXCD; wgid = (xcd < r ? xcd * (q + 1) : r * (q + 1) + (xcd - r) * q) + off; }
        const int nig = WGM * nN, gid = wgid / nig, fm = gid * WGM, gsz = (nM - fm) < WGM ? (nM - fm) : WGM;
        u.pm = fm + ((wgid % nig) % gsz); u.pn = (wgid % nig) / gsz; return true;
    }
    __device__ __forceinline__ void a_ready(const Unit&) const {}
    __device__ __forceinline__ void done(const Unit&) const {}
};
__device__ __forceinline__ unsigned cvt_pk_bf16(float lo, float hi) { unsigned r; asm volatile("v_cvt_pk_bf16_f32 %0, %1, %2" : "=v"(r) : "v"(lo), "v"(hi)); return r; }
template <class Epi, class Sched, bool ALIGN_EPI = false, bool SP2 = false>
__device__ __forceinline__ void gemm_phase(PG8_LAS unsigned char* lds, const Gemm g, const Sched& S, const Epi& E) {
    int tid_ = threadIdx.x; asm volatile("" : "+v"(tid_));
    const int tid = tid_, wid = __builtin_amdgcn_readfirstlane(tid >> 6), lane = tid & 63, wr = wid >> 2, wc = wid & 3, fr = lane & 15, fq = lane >> 4;
    const int K = g.K, nt = K / BK;
    unsigned voffA[2], voffB[2];
#pragma unroll
    for (int i = 0; i < 2; ++i) { int R, C; stage_rc(tid * 16 + i * 8192, R, C); const int Rb = Epi::PERM ? ((R & ~31) + perm32(R & 31)) : R;
        voffA[i] = (unsigned)(R * K + C) * 2u; voffB[i] = (unsigned)(Rb * K + C) * 2u; }
    const size_t kstep = (size_t)(BK * 2);
    const size_t hstep = (size_t)HALF * K * 2;
    const size_t tstep = 2 * hstep;
    const unsigned ldsw = (unsigned)wid * 1024u;
    const int aoff = lds_byte(wr * 64 + fr, fq * 8), boff = lds_byte(wc * 32 + fr, fq * 8);
#define PG8_SA(b, h) (((b) * 2 + (h)) * HTB)
#define PG8_SB(b, h) ((4 + (b) * 2 + (h)) * HTB)
#define PG8_STAGE(bufoff, gbase, voff) do { _Pragma("unroll") for (int _i = 0; _i < 2; ++_i) \
        __builtin_amdgcn_global_load_lds((const unsigned*)((const char*)(gbase) + (voff)[_i]), (PG8_LAS unsigned*)(lds + (bufoff) + ldsw + _i * 8192), 16, 0, 0); } while (0)
#define PG8_LDA(dst, b, h) do { _Pragma("unroll") for (int m = 0; m < 4; ++m) _Pragma("unroll") for (int k = 0; k < 2; ++k) dst[m][k] = *(const PG8_LAS bf16x8*)(lds + PG8_SA(b, h) + aoff + m * 2048 + k * 1024); } while (0)
#define PG8_LDB(dst, b, h) do { _Pragma("unroll") for (int n = 0; n < 2; ++n) _Pragma("unroll") for (int k = 0; k < 2; ++k) dst[n][k] = *(const PG8_LAS bf16x8*)(lds + PG8_SB(b, h) + boff + n * 2048 + k * 1024); } while (0)
#define PG8_MMA(ai, bj, At, Bt) do { __builtin_amdgcn_s_setprio(1); _Pragma("unroll") for (int m = 0; m < 4; ++m) _Pragma("unroll") for (int n = 0; n < 2; ++n) _Pragma("unroll") for (int k = 0; k < 2; ++k) \
        acc[ai][bj][m][n] = __builtin_amdgcn_mfma_f32_16x16x32_bf16(Bt[n][k], At[m][k], acc[ai][bj][m][n], 0, 0, 0); __builtin_amdgcn_s_setprio(0); } while (0)
#define PG8_WAIT_V(n) asm volatile("s_waitcnt vmcnt(" #n ")" ::: "memory")
#define PG8_WAIT_L(n) asm volatile("s_waitcnt lgkmcnt(" #n ")" ::: "memory")
#define PG8_BAR __builtin_amdgcn_s_barrier()
#define PG8_SCHED __builtin_amdgcn_sched_barrier(0)
    Unit cur, nxt; int ui = 0;
    if (!S.next(0, cur)) return;
    f32x4 acc[2][2][4][2];
#pragma unroll
    for (int a = 0; a < 2; ++a)
#pragma unroll
        for (int b = 0; b < 2; ++b)
#pragma unroll
            for (int m = 0; m < 4; ++m)
#pragma unroll
                for (int n = 0; n < 2; ++n) acc[a][b][m][n] = (f32x4){0.f, 0.f, 0.f, 0.f};
    bf16x8 At[4][2], B0[2][2], B1[2][2];
    const char* cA = (const char*)g.A + (size_t)cur.pm * tstep; const char* cB = (const char*)g.Bt + (size_t)cur.pn * tstep;
    S.a_ready(cur);
    if constexpr (SP2) {
        PG8_STAGE(PG8_SB(0, 0), cB, voffB); PG8_STAGE(PG8_SB(0, 1), cB + hstep, voffB); PG8_STAGE(PG8_SA(0, 0), cA, voffA); PG8_STAGE(PG8_SA(0, 1), cA + hstep, voffA);
        if (wr == 1) PG8_BAR;
        PG8_WAIT_V(2); PG8_BAR;
        PG8_STAGE(PG8_SB(1, 0), cB + kstep, voffB); PG8_STAGE(PG8_SA(1, 0), cA + kstep, voffA); PG8_STAGE(PG8_SB(1, 1), cB + hstep + kstep, voffB);
        PG8_WAIT_V(6); PG8_BAR;
    } else {
        PG8_STAGE(PG8_SB(0, 0), cB, voffB); PG8_STAGE(PG8_SA(0, 0), cA, voffA); PG8_STAGE(PG8_SB(0, 1), cB + hstep, voffB); PG8_STAGE(PG8_SA(0, 1), cA + hstep, voffA);
        if (wr == 1) PG8_BAR;
        PG8_WAIT_V(4); PG8_BAR;
        PG8_STAGE(PG8_SB(1, 0), cB + kstep, voffB); PG8_STAGE(PG8_SA(1, 0), cA + kstep, voffA); PG8_STAGE(PG8_SB(1, 1), cB + hstep + kstep, voffB);
        PG8_WAIT_V(6); PG8_BAR;
    }
    for (;;) {
        const bool has_next = S.next(ui + 1, nxt);
        const char* nA = has_next ? (const char*)g.A + (size_t)nxt.pm * tstep : cA; const char* nB = has_next ? (const char*)g.Bt + (size_t)nxt.pn * tstep : cB;
        for (int t = 0; t < nt; t += 2) {
            const bool last = (t == nt - 2);
            const char* a1 = cA + (size_t)(t + 1) * kstep;
            const char* a2 = last ? nA : cA + (size_t)(t + 2) * kstep; const char* b2 = last ? nB : cB + (size_t)(t + 2) * kstep;
            const char* a3 = a2 + kstep; const char* b3 = b2 + kstep;
            if (last && has_next) S.a_ready(nxt);
            if constexpr (SP2) {
            PG8_LDB(B0, 0, 0); PG8_LDB(B1, 0, 1); PG8_SCHED; PG8_LDA(At, 0, 0); PG8_STAGE(PG8_SA(1, 1), a1 + hstep, voffA);
            PG8_WAIT_V(8); PG8_WAIT_L(0); PG8_BAR; PG8_MMA(0, 0, At, B0); PG8_MMA(0, 1, At, B1); PG8_BAR; PG8_SCHED;
            PG8_LDA(At, 0, 1); PG8_STAGE(PG8_SB(0, 0), b2, voffB); PG8_STAGE(PG8_SB(0, 1), b2 + hstep, voffB); PG8_STAGE(PG8_SA(0, 0), a2, voffA);
            PG8_WAIT_V(8); PG8_WAIT_L(0); PG8_BAR; PG8_MMA(1, 0, At, B0); PG8_MMA(1, 1, At, B1); PG8_BAR; PG8_SCHED;
            PG8_LDB(B0, 1, 0); PG8_LDB(B1, 1, 1); PG8_SCHED; PG8_LDA(At, 1, 0); PG8_STAGE(PG8_SA(0, 1), a2 + hstep, voffA);
            PG8_WAIT_V(8); PG8_WAIT_L(0); PG8_BAR; PG8_MMA(0, 0, At, B0); PG8_MMA(0, 1, At, B1); PG8_BAR; PG8_SCHED;
            PG8_LDA(At, 1, 1); PG8_STAGE(PG8_SB(1, 0), b3, voffB); PG8_STAGE(PG8_SB(1, 1), b3 + hstep, voffB); PG8_STAGE(PG8_SA(1, 0), a3, voffA);
            PG8_WAIT_V(8); PG8_WAIT_L(0); PG8_BAR; PG8_MMA(1, 0, At, B0); PG8_MMA(1, 1, At, B1); PG8_BAR; PG8_SCHED;
            } else {
            PG8_LDB(B0, 0, 0); PG8_SCHED; PG8_LDA(At, 0, 0); PG8_STAGE(PG8_SA(1, 1), a1 + hstep, voffA);
            PG8_WAIT_L(8); PG8_BAR; PG8_WAIT_L(0); PG8_MMA(0, 0, At, B0); PG8_BAR; PG8_SCHED;
            PG8_LDB(B1, 0, 1); PG8_STAGE(PG8_SB(0, 0), b2, voffB);
            PG8_BAR; PG8_WAIT_L(0); PG8_MMA(0, 1, At, B1); PG8_BAR;
            PG8_LDA(At, 0, 1); PG8_STAGE(PG8_SA(0, 0), a2, voffA);
            PG8_BAR; PG8_WAIT_L(0); PG8_MMA(1, 0, At, B0); PG8_BAR; PG8_SCHED;
            PG8_STAGE(PG8_SB(0, 1), b2 + hstep, voffB);
            PG8_WAIT_V(6); PG8_BAR; PG8_MMA(1, 1, At, B1); PG8_BAR;
            PG8_LDB(B0, 1, 0); PG8_SCHED; PG8_LDA(At, 1, 0); PG8_STAGE(PG8_SA(0, 1), a2 + hstep, voffA);
            PG8_WAIT_L(8); PG8_BAR; PG8_WAIT_L(0); PG8_MMA(0, 0, At, B0); PG8_BAR; PG8_SCHED;
            PG8_LDB(B1, 1, 1); PG8_STAGE(PG8_SB(1, 0), b3, voffB);
            PG8_BAR; PG8_WAIT_L(0); PG8_MMA(0, 1, At, B1); PG8_BAR;
            PG8_LDA(At, 1, 1); PG8_STAGE(PG8_SA(1, 0), a3, voffA);
            PG8_BAR; PG8_WAIT_L(0); PG8_MMA(1, 0, At, B0); PG8_BAR; PG8_SCHED;
            PG8_STAGE(PG8_SB(1, 1), b3 + hstep, voffB);
            PG8_WAIT_V(6); PG8_BAR; PG8_MMA(1, 1, At, B1); PG8_BAR;
            }
        }
        if constexpr (ALIGN_EPI) { if (wr == 0) PG8_BAR; }
        if constexpr (!Epi::AFTER_DRAIN) { E(acc, cur, wr, wc, fr, fq); S.done(cur); }
        if (!has_next) break;
#pragma unroll
        for (int a = 0; a < 2; ++a)
#pragma unroll
            for (int b = 0; b < 2; ++b)
#pragma unroll
                for (int m = 0; m < 4; ++m)
#pragma unroll
                    for (int n = 0; n < 2; ++n) acc[a][b][m][n] = (f32x4){0.f, 0.f, 0.f, 0.f};
        cur = nxt; cA = nA; cB = nB; ++ui;
        if constexpr (ALIGN_EPI) { if (wr == 1) PG8_BAR; }
    }
    PG8_WAIT_V(0);
    if constexpr (!ALIGN_EPI) { if (wr == 0) PG8_BAR; }
    PG8_BAR;
    if constexpr (Epi::AFTER_DRAIN) { E.fused(acc, cur, wr, wc, fr, fq, lds, wid, lane); S.done(cur); }
#undef PG8_SA
#undef PG8_SB
#undef PG8_STAGE
#undef PG8_LDA
#undef PG8_LDB
#undef PG8_MMA
#undef PG8_WAIT_V
#undef PG8_WAIT_L
#undef PG8_BAR
#undef PG8_SCHED
}
}

constexpr int D = 1024, NB = 2, SEQ = 16384, NMETA = 16, LTOK = SEQ + NMETA  , PADR = 112, T = PADR + LTOK  ;
constexpr int M = NB * T;
constexpr int DEPTH = 2, HD = 64, RW_H = 6, SB_H = 5, FX_H = 5, RW_W = 384, SHIFT_W = 1280, D_IN = 6277;
constexpr int QKV_W = 1920;
constexpr int N1 = 3328;
constexpr int FCOL = 3200, GCOL = 3205;
constexpr int NEXP = 16, DEXP = 256;
constexpr int MS = 70144;
constexpr int LCH = 32, LPADDED = 16448;
constexpr int KBP = 16896;
constexpr float C2 = 0.125f * 1.4426950408889634f;
constexpr float LOG2E = 1.4426950408889634f;
constexpr int NWAVES = 8, NTHR = 512;

constexpr size_t MiB = 1u << 20;
constexpr size_t WS_CTL = 0, CTL_ZERO_BYTES = 65536;
constexpr size_t WS_HM = 1 * MiB;
constexpr size_t WS_LOGF = WS_HM + 131072;
constexpr size_t WS_KB2 = WS_LOGF + (size_t)M * 32;
constexpr size_t WS_TOK = WS_KB2 + (size_t)10 * KBP * 4;
constexpr size_t WS_SLOT = WS_TOK + (size_t)M * 32;
constexpr size_t WS_CWS = WS_SLOT + (size_t)M * 8;
constexpr size_t WS_WGCNT = WS_CWS + (size_t)MS * 4;
constexpr size_t WS_SMALL_END = WS_WGCNT + 256 * 16 * 4;
static_assert(WS_SMALL_END <= 8 * MiB, "small buffers");
constexpr size_t WS_WIN = 8 * MiB;
constexpr size_t WS_WG = WS_WIN + (size_t)N1 * 1024 * 2;
constexpr size_t WS_WP = WS_WG + (size_t)3072 * 1024 * 2;
constexpr size_t WS_WO = WS_WP + (size_t)3072 * 384 * 2;
constexpr size_t WS_WGU = WS_WO + (size_t)1024 * 1024 * 2;
constexpr size_t WS_WD = WS_WGU + (size_t)8192 * 1024 * 2;
constexpr size_t WS_W_END = WS_WD + (size_t)16384 * 256 * 2;
static_assert(WS_W_END <= 49 * MiB, "weights");
constexpr size_t WS_HB = 49 * MiB;
constexpr size_t WS_BIG = 115 * MiB;
constexpr size_t WS_USH = WS_BIG;
constexpr size_t WS_YCAT = WS_BIG;
constexpr size_t WS_QKV = WS_BIG + 82 * MiB;
constexpr size_t WS_RW = WS_BIG + 204 * MiB;
constexpr size_t WS_BN = WS_BIG + 349 * MiB;
constexpr size_t WS_GATES = WS_BIG + 82 * MiB;
constexpr size_t WS_MERGED = WS_BIG + 276 * MiB;
constexpr size_t WS_AS = WS_BIG;
constexpr size_t WS_HS = WS_BIG + 137 * MiB;
constexpr size_t WS_Y = WS_BIG + 172 * MiB;
constexpr size_t WS_END = WS_BIG + 374 * MiB;
static_assert((size_t)(M + 256) * 1280 * 2 <= 82 * MiB && (size_t)3 * M * 384 * 2 <= 82 * MiB && (size_t)(M + 256) * 1920 * 2 <= 122 * MiB, "big map 1");
static_assert((size_t)12 * LPADDED * 768 <= 145 * MiB && (size_t)M * 384 * 2 <= 25 * MiB && (size_t)M * 3072 * 2 <= 194 * MiB && (size_t)M * 2048 <= 65 * MiB, "big map 2");
static_assert((size_t)MS * 2048 <= 137 * MiB && (size_t)MS * 512 <= 35 * MiB && WS_END <= 489 * MiB, "big map 3");

constexpr int CW_BAR = 0;
constexpr int CW_QUEUE = 4096;
constexpr int CW_ECNT = 4352;
static_assert((CW_ECNT + 128) * 4 <= (int)CTL_ZERO_BYTES, "ctl");

constexpr int RING_BYTES = 131072, MISC_OFF = RING_BYTES, LDS_BYTES = 147456;

typedef unsigned short bf16_t;
typedef float f32x4 __attribute__((ext_vector_type(4)));
typedef float f32x2 __attribute__((ext_vector_type(2)));
typedef float f32x16 __attribute__((ext_vector_type(16)));
typedef unsigned u32x4 __attribute__((ext_vector_type(4)));
typedef unsigned u32x2 __attribute__((ext_vector_type(2)));
typedef short bf16x8 __attribute__((ext_vector_type(8)));
typedef short s16x4 __attribute__((ext_vector_type(4)));
typedef _Float16 f16x4 __attribute__((ext_vector_type(4)));
typedef __bf16 bf16x2_t __attribute__((ext_vector_type(2)));

__device__ __forceinline__ unsigned pk2(float lo, float hi) { f32x2 v = {lo, hi}; bf16x2_t b = __builtin_convertvector(v, bf16x2_t); return __builtin_bit_cast(unsigned, b); }
__device__ __forceinline__ unsigned short f2bf(float f) { return (unsigned short)(pk2(f, 0.f) & 0xffffu); }
__device__ __forceinline__ float bf_lo(unsigned u) { return __uint_as_float(u << 16); }
__device__ __forceinline__ float bf_hi(unsigned u) { return __uint_as_float(u & 0xffff0000u); }
__device__ __forceinline__ float bf2f(unsigned short h) { return __uint_as_float((unsigned)h << 16); }
template <int CTRL> __device__ __forceinline__ float dpp_f(float x) { return __int_as_float(__builtin_amdgcn_update_dpp(0, __float_as_int(x), CTRL, 0xF, 0xF, false)); }
__device__ __forceinline__ float allred16(float p) { p += dpp_f<0x128>(p); p += dpp_f<0x124>(p); p += dpp_f<0x122>(p); p += dpp_f<0x121>(p); return p; }
__device__ __forceinline__ float wave_sum(float v) {
    v = allred16(v);
    { auto sw = __builtin_amdgcn_permlane16_swap(__float_as_uint(v), __float_as_uint(v), false, false); v = __uint_as_float(sw[0]) + __uint_as_float(sw[1]); }
    { auto sw = __builtin_amdgcn_permlane32_swap(__float_as_uint(v), __float_as_uint(v), false, false); v = __uint_as_float(sw[0]) + __uint_as_float(sw[1]); }
    return v;
}
__device__ __forceinline__ float fast_exp(float x) { return __builtin_amdgcn_exp2f(x * LOG2E); }
__device__ __forceinline__ float fast_log(float x) { return __builtin_amdgcn_logf(x) * 0.6931471805599453f; }
__device__ __forceinline__ float softplus_f(float z) { return fmaxf(z, 0.f) + fast_log(1.f + fast_exp(-fabsf(z))); }

#define XB_TMO      128
#define XB_XCNT(j)  (256  + 64 * (j))
#define XB_XSUB(j)  (1280 + 64 * (j))
#define XB_XGEN(j)  (2304 + 64 * (j))
#define XB_TOP      3328
#define XB_TOPGEN   3392
#define XCD_BAR_WORDS 3456
#define XB_SPIN_CAP (1u << 20)
__device__ __forceinline__ unsigned xb_ld(unsigned* p)              { return __hip_atomic_load(p, __ATOMIC_RELAXED, __HIP_MEMORY_SCOPE_AGENT); }
__device__ __forceinline__ unsigned xb_add(unsigned* p, unsigned v) { return __hip_atomic_fetch_add(p, v, __ATOMIC_RELAXED, __HIP_MEMORY_SCOPE_AGENT); }
__device__ __forceinline__ unsigned xb_xcc_id() { return (unsigned)__builtin_amdgcn_s_getreg((3 << 11) | 20) & 0xFu; }
#define XB_SPIN(cond, bar) do { unsigned _sp = 0; while (cond) { __builtin_amdgcn_s_sleep(1); \
    if ((++_sp & 255u) == 0u) { if (xb_ld(&(bar)[XB_TMO])) break; if (_sp > XB_SPIN_CAP) { atomicAdd(&(bar)[XB_TMO], 1u); break; } } } } while (0)

struct XcdBarrier {
    unsigned* bar; unsigned x;
    volatile LAS unsigned* st;
};

__device__ __forceinline__ XcdBarrier xcd_barrier_post(unsigned* bar, volatile LAS unsigned* st) {
    XcdBarrier b; b.bar = bar; b.x = xb_xcc_id(); b.st = st;
    if (threadIdx.x == 0) (void)xb_add(&bar[XB_XCNT(b.x)], 1u);
    return b;
}
__device__ __forceinline__ void xcd_barrier_complete(unsigned* bar, unsigned x, unsigned& nloc, unsigned& nx) {
    const unsigned G = gridDim.x * gridDim.y * gridDim.z;
    unsigned sum, cnt, mine, sp = 0u;
    for (;;) {
        sum = 0u; cnt = 0u; mine = 0u;
#pragma unroll
        for (unsigned j = 0; j < 16; ++j) { const unsigned c = xb_ld(&bar[XB_XCNT(j)]); sum += c; cnt += (c > 0u) ? 1u : 0u; mine = (j == x) ? c : mine; }
        if (sum == G) break;
        __builtin_amdgcn_s_sleep(1);
        if ((++sp & 255u) == 0u) { if (xb_ld(&bar[XB_TMO])) break; if (sp > XB_SPIN_CAP) { atomicAdd(&bar[XB_TMO], 1u); break; } }
    }
    nloc = mine > 0u ? mine : 1u; nx = cnt > 0u ? cnt : 1u;
}

__device__ __forceinline__ void xcd_barrier(const XcdBarrier& b) {
    asm volatile("s_waitcnt vmcnt(0)" ::: "memory");
    __syncthreads();
    if (threadIdx.x == 0) {
        unsigned* bar = b.bar;
        __builtin_amdgcn_s_waitcnt(0);
        unsigned nloc = b.st[0], nx = b.st[1];
        if (nloc == 0u) { xcd_barrier_complete(bar, b.x, nloc, nx); b.st[0] = nloc; b.st[1] = nx; }
        const unsigned old = xb_add(&bar[XB_XSUB(b.x)], 1u);
        const unsigned gen = old / nloc;
        if (old + 1u == (gen + 1u) * nloc) {
            __builtin_amdgcn_fence(__ATOMIC_RELEASE, "agent");
            asm volatile("s_waitcnt vmcnt(0)" ::: "memory");
            const unsigned og = xb_add(&bar[XB_TOP], 1u);
            const unsigned tg = og / nx;
            if (og + 1u == (tg + 1u) * nx) xb_add(&bar[XB_TOPGEN], 1u);
            else XB_SPIN(xb_ld(&bar[XB_TOPGEN]) == tg, bar);
            __builtin_amdgcn_fence(__ATOMIC_ACQUIRE, "agent");
            xb_add(&bar[XB_XGEN(b.x)], 1u);
            asm volatile("s_waitcnt vmcnt(0)" ::: "memory");
        } else {
            XB_SPIN(xb_ld(&bar[XB_XGEN(b.x)]) == gen, bar);
            __builtin_amdgcn_fence(__ATOMIC_ACQUIRE, "agent");
            asm volatile("s_waitcnt vmcnt(0)" ::: "memory");
        }
    }
    __syncthreads();
}

struct Args { const float* in[29]; float* out; unsigned char* ws; };
enum { I_X = 0, I_META, I_N1G, I_WIN, I_MU, I_WUP, I_W0, I_AUP, I_A0, I_KK, I_KA, I_RK, I_LNG, I_LNB, I_FB, I_QG, I_KG, I_WPR, I_WPS, I_WPF, I_WOUT, I_N2G, I_MWG, I_MBG, I_MWE, I_MBE, I_MGATE, I_MUP, I_MDOWN };
struct ArgsL { volatile LAS unsigned* tab; float* out; unsigned char* ws;
    __device__ __forceinline__ const float* in(int i) const { const unsigned lo = tab[2 * i], hi = tab[2 * i + 1];
        return (const float*)(((unsigned long long)(unsigned)__builtin_amdgcn_readfirstlane((int)hi) << 32) | (unsigned long long)(unsigned)__builtin_amdgcn_readfirstlane((int)lo)); }
};
struct Frame { LAS unsigned char* lds; volatile LAS unsigned* MISC; int tid, lane, wave, bx; };

__device__ __forceinline__ float* hrow(const ArgsL& a, int b, int l) {
    return l < NMETA ? (float*)(a.ws + WS_HM) + (size_t)(b * NMETA + l) * D : a.out + ((size_t)b * SEQ + (l - NMETA)) * D;
}
#define LDS_WAIT() asm volatile("s_waitcnt lgkmcnt(0)" ::: "memory")
#define HB_PTR(a) ((bf16_t*)((a).ws + WS_HB))
#define A_PTR(a) ((bf16_t*)((a).out))

__device__ __forceinline__ void tr_item(const float* W, int ldw, int sc0, int nvalid, int k0, int kvalid, bf16_t* WT, int Kd, int r0, LAS float* scr, int lane) {
    float tv[32];
#pragma unroll
    for (int i = 0; i < 32; ++i) { const int kk = 2 * i + (lane >> 5), n = lane & 31; tv[i] = 0.f;
        if (n < nvalid && k0 + kk < kvalid) tv[i] = W[(size_t)(k0 + kk) * ldw + sc0 + n]; }
#pragma unroll
    for (int i = 0; i < 32; ++i) { const int kk = 2 * i + (lane >> 5), n = lane & 31; scr[kk * 33 + n] = tv[i]; }
    LDS_WAIT();
    const int c = lane & 7;
#pragma unroll
    for (int j = 0; j < 4; ++j) { const int n = (lane >> 3) + 8 * j; const LAS float* s = scr + (8 * c) * 33 + n;
        u32x4 o; o.x = pk2(s[0 * 33], s[1 * 33]); o.y = pk2(s[2 * 33], s[3 * 33]); o.z = pk2(s[4 * 33], s[5 * 33]); o.w = pk2(s[6 * 33], s[7 * 33]);
        *(u32x4*)(WT + (size_t)(r0 + n) * Kd + k0 + 8 * c) = o; }
    LDS_WAIT();
}
__device__ __forceinline__ void phase_wconv(const ArgsL& a, Frame& F, int layer) {
    LAS float* scr = (LAS float*)(F.lds + F.wave * 8448);
    const int gw = F.bx * NWAVES + F.wave, NGW = gridDim.x * NWAVES;
    constexpr int C1 = 16 * 104, C2_ = C1 + 16 * 96, C3 = C2_ + 6 * 96, C4 = C3 + 16 * 32, C5 = C4 + 16 * 256, C6 = C5 + 4 * 512;
    unsigned char* ws = a.ws;
    for (int it = gw; it < C6; it += NGW) {
        if (it < C1) { const int kb = it / 104, nb = it % 104, r0 = nb * 32;
            tr_item(a.in(I_WIN) + (size_t)layer * D * D_IN, D_IN, r0, r0 < FCOL ? 32 : 0, kb * 64, 1024, (bf16_t*)(ws + WS_WIN), 1024, r0, scr, F.lane); }
        else if (it < C2_) { const int r = it - C1, kb = r / 96, nb = r % 96, r0 = nb * 32;
            tr_item(a.in(I_WIN) + (size_t)layer * D * D_IN, D_IN, GCOL + r0, 32, kb * 64, 1024, (bf16_t*)(ws + WS_WG), 1024, r0, scr, F.lane); }
        else if (it < C3) { const int r = it - C2_, kb = r / 96, nb = r % 96, r0 = nb * 32, br = r0 >> 10;
            const float* W = (br == 0 ? a.in(I_WPR) + (size_t)layer * 384 * D : br == 1 ? a.in(I_WPS) + (size_t)layer * 320 * D : a.in(I_WPF) + (size_t)layer * 320 * D);
            tr_item(W, D, r0 & 1023, 32, kb * 64, br == 0 ? 384 : 320, (bf16_t*)(ws + WS_WP), 384, r0, scr, F.lane); }
        else if (it < C4) { const int r = it - C3, kb = r / 32, nb = r % 32, r0 = nb * 32;
            tr_item(a.in(I_WOUT) + (size_t)layer * D * D, D, r0, 32, kb * 64, 1024, (bf16_t*)(ws + WS_WO), 1024, r0, scr, F.lane); }
        else if (it < C5) { const int r = it - C4, kb = r / 256, nb = r % 256, r0 = nb * 32, e = r0 >> 9, rr = r0 & 511, j = rr >> 8, q = rr & 255;
            const float* W = (q >= 128 ? a.in(I_MUP) : a.in(I_MGATE)) + ((size_t)layer * NEXP + e) * D * DEXP;
            tr_item(W, DEXP, j * 128 + (q & 127), 32, kb * 64, 1024, (bf16_t*)(ws + WS_WGU), 1024, r0, scr, F.lane); }
        else { const int r = it - C5, kb = r / 512, nb = r % 512, r0 = nb * 32, e = r0 >> 10;
            tr_item(a.in(I_MDOWN) + ((size_t)layer * NEXP + e) * DEXP * D, D, r0 & 1023, 32, kb * 64, 256, (bf16_t*)(ws + WS_WD), 256, r0, scr, F.lane); }
    }
}

__device__ __forceinline__ void add_y_row(f32x4 (&v)[4], const bf16_t* Y, int slot, int lane) {
    const u32x2* y = (const u32x2*)(Y + (size_t)slot * D) + lane;
#pragma unroll
    for (int j = 0; j < 4; ++j) { const u32x2 t = y[64 * j]; v[j].x += bf_lo(t.x); v[j].y += bf_hi(t.x); v[j].z += bf_lo(t.y); v[j].w += bf_hi(t.y); }
}
template <int MODE>
__device__ __forceinline__ void phase_norm(const ArgsL& a, Frame& F, int layer, const bool dry = false) {
    const int lane = F.lane;
    LAS float* wl = (LAS float*)F.lds;
    LAS int* lcnt = (LAS int*)(F.lds + 20 * 4096);
    unsigned char* ws = a.ws;
    if (MODE == 1) {
        const float* win = a.in(I_WIN) + (size_t)layer * D * D_IN;
        for (int idx = F.tid; idx < 5 * 1024; idx += NTHR) { const int j = idx >> 10, k = idx & 1023; wl[j * 1024 + k] = win[(size_t)k * D_IN + FCOL + j]; }
    }
    if (MODE == 2) {
        const float* wg = a.in(I_MWG) + (size_t)layer * D * 4; const float* we = a.in(I_MWE) + (size_t)layer * D * 16;
        for (int i4 = F.tid; i4 < 1024; i4 += NTHR) { const f32x4 f = *(const f32x4*)(wg + 4 * i4); wl[i4] = f.x; wl[1024 + i4] = f.y; wl[2048 + i4] = f.z; wl[3072 + i4] = f.w; }
        for (int i4 = F.tid; i4 < 4096; i4 += NTHR) { const int k = i4 >> 2, c = i4 & 3; const f32x4 f = *(const f32x4*)(we + 4 * i4); LAS float* d = wl + (4 + 4 * c) * 1024 + k;
            d[0] = f.x; d[1024] = f.y; d[2048] = f.z; d[3072] = f.w; }
        if (F.tid < 16) lcnt[F.tid] = 0;
    }
    __syncthreads();
    const int gw = F.bx * NWAVES + F.wave, NGW = gridDim.x * NWAVES;
    const float* gsrc = (MODE == 2 ? a.in(I_N2G) : a.in(I_N1G)) + layer * D;
    f32x4 gv[4];
#pragma unroll
    for (int j = 0; j < 4; ++j) gv[j] = (MODE == 0) ? (f32x4){0.f, 0.f, 0.f, 0.f} : *(const f32x4*)(gsrc + 4 * lane + 256 * j);
    bf16_t* A = A_PTR(a); bf16_t* HB = HB_PTR(a);
    const bf16_t* Y = (const bf16_t*)(ws + WS_Y);
    const int* SLOT = (const int*)(ws + WS_SLOT);
    constexpr bool COMB0 = (MODE == 0);
    const bool comb = COMB0 || (MODE == 1 && layer > 0);
    f32x4 vn[4]; u32x2 yan[4], ybn[4];
#pragma unroll
    for (int j = 0; j < 4; ++j) { vn[j] = (f32x4){0.f, 0.f, 0.f, 0.f}; yan[j] = (u32x2){0u, 0u}; ybn[j] = (u32x2){0u, 0u}; }
#define NRM_VALID(mm) ((mm) < M && ((mm) % T) - PADR >= (MODE == 0 ? NMETA : 0))
#define NRM_LOAD(mm, s0_, s1_) do { if (NRM_VALID(mm)) { const int bb_ = (mm) / T, ll_ = (mm) - bb_ * T - PADR; \
        if (MODE == 1 && layer == 0) { const float* src_ = (ll_ < NMETA) ? a.in(I_META) + (size_t)ll_ * D : a.in(I_X) + ((size_t)bb_ * SEQ + (ll_ - NMETA)) * D; \
            _Pragma("unroll") for (int j = 0; j < 4; ++j) vn[j] = *(const f32x4*)(src_ + 4 * lane + 256 * j); } \
        else { const u32x2* hs_ = (const u32x2*)(HB + (size_t)(mm) * D) + lane; \
            _Pragma("unroll") for (int j = 0; j < 4; ++j) { const u32x2 t_ = hs_[64 * j]; vn[j] = (f32x4){bf_lo(t_.x), bf_hi(t_.x), bf_lo(t_.y), bf_hi(t_.y)}; } } \
        if (comb) { const u32x2* y0_ = (const u32x2*)(Y + (size_t)(s0_) * D) + lane; const u32x2* y1_ = (const u32x2*)(Y + (size_t)(s1_) * D) + lane; \
            _Pragma("unroll") for (int j = 0; j < 4; ++j) { yan[j] = y0_[64 * j]; ybn[j] = y1_[64 * j]; } } } } while (0)
    int sa1 = 0, sb1 = 0, sa2 = 0, sb2 = 0;
    if (comb) { if (NRM_VALID(gw)) { sa1 = SLOT[2 * gw]; sb1 = SLOT[2 * gw + 1]; } if (NRM_VALID(gw + NGW)) { sa2 = SLOT[2 * (gw + NGW)]; sb2 = SLOT[2 * (gw + NGW) + 1]; } }
    NRM_LOAD(gw, sa1, sb1);
    for (int m = gw; m < M; m += NGW) {
        f32x4 v[4]; u32x2 ya[4], yb[4];
#pragma unroll
        for (int j = 0; j < 4; ++j) { v[j] = vn[j]; ya[j] = yan[j]; yb[j] = ybn[j]; }
        int sa3 = 0, sb3 = 0;
        if (comb && NRM_VALID(m + 2 * NGW)) { sa3 = SLOT[2 * (m + 2 * NGW)]; sb3 = SLOT[2 * (m + 2 * NGW) + 1]; }
        NRM_LOAD(m + NGW, sa2, sb2);
        sa2 = sa3; sb2 = sb3;
        const int b = m / T, p = m - b * T, l = p - PADR;
        if (l < 0) {
            if (MODE == 1 && !dry) {
                u32x2* o = (u32x2*)(A + (size_t)m * D) + lane;
#pragma unroll
                for (int j = 0; j < 4; ++j) o[64 * j] = (u32x2){0u, 0u};
                if (lane < 8) ((float*)(ws + WS_LOGF))[(size_t)m * 8 + lane] = 0.f;
            }
            continue;
        }
        if (MODE == 0 && l < NMETA) continue;
        if (comb) {
#pragma unroll
            for (int j = 0; j < 4; ++j) { v[j].x += bf_lo(ya[j].x) + bf_lo(yb[j].x); v[j].y += bf_hi(ya[j].x) + bf_hi(yb[j].x); v[j].z += bf_lo(ya[j].y) + bf_lo(yb[j].y); v[j].w += bf_hi(ya[j].y) + bf_hi(yb[j].y); }
        }
        if (MODE == 0 && !dry) { float* op = a.out + ((size_t)b * SEQ + (l - NMETA)) * D;
#pragma unroll
            for (int j = 0; j < 4; ++j) *(f32x4*)(op + 4 * lane + 256 * j) = v[j]; }
        if (MODE == 1 && !dry) { u32x2* hd = (u32x2*)(HB + (size_t)m * D) + lane;
#pragma unroll
            for (int j = 0; j < 4; ++j) hd[64 * j] = (u32x2){pk2(v[j].x, v[j].y), pk2(v[j].z, v[j].w)};
        }
        if (MODE == 0) continue;
        float ss = 0.f;
#pragma unroll
        for (int j = 0; j < 4; ++j) ss += (v[j].x * v[j].x + v[j].y * v[j].y) + (v[j].z * v[j].z + v[j].w * v[j].w);
        const float r = 1.0f / sqrtf(wave_sum(ss) * (1.0f / D) + 1e-6f);
#pragma unroll
        for (int j = 0; j < 4; ++j) v[j] = v[j] * r * gv[j];
        u32x2* o = (u32x2*)(A + (size_t)m * D) + lane;
        if (!dry) {
#pragma unroll
        for (int j = 0; j < 4; ++j) o[64 * j] = (u32x2){pk2(v[j].x, v[j].y), pk2(v[j].z, v[j].w)}; }
        else { float sink = v[0].x + v[1].y + v[2].z + v[3].w; asm volatile("" :: "v"(sink)); }
        if (MODE == 1) {
            float dsum[5];
#pragma unroll
            for (int q = 0; q < 5; ++q) { float d = 0.f;
#pragma unroll
                for (int j = 0; j < 4; ++j) { const f32x4 w = *(const LAS f32x4*)(wl + q * 1024 + 4 * lane + 256 * j); d += (v[j].x * w.x + v[j].y * w.y) + (v[j].z * w.z + v[j].w * w.w); }
                dsum[q] = wave_sum(d); }
            float mine = dsum[0];
            mine = lane == 1 ? dsum[1] : mine; mine = lane == 2 ? dsum[2] : mine; mine = lane == 3 ? dsum[3] : mine; mine = lane == 4 ? dsum[4] : mine;
            if (lane < 8 && !dry) { float lf = 0.f;
                if (lane < 5) { const float xx = mine + a.in(I_FB)[layer * 5 + lane]; lf = fminf(xx, 0.f) - fast_log(1.f + fast_exp(-fabsf(xx))); }
                ((float*)(ws + WS_LOGF))[(size_t)m * 8 + lane] = lf; }
        }
        if (MODE == 2) {
            float dp[20];
#pragma unroll
            for (int q = 0; q < 20; ++q) { float d = 0.f;
#pragma unroll
                for (int j = 0; j < 4; ++j) { const f32x4 w = *(const LAS f32x4*)(wl + q * 1024 + 4 * lane + 256 * j); d += (v[j].x * w.x + v[j].y * w.y) + (v[j].z * w.z + v[j].w * w.w); }
                dp[q] = d; }
            float sA[10], sB[5];
#pragma unroll
            for (int i = 0; i < 10; ++i) { auto sw = __builtin_amdgcn_permlane32_swap(__float_as_uint(dp[2 * i]), __float_as_uint(dp[2 * i + 1]), false, false); sA[i] = __uint_as_float(sw[0]) + __uint_as_float(sw[1]); }
#pragma unroll
            for (int i = 0; i < 5; ++i) { auto sw = __builtin_amdgcn_permlane16_swap(__float_as_uint(sA[2 * i]), __float_as_uint(sA[2 * i + 1]), false, false); sB[i] = allred16(__uint_as_float(sw[0]) + __uint_as_float(sw[1])); }
            LAS float* red = (LAS float*)(F.lds + 81920 + 256) + F.wave * 32;
            { const int rho = lane >> 4, vsel = ((rho & 1) << 1) | (rho >> 1);
              if ((lane & 15) == 0) {
#pragma unroll
                  for (int i = 0; i < 5; ++i) red[4 * i + vsel] = sB[i]; } }
            LDS_WAIT();
            float ds[20];
#pragma unroll
            for (int i = 0; i < 5; ++i) { const f32x4 t4 = *(const LAS f32x4*)(red + 4 * i); ds[4 * i] = t4.x; ds[4 * i + 1] = t4.y; ds[4 * i + 2] = t4.z; ds[4 * i + 3] = t4.w; }
            LDS_WAIT();
            const float* bg = a.in(I_MBG) + layer * 4; const float* be = a.in(I_MBE) + layer * 16;
            float lg0 = ds[0] + bg[0], lg1 = ds[1] + bg[1], lg2 = ds[2] + bg[2], lg3 = ds[3] + bg[3];
            int g = 0; float mx = lg0;
            if (lg1 > mx) { mx = lg1; g = 1; } if (lg2 > mx) { mx = lg2; g = 2; } if (lg3 > mx) { mx = lg3; g = 3; }
            const float den = fast_exp(lg0 - mx) + fast_exp(lg1 - mx) + fast_exp(lg2 - mx) + fast_exp(lg3 - mx);
            const float pgrp = 1.0f / den;
            float s0 = g == 0 ? ds[4] : g == 1 ? ds[8] : g == 2 ? ds[12] : ds[16];
            float s1 = g == 0 ? ds[5] : g == 1 ? ds[9] : g == 2 ? ds[13] : ds[17];
            float s2 = g == 0 ? ds[6] : g == 1 ? ds[10] : g == 2 ? ds[14] : ds[18];
            float s3 = g == 0 ? ds[7] : g == 1 ? ds[11] : g == 2 ? ds[15] : ds[19];
            s0 += be[g * 4 + 0]; s1 += be[g * 4 + 1]; s2 += be[g * 4 + 2]; s3 += be[g * 4 + 3];
            int i0 = 0; float v0 = s0;
            if (s1 > v0) { v0 = s1; i0 = 1; } if (s2 > v0) { v0 = s2; i0 = 2; } if (s3 > v0) { v0 = s3; i0 = 3; }
            int i1 = -1; float v1 = -3.0e38f;
            if (i0 != 0 && s0 > v1) { v1 = s0; i1 = 0; } if (i0 != 1 && s1 > v1) { v1 = s1; i1 = 1; } if (i0 != 2 && s2 > v1) { v1 = s2; i1 = 2; } if (i0 != 3 && s3 > v1) { v1 = s3; i1 = 3; }
            const float e1 = fast_exp(v1 - v0), pt0 = 1.0f / (1.0f + e1), pt1 = e1 * pt0;
            if (dry) { float sink = pgrp * pt0 + pt1; asm volatile("" :: "v"(sink)); }
            if (lane == 0 && !dry) {
                const int ea = g * 4 + i0, eb = g * 4 + i1;
                const int la = atomicAdd((int*)&lcnt[ea], 1), lb = atomicAdd((int*)&lcnt[eb], 1);
                int* tk = (int*)(ws + WS_TOK) + (size_t)m * 8;
                tk[0] = ea; tk[1] = eb; tk[2] = __float_as_int(pgrp * pt0); tk[3] = __float_as_int(pgrp * pt1); tk[4] = la; tk[5] = lb;
            }
        }
    }
    __syncthreads();
#undef NRM_LOAD
#undef NRM_VALID
    if (MODE == 2 && F.tid < 16 && !dry) {
        const int c = lcnt[F.tid];
        ((int*)(ws + WS_WGCNT))[F.bx * 16 + F.tid] = c;
        atomicAdd((int*)(ws + WS_CTL) + CW_ECNT + 64 * layer + F.tid, c);
    }
    __syncthreads();
}

__device__ __forceinline__ void phase_norm2(const ArgsL& a, Frame& F, int layer, const bool dry = false) {
    const int lane = F.lane;
    LAS float* wl = (LAS float*)F.lds;
    LAS int* lcnt = (LAS int*)(F.lds + 20 * 4096);
    unsigned char* ws = a.ws;
    {
        const float* wg = a.in(I_MWG) + (size_t)layer * D * 4; const float* we = a.in(I_MWE) + (size_t)layer * D * 16;
        for (int i4 = F.tid; i4 < 1024; i4 += NTHR) { const f32x4 f = *(const f32x4*)(wg + 4 * i4); wl[i4] = f.x; wl[1024 + i4] = f.y; wl[2048 + i4] = f.z; wl[3072 + i4] = f.w; }
        for (int i4 = F.tid; i4 < 4096; i4 += NTHR) { const int k = i4 >> 2, c = i4 & 3; const f32x4 f = *(const f32x4*)(we + 4 * i4); LAS float* d = wl + (4 + 4 * c) * 1024 + k;
            d[0] = f.x; d[1024] = f.y; d[2048] = f.z; d[3072] = f.w; }
        if (F.tid < 16) lcnt[F.tid] = 0;
    }
    __syncthreads();
    const int gw = F.bx * NWAVES + F.wave, NGW = gridDim.x * NWAVES;
    LAS float* gl = (LAS float*)(F.lds + 86016);
    LAS float* bl = (LAS float*)(F.lds + 90112);
    for (int i = F.tid; i < 1024; i += NTHR) gl[i] = a.in(I_N2G)[layer * D + i];
    if (F.tid < 4) bl[F.tid] = a.in(I_MBG)[layer * 4 + F.tid];
    if (F.tid >= 64 && F.tid < 80) bl[4 + F.tid - 64] = a.in(I_MBE)[layer * 16 + F.tid - 64];
    __syncthreads();
    bf16_t* A = A_PTR(a); const bf16_t* HB = HB_PTR(a);
    LAS float* red = (LAS float*)(F.lds + 81920 + 256) + F.wave * 96;
#define N2_VALID(mm) ((mm) < M && ((mm) % T) >= PADR)
    constexpr int NR = 2;
    for (int m0 = gw; m0 < M; m0 += NR * NGW) {
        f32x4 v[NR][4];
#pragma unroll
        for (int rr = 0; rr < NR; ++rr) { const int mm_ = m0 + rr * NGW;
            if (N2_VALID(mm_)) { const u32x2* hs_ = (const u32x2*)(HB + (size_t)mm_ * D) + lane;
#pragma unroll
                for (int j = 0; j < 4; ++j) { const u32x2 t = hs_[64 * j]; v[rr][j] = (f32x4){bf_lo(t.x), bf_hi(t.x), bf_lo(t.y), bf_hi(t.y)}; } }
            else {
#pragma unroll
                for (int j = 0; j < 4; ++j) v[rr][j] = (f32x4){0.f, 0.f, 0.f, 0.f}; } }
        float ss[NR];
#pragma unroll
        for (int rr = 0; rr < NR; ++rr) { float s_ = 0.f;
#pragma unroll
            for (int j = 0; j < 4; ++j) s_ += (v[rr][j].x * v[rr][j].x + v[rr][j].y * v[rr][j].y) + (v[rr][j].z * v[rr][j].z + v[rr][j].w * v[rr][j].w);
            ss[rr] = s_; }
#pragma unroll
        for (int rr = 0; rr < NR; ++rr) ss[rr] = wave_sum(ss[rr]);
#pragma unroll
        for (int rr = 0; rr < NR; ++rr) { const int mm = m0 + rr * NGW; const float r = 1.0f / sqrtf(ss[rr] * (1.0f / D) + 1e-6f);
#pragma unroll
            for (int j = 0; j < 4; ++j) v[rr][j] = v[rr][j] * r * *(const LAS f32x4*)(gl + 4 * lane + 256 * j);
            if (N2_VALID(mm) && !dry) { u32x2* o = (u32x2*)(A + (size_t)mm * D) + lane;
#pragma unroll
                for (int j = 0; j < 4; ++j) o[64 * j] = (u32x2){pk2(v[rr][j].x, v[rr][j].y), pk2(v[rr][j].z, v[rr][j].w)}; } }
        { const int rho = lane >> 4, vsel = ((rho & 1) << 1) | (rho >> 1);
#pragma unroll
          for (int qh = 0; qh < 2; ++qh) {
            float dp[NR][10];
#pragma unroll
            for (int q = 0; q < 10; ++q) { f32x4 w[4];
#pragma unroll
                for (int j = 0; j < 4; ++j) w[j] = *(const LAS f32x4*)(wl + (qh * 10 + q) * 1024 + 4 * lane + 256 * j);
#pragma unroll
                for (int rr = 0; rr < NR; ++rr) { float d = 0.f;
#pragma unroll
                    for (int j = 0; j < 4; ++j) d += (v[rr][j].x * w[j].x + v[rr][j].y * w[j].y) + (v[rr][j].z * w[j].z + v[rr][j].w * w[j].w);
                    dp[rr][q] = d; }
                if (q & 1) __builtin_amdgcn_sched_barrier(0); }
#pragma unroll
            for (int rr = 0; rr < NR; ++rr) { float sA[6], sB[3]; sA[5] = 0.f;
#pragma unroll
                for (int i = 0; i < 5; ++i) { auto sw = __builtin_amdgcn_permlane32_swap(__float_as_uint(dp[rr][2 * i]), __float_as_uint(dp[rr][2 * i + 1]), false, false); sA[i] = __uint_as_float(sw[0]) + __uint_as_float(sw[1]); }
#pragma unroll
                for (int k = 0; k < 3; ++k) { auto sw = __builtin_amdgcn_permlane16_swap(__float_as_uint(sA[2 * k]), __float_as_uint(sA[2 * k + 1]), false, false); sB[k] = allred16(__uint_as_float(sw[0]) + __uint_as_float(sw[1])); }
                if ((lane & 15) == 0) {
#pragma unroll
                    for (int k = 0; k < 3; ++k) red[rr * 24 + qh * 10 + 4 * k + vsel] = sB[k]; } }
            __builtin_amdgcn_sched_barrier(0);
          } }
        LDS_WAIT();
        if (lane < NR) {
            const int mm = m0 + lane * NGW;
            float ds[20];
#pragma unroll
            for (int i = 0; i < 5; ++i) { const f32x4 t4 = *(const LAS f32x4*)(red + lane * 24 + 4 * i); ds[4 * i] = t4.x; ds[4 * i + 1] = t4.y; ds[4 * i + 2] = t4.z; ds[4 * i + 3] = t4.w; }
            const float lg0 = ds[0] + bl[0], lg1 = ds[1] + bl[1], lg2 = ds[2] + bl[2], lg3 = ds[3] + bl[3];
            int g = 0; float mx = lg0;
            if (lg1 > mx) { mx = lg1; g = 1; } if (lg2 > mx) { mx = lg2; g = 2; } if (lg3 > mx) { mx = lg3; g = 3; }
            const float den = fast_exp(lg0 - mx) + fast_exp(lg1 - mx) + fast_exp(lg2 - mx) + fast_exp(lg3 - mx);
            const float pgrp = 1.0f / den;
            const f32x4 be4 = *(const LAS f32x4*)(bl + 4 + 4 * g);
            float s0 = (g == 0 ? ds[4] : g == 1 ? ds[8] : g == 2 ? ds[12] : ds[16]) + be4.x;
            float s1 = (g == 0 ? ds[5] : g == 1 ? ds[9] : g == 2 ? ds[13] : ds[17]) + be4.y;
            float s2 = (g == 0 ? ds[6] : g == 1 ? ds[10] : g == 2 ? ds[14] : ds[18]) + be4.z;
            float s3 = (g == 0 ? ds[7] : g == 1 ? ds[11] : g == 2 ? ds[15] : ds[19]) + be4.w;
            int i0 = 0; float v0 = s0;
            if (s1 > v0) { v0 = s1; i0 = 1; } if (s2 > v0) { v0 = s2; i0 = 2; } if (s3 > v0) { v0 = s3; i0 = 3; }
            int i1 = -1; float v1 = -3.0e38f;
            if (i0 != 0 && s0 > v1) { v1 = s0; i1 = 0; } if (i0 != 1 && s1 > v1) { v1 = s1; i1 = 1; } if (i0 != 2 && s2 > v1) { v1 = s2; i1 = 2; } if (i0 != 3 && s3 > v1) { v1 = s3; i1 = 3; }
            const float e1 = fast_exp(v1 - v0), pt0 = 1.0f / (1.0f + e1), pt1 = e1 * pt0;
            if (N2_VALID(mm) && !dry) {
                const int ea = g * 4 + i0, eb = g * 4 + i1;
                const int la = atomicAdd((int*)&lcnt[ea], 1), lb = atomicAdd((int*)&lcnt[eb], 1);
                int* tk = (int*)(ws + WS_TOK) + (size_t)mm * 8;
                tk[0] = ea; tk[1] = eb; tk[2] = __float_as_int(pgrp * pt0); tk[3] = __float_as_int(pgrp * pt1); tk[4] = la; tk[5] = lb;
            } else { float sink = pgrp * pt0 + pt1; asm volatile("" :: "v"(sink)); }
        }
        LDS_WAIT();
    }
#undef N2_VALID
    __syncthreads();
    if (F.tid < 16 && !dry) {
        const int c = lcnt[F.tid];
        ((int*)(ws + WS_WGCNT))[F.bx * 16 + F.tid] = c;
        atomicAdd((int*)(ws + WS_CTL) + CW_ECNT + 64 * layer + F.tid, c);
    }
    __syncthreads();
}

__device__ __forceinline__ void phase_route(const ArgsL& a, Frame& F, int layer) {
    unsigned char* ws = a.ws;
    LAS int* tbl = (LAS int*)F.lds;
    LAS int* part = tbl + 16;
    {
        const int e = F.tid & 15, q = F.tid >> 4; const int* wc = (const int*)(ws + WS_WGCNT); int acc = 0;
#pragma unroll
        for (int i = 0; i < 8; ++i) { const int w = q + 32 * i; if (w < (int)F.bx) acc += wc[w * 16 + e]; }
        part[q * 16 + e] = acc;
    }
    __syncthreads();
    if (F.tid < 16) {
        const int* cnt = (const int*)(ws + WS_CTL) + CW_ECNT + 64 * layer;
        int cv[16];
#pragma unroll
        for (int e = 0; e < 16; ++e) cv[e] = __hip_atomic_load(cnt + e, __ATOMIC_RELAXED, __HIP_MEMORY_SCOPE_AGENT);
        int base = 0;
#pragma unroll
        for (int e = 0; e < 16; ++e) if (e < F.tid) base += ((cv[e] + 255) >> 8) << 8;
#pragma unroll
        for (int q = 0; q < 32; ++q) base += part[q * 16 + F.tid];
        tbl[F.tid] = base;
    }
    __syncthreads();
    const int gw = F.bx * NWAVES + F.wave, NGW = gridDim.x * NWAVES, lane = F.lane;
    const bf16_t* A = A_PTR(a); bf16_t* AS = (bf16_t*)(ws + WS_AS);
    int tn[6] = {0, 0, 0, 0, 0, 0}; u32x4 xn0 = {0u, 0u, 0u, 0u}, xn1 = {0u, 0u, 0u, 0u};
#define RT_LOAD(mm) do { if ((mm) < M && ((mm) % T) >= PADR) { const int* tk_ = (const int*)(ws + WS_TOK) + (size_t)(mm) * 8; \
        _Pragma("unroll") for (int q_ = 0; q_ < 6; ++q_) tn[q_] = tk_[q_]; \
        const u32x4* src_ = (const u32x4*)(A + (size_t)(mm) * D) + lane; xn0 = src_[0]; xn1 = src_[64]; } } while (0)
    RT_LOAD(gw);
    for (int m = gw; m < M; m += NGW) {
        int tk[6];
#pragma unroll
        for (int q = 0; q < 6; ++q) tk[q] = tn[q];
        const u32x4 x0 = xn0, x1 = xn1;
        RT_LOAD(m + NGW);
        const int b = m / T, p = m - b * T, l = p - PADR;
        if (l < 0) continue;
        const int ea = tk[0], eb = tk[1], sa = tbl[ea] + tk[4], sb = tbl[eb] + tk[5];
        u32x4* d0 = (u32x4*)(AS + (size_t)sa * D) + lane; u32x4* d1 = (u32x4*)(AS + (size_t)sb * D) + lane;
        d0[0] = x0; d0[64] = x1; d1[0] = x0; d1[64] = x1;
        if (lane == 0) { int* sl = (int*)(ws + WS_SLOT) + 2 * m; sl[0] = sa; sl[1] = sb;
            float* cw = (float*)(ws + WS_CWS); cw[sa] = __int_as_float(tk[2]); cw[sb] = __int_as_float(tk[3]); }
    }
#undef RT_LOAD
    __syncthreads();
}

#ifndef PR_STAGES
#define PR_STAGES 15
#endif
__device__ __forceinline__ void phase_prep(const ArgsL& a, Frame& F, int layer, const bool dry = false) {
    unsigned char* ws = a.ws;
    LAS float* xs = (LAS float*)F.lds;
    const int wave = F.wave, lane = F.lane, tid = F.tid;
    const int m0 = F.bx * 129;
    const bf16_t* USH = (const bf16_t*)(ws + WS_USH);
    bf16_t* QKV = (bf16_t*)(ws + WS_QKV);
    if (F.bx < 10 && (!dry || (PR_STAGES & 8))) {
        const int bh = F.bx, b = bh / 5, h = bh % 5;
        const float* LOGF = (const float*)(ws + WS_LOGF) + (size_t)(b * T + PADR) * 8 + h;
        float* kb = (float*)(ws + WS_KB2) + (size_t)bh * KBP;
        LAS float* wtot = (LAS float*)F.lds;
        float v[33];
        const int l0 = tid * 33;
#pragma unroll
        for (int i = 0; i < 33; ++i) v[i] = (l0 + i < LTOK) ? LOGF[(size_t)(l0 + i) * 8] : 0.f;
#pragma unroll
        for (int i = 1; i < 33; ++i) v[i] += v[i - 1];
        float incl = v[32];
#pragma unroll
        for (int o = 1; o < 64; o <<= 1) { const float t = __shfl_up(incl, o); if (lane >= o) incl += t; }
        if (lane == 63) wtot[wave] = incl;
        __syncthreads();
        float off = incl - v[32];
        for (int w = 0; w < wave; ++w) off += wtot[w];
#pragma unroll
        for (int i = 0; i < 33; ++i) if (l0 + i < LTOK && !dry) kb[PADR + l0 + i] = -(off + v[i]) * LOG2E;
        for (int p = tid; p < PADR; p += NTHR) kb[p] = 0.f;
        for (int p = T + tid; p < KBP; p += NTHR) kb[p] = 0.f;
        __syncthreads();
    }
    if (F.bx >= 16 && F.bx < 28) {
        unsigned* z = (unsigned*)(ws + WS_RW + ((size_t)(F.bx - 16) * LPADDED + LTOK) * 768);
        for (int i = tid; i < (LPADDED - LTOK) * 192; i += NTHR) z[i] = 0u;
    }
    const int r16 = lane & 15, q4 = lane >> 4, hh = wave < 6 ? wave : 0;
    bf16x8 bw[2][4][2];
    float cw0[4], ca0[4], ckk[4], cka[4], crk[4];
    {
        const float* WUp = a.in(I_WUP) + (size_t)layer * 64 * RW_W + hh * 64 + r16; const float* AUp = a.in(I_AUP) + (size_t)layer * 64 * RW_W + hh * 64 + r16;
#pragma unroll
        for (int mtx = 0; mtx < 2; ++mtx)
#pragma unroll
            for (int blk = 0; blk < 4; ++blk)
#pragma unroll
                for (int ks = 0; ks < 2; ++ks) { const float* p_ = (mtx ? AUp : WUp) + (size_t)(32 * ks + 8 * q4) * RW_W + blk * 16;
                    const float f0 = p_[0], f1 = p_[RW_W], f2 = p_[2 * RW_W], f3 = p_[3 * RW_W], f4 = p_[4 * RW_W], f5 = p_[5 * RW_W], f6 = p_[6 * RW_W], f7 = p_[7 * RW_W];
                    bw[mtx][blk][ks] = __builtin_bit_cast(bf16x8, (u32x4){pk2(f0, f1), pk2(f2, f3), pk2(f4, f5), pk2(f6, f7)}); }
#pragma unroll
        for (int blk = 0; blk < 4; ++blk) { const int ch = layer * RW_W + hh * 64 + blk * 16 + r16;
            cw0[blk] = a.in(I_W0)[ch]; ca0[blk] = a.in(I_A0)[ch]; ckk[blk] = a.in(I_KK)[ch]; cka[blk] = a.in(I_KA)[ch]; crk[blk] = a.in(I_RK)[ch]; }
    }
    const float* mu = a.in(I_MU) + layer * SHIFT_W;
    f32x4 gq4 = *(const f32x4*)(a.in(I_QG) + layer * 64 + (lane & 15) * 4) * C2; const f32x4 gk4 = *(const f32x4*)(a.in(I_KG) + layer * 64 + (lane & 15) * 4);
    _Float16* RW = (_Float16*)(ws + WS_RW);
    bf16_t* BN = (bf16_t*)(ws + WS_BN);
    for (int t0 = 0; t0 < 129; t0 += 16) {
        const int nt = (129 - t0) < 16 ? (129 - t0) : 16;
        if (!dry || (PR_STAGES & 1)) {
            int tid = F.tid; asm volatile("" : "+v"(tid));
            u32x4 uu4[5], pp4[5];
#pragma unroll
            for (int q5 = 0; q5 < 5; ++q5) { const int item = tid + q5 * NTHR; uu4[q5] = (u32x4){0u, 0u, 0u, 0u}; pp4[q5] = (u32x4){0u, 0u, 0u, 0u};
                if (item < nt * 160) { const int tok = item / 160, ch = item - tok * 160, m = m0 + t0 + tok;
                    uu4[q5] = *(const u32x4*)(USH + (size_t)m * SHIFT_W + ch * 8);
                    if (m > 0) pp4[q5] = *(const u32x4*)(USH + (size_t)(m - 1) * SHIFT_W + ch * 8); } }
#pragma unroll
            for (int q5 = 0; q5 < 5; ++q5) { const int item = tid + q5 * NTHR;
                if (item < nt * 160) { const int tok = item / 160, ch = item - tok * 160;
                    const u32x4 u = uu4[q5], pv = pp4[q5];
                    const f32x4 mu0 = *(const f32x4*)(mu + ch * 8), mu1 = *(const f32x4*)(mu + ch * 8 + 4);
                    float x[8];
                    { float uu, pp;
                      uu = bf_lo(u.x); pp = bf_lo(pv.x); x[0] = uu + (pp - uu) * mu0.x;  uu = bf_hi(u.x); pp = bf_hi(pv.x); x[1] = uu + (pp - uu) * mu0.y;
                      uu = bf_lo(u.y); pp = bf_lo(pv.y); x[2] = uu + (pp - uu) * mu0.z;  uu = bf_hi(u.y); pp = bf_hi(pv.y); x[3] = uu + (pp - uu) * mu0.w;
                      uu = bf_lo(u.z); pp = bf_lo(pv.z); x[4] = uu + (pp - uu) * mu1.x;  uu = bf_hi(u.z); pp = bf_hi(pv.z); x[5] = uu + (pp - uu) * mu1.y;
                      uu = bf_lo(u.w); pp = bf_lo(pv.w); x[6] = uu + (pp - uu) * mu1.z;  uu = bf_hi(u.w); pp = bf_hi(pv.w); x[7] = uu + (pp - uu) * mu1.w; }
                    if (ch >= 144 && ch < 152) {
#pragma unroll
                        for (int q = 0; q < 8; ++q) { const float e = fast_exp(-2.f * fabsf(x[q])); const float th = (1.f - e) / (1.f + e); x[q] = x[q] < 0.f ? -th : th; }
                    }
                    LAS f32x4* d = (LAS f32x4*)(xs + tok * SHIFT_W + ch * 8);
                    d[0] = (f32x4){x[0], x[1], x[2], x[3]}; d[1] = (f32x4){x[4], x[5], x[6], x[7]}; } }
        }
        __syncthreads();
        if (wave < 6) { if (!dry || (PR_STAGES & 2)) {
            f32x4 acc[2][4];
#pragma unroll
            for (int mtx = 0; mtx < 2; ++mtx) {
                bf16x8 af[2];
#pragma unroll
                for (int ks = 0; ks < 2; ++ks) { const LAS float* xp = xs + r16 * SHIFT_W + 1152 + 64 * mtx + 32 * ks + 8 * q4;
                    const f32x4 u0 = *(const LAS f32x4*)xp, u1 = *(const LAS f32x4*)(xp + 4);
                    af[ks] = __builtin_bit_cast(bf16x8, (u32x4){pk2(u0.x, u0.y), pk2(u0.z, u0.w), pk2(u1.x, u1.y), pk2(u1.z, u1.w)}); }
#pragma unroll
                for (int blk = 0; blk < 4; ++blk) { f32x4 c4 = {0.f, 0.f, 0.f, 0.f};
                    c4 = __builtin_amdgcn_mfma_f32_16x16x32_bf16(af[0], bw[mtx][blk][0], c4, 0, 0, 0);
                    c4 = __builtin_amdgcn_mfma_f32_16x16x32_bf16(af[1], bw[mtx][blk][1], c4, 0, 0, 0);
                    acc[mtx][blk] = c4; }
            }
#pragma unroll
            for (int i = 0; i < 4; ++i) {
                const int tok = 4 * q4 + i, m = m0 + t0 + tok, b = m / T, p = m - b * T, l = p - PADR;
                const bool ok = (tok < nt) && (l >= 0);
                const LAS float* xr = xs + (tok < 16 ? tok : 0) * SHIFT_W + hh * 64 + r16;
                float kkr[4], kpv[4], avv4[4], omv[4], rv4[4], vv4[4];
                float ssq = 0.f, cf = 0.f;
#pragma unroll
                for (int blk = 0; blk < 4; ++blk) {
                    const float wlv = cw0[blk] + acc[0][blk][i], alv = ca0[blk] + acc[1][blk][i];
                    const float r = xr[blk * 16], k = xr[384 + blk * 16], v = xr[768 + blk * 16];
                    const float logw = -softplus_f(-wlv) - 0.5f;
                    const float xw = fast_exp(logw);
                    omv[blk] = xw < 0.02f ? xw * (1.f - 0.5f * xw + xw * xw * (1.f / 6.f)) : 1.f - fast_exp(-xw);
                    const float av = 1.f / (1.f + fast_exp(-alv));
                    kkr[blk] = k * ckk[blk]; kpv[blk] = k * (1.f + (av - 1.f) * cka[blk]); avv4[blk] = av; rv4[blk] = r; vv4[blk] = v;
                    ssq += kkr[blk] * kkr[blk]; cf += r * kpv[blk] * crk[blk];
                }
                ssq = allred16(ssq); cf = allred16(cf);
                const float inv = 1.0f / fmaxf(sqrtf(ssq), 1e-12f);
                if (ok && !dry) {
                    _Float16* o = RW + ((size_t)(b * RW_H + hh) * LPADDED + l) * 384 + r16;
#pragma unroll
                    for (int blk = 0; blk < 4; ++blk) { const float kk = kkr[blk] * inv, bb = kk * avv4[blk];
                        o[blk * 16] = (_Float16)kk; o[64 + blk * 16] = (_Float16)(-omv[blk]); o[128 + blk * 16] = (_Float16)(-bb); o[192 + blk * 16] = (_Float16)kpv[blk];
                        o[256 + blk * 16] = (_Float16)rv4[blk]; o[320 + blk * 16] = (_Float16)vv4[blk];
                        BN[(size_t)m * RW_W + hh * 64 + blk * 16 + r16] = f2bf(cf * vv4[blk]); }
                } else { float sink = ssq + cf + inv + omv[0] + kpv[1]; asm volatile("" :: "v"(sink)); }
            } }
        }
        if (!dry || (PR_STAGES & 4)) {
            const int it4 = lane >> 4, e4 = lane & 15;
            u32x2 xv[5]; bf16_t* qp5[5]; bool okv[5];
#pragma unroll
            for (int ps = 0; ps < 5; ++ps) { const int item = (ps * 8 + wave) * 4 + it4, tok = item / 10, hq = item - tok * 10;
                const int m = m0 + t0 + tok, p = m % T;
                okv[ps] = (tok < nt) && (p >= PADR);
                qp5[ps] = QKV + (size_t)m * QKV_W + 960 + hq * 64 + e4 * 4;
                xv[ps] = okv[ps] ? *(const u32x2*)qp5[ps] : (u32x2){0u, 0u}; }
#pragma unroll
            for (int ps = 0; ps < 5; ++ps) { const int item = (ps * 8 + wave) * 4 + it4, hq = item % 10;
                const float x0 = bf_lo(xv[ps].x), x1 = bf_hi(xv[ps].x), x2 = bf_lo(xv[ps].y), x3 = bf_hi(xv[ps].y);
                const float ss = allred16((x0 * x0 + x1 * x1) + (x2 * x2 + x3 * x3));
                const float rs = 1.0f / sqrtf(ss * (1.0f / 64.f) + 1e-6f);
                const f32x4 gg = hq < 5 ? gq4 : gk4;
                const u32x2 w = {pk2(x0 * rs * gg.x, x1 * rs * gg.y), pk2(x2 * rs * gg.z, x3 * rs * gg.w)};
                if (okv[ps] && !dry) *(u32x2*)qp5[ps] = w; else asm volatile("" :: "v"(w.x), "v"(w.y)); }
        }
        __syncthreads();
    }
}


constexpr int SCH = 16;
static_assert(LTOK % SCH == 0, "whole chunks");
__device__ __forceinline__ void rwkv_scan(const ArgsL& a, Frame& F, int wgi, int dry = 0) {
    const int bh = wgi >> 4, q8 = wgi & 15, b = bh / RW_H, h = bh % RW_H;
    const int tid = F.tid, wave = F.wave, lane = F.lane;
    const unsigned char* rw = a.ws + WS_RW + (size_t)bh * LPADDED * 768;
    LAS float* ring = (LAS float*)F.lds;
    LAS float* ypart = (LAS float*)(F.lds + 49152);
    LAS unsigned char* stg = F.lds + 81920;
    bf16_t* y0 = (bf16_t*)(a.ws + WS_YCAT);
    constexpr int NCH = LTOK / SCH;
    const bool isld = (wave & 2) != 0; const int lw = (wave & 1) + ((wave >> 2) << 1), tl = lw * 64 + lane;
    float s0 = 0.f, s1 = 0.f;
    const int i32 = lane & 31, rsel = lane >> 5, rloc = 2 * wave + rsel;
#define RW_BAR() asm volatile("s_waitcnt lgkmcnt(0)\n\ts_barrier" ::: "memory")
#define RW_ISSUE(cc) do { const unsigned char* src_ = rw + (size_t)(cc) * SCH * 768 + (size_t)tl * 16; LAS unsigned char* d_ = stg + ((cc) & 3) * 12288 + lw * 1024; \
        _Pragma("unroll") for (int k_ = 0; k_ < 3; ++k_) __builtin_amdgcn_global_load_lds((const unsigned*)(src_ + k_ * 4096), (LAS unsigned*)(d_ + k_ * 4096), 16, 0, 0); } while (0)
#define RW_CONVERT(cc) do { const LAS unsigned char* s_ = stg + ((cc) & 3) * 12288 + tl * 16; LAS float* rb_ = ring + ((cc) & 1) * 6144; \
        _Pragma("unroll") for (int k_ = 0; k_ < 3; ++k_) { const int pc_ = tl + 256 * k_; const int t_ = pc_ / 48, q_ = pc_ - t_ * 48, vec_ = q_ >> 3, e0_ = (q_ & 7) * 8; \
            const u32x4 w_ = *(const LAS u32x4*)(s_ + k_ * 4096); \
            const f16x4 lo_ = __builtin_bit_cast(f16x4, (u32x2){w_.x, w_.y}), hi_ = __builtin_bit_cast(f16x4, (u32x2){w_.z, w_.w}); \
            const float f0 = (float)lo_.x, f1 = (float)lo_.y, f2 = (float)lo_.z, f3 = (float)lo_.w, f4 = (float)hi_.x, f5 = (float)hi_.y, f6 = (float)hi_.z, f7 = (float)hi_.w; \
            if (vec_ < 4) { LAS float* d_ = rb_ + t_ * 384 + (vec_ >> 1) * 128 + (e0_ >> 1) * 4 + (vec_ & 1) * 2; \
                *(LAS f32x2*)(d_) = (f32x2){f0, f1}; *(LAS f32x2*)(d_ + 4) = (f32x2){f2, f3}; *(LAS f32x2*)(d_ + 8) = (f32x2){f4, f5}; *(LAS f32x2*)(d_ + 12) = (f32x2){f6, f7}; } \
            else { LAS f32x4* d_ = (LAS f32x4*)(rb_ + t_ * 384 + (vec_ == 4 ? 256 : 320) + e0_); d_[0] = (f32x4){f0, f1, f2, f3}; d_[1] = (f32x4){f4, f5, f6, f7}; } } } while (0)
#define RW_STORE_Y(cc) do { if (tl < 32) { const LAS float* yb_ = ypart + ((cc) & 1) * 4096; const int t_ = tl >> 1, pr_ = tl & 1; const int l_ = (cc) * SCH + t_; \
        const LAS f32x4* q_ = (const LAS f32x4*)(yb_ + t_ * 128 + pr_ * 64); f32x4 sa_ = q_[0], sb_ = q_[8]; \
        _Pragma("unroll") for (int k_ = 1; k_ < 8; ++k_) { sa_ = sa_ + q_[k_]; sb_ = sb_ + q_[8 + k_]; } \
        *(unsigned*)(y0 + (size_t)(b * T + PADR + l_) * RW_W + h * 64 + q8 * 4 + 2 * pr_) = pk2((sa_.x + sa_.y) + (sa_.z + sa_.w), (sb_.x + sb_.y) + (sb_.z + sb_.w)); } } while (0)
    if (isld) {
        RW_ISSUE(0); asm volatile("s_waitcnt vmcnt(0)" ::: "memory"); RW_CONVERT(0);
        RW_ISSUE(1); RW_ISSUE(2);
    }
    RW_BAR();
    for (int c = 0; c < NCH; ++c) {
        if (isld) {
            if (c + 2 < NCH) { asm volatile("s_waitcnt vmcnt(3)" ::: "memory"); RW_CONVERT(c + 1); }
            else if (c + 1 < NCH) { asm volatile("s_waitcnt vmcnt(0)" ::: "memory"); RW_CONVERT(c + 1); }
            if (c > 0 && !dry) RW_STORE_Y(c - 1);
            if (c + 3 < NCH) RW_ISSUE(c + 3);
        } else if (dry != 1 && wave < 2) {
            const unsigned ba = (unsigned)(uintptr_t)(ring + (c & 1) * 6144) + i32 * 16, ca = (unsigned)(uintptr_t)(ring + (c & 1) * 6144) + 1024 + i32 * 8,
                           va = (unsigned)(uintptr_t)(ring + (c & 1) * 6144) + 1280 + (q8 * 4 + rloc) * 4, ya = (unsigned)(uintptr_t)(ypart + (c & 1) * 4096 + rloc * 32 + i32);
            f32x4 OA[4], OB[4]; f32x2 OC[4]; float OV[4];
            OC[3] = (f32x2){0.f, 0.f};
#define RW_FETCH(tt, sl) asm volatile("ds_read_b128 %0, %4 offset:%c7\n\tds_read_b128 %1, %4 offset:%c8\n\tds_read_b64 %2, %5 offset:%c7\n\tds_read_b32 %3, %6 offset:%c7" \
                : "=&v"(OA[sl]), "=&v"(OB[sl]), "=&v"(OC[sl]), "=&v"(OV[sl]) : "v"(ba), "v"(ca), "v"(va), "i"((tt) * 1536), "i"((tt) * 1536 + 512) : "memory")
            RW_FETCH(0, 0); RW_FETCH(1, 1);
            float p, p2, y;
#define RW_STEP(t, WAITN, YL1, YL2, YW, FETCHL) asm volatile( \
                "s_waitcnt lgkmcnt(" WAITN ")\n\t" \
                "v_mul_f32 %[p], %[s0], %[kk0]\n\t" \
                "v_fmac_f32 %[p], %[s1], %[kk1]\n\t" \
                YL1 "\n\t" YL2 "\n\t" \
                XL8 "\n\t" \
                "v_fmac_f32 %[s0], %[s0], %[om0]\n\t" \
                "v_fmac_f32 %[s1], %[s1], %[om1]\n\t" \
                XL4 "\n\t" \
                "v_fmac_f32 %[s0], %[vf], %[kv0]\n\t" \
                "v_fmac_f32 %[s1], %[vf], %[kv1]\n\t" \
                XL2 "\n\t" \
                YW "\n\t" \
                FETCHL \
                : [p] "=&v"(p), [p2] "=&v"(p2), [y] "=&v"(y), [s0] "+v"(s0), [s1] "+v"(s1), [nA] "=&v"(OA[((t) + 2) & 3]), [nB] "=&v"(OB[((t) + 2) & 3]), [nC] "=&v"(OC[((t) + 2) & 3]), [nV] "=&v"(OV[((t) + 2) & 3]) \
                : [kk0] "v"(OA[(t) & 3].x), [kk1] "v"(OA[(t) & 3].y), [om0] "v"(OA[(t) & 3].z), [om1] "v"(OA[(t) & 3].w), [bb0] "v"(OB[(t) & 3].x), [bb1] "v"(OB[(t) & 3].y), [kv0] "v"(OB[(t) & 3].z), [kv1] "v"(OB[(t) & 3].w), \
                  [vf] "v"(OV[(t) & 3]), [rp0] "v"(OC[((t) + 3) & 3].x), [rp1] "v"(OC[((t) + 3) & 3].y), [ba] "v"(ba), [ca] "v"(ca), [va] "v"(va), [ya] "v"(ya), \
                  [oa] "i"(((t) + 2) * 1536), [ob] "i"(((t) + 2) * 1536 + 512), [oy] "i"(((t) - 1) * 512) : "memory")
#define RW_YL1 "v_mul_f32 %[y], %[s0], %[rp0]"
#define RW_YL2 "v_fmac_f32 %[y], %[s1], %[rp1]"
#define RW_YW  "ds_write_b32 %[ya], %[y] offset:%c[oy]"
#define RW_NOP "s_nop 0"
#define RW_TAIL_F "ds_read_b128 %[nA], %[ba] offset:%c[oa]\n\t" \
                XL1 "\n\t" \
                "ds_read_b128 %[nB], %[ba] offset:%c[ob]\n\t" \
                "ds_read_b64 %[nC], %[ca] offset:%c[oa]\n\t" \
                "v_mov_b32 %[p2], %[p]\n\t" \
                "ds_read_b32 %[nV], %[va] offset:%c[oa]\n\t" \
                "s_nop 0\n\t" \
                XSW "\n\t" \
                "v_add_f32 %[p], %[p], %[p2]\n\t" \
                "v_fmac_f32 %[s0], %[p], %[bb0]\n\t" \
                "v_fmac_f32 %[s1], %[p], %[bb1]"
#define RW_TAIL_N "s_nop 0\n\t" \
                XL1 "\n\t" \
                "s_nop 1\n\t" \
                "v_mov_b32 %[p2], %[p]\n\t" \
                "s_nop 1\n\t" \
                XSW "\n\t" \
                "v_add_f32 %[p], %[p], %[p2]\n\t" \
                "v_fmac_f32 %[s0], %[p], %[bb0]\n\t" \
                "v_fmac_f32 %[s1], %[p], %[bb1]"
#define RW_ALLSTEPS() do { \
            RW_STEP(0, "4", RW_NOP, RW_NOP, RW_NOP, RW_TAIL_F); \
            RW_STEP(1, "4", RW_YL1, RW_YL2, RW_YW, RW_TAIL_F); \
            RW_STEP(2, "5", RW_YL1, RW_YL2, RW_YW, RW_TAIL_F);  RW_STEP(3, "5", RW_YL1, RW_YL2, RW_YW, RW_TAIL_F);  RW_STEP(4, "5", RW_YL1, RW_YL2, RW_YW, RW_TAIL_F); \
            RW_STEP(5, "5", RW_YL1, RW_YL2, RW_YW, RW_TAIL_F);  RW_STEP(6, "5", RW_YL1, RW_YL2, RW_YW, RW_TAIL_F);  RW_STEP(7, "5", RW_YL1, RW_YL2, RW_YW, RW_TAIL_F); \
            RW_STEP(8, "5", RW_YL1, RW_YL2, RW_YW, RW_TAIL_F);  RW_STEP(9, "5", RW_YL1, RW_YL2, RW_YW, RW_TAIL_F);  RW_STEP(10, "5", RW_YL1, RW_YL2, RW_YW, RW_TAIL_F); \
            RW_STEP(11, "5", RW_YL1, RW_YL2, RW_YW, RW_TAIL_F); RW_STEP(12, "5", RW_YL1, RW_YL2, RW_YW, RW_TAIL_F); RW_STEP(13, "5", RW_YL1, RW_YL2, RW_YW, RW_TAIL_F); \
            RW_STEP(14, "5", RW_YL1, RW_YL2, RW_YW, RW_TAIL_N); \
            RW_STEP(15, "1", RW_YL1, RW_YL2, RW_YW, RW_TAIL_N); \
            asm volatile("v_mul_f32 %[y], %[s0], %[r0]\n\tv_fmac_f32 %[y], %[s1], %[r1]\n\tds_write_b32 %[ya], %[y] offset:7680" : [y] "=&v"(y) : [s0] "v"(s0), [s1] "v"(s1), [r0] "v"(OC[3].x), [r1] "v"(OC[3].y), [ya] "v"(ya) : "memory"); \
 } while (0)
#ifdef SCAN_PROBE_NOXL
            if (dry == 2) {
#define XL8 "v_add_f32 %[p], %[p], %[p]"
#define XL4 "v_add_f32 %[p], %[p], %[p]"
#define XL2 "v_add_f32 %[p], %[p], %[p]"
#define XL1 "v_add_f32 %[p], %[p], %[p]"
#define XSW "v_add_f32 %[p], %[p], %[p2]"
                RW_ALLSTEPS();
#undef XL8
#undef XL4
#undef XL2
#undef XL1
#undef XSW
            } else
#endif
            {
#define XL8 "v_add_f32_dpp %[p], %[p], %[p] row_ror:8 row_mask:0xf bank_mask:0xf bound_ctrl:1"
#define XL4 "v_add_f32_dpp %[p], %[p], %[p] row_ror:4 row_mask:0xf bank_mask:0xf bound_ctrl:1"
#define XL2 "v_add_f32_dpp %[p], %[p], %[p] row_ror:2 row_mask:0xf bank_mask:0xf bound_ctrl:1"
#define XL1 "v_add_f32_dpp %[p], %[p], %[p] row_ror:1 row_mask:0xf bank_mask:0xf bound_ctrl:1"
#define XSW "v_permlane16_swap_b32 %[p], %[p2]"
                RW_ALLSTEPS();
            }
#undef RW_ALLSTEPS
#undef RW_STEP
#undef XL8
#undef XL4
#undef XL2
#undef XL1
#undef XSW
#undef RW_YL1
#undef RW_YL2
#undef RW_YW
#undef RW_NOP
#undef RW_TAIL_F
#undef RW_TAIL_N
#undef RW_FETCH
        }
        RW_BAR();
    }
    if (isld && !dry) RW_STORE_Y(NCH - 1);
    asm volatile("s_waitcnt vmcnt(0) lgkmcnt(0)\n\ts_barrier" ::: "memory");
#undef RW_STORE_Y
#undef RW_ISSUE
#undef RW_CONVERT
#undef RW_BAR
}

__device__ __forceinline__ int crow(int r, int hi) { return (r & 3) + 8 * (r >> 2) + 4 * hi; }
__device__ __forceinline__ void glds16(const void* gsrc, unsigned lds_dst) { unsigned keep;
    asm volatile("s_mov_b32 %0, m0\n\ts_mov_b32 m0, %2\n\ts_nop 0\n\tglobal_load_lds_dwordx4 %1, off\n\ts_mov_b32 m0, %0" : "=&s"(keep) : "v"(gsrc), "s"(lds_dst) : "memory"); }
__device__ __forceinline__ void glds4(const void* gsrc, unsigned lds_dst) { unsigned keep;
    asm volatile("s_mov_b32 %0, m0\n\ts_mov_b32 m0, %2\n\ts_nop 0\n\tglobal_load_lds_dword %1, off\n\ts_mov_b32 m0, %0" : "=&s"(keep) : "v"(gsrc), "s"(lds_dst) : "memory"); }
typedef LAS const char* lds_cptr;
constexpr int FX_K = 0, FX_V = 24576, FX_WS = 49152, FX_OST = 51200, FX_FLG = 83968, FX_KB = 84224  ;

__device__ __forceinline__ void fx_pv(f32x16* o, int vb, bf16x8 pa0, bf16x8 pa1, bf16x8 pa2, bf16x8 pa3) {
#pragma unroll
    for (int d0 = 0; d0 < 2; ++d0) { s16x4 lo[4], hi[4];
#pragma unroll
        for (int ks = 0; ks < 4; ++ks) {
            asm volatile("ds_read_b64_tr_b16 %0,%1 offset:%c2" : "=&v"(lo[ks]) : "v"(vb), "i"(d0 * 4096 + ks * 1024) : "memory");
            asm volatile("ds_read_b64_tr_b16 %0,%1 offset:%c2" : "=&v"(hi[ks]) : "v"(vb), "i"(d0 * 4096 + ks * 1024 + 512) : "memory"); }
        asm volatile("s_waitcnt lgkmcnt(0)" ::: "memory"); __builtin_amdgcn_sched_barrier(0);
#define FX_PK(k) (bf16x8){lo[k][0], lo[k][1], lo[k][2], lo[k][3], hi[k][0], hi[k][1], hi[k][2], hi[k][3]}
        o[d0] = __builtin_amdgcn_mfma_f32_32x32x16_bf16(pa0, FX_PK(0), o[d0], 0, 0, 0);
        o[d0] = __builtin_amdgcn_mfma_f32_32x32x16_bf16(pa1, FX_PK(1), o[d0], 0, 0, 0);
        o[d0] = __builtin_amdgcn_mfma_f32_32x32x16_bf16(pa2, FX_PK(2), o[d0], 0, 0, 0);
        o[d0] = __builtin_amdgcn_mfma_f32_32x32x16_bf16(pa3, FX_PK(3), o[d0], 0, 0, 0);
#undef FX_PK
    }
}
__device__ __forceinline__ float halves_max(float m) { auto rr = __builtin_amdgcn_permlane32_swap(__float_as_uint(m), __float_as_uint(m), false, false); return fmaxf(__uint_as_float(rr[0]), __uint_as_float(rr[1])); }
__device__ __forceinline__ float halves_sum(float m) { auto rr = __builtin_amdgcn_permlane32_swap(__float_as_uint(m), __float_as_uint(m), false, false); return __uint_as_float(rr[0]) + __uint_as_float(rr[1]); }

template <int KIND>
__device__ __forceinline__ void attn_unit(const ArgsL& a, Frame& F, int b, int h, int qb, float bound) {
    const int lane = F.lane, wave = F.wave, r32 = lane & 31, hi = lane >> 5;
    LAS unsigned char* lds = F.lds;
    const bf16_t* QKV = (const bf16_t*)(a.ws + WS_QKV);
    const size_t rowbase = (size_t)b * T;
    const int p0 = qb * 256;
    constexpr int QC = KIND ? 0 : 960, KC = KIND ? 320 : 1280, VC = KIND ? 640 : 1600;
    const bf16_t* Qw = QKV + (rowbase + p0 + wave * 32) * QKV_W + QC + h * 64;
    const bf16_t* Kh = QKV + rowbase * QKV_W + KC + h * 64;
    const bf16_t* Vh = QKV + rowbase * QKV_W + VC + h * 64;
    const float* kbias = (const float*)(a.ws + WS_KB2) + (size_t)(b * FX_H + h) * KBP;
    const unsigned lds0 = (unsigned)(uintptr_t)lds;
    bf16x8 qr[4];
#pragma unroll
    for (int d0 = 0; d0 < 4; ++d0) qr[d0] = *(const bf16x8*)(Qw + (size_t)r32 * QKV_W + d0 * 16 + hi * 8);
    const int qp = p0 + wave * 32 + r32;
    const bool qvalid = (qp >= PADR) && (qp < T);
    const int plast = (p0 + 255) < (T - 1) ? (p0 + 255) : (T - 1);
    const int jlast = plast >> 6, jfirst = PADR >> 6;
    const int jw = (p0 + wave * 32 + 31) >> 6;
    const bf16_t* ksrc = Kh + (size_t)lane * QKV_W + wave * 8;
    const bf16_t* vsrc = Vh + (size_t)(16 * (wave & 3) + (lane >> 2)) * QKV_W + (wave >> 2) * 32 + (lane & 3) * 8;
    const unsigned kdst = lds0 + FX_K + wave * 1024, vdst = lds0 + FX_V + wave * 1024;
#define FX_DMA(j, slot) do { glds16(ksrc + (size_t)(j) * 64 * QKV_W, (unsigned)__builtin_amdgcn_readfirstlane(kdst + (slot) * 8192)); \
                             glds16(vsrc + (size_t)(j) * 64 * QKV_W, (unsigned)__builtin_amdgcn_readfirstlane(vdst + (slot) * 8192)); \
                             if (KIND == 0) glds4(kbias + 64 * (j) + lane, (unsigned)__builtin_amdgcn_readfirstlane(lds0 + FX_KB + (slot) * 2048 + wave * 256)); } while (0)
    const int vb0 = (int)(lds0 + FX_V) + ((lane >> 4) & 1) * 32 + (lane & 3) * 8 + (4 * hi + ((lane & 15) >> 2)) * 64;
    const lds_cptr kp0 = (lds_cptr)lds + FX_K + hi * 1024 + r32 * 16;
    LAS float* wsf = (LAS float*)(lds + FX_WS) + wave * 64;
    LAS float* flg = (LAS float*)(lds + FX_FLG);
    float m_run = KIND ? 0.f : -1.0e30f, l_run = 0.f;
    f32x16 o[2]; o[0] = f32x16{}; o[1] = f32x16{};
    asm volatile("" : "+v"(qr[0]), "+v"(qr[1]), "+v"(qr[2]), "+v"(qr[3]));
    int slot = 0;
    FX_DMA(jlast, 0);
    if (jlast > jfirst) FX_DMA(jlast - 1, 1);
    for (int j = jlast; j >= jfirst; --j) {
        if (j > jfirst) { if (KIND == 0) asm volatile("s_waitcnt vmcnt(3) lgkmcnt(0)\n\ts_barrier" ::: "memory"); else asm volatile("s_waitcnt vmcnt(2) lgkmcnt(0)\n\ts_barrier" ::: "memory"); }
        else asm volatile("s_waitcnt vmcnt(0) lgkmcnt(0)\n\ts_barrier" ::: "memory");
        if (j < jlast) {
            const LAS float* fl = flg + ((j + 1) & 1) * 16;
            const f32x4 fa = *(const LAS f32x4*)(fl), fb = *(const LAS f32x4*)(fl + 4);
            bool stop;
            if constexpr (KIND == 0) {
                const float mmin = fminf(fminf(fminf(fa.x, fa.y), fminf(fa.z, fa.w)), fminf(fminf(fb.x, fb.y), fminf(fb.z, fb.w)));
                stop = (bound + fl[8] - mmin) < -150.0f;
            } else {
                const float mmax = fmaxf(fmaxf(fmaxf(fa.x, fa.y), fmaxf(fa.z, fa.w)), fmaxf(fmaxf(fb.x, fb.y), fmaxf(fb.z, fb.w)));
                stop = mmax < -150.0f;
            }
            if (stop) break;
        }
        { const int s2 = slot + 2 >= 3 ? slot - 1 : slot + 2; if (j - 2 >= jfirst) FX_DMA(j - 2, s2); }
        if (j <= jw) {
            f32x16 s0v = f32x16{}, s1v = f32x16{};
            const lds_cptr kp = kp0 + slot * 8192;
#pragma unroll
            for (int d0 = 0; d0 < 4; ++d0) {
                const bf16x8 b0 = *(const LAS bf16x8*)(kp + d0 * 2048);
                const bf16x8 b1 = *(const LAS bf16x8*)(kp + d0 * 2048 + 512);
                s0v = __builtin_amdgcn_mfma_f32_32x32x16_bf16(b0, qr[d0], s0v, 0, 0, 0);
                s1v = __builtin_amdgcn_mfma_f32_32x32x16_bf16(b1, qr[d0], s1v, 0, 0, 0);
            }
            const bool edge = (64 * j + 63 >= p0 + wave * 32) || (64 * j < PADR);
            if constexpr (KIND == 0) {
                const LAS float* kbj = (const LAS float*)(lds + FX_KB + slot * 2048 + wave * 256) + 4 * hi;
#pragma unroll
                for (int g = 0; g < 4; ++g) { const f32x4 t0 = *(const LAS f32x4*)(kbj + 8 * g), t1 = *(const LAS f32x4*)(kbj + 32 + 8 * g);
                    s0v[4 * g] += t0.x; s0v[4 * g + 1] += t0.y; s0v[4 * g + 2] += t0.z; s0v[4 * g + 3] += t0.w;
                    s1v[4 * g] += t1.x; s1v[4 * g + 1] += t1.y; s1v[4 * g + 2] += t1.z; s1v[4 * g + 3] += t1.w; }
                if (edge) {
#pragma unroll
                    for (int r = 0; r < 16; ++r) { const int key = 64 * j + crow(r, hi);
                        if (key > qp || key < PADR) s0v[r] = -INFINITY;
                        if (key + 32 > qp || key + 32 < PADR) s1v[r] = -INFINITY; }
                }
                float rm = fmaxf(s0v[0], s1v[0]);
#pragma unroll
                for (int r = 1; r < 16; ++r) rm = fmaxf(rm, fmaxf(s0v[r], s1v[r]));
                rm = halves_max(rm);
                const float m_new = fmaxf(m_run, rm);
                const float f = __builtin_amdgcn_exp2f(m_run - m_new);
                m_run = m_new;
                float rs = 0.f;
#pragma unroll
                for (int r = 0; r < 16; ++r) { s0v[r] = __builtin_amdgcn_exp2f(s0v[r] - m_new); s1v[r] = __builtin_amdgcn_exp2f(s1v[r] - m_new); rs += s0v[r] + s1v[r]; }
                rs = halves_sum(rs);
                l_run = l_run * f + rs;
                if (!__all(f == 1.0f)) {
                    if (hi == 0) wsf[r32] = f;
                    LDS_WAIT();
#pragma unroll
                    for (int d_ = 0; d_ < 2; ++d_)
#pragma unroll
                        for (int r = 0; r < 16; ++r) o[d_][r] *= wsf[crow(r, hi)];
                }
            } else {
                f32x16 l0, l1;
#pragma unroll
                for (int r = 0; r < 16; ++r) {
                    const float z0 = s0v[r], z1 = s1v[r];
                    float a0 = -(fmaxf(z0, 0.f) + __builtin_amdgcn_logf(1.f + __builtin_amdgcn_exp2f(-fabsf(z0))));
                    float a1 = -(fmaxf(z1, 0.f) + __builtin_amdgcn_logf(1.f + __builtin_amdgcn_exp2f(-fabsf(z1))));
                    if (edge) { const int key = 64 * j + crow(r, hi);
                        if (key >= qp || key < PADR) { a0 = 0.f; s0v[r] = -INFINITY; }
                        if (key + 32 >= qp || key + 32 < PADR) { a1 = 0.f; s1v[r] = -INFINITY; } }
                    l0[r] = a0; l1[r] = a1;
                }
                float A[8], SA[9], SO[9];
#pragma unroll
                for (int g = 0; g < 4; ++g) { A[g] = (l0[4 * g] + l0[4 * g + 1]) + (l0[4 * g + 2] + l0[4 * g + 3]); A[4 + g] = (l1[4 * g] + l1[4 * g + 1]) + (l1[4 * g + 2] + l1[4 * g + 3]); }
                SA[8] = 0.f; SO[8] = 0.f;
#pragma unroll
                for (int g = 7; g >= 0; --g) SA[g] = A[g] + SA[g + 1];
#pragma unroll
                for (int g = 0; g < 8; ++g) { auto rr = __builtin_amdgcn_permlane32_swap(__float_as_uint(SA[g]), __float_as_uint(SA[g]), false, false); SO[g] = __uint_as_float(hi ? rr[0] : rr[1]); }
                const float R = m_run;
#pragma unroll
                for (int g = 0; g < 8; ++g) {
                    const float E = SA[g + 1] + (hi ? SO[g + 1] : SO[g]) + R;
                    if (g < 4) { float t = E;
                        s0v[4 * g + 3] = __builtin_amdgcn_exp2f(s0v[4 * g + 3] + l0[4 * g + 3] + t); t += l0[4 * g + 3];
                        s0v[4 * g + 2] = __builtin_amdgcn_exp2f(s0v[4 * g + 2] + l0[4 * g + 2] + t); t += l0[4 * g + 2];
                        s0v[4 * g + 1] = __builtin_amdgcn_exp2f(s0v[4 * g + 1] + l0[4 * g + 1] + t); t += l0[4 * g + 1];
                        s0v[4 * g + 0] = __builtin_amdgcn_exp2f(s0v[4 * g + 0] + l0[4 * g + 0] + t);
                    } else { const int q = g - 4; float t = E;
                        s1v[4 * q + 3] = __builtin_amdgcn_exp2f(s1v[4 * q + 3] + l1[4 * q + 3] + t); t += l1[4 * q + 3];
                        s1v[4 * q + 2] = __builtin_amdgcn_exp2f(s1v[4 * q + 2] + l1[4 * q + 2] + t); t += l1[4 * q + 2];
                        s1v[4 * q + 1] = __builtin_amdgcn_exp2f(s1v[4 * q + 1] + l1[4 * q + 1] + t); t += l1[4 * q + 1];
                        s1v[4 * q + 0] = __builtin_amdgcn_exp2f(s1v[4 * q + 0] + l1[4 * q + 0] + t);
                    }
                }
                m_run = R + SA[0] + SO[0];
            }
            u32x4 pw0, pw1, pw2, pw3;
            pw0 = (u32x4){pk2(s0v[0], s0v[1]), pk2(s0v[2], s0v[3]), pk2(s0v[4], s0v[5]), pk2(s0v[6], s0v[7])};
            pw1 = (u32x4){pk2(s0v[8], s0v[9]), pk2(s0v[10], s0v[11]), pk2(s0v[12], s0v[13]), pk2(s0v[14], s0v[15])};
            pw2 = (u32x4){pk2(s1v[0], s1v[1]), pk2(s1v[2], s1v[3]), pk2(s1v[4], s1v[5]), pk2(s1v[6], s1v[7])};
            pw3 = (u32x4){pk2(s1v[8], s1v[9]), pk2(s1v[10], s1v[11]), pk2(s1v[12], s1v[13]), pk2(s1v[14], s1v[15])};
            fx_pv(o, vb0 + slot * 8192, __builtin_bit_cast(bf16x8, pw0), __builtin_bit_cast(bf16x8, pw1), __builtin_bit_cast(bf16x8, pw2), __builtin_bit_cast(bf16x8, pw3));
        }
        float mm = qvalid ? m_run : (KIND ? -3.0e38f : 3.0e38f);
        if constexpr (KIND == 0) { mm = fminf(mm, dpp_f<0x128>(mm)); mm = fminf(mm, dpp_f<0x124>(mm)); mm = fminf(mm, dpp_f<0x122>(mm)); mm = fminf(mm, dpp_f<0x121>(mm));
            { auto sw = __builtin_amdgcn_permlane16_swap(__float_as_uint(mm), __float_as_uint(mm), false, false); mm = fminf(__uint_as_float(sw[0]), __uint_as_float(sw[1])); }
            { auto sw = __builtin_amdgcn_permlane32_swap(__float_as_uint(mm), __float_as_uint(mm), false, false); mm = fminf(__uint_as_float(sw[0]), __uint_as_float(sw[1])); } }
        else { mm = fmaxf(mm, dpp_f<0x128>(mm)); mm = fmaxf(mm, dpp_f<0x124>(mm)); mm = fmaxf(mm, dpp_f<0x122>(mm)); mm = fmaxf(mm, dpp_f<0x121>(mm));
            { auto sw = __builtin_amdgcn_permlane16_swap(__float_as_uint(mm), __float_as_uint(mm), false, false); mm = fmaxf(__uint_as_float(sw[0]), __uint_as_float(sw[1])); }
            { auto sw = __builtin_amdgcn_permlane32_swap(__float_as_uint(mm), __float_as_uint(mm), false, false); mm = fmaxf(__uint_as_float(sw[0]), __uint_as_float(sw[1])); } }
        if (lane == 0) { flg[(j & 1) * 16 + wave] = mm;
            if (KIND == 0 && wave == 0) flg[(j & 1) * 16 + 8] = *(const LAS float*)(lds + FX_KB + slot * 2048); }
        slot = slot == 2 ? 0 : slot + 1;
    }
    asm volatile("s_waitcnt vmcnt(0) lgkmcnt(0)\n\ts_barrier" ::: "memory");
    float rli[16];
    if constexpr (KIND == 0) {
        if (hi == 0) wsf[32 + r32] = l_run;
        LDS_WAIT();
#pragma unroll
        for (int r = 0; r < 16; ++r) rli[r] = __builtin_amdgcn_rcpf(wsf[32 + crow(r, hi)]);
    } else {
#pragma unroll
        for (int r = 0; r < 16; ++r) rli[r] = 1.0f;
    }
    bf16_t* Ow = (bf16_t*)(a.ws + WS_YCAT) + (size_t)(KIND ? 1 : 2) * M * RW_W + (rowbase + p0 + wave * 32) * RW_W + h * 64;
    {
        LAS bf16_t* stg = (LAS bf16_t*)(lds + FX_OST) + wave * 2048;
#pragma unroll
        for (int r = 0; r < 16; ++r) { const int orow = crow(r, hi);
#pragma unroll
            for (int d0 = 0; d0 < 2; ++d0) stg[orow * 64 + d0 * 32 + r32] = f2bf(o[d0][r] * rli[r]); }
        LDS_WAIT();
#pragma unroll
        for (int i = 0; i < 4; ++i) { const int row = i * 8 + (lane >> 3), ch = lane & 7; const u32x4 v = *(const LAS u32x4*)(stg + row * 64 + ch * 8);
            const int pr = p0 + wave * 32 + row;
            if (pr >= PADR && pr < T) *(u32x4*)(Ow + (size_t)row * RW_W + ch * 8) = v; }
    }
    asm volatile("s_waitcnt lgkmcnt(0)\n\ts_barrier" ::: "memory");
#undef FX_DMA
}


constexpr int CK = 64, NCK = 257, CKB = 40960;
static_assert(LPADDED == CK * NCK, "padded steps");
__device__ __forceinline__ int swz(int row, int chunk) { return row * 128 + ((chunk ^ (row & 7)) << 4); }
__device__ __forceinline__ void ck_mm(f32x16& acc, LAS unsigned char* A, LAS unsigned char* Bt, int m0, int n0, int r32, int hi) {
#pragma unroll
    for (int ks = 0; ks < 4; ++ks) {
        const bf16x8 av = *(const LAS bf16x8*)(A + swz(m0 + r32, 2 * ks + hi));
        const bf16x8 bv = *(const LAS bf16x8*)(Bt + swz(n0 + r32, 2 * ks + hi));
        acc = __builtin_amdgcn_mfma_f32_32x32x16_bf16(av, bv, acc, 0, 0, 0);
    }
}
__device__ __forceinline__ void ck_store_t(LAS unsigned char* dst, const f32x16& acc, int m0, int n0, int r32, int hi) {
#pragma unroll
    for (int g = 0; g < 4; ++g) { const u32x2 w = {pk2(acc[4 * g], acc[4 * g + 1]), pk2(acc[4 * g + 2], acc[4 * g + 3])};
        *(LAS u32x2*)(dst + swz(n0 + r32, (m0 >> 3) + g) + hi * 8) = w; }
}
constexpr int CA_KAP = 0, CA_BET = 8192, CA_CHI = 16384, CA_RHO = 24576, CA_VMT = 32768, CA_BHT = 40960, CA_KHT = 49152, CA_AK = 57344, CA_RB = 65536, CA_RK = 73728,
              CA_AB = 81920  , CA_RHS = 98304  , CA_G64 = MISC_OFF + 2048  , CA_SCR = MISC_OFF + 4096  ;

#ifndef CA_STAGES
#define CA_STAGES 15
#endif
__device__ __forceinline__ void phase_chunkA(const ArgsL& a, Frame& F, const bool dry = false) {
    const int wave = F.wave;
    LAS unsigned char* L = F.lds;
    u32x4 pre6[6];
    for (int id = F.bx; id < 12 * NCK; id += (int)gridDim.x) {
        int tid = F.tid, lane, r32, hi;
#define CK_FRESH() do { asm volatile("" : "+v"(tid)); lane = tid & 63; r32 = lane & 31; hi = lane >> 5; } while (0)
        CK_FRESH();
        const int bh = id / NCK, c = id - bh * NCK;
        unsigned char* blk = a.ws + WS_RW + ((size_t)bh * LPADDED + (size_t)c * CK) * 768;
        {
            if (id == F.bx) {
#pragma unroll
                for (int q6 = 0; q6 < 6; ++q6) pre6[q6] = *(const u32x4*)(blk + (size_t)(tid + q6 * NTHR) * 16);
            }
#pragma unroll
            for (int q6 = 0; q6 < 6; ++q6) *(LAS u32x4*)(L + CA_AB + (tid + q6 * NTHR) * 16) = pre6[q6];
            __syncthreads();
            const int k = tid & 63, tq = tid >> 6;
            const LAS _Float16* src = (const LAS _Float16*)(L + CA_AB) + (tq * 8) * 384 + k;
            float kk[8], w[8], bb[8], kp[8], rr[8], vv[8];
#pragma unroll
            for (int e = 0; e < 8; ++e) { kk[e] = (float)src[e * 384]; w[e] = 1.f + (float)src[e * 384 + 64]; bb[e] = -(float)src[e * 384 + 128];
                kp[e] = (float)src[e * 384 + 192]; rr[e] = (float)src[e * 384 + 256]; vv[e] = (float)src[e * 384 + 320]; }
            float g[8]; g[0] = w[0];
#pragma unroll
            for (int e = 1; e < 8; ++e) g[e] = g[e - 1] * w[e];
            LAS float* scr = (LAS float*)(L + CA_SCR);
            scr[tq * 64 + k] = g[7];
            __syncthreads();
            {
                const int idn = id + (int)gridDim.x;
                if (idn < 12 * NCK) { const int bhn = idn / NCK, cn = idn - bhn * NCK; const unsigned char* bn_ = a.ws + WS_RW + ((size_t)bhn * LPADDED + (size_t)cn * CK) * 768;
#pragma unroll
                    for (int q6 = 0; q6 < 6; ++q6) pre6[q6] = *(const u32x4*)(bn_ + (size_t)(tid + q6 * NTHR) * 16); }
            }
            float pre = 1.f, tot = 1.f;
#pragma unroll
            for (int q = 0; q < 8; ++q) { const float s = scr[q * 64 + k]; if (q < tq) pre *= s; tot *= s; }
            if (tq == 0) ((LAS float*)(L + CA_G64))[k] = tot;
            unsigned bh4[4], kh4[4], vm4[4];
            float Gp = pre;
#pragma unroll
            for (int e = 0; e < 8; ++e) {
                const int t = tq * 8 + e; const float G = pre * g[e], iG = __builtin_amdgcn_rcpf(G);
                const float kap = kk[e] * Gp, bet = bb[e] * iG, chi = kp[e] * iG, rho = rr[e] * G;
                const int o = swz(t, k >> 3) + (k & 7) * 2;
                *(LAS unsigned short*)(L + CA_KAP + o) = f2bf(kap); *(LAS unsigned short*)(L + CA_BET + o) = f2bf(bet);
                *(LAS unsigned short*)(L + CA_CHI + o) = f2bf(chi); *(LAS unsigned short*)(L + CA_RHO + o) = f2bf(rho);
                ((LAS float*)(L + CA_RHS))[t * 128 + k] = kap;
                const float bhv = bet * tot, khv = chi * tot;
                if (e & 1) { bh4[e >> 1] |= (unsigned)f2bf(bhv) << 16; kh4[e >> 1] |= (unsigned)f2bf(khv) << 16; vm4[e >> 1] |= (unsigned)f2bf(vv[e]) << 16; }
                else { bh4[e >> 1] = f2bf(bhv); kh4[e >> 1] = f2bf(khv); vm4[e >> 1] = f2bf(vv[e]); }
                Gp = G;
            }
            *(LAS u32x4*)(L + CA_BHT + swz(k, tq)) = (u32x4){bh4[0], bh4[1], bh4[2], bh4[3]};
            *(LAS u32x4*)(L + CA_KHT + swz(k, tq)) = (u32x4){kh4[0], kh4[1], kh4[2], kh4[3]};
            *(LAS u32x4*)(L + CA_VMT + swz(k, tq)) = (u32x4){vm4[0], vm4[1], vm4[2], vm4[3]};
        }
        __syncthreads();
        CK_FRESH();
        if (!dry || (CA_STAGES & 2)) {
            const int p = wave & 3, nb = wave >> 2;
            LAS unsigned char* Am = L + ((p & 1) ? CA_CHI : CA_BET);
            LAS unsigned char* Bm = L + ((p & 2) ? CA_RHO : CA_KAP);
#pragma unroll
            for (int mb = 0; mb < 2; ++mb) {
                f32x16 acc = f32x16{};
                if (!(mb == 1 && nb == 0)) ck_mm(acc, Am, Bm, mb * 32, nb * 32, r32, hi);
                const int t = nb * 32 + r32;
#pragma unroll
                for (int i = 0; i < 16; ++i) { const int j = mb * 32 + crow(i, hi); const bool keep = (p & 2) ? (j <= t) : (j < t); if (!keep) acc[i] = 0.f; }
                if (p == 0) {
#pragma unroll
                    for (int gq = 0; gq < 4; ++gq) { LAS float* ab_ = (LAS float*)(L + CA_AB) + t * 64 + (mb * 8 + 2 * gq + hi);
                        ab_[0] = acc[4 * gq]; ab_[16] = acc[4 * gq + 1]; ab_[32] = acc[4 * gq + 2]; ab_[48] = acc[4 * gq + 3]; }
                } else ck_store_t(L + (p == 1 ? CA_AK : p == 2 ? CA_RB : CA_RK), acc, mb * 32, nb * 32, r32, hi);
            }
        }
        __syncthreads();
        CK_FRESH();
        if (wave < 4 && (!dry || (CA_STAGES & 2))) {
            const int mb = wave >> 1, nb = wave & 1;
            f32x16 acc = f32x16{};
            ck_mm(acc, L + CA_AK, L + CA_VMT, mb * 32, nb * 32, r32, hi);
#pragma unroll
            for (int i = 0; i < 16; ++i) ((LAS float*)(L + CA_RHS))[(mb * 32 + crow(i, hi)) * 128 + 64 + nb * 32 + r32] = acc[i];
        }
        __syncthreads();
        CK_FRESH();
        if (!dry || (CA_STAGES & 4)) {
            const int col = tid >> 2, p = tid & 3;
            unsigned abv = (unsigned)(uintptr_t)(L + CA_AB) + p * 64; asm volatile("" : "+v"(abv));
            const LAS float* ab = (const LAS float*)(uintptr_t)abv;
            const LAS float* rhs = (const LAS float*)(L + CA_RHS) + col;
            float xo[16];
#pragma unroll
            for (int i = 0; i < 16; ++i) xo[i] = 0.f;
#pragma unroll
            for (int tg = 0; tg < 64; tg += 4) {
                f32x4 av[4][4]; float rv[4];
#pragma unroll
                for (int r = 0; r < 4; ++r) { rv[r] = rhs[(tg + r) * 128];
#pragma unroll
                    for (int i4 = 0; i4 < (tg + r + 15) / 16; ++i4) av[r][i4] = *(const LAS f32x4*)(ab + (tg + r) * 64 + 4 * i4); }
#pragma unroll
                for (int r = 0; r < 4; ++r) { const int t = tg + r;
                    float s0 = (p == 0) ? rv[r] : 0.f, s1 = 0.f;
#pragma unroll
                    for (int i4 = 0; i4 < (t + 15) / 16; ++i4) {
                        s0 -= av[r][i4].x * xo[4 * i4]; s1 -= av[r][i4].y * xo[4 * i4 + 1]; s0 -= av[r][i4].z * xo[4 * i4 + 2]; s1 -= av[r][i4].w * xo[4 * i4 + 3]; }
                    float sx = s0 + s1;
                    sx += dpp_f<0xB1>(sx);
                    sx += dpp_f<0x4E>(sx);
                    if ((t & 3) == p) xo[t >> 2] = sx;
                    asm volatile("" : "+v"(xo[t >> 2]));
                }
                __builtin_amdgcn_sched_barrier(0);
            }
            LAS unsigned char* dst = L + (col < 64 ? CA_KAP : CA_BET);
            const int rowc = col & 63;
#pragma unroll
            for (int i = 0; i < 16; ++i) { const int tt = 4 * i + p; *(LAS unsigned short*)(dst + swz(rowc, tt >> 3) + (tt & 7) * 2) = f2bf(-xo[i]); }
        }
        __syncthreads();
        CK_FRESH();
        if (!dry || (CA_STAGES & 8)) {
            const int ty = wave >> 1;
            LAS unsigned char* nW1 = L + CA_KAP; LAS unsigned char* nW2 = L + CA_BET;
#pragma unroll
            for (int qq = 0; qq < 2; ++qq) {
                const int q = (wave & 1) * 2 + qq, qa = q >> 1, qb = q & 1;
                f32x16 acc = f32x16{};
                if (ty == 0) {
                    const int t = qa * 32 + r32;
#pragma unroll
                    for (int gq = 0; gq < 4; ++gq) { const u32x2 rv = *(const LAS u32x2*)(L + CA_RHO + swz(t, qb * 4 + gq) + hi * 8);
                        acc[4 * gq] = bf_lo(rv.x); acc[4 * gq + 1] = bf_hi(rv.x); acc[4 * gq + 2] = bf_lo(rv.y); acc[4 * gq + 3] = bf_hi(rv.y); }
                    ck_mm(acc, nW1, L + CA_RB, qb * 32, qa * 32, r32, hi);
                } else if (ty == 1) {
                    ck_mm(acc, nW1, L + CA_BHT, qb * 32, qa * 32, r32, hi);
                    if (qa == qb) { const float g64 = ((const LAS float*)(L + CA_G64))[qa * 32 + r32];
#pragma unroll
                        for (int i = 0; i < 16; ++i) if (crow(i, hi) == r32) acc[i] += g64; }
                } else if (ty == 2) {
                    ck_mm(acc, L + CA_KHT, L + CA_VMT, qb * 32, qa * 32, r32, hi);
                    ck_mm(acc, L + CA_BHT, nW2, qb * 32, qa * 32, r32, hi);
                } else {
                    ck_mm(acc, L + CA_RK, L + CA_VMT, qb * 32, qa * 32, r32, hi);
                    ck_mm(acc, L + CA_RB, nW2, qb * 32, qa * 32, r32, hi);
                }
                if (dry) { float sink = acc[0] + acc[5] + acc[10] + acc[15]; asm volatile("" :: "v"(sink)); }
                else if (ty < 2) {
                    unsigned char* o = blk + (ty == 0 ? 8192 : 0) + (size_t)(((qa * 2 + qb) * 2) * 1024) + lane * 16;
#pragma unroll
                    for (int ks = 0; ks < 2; ++ks)
                        *(u32x4*)(o + ks * 1024) = (u32x4){pk2(acc[8 * ks], acc[8 * ks + 1]), pk2(acc[8 * ks + 2], acc[8 * ks + 3]), pk2(acc[8 * ks + 4], acc[8 * ks + 5]), pk2(acc[8 * ks + 6], acc[8 * ks + 7])};
                } else if (ty == 2) {
                    unsigned char* o = blk + 16384 + (qa * 2 + qb) * 4096 + lane * 16;
#pragma unroll
                    for (int g = 0; g < 4; ++g) *(f32x4*)(o + g * 1024) = (f32x4){acc[4 * g], acc[4 * g + 1], acc[4 * g + 2], acc[4 * g + 3]};
                } else {
                    unsigned char* o = blk + 32768 + (qa * 2 + qb) * 2048 + lane * 8;
#pragma unroll
                    for (int g = 0; g < 4; ++g) *(u32x2*)(o + g * 512) = (u32x2){pk2(acc[4 * g], acc[4 * g + 1]), pk2(acc[4 * g + 2], acc[4 * g + 3])};
                }
            }
        }
        __syncthreads();
    }
}

__device__ __forceinline__ void rwkv_chunkB(const ArgsL& a, Frame& F, int bh) {
    const int lane = F.lane, wave = F.wave, r32 = lane & 31, hi = lane >> 5;
    const int b = bh / RW_H, h = bh % RW_H;
    LAS unsigned char* L = F.lds;
    const unsigned char* base = a.ws + WS_RW + (size_t)bh * LPADDED * 768;
    bf16_t* y0 = (bf16_t*)(a.ws + WS_YCAT);
    const bool isld = (wave & 2) != 0; const int lw = (wave & 1) + ((wave >> 2) << 1);
    LAS unsigned char* yimg0 = L + 3 * CKB; LAS unsigned char* yimg1 = L + MISC_OFF + 8192;
#define CB_ISSUE(cc) do { const unsigned char* s_ = base + (size_t)(cc) * CK * 768 + (size_t)lw * 1024 + lane * 16; LAS unsigned char* d_ = L + ((cc) % 3) * CKB + lw * 1024; \
        _Pragma("unroll") for (int r_ = 0; r_ < 10; ++r_) __builtin_amdgcn_global_load_lds((const unsigned*)(s_ + r_ * 4096), (LAS unsigned*)(d_ + r_ * 4096), 16, 0, 0); } while (0)
#define CB_YOUT(cc) do { const LAS unsigned char* im_ = ((cc) & 1) ? yimg1 : yimg0; \
        _Pragma("unroll") for (int r_ = 0; r_ < 8; ++r_) { const int t_ = r_ * 8 + (lane >> 3), l_ = (cc) * CK + t_; const u32x4 v_ = *(const LAS u32x4*)(im_ + t_ * 128 + (lane & 7) * 16); \
            if (l_ < LTOK) *(u32x4*)(y0 + (size_t)(b * T + PADR + l_) * RW_W + h * 64 + (lane & 7) * 8) = v_; } } while (0)
    if (isld) { CB_ISSUE(0); CB_ISSUE(1); asm volatile("s_waitcnt vmcnt(10)" ::: "memory"); }
    asm volatile("s_waitcnt lgkmcnt(0)\n\ts_barrier" ::: "memory");
    f32x16 Z0 = f32x16{}, Z1 = f32x16{};
    for (int c = 0; c < NCK; ++c) {
        if (isld) {
            if (wave == 6 && c > 0) CB_YOUT(c - 1);
            if (c + 2 < NCK) CB_ISSUE(c + 2);
            if (c + 2 < NCK) asm volatile("s_waitcnt vmcnt(10)" ::: "memory"); else asm volatile("s_waitcnt vmcnt(0)" ::: "memory");
        } else if (wave < 2) {
            const LAS unsigned char* S = L + (c % 3) * CKB;
            LAS unsigned char* yim = (c & 1) ? yimg1 : yimg0;
            const int vb = wave;
            bf16x8 zf[2][2];
#pragma unroll
            for (int ks = 0; ks < 2; ++ks) {
                zf[0][ks] = __builtin_bit_cast(bf16x8, (u32x4){pk2(Z0[8 * ks], Z0[8 * ks + 1]), pk2(Z0[8 * ks + 2], Z0[8 * ks + 3]), pk2(Z0[8 * ks + 4], Z0[8 * ks + 5]), pk2(Z0[8 * ks + 6], Z0[8 * ks + 7])});
                zf[1][ks] = __builtin_bit_cast(bf16x8, (u32x4){pk2(Z1[8 * ks], Z1[8 * ks + 1]), pk2(Z1[8 * ks + 2], Z1[8 * ks + 3]), pk2(Z1[8 * ks + 4], Z1[8 * ks + 5]), pk2(Z1[8 * ks + 6], Z1[8 * ks + 7])});
            }
#pragma unroll
            for (int tb = 0; tb < 2; ++tb) {
                f32x16 acc;
                const LAS unsigned char* yt = S + 32768 + (vb * 2 + tb) * 2048 + lane * 8;
#pragma unroll
                for (int g = 0; g < 4; ++g) { const u32x2 w = *(const LAS u32x2*)(yt + g * 512); acc[4 * g] = bf_lo(w.x); acc[4 * g + 1] = bf_hi(w.x); acc[4 * g + 2] = bf_lo(w.y); acc[4 * g + 3] = bf_hi(w.y); }
#pragma unroll
                for (int kb2 = 0; kb2 < 2; ++kb2)
#pragma unroll
                    for (int ks = 0; ks < 2; ++ks) { const bf16x8 pa = *(const LAS bf16x8*)(S + 8192 + ((tb * 2 + kb2) * 2 + ks) * 1024 + lane * 16);
                        acc = __builtin_amdgcn_mfma_f32_32x32x16_bf16(pa, zf[kb2][ks], acc, 0, 0, 0); }
#pragma unroll
                for (int i = 0; i < 16; ++i) *(LAS unsigned short*)(yim + (tb * 32 + crow(i, hi)) * 128 + (vb * 32 + r32) * 2) = f2bf(acc[i]);
            }
            f32x16 N0, N1;
            { const LAS unsigned char* n0 = S + 16384 + (vb * 2 + 0) * 4096 + lane * 16; const LAS unsigned char* n1 = S + 16384 + (vb * 2 + 1) * 4096 + lane * 16;
#pragma unroll
              for (int g = 0; g < 4; ++g) { const f32x4 u0 = *(const LAS f32x4*)(n0 + g * 1024), u1 = *(const LAS f32x4*)(n1 + g * 1024);
                  N0[4 * g] = u0.x; N0[4 * g + 1] = u0.y; N0[4 * g + 2] = u0.z; N0[4 * g + 3] = u0.w; N1[4 * g] = u1.x; N1[4 * g + 1] = u1.y; N1[4 * g + 2] = u1.z; N1[4 * g + 3] = u1.w; } }
#pragma unroll
            for (int kb2 = 0; kb2 < 2; ++kb2)
#pragma unroll
                for (int ks = 0; ks < 2; ++ks) {
                    const bf16x8 m0 = *(const LAS bf16x8*)(S + ((0 * 2 + kb2) * 2 + ks) * 1024 + lane * 16);
                    const bf16x8 m1 = *(const LAS bf16x8*)(S + ((1 * 2 + kb2) * 2 + ks) * 1024 + lane * 16);
                    N0 = __builtin_amdgcn_mfma_f32_32x32x16_bf16(m0, zf[kb2][ks], N0, 0, 0, 0);
                    N1 = __builtin_amdgcn_mfma_f32_32x32x16_bf16(m1, zf[kb2][ks], N1, 0, 0, 0);
                }
            Z0 = N0; Z1 = N1;
        }
        asm volatile("s_waitcnt lgkmcnt(0)\n\ts_barrier" ::: "memory");
    }
    if (wave == 6) CB_YOUT(NCK - 1);
    asm volatile("s_waitcnt vmcnt(0) lgkmcnt(0)\n\ts_barrier" ::: "memory");
#undef CB_ISSUE
#undef CB_YOUT
}

constexpr int N_FX_UNITS = 65 * 10, N_SB_UNITS = 65 * 10, N_RW_WG = 192;
#ifndef REP_SCAN
#define REP_SCAN 1
#endif
#ifndef REP_SCAN_DRY
#define REP_SCAN_DRY 0
#endif
#ifndef REP_FOX
#define REP_FOX 1
#endif
#ifndef REP_SB
#define REP_SB 1
#endif
__device__ __forceinline__ void phase_mix(const ArgsL& a, Frame& F, int layer) {
#ifdef SEQ_SCAN
    if (F.bx < N_RW_WG) { int nr = REP_SCAN; asm volatile("" : "+s"(nr)); for (int r = 0; r < nr; ++r) rwkv_scan(a, F, F.bx, (r + 1 < nr) ? REP_SCAN_DRY : 0); }
#else
#ifndef REP_CHB
#define REP_CHB 1
#endif
    if (F.bx < 12) { int nr = REP_CHB; asm volatile("" : "+s"(nr)); for (int r = 0; r < nr; ++r) rwkv_chunkB(a, F, F.bx); }
#endif
    float gqm = fabsf(a.in(I_QG)[layer * 64 + F.lane]), gkm = fabsf(a.in(I_KG)[layer * 64 + F.lane]);
#pragma unroll
    for (int off = 1; off < 64; off <<= 1) { gqm = fmaxf(gqm, __shfl_xor(gqm, off)); gkm = fmaxf(gkm, __shfl_xor(gkm, off)); }
    const float bound = 64.0f * C2 * gqm * gkm * 1.02f + 0.5f;
    unsigned* head = (unsigned*)(a.ws + WS_CTL) + CW_QUEUE + 64 * layer;
    for (;;) {
        if (F.tid == 0) F.MISC[16] = __hip_atomic_fetch_add(head, 1u, __ATOMIC_RELAXED, __HIP_MEMORY_SCOPE_AGENT);
        __syncthreads();
        const int u = (int)F.MISC[16];
        __syncthreads();
        if (u >= N_FX_UNITS + N_SB_UNITS) break;
        if (u < N_FX_UNITS) { const int qb = 64 - u / 10, bh = u % 10; int nr = REP_FOX; asm volatile("" : "+s"(nr)); for (int r = 0; r < nr; ++r) attn_unit<0>(a, F, bh / FX_H, bh % FX_H, qb, bound); }
        else { const int v = u - N_FX_UNITS; const int qb = 64 - v / 10, bh = v % 10; int nr = REP_SB; asm volatile("" : "+s"(nr)); for (int r = 0; r < nr; ++r) attn_unit<1>(a, F, bh / SB_H, bh % SB_H, qb, bound); }
    }
}

__device__ __forceinline__ void phase_post(const ArgsL& a, Frame& F, int layer, const bool dry = false) {
    const int gw = F.bx * NWAVES + F.wave, NGW = gridDim.x * NWAVES, lane = F.lane;
    bf16_t* Y0 = (bf16_t*)(a.ws + WS_YCAT); const bf16_t* BN = (const bf16_t*)(a.ws + WS_BN);
    float lg[6], lb[6];
    { const float* g = a.in(I_LNG) + layer * RW_W + lane; const float* bb = a.in(I_LNB) + layer * RW_W + lane;
#pragma unroll
      for (int hh = 0; hh < 6; ++hh) { lg[hh] = g[hh * 64]; lb[hh] = bb[hh * 64]; } }
    unsigned short yv[6], bv[6], yn[6], bn[6];
    int m = gw;
    if (m < M) {
#pragma unroll
        for (int hh = 0; hh < 6; ++hh) { yv[hh] = Y0[(size_t)m * RW_W + hh * 64 + lane]; bv[hh] = BN[(size_t)m * RW_W + hh * 64 + lane]; }
    }
    for (; m < M; m += NGW) {
        const int mn = m + NGW;
        if (mn < M) {
#pragma unroll
            for (int hh = 0; hh < 6; ++hh) { yn[hh] = Y0[(size_t)mn * RW_W + hh * 64 + lane]; bn[hh] = BN[(size_t)mn * RW_W + hh * 64 + lane]; }
        }
        const int b = m / T, p = m - b * T;
        bf16_t* yp = Y0 + (size_t)m * RW_W + lane;
        if (p < PADR) {
            if (!dry) {
#pragma unroll
            for (int hh = 0; hh < 6; ++hh) yp[hh * 64] = 0; }
        } else {
#pragma unroll
            for (int hh = 0; hh < 6; ++hh) {
                const float y = bf2f(yv[hh]);
                const float mean = wave_sum(y) * (1.f / 64.f);
                const float d = y - mean;
                const float var = wave_sum(d * d) * (1.f / 64.f);
                const unsigned short r_ = f2bf(d * (1.0f / sqrtf(var + 64e-5f)) * lg[hh] + lb[hh] + bf2f(bv[hh])); if (!dry) yp[hh * 64] = r_; else asm volatile("" :: "v"(r_));
            }
        }
#pragma unroll
        for (int hh = 0; hh < 6; ++hh) { yv[hh] = yn[hh]; bv[hh] = bn[hh]; }
    }
    if (!dry) for (int it = gw; it < 2 * M; it += NGW) {
        const int sl = it / M, m2 = it - sl * M; const int b = m2 / T, p = m2 - b * T;
        bf16_t* row = Y0 + (size_t)(sl + 1) * M * RW_W + (size_t)m2 * RW_W;
        if (p < PADR) { for (int c = lane; c < RW_W / 2; c += 64) ((unsigned*)row)[c] = 0u; }
        else if (lane < 32) ((unsigned*)(row + 320))[lane] = 0u;
    }
}

struct EpiInproj { static constexpr bool PERM = true, AFTER_DRAIN = false; bf16_t* ush; bf16_t* qkv;
    __device__ __forceinline__ void operator()(const f32x4 (&acc)[2][2][4][2], const pg8::Unit& u, int wr, int wc, int fr, int fq) const {
        asm volatile("" : "+v"(fr), "+v"(fq));
        const int row0 = u.pm * 256 + wr * 64 + fr, colt = u.pn * 256 + wc * 32 + 8 * fq;
#pragma unroll
        for (int ai = 0; ai < 2; ++ai)
#pragma unroll
            for (int m = 0; m < 4; ++m) { const size_t row = (size_t)(row0 + ai * 128 + m * 16);
#pragma unroll
                for (int bj = 0; bj < 2; ++bj) { const int col = colt + bj * 128; const f32x4 v0 = acc[ai][bj][m][0], v1 = acc[ai][bj][m][1];
                    const float sc = (col >= SHIFT_W && col < SHIFT_W + 320) ? C2 : 1.0f;
                    u32x4 w; w.x = pk2(v0[0] * sc, v0[1] * sc); w.y = pk2(v0[2] * sc, v0[3] * sc); w.z = pk2(v1[0] * sc, v1[1] * sc); w.w = pk2(v1[2] * sc, v1[3] * sc);
                    if (col < SHIFT_W) *(u32x4*)(ush + row * SHIFT_W + col) = w;
                    else if (col < SHIFT_W + QKV_W) *(u32x4*)(qkv + row * QKV_W + (col - SHIFT_W)) = w; } }
    }
};
struct EpiGates { static constexpr bool PERM = true, AFTER_DRAIN = false; bf16_t* gates;
    __device__ __forceinline__ void operator()(const f32x4 (&acc)[2][2][4][2], const pg8::Unit& u, int wr, int wc, int fr, int fq) const {
        asm volatile("" : "+v"(fr), "+v"(fq));
        const int row0 = u.pm * 256 + wr * 64 + fr, colt = u.pn * 256 + wc * 32 + 8 * fq;
#pragma unroll
        for (int ai = 0; ai < 2; ++ai)
#pragma unroll
            for (int m = 0; m < 4; ++m) { const size_t row = (size_t)(row0 + ai * 128 + m * 16);
#pragma unroll
                for (int bj = 0; bj < 2; ++bj) { const int col = colt + bj * 128; f32x4 v0 = acc[ai][bj][m][0], v1 = acc[ai][bj][m][1];
#pragma unroll
                    for (int q = 0; q < 4; ++q) { v0[q] = __builtin_amdgcn_rcpf(1.f + __builtin_amdgcn_exp2f(-v0[q] * LOG2E)); v1[q] = __builtin_amdgcn_rcpf(1.f + __builtin_amdgcn_exp2f(-v1[q] * LOG2E)); }
                    u32x4 w; w.x = pk2(v0[0], v0[1]); w.y = pk2(v0[2], v0[3]); w.z = pk2(v1[0], v1[1]); w.w = pk2(v1[2], v1[3]);
                    *(u32x4*)(gates + row * 3072 + col) = w; } }
    }
};
struct EpiMerge { static constexpr bool PERM = true, AFTER_DRAIN = false; const bf16_t* gates; bf16_t* merged;
    __device__ __forceinline__ void operator()(const f32x4 (&acc)[2][2][4][2], const pg8::Unit& u, int wr, int wc, int fr, int fq) const {
        asm volatile("" : "+v"(fr), "+v"(fq));
        const int br = u.pn >> 2, pn = u.pn & 3, pm = u.pm - br * 129;
        const int row0 = pm * 256 + wr * 64 + fr, colt = pn * 256 + wc * 32 + 8 * fq;
        u32x4 gn[2], on[2];
#define MRG_LOAD(q) do { const size_t row_ = (size_t)(row0 + ((q) >> 2) * 128 + ((q) & 3) * 16); \
            _Pragma("unroll") for (int bj = 0; bj < 2; ++bj) { const int col_ = colt + bj * 128; gn[bj] = *(const u32x4*)(gates + row_ * 3072 + br * 1024 + col_); \
                on[bj] = (u32x4){0u, 0u, 0u, 0u}; if (br > 0) on[bj] = *(const u32x4*)(merged + row_ * D + col_); } } while (0)
        MRG_LOAD(0);
#pragma unroll
        for (int q = 0; q < 8; ++q) {
            const int ai = q >> 2, m = q & 3; const size_t row = (size_t)(row0 + ai * 128 + m * 16);
            u32x4 g[2], o[2];
#pragma unroll
            for (int bj = 0; bj < 2; ++bj) { g[bj] = gn[bj]; o[bj] = on[bj]; }
            if (q < 7) MRG_LOAD(q + 1);
#pragma unroll
            for (int bj = 0; bj < 2; ++bj) { const int col = colt + bj * 128; const f32x4 v0 = acc[ai][bj][m][0], v1 = acc[ai][bj][m][1];
                u32x4 w;
                w.x = pk2(bf_lo(g[bj].x) * v0[0] + bf_lo(o[bj].x), bf_hi(g[bj].x) * v0[1] + bf_hi(o[bj].x));
                w.y = pk2(bf_lo(g[bj].y) * v0[2] + bf_lo(o[bj].y), bf_hi(g[bj].y) * v0[3] + bf_hi(o[bj].y));
                w.z = pk2(bf_lo(g[bj].z) * v1[0] + bf_lo(o[bj].z), bf_hi(g[bj].z) * v1[1] + bf_hi(o[bj].z));
                w.w = pk2(bf_lo(g[bj].w) * v1[2] + bf_lo(o[bj].w), bf_hi(g[bj].w) * v1[3] + bf_hi(o[bj].w));
                *(u32x4*)(merged + row * D + col) = w; }
            __builtin_amdgcn_sched_barrier(0);
        }
#undef MRG_LOAD
    }
};
struct MergeOrder { int G, c, ntau;
    __device__ __forceinline__ bool next(int i, pg8::Unit& u) const { const int it = i / 3, br = i - 3 * it; const long tau = (long)it * G + c; if (tau >= ntau) return false;
        const int t = (int)(tau % 516); u.pm = br * 129 + (t >> 2); u.pn = br * 4 + (t & 3); return true; }
    __device__ __forceinline__ void a_ready(const pg8::Unit&) const {}
    __device__ __forceinline__ void done(const pg8::Unit&) const {}
};
struct EpiOut { static constexpr bool PERM = true, AFTER_DRAIN = false; bf16_t* hb;
    __device__ __forceinline__ void operator()(const f32x4 (&acc)[2][2][4][2], const pg8::Unit& u, int wr, int wc, int fr, int fq) const {
        asm volatile("" : "+v"(fr), "+v"(fq));
        const int row0 = u.pm * 256 + wr * 64 + fr, colt = u.pn * 256 + wc * 32 + 8 * fq;
        u32x4 hn[2];
#define OUT_LOAD(q) do { const bf16_t* p_ = hb + (size_t)(row0 + ((q) >> 2) * 128 + ((q) & 3) * 16) * D + colt; hn[0] = *(const u32x4*)(p_); hn[1] = *(const u32x4*)(p_ + 128); } while (0)
        OUT_LOAD(0);
#pragma unroll
        for (int q = 0; q < 8; ++q) {
            const int ai = q >> 2, m = q & 3;
            bf16_t* hp = hb + (size_t)(row0 + ai * 128 + m * 16) * D + colt; const u32x4 h0 = hn[0], h1 = hn[1];
            if (q < 7) OUT_LOAD(q + 1);
#pragma unroll
            for (int bj = 0; bj < 2; ++bj) { const u32x4 hh = bj ? h1 : h0; const f32x4 v0 = acc[ai][bj][m][0], v1 = acc[ai][bj][m][1];
                u32x4 w; w.x = pk2(bf_lo(hh.x) + v0[0], bf_hi(hh.x) + v0[1]); w.y = pk2(bf_lo(hh.y) + v0[2], bf_hi(hh.y) + v0[3]);
                w.z = pk2(bf_lo(hh.z) + v1[0], bf_hi(hh.z) + v1[1]); w.w = pk2(bf_lo(hh.w) + v1[2], bf_hi(hh.w) + v1[3]);
                *(u32x4*)(hp + bj * 128) = w; }
            __builtin_amdgcn_sched_barrier(0);
        }
#undef OUT_LOAD
    }
};
struct MoeOrder { const volatile LAS int* tb; int ntile, npt, G, c, rep;
    __device__ __forceinline__ bool next(int i, pg8::Unit& u) const { long L = (long)i * G + c; if (L >= (long)ntile * npt * rep) return false; L %= (long)ntile * npt;
        const int tau = (int)(L / npt), j = (int)(L - (long)tau * npt); int e = 0;
#pragma unroll
        for (int k = 1; k < 16; ++k) e += (tau >= tb[k]) ? 1 : 0;
        u.pm = tau; u.pn = __builtin_amdgcn_readfirstlane(e) * npt + j; return true; }
    __device__ __forceinline__ void a_ready(const pg8::Unit&) const {}
    __device__ __forceinline__ void done(const pg8::Unit&) const {}
};
struct EpiMoeUp { static constexpr bool PERM = true, AFTER_DRAIN = false; bf16_t* hs;
    __device__ __forceinline__ void operator()(const f32x4 (&acc)[2][2][4][2], const pg8::Unit& u, int wr, int wc, int fr, int fq) const {
        asm volatile("" : "+v"(fr), "+v"(fq));
        const int row0 = u.pm * 256 + wr * 64 + fr, col = (u.pn & 1) * 128 + wc * 32 + 8 * fq;
#pragma unroll
        for (int ai = 0; ai < 2; ++ai)
#pragma unroll
            for (int m = 0; m < 4; ++m) { const size_t row = (size_t)(row0 + ai * 128 + m * 16); float r[8];
#pragma unroll
                for (int n = 0; n < 2; ++n)
#pragma unroll
                    for (int q = 0; q < 4; ++q) { const float gte = acc[ai][0][m][n][q], up = acc[ai][1][m][n][q]; r[4 * n + q] = gte * __builtin_amdgcn_rcpf(1.f + __builtin_amdgcn_exp2f(-gte * LOG2E)) * up; }
                u32x4 w; w.x = pk2(r[0], r[1]); w.y = pk2(r[2], r[3]); w.z = pk2(r[4], r[5]); w.w = pk2(r[6], r[7]);
                *(u32x4*)(hs + row * DEXP + col) = w; }
    }
};
struct EpiMoeDown { static constexpr bool PERM = true, AFTER_DRAIN = false; bf16_t* y; const float* cws;
    __device__ __forceinline__ void operator()(const f32x4 (&acc)[2][2][4][2], const pg8::Unit& u, int wr, int wc, int fr, int fq) const {
        asm volatile("" : "+v"(fr), "+v"(fq));
        const int row0 = u.pm * 256 + wr * 64 + fr, colt = (u.pn & 3) * 256 + wc * 32 + 8 * fq;
        float cw[8];
#pragma unroll
        for (int q = 0; q < 8; ++q) cw[q] = cws[row0 + (q >> 2) * 128 + (q & 3) * 16];
#pragma unroll
        for (int ai = 0; ai < 2; ++ai)
#pragma unroll
            for (int m = 0; m < 4; ++m) { const size_t row = (size_t)(row0 + ai * 128 + m * 16); const float cwv = cw[ai * 4 + m];
#pragma unroll
                for (int bj = 0; bj < 2; ++bj) { const int col = colt + bj * 128; const f32x4 v0 = acc[ai][bj][m][0] * cwv, v1 = acc[ai][bj][m][1] * cwv;
                    u32x4 w; w.x = pk2(v0[0], v0[1]); w.y = pk2(v0[2], v0[3]); w.z = pk2(v1[0], v1[1]); w.w = pk2(v1[2], v1[3]);
                    *(u32x4*)(y + row * D + col) = w; } }
    }
};


#ifndef PH_MASK
#define PH_MASK 0xFFFF
#endif
#define PH(k) ((PH_MASK >> (k)) & 1)
#ifndef PROBE_DUP
#define PROBE_DUP 0
#endif
#define DUPN(bit) (((PROBE_DUP >> (bit)) & 1) ? 2 : 1)
#ifndef PROBE_THIN
#define PROBE_THIN 0
#endif
#define THIN(bit) ((PROBE_THIN >> (bit)) & 1)
#define FRESH() do { asm volatile("" : "+v"(F.tid)); F.lane = F.tid & 63; F.wave = __builtin_amdgcn_readfirstlane(F.tid >> 6); { int bx_ = (int)blockIdx.x; asm volatile("" : "+s"(bx_)); F.bx = bx_; } { unsigned char* w_ = a.ws; asm volatile("" : "+s"(w_)); a.ws = w_; } } while (0)
__global__ void __launch_bounds__(NTHR, 2) hybrid_fwd(Args ka) {
    extern __shared__ __attribute__((aligned(16))) unsigned char lds_raw[];
    Frame F;
    F.lds = (LAS unsigned char*)lds_raw;
    F.MISC = (volatile LAS unsigned*)(F.lds + MISC_OFF);
    F.tid = threadIdx.x; F.lane = F.tid & 63; F.wave = __builtin_amdgcn_readfirstlane(F.tid >> 6); F.bx = (int)blockIdx.x;
    for (int u = F.tid; u < (LDS_BYTES - MISC_OFF) / 4; u += NTHR) ((LAS unsigned*)(F.lds + MISC_OFF))[u] = 0u;
    __syncthreads();
    if (F.tid < 29) { const unsigned long long p = (unsigned long long)ka.in[F.tid]; F.MISC[64 + 2 * F.tid] = (unsigned)p; F.MISC[65 + 2 * F.tid] = (unsigned)(p >> 32); }
    __syncthreads();
    ArgsL a; a.tab = F.MISC + 64; a.out = ka.out; a.ws = ka.ws;
    XcdBarrier bar = xcd_barrier_post((unsigned*)(a.ws + WS_CTL) + CW_BAR, F.MISC + 8);
    const int G = (int)gridDim.x, c = (int)blockIdx.x;
    PG8_LAS unsigned char* ring = (PG8_LAS unsigned char*)F.lds;

#ifdef PROF_K
    volatile LAS unsigned* tsl = F.MISC + 1536; int nts = 0;
    if (blockIdx.x == 0 && F.tid == 0) tsl[nts] = (unsigned)__builtin_amdgcn_s_memrealtime();
    ++nts;
#define BARX() do { xcd_barrier(bar); if (blockIdx.x == 0 && F.tid == 0) tsl[nts] = (unsigned)__builtin_amdgcn_s_memrealtime(); ++nts; } while (0)
#else
#define BARX() xcd_barrier(bar)
#endif
    for (int layer = 0; layer < DEPTH; ++layer) {
        for (int rep = 0; rep < DUPN(8); ++rep) { FRESH(); if (PH(0)) phase_wconv(a, F, layer); }
        __syncthreads();
        if (THIN(0)) { FRESH(); phase_norm<1>(a, F, layer, true); }
        FRESH(); if (PH(1)) phase_norm<1>(a, F, layer);
        BARX();
        FRESH(); if (PH(2)) {
            pg8::Gemm g{(const bf16_t*)A_PTR(a), (const bf16_t*)(a.ws + WS_WIN), M, N1, D}; pg8::StaticOrder S; S.init(M, N1, G, c, DUPN(3));
            EpiInproj E{(bf16_t*)(a.ws + WS_USH), (bf16_t*)(a.ws + WS_QKV)};
            pg8::gemm_phase<EpiInproj, pg8::StaticOrder, true, true>(ring, g, S, E);
        }
        BARX();
        if (THIN(1)) { FRESH(); phase_prep(a, F, layer, true); }
        FRESH(); if (PH(3)) phase_prep(a, F, layer);
        BARX();
#ifndef SEQ_SCAN
        if (THIN(2)) { FRESH(); phase_chunkA(a, F, true); }
        FRESH(); if (PH(4)) phase_chunkA(a, F);
        BARX();
#endif
        FRESH(); if (PH(4)) phase_mix(a, F, layer);
        BARX();
        if (THIN(3)) { FRESH(); phase_post(a, F, layer, true); }
        FRESH(); if (PH(5)) phase_post(a, F, layer);
        FRESH(); if (PH(6)) {
            pg8::Gemm g{(const bf16_t*)A_PTR(a), (const bf16_t*)(a.ws + WS_WG), M, 3072, D}; pg8::StaticOrder S; S.init(M, 3072, G, c, DUPN(4));
            EpiGates E{(bf16_t*)(a.ws + WS_GATES)};
            pg8::gemm_phase<EpiGates, pg8::StaticOrder, true, true>(ring, g, S, E);
        }
        BARX();
        FRESH(); if (PH(7)) {
            int kdim = RW_W; asm volatile("" : "+s"(kdim));
            pg8::Gemm g{(const bf16_t*)(a.ws + WS_YCAT), (const bf16_t*)(a.ws + WS_WP), 3 * M, 3072, kdim}; MergeOrder S{G, c, 516 * DUPN(5)};
            EpiMerge E{(const bf16_t*)(a.ws + WS_GATES), (bf16_t*)(a.ws + WS_MERGED)};
            pg8::gemm_phase<EpiMerge, MergeOrder, false, true>(ring, g, S, E);
        }
        BARX();
        FRESH(); if (PH(8)) {
            pg8::Gemm g{(const bf16_t*)(a.ws + WS_MERGED), (const bf16_t*)(a.ws + WS_WO), M, D, D}; pg8::StaticOrder S; S.init(M, D, G, c, 1);
            EpiOut E{HB_PTR(a)};
            pg8::gemm_phase<EpiOut, pg8::StaticOrder, true, true>(ring, g, S, E);
        }
        BARX();
        if (THIN(4)) { FRESH(); phase_norm2(a, F, layer, true); }
        FRESH(); if (PH(9)) phase_norm2(a, F, layer);
        BARX();
        for (int rep = 0; rep < DUPN(7); ++rep) { FRESH(); if (PH(10)) phase_route(a, F, layer); }
        BARX();
        volatile LAS int* tb = (volatile LAS int*)(F.MISC + 32);
        if (F.tid <= 16) { const int* cnt = (const int*)(a.ws + WS_CTL) + CW_ECNT + 64 * layer; int t = 0;
            for (int e = 0; e < F.tid; ++e) t += (__hip_atomic_load(cnt + e, __ATOMIC_RELAXED, __HIP_MEMORY_SCOPE_AGENT) + 255) >> 8;
            tb[F.tid] = t; }
        __syncthreads();
        const int ntile = tb[16];
        FRESH(); if (PH(11)) {
            pg8::Gemm g{(const bf16_t*)(a.ws + WS_AS), (const bf16_t*)(a.ws + WS_WGU), MS, 8192, D}; MoeOrder S{tb, ntile, 2, G, c, DUPN(6)};
            EpiMoeUp E{(bf16_t*)(a.ws + WS_HS)};
            pg8::gemm_phase<EpiMoeUp, MoeOrder, true, true>(ring, g, S, E);
        }
        BARX();
        FRESH(); if (PH(12)) {
            int kdim = DEXP; asm volatile("" : "+s"(kdim));
            pg8::Gemm g{(const bf16_t*)(a.ws + WS_HS), (const bf16_t*)(a.ws + WS_WD), MS, 16384, kdim}; MoeOrder S{tb, ntile, 4, G, c, DUPN(6)};
            EpiMoeDown E{(bf16_t*)(a.ws + WS_Y), (const float*)(a.ws + WS_CWS)};
            pg8::gemm_phase<EpiMoeDown, MoeOrder, true, true>(ring, g, S, E);
        }
        BARX();
    }
    if (THIN(5)) { FRESH(); phase_norm<0>(a, F, DEPTH - 1, true); }
    FRESH(); if (PH(13)) phase_norm<0>(a, F, DEPTH - 1);
#ifdef PROF_K
    BARX();
    if (blockIdx.x == 0) {
        __syncthreads();
        float us;
        if (PROF_K < 0) us = 100.f;
        else if (PROF_K == 12) us = (float)(tsl[25] - tsl[24]) * 0.01f;
        else if (PROF_K == 13) us = (float)(tsl[25] - tsl[0]) * 0.01f;
        else us = ((float)(tsl[1 + PROF_K] - tsl[PROF_K]) + (float)(tsl[13 + PROF_K] - tsl[12 + PROF_K])) * 0.01f;
        us = 4.f * rintf(us * 0.25f);
        for (int i = F.tid; i < 16384; i += NTHR) a.out[i] = us;
    }
#endif
#ifdef CLOCK_PROBE
    if (blockIdx.x == 0 && F.wave == 0) {
        float c0 = 1.f, c1 = 2.f, c2 = 3.f, c3 = 4.f, c4 = 5.f, c5 = 6.f, c6 = 7.f, c7 = 8.f;
        for (int i = 0; i < CLOCK_PROBE; ++i) {
            asm volatile("v_fma_f32 %0, %0, %0, %0\n\tv_fma_f32 %1, %1, %1, %1\n\tv_fma_f32 %2, %2, %2, %2\n\tv_fma_f32 %3, %3, %3, %3\n\tv_fma_f32 %4, %4, %4, %4\n\tv_fma_f32 %5, %5, %5, %5\n\tv_fma_f32 %6, %6, %6, %6\n\tv_fma_f32 %7, %7, %7, %7"
                         : "+v"(c0), "+v"(c1), "+v"(c2), "+v"(c3), "+v"(c4), "+v"(c5), "+v"(c6), "+v"(c7));
        }
        asm volatile("" :: "v"(c0), "v"(c1), "v"(c2), "v"(c3), "v"(c4), "v"(c5), "v"(c6), "v"(c7));
    }
#endif
}

extern "C" void kernel_launch(void* const* d_in, const int* in_sizes, int n_in, void* d_out, int out_size, void* d_ws, size_t ws_size, hipStream_t stream) {
    static int ready = 0;
    if (ready == 0) {
        if (n_in != 29 || out_size != NB * SEQ * D || ws_size < WS_END) { fprintf(stderr, "kernel_launch: unexpected problem shape (n_in %d, out %d, ws %zu < %zu)\n", n_in, out_size, ws_size, (size_t)WS_END); ready = -1; return; }
        if (hipFuncSetAttribute((const void*)hybrid_fwd, hipFuncAttributeMaxDynamicSharedMemorySize, LDS_BYTES) != hipSuccess) { fprintf(stderr, "kernel_launch: hipFuncSetAttribute failed\n"); ready = -1; return; }
        int per_cu = 0;
        if (hipOccupancyMaxActiveBlocksPerMultiprocessor(&per_cu, (const void*)hybrid_fwd, NTHR, LDS_BYTES) != hipSuccess || per_cu < 1) fprintf(stderr, "kernel_launch: occupancy query says %d\n", per_cu);
        (void)hipGetLastError();
        ready = 1;
    }
    if (ready < 0) return;
    (void)in_sizes;
    if (hipMemsetAsync((char*)d_ws + WS_CTL, 0, CTL_ZERO_BYTES, stream) != hipSuccess) return;
    Args a{};
    for (int i = 0; i < 29; ++i) a.in[i] = (const float*)d_in[i];
    a.out = (float*)d_out; a.ws = (unsigned char*)d_ws;
    hipLaunchKernelGGL(hybrid_fwd, dim3(256), dim3(NTHR), LDS_BYTES, stream, a);
}
```

```cpp
#include <hip/hip_runtime.h>
#include <hip/hip_bf16.h>
#include <cstdio>
#include <cstdint>

#define GAS __attribute__((address_space(1)))
#define LAS __attribute__((address_space(3)))

namespace pg8 {
#define PG8_LAS __attribute__((address_space(3)))
typedef unsigned short bf16_t;
typedef short bf16x8 __attribute__((ext_vector_type(8)));
typedef float f32x4 __attribute__((ext_vector_type(4)));
typedef unsigned u32x4 __attribute__((ext_vector_type(4)));
constexpr int BM = 256, BK = 64, HALF = 128, HTB = HALF * BK * 2  , STAGE_BYTES = 8 * HTB, NXCD = 8, WGM = 8;

__host__ __device__ __forceinline__ int lds_byte(int r, int c) { const int st = (r >> 4) * 2 + (c >> 5), rr = r & 15, cc = c & 31, ob = rr * 64 + cc * 2; return st * 1024 + (ob ^ (((ob >> 9) & 1) << 5)); }
__host__ __device__ __forceinline__ void stage_rc(int b, int& R, int& C) { const int st = b / 1024, sb = b % 1024, swz = sb ^ (((sb >> 9) & 1) << 5); R = (st >> 1) * 16 + swz / 64; C = (st & 1) * 32 + (swz % 64) / 2; }
__host__ __device__ __forceinline__ int perm32(int rho) { const int n = rho >> 4, i = rho & 15; return 8 * (i >> 2) + 4 * n + (i & 3); }

struct Unit { int pm, pn; };
struct Gemm { const bf16_t* A; const bf16_t* Bt; int M, N, K; };

struct StaticOrder {
    int nM, nN, nwg, G, c, rep;
    __host__ __device__ void init(int M, int N, int G_, int c_, int rep_ = 1) { nM = M / BM; nN = N / BM; nwg = nM * nN; G = G_; c = c_; rep = rep_; }
    __host__ __device__ bool next(int i, Unit& u) const {
        const long L = (long)i * G + c; if (L >= (long)nwg * rep) return false;
        int wgid = (int)(L % nwg); { const int q = nwg / NXCD, r = nwg % NXCD, xcd = wgid % NXCD, off = wgid / NXCD; wgid = (xcd < r ? xcd * (q + 1) : r * (q + 1) + (xcd - r) * q) + off; }
        const int nig = WGM * nN, gid = wgid / nig, fm = gid * WGM, gsz = (nM - fm) < WGM ? (nM - fm) : WGM;
        u.pm = fm + ((wgid % nig) % gsz); u.pn = (wgid % nig) / gsz; return true;
    }
    __device__ __forceinline__ void a_ready(const Unit&) const {}
    __device__ __forceinline__ void done(const Unit&) const {}
};
__device__ __forceinline__ unsigned cvt_pk_bf16(float lo, float hi) { unsigned r; asm volatile("v_cvt_pk_bf16_f32 %0, %1, %2" : "=v"(r) : "v"(lo), "v"(hi)); return r; }
template <class Epi, class Sched, bool ALIGN_EPI = false, bool SP2 = false>
__device__ __forceinline__ void gemm_phase(PG8_LAS unsigned char* lds, const Gemm g, const Sched& S, const Epi& E) {
    int tid_ = threadIdx.x; asm volatile("" : "+v"(tid_));
    const int tid = tid_, wid = __builtin_amdgcn_readfirstlane(tid >> 6), lane = tid & 63, wr = wid >> 2, wc = wid & 3, fr = lane & 15, fq = lane >> 4;
    const int K = g.K, nt = K / BK;
    unsigned voffA[2], voffB[2];
#pragma unroll
    for (int i = 0; i < 2; ++i) { int R, C; stage_rc(tid * 16 + i * 8192, R, C); const int Rb = Epi::PERM ? ((R & ~31) + perm32(R & 31)) : R;
        voffA[i] = (unsigned)(R * K + C) * 2u; voffB[i] = (unsigned)(Rb * K + C) * 2u; }
    const size_t kstep = (size_t)(BK * 2);
    const size_t hstep = (size_t)HALF * K * 2;
    const size_t tstep = 2 * hstep;
    const unsigned ldsw = (unsigned)wid * 1024u;
    const int aoff = lds_byte(wr * 64 + fr, fq * 8), boff = lds_byte(wc * 32 + fr, fq * 8);
#define PG8_SA(b, h) (((b) * 2 + (h)) * HTB)
#define PG8_SB(b, h) ((4 + (b) * 2 + (h)) * HTB)
#define PG8_STAGE(bufoff, gbase, voff) do { _Pragma("unroll") for (int _i = 0; _i < 2; ++_i) \
        __builtin_amdgcn_global_load_lds((const unsigned*)((const char*)(gbase) + (voff)[_i]), (PG8_LAS unsigned*)(lds + (bufoff) + ldsw + _i * 8192), 16, 0, 0); } while (0)
#define PG8_LDA(dst, b, h) do { _Pragma("unroll") for (int m = 0; m < 4; ++m) _Pragma("unroll") for (int k = 0; k < 2; ++k) dst[m][k] = *(const PG8_LAS bf16x8*)(lds + PG8_SA(b, h) + aoff + m * 2048 + k * 1024); } while (0)
#define PG8_LDB(dst, b, h) do { _Pragma("unroll") for (int n = 0; n < 2; ++n) _Pragma("unroll") for (int k = 0; k < 2; ++k) dst[n][k] = *(const PG8_LAS bf16x8*)(lds + PG8_SB(b, h) + boff + n * 2048 + k * 1024); } while (0)
#define PG8_MMA(ai, bj, At, Bt) do { __builtin_amdgcn_s_setprio(1); _Pragma("unroll") for (int m = 0; m < 4; ++m) _Pragma("unroll") for (int n = 0; n < 2; ++n) _Pragma("unroll") for (int k = 0; k < 2; ++k) \
        acc[ai][bj][m][n] = __builtin_amdgcn_mfma_f32_16x16x32_bf16(Bt[n][k], At[m][k], acc[ai][bj][m][n], 0, 0, 0); __builtin_amdgcn_s_setprio(0); } while (0)
#define PG8_WAIT_V(n) asm volatile("s_waitcnt vmcnt(" #n ")" ::: "memory")
#define PG8_WAIT_L(n) asm volatile("s_waitcnt lgkmcnt(" #n ")" ::: "memory")
#define PG8_BAR __builtin_amdgcn_s_barrier()
#define PG8_SCHED __builtin_amdgcn_sched_barrier(0)
    Unit cur, nxt; int ui = 0;
    if (!S.next(0, cur)) return;
    f32x4 acc[2][2][4][2];
#pragma unroll
    for (int a = 0; a < 2; ++a)
#pragma unroll
        for (int b = 0; b < 2; ++b)
#pragma unroll
            for (int m = 0; m < 4; ++m)
#pragma unroll
                for (int n = 0; n < 2; ++n) acc[a][b][m][n] = (f32x4){0.f, 0.f, 0.f, 0.f};
    bf16x8 At[4][2], B0[2][2], B1[2][2];
    const char* cA = (const char*)g.A + (size_t)cur.pm * tstep; const char* cB = (const char*)g.Bt + (size_t)cur.pn * tstep;
    S.a_ready(cur);
    if constexpr (SP2) {
        PG8_STAGE(PG8_SB(0, 0), cB, voffB); PG8_STAGE(PG8_SB(0, 1), cB + hstep, voffB); PG8_STAGE(PG8_SA(0, 0), cA, voffA); PG8_STAGE(PG8_SA(0, 1), cA + hstep, voffA);
        if (wr == 1) PG8_BAR;
        PG8_WAIT_V(2); PG8_BAR;
        PG8_STAGE(PG8_SB(1, 0), cB + kstep, voffB); PG8_STAGE(PG8_SA(1, 0), cA + kstep, voffA); PG8_STAGE(PG8_SB(1, 1), cB + hstep + kstep, voffB);
        PG8_WAIT_V(6); PG8_BAR;
    } else {
        PG8_STAGE(PG8_SB(0, 0), cB, voffB); PG8_STAGE(PG8_SA(0, 0), cA, voffA); PG8_STAGE(PG8_SB(0, 1), cB + hstep, voffB); PG8_STAGE(PG8_SA(0, 1), cA + hstep, voffA);
        if (wr == 1) PG8_BAR;
        PG8_WAIT_V(4); PG8_BAR;
        PG8_STAGE(PG8_SB(1, 0), cB + kstep, voffB); PG8_STAGE(PG8_SA(1, 0), cA + kstep, voffA); PG8_STAGE(PG8_SB(1, 1), cB + hstep + kstep, voffB);
        PG8_WAIT_V(6); PG8_BAR;
    }
    for (;;) {
        const bool has_next = S.next(ui + 1, nxt);
        const char* nA = has_next ? (const char*)g.A + (size_t)nxt.pm * tstep : cA; const char* nB = has_next ? (const char*)g.Bt + (size_t)nxt.pn * tstep : cB;
        for (int t = 0; t < nt; t += 2) {
            const bool last = (t == nt - 2);
            const char* a1 = cA + (size_t)(t + 1) * kstep;
            const char* a2 = last ? nA : cA + (size_t)(t + 2) * kstep; const char* b2 = last ? nB : cB + (size_t)(t + 2) * kstep;
            const char* a3 = a2 + kstep; const char* b3 = b2 + kstep;
            if (last && has_next) S.a_ready(nxt);
            if constexpr (SP2) {
            PG8_LDB(B0, 0, 0); PG8_LDB(B1, 0, 1); PG8_SCHED; PG8_LDA(At, 0, 0); PG8_STAGE(PG8_SA(1, 1), a1 + hstep, voffA);
            PG8_WAIT_V(8); PG8_WAIT_L(0); PG8_BAR; PG8_MMA(0, 0, At, B0); PG8_MMA(0, 1, At, B1); PG8_BAR; PG8_SCHED;
            PG8_LDA(At, 0, 1); PG8_STAGE(PG8_SB(0, 0), b2, voffB); PG8_STAGE(PG8_SB(0, 1), b2 + hstep, voffB); PG8_STAGE(PG8_SA(0, 0), a2, voffA);
            PG8_WAIT_V(8); PG8_WAIT_L(0); PG8_BAR; PG8_MMA(1, 0, At, B0); PG8_MMA(1, 1, At, B1); PG8_BAR; PG8_SCHED;
            PG8_LDB(B0, 1, 0); PG8_LDB(B1, 1, 1); PG8_SCHED; PG8_LDA(At, 1, 0); PG8_STAGE(PG8_SA(0, 1), a2 + hstep, voffA);
            PG8_WAIT_V(8); PG8_WAIT_L(0); PG8_BAR; PG8_MMA(0, 0, At, B0); PG8_MMA(0, 1, At, B1); PG8_BAR; PG8_SCHED;
            PG8_LDA(At, 1, 1); PG8_STAGE(PG8_SB(1, 0), b3, voffB); PG8_STAGE(PG8_SB(1, 1), b3 + hstep, voffB); PG8_STAGE(PG8_SA(1, 0), a3, voffA);
            PG8_WAIT_V(8); PG8_WAIT_L(0); PG8_BAR; PG8_MMA(1, 0, At, B0); PG8_MMA(1, 1, At, B1); PG8_BAR; PG8_SCHED;
            } else {
            PG8_LDB(B0, 0, 0); PG8_SCHED; PG8_LDA(At, 0, 0); PG8_STAGE(PG8_SA(1, 1), a1 + hstep, voffA);
            PG8_WAIT_L(8); PG8_BAR; PG8_WAIT_L(0); PG8_MMA(0, 0, At, B0); PG8_BAR; PG8_SCHED;
            PG8_LDB(B1, 0, 1); PG8_STAGE(PG8_SB(0, 0), b2, voffB);
            PG8_BAR; PG8_WAIT_L(0); PG8_MMA(0, 1, At, B1); PG8_BAR;
            PG8_LDA(At, 0, 1); PG8_STAGE(PG8_SA(0, 0), a2, voffA);
            PG8_BAR; PG8_WAIT_L(0); PG8_MMA(1, 0, At, B0); PG8_BAR; PG8_SCHED;
            PG8_STAGE(PG8_SB(0, 1), b2 + hstep, voffB);
            PG8_WAIT_V(6); PG8_BAR; PG8_MMA(1, 1, At, B1); PG8_BAR;
            PG8_LDB(B0, 1, 0); PG8_SCHED; PG8_LDA(At, 1, 0); PG8_STAGE(PG8_SA(0, 1), a2 + hstep, voffA);
            PG8_WAIT_L(8); PG8_BAR; PG8_WAIT_L(0); PG8_MMA(0, 0, At, B0); PG8_BAR; PG8_SCHED;
            PG8_LDB(B1, 1, 1); PG8_STAGE(PG8_SB(1, 0), b3, voffB);
            PG8_BAR; PG8_WAIT_L(0); PG8_MMA(0, 1, At, B1); PG8_BAR;
            PG8_LDA(At, 1, 1); PG8_STAGE(PG8_SA(1, 0), a3, voffA);
            PG8_BAR; PG8_WAIT_L(0); PG8_MMA(1, 0, At, B0); PG8_BAR; PG8_SCHED;
            PG8_STAGE(PG8_SB(1, 1), b3 + hstep, voffB);
            PG8_WAIT_V(6); PG8_BAR; PG8_MMA(1, 1, At, B1); PG8_BAR;
            }
            if constexpr (Epi::MIDHOOK) { if (t + 2 == 6 || t + 2 == 12) E.mid(acc, cur, wr, wc, fr, fq, (t + 2) / 6); }
        }
        if constexpr (ALIGN_EPI) { if (wr == 0) PG8_BAR; }
        if constexpr (!Epi::AFTER_DRAIN) { E(acc, cur, wr, wc, fr, fq); S.done(cur); }
        if (!has_next) break;
#pragma unroll
        for (int a = 0; a < 2; ++a)
#pragma unroll
            for (int b = 0; b < 2; ++b)
#pragma unroll
                for (int m = 0; m < 4; ++m)
#pragma unroll
                    for (int n = 0; n < 2; ++n) acc[a][b][m][n] = (f32x4){0.f, 0.f, 0.f, 0.f};
        cur = nxt; cA = nA; cB = nB; ++ui;
        if constexpr (ALIGN_EPI) { if (wr == 1) PG8_BAR; }
    }
    PG8_WAIT_V(0);
    if constexpr (!ALIGN_EPI) { if (wr == 0) PG8_BAR; }
    PG8_BAR;
    if constexpr (Epi::AFTER_DRAIN) { E.fused(acc, cur, wr, wc, fr, fq, lds, wid, lane); S.done(cur); }
#undef PG8_SA
#undef PG8_SB
#undef PG8_STAGE
#undef PG8_LDA
#undef PG8_LDB
#undef PG8_MMA
#undef PG8_WAIT_V
#undef PG8_WAIT_L
#undef PG8_BAR
#undef PG8_SCHED
}
}

constexpr int D = 1024, NB = 2, SEQ = 16384, NMETA = 16, LTOK = SEQ + NMETA  , PADR = 112, T = PADR + LTOK  ;
constexpr int M = NB * T;
constexpr int DEPTH = 2, HD = 64, RW_H = 6, SB_H = 5, FX_H = 5, RW_W = 384, SHIFT_W = 1280, D_IN = 6277;
constexpr int YC_W = 1152;
constexpr int QKV_W = 1920;
constexpr int N1 = 3328;
constexpr int FCOL = 3200, GCOL = 3205;
constexpr int NEXP = 16, DEXP = 256;
constexpr int MS = 70144;
constexpr int LCH = 32, LPADDED = 16448;
constexpr int KBP = 16896;
constexpr float C2 = 0.125f * 1.4426950408889634f;
constexpr float LOG2E = 1.4426950408889634f;
constexpr int NWAVES = 8, NTHR = 512;

constexpr size_t MiB = 1u << 20;
constexpr size_t WS_CTL = 0, CTL_ZERO_BYTES = 65536;
constexpr size_t WS_HM = 1 * MiB;
constexpr size_t WS_LOGF = WS_HM + 131072;
constexpr size_t WS_KB2 = WS_LOGF + (size_t)M * 32;
constexpr size_t WS_TOK = WS_KB2 + (size_t)10 * KBP * 4;
constexpr size_t WS_SLOT = WS_TOK + (size_t)M * 32;
constexpr size_t WS_CWS = WS_SLOT + (size_t)M * 8;
constexpr size_t WS_WGCNT = WS_CWS + (size_t)MS * 4;
constexpr size_t WS_SMALL_END = WS_WGCNT + 256 * 16 * 4;
static_assert(WS_SMALL_END <= 8 * MiB, "small buffers");
constexpr size_t WS_WIN = 8 * MiB;
constexpr size_t WS_WG = WS_WIN + (size_t)N1 * 1024 * 2;
constexpr size_t WS_WP = WS_WG + (size_t)3072 * 1024 * 2;
constexpr size_t WS_WO = WS_WP + (size_t)3072 * 384 * 2;
constexpr size_t WS_WGU = WS_WO + (size_t)1024 * 1024 * 2;
constexpr size_t WS_WD = WS_WGU + (size_t)8192 * 1024 * 2;
constexpr size_t WS_W_END = WS_WD + (size_t)16384 * 256 * 2;
static_assert(WS_W_END <= 49 * MiB, "weights");
constexpr size_t WS_HB = 49 * MiB;
constexpr size_t WS_BIG = 115 * MiB;
constexpr size_t WS_USH = WS_BIG;
constexpr size_t WS_YCAT = WS_BIG;
constexpr size_t WS_QKV = WS_BIG + 82 * MiB;
constexpr size_t WS_RW = WS_BIG + 204 * MiB;
constexpr size_t WS_BN = WS_BIG + 349 * MiB;
constexpr size_t WS_GATES = WS_BIG + 82 * MiB;
constexpr size_t WS_MERGED = WS_BIG + 276 * MiB;
constexpr size_t WS_AS = WS_BIG;
constexpr size_t WS_HS = WS_BIG + 137 * MiB;
constexpr size_t WS_Y = WS_BIG + 172 * MiB;
constexpr size_t WS_END = WS_BIG + 374 * MiB;
static_assert((size_t)(M + 256) * 1280 * 2 <= 82 * MiB && (size_t)3 * M * 384 * 2 <= 82 * MiB && (size_t)(M + 256) * 1920 * 2 <= 122 * MiB, "big map 1");
static_assert((size_t)12 * LPADDED * 768 <= 145 * MiB && (size_t)M * 384 * 2 <= 25 * MiB && (size_t)M * 3072 * 2 <= 194 * MiB && (size_t)M * 2048 <= 65 * MiB, "big map 2");
static_assert((size_t)MS * 2048 <= 137 * MiB && (size_t)MS * 512 <= 35 * MiB && WS_END <= 489 * MiB, "big map 3");

constexpr int CW_BAR = 0;
constexpr int CW_QUEUE = 4096;
constexpr int CW_ECNT = 4352;
static_assert((CW_ECNT + 128) * 4 <= (int)CTL_ZERO_BYTES, "ctl");

constexpr int RING_BYTES = 131072, MISC_OFF = RING_BYTES, LDS_BYTES = 147456;

typedef unsigned short bf16_t;
typedef float f32x4 __attribute__((ext_vector_type(4)));
typedef float f32x2 __attribute__((ext_vector_type(2)));
typedef float f32x16 __attribute__((ext_vector_type(16)));
typedef unsigned u32x4 __attribute__((ext_vector_type(4)));
typedef unsigned u32x2 __attribute__((ext_vector_type(2)));
typedef short bf16x8 __attribute__((ext_vector_type(8)));
typedef short s16x4 __attribute__((ext_vector_type(4)));
typedef _Float16 f16x4 __attribute__((ext_vector_type(4)));
typedef __bf16 bf16x2_t __attribute__((ext_vector_type(2)));

__device__ __forceinline__ unsigned pk2(float lo, float hi) { f32x2 v = {lo, hi}; bf16x2_t b = __builtin_convertvector(v, bf16x2_t); return __builtin_bit_cast(unsigned, b); }
__device__ __forceinline__ unsigned short f2bf(float f) { return (unsigned short)(pk2(f, 0.f) & 0xffffu); }
__device__ __forceinline__ float bf_lo(unsigned u) { return __uint_as_float(u << 16); }
__device__ __forceinline__ float bf_hi(unsigned u) { return __uint_as_float(u & 0xffff0000u); }
__device__ __forceinline__ float bf2f(unsigned short h) { return __uint_as_float((unsigned)h << 16); }
template <int CTRL> __device__ __forceinline__ float dpp_f(float x) { return __int_as_float(__builtin_amdgcn_update_dpp(0, __float_as_int(x), CTRL, 0xF, 0xF, false)); }
__device__ __forceinline__ float allred16(float p) { p += dpp_f<0x128>(p); p += dpp_f<0x124>(p); p += dpp_f<0x122>(p); p += dpp_f<0x121>(p); return p; }
__device__ __forceinline__ float wave_sum(float v) {
    v = allred16(v);
    { auto sw = __builtin_amdgcn_permlane16_swap(__float_as_uint(v), __float_as_uint(v), false, false); v = __uint_as_float(sw[0]) + __uint_as_float(sw[1]); }
    { auto sw = __builtin_amdgcn_permlane32_swap(__float_as_uint(v), __float_as_uint(v), false, false); v = __uint_as_float(sw[0]) + __uint_as_float(sw[1]); }
    return v;
}
__device__ __forceinline__ float fast_exp(float x) { return __builtin_amdgcn_exp2f(x * LOG2E); }
__device__ __forceinline__ float fast_log(float x) { return __builtin_amdgcn_logf(x) * 0.6931471805599453f; }
__device__ __forceinline__ float softplus_f(float z) { return fmaxf(z, 0.f) + fast_log(1.f + fast_exp(-fabsf(z))); }

#define XB_TMO      128
#define XB_XCNT(j)  (256  + 64 * (j))
#define XB_XSUB(j)  (1280 + 64 * (j))
#define XB_XGEN(j)  (2304 + 64 * (j))
#define XB_TOP      3328
#define XB_TOPGEN   3392
#define XCD_BAR_WORDS 3456
#define XB_SPIN_CAP (1u << 20)
__device__ __forceinline__ unsigned xb_ld(unsigned* p)              { return __hip_atomic_load(p, __ATOMIC_RELAXED, __HIP_MEMORY_SCOPE_AGENT); }
__device__ __forceinline__ unsigned xb_add(unsigned* p, unsigned v) { return __hip_atomic_fetch_add(p, v, __ATOMIC_RELAXED, __HIP_MEMORY_SCOPE_AGENT); }
__device__ __forceinline__ unsigned xb_xcc_id() { return (unsigned)__builtin_amdgcn_s_getreg((3 << 11) | 20) & 0xFu; }
#define XB_SPIN(cond, bar) do { unsigned _sp = 0; while (cond) { __builtin_amdgcn_s_sleep(1); \
    if ((++_sp & 255u) == 0u) { if (xb_ld(&(bar)[XB_TMO])) break; if (_sp > XB_SPIN_CAP) { atomicAdd(&(bar)[XB_TMO], 1u); break; } } } } while (0)

struct XcdBarrier {
    unsigned* bar; unsigned x;
    volatile LAS unsigned* st;
};

__device__ __forceinline__ XcdBarrier xcd_barrier_post(unsigned* bar, volatile LAS unsigned* st) {
    XcdBarrier b; b.bar = bar; b.x = xb_xcc_id(); b.st = st;
    if (threadIdx.x == 0) (void)xb_add(&bar[XB_XCNT(b.x)], 1u);
    return b;
}
__device__ __forceinline__ void xcd_barrier_complete(unsigned* bar, unsigned x, unsigned& nloc, unsigned& nx) {
    const unsigned G = gridDim.x * gridDim.y * gridDim.z;
    unsigned sum, cnt, mine, sp = 0u;
    for (;;) {
        sum = 0u; cnt = 0u; mine = 0u;
#pragma unroll
        for (unsigned j = 0; j < 16; ++j) { const unsigned c = xb_ld(&bar[XB_XCNT(j)]); sum += c; cnt += (c > 0u) ? 1u : 0u; mine = (j == x) ? c : mine; }
        if (sum == G) break;
        __builtin_amdgcn_s_sleep(1);
        if ((++sp & 255u) == 0u) { if (xb_ld(&bar[XB_TMO])) break; if (sp > XB_SPIN_CAP) { atomicAdd(&bar[XB_TMO], 1u); break; } }
    }
    nloc = mine > 0u ? mine : 1u; nx = cnt > 0u ? cnt : 1u;
}

__device__ __forceinline__ void xcd_barrier(const XcdBarrier& b) {
    asm volatile("s_waitcnt vmcnt(0)" ::: "memory");
    __syncthreads();
    if (threadIdx.x == 0) {
        unsigned* bar = b.bar;
        __builtin_amdgcn_s_waitcnt(0);
        unsigned nloc = b.st[0], nx = b.st[1];
        if (nloc == 0u) { xcd_barrier_complete(bar, b.x, nloc, nx); b.st[0] = nloc; b.st[1] = nx; }
        const unsigned old = xb_add(&bar[XB_XSUB(b.x)], 1u);
        const unsigned gen = old / nloc;
        if (old + 1u == (gen + 1u) * nloc) {
            __builtin_amdgcn_fence(__ATOMIC_RELEASE, "agent");
            asm volatile("s_waitcnt vmcnt(0)" ::: "memory");
            const unsigned og = xb_add(&bar[XB_TOP], 1u);
            const unsigned tg = og / nx;
            if (og + 1u == (tg + 1u) * nx) xb_add(&bar[XB_TOPGEN], 1u);
            else XB_SPIN(xb_ld(&bar[XB_TOPGEN]) == tg, bar);
            __builtin_amdgcn_fence(__ATOMIC_ACQUIRE, "agent");
            xb_add(&bar[XB_XGEN(b.x)], 1u);
            asm volatile("s_waitcnt vmcnt(0)" ::: "memory");
        } else {
            XB_SPIN(xb_ld(&bar[XB_XGEN(b.x)]) == gen, bar);
            __builtin_amdgcn_fence(__ATOMIC_ACQUIRE, "agent");
            asm volatile("s_waitcnt vmcnt(0)" ::: "memory");
        }
    }
    __syncthreads();
}

struct Args { const float* in[29]; float* out; unsigned char* ws; };
enum { I_X = 0, I_META, I_N1G, I_WIN, I_MU, I_WUP, I_W0, I_AUP, I_A0, I_KK, I_KA, I_RK, I_LNG, I_LNB, I_FB, I_QG, I_KG, I_WPR, I_WPS, I_WPF, I_WOUT, I_N2G, I_MWG, I_MBG, I_MWE, I_MBE, I_MGATE, I_MUP, I_MDOWN };
struct ArgsL { volatile LAS unsigned* tab; float* out; unsigned char* ws;
    __device__ __forceinline__ const float* in(int i) const { const unsigned lo = tab[2 * i], hi = tab[2 * i + 1];
        return (const float*)(((unsigned long long)(unsigned)__builtin_amdgcn_readfirstlane((int)hi) << 32) | (unsigned long long)(unsigned)__builtin_amdgcn_readfirstlane((int)lo)); }
};
struct Frame { LAS unsigned char* lds; volatile LAS unsigned* MISC; int tid, lane, wave, bx; };

__device__ __forceinline__ float* hrow(const ArgsL& a, int b, int l) {
    return l < NMETA ? (float*)(a.ws + WS_HM) + (size_t)(b * NMETA + l) * D : a.out + ((size_t)b * SEQ + (l - NMETA)) * D;
}
#define LDS_WAIT() asm volatile("s_waitcnt lgkmcnt(0)" ::: "memory")
#define HB_PTR(a) ((bf16_t*)((a).ws + WS_HB))
#define A_PTR(a) ((bf16_t*)((a).out))

__device__ __forceinline__ void tr_item(const float* W, int ldw, int sc0, int nvalid, int k0, int kvalid, bf16_t* WT, int Kd, int r0, LAS float* scr, int lane) {
    float tv[32];
#pragma unroll
    for (int i = 0; i < 32; ++i) { const int kk = 2 * i + (lane >> 5), n = lane & 31; tv[i] = 0.f;
        if (n < nvalid && k0 + kk < kvalid) tv[i] = W[(size_t)(k0 + kk) * ldw + sc0 + n]; }
#pragma unroll
    for (int i = 0; i < 32; ++i) { const int kk = 2 * i + (lane >> 5), n = lane & 31; scr[kk * 33 + n] = tv[i]; }
    LDS_WAIT();
    const int c = lane & 7;
#pragma unroll
    for (int j = 0; j < 4; ++j) { const int n = (lane >> 3) + 8 * j; const LAS float* s = scr + (8 * c) * 33 + n;
        u32x4 o; o.x = pk2(s[0 * 33], s[1 * 33]); o.y = pk2(s[2 * 33], s[3 * 33]); o.z = pk2(s[4 * 33], s[5 * 33]); o.w = pk2(s[6 * 33], s[7 * 33]);
        *(u32x4*)(WT + (size_t)(r0 + n) * Kd + k0 + 8 * c) = o; }
    LDS_WAIT();
}
__device__ __forceinline__ void tr_item2(const float* W, int ldw, int sc0, int nvalid, int k0, int kvalid, bf16_t* WT, int Kd, int r0, int kd0, LAS float* scr, int lane) {
    float tv[32];
#pragma unroll
    for (int i = 0; i < 32; ++i) { const int kk = 2 * i + (lane >> 5), n = lane & 31; tv[i] = 0.f;
        if (n < nvalid && k0 + kk < kvalid) tv[i] = W[(size_t)(k0 + kk) * ldw + sc0 + n]; }
#pragma unroll
    for (int i = 0; i < 32; ++i) { const int kk = 2 * i + (lane >> 5), n = lane & 31; scr[kk * 33 + n] = tv[i]; }
    LDS_WAIT();
    const int c = lane & 7;
#pragma unroll
    for (int j = 0; j < 4; ++j) { const int n = (lane >> 3) + 8 * j; const LAS float* s = scr + (8 * c) * 33 + n;
        u32x4 o; o.x = pk2(s[0 * 33], s[1 * 33]); o.y = pk2(s[2 * 33], s[3 * 33]); o.z = pk2(s[4 * 33], s[5 * 33]); o.w = pk2(s[6 * 33], s[7 * 33]);
        *(u32x4*)(WT + (size_t)(r0 + n) * Kd + kd0 + 8 * c) = o; }
    LDS_WAIT();
}
__device__ __forceinline__ void phase_wconv(const ArgsL& a, Frame& F, int layer) {
    LAS float* scr = (LAS float*)(F.lds + F.wave * 8448);
    const int gw = F.bx * NWAVES + F.wave, NGW = gridDim.x * NWAVES;
    constexpr int C1 = 16 * 104, C2_ = C1 + 16 * 96, C3 = C2_ + 6 * 96, C4 = C3 + 16 * 32, C5 = C4 + 16 * 256, C6 = C5 + 4 * 512;
    unsigned char* ws = a.ws;
    for (int it = gw; it < C6; it += NGW) {
        if (it < C1) { const int kb = it / 104, nb = it % 104, r0 = nb * 32;
            tr_item(a.in(I_WIN) + (size_t)layer * D * D_IN, D_IN, r0, r0 < FCOL ? 32 : 0, kb * 64, 1024, (bf16_t*)(ws + WS_WIN), 1024, r0, scr, F.lane); }
        else if (it < C2_) { const int r = it - C1, kb = r / 96, nb = r % 96, r0 = nb * 32;
            tr_item(a.in(I_WIN) + (size_t)layer * D * D_IN, D_IN, GCOL + r0, 32, kb * 64, 1024, (bf16_t*)(ws + WS_WG), 1024, r0, scr, F.lane); }
        else if (it < C3) { const int r = it - C2_, kb = r / 32, nb = r % 32, r0 = nb * 32, br = kb / 6, k0 = (kb % 6) * 64;
            const float* W = (br == 0 ? a.in(I_WPR) + (size_t)layer * 384 * D : br == 1 ? a.in(I_WPS) + (size_t)layer * 320 * D : a.in(I_WPF) + (size_t)layer * 320 * D);
            tr_item2(W, D, r0, 32, k0, br == 0 ? 384 : 320, (bf16_t*)(ws + WS_WP), YC_W, r0, br * 384 + k0, scr, F.lane); }
        else if (it < C4) { const int r = it - C3, kb = r / 32, nb = r % 32, r0 = nb * 32;
            tr_item(a.in(I_WOUT) + (size_t)layer * D * D, D, r0, 32, kb * 64, 1024, (bf16_t*)(ws + WS_WO), 1024, r0, scr, F.lane); }
        else if (it < C5) { const int r = it - C4, kb = r / 256, nb = r % 256, r0 = nb * 32, e = r0 >> 9, rr = r0 & 511, j = rr >> 8, q = rr & 255;
            const float* W = (q >= 128 ? a.in(I_MUP) : a.in(I_MGATE)) + ((size_t)layer * NEXP + e) * D * DEXP;
            tr_item(W, DEXP, j * 128 + (q & 127), 32, kb * 64, 1024, (bf16_t*)(ws + WS_WGU), 1024, r0, scr, F.lane); }
        else { const int r = it - C5, kb = r / 512, nb = r % 512, r0 = nb * 32, e = r0 >> 10;
            tr_item(a.in(I_MDOWN) + ((size_t)layer * NEXP + e) * DEXP * D, D, r0 & 1023, 32, kb * 64, 256, (bf16_t*)(ws + WS_WD), 256, r0, scr, F.lane); }
    }
}

__device__ __forceinline__ void add_y_row(f32x4 (&v)[4], const bf16_t* Y, int slot, int lane) {
    const u32x2* y = (const u32x2*)(Y + (size_t)slot * D) + lane;
#pragma unroll
    for (int j = 0; j < 4; ++j) { const u32x2 t = y[64 * j]; v[j].x += bf_lo(t.x); v[j].y += bf_hi(t.x); v[j].z += bf_lo(t.y); v[j].w += bf_hi(t.y); }
}
template <int MODE>
__device__ __forceinline__ void phase_norm(const ArgsL& a, Frame& F, int layer, const bool dry = false) {
    const int lane = F.lane;
    LAS float* wl = (LAS float*)F.lds;
    LAS int* lcnt = (LAS int*)(F.lds + 20 * 4096);
    unsigned char* ws = a.ws;
    if (MODE == 1) {
        const float* win = a.in(I_WIN) + (size_t)layer * D * D_IN;
        for (int idx = F.tid; idx < 5 * 1024; idx += NTHR) { const int j = idx >> 10, k = idx & 1023; wl[j * 1024 + k] = win[(size_t)k * D_IN + FCOL + j]; }
    }
    if (MODE == 2) {
        const float* wg = a.in(I_MWG) + (size_t)layer * D * 4; const float* we = a.in(I_MWE) + (size_t)layer * D * 16;
        for (int i4 = F.tid; i4 < 1024; i4 += NTHR) { const f32x4 f = *(const f32x4*)(wg + 4 * i4); wl[i4] = f.x; wl[1024 + i4] = f.y; wl[2048 + i4] = f.z; wl[3072 + i4] = f.w; }
        for (int i4 = F.tid; i4 < 4096; i4 += NTHR) { const int k = i4 >> 2, c = i4 & 3; const f32x4 f = *(const f32x4*)(we + 4 * i4); LAS float* d = wl + (4 + 4 * c) * 1024 + k;
            d[0] = f.x; d[1024] = f.y; d[2048] = f.z; d[3072] = f.w; }
        if (F.tid < 16) lcnt[F.tid] = 0;
    }
    __syncthreads();
    const int gw = F.bx * NWAVES + F.wave, NGW = gridDim.x * NWAVES;
    const float* gsrc = (MODE == 2 ? a.in(I_N2G) : a.in(I_N1G)) + layer * D;
    f32x4 gv[4];
#pragma unroll
    for (int j = 0; j < 4; ++j) gv[j] = (MODE == 0) ? (f32x4){0.f, 0.f, 0.f, 0.f} : *(const f32x4*)(gsrc + 4 * lane + 256 * j);
    bf16_t* A = A_PTR(a); bf16_t* HB = HB_PTR(a);
    const bf16_t* Y = (const bf16_t*)(ws + WS_Y);
    const int* SLOT = (const int*)(ws + WS_SLOT);
    constexpr bool COMB0 = (MODE == 0);
    const bool comb = COMB0 || (MODE == 1 && layer > 0);
    f32x4 vn[4]; u32x2 yan[4], ybn[4];
#pragma unroll
    for (int j = 0; j < 4; ++j) { vn[j] = (f32x4){0.f, 0.f, 0.f, 0.f}; yan[j] = (u32x2){0u, 0u}; ybn[j] = (u32x2){0u, 0u}; }
#define NRM_VALID(mm) ((mm) < M && ((mm) % T) - PADR >= (MODE == 0 ? NMETA : 0))
#define NRM_LOAD(mm, s0_, s1_) do { if (NRM_VALID(mm)) { const int bb_ = (mm) / T, ll_ = (mm) - bb_ * T - PADR; \
        if (MODE == 1 && layer == 0) { const float* src_ = (ll_ < NMETA) ? a.in(I_META) + (size_t)ll_ * D : a.in(I_X) + ((size_t)bb_ * SEQ + (ll_ - NMETA)) * D; \
            _Pragma("unroll") for (int j = 0; j < 4; ++j) vn[j] = *(const f32x4*)(src_ + 4 * lane + 256 * j); } \
        else { const u32x2* hs_ = (const u32x2*)(HB + (size_t)(mm) * D) + lane; \
            _Pragma("unroll") for (int j = 0; j < 4; ++j) { const u32x2 t_ = hs_[64 * j]; vn[j] = (f32x4){bf_lo(t_.x), bf_hi(t_.x), bf_lo(t_.y), bf_hi(t_.y)}; } } \
        if (comb) { const u32x2* y0_ = (const u32x2*)(Y + (size_t)(s0_) * D) + lane; const u32x2* y1_ = (const u32x2*)(Y + (size_t)(s1_) * D) + lane; \
            _Pragma("unroll") for (int j = 0; j < 4; ++j) { yan[j] = y0_[64 * j]; ybn[j] = y1_[64 * j]; } } } } while (0)
    int sa1 = 0, sb1 = 0, sa2 = 0, sb2 = 0;
    if (comb) { if (NRM_VALID(gw)) { sa1 = SLOT[2 * gw]; sb1 = SLOT[2 * gw + 1]; } if (NRM_VALID(gw + NGW)) { sa2 = SLOT[2 * (gw + NGW)]; sb2 = SLOT[2 * (gw + NGW) + 1]; } }
    NRM_LOAD(gw, sa1, sb1);
    for (int m = gw; m < M; m += NGW) {
        f32x4 v[4]; u32x2 ya[4], yb[4];
#pragma unroll
        for (int j = 0; j < 4; ++j) { v[j] = vn[j]; ya[j] = yan[j]; yb[j] = ybn[j]; }
        int sa3 = 0, sb3 = 0;
        if (comb && NRM_VALID(m + 2 * NGW)) { sa3 = SLOT[2 * (m + 2 * NGW)]; sb3 = SLOT[2 * (m + 2 * NGW) + 1]; }
        NRM_LOAD(m + NGW, sa2, sb2);
        sa2 = sa3; sb2 = sb3;
        const int b = m / T, p = m - b * T, l = p - PADR;
        if (l < 0) {
            if (MODE == 1 && !dry) {
                u32x2* o = (u32x2*)(A + (size_t)m * D) + lane;
#pragma unroll
                for (int j = 0; j < 4; ++j) o[64 * j] = (u32x2){0u, 0u};
                if (lane < 8) ((float*)(ws + WS_LOGF))[(size_t)m * 8 + lane] = 0.f;
            }
            continue;
        }
        if (MODE == 0 && l < NMETA) continue;
        if (comb) {
#pragma unroll
            for (int j = 0; j < 4; ++j) { v[j].x += bf_lo(ya[j].x) + bf_lo(yb[j].x); v[j].y += bf_hi(ya[j].x) + bf_hi(yb[j].x); v[j].z += bf_lo(ya[j].y) + bf_lo(yb[j].y); v[j].w += bf_hi(ya[j].y) + bf_hi(yb[j].y); }
        }
        if (MODE == 0 && !dry) { float* op = a.out + ((size_t)b * SEQ + (l - NMETA)) * D;
#pragma unroll
            for (int j = 0; j < 4; ++j) *(f32x4*)(op + 4 * lane + 256 * j) = v[j]; }
        if (MODE == 1 && !dry) { u32x2* hd = (u32x2*)(HB + (size_t)m * D) + lane;
#pragma unroll
            for (int j = 0; j < 4; ++j) hd[64 * j] = (u32x2){pk2(v[j].x, v[j].y), pk2(v[j].z, v[j].w)};
        }
        if (MODE == 0) continue;
        float ss = 0.f;
#pragma unroll
        for (int j = 0; j < 4; ++j) ss += (v[j].x * v[j].x + v[j].y * v[j].y) + (v[j].z * v[j].z + v[j].w * v[j].w);
        const float r = 1.0f / sqrtf(wave_sum(ss) * (1.0f / D) + 1e-6f);
#pragma unroll
        for (int j = 0; j < 4; ++j) v[j] = v[j] * r * gv[j];
        u32x2* o = (u32x2*)(A + (size_t)m * D) + lane;
        if (!dry) {
#pragma unroll
        for (int j = 0; j < 4; ++j) o[64 * j] = (u32x2){pk2(v[j].x, v[j].y), pk2(v[j].z, v[j].w)}; }
        else { float sink = v[0].x + v[1].y + v[2].z + v[3].w; asm volatile("" :: "v"(sink)); }
        if (MODE == 1) {
            float dsum[5];
#pragma unroll
            for (int q = 0; q < 5; ++q) { float d = 0.f;
#pragma unroll
                for (int j = 0; j < 4; ++j) { const f32x4 w = *(const LAS f32x4*)(wl + q * 1024 + 4 * lane + 256 * j); d += (v[j].x * w.x + v[j].y * w.y) + (v[j].z * w.z + v[j].w * w.w); }
                dsum[q] = wave_sum(d); }
            float mine = dsum[0];
            mine = lane == 1 ? dsum[1] : mine; mine = lane == 2 ? dsum[2] : mine; mine = lane == 3 ? dsum[3] : mine; mine = lane == 4 ? dsum[4] : mine;
            if (lane < 8 && !dry) { float lf = 0.f;
                if (lane < 5) { const float xx = mine + a.in(I_FB)[layer * 5 + lane]; lf = fminf(xx, 0.f) - fast_log(1.f + fast_exp(-fabsf(xx))); }
                ((float*)(ws + WS_LOGF))[(size_t)m * 8 + lane] = lf; }
        }
        if (MODE == 2) {
            float dp[20];
#pragma unroll
            for (int q = 0; q < 20; ++q) { float d = 0.f;
#pragma unroll
                for (int j = 0; j < 4; ++j) { const f32x4 w = *(const LAS f32x4*)(wl + q * 1024 + 4 * lane + 256 * j); d += (v[j].x * w.x + v[j].y * w.y) + (v[j].z * w.z + v[j].w * w.w); }
                dp[q] = d; }
            float sA[10], sB[5];
#pragma unroll
            for (int i = 0; i < 10; ++i) { auto sw = __builtin_amdgcn_permlane32_swap(__float_as_uint(dp[2 * i]), __float_as_uint(dp[2 * i + 1]), false, false); sA[i] = __uint_as_float(sw[0]) + __uint_as_float(sw[1]); }
#pragma unroll
            for (int i = 0; i < 5; ++i) { auto sw = __builtin_amdgcn_permlane16_swap(__float_as_uint(sA[2 * i]), __float_as_uint(sA[2 * i + 1]), false, false); sB[i] = allred16(__uint_as_float(sw[0]) + __uint_as_float(sw[1])); }
            LAS float* red = (LAS float*)(F.lds + 81920 + 256) + F.wave * 32;
            { const int rho = lane >> 4, vsel = ((rho & 1) << 1) | (rho >> 1);
              if ((lane & 15) == 0) {
#pragma unroll
                  for (int i = 0; i < 5; ++i) red[4 * i + vsel] = sB[i]; } }
            LDS_WAIT();
            float ds[20];
#pragma unroll
            for (int i = 0; i < 5; ++i) { const f32x4 t4 = *(const LAS f32x4*)(red + 4 * i); ds[4 * i] = t4.x; ds[4 * i + 1] = t4.y; ds[4 * i + 2] = t4.z; ds[4 * i + 3] = t4.w; }
            LDS_WAIT();
            const float* bg = a.in(I_MBG) + layer * 4; const float* be = a.in(I_MBE) + layer * 16;
            float lg0 = ds[0] + bg[0], lg1 = ds[1] + bg[1], lg2 = ds[2] + bg[2], lg3 = ds[3] + bg[3];
            int g = 0; float mx = lg0;
            if (lg1 > mx) { mx = lg1; g = 1; } if (lg2 > mx) { mx = lg2; g = 2; } if (lg3 > mx) { mx = lg3; g = 3; }
            const float den = fast_exp(lg0 - mx) + fast_exp(lg1 - mx) + fast_exp(lg2 - mx) + fast_exp(lg3 - mx);
            const float pgrp = 1.0f / den;
            float s0 = g == 0 ? ds[4] : g == 1 ? ds[8] : g == 2 ? ds[12] : ds[16];
            float s1 = g == 0 ? ds[5] : g == 1 ? ds[9] : g == 2 ? ds[13] : ds[17];
            float s2 = g == 0 ? ds[6] : g == 1 ? ds[10] : g == 2 ? ds[14] : ds[18];
            float s3 = g == 0 ? ds[7] : g == 1 ? ds[11] : g == 2 ? ds[15] : ds[19];
            s0 += be[g * 4 + 0]; s1 += be[g * 4 + 1]; s2 += be[g * 4 + 2]; s3 += be[g * 4 + 3];
            int i0 = 0; float v0 = s0;
            if (s1 > v0) { v0 = s1; i0 = 1; } if (s2 > v0) { v0 = s2; i0 = 2; } if (s3 > v0) { v0 = s3; i0 = 3; }
            int i1 = -1; float v1 = -3.0e38f;
            if (i0 != 0 && s0 > v1) { v1 = s0; i1 = 0; } if (i0 != 1 && s1 > v1) { v1 = s1; i1 = 1; } if (i0 != 2 && s2 > v1) { v1 = s2; i1 = 2; } if (i0 != 3 && s3 > v1) { v1 = s3; i1 = 3; }
            const float e1 = fast_exp(v1 - v0), pt0 = 1.0f / (1.0f + e1), pt1 = e1 * pt0;
            if (dry) { float sink = pgrp * pt0 + pt1; asm volatile("" :: "v"(sink)); }
            if (lane == 0 && !dry) {
                const int ea = g * 4 + i0, eb = g * 4 + i1;
                const int la = atomicAdd((int*)&lcnt[ea], 1), lb = atomicAdd((int*)&lcnt[eb], 1);
                int* tk = (int*)(ws + WS_TOK) + (size_t)m * 8;
                tk[0] = ea; tk[1] = eb; tk[2] = __float_as_int(pgrp * pt0); tk[3] = __float_as_int(pgrp * pt1); tk[4] = la; tk[5] = lb;
            }
        }
    }
    __syncthreads();
#undef NRM_LOAD
#undef NRM_VALID
    if (MODE == 2 && F.tid < 16 && !dry) {
        const int c = lcnt[F.tid];
        ((int*)(ws + WS_WGCNT))[F.bx * 16 + F.tid] = c;
        atomicAdd((int*)(ws + WS_CTL) + CW_ECNT + 64 * layer + F.tid, c);
    }
    __syncthreads();
}

__device__ __forceinline__ void phase_norm2(const ArgsL& a, Frame& F, int layer, const bool dry = false) {
    const int lane = F.lane;
    LAS float* wl = (LAS float*)F.lds;
    LAS int* lcnt = (LAS int*)(F.lds + 20 * 4096);
    unsigned char* ws = a.ws;
    {
        const float* wg = a.in(I_MWG) + (size_t)layer * D * 4; const float* we = a.in(I_MWE) + (size_t)layer * D * 16;
        for (int i4 = F.tid; i4 < 1024; i4 += NTHR) { const f32x4 f = *(const f32x4*)(wg + 4 * i4); wl[i4] = f.x; wl[1024 + i4] = f.y; wl[2048 + i4] = f.z; wl[3072 + i4] = f.w; }
        for (int i4 = F.tid; i4 < 4096; i4 += NTHR) { const int k = i4 >> 2, c = i4 & 3; const f32x4 f = *(const f32x4*)(we + 4 * i4); LAS float* d = wl + (4 + 4 * c) * 1024 + k;
            d[0] = f.x; d[1024] = f.y; d[2048] = f.z; d[3072] = f.w; }
        if (F.tid < 16) lcnt[F.tid] = 0;
    }
    __syncthreads();
    const int gw = F.bx * NWAVES + F.wave, NGW = gridDim.x * NWAVES;
    LAS float* gl = (LAS float*)(F.lds + 86016);
    LAS float* bl = (LAS float*)(F.lds + 90112);
    for (int i = F.tid; i < 1024; i += NTHR) gl[i] = a.in(I_N2G)[layer * D + i];
    if (F.tid < 4) bl[F.tid] = a.in(I_MBG)[layer * 4 + F.tid];
    if (F.tid >= 64 && F.tid < 80) bl[4 + F.tid - 64] = a.in(I_MBE)[layer * 16 + F.tid - 64];
    __syncthreads();
    bf16_t* A = A_PTR(a); const bf16_t* HB = HB_PTR(a);
    LAS float* red = (LAS float*)(F.lds + 81920 + 256) + F.wave * 96;
#define N2_VALID(mm) ((mm) < M && ((mm) % T) >= PADR)
    constexpr int NR = 2;
    for (int m0 = gw; m0 < M; m0 += NR * NGW) {
        f32x4 v[NR][4];
#pragma unroll
        for (int rr = 0; rr < NR; ++rr) { const int mm_ = m0 + rr * NGW;
            if (N2_VALID(mm_)) { const u32x2* hs_ = (const u32x2*)(HB + (size_t)mm_ * D) + lane;
#pragma unroll
                for (int j = 0; j < 4; ++j) { const u32x2 t = hs_[64 * j]; v[rr][j] = (f32x4){bf_lo(t.x), bf_hi(t.x), bf_lo(t.y), bf_hi(t.y)}; } }
            else {
#pragma unroll
                for (int j = 0; j < 4; ++j) v[rr][j] = (f32x4){0.f, 0.f, 0.f, 0.f}; } }
        float ss[NR];
#pragma unroll
        for (int rr = 0; rr < NR; ++rr) { float s_ = 0.f;
#pragma unroll
            for (int j = 0; j < 4; ++j) s_ += (v[rr][j].x * v[rr][j].x + v[rr][j].y * v[rr][j].y) + (v[rr][j].z * v[rr][j].z + v[rr][j].w * v[rr][j].w);
            ss[rr] = s_; }
#pragma unroll
        for (int rr = 0; rr < NR; ++rr) ss[rr] = wave_sum(ss[rr]);
#pragma unroll
        for (int rr = 0; rr < NR; ++rr) { const int mm = m0 + rr * NGW; const float r = 1.0f / sqrtf(ss[rr] * (1.0f / D) + 1e-6f);
#pragma unroll
            for (int j = 0; j < 4; ++j) v[rr][j] = v[rr][j] * r * *(const LAS f32x4*)(gl + 4 * lane + 256 * j);
            if (N2_VALID(mm) && !dry) { u32x2* o = (u32x2*)(A + (size_t)mm * D) + lane;
#pragma unroll
                for (int j = 0; j < 4; ++j) o[64 * j] = (u32x2){pk2(v[rr][j].x, v[rr][j].y), pk2(v[rr][j].z, v[rr][j].w)}; } }
        { const int rho = lane >> 4, vsel = ((rho & 1) << 1) | (rho >> 1);
#pragma unroll
          for (int qh = 0; qh < 2; ++qh) {
            float dp[NR][10];
#pragma unroll
            for (int q = 0; q < 10; ++q) { f32x4 w[4];
#pragma unroll
                for (int j = 0; j < 4; ++j) w[j] = *(const LAS f32x4*)(wl + (qh * 10 + q) * 1024 + 4 * lane + 256 * j);
#pragma unroll
                for (int rr = 0; rr < NR; ++rr) { float d = 0.f;
#pragma unroll
                    for (int j = 0; j < 4; ++j) d += (v[rr][j].x * w[j].x + v[rr][j].y * w[j].y) + (v[rr][j].z * w[j].z + v[rr][j].w * w[j].w);
                    dp[rr][q] = d; }
                if (q & 1) __builtin_amdgcn_sched_barrier(0); }
#pragma unroll
            for (int rr = 0; rr < NR; ++rr) { float sA[6], sB[3]; sA[5] = 0.f;
#pragma unroll
                for (int i = 0; i < 5; ++i) { auto sw = __builtin_amdgcn_permlane32_swap(__float_as_uint(dp[rr][2 * i]), __float_as_uint(dp[rr][2 * i + 1]), false, false); sA[i] = __uint_as_float(sw[0]) + __uint_as_float(sw[1]); }
#pragma unroll
                for (int k = 0; k < 3; ++k) { auto sw = __builtin_amdgcn_permlane16_swap(__float_as_uint(sA[2 * k]), __float_as_uint(sA[2 * k + 1]), false, false); sB[k] = allred16(__uint_as_float(sw[0]) + __uint_as_float(sw[1])); }
                if ((lane & 15) == 0) {
#pragma unroll
                    for (int k = 0; k < 3; ++k) red[rr * 24 + qh * 10 + 4 * k + vsel] = sB[k]; } }
            __builtin_amdgcn_sched_barrier(0);
          } }
        LDS_WAIT();
        if (lane < NR) {
            const int mm = m0 + lane * NGW;
            float ds[20];
#pragma unroll
            for (int i = 0; i < 5; ++i) { const f32x4 t4 = *(const LAS f32x4*)(red + lane * 24 + 4 * i); ds[4 * i] = t4.x; ds[4 * i + 1] = t4.y; ds[4 * i + 2] = t4.z; ds[4 * i + 3] = t4.w; }
            const float lg0 = ds[0] + bl[0], lg1 = ds[1] + bl[1], lg2 = ds[2] + bl[2], lg3 = ds[3] + bl[3];
            int g = 0; float mx = lg0;
            if (lg1 > mx) { mx = lg1; g = 1; } if (lg2 > mx) { mx = lg2; g = 2; } if (lg3 > mx) { mx = lg3; g = 3; }
            const float den = fast_exp(lg0 - mx) + fast_exp(lg1 - mx) + fast_exp(lg2 - mx) + fast_exp(lg3 - mx);
            const float pgrp = 1.0f / den;
            const f32x4 be4 = *(const LAS f32x4*)(bl + 4 + 4 * g);
            float s0 = (g == 0 ? ds[4] : g == 1 ? ds[8] : g == 2 ? ds[12] : ds[16]) + be4.x;
            float s1 = (g == 0 ? ds[5] : g == 1 ? ds[9] : g == 2 ? ds[13] : ds[17]) + be4.y;
            float s2 = (g == 0 ? ds[6] : g == 1 ? ds[10] : g == 2 ? ds[14] : ds[18]) + be4.z;
            float s3 = (g == 0 ? ds[7] : g == 1 ? ds[11] : g == 2 ? ds[15] : ds[19]) + be4.w;
            int i0 = 0; float v0 = s0;
            if (s1 > v0) { v0 = s1; i0 = 1; } if (s2 > v0) { v0 = s2; i0 = 2; } if (s3 > v0) { v0 = s3; i0 = 3; }
            int i1 = -1; float v1 = -3.0e38f;
            if (i0 != 0 && s0 > v1) { v1 = s0; i1 = 0; } if (i0 != 1 && s1 > v1) { v1 = s1; i1 = 1; } if (i0 != 2 && s2 > v1) { v1 = s2; i1 = 2; } if (i0 != 3 && s3 > v1) { v1 = s3; i1 = 3; }
            const float e1 = fast_exp(v1 - v0), pt0 = 1.0f / (1.0f + e1), pt1 = e1 * pt0;
            if (N2_VALID(mm) && !dry) {
                const int ea = g * 4 + i0, eb = g * 4 + i1;
                const int la = atomicAdd((int*)&lcnt[ea], 1), lb = atomicAdd((int*)&lcnt[eb], 1);
                int* tk = (int*)(ws + WS_TOK) + (size_t)mm * 8;
                tk[0] = ea; tk[1] = eb; tk[2] = __float_as_int(pgrp * pt0); tk[3] = __float_as_int(pgrp * pt1); tk[4] = la; tk[5] = lb;
            } else { float sink = pgrp * pt0 + pt1; asm volatile("" :: "v"(sink)); }
        }
        LDS_WAIT();
    }
#undef N2_VALID
    __syncthreads();
    if (F.tid < 16 && !dry) {
        const int c = lcnt[F.tid];
        ((int*)(ws + WS_WGCNT))[F.bx * 16 + F.tid] = c;
        atomicAdd((int*)(ws + WS_CTL) + CW_ECNT + 64 * layer + F.tid, c);
    }
    __syncthreads();
}

__device__ __forceinline__ void phase_route(const ArgsL& a, Frame& F, int layer) {
    unsigned char* ws = a.ws;
    LAS int* tbl = (LAS int*)F.lds;
    LAS int* part = tbl + 16;
    {
        const int e = F.tid & 15, q = F.tid >> 4; const int* wc = (const int*)(ws + WS_WGCNT); int acc = 0;
#pragma unroll
        for (int i = 0; i < 8; ++i) { const int w = q + 32 * i; if (w < (int)F.bx) acc += wc[w * 16 + e]; }
        part[q * 16 + e] = acc;
    }
    __syncthreads();
    if (F.tid < 16) {
        const int* cnt = (const int*)(ws + WS_CTL) + CW_ECNT + 64 * layer;
        int cv[16];
#pragma unroll
        for (int e = 0; e < 16; ++e) cv[e] = __hip_atomic_load(cnt + e, __ATOMIC_RELAXED, __HIP_MEMORY_SCOPE_AGENT);
        int base = 0;
#pragma unroll
        for (int e = 0; e < 16; ++e) if (e < F.tid) base += ((cv[e] + 255) >> 8) << 8;
#pragma unroll
        for (int q = 0; q < 32; ++q) base += part[q * 16 + F.tid];
        tbl[F.tid] = base;
    }
    __syncthreads();
    const int gw = F.bx * NWAVES + F.wave, NGW = gridDim.x * NWAVES, lane = F.lane;
    const bf16_t* A = A_PTR(a); bf16_t* AS = (bf16_t*)(ws + WS_AS);
    int tn[6] = {0, 0, 0, 0, 0, 0}; u32x4 xn0 = {0u, 0u, 0u, 0u}, xn1 = {0u, 0u, 0u, 0u};
#define RT_LOAD(mm) do { if ((mm) < M && ((mm) % T) >= PADR) { const int* tk_ = (const int*)(ws + WS_TOK) + (size_t)(mm) * 8; \
        _Pragma("unroll") for (int q_ = 0; q_ < 6; ++q_) tn[q_] = tk_[q_]; \
        const u32x4* src_ = (const u32x4*)(A + (size_t)(mm) * D) + lane; xn0 = src_[0]; xn1 = src_[64]; } } while (0)
    RT_LOAD(gw);
    for (int m = gw; m < M; m += NGW) {
        int tk[6];
#pragma unroll
        for (int q = 0; q < 6; ++q) tk[q] = tn[q];
        const u32x4 x0 = xn0, x1 = xn1;
        RT_LOAD(m + NGW);
        const int b = m / T, p = m - b * T, l = p - PADR;
        if (l < 0) continue;
        const int ea = tk[0], eb = tk[1], sa = tbl[ea] + tk[4], sb = tbl[eb] + tk[5];
        u32x4* d0 = (u32x4*)(AS + (size_t)sa * D) + lane; u32x4* d1 = (u32x4*)(AS + (size_t)sb * D) + lane;
        d0[0] = x0; d0[64] = x1; d1[0] = x0; d1[64] = x1;
        if (lane == 0) { int* sl = (int*)(ws + WS_SLOT) + 2 * m; sl[0] = sa; sl[1] = sb;
            float* cw = (float*)(ws + WS_CWS); cw[sa] = __int_as_float(tk[2]); cw[sb] = __int_as_float(tk[3]); }
    }
#undef RT_LOAD
    __syncthreads();
}

#ifndef PR_STAGES
#define PR_STAGES 15
#endif
__device__ __forceinline__ void phase_prep(const ArgsL& a, Frame& F, int layer, const bool dry = false) {
    unsigned char* ws = a.ws;
    LAS float* xs = (LAS float*)F.lds;
    const int wave = F.wave, lane = F.lane, tid = F.tid;
    const int m0 = F.bx * 129;
    const bf16_t* USH = (const bf16_t*)(ws + WS_USH);
    bf16_t* QKV = (bf16_t*)(ws + WS_QKV);
    if (F.bx < 10 && (!dry || (PR_STAGES & 8))) {
        const int bh = F.bx, b = bh / 5, h = bh % 5;
        const float* LOGF = (const float*)(ws + WS_LOGF) + (size_t)(b * T + PADR) * 8 + h;
        float* kb = (float*)(ws + WS_KB2) + (size_t)bh * KBP;
        LAS float* wtot = (LAS float*)F.lds;
        float v[33];
        const int l0 = tid * 33;
#pragma unroll
        for (int i = 0; i < 33; ++i) v[i] = (l0 + i < LTOK) ? LOGF[(size_t)(l0 + i) * 8] : 0.f;
#pragma unroll
        for (int i = 1; i < 33; ++i) v[i] += v[i - 1];
        float incl = v[32];
#pragma unroll
        for (int o = 1; o < 64; o <<= 1) { const float t = __shfl_up(incl, o); if (lane >= o) incl += t; }
        if (lane == 63) wtot[wave] = incl;
        __syncthreads();
        float off = incl - v[32];
        for (int w = 0; w < wave; ++w) off += wtot[w];
#pragma unroll
        for (int i = 0; i < 33; ++i) if (l0 + i < LTOK && !dry) kb[PADR + l0 + i] = -(off + v[i]) * LOG2E;
        for (int p = tid; p < PADR; p += NTHR) kb[p] = 0.f;
        for (int p = T + tid; p < KBP; p += NTHR) kb[p] = 0.f;
        __syncthreads();
    }
    if (F.bx >= 16 && F.bx < 28) {
        unsigned* z = (unsigned*)(ws + WS_RW + ((size_t)(F.bx - 16) * LPADDED + LTOK) * 768);
        for (int i = tid; i < (LPADDED - LTOK) * 192; i += NTHR) z[i] = 0u;
    }
    const int r16 = lane & 15, q4 = lane >> 4, hh = wave < 6 ? wave : 0;
    bf16x8 bw[2][4][2];
    float cw0[4], ca0[4], ckk[4], cka[4], crk[4];
    {
        const float* WUp = a.in(I_WUP) + (size_t)layer * 64 * RW_W + hh * 64 + r16; const float* AUp = a.in(I_AUP) + (size_t)layer * 64 * RW_W + hh * 64 + r16;
#pragma unroll
        for (int mtx = 0; mtx < 2; ++mtx)
#pragma unroll
            for (int blk = 0; blk < 4; ++blk)
#pragma unroll
                for (int ks = 0; ks < 2; ++ks) { const float* p_ = (mtx ? AUp : WUp) + (size_t)(32 * ks + 8 * q4) * RW_W + blk * 16;
                    const float f0 = p_[0], f1 = p_[RW_W], f2 = p_[2 * RW_W], f3 = p_[3 * RW_W], f4 = p_[4 * RW_W], f5 = p_[5 * RW_W], f6 = p_[6 * RW_W], f7 = p_[7 * RW_W];
                    bw[mtx][blk][ks] = __builtin_bit_cast(bf16x8, (u32x4){pk2(f0, f1), pk2(f2, f3), pk2(f4, f5), pk2(f6, f7)}); }
#pragma unroll
        for (int blk = 0; blk < 4; ++blk) { const int ch = layer * RW_W + hh * 64 + blk * 16 + r16;
            cw0[blk] = a.in(I_W0)[ch]; ca0[blk] = a.in(I_A0)[ch]; ckk[blk] = a.in(I_KK)[ch]; cka[blk] = a.in(I_KA)[ch]; crk[blk] = a.in(I_RK)[ch]; }
    }
    const float* mu = a.in(I_MU) + layer * SHIFT_W;
    f32x4 gq4 = *(const f32x4*)(a.in(I_QG) + layer * 64 + (lane & 15) * 4) * C2; const f32x4 gk4 = *(const f32x4*)(a.in(I_KG) + layer * 64 + (lane & 15) * 4);
    _Float16* RW = (_Float16*)(ws + WS_RW);
    bf16_t* BN = (bf16_t*)(ws + WS_BN);
    for (int t0 = 0; t0 < 129; t0 += 16) {
        const int nt = (129 - t0) < 16 ? (129 - t0) : 16;
        if (!dry || (PR_STAGES & 1)) {
            int tid = F.tid; asm volatile("" : "+v"(tid));
            u32x4 uu4[5], pp4[5];
#pragma unroll
            for (int q5 = 0; q5 < 5; ++q5) { const int item = tid + q5 * NTHR; uu4[q5] = (u32x4){0u, 0u, 0u, 0u}; pp4[q5] = (u32x4){0u, 0u, 0u, 0u};
                if (item < nt * 160) { const int tok = item / 160, ch = item - tok * 160, m = m0 + t0 + tok;
                    uu4[q5] = *(const u32x4*)(USH + (size_t)m * SHIFT_W + ch * 8);
                    if (m > 0) pp4[q5] = *(const u32x4*)(USH + (size_t)(m - 1) * SHIFT_W + ch * 8); } }
#pragma unroll
            for (int q5 = 0; q5 < 5; ++q5) { const int item = tid + q5 * NTHR;
                if (item < nt * 160) { const int tok = item / 160, ch = item - tok * 160;
                    const u32x4 u = uu4[q5], pv = pp4[q5];
                    const f32x4 mu0 = *(const f32x4*)(mu + ch * 8), mu1 = *(const f32x4*)(mu + ch * 8 + 4);
                    float x[8];
                    { float uu, pp;
                      uu = bf_lo(u.x); pp = bf_lo(pv.x); x[0] = uu + (pp - uu) * mu0.x;  uu = bf_hi(u.x); pp = bf_hi(pv.x); x[1] = uu + (pp - uu) * mu0.y;
                      uu = bf_lo(u.y); pp = bf_lo(pv.y); x[2] = uu + (pp - uu) * mu0.z;  uu = bf_hi(u.y); pp = bf_hi(pv.y); x[3] = uu + (pp - uu) * mu0.w;
                      uu = bf_lo(u.z); pp = bf_lo(pv.z); x[4] = uu + (pp - uu) * mu1.x;  uu = bf_hi(u.z); pp = bf_hi(pv.z); x[5] = uu + (pp - uu) * mu1.y;
                      uu = bf_lo(u.w); pp = bf_lo(pv.w); x[6] = uu + (pp - uu) * mu1.z;  uu = bf_hi(u.w); pp = bf_hi(pv.w); x[7] = uu + (pp - uu) * mu1.w; }
                    if (ch >= 144 && ch < 152) {
#pragma unroll
                        for (int q = 0; q < 8; ++q) { const float e = fast_exp(-2.f * fabsf(x[q])); const float th = (1.f - e) / (1.f + e); x[q] = x[q] < 0.f ? -th : th; }
                    }
                    LAS f32x4* d = (LAS f32x4*)(xs + tok * SHIFT_W + ch * 8);
                    d[0] = (f32x4){x[0], x[1], x[2], x[3]}; d[1] = (f32x4){x[4], x[5], x[6], x[7]}; } }
        }
        __syncthreads();
        if (wave < 6) { if (!dry || (PR_STAGES & 2)) {
            f32x4 acc[2][4];
#pragma unroll
            for (int mtx = 0; mtx < 2; ++mtx) {
                bf16x8 af[2];
#pragma unroll
                for (int ks = 0; ks < 2; ++ks) { const LAS float* xp = xs + r16 * SHIFT_W + 1152 + 64 * mtx + 32 * ks + 8 * q4;
                    const f32x4 u0 = *(const LAS f32x4*)xp, u1 = *(const LAS f32x4*)(xp + 4);
                    af[ks] = __builtin_bit_cast(bf16x8, (u32x4){pk2(u0.x, u0.y), pk2(u0.z, u0.w), pk2(u1.x, u1.y), pk2(u1.z, u1.w)}); }
#pragma unroll
                for (int blk = 0; blk < 4; ++blk) { f32x4 c4 = {0.f, 0.f, 0.f, 0.f};
                    c4 = __builtin_amdgcn_mfma_f32_16x16x32_bf16(af[0], bw[mtx][blk][0], c4, 0, 0, 0);
                    c4 = __builtin_amdgcn_mfma_f32_16x16x32_bf16(af[1], bw[mtx][blk][1], c4, 0, 0, 0);
                    acc[mtx][blk] = c4; }
            }
#pragma unroll
            for (int i = 0; i < 4; ++i) {
                const int tok = 4 * q4 + i, m = m0 + t0 + tok, b = m / T, p = m - b * T, l = p - PADR;
                const bool ok = (tok < nt) && (l >= 0);
                const LAS float* xr = xs + (tok < 16 ? tok : 0) * SHIFT_W + hh * 64 + r16;
                float kkr[4], kpv[4], avv4[4], omv[4], rv4[4], vv4[4];
                float ssq = 0.f, cf = 0.f;
#pragma unroll
                for (int blk = 0; blk < 4; ++blk) {
                    const float wlv = cw0[blk] + acc[0][blk][i], alv = ca0[blk] + acc[1][blk][i];
                    const float r = xr[blk * 16], k = xr[384 + blk * 16], v = xr[768 + blk * 16];
                    const float logw = -softplus_f(-wlv) - 0.5f;
                    const float xw = fast_exp(logw);
                    omv[blk] = xw < 0.02f ? xw * (1.f - 0.5f * xw + xw * xw * (1.f / 6.f)) : 1.f - fast_exp(-xw);
                    const float av = 1.f / (1.f + fast_exp(-alv));
                    kkr[blk] = k * ckk[blk]; kpv[blk] = k * (1.f + (av - 1.f) * cka[blk]); avv4[blk] = av; rv4[blk] = r; vv4[blk] = v;
                    ssq += kkr[blk] * kkr[blk]; cf += r * kpv[blk] * crk[blk];
                }
                ssq = allred16(ssq); cf = allred16(cf);
                const float inv = 1.0f / fmaxf(sqrtf(ssq), 1e-12f);
                if (ok && !dry) {
                    _Float16* o = RW + ((size_t)(b * RW_H + hh) * LPADDED + l) * 384 + r16;
#pragma unroll
                    for (int blk = 0; blk < 4; ++blk) { const float kk = kkr[blk] * inv, bb = kk * avv4[blk];
                        o[blk * 16] = (_Float16)kk; o[64 + blk * 16] = (_Float16)(-omv[blk]); o[128 + blk * 16] = (_Float16)(-bb); o[192 + blk * 16] = (_Float16)kpv[blk];
                        o[256 + blk * 16] = (_Float16)rv4[blk]; o[320 + blk * 16] = (_Float16)vv4[blk];
                        BN[(size_t)m * RW_W + hh * 64 + blk * 16 + r16] = f2bf(cf * vv4[blk]); }
                } else { float sink = ssq + cf + inv + omv[0] + kpv[1]; asm volatile("" :: "v"(sink)); }
            } }
        }
        if (!dry || (PR_STAGES & 4)) {
            const int it4 = lane >> 4, e4 = lane & 15;
            u32x2 xv[5]; bf16_t* qp5[5]; bool okv[5];
#pragma unroll
            for (int ps = 0; ps < 5; ++ps) { const int item = (ps * 8 + wave) * 4 + it4, tok = item / 10, hq = item - tok * 10;
                const int m = m0 + t0 + tok, p = m % T;
                okv[ps] = (tok < nt) && (p >= PADR);
                qp5[ps] = QKV + (size_t)m * QKV_W + 960 + hq * 64 + e4 * 4;
                xv[ps] = okv[ps] ? *(const u32x2*)qp5[ps] : (u32x2){0u, 0u}; }
#pragma unroll
            for (int ps = 0; ps < 5; ++ps) { const int item = (ps * 8 + wave) * 4 + it4, hq = item % 10;
                const float x0 = bf_lo(xv[ps].x), x1 = bf_hi(xv[ps].x), x2 = bf_lo(xv[ps].y), x3 = bf_hi(xv[ps].y);
                const float ss = allred16((x0 * x0 + x1 * x1) + (x2 * x2 + x3 * x3));
                const float rs = 1.0f / sqrtf(ss * (1.0f / 64.f) + 1e-6f);
                const f32x4 gg = hq < 5 ? gq4 : gk4;
                const u32x2 w = {pk2(x0 * rs * gg.x, x1 * rs * gg.y), pk2(x2 * rs * gg.z, x3 * rs * gg.w)};
                if (okv[ps] && !dry) *(u32x2*)qp5[ps] = w; else asm volatile("" :: "v"(w.x), "v"(w.y)); }
        }
        __syncthreads();
    }
}


constexpr int SCH = 16;
static_assert(LTOK % SCH == 0, "whole chunks");
__device__ __forceinline__ void rwkv_scan(const ArgsL& a, Frame& F, int wgi, int dry = 0) {
    const int bh = wgi >> 4, q8 = wgi & 15, b = bh / RW_H, h = bh % RW_H;
    const int tid = F.tid, wave = F.wave, lane = F.lane;
    const unsigned char* rw = a.ws + WS_RW + (size_t)bh * LPADDED * 768;
    LAS float* ring = (LAS float*)F.lds;
    LAS float* ypart = (LAS float*)(F.lds + 49152);
    LAS unsigned char* stg = F.lds + 81920;
    bf16_t* y0 = (bf16_t*)(a.ws + WS_YCAT);
    constexpr int NCH = LTOK / SCH;
    const bool isld = (wave & 2) != 0; const int lw = (wave & 1) + ((wave >> 2) << 1), tl = lw * 64 + lane;
    float s0 = 0.f, s1 = 0.f;
    const int i32 = lane & 31, rsel = lane >> 5, rloc = 2 * wave + rsel;
#define RW_BAR() asm volatile("s_waitcnt lgkmcnt(0)\n\ts_barrier" ::: "memory")
#define RW_ISSUE(cc) do { const unsigned char* src_ = rw + (size_t)(cc) * SCH * 768 + (size_t)tl * 16; LAS unsigned char* d_ = stg + ((cc) & 3) * 12288 + lw * 1024; \
        _Pragma("unroll") for (int k_ = 0; k_ < 3; ++k_) __builtin_amdgcn_global_load_lds((const unsigned*)(src_ + k_ * 4096), (LAS unsigned*)(d_ + k_ * 4096), 16, 0, 0); } while (0)
#define RW_CONVERT(cc) do { const LAS unsigned char* s_ = stg + ((cc) & 3) * 12288 + tl * 16; LAS float* rb_ = ring + ((cc) & 1) * 6144; \
        _Pragma("unroll") for (int k_ = 0; k_ < 3; ++k_) { const int pc_ = tl + 256 * k_; const int t_ = pc_ / 48, q_ = pc_ - t_ * 48, vec_ = q_ >> 3, e0_ = (q_ & 7) * 8; \
            const u32x4 w_ = *(const LAS u32x4*)(s_ + k_ * 4096); \
            const f16x4 lo_ = __builtin_bit_cast(f16x4, (u32x2){w_.x, w_.y}), hi_ = __builtin_bit_cast(f16x4, (u32x2){w_.z, w_.w}); \
            const float f0 = (float)lo_.x, f1 = (float)lo_.y, f2 = (float)lo_.z, f3 = (float)lo_.w, f4 = (float)hi_.x, f5 = (float)hi_.y, f6 = (float)hi_.z, f7 = (float)hi_.w; \
            if (vec_ < 4) { LAS float* d_ = rb_ + t_ * 384 + (vec_ >> 1) * 128 + (e0_ >> 1) * 4 + (vec_ & 1) * 2; \
                *(LAS f32x2*)(d_) = (f32x2){f0, f1}; *(LAS f32x2*)(d_ + 4) = (f32x2){f2, f3}; *(LAS f32x2*)(d_ + 8) = (f32x2){f4, f5}; *(LAS f32x2*)(d_ + 12) = (f32x2){f6, f7}; } \
            else { LAS f32x4* d_ = (LAS f32x4*)(rb_ + t_ * 384 + (vec_ == 4 ? 256 : 320) + e0_); d_[0] = (f32x4){f0, f1, f2, f3}; d_[1] = (f32x4){f4, f5, f6, f7}; } } } while (0)
#define RW_STORE_Y(cc) do { if (tl < 32) { const LAS float* yb_ = ypart + ((cc) & 1) * 4096; const int t_ = tl >> 1, pr_ = tl & 1; const int l_ = (cc) * SCH + t_; \
        const LAS f32x4* q_ = (const LAS f32x4*)(yb_ + t_ * 128 + pr_ * 64); f32x4 sa_ = q_[0], sb_ = q_[8]; \
        _Pragma("unroll") for (int k_ = 1; k_ < 8; ++k_) { sa_ = sa_ + q_[k_]; sb_ = sb_ + q_[8 + k_]; } \
        *(unsigned*)(y0 + (size_t)(b * T + PADR + l_) * RW_W + h * 64 + q8 * 4 + 2 * pr_) = pk2((sa_.x + sa_.y) + (sa_.z + sa_.w), (sb_.x + sb_.y) + (sb_.z + sb_.w)); } } while (0)
    if (isld) {
        RW_ISSUE(0); asm volatile("s_waitcnt vmcnt(0)" ::: "memory"); RW_CONVERT(0);
        RW_ISSUE(1); RW_ISSUE(2);
    }
    RW_BAR();
    for (int c = 0; c < NCH; ++c) {
        if (isld) {
            if (c + 2 < NCH) { asm volatile("s_waitcnt vmcnt(3)" ::: "memory"); RW_CONVERT(c + 1); }
            else if (c + 1 < NCH) { asm volatile("s_waitcnt vmcnt(0)" ::: "memory"); RW_CONVERT(c + 1); }
            if (c > 0 && !dry) RW_STORE_Y(c - 1);
            if (c + 3 < NCH) RW_ISSUE(c + 3);
        } else if (dry != 1 && wave < 2) {
            const unsigned ba = (unsigned)(uintptr_t)(ring + (c & 1) * 6144) + i32 * 16, ca = (unsigned)(uintptr_t)(ring + (c & 1) * 6144) + 1024 + i32 * 8,
                           va = (unsigned)(uintptr_t)(ring + (c & 1) * 6144) + 1280 + (q8 * 4 + rloc) * 4, ya = (unsigned)(uintptr_t)(ypart + (c & 1) * 4096 + rloc * 32 + i32);
            f32x4 OA[4], OB[4]; f32x2 OC[4]; float OV[4];
            OC[3] = (f32x2){0.f, 0.f};
#define RW_FETCH(tt, sl) asm volatile("ds_read_b128 %0, %4 offset:%c7\n\tds_read_b128 %1, %4 offset:%c8\n\tds_read_b64 %2, %5 offset:%c7\n\tds_read_b32 %3, %6 offset:%c7" \
                : "=&v"(OA[sl]), "=&v"(OB[sl]), "=&v"(OC[sl]), "=&v"(OV[sl]) : "v"(ba), "v"(ca), "v"(va), "i"((tt) * 1536), "i"((tt) * 1536 + 512) : "memory")
            RW_FETCH(0, 0); RW_FETCH(1, 1);
            float p, p2, y;
#define RW_STEP(t, WAITN, YL1, YL2, YW, FETCHL) asm volatile( \
                "s_waitcnt lgkmcnt(" WAITN ")\n\t" \
                "v_mul_f32 %[p], %[s0], %[kk0]\n\t" \
                "v_fmac_f32 %[p], %[s1], %[kk1]\n\t" \
                YL1 "\n\t" YL2 "\n\t" \
                XL8 "\n\t" \
                "v_fmac_f32 %[s0], %[s0], %[om0]\n\t" \
                "v_fmac_f32 %[s1], %[s1], %[om1]\n\t" \
                XL4 "\n\t" \
                "v_fmac_f32 %[s0], %[vf], %[kv0]\n\t" \
                "v_fmac_f32 %[s1], %[vf], %[kv1]\n\t" \
                XL2 "\n\t" \
                YW "\n\t" \
                FETCHL \
                : [p] "=&v"(p), [p2] "=&v"(p2), [y] "=&v"(y), [s0] "+v"(s0), [s1] "+v"(s1), [nA] "=&v"(OA[((t) + 2) & 3]), [nB] "=&v"(OB[((t) + 2) & 3]), [nC] "=&v"(OC[((t) + 2) & 3]), [nV] "=&v"(OV[((t) + 2) & 3]) \
                : [kk0] "v"(OA[(t) & 3].x), [kk1] "v"(OA[(t) & 3].y), [om0] "v"(OA[(t) & 3].z), [om1] "v"(OA[(t) & 3].w), [bb0] "v"(OB[(t) & 3].x), [bb1] "v"(OB[(t) & 3].y), [kv0] "v"(OB[(t) & 3].z), [kv1] "v"(OB[(t) & 3].w), \
                  [vf] "v"(OV[(t) & 3]), [rp0] "v"(OC[((t) + 3) & 3].x), [rp1] "v"(OC[((t) + 3) & 3].y), [ba] "v"(ba), [ca] "v"(ca), [va] "v"(va), [ya] "v"(ya), \
                  [oa] "i"(((t) + 2) * 1536), [ob] "i"(((t) + 2) * 1536 + 512), [oy] "i"(((t) - 1) * 512) : "memory")
#define RW_YL1 "v_mul_f32 %[y], %[s0], %[rp0]"
#define RW_YL2 "v_fmac_f32 %[y], %[s1], %[rp1]"
#define RW_YW  "ds_write_b32 %[ya], %[y] offset:%c[oy]"
#define RW_NOP "s_nop 0"
#define RW_TAIL_F "ds_read_b128 %[nA], %[ba] offset:%c[oa]\n\t" \
                XL1 "\n\t" \
                "ds_read_b128 %[nB], %[ba] offset:%c[ob]\n\t" \
                "ds_read_b64 %[nC], %[ca] offset:%c[oa]\n\t" \
                "v_mov_b32 %[p2], %[p]\n\t" \
                "ds_read_b32 %[nV], %[va] offset:%c[oa]\n\t" \
                "s_nop 0\n\t" \
                XSW "\n\t" \
                "v_add_f32 %[p], %[p], %[p2]\n\t" \
                "v_fmac_f32 %[s0], %[p], %[bb0]\n\t" \
                "v_fmac_f32 %[s1], %[p], %[bb1]"
#define RW_TAIL_N "s_nop 0\n\t" \
                XL1 "\n\t" \
                "s_nop 1\n\t" \
                "v_mov_b32 %[p2], %[p]\n\t" \
                "s_nop 1\n\t" \
                XSW "\n\t" \
                "v_add_f32 %[p], %[p], %[p2]\n\t" \
                "v_fmac_f32 %[s0], %[p], %[bb0]\n\t" \
                "v_fmac_f32 %[s1], %[p], %[bb1]"
#define RW_ALLSTEPS() do { \
            RW_STEP(0, "4", RW_NOP, RW_NOP, RW_NOP, RW_TAIL_F); \
            RW_STEP(1, "4", RW_YL1, RW_YL2, RW_YW, RW_TAIL_F); \
            RW_STEP(2, "5", RW_YL1, RW_YL2, RW_YW, RW_TAIL_F);  RW_STEP(3, "5", RW_YL1, RW_YL2, RW_YW, RW_TAIL_F);  RW_STEP(4, "5", RW_YL1, RW_YL2, RW_YW, RW_TAIL_F); \
            RW_STEP(5, "5", RW_YL1, RW_YL2, RW_YW, RW_TAIL_F);  RW_STEP(6, "5", RW_YL1, RW_YL2, RW_YW, RW_TAIL_F);  RW_STEP(7, "5", RW_YL1, RW_YL2, RW_YW, RW_TAIL_F); \
            RW_STEP(8, "5", RW_YL1, RW_YL2, RW_YW, RW_TAIL_F);  RW_STEP(9, "5", RW_YL1, RW_YL2, RW_YW, RW_TAIL_F);  RW_STEP(10, "5", RW_YL1, RW_YL2, RW_YW, RW_TAIL_F); \
            RW_STEP(11, "5", RW_YL1, RW_YL2, RW_YW, RW_TAIL_F); RW_STEP(12, "5", RW_YL1, RW_YL2, RW_YW, RW_TAIL_F); RW_STEP(13, "5", RW_YL1, RW_YL2, RW_YW, RW_TAIL_F); \
            RW_STEP(14, "5", RW_YL1, RW_YL2, RW_YW, RW_TAIL_N); \
            RW_STEP(15, "1", RW_YL1, RW_YL2, RW_YW, RW_TAIL_N); \
            asm volatile("v_mul_f32 %[y], %[s0], %[r0]\n\tv_fmac_f32 %[y], %[s1], %[r1]\n\tds_write_b32 %[ya], %[y] offset:7680" : [y] "=&v"(y) : [s0] "v"(s0), [s1] "v"(s1), [r0] "v"(OC[3].x), [r1] "v"(OC[3].y), [ya] "v"(ya) : "memory"); \
 } while (0)
#ifdef SCAN_PROBE_NOXL
            if (dry == 2) {
#define XL8 "v_add_f32 %[p], %[p], %[p]"
#define XL4 "v_add_f32 %[p], %[p], %[p]"
#define XL2 "v_add_f32 %[p], %[p], %[p]"
#define XL1 "v_add_f32 %[p], %[p], %[p]"
#define XSW "v_add_f32 %[p], %[p], %[p2]"
                RW_ALLSTEPS();
#undef XL8
#undef XL4
#undef XL2
#undef XL1
#undef XSW
            } else
#endif
            {
#define XL8 "v_add_f32_dpp %[p], %[p], %[p] row_ror:8 row_mask:0xf bank_mask:0xf bound_ctrl:1"
#define XL4 "v_add_f32_dpp %[p], %[p], %[p] row_ror:4 row_mask:0xf bank_mask:0xf bound_ctrl:1"
#define XL2 "v_add_f32_dpp %[p], %[p], %[p] row_ror:2 row_mask:0xf bank_mask:0xf bound_ctrl:1"
#define XL1 "v_add_f32_dpp %[p], %[p], %[p] row_ror:1 row_mask:0xf bank_mask:0xf bound_ctrl:1"
#define XSW "v_permlane16_swap_b32 %[p], %[p2]"
                RW_ALLSTEPS();
            }
#undef RW_ALLSTEPS
#undef RW_STEP
#undef XL8
#undef XL4
#undef XL2
#undef XL1
#undef XSW
#undef RW_YL1
#undef RW_YL2
#undef RW_YW
#undef RW_NOP
#undef RW_TAIL_F
#undef RW_TAIL_N
#undef RW_FETCH
        }
        RW_BAR();
    }
    if (isld && !dry) RW_STORE_Y(NCH - 1);
    asm volatile("s_waitcnt vmcnt(0) lgkmcnt(0)\n\ts_barrier" ::: "memory");
#undef RW_STORE_Y
#undef RW_ISSUE
#undef RW_CONVERT
#undef RW_BAR
}

__device__ __forceinline__ int crow(int r, int hi) { return (r & 3) + 8 * (r >> 2) + 4 * hi; }
__device__ __forceinline__ void glds16(const void* gsrc, unsigned lds_dst) { unsigned keep;
    asm volatile("s_mov_b32 %0, m0\n\ts_mov_b32 m0, %2\n\ts_nop 0\n\tglobal_load_lds_dwordx4 %1, off\n\ts_mov_b32 m0, %0" : "=&s"(keep) : "v"(gsrc), "s"(lds_dst) : "memory"); }
__device__ __forceinline__ void glds4(const void* gsrc, unsigned lds_dst) { unsigned keep;
    asm volatile("s_mov_b32 %0, m0\n\ts_mov_b32 m0, %2\n\ts_nop 0\n\tglobal_load_lds_dword %1, off\n\ts_mov_b32 m0, %0" : "=&s"(keep) : "v"(gsrc), "s"(lds_dst) : "memory"); }
typedef LAS const char* lds_cptr;
constexpr int FX_K = 0, FX_V = 24576, FX_WS = 49152, FX_OST = 51200, FX_FLG = 83968, FX_KB = 84224  ;

__device__ __forceinline__ void fx_pv(f32x16* o, int vb, bf16x8 pa0, bf16x8 pa1, bf16x8 pa2, bf16x8 pa3) {
#pragma unroll
    for (int d0 = 0; d0 < 2; ++d0) { s16x4 lo[4], hi[4];
#pragma unroll
        for (int ks = 0; ks < 4; ++ks) {
            asm volatile("ds_read_b64_tr_b16 %0,%1 offset:%c2" : "=&v"(lo[ks]) : "v"(vb), "i"(d0 * 4096 + ks * 1024) : "memory");
            asm volatile("ds_read_b64_tr_b16 %0,%1 offset:%c2" : "=&v"(hi[ks]) : "v"(vb), "i"(d0 * 4096 + ks * 1024 + 512) : "memory"); }
        asm volatile("s_waitcnt lgkmcnt(0)" ::: "memory"); __builtin_amdgcn_sched_barrier(0);
#define FX_PK(k) (bf16x8){lo[k][0], lo[k][1], lo[k][2], lo[k][3], hi[k][0], hi[k][1], hi[k][2], hi[k][3]}
        o[d0] = __builtin_amdgcn_mfma_f32_32x32x16_bf16(pa0, FX_PK(0), o[d0], 0, 0, 0);
        o[d0] = __builtin_amdgcn_mfma_f32_32x32x16_bf16(pa1, FX_PK(1), o[d0], 0, 0, 0);
        o[d0] = __builtin_amdgcn_mfma_f32_32x32x16_bf16(pa2, FX_PK(2), o[d0], 0, 0, 0);
        o[d0] = __builtin_amdgcn_mfma_f32_32x32x16_bf16(pa3, FX_PK(3), o[d0], 0, 0, 0);
#undef FX_PK
    }
}
__device__ __forceinline__ float halves_max(float m) { auto rr = __builtin_amdgcn_permlane32_swap(__float_as_uint(m), __float_as_uint(m), false, false); return fmaxf(__uint_as_float(rr[0]), __uint_as_float(rr[1])); }
__device__ __forceinline__ float halves_sum(float m) { auto rr = __builtin_amdgcn_permlane32_swap(__float_as_uint(m), __float_as_uint(m), false, false); return __uint_as_float(rr[0]) + __uint_as_float(rr[1]); }

template <int KIND>
__device__ __forceinline__ void attn_unit(const ArgsL& a, Frame& F, int b, int h, int qb, float bound) {
    const int lane = F.lane, wave = F.wave, r32 = lane & 31, hi = lane >> 5;
    LAS unsigned char* lds = F.lds;
    const bf16_t* QKV = (const bf16_t*)(a.ws + WS_QKV);
    const size_t rowbase = (size_t)b * T;
    const int p0 = qb * 256;
    constexpr int QC = KIND ? 0 : 960, KC = KIND ? 320 : 1280, VC = KIND ? 640 : 1600;
    const bf16_t* Qw = QKV + (rowbase + p0 + wave * 32) * QKV_W + QC + h * 64;
    const bf16_t* Kh = QKV + rowbase * QKV_W + KC + h * 64;
    const bf16_t* Vh = QKV + rowbase * QKV_W + VC + h * 64;
    const float* kbias = (const float*)(a.ws + WS_KB2) + (size_t)(b * FX_H + h) * KBP;
    const unsigned lds0 = (unsigned)(uintptr_t)lds;
    bf16x8 qr[4];
#pragma unroll
    for (int d0 = 0; d0 < 4; ++d0) qr[d0] = *(const bf16x8*)(Qw + (size_t)r32 * QKV_W + d0 * 16 + hi * 8);
    const int qp = p0 + wave * 32 + r32;
    const bool qvalid = (qp >= PADR) && (qp < T);
    const int plast = (p0 + 255) < (T - 1) ? (p0 + 255) : (T - 1);
    const int jlast = plast >> 6, jfirst = PADR >> 6;
    const int jw = (p0 + wave * 32 + 31) >> 6;
    const bf16_t* ksrc = Kh + (size_t)lane * QKV_W + wave * 8;
    const bf16_t* vsrc = Vh + (size_t)(16 * (wave & 3) + (lane >> 2)) * QKV_W + (wave >> 2) * 32 + (lane & 3) * 8;
    const unsigned kdst = lds0 + FX_K + wave * 1024, vdst = lds0 + FX_V + wave * 1024;
#define FX_DMA(j, slot) do { glds16(ksrc + (size_t)(j) * 64 * QKV_W, (unsigned)__builtin_amdgcn_readfirstlane(kdst + (slot) * 8192)); \
                             glds16(vsrc + (size_t)(j) * 64 * QKV_W, (unsigned)__builtin_amdgcn_readfirstlane(vdst + (slot) * 8192)); \
                             if (KIND == 0) glds4(kbias + 64 * (j) + lane, (unsigned)__builtin_amdgcn_readfirstlane(lds0 + FX_KB + (slot) * 2048 + wave * 256)); } while (0)
    const int vb0 = (int)(lds0 + FX_V) + ((lane >> 4) & 1) * 32 + (lane & 3) * 8 + (4 * hi + ((lane & 15) >> 2)) * 64;
    const lds_cptr kp0 = (lds_cptr)lds + FX_K + hi * 1024 + r32 * 16;
    LAS float* wsf = (LAS float*)(lds + FX_WS) + wave * 64;
    LAS float* flg = (LAS float*)(lds + FX_FLG);
    float m_run = KIND ? 0.f : -1.0e30f, l_run = 0.f;
    f32x16 o[2]; o[0] = f32x16{}; o[1] = f32x16{};
    asm volatile("" : "+v"(qr[0]), "+v"(qr[1]), "+v"(qr[2]), "+v"(qr[3]));
    int slot = 0;
    FX_DMA(jlast, 0);
    if (jlast > jfirst) FX_DMA(jlast - 1, 1);
    for (int j = jlast; j >= jfirst; --j) {
        if (j > jfirst) { if (KIND == 0) asm volatile("s_waitcnt vmcnt(3) lgkmcnt(0)\n\ts_barrier" ::: "memory"); else asm volatile("s_waitcnt vmcnt(2) lgkmcnt(0)\n\ts_barrier" ::: "memory"); }
        else asm volatile("s_waitcnt vmcnt(0) lgkmcnt(0)\n\ts_barrier" ::: "memory");
        if (j < jlast) {
            const LAS float* fl = flg + ((j + 1) & 1) * 16;
            const f32x4 fa = *(const LAS f32x4*)(fl), fb = *(const LAS f32x4*)(fl + 4);
            bool stop;
            if constexpr (KIND == 0) {
                const float mmin = fminf(fminf(fminf(fa.x, fa.y), fminf(fa.z, fa.w)), fminf(fminf(fb.x, fb.y), fminf(fb.z, fb.w)));
                stop = (bound + fl[8] - mmin) < -150.0f;
            } else {
                const float mmax = fmaxf(fmaxf(fmaxf(fa.x, fa.y), fmaxf(fa.z, fa.w)), fmaxf(fmaxf(fb.x, fb.y), fmaxf(fb.z, fb.w)));
                stop = mmax < -150.0f;
            }
            if (stop) break;
        }
        { const int s2 = slot + 2 >= 3 ? slot - 1 : slot + 2; if (j - 2 >= jfirst) FX_DMA(j - 2, s2); }
        if (j <= jw) {
            f32x16 s0v = f32x16{}, s1v = f32x16{};
            const lds_cptr kp = kp0 + slot * 8192;
#pragma unroll
            for (int d0 = 0; d0 < 4; ++d0) {
                const bf16x8 b0 = *(const LAS bf16x8*)(kp + d0 * 2048);
                const bf16x8 b1 = *(const LAS bf16x8*)(kp + d0 * 2048 + 512);
                s0v = __builtin_amdgcn_mfma_f32_32x32x16_bf16(b0, qr[d0], s0v, 0, 0, 0);
                s1v = __builtin_amdgcn_mfma_f32_32x32x16_bf16(b1, qr[d0], s1v, 0, 0, 0);
            }
            const bool edge = (64 * j + 63 >= p0 + wave * 32) || (64 * j < PADR);
            if constexpr (KIND == 0) {
                const LAS float* kbj = (const LAS float*)(lds + FX_KB + slot * 2048 + wave * 256) + 4 * hi;
#pragma unroll
                for (int g = 0; g < 4; ++g) { const f32x4 t0 = *(const LAS f32x4*)(kbj + 8 * g), t1 = *(const LAS f32x4*)(kbj + 32 + 8 * g);
                    s0v[4 * g] += t0.x; s0v[4 * g + 1] += t0.y; s0v[4 * g + 2] += t0.z; s0v[4 * g + 3] += t0.w;
                    s1v[4 * g] += t1.x; s1v[4 * g + 1] += t1.y; s1v[4 * g + 2] += t1.z; s1v[4 * g + 3] += t1.w; }
                if (edge) {
#pragma unroll
                    for (int r = 0; r < 16; ++r) { const int key = 64 * j + crow(r, hi);
                        if (key > qp || key < PADR) s0v[r] = -INFINITY;
                        if (key + 32 > qp || key + 32 < PADR) s1v[r] = -INFINITY; }
                }
                float rm = fmaxf(s0v[0], s1v[0]);
#pragma unroll
                for (int r = 1; r < 16; ++r) rm = fmaxf(rm, fmaxf(s0v[r], s1v[r]));
                rm = halves_max(rm);
                const float m_new = fmaxf(m_run, rm);
                const float f = __builtin_amdgcn_exp2f(m_run - m_new);
                m_run = m_new;
                float rs = 0.f;
#pragma unroll
                for (int r = 0; r < 16; ++r) { s0v[r] = __builtin_amdgcn_exp2f(s0v[r] - m_new); s1v[r] = __builtin_amdgcn_exp2f(s1v[r] - m_new); rs += s0v[r] + s1v[r]; }
                rs = halves_sum(rs);
                l_run = l_run * f + rs;
                if (!__all(f == 1.0f)) {
                    if (hi == 0) wsf[r32] = f;
                    LDS_WAIT();
#pragma unroll
                    for (int d_ = 0; d_ < 2; ++d_)
#pragma unroll
                        for (int r = 0; r < 16; ++r) o[d_][r] *= wsf[crow(r, hi)];
                }
            } else {
                f32x16 l0, l1;
#pragma unroll
                for (int r = 0; r < 16; ++r) {
                    const float z0 = s0v[r], z1 = s1v[r];
                    float a0 = -(fmaxf(z0, 0.f) + __builtin_amdgcn_logf(1.f + __builtin_amdgcn_exp2f(-fabsf(z0))));
                    float a1 = -(fmaxf(z1, 0.f) + __builtin_amdgcn_logf(1.f + __builtin_amdgcn_exp2f(-fabsf(z1))));
                    if (edge) { const int key = 64 * j + crow(r, hi);
                        if (key >= qp || key < PADR) { a0 = 0.f; s0v[r] = -INFINITY; }
                        if (key + 32 >= qp || key + 32 < PADR) { a1 = 0.f; s1v[r] = -INFINITY; } }
                    l0[r] = a0; l1[r] = a1;
                }
                float A[8], SA[9], SO[9];
#pragma unroll
                for (int g = 0; g < 4; ++g) { A[g] = (l0[4 * g] + l0[4 * g + 1]) + (l0[4 * g + 2] + l0[4 * g + 3]); A[4 + g] = (l1[4 * g] + l1[4 * g + 1]) + (l1[4 * g + 2] + l1[4 * g + 3]); }
                SA[8] = 0.f; SO[8] = 0.f;
#pragma unroll
                for (int g = 7; g >= 0; --g) SA[g] = A[g] + SA[g + 1];
#pragma unroll
                for (int g = 0; g < 8; ++g) { auto rr = __builtin_amdgcn_permlane32_swap(__float_as_uint(SA[g]), __float_as_uint(SA[g]), false, false); SO[g] = __uint_as_float(hi ? rr[0] : rr[1]); }
                const float R = m_run;
#pragma unroll
                for (int g = 0; g < 8; ++g) {
                    const float E = SA[g + 1] + (hi ? SO[g + 1] : SO[g]) + R;
                    if (g < 4) { float t = E;
                        s0v[4 * g + 3] = __builtin_amdgcn_exp2f(s0v[4 * g + 3] + l0[4 * g + 3] + t); t += l0[4 * g + 3];
                        s0v[4 * g + 2] = __builtin_amdgcn_exp2f(s0v[4 * g + 2] + l0[4 * g + 2] + t); t += l0[4 * g + 2];
                        s0v[4 * g + 1] = __builtin_amdgcn_exp2f(s0v[4 * g + 1] + l0[4 * g + 1] + t); t += l0[4 * g + 1];
                        s0v[4 * g + 0] = __builtin_amdgcn_exp2f(s0v[4 * g + 0] + l0[4 * g + 0] + t);
                    } else { const int q = g - 4; float t = E;
                        s1v[4 * q + 3] = __builtin_amdgcn_exp2f(s1v[4 * q + 3] + l1[4 * q + 3] + t); t += l1[4 * q + 3];
                        s1v[4 * q + 2] = __builtin_amdgcn_exp2f(s1v[4 * q + 2] + l1[4 * q + 2] + t); t += l1[4 * q + 2];
                        s1v[4 * q + 1] = __builtin_amdgcn_exp2f(s1v[4 * q + 1] + l1[4 * q + 1] + t); t += l1[4 * q + 1];
                        s1v[4 * q + 0] = __builtin_amdgcn_exp2f(s1v[4 * q + 0] + l1[4 * q + 0] + t);
                    }
                }
                m_run = R + SA[0] + SO[0];
            }
            u32x4 pw0, pw1, pw2, pw3;
            pw0 = (u32x4){pk2(s0v[0], s0v[1]), pk2(s0v[2], s0v[3]), pk2(s0v[4], s0v[5]), pk2(s0v[6], s0v[7])};
            pw1 = (u32x4){pk2(s0v[8], s0v[9]), pk2(s0v[10], s0v[11]), pk2(s0v[12], s0v[13]), pk2(s0v[14], s0v[15])};
            pw2 = (u32x4){pk2(s1v[0], s1v[1]), pk2(s1v[2], s1v[3]), pk2(s1v[4], s1v[5]), pk2(s1v[6], s1v[7])};
            pw3 = (u32x4){pk2(s1v[8], s1v[9]), pk2(s1v[10], s1v[11]), pk2(s1v[12], s1v[13]), pk2(s1v[14], s1v[15])};
            fx_pv(o, vb0 + slot * 8192, __builtin_bit_cast(bf16x8, pw0), __builtin_bit_cast(bf16x8, pw1), __builtin_bit_cast(bf16x8, pw2), __builtin_bit_cast(bf16x8, pw3));
        }
        float mm = qvalid ? m_run : (KIND ? -3.0e38f : 3.0e38f);
        if constexpr (KIND == 0) { mm = fminf(mm, dpp_f<0x128>(mm)); mm = fminf(mm, dpp_f<0x124>(mm)); mm = fminf(mm, dpp_f<0x122>(mm)); mm = fminf(mm, dpp_f<0x121>(mm));
            { auto sw = __builtin_amdgcn_permlane16_swap(__float_as_uint(mm), __float_as_uint(mm), false, false); mm = fminf(__uint_as_float(sw[0]), __uint_as_float(sw[1])); }
            { auto sw = __builtin_amdgcn_permlane32_swap(__float_as_uint(mm), __float_as_uint(mm), false, false); mm = fminf(__uint_as_float(sw[0]), __uint_as_float(sw[1])); } }
        else { mm = fmaxf(mm, dpp_f<0x128>(mm)); mm = fmaxf(mm, dpp_f<0x124>(mm)); mm = fmaxf(mm, dpp_f<0x122>(mm)); mm = fmaxf(mm, dpp_f<0x121>(mm));
            { auto sw = __builtin_amdgcn_permlane16_swap(__float_as_uint(mm), __float_as_uint(mm), false, false); mm = fmaxf(__uint_as_float(sw[0]), __uint_as_float(sw[1])); }
            { auto sw = __builtin_amdgcn_permlane32_swap(__float_as_uint(mm), __float_as_uint(mm), false, false); mm = fmaxf(__uint_as_float(sw[0]), __uint_as_float(sw[1])); } }
        if (lane == 0) { flg[(j & 1) * 16 + wave] = mm;
            if (KIND == 0 && wave == 0) flg[(j & 1) * 16 + 8] = *(const LAS float*)(lds + FX_KB + slot * 2048); }
        slot = slot == 2 ? 0 : slot + 1;
    }
    asm volatile("s_waitcnt vmcnt(0) lgkmcnt(0)\n\ts_barrier" ::: "memory");
    float rli[16];
    if constexpr (KIND == 0) {
        if (hi == 0) wsf[32 + r32] = l_run;
        LDS_WAIT();
#pragma unroll
        for (int r = 0; r < 16; ++r) rli[r] = __builtin_amdgcn_rcpf(wsf[32 + crow(r, hi)]);
    } else {
#pragma unroll
        for (int r = 0; r < 16; ++r) rli[r] = 1.0f;
    }
    bf16_t* Ow = (bf16_t*)(a.ws + WS_YCAT) + (rowbase + p0 + wave * 32) * YC_W + (KIND ? 384 : 768) + h * 64;
    {
        LAS bf16_t* stg = (LAS bf16_t*)(lds + FX_OST) + wave * 2048;
#pragma unroll
        for (int r = 0; r < 16; ++r) { const int orow = crow(r, hi);
#pragma unroll
            for (int d0 = 0; d0 < 2; ++d0) stg[orow * 64 + d0 * 32 + r32] = f2bf(o[d0][r] * rli[r]); }
        LDS_WAIT();
#pragma unroll
        for (int i = 0; i < 4; ++i) { const int row = i * 8 + (lane >> 3), ch = lane & 7; const u32x4 v = *(const LAS u32x4*)(stg + row * 64 + ch * 8);
            const int pr = p0 + wave * 32 + row;
            if (pr >= PADR && pr < T) *(u32x4*)(Ow + (size_t)row * YC_W + ch * 8) = v; }
    }
    asm volatile("s_waitcnt lgkmcnt(0)\n\ts_barrier" ::: "memory");
#undef FX_DMA
}


constexpr int CK = 64, NCK = 257, CKB = 40960;
static_assert(LPADDED == CK * NCK, "padded steps");
__device__ __forceinline__ int swz(int row, int chunk) { return row * 128 + ((chunk ^ (row & 7)) << 4); }
__device__ __forceinline__ void ck_mm(f32x16& acc, LAS unsigned char* A, LAS unsigned char* Bt, int m0, int n0, int r32, int hi) {
#pragma unroll
    for (int ks = 0; ks < 4; ++ks) {
        const bf16x8 av = *(const LAS bf16x8*)(A + swz(m0 + r32, 2 * ks + hi));
        const bf16x8 bv = *(const LAS bf16x8*)(Bt + swz(n0 + r32, 2 * ks + hi));
        acc = __builtin_amdgcn_mfma_f32_32x32x16_bf16(av, bv, acc, 0, 0, 0);
    }
}
__device__ __forceinline__ void ck_store_t(LAS unsigned char* dst, const f32x16& acc, int m0, int n0, int r32, int hi) {
#pragma unroll
    for (int g = 0; g < 4; ++g) { const u32x2 w = {pk2(acc[4 * g], acc[4 * g + 1]), pk2(acc[4 * g + 2], acc[4 * g + 3])};
        *(LAS u32x2*)(dst + swz(n0 + r32, (m0 >> 3) + g) + hi * 8) = w; }
}
constexpr int CA_KAP = 0, CA_BET = 8192, CA_CHI = 16384, CA_RHO = 24576, CA_VMT = 32768, CA_BHT = 40960, CA_KHT = 49152, CA_AK = 57344, CA_RB = 65536, CA_RK = 73728,
              CA_AB = 81920  , CA_RHS = 98304  , CA_G64 = MISC_OFF + 2048  , CA_SCR = MISC_OFF + 4096  ;

#ifndef CA_STAGES
#define CA_STAGES 15
#endif
__device__ __forceinline__ void phase_chunkA(const ArgsL& a, Frame& F, const bool dry = false) {
    const int wave = F.wave;
    LAS unsigned char* L = F.lds;
    u32x4 pre6[6];
    for (int id = F.bx; id < 12 * NCK; id += (int)gridDim.x) {
        int tid = F.tid, lane, r32, hi;
#define CK_FRESH() do { asm volatile("" : "+v"(tid)); lane = tid & 63; r32 = lane & 31; hi = lane >> 5; } while (0)
        CK_FRESH();
        const int bh = id / NCK, c = id - bh * NCK;
        unsigned char* blk = a.ws + WS_RW + ((size_t)bh * LPADDED + (size_t)c * CK) * 768;
        {
            if (id == F.bx) {
#pragma unroll
                for (int q6 = 0; q6 < 6; ++q6) pre6[q6] = *(const u32x4*)(blk + (size_t)(tid + q6 * NTHR) * 16);
            }
#pragma unroll
            for (int q6 = 0; q6 < 6; ++q6) *(LAS u32x4*)(L + CA_AB + (tid + q6 * NTHR) * 16) = pre6[q6];
            __syncthreads();
            const int k = tid & 63, tq = tid >> 6;
            const LAS _Float16* src = (const LAS _Float16*)(L + CA_AB) + (tq * 8) * 384 + k;
            float kk[8], w[8], bb[8], kp[8], rr[8], vv[8];
#pragma unroll
            for (int e = 0; e < 8; ++e) { kk[e] = (float)src[e * 384]; w[e] = 1.f + (float)src[e * 384 + 64]; bb[e] = -(float)src[e * 384 + 128];
                kp[e] = (float)src[e * 384 + 192]; rr[e] = (float)src[e * 384 + 256]; vv[e] = (float)src[e * 384 + 320]; }
            float g[8]; g[0] = w[0];
#pragma unroll
            for (int e = 1; e < 8; ++e) g[e] = g[e - 1] * w[e];
            LAS float* scr = (LAS float*)(L + CA_SCR);
            scr[tq * 64 + k] = g[7];
            __syncthreads();
            {
                const int idn = id + (int)gridDim.x;
                if (idn < 12 * NCK) { const int bhn = idn / NCK, cn = idn - bhn * NCK; const unsigned char* bn_ = a.ws + WS_RW + ((size_t)bhn * LPADDED + (size_t)cn * CK) * 768;
#pragma unroll
                    for (int q6 = 0; q6 < 6; ++q6) pre6[q6] = *(const u32x4*)(bn_ + (size_t)(tid + q6 * NTHR) * 16); }
            }
            float pre = 1.f, tot = 1.f;
#pragma unroll
            for (int q = 0; q < 8; ++q) { const float s = scr[q * 64 + k]; if (q < tq) pre *= s; tot *= s; }
            if (tq == 0) ((LAS float*)(L + CA_G64))[k] = tot;
            unsigned bh4[4], kh4[4], vm4[4];
            float Gp = pre;
#pragma unroll
            for (int e = 0; e < 8; ++e) {
                const int t = tq * 8 + e; const float G = pre * g[e], iG = __builtin_amdgcn_rcpf(G);
                const float kap = kk[e] * Gp, bet = bb[e] * iG, chi = kp[e] * iG, rho = rr[e] * G;
                const int o = swz(t, k >> 3) + (k & 7) * 2;
                *(LAS unsigned short*)(L + CA_KAP + o) = f2bf(kap); *(LAS unsigned short*)(L + CA_BET + o) = f2bf(bet);
                *(LAS unsigned short*)(L + CA_CHI + o) = f2bf(chi); *(LAS unsigned short*)(L + CA_RHO + o) = f2bf(rho);
                ((LAS float*)(L + CA_RHS))[t * 128 + k] = kap;
                const float bhv = bet * tot, khv = chi * tot;
                if (e & 1) { bh4[e >> 1] |= (unsigned)f2bf(bhv) << 16; kh4[e >> 1] |= (unsigned)f2bf(khv) << 16; vm4[e >> 1] |= (unsigned)f2bf(vv[e]) << 16; }
                else { bh4[e >> 1] = f2bf(bhv); kh4[e >> 1] = f2bf(khv); vm4[e >> 1] = f2bf(vv[e]); }
                Gp = G;
            }
            *(LAS u32x4*)(L + CA_BHT + swz(k, tq)) = (u32x4){bh4[0], bh4[1], bh4[2], bh4[3]};
            *(LAS u32x4*)(L + CA_KHT + swz(k, tq)) = (u32x4){kh4[0], kh4[1], kh4[2], kh4[3]};
            *(LAS u32x4*)(L + CA_VMT + swz(k, tq)) = (u32x4){vm4[0], vm4[1], vm4[2], vm4[3]};
        }
        __syncthreads();
        CK_FRESH();
        if (!dry || (CA_STAGES & 2)) {
            const int p = wave & 3, nb = wave >> 2;
            LAS unsigned char* Am = L + ((p & 1) ? CA_CHI : CA_BET);
            LAS unsigned char* Bm = L + ((p & 2) ? CA_RHO : CA_KAP);
#pragma unroll
            for (int mb = 0; mb < 2; ++mb) {
                f32x16 acc = f32x16{};
                if (!(mb == 1 && nb == 0)) ck_mm(acc, Am, Bm, mb * 32, nb * 32, r32, hi);
                const int t = nb * 32 + r32;
#pragma unroll
                for (int i = 0; i < 16; ++i) { const int j = mb * 32 + crow(i, hi); const bool keep = (p & 2) ? (j <= t) : (j < t); if (!keep) acc[i] = 0.f; }
                if (p == 0) {
#pragma unroll
                    for (int gq = 0; gq < 4; ++gq) { LAS float* ab_ = (LAS float*)(L + CA_AB) + t * 64 + (mb * 8 + 2 * gq + hi);
                        ab_[0] = acc[4 * gq]; ab_[16] = acc[4 * gq + 1]; ab_[32] = acc[4 * gq + 2]; ab_[48] = acc[4 * gq + 3]; }
                } else ck_store_t(L + (p == 1 ? CA_AK : p == 2 ? CA_RB : CA_RK), acc, mb * 32, nb * 32, r32, hi);
            }
        }
        __syncthreads();
        CK_FRESH();
        if (wave < 4 && (!dry || (CA_STAGES & 2))) {
            const int mb = wave >> 1, nb = wave & 1;
            f32x16 acc = f32x16{};
            ck_mm(acc, L + CA_AK, L + CA_VMT, mb * 32, nb * 32, r32, hi);
#pragma unroll
            for (int i = 0; i < 16; ++i) ((LAS float*)(L + CA_RHS))[(mb * 32 + crow(i, hi)) * 128 + 64 + nb * 32 + r32] = acc[i];
        }
        __syncthreads();
        CK_FRESH();
        if (!dry || (CA_STAGES & 4)) {
            const int col = tid >> 2, p = tid & 3;
            unsigned abv = (unsigned)(uintptr_t)(L + CA_AB) + p * 64; asm volatile("" : "+v"(abv));
            const LAS float* ab = (const LAS float*)(uintptr_t)abv;
            const LAS float* rhs = (const LAS float*)(L + CA_RHS) + col;
            float xo[16];
#pragma unroll
            for (int i = 0; i < 16; ++i) xo[i] = 0.f;
#pragma unroll
            for (int tg = 0; tg < 64; tg += 4) {
                f32x4 av[4][4]; float rv[4];
#pragma unroll
                for (int r = 0; r < 4; ++r) { rv[r] = rhs[(tg + r) * 128];
#pragma unroll
                    for (int i4 = 0; i4 < (tg + r + 15) / 16; ++i4) av[r][i4] = *(const LAS f32x4*)(ab + (tg + r) * 64 + 4 * i4); }
#pragma unroll
                for (int r = 0; r < 4; ++r) { const int t = tg + r;
                    float s0 = (p == 0) ? rv[r] : 0.f, s1 = 0.f;
#pragma unroll
                    for (int i4 = 0; i4 < (t + 15) / 16; ++i4) {
                        s0 -= av[r][i4].x * xo[4 * i4]; s1 -= av[r][i4].y * xo[4 * i4 + 1]; s0 -= av[r][i4].z * xo[4 * i4 + 2]; s1 -= av[r][i4].w * xo[4 * i4 + 3]; }
                    float sx = s0 + s1;
                    sx += dpp_f<0xB1>(sx);
                    sx += dpp_f<0x4E>(sx);
                    if ((t & 3) == p) xo[t >> 2] = sx;
                    asm volatile("" : "+v"(xo[t >> 2]));
                }
                __builtin_amdgcn_sched_barrier(0);
            }
            LAS unsigned char* dst = L + (col < 64 ? CA_KAP : CA_BET);
            const int rowc = col & 63;
#pragma unroll
            for (int i = 0; i < 16; ++i) { const int tt = 4 * i + p; *(LAS unsigned short*)(dst + swz(rowc, tt >> 3) + (tt & 7) * 2) = f2bf(-xo[i]); }
        }
        __syncthreads();
        CK_FRESH();
        if (!dry || (CA_STAGES & 8)) {
            const int ty = wave >> 1;
            LAS unsigned char* nW1 = L + CA_KAP; LAS unsigned char* nW2 = L + CA_BET;
#pragma unroll
            for (int qq = 0; qq < 2; ++qq) {
                const int q = (wave & 1) * 2 + qq, qa = q >> 1, qb = q & 1;
                f32x16 acc = f32x16{};
                if (ty == 0) {
                    const int t = qa * 32 + r32;
#pragma unroll
                    for (int gq = 0; gq < 4; ++gq) { const u32x2 rv = *(const LAS u32x2*)(L + CA_RHO + swz(t, qb * 4 + gq) + hi * 8);
                        acc[4 * gq] = bf_lo(rv.x); acc[4 * gq + 1] = bf_hi(rv.x); acc[4 * gq + 2] = bf_lo(rv.y); acc[4 * gq + 3] = bf_hi(rv.y); }
                    ck_mm(acc, nW1, L + CA_RB, qb * 32, qa * 32, r32, hi);
                } else if (ty == 1) {
                    ck_mm(acc, nW1, L + CA_BHT, qb * 32, qa * 32, r32, hi);
                    if (qa == qb) { const float g64 = ((const LAS float*)(L + CA_G64))[qa * 32 + r32];
#pragma unroll
                        for (int i = 0; i < 16; ++i) if (crow(i, hi) == r32) acc[i] += g64; }
                } else if (ty == 2) {
                    ck_mm(acc, L + CA_KHT, L + CA_VMT, qb * 32, qa * 32, r32, hi);
                    ck_mm(acc, L + CA_BHT, nW2, qb * 32, qa * 32, r32, hi);
                } else {
                    ck_mm(acc, L + CA_RK, L + CA_VMT, qb * 32, qa * 32, r32, hi);
                    ck_mm(acc, L + CA_RB, nW2, qb * 32, qa * 32, r32, hi);
                }
                if (dry) { float sink = acc[0] + acc[5] + acc[10] + acc[15]; asm volatile("" :: "v"(sink)); }
                else if (ty < 2) {
                    unsigned char* o = blk + (ty == 0 ? 8192 : 0) + (size_t)(((qa * 2 + qb) * 2) * 1024) + lane * 16;
#pragma unroll
                    for (int ks = 0; ks < 2; ++ks)
                        *(u32x4*)(o + ks * 1024) = (u32x4){pk2(acc[8 * ks], acc[8 * ks + 1]), pk2(acc[8 * ks + 2], acc[8 * ks + 3]), pk2(acc[8 * ks + 4], acc[8 * ks + 5]), pk2(acc[8 * ks + 6], acc[8 * ks + 7])};
                } else if (ty == 2) {
                    unsigned char* o = blk + 16384 + (qa * 2 + qb) * 4096 + lane * 16;
#pragma unroll
                    for (int g = 0; g < 4; ++g) *(f32x4*)(o + g * 1024) = (f32x4){acc[4 * g], acc[4 * g + 1], acc[4 * g + 2], acc[4 * g + 3]};
                } else {
                    unsigned char* o = blk + 32768 + (qa * 2 + qb) * 2048 + lane * 8;
#pragma unroll
                    for (int g = 0; g < 4; ++g) *(u32x2*)(o + g * 512) = (u32x2){pk2(acc[4 * g], acc[4 * g + 1]), pk2(acc[4 * g + 2], acc[4 * g + 3])};
                }
            }
        }
        __syncthreads();
    }
}

__device__ __forceinline__ void rwkv_chunkB(const ArgsL& a, Frame& F, int bh) {
    const int lane = F.lane, wave = F.wave, r32 = lane & 31, hi = lane >> 5;
    const int b = bh / RW_H, h = bh % RW_H;
    LAS unsigned char* L = F.lds;
    const unsigned char* base = a.ws + WS_RW + (size_t)bh * LPADDED * 768;
    bf16_t* y0 = (bf16_t*)(a.ws + WS_YCAT);
    const bool isld = (wave & 2) != 0; const int lw = (wave & 1) + ((wave >> 2) << 1);
    LAS unsigned char* yimg0 = L + 3 * CKB; LAS unsigned char* yimg1 = L + MISC_OFF + 8192;
#define CB_ISSUE(cc) do { const unsigned char* s_ = base + (size_t)(cc) * CK * 768 + (size_t)lw * 1024 + lane * 16; LAS unsigned char* d_ = L + ((cc) % 3) * CKB + lw * 1024; \
        _Pragma("unroll") for (int r_ = 0; r_ < 10; ++r_) __builtin_amdgcn_global_load_lds((const unsigned*)(s_ + r_ * 4096), (LAS unsigned*)(d_ + r_ * 4096), 16, 0, 0); } while (0)
#define CB_YOUT(cc) do { const LAS unsigned char* im_ = ((cc) & 1) ? yimg1 : yimg0; \
        _Pragma("unroll") for (int r_ = 0; r_ < 8; ++r_) { const int t_ = r_ * 8 + (lane >> 3), l_ = (cc) * CK + t_; const u32x4 v_ = *(const LAS u32x4*)(im_ + t_ * 128 + (lane & 7) * 16); \
            if (l_ < LTOK) *(u32x4*)(y0 + (size_t)(b * T + PADR + l_) * YC_W + h * 64 + (lane & 7) * 8) = v_; } } while (0)
    if (isld) { CB_ISSUE(0); CB_ISSUE(1); asm volatile("s_waitcnt vmcnt(10)" ::: "memory"); }
    asm volatile("s_waitcnt lgkmcnt(0)\n\ts_barrier" ::: "memory");
    f32x16 Z0 = f32x16{}, Z1 = f32x16{};
    for (int c = 0; c < NCK; ++c) {
        if (isld) {
            if (wave == 6 && c > 0) CB_YOUT(c - 1);
            if (c + 2 < NCK) CB_ISSUE(c + 2);
            if (c + 2 < NCK) asm volatile("s_waitcnt vmcnt(10)" ::: "memory"); else asm volatile("s_waitcnt vmcnt(0)" ::: "memory");
        } else if (wave < 2) {
            const LAS unsigned char* S = L + (c % 3) * CKB;
            LAS unsigned char* yim = (c & 1) ? yimg1 : yimg0;
            const int vb = wave;
            bf16x8 zf[2][2];
#pragma unroll
            for (int ks = 0; ks < 2; ++ks) {
                zf[0][ks] = __builtin_bit_cast(bf16x8, (u32x4){pk2(Z0[8 * ks], Z0[8 * ks + 1]), pk2(Z0[8 * ks + 2], Z0[8 * ks + 3]), pk2(Z0[8 * ks + 4], Z0[8 * ks + 5]), pk2(Z0[8 * ks + 6], Z0[8 * ks + 7])});
                zf[1][ks] = __builtin_bit_cast(bf16x8, (u32x4){pk2(Z1[8 * ks], Z1[8 * ks + 1]), pk2(Z1[8 * ks + 2], Z1[8 * ks + 3]), pk2(Z1[8 * ks + 4], Z1[8 * ks + 5]), pk2(Z1[8 * ks + 6], Z1[8 * ks + 7])});
            }
#pragma unroll
            for (int tb = 0; tb < 2; ++tb) {
                f32x16 acc;
                const LAS unsigned char* yt = S + 32768 + (vb * 2 + tb) * 2048 + lane * 8;
#pragma unroll
                for (int g = 0; g < 4; ++g) { const u32x2 w = *(const LAS u32x2*)(yt + g * 512); acc[4 * g] = bf_lo(w.x); acc[4 * g + 1] = bf_hi(w.x); acc[4 * g + 2] = bf_lo(w.y); acc[4 * g + 3] = bf_hi(w.y); }
#pragma unroll
                for (int kb2 = 0; kb2 < 2; ++kb2)
#pragma unroll
                    for (int ks = 0; ks < 2; ++ks) { const bf16x8 pa = *(const LAS bf16x8*)(S + 8192 + ((tb * 2 + kb2) * 2 + ks) * 1024 + lane * 16);
                        acc = __builtin_amdgcn_mfma_f32_32x32x16_bf16(pa, zf[kb2][ks], acc, 0, 0, 0); }
#pragma unroll
                for (int i = 0; i < 16; ++i) *(LAS unsigned short*)(yim + (tb * 32 + crow(i, hi)) * 128 + (vb * 32 + r32) * 2) = f2bf(acc[i]);
            }
            f32x16 N0, N1;
            { const LAS unsigned char* n0 = S + 16384 + (vb * 2 + 0) * 4096 + lane * 16; const LAS unsigned char* n1 = S + 16384 + (vb * 2 + 1) * 4096 + lane * 16;
#pragma unroll
              for (int g = 0; g < 4; ++g) { const f32x4 u0 = *(const LAS f32x4*)(n0 + g * 1024), u1 = *(const LAS f32x4*)(n1 + g * 1024);
                  N0[4 * g] = u0.x; N0[4 * g + 1] = u0.y; N0[4 * g + 2] = u0.z; N0[4 * g + 3] = u0.w; N1[4 * g] = u1.x; N1[4 * g + 1] = u1.y; N1[4 * g + 2] = u1.z; N1[4 * g + 3] = u1.w; } }
#pragma unroll
            for (int kb2 = 0; kb2 < 2; ++kb2)
#pragma unroll
                for (int ks = 0; ks < 2; ++ks) {
                    const bf16x8 m0 = *(const LAS bf16x8*)(S + ((0 * 2 + kb2) * 2 + ks) * 1024 + lane * 16);
                    const bf16x8 m1 = *(const LAS bf16x8*)(S + ((1 * 2 + kb2) * 2 + ks) * 1024 + lane * 16);
                    N0 = __builtin_amdgcn_mfma_f32_32x32x16_bf16(m0, zf[kb2][ks], N0, 0, 0, 0);
                    N1 = __builtin_amdgcn_mfma_f32_32x32x16_bf16(m1, zf[kb2][ks], N1, 0, 0, 0);
                }
            Z0 = N0; Z1 = N1;
        }
        asm volatile("s_waitcnt lgkmcnt(0)\n\ts_barrier" ::: "memory");
    }
    if (wave == 6) CB_YOUT(NCK - 1);
    asm volatile("s_waitcnt vmcnt(0) lgkmcnt(0)\n\ts_barrier" ::: "memory");
#undef CB_ISSUE
#undef CB_YOUT
}

constexpr int N_FX_UNITS = 65 * 10, N_SB_UNITS = 65 * 10, N_RW_WG = 192;
#ifndef REP_SCAN
#define REP_SCAN 1
#endif
#ifndef REP_SCAN_DRY
#define REP_SCAN_DRY 0
#endif
#ifndef REP_FOX
#define REP_FOX 1
#endif
#ifndef REP_SB
#define REP_SB 1
#endif
__device__ __forceinline__ void phase_mix(const ArgsL& a, Frame& F, int layer) {
#ifdef SEQ_SCAN
    if (F.bx < N_RW_WG) { int nr = REP_SCAN; asm volatile("" : "+s"(nr)); for (int r = 0; r < nr; ++r) rwkv_scan(a, F, F.bx, (r + 1 < nr) ? REP_SCAN_DRY : 0); }
#else
#ifndef REP_CHB
#define REP_CHB 1
#endif
    if (F.bx < 12) { int nr = REP_CHB; asm volatile("" : "+s"(nr)); for (int r = 0; r < nr; ++r) rwkv_chunkB(a, F, F.bx); }
#endif
    float gqm = fabsf(a.in(I_QG)[layer * 64 + F.lane]), gkm = fabsf(a.in(I_KG)[layer * 64 + F.lane]);
#pragma unroll
    for (int off = 1; off < 64; off <<= 1) { gqm = fmaxf(gqm, __shfl_xor(gqm, off)); gkm = fmaxf(gkm, __shfl_xor(gkm, off)); }
    const float bound = 64.0f * C2 * gqm * gkm * 1.02f + 0.5f;
    unsigned* head = (unsigned*)(a.ws + WS_CTL) + CW_QUEUE + 64 * layer;
    for (;;) {
        if (F.tid == 0) F.MISC[16] = __hip_atomic_fetch_add(head, 1u, __ATOMIC_RELAXED, __HIP_MEMORY_SCOPE_AGENT);
        __syncthreads();
        const int u = (int)F.MISC[16];
        __syncthreads();
        if (u >= N_FX_UNITS + N_SB_UNITS) break;
        if (u < N_FX_UNITS) { const int qb = 64 - u / 10, bh = u % 10; int nr = REP_FOX; asm volatile("" : "+s"(nr)); for (int r = 0; r < nr; ++r) attn_unit<0>(a, F, bh / FX_H, bh % FX_H, qb, bound); }
        else { const int v = u - N_FX_UNITS; const int qb = 64 - v / 10, bh = v % 10; int nr = REP_SB; asm volatile("" : "+s"(nr)); for (int r = 0; r < nr; ++r) attn_unit<1>(a, F, bh / SB_H, bh % SB_H, qb, bound); }
    }
}

__device__ __forceinline__ void phase_post(const ArgsL& a, Frame& F, int layer, const bool dry = false) {
    const int lane = F.lane, wave = F.wave, it4 = lane >> 4, e4 = lane & 15;
    bf16_t* Y0 = (bf16_t*)(a.ws + WS_YCAT); const bf16_t* BN = (const bf16_t*)(a.ws + WS_BN);
    LAS float* lgl = (LAS float*)F.lds;
    for (int i = F.tid; i < 2 * RW_W; i += NTHR) lgl[i] = (i < RW_W) ? a.in(I_LNG)[layer * RW_W + i] : a.in(I_LNB)[layer * RW_W + i - RW_W];
    __syncthreads();
    unsigned* head = (unsigned*)(a.ws + WS_CTL) + CW_QUEUE + 64 * layer + 32 + (dry ? 8 : 0);
    for (;;) {
        if (F.tid == 0) F.MISC[17] = __hip_atomic_fetch_add(head, 1u, __ATOMIC_RELAXED, __HIP_MEMORY_SCOPE_AGENT);
        __syncthreads();
        const int ch = (int)F.MISC[17];
        __syncthreads();
        if (ch >= M / 64) break;
        u32x2 yn = {0u, 0u}, bn = {0u, 0u};
#define PP_ADDR(ps) const int item_ = (ps) * 32 + wave * 4 + it4, rw_ = item_ / 6, hh_ = item_ - rw_ * 6; const int m_ = ch * 64 + rw_; const size_t off_ = (size_t)m_ * RW_W + hh_ * 64 + e4 * 4, offy_ = (size_t)m_ * YC_W + hh_ * 64 + e4 * 4
        { PP_ADDR(0); yn = *(const u32x2*)(Y0 + offy_); bn = *(const u32x2*)(BN + off_); }
#pragma unroll 1
        for (int ps = 0; ps < 12; ++ps) {
            const u32x2 yv = yn, bv = bn;
            if (ps + 1 < 12) { PP_ADDR(ps + 1); yn = *(const u32x2*)(Y0 + offy_); bn = *(const u32x2*)(BN + off_); }
            PP_ADDR(ps);
            const int p = m_ % T;
            u32x2 w = {0u, 0u};
            if (p >= PADR) {
                const float y0 = bf_lo(yv.x), y1 = bf_hi(yv.x), y2 = bf_lo(yv.y), y3 = bf_hi(yv.y);
                const float mean = allred16((y0 + y1) + (y2 + y3)) * (1.f / 64.f);
                const float d0 = y0 - mean, d1 = y1 - mean, d2 = y2 - mean, d3 = y3 - mean;
                const float rs = 1.0f / sqrtf(allred16((d0 * d0 + d1 * d1) + (d2 * d2 + d3 * d3)) * (1.f / 64.f) + 64e-5f);
                const f32x4 g4 = *(const LAS f32x4*)(lgl + hh_ * 64 + e4 * 4), b4 = *(const LAS f32x4*)(lgl + RW_W + hh_ * 64 + e4 * 4);
                w = (u32x2){pk2(d0 * rs * g4.x + b4.x + bf_lo(bv.x), d1 * rs * g4.y + b4.y + bf_hi(bv.x)), pk2(d2 * rs * g4.z + b4.z + bf_lo(bv.y), d3 * rs * g4.w + b4.w + bf_hi(bv.y))};
            }
            if (!dry) *(u32x2*)(Y0 + offy_) = w; else asm volatile("" :: "v"(w.x), "v"(w.y));
        }
#undef PP_ADDR
        if (!dry) {
#pragma unroll 1
            for (int k = 0; k < 16; ++k) { const int pr = wave * 16 + k, sl = pr >> 6, m2 = ch * 64 + (pr & 63); const int p = m2 % T;
                bf16_t* row = Y0 + (size_t)m2 * YC_W + 384 * (sl + 1);
                if (p < PADR) { for (int c = lane; c < RW_W / 2; c += 64) ((unsigned*)row)[c] = 0u; }
                else if (lane < 32) ((unsigned*)(row + 320))[lane] = 0u; }
        }
    }
}

struct EpiInproj { static constexpr bool PERM = true, AFTER_DRAIN = false, MIDHOOK = false; bf16_t* ush; bf16_t* qkv;
    __device__ __forceinline__ void operator()(const f32x4 (&acc)[2][2][4][2], const pg8::Unit& u, int wr, int wc, int fr, int fq) const {
        asm volatile("" : "+v"(fr), "+v"(fq));
        const int row0 = u.pm * 256 + wr * 64 + fr, colt = u.pn * 256 + wc * 32 + 8 * fq;
#pragma unroll
        for (int ai = 0; ai < 2; ++ai)
#pragma unroll
            for (int m = 0; m < 4; ++m) { const size_t row = (size_t)(row0 + ai * 128 + m * 16);
#pragma unroll
                for (int bj = 0; bj < 2; ++bj) { const int col = colt + bj * 128; const f32x4 v0 = acc[ai][bj][m][0], v1 = acc[ai][bj][m][1];
                    const float sc = (col >= SHIFT_W && col < SHIFT_W + 320) ? C2 : 1.0f;
                    u32x4 w; w.x = pk2(v0[0] * sc, v0[1] * sc); w.y = pk2(v0[2] * sc, v0[3] * sc); w.z = pk2(v1[0] * sc, v1[1] * sc); w.w = pk2(v1[2] * sc, v1[3] * sc);
                    if (col < SHIFT_W) *(u32x4*)(ush + row * SHIFT_W + col) = w;
                    else if (col < SHIFT_W + QKV_W) *(u32x4*)(qkv + row * QKV_W + (col - SHIFT_W)) = w; } }
    }
};
struct EpiGates { static constexpr bool PERM = true, AFTER_DRAIN = false, MIDHOOK = false; bf16_t* gates;
    __device__ __forceinline__ void operator()(const f32x4 (&acc)[2][2][4][2], const pg8::Unit& u, int wr, int wc, int fr, int fq) const {
        asm volatile("" : "+v"(fr), "+v"(fq));
        const int row0 = u.pm * 256 + wr * 64 + fr, colt = u.pn * 256 + wc * 32 + 8 * fq;
#pragma unroll
        for (int ai = 0; ai < 2; ++ai)
#pragma unroll
            for (int m = 0; m < 4; ++m) { const size_t row = (size_t)(row0 + ai * 128 + m * 16);
#pragma unroll
                for (int bj = 0; bj < 2; ++bj) { const int col = colt + bj * 128; f32x4 v0 = acc[ai][bj][m][0], v1 = acc[ai][bj][m][1];
#pragma unroll
                    for (int q = 0; q < 4; ++q) { v0[q] = __builtin_amdgcn_rcpf(1.f + __builtin_amdgcn_exp2f(-v0[q] * LOG2E)); v1[q] = __builtin_amdgcn_rcpf(1.f + __builtin_amdgcn_exp2f(-v1[q] * LOG2E)); }
                    u32x4 w; w.x = pk2(v0[0], v0[1]); w.y = pk2(v0[2], v0[3]); w.z = pk2(v1[0], v1[1]); w.w = pk2(v1[2], v1[3]);
                    *(u32x4*)(gates + row * 3072 + col) = w; } }
    }
};
struct EpiMergeF { static constexpr bool PERM = true, AFTER_DRAIN = false, MIDHOOK = true; const bf16_t* gates; bf16_t* merged;
    __device__ __forceinline__ void mid(f32x4 (&acc)[2][2][4][2], const pg8::Unit& u, int wr, int wc, int fr, int fq, int seg) const {
        asm volatile("" : "+v"(fr), "+v"(fq));
        const int row0 = u.pm * 256 + wr * 64 + fr, colt = u.pn * 256 + wc * 32 + 8 * fq;
#pragma unroll
        for (int q = 0; q < 8; ++q) { const int ai = q >> 2, m = q & 3; const size_t row = (size_t)(row0 + ai * 128 + m * 16);
            u32x4 gp[2], gn[2];
#pragma unroll
            for (int bj = 0; bj < 2; ++bj) { const bf16_t* gpt = gates + row * 3072 + (seg - 1) * 1024 + colt + bj * 128; gp[bj] = *(const u32x4*)gpt; gn[bj] = *(const u32x4*)(gpt + 1024); }
#pragma unroll
            for (int bj = 0; bj < 2; ++bj) { f32x4& v0 = acc[ai][bj][m][0]; f32x4& v1 = acc[ai][bj][m][1];
                v0[0] *= bf_lo(gp[bj].x) * __builtin_amdgcn_rcpf(bf_lo(gn[bj].x)); v0[1] *= bf_hi(gp[bj].x) * __builtin_amdgcn_rcpf(bf_hi(gn[bj].x));
                v0[2] *= bf_lo(gp[bj].y) * __builtin_amdgcn_rcpf(bf_lo(gn[bj].y)); v0[3] *= bf_hi(gp[bj].y) * __builtin_amdgcn_rcpf(bf_hi(gn[bj].y));
                v1[0] *= bf_lo(gp[bj].z) * __builtin_amdgcn_rcpf(bf_lo(gn[bj].z)); v1[1] *= bf_hi(gp[bj].z) * __builtin_amdgcn_rcpf(bf_hi(gn[bj].z));
                v1[2] *= bf_lo(gp[bj].w) * __builtin_amdgcn_rcpf(bf_lo(gn[bj].w)); v1[3] *= bf_hi(gp[bj].w) * __builtin_amdgcn_rcpf(bf_hi(gn[bj].w)); }
            if (q & 1) __builtin_amdgcn_sched_barrier(0); }
    }
    __device__ __forceinline__ void operator()(const f32x4 (&acc)[2][2][4][2], const pg8::Unit& u, int wr, int wc, int fr, int fq) const {
        asm volatile("" : "+v"(fr), "+v"(fq));
        const int row0 = u.pm * 256 + wr * 64 + fr, colt = u.pn * 256 + wc * 32 + 8 * fq;
#pragma unroll
        for (int q = 0; q < 8; ++q) { const int ai = q >> 2, m = q & 3; const size_t row = (size_t)(row0 + ai * 128 + m * 16);
            u32x4 g[2];
#pragma unroll
            for (int bj = 0; bj < 2; ++bj) g[bj] = *(const u32x4*)(gates + row * 3072 + 2048 + colt + bj * 128);
#pragma unroll
            for (int bj = 0; bj < 2; ++bj) { const f32x4 v0 = acc[ai][bj][m][0], v1 = acc[ai][bj][m][1];
                u32x4 w;
                w.x = pk2(bf_lo(g[bj].x) * v0[0], bf_hi(g[bj].x) * v0[1]); w.y = pk2(bf_lo(g[bj].y) * v0[2], bf_hi(g[bj].y) * v0[3]);
                w.z = pk2(bf_lo(g[bj].z) * v1[0], bf_hi(g[bj].z) * v1[1]); w.w = pk2(bf_lo(g[bj].w) * v1[2], bf_hi(g[bj].w) * v1[3]);
                *(u32x4*)(merged + row * D + colt + bj * 128) = w; }
            if (q & 1) __builtin_amdgcn_sched_barrier(0); }
    }
};
struct EpiOut { static constexpr bool PERM = true, AFTER_DRAIN = false, MIDHOOK = false; bf16_t* hb;
    __device__ __forceinline__ void operator()(const f32x4 (&acc)[2][2][4][2], const pg8::Unit& u, int wr, int wc, int fr, int fq) const {
        asm volatile("" : "+v"(fr), "+v"(fq));
        const int row0 = u.pm * 256 + wr * 64 + fr, colt = u.pn * 256 + wc * 32 + 8 * fq;
        u32x4 hn[2];
#define OUT_LOAD(q) do { const bf16_t* p_ = hb + (size_t)(row0 + ((q) >> 2) * 128 + ((q) & 3) * 16) * D + colt; hn[0] = *(const u32x4*)(p_); hn[1] = *(const u32x4*)(p_ + 128); } while (0)
        OUT_LOAD(0);
#pragma unroll
        for (int q = 0; q < 8; ++q) {
            const int ai = q >> 2, m = q & 3;
            bf16_t* hp = hb + (size_t)(row0 + ai * 128 + m * 16) * D + colt; const u32x4 h0 = hn[0], h1 = hn[1];
            if (q < 7) OUT_LOAD(q + 1);
#pragma unroll
            for (int bj = 0; bj < 2; ++bj) { const u32x4 hh = bj ? h1 : h0; const f32x4 v0 = acc[ai][bj][m][0], v1 = acc[ai][bj][m][1];
                u32x4 w; w.x = pk2(bf_lo(hh.x) + v0[0], bf_hi(hh.x) + v0[1]); w.y = pk2(bf_lo(hh.y) + v0[2], bf_hi(hh.y) + v0[3]);
                w.z = pk2(bf_lo(hh.z) + v1[0], bf_hi(hh.z) + v1[1]); w.w = pk2(bf_lo(hh.w) + v1[2], bf_hi(hh.w) + v1[3]);
                *(u32x4*)(hp + bj * 128) = w; }
            __builtin_amdgcn_sched_barrier(0);
        }
#undef OUT_LOAD
    }
};
struct MoeOrder { const volatile LAS int* tb; int ntile, npt, G, c, rep;
    __device__ __forceinline__ bool next(int i, pg8::Unit& u) const { long L = (long)i * G + c; if (L >= (long)ntile * npt * rep) return false; L %= (long)ntile * npt;
        const int tau = (int)(L / npt), j = (int)(L - (long)tau * npt); int e = 0;
#pragma unroll
        for (int k = 1; k < 16; ++k) e += (tau >= tb[k]) ? 1 : 0;
        u.pm = tau; u.pn = __builtin_amdgcn_readfirstlane(e) * npt + j; return true; }
    __device__ __forceinline__ void a_ready(const pg8::Unit&) const {}
    __device__ __forceinline__ void done(const pg8::Unit&) const {}
};
struct EpiMoeUp { static constexpr bool PERM = true, AFTER_DRAIN = false, MIDHOOK = false; bf16_t* hs;
    __device__ __forceinline__ void operator()(const f32x4 (&acc)[2][2][4][2], const pg8::Unit& u, int wr, int wc, int fr, int fq) const {
        asm volatile("" : "+v"(fr), "+v"(fq));
        const int row0 = u.pm * 256 + wr * 64 + fr, col = (u.pn & 1) * 128 + wc * 32 + 8 * fq;
#pragma unroll
        for (int ai = 0; ai < 2; ++ai)
#pragma unroll
            for (int m = 0; m < 4; ++m) { const size_t row = (size_t)(row0 + ai * 128 + m * 16); float r[8];
#pragma unroll
                for (int n = 0; n < 2; ++n)
#pragma unroll
                    for (int q = 0; q < 4; ++q) { const float gte = acc[ai][0][m][n][q], up = acc[ai][1][m][n][q]; r[4 * n + q] = gte * __builtin_amdgcn_rcpf(1.f + __builtin_amdgcn_exp2f(-gte * LOG2E)) * up; }
                u32x4 w; w.x = pk2(r[0], r[1]); w.y = pk2(r[2], r[3]); w.z = pk2(r[4], r[5]); w.w = pk2(r[6], r[7]);
                *(u32x4*)(hs + row * DEXP + col) = w; }
    }
};
struct EpiMoeDown { static constexpr bool PERM = true, AFTER_DRAIN = false, MIDHOOK = false; bf16_t* y; const float* cws;
    __device__ __forceinline__ void operator()(const f32x4 (&acc)[2][2][4][2], const pg8::Unit& u, int wr, int wc, int fr, int fq) const {
        asm volatile("" : "+v"(fr), "+v"(fq));
        const int row0 = u.pm * 256 + wr * 64 + fr, colt = (u.pn & 3) * 256 + wc * 32 + 8 * fq;
        float cw[8];
#pragma unroll
        for (int q = 0; q < 8; ++q) cw[q] = cws[row0 + (q >> 2) * 128 + (q & 3) * 16];
#pragma unroll
        for (int ai = 0; ai < 2; ++ai)
#pragma unroll
            for (int m = 0; m < 4; ++m) { const size_t row = (size_t)(row0 + ai * 128 + m * 16); const float cwv = cw[ai * 4 + m];
#pragma unroll
                for (int bj = 0; bj < 2; ++bj) { const int col = colt + bj * 128; const f32x4 v0 = acc[ai][bj][m][0] * cwv, v1 = acc[ai][bj][m][1] * cwv;
                    u32x4 w; w.x = pk2(v0[0], v0[1]); w.y = pk2(v0[2], v0[3]); w.z = pk2(v1[0], v1[1]); w.w = pk2(v1[2], v1[3]);
                    *(u32x4*)(y + row * D + col) = w; } }
    }
};


#ifndef PH_MASK
#define PH_MASK 0xFFFF
#endif
#define PH(k) ((PH_MASK >> (k)) & 1)
#ifndef PROBE_DUP
#define PROBE_DUP 0
#endif
#define DUPN(bit) (((PROBE_DUP >> (bit)) & 1) ? 2 : 1)
#ifndef PROBE_THIN
#define PROBE_THIN 0
#endif
#define THIN(bit) ((PROBE_THIN >> (bit)) & 1)
#define FRESH() do { asm volatile("" : "+v"(F.tid)); F.lane = F.tid & 63; F.wave = __builtin_amdgcn_readfirstlane(F.tid >> 6); { int bx_ = (int)blockIdx.x; asm volatile("" : "+s"(bx_)); F.bx = bx_; } { unsigned char* w_ = a.ws; asm volatile("" : "+s"(w_)); a.ws = w_; } } while (0)
__global__ void __launch_bounds__(NTHR, 2) hybrid_fwd(Args ka) {
    extern __shared__ __attribute__((aligned(16))) unsigned char lds_raw[];
    Frame F;
    F.lds = (LAS unsigned char*)lds_raw;
    F.MISC = (volatile LAS unsigned*)(F.lds + MISC_OFF);
    F.tid = threadIdx.x; F.lane = F.tid & 63; F.wave = __builtin_amdgcn_readfirstlane(F.tid >> 6); F.bx = (int)blockIdx.x;
    for (int u = F.tid; u < (LDS_BYTES - MISC_OFF) / 4; u += NTHR) ((LAS unsigned*)(F.lds + MISC_OFF))[u] = 0u;
    __syncthreads();
    if (F.tid < 29) { const unsigned long long p = (unsigned long long)ka.in[F.tid]; F.MISC[64 + 2 * F.tid] = (unsigned)p; F.MISC[65 + 2 * F.tid] = (unsigned)(p >> 32); }
    __syncthreads();
    ArgsL a; a.tab = F.MISC + 64; a.out = ka.out; a.ws = ka.ws;
    XcdBarrier bar = xcd_barrier_post((unsigned*)(a.ws + WS_CTL) + CW_BAR, F.MISC + 8);
    const int G = (int)gridDim.x, c = (int)blockIdx.x;
    PG8_LAS unsigned char* ring = (PG8_LAS unsigned char*)F.lds;

#ifdef PROF_K
    volatile LAS unsigned* tsl = F.MISC + 1536; int nts = 0;
    if (blockIdx.x == 0 && F.tid == 0) tsl[nts] = (unsigned)__builtin_amdgcn_s_memrealtime();
    ++nts;
#define BARX() do { xcd_barrier(bar); if (blockIdx.x == 0 && F.tid == 0) tsl[nts] = (unsigned)__builtin_amdgcn_s_memrealtime(); ++nts; } while (0)
#else
#define BARX() xcd_barrier(bar)
#endif
    for (int layer = 0; layer < DEPTH; ++layer) {
        for (int rep = 0; rep < DUPN(8); ++rep) { FRESH(); if (PH(0)) phase_wconv(a, F, layer); }
        __syncthreads();
        if (THIN(0)) { FRESH(); phase_norm<1>(a, F, layer, true); }
        FRESH(); if (PH(1)) phase_norm<1>(a, F, layer);
        BARX();
        FRESH(); if (PH(2)) {
            pg8::Gemm g{(const bf16_t*)A_PTR(a), (const bf16_t*)(a.ws + WS_WIN), M, N1, D}; pg8::StaticOrder S; S.init(M, N1, G, c, DUPN(3));
            EpiInproj E{(bf16_t*)(a.ws + WS_USH), (bf16_t*)(a.ws + WS_QKV)};
            pg8::gemm_phase<EpiInproj, pg8::StaticOrder, true, true>(ring, g, S, E);
        }
        BARX();
        if (THIN(1)) { FRESH(); phase_prep(a, F, layer, true); }
        FRESH(); if (PH(3)) phase_prep(a, F, layer);
        BARX();
#ifndef SEQ_SCAN
        if (THIN(2)) { FRESH(); phase_chunkA(a, F, true); }
        FRESH(); if (PH(4)) phase_chunkA(a, F);
        BARX();
#endif
        FRESH(); if (PH(4)) phase_mix(a, F, layer);
        BARX();
        FRESH(); if (PH(6)) {
            pg8::Gemm g{(const bf16_t*)A_PTR(a), (const bf16_t*)(a.ws + WS_WG), M, 3072, D}; pg8::StaticOrder S; S.init(M, 3072, G, c, DUPN(4));
            EpiGates E{(bf16_t*)(a.ws + WS_GATES)};
            pg8::gemm_phase<EpiGates, pg8::StaticOrder, true, true>(ring, g, S, E);
        }
        asm volatile("s_waitcnt vmcnt(0) lgkmcnt(0)" ::: "memory"); __syncthreads();
        if (THIN(3)) { FRESH(); phase_post(a, F, layer, true); }
        FRESH(); if (PH(5)) phase_post(a, F, layer);
        BARX();
        FRESH(); if (PH(7)) {
            pg8::Gemm g{(const bf16_t*)(a.ws + WS_YCAT), (const bf16_t*)(a.ws + WS_WP), M, D, YC_W}; pg8::StaticOrder S; S.init(M, D, G, c, DUPN(5));
            EpiMergeF E{(const bf16_t*)(a.ws + WS_GATES), (bf16_t*)(a.ws + WS_MERGED)};
            pg8::gemm_phase<EpiMergeF, pg8::StaticOrder, true, true>(ring, g, S, E);
        }
        BARX();
        FRESH(); if (PH(8)) {
            pg8::Gemm g{(const bf16_t*)(a.ws + WS_MERGED), (const bf16_t*)(a.ws + WS_WO), M, D, D}; pg8::StaticOrder S; S.init(M, D, G, c, 1);
            EpiOut E{HB_PTR(a)};
            pg8::gemm_phase<EpiOut, pg8::StaticOrder, true, true>(ring, g, S, E);
        }
        BARX();
        if (THIN(4)) { FRESH(); phase_norm2(a, F, layer, true); }
        FRESH(); if (PH(9)) phase_norm2(a, F, layer);
        BARX();
        for (int rep = 0; rep < DUPN(7); ++rep) { FRESH(); if (PH(10)) phase_route(a, F, layer); }
        BARX();
        volatile LAS int* tb = (volatile LAS int*)(F.MISC + 32);
        if (F.tid <= 16) { const int* cnt = (const int*)(a.ws + WS_CTL) + CW_ECNT + 64 * layer; int t = 0;
            for (int e = 0; e < F.tid; ++e) t += (__hip_atomic_load(cnt + e, __ATOMIC_RELAXED, __HIP_MEMORY_SCOPE_AGENT) + 255) >> 8;
            tb[F.tid] = t; }
        __syncthreads();
        const int ntile = tb[16];
        FRESH(); if (PH(11)) {
            pg8::Gemm g{(const bf16_t*)(a.ws + WS_AS), (const bf16_t*)(a.ws + WS_WGU), MS, 8192, D}; MoeOrder S{tb, ntile, 2, G, c, DUPN(6)};
            EpiMoeUp E{(bf16_t*)(a.ws + WS_HS)};
            pg8::gemm_phase<EpiMoeUp, MoeOrder, true, true>(ring, g, S, E);
        }
        BARX();
        FRESH(); if (PH(12)) {
            int kdim = DEXP; asm volatile("" : "+s"(kdim));
            pg8::Gemm g{(const bf16_t*)(a.ws + WS_HS), (const bf16_t*)(a.ws + WS_WD), MS, 16384, kdim}; MoeOrder S{tb, ntile, 4, G, c, DUPN(6)};
            EpiMoeDown E{(bf16_t*)(a.ws + WS_Y), (const float*)(a.ws + WS_CWS)};
            pg8::gemm_phase<EpiMoeDown, MoeOrder, true, true>(ring, g, S, E);
        }
        BARX();
    }
    if (THIN(5)) { FRESH(); phase_norm<0>(a, F, DEPTH - 1, true); }
    FRESH(); if (PH(13)) phase_norm<0>(a, F, DEPTH - 1);
#ifdef PROF_K
    BARX();
    if (blockIdx.x == 0) {
        __syncthreads();
        float us;
        if (PROF_K < 0) us = 100.f;
        else if (PROF_K == 12) us = (float)(tsl[25] - tsl[24]) * 0.01f;
        else if (PROF_K == 13) us = (float)(tsl[25] - tsl[0]) * 0.01f;
        else us = ((float)(tsl[1 + PROF_K] - tsl[PROF_K]) + (float)(tsl[13 + PROF_K] - tsl[12 + PROF_K])) * 0.01f;
        us = 4.f * rintf(us * 0.25f);
        for (int i = F.tid; i < 16384; i += NTHR) a.out[i] = us;
    }
#endif
#ifdef CLOCK_PROBE
    if (blockIdx.x == 0 && F.wave == 0) {
        float c0 = 1.f, c1 = 2.f, c2 = 3.f, c3 = 4.f, c4 = 5.f, c5 = 6.f, c6 = 7.f, c7 = 8.f;
        for (int i = 0; i < CLOCK_PROBE; ++i) {
            asm volatile("v_fma_f32 %0, %0, %0, %0\n\tv_fma_f32 %1, %1, %1, %1\n\tv_fma_f32 %2, %2, %2, %2\n\tv_fma_f32 %3, %3, %3, %3\n\tv_fma_f32 %4, %4, %4, %4\n\tv_fma_f32 %5, %5, %5, %5\n\tv_fma_f32 %6, %6, %6, %6\n\tv_fma_f32 %7, %7, %7, %7"
                         : "+v"(c0), "+v"(c1), "+v"(c2), "+v"(c3), "+v"(c4), "+v"(c5), "+v"(c6), "+v"(c7));
        }
        asm volatile("" :: "v"(c0), "v"(c1), "v"(c2), "v"(c3), "v"(c4), "v"(c5), "v"(c6), "v"(c7));
    }
#endif
}

extern "C" void kernel_launch(void* const* d_in, const int* in_sizes, int n_in, void* d_out, int out_size, void* d_ws, size_t ws_size, hipStream_t stream) {
    static int ready = 0;
    if (ready == 0) {
        if (n_in != 29 || out_size != NB * SEQ * D || ws_size < WS_END) { fprintf(stderr, "kernel_launch: unexpected problem shape (n_in %d, out %d, ws %zu < %zu)\n", n_in, out_size, ws_size, (size_t)WS_END); ready = -1; return; }
        if (hipFuncSetAttribute((const void*)hybrid_fwd, hipFuncAttributeMaxDynamicSharedMemorySize, LDS_BYTES) != hipSuccess) { fprintf(stderr, "kernel_launch: hipFuncSetAttribute failed\n"); ready = -1; return; }
        int per_cu = 0;
        if (hipOccupancyMaxActiveBlocksPerMultiprocessor(&per_cu, (const void*)hybrid_fwd, NTHR, LDS_BYTES) != hipSuccess || per_cu < 1) fprintf(stderr, "kernel_launch: occupancy query says %d\n", per_cu);
        (void)hipGetLastError();
        ready = 1;
    }
    if (ready < 0) return;
    (void)in_sizes;
    if (hipMemsetAsync((char*)d_ws + WS_CTL, 0, CTL_ZERO_BYTES, stream) != hipSuccess) return;
    Args a{};
    for (int i = 0; i < 29; ++i) a.in[i] = (const float*)d_in[i];
    a.out = (float*)d_out; a.ws = (unsigned char*)d_ws;
    hipLaunchKernelGGL(hybrid_fwd, dim3(256), dim3(NTHR), LDS_BYTES, stream, a);
}
```

```cpp
#include <hip/hip_runtime.h>
#include <hip/hip_bf16.h>
#include <cstdio>
#include <cstdint>

#define GAS __attribute__((address_space(1)))
#define LAS __attribute__((address_space(3)))

namespace pg8 {
#define PG8_LAS __attribute__((address_space(3)))
typedef unsigned short bf16_t;
typedef short bf16x8 __attribute__((ext_vector_type(8)));
typedef float f32x4 __attribute__((ext_vector_type(4)));
typedef unsigned u32x4 __attribute__((ext_vector_type(4)));
constexpr int BM = 256, BK = 64, HALF = 128, HTB = HALF * BK * 2  , STAGE_BYTES = 8 * HTB, NXCD = 8, WGM = 8;

__host__ __device__ __forceinline__ int lds_byte(int r, int c) { const int st = (r >> 4) * 2 + (c >> 5), rr = r & 15, cc = c & 31, ob = rr * 64 + cc * 2; return st * 1024 + (ob ^ (((ob >> 9) & 1) << 5)); }
__host__ __device__ __forceinline__ void stage_rc(int b, int& R, int& C) { const int st = b / 1024, sb = b % 1024, swz = sb ^ (((sb >> 9) & 1) << 5); R = (st >> 1) * 16 + swz / 64; C = (st & 1) * 32 + (swz % 64) / 2; }
__host__ __device__ __forceinline__ int perm32(int rho) { const int n = rho >> 4, i = rho & 15; return 8 * (i >> 2) + 4 * n + (i & 3); }

struct Unit { int pm, pn; };
struct Gemm { const bf16_t* A; const bf16_t* Bt; int M, N, K; };

struct StaticOrder {
    int nM, nN, nwg, G, c, rep;
    __host__ __device__ void init(int M, int N, int G_, int c_, int rep_ = 1) { nM = M / BM; nN = N / BM; nwg = nM * nN; G = G_; c = c_; rep = rep_; }
    __host__ __device__ bool next(int i, Unit& u) const {
        const long L = (long)i * G + c; if (L >= (long)nwg * rep) return false;
        int wgid = (int)(L % nwg); { const int q = nwg / NXCD, r = nwg % NXCD, xcd = wgid % NXCD, off = wgid / NXCD; wgid = (xcd < r ? xcd * (q + 1) : r * (q + 1) + (xcd - r) * q) + off; }
        const int nig = WGM * nN, gid = wgid / nig, fm = gid * WGM, gsz = (nM - fm) < WGM ? (nM - fm) : WGM;
        u.pm = fm + ((wgid % nig) % gsz); u.pn = (wgid % nig) / gsz; return true;
    }
    __device__ __forceinline__ void a_ready(const Unit&) const {}
    __device__ __forceinline__ void done(const Unit&) const {}
};
__device__ __forceinline__ unsigned cvt_pk_bf16(float lo, float hi) { unsigned r; asm volatile("v_cvt_pk_bf16_f32 %0, %1, %2" : "=v"(r) : "v"(lo), "v"(hi)); return r; }
template <class Epi, class Sched, bool ALIGN_EPI = false, bool SP2 = false>
__device__ __forceinline__ void gemm_phase(PG8_LAS unsigned char* lds, const Gemm g, const Sched& S, const Epi& E) {
    int tid_ = threadIdx.x; asm volatile("" : "+v"(tid_));
    const int tid = tid_, wid = __builtin_amdgcn_readfirstlane(tid >> 6), lane = tid & 63, wr = wid >> 2, wc = wid & 3, fr = lane & 15, fq = lane >> 4;
    const int K = g.K, nt = K / BK;
    unsigned voffA[2], voffB[2];
#pragma unroll
    for (int i = 0; i < 2; ++i) { int R, C; stage_rc(tid * 16 + i * 8192, R, C); const int Rb = Epi::PERM ? ((R & ~31) + perm32(R & 31)) : R;
        voffA[i] = (unsigned)(R * K + C) * 2u; voffB[i] = (unsigned)(Rb * K + C) * 2u; }
    const size_t kstep = (size_t)(BK * 2);
    const size_t hstep = (size_t)HALF * K * 2;
    const size_t tstep = 2 * hstep;
    const unsigned ldsw = (unsigned)wid * 1024u;
    const int aoff = lds_byte(wr * 64 + fr, fq * 8), boff = lds_byte(wc * 32 + fr, fq * 8);
#define PG8_SA(b, h) (((b) * 2 + (h)) * HTB)
#define PG8_SB(b, h) ((4 + (b) * 2 + (h)) * HTB)
#define PG8_STAGE(bufoff, gbase, voff) do { _Pragma("unroll") for (int _i = 0; _i < 2; ++_i) \
        __builtin_amdgcn_global_load_lds((const unsigned*)((const char*)(gbase) + (voff)[_i]), (PG8_LAS unsigned*)(lds + (bufoff) + ldsw + _i * 8192), 16, 0, 0); } while (0)
#define PG8_LDA(dst, b, h) do { _Pragma("unroll") for (int m = 0; m < 4; ++m) _Pragma("unroll") for (int k = 0; k < 2; ++k) dst[m][k] = *(const PG8_LAS bf16x8*)(lds + PG8_SA(b, h) + aoff + m * 2048 + k * 1024); } while (0)
#define PG8_LDB(dst, b, h) do { _Pragma("unroll") for (int n = 0; n < 2; ++n) _Pragma("unroll") for (int k = 0; k < 2; ++k) dst[n][k] = *(const PG8_LAS bf16x8*)(lds + PG8_SB(b, h) + boff + n * 2048 + k * 1024); } while (0)
#define PG8_MMA(ai, bj, At, Bt) do { __builtin_amdgcn_s_setprio(1); _Pragma("unroll") for (int m = 0; m < 4; ++m) _Pragma("unroll") for (int n = 0; n < 2; ++n) _Pragma("unroll") for (int k = 0; k < 2; ++k) \
        acc[ai][bj][m][n] = __builtin_amdgcn_mfma_f32_16x16x32_bf16(Bt[n][k], At[m][k], acc[ai][bj][m][n], 0, 0, 0); __builtin_amdgcn_s_setprio(0); } while (0)
#define PG8_WAIT_V(n) asm volatile("s_waitcnt vmcnt(" #n ")" ::: "memory")
#define PG8_WAIT_L(n) asm volatile("s_waitcnt lgkmcnt(" #n ")" ::: "memory")
#define PG8_BAR __builtin_amdgcn_s_barrier()
#define PG8_SCHED __builtin_amdgcn_sched_barrier(0)
    Unit cur, nxt; int ui = 0;
    if (!S.next(0, cur)) return;
    f32x4 acc[2][2][4][2];
#pragma unroll
    for (int a = 0; a < 2; ++a)
#pragma unroll
        for (int b = 0; b < 2; ++b)
#pragma unroll
            for (int m = 0; m < 4; ++m)
#pragma unroll
                for (int n = 0; n < 2; ++n) acc[a][b][m][n] = (f32x4){0.f, 0.f, 0.f, 0.f};
    bf16x8 At[4][2], B0[2][2], B1[2][2];
    const char* cA = (const char*)g.A + (size_t)cur.pm * tstep; const char* cB = (const char*)g.Bt + (size_t)cur.pn * tstep;
    S.a_ready(cur);
    if constexpr (SP2) {
        PG8_STAGE(PG8_SB(0, 0), cB, voffB); PG8_STAGE(PG8_SB(0, 1), cB + hstep, voffB); PG8_STAGE(PG8_SA(0, 0), cA, voffA); PG8_STAGE(PG8_SA(0, 1), cA + hstep, voffA);
        if (wr == 1) PG8_BAR;
        PG8_WAIT_V(2); PG8_BAR;
        PG8_STAGE(PG8_SB(1, 0), cB + kstep, voffB); PG8_STAGE(PG8_SA(1, 0), cA + kstep, voffA); PG8_STAGE(PG8_SB(1, 1), cB + hstep + kstep, voffB);
        PG8_WAIT_V(6); PG8_BAR;
    } else {
        PG8_STAGE(PG8_SB(0, 0), cB, voffB); PG8_STAGE(PG8_SA(0, 0), cA, voffA); PG8_STAGE(PG8_SB(0, 1), cB + hstep, voffB); PG8_STAGE(PG8_SA(0, 1), cA + hstep, voffA);
        if (wr == 1) PG8_BAR;
        PG8_WAIT_V(4); PG8_BAR;
        PG8_STAGE(PG8_SB(1, 0), cB + kstep, voffB); PG8_STAGE(PG8_SA(1, 0), cA + kstep, voffA); PG8_STAGE(PG8_SB(1, 1), cB + hstep + kstep, voffB);
        PG8_WAIT_V(6); PG8_BAR;
    }
    for (;;) {
        const bool has_next = S.next(ui + 1, nxt);
        const char* nA = has_next ? (const char*)g.A + (size_t)nxt.pm * tstep : cA; const char* nB = has_next ? (const char*)g.Bt + (size_t)nxt.pn * tstep : cB;
        for (int t = 0; t < nt; t += 2) {
            const bool last = (t == nt - 2);
            const char* a1 = cA + (size_t)(t + 1) * kstep;
            const char* a2 = last ? nA : cA + (size_t)(t + 2) * kstep; const char* b2 = last ? nB : cB + (size_t)(t + 2) * kstep;
            const char* a3 = a2 + kstep; const char* b3 = b2 + kstep;
            if (last && has_next) S.a_ready(nxt);
            if constexpr (SP2) {
            PG8_LDB(B0, 0, 0); PG8_LDB(B1, 0, 1); PG8_SCHED; PG8_LDA(At, 0, 0); PG8_STAGE(PG8_SA(1, 1), a1 + hstep, voffA);
            PG8_WAIT_V(8); PG8_WAIT_L(0); PG8_BAR; PG8_MMA(0, 0, At, B0); PG8_MMA(0, 1, At, B1); PG8_BAR; PG8_SCHED;
            PG8_LDA(At, 0, 1); PG8_STAGE(PG8_SB(0, 0), b2, voffB); PG8_STAGE(PG8_SB(0, 1), b2 + hstep, voffB); PG8_STAGE(PG8_SA(0, 0), a2, voffA);
            PG8_WAIT_V(8); PG8_WAIT_L(0); PG8_BAR; PG8_MMA(1, 0, At, B0); PG8_MMA(1, 1, At, B1); PG8_BAR; PG8_SCHED;
            PG8_LDB(B0, 1, 0); PG8_LDB(B1, 1, 1); PG8_SCHED; PG8_LDA(At, 1, 0); PG8_STAGE(PG8_SA(0, 1), a2 + hstep, voffA);
            PG8_WAIT_V(8); PG8_WAIT_L(0); PG8_BAR; PG8_MMA(0, 0, At, B0); PG8_MMA(0, 1, At, B1); PG8_BAR; PG8_SCHED;
            PG8_LDA(At, 1, 1); PG8_STAGE(PG8_SB(1, 0), b3, voffB); PG8_STAGE(PG8_SB(1, 1), b3 + hstep, voffB); PG8_STAGE(PG8_SA(1, 0), a3, voffA);
            PG8_WAIT_V(8); PG8_WAIT_L(0); PG8_BAR; PG8_MMA(1, 0, At, B0); PG8_MMA(1, 1, At, B1); PG8_BAR; PG8_SCHED;
            } else {
            PG8_LDB(B0, 0, 0); PG8_SCHED; PG8_LDA(At, 0, 0); PG8_STAGE(PG8_SA(1, 1), a1 + hstep, voffA);
            PG8_WAIT_L(8); PG8_BAR; PG8_WAIT_L(0); PG8_MMA(0, 0, At, B0); PG8_BAR; PG8_SCHED;
            PG8_LDB(B1, 0, 1); PG8_STAGE(PG8_SB(0, 0), b2, voffB);
            PG8_BAR; PG8_WAIT_L(0); PG8_MMA(0, 1, At, B1); PG8_BAR;
            PG8_LDA(At, 0, 1); PG8_STAGE(PG8_SA(0, 0), a2, voffA);
            PG8_BAR; PG8_WAIT_L(0); PG8_MMA(1, 0, At, B0); PG8_BAR; PG8_SCHED;
            PG8_STAGE(PG8_SB(0, 1), b2 + hstep, voffB);
            PG8_WAIT_V(6); PG8_BAR; PG8_MMA(1, 1, At, B1); PG8_BAR;
            PG8_LDB(B0, 1, 0); PG8_SCHED; PG8_LDA(At, 1, 0); PG8_STAGE(PG8_SA(0, 1), a2 + hstep, voffA);
            PG8_WAIT_L(8); PG8_BAR; PG8_WAIT_L(0); PG8_MMA(0, 0, At, B0); PG8_BAR; PG8_SCHED;
            PG8_LDB(B1, 1, 1); PG8_STAGE(PG8_SB(1, 0), b3, voffB);
            PG8_BAR; PG8_WAIT_L(0); PG8_MMA(0, 1, At, B1); PG8_BAR;
            PG8_LDA(At, 1, 1); PG8_STAGE(PG8_SA(1, 0), a3, voffA);
            PG8_BAR; PG8_WAIT_L(0); PG8_MMA(1, 0, At, B0); PG8_BAR; PG8_SCHED;
            PG8_STAGE(PG8_SB(1, 1), b3 + hstep, voffB);
            PG8_WAIT_V(6); PG8_BAR; PG8_MMA(1, 1, At, B1); PG8_BAR;
            }
            if constexpr (Epi::MIDHOOK) { if (t + 2 == 6 || t + 2 == 12) E.mid(acc, cur, wr, wc, fr, fq, (t + 2) / 6); }
        }
        if constexpr (ALIGN_EPI) { if (wr == 0) PG8_BAR; }
        if constexpr (!Epi::AFTER_DRAIN) { E(acc, cur, wr, wc, fr, fq); S.done(cur); }
        if (!has_next) break;
#pragma unroll
        for (int a = 0; a < 2; ++a)
#pragma unroll
            for (int b = 0; b < 2; ++b)
#pragma unroll
                for (int m = 0; m < 4; ++m)
#pragma unroll
                    for (int n = 0; n < 2; ++n) acc[a][b][m][n] = (f32x4){0.f, 0.f, 0.f, 0.f};
        cur = nxt; cA = nA; cB = nB; ++ui;
        if constexpr (ALIGN_EPI) { if (wr == 1) PG8_BAR; }
    }
    PG8_WAIT_V(0);
    if constexpr (!ALIGN_EPI) { if (wr == 0) PG8_BAR; }
    PG8_BAR;
    if constexpr (Epi::AFTER_DRAIN) { E.fused(acc, cur, wr, wc, fr, fq, lds, wid, lane); S.done(cur); }
#undef PG8_SA
#undef PG8_SB
#undef PG8_STAGE
#undef PG8_LDA
#undef PG8_LDB
#undef PG8_MMA
#undef PG8_WAIT_V
#undef PG8_WAIT_L
#undef PG8_BAR
#undef PG8_SCHED
}
}

constexpr int D = 1024, NB = 2, SEQ = 16384, NMETA = 16, LTOK = SEQ + NMETA  , PADR = 112, T = PADR + LTOK  ;
constexpr int M = NB * T;
constexpr int DEPTH = 2, HD = 64, RW_H = 6, SB_H = 5, FX_H = 5, RW_W = 384, SHIFT_W = 1280, D_IN = 6277;
constexpr int YC_W = 1152;
constexpr int QKV_W = 1920;
constexpr int N1 = 3328;
constexpr int FCOL = 3200, GCOL = 3205;
constexpr int NEXP = 16, DEXP = 256;
constexpr int MS = 70144;
constexpr int LCH = 32, LPADDED = 16448;
constexpr int KBP = 16896;
constexpr float C2 = 0.125f * 1.4426950408889634f;
constexpr float LOG2E = 1.4426950408889634f;
constexpr int NWAVES = 8, NTHR = 512;

constexpr size_t MiB = 1u << 20;
constexpr size_t WS_CTL = 0, CTL_ZERO_BYTES = 65536;
constexpr size_t WS_HM = 1 * MiB;
constexpr size_t WS_LOGF = WS_HM + 131072;
constexpr size_t WS_KB2 = WS_LOGF + (size_t)M * 32;
constexpr size_t WS_TOK = WS_KB2 + (size_t)10 * KBP * 4;
constexpr size_t WS_SLOT = WS_TOK + (size_t)M * 32;
constexpr size_t WS_CWS = WS_SLOT + (size_t)M * 8;
constexpr size_t WS_WGCNT = WS_CWS + (size_t)MS * 4;
constexpr size_t WS_SMALL_END = WS_WGCNT + 256 * 16 * 4;
static_assert(WS_SMALL_END <= 8 * MiB, "small buffers");
constexpr size_t WS_WIN = 8 * MiB;
constexpr size_t WS_WG = WS_WIN + (size_t)N1 * 1024 * 2;
constexpr size_t WS_WP = WS_WG + (size_t)3072 * 1024 * 2;
constexpr size_t WS_WO = WS_WP + (size_t)3072 * 384 * 2;
constexpr size_t WS_WGU = WS_WO + (size_t)1024 * 1024 * 2;
constexpr size_t WS_WD = WS_WGU + (size_t)8192 * 1024 * 2;
constexpr size_t WS_W_END = WS_WD + (size_t)16384 * 256 * 2;
static_assert(WS_W_END <= 49 * MiB, "weights");
constexpr size_t WS_HB = 49 * MiB;
constexpr size_t WS_BIG = 115 * MiB;
constexpr size_t WS_USH = WS_BIG;
constexpr size_t WS_YCAT = WS_BIG;
constexpr size_t WS_QKV = WS_BIG + 82 * MiB;
constexpr size_t WS_RW = WS_BIG + 204 * MiB;
constexpr size_t WS_BN = WS_BIG + 349 * MiB;
constexpr size_t WS_GATES = WS_BIG + 82 * MiB;
constexpr size_t WS_MERGED = WS_BIG + 276 * MiB;
constexpr size_t WS_AS = WS_BIG;
constexpr size_t WS_HS = WS_BIG + 137 * MiB;
constexpr size_t WS_Y = WS_BIG + 172 * MiB;
constexpr size_t WS_END = WS_BIG + 374 * MiB;
static_assert((size_t)(M + 256) * 1280 * 2 <= 82 * MiB && (size_t)3 * M * 384 * 2 <= 82 * MiB && (size_t)(M + 256) * 1920 * 2 <= 122 * MiB, "big map 1");
static_assert((size_t)12 * LPADDED * 768 <= 145 * MiB && (size_t)M * 384 * 2 <= 25 * MiB && (size_t)M * 3072 * 2 <= 194 * MiB && (size_t)M * 2048 <= 65 * MiB, "big map 2");
static_assert((size_t)MS * 2048 <= 137 * MiB && (size_t)MS * 512 <= 35 * MiB && WS_END <= 489 * MiB, "big map 3");

constexpr int CW_BAR = 0;
constexpr int CW_QUEUE = 4096;
constexpr int CW_ECNT = 4352;
static_assert((CW_ECNT + 128) * 4 <= (int)CTL_ZERO_BYTES, "ctl");

constexpr int RING_BYTES = 131072, MISC_OFF = RING_BYTES, LDS_BYTES = 147456;

typedef unsigned short bf16_t;
typedef float f32x4 __attribute__((ext_vector_type(4)));
typedef float f32x2 __attribute__((ext_vector_type(2)));
typedef float f32x16 __attribute__((ext_vector_type(16)));
typedef unsigned u32x4 __attribute__((ext_vector_type(4)));
typedef unsigned u32x2 __attribute__((ext_vector_type(2)));
typedef short bf16x8 __attribute__((ext_vector_type(8)));
typedef short s16x4 __attribute__((ext_vector_type(4)));
typedef _Float16 f16x4 __attribute__((ext_vector_type(4)));
typedef __bf16 bf16x2_t __attribute__((ext_vector_type(2)));

__device__ __forceinline__ unsigned pk2(float lo, float hi) { f32x2 v = {lo, hi}; bf16x2_t b = __builtin_convertvector(v, bf16x2_t); return __builtin_bit_cast(unsigned, b); }
__device__ __forceinline__ unsigned short f2bf(float f) { return (unsigned short)(pk2(f, 0.f) & 0xffffu); }
__device__ __forceinline__ float bf_lo(unsigned u) { return __uint_as_float(u << 16); }
__device__ __forceinline__ float bf_hi(unsigned u) { return __uint_as_float(u & 0xffff0000u); }
__device__ __forceinline__ float bf2f(unsigned short h) { return __uint_as_float((unsigned)h << 16); }
template <int CTRL> __device__ __forceinline__ float dpp_f(float x) { return __int_as_float(__builtin_amdgcn_update_dpp(0, __float_as_int(x), CTRL, 0xF, 0xF, false)); }
__device__ __forceinline__ float allred16(float p) { p += dpp_f<0x128>(p); p += dpp_f<0x124>(p); p += dpp_f<0x122>(p); p += dpp_f<0x121>(p); return p; }
__device__ __forceinline__ float wave_sum(float v) {
    v = allred16(v);
    { auto sw = __builtin_amdgcn_permlane16_swap(__float_as_uint(v), __float_as_uint(v), false, false); v = __uint_as_float(sw[0]) + __uint_as_float(sw[1]); }
    { auto sw = __builtin_amdgcn_permlane32_swap(__float_as_uint(v), __float_as_uint(v), false, false); v = __uint_as_float(sw[0]) + __uint_as_float(sw[1]); }
    return v;
}
__device__ __forceinline__ float fast_exp(float x) { return __builtin_amdgcn_exp2f(x * LOG2E); }
__device__ __forceinline__ float fast_log(float x) { return __builtin_amdgcn_logf(x) * 0.6931471805599453f; }
__device__ __forceinline__ float softplus_f(float z) { return fmaxf(z, 0.f) + fast_log(1.f + fast_exp(-fabsf(z))); }

#define XB_TMO      128
#define XB_XCNT(j)  (256  + 64 * (j))
#define XB_XSUB(j)  (1280 + 64 * (j))
#define XB_XGEN(j)  (2304 + 64 * (j))
#define XB_TOP      3328
#define XB_TOPGEN   3392
#define XCD_BAR_WORDS 3456
#define XB_SPIN_CAP (1u << 20)
__device__ __forceinline__ unsigned xb_ld(unsigned* p)              { return __hip_atomic_load(p, __ATOMIC_RELAXED, __HIP_MEMORY_SCOPE_AGENT); }
__device__ __forceinline__ unsigned xb_add(unsigned* p, unsigned v) { return __hip_atomic_fetch_add(p, v, __ATOMIC_RELAXED, __HIP_MEMORY_SCOPE_AGENT); }
__device__ __forceinline__ unsigned xb_xcc_id() { return (unsigned)__builtin_amdgcn_s_getreg((3 << 11) | 20) & 0xFu; }
#define XB_SPIN(cond, bar) do { unsigned _sp = 0; while (cond) { __builtin_amdgcn_s_sleep(1); \
    if ((++_sp & 255u) == 0u) { if (xb_ld(&(bar)[XB_TMO])) break; if (_sp > XB_SPIN_CAP) { atomicAdd(&(bar)[XB_TMO], 1u); break; } } } } while (0)

struct XcdBarrier {
    unsigned* bar; unsigned x;
    volatile LAS unsigned* st;
};

__device__ __forceinline__ XcdBarrier xcd_barrier_post(unsigned* bar, volatile LAS unsigned* st) {
    XcdBarrier b; b.bar = bar; b.x = xb_xcc_id(); b.st = st;
    if (threadIdx.x == 0) (void)xb_add(&bar[XB_XCNT(b.x)], 1u);
    return b;
}
__device__ __forceinline__ void xcd_barrier_complete(unsigned* bar, unsigned x, unsigned& nloc, unsigned& nx) {
    const unsigned G = gridDim.x * gridDim.y * gridDim.z;
    unsigned sum, cnt, mine, sp = 0u;
    for (;;) {
        sum = 0u; cnt = 0u; mine = 0u;
#pragma unroll
        for (unsigned j = 0; j < 16; ++j) { const unsigned c = xb_ld(&bar[XB_XCNT(j)]); sum += c; cnt += (c > 0u) ? 1u : 0u; mine = (j == x) ? c : mine; }
        if (sum == G) break;
        __builtin_amdgcn_s_sleep(1);
        if ((++sp & 255u) == 0u) { if (xb_ld(&bar[XB_TMO])) break; if (sp > XB_SPIN_CAP) { atomicAdd(&bar[XB_TMO], 1u); break; } }
    }
    nloc = mine > 0u ? mine : 1u; nx = cnt > 0u ? cnt : 1u;
}

__device__ __forceinline__ void xcd_barrier(const XcdBarrier& b) {
    asm volatile("s_waitcnt vmcnt(0)" ::: "memory");
    __syncthreads();
    if (threadIdx.x == 0) {
        unsigned* bar = b.bar;
        __builtin_amdgcn_s_waitcnt(0);
        unsigned nloc = b.st[0], nx = b.st[1];
        if (nloc == 0u) { xcd_barrier_complete(bar, b.x, nloc, nx); b.st[0] = nloc; b.st[1] = nx; }
        const unsigned old = xb_add(&bar[XB_XSUB(b.x)], 1u);
        const unsigned gen = old / nloc;
        if (old + 1u == (gen + 1u) * nloc) {
            __builtin_amdgcn_fence(__ATOMIC_RELEASE, "agent");
            asm volatile("s_waitcnt vmcnt(0)" ::: "memory");
            const unsigned og = xb_add(&bar[XB_TOP], 1u);
            const unsigned tg = og / nx;
            if (og + 1u == (tg + 1u) * nx) xb_add(&bar[XB_TOPGEN], 1u);
            else XB_SPIN(xb_ld(&bar[XB_TOPGEN]) == tg, bar);
            __builtin_amdgcn_fence(__ATOMIC_ACQUIRE, "agent");
            xb_add(&bar[XB_XGEN(b.x)], 1u);
            asm volatile("s_waitcnt vmcnt(0)" ::: "memory");
        } else {
            XB_SPIN(xb_ld(&bar[XB_XGEN(b.x)]) == gen, bar);
            __builtin_amdgcn_fence(__ATOMIC_ACQUIRE, "agent");
            asm volatile("s_waitcnt vmcnt(0)" ::: "memory");
        }
    }
    __syncthreads();
}

struct Args { const float* in[29]; float* out; unsigned char* ws; };
enum { I_X = 0, I_META, I_N1G, I_WIN, I_MU, I_WUP, I_W0, I_AUP, I_A0, I_KK, I_KA, I_RK, I_LNG, I_LNB, I_FB, I_QG, I_KG, I_WPR, I_WPS, I_WPF, I_WOUT, I_N2G, I_MWG, I_MBG, I_MWE, I_MBE, I_MGATE, I_MUP, I_MDOWN };
struct ArgsL { volatile LAS unsigned* tab; float* out; unsigned char* ws;
    __device__ __forceinline__ const float* in(int i) const { const unsigned lo = tab[2 * i], hi = tab[2 * i + 1];
        return (const float*)(((unsigned long long)(unsigned)__builtin_amdgcn_readfirstlane((int)hi) << 32) | (unsigned long long)(unsigned)__builtin_amdgcn_readfirstlane((int)lo)); }
};
struct Frame { LAS unsigned char* lds; volatile LAS unsigned* MISC; int tid, lane, wave, bx; };

__device__ __forceinline__ float* hrow(const ArgsL& a, int b, int l) {
    return l < NMETA ? (float*)(a.ws + WS_HM) + (size_t)(b * NMETA + l) * D : a.out + ((size_t)b * SEQ + (l - NMETA)) * D;
}
#define LDS_WAIT() asm volatile("s_waitcnt lgkmcnt(0)" ::: "memory")
#define HB_PTR(a) ((bf16_t*)((a).ws + WS_HB))
#define A_PTR(a) ((bf16_t*)((a).out))

__device__ __forceinline__ void tr_item(const float* W, int ldw, int sc0, int nvalid, int k0, int kvalid, bf16_t* WT, int Kd, int r0, LAS float* scr, int lane) {
    float tv[32];
#pragma unroll
    for (int i = 0; i < 32; ++i) { const int kk = 2 * i + (lane >> 5), n = lane & 31; tv[i] = 0.f;
        if (n < nvalid && k0 + kk < kvalid) tv[i] = W[(size_t)(k0 + kk) * ldw + sc0 + n]; }
#pragma unroll
    for (int i = 0; i < 32; ++i) { const int kk = 2 * i + (lane >> 5), n = lane & 31; scr[kk * 33 + n] = tv[i]; }
    LDS_WAIT();
    const int c = lane & 7;
#pragma unroll
    for (int j = 0; j < 4; ++j) { const int n = (lane >> 3) + 8 * j; const LAS float* s = scr + (8 * c) * 33 + n;
        u32x4 o; o.x = pk2(s[0 * 33], s[1 * 33]); o.y = pk2(s[2 * 33], s[3 * 33]); o.z = pk2(s[4 * 33], s[5 * 33]); o.w = pk2(s[6 * 33], s[7 * 33]);
        *(u32x4*)(WT + (size_t)(r0 + n) * Kd + k0 + 8 * c) = o; }
    LDS_WAIT();
}
__device__ __forceinline__ void tr_item2(const float* W, int ldw, int sc0, int nvalid, int k0, int kvalid, bf16_t* WT, int Kd, int r0, int kd0, LAS float* scr, int lane) {
    float tv[32];
#pragma unroll
    for (int i = 0; i < 32; ++i) { const int kk = 2 * i + (lane >> 5), n = lane & 31; tv[i] = 0.f;
        if (n < nvalid && k0 + kk < kvalid) tv[i] = W[(size_t)(k0 + kk) * ldw + sc0 + n]; }
#pragma unroll
    for (int i = 0; i < 32; ++i) { const int kk = 2 * i + (lane >> 5), n = lane & 31; scr[kk * 33 + n] = tv[i]; }
    LDS_WAIT();
    const int c = lane & 7;
#pragma unroll
    for (int j = 0; j < 4; ++j) { const int n = (lane >> 3) + 8 * j; const LAS float* s = scr + (8 * c) * 33 + n;
        u32x4 o; o.x = pk2(s[0 * 33], s[1 * 33]); o.y = pk2(s[2 * 33], s[3 * 33]); o.z = pk2(s[4 * 33], s[5 * 33]); o.w = pk2(s[6 * 33], s[7 * 33]);
        *(u32x4*)(WT + (size_t)(r0 + n) * Kd + kd0 + 8 * c) = o; }
    LDS_WAIT();
}
__device__ __forceinline__ void phase_wconv(const ArgsL& a, Frame& F, int layer) {
    LAS float* scr = (LAS float*)(F.lds + F.wave * 8448);
    const int gw = F.bx * NWAVES + F.wave, NGW = gridDim.x * NWAVES;
    constexpr int C1 = 16 * 104, C2_ = C1 + 16 * 96, C3 = C2_ + 6 * 96, C4 = C3 + 16 * 32, C5 = C4 + 16 * 256, C6 = C5 + 4 * 512;
    unsigned char* ws = a.ws;
    for (int it = gw; it < C6; it += NGW) {
        if (it < C1) { const int kb = it / 104, nb = it % 104, r0 = nb * 32;
            tr_item(a.in(I_WIN) + (size_t)layer * D * D_IN, D_IN, r0, r0 < FCOL ? 32 : 0, kb * 64, 1024, (bf16_t*)(ws + WS_WIN), 1024, r0, scr, F.lane); }
        else if (it < C2_) { const int r = it - C1, kb = r / 96, nb = r % 96, r0 = nb * 32;
            tr_item(a.in(I_WIN) + (size_t)layer * D * D_IN, D_IN, GCOL + r0, 32, kb * 64, 1024, (bf16_t*)(ws + WS_WG), 1024, r0, scr, F.lane); }
        else if (it < C3) { const int r = it - C2_, kb = r / 32, nb = r % 32, r0 = nb * 32, br = kb / 6, k0 = (kb % 6) * 64;
            const float* W = (br == 0 ? a.in(I_WPR) + (size_t)layer * 384 * D : br == 1 ? a.in(I_WPS) + (size_t)layer * 320 * D : a.in(I_WPF) + (size_t)layer * 320 * D);
            tr_item2(W, D, r0, 32, k0, br == 0 ? 384 : 320, (bf16_t*)(ws + WS_WP), YC_W, r0, br * 384 + k0, scr, F.lane); }
        else if (it < C4) { const int r = it - C3, kb = r / 32, nb = r % 32, r0 = nb * 32;
            tr_item(a.in(I_WOUT) + (size_t)layer * D * D, D, r0, 32, kb * 64, 1024, (bf16_t*)(ws + WS_WO), 1024, r0, scr, F.lane); }
        else if (it < C5) { const int r = it - C4, kb = r / 256, nb = r % 256, r0 = nb * 32, e = r0 >> 9, rr = r0 & 511, j = rr >> 8, q = rr & 255;
            const float* W = (q >= 128 ? a.in(I_MUP) : a.in(I_MGATE)) + ((size_t)layer * NEXP + e) * D * DEXP;
            tr_item(W, DEXP, j * 128 + (q & 127), 32, kb * 64, 1024, (bf16_t*)(ws + WS_WGU), 1024, r0, scr, F.lane); }
        else { const int r = it - C5, kb = r / 512, nb = r % 512, r0 = nb * 32, e = r0 >> 10;
            tr_item(a.in(I_MDOWN) + ((size_t)layer * NEXP + e) * DEXP * D, D, r0 & 1023, 32, kb * 64, 256, (bf16_t*)(ws + WS_WD), 256, r0, scr, F.lane); }
    }
}

__device__ __forceinline__ void add_y_row(f32x4 (&v)[4], const bf16_t* Y, int slot, int lane) {
    const u32x2* y = (const u32x2*)(Y + (size_t)slot * D) + lane;
#pragma unroll
    for (int j = 0; j < 4; ++j) { const u32x2 t = y[64 * j]; v[j].x += bf_lo(t.x); v[j].y += bf_hi(t.x); v[j].z += bf_lo(t.y); v[j].w += bf_hi(t.y); }
}
template <int MODE>
__device__ __forceinline__ void phase_norm(const ArgsL& a, Frame& F, int layer, const bool dry = false) {
    const int lane = F.lane;
    LAS float* wl = (LAS float*)F.lds;
    LAS int* lcnt = (LAS int*)(F.lds + 20 * 4096);
    unsigned char* ws = a.ws;
    if (MODE == 1) {
        const float* win = a.in(I_WIN) + (size_t)layer * D * D_IN;
        for (int idx = F.tid; idx < 5 * 1024; idx += NTHR) { const int j = idx >> 10, k = idx & 1023; wl[j * 1024 + k] = win[(size_t)k * D_IN + FCOL + j]; }
    }
    if (MODE == 2) {
        const float* wg = a.in(I_MWG) + (size_t)layer * D * 4; const float* we = a.in(I_MWE) + (size_t)layer * D * 16;
        for (int i4 = F.tid; i4 < 1024; i4 += NTHR) { const f32x4 f = *(const f32x4*)(wg + 4 * i4); wl[i4] = f.x; wl[1024 + i4] = f.y; wl[2048 + i4] = f.z; wl[3072 + i4] = f.w; }
        for (int i4 = F.tid; i4 < 4096; i4 += NTHR) { const int k = i4 >> 2, c = i4 & 3; const f32x4 f = *(const f32x4*)(we + 4 * i4); LAS float* d = wl + (4 + 4 * c) * 1024 + k;
            d[0] = f.x; d[1024] = f.y; d[2048] = f.z; d[3072] = f.w; }
        if (F.tid < 16) lcnt[F.tid] = 0;
    }
    __syncthreads();
    const int gw = F.bx * NWAVES + F.wave, NGW = gridDim.x * NWAVES;
    const float* gsrc = (MODE == 2 ? a.in(I_N2G) : a.in(I_N1G)) + layer * D;
    f32x4 gv[4];
#pragma unroll
    for (int j = 0; j < 4; ++j) gv[j] = (MODE == 0) ? (f32x4){0.f, 0.f, 0.f, 0.f} : *(const f32x4*)(gsrc + 4 * lane + 256 * j);
    bf16_t* A = A_PTR(a); bf16_t* HB = HB_PTR(a);
    const bf16_t* Y = (const bf16_t*)(ws + WS_Y);
    const int* SLOT = (const int*)(ws + WS_SLOT);
    constexpr bool COMB0 = (MODE == 0);
    const bool comb = COMB0 || (MODE == 1 && layer > 0);
    f32x4 vn[4]; u32x2 yan[4], ybn[4];
#pragma unroll
    for (int j = 0; j < 4; ++j) { vn[j] = (f32x4){0.f, 0.f, 0.f, 0.f}; yan[j] = (u32x2){0u, 0u}; ybn[j] = (u32x2){0u, 0u}; }
#define NRM_VALID(mm) ((mm) < M && ((mm) % T) - PADR >= (MODE == 0 ? NMETA : 0))
#define NRM_LOAD(mm, s0_, s1_) do { if (NRM_VALID(mm)) { const int bb_ = (mm) / T, ll_ = (mm) - bb_ * T - PADR; \
        if (MODE == 1 && layer == 0) { const float* src_ = (ll_ < NMETA) ? a.in(I_META) + (size_t)ll_ * D : a.in(I_X) + ((size_t)bb_ * SEQ + (ll_ - NMETA)) * D; \
            _Pragma("unroll") for (int j = 0; j < 4; ++j) vn[j] = *(const f32x4*)(src_ + 4 * lane + 256 * j); } \
        else { const u32x2* hs_ = (const u32x2*)(HB + (size_t)(mm) * D) + lane; \
            _Pragma("unroll") for (int j = 0; j < 4; ++j) { const u32x2 t_ = hs_[64 * j]; vn[j] = (f32x4){bf_lo(t_.x), bf_hi(t_.x), bf_lo(t_.y), bf_hi(t_.y)}; } } \
        if (comb) { const u32x2* y0_ = (const u32x2*)(Y + (size_t)(s0_) * D) + lane; const u32x2* y1_ = (const u32x2*)(Y + (size_t)(s1_) * D) + lane; \
            _Pragma("unroll") for (int j = 0; j < 4; ++j) { yan[j] = y0_[64 * j]; ybn[j] = y1_[64 * j]; } } } } while (0)
    int sa1 = 0, sb1 = 0, sa2 = 0, sb2 = 0;
    if (comb) { if (NRM_VALID(gw)) { sa1 = SLOT[2 * gw]; sb1 = SLOT[2 * gw + 1]; } if (NRM_VALID(gw + NGW)) { sa2 = SLOT[2 * (gw + NGW)]; sb2 = SLOT[2 * (gw + NGW) + 1]; } }
    NRM_LOAD(gw, sa1, sb1);
    for (int m = gw; m < M; m += NGW) {
        f32x4 v[4]; u32x2 ya[4], yb[4];
#pragma unroll
        for (int j = 0; j < 4; ++j) { v[j] = vn[j]; ya[j] = yan[j]; yb[j] = ybn[j]; }
        int sa3 = 0, sb3 = 0;
        if (comb && NRM_VALID(m + 2 * NGW)) { sa3 = SLOT[2 * (m + 2 * NGW)]; sb3 = SLOT[2 * (m + 2 * NGW) + 1]; }
        NRM_LOAD(m + NGW, sa2, sb2);
        sa2 = sa3; sb2 = sb3;
        const int b = m / T, p = m - b * T, l = p - PADR;
        if (l < 0) {
            if (MODE == 1 && !dry) {
                u32x2* o = (u32x2*)(A + (size_t)m * D) + lane;
#pragma unroll
                for (int j = 0; j < 4; ++j) o[64 * j] = (u32x2){0u, 0u};
                if (lane < 8) ((float*)(ws + WS_LOGF))[(size_t)m * 8 + lane] = 0.f;
            }
            continue;
        }
        if (MODE == 0 && l < NMETA) continue;
        if (comb) {
#pragma unroll
            for (int j = 0; j < 4; ++j) { v[j].x += bf_lo(ya[j].x) + bf_lo(yb[j].x); v[j].y += bf_hi(ya[j].x) + bf_hi(yb[j].x); v[j].z += bf_lo(ya[j].y) + bf_lo(yb[j].y); v[j].w += bf_hi(ya[j].y) + bf_hi(yb[j].y); }
        }
        if (MODE == 0 && !dry) { float* op = a.out + ((size_t)b * SEQ + (l - NMETA)) * D;
#pragma unroll
            for (int j = 0; j < 4; ++j) *(f32x4*)(op + 4 * lane + 256 * j) = v[j]; }
        if (MODE == 1 && !dry) { u32x2* hd = (u32x2*)(HB + (size_t)m * D) + lane;
#pragma unroll
            for (int j = 0; j < 4; ++j) hd[64 * j] = (u32x2){pk2(v[j].x, v[j].y), pk2(v[j].z, v[j].w)};
        }
        if (MODE == 0) continue;
        float ss = 0.f;
#pragma unroll
        for (int j = 0; j < 4; ++j) ss += (v[j].x * v[j].x + v[j].y * v[j].y) + (v[j].z * v[j].z + v[j].w * v[j].w);
        const float r = 1.0f / sqrtf(wave_sum(ss) * (1.0f / D) + 1e-6f);
#pragma unroll
        for (int j = 0; j < 4; ++j) v[j] = v[j] * r * gv[j];
        u32x2* o = (u32x2*)(A + (size_t)m * D) + lane;
        if (!dry) {
#pragma unroll
        for (int j = 0; j < 4; ++j) o[64 * j] = (u32x2){pk2(v[j].x, v[j].y), pk2(v[j].z, v[j].w)}; }
        else { float sink = v[0].x + v[1].y + v[2].z + v[3].w; asm volatile("" :: "v"(sink)); }
        if (MODE == 1) {
            float dsum[5];
#pragma unroll
            for (int q = 0; q < 5; ++q) { float d = 0.f;
#pragma unroll
                for (int j = 0; j < 4; ++j) { const f32x4 w = *(const LAS f32x4*)(wl + q * 1024 + 4 * lane + 256 * j); d += (v[j].x * w.x + v[j].y * w.y) + (v[j].z * w.z + v[j].w * w.w); }
                dsum[q] = wave_sum(d); }
            float mine = dsum[0];
            mine = lane == 1 ? dsum[1] : mine; mine = lane == 2 ? dsum[2] : mine; mine = lane == 3 ? dsum[3] : mine; mine = lane == 4 ? dsum[4] : mine;
            if (lane < 8 && !dry) { float lf = 0.f;
                if (lane < 5) { const float xx = mine + a.in(I_FB)[layer * 5 + lane]; lf = fminf(xx, 0.f) - fast_log(1.f + fast_exp(-fabsf(xx))); }
                ((float*)(ws + WS_LOGF))[(size_t)m * 8 + lane] = lf; }
        }
        if (MODE == 2) {
            float dp[20];
#pragma unroll
            for (int q = 0; q < 20; ++q) { float d = 0.f;
#pragma unroll
                for (int j = 0; j < 4; ++j) { const f32x4 w = *(const LAS f32x4*)(wl + q * 1024 + 4 * lane + 256 * j); d += (v[j].x * w.x + v[j].y * w.y) + (v[j].z * w.z + v[j].w * w.w); }
                dp[q] = d; }
            float sA[10], sB[5];
#pragma unroll
            for (int i = 0; i < 10; ++i) { auto sw = __builtin_amdgcn_permlane32_swap(__float_as_uint(dp[2 * i]), __float_as_uint(dp[2 * i + 1]), false, false); sA[i] = __uint_as_float(sw[0]) + __uint_as_float(sw[1]); }
#pragma unroll
            for (int i = 0; i < 5; ++i) { auto sw = __builtin_amdgcn_permlane16_swap(__float_as_uint(sA[2 * i]), __float_as_uint(sA[2 * i + 1]), false, false); sB[i] = allred16(__uint_as_float(sw[0]) + __uint_as_float(sw[1])); }
            LAS float* red = (LAS float*)(F.lds + 81920 + 256) + F.wave * 32;
            { const int rho = lane >> 4, vsel = ((rho & 1) << 1) | (rho >> 1);
              if ((lane & 15) == 0) {
#pragma unroll
                  for (int i = 0; i < 5; ++i) red[4 * i + vsel] = sB[i]; } }
            LDS_WAIT();
            float ds[20];
#pragma unroll
            for (int i = 0; i < 5; ++i) { const f32x4 t4 = *(const LAS f32x4*)(red + 4 * i); ds[4 * i] = t4.x; ds[4 * i + 1] = t4.y; ds[4 * i + 2] = t4.z; ds[4 * i + 3] = t4.w; }
            LDS_WAIT();
            const float* bg = a.in(I_MBG) + layer * 4; const float* be = a.in(I_MBE) + layer * 16;
            float lg0 = ds[0] + bg[0], lg1 = ds[1] + bg[1], lg2 = ds[2] + bg[2], lg3 = ds[3] + bg[3];
            int g = 0; float mx = lg0;
            if (lg1 > mx) { mx = lg1; g = 1; } if (lg2 > mx) { mx = lg2; g = 2; } if (lg3 > mx) { mx = lg3; g = 3; }
            const float den = fast_exp(lg0 - mx) + fast_exp(lg1 - mx) + fast_exp(lg2 - mx) + fast_exp(lg3 - mx);
            const float pgrp = 1.0f / den;
            float s0 = g == 0 ? ds[4] : g == 1 ? ds[8] : g == 2 ? ds[12] : ds[16];
            float s1 = g == 0 ? ds[5] : g == 1 ? ds[9] : g == 2 ? ds[13] : ds[17];
            float s2 = g == 0 ? ds[6] : g == 1 ? ds[10] : g == 2 ? ds[14] : ds[18];
            float s3 = g == 0 ? ds[7] : g == 1 ? ds[11] : g == 2 ? ds[15] : ds[19];
            s0 += be[g * 4 + 0]; s1 += be[g * 4 + 1]; s2 += be[g * 4 + 2]; s3 += be[g * 4 + 3];
            int i0 = 0; float v0 = s0;
            if (s1 > v0) { v0 = s1; i0 = 1; } if (s2 > v0) { v0 = s2; i0 = 2; } if (s3 > v0) { v0 = s3; i0 = 3; }
            int i1 = -1; float v1 = -3.0e38f;
            if (i0 != 0 && s0 > v1) { v1 = s0; i1 = 0; } if (i0 != 1 && s1 > v1) { v1 = s1; i1 = 1; } if (i0 != 2 && s2 > v1) { v1 = s2; i1 = 2; } if (i0 != 3 && s3 > v1) { v1 = s3; i1 = 3; }
            const float e1 = fast_exp(v1 - v0), pt0 = 1.0f / (1.0f + e1), pt1 = e1 * pt0;
            if (dry) { float sink = pgrp * pt0 + pt1; asm volatile("" :: "v"(sink)); }
            if (lane == 0 && !dry) {
                const int ea = g * 4 + i0, eb = g * 4 + i1;
                const int la = atomicAdd((int*)&lcnt[ea], 1), lb = atomicAdd((int*)&lcnt[eb], 1);
                int* tk = (int*)(ws + WS_TOK) + (size_t)m * 8;
                tk[0] = ea; tk[1] = eb; tk[2] = __float_as_int(pgrp * pt0); tk[3] = __float_as_int(pgrp * pt1); tk[4] = la; tk[5] = lb;
            }
        }
    }
    __syncthreads();
#undef NRM_LOAD
#undef NRM_VALID
    if (MODE == 2 && F.tid < 16 && !dry) {
        const int c = lcnt[F.tid];
        ((int*)(ws + WS_WGCNT))[F.bx * 16 + F.tid] = c;
        atomicAdd((int*)(ws + WS_CTL) + CW_ECNT + 64 * layer + F.tid, c);
    }
    __syncthreads();
}

__device__ __forceinline__ void phase_norm2(const ArgsL& a, Frame& F, int layer, const bool dry = false) {
    const int lane = F.lane;
    LAS float* wl = (LAS float*)F.lds;
    LAS int* lcnt = (LAS int*)(F.lds + 20 * 4096);
    unsigned char* ws = a.ws;
    {
        const float* wg = a.in(I_MWG) + (size_t)layer * D * 4; const float* we = a.in(I_MWE) + (size_t)layer * D * 16;
        for (int i4 = F.tid; i4 < 1024; i4 += NTHR) { const f32x4 f = *(const f32x4*)(wg + 4 * i4); wl[i4] = f.x; wl[1024 + i4] = f.y; wl[2048 + i4] = f.z; wl[3072 + i4] = f.w; }
        for (int i4 = F.tid; i4 < 4096; i4 += NTHR) { const int k = i4 >> 2, c = i4 & 3; const f32x4 f = *(const f32x4*)(we + 4 * i4); LAS float* d = wl + (4 + 4 * c) * 1024 + k;
            d[0] = f.x; d[1024] = f.y; d[2048] = f.z; d[3072] = f.w; }
        if (F.tid < 16) lcnt[F.tid] = 0;
    }
    __syncthreads();
    const int gw = F.bx * NWAVES + F.wave, NGW = gridDim.x * NWAVES;
    LAS float* gl = (LAS float*)(F.lds + 86016);
    LAS float* bl = (LAS float*)(F.lds + 90112);
    for (int i = F.tid; i < 1024; i += NTHR) gl[i] = a.in(I_N2G)[layer * D + i];
    if (F.tid < 4) bl[F.tid] = a.in(I_MBG)[layer * 4 + F.tid];
    if (F.tid >= 64 && F.tid < 80) bl[4 + F.tid - 64] = a.in(I_MBE)[layer * 16 + F.tid - 64];
    __syncthreads();
    bf16_t* A = A_PTR(a); const bf16_t* HB = HB_PTR(a);
    LAS float* red = (LAS float*)(F.lds + 81920 + 256) + F.wave * 96;
#define N2_VALID(mm) ((mm) < M && ((mm) % T) >= PADR)
    constexpr int NR = 2;
    for (int m0 = gw; m0 < M; m0 += NR * NGW) {
        f32x4 v[NR][4];
#pragma unroll
        for (int rr = 0; rr < NR; ++rr) { const int mm_ = m0 + rr * NGW;
            if (N2_VALID(mm_)) { const u32x2* hs_ = (const u32x2*)(HB + (size_t)mm_ * D) + lane;
#pragma unroll
                for (int j = 0; j < 4; ++j) { const u32x2 t = hs_[64 * j]; v[rr][j] = (f32x4){bf_lo(t.x), bf_hi(t.x), bf_lo(t.y), bf_hi(t.y)}; } }
            else {
#pragma unroll
                for (int j = 0; j < 4; ++j) v[rr][j] = (f32x4){0.f, 0.f, 0.f, 0.f}; } }
        float ss[NR];
#pragma unroll
        for (int rr = 0; rr < NR; ++rr) { float s_ = 0.f;
#pragma unroll
            for (int j = 0; j < 4; ++j) s_ += (v[rr][j].x * v[rr][j].x + v[rr][j].y * v[rr][j].y) + (v[rr][j].z * v[rr][j].z + v[rr][j].w * v[rr][j].w);
            ss[rr] = s_; }
#pragma unroll
        for (int rr = 0; rr < NR; ++rr) ss[rr] = wave_sum(ss[rr]);
#pragma unroll
        for (int rr = 0; rr < NR; ++rr) { const int mm = m0 + rr * NGW; const float r = 1.0f / sqrtf(ss[rr] * (1.0f / D) + 1e-6f);
#pragma unroll
            for (int j = 0; j < 4; ++j) v[rr][j] = v[rr][j] * r * *(const LAS f32x4*)(gl + 4 * lane + 256 * j);
            if (N2_VALID(mm) && !dry) { u32x2* o = (u32x2*)(A + (size_t)mm * D) + lane;
#pragma unroll
                for (int j = 0; j < 4; ++j) o[64 * j] = (u32x2){pk2(v[rr][j].x, v[rr][j].y), pk2(v[rr][j].z, v[rr][j].w)}; } }
        { const int rho = lane >> 4, vsel = ((rho & 1) << 1) | (rho >> 1);
#pragma unroll
          for (int qh = 0; qh < 2; ++qh) {
            float dp[NR][10];
#pragma unroll
            for (int q = 0; q < 10; ++q) { f32x4 w[4];
#pragma unroll
                for (int j = 0; j < 4; ++j) w[j] = *(const LAS f32x4*)(wl + (qh * 10 + q) * 1024 + 4 * lane + 256 * j);
#pragma unroll
                for (int rr = 0; rr < NR; ++rr) { float d = 0.f;
#pragma unroll
                    for (int j = 0; j < 4; ++j) d += (v[rr][j].x * w[j].x + v[rr][j].y * w[j].y) + (v[rr][j].z * w[j].z + v[rr][j].w * w[j].w);
                    dp[rr][q] = d; }
                if (q & 1) __builtin_amdgcn_sched_barrier(0); }
#pragma unroll
            for (int rr = 0; rr < NR; ++rr) { float sA[6], sB[3]; sA[5] = 0.f;
#pragma unroll
                for (int i = 0; i < 5; ++i) { auto sw = __builtin_amdgcn_permlane32_swap(__float_as_uint(dp[rr][2 * i]), __float_as_uint(dp[rr][2 * i + 1]), false, false); sA[i] = __uint_as_float(sw[0]) + __uint_as_float(sw[1]); }
#pragma unroll
                for (int k = 0; k < 3; ++k) { auto sw = __builtin_amdgcn_permlane16_swap(__float_as_uint(sA[2 * k]), __float_as_uint(sA[2 * k + 1]), false, false); sB[k] = allred16(__uint_as_float(sw[0]) + __uint_as_float(sw[1])); }
                if ((lane & 15) == 0) {
#pragma unroll
                    for (int k = 0; k < 3; ++k) red[rr * 24 + qh * 10 + 4 * k + vsel] = sB[k]; } }
            __builtin_amdgcn_sched_barrier(0);
          } }
        LDS_WAIT();
        if (lane < NR) {
            const int mm = m0 + lane * NGW;
            float ds[20];
#pragma unroll
            for (int i = 0; i < 5; ++i) { const f32x4 t4 = *(const LAS f32x4*)(red + lane * 24 + 4 * i); ds[4 * i] = t4.x; ds[4 * i + 1] = t4.y; ds[4 * i + 2] = t4.z; ds[4 * i + 3] = t4.w; }
            const float lg0 = ds[0] + bl[0], lg1 = ds[1] + bl[1], lg2 = ds[2] + bl[2], lg3 = ds[3] + bl[3];
            int g = 0; float mx = lg0;
            if (lg1 > mx) { mx = lg1; g = 1; } if (lg2 > mx) { mx = lg2; g = 2; } if (lg3 > mx) { mx = lg3; g = 3; }
            const float den = fast_exp(lg0 - mx) + fast_exp(lg1 - mx) + fast_exp(lg2 - mx) + fast_exp(lg3 - mx);
            const float pgrp = 1.0f / den;
            const f32x4 be4 = *(const LAS f32x4*)(bl + 4 + 4 * g);
            float s0 = (g == 0 ? ds[4] : g == 1 ? ds[8] : g == 2 ? ds[12] : ds[16]) + be4.x;
            float s1 = (g == 0 ? ds[5] : g == 1 ? ds[9] : g == 2 ? ds[13] : ds[17]) + be4.y;
            float s2 = (g == 0 ? ds[6] : g == 1 ? ds[10] : g == 2 ? ds[14] : ds[18]) + be4.z;
            float s3 = (g == 0 ? ds[7] : g == 1 ? ds[11] : g == 2 ? ds[15] : ds[19]) + be4.w;
            int i0 = 0; float v0 = s0;
            if (s1 > v0) { v0 = s1; i0 = 1; } if (s2 > v0) { v0 = s2; i0 = 2; } if (s3 > v0) { v0 = s3; i0 = 3; }
            int i1 = -1; float v1 = -3.0e38f;
            if (i0 != 0 && s0 > v1) { v1 = s0; i1 = 0; } if (i0 != 1 && s1 > v1) { v1 = s1; i1 = 1; } if (i0 != 2 && s2 > v1) { v1 = s2; i1 = 2; } if (i0 != 3 && s3 > v1) { v1 = s3; i1 = 3; }
            const float e1 = fast_exp(v1 - v0), pt0 = 1.0f / (1.0f + e1), pt1 = e1 * pt0;
            if (N2_VALID(mm) && !dry) {
                const int ea = g * 4 + i0, eb = g * 4 + i1;
                const int la = atomicAdd((int*)&lcnt[ea], 1), lb = atomicAdd((int*)&lcnt[eb], 1);
                int* tk = (int*)(ws + WS_TOK) + (size_t)mm * 8;
                tk[0] = ea; tk[1] = eb; tk[2] = __float_as_int(pgrp * pt0); tk[3] = __float_as_int(pgrp * pt1); tk[4] = la; tk[5] = lb;
            } else { float sink = pgrp * pt0 + pt1; asm volatile("" :: "v"(sink)); }
        }
        LDS_WAIT();
    }
#undef N2_VALID
    __syncthreads();
    if (F.tid < 16 && !dry) {
        const int c = lcnt[F.tid];
        ((int*)(ws + WS_WGCNT))[F.bx * 16 + F.tid] = c;
        atomicAdd((int*)(ws + WS_CTL) + CW_ECNT + 64 * layer + F.tid, c);
    }
    __syncthreads();
}

__device__ __forceinline__ void phase_route(const ArgsL& a, Frame& F, int layer) {
    unsigned char* ws = a.ws;
    LAS int* tbl = (LAS int*)F.lds;
    LAS int* part = tbl + 16;
    {
        const int e = F.tid & 15, q = F.tid >> 4; const int* wc = (const int*)(ws + WS_WGCNT); int acc = 0;
#pragma unroll
        for (int i = 0; i < 8; ++i) { const int w = q + 32 * i; if (w < (int)F.bx) acc += wc[w * 16 + e]; }
        part[q * 16 + e] = acc;
    }
    __syncthreads();
    if (F.tid < 16) {
        const int* cnt = (const int*)(ws + WS_CTL) + CW_ECNT + 64 * layer;
        int cv[16];
#pragma unroll
        for (int e = 0; e < 16; ++e) cv[e] = __hip_atomic_load(cnt + e, __ATOMIC_RELAXED, __HIP_MEMORY_SCOPE_AGENT);
        int base = 0;
#pragma unroll
        for (int e = 0; e < 16; ++e) if (e < F.tid) base += ((cv[e] + 255) >> 8) << 8;
#pragma unroll
        for (int q = 0; q < 32; ++q) base += part[q * 16 + F.tid];
        tbl[F.tid] = base;
    }
    __syncthreads();
    const int gw = F.bx * NWAVES + F.wave, NGW = gridDim.x * NWAVES, lane = F.lane;
    const bf16_t* A = A_PTR(a); bf16_t* AS = (bf16_t*)(ws + WS_AS);
    int tn[6] = {0, 0, 0, 0, 0, 0}; u32x4 xn0 = {0u, 0u, 0u, 0u}, xn1 = {0u, 0u, 0u, 0u};
#define RT_LOAD(mm) do { if ((mm) < M && ((mm) % T) >= PADR) { const int* tk_ = (const int*)(ws + WS_TOK) + (size_t)(mm) * 8; \
        _Pragma("unroll") for (int q_ = 0; q_ < 6; ++q_) tn[q_] = tk_[q_]; \
        const u32x4* src_ = (const u32x4*)(A + (size_t)(mm) * D) + lane; xn0 = src_[0]; xn1 = src_[64]; } } while (0)
    RT_LOAD(gw);
    for (int m = gw; m < M; m += NGW) {
        int tk[6];
#pragma unroll
        for (int q = 0; q < 6; ++q) tk[q] = tn[q];
        const u32x4 x0 = xn0, x1 = xn1;
        RT_LOAD(m + NGW);
        const int b = m / T, p = m - b * T, l = p - PADR;
        if (l < 0) continue;
        const int ea = tk[0], eb = tk[1], sa = tbl[ea] + tk[4], sb = tbl[eb] + tk[5];
        u32x4* d0 = (u32x4*)(AS + (size_t)sa * D) + lane; u32x4* d1 = (u32x4*)(AS + (size_t)sb * D) + lane;
        d0[0] = x0; d0[64] = x1; d1[0] = x0; d1[64] = x1;
        if (lane == 0) { int* sl = (int*)(ws + WS_SLOT) + 2 * m; sl[0] = sa; sl[1] = sb;
            float* cw = (float*)(ws + WS_CWS); cw[sa] = __int_as_float(tk[2]); cw[sb] = __int_as_float(tk[3]); }
    }
#undef RT_LOAD
    __syncthreads();
}

#ifndef PR_STAGES
#define PR_STAGES 15
#endif
__device__ __forceinline__ void phase_prep(const ArgsL& a, Frame& F, int layer, const bool dry = false) {
    unsigned char* ws = a.ws;
    LAS float* xs = (LAS float*)F.lds;
    const int wave = F.wave, lane = F.lane, tid = F.tid;
    const int m0 = F.bx * 129;
    const bf16_t* USH = (const bf16_t*)(ws + WS_USH);
    bf16_t* QKV = (bf16_t*)(ws + WS_QKV);
    if (F.bx < 10 && (!dry || (PR_STAGES & 8))) {
        const int bh = F.bx, b = bh / 5, h = bh % 5;
        const float* LOGF = (const float*)(ws + WS_LOGF) + (size_t)(b * T + PADR) * 8 + h;
        float* kb = (float*)(ws + WS_KB2) + (size_t)bh * KBP;
        LAS float* wtot = (LAS float*)F.lds;
        float v[33];
        const int l0 = tid * 33;
#pragma unroll
        for (int i = 0; i < 33; ++i) v[i] = (l0 + i < LTOK) ? LOGF[(size_t)(l0 + i) * 8] : 0.f;
#pragma unroll
        for (int i = 1; i < 33; ++i) v[i] += v[i - 1];
        float incl = v[32];
#pragma unroll
        for (int o = 1; o < 64; o <<= 1) { const float t = __shfl_up(incl, o); if (lane >= o) incl += t; }
        if (lane == 63) wtot[wave] = incl;
        __syncthreads();
        float off = incl - v[32];
        for (int w = 0; w < wave; ++w) off += wtot[w];
#pragma unroll
        for (int i = 0; i < 33; ++i) if (l0 + i < LTOK && !dry) kb[PADR + l0 + i] = -(off + v[i]) * LOG2E;
        for (int p = tid; p < PADR; p += NTHR) kb[p] = 0.f;
        for (int p = T + tid; p < KBP; p += NTHR) kb[p] = 0.f;
        __syncthreads();
    }
    if (F.bx >= 16 && F.bx < 28) {
        unsigned* z = (unsigned*)(ws + WS_RW + ((size_t)(F.bx - 16) * LPADDED + LTOK) * 768);
        for (int i = tid; i < (LPADDED - LTOK) * 192; i += NTHR) z[i] = 0u;
    }
    const int r16 = lane & 15, q4 = lane >> 4, hh = wave < 6 ? wave : 0;
    bf16x8 bw[2][4][2];
    float cw0[4], ca0[4], ckk[4], cka[4], crk[4];
    {
        const float* WUp = a.in(I_WUP) + (size_t)layer * 64 * RW_W + hh * 64 + r16; const float* AUp = a.in(I_AUP) + (size_t)layer * 64 * RW_W + hh * 64 + r16;
#pragma unroll
        for (int mtx = 0; mtx < 2; ++mtx)
#pragma unroll
            for (int blk = 0; blk < 4; ++blk)
#pragma unroll
                for (int ks = 0; ks < 2; ++ks) { const float* p_ = (mtx ? AUp : WUp) + (size_t)(32 * ks + 8 * q4) * RW_W + blk * 16;
                    const float f0 = p_[0], f1 = p_[RW_W], f2 = p_[2 * RW_W], f3 = p_[3 * RW_W], f4 = p_[4 * RW_W], f5 = p_[5 * RW_W], f6 = p_[6 * RW_W], f7 = p_[7 * RW_W];
                    bw[mtx][blk][ks] = __builtin_bit_cast(bf16x8, (u32x4){pk2(f0, f1), pk2(f2, f3), pk2(f4, f5), pk2(f6, f7)}); }
#pragma unroll
        for (int blk = 0; blk < 4; ++blk) { const int ch = layer * RW_W + hh * 64 + blk * 16 + r16;
            cw0[blk] = a.in(I_W0)[ch]; ca0[blk] = a.in(I_A0)[ch]; ckk[blk] = a.in(I_KK)[ch]; cka[blk] = a.in(I_KA)[ch]; crk[blk] = a.in(I_RK)[ch]; }
    }
    const float* mu = a.in(I_MU) + layer * SHIFT_W;
    f32x4 gq4 = *(const f32x4*)(a.in(I_QG) + layer * 64 + (lane & 15) * 4) * C2; const f32x4 gk4 = *(const f32x4*)(a.in(I_KG) + layer * 64 + (lane & 15) * 4);
    _Float16* RW = (_Float16*)(ws + WS_RW);
    bf16_t* BN = (bf16_t*)(ws + WS_BN);
    for (int t0 = 0; t0 < 129; t0 += 16) {
        const int nt = (129 - t0) < 16 ? (129 - t0) : 16;
        if (!dry || (PR_STAGES & 1)) {
            int tid = F.tid; asm volatile("" : "+v"(tid));
            u32x4 uu4[5], pp4[5];
#pragma unroll
            for (int q5 = 0; q5 < 5; ++q5) { const int item = tid + q5 * NTHR; uu4[q5] = (u32x4){0u, 0u, 0u, 0u}; pp4[q5] = (u32x4){0u, 0u, 0u, 0u};
                if (item < nt * 160) { const int tok = item / 160, ch = item - tok * 160, m = m0 + t0 + tok;
                    uu4[q5] = *(const u32x4*)(USH + (size_t)m * SHIFT_W + ch * 8);
                    if (m > 0) pp4[q5] = *(const u32x4*)(USH + (size_t)(m - 1) * SHIFT_W + ch * 8); } }
#pragma unroll
            for (int q5 = 0; q5 < 5; ++q5) { const int item = tid + q5 * NTHR;
                if (item < nt * 160) { const int tok = item / 160, ch = item - tok * 160;
                    const u32x4 u = uu4[q5], pv = pp4[q5];
                    const f32x4 mu0 = *(const f32x4*)(mu + ch * 8), mu1 = *(const f32x4*)(mu + ch * 8 + 4);
                    float x[8];
                    { float uu, pp;
                      uu = bf_lo(u.x); pp = bf_lo(pv.x); x[0] = uu + (pp - uu) * mu0.x;  uu = bf_hi(u.x); pp = bf_hi(pv.x); x[1] = uu + (pp - uu) * mu0.y;
                      uu = bf_lo(u.y); pp = bf_lo(pv.y); x[2] = uu + (pp - uu) * mu0.z;  uu = bf_hi(u.y); pp = bf_hi(pv.y); x[3] = uu + (pp - uu) * mu0.w;
                      uu = bf_lo(u.z); pp = bf_lo(pv.z); x[4] = uu + (pp - uu) * mu1.x;  uu = bf_hi(u.z); pp = bf_hi(pv.z); x[5] = uu + (pp - uu) * mu1.y;
                      uu = bf_lo(u.w); pp = bf_lo(pv.w); x[6] = uu + (pp - uu) * mu1.z;  uu = bf_hi(u.w); pp = bf_hi(pv.w); x[7] = uu + (pp - uu) * mu1.w; }
                    if (ch >= 144 && ch < 152) {
#pragma unroll
                        for (int q = 0; q < 8; ++q) { const float e = fast_exp(-2.f * fabsf(x[q])); const float th = (1.f - e) / (1.f + e); x[q] = x[q] < 0.f ? -th : th; }
                    }
                    LAS f32x4* d = (LAS f32x4*)(xs + tok * SHIFT_W + ch * 8);
                    d[0] = (f32x4){x[0], x[1], x[2], x[3]}; d[1] = (f32x4){x[4], x[5], x[6], x[7]}; } }
        }
        __syncthreads();
        if (wave < 6) { if (!dry || (PR_STAGES & 2)) {
            f32x4 acc[2][4];
#pragma unroll
            for (int mtx = 0; mtx < 2; ++mtx) {
                bf16x8 af[2];
#pragma unroll
                for (int ks = 0; ks < 2; ++ks) { const LAS float* xp = xs + r16 * SHIFT_W + 1152 + 64 * mtx + 32 * ks + 8 * q4;
                    const f32x4 u0 = *(const LAS f32x4*)xp, u1 = *(const LAS f32x4*)(xp + 4);
                    af[ks] = __builtin_bit_cast(bf16x8, (u32x4){pk2(u0.x, u0.y), pk2(u0.z, u0.w), pk2(u1.x, u1.y), pk2(u1.z, u1.w)}); }
#pragma unroll
                for (int blk = 0; blk < 4; ++blk) { f32x4 c4 = {0.f, 0.f, 0.f, 0.f};
                    c4 = __builtin_amdgcn_mfma_f32_16x16x32_bf16(af[0], bw[mtx][blk][0], c4, 0, 0, 0);
                    c4 = __builtin_amdgcn_mfma_f32_16x16x32_bf16(af[1], bw[mtx][blk][1], c4, 0, 0, 0);
                    acc[mtx][blk] = c4; }
            }
#pragma unroll
            for (int i = 0; i < 4; ++i) {
                const int tok = 4 * q4 + i, m = m0 + t0 + tok, b = m / T, p = m - b * T, l = p - PADR;
                const bool ok = (tok < nt) && (l >= 0);
                const LAS float* xr = xs + (tok < 16 ? tok : 0) * SHIFT_W + hh * 64 + r16;
                float kkr[4], kpv[4], avv4[4], omv[4], rv4[4], vv4[4];
                float ssq = 0.f, cf = 0.f;
#pragma unroll
                for (int blk = 0; blk < 4; ++blk) {
                    const float wlv = cw0[blk] + acc[0][blk][i], alv = ca0[blk] + acc[1][blk][i];
                    const float r = xr[blk * 16], k = xr[384 + blk * 16], v = xr[768 + blk * 16];
                    const float logw = -softplus_f(-wlv) - 0.5f;
                    const float xw = fast_exp(logw);
                    omv[blk] = xw < 0.02f ? xw * (1.f - 0.5f * xw + xw * xw * (1.f / 6.f)) : 1.f - fast_exp(-xw);
                    const float av = 1.f / (1.f + fast_exp(-alv));
                    kkr[blk] = k * ckk[blk]; kpv[blk] = k * (1.f + (av - 1.f) * cka[blk]); avv4[blk] = av; rv4[blk] = r; vv4[blk] = v;
                    ssq += kkr[blk] * kkr[blk]; cf += r * kpv[blk] * crk[blk];
                }
                ssq = allred16(ssq); cf = allred16(cf);
                const float inv = 1.0f / fmaxf(sqrtf(ssq), 1e-12f);
                if (ok && !dry) {
                    _Float16* o = RW + ((size_t)(b * RW_H + hh) * LPADDED + l) * 384 + r16;
#pragma unroll
                    for (int blk = 0; blk < 4; ++blk) { const float kk = kkr[blk] * inv, bb = kk * avv4[blk];
                        o[blk * 16] = (_Float16)kk; o[64 + blk * 16] = (_Float16)(-omv[blk]); o[128 + blk * 16] = (_Float16)(-bb); o[192 + blk * 16] = (_Float16)kpv[blk];
                        o[256 + blk * 16] = (_Float16)rv4[blk]; o[320 + blk * 16] = (_Float16)vv4[blk];
                        BN[(size_t)m * RW_W + hh * 64 + blk * 16 + r16] = f2bf(cf * vv4[blk]); }
                } else { float sink = ssq + cf + inv + omv[0] + kpv[1]; asm volatile("" :: "v"(sink)); }
            } }
        }
        if (!dry || (PR_STAGES & 4)) {
            const int it4 = lane >> 4, e4 = lane & 15;
            u32x2 xv[5]; bf16_t* qp5[5]; bool okv[5];
#pragma unroll
            for (int ps = 0; ps < 5; ++ps) { const int item = (ps * 8 + wave) * 4 + it4, tok = item / 10, hq = item - tok * 10;
                const int m = m0 + t0 + tok, p = m % T;
                okv[ps] = (tok < nt) && (p >= PADR);
                qp5[ps] = QKV + (size_t)m * QKV_W + 960 + hq * 64 + e4 * 4;
                xv[ps] = okv[ps] ? *(const u32x2*)qp5[ps] : (u32x2){0u, 0u}; }
#pragma unroll
            for (int ps = 0; ps < 5; ++ps) { const int item = (ps * 8 + wave) * 4 + it4, hq = item % 10;
                const float x0 = bf_lo(xv[ps].x), x1 = bf_hi(xv[ps].x), x2 = bf_lo(xv[ps].y), x3 = bf_hi(xv[ps].y);
                const float ss = allred16((x0 * x0 + x1 * x1) + (x2 * x2 + x3 * x3));
                const float rs = 1.0f / sqrtf(ss * (1.0f / 64.f) + 1e-6f);
                const f32x4 gg = hq < 5 ? gq4 : gk4;
                const u32x2 w = {pk2(x0 * rs * gg.x, x1 * rs * gg.y), pk2(x2 * rs * gg.z, x3 * rs * gg.w)};
                if (okv[ps] && !dry) *(u32x2*)qp5[ps] = w; else asm volatile("" :: "v"(w.x), "v"(w.y)); }
        }
        __syncthreads();
    }
}


constexpr int SCH = 16;
static_assert(LTOK % SCH == 0, "whole chunks");
__device__ __forceinline__ void rwkv_scan(const ArgsL& a, Frame& F, int wgi, int dry = 0) {
    const int bh = wgi >> 4, q8 = wgi & 15, b = bh / RW_H, h = bh % RW_H;
    const int tid = F.tid, wave = F.wave, lane = F.lane;
    const unsigned char* rw = a.ws + WS_RW + (size_t)bh * LPADDED * 768;
    LAS float* ring = (LAS float*)F.lds;
    LAS float* ypart = (LAS float*)(F.lds + 49152);
    LAS unsigned char* stg = F.lds + 81920;
    bf16_t* y0 = (bf16_t*)(a.ws + WS_YCAT);
    constexpr int NCH = LTOK / SCH;
    const bool isld = (wave & 2) != 0; const int lw = (wave & 1) + ((wave >> 2) << 1), tl = lw * 64 + lane;
    float s0 = 0.f, s1 = 0.f;
    const int i32 = lane & 31, rsel = lane >> 5, rloc = 2 * wave + rsel;
#define RW_BAR() asm volatile("s_waitcnt lgkmcnt(0)\n\ts_barrier" ::: "memory")
#define RW_ISSUE(cc) do { const unsigned char* src_ = rw + (size_t)(cc) * SCH * 768 + (size_t)tl * 16; LAS unsigned char* d_ = stg + ((cc) & 3) * 12288 + lw * 1024; \
        _Pragma("unroll") for (int k_ = 0; k_ < 3; ++k_) __builtin_amdgcn_global_load_lds((const unsigned*)(src_ + k_ * 4096), (LAS unsigned*)(d_ + k_ * 4096), 16, 0, 0); } while (0)
#define RW_CONVERT(cc) do { const LAS unsigned char* s_ = stg + ((cc) & 3) * 12288 + tl * 16; LAS float* rb_ = ring + ((cc) & 1) * 6144; \
        _Pragma("unroll") for (int k_ = 0; k_ < 3; ++k_) { const int pc_ = tl + 256 * k_; const int t_ = pc_ / 48, q_ = pc_ - t_ * 48, vec_ = q_ >> 3, e0_ = (q_ & 7) * 8; \
            const u32x4 w_ = *(const LAS u32x4*)(s_ + k_ * 4096); \
            const f16x4 lo_ = __builtin_bit_cast(f16x4, (u32x2){w_.x, w_.y}), hi_ = __builtin_bit_cast(f16x4, (u32x2){w_.z, w_.w}); \
            const float f0 = (float)lo_.x, f1 = (float)lo_.y, f2 = (float)lo_.z, f3 = (float)lo_.w, f4 = (float)hi_.x, f5 = (float)hi_.y, f6 = (float)hi_.z, f7 = (float)hi_.w; \
            if (vec_ < 4) { LAS float* d_ = rb_ + t_ * 384 + (vec_ >> 1) * 128 + (e0_ >> 1) * 4 + (vec_ & 1) * 2; \
                *(LAS f32x2*)(d_) = (f32x2){f0, f1}; *(LAS f32x2*)(d_ + 4) = (f32x2){f2, f3}; *(LAS f32x2*)(d_ + 8) = (f32x2){f4, f5}; *(LAS f32x2*)(d_ + 12) = (f32x2){f6, f7}; } \
            else { LAS f32x4* d_ = (LAS f32x4*)(rb_ + t_ * 384 + (vec_ == 4 ? 256 : 320) + e0_); d_[0] = (f32x4){f0, f1, f2, f3}; d_[1] = (f32x4){f4, f5, f6, f7}; } } } while (0)
#define RW_STORE_Y(cc) do { if (tl < 32) { const LAS float* yb_ = ypart + ((cc) & 1) * 4096; const int t_ = tl >> 1, pr_ = tl & 1; const int l_ = (cc) * SCH + t_; \
        const LAS f32x4* q_ = (const LAS f32x4*)(yb_ + t_ * 128 + pr_ * 64); f32x4 sa_ = q_[0], sb_ = q_[8]; \
        _Pragma("unroll") for (int k_ = 1; k_ < 8; ++k_) { sa_ = sa_ + q_[k_]; sb_ = sb_ + q_[8 + k_]; } \
        *(unsigned*)(y0 + (size_t)(b * T + PADR + l_) * RW_W + h * 64 + q8 * 4 + 2 * pr_) = pk2((sa_.x + sa_.y) + (sa_.z + sa_.w), (sb_.x + sb_.y) + (sb_.z + sb_.w)); } } while (0)
    if (isld) {
        RW_ISSUE(0); asm volatile("s_waitcnt vmcnt(0)" ::: "memory"); RW_CONVERT(0);
        RW_ISSUE(1); RW_ISSUE(2);
    }
    RW_BAR();
    for (int c = 0; c < NCH; ++c) {
        if (isld) {
            if (c + 2 < NCH) { asm volatile("s_waitcnt vmcnt(3)" ::: "memory"); RW_CONVERT(c + 1); }
            else if (c + 1 < NCH) { asm volatile("s_waitcnt vmcnt(0)" ::: "memory"); RW_CONVERT(c + 1); }
            if (c > 0 && !dry) RW_STORE_Y(c - 1);
            if (c + 3 < NCH) RW_ISSUE(c + 3);
        } else if (dry != 1 && wave < 2) {
            const unsigned ba = (unsigned)(uintptr_t)(ring + (c & 1) * 6144) + i32 * 16, ca = (unsigned)(uintptr_t)(ring + (c & 1) * 6144) + 1024 + i32 * 8,
                           va = (unsigned)(uintptr_t)(ring + (c & 1) * 6144) + 1280 + (q8 * 4 + rloc) * 4, ya = (unsigned)(uintptr_t)(ypart + (c & 1) * 4096 + rloc * 32 + i32);
            f32x4 OA[4], OB[4]; f32x2 OC[4]; float OV[4];
            OC[3] = (f32x2){0.f, 0.f};
#define RW_FETCH(tt, sl) asm volatile("ds_read_b128 %0, %4 offset:%c7\n\tds_read_b128 %1, %4 offset:%c8\n\tds_read_b64 %2, %5 offset:%c7\n\tds_read_b32 %3, %6 offset:%c7" \
                : "=&v"(OA[sl]), "=&v"(OB[sl]), "=&v"(OC[sl]), "=&v"(OV[sl]) : "v"(ba), "v"(ca), "v"(va), "i"((tt) * 1536), "i"((tt) * 1536 + 512) : "memory")
            RW_FETCH(0, 0); RW_FETCH(1, 1);
            float p, p2, y;
#define RW_STEP(t, WAITN, YL1, YL2, YW, FETCHL) asm volatile( \
                "s_waitcnt lgkmcnt(" WAITN ")\n\t" \
                "v_mul_f32 %[p], %[s0], %[kk0]\n\t" \
                "v_fmac_f32 %[p], %[s1], %[kk1]\n\t" \
                YL1 "\n\t" YL2 "\n\t" \
                XL8 "\n\t" \
                "v_fmac_f32 %[s0], %[s0], %[om0]\n\t" \
                "v_fmac_f32 %[s1], %[s1], %[om1]\n\t" \
                XL4 "\n\t" \
                "v_fmac_f32 %[s0], %[vf], %[kv0]\n\t" \
                "v_fmac_f32 %[s1], %[vf], %[kv1]\n\t" \
                XL2 "\n\t" \
                YW "\n\t" \
                FETCHL \
                : [p] "=&v"(p), [p2] "=&v"(p2), [y] "=&v"(y), [s0] "+v"(s0), [s1] "+v"(s1), [nA] "=&v"(OA[((t) + 2) & 3]), [nB] "=&v"(OB[((t) + 2) & 3]), [nC] "=&v"(OC[((t) + 2) & 3]), [nV] "=&v"(OV[((t) + 2) & 3]) \
                : [kk0] "v"(OA[(t) & 3].x), [kk1] "v"(OA[(t) & 3].y), [om0] "v"(OA[(t) & 3].z), [om1] "v"(OA[(t) & 3].w), [bb0] "v"(OB[(t) & 3].x), [bb1] "v"(OB[(t) & 3].y), [kv0] "v"(OB[(t) & 3].z), [kv1] "v"(OB[(t) & 3].w), \
                  [vf] "v"(OV[(t) & 3]), [rp0] "v"(OC[((t) + 3) & 3].x), [rp1] "v"(OC[((t) + 3) & 3].y), [ba] "v"(ba), [ca] "v"(ca), [va] "v"(va), [ya] "v"(ya), \
                  [oa] "i"(((t) + 2) * 1536), [ob] "i"(((t) + 2) * 1536 + 512), [oy] "i"(((t) - 1) * 512) : "memory")
#define RW_YL1 "v_mul_f32 %[y], %[s0], %[rp0]"
#define RW_YL2 "v_fmac_f32 %[y], %[s1], %[rp1]"
#define RW_YW  "ds_write_b32 %[ya], %[y] offset:%c[oy]"
#define RW_NOP "s_nop 0"
#define RW_TAIL_F "ds_read_b128 %[nA], %[ba] offset:%c[oa]\n\t" \
                XL1 "\n\t" \
                "ds_read_b128 %[nB], %[ba] offset:%c[ob]\n\t" \
                "ds_read_b64 %[nC], %[ca] offset:%c[oa]\n\t" \
                "v_mov_b32 %[p2], %[p]\n\t" \
                "ds_read_b32 %[nV], %[va] offset:%c[oa]\n\t" \
                "s_nop 0\n\t" \
                XSW "\n\t" \
                "v_add_f32 %[p], %[p], %[p2]\n\t" \
                "v_fmac_f32 %[s0], %[p], %[bb0]\n\t" \
                "v_fmac_f32 %[s1], %[p], %[bb1]"
#define RW_TAIL_N "s_nop 0\n\t" \
                XL1 "\n\t" \
                "s_nop 1\n\t" \
                "v_mov_b32 %[p2], %[p]\n\t" \
                "s_nop 1\n\t" \
                XSW "\n\t" \
                "v_add_f32 %[p], %[p], %[p2]\n\t" \
                "v_fmac_f32 %[s0], %[p], %[bb0]\n\t" \
                "v_fmac_f32 %[s1], %[p], %[bb1]"
#define RW_ALLSTEPS() do { \
            RW_STEP(0, "4", RW_NOP, RW_NOP, RW_NOP, RW_TAIL_F); \
            RW_STEP(1, "4", RW_YL1, RW_YL2, RW_YW, RW_TAIL_F); \
            RW_STEP(2, "5", RW_YL1, RW_YL2, RW_YW, RW_TAIL_F);  RW_STEP(3, "5", RW_YL1, RW_YL2, RW_YW, RW_TAIL_F);  RW_STEP(4, "5", RW_YL1, RW_YL2, RW_YW, RW_TAIL_F); \
            RW_STEP(5, "5", RW_YL1, RW_YL2, RW_YW, RW_TAIL_F);  RW_STEP(6, "5", RW_YL1, RW_YL2, RW_YW, RW_TAIL_F);  RW_STEP(7, "5", RW_YL1, RW_YL2, RW_YW, RW_TAIL_F); \
            RW_STEP(8, "5", RW_YL1, RW_YL2, RW_YW, RW_TAIL_F);  RW_STEP(9, "5", RW_YL1, RW_YL2, RW_YW, RW_TAIL_F);  RW_STEP(10, "5", RW_YL1, RW_YL2, RW_YW, RW_TAIL_F); \
            RW_STEP(11, "5", RW_YL1, RW_YL2, RW_YW, RW_TAIL_F); RW_STEP(12, "5", RW_YL1, RW_YL2, RW_YW, RW_TAIL_F); RW_STEP(13, "5", RW_YL1, RW_YL2, RW_YW, RW_TAIL_F); \
            RW_STEP(14, "5", RW_YL1, RW_YL2, RW_YW, RW_TAIL_N); \
            RW_STEP(15, "1", RW_YL1, RW_YL2, RW_YW, RW_TAIL_N); \
            asm volatile("v_mul_f32 %[y], %[s0], %[r0]\n\tv_fmac_f32 %[y], %[s1], %[r1]\n\tds_write_b32 %[ya], %[y] offset:7680" : [y] "=&v"(y) : [s0] "v"(s0), [s1] "v"(s1), [r0] "v"(OC[3].x), [r1] "v"(OC[3].y), [ya] "v"(ya) : "memory"); \
 } while (0)
#ifdef SCAN_PROBE_NOXL
            if (dry == 2) {
#define XL8 "v_add_f32 %[p], %[p], %[p]"
#define XL4 "v_add_f32 %[p], %[p], %[p]"
#define XL2 "v_add_f32 %[p], %[p], %[p]"
#define XL1 "v_add_f32 %[p], %[p], %[p]"
#define XSW "v_add_f32 %[p], %[p], %[p2]"
                RW_ALLSTEPS();
#undef XL8
#undef XL4
#undef XL2
#undef XL1
#undef XSW
            } else
#endif
            {
#define XL8 "v_add_f32_dpp %[p], %[p], %[p] row_ror:8 row_mask:0xf bank_mask:0xf bound_ctrl:1"
#define XL4 "v_add_f32_dpp %[p], %[p], %[p] row_ror:4 row_mask:0xf bank_mask:0xf bound_ctrl:1"
#define XL2 "v_add_f32_dpp %[p], %[p], %[p] row_ror:2 row_mask:0xf bank_mask:0xf bound_ctrl:1"
#define XL1 "v_add_f32_dpp %[p], %[p], %[p] row_ror:1 row_mask:0xf bank_mask:0xf bound_ctrl:1"
#define XSW "v_permlane16_swap_b32 %[p], %[p2]"
                RW_ALLSTEPS();
            }
#undef RW_ALLSTEPS
#undef RW_STEP
#undef XL8
#undef XL4
#undef XL2
#undef XL1
#undef XSW
#undef RW_YL1
#undef RW_YL2
#undef RW_YW
#undef RW_NOP
#undef RW_TAIL_F
#undef RW_TAIL_N
#undef RW_FETCH
        }
        RW_BAR();
    }
    if (isld && !dry) RW_STORE_Y(NCH - 1);
    asm volatile("s_waitcnt vmcnt(0) lgkmcnt(0)\n\ts_barrier" ::: "memory");
#undef RW_STORE_Y
#undef RW_ISSUE
#undef RW_CONVERT
#undef RW_BAR
}

__device__ __forceinline__ int crow(int r, int hi) { return (r & 3) + 8 * (r >> 2) + 4 * hi; }
__device__ __forceinline__ void glds16(const void* gsrc, unsigned lds_dst) { unsigned keep;
    asm volatile("s_mov_b32 %0, m0\n\ts_mov_b32 m0, %2\n\ts_nop 0\n\tglobal_load_lds_dwordx4 %1, off\n\ts_mov_b32 m0, %0" : "=&s"(keep) : "v"(gsrc), "s"(lds_dst) : "memory"); }
__device__ __forceinline__ void glds4(const void* gsrc, unsigned lds_dst) { unsigned keep;
    asm volatile("s_mov_b32 %0, m0\n\ts_mov_b32 m0, %2\n\ts_nop 0\n\tglobal_load_lds_dword %1, off\n\ts_mov_b32 m0, %0" : "=&s"(keep) : "v"(gsrc), "s"(lds_dst) : "memory"); }
typedef LAS const char* lds_cptr;
constexpr int FX_K = 0, FX_V = 24576, FX_WS = 49152, FX_OST = 51200, FX_FLG = 83968, FX_KB = 84224  ;

__device__ __forceinline__ void fx_pv(f32x16* o, int vb, bf16x8 pa0, bf16x8 pa1, bf16x8 pa2, bf16x8 pa3) {
#pragma unroll
    for (int d0 = 0; d0 < 2; ++d0) { s16x4 lo[4], hi[4];
#pragma unroll
        for (int ks = 0; ks < 4; ++ks) {
            asm volatile("ds_read_b64_tr_b16 %0,%1 offset:%c2" : "=&v"(lo[ks]) : "v"(vb), "i"(d0 * 4096 + ks * 1024) : "memory");
            asm volatile("ds_read_b64_tr_b16 %0,%1 offset:%c2" : "=&v"(hi[ks]) : "v"(vb), "i"(d0 * 4096 + ks * 1024 + 512) : "memory"); }
        asm volatile("s_waitcnt lgkmcnt(0)" ::: "memory"); __builtin_amdgcn_sched_barrier(0);
#define FX_PK(k) (bf16x8){lo[k][0], lo[k][1], lo[k][2], lo[k][3], hi[k][0], hi[k][1], hi[k][2], hi[k][3]}
        o[d0] = __builtin_amdgcn_mfma_f32_32x32x16_bf16(pa0, FX_PK(0), o[d0], 0, 0, 0);
        o[d0] = __builtin_amdgcn_mfma_f32_32x32x16_bf16(pa1, FX_PK(1), o[d0], 0, 0, 0);
        o[d0] = __builtin_amdgcn_mfma_f32_32x32x16_bf16(pa2, FX_PK(2), o[d0], 0, 0, 0);
        o[d0] = __builtin_amdgcn_mfma_f32_32x32x16_bf16(pa3, FX_PK(3), o[d0], 0, 0, 0);
#undef FX_PK
    }
}
__device__ __forceinline__ float halves_max(float m) { auto rr = __builtin_amdgcn_permlane32_swap(__float_as_uint(m), __float_as_uint(m), false, false); return fmaxf(__uint_as_float(rr[0]), __uint_as_float(rr[1])); }
__device__ __forceinline__ float halves_sum(float m) { auto rr = __builtin_amdgcn_permlane32_swap(__float_as_uint(m), __float_as_uint(m), false, false); return __uint_as_float(rr[0]) + __uint_as_float(rr[1]); }

constexpr float ATT_EXIT = -40.0f;
template <int KIND>
__device__ __forceinline__ void attn_unit(const ArgsL& a, Frame& F, int b, int h, int qb, float bound) {
    const int lane = F.lane, wave = F.wave, r32 = lane & 31, hi = lane >> 5;
    LAS unsigned char* lds = F.lds;
    const bf16_t* QKV = (const bf16_t*)(a.ws + WS_QKV);
    const size_t rowbase = (size_t)b * T;
    const int p0 = qb * 256;
    constexpr int QC = KIND ? 0 : 960, KC = KIND ? 320 : 1280, VC = KIND ? 640 : 1600;
    const bf16_t* Qw = QKV + (rowbase + p0 + wave * 32) * QKV_W + QC + h * 64;
    const bf16_t* Kh = QKV + rowbase * QKV_W + KC + h * 64;
    const bf16_t* Vh = QKV + rowbase * QKV_W + VC + h * 64;
    const float* kbias = (const float*)(a.ws + WS_KB2) + (size_t)(b * FX_H + h) * KBP;
    const unsigned lds0 = (unsigned)(uintptr_t)lds;
    bf16x8 qr[4];
#pragma unroll
    for (int d0 = 0; d0 < 4; ++d0) qr[d0] = *(const bf16x8*)(Qw + (size_t)r32 * QKV_W + d0 * 16 + hi * 8);
    const int qp = p0 + wave * 32 + r32;
    const bool qvalid = (qp >= PADR) && (qp < T);
    const int plast = (p0 + 255) < (T - 1) ? (p0 + 255) : (T - 1);
    const int jlast = plast >> 6, jfirst = PADR >> 6;
    const int jw = (p0 + wave * 32 + 31) >> 6;
    const bf16_t* ksrc = Kh + (size_t)lane * QKV_W + wave * 8;
    const bf16_t* vsrc = Vh + (size_t)(16 * (wave & 3) + (lane >> 2)) * QKV_W + (wave >> 2) * 32 + (lane & 3) * 8;
    const unsigned kdst = lds0 + FX_K + wave * 1024, vdst = lds0 + FX_V + wave * 1024;
#define FX_DMA(j, slot) do { glds16(ksrc + (size_t)(j) * 64 * QKV_W, (unsigned)__builtin_amdgcn_readfirstlane(kdst + (slot) * 8192)); \
                             glds16(vsrc + (size_t)(j) * 64 * QKV_W, (unsigned)__builtin_amdgcn_readfirstlane(vdst + (slot) * 8192)); \
                             if (KIND == 0) glds4(kbias + 64 * (j) + lane, (unsigned)__builtin_amdgcn_readfirstlane(lds0 + FX_KB + (slot) * 2048 + wave * 256)); } while (0)
    const int vb0 = (int)(lds0 + FX_V) + ((lane >> 4) & 1) * 32 + (lane & 3) * 8 + (4 * hi + ((lane & 15) >> 2)) * 64;
    const lds_cptr kp0 = (lds_cptr)lds + FX_K + hi * 1024 + r32 * 16;
    LAS float* wsf = (LAS float*)(lds + FX_WS) + wave * 64;
    LAS float* flg = (LAS float*)(lds + FX_FLG);
    float m_run = KIND ? 0.f : -1.0e30f, l_run = 0.f;
    f32x16 o[2]; o[0] = f32x16{}; o[1] = f32x16{};
    asm volatile("" : "+v"(qr[0]), "+v"(qr[1]), "+v"(qr[2]), "+v"(qr[3]));
    int slot = 0;
    FX_DMA(jlast, 0);
    if (jlast > jfirst) FX_DMA(jlast - 1, 1);
    for (int j = jlast; j >= jfirst; --j) {
        if (j > jfirst) { if (KIND == 0) asm volatile("s_waitcnt vmcnt(3) lgkmcnt(0)\n\ts_barrier" ::: "memory"); else asm volatile("s_waitcnt vmcnt(2) lgkmcnt(0)\n\ts_barrier" ::: "memory"); }
        else asm volatile("s_waitcnt vmcnt(0) lgkmcnt(0)\n\ts_barrier" ::: "memory");
        if (j < jlast) {
            const LAS float* fl = flg + ((j + 1) & 1) * 16;
            const f32x4 fa = *(const LAS f32x4*)(fl), fb = *(const LAS f32x4*)(fl + 4);
            bool stop;
            if constexpr (KIND == 0) {
                const float mmin = fminf(fminf(fminf(fa.x, fa.y), fminf(fa.z, fa.w)), fminf(fminf(fb.x, fb.y), fminf(fb.z, fb.w)));
                stop = (bound + fl[8] - mmin) < ATT_EXIT;
            } else {
                const float mmax = fmaxf(fmaxf(fmaxf(fa.x, fa.y), fmaxf(fa.z, fa.w)), fmaxf(fmaxf(fb.x, fb.y), fmaxf(fb.z, fb.w)));
                stop = mmax < ATT_EXIT;
            }
            if (stop) break;
        }
        { const int s2 = slot + 2 >= 3 ? slot - 1 : slot + 2; if (j - 2 >= jfirst) FX_DMA(j - 2, s2); }
        if (j <= jw) {
            f32x16 s0v = f32x16{}, s1v = f32x16{};
            const lds_cptr kp = kp0 + slot * 8192;
#pragma unroll
            for (int d0 = 0; d0 < 4; ++d0) {
                const bf16x8 b0 = *(const LAS bf16x8*)(kp + d0 * 2048);
                const bf16x8 b1 = *(const LAS bf16x8*)(kp + d0 * 2048 + 512);
                s0v = __builtin_amdgcn_mfma_f32_32x32x16_bf16(b0, qr[d0], s0v, 0, 0, 0);
                s1v = __builtin_amdgcn_mfma_f32_32x32x16_bf16(b1, qr[d0], s1v, 0, 0, 0);
            }
            const bool edge = (64 * j + 63 >= p0 + wave * 32) || (64 * j < PADR);
            if constexpr (KIND == 0) {
                const LAS float* kbj = (const LAS float*)(lds + FX_KB + slot * 2048 + wave * 256) + 4 * hi;
#pragma unroll
                for (int g = 0; g < 4; ++g) { const f32x4 t0 = *(const LAS f32x4*)(kbj + 8 * g), t1 = *(const LAS f32x4*)(kbj + 32 + 8 * g);
                    s0v[4 * g] += t0.x; s0v[4 * g + 1] += t0.y; s0v[4 * g + 2] += t0.z; s0v[4 * g + 3] += t0.w;
                    s1v[4 * g] += t1.x; s1v[4 * g + 1] += t1.y; s1v[4 * g + 2] += t1.z; s1v[4 * g + 3] += t1.w; }
                if (edge) {
#pragma unroll
                    for (int r = 0; r < 16; ++r) { const int key = 64 * j + crow(r, hi);
                        if (key > qp || key < PADR) s0v[r] = -INFINITY;
                        if (key + 32 > qp || key + 32 < PADR) s1v[r] = -INFINITY; }
                }
                float rm = fmaxf(s0v[0], s1v[0]);
#pragma unroll
                for (int r = 1; r < 16; ++r) rm = fmaxf(rm, fmaxf(s0v[r], s1v[r]));
                rm = halves_max(rm);
                const float m_new = fmaxf(m_run, rm);
                const float f = __builtin_amdgcn_exp2f(m_run - m_new);
                m_run = m_new;
                float rs = 0.f;
#pragma unroll
                for (int r = 0; r < 16; ++r) { s0v[r] = __builtin_amdgcn_exp2f(s0v[r] - m_new); s1v[r] = __builtin_amdgcn_exp2f(s1v[r] - m_new); rs += s0v[r] + s1v[r]; }
                rs = halves_sum(rs);
                l_run = l_run * f + rs;
                if (!__all(f == 1.0f)) {
                    if (hi == 0) wsf[r32] = f;
                    LDS_WAIT();
#pragma unroll
                    for (int d_ = 0; d_ < 2; ++d_)
#pragma unroll
                        for (int r = 0; r < 16; ++r) o[d_][r] *= wsf[crow(r, hi)];
                }
            } else {
                f32x16 l0, l1;
#pragma unroll
                for (int r = 0; r < 16; ++r) {
                    const float z0 = s0v[r], z1 = s1v[r];
                    float a0 = -(fmaxf(z0, 0.f) + __builtin_amdgcn_logf(1.f + __builtin_amdgcn_exp2f(-fabsf(z0))));
                    float a1 = -(fmaxf(z1, 0.f) + __builtin_amdgcn_logf(1.f + __builtin_amdgcn_exp2f(-fabsf(z1))));
                    if (edge) { const int key = 64 * j + crow(r, hi);
                        if (key >= qp || key < PADR) { a0 = 0.f; s0v[r] = -INFINITY; }
                        if (key + 32 >= qp || key + 32 < PADR) { a1 = 0.f; s1v[r] = -INFINITY; } }
                    l0[r] = a0; l1[r] = a1;
                }
                float A[8], SA[9], SO[9];
#pragma unroll
                for (int g = 0; g < 4; ++g) { A[g] = (l0[4 * g] + l0[4 * g + 1]) + (l0[4 * g + 2] + l0[4 * g + 3]); A[4 + g] = (l1[4 * g] + l1[4 * g + 1]) + (l1[4 * g + 2] + l1[4 * g + 3]); }
                SA[8] = 0.f; SO[8] = 0.f;
#pragma unroll
                for (int g = 7; g >= 0; --g) SA[g] = A[g] + SA[g + 1];
#pragma unroll
                for (int g = 0; g < 8; ++g) { auto rr = __builtin_amdgcn_permlane32_swap(__float_as_uint(SA[g]), __float_as_uint(SA[g]), false, false); SO[g] = __uint_as_float(hi ? rr[0] : rr[1]); }
                const float R = m_run;
#pragma unroll
                for (int g = 0; g < 8; ++g) {
                    const float E = SA[g + 1] + (hi ? SO[g + 1] : SO[g]) + R;
                    if (g < 4) { float t = E;
                        s0v[4 * g + 3] = __builtin_amdgcn_exp2f(s0v[4 * g + 3] + l0[4 * g + 3] + t); t += l0[4 * g + 3];
                        s0v[4 * g + 2] = __builtin_amdgcn_exp2f(s0v[4 * g + 2] + l0[4 * g + 2] + t); t += l0[4 * g + 2];
                        s0v[4 * g + 1] = __builtin_amdgcn_exp2f(s0v[4 * g + 1] + l0[4 * g + 1] + t); t += l0[4 * g + 1];
                        s0v[4 * g + 0] = __builtin_amdgcn_exp2f(s0v[4 * g + 0] + l0[4 * g + 0] + t);
                    } else { const int q = g - 4; float t = E;
                        s1v[4 * q + 3] = __builtin_amdgcn_exp2f(s1v[4 * q + 3] + l1[4 * q + 3] + t); t += l1[4 * q + 3];
                        s1v[4 * q + 2] = __builtin_amdgcn_exp2f(s1v[4 * q + 2] + l1[4 * q + 2] + t); t += l1[4 * q + 2];
                        s1v[4 * q + 1] = __builtin_amdgcn_exp2f(s1v[4 * q + 1] + l1[4 * q + 1] + t); t += l1[4 * q + 1];
                        s1v[4 * q + 0] = __builtin_amdgcn_exp2f(s1v[4 * q + 0] + l1[4 * q + 0] + t);
                    }
                }
                m_run = R + SA[0] + SO[0];
            }
            u32x4 pw0, pw1, pw2, pw3;
            pw0 = (u32x4){pk2(s0v[0], s0v[1]), pk2(s0v[2], s0v[3]), pk2(s0v[4], s0v[5]), pk2(s0v[6], s0v[7])};
            pw1 = (u32x4){pk2(s0v[8], s0v[9]), pk2(s0v[10], s0v[11]), pk2(s0v[12], s0v[13]), pk2(s0v[14], s0v[15])};
            pw2 = (u32x4){pk2(s1v[0], s1v[1]), pk2(s1v[2], s1v[3]), pk2(s1v[4], s1v[5]), pk2(s1v[6], s1v[7])};
            pw3 = (u32x4){pk2(s1v[8], s1v[9]), pk2(s1v[10], s1v[11]), pk2(s1v[12], s1v[13]), pk2(s1v[14], s1v[15])};
            fx_pv(o, vb0 + slot * 8192, __builtin_bit_cast(bf16x8, pw0), __builtin_bit_cast(bf16x8, pw1), __builtin_bit_cast(bf16x8, pw2), __builtin_bit_cast(bf16x8, pw3));
        }
        float mm = qvalid ? m_run : (KIND ? -3.0e38f : 3.0e38f);
        if constexpr (KIND == 0) { mm = fminf(mm, dpp_f<0x128>(mm)); mm = fminf(mm, dpp_f<0x124>(mm)); mm = fminf(mm, dpp_f<0x122>(mm)); mm = fminf(mm, dpp_f<0x121>(mm));
            { auto sw = __builtin_amdgcn_permlane16_swap(__float_as_uint(mm), __float_as_uint(mm), false, false); mm = fminf(__uint_as_float(sw[0]), __uint_as_float(sw[1])); }
            { auto sw = __builtin_amdgcn_permlane32_swap(__float_as_uint(mm), __float_as_uint(mm), false, false); mm = fminf(__uint_as_float(sw[0]), __uint_as_float(sw[1])); } }
        else { mm = fmaxf(mm, dpp_f<0x128>(mm)); mm = fmaxf(mm, dpp_f<0x124>(mm)); mm = fmaxf(mm, dpp_f<0x122>(mm)); mm = fmaxf(mm, dpp_f<0x121>(mm));
            { auto sw = __builtin_amdgcn_permlane16_swap(__float_as_uint(mm), __float_as_uint(mm), false, false); mm = fmaxf(__uint_as_float(sw[0]), __uint_as_float(sw[1])); }
            { auto sw = __builtin_amdgcn_permlane32_swap(__float_as_uint(mm), __float_as_uint(mm), false, false); mm = fmaxf(__uint_as_float(sw[0]), __uint_as_float(sw[1])); } }
        if (lane == 0) { flg[(j & 1) * 16 + wave] = mm;
            if (KIND == 0 && wave == 0) flg[(j & 1) * 16 + 8] = *(const LAS float*)(lds + FX_KB + slot * 2048); }
        slot = slot == 2 ? 0 : slot + 1;
    }
    asm volatile("s_waitcnt vmcnt(0) lgkmcnt(0)\n\ts_barrier" ::: "memory");
    float rli[16];
    if constexpr (KIND == 0) {
        if (hi == 0) wsf[32 + r32] = l_run;
        LDS_WAIT();
#pragma unroll
        for (int r = 0; r < 16; ++r) rli[r] = __builtin_amdgcn_rcpf(wsf[32 + crow(r, hi)]);
    } else {
#pragma unroll
        for (int r = 0; r < 16; ++r) rli[r] = 1.0f;
    }
    bf16_t* Ow = (bf16_t*)(a.ws + WS_YCAT) + (rowbase + p0 + wave * 32) * YC_W + (KIND ? 384 : 768) + h * 64;
    {
        LAS bf16_t* stg = (LAS bf16_t*)(lds + FX_OST) + wave * 2048;
#pragma unroll
        for (int r = 0; r < 16; ++r) { const int orow = crow(r, hi);
#pragma unroll
            for (int d0 = 0; d0 < 2; ++d0) stg[orow * 64 + d0 * 32 + r32] = f2bf(o[d0][r] * rli[r]); }
        LDS_WAIT();
#pragma unroll
        for (int i = 0; i < 4; ++i) { const int row = i * 8 + (lane >> 3), ch = lane & 7; const u32x4 v = *(const LAS u32x4*)(stg + row * 64 + ch * 8);
            const int pr = p0 + wave * 32 + row;
            if (pr >= PADR && pr < T) *(u32x4*)(Ow + (size_t)row * YC_W + ch * 8) = v; }
    }
    asm volatile("s_waitcnt lgkmcnt(0)\n\ts_barrier" ::: "memory");
#undef FX_DMA
}


constexpr int CK = 64, NCK = 257, CKB = 40960;
static_assert(LPADDED == CK * NCK, "padded steps");
__device__ __forceinline__ int swz(int row, int chunk) { return row * 128 + ((chunk ^ (row & 7)) << 4); }
__device__ __forceinline__ void ck_mm(f32x16& acc, LAS unsigned char* A, LAS unsigned char* Bt, int m0, int n0, int r32, int hi) {
#pragma unroll
    for (int ks = 0; ks < 4; ++ks) {
        const bf16x8 av = *(const LAS bf16x8*)(A + swz(m0 + r32, 2 * ks + hi));
        const bf16x8 bv = *(const LAS bf16x8*)(Bt + swz(n0 + r32, 2 * ks + hi));
        acc = __builtin_amdgcn_mfma_f32_32x32x16_bf16(av, bv, acc, 0, 0, 0);
    }
}
__device__ __forceinline__ void ck_store_t(LAS unsigned char* dst, const f32x16& acc, int m0, int n0, int r32, int hi) {
#pragma unroll
    for (int g = 0; g < 4; ++g) { const u32x2 w = {pk2(acc[4 * g], acc[4 * g + 1]), pk2(acc[4 * g + 2], acc[4 * g + 3])};
        *(LAS u32x2*)(dst + swz(n0 + r32, (m0 >> 3) + g) + hi * 8) = w; }
}
constexpr int CA_KAP = 0, CA_BET = 8192, CA_CHI = 16384, CA_RHO = 24576, CA_VMT = 32768, CA_BHT = 40960, CA_KHT = 49152, CA_AK = 57344, CA_RB = 65536, CA_RK = 73728,
              CA_AB = 81920  , CA_RHS = 98304  , CA_G64 = MISC_OFF + 2048  , CA_SCR = MISC_OFF + 4096  ;

#ifndef CA_STAGES
#define CA_STAGES 15
#endif
__device__ __forceinline__ void phase_chunkA(const ArgsL& a, Frame& F, const bool dry = false) {
    const int wave = F.wave;
    LAS unsigned char* L = F.lds;
    u32x4 pre6[6];
    for (int id = F.bx; id < 12 * NCK; id += (int)gridDim.x) {
        int tid = F.tid, lane, r32, hi;
#define CK_FRESH() do { asm volatile("" : "+v"(tid)); lane = tid & 63; r32 = lane & 31; hi = lane >> 5; } while (0)
        CK_FRESH();
        const int bh = id / NCK, c = id - bh * NCK;
        unsigned char* blk = a.ws + WS_RW + ((size_t)bh * LPADDED + (size_t)c * CK) * 768;
        {
            if (id == F.bx) {
#pragma unroll
                for (int q6 = 0; q6 < 6; ++q6) pre6[q6] = *(const u32x4*)(blk + (size_t)(tid + q6 * NTHR) * 16);
            }
#pragma unroll
            for (int q6 = 0; q6 < 6; ++q6) *(LAS u32x4*)(L + CA_AB + (tid + q6 * NTHR) * 16) = pre6[q6];
            __syncthreads();
            const int k = tid & 63, tq = tid >> 6;
            const LAS _Float16* src = (const LAS _Float16*)(L + CA_AB) + (tq * 8) * 384 + k;
            float kk[8], w[8], bb[8], kp[8], rr[8], vv[8];
#pragma unroll
            for (int e = 0; e < 8; ++e) { kk[e] = (float)src[e * 384]; w[e] = 1.f + (float)src[e * 384 + 64]; bb[e] = -(float)src[e * 384 + 128];
                kp[e] = (float)src[e * 384 + 192]; rr[e] = (float)src[e * 384 + 256]; vv[e] = (float)src[e * 384 + 320]; }
            float g[8]; g[0] = w[0];
#pragma unroll
            for (int e = 1; e < 8; ++e) g[e] = g[e - 1] * w[e];
            LAS float* scr = (LAS float*)(L + CA_SCR);
            scr[tq * 64 + k] = g[7];
            __syncthreads();
            {
                const int idn = id + (int)gridDim.x;
                if (idn < 12 * NCK) { const int bhn = idn / NCK, cn = idn - bhn * NCK; const unsigned char* bn_ = a.ws + WS_RW + ((size_t)bhn * LPADDED + (size_t)cn * CK) * 768;
#pragma unroll
                    for (int q6 = 0; q6 < 6; ++q6) pre6[q6] = *(const u32x4*)(bn_ + (size_t)(tid + q6 * NTHR) * 16); }
            }
            float pre = 1.f, tot = 1.f;
#pragma unroll
            for (int q = 0; q < 8; ++q) { const float s = scr[q * 64 + k]; if (q < tq) pre *= s; tot *= s; }
            if (tq == 0) ((LAS float*)(L + CA_G64))[k] = tot;
            unsigned bh4[4], kh4[4], vm4[4];
            float Gp = pre;
#pragma unroll
            for (int e = 0; e < 8; ++e) {
                const int t = tq * 8 + e; const float G = pre * g[e], iG = __builtin_amdgcn_rcpf(G);
                const float kap = kk[e] * Gp, bet = bb[e] * iG, chi = kp[e] * iG, rho = rr[e] * G;
                const int o = swz(t, k >> 3) + (k & 7) * 2;
                *(LAS unsigned short*)(L + CA_KAP + o) = f2bf(kap); *(LAS unsigned short*)(L + CA_BET + o) = f2bf(bet);
                *(LAS unsigned short*)(L + CA_CHI + o) = f2bf(chi); *(LAS unsigned short*)(L + CA_RHO + o) = f2bf(rho);
                ((LAS float*)(L + CA_RHS))[t * 128 + k] = kap;
                const float bhv = bet * tot, khv = chi * tot;
                if (e & 1) { bh4[e >> 1] |= (unsigned)f2bf(bhv) << 16; kh4[e >> 1] |= (unsigned)f2bf(khv) << 16; vm4[e >> 1] |= (unsigned)f2bf(vv[e]) << 16; }
                else { bh4[e >> 1] = f2bf(bhv); kh4[e >> 1] = f2bf(khv); vm4[e >> 1] = f2bf(vv[e]); }
                Gp = G;
            }
            *(LAS u32x4*)(L + CA_BHT + swz(k, tq)) = (u32x4){bh4[0], bh4[1], bh4[2], bh4[3]};
            *(LAS u32x4*)(L + CA_KHT + swz(k, tq)) = (u32x4){kh4[0], kh4[1], kh4[2], kh4[3]};
            *(LAS u32x4*)(L + CA_VMT + swz(k, tq)) = (u32x4){vm4[0], vm4[1], vm4[2], vm4[3]};
        }
        __syncthreads();
        CK_FRESH();
        if (!dry || (CA_STAGES & 2)) {
            const int p = wave & 3, nb = wave >> 2;
            LAS unsigned char* Am = L + ((p & 1) ? CA_CHI : CA_BET);
            LAS unsigned char* Bm = L + ((p & 2) ? CA_RHO : CA_KAP);
#pragma unroll
            for (int mb = 0; mb < 2; ++mb) {
                f32x16 acc = f32x16{};
                if (!(mb == 1 && nb == 0)) ck_mm(acc, Am, Bm, mb * 32, nb * 32, r32, hi);
                const int t = nb * 32 + r32;
#pragma unroll
                for (int i = 0; i < 16; ++i) { const int j = mb * 32 + crow(i, hi); const bool keep = (p & 2) ? (j <= t) : (j < t); if (!keep) acc[i] = 0.f; }
                if (p == 0) {
#pragma unroll
                    for (int gq = 0; gq < 4; ++gq) { LAS float* ab_ = (LAS float*)(L + CA_AB) + t * 64 + (mb * 8 + 2 * gq + hi);
                        ab_[0] = acc[4 * gq]; ab_[16] = acc[4 * gq + 1]; ab_[32] = acc[4 * gq + 2]; ab_[48] = acc[4 * gq + 3]; }
                } else ck_store_t(L + (p == 1 ? CA_AK : p == 2 ? CA_RB : CA_RK), acc, mb * 32, nb * 32, r32, hi);
            }
        }
        __syncthreads();
        CK_FRESH();
        if (wave < 4 && (!dry || (CA_STAGES & 2))) {
            const int mb = wave >> 1, nb = wave & 1;
            f32x16 acc = f32x16{};
            ck_mm(acc, L + CA_AK, L + CA_VMT, mb * 32, nb * 32, r32, hi);
#pragma unroll
            for (int i = 0; i < 16; ++i) ((LAS float*)(L + CA_RHS))[(mb * 32 + crow(i, hi)) * 128 + 64 + nb * 32 + r32] = acc[i];
        }
        __syncthreads();
        CK_FRESH();
        if (!dry || (CA_STAGES & 4)) {
            const int col = tid >> 2, p = tid & 3;
            unsigned abv = (unsigned)(uintptr_t)(L + CA_AB) + p * 64; asm volatile("" : "+v"(abv));
            const LAS float* ab = (const LAS float*)(uintptr_t)abv;
            const LAS float* rhs = (const LAS float*)(L + CA_RHS) + col;
            float xo[16];
#pragma unroll
            for (int i = 0; i < 16; ++i) xo[i] = 0.f;
#pragma unroll
            for (int tg = 0; tg < 64; tg += 4) {
                f32x4 av[4][4]; float rv[4];
#pragma unroll
                for (int r = 0; r < 4; ++r) { rv[r] = rhs[(tg + r) * 128];
#pragma unroll
                    for (int i4 = 0; i4 < (tg + r + 15) / 16; ++i4) av[r][i4] = *(const LAS f32x4*)(ab + (tg + r) * 64 + 4 * i4); }
#pragma unroll
                for (int r = 0; r < 4; ++r) { const int t = tg + r;
                    float s0 = (p == 0) ? rv[r] : 0.f, s1 = 0.f;
#pragma unroll
                    for (int i4 = 0; i4 < (t + 15) / 16; ++i4) {
                        s0 -= av[r][i4].x * xo[4 * i4]; s1 -= av[r][i4].y * xo[4 * i4 + 1]; s0 -= av[r][i4].z * xo[4 * i4 + 2]; s1 -= av[r][i4].w * xo[4 * i4 + 3]; }
                    float sx = s0 + s1;
                    sx += dpp_f<0xB1>(sx);
                    sx += dpp_f<0x4E>(sx);
                    if ((t & 3) == p) xo[t >> 2] = sx;
                    asm volatile("" : "+v"(xo[t >> 2]));
                }
                __builtin_amdgcn_sched_barrier(0);
            }
            LAS unsigned char* dst = L + (col < 64 ? CA_KAP : CA_BET);
            const int rowc = col & 63;
#pragma unroll
            for (int i = 0; i < 16; ++i) { const int tt = 4 * i + p; *(LAS unsigned short*)(dst + swz(rowc, tt >> 3) + (tt & 7) * 2) = f2bf(-xo[i]); }
        }
        __syncthreads();
        CK_FRESH();
        if (!dry || (CA_STAGES & 8)) {
            const int ty = wave >> 1;
            LAS unsigned char* nW1 = L + CA_KAP; LAS unsigned char* nW2 = L + CA_BET;
#pragma unroll
            for (int qq = 0; qq < 2; ++qq) {
                const int q = (wave & 1) * 2 + qq, qa = q >> 1, qb = q & 1;
                f32x16 acc = f32x16{};
                if (ty == 0) {
                    const int t = qa * 32 + r32;
#pragma unroll
                    for (int gq = 0; gq < 4; ++gq) { const u32x2 rv = *(const LAS u32x2*)(L + CA_RHO + swz(t, qb * 4 + gq) + hi * 8);
                        acc[4 * gq] = bf_lo(rv.x); acc[4 * gq + 1] = bf_hi(rv.x); acc[4 * gq + 2] = bf_lo(rv.y); acc[4 * gq + 3] = bf_hi(rv.y); }
                    ck_mm(acc, nW1, L + CA_RB, qb * 32, qa * 32, r32, hi);
                } else if (ty == 1) {
                    ck_mm(acc, nW1, L + CA_BHT, qb * 32, qa * 32, r32, hi);
                    if (qa == qb) { const float g64 = ((const LAS float*)(L + CA_G64))[qa * 32 + r32];
#pragma unroll
                        for (int i = 0; i < 16; ++i) if (crow(i, hi) == r32) acc[i] += g64; }
                } else if (ty == 2) {
                    ck_mm(acc, L + CA_KHT, L + CA_VMT, qb * 32, qa * 32, r32, hi);
                    ck_mm(acc, L + CA_BHT, nW2, qb * 32, qa * 32, r32, hi);
                } else {
                    ck_mm(acc, L + CA_RK, L + CA_VMT, qb * 32, qa * 32, r32, hi);
                    ck_mm(acc, L + CA_RB, nW2, qb * 32, qa * 32, r32, hi);
                }
                if (dry) { float sink = acc[0] + acc[5] + acc[10] + acc[15]; asm volatile("" :: "v"(sink)); }
                else if (ty < 2) {
                    unsigned char* o = blk + (ty == 0 ? 8192 : 0) + (size_t)(((qa * 2 + qb) * 2) * 1024) + lane * 16;
#pragma unroll
                    for (int ks = 0; ks < 2; ++ks)
                        *(u32x4*)(o + ks * 1024) = (u32x4){pk2(acc[8 * ks], acc[8 * ks + 1]), pk2(acc[8 * ks + 2], acc[8 * ks + 3]), pk2(acc[8 * ks + 4], acc[8 * ks + 5]), pk2(acc[8 * ks + 6], acc[8 * ks + 7])};
                } else if (ty == 2) {
                    unsigned char* o = blk + 16384 + (qa * 2 + qb) * 4096 + lane * 16;
#pragma unroll
                    for (int g = 0; g < 4; ++g) *(f32x4*)(o + g * 1024) = (f32x4){acc[4 * g], acc[4 * g + 1], acc[4 * g + 2], acc[4 * g + 3]};
                } else {
                    unsigned char* o = blk + 32768 + (qa * 2 + qb) * 2048 + lane * 8;
#pragma unroll
                    for (int g = 0; g < 4; ++g) *(u32x2*)(o + g * 512) = (u32x2){pk2(acc[4 * g], acc[4 * g + 1]), pk2(acc[4 * g + 2], acc[4 * g + 3])};
                }
            }
        }
        __syncthreads();
    }
}

__device__ __forceinline__ void rwkv_chunkB(const ArgsL& a, Frame& F, int bh) {
    const int lane = F.lane, wave = F.wave, r32 = lane & 31, hi = lane >> 5;
    const int b = bh / RW_H, h = bh % RW_H;
    LAS unsigned char* L = F.lds;
    const unsigned char* base = a.ws + WS_RW + (size_t)bh * LPADDED * 768;
    bf16_t* y0 = (bf16_t*)(a.ws + WS_YCAT);
    const bool isld = (wave & 2) != 0; const int lw = (wave & 1) + ((wave >> 2) << 1);
    LAS unsigned char* yimg0 = L + 3 * CKB; LAS unsigned char* yimg1 = L + MISC_OFF + 8192;
#define CB_ISSUE(cc) do { const unsigned char* s_ = base + (size_t)(cc) * CK * 768 + (size_t)lw * 1024 + lane * 16; LAS unsigned char* d_ = L + ((cc) % 3) * CKB + lw * 1024; \
        _Pragma("unroll") for (int r_ = 0; r_ < 10; ++r_) __builtin_amdgcn_global_load_lds((const unsigned*)(s_ + r_ * 4096), (LAS unsigned*)(d_ + r_ * 4096), 16, 0, 0); } while (0)
#define CB_YOUT(cc) do { const LAS unsigned char* im_ = ((cc) & 1) ? yimg1 : yimg0; \
        _Pragma("unroll") for (int r_ = 0; r_ < 8; ++r_) { const int t_ = r_ * 8 + (lane >> 3), l_ = (cc) * CK + t_; const u32x4 v_ = *(const LAS u32x4*)(im_ + t_ * 128 + (lane & 7) * 16); \
            if (l_ < LTOK) *(u32x4*)(y0 + (size_t)(b * T + PADR + l_) * YC_W + h * 64 + (lane & 7) * 8) = v_; } } while (0)
    if (isld) { CB_ISSUE(0); CB_ISSUE(1); asm volatile("s_waitcnt vmcnt(10)" ::: "memory"); }
    asm volatile("s_waitcnt lgkmcnt(0)\n\ts_barrier" ::: "memory");
    f32x16 Z0 = f32x16{}, Z1 = f32x16{};
    for (int c = 0; c < NCK; ++c) {
        if (isld) {
            if (wave == 6 && c > 0) CB_YOUT(c - 1);
            if (c + 2 < NCK) CB_ISSUE(c + 2);
            if (c + 2 < NCK) asm volatile("s_waitcnt vmcnt(10)" ::: "memory"); else asm volatile("s_waitcnt vmcnt(0)" ::: "memory");
        } else if (wave < 2) {
            const LAS unsigned char* S = L + (c % 3) * CKB;
            LAS unsigned char* yim = (c & 1) ? yimg1 : yimg0;
            const int vb = wave;
            bf16x8 zf[2][2];
#pragma unroll
            for (int ks = 0; ks < 2; ++ks) {
                zf[0][ks] = __builtin_bit_cast(bf16x8, (u32x4){pk2(Z0[8 * ks], Z0[8 * ks + 1]), pk2(Z0[8 * ks + 2], Z0[8 * ks + 3]), pk2(Z0[8 * ks + 4], Z0[8 * ks + 5]), pk2(Z0[8 * ks + 6], Z0[8 * ks + 7])});
                zf[1][ks] = __builtin_bit_cast(bf16x8, (u32x4){pk2(Z1[8 * ks], Z1[8 * ks + 1]), pk2(Z1[8 * ks + 2], Z1[8 * ks + 3]), pk2(Z1[8 * ks + 4], Z1[8 * ks + 5]), pk2(Z1[8 * ks + 6], Z1[8 * ks + 7])});
            }
#pragma unroll
            for (int tb = 0; tb < 2; ++tb) {
                f32x16 acc;
                const LAS unsigned char* yt = S + 32768 + (vb * 2 + tb) * 2048 + lane * 8;
#pragma unroll
                for (int g = 0; g < 4; ++g) { const u32x2 w = *(const LAS u32x2*)(yt + g * 512); acc[4 * g] = bf_lo(w.x); acc[4 * g + 1] = bf_hi(w.x); acc[4 * g + 2] = bf_lo(w.y); acc[4 * g + 3] = bf_hi(w.y); }
#pragma unroll
                for (int kb2 = 0; kb2 < 2; ++kb2)
#pragma unroll
                    for (int ks = 0; ks < 2; ++ks) { const bf16x8 pa = *(const LAS bf16x8*)(S + 8192 + ((tb * 2 + kb2) * 2 + ks) * 1024 + lane * 16);
                        acc = __builtin_amdgcn_mfma_f32_32x32x16_bf16(pa, zf[kb2][ks], acc, 0, 0, 0); }
#pragma unroll
                for (int i = 0; i < 16; ++i) *(LAS unsigned short*)(yim + (tb * 32 + crow(i, hi)) * 128 + (vb * 32 + r32) * 2) = f2bf(acc[i]);
            }
            f32x16 N0, N1;
            { const LAS unsigned char* n0 = S + 16384 + (vb * 2 + 0) * 4096 + lane * 16; const LAS unsigned char* n1 = S + 16384 + (vb * 2 + 1) * 4096 + lane * 16;
#pragma unroll
              for (int g = 0; g < 4; ++g) { const f32x4 u0 = *(const LAS f32x4*)(n0 + g * 1024), u1 = *(const LAS f32x4*)(n1 + g * 1024);
                  N0[4 * g] = u0.x; N0[4 * g + 1] = u0.y; N0[4 * g + 2] = u0.z; N0[4 * g + 3] = u0.w; N1[4 * g] = u1.x; N1[4 * g + 1] = u1.y; N1[4 * g + 2] = u1.z; N1[4 * g + 3] = u1.w; } }
#pragma unroll
            for (int kb2 = 0; kb2 < 2; ++kb2)
#pragma unroll
                for (int ks = 0; ks < 2; ++ks) {
                    const bf16x8 m0 = *(const LAS bf16x8*)(S + ((0 * 2 + kb2) * 2 + ks) * 1024 + lane * 16);
                    const bf16x8 m1 = *(const LAS bf16x8*)(S + ((1 * 2 + kb2) * 2 + ks) * 1024 + lane * 16);
                    N0 = __builtin_amdgcn_mfma_f32_32x32x16_bf16(m0, zf[kb2][ks], N0, 0, 0, 0);
                    N1 = __builtin_amdgcn_mfma_f32_32x32x16_bf16(m1, zf[kb2][ks], N1, 0, 0, 0);
                }
            Z0 = N0; Z1 = N1;
        }
        asm volatile("s_waitcnt lgkmcnt(0)\n\ts_barrier" ::: "memory");
    }
    if (wave == 6) CB_YOUT(NCK - 1);
    asm volatile("s_waitcnt vmcnt(0) lgkmcnt(0)\n\ts_barrier" ::: "memory");
#undef CB_ISSUE
#undef CB_YOUT
}

constexpr int N_FX_UNITS = 65 * 10, N_SB_UNITS = 65 * 10, N_RW_WG = 192;
#ifndef REP_SCAN
#define REP_SCAN 1
#endif
#ifndef REP_SCAN_DRY
#define REP_SCAN_DRY 0
#endif
#ifndef REP_FOX
#define REP_FOX 1
#endif
#ifndef REP_SB
#define REP_SB 1
#endif
__device__ __forceinline__ void phase_mix(const ArgsL& a, Frame& F, int layer) {
#ifdef SEQ_SCAN
    if (F.bx < N_RW_WG) { int nr = REP_SCAN; asm volatile("" : "+s"(nr)); for (int r = 0; r < nr; ++r) rwkv_scan(a, F, F.bx, (r + 1 < nr) ? REP_SCAN_DRY : 0); }
#else
#ifndef REP_CHB
#define REP_CHB 1
#endif
    if (F.bx < 12) { int nr = REP_CHB; asm volatile("" : "+s"(nr)); for (int r = 0; r < nr; ++r) rwkv_chunkB(a, F, F.bx); }
#endif
    float gqm = fabsf(a.in(I_QG)[layer * 64 + F.lane]), gkm = fabsf(a.in(I_KG)[layer * 64 + F.lane]);
#pragma unroll
    for (int off = 1; off < 64; off <<= 1) { gqm = fmaxf(gqm, __shfl_xor(gqm, off)); gkm = fmaxf(gkm, __shfl_xor(gkm, off)); }
    const float bound = 64.0f * C2 * gqm * gkm * 1.02f + 0.5f;
    unsigned* head = (unsigned*)(a.ws + WS_CTL) + CW_QUEUE + 64 * layer;
    for (;;) {
        if (F.tid == 0) F.MISC[16] = __hip_atomic_fetch_add(head, 1u, __ATOMIC_RELAXED, __HIP_MEMORY_SCOPE_AGENT);
        __syncthreads();
        const int u = (int)F.MISC[16];
        __syncthreads();
        if (u >= N_FX_UNITS + N_SB_UNITS) break;
        if (u < N_FX_UNITS) { const int qb = 64 - u / 10, bh = u % 10; int nr = REP_FOX; asm volatile("" : "+s"(nr)); for (int r = 0; r < nr; ++r) attn_unit<0>(a, F, bh / FX_H, bh % FX_H, qb, bound); }
        else { const int v = u - N_FX_UNITS; const int qb = 64 - v / 10, bh = v % 10; int nr = REP_SB; asm volatile("" : "+s"(nr)); for (int r = 0; r < nr; ++r) attn_unit<1>(a, F, bh / SB_H, bh % SB_H, qb, bound); }
    }
}

__device__ __forceinline__ void phase_post(const ArgsL& a, Frame& F, int layer, const bool dry = false) {
    const int lane = F.lane, wave = F.wave, it4 = lane >> 4, e4 = lane & 15;
    bf16_t* Y0 = (bf16_t*)(a.ws + WS_YCAT); const bf16_t* BN = (const bf16_t*)(a.ws + WS_BN);
    LAS float* lgl = (LAS float*)F.lds;
    for (int i = F.tid; i < 2 * RW_W; i += NTHR) lgl[i] = (i < RW_W) ? a.in(I_LNG)[layer * RW_W + i] : a.in(I_LNB)[layer * RW_W + i - RW_W];
    __syncthreads();
    unsigned* head = (unsigned*)(a.ws + WS_CTL) + CW_QUEUE + 64 * layer + 32 + (dry ? 8 : 0);
    for (;;) {
        if (F.tid == 0) F.MISC[17] = __hip_atomic_fetch_add(head, 1u, __ATOMIC_RELAXED, __HIP_MEMORY_SCOPE_AGENT);
        __syncthreads();
        const int ch = (int)F.MISC[17];
        __syncthreads();
        if (ch >= M / 64) break;
        u32x2 yn = {0u, 0u}, bn = {0u, 0u};
#define PP_ADDR(ps) const int item_ = (ps) * 32 + wave * 4 + it4, rw_ = item_ / 6, hh_ = item_ - rw_ * 6; const int m_ = ch * 64 + rw_; const size_t off_ = (size_t)m_ * RW_W + hh_ * 64 + e4 * 4, offy_ = (size_t)m_ * YC_W + hh_ * 64 + e4 * 4
        { PP_ADDR(0); yn = *(const u32x2*)(Y0 + offy_); bn = *(const u32x2*)(BN + off_); }
#pragma unroll 1
        for (int ps = 0; ps < 12; ++ps) {
            const u32x2 yv = yn, bv = bn;
            if (ps + 1 < 12) { PP_ADDR(ps + 1); yn = *(const u32x2*)(Y0 + offy_); bn = *(const u32x2*)(BN + off_); }
            PP_ADDR(ps);
            const int p = m_ % T;
            u32x2 w = {0u, 0u};
            if (p >= PADR) {
                const float y0 = bf_lo(yv.x), y1 = bf_hi(yv.x), y2 = bf_lo(yv.y), y3 = bf_hi(yv.y);
                const float mean = allred16((y0 + y1) + (y2 + y3)) * (1.f / 64.f);
                const float d0 = y0 - mean, d1 = y1 - mean, d2 = y2 - mean, d3 = y3 - mean;
                const float rs = 1.0f / sqrtf(allred16((d0 * d0 + d1 * d1) + (d2 * d2 + d3 * d3)) * (1.f / 64.f) + 64e-5f);
                const f32x4 g4 = *(const LAS f32x4*)(lgl + hh_ * 64 + e4 * 4), b4 = *(const LAS f32x4*)(lgl + RW_W + hh_ * 64 + e4 * 4);
                w = (u32x2){pk2(d0 * rs * g4.x + b4.x + bf_lo(bv.x), d1 * rs * g4.y + b4.y + bf_hi(bv.x)), pk2(d2 * rs * g4.z + b4.z + bf_lo(bv.y), d3 * rs * g4.w + b4.w + bf_hi(bv.y))};
            }
            if (!dry) *(u32x2*)(Y0 + offy_) = w; else asm volatile("" :: "v"(w.x), "v"(w.y));
        }
#undef PP_ADDR
        if (!dry) {
#pragma unroll 1
            for (int k = 0; k < 16; ++k) { const int pr = wave * 16 + k, sl = pr >> 6, m2 = ch * 64 + (pr & 63); const int p = m2 % T;
                bf16_t* row = Y0 + (size_t)m2 * YC_W + 384 * (sl + 1);
                if (p < PADR) { for (int c = lane; c < RW_W / 2; c += 64) ((unsigned*)row)[c] = 0u; }
                else if (lane < 32) ((unsigned*)(row + 320))[lane] = 0u; }
        }
    }
}

struct EpiInproj { static constexpr bool PERM = true, AFTER_DRAIN = false, MIDHOOK = false; bf16_t* ush; bf16_t* qkv;
    __device__ __forceinline__ void operator()(const f32x4 (&acc)[2][2][4][2], const pg8::Unit& u, int wr, int wc, int fr, int fq) const {
        asm volatile("" : "+v"(fr), "+v"(fq));
        const int row0 = u.pm * 256 + wr * 64 + fr, colt = u.pn * 256 + wc * 32 + 8 * fq;
#pragma unroll
        for (int ai = 0; ai < 2; ++ai)
#pragma unroll
            for (int m = 0; m < 4; ++m) { const size_t row = (size_t)(row0 + ai * 128 + m * 16);
#pragma unroll
                for (int bj = 0; bj < 2; ++bj) { const int col = colt + bj * 128; const f32x4 v0 = acc[ai][bj][m][0], v1 = acc[ai][bj][m][1];
                    const float sc = (col >= SHIFT_W && col < SHIFT_W + 320) ? C2 : 1.0f;
                    u32x4 w; w.x = pk2(v0[0] * sc, v0[1] * sc); w.y = pk2(v0[2] * sc, v0[3] * sc); w.z = pk2(v1[0] * sc, v1[1] * sc); w.w = pk2(v1[2] * sc, v1[3] * sc);
                    if (col < SHIFT_W) *(u32x4*)(ush + row * SHIFT_W + col) = w;
                    else if (col < SHIFT_W + QKV_W) *(u32x4*)(qkv + row * QKV_W + (col - SHIFT_W)) = w; } }
    }
};
struct EpiGates { static constexpr bool PERM = true, AFTER_DRAIN = false, MIDHOOK = false; bf16_t* gates;
    __device__ __forceinline__ void operator()(const f32x4 (&acc)[2][2][4][2], const pg8::Unit& u, int wr, int wc, int fr, int fq) const {
        asm volatile("" : "+v"(fr), "+v"(fq));
        const int row0 = u.pm * 256 + wr * 64 + fr, colt = u.pn * 256 + wc * 32 + 8 * fq;
#pragma unroll
        for (int ai = 0; ai < 2; ++ai)
#pragma unroll
            for (int m = 0; m < 4; ++m) { const size_t row = (size_t)(row0 + ai * 128 + m * 16);
#pragma unroll
                for (int bj = 0; bj < 2; ++bj) { const int col = colt + bj * 128; f32x4 v0 = acc[ai][bj][m][0], v1 = acc[ai][bj][m][1];
#pragma unroll
                    for (int q = 0; q < 4; ++q) { v0[q] = __builtin_amdgcn_rcpf(1.f + __builtin_amdgcn_exp2f(-v0[q] * LOG2E)); v1[q] = __builtin_amdgcn_rcpf(1.f + __builtin_amdgcn_exp2f(-v1[q] * LOG2E)); }
                    u32x4 w; w.x = pk2(v0[0], v0[1]); w.y = pk2(v0[2], v0[3]); w.z = pk2(v1[0], v1[1]); w.w = pk2(v1[2], v1[3]);
                    *(u32x4*)(gates + row * 3072 + col) = w; } }
    }
};
struct EpiMergeF { static constexpr bool PERM = true, AFTER_DRAIN = false, MIDHOOK = true; const bf16_t* gates; bf16_t* merged;
    __device__ __forceinline__ void mid(f32x4 (&acc)[2][2][4][2], const pg8::Unit& u, int wr, int wc, int fr, int fq, int seg) const {
        asm volatile("" : "+v"(fr), "+v"(fq));
        const int row0 = u.pm * 256 + wr * 64 + fr, colt = u.pn * 256 + wc * 32 + 8 * fq;
        u32x4 gpn[2], gnn[2];
#define MG_LOAD(q) do { const bf16_t* gpt_ = gates + (size_t)(row0 + ((q) >> 2) * 128 + ((q) & 3) * 16) * 3072 + (seg - 1) * 1024 + colt; \
            gpn[0] = *(const u32x4*)gpt_; gnn[0] = *(const u32x4*)(gpt_ + 1024); gpn[1] = *(const u32x4*)(gpt_ + 128); gnn[1] = *(const u32x4*)(gpt_ + 1024 + 128); } while (0)
        MG_LOAD(0);
#pragma unroll
        for (int q = 0; q < 8; ++q) { const int ai = q >> 2, m = q & 3;
            u32x4 gp[2], gn[2];
#pragma unroll
            for (int bj = 0; bj < 2; ++bj) { gp[bj] = gpn[bj]; gn[bj] = gnn[bj]; }
            if (q < 7) MG_LOAD(q + 1);
#pragma unroll
            for (int bj = 0; bj < 2; ++bj) { f32x4& v0 = acc[ai][bj][m][0]; f32x4& v1 = acc[ai][bj][m][1];
                v0[0] *= bf_lo(gp[bj].x) * __builtin_amdgcn_rcpf(bf_lo(gn[bj].x)); v0[1] *= bf_hi(gp[bj].x) * __builtin_amdgcn_rcpf(bf_hi(gn[bj].x));
                v0[2] *= bf_lo(gp[bj].y) * __builtin_amdgcn_rcpf(bf_lo(gn[bj].y)); v0[3] *= bf_hi(gp[bj].y) * __builtin_amdgcn_rcpf(bf_hi(gn[bj].y));
                v1[0] *= bf_lo(gp[bj].z) * __builtin_amdgcn_rcpf(bf_lo(gn[bj].z)); v1[1] *= bf_hi(gp[bj].z) * __builtin_amdgcn_rcpf(bf_hi(gn[bj].z));
                v1[2] *= bf_lo(gp[bj].w) * __builtin_amdgcn_rcpf(bf_lo(gn[bj].w)); v1[3] *= bf_hi(gp[bj].w) * __builtin_amdgcn_rcpf(bf_hi(gn[bj].w)); }
            __builtin_amdgcn_sched_barrier(0); }
#undef MG_LOAD
    }
    __device__ __forceinline__ void operator()(const f32x4 (&acc)[2][2][4][2], const pg8::Unit& u, int wr, int wc, int fr, int fq) const {
        asm volatile("" : "+v"(fr), "+v"(fq));
        const int row0 = u.pm * 256 + wr * 64 + fr, colt = u.pn * 256 + wc * 32 + 8 * fq;
        u32x4 gnx[2];
#define MG_LOAD2(q) do { const bf16_t* gpt_ = gates + (size_t)(row0 + ((q) >> 2) * 128 + ((q) & 3) * 16) * 3072 + 2048 + colt; gnx[0] = *(const u32x4*)gpt_; gnx[1] = *(const u32x4*)(gpt_ + 128); } while (0)
        MG_LOAD2(0);
#pragma unroll
        for (int q = 0; q < 8; ++q) { const int ai = q >> 2, m = q & 3; const size_t row = (size_t)(row0 + ai * 128 + m * 16);
            u32x4 g[2];
#pragma unroll
            for (int bj = 0; bj < 2; ++bj) g[bj] = gnx[bj];
            if (q < 7) MG_LOAD2(q + 1);
#pragma unroll
            for (int bj = 0; bj < 2; ++bj) { const f32x4 v0 = acc[ai][bj][m][0], v1 = acc[ai][bj][m][1];
                u32x4 w;
                w.x = pk2(bf_lo(g[bj].x) * v0[0], bf_hi(g[bj].x) * v0[1]); w.y = pk2(bf_lo(g[bj].y) * v0[2], bf_hi(g[bj].y) * v0[3]);
                w.z = pk2(bf_lo(g[bj].z) * v1[0], bf_hi(g[bj].z) * v1[1]); w.w = pk2(bf_lo(g[bj].w) * v1[2], bf_hi(g[bj].w) * v1[3]);
                *(u32x4*)(merged + row * D + colt + bj * 128) = w; }
            __builtin_amdgcn_sched_barrier(0); }
#undef MG_LOAD2
    }
};
struct EpiOut { static constexpr bool PERM = true, AFTER_DRAIN = false, MIDHOOK = false; bf16_t* hb;
    __device__ __forceinline__ void operator()(const f32x4 (&acc)[2][2][4][2], const pg8::Unit& u, int wr, int wc, int fr, int fq) const {
        asm volatile("" : "+v"(fr), "+v"(fq));
        const int row0 = u.pm * 256 + wr * 64 + fr, colt = u.pn * 256 + wc * 32 + 8 * fq;
        u32x4 hn[2];
#define OUT_LOAD(q) do { const bf16_t* p_ = hb + (size_t)(row0 + ((q) >> 2) * 128 + ((q) & 3) * 16) * D + colt; hn[0] = *(const u32x4*)(p_); hn[1] = *(const u32x4*)(p_ + 128); } while (0)
        OUT_LOAD(0);
#pragma unroll
        for (int q = 0; q < 8; ++q) {
            const int ai = q >> 2, m = q & 3;
            bf16_t* hp = hb + (size_t)(row0 + ai * 128 + m * 16) * D + colt; const u32x4 h0 = hn[0], h1 = hn[1];
            if (q < 7) OUT_LOAD(q + 1);
#pragma unroll
            for (int bj = 0; bj < 2; ++bj) { const u32x4 hh = bj ? h1 : h0; const f32x4 v0 = acc[ai][bj][m][0], v1 = acc[ai][bj][m][1];
                u32x4 w; w.x = pk2(bf_lo(hh.x) + v0[0], bf_hi(hh.x) + v0[1]); w.y = pk2(bf_lo(hh.y) + v0[2], bf_hi(hh.y) + v0[3]);
                w.z = pk2(bf_lo(hh.z) + v1[0], bf_hi(hh.z) + v1[1]); w.w = pk2(bf_lo(hh.w) + v1[2], bf_hi(hh.w) + v1[3]);
                *(u32x4*)(hp + bj * 128) = w; }
            __builtin_amdgcn_sched_barrier(0);
        }
#undef OUT_LOAD
    }
};
struct MoeOrder { const volatile LAS int* tb; int ntile, npt, G, c, rep;
    __device__ __forceinline__ bool next(int i, pg8::Unit& u) const { long L = (long)i * G + c; if (L >= (long)ntile * npt * rep) return false; L %= (long)ntile * npt;
        const int tau = (int)(L / npt), j = (int)(L - (long)tau * npt); int e = 0;
#pragma unroll
        for (int k = 1; k < 16; ++k) e += (tau >= tb[k]) ? 1 : 0;
        u.pm = tau; u.pn = __builtin_amdgcn_readfirstlane(e) * npt + j; return true; }
    __device__ __forceinline__ void a_ready(const pg8::Unit&) const {}
    __device__ __forceinline__ void done(const pg8::Unit&) const {}
};
struct EpiMoeUp { static constexpr bool PERM = true, AFTER_DRAIN = false, MIDHOOK = false; bf16_t* hs;
    __device__ __forceinline__ void operator()(const f32x4 (&acc)[2][2][4][2], const pg8::Unit& u, int wr, int wc, int fr, int fq) const {
        asm volatile("" : "+v"(fr), "+v"(fq));
        const int row0 = u.pm * 256 + wr * 64 + fr, col = (u.pn & 1) * 128 + wc * 32 + 8 * fq;
#pragma unroll
        for (int ai = 0; ai < 2; ++ai)
#pragma unroll
            for (int m = 0; m < 4; ++m) { const size_t row = (size_t)(row0 + ai * 128 + m * 16); float r[8];
#pragma unroll
                for (int n = 0; n < 2; ++n)
#pragma unroll
                    for (int q = 0; q < 4; ++q) { const float gte = acc[ai][0][m][n][q], up = acc[ai][1][m][n][q]; r[4 * n + q] = gte * __builtin_amdgcn_rcpf(1.f + __builtin_amdgcn_exp2f(-gte * LOG2E)) * up; }
                u32x4 w; w.x = pk2(r[0], r[1]); w.y = pk2(r[2], r[3]); w.z = pk2(r[4], r[5]); w.w = pk2(r[6], r[7]);
                *(u32x4*)(hs + row * DEXP + col) = w; }
    }
};
struct EpiMoeDown { static constexpr bool PERM = true, AFTER_DRAIN = false, MIDHOOK = false; bf16_t* y; const float* cws;
    __device__ __forceinline__ void operator()(const f32x4 (&acc)[2][2][4][2], const pg8::Unit& u, int wr, int wc, int fr, int fq) const {
        asm volatile("" : "+v"(fr), "+v"(fq));
        const int row0 = u.pm * 256 + wr * 64 + fr, colt = (u.pn & 3) * 256 + wc * 32 + 8 * fq;
        float cw[8];
#pragma unroll
        for (int q = 0; q < 8; ++q) cw[q] = cws[row0 + (q >> 2) * 128 + (q & 3) * 16];
#pragma unroll
        for (int ai = 0; ai < 2; ++ai)
#pragma unroll
            for (int m = 0; m < 4; ++m) { const size_t row = (size_t)(row0 + ai * 128 + m * 16); const float cwv = cw[ai * 4 + m];
#pragma unroll
                for (int bj = 0; bj < 2; ++bj) { const int col = colt + bj * 128; const f32x4 v0 = acc[ai][bj][m][0] * cwv, v1 = acc[ai][bj][m][1] * cwv;
                    u32x4 w; w.x = pk2(v0[0], v0[1]); w.y = pk2(v0[2], v0[3]); w.z = pk2(v1[0], v1[1]); w.w = pk2(v1[2], v1[3]);
                    *(u32x4*)(y + row * D + col) = w; } }
    }
};


#ifndef PH_MASK
#define PH_MASK 0xFFFF
#endif
#define PH(k) ((PH_MASK >> (k)) & 1)
#ifndef PROBE_DUP
#define PROBE_DUP 0
#endif
#define DUPN(bit) (((PROBE_DUP >> (bit)) & 1) ? 2 : 1)
#ifndef PROBE_THIN
#define PROBE_THIN 0
#endif
#define THIN(bit) ((PROBE_THIN >> (bit)) & 1)
#define FRESH() do { asm volatile("" : "+v"(F.tid)); F.lane = F.tid & 63; F.wave = __builtin_amdgcn_readfirstlane(F.tid >> 6); { int bx_ = (int)blockIdx.x; asm volatile("" : "+s"(bx_)); F.bx = bx_; } { unsigned char* w_ = a.ws; asm volatile("" : "+s"(w_)); a.ws = w_; } } while (0)
__global__ void __launch_bounds__(NTHR, 2) hybrid_fwd(Args ka) {
    extern __shared__ __attribute__((aligned(16))) unsigned char lds_raw[];
    Frame F;
    F.lds = (LAS unsigned char*)lds_raw;
    F.MISC = (volatile LAS unsigned*)(F.lds + MISC_OFF);
    F.tid = threadIdx.x; F.lane = F.tid & 63; F.wave = __builtin_amdgcn_readfirstlane(F.tid >> 6); F.bx = (int)blockIdx.x;
    for (int u = F.tid; u < (LDS_BYTES - MISC_OFF) / 4; u += NTHR) ((LAS unsigned*)(F.lds + MISC_OFF))[u] = 0u;
    __syncthreads();
    if (F.tid < 29) { const unsigned long long p = (unsigned long long)ka.in[F.tid]; F.MISC[64 + 2 * F.tid] = (unsigned)p; F.MISC[65 + 2 * F.tid] = (unsigned)(p >> 32); }
    __syncthreads();
    ArgsL a; a.tab = F.MISC + 64; a.out = ka.out; a.ws = ka.ws;
    XcdBarrier bar = xcd_barrier_post((unsigned*)(a.ws + WS_CTL) + CW_BAR, F.MISC + 8);
    const int G = (int)gridDim.x, c = (int)blockIdx.x;
    PG8_LAS unsigned char* ring = (PG8_LAS unsigned char*)F.lds;

#ifdef PROF_K
    volatile LAS unsigned* tsl = F.MISC + 1536; int nts = 0;
    if (blockIdx.x == 0 && F.tid == 0) tsl[nts] = (unsigned)__builtin_amdgcn_s_memrealtime();
    ++nts;
#define BARX() do { xcd_barrier(bar); if (blockIdx.x == 0 && F.tid == 0) tsl[nts] = (unsigned)__builtin_amdgcn_s_memrealtime(); ++nts; } while (0)
#else
#define BARX() xcd_barrier(bar)
#endif
    for (int layer = 0; layer < DEPTH; ++layer) {
        for (int rep = 0; rep < DUPN(8); ++rep) { FRESH(); if (PH(0)) phase_wconv(a, F, layer); }
        __syncthreads();
        if (THIN(0)) { FRESH(); phase_norm<1>(a, F, layer, true); }
        FRESH(); if (PH(1)) phase_norm<1>(a, F, layer);
        BARX();
        FRESH(); if (PH(2)) {
            pg8::Gemm g{(const bf16_t*)A_PTR(a), (const bf16_t*)(a.ws + WS_WIN), M, N1, D}; pg8::StaticOrder S; S.init(M, N1, G, c, DUPN(3));
            EpiInproj E{(bf16_t*)(a.ws + WS_USH), (bf16_t*)(a.ws + WS_QKV)};
            pg8::gemm_phase<EpiInproj, pg8::StaticOrder, true, true>(ring, g, S, E);
        }
        BARX();
        if (THIN(1)) { FRESH(); phase_prep(a, F, layer, true); }
        FRESH(); if (PH(3)) phase_prep(a, F, layer);
        BARX();
#ifndef SEQ_SCAN
        if (THIN(2)) { FRESH(); phase_chunkA(a, F, true); }
        FRESH(); if (PH(4)) phase_chunkA(a, F);
        BARX();
#endif
        FRESH(); if (PH(4)) phase_mix(a, F, layer);
        BARX();
        FRESH(); if (PH(6)) {
            pg8::Gemm g{(const bf16_t*)A_PTR(a), (const bf16_t*)(a.ws + WS_WG), M, 3072, D}; pg8::StaticOrder S; S.init(M, 3072, G, c, DUPN(4));
            EpiGates E{(bf16_t*)(a.ws + WS_GATES)};
            pg8::gemm_phase<EpiGates, pg8::StaticOrder, true, true>(ring, g, S, E);
        }
        asm volatile("s_waitcnt vmcnt(0) lgkmcnt(0)" ::: "memory"); __syncthreads();
        if (THIN(3)) { FRESH(); phase_post(a, F, layer, true); }
        FRESH(); if (PH(5)) phase_post(a, F, layer);
        BARX();
        FRESH(); if (PH(7)) {
            pg8::Gemm g{(const bf16_t*)(a.ws + WS_YCAT), (const bf16_t*)(a.ws + WS_WP), M, D, YC_W}; pg8::StaticOrder S; S.init(M, D, G, c, DUPN(5));
            EpiMergeF E{(const bf16_t*)(a.ws + WS_GATES), (bf16_t*)(a.ws + WS_MERGED)};
            pg8::gemm_phase<EpiMergeF, pg8::StaticOrder, true, true>(ring, g, S, E);
        }
        BARX();
        FRESH(); if (PH(8)) {
            pg8::Gemm g{(const bf16_t*)(a.ws + WS_MERGED), (const bf16_t*)(a.ws + WS_WO), M, D, D}; pg8::StaticOrder S; S.init(M, D, G, c, 1);
            EpiOut E{HB_PTR(a)};
            pg8::gemm_phase<EpiOut, pg8::StaticOrder, true, true>(ring, g, S, E);
        }
        BARX();
        if (THIN(4)) { FRESH(); phase_norm2(a, F, layer, true); }
        FRESH(); if (PH(9)) phase_norm2(a, F, layer);
        BARX();
        for (int rep = 0; rep < DUPN(7); ++rep) { FRESH(); if (PH(10)) phase_route(a, F, layer); }
        BARX();
        volatile LAS int* tb = (volatile LAS int*)(F.MISC + 32);
        if (F.tid <= 16) { const int* cnt = (const int*)(a.ws + WS_CTL) + CW_ECNT + 64 * layer; int t = 0;
            for (int e = 0; e < F.tid; ++e) t += (__hip_atomic_load(cnt + e, __ATOMIC_RELAXED, __HIP_MEMORY_SCOPE_AGENT) + 255) >> 8;
            tb[F.tid] = t; }
        __syncthreads();
        const int ntile = tb[16];
        FRESH(); if (PH(11)) {
            pg8::Gemm g{(const bf16_t*)(a.ws + WS_AS), (const bf16_t*)(a.ws + WS_WGU), MS, 8192, D}; MoeOrder S{tb, ntile, 2, G, c, DUPN(6)};
            EpiMoeUp E{(bf16_t*)(a.ws + WS_HS)};
            pg8::gemm_phase<EpiMoeUp, MoeOrder, true, true>(ring, g, S, E);
        }
        BARX();
        FRESH(); if (PH(12)) {
            int kdim = DEXP; asm volatile("" : "+s"(kdim));
            pg8::Gemm g{(const bf16_t*)(a.ws + WS_HS), (const bf16_t*)(a.ws + WS_WD), MS, 16384, kdim}; MoeOrder S{tb, ntile, 4, G, c, DUPN(6)};
            EpiMoeDown E{(bf16_t*)(a.ws + WS_Y), (const float*)(a.ws + WS_CWS)};
            pg8::gemm_phase<EpiMoeDown, MoeOrder, true, true>(ring, g, S, E);
        }
        BARX();
    }
    if (THIN(5)) { FRESH(); phase_norm<0>(a, F, DEPTH - 1, true); }
    FRESH(); if (PH(13)) phase_norm<0>(a, F, DEPTH - 1);
#ifdef PROF_K
    BARX();
    if (blockIdx.x == 0) {
        __syncthreads();
        float us;
        if (PROF_K < 0) us = 100.f;
        else if (PROF_K == 12) us = (float)(tsl[25] - tsl[24]) * 0.01f;
        else if (PROF_K == 13) us = (float)(tsl[25] - tsl[0]) * 0.01f;
        else us = ((float)(tsl[1 + PROF_K] - tsl[PROF_K]) + (float)(tsl[13 + PROF_K] - tsl[12 + PROF_K])) * 0.01f;
        us = 4.f * rintf(us * 0.25f);
        for (int i = F.tid; i < 16384; i += NTHR) a.out[i] = us;
    }
#endif
#ifdef CLOCK_PROBE
    if (blockIdx.x == 0 && F.wave == 0) {
        float c0 = 1.f, c1 = 2.f, c2 = 3.f, c3 = 4.f, c4 = 5.f, c5 = 6.f, c6 = 7.f, c7 = 8.f;
        for (int i = 0; i < CLOCK_PROBE; ++i) {
            asm volatile("v_fma_f32 %0, %0, %0, %0\n\tv_fma_f32 %1, %1, %1, %1\n\tv_fma_f32 %2, %2, %2, %2\n\tv_fma_f32 %3, %3, %3, %3\n\tv_fma_f32 %4, %4, %4, %4\n\tv_fma_f32 %5, %5, %5, %5\n\tv_fma_f32 %6, %6, %6, %6\n\tv_fma_f32 %7, %7, %7, %7"
                         : "+v"(c0), "+v"(c1), "+v"(c2), "+v"(c3), "+v"(c4), "+v"(c5), "+v"(c6), "+v"(c7));
        }
        asm volatile("" :: "v"(c0), "v"(c1), "v"(c2), "v"(c3), "v"(c4), "v"(c5), "v"(c6), "v"(c7));
    }
#endif
}

extern "C" void kernel_launch(void* const* d_in, const int* in_sizes, int n_in, void* d_out, int out_size, void* d_ws, size_t ws_size, hipStream_t stream) {
    static int ready = 0;
    if (ready == 0) {
        if (n_in != 29 || out_size != NB * SEQ * D || ws_size < WS_END) { fprintf(stderr, "kernel_launch: unexpected problem shape (n_in %d, out %d, ws %zu < %zu)\n", n_in, out_size, ws_size, (size_t)WS_END); ready = -1; return; }
        if (hipFuncSetAttribute((const void*)hybrid_fwd, hipFuncAttributeMaxDynamicSharedMemorySize, LDS_BYTES) != hipSuccess) { fprintf(stderr, "kernel_launch: hipFuncSetAttribute failed\n"); ready = -1; return; }
        int per_cu = 0;
        if (hipOccupancyMaxActiveBlocksPerMultiprocessor(&per_cu, (const void*)hybrid_fwd, NTHR, LDS_BYTES) != hipSuccess || per_cu < 1) fprintf(stderr, "kernel_launch: occupancy query says %d\n", per_cu);
        (void)hipGetLastError();
        ready = 1;
    }
    if (ready < 0) return;
    (void)in_sizes;
    if (hipMemsetAsync((char*)d_ws + WS_CTL, 0, CTL_ZERO_BYTES, stream) != hipSuccess) return;
    Args a{};
    for (int i = 0; i < 29; ++i) a.in[i] = (const float*)d_in[i];
    a.out = (float*)d_out; a.ws = (unsigned char*)d_ws;
    hipLaunchKernelGGL(hybrid_fwd, dim3(256), dim3(NTHR), LDS_BYTES, stream, a);
}
```

```cpp
#include <hip/hip_runtime.h>
#include <hip/hip_bf16.h>
#include <cstdio>
#include <cstdint>

#define GAS __attribute__((address_space(1)))
#define LAS __attribute__((address_space(3)))

namespace pg8 {
#define PG8_LAS __attribute__((address_space(3)))
typedef unsigned short bf16_t;
typedef short bf16x8 __attribute__((ext_vector_type(8)));
typedef float f32x4 __attribute__((ext_vector_type(4)));
typedef unsigned u32x4 __attribute__((ext_vector_type(4)));
constexpr int BM = 256, BK = 64, HALF = 128, HTB = HALF * BK * 2  , STAGE_BYTES = 8 * HTB, NXCD = 8, WGM = 8;

__host__ __device__ __forceinline__ int lds_byte(int r, int c) { const int st = (r >> 4) * 2 + (c >> 5), rr = r & 15, cc = c & 31, ob = rr * 64 + cc * 2; return st * 1024 + (ob ^ (((ob >> 9) & 1) << 5)); }
__host__ __device__ __forceinline__ void stage_rc(int b, int& R, int& C) { const int st = b / 1024, sb = b % 1024, swz = sb ^ (((sb >> 9) & 1) << 5); R = (st >> 1) * 16 + swz / 64; C = (st & 1) * 32 + (swz % 64) / 2; }
__host__ __device__ __forceinline__ int perm32(int rho) { const int n = rho >> 4, i = rho & 15; return 8 * (i >> 2) + 4 * n + (i & 3); }

struct Unit { int pm, pn; };
struct Gemm { const bf16_t* A; const bf16_t* Bt; int M, N, K; };

struct StaticOrder {
    int nM, nN, nwg, G, c, rep;
    __host__ __device__ void init(int M, int N, int G_, int c_, int rep_ = 1) { nM = M / BM; nN = N / BM; nwg = nM * nN; G = G_; c = c_; rep = rep_; }
    __host__ __device__ bool next(int i, Unit& u) const {
        const long L = (long)i * G + c; if (L >= (long)nwg * rep) return false;
        int wgid = (int)(L % nwg); { const int q = nwg / NXCD, r = nwg % NXCD, xcd = wgid % NXCD, off = wgid / NXCD; wgid = (xcd < r ? xcd * (q + 1) : r * (q + 1) + (xcd - r) * q) + off; }
        const int nig = WGM * nN, gid = wgid / nig, fm = gid * WGM, gsz = (nM - fm) < WGM ? (nM - fm) : WGM;
        u.pm = fm + ((wgid % nig) % gsz); u.pn = (wgid % nig) / gsz; return true;
    }
    __device__ __forceinline__ void a_ready(const Unit&) const {}
    __device__ __forceinline__ void done(const Unit&) const {}
};
__device__ __forceinline__ unsigned cvt_pk_bf16(float lo, float hi) { unsigned r; asm volatile("v_cvt_pk_bf16_f32 %0, %1, %2" : "=v"(r) : "v"(lo), "v"(hi)); return r; }
template <class Epi, class Sched, bool ALIGN_EPI = false, bool SP2 = false>
__device__ __forceinline__ void gemm_phase(PG8_LAS unsigned char* lds, const Gemm g, const Sched& S, const Epi& E) {
    int tid_ = threadIdx.x; asm volatile("" : "+v"(tid_));
    const int tid = tid_, wid = __builtin_amdgcn_readfirstlane(tid >> 6), lane = tid & 63, wr = wid >> 2, wc = wid & 3, fr = lane & 15, fq = lane >> 4;
    const int K = g.K, nt = K / BK;
    unsigned voffA[2], voffB[2];
#pragma unroll
    for (int i = 0; i < 2; ++i) { int R, C; stage_rc(tid * 16 + i * 8192, R, C); const int Rb = Epi::PERM ? ((R & ~31) + perm32(R & 31)) : R;
        voffA[i] = (unsigned)(R * K + C) * 2u; voffB[i] = (unsigned)(Rb * K + C) * 2u; }
    const size_t kstep = (size_t)(BK * 2);
    const size_t hstep = (size_t)HALF * K * 2;
    const size_t tstep = 2 * hstep;
    const unsigned ldsw = (unsigned)wid * 1024u;
    const int aoff = lds_byte(wr * 64 + fr, fq * 8), boff = lds_byte(wc * 32 + fr, fq * 8);
#define PG8_SA(b, h) (((b) * 2 + (h)) * HTB)
#define PG8_SB(b, h) ((4 + (b) * 2 + (h)) * HTB)
#define PG8_STAGE(bufoff, gbase, voff) do { _Pragma("unroll") for (int _i = 0; _i < 2; ++_i) \
        __builtin_amdgcn_global_load_lds((const unsigned*)((const char*)(gbase) + (voff)[_i]), (PG8_LAS unsigned*)(lds + (bufoff) + ldsw + _i * 8192), 16, 0, 0); } while (0)
#define PG8_LDA(dst, b, h) do { _Pragma("unroll") for (int m = 0; m < 4; ++m) _Pragma("unroll") for (int k = 0; k < 2; ++k) dst[m][k] = *(const PG8_LAS bf16x8*)(lds + PG8_SA(b, h) + aoff + m * 2048 + k * 1024); } while (0)
#define PG8_LDB(dst, b, h) do { _Pragma("unroll") for (int n = 0; n < 2; ++n) _Pragma("unroll") for (int k = 0; k < 2; ++k) dst[n][k] = *(const PG8_LAS bf16x8*)(lds + PG8_SB(b, h) + boff + n * 2048 + k * 1024); } while (0)
#define PG8_MMA(ai, bj, At, Bt) do { __builtin_amdgcn_s_setprio(1); _Pragma("unroll") for (int m = 0; m < 4; ++m) _Pragma("unroll") for (int n = 0; n < 2; ++n) _Pragma("unroll") for (int k = 0; k < 2; ++k) \
        acc[ai][bj][m][n] = __builtin_amdgcn_mfma_f32_16x16x32_bf16(Bt[n][k], At[m][k], acc[ai][bj][m][n], 0, 0, 0); __builtin_amdgcn_s_setprio(0); } while (0)
#define PG8_WAIT_V(n) asm volatile("s_waitcnt vmcnt(" #n ")" ::: "memory")
#define PG8_WAIT_L(n) asm volatile("s_waitcnt lgkmcnt(" #n ")" ::: "memory")
#define PG8_BAR __builtin_amdgcn_s_barrier()
#define PG8_SCHED __builtin_amdgcn_sched_barrier(0)
    Unit cur, nxt; int ui = 0;
    if (!S.next(0, cur)) return;
    f32x4 acc[2][2][4][2];
#pragma unroll
    for (int a = 0; a < 2; ++a)
#pragma unroll
        for (int b = 0; b < 2; ++b)
#pragma unroll
            for (int m = 0; m < 4; ++m)
#pragma unroll
                for (int n = 0; n < 2; ++n) acc[a][b][m][n] = (f32x4){0.f, 0.f, 0.f, 0.f};
    bf16x8 At[4][2], B0[2][2], B1[2][2];
    const char* cA = (const char*)g.A + (size_t)cur.pm * tstep; const char* cB = (const char*)g.Bt + (size_t)cur.pn * tstep;
    S.a_ready(cur);
    if constexpr (SP2) {
        PG8_STAGE(PG8_SB(0, 0), cB, voffB); PG8_STAGE(PG8_SB(0, 1), cB + hstep, voffB); PG8_STAGE(PG8_SA(0, 0), cA, voffA); PG8_STAGE(PG8_SA(0, 1), cA + hstep, voffA);
        if (wr == 1) PG8_BAR;
        PG8_WAIT_V(2); PG8_BAR;
        PG8_STAGE(PG8_SB(1, 0), cB + kstep, voffB); PG8_STAGE(PG8_SA(1, 0), cA + kstep, voffA); PG8_STAGE(PG8_SB(1, 1), cB + hstep + kstep, voffB);
        PG8_WAIT_V(6); PG8_BAR;
    } else {
        PG8_STAGE(PG8_SB(0, 0), cB, voffB); PG8_STAGE(PG8_SA(0, 0), cA, voffA); PG8_STAGE(PG8_SB(0, 1), cB + hstep, voffB); PG8_STAGE(PG8_SA(0, 1), cA + hstep, voffA);
        if (wr == 1) PG8_BAR;
        PG8_WAIT_V(4); PG8_BAR;
        PG8_STAGE(PG8_SB(1, 0), cB + kstep, voffB); PG8_STAGE(PG8_SA(1, 0), cA + kstep, voffA); PG8_STAGE(PG8_SB(1, 1), cB + hstep + kstep, voffB);
        PG8_WAIT_V(6); PG8_BAR;
    }
    for (;;) {
        const bool has_next = S.next(ui + 1, nxt);
        const char* nA = has_next ? (const char*)g.A + (size_t)nxt.pm * tstep : cA; const char* nB = has_next ? (const char*)g.Bt + (size_t)nxt.pn * tstep : cB;
        for (int t = 0; t < nt; t += 2) {
            const bool last = (t == nt - 2);
            const char* a1 = cA + (size_t)(t + 1) * kstep;
            const char* a2 = last ? nA : cA + (size_t)(t + 2) * kstep; const char* b2 = last ? nB : cB + (size_t)(t + 2) * kstep;
            const char* a3 = a2 + kstep; const char* b3 = b2 + kstep;
            if (last && has_next) S.a_ready(nxt);
            if constexpr (SP2) {
            PG8_LDB(B0, 0, 0); PG8_LDB(B1, 0, 1); PG8_SCHED; PG8_LDA(At, 0, 0); PG8_STAGE(PG8_SA(1, 1), a1 + hstep, voffA);
            PG8_WAIT_V(8); PG8_WAIT_L(0); PG8_BAR; PG8_MMA(0, 0, At, B0); PG8_MMA(0, 1, At, B1); PG8_BAR; PG8_SCHED;
            PG8_LDA(At, 0, 1); PG8_STAGE(PG8_SB(0, 0), b2, voffB); PG8_STAGE(PG8_SB(0, 1), b2 + hstep, voffB); PG8_STAGE(PG8_SA(0, 0), a2, voffA);
            PG8_WAIT_V(8); PG8_WAIT_L(0); PG8_BAR; PG8_MMA(1, 0, At, B0); PG8_MMA(1, 1, At, B1); PG8_BAR; PG8_SCHED;
            PG8_LDB(B0, 1, 0); PG8_LDB(B1, 1, 1); PG8_SCHED; PG8_LDA(At, 1, 0); PG8_STAGE(PG8_SA(0, 1), a2 + hstep, voffA);
            PG8_WAIT_V(8); PG8_WAIT_L(0); PG8_BAR; PG8_MMA(0, 0, At, B0); PG8_MMA(0, 1, At, B1); PG8_BAR; PG8_SCHED;
            PG8_LDA(At, 1, 1); PG8_STAGE(PG8_SB(1, 0), b3, voffB); PG8_STAGE(PG8_SB(1, 1), b3 + hstep, voffB); PG8_STAGE(PG8_SA(1, 0), a3, voffA);
            PG8_WAIT_V(8); PG8_WAIT_L(0); PG8_BAR; PG8_MMA(1, 0, At, B0); PG8_MMA(1, 1, At, B1); PG8_BAR; PG8_SCHED;
            } else {
            PG8_LDB(B0, 0, 0); PG8_SCHED; PG8_LDA(At, 0, 0); PG8_STAGE(PG8_SA(1, 1), a1 + hstep, voffA);
            PG8_WAIT_L(8); PG8_BAR; PG8_WAIT_L(0); PG8_MMA(0, 0, At, B0); PG8_BAR; PG8_SCHED;
            PG8_LDB(B1, 0, 1); PG8_STAGE(PG8_SB(0, 0), b2, voffB);
            PG8_BAR; PG8_WAIT_L(0); PG8_MMA(0, 1, At, B1); PG8_BAR;
            PG8_LDA(At, 0, 1); PG8_STAGE(PG8_SA(0, 0), a2, voffA);
            PG8_BAR; PG8_WAIT_L(0); PG8_MMA(1, 0, At, B0); PG8_BAR; PG8_SCHED;
            PG8_STAGE(PG8_SB(0, 1), b2 + hstep, voffB);
            PG8_WAIT_V(6); PG8_BAR; PG8_MMA(1, 1, At, B1); PG8_BAR;
            PG8_LDB(B0, 1, 0); PG8_SCHED; PG8_LDA(At, 1, 0); PG8_STAGE(PG8_SA(0, 1), a2 + hstep, voffA);
            PG8_WAIT_L(8); PG8_BAR; PG8_WAIT_L(0); PG8_MMA(0, 0, At, B0); PG8_BAR; PG8_SCHED;
            PG8_LDB(B1, 1, 1); PG8_STAGE(PG8_SB(1, 0), b3, voffB);
            PG8_BAR; PG8_WAIT_L(0); PG8_MMA(0, 1, At, B1); PG8_BAR;
            PG8_LDA(At, 1, 1); PG8_STAGE(PG8_SA(1, 0), a3, voffA);
            PG8_BAR; PG8_WAIT_L(0); PG8_MMA(1, 0, At, B0); PG8_BAR; PG8_SCHED;
            PG8_STAGE(PG8_SB(1, 1), b3 + hstep, voffB);
            PG8_WAIT_V(6); PG8_BAR; PG8_MMA(1, 1, At, B1); PG8_BAR;
            }
            if constexpr (Epi::MIDHOOK) { if (t + 2 == 6 || t + 2 == 12) E.mid(acc, cur, wr, wc, fr, fq, (t + 2) / 6); }
        }
        if constexpr (ALIGN_EPI) { if (wr == 0) PG8_BAR; }
        if constexpr (!Epi::AFTER_DRAIN) { E(acc, cur, wr, wc, fr, fq); S.done(cur); }
        if (!has_next) break;
#pragma unroll
        for (int a = 0; a < 2; ++a)
#pragma unroll
            for (int b = 0; b < 2; ++b)
#pragma unroll
                for (int m = 0; m < 4; ++m)
#pragma unroll
                    for (int n = 0; n < 2; ++n) acc[a][b][m][n] = (f32x4){0.f, 0.f, 0.f, 0.f};
        cur = nxt; cA = nA; cB = nB; ++ui;
        if constexpr (ALIGN_EPI) { if (wr == 1) PG8_BAR; }
    }
    PG8_WAIT_V(0);
    if constexpr (!ALIGN_EPI) { if (wr == 0) PG8_BAR; }
    PG8_BAR;
    if constexpr (Epi::AFTER_DRAIN) { E.fused(acc, cur, wr, wc, fr, fq, lds, wid, lane); S.done(cur); }
#undef PG8_SA
#undef PG8_SB
#undef PG8_STAGE
#undef PG8_LDA
#undef PG8_LDB
#undef PG8_MMA
#undef PG8_WAIT_V
#undef PG8_WAIT_L
#undef PG8_BAR
#undef PG8_SCHED
}
}

constexpr int D = 1024, NB = 2, SEQ = 16384, NMETA = 16, LTOK = SEQ + NMETA  , PADR = 112, T = PADR + LTOK  ;
constexpr int M = NB * T;
constexpr int DEPTH = 2, HD = 64, RW_H = 6, SB_H = 5, FX_H = 5, RW_W = 384, SHIFT_W = 1280, D_IN = 6277;
constexpr int YC_W = 1152;
constexpr int QKV_W = 1920;
constexpr int N1 = 3328;
constexpr int FCOL = 3200, GCOL = 3205;
constexpr int NEXP = 16, DEXP = 256;
constexpr int MS = 70144;
constexpr int LCH = 32, LPADDED = 16448;
constexpr int KBP = 16896;
constexpr float C2 = 0.125f * 1.4426950408889634f;
constexpr float LOG2E = 1.4426950408889634f;
constexpr int NWAVES = 8, NTHR = 512;

constexpr size_t MiB = 1u << 20;
constexpr size_t WS_CTL = 0, CTL_ZERO_BYTES = 131072;
constexpr size_t WS_HM = 1 * MiB;
constexpr size_t WS_LOGF = WS_HM + 131072;
constexpr size_t WS_KB2 = WS_LOGF + (size_t)M * 32;
constexpr size_t WS_TOK = WS_KB2 + (size_t)10 * KBP * 4;
constexpr size_t WS_SLOT = WS_TOK + (size_t)M * 32;
constexpr size_t WS_CWS = WS_SLOT + (size_t)M * 8;
constexpr size_t WS_WGCNT = WS_CWS + (size_t)MS * 4;
constexpr size_t WS_SMALL_END = WS_WGCNT + 256 * 16 * 4;
static_assert(WS_SMALL_END <= 8 * MiB, "small buffers");
constexpr size_t WS_WIN = 8 * MiB;
constexpr size_t WS_WG = WS_WIN + (size_t)N1 * 1024 * 2;
constexpr size_t WS_WP = WS_WG + (size_t)3072 * 1024 * 2;
constexpr size_t WS_WO = WS_WP + (size_t)3072 * 384 * 2;
constexpr size_t WS_WGU = WS_WO + (size_t)1024 * 1024 * 2;
constexpr size_t WS_WD = WS_WGU + (size_t)8192 * 1024 * 2;
constexpr size_t WS_W_END = WS_WD + (size_t)16384 * 256 * 2;
static_assert(WS_W_END <= 49 * MiB, "weights");
constexpr size_t WS_HB = 49 * MiB;
constexpr size_t WS_BIG = 115 * MiB;
constexpr size_t WS_USH = WS_BIG;
constexpr size_t WS_YCAT = WS_BIG;
constexpr size_t WS_QKV = WS_BIG + 82 * MiB;
constexpr size_t WS_RW = WS_BIG + 204 * MiB;
constexpr size_t WS_BN = WS_BIG + 349 * MiB;
constexpr size_t WS_GATES = WS_BIG + 82 * MiB;
constexpr size_t WS_MERGED = WS_BIG + 276 * MiB;
constexpr size_t WS_AS = WS_BIG;
constexpr size_t WS_HS = WS_BIG + 137 * MiB;
constexpr size_t WS_Y = WS_BIG + 172 * MiB;
constexpr size_t WS_END = WS_BIG + 374 * MiB;
static_assert((size_t)(M + 256) * 1280 * 2 <= 82 * MiB && (size_t)3 * M * 384 * 2 <= 82 * MiB && (size_t)(M + 256) * 1920 * 2 <= 122 * MiB, "big map 1");
static_assert((size_t)12 * LPADDED * 768 <= 145 * MiB && (size_t)M * 384 * 2 <= 25 * MiB && (size_t)M * 3072 * 2 <= 194 * MiB && (size_t)M * 2048 <= 65 * MiB, "big map 2");
static_assert((size_t)MS * 2048 <= 137 * MiB && (size_t)MS * 512 <= 35 * MiB && WS_END <= 489 * MiB, "big map 3");

constexpr int CW_BAR = 0;
constexpr int CW_QUEUE = 4096;
constexpr int CW_ECNT = 4352;
constexpr int CW_CHAIN = 8192, CH_STRIDE = 32;
static_assert((CW_ECNT + 128) <= CW_CHAIN && (CW_CHAIN + DEPTH * 2 * 129 * CH_STRIDE) * 4 <= (int)CTL_ZERO_BYTES, "ctl");

constexpr int RING_BYTES = 131072, MISC_OFF = RING_BYTES, LDS_BYTES = 163840;

typedef unsigned short bf16_t;
typedef float f32x4 __attribute__((ext_vector_type(4)));
typedef float f32x2 __attribute__((ext_vector_type(2)));
typedef float f32x16 __attribute__((ext_vector_type(16)));
typedef unsigned u32x4 __attribute__((ext_vector_type(4)));
typedef unsigned u32x2 __attribute__((ext_vector_type(2)));
typedef short bf16x8 __attribute__((ext_vector_type(8)));
typedef short s16x4 __attribute__((ext_vector_type(4)));
typedef _Float16 f16x4 __attribute__((ext_vector_type(4)));
typedef __bf16 bf16x2_t __attribute__((ext_vector_type(2)));

__device__ __forceinline__ unsigned pk2(float lo, float hi) { f32x2 v = {lo, hi}; bf16x2_t b = __builtin_convertvector(v, bf16x2_t); return __builtin_bit_cast(unsigned, b); }
__device__ __forceinline__ unsigned short f2bf(float f) { return (unsigned short)(pk2(f, 0.f) & 0xffffu); }
__device__ __forceinline__ float bf_lo(unsigned u) { return __uint_as_float(u << 16); }
__device__ __forceinline__ float bf_hi(unsigned u) { return __uint_as_float(u & 0xffff0000u); }
__device__ __forceinline__ float bf2f(unsigned short h) { return __uint_as_float((unsigned)h << 16); }
template <int CTRL> __device__ __forceinline__ float dpp_f(float x) { return __int_as_float(__builtin_amdgcn_update_dpp(0, __float_as_int(x), CTRL, 0xF, 0xF, false)); }
__device__ __forceinline__ float allred16(float p) { p += dpp_f<0x128>(p); p += dpp_f<0x124>(p); p += dpp_f<0x122>(p); p += dpp_f<0x121>(p); return p; }
__device__ __forceinline__ float wave_sum(float v) {
    v = allred16(v);
    { auto sw = __builtin_amdgcn_permlane16_swap(__float_as_uint(v), __float_as_uint(v), false, false); v = __uint_as_float(sw[0]) + __uint_as_float(sw[1]); }
    { auto sw = __builtin_amdgcn_permlane32_swap(__float_as_uint(v), __float_as_uint(v), false, false); v = __uint_as_float(sw[0]) + __uint_as_float(sw[1]); }
    return v;
}
__device__ __forceinline__ float fast_exp(float x) { return __builtin_amdgcn_exp2f(x * LOG2E); }
__device__ __forceinline__ float fast_log(float x) { return __builtin_amdgcn_logf(x) * 0.6931471805599453f; }
__device__ __forceinline__ float softplus_f(float z) { return fmaxf(z, 0.f) + fast_log(1.f + fast_exp(-fabsf(z))); }

#define XB_TMO      128
#define XB_XCNT(j)  (256  + 64 * (j))
#define XB_XSUB(j)  (1280 + 64 * (j))
#define XB_XGEN(j)  (2304 + 64 * (j))
#define XB_TOP      3328
#define XB_TOPGEN   3392
#define XCD_BAR_WORDS 3456
#define XB_SPIN_CAP (1u << 20)
__device__ __forceinline__ unsigned xb_ld(unsigned* p)              { return __hip_atomic_load(p, __ATOMIC_RELAXED, __HIP_MEMORY_SCOPE_AGENT); }
__device__ __forceinline__ unsigned xb_add(unsigned* p, unsigned v) { return __hip_atomic_fetch_add(p, v, __ATOMIC_RELAXED, __HIP_MEMORY_SCOPE_AGENT); }
__device__ __forceinline__ unsigned xb_xcc_id() { return (unsigned)__builtin_amdgcn_s_getreg((3 << 11) | 20) & 0xFu; }
#define XB_SPIN(cond, bar) do { unsigned _sp = 0; while (cond) { __builtin_amdgcn_s_sleep(1); \
    if ((++_sp & 255u) == 0u) { if (xb_ld(&(bar)[XB_TMO])) break; if (_sp > XB_SPIN_CAP) { atomicAdd(&(bar)[XB_TMO], 1u); break; } } } } while (0)

struct XcdBarrier {
    unsigned* bar; unsigned x;
    volatile LAS unsigned* st;
};

__device__ __forceinline__ XcdBarrier xcd_barrier_post(unsigned* bar, volatile LAS unsigned* st) {
    XcdBarrier b; b.bar = bar; b.x = xb_xcc_id(); b.st = st;
    if (threadIdx.x == 0) (void)xb_add(&bar[XB_XCNT(b.x)], 1u);
    return b;
}
__device__ __forceinline__ void xcd_barrier_complete(unsigned* bar, unsigned x, unsigned& nloc, unsigned& nx) {
    const unsigned G = gridDim.x * gridDim.y * gridDim.z;
    unsigned sum, cnt, mine, sp = 0u;
    for (;;) {
        sum = 0u; cnt = 0u; mine = 0u;
#pragma unroll
        for (unsigned j = 0; j < 16; ++j) { const unsigned c = xb_ld(&bar[XB_XCNT(j)]); sum += c; cnt += (c > 0u) ? 1u : 0u; mine = (j == x) ? c : mine; }
        if (sum == G) break;
        __builtin_amdgcn_s_sleep(1);
        if ((++sp & 255u) == 0u) { if (xb_ld(&bar[XB_TMO])) break; if (sp > XB_SPIN_CAP) { atomicAdd(&bar[XB_TMO], 1u); break; } }
    }
    nloc = mine > 0u ? mine : 1u; nx = cnt > 0u ? cnt : 1u;
}

__device__ __forceinline__ void xcd_barrier(const XcdBarrier& b) {
    asm volatile("s_waitcnt vmcnt(0)" ::: "memory");
    __syncthreads();
    if (threadIdx.x == 0) {
        unsigned* bar = b.bar;
        __builtin_amdgcn_s_waitcnt(0);
        unsigned nloc = b.st[0], nx = b.st[1];
        if (nloc == 0u) { xcd_barrier_complete(bar, b.x, nloc, nx); b.st[0] = nloc; b.st[1] = nx; }
        const unsigned old = xb_add(&bar[XB_XSUB(b.x)], 1u);
        const unsigned gen = old / nloc;
        if (old + 1u == (gen + 1u) * nloc) {
            __builtin_amdgcn_fence(__ATOMIC_RELEASE, "agent");
            asm volatile("s_waitcnt vmcnt(0)" ::: "memory");
            const unsigned og = xb_add(&bar[XB_TOP], 1u);
            const unsigned tg = og / nx;
            if (og + 1u == (tg + 1u) * nx) xb_add(&bar[XB_TOPGEN], 1u);
            else XB_SPIN(xb_ld(&bar[XB_TOPGEN]) == tg, bar);
            __builtin_amdgcn_fence(__ATOMIC_ACQUIRE, "agent");
            xb_add(&bar[XB_XGEN(b.x)], 1u);
            asm volatile("s_waitcnt vmcnt(0)" ::: "memory");
        } else {
            XB_SPIN(xb_ld(&bar[XB_XGEN(b.x)]) == gen, bar);
            __builtin_amdgcn_fence(__ATOMIC_ACQUIRE, "agent");
            asm volatile("s_waitcnt vmcnt(0)" ::: "memory");
        }
    }
    __syncthreads();
}

struct Args { const float* in[29]; float* out; unsigned char* ws; };
enum { I_X = 0, I_META, I_N1G, I_WIN, I_MU, I_WUP, I_W0, I_AUP, I_A0, I_KK, I_KA, I_RK, I_LNG, I_LNB, I_FB, I_QG, I_KG, I_WPR, I_WPS, I_WPF, I_WOUT, I_N2G, I_MWG, I_MBG, I_MWE, I_MBE, I_MGATE, I_MUP, I_MDOWN };
struct ArgsL { volatile LAS unsigned* tab; float* out; unsigned char* ws;
    __device__ __forceinline__ const float* in(int i) const { const unsigned lo = tab[2 * i], hi = tab[2 * i + 1];
        return (const float*)(((unsigned long long)(unsigned)__builtin_amdgcn_readfirstlane((int)hi) << 32) | (unsigned long long)(unsigned)__builtin_amdgcn_readfirstlane((int)lo)); }
};
struct Frame { LAS unsigned char* lds; volatile LAS unsigned* MISC; int tid, lane, wave, bx; };

__device__ __forceinline__ float* hrow(const ArgsL& a, int b, int l) {
    return l < NMETA ? (float*)(a.ws + WS_HM) + (size_t)(b * NMETA + l) * D : a.out + ((size_t)b * SEQ + (l - NMETA)) * D;
}
#define LDS_WAIT() asm volatile("s_waitcnt lgkmcnt(0)" ::: "memory")
#define HB_PTR(a) ((bf16_t*)((a).ws + WS_HB))
#define A_PTR(a) ((bf16_t*)((a).out))

__device__ __forceinline__ void tr_item(const float* W, int ldw, int sc0, int nvalid, int k0, int kvalid, bf16_t* WT, int Kd, int r0, LAS float* scr, int lane) {
    float tv[32];
#pragma unroll
    for (int i = 0; i < 32; ++i) { const int kk = 2 * i + (lane >> 5), n = lane & 31; tv[i] = 0.f;
        if (n < nvalid && k0 + kk < kvalid) tv[i] = W[(size_t)(k0 + kk) * ldw + sc0 + n]; }
#pragma unroll
    for (int i = 0; i < 32; ++i) { const int kk = 2 * i + (lane >> 5), n = lane & 31; scr[kk * 33 + n] = tv[i]; }
    LDS_WAIT();
    const int c = lane & 7;
#pragma unroll
    for (int j = 0; j < 4; ++j) { const int n = (lane >> 3) + 8 * j; const LAS float* s = scr + (8 * c) * 33 + n;
        u32x4 o; o.x = pk2(s[0 * 33], s[1 * 33]); o.y = pk2(s[2 * 33], s[3 * 33]); o.z = pk2(s[4 * 33], s[5 * 33]); o.w = pk2(s[6 * 33], s[7 * 33]);
        *(u32x4*)(WT + (size_t)(r0 + n) * Kd + k0 + 8 * c) = o; }
    LDS_WAIT();
}
__device__ __forceinline__ void tr_item2(const float* W, int ldw, int sc0, int nvalid, int k0, int kvalid, bf16_t* WT, int Kd, int r0, int kd0, LAS float* scr, int lane) {
    float tv[32];
#pragma unroll
    for (int i = 0; i < 32; ++i) { const int kk = 2 * i + (lane >> 5), n = lane & 31; tv[i] = 0.f;
        if (n < nvalid && k0 + kk < kvalid) tv[i] = W[(size_t)(k0 + kk) * ldw + sc0 + n]; }
#pragma unroll
    for (int i = 0; i < 32; ++i) { const int kk = 2 * i + (lane >> 5), n = lane & 31; scr[kk * 33 + n] = tv[i]; }
    LDS_WAIT();
    const int c = lane & 7;
#pragma unroll
    for (int j = 0; j < 4; ++j) { const int n = (lane >> 3) + 8 * j; const LAS float* s = scr + (8 * c) * 33 + n;
        u32x4 o; o.x = pk2(s[0 * 33], s[1 * 33]); o.y = pk2(s[2 * 33], s[3 * 33]); o.z = pk2(s[4 * 33], s[5 * 33]); o.w = pk2(s[6 * 33], s[7 * 33]);
        *(u32x4*)(WT + (size_t)(r0 + n) * Kd + kd0 + 8 * c) = o; }
    LDS_WAIT();
}
__device__ __forceinline__ void phase_wconv(const ArgsL& a, Frame& F, int layer) {
    LAS float* scr = (LAS float*)(F.lds + F.wave * 8448);
    const int gw = F.bx * NWAVES + F.wave, NGW = gridDim.x * NWAVES;
    constexpr int C1 = 16 * 104, C2_ = C1 + 16 * 96, C3 = C2_ + 6 * 96, C4 = C3 + 16 * 32, C5 = C4 + 16 * 256, C6 = C5 + 4 * 512;
    unsigned char* ws = a.ws;
    for (int it = gw; it < C6; it += NGW) {
        if (it < C1) { const int kb = it / 104, nb = it % 104, r0 = nb * 32;
            tr_item(a.in(I_WIN) + (size_t)layer * D * D_IN, D_IN, r0, r0 < FCOL ? 32 : 0, kb * 64, 1024, (bf16_t*)(ws + WS_WIN), 1024, r0, scr, F.lane); }
        else if (it < C2_) { const int r = it - C1, kb = r / 96, nb = r % 96, r0 = nb * 32;
            tr_item(a.in(I_WIN) + (size_t)layer * D * D_IN, D_IN, GCOL + r0, 32, kb * 64, 1024, (bf16_t*)(ws + WS_WG), 1024, r0, scr, F.lane); }
        else if (it < C3) { const int r = it - C2_, kb = r / 32, nb = r % 32, r0 = nb * 32, br = kb / 6, k0 = (kb % 6) * 64;
            const float* W = (br == 0 ? a.in(I_WPR) + (size_t)layer * 384 * D : br == 1 ? a.in(I_WPS) + (size_t)layer * 320 * D : a.in(I_WPF) + (size_t)layer * 320 * D);
            tr_item2(W, D, r0, 32, k0, br == 0 ? 384 : 320, (bf16_t*)(ws + WS_WP), YC_W, r0, br * 384 + k0, scr, F.lane); }
        else if (it < C4) { const int r = it - C3, kb = r / 32, nb = r % 32, r0 = nb * 32;
            tr_item(a.in(I_WOUT) + (size_t)layer * D * D, D, r0, 32, kb * 64, 1024, (bf16_t*)(ws + WS_WO), 1024, r0, scr, F.lane); }
        else if (it < C5) { const int r = it - C4, kb = r / 256, nb = r % 256, r0 = nb * 32, e = r0 >> 9, rr = r0 & 511, j = rr >> 8, q = rr & 255;
            const float* W = (q >= 128 ? a.in(I_MUP) : a.in(I_MGATE)) + ((size_t)layer * NEXP + e) * D * DEXP;
            tr_item(W, DEXP, j * 128 + (q & 127), 32, kb * 64, 1024, (bf16_t*)(ws + WS_WGU), 1024, r0, scr, F.lane); }
        else { const int r = it - C5, kb = r / 512, nb = r % 512, r0 = nb * 32, e = r0 >> 10;
            tr_item(a.in(I_MDOWN) + ((size_t)layer * NEXP + e) * DEXP * D, D, r0 & 1023, 32, kb * 64, 256, (bf16_t*)(ws + WS_WD), 256, r0, scr, F.lane); }
    }
}

__device__ __forceinline__ void add_y_row(f32x4 (&v)[4], const bf16_t* Y, int slot, int lane) {
    const u32x2* y = (const u32x2*)(Y + (size_t)slot * D) + lane;
#pragma unroll
    for (int j = 0; j < 4; ++j) { const u32x2 t = y[64 * j]; v[j].x += bf_lo(t.x); v[j].y += bf_hi(t.x); v[j].z += bf_lo(t.y); v[j].w += bf_hi(t.y); }
}
template <int MODE>
__device__ __forceinline__ void phase_norm(const ArgsL& a, Frame& F, int layer, const bool dry = false) {
    const int lane = F.lane;
    LAS float* wl = (LAS float*)F.lds;
    LAS int* lcnt = (LAS int*)(F.lds + 20 * 4096);
    unsigned char* ws = a.ws;
    if (MODE == 1) {
        const float* win = a.in(I_WIN) + (size_t)layer * D * D_IN;
        for (int idx = F.tid; idx < 5 * 1024; idx += NTHR) { const int j = idx >> 10, k = idx & 1023; wl[j * 1024 + k] = win[(size_t)k * D_IN + FCOL + j]; }
    }
    if (MODE == 2) {
        const float* wg = a.in(I_MWG) + (size_t)layer * D * 4; const float* we = a.in(I_MWE) + (size_t)layer * D * 16;
        for (int i4 = F.tid; i4 < 1024; i4 += NTHR) { const f32x4 f = *(const f32x4*)(wg + 4 * i4); wl[i4] = f.x; wl[1024 + i4] = f.y; wl[2048 + i4] = f.z; wl[3072 + i4] = f.w; }
        for (int i4 = F.tid; i4 < 4096; i4 += NTHR) { const int k = i4 >> 2, c = i4 & 3; const f32x4 f = *(const f32x4*)(we + 4 * i4); LAS float* d = wl + (4 + 4 * c) * 1024 + k;
            d[0] = f.x; d[1024] = f.y; d[2048] = f.z; d[3072] = f.w; }
        if (F.tid < 16) lcnt[F.tid] = 0;
    }
    __syncthreads();
    const int gw = F.bx * NWAVES + F.wave, NGW = gridDim.x * NWAVES;
    const float* gsrc = (MODE == 2 ? a.in(I_N2G) : a.in(I_N1G)) + layer * D;
    f32x4 gv[4];
#pragma unroll
    for (int j = 0; j < 4; ++j) gv[j] = (MODE == 0) ? (f32x4){0.f, 0.f, 0.f, 0.f} : *(const f32x4*)(gsrc + 4 * lane + 256 * j);
    bf16_t* A = A_PTR(a); bf16_t* HB = HB_PTR(a);
    const bf16_t* Y = (const bf16_t*)(ws + WS_Y);
    const int* SLOT = (const int*)(ws + WS_SLOT);
    constexpr bool COMB0 = (MODE == 0);
    const bool comb = COMB0 || (MODE == 1 && layer > 0);
    f32x4 vn[4]; u32x2 yan[4], ybn[4];
#pragma unroll
    for (int j = 0; j < 4; ++j) { vn[j] = (f32x4){0.f, 0.f, 0.f, 0.f}; yan[j] = (u32x2){0u, 0u}; ybn[j] = (u32x2){0u, 0u}; }
#define NRM_VALID(mm) ((mm) < M && ((mm) % T) - PADR >= (MODE == 0 ? NMETA : 0))
#define NRM_LOAD(mm, s0_, s1_) do { if (NRM_VALID(mm)) { const int bb_ = (mm) / T, ll_ = (mm) - bb_ * T - PADR; \
        if (MODE == 1 && layer == 0) { const float* src_ = (ll_ < NMETA) ? a.in(I_META) + (size_t)ll_ * D : a.in(I_X) + ((size_t)bb_ * SEQ + (ll_ - NMETA)) * D; \
            _Pragma("unroll") for (int j = 0; j < 4; ++j) vn[j] = *(const f32x4*)(src_ + 4 * lane + 256 * j); } \
        else { const u32x2* hs_ = (const u32x2*)(HB + (size_t)(mm) * D) + lane; \
            _Pragma("unroll") for (int j = 0; j < 4; ++j) { const u32x2 t_ = hs_[64 * j]; vn[j] = (f32x4){bf_lo(t_.x), bf_hi(t_.x), bf_lo(t_.y), bf_hi(t_.y)}; } } \
        if (comb) { const u32x2* y0_ = (const u32x2*)(Y + (size_t)(s0_) * D) + lane; const u32x2* y1_ = (const u32x2*)(Y + (size_t)(s1_) * D) + lane; \
            _Pragma("unroll") for (int j = 0; j < 4; ++j) { yan[j] = y0_[64 * j]; ybn[j] = y1_[64 * j]; } } } } while (0)
    int sa1 = 0, sb1 = 0, sa2 = 0, sb2 = 0;
    if (comb) { if (NRM_VALID(gw)) { sa1 = SLOT[2 * gw]; sb1 = SLOT[2 * gw + 1]; } if (NRM_VALID(gw + NGW)) { sa2 = SLOT[2 * (gw + NGW)]; sb2 = SLOT[2 * (gw + NGW) + 1]; } }
    NRM_LOAD(gw, sa1, sb1);
    for (int m = gw; m < M; m += NGW) {
        f32x4 v[4]; u32x2 ya[4], yb[4];
#pragma unroll
        for (int j = 0; j < 4; ++j) { v[j] = vn[j]; ya[j] = yan[j]; yb[j] = ybn[j]; }
        int sa3 = 0, sb3 = 0;
        if (comb && NRM_VALID(m + 2 * NGW)) { sa3 = SLOT[2 * (m + 2 * NGW)]; sb3 = SLOT[2 * (m + 2 * NGW) + 1]; }
        NRM_LOAD(m + NGW, sa2, sb2);
        sa2 = sa3; sb2 = sb3;
        const int b = m / T, p = m - b * T, l = p - PADR;
        if (l < 0) {
            if (MODE == 1 && !dry) {
                u32x2* o = (u32x2*)(A + (size_t)m * D) + lane;
#pragma unroll
                for (int j = 0; j < 4; ++j) o[64 * j] = (u32x2){0u, 0u};
                if (lane < 8) ((float*)(ws + WS_LOGF))[(size_t)m * 8 + lane] = 0.f;
            }
            continue;
        }
        if (MODE == 0 && l < NMETA) continue;
        if (comb) {
#pragma unroll
            for (int j = 0; j < 4; ++j) { v[j].x += bf_lo(ya[j].x) + bf_lo(yb[j].x); v[j].y += bf_hi(ya[j].x) + bf_hi(yb[j].x); v[j].z += bf_lo(ya[j].y) + bf_lo(yb[j].y); v[j].w += bf_hi(ya[j].y) + bf_hi(yb[j].y); }
        }
        if (MODE == 0 && !dry) { float* op = a.out + ((size_t)b * SEQ + (l - NMETA)) * D;
#pragma unroll
            for (int j = 0; j < 4; ++j) *(f32x4*)(op + 4 * lane + 256 * j) = v[j]; }
        if (MODE == 1 && !dry) { u32x2* hd = (u32x2*)(HB + (size_t)m * D) + lane;
#pragma unroll
            for (int j = 0; j < 4; ++j) hd[64 * j] = (u32x2){pk2(v[j].x, v[j].y), pk2(v[j].z, v[j].w)};
        }
        if (MODE == 0) continue;
        float ss = 0.f;
#pragma unroll
        for (int j = 0; j < 4; ++j) ss += (v[j].x * v[j].x + v[j].y * v[j].y) + (v[j].z * v[j].z + v[j].w * v[j].w);
        const float r = 1.0f / sqrtf(wave_sum(ss) * (1.0f / D) + 1e-6f);
#pragma unroll
        for (int j = 0; j < 4; ++j) v[j] = v[j] * r * gv[j];
        u32x2* o = (u32x2*)(A + (size_t)m * D) + lane;
        if (!dry) {
#pragma unroll
        for (int j = 0; j < 4; ++j) o[64 * j] = (u32x2){pk2(v[j].x, v[j].y), pk2(v[j].z, v[j].w)}; }
        else { float sink = v[0].x + v[1].y + v[2].z + v[3].w; asm volatile("" :: "v"(sink)); }
        if (MODE == 1) {
            float dsum[5];
#pragma unroll
            for (int q = 0; q < 5; ++q) { float d = 0.f;
#pragma unroll
                for (int j = 0; j < 4; ++j) { const f32x4 w = *(const LAS f32x4*)(wl + q * 1024 + 4 * lane + 256 * j); d += (v[j].x * w.x + v[j].y * w.y) + (v[j].z * w.z + v[j].w * w.w); }
                dsum[q] = wave_sum(d); }
            float mine = dsum[0];
            mine = lane == 1 ? dsum[1] : mine; mine = lane == 2 ? dsum[2] : mine; mine = lane == 3 ? dsum[3] : mine; mine = lane == 4 ? dsum[4] : mine;
            if (lane < 8 && !dry) { float lf = 0.f;
                if (lane < 5) { const float xx = mine + a.in(I_FB)[layer * 5 + lane]; lf = fminf(xx, 0.f) - fast_log(1.f + fast_exp(-fabsf(xx))); }
                ((float*)(ws + WS_LOGF))[(size_t)m * 8 + lane] = lf; }
        }
        if (MODE == 2) {
            float dp[20];
#pragma unroll
            for (int q = 0; q < 20; ++q) { float d = 0.f;
#pragma unroll
                for (int j = 0; j < 4; ++j) { const f32x4 w = *(const LAS f32x4*)(wl + q * 1024 + 4 * lane + 256 * j); d += (v[j].x * w.x + v[j].y * w.y) + (v[j].z * w.z + v[j].w * w.w); }
                dp[q] = d; }
            float sA[10], sB[5];
#pragma unroll
            for (int i = 0; i < 10; ++i) { auto sw = __builtin_amdgcn_permlane32_swap(__float_as_uint(dp[2 * i]), __float_as_uint(dp[2 * i + 1]), false, false); sA[i] = __uint_as_float(sw[0]) + __uint_as_float(sw[1]); }
#pragma unroll
            for (int i = 0; i < 5; ++i) { auto sw = __builtin_amdgcn_permlane16_swap(__float_as_uint(sA[2 * i]), __float_as_uint(sA[2 * i + 1]), false, false); sB[i] = allred16(__uint_as_float(sw[0]) + __uint_as_float(sw[1])); }
            LAS float* red = (LAS float*)(F.lds + 81920 + 256) + F.wave * 32;
            { const int rho = lane >> 4, vsel = ((rho & 1) << 1) | (rho >> 1);
              if ((lane & 15) == 0) {
#pragma unroll
                  for (int i = 0; i < 5; ++i) red[4 * i + vsel] = sB[i]; } }
            LDS_WAIT();
            float ds[20];
#pragma unroll
            for (int i = 0; i < 5; ++i) { const f32x4 t4 = *(const LAS f32x4*)(red + 4 * i); ds[4 * i] = t4.x; ds[4 * i + 1] = t4.y; ds[4 * i + 2] = t4.z; ds[4 * i + 3] = t4.w; }
            LDS_WAIT();
            const float* bg = a.in(I_MBG) + layer * 4; const float* be = a.in(I_MBE) + layer * 16;
            float lg0 = ds[0] + bg[0], lg1 = ds[1] + bg[1], lg2 = ds[2] + bg[2], lg3 = ds[3] + bg[3];
            int g = 0; float mx = lg0;
            if (lg1 > mx) { mx = lg1; g = 1; } if (lg2 > mx) { mx = lg2; g = 2; } if (lg3 > mx) { mx = lg3; g = 3; }
            const float den = fast_exp(lg0 - mx) + fast_exp(lg1 - mx) + fast_exp(lg2 - mx) + fast_exp(lg3 - mx);
            const float pgrp = 1.0f / den;
            float s0 = g == 0 ? ds[4] : g == 1 ? ds[8] : g == 2 ? ds[12] : ds[16];
            float s1 = g == 0 ? ds[5] : g == 1 ? ds[9] : g == 2 ? ds[13] : ds[17];
            float s2 = g == 0 ? ds[6] : g == 1 ? ds[10] : g == 2 ? ds[14] : ds[18];
            float s3 = g == 0 ? ds[7] : g == 1 ? ds[11] : g == 2 ? ds[15] : ds[19];
            s0 += be[g * 4 + 0]; s1 += be[g * 4 + 1]; s2 += be[g * 4 + 2]; s3 += be[g * 4 + 3];
            int i0 = 0; float v0 = s0;
            if (s1 > v0) { v0 = s1; i0 = 1; } if (s2 > v0) { v0 = s2; i0 = 2; } if (s3 > v0) { v0 = s3; i0 = 3; }
            int i1 = -1; float v1 = -3.0e38f;
            if (i0 != 0 && s0 > v1) { v1 = s0; i1 = 0; } if (i0 != 1 && s1 > v1) { v1 = s1; i1 = 1; } if (i0 != 2 && s2 > v1) { v1 = s2; i1 = 2; } if (i0 != 3 && s3 > v1) { v1 = s3; i1 = 3; }
            const float e1 = fast_exp(v1 - v0), pt0 = 1.0f / (1.0f + e1), pt1 = e1 * pt0;
            if (dry) { float sink = pgrp * pt0 + pt1; asm volatile("" :: "v"(sink)); }
            if (lane == 0 && !dry) {
                const int ea = g * 4 + i0, eb = g * 4 + i1;
                const int la = atomicAdd((int*)&lcnt[ea], 1), lb = atomicAdd((int*)&lcnt[eb], 1);
                int* tk = (int*)(ws + WS_TOK) + (size_t)m * 8;
                tk[0] = ea; tk[1] = eb; tk[2] = __float_as_int(pgrp * pt0); tk[3] = __float_as_int(pgrp * pt1); tk[4] = la; tk[5] = lb;
            }
        }
    }
    __syncthreads();
#undef NRM_LOAD
#undef NRM_VALID
    if (MODE == 2 && F.tid < 16 && !dry) {
        const int c = lcnt[F.tid];
        ((int*)(ws + WS_WGCNT))[F.bx * 16 + F.tid] = c;
        atomicAdd((int*)(ws + WS_CTL) + CW_ECNT + 64 * layer + F.tid, c);
    }
    __syncthreads();
}

__device__ __forceinline__ void phase_norm2(const ArgsL& a, Frame& F, int layer, const bool dry = false) {
    const int lane = F.lane;
    LAS float* wl = (LAS float*)F.lds;
    LAS int* lcnt = (LAS int*)(F.lds + 20 * 4096);
    unsigned char* ws = a.ws;
    {
        const float* wg = a.in(I_MWG) + (size_t)layer * D * 4; const float* we = a.in(I_MWE) + (size_t)layer * D * 16;
        for (int i4 = F.tid; i4 < 1024; i4 += NTHR) { const f32x4 f = *(const f32x4*)(wg + 4 * i4); wl[i4] = f.x; wl[1024 + i4] = f.y; wl[2048 + i4] = f.z; wl[3072 + i4] = f.w; }
        for (int i4 = F.tid; i4 < 4096; i4 += NTHR) { const int k = i4 >> 2, c = i4 & 3; const f32x4 f = *(const f32x4*)(we + 4 * i4); LAS float* d = wl + (4 + 4 * c) * 1024 + k;
            d[0] = f.x; d[1024] = f.y; d[2048] = f.z; d[3072] = f.w; }
        if (F.tid < 16) lcnt[F.tid] = 0;
    }
    __syncthreads();
    const int gw = F.bx * NWAVES + F.wave, NGW = gridDim.x * NWAVES;
    LAS float* gl = (LAS float*)(F.lds + 86016);
    LAS float* bl = (LAS float*)(F.lds + 90112);
    for (int i = F.tid; i < 1024; i += NTHR) gl[i] = a.in(I_N2G)[layer * D + i];
    if (F.tid < 4) bl[F.tid] = a.in(I_MBG)[layer * 4 + F.tid];
    if (F.tid >= 64 && F.tid < 80) bl[4 + F.tid - 64] = a.in(I_MBE)[layer * 16 + F.tid - 64];
    __syncthreads();
    bf16_t* A = A_PTR(a); const bf16_t* HB = HB_PTR(a);
    LAS float* red = (LAS float*)(F.lds + 81920 + 256) + F.wave * 96;
#define N2_VALID(mm) ((mm) < M && ((mm) % T) >= PADR)
    constexpr int NR = 2;
    for (int m0 = gw; m0 < M; m0 += NR * NGW) {
        f32x4 v[NR][4];
#pragma unroll
        for (int rr = 0; rr < NR; ++rr) { const int mm_ = m0 + rr * NGW;
            if (N2_VALID(mm_)) { const u32x2* hs_ = (const u32x2*)(HB + (size_t)mm_ * D) + lane;
#pragma unroll
                for (int j = 0; j < 4; ++j) { const u32x2 t = hs_[64 * j]; v[rr][j] = (f32x4){bf_lo(t.x), bf_hi(t.x), bf_lo(t.y), bf_hi(t.y)}; } }
            else {
#pragma unroll
                for (int j = 0; j < 4; ++j) v[rr][j] = (f32x4){0.f, 0.f, 0.f, 0.f}; } }
        float ss[NR];
#pragma unroll
        for (int rr = 0; rr < NR; ++rr) { float s_ = 0.f;
#pragma unroll
            for (int j = 0; j < 4; ++j) s_ += (v[rr][j].x * v[rr][j].x + v[rr][j].y * v[rr][j].y) + (v[rr][j].z * v[rr][j].z + v[rr][j].w * v[rr][j].w);
            ss[rr] = s_; }
#pragma unroll
        for (int rr = 0; rr < NR; ++rr) ss[rr] = wave_sum(ss[rr]);
#pragma unroll
        for (int rr = 0; rr < NR; ++rr) { const int mm = m0 + rr * NGW; const float r = 1.0f / sqrtf(ss[rr] * (1.0f / D) + 1e-6f);
#pragma unroll
            for (int j = 0; j < 4; ++j) v[rr][j] = v[rr][j] * r * *(const LAS f32x4*)(gl + 4 * lane + 256 * j);
            if (N2_VALID(mm) && !dry) { u32x2* o = (u32x2*)(A + (size_t)mm * D) + lane;
#pragma unroll
                for (int j = 0; j < 4; ++j) o[64 * j] = (u32x2){pk2(v[rr][j].x, v[rr][j].y), pk2(v[rr][j].z, v[rr][j].w)}; } }
        { const int rho = lane >> 4, vsel = ((rho & 1) << 1) | (rho >> 1);
#pragma unroll
          for (int qh = 0; qh < 2; ++qh) {
            float dp[NR][10];
#pragma unroll
            for (int q = 0; q < 10; ++q) { f32x4 w[4];
#pragma unroll
                for (int j = 0; j < 4; ++j) w[j] = *(const LAS f32x4*)(wl + (qh * 10 + q) * 1024 + 4 * lane + 256 * j);
#pragma unroll
                for (int rr = 0; rr < NR; ++rr) { float d = 0.f;
#pragma unroll
                    for (int j = 0; j < 4; ++j) d += (v[rr][j].x * w[j].x + v[rr][j].y * w[j].y) + (v[rr][j].z * w[j].z + v[rr][j].w * w[j].w);
                    dp[rr][q] = d; }
                if (q & 1) __builtin_amdgcn_sched_barrier(0); }
#pragma unroll
            for (int rr = 0; rr < NR; ++rr) { float sA[6], sB[3]; sA[5] = 0.f;
#pragma unroll
                for (int i = 0; i < 5; ++i) { auto sw = __builtin_amdgcn_permlane32_swap(__float_as_uint(dp[rr][2 * i]), __float_as_uint(dp[rr][2 * i + 1]), false, false); sA[i] = __uint_as_float(sw[0]) + __uint_as_float(sw[1]); }
#pragma unroll
                for (int k = 0; k < 3; ++k) { auto sw = __builtin_amdgcn_permlane16_swap(__float_as_uint(sA[2 * k]), __float_as_uint(sA[2 * k + 1]), false, false); sB[k] = allred16(__uint_as_float(sw[0]) + __uint_as_float(sw[1])); }
                if ((lane & 15) == 0) {
#pragma unroll
                    for (int k = 0; k < 3; ++k) red[rr * 24 + qh * 10 + 4 * k + vsel] = sB[k]; } }
            __builtin_amdgcn_sched_barrier(0);
          } }
        LDS_WAIT();
        if (lane < NR) {
            const int mm = m0 + lane * NGW;
            float ds[20];
#pragma unroll
            for (int i = 0; i < 5; ++i) { const f32x4 t4 = *(const LAS f32x4*)(red + lane * 24 + 4 * i); ds[4 * i] = t4.x; ds[4 * i + 1] = t4.y; ds[4 * i + 2] = t4.z; ds[4 * i + 3] = t4.w; }
            const float lg0 = ds[0] + bl[0], lg1 = ds[1] + bl[1], lg2 = ds[2] + bl[2], lg3 = ds[3] + bl[3];
            int g = 0; float mx = lg0;
            if (lg1 > mx) { mx = lg1; g = 1; } if (lg2 > mx) { mx = lg2; g = 2; } if (lg3 > mx) { mx = lg3; g = 3; }
            const float den = fast_exp(lg0 - mx) + fast_exp(lg1 - mx) + fast_exp(lg2 - mx) + fast_exp(lg3 - mx);
            const float pgrp = 1.0f / den;
            const f32x4 be4 = *(const LAS f32x4*)(bl + 4 + 4 * g);
            float s0 = (g == 0 ? ds[4] : g == 1 ? ds[8] : g == 2 ? ds[12] : ds[16]) + be4.x;
            float s1 = (g == 0 ? ds[5] : g == 1 ? ds[9] : g == 2 ? ds[13] : ds[17]) + be4.y;
            float s2 = (g == 0 ? ds[6] : g == 1 ? ds[10] : g == 2 ? ds[14] : ds[18]) + be4.z;
            float s3 = (g == 0 ? ds[7] : g == 1 ? ds[11] : g == 2 ? ds[15] : ds[19]) + be4.w;
            int i0 = 0; float v0 = s0;
            if (s1 > v0) { v0 = s1; i0 = 1; } if (s2 > v0) { v0 = s2; i0 = 2; } if (s3 > v0) { v0 = s3; i0 = 3; }
            int i1 = -1; float v1 = -3.0e38f;
            if (i0 != 0 && s0 > v1) { v1 = s0; i1 = 0; } if (i0 != 1 && s1 > v1) { v1 = s1; i1 = 1; } if (i0 != 2 && s2 > v1) { v1 = s2; i1 = 2; } if (i0 != 3 && s3 > v1) { v1 = s3; i1 = 3; }
            const float e1 = fast_exp(v1 - v0), pt0 = 1.0f / (1.0f + e1), pt1 = e1 * pt0;
            if (N2_VALID(mm) && !dry) {
                const int ea = g * 4 + i0, eb = g * 4 + i1;
                const int la = atomicAdd((int*)&lcnt[ea], 1), lb = atomicAdd((int*)&lcnt[eb], 1);
                int* tk = (int*)(ws + WS_TOK) + (size_t)mm * 8;
                tk[0] = ea; tk[1] = eb; tk[2] = __float_as_int(pgrp * pt0); tk[3] = __float_as_int(pgrp * pt1); tk[4] = la; tk[5] = lb;
            } else { float sink = pgrp * pt0 + pt1; asm volatile("" :: "v"(sink)); }
        }
        LDS_WAIT();
    }
#undef N2_VALID
    __syncthreads();
    if (F.tid < 16 && !dry) {
        const int c = lcnt[F.tid];
        ((int*)(ws + WS_WGCNT))[F.bx * 16 + F.tid] = c;
        atomicAdd((int*)(ws + WS_CTL) + CW_ECNT + 64 * layer + F.tid, c);
    }
    __syncthreads();
}

__device__ __forceinline__ void phase_route(const ArgsL& a, Frame& F, int layer) {
    unsigned char* ws = a.ws;
    LAS int* tbl = (LAS int*)F.lds;
    LAS int* part = tbl + 16;
    {
        const int e = F.tid & 15, q = F.tid >> 4; const int* wc = (const int*)(ws + WS_WGCNT); int acc = 0;
#pragma unroll
        for (int i = 0; i < 8; ++i) { const int w = q + 32 * i; if (w < (int)F.bx) acc += wc[w * 16 + e]; }
        part[q * 16 + e] = acc;
    }
    __syncthreads();
    if (F.tid < 16) {
        const int* cnt = (const int*)(ws + WS_CTL) + CW_ECNT + 64 * layer;
        int cv[16];
#pragma unroll
        for (int e = 0; e < 16; ++e) cv[e] = __hip_atomic_load(cnt + e, __ATOMIC_RELAXED, __HIP_MEMORY_SCOPE_AGENT);
        int base = 0;
#pragma unroll
        for (int e = 0; e < 16; ++e) if (e < F.tid) base += ((cv[e] + 255) >> 8) << 8;
#pragma unroll
        for (int q = 0; q < 32; ++q) base += part[q * 16 + F.tid];
        tbl[F.tid] = base;
    }
    __syncthreads();
    const int gw = F.bx * NWAVES + F.wave, NGW = gridDim.x * NWAVES, lane = F.lane;
    const bf16_t* A = A_PTR(a); bf16_t* AS = (bf16_t*)(ws + WS_AS);
    int tn[6] = {0, 0, 0, 0, 0, 0}; u32x4 xn0 = {0u, 0u, 0u, 0u}, xn1 = {0u, 0u, 0u, 0u};
#define RT_LOAD(mm) do { if ((mm) < M && ((mm) % T) >= PADR) { const int* tk_ = (const int*)(ws + WS_TOK) + (size_t)(mm) * 8; \
        _Pragma("unroll") for (int q_ = 0; q_ < 6; ++q_) tn[q_] = tk_[q_]; \
        const u32x4* src_ = (const u32x4*)(A + (size_t)(mm) * D) + lane; xn0 = src_[0]; xn1 = src_[64]; } } while (0)
    RT_LOAD(gw);
    for (int m = gw; m < M; m += NGW) {
        int tk[6];
#pragma unroll
        for (int q = 0; q < 6; ++q) tk[q] = tn[q];
        const u32x4 x0 = xn0, x1 = xn1;
        RT_LOAD(m + NGW);
        const int b = m / T, p = m - b * T, l = p - PADR;
        if (l < 0) continue;
        const int ea = tk[0], eb = tk[1], sa = tbl[ea] + tk[4], sb = tbl[eb] + tk[5];
        u32x4* d0 = (u32x4*)(AS + (size_t)sa * D) + lane; u32x4* d1 = (u32x4*)(AS + (size_t)sb * D) + lane;
        d0[0] = x0; d0[64] = x1; d1[0] = x0; d1[64] = x1;
        if (lane == 0) { int* sl = (int*)(ws + WS_SLOT) + 2 * m; sl[0] = sa; sl[1] = sb;
            float* cw = (float*)(ws + WS_CWS); cw[sa] = __int_as_float(tk[2]); cw[sb] = __int_as_float(tk[3]); }
    }
#undef RT_LOAD
    __syncthreads();
}

#ifndef PR_STAGES
#define PR_STAGES 15
#endif
__device__ __forceinline__ void phase_prep(const ArgsL& a, Frame& F, int layer, const bool dry = false) {
    unsigned char* ws = a.ws;
    LAS float* xs = (LAS float*)F.lds;
    const int wave = F.wave, lane = F.lane, tid = F.tid;
    const int m0 = F.bx * 129;
    const bf16_t* USH = (const bf16_t*)(ws + WS_USH);
    bf16_t* QKV = (bf16_t*)(ws + WS_QKV);
    if (F.bx < 10 && (!dry || (PR_STAGES & 8))) {
        const int bh = F.bx, b = bh / 5, h = bh % 5;
        const float* LOGF = (const float*)(ws + WS_LOGF) + (size_t)(b * T + PADR) * 8 + h;
        float* kb = (float*)(ws + WS_KB2) + (size_t)bh * KBP;
        LAS float* wtot = (LAS float*)F.lds;
        float v[33];
        const int l0 = tid * 33;
#pragma unroll
        for (int i = 0; i < 33; ++i) v[i] = (l0 + i < LTOK) ? LOGF[(size_t)(l0 + i) * 8] : 0.f;
#pragma unroll
        for (int i = 1; i < 33; ++i) v[i] += v[i - 1];
        float incl = v[32];
#pragma unroll
        for (int o = 1; o < 64; o <<= 1) { const float t = __shfl_up(incl, o); if (lane >= o) incl += t; }
        if (lane == 63) wtot[wave] = incl;
        __syncthreads();
        float off = incl - v[32];
        for (int w = 0; w < wave; ++w) off += wtot[w];
#pragma unroll
        for (int i = 0; i < 33; ++i) if (l0 + i < LTOK && !dry) kb[PADR + l0 + i] = -(off + v[i]) * LOG2E;
        for (int p = tid; p < PADR; p += NTHR) kb[p] = 0.f;
        for (int p = T + tid; p < KBP; p += NTHR) kb[p] = 0.f;
        __syncthreads();
    }
    if (F.bx >= 16 && F.bx < 28) {
        unsigned* z = (unsigned*)(ws + WS_RW + ((size_t)(F.bx - 16) * LPADDED + LTOK) * 768);
        for (int i = tid; i < (LPADDED - LTOK) * 192; i += NTHR) z[i] = 0u;
    }
    const int r16 = lane & 15, q4 = lane >> 4, hh = wave < 6 ? wave : 0;
    bf16x8 bw[2][4][2];
    float cw0[4], ca0[4], ckk[4], cka[4], crk[4];
    {
        const float* WUp = a.in(I_WUP) + (size_t)layer * 64 * RW_W + hh * 64 + r16; const float* AUp = a.in(I_AUP) + (size_t)layer * 64 * RW_W + hh * 64 + r16;
#pragma unroll
        for (int mtx = 0; mtx < 2; ++mtx)
#pragma unroll
            for (int blk = 0; blk < 4; ++blk)
#pragma unroll
                for (int ks = 0; ks < 2; ++ks) { const float* p_ = (mtx ? AUp : WUp) + (size_t)(32 * ks + 8 * q4) * RW_W + blk * 16;
                    const float f0 = p_[0], f1 = p_[RW_W], f2 = p_[2 * RW_W], f3 = p_[3 * RW_W], f4 = p_[4 * RW_W], f5 = p_[5 * RW_W], f6 = p_[6 * RW_W], f7 = p_[7 * RW_W];
                    bw[mtx][blk][ks] = __builtin_bit_cast(bf16x8, (u32x4){pk2(f0, f1), pk2(f2, f3), pk2(f4, f5), pk2(f6, f7)}); }
#pragma unroll
        for (int blk = 0; blk < 4; ++blk) { const int ch = layer * RW_W + hh * 64 + blk * 16 + r16;
            cw0[blk] = a.in(I_W0)[ch]; ca0[blk] = a.in(I_A0)[ch]; ckk[blk] = a.in(I_KK)[ch]; cka[blk] = a.in(I_KA)[ch]; crk[blk] = a.in(I_RK)[ch]; }
    }
    const float* mu = a.in(I_MU) + layer * SHIFT_W;
    f32x4 gq4 = *(const f32x4*)(a.in(I_QG) + layer * 64 + (lane & 15) * 4) * C2; const f32x4 gk4 = *(const f32x4*)(a.in(I_KG) + layer * 64 + (lane & 15) * 4);
    _Float16* RW = (_Float16*)(ws + WS_RW);
    bf16_t* BN = (bf16_t*)(ws + WS_BN);
    for (int t0 = 0; t0 < 129; t0 += 16) {
        const int nt = (129 - t0) < 16 ? (129 - t0) : 16;
        if (!dry || (PR_STAGES & 1)) {
            int tid = F.tid; asm volatile("" : "+v"(tid));
            u32x4 uu4[5], pp4[5];
#pragma unroll
            for (int q5 = 0; q5 < 5; ++q5) { const int item = tid + q5 * NTHR; uu4[q5] = (u32x4){0u, 0u, 0u, 0u}; pp4[q5] = (u32x4){0u, 0u, 0u, 0u};
                if (item < nt * 160) { const int tok = item / 160, ch = item - tok * 160, m = m0 + t0 + tok;
                    uu4[q5] = *(const u32x4*)(USH + (size_t)m * SHIFT_W + ch * 8);
                    if (m > 0) pp4[q5] = *(const u32x4*)(USH + (size_t)(m - 1) * SHIFT_W + ch * 8); } }
#pragma unroll
            for (int q5 = 0; q5 < 5; ++q5) { const int item = tid + q5 * NTHR;
                if (item < nt * 160) { const int tok = item / 160, ch = item - tok * 160;
                    const u32x4 u = uu4[q5], pv = pp4[q5];
                    const f32x4 mu0 = *(const f32x4*)(mu + ch * 8), mu1 = *(const f32x4*)(mu + ch * 8 + 4);
                    float x[8];
                    { float uu, pp;
                      uu = bf_lo(u.x); pp = bf_lo(pv.x); x[0] = uu + (pp - uu) * mu0.x;  uu = bf_hi(u.x); pp = bf_hi(pv.x); x[1] = uu + (pp - uu) * mu0.y;
                      uu = bf_lo(u.y); pp = bf_lo(pv.y); x[2] = uu + (pp - uu) * mu0.z;  uu = bf_hi(u.y); pp = bf_hi(pv.y); x[3] = uu + (pp - uu) * mu0.w;
                      uu = bf_lo(u.z); pp = bf_lo(pv.z); x[4] = uu + (pp - uu) * mu1.x;  uu = bf_hi(u.z); pp = bf_hi(pv.z); x[5] = uu + (pp - uu) * mu1.y;
                      uu = bf_lo(u.w); pp = bf_lo(pv.w); x[6] = uu + (pp - uu) * mu1.z;  uu = bf_hi(u.w); pp = bf_hi(pv.w); x[7] = uu + (pp - uu) * mu1.w; }
                    if (ch >= 144 && ch < 152) {
#pragma unroll
                        for (int q = 0; q < 8; ++q) { const float e = fast_exp(-2.f * fabsf(x[q])); const float th = (1.f - e) / (1.f + e); x[q] = x[q] < 0.f ? -th : th; }
                    }
                    LAS f32x4* d = (LAS f32x4*)(xs + tok * SHIFT_W + ch * 8);
                    d[0] = (f32x4){x[0], x[1], x[2], x[3]}; d[1] = (f32x4){x[4], x[5], x[6], x[7]}; } }
        }
        __syncthreads();
        if (wave < 6) { if (!dry || (PR_STAGES & 2)) {
            f32x4 acc[2][4];
#pragma unroll
            for (int mtx = 0; mtx < 2; ++mtx) {
                bf16x8 af[2];
#pragma unroll
                for (int ks = 0; ks < 2; ++ks) { const LAS float* xp = xs + r16 * SHIFT_W + 1152 + 64 * mtx + 32 * ks + 8 * q4;
                    const f32x4 u0 = *(const LAS f32x4*)xp, u1 = *(const LAS f32x4*)(xp + 4);
                    af[ks] = __builtin_bit_cast(bf16x8, (u32x4){pk2(u0.x, u0.y), pk2(u0.z, u0.w), pk2(u1.x, u1.y), pk2(u1.z, u1.w)}); }
#pragma unroll
                for (int blk = 0; blk < 4; ++blk) { f32x4 c4 = {0.f, 0.f, 0.f, 0.f};
                    c4 = __builtin_amdgcn_mfma_f32_16x16x32_bf16(af[0], bw[mtx][blk][0], c4, 0, 0, 0);
                    c4 = __builtin_amdgcn_mfma_f32_16x16x32_bf16(af[1], bw[mtx][blk][1], c4, 0, 0, 0);
                    acc[mtx][blk] = c4; }
            }
#pragma unroll
            for (int i = 0; i < 4; ++i) {
                const int tok = 4 * q4 + i, m = m0 + t0 + tok, b = m / T, p = m - b * T, l = p - PADR;
                const bool ok = (tok < nt) && (l >= 0);
                const LAS float* xr = xs + (tok < 16 ? tok : 0) * SHIFT_W + hh * 64 + r16;
                float kkr[4], kpv[4], avv4[4], omv[4], rv4[4], vv4[4];
                float ssq = 0.f, cf = 0.f;
#pragma unroll
                for (int blk = 0; blk < 4; ++blk) {
                    const float wlv = cw0[blk] + acc[0][blk][i], alv = ca0[blk] + acc[1][blk][i];
                    const float r = xr[blk * 16], k = xr[384 + blk * 16], v = xr[768 + blk * 16];
                    const float logw = -softplus_f(-wlv) - 0.5f;
                    const float xw = fast_exp(logw);
                    omv[blk] = xw < 0.02f ? xw * (1.f - 0.5f * xw + xw * xw * (1.f / 6.f)) : 1.f - fast_exp(-xw);
                    const float av = 1.f / (1.f + fast_exp(-alv));
                    kkr[blk] = k * ckk[blk]; kpv[blk] = k * (1.f + (av - 1.f) * cka[blk]); avv4[blk] = av; rv4[blk] = r; vv4[blk] = v;
                    ssq += kkr[blk] * kkr[blk]; cf += r * kpv[blk] * crk[blk];
                }
                ssq = allred16(ssq); cf = allred16(cf);
                const float inv = 1.0f / fmaxf(sqrtf(ssq), 1e-12f);
                if (ok && !dry) {
                    _Float16* o = RW + ((size_t)(b * RW_H + hh) * LPADDED + l) * 384 + r16;
#pragma unroll
                    for (int blk = 0; blk < 4; ++blk) { const float kk = kkr[blk] * inv, bb = kk * avv4[blk];
                        o[blk * 16] = (_Float16)kk; o[64 + blk * 16] = (_Float16)(-omv[blk]); o[128 + blk * 16] = (_Float16)(-bb); o[192 + blk * 16] = (_Float16)kpv[blk];
                        o[256 + blk * 16] = (_Float16)rv4[blk]; o[320 + blk * 16] = (_Float16)vv4[blk];
                        BN[(size_t)m * RW_W + hh * 64 + blk * 16 + r16] = f2bf(cf * vv4[blk]); }
                } else { float sink = ssq + cf + inv + omv[0] + kpv[1]; asm volatile("" :: "v"(sink)); }
            } }
        }
        if (!dry || (PR_STAGES & 4)) {
            const int it4 = lane >> 4, e4 = lane & 15;
            u32x2 xv[5]; bf16_t* qp5[5]; bool okv[5];
#pragma unroll
            for (int ps = 0; ps < 5; ++ps) { const int item = (ps * 8 + wave) * 4 + it4, tok = item / 10, hq = item - tok * 10;
                const int m = m0 + t0 + tok, p = m % T;
                okv[ps] = (tok < nt) && (p >= PADR);
                qp5[ps] = QKV + (size_t)m * QKV_W + 960 + hq * 64 + e4 * 4;
                xv[ps] = okv[ps] ? *(const u32x2*)qp5[ps] : (u32x2){0u, 0u}; }
#pragma unroll
            for (int ps = 0; ps < 5; ++ps) { const int item = (ps * 8 + wave) * 4 + it4, hq = item % 10;
                const float x0 = bf_lo(xv[ps].x), x1 = bf_hi(xv[ps].x), x2 = bf_lo(xv[ps].y), x3 = bf_hi(xv[ps].y);
                const float ss = allred16((x0 * x0 + x1 * x1) + (x2 * x2 + x3 * x3));
                const float rs = 1.0f / sqrtf(ss * (1.0f / 64.f) + 1e-6f);
                const f32x4 gg = hq < 5 ? gq4 : gk4;
                const u32x2 w = {pk2(x0 * rs * gg.x, x1 * rs * gg.y), pk2(x2 * rs * gg.z, x3 * rs * gg.w)};
                if (okv[ps] && !dry) *(u32x2*)qp5[ps] = w; else asm volatile("" :: "v"(w.x), "v"(w.y)); }
        }
        __syncthreads();
    }
}


constexpr int SCH = 16;
static_assert(LTOK % SCH == 0, "whole chunks");
__device__ __forceinline__ void rwkv_scan(const ArgsL& a, Frame& F, int wgi, int dry = 0) {
    const int bh = wgi >> 4, q8 = wgi & 15, b = bh / RW_H, h = bh % RW_H;
    const int tid = F.tid, wave = F.wave, lane = F.lane;
    const unsigned char* rw = a.ws + WS_RW + (size_t)bh * LPADDED * 768;
    LAS float* ring = (LAS float*)F.lds;
    LAS float* ypart = (LAS float*)(F.lds + 49152);
    LAS unsigned char* stg = F.lds + 81920;
    bf16_t* y0 = (bf16_t*)(a.ws + WS_YCAT);
    constexpr int NCH = LTOK / SCH;
    const bool isld = (wave & 2) != 0; const int lw = (wave & 1) + ((wave >> 2) << 1), tl = lw * 64 + lane;
    float s0 = 0.f, s1 = 0.f;
    const int i32 = lane & 31, rsel = lane >> 5, rloc = 2 * wave + rsel;
#define RW_BAR() asm volatile("s_waitcnt lgkmcnt(0)\n\ts_barrier" ::: "memory")
#define RW_ISSUE(cc) do { const unsigned char* src_ = rw + (size_t)(cc) * SCH * 768 + (size_t)tl * 16; LAS unsigned char* d_ = stg + ((cc) & 3) * 12288 + lw * 1024; \
        _Pragma("unroll") for (int k_ = 0; k_ < 3; ++k_) __builtin_amdgcn_global_load_lds((const unsigned*)(src_ + k_ * 4096), (LAS unsigned*)(d_ + k_ * 4096), 16, 0, 0); } while (0)
#define RW_CONVERT(cc) do { const LAS unsigned char* s_ = stg + ((cc) & 3) * 12288 + tl * 16; LAS float* rb_ = ring + ((cc) & 1) * 6144; \
        _Pragma("unroll") for (int k_ = 0; k_ < 3; ++k_) { const int pc_ = tl + 256 * k_; const int t_ = pc_ / 48, q_ = pc_ - t_ * 48, vec_ = q_ >> 3, e0_ = (q_ & 7) * 8; \
            const u32x4 w_ = *(const LAS u32x4*)(s_ + k_ * 4096); \
            const f16x4 lo_ = __builtin_bit_cast(f16x4, (u32x2){w_.x, w_.y}), hi_ = __builtin_bit_cast(f16x4, (u32x2){w_.z, w_.w}); \
            const float f0 = (float)lo_.x, f1 = (float)lo_.y, f2 = (float)lo_.z, f3 = (float)lo_.w, f4 = (float)hi_.x, f5 = (float)hi_.y, f6 = (float)hi_.z, f7 = (float)hi_.w; \
            if (vec_ < 4) { LAS float* d_ = rb_ + t_ * 384 + (vec_ >> 1) * 128 + (e0_ >> 1) * 4 + (vec_ & 1) * 2; \
                *(LAS f32x2*)(d_) = (f32x2){f0, f1}; *(LAS f32x2*)(d_ + 4) = (f32x2){f2, f3}; *(LAS f32x2*)(d_ + 8) = (f32x2){f4, f5}; *(LAS f32x2*)(d_ + 12) = (f32x2){f6, f7}; } \
            else { LAS f32x4* d_ = (LAS f32x4*)(rb_ + t_ * 384 + (vec_ == 4 ? 256 : 320) + e0_); d_[0] = (f32x4){f0, f1, f2, f3}; d_[1] = (f32x4){f4, f5, f6, f7}; } } } while (0)
#define RW_STORE_Y(cc) do { if (tl < 32) { const LAS float* yb_ = ypart + ((cc) & 1) * 4096; const int t_ = tl >> 1, pr_ = tl & 1; const int l_ = (cc) * SCH + t_; \
        const LAS f32x4* q_ = (const LAS f32x4*)(yb_ + t_ * 128 + pr_ * 64); f32x4 sa_ = q_[0], sb_ = q_[8]; \
        _Pragma("unroll") for (int k_ = 1; k_ < 8; ++k_) { sa_ = sa_ + q_[k_]; sb_ = sb_ + q_[8 + k_]; } \
        *(unsigned*)(y0 + (size_t)(b * T + PADR + l_) * RW_W + h * 64 + q8 * 4 + 2 * pr_) = pk2((sa_.x + sa_.y) + (sa_.z + sa_.w), (sb_.x + sb_.y) + (sb_.z + sb_.w)); } } while (0)
    if (isld) {
        RW_ISSUE(0); asm volatile("s_waitcnt vmcnt(0)" ::: "memory"); RW_CONVERT(0);
        RW_ISSUE(1); RW_ISSUE(2);
    }
    RW_BAR();
    for (int c = 0; c < NCH; ++c) {
        if (isld) {
            if (c + 2 < NCH) { asm volatile("s_waitcnt vmcnt(3)" ::: "memory"); RW_CONVERT(c + 1); }
            else if (c + 1 < NCH) { asm volatile("s_waitcnt vmcnt(0)" ::: "memory"); RW_CONVERT(c + 1); }
            if (c > 0 && !dry) RW_STORE_Y(c - 1);
            if (c + 3 < NCH) RW_ISSUE(c + 3);
        } else if (dry != 1 && wave < 2) {
            const unsigned ba = (unsigned)(uintptr_t)(ring + (c & 1) * 6144) + i32 * 16, ca = (unsigned)(uintptr_t)(ring + (c & 1) * 6144) + 1024 + i32 * 8,
                           va = (unsigned)(uintptr_t)(ring + (c & 1) * 6144) + 1280 + (q8 * 4 + rloc) * 4, ya = (unsigned)(uintptr_t)(ypart + (c & 1) * 4096 + rloc * 32 + i32);
            f32x4 OA[4], OB[4]; f32x2 OC[4]; float OV[4];
            OC[3] = (f32x2){0.f, 0.f};
#define RW_FETCH(tt, sl) asm volatile("ds_read_b128 %0, %4 offset:%c7\n\tds_read_b128 %1, %4 offset:%c8\n\tds_read_b64 %2, %5 offset:%c7\n\tds_read_b32 %3, %6 offset:%c7" \
                : "=&v"(OA[sl]), "=&v"(OB[sl]), "=&v"(OC[sl]), "=&v"(OV[sl]) : "v"(ba), "v"(ca), "v"(va), "i"((tt) * 1536), "i"((tt) * 1536 + 512) : "memory")
            RW_FETCH(0, 0); RW_FETCH(1, 1);
            float p, p2, y;
#define RW_STEP(t, WAITN, YL1, YL2, YW, FETCHL) asm volatile( \
                "s_waitcnt lgkmcnt(" WAITN ")\n\t" \
                "v_mul_f32 %[p], %[s0], %[kk0]\n\t" \
                "v_fmac_f32 %[p], %[s1], %[kk1]\n\t" \
                YL1 "\n\t" YL2 "\n\t" \
                XL8 "\n\t" \
                "v_fmac_f32 %[s0], %[s0], %[om0]\n\t" \
                "v_fmac_f32 %[s1], %[s1], %[om1]\n\t" \
                XL4 "\n\t" \
                "v_fmac_f32 %[s0], %[vf], %[kv0]\n\t" \
                "v_fmac_f32 %[s1], %[vf], %[kv1]\n\t" \
                XL2 "\n\t" \
                YW "\n\t" \
                FETCHL \
                : [p] "=&v"(p), [p2] "=&v"(p2), [y] "=&v"(y), [s0] "+v"(s0), [s1] "+v"(s1), [nA] "=&v"(OA[((t) + 2) & 3]), [nB] "=&v"(OB[((t) + 2) & 3]), [nC] "=&v"(OC[((t) + 2) & 3]), [nV] "=&v"(OV[((t) + 2) & 3]) \
                : [kk0] "v"(OA[(t) & 3].x), [kk1] "v"(OA[(t) & 3].y), [om0] "v"(OA[(t) & 3].z), [om1] "v"(OA[(t) & 3].w), [bb0] "v"(OB[(t) & 3].x), [bb1] "v"(OB[(t) & 3].y), [kv0] "v"(OB[(t) & 3].z), [kv1] "v"(OB[(t) & 3].w), \
                  [vf] "v"(OV[(t) & 3]), [rp0] "v"(OC[((t) + 3) & 3].x), [rp1] "v"(OC[((t) + 3) & 3].y), [ba] "v"(ba), [ca] "v"(ca), [va] "v"(va), [ya] "v"(ya), \
                  [oa] "i"(((t) + 2) * 1536), [ob] "i"(((t) + 2) * 1536 + 512), [oy] "i"(((t) - 1) * 512) : "memory")
#define RW_YL1 "v_mul_f32 %[y], %[s0], %[rp0]"
#define RW_YL2 "v_fmac_f32 %[y], %[s1], %[rp1]"
#define RW_YW  "ds_write_b32 %[ya], %[y] offset:%c[oy]"
#define RW_NOP "s_nop 0"
#define RW_TAIL_F "ds_read_b128 %[nA], %[ba] offset:%c[oa]\n\t" \
                XL1 "\n\t" \
                "ds_read_b128 %[nB], %[ba] offset:%c[ob]\n\t" \
                "ds_read_b64 %[nC], %[ca] offset:%c[oa]\n\t" \
                "v_mov_b32 %[p2], %[p]\n\t" \
                "ds_read_b32 %[nV], %[va] offset:%c[oa]\n\t" \
                "s_nop 0\n\t" \
                XSW "\n\t" \
                "v_add_f32 %[p], %[p], %[p2]\n\t" \
                "v_fmac_f32 %[s0], %[p], %[bb0]\n\t" \
                "v_fmac_f32 %[s1], %[p], %[bb1]"
#define RW_TAIL_N "s_nop 0\n\t" \
                XL1 "\n\t" \
                "s_nop 1\n\t" \
                "v_mov_b32 %[p2], %[p]\n\t" \
                "s_nop 1\n\t" \
                XSW "\n\t" \
                "v_add_f32 %[p], %[p], %[p2]\n\t" \
                "v_fmac_f32 %[s0], %[p], %[bb0]\n\t" \
                "v_fmac_f32 %[s1], %[p], %[bb1]"
#define RW_ALLSTEPS() do { \
            RW_STEP(0, "4", RW_NOP, RW_NOP, RW_NOP, RW_TAIL_F); \
            RW_STEP(1, "4", RW_YL1, RW_YL2, RW_YW, RW_TAIL_F); \
            RW_STEP(2, "5", RW_YL1, RW_YL2, RW_YW, RW_TAIL_F);  RW_STEP(3, "5", RW_YL1, RW_YL2, RW_YW, RW_TAIL_F);  RW_STEP(4, "5", RW_YL1, RW_YL2, RW_YW, RW_TAIL_F); \
            RW_STEP(5, "5", RW_YL1, RW_YL2, RW_YW, RW_TAIL_F);  RW_STEP(6, "5", RW_YL1, RW_YL2, RW_YW, RW_TAIL_F);  RW_STEP(7, "5", RW_YL1, RW_YL2, RW_YW, RW_TAIL_F); \
            RW_STEP(8, "5", RW_YL1, RW_YL2, RW_YW, RW_TAIL_F);  RW_STEP(9, "5", RW_YL1, RW_YL2, RW_YW, RW_TAIL_F);  RW_STEP(10, "5", RW_YL1, RW_YL2, RW_YW, RW_TAIL_F); \
            RW_STEP(11, "5", RW_YL1, RW_YL2, RW_YW, RW_TAIL_F); RW_STEP(12, "5", RW_YL1, RW_YL2, RW_YW, RW_TAIL_F); RW_STEP(13, "5", RW_YL1, RW_YL2, RW_YW, RW_TAIL_F); \
            RW_STEP(14, "5", RW_YL1, RW_YL2, RW_YW, RW_TAIL_N); \
            RW_STEP(15, "1", RW_YL1, RW_YL2, RW_YW, RW_TAIL_N); \
            asm volatile("v_mul_f32 %[y], %[s0], %[r0]\n\tv_fmac_f32 %[y], %[s1], %[r1]\n\tds_write_b32 %[ya], %[y] offset:7680" : [y] "=&v"(y) : [s0] "v"(s0), [s1] "v"(s1), [r0] "v"(OC[3].x), [r1] "v"(OC[3].y), [ya] "v"(ya) : "memory"); \
 } while (0)
#ifdef SCAN_PROBE_NOXL
            if (dry == 2) {
#define XL8 "v_add_f32 %[p], %[p], %[p]"
#define XL4 "v_add_f32 %[p], %[p], %[p]"
#define XL2 "v_add_f32 %[p], %[p], %[p]"
#define XL1 "v_add_f32 %[p], %[p], %[p]"
#define XSW "v_add_f32 %[p], %[p], %[p2]"
                RW_ALLSTEPS();
#undef XL8
#undef XL4
#undef XL2
#undef XL1
#undef XSW
            } else
#endif
            {
#define XL8 "v_add_f32_dpp %[p], %[p], %[p] row_ror:8 row_mask:0xf bank_mask:0xf bound_ctrl:1"
#define XL4 "v_add_f32_dpp %[p], %[p], %[p] row_ror:4 row_mask:0xf bank_mask:0xf bound_ctrl:1"
#define XL2 "v_add_f32_dpp %[p], %[p], %[p] row_ror:2 row_mask:0xf bank_mask:0xf bound_ctrl:1"
#define XL1 "v_add_f32_dpp %[p], %[p], %[p] row_ror:1 row_mask:0xf bank_mask:0xf bound_ctrl:1"
#define XSW "v_permlane16_swap_b32 %[p], %[p2]"
                RW_ALLSTEPS();
            }
#undef RW_ALLSTEPS
#undef RW_STEP
#undef XL8
#undef XL4
#undef XL2
#undef XL1
#undef XSW
#undef RW_YL1
#undef RW_YL2
#undef RW_YW
#undef RW_NOP
#undef RW_TAIL_F
#undef RW_TAIL_N
#undef RW_FETCH
        }
        RW_BAR();
    }
    if (isld && !dry) RW_STORE_Y(NCH - 1);
    asm volatile("s_waitcnt vmcnt(0) lgkmcnt(0)\n\ts_barrier" ::: "memory");
#undef RW_STORE_Y
#undef RW_ISSUE
#undef RW_CONVERT
#undef RW_BAR
}

__device__ __forceinline__ int crow(int r, int hi) { return (r & 3) + 8 * (r >> 2) + 4 * hi; }
__device__ __forceinline__ void glds16(const void* gsrc, unsigned lds_dst) { unsigned keep;
    asm volatile("s_mov_b32 %0, m0\n\ts_mov_b32 m0, %2\n\ts_nop 0\n\tglobal_load_lds_dwordx4 %1, off\n\ts_mov_b32 m0, %0" : "=&s"(keep) : "v"(gsrc), "s"(lds_dst) : "memory"); }
__device__ __forceinline__ void glds4(const void* gsrc, unsigned lds_dst) { unsigned keep;
    asm volatile("s_mov_b32 %0, m0\n\ts_mov_b32 m0, %2\n\ts_nop 0\n\tglobal_load_lds_dword %1, off\n\ts_mov_b32 m0, %0" : "=&s"(keep) : "v"(gsrc), "s"(lds_dst) : "memory"); }
typedef LAS const char* lds_cptr;
constexpr int FX_K = 0, FX_V = 24576, FX_WS = 49152, FX_OST = 51200, FX_FLG = 83968, FX_KB = 84224  ;

__device__ __forceinline__ void fx_pv(f32x16* o, int vb, bf16x8 pa0, bf16x8 pa1, bf16x8 pa2, bf16x8 pa3) {
#pragma unroll
    for (int d0 = 0; d0 < 2; ++d0) { s16x4 lo[4], hi[4];
#pragma unroll
        for (int ks = 0; ks < 4; ++ks) {
            asm volatile("ds_read_b64_tr_b16 %0,%1 offset:%c2" : "=&v"(lo[ks]) : "v"(vb), "i"(d0 * 4096 + ks * 1024) : "memory");
            asm volatile("ds_read_b64_tr_b16 %0,%1 offset:%c2" : "=&v"(hi[ks]) : "v"(vb), "i"(d0 * 4096 + ks * 1024 + 512) : "memory"); }
        asm volatile("s_waitcnt lgkmcnt(0)" ::: "memory"); __builtin_amdgcn_sched_barrier(0);
#define FX_PK(k) (bf16x8){lo[k][0], lo[k][1], lo[k][2], lo[k][3], hi[k][0], hi[k][1], hi[k][2], hi[k][3]}
        o[d0] = __builtin_amdgcn_mfma_f32_32x32x16_bf16(pa0, FX_PK(0), o[d0], 0, 0, 0);
        o[d0] = __builtin_amdgcn_mfma_f32_32x32x16_bf16(pa1, FX_PK(1), o[d0], 0, 0, 0);
        o[d0] = __builtin_amdgcn_mfma_f32_32x32x16_bf16(pa2, FX_PK(2), o[d0], 0, 0, 0);
        o[d0] = __builtin_amdgcn_mfma_f32_32x32x16_bf16(pa3, FX_PK(3), o[d0], 0, 0, 0);
#undef FX_PK
    }
}
__device__ __forceinline__ float halves_max(float m) { auto rr = __builtin_amdgcn_permlane32_swap(__float_as_uint(m), __float_as_uint(m), false, false); return fmaxf(__uint_as_float(rr[0]), __uint_as_float(rr[1])); }
__device__ __forceinline__ float halves_sum(float m) { auto rr = __builtin_amdgcn_permlane32_swap(__float_as_uint(m), __float_as_uint(m), false, false); return __uint_as_float(rr[0]) + __uint_as_float(rr[1]); }

constexpr float ATT_EXIT = -40.0f;
template <int KIND>
__device__ __forceinline__ void attn_unit(const ArgsL& a, Frame& F, int b, int h, int qb, float bound) {
    const int lane = F.lane, wave = F.wave, r32 = lane & 31, hi = lane >> 5;
    LAS unsigned char* lds = F.lds;
    const bf16_t* QKV = (const bf16_t*)(a.ws + WS_QKV);
    const size_t rowbase = (size_t)b * T;
    const int p0 = qb * 256;
    constexpr int QC = KIND ? 0 : 960, KC = KIND ? 320 : 1280, VC = KIND ? 640 : 1600;
    const bf16_t* Qw = QKV + (rowbase + p0 + wave * 32) * QKV_W + QC + h * 64;
    const bf16_t* Kh = QKV + rowbase * QKV_W + KC + h * 64;
    const bf16_t* Vh = QKV + rowbase * QKV_W + VC + h * 64;
    const float* kbias = (const float*)(a.ws + WS_KB2) + (size_t)(b * FX_H + h) * KBP;
    const unsigned lds0 = (unsigned)(uintptr_t)lds;
    bf16x8 qr[4];
#pragma unroll
    for (int d0 = 0; d0 < 4; ++d0) qr[d0] = *(const bf16x8*)(Qw + (size_t)r32 * QKV_W + d0 * 16 + hi * 8);
    const int qp = p0 + wave * 32 + r32;
    const bool qvalid = (qp >= PADR) && (qp < T);
    const int plast = (p0 + 255) < (T - 1) ? (p0 + 255) : (T - 1);
    const int jlast = plast >> 6, jfirst = PADR >> 6;
    const int jw = (p0 + wave * 32 + 31) >> 6;
    const bf16_t* ksrc = Kh + (size_t)lane * QKV_W + wave * 8;
    const bf16_t* vsrc = Vh + (size_t)(16 * (wave & 3) + (lane >> 2)) * QKV_W + (wave >> 2) * 32 + (lane & 3) * 8;
    const unsigned kdst = lds0 + FX_K + wave * 1024, vdst = lds0 + FX_V + wave * 1024;
#define FX_DMA(j, slot) do { glds16(ksrc + (size_t)(j) * 64 * QKV_W, (unsigned)__builtin_amdgcn_readfirstlane(kdst + (slot) * 8192)); \
                             glds16(vsrc + (size_t)(j) * 64 * QKV_W, (unsigned)__builtin_amdgcn_readfirstlane(vdst + (slot) * 8192)); \
                             if (KIND == 0) glds4(kbias + 64 * (j) + lane, (unsigned)__builtin_amdgcn_readfirstlane(lds0 + FX_KB + (slot) * 2048 + wave * 256)); } while (0)
    const int vb0 = (int)(lds0 + FX_V) + ((lane >> 4) & 1) * 32 + (lane & 3) * 8 + (4 * hi + ((lane & 15) >> 2)) * 64;
    const lds_cptr kp0 = (lds_cptr)lds + FX_K + hi * 1024 + r32 * 16;
    LAS float* wsf = (LAS float*)(lds + FX_WS) + wave * 64;
    LAS float* flg = (LAS float*)(lds + FX_FLG);
    float m_run = KIND ? 0.f : -1.0e30f, l_run = 0.f;
    f32x16 o[2]; o[0] = f32x16{}; o[1] = f32x16{};
    asm volatile("" : "+v"(qr[0]), "+v"(qr[1]), "+v"(qr[2]), "+v"(qr[3]));
    int slot = 0;
    FX_DMA(jlast, 0);
    if (jlast > jfirst) FX_DMA(jlast - 1, 1);
    for (int j = jlast; j >= jfirst; --j) {
        if (j > jfirst) { if (KIND == 0) asm volatile("s_waitcnt vmcnt(3) lgkmcnt(0)\n\ts_barrier" ::: "memory"); else asm volatile("s_waitcnt vmcnt(2) lgkmcnt(0)\n\ts_barrier" ::: "memory"); }
        else asm volatile("s_waitcnt vmcnt(0) lgkmcnt(0)\n\ts_barrier" ::: "memory");
        if (j < jlast) {
            const LAS float* fl = flg + ((j + 1) & 1) * 16;
            const f32x4 fa = *(const LAS f32x4*)(fl), fb = *(const LAS f32x4*)(fl + 4);
            bool stop;
            if constexpr (KIND == 0) {
                const float mmin = fminf(fminf(fminf(fa.x, fa.y), fminf(fa.z, fa.w)), fminf(fminf(fb.x, fb.y), fminf(fb.z, fb.w)));
                stop = (bound + fl[8] - mmin) < ATT_EXIT;
            } else {
                const float mmax = fmaxf(fmaxf(fmaxf(fa.x, fa.y), fmaxf(fa.z, fa.w)), fmaxf(fmaxf(fb.x, fb.y), fmaxf(fb.z, fb.w)));
                stop = mmax < ATT_EXIT;
            }
            if (stop) break;
        }
        { const int s2 = slot + 2 >= 3 ? slot - 1 : slot + 2; if (j - 2 >= jfirst) FX_DMA(j - 2, s2); }
        if (j <= jw) {
            f32x16 s0v = f32x16{}, s1v = f32x16{};
            const lds_cptr kp = kp0 + slot * 8192;
#pragma unroll
            for (int d0 = 0; d0 < 4; ++d0) {
                const bf16x8 b0 = *(const LAS bf16x8*)(kp + d0 * 2048);
                const bf16x8 b1 = *(const LAS bf16x8*)(kp + d0 * 2048 + 512);
                s0v = __builtin_amdgcn_mfma_f32_32x32x16_bf16(b0, qr[d0], s0v, 0, 0, 0);
                s1v = __builtin_amdgcn_mfma_f32_32x32x16_bf16(b1, qr[d0], s1v, 0, 0, 0);
            }
            const bool edge = (64 * j + 63 >= p0 + wave * 32) || (64 * j < PADR);
            if constexpr (KIND == 0) {
                const LAS float* kbj = (const LAS float*)(lds + FX_KB + slot * 2048 + wave * 256) + 4 * hi;
#pragma unroll
                for (int g = 0; g < 4; ++g) { const f32x4 t0 = *(const LAS f32x4*)(kbj + 8 * g), t1 = *(const LAS f32x4*)(kbj + 32 + 8 * g);
                    s0v[4 * g] += t0.x; s0v[4 * g + 1] += t0.y; s0v[4 * g + 2] += t0.z; s0v[4 * g + 3] += t0.w;
                    s1v[4 * g] += t1.x; s1v[4 * g + 1] += t1.y; s1v[4 * g + 2] += t1.z; s1v[4 * g + 3] += t1.w; }
                if (edge) {
#pragma unroll
                    for (int r = 0; r < 16; ++r) { const int key = 64 * j + crow(r, hi);
                        if (key > qp || key < PADR) s0v[r] = -INFINITY;
                        if (key + 32 > qp || key + 32 < PADR) s1v[r] = -INFINITY; }
                }
                float rm = fmaxf(s0v[0], s1v[0]);
#pragma unroll
                for (int r = 1; r < 16; ++r) rm = fmaxf(rm, fmaxf(s0v[r], s1v[r]));
                rm = halves_max(rm);
                const float m_new = fmaxf(m_run, rm);
                const float f = __builtin_amdgcn_exp2f(m_run - m_new);
                m_run = m_new;
                float rs = 0.f;
#pragma unroll
                for (int r = 0; r < 16; ++r) { s0v[r] = __builtin_amdgcn_exp2f(s0v[r] - m_new); s1v[r] = __builtin_amdgcn_exp2f(s1v[r] - m_new); rs += s0v[r] + s1v[r]; }
                rs = halves_sum(rs);
                l_run = l_run * f + rs;
                if (!__all(f == 1.0f)) {
                    if (hi == 0) wsf[r32] = f;
                    LDS_WAIT();
#pragma unroll
                    for (int d_ = 0; d_ < 2; ++d_)
#pragma unroll
                        for (int r = 0; r < 16; ++r) o[d_][r] *= wsf[crow(r, hi)];
                }
            } else {
                f32x16 l0, l1;
#pragma unroll
                for (int r = 0; r < 16; ++r) {
                    const float z0 = s0v[r], z1 = s1v[r];
                    float a0 = -(fmaxf(z0, 0.f) + __builtin_amdgcn_logf(1.f + __builtin_amdgcn_exp2f(-fabsf(z0))));
                    float a1 = -(fmaxf(z1, 0.f) + __builtin_amdgcn_logf(1.f + __builtin_amdgcn_exp2f(-fabsf(z1))));
                    if (edge) { const int key = 64 * j + crow(r, hi);
                        if (key >= qp || key < PADR) { a0 = 0.f; s0v[r] = -INFINITY; }
                        if (key + 32 >= qp || key + 32 < PADR) { a1 = 0.f; s1v[r] = -INFINITY; } }
                    l0[r] = a0; l1[r] = a1;
                }
                float A[8], SA[9], SO[9];
#pragma unroll
                for (int g = 0; g < 4; ++g) { A[g] = (l0[4 * g] + l0[4 * g + 1]) + (l0[4 * g + 2] + l0[4 * g + 3]); A[4 + g] = (l1[4 * g] + l1[4 * g + 1]) + (l1[4 * g + 2] + l1[4 * g + 3]); }
                SA[8] = 0.f; SO[8] = 0.f;
#pragma unroll
                for (int g = 7; g >= 0; --g) SA[g] = A[g] + SA[g + 1];
#pragma unroll
                for (int g = 0; g < 8; ++g) { auto rr = __builtin_amdgcn_permlane32_swap(__float_as_uint(SA[g]), __float_as_uint(SA[g]), false, false); SO[g] = __uint_as_float(hi ? rr[0] : rr[1]); }
                const float R = m_run;
#pragma unroll
                for (int g = 0; g < 8; ++g) {
                    const float E = SA[g + 1] + (hi ? SO[g + 1] : SO[g]) + R;
                    if (g < 4) { float t = E;
                        s0v[4 * g + 3] = __builtin_amdgcn_exp2f(s0v[4 * g + 3] + l0[4 * g + 3] + t); t += l0[4 * g + 3];
                        s0v[4 * g + 2] = __builtin_amdgcn_exp2f(s0v[4 * g + 2] + l0[4 * g + 2] + t); t += l0[4 * g + 2];
                        s0v[4 * g + 1] = __builtin_amdgcn_exp2f(s0v[4 * g + 1] + l0[4 * g + 1] + t); t += l0[4 * g + 1];
                        s0v[4 * g + 0] = __builtin_amdgcn_exp2f(s0v[4 * g + 0] + l0[4 * g + 0] + t);
                    } else { const int q = g - 4; float t = E;
                        s1v[4 * q + 3] = __builtin_amdgcn_exp2f(s1v[4 * q + 3] + l1[4 * q + 3] + t); t += l1[4 * q + 3];
                        s1v[4 * q + 2] = __builtin_amdgcn_exp2f(s1v[4 * q + 2] + l1[4 * q + 2] + t); t += l1[4 * q + 2];
                        s1v[4 * q + 1] = __builtin_amdgcn_exp2f(s1v[4 * q + 1] + l1[4 * q + 1] + t); t += l1[4 * q + 1];
                        s1v[4 * q + 0] = __builtin_amdgcn_exp2f(s1v[4 * q + 0] + l1[4 * q + 0] + t);
                    }
                }
                m_run = R + SA[0] + SO[0];
            }
            u32x4 pw0, pw1, pw2, pw3;
            pw0 = (u32x4){pk2(s0v[0], s0v[1]), pk2(s0v[2], s0v[3]), pk2(s0v[4], s0v[5]), pk2(s0v[6], s0v[7])};
            pw1 = (u32x4){pk2(s0v[8], s0v[9]), pk2(s0v[10], s0v[11]), pk2(s0v[12], s0v[13]), pk2(s0v[14], s0v[15])};
            pw2 = (u32x4){pk2(s1v[0], s1v[1]), pk2(s1v[2], s1v[3]), pk2(s1v[4], s1v[5]), pk2(s1v[6], s1v[7])};
            pw3 = (u32x4){pk2(s1v[8], s1v[9]), pk2(s1v[10], s1v[11]), pk2(s1v[12], s1v[13]), pk2(s1v[14], s1v[15])};
            fx_pv(o, vb0 + slot * 8192, __builtin_bit_cast(bf16x8, pw0), __builtin_bit_cast(bf16x8, pw1), __builtin_bit_cast(bf16x8, pw2), __builtin_bit_cast(bf16x8, pw3));
        }
        float mm = qvalid ? m_run : (KIND ? -3.0e38f : 3.0e38f);
        if constexpr (KIND == 0) { mm = fminf(mm, dpp_f<0x128>(mm)); mm = fminf(mm, dpp_f<0x124>(mm)); mm = fminf(mm, dpp_f<0x122>(mm)); mm = fminf(mm, dpp_f<0x121>(mm));
            { auto sw = __builtin_amdgcn_permlane16_swap(__float_as_uint(mm), __float_as_uint(mm), false, false); mm = fminf(__uint_as_float(sw[0]), __uint_as_float(sw[1])); }
            { auto sw = __builtin_amdgcn_permlane32_swap(__float_as_uint(mm), __float_as_uint(mm), false, false); mm = fminf(__uint_as_float(sw[0]), __uint_as_float(sw[1])); } }
        else { mm = fmaxf(mm, dpp_f<0x128>(mm)); mm = fmaxf(mm, dpp_f<0x124>(mm)); mm = fmaxf(mm, dpp_f<0x122>(mm)); mm = fmaxf(mm, dpp_f<0x121>(mm));
            { auto sw = __builtin_amdgcn_permlane16_swap(__float_as_uint(mm), __float_as_uint(mm), false, false); mm = fmaxf(__uint_as_float(sw[0]), __uint_as_float(sw[1])); }
            { auto sw = __builtin_amdgcn_permlane32_swap(__float_as_uint(mm), __float_as_uint(mm), false, false); mm = fmaxf(__uint_as_float(sw[0]), __uint_as_float(sw[1])); } }
        if (lane == 0) { flg[(j & 1) * 16 + wave] = mm;
            if (KIND == 0 && wave == 0) flg[(j & 1) * 16 + 8] = *(const LAS float*)(lds + FX_KB + slot * 2048); }
        slot = slot == 2 ? 0 : slot + 1;
    }
    asm volatile("s_waitcnt vmcnt(0) lgkmcnt(0)\n\ts_barrier" ::: "memory");
    float rli[16];
    if constexpr (KIND == 0) {
        if (hi == 0) wsf[32 + r32] = l_run;
        LDS_WAIT();
#pragma unroll
        for (int r = 0; r < 16; ++r) rli[r] = __builtin_amdgcn_rcpf(wsf[32 + crow(r, hi)]);
    } else {
#pragma unroll
        for (int r = 0; r < 16; ++r) rli[r] = 1.0f;
    }
    bf16_t* Ow = (bf16_t*)(a.ws + WS_YCAT) + (rowbase + p0 + wave * 32) * YC_W + (KIND ? 384 : 768) + h * 64;
    {
        LAS bf16_t* stg = (LAS bf16_t*)(lds + FX_OST) + wave * 2048;
#pragma unroll
        for (int r = 0; r < 16; ++r) { const int orow = crow(r, hi);
#pragma unroll
            for (int d0 = 0; d0 < 2; ++d0) stg[orow * 64 + d0 * 32 + r32] = f2bf(o[d0][r] * rli[r]); }
        LDS_WAIT();
#pragma unroll
        for (int i = 0; i < 4; ++i) { const int row = i * 8 + (lane >> 3), ch = lane & 7; const u32x4 v = *(const LAS u32x4*)(stg + row * 64 + ch * 8);
            const int pr = p0 + wave * 32 + row;
            if (pr >= PADR && pr < T) *(u32x4*)(Ow + (size_t)row * YC_W + ch * 8) = v; }
    }
    asm volatile("s_waitcnt lgkmcnt(0)\n\ts_barrier" ::: "memory");
#undef FX_DMA
}


constexpr int CK = 64, NCK = 257, CKB = 40960, CB_ZF = 147456  ;
static_assert(LPADDED == CK * NCK, "padded steps");
__device__ __forceinline__ int swz(int row, int chunk) { return row * 128 + ((chunk ^ (row & 7)) << 4); }
__device__ __forceinline__ void ck_mm(f32x16& acc, LAS unsigned char* A, LAS unsigned char* Bt, int m0, int n0, int r32, int hi) {
#pragma unroll
    for (int ks = 0; ks < 4; ++ks) {
        const bf16x8 av = *(const LAS bf16x8*)(A + swz(m0 + r32, 2 * ks + hi));
        const bf16x8 bv = *(const LAS bf16x8*)(Bt + swz(n0 + r32, 2 * ks + hi));
        acc = __builtin_amdgcn_mfma_f32_32x32x16_bf16(av, bv, acc, 0, 0, 0);
    }
}
__device__ __forceinline__ void ck_store_t(LAS unsigned char* dst, const f32x16& acc, int m0, int n0, int r32, int hi) {
#pragma unroll
    for (int g = 0; g < 4; ++g) { const u32x2 w = {pk2(acc[4 * g], acc[4 * g + 1]), pk2(acc[4 * g + 2], acc[4 * g + 3])};
        *(LAS u32x2*)(dst + swz(n0 + r32, (m0 >> 3) + g) + hi * 8) = w; }
}
constexpr int CA_KAP = 0, CA_BET = 8192, CA_CHI = 16384, CA_RHO = 24576, CA_VMT = 32768, CA_BHT = 40960, CA_KHT = 49152, CA_AK = 57344, CA_RB = 65536, CA_RK = 73728,
              CA_AB = 81920  , CA_RHS = 98304  , CA_G64 = MISC_OFF + 2048  , CA_SCR = MISC_OFF + 4096  ;

#ifndef CA_STAGES
#define CA_STAGES 15
#endif
__device__ __forceinline__ void phase_chunkA(const ArgsL& a, Frame& F, const bool dry = false) {
    const int wave = F.wave;
    LAS unsigned char* L = F.lds;
    u32x4 pre6[6];
    for (int id = F.bx; id < 12 * NCK; id += (int)gridDim.x) {
        int tid = F.tid, lane, r32, hi;
#define CK_FRESH() do { asm volatile("" : "+v"(tid)); lane = tid & 63; r32 = lane & 31; hi = lane >> 5; } while (0)
        CK_FRESH();
        const int bh = id / NCK, c = id - bh * NCK;
        unsigned char* blk = a.ws + WS_RW + ((size_t)bh * LPADDED + (size_t)c * CK) * 768;
        {
            if (id == F.bx) {
#pragma unroll
                for (int q6 = 0; q6 < 6; ++q6) pre6[q6] = *(const u32x4*)(blk + (size_t)(tid + q6 * NTHR) * 16);
            }
#pragma unroll
            for (int q6 = 0; q6 < 6; ++q6) *(LAS u32x4*)(L + CA_AB + (tid + q6 * NTHR) * 16) = pre6[q6];
            __syncthreads();
            const int k = tid & 63, tq = tid >> 6;
            const LAS _Float16* src = (const LAS _Float16*)(L + CA_AB) + (tq * 8) * 384 + k;
            float kk[8], w[8], bb[8], kp[8], rr[8], vv[8];
#pragma unroll
            for (int e = 0; e < 8; ++e) { kk[e] = (float)src[e * 384]; w[e] = 1.f + (float)src[e * 384 + 64]; bb[e] = -(float)src[e * 384 + 128];
                kp[e] = (float)src[e * 384 + 192]; rr[e] = (float)src[e * 384 + 256]; vv[e] = (float)src[e * 384 + 320]; }
            float g[8]; g[0] = w[0];
#pragma unroll
            for (int e = 1; e < 8; ++e) g[e] = g[e - 1] * w[e];
            LAS float* scr = (LAS float*)(L + CA_SCR);
            scr[tq * 64 + k] = g[7];
            __syncthreads();
            {
                const int idn = id + (int)gridDim.x;
                if (idn < 12 * NCK) { const int bhn = idn / NCK, cn = idn - bhn * NCK; const unsigned char* bn_ = a.ws + WS_RW + ((size_t)bhn * LPADDED + (size_t)cn * CK) * 768;
#pragma unroll
                    for (int q6 = 0; q6 < 6; ++q6) pre6[q6] = *(const u32x4*)(bn_ + (size_t)(tid + q6 * NTHR) * 16); }
            }
            float pre = 1.f, tot = 1.f;
#pragma unroll
            for (int q = 0; q < 8; ++q) { const float s = scr[q * 64 + k]; if (q < tq) pre *= s; tot *= s; }
            if (tq == 0) ((LAS float*)(L + CA_G64))[k] = tot;
            unsigned bh4[4], kh4[4], vm4[4];
            float Gp = pre;
#pragma unroll
            for (int e = 0; e < 8; ++e) {
                const int t = tq * 8 + e; const float G = pre * g[e], iG = __builtin_amdgcn_rcpf(G);
                const float kap = kk[e] * Gp, bet = bb[e] * iG, chi = kp[e] * iG, rho = rr[e] * G;
                const int o = swz(t, k >> 3) + (k & 7) * 2;
                *(LAS unsigned short*)(L + CA_KAP + o) = f2bf(kap); *(LAS unsigned short*)(L + CA_BET + o) = f2bf(bet);
                *(LAS unsigned short*)(L + CA_CHI + o) = f2bf(chi); *(LAS unsigned short*)(L + CA_RHO + o) = f2bf(rho);
                ((LAS float*)(L + CA_RHS))[t * 128 + k] = kap;
                const float bhv = bet * tot, khv = chi * tot;
                if (e & 1) { bh4[e >> 1] |= (unsigned)f2bf(bhv) << 16; kh4[e >> 1] |= (unsigned)f2bf(khv) << 16; vm4[e >> 1] |= (unsigned)f2bf(vv[e]) << 16; }
                else { bh4[e >> 1] = f2bf(bhv); kh4[e >> 1] = f2bf(khv); vm4[e >> 1] = f2bf(vv[e]); }
                Gp = G;
            }
            *(LAS u32x4*)(L + CA_BHT + swz(k, tq)) = (u32x4){bh4[0], bh4[1], bh4[2], bh4[3]};
            *(LAS u32x4*)(L + CA_KHT + swz(k, tq)) = (u32x4){kh4[0], kh4[1], kh4[2], kh4[3]};
            *(LAS u32x4*)(L + CA_VMT + swz(k, tq)) = (u32x4){vm4[0], vm4[1], vm4[2], vm4[3]};
        }
        __syncthreads();
        CK_FRESH();
        if (!dry || (CA_STAGES & 2)) {
            const int p = wave & 3, nb = wave >> 2;
            LAS unsigned char* Am = L + ((p & 1) ? CA_CHI : CA_BET);
            LAS unsigned char* Bm = L + ((p & 2) ? CA_RHO : CA_KAP);
#pragma unroll
            for (int mb = 0; mb < 2; ++mb) {
                f32x16 acc = f32x16{};
                if (!(mb == 1 && nb == 0)) ck_mm(acc, Am, Bm, mb * 32, nb * 32, r32, hi);
                const int t = nb * 32 + r32;
#pragma unroll
                for (int i = 0; i < 16; ++i) { const int j = mb * 32 + crow(i, hi); const bool keep = (p & 2) ? (j <= t) : (j < t); if (!keep) acc[i] = 0.f; }
                if (p == 0) {
#pragma unroll
                    for (int gq = 0; gq < 4; ++gq) { LAS float* ab_ = (LAS float*)(L + CA_AB) + t * 64 + (mb * 8 + 2 * gq + hi);
                        ab_[0] = acc[4 * gq]; ab_[16] = acc[4 * gq + 1]; ab_[32] = acc[4 * gq + 2]; ab_[48] = acc[4 * gq + 3]; }
                } else ck_store_t(L + (p == 1 ? CA_AK : p == 2 ? CA_RB : CA_RK), acc, mb * 32, nb * 32, r32, hi);
            }
        }
        __syncthreads();
        CK_FRESH();
        if (wave < 4 && (!dry || (CA_STAGES & 2))) {
            const int mb = wave >> 1, nb = wave & 1;
            f32x16 acc = f32x16{};
            ck_mm(acc, L + CA_AK, L + CA_VMT, mb * 32, nb * 32, r32, hi);
#pragma unroll
            for (int i = 0; i < 16; ++i) ((LAS float*)(L + CA_RHS))[(mb * 32 + crow(i, hi)) * 128 + 64 + nb * 32 + r32] = acc[i];
        }
        __syncthreads();
        CK_FRESH();
        if (!dry || (CA_STAGES & 4)) {
            const int col = tid >> 2, p = tid & 3;
            unsigned abv = (unsigned)(uintptr_t)(L + CA_AB) + p * 64; asm volatile("" : "+v"(abv));
            const LAS float* ab = (const LAS float*)(uintptr_t)abv;
            const LAS float* rhs = (const LAS float*)(L + CA_RHS) + col;
            float xo[16];
#pragma unroll
            for (int i = 0; i < 16; ++i) xo[i] = 0.f;
#pragma unroll
            for (int tg = 0; tg < 64; tg += 4) {
                f32x4 av[4][4]; float rv[4];
#pragma unroll
                for (int r = 0; r < 4; ++r) { rv[r] = rhs[(tg + r) * 128];
#pragma unroll
                    for (int i4 = 0; i4 < (tg + r + 15) / 16; ++i4) av[r][i4] = *(const LAS f32x4*)(ab + (tg + r) * 64 + 4 * i4); }
#pragma unroll
                for (int r = 0; r < 4; ++r) { const int t = tg + r;
                    float s0 = (p == 0) ? rv[r] : 0.f, s1 = 0.f;
#pragma unroll
                    for (int i4 = 0; i4 < (t + 15) / 16; ++i4) {
                        s0 -= av[r][i4].x * xo[4 * i4]; s1 -= av[r][i4].y * xo[4 * i4 + 1]; s0 -= av[r][i4].z * xo[4 * i4 + 2]; s1 -= av[r][i4].w * xo[4 * i4 + 3]; }
                    float sx = s0 + s1;
                    sx += dpp_f<0xB1>(sx);
                    sx += dpp_f<0x4E>(sx);
                    if ((t & 3) == p) xo[t >> 2] = sx;
                    asm volatile("" : "+v"(xo[t >> 2]));
                }
                __builtin_amdgcn_sched_barrier(0);
            }
            LAS unsigned char* dst = L + (col < 64 ? CA_KAP : CA_BET);
            const int rowc = col & 63;
#pragma unroll
            for (int i = 0; i < 16; ++i) { const int tt = 4 * i + p; *(LAS unsigned short*)(dst + swz(rowc, tt >> 3) + (tt & 7) * 2) = f2bf(-xo[i]); }
        }
        __syncthreads();
        CK_FRESH();
        if (!dry || (CA_STAGES & 8)) {
            const int ty = wave >> 1;
            LAS unsigned char* nW1 = L + CA_KAP; LAS unsigned char* nW2 = L + CA_BET;
#pragma unroll
            for (int qq = 0; qq < 2; ++qq) {
                const int q = (wave & 1) * 2 + qq, qa = q >> 1, qb = q & 1;
                f32x16 acc = f32x16{};
                if (ty == 0) {
                    const int t = qa * 32 + r32;
#pragma unroll
                    for (int gq = 0; gq < 4; ++gq) { const u32x2 rv = *(const LAS u32x2*)(L + CA_RHO + swz(t, qb * 4 + gq) + hi * 8);
                        acc[4 * gq] = bf_lo(rv.x); acc[4 * gq + 1] = bf_hi(rv.x); acc[4 * gq + 2] = bf_lo(rv.y); acc[4 * gq + 3] = bf_hi(rv.y); }
                    ck_mm(acc, nW1, L + CA_RB, qb * 32, qa * 32, r32, hi);
                } else if (ty == 1) {
                    ck_mm(acc, nW1, L + CA_BHT, qb * 32, qa * 32, r32, hi);
                    if (qa == qb) { const float g64 = ((const LAS float*)(L + CA_G64))[qa * 32 + r32];
#pragma unroll
                        for (int i = 0; i < 16; ++i) if (crow(i, hi) == r32) acc[i] += g64; }
                } else if (ty == 2) {
                    ck_mm(acc, L + CA_KHT, L + CA_VMT, qb * 32, qa * 32, r32, hi);
                    ck_mm(acc, L + CA_BHT, nW2, qb * 32, qa * 32, r32, hi);
                } else {
                    ck_mm(acc, L + CA_VMT, L + CA_RK, qa * 32, qb * 32, r32, hi);
                    ck_mm(acc, nW2, L + CA_RB, qa * 32, qb * 32, r32, hi);
                }
                if (dry) { float sink = acc[0] + acc[5] + acc[10] + acc[15]; asm volatile("" :: "v"(sink)); }
                else if (ty < 2) {
                    unsigned char* o = blk + (ty == 0 ? 8192 : 0) + (size_t)(((qa * 2 + qb) * 2) * 1024) + lane * 16;
#pragma unroll
                    for (int ks = 0; ks < 2; ++ks)
                        *(u32x4*)(o + ks * 1024) = (u32x4){pk2(acc[8 * ks], acc[8 * ks + 1]), pk2(acc[8 * ks + 2], acc[8 * ks + 3]), pk2(acc[8 * ks + 4], acc[8 * ks + 5]), pk2(acc[8 * ks + 6], acc[8 * ks + 7])};
                } else if (ty == 2) {
                    unsigned char* o = blk + 16384 + (qa * 2 + qb) * 4096 + lane * 16;
#pragma unroll
                    for (int g = 0; g < 4; ++g) *(f32x4*)(o + g * 1024) = (f32x4){acc[4 * g], acc[4 * g + 1], acc[4 * g + 2], acc[4 * g + 3]};
                } else {
                    unsigned char* o = blk + 32768 + (qa * 2 + qb) * 2048 + lane * 8;
#pragma unroll
                    for (int g = 0; g < 4; ++g) *(u32x2*)(o + g * 512) = (u32x2){pk2(acc[4 * g], acc[4 * g + 1]), pk2(acc[4 * g + 2], acc[4 * g + 3])};
                }
            }
        }
        __syncthreads();
    }
}

__device__ __forceinline__ void rwkv_chunkB(const ArgsL& a, Frame& F, int bh) {
    const int lane = F.lane, wave = F.wave, r32 = lane & 31, hi = lane >> 5;
    const int b = bh / RW_H, h = bh % RW_H;
    LAS unsigned char* L = F.lds;
    const unsigned char* base = a.ws + WS_RW + (size_t)bh * LPADDED * 768;
    bf16_t* y0 = (bf16_t*)(a.ws + WS_YCAT);
    const bool isld = (wave & 2) != 0; const int lw = (wave & 1) + ((wave >> 2) << 1);
    LAS unsigned char* yimg0 = L + 3 * CKB; LAS unsigned char* yimg1 = L + MISC_OFF + 8192;
    LAS unsigned char* zfb = L + CB_ZF;
#define CB_ISSUE(cc) do { const unsigned char* s_ = base + (size_t)(cc) * CK * 768 + (size_t)lw * 1024 + lane * 16; LAS unsigned char* d_ = L + ((cc) % 3) * CKB + lw * 1024; \
        _Pragma("unroll") for (int r_ = 0; r_ < 10; ++r_) __builtin_amdgcn_global_load_lds((const unsigned*)(s_ + r_ * 4096), (LAS unsigned*)(d_ + r_ * 4096), 16, 0, 0); } while (0)
#define CB_YOUT(cc) do { const LAS unsigned char* im_ = ((cc) & 1) ? yimg1 : yimg0; \
        _Pragma("unroll") for (int r_ = 0; r_ < 8; ++r_) { const int t_ = r_ * 8 + (lane >> 3), l_ = (cc) * CK + t_; const u32x4 v_ = *(const LAS u32x4*)(im_ + t_ * 128 + (((lane & 7) ^ (t_ & 7)) * 16)); \
            if (l_ < LTOK) *(u32x4*)(y0 + (size_t)(b * T + PADR + l_) * YC_W + h * 64 + (lane & 7) * 8) = v_; } } while (0)
    if (isld) { CB_ISSUE(0); CB_ISSUE(1); asm volatile("s_waitcnt vmcnt(10)" ::: "memory"); }
    bf16x8 zf[2][2];
#pragma unroll
    for (int q = 0; q < 4; ++q) zf[q >> 1][q & 1] = bf16x8{};
    if (wave < 2) {
#pragma unroll
        for (int q = 0; q < 4; ++q) *(LAS bf16x8*)(zfb + wave * 4096 + q * 1024 + lane * 16) = bf16x8{};
    }
    asm volatile("s_waitcnt lgkmcnt(0)\n\ts_barrier" ::: "memory");
    for (int c = 0; c < NCK; ++c) {
        const LAS unsigned char* S = L + (c % 3) * CKB;
        if (wave < 2) {
            const int vb = wave;
            f32x16 N0, N1;
            { const LAS unsigned char* n0 = S + 16384 + (vb * 2 + 0) * 4096 + lane * 16; const LAS unsigned char* n1 = S + 16384 + (vb * 2 + 1) * 4096 + lane * 16;
#pragma unroll
              for (int g = 0; g < 4; ++g) { const f32x4 u0 = *(const LAS f32x4*)(n0 + g * 1024), u1 = *(const LAS f32x4*)(n1 + g * 1024);
                  N0[4 * g] = u0.x; N0[4 * g + 1] = u0.y; N0[4 * g + 2] = u0.z; N0[4 * g + 3] = u0.w; N1[4 * g] = u1.x; N1[4 * g + 1] = u1.y; N1[4 * g + 2] = u1.z; N1[4 * g + 3] = u1.w; } }
#pragma unroll
            for (int kb2 = 0; kb2 < 2; ++kb2)
#pragma unroll
                for (int ks = 0; ks < 2; ++ks) {
                    const bf16x8 m0 = *(const LAS bf16x8*)(S + ((0 * 2 + kb2) * 2 + ks) * 1024 + lane * 16);
                    const bf16x8 m1 = *(const LAS bf16x8*)(S + ((1 * 2 + kb2) * 2 + ks) * 1024 + lane * 16);
                    N0 = __builtin_amdgcn_mfma_f32_32x32x16_bf16(m0, zf[kb2][ks], N0, 0, 0, 0);
                    N1 = __builtin_amdgcn_mfma_f32_32x32x16_bf16(m1, zf[kb2][ks], N1, 0, 0, 0);
                }
            LAS unsigned char* zo = zfb + ((c + 1) & 1) * 8192 + vb * 4096 + lane * 16;
#pragma unroll
            for (int ks = 0; ks < 2; ++ks) {
                zf[0][ks] = __builtin_bit_cast(bf16x8, (u32x4){pk2(N0[8 * ks], N0[8 * ks + 1]), pk2(N0[8 * ks + 2], N0[8 * ks + 3]), pk2(N0[8 * ks + 4], N0[8 * ks + 5]), pk2(N0[8 * ks + 6], N0[8 * ks + 7])});
                zf[1][ks] = __builtin_bit_cast(bf16x8, (u32x4){pk2(N1[8 * ks], N1[8 * ks + 1]), pk2(N1[8 * ks + 2], N1[8 * ks + 3]), pk2(N1[8 * ks + 4], N1[8 * ks + 5]), pk2(N1[8 * ks + 6], N1[8 * ks + 7])});
                *(LAS bf16x8*)(zo + (0 * 2 + ks) * 1024) = zf[0][ks]; *(LAS bf16x8*)(zo + (1 * 2 + ks) * 1024) = zf[1][ks];
            }
        } else if (isld) {
            if (wave == 6 && c > 0) CB_YOUT(c - 1);
            if (c + 2 < NCK) CB_ISSUE(c + 2);
            if (wave < 4) {
                const int vb = wave - 2;
                LAS unsigned char* yim = (c & 1) ? yimg1 : yimg0;
                const LAS unsigned char* zs = zfb + (c & 1) * 8192 + vb * 4096 + lane * 16;
                bf16x8 zq[2][2];
#pragma unroll
                for (int q = 0; q < 4; ++q) zq[q >> 1][q & 1] = *(const LAS bf16x8*)(zs + q * 1024);
#pragma unroll
                for (int tb = 0; tb < 2; ++tb) {
                    f32x16 acc;
                    const LAS unsigned char* yt = S + 32768 + (vb * 2 + tb) * 2048 + lane * 8;
#pragma unroll
                    for (int g = 0; g < 4; ++g) { const u32x2 w = *(const LAS u32x2*)(yt + g * 512); acc[4 * g] = bf_lo(w.x); acc[4 * g + 1] = bf_hi(w.x); acc[4 * g + 2] = bf_lo(w.y); acc[4 * g + 3] = bf_hi(w.y); }
#pragma unroll
                    for (int kb2 = 0; kb2 < 2; ++kb2)
#pragma unroll
                        for (int ks = 0; ks < 2; ++ks) { const bf16x8 pa = *(const LAS bf16x8*)(S + 8192 + ((tb * 2 + kb2) * 2 + ks) * 1024 + lane * 16);
                            acc = __builtin_amdgcn_mfma_f32_32x32x16_bf16(zq[kb2][ks], pa, acc, 0, 0, 0); }
                    const int t = tb * 32 + r32;
#pragma unroll
                    for (int g = 0; g < 4; ++g) { const u32x2 w = {pk2(acc[4 * g], acc[4 * g + 1]), pk2(acc[4 * g + 2], acc[4 * g + 3])};
                        *(LAS u32x2*)(yim + t * 128 + (((vb * 8 + 2 * g + hi) ^ (2 * (t & 7))) * 8)) = w; }
                }
            }
            if (c + 2 < NCK) asm volatile("s_waitcnt vmcnt(10)" ::: "memory"); else asm volatile("s_waitcnt vmcnt(0)" ::: "memory");
        }
        asm volatile("s_waitcnt lgkmcnt(0)\n\ts_barrier" ::: "memory");
    }
    if (wave == 6) CB_YOUT(NCK - 1);
    asm volatile("s_waitcnt vmcnt(0) lgkmcnt(0)\n\ts_barrier" ::: "memory");
#undef CB_ISSUE
#undef CB_YOUT
}

constexpr int N_FX_UNITS = 65 * 10, N_SB_UNITS = 65 * 10, N_RW_WG = 192;
#ifndef REP_SCAN
#define REP_SCAN 1
#endif
#ifndef REP_SCAN_DRY
#define REP_SCAN_DRY 0
#endif
#ifndef REP_FOX
#define REP_FOX 1
#endif
#ifndef REP_SB
#define REP_SB 1
#endif
__device__ __forceinline__ void phase_mix(const ArgsL& a, Frame& F, int layer) {
#ifdef SEQ_SCAN
    if (F.bx < N_RW_WG) { int nr = REP_SCAN; asm volatile("" : "+s"(nr)); for (int r = 0; r < nr; ++r) rwkv_scan(a, F, F.bx, (r + 1 < nr) ? REP_SCAN_DRY : 0); }
#else
#ifndef REP_CHB
#define REP_CHB 1
#endif
    if (F.bx < 12) { int nr = REP_CHB; asm volatile("" : "+s"(nr)); for (int r = 0; r < nr; ++r) rwkv_chunkB(a, F, F.bx); }
#endif
    float gqm = fabsf(a.in(I_QG)[layer * 64 + F.lane]), gkm = fabsf(a.in(I_KG)[layer * 64 + F.lane]);
#pragma unroll
    for (int off = 1; off < 64; off <<= 1) { gqm = fmaxf(gqm, __shfl_xor(gqm, off)); gkm = fmaxf(gkm, __shfl_xor(gkm, off)); }
    const float bound = 64.0f * C2 * gqm * gkm * 1.02f + 0.5f;
    unsigned* head = (unsigned*)(a.ws + WS_CTL) + CW_QUEUE + 64 * layer;
    for (;;) {
        if (F.tid == 0) F.MISC[16] = __hip_atomic_fetch_add(head, 1u, __ATOMIC_RELAXED, __HIP_MEMORY_SCOPE_AGENT);
        __syncthreads();
        const int u = (int)F.MISC[16];
        __syncthreads();
        if (u >= N_FX_UNITS + N_SB_UNITS) break;
        if (u < N_FX_UNITS) { const int qb = 64 - u / 10, bh = u % 10; int nr = REP_FOX; asm volatile("" : "+s"(nr)); for (int r = 0; r < nr; ++r) attn_unit<0>(a, F, bh / FX_H, bh % FX_H, qb, bound); }
        else { const int v = u - N_FX_UNITS; const int qb = 64 - v / 10, bh = v % 10; int nr = REP_SB; asm volatile("" : "+s"(nr)); for (int r = 0; r < nr; ++r) attn_unit<1>(a, F, bh / SB_H, bh % SB_H, qb, bound); }
    }
}

__device__ __forceinline__ void chain_publish(unsigned* cnt, int pm) {
    asm volatile("s_waitcnt vmcnt(0)" ::: "memory");
    if ((threadIdx.x & 63) == 0) __hip_atomic_fetch_add(cnt + CH_STRIDE * pm, 1u, __ATOMIC_RELAXED, __HIP_MEMORY_SCOPE_AGENT);
}
template <bool WAIT, bool PUB>
struct ChainOrder : pg8::StaticOrder {
    const unsigned* ready; unsigned need; unsigned* mine;
    __device__ __forceinline__ void a_ready(const pg8::Unit& u) const {
        if constexpr (WAIT) {
            if (threadIdx.x < 64) {
                const unsigned* w = ready + CH_STRIDE * u.pm; unsigned polls = 0;
                while ((unsigned)__builtin_amdgcn_readfirstlane(__hip_atomic_load(w, __ATOMIC_RELAXED, __HIP_MEMORY_SCOPE_AGENT)) < need) { if (++polls > (1u << 18)) break; __builtin_amdgcn_s_sleep(2); }
                __builtin_amdgcn_fence(__ATOMIC_ACQUIRE, "agent");
                asm volatile("s_waitcnt vmcnt(0)" ::: "memory");
            }
            asm volatile("" ::: "memory"); __builtin_amdgcn_s_barrier(); asm volatile("" ::: "memory");
        }
    }
    __device__ __forceinline__ void done(const pg8::Unit& u) const { if constexpr (PUB) chain_publish(mine, u.pm); }
};

__device__ __forceinline__ void phase_post(const ArgsL& a, Frame& F, int layer, unsigned* chain, const bool dry = false) {
    const int lane = F.lane, wave = F.wave, it4 = lane >> 4, e4 = lane & 15;
    bf16_t* Y0 = (bf16_t*)(a.ws + WS_YCAT); const bf16_t* BN = (const bf16_t*)(a.ws + WS_BN);
    const __amdgpu_buffer_rsrc_t yrs = __builtin_amdgcn_make_buffer_rsrc((void*)Y0, 0, (int)((size_t)M * YC_W * 2), 0x00020000);
    LAS float* lgl = (LAS float*)F.lds;
    for (int i = F.tid; i < 2 * RW_W; i += NTHR) lgl[i] = (i < RW_W) ? a.in(I_LNG)[layer * RW_W + i] : a.in(I_LNB)[layer * RW_W + i - RW_W];
    __syncthreads();
    unsigned* head = (unsigned*)(a.ws + WS_CTL) + CW_QUEUE + 64 * layer + 32 + (dry ? 8 : 0);
    for (;;) {
        if (F.tid == 0) F.MISC[17] = __hip_atomic_fetch_add(head, 1u, __ATOMIC_RELAXED, __HIP_MEMORY_SCOPE_AGENT);
        __syncthreads();
        const int ch = (int)F.MISC[17];
        __syncthreads();
        if (ch >= M / 64) break;
        u32x2 yn = {0u, 0u}, bn = {0u, 0u};
#define PP_ADDR(ps) const int item_ = (ps) * 32 + wave * 4 + it4, rw_ = item_ / 6, hh_ = item_ - rw_ * 6; const int m_ = ch * 64 + rw_; const size_t off_ = (size_t)m_ * RW_W + hh_ * 64 + e4 * 4, offy_ = (size_t)m_ * YC_W + hh_ * 64 + e4 * 4
        { PP_ADDR(0); yn = *(const u32x2*)(Y0 + offy_); bn = *(const u32x2*)(BN + off_); }
#pragma unroll 1
        for (int ps = 0; ps < 12; ++ps) {
            const u32x2 yv = yn, bv = bn;
            if (ps + 1 < 12) { PP_ADDR(ps + 1); yn = *(const u32x2*)(Y0 + offy_); bn = *(const u32x2*)(BN + off_); }
            PP_ADDR(ps);
            const int p = m_ % T;
            u32x2 w = {0u, 0u};
            if (p >= PADR) {
                const float y0 = bf_lo(yv.x), y1 = bf_hi(yv.x), y2 = bf_lo(yv.y), y3 = bf_hi(yv.y);
                const float mean = allred16((y0 + y1) + (y2 + y3)) * (1.f / 64.f);
                const float d0 = y0 - mean, d1 = y1 - mean, d2 = y2 - mean, d3 = y3 - mean;
                const float rs = 1.0f / sqrtf(allred16((d0 * d0 + d1 * d1) + (d2 * d2 + d3 * d3)) * (1.f / 64.f) + 64e-5f);
                const f32x4 g4 = *(const LAS f32x4*)(lgl + hh_ * 64 + e4 * 4), b4 = *(const LAS f32x4*)(lgl + RW_W + hh_ * 64 + e4 * 4);
                w = (u32x2){pk2(d0 * rs * g4.x + b4.x + bf_lo(bv.x), d1 * rs * g4.y + b4.y + bf_hi(bv.x)), pk2(d2 * rs * g4.z + b4.z + bf_lo(bv.y), d3 * rs * g4.w + b4.w + bf_hi(bv.y))};
            }
            if (!dry) __builtin_amdgcn_raw_buffer_store_b64(w, yrs, (int)(offy_ * 2), 0, 16); else asm volatile("" :: "v"(w.x), "v"(w.y));
        }
#undef PP_ADDR
        if (!dry) {
#pragma unroll 1
            for (int k = 0; k < 16; ++k) { const int pr = wave * 16 + k, sl = pr >> 6, m2 = ch * 64 + (pr & 63); const int p = m2 % T;
                const int rowb = (int)(((size_t)m2 * YC_W + 384 * (sl + 1)) * 2);
                if (p < PADR) { for (int c = lane; c < RW_W / 2; c += 64) __builtin_amdgcn_raw_buffer_store_b32(0u, yrs, rowb + 4 * c, 0, 16); }
                else if (lane < 32) __builtin_amdgcn_raw_buffer_store_b32(0u, yrs, rowb + 640 + 4 * lane, 0, 16); }
            chain_publish(chain, ch >> 2);
        }
    }
}

struct EpiInproj { static constexpr bool PERM = true, AFTER_DRAIN = false, MIDHOOK = false; bf16_t* ush; bf16_t* qkv;
    __device__ __forceinline__ void operator()(const f32x4 (&acc)[2][2][4][2], const pg8::Unit& u, int wr, int wc, int fr, int fq) const {
        asm volatile("" : "+v"(fr), "+v"(fq));
        const int row0 = u.pm * 256 + wr * 64 + fr, colt = u.pn * 256 + wc * 32 + 8 * fq;
#pragma unroll
        for (int ai = 0; ai < 2; ++ai)
#pragma unroll
            for (int m = 0; m < 4; ++m) { const size_t row = (size_t)(row0 + ai * 128 + m * 16);
#pragma unroll
                for (int bj = 0; bj < 2; ++bj) { const int col = colt + bj * 128; const f32x4 v0 = acc[ai][bj][m][0], v1 = acc[ai][bj][m][1];
                    const float sc = (col >= SHIFT_W && col < SHIFT_W + 320) ? C2 : 1.0f;
                    u32x4 w; w.x = pk2(v0[0] * sc, v0[1] * sc); w.y = pk2(v0[2] * sc, v0[3] * sc); w.z = pk2(v1[0] * sc, v1[1] * sc); w.w = pk2(v1[2] * sc, v1[3] * sc);
                    if (col < SHIFT_W) *(u32x4*)(ush + row * SHIFT_W + col) = w;
                    else if (col < SHIFT_W + QKV_W) *(u32x4*)(qkv + row * QKV_W + (col - SHIFT_W)) = w; } }
    }
};
struct EpiGates { static constexpr bool PERM = true, AFTER_DRAIN = false, MIDHOOK = false; bf16_t* gates;
    __device__ __forceinline__ void operator()(const f32x4 (&acc)[2][2][4][2], const pg8::Unit& u, int wr, int wc, int fr, int fq) const {
        asm volatile("" : "+v"(fr), "+v"(fq));
        const int row0 = u.pm * 256 + wr * 64 + fr, colt = u.pn * 256 + wc * 32 + 8 * fq;
        const __amdgpu_buffer_rsrc_t rs = __builtin_amdgcn_make_buffer_rsrc((void*)gates, 0, (int)((size_t)M * 3072 * 2), 0x00020000);
#pragma unroll
        for (int ai = 0; ai < 2; ++ai)
#pragma unroll
            for (int m = 0; m < 4; ++m) { const size_t row = (size_t)(row0 + ai * 128 + m * 16);
#pragma unroll
                for (int bj = 0; bj < 2; ++bj) { const int col = colt + bj * 128; f32x4 v0 = acc[ai][bj][m][0], v1 = acc[ai][bj][m][1];
#pragma unroll
                    for (int q = 0; q < 4; ++q) { v0[q] = __builtin_amdgcn_rcpf(1.f + __builtin_amdgcn_exp2f(-v0[q] * LOG2E)); v1[q] = __builtin_amdgcn_rcpf(1.f + __builtin_amdgcn_exp2f(-v1[q] * LOG2E)); }
                    u32x4 w; w.x = pk2(v0[0], v0[1]); w.y = pk2(v0[2], v0[3]); w.z = pk2(v1[0], v1[1]); w.w = pk2(v1[2], v1[3]);
                    __builtin_amdgcn_raw_buffer_store_b128(w, rs, (int)((row * 3072 + col) * 2), 0, 16); } }
    }
};
struct EpiMergeF { static constexpr bool PERM = true, AFTER_DRAIN = false, MIDHOOK = true; const bf16_t* gates; bf16_t* merged;
    __device__ __forceinline__ void mid(f32x4 (&acc)[2][2][4][2], const pg8::Unit& u, int wr, int wc, int fr, int fq, int seg) const {
        asm volatile("" : "+v"(fr), "+v"(fq));
        const int row0 = u.pm * 256 + wr * 64 + fr, colt = u.pn * 256 + wc * 32 + 8 * fq;
        u32x4 gpn[2], gnn[2];
#define MG_LOAD(q) do { const bf16_t* gpt_ = gates + (size_t)(row0 + ((q) >> 2) * 128 + ((q) & 3) * 16) * 3072 + (seg - 1) * 1024 + colt; \
            gpn[0] = *(const u32x4*)gpt_; gnn[0] = *(const u32x4*)(gpt_ + 1024); gpn[1] = *(const u32x4*)(gpt_ + 128); gnn[1] = *(const u32x4*)(gpt_ + 1024 + 128); } while (0)
        MG_LOAD(0);
#pragma unroll
        for (int q = 0; q < 8; ++q) { const int ai = q >> 2, m = q & 3;
            u32x4 gp[2], gn[2];
#pragma unroll
            for (int bj = 0; bj < 2; ++bj) { gp[bj] = gpn[bj]; gn[bj] = gnn[bj]; }
            if (q < 7) MG_LOAD(q + 1);
#pragma unroll
            for (int bj = 0; bj < 2; ++bj) { f32x4& v0 = acc[ai][bj][m][0]; f32x4& v1 = acc[ai][bj][m][1];
                v0[0] *= bf_lo(gp[bj].x) * __builtin_amdgcn_rcpf(bf_lo(gn[bj].x)); v0[1] *= bf_hi(gp[bj].x) * __builtin_amdgcn_rcpf(bf_hi(gn[bj].x));
                v0[2] *= bf_lo(gp[bj].y) * __builtin_amdgcn_rcpf(bf_lo(gn[bj].y)); v0[3] *= bf_hi(gp[bj].y) * __builtin_amdgcn_rcpf(bf_hi(gn[bj].y));
                v1[0] *= bf_lo(gp[bj].z) * __builtin_amdgcn_rcpf(bf_lo(gn[bj].z)); v1[1] *= bf_hi(gp[bj].z) * __builtin_amdgcn_rcpf(bf_hi(gn[bj].z));
                v1[2] *= bf_lo(gp[bj].w) * __builtin_amdgcn_rcpf(bf_lo(gn[bj].w)); v1[3] *= bf_hi(gp[bj].w) * __builtin_amdgcn_rcpf(bf_hi(gn[bj].w)); }
            __builtin_amdgcn_sched_barrier(0); }
#undef MG_LOAD
    }
    __device__ __forceinline__ void operator()(const f32x4 (&acc)[2][2][4][2], const pg8::Unit& u, int wr, int wc, int fr, int fq) const {
        asm volatile("" : "+v"(fr), "+v"(fq));
        const int row0 = u.pm * 256 + wr * 64 + fr, colt = u.pn * 256 + wc * 32 + 8 * fq;
        const __amdgpu_buffer_rsrc_t mrs = __builtin_amdgcn_make_buffer_rsrc((void*)merged, 0, (int)((size_t)M * D * 2), 0x00020000);
        u32x4 gnx[2];
#define MG_LOAD2(q) do { const bf16_t* gpt_ = gates + (size_t)(row0 + ((q) >> 2) * 128 + ((q) & 3) * 16) * 3072 + 2048 + colt; gnx[0] = *(const u32x4*)gpt_; gnx[1] = *(const u32x4*)(gpt_ + 128); } while (0)
        MG_LOAD2(0);
#pragma unroll
        for (int q = 0; q < 8; ++q) { const int ai = q >> 2, m = q & 3; const size_t row = (size_t)(row0 + ai * 128 + m * 16);
            u32x4 g[2];
#pragma unroll
            for (int bj = 0; bj < 2; ++bj) g[bj] = gnx[bj];
            if (q < 7) MG_LOAD2(q + 1);
#pragma unroll
            for (int bj = 0; bj < 2; ++bj) { const f32x4 v0 = acc[ai][bj][m][0], v1 = acc[ai][bj][m][1];
                u32x4 w;
                w.x = pk2(bf_lo(g[bj].x) * v0[0], bf_hi(g[bj].x) * v0[1]); w.y = pk2(bf_lo(g[bj].y) * v0[2], bf_hi(g[bj].y) * v0[3]);
                w.z = pk2(bf_lo(g[bj].z) * v1[0], bf_hi(g[bj].z) * v1[1]); w.w = pk2(bf_lo(g[bj].w) * v1[2], bf_hi(g[bj].w) * v1[3]);
                __builtin_amdgcn_raw_buffer_store_b128(w, mrs, (int)((row * D + colt + bj * 128) * 2), 0, 16); }
            __builtin_amdgcn_sched_barrier(0); }
#undef MG_LOAD2
    }
};
struct EpiOut { static constexpr bool PERM = true, AFTER_DRAIN = false, MIDHOOK = false; bf16_t* hb;
    __device__ __forceinline__ void operator()(const f32x4 (&acc)[2][2][4][2], const pg8::Unit& u, int wr, int wc, int fr, int fq) const {
        asm volatile("" : "+v"(fr), "+v"(fq));
        const int row0 = u.pm * 256 + wr * 64 + fr, colt = u.pn * 256 + wc * 32 + 8 * fq;
        u32x4 hn[2];
#define OUT_LOAD(q) do { const bf16_t* p_ = hb + (size_t)(row0 + ((q) >> 2) * 128 + ((q) & 3) * 16) * D + colt; hn[0] = *(const u32x4*)(p_); hn[1] = *(const u32x4*)(p_ + 128); } while (0)
        OUT_LOAD(0);
#pragma unroll
        for (int q = 0; q < 8; ++q) {
            const int ai = q >> 2, m = q & 3;
            bf16_t* hp = hb + (size_t)(row0 + ai * 128 + m * 16) * D + colt; const u32x4 h0 = hn[0], h1 = hn[1];
            if (q < 7) OUT_LOAD(q + 1);
#pragma unroll
            for (int bj = 0; bj < 2; ++bj) { const u32x4 hh = bj ? h1 : h0; const f32x4 v0 = acc[ai][bj][m][0], v1 = acc[ai][bj][m][1];
                u32x4 w; w.x = pk2(bf_lo(hh.x) + v0[0], bf_hi(hh.x) + v0[1]); w.y = pk2(bf_lo(hh.y) + v0[2], bf_hi(hh.y) + v0[3]);
                w.z = pk2(bf_lo(hh.z) + v1[0], bf_hi(hh.z) + v1[1]); w.w = pk2(bf_lo(hh.w) + v1[2], bf_hi(hh.w) + v1[3]);
                *(u32x4*)(hp + bj * 128) = w; }
            __builtin_amdgcn_sched_barrier(0);
        }
#undef OUT_LOAD
    }
};
struct MoeOrder { const volatile LAS int* tb; int ntile, npt, G, c, rep;
    __device__ __forceinline__ bool next(int i, pg8::Unit& u) const { long L = (long)i * G + c; if (L >= (long)ntile * npt * rep) return false; L %= (long)ntile * npt;
        const int tau = (int)(L / npt), j = (int)(L - (long)tau * npt); int e = 0;
#pragma unroll
        for (int k = 1; k < 16; ++k) e += (tau >= tb[k]) ? 1 : 0;
        u.pm = tau; u.pn = __builtin_amdgcn_readfirstlane(e) * npt + j; return true; }
    __device__ __forceinline__ void a_ready(const pg8::Unit&) const {}
    __device__ __forceinline__ void done(const pg8::Unit&) const {}
};
struct EpiMoeUp { static constexpr bool PERM = true, AFTER_DRAIN = false, MIDHOOK = false; bf16_t* hs;
    __device__ __forceinline__ void operator()(const f32x4 (&acc)[2][2][4][2], const pg8::Unit& u, int wr, int wc, int fr, int fq) const {
        asm volatile("" : "+v"(fr), "+v"(fq));
        const int row0 = u.pm * 256 + wr * 64 + fr, col = (u.pn & 1) * 128 + wc * 32 + 8 * fq;
#pragma unroll
        for (int ai = 0; ai < 2; ++ai)
#pragma unroll
            for (int m = 0; m < 4; ++m) { const size_t row = (size_t)(row0 + ai * 128 + m * 16); float r[8];
#pragma unroll
                for (int n = 0; n < 2; ++n)
#pragma unroll
                    for (int q = 0; q < 4; ++q) { const float gte = acc[ai][0][m][n][q], up = acc[ai][1][m][n][q]; r[4 * n + q] = gte * __builtin_amdgcn_rcpf(1.f + __builtin_amdgcn_exp2f(-gte * LOG2E)) * up; }
                u32x4 w; w.x = pk2(r[0], r[1]); w.y = pk2(r[2], r[3]); w.z = pk2(r[4], r[5]); w.w = pk2(r[6], r[7]);
                *(u32x4*)(hs + row * DEXP + col) = w; }
    }
};
struct EpiMoeDown { static constexpr bool PERM = true, AFTER_DRAIN = false, MIDHOOK = false; bf16_t* y; const float* cws;
    __device__ __forceinline__ void operator()(const f32x4 (&acc)[2][2][4][2], const pg8::Unit& u, int wr, int wc, int fr, int fq) const {
        asm volatile("" : "+v"(fr), "+v"(fq));
        const int row0 = u.pm * 256 + wr * 64 + fr, colt = (u.pn & 3) * 256 + wc * 32 + 8 * fq;
        float cw[8];
#pragma unroll
        for (int q = 0; q < 8; ++q) cw[q] = cws[row0 + (q >> 2) * 128 + (q & 3) * 16];
#pragma unroll
        for (int ai = 0; ai < 2; ++ai)
#pragma unroll
            for (int m = 0; m < 4; ++m) { const size_t row = (size_t)(row0 + ai * 128 + m * 16); const float cwv = cw[ai * 4 + m];
#pragma unroll
                for (int bj = 0; bj < 2; ++bj) { const int col = colt + bj * 128; const f32x4 v0 = acc[ai][bj][m][0] * cwv, v1 = acc[ai][bj][m][1] * cwv;
                    u32x4 w; w.x = pk2(v0[0], v0[1]); w.y = pk2(v0[2], v0[3]); w.z = pk2(v1[0], v1[1]); w.w = pk2(v1[2], v1[3]);
                    *(u32x4*)(y + row * D + col) = w; } }
    }
};


#ifndef PH_MASK
#define PH_MASK 0xFFFF
#endif
#define PH(k) ((PH_MASK >> (k)) & 1)
#ifndef PROBE_DUP
#define PROBE_DUP 0
#endif
#define DUPN(bit) (((PROBE_DUP >> (bit)) & 1) ? 2 : 1)
#ifndef PROBE_THIN
#define PROBE_THIN 0
#endif
#define THIN(bit) ((PROBE_THIN >> (bit)) & 1)
#define FRESH() do { asm volatile("" : "+v"(F.tid)); F.lane = F.tid & 63; F.wave = __builtin_amdgcn_readfirstlane(F.tid >> 6); { int bx_ = (int)blockIdx.x; asm volatile("" : "+s"(bx_)); F.bx = bx_; } { unsigned char* w_ = a.ws; asm volatile("" : "+s"(w_)); a.ws = w_; } } while (0)
__global__ void __launch_bounds__(NTHR, 2) hybrid_fwd(Args ka) {
    extern __shared__ __attribute__((aligned(16))) unsigned char lds_raw[];
    Frame F;
    F.lds = (LAS unsigned char*)lds_raw;
    F.MISC = (volatile LAS unsigned*)(F.lds + MISC_OFF);
    F.tid = threadIdx.x; F.lane = F.tid & 63; F.wave = __builtin_amdgcn_readfirstlane(F.tid >> 6); F.bx = (int)blockIdx.x;
    for (int u = F.tid; u < (LDS_BYTES - MISC_OFF) / 4; u += NTHR) ((LAS unsigned*)(F.lds + MISC_OFF))[u] = 0u;
    __syncthreads();
    if (F.tid < 29) { const unsigned long long p = (unsigned long long)ka.in[F.tid]; F.MISC[64 + 2 * F.tid] = (unsigned)p; F.MISC[65 + 2 * F.tid] = (unsigned)(p >> 32); }
    __syncthreads();
    ArgsL a; a.tab = F.MISC + 64; a.out = ka.out; a.ws = ka.ws;
    XcdBarrier bar = xcd_barrier_post((unsigned*)(a.ws + WS_CTL) + CW_BAR, F.MISC + 8);
    const int G = (int)gridDim.x, c = (int)blockIdx.x;
    PG8_LAS unsigned char* ring = (PG8_LAS unsigned char*)F.lds;

#ifdef PROF_K
    volatile LAS unsigned* tsl = F.MISC + 1536; int nts = 0;
    if (blockIdx.x == 0 && F.tid == 0) tsl[nts] = (unsigned)__builtin_amdgcn_s_memrealtime();
    ++nts;
#define BARX() do { xcd_barrier(bar); if (blockIdx.x == 0 && F.tid == 0) tsl[nts] = (unsigned)__builtin_amdgcn_s_memrealtime(); ++nts; } while (0)
#else
#define BARX() xcd_barrier(bar)
#endif
    for (int layer = 0; layer < DEPTH; ++layer) {
        for (int rep = 0; rep < DUPN(8); ++rep) { FRESH(); if (PH(0)) phase_wconv(a, F, layer); }
        __syncthreads();
        if (THIN(0)) { FRESH(); phase_norm<1>(a, F, layer, true); }
        FRESH(); if (PH(1)) phase_norm<1>(a, F, layer);
        BARX();
        FRESH(); if (PH(2)) {
            pg8::Gemm g{(const bf16_t*)A_PTR(a), (const bf16_t*)(a.ws + WS_WIN), M, N1, D}; pg8::StaticOrder S; S.init(M, N1, G, c, DUPN(3));
            EpiInproj E{(bf16_t*)(a.ws + WS_USH), (bf16_t*)(a.ws + WS_QKV)};
            pg8::gemm_phase<EpiInproj, pg8::StaticOrder, true, true>(ring, g, S, E);
        }
        BARX();
        if (THIN(1)) { FRESH(); phase_prep(a, F, layer, true); }
        FRESH(); if (PH(3)) phase_prep(a, F, layer);
        BARX();
#ifndef SEQ_SCAN
        if (THIN(2)) { FRESH(); phase_chunkA(a, F, true); }
        FRESH(); if (PH(4)) phase_chunkA(a, F);
        BARX();
#endif
        FRESH(); if (PH(4)) phase_mix(a, F, layer);
        BARX();
        unsigned* ch2 = (unsigned*)(a.ws + WS_CTL) + CW_CHAIN + (layer * 2) * 129 * CH_STRIDE; unsigned* ch3 = ch2 + 129 * CH_STRIDE;
        FRESH(); if (PH(6)) {
            pg8::Gemm g{(const bf16_t*)A_PTR(a), (const bf16_t*)(a.ws + WS_WG), M, 3072, D}; ChainOrder<false, true> S; S.init(M, 3072, G, c, 1); S.ready = nullptr; S.need = 0u; S.mine = ch2;
            EpiGates E{(bf16_t*)(a.ws + WS_GATES)};
            pg8::gemm_phase<EpiGates, ChainOrder<false, true>, true, true>(ring, g, S, E);
        }
        asm volatile("s_waitcnt vmcnt(0) lgkmcnt(0)" ::: "memory"); __syncthreads();
        if (THIN(3)) { FRESH(); phase_post(a, F, layer, ch2, true); }
        FRESH(); if (PH(5)) { if (!((c >= 16 && c < 20) || (c >= 32 && c < 36))) phase_post(a, F, layer, ch2); }
        __syncthreads();
        FRESH(); if (PH(7)) {
            pg8::Gemm g{(const bf16_t*)(a.ws + WS_YCAT), (const bf16_t*)(a.ws + WS_WP), M, D, YC_W}; ChainOrder<true, true> S; S.init(M, D, G, (c + G - 16) % G, 1); S.ready = ch2; S.need = 128u; S.mine = ch3;
            EpiMergeF E{(const bf16_t*)(a.ws + WS_GATES), (bf16_t*)(a.ws + WS_MERGED)};
            pg8::gemm_phase<EpiMergeF, ChainOrder<true, true>, true, true>(ring, g, S, E);
        }
        FRESH(); if (PH(8)) {
            pg8::Gemm g{(const bf16_t*)(a.ws + WS_MERGED), (const bf16_t*)(a.ws + WS_WO), M, D, D}; ChainOrder<true, false> S; S.init(M, D, G, (c + G - 32) % G, 1); S.ready = ch3; S.need = 32u; S.mine = nullptr;
            EpiOut E{HB_PTR(a)};
            pg8::gemm_phase<EpiOut, ChainOrder<true, false>, true, true>(ring, g, S, E);
        }
        BARX();
        if (THIN(4)) { FRESH(); phase_norm2(a, F, layer, true); }
        FRESH(); if (PH(9)) phase_norm2(a, F, layer);
        BARX();
        for (int rep = 0; rep < DUPN(7); ++rep) { FRESH(); if (PH(10)) phase_route(a, F, layer); }
        BARX();
        volatile LAS int* tb = (volatile LAS int*)(F.MISC + 32);
        if (F.tid <= 16) { const int* cnt = (const int*)(a.ws + WS_CTL) + CW_ECNT + 64 * layer; int t = 0;
            for (int e = 0; e < F.tid; ++e) t += (__hip_atomic_load(cnt + e, __ATOMIC_RELAXED, __HIP_MEMORY_SCOPE_AGENT) + 255) >> 8;
            tb[F.tid] = t; }
        __syncthreads();
        const int ntile = tb[16];
        FRESH(); if (PH(11)) {
            pg8::Gemm g{(const bf16_t*)(a.ws + WS_AS), (const bf16_t*)(a.ws + WS_WGU), MS, 8192, D}; MoeOrder S{tb, ntile, 2, G, c, DUPN(6)};
            EpiMoeUp E{(bf16_t*)(a.ws + WS_HS)};
            pg8::gemm_phase<EpiMoeUp, MoeOrder, true, true>(ring, g, S, E);
        }
        BARX();
        FRESH(); if (PH(12)) {
            int kdim = DEXP; asm volatile("" : "+s"(kdim));
            pg8::Gemm g{(const bf16_t*)(a.ws + WS_HS), (const bf16_t*)(a.ws + WS_WD), MS, 16384, kdim}; MoeOrder S{tb, ntile, 4, G, c, DUPN(6)};
            EpiMoeDown E{(bf16_t*)(a.ws + WS_Y), (const float*)(a.ws + WS_CWS)};
            pg8::gemm_phase<EpiMoeDown, MoeOrder, true, true>(ring, g, S, E);
        }
        BARX();
    }
    if (THIN(5)) { FRESH(); phase_norm<0>(a, F, DEPTH - 1, true); }
    FRESH(); if (PH(13)) phase_norm<0>(a, F, DEPTH - 1);
#ifdef PROF_K
    BARX();
    if (blockIdx.x == 0) {
        __syncthreads();
        float us;
        if (PROF_K < 0) us = 100.f;
        else if (PROF_K == 12) us = (float)(tsl[25] - tsl[24]) * 0.01f;
        else if (PROF_K == 13) us = (float)(tsl[25] - tsl[0]) * 0.01f;
        else us = ((float)(tsl[1 + PROF_K] - tsl[PROF_K]) + (float)(tsl[13 + PROF_K] - tsl[12 + PROF_K])) * 0.01f;
        us = 4.f * rintf(us * 0.25f);
        for (int i = F.tid; i < 16384; i += NTHR) a.out[i] = us;
    }
#endif
#ifdef CLOCK_PROBE
    if (blockIdx.x == 0 && F.wave == 0) {
        float c0 = 1.f, c1 = 2.f, c2 = 3.f, c3 = 4.f, c4 = 5.f, c5 = 6.f, c6 = 7.f, c7 = 8.f;
        for (int i = 0; i < CLOCK_PROBE; ++i) {
            asm volatile("v_fma_f32 %0, %0, %0, %0\n\tv_fma_f32 %1, %1, %1, %1\n\tv_fma_f32 %2, %2, %2, %2\n\tv_fma_f32 %3, %3, %3, %3\n\tv_fma_f32 %4, %4, %4, %4\n\tv_fma_f32 %5, %5, %5, %5\n\tv_fma_f32 %6, %6, %6, %6\n\tv_fma_f32 %7, %7, %7, %7"
                         : "+v"(c0), "+v"(c1), "+v"(c2), "+v"(c3), "+v"(c4), "+v"(c5), "+v"(c6), "+v"(c7));
        }
        asm volatile("" :: "v"(c0), "v"(c1), "v"(c2), "v"(c3), "v"(c4), "v"(c5), "v"(c6), "v"(c7));
    }
#endif
}

extern "C" void kernel_launch(void* const* d_in, const int* in_sizes, int n_in, void* d_out, int out_size, void* d_ws, size_t ws_size, hipStream_t stream) {
    static int ready = 0;
    if (ready == 0) {
        if (n_in != 29 || out_size != NB * SEQ * D || ws_size < WS_END) { fprintf(stderr, "kernel_launch: unexpected problem shape (n_in %d, out %d, ws %zu < %zu)\n", n_in, out_size, ws_size, (size_t)WS_END); ready = -1; return; }
        if (hipFuncSetAttribute((const void*)hybrid_fwd, hipFuncAttributeMaxDynamicSharedMemorySize, LDS_BYTES) != hipSuccess) { fprintf(stderr, "kernel_launch: hipFuncSetAttribute failed\n"); ready = -1; return; }
        int per_cu = 0;
        if (hipOccupancyMaxActiveBlocksPerMultiprocessor(&per_cu, (const void*)hybrid_fwd, NTHR, LDS_BYTES) != hipSuccess || per_cu < 1) fprintf(stderr, "kernel_launch: occupancy query says %d\n", per_cu);
        (void)hipGetLastError();
        ready = 1;
    }
    if (ready < 0) return;
    (void)in_sizes;
    if (hipMemsetAsync((char*)d_ws + WS_CTL, 0, CTL_ZERO_BYTES, stream) != hipSuccess) return;
    Args a{};
    for (int i = 0; i < 29; ++i) a.in[i] = (const float*)d_in[i];
    a.out = (float*)d_out; a.ws = (unsigned char*)d_ws;
    hipLaunchKernelGGL(hybrid_fwd, dim3(256), dim3(NTHR), LDS_BYTES, stream, a);
}
```

```cpp
#include <hip/hip_runtime.h>
#include <hip/hip_bf16.h>
#include <cstdio>
#include <cstdint>

#define GAS __attribute__((address_space(1)))
#define LAS __attribute__((address_space(3)))

namespace pg8 {
#define PG8_LAS __attribute__((address_space(3)))
typedef unsigned short bf16_t;
typedef short bf16x8 __attribute__((ext_vector_type(8)));
typedef float f32x4 __attribute__((ext_vector_type(4)));
typedef unsigned u32x4 __attribute__((ext_vector_type(4)));
constexpr int BM = 256, BK = 64, HALF = 128, HTB = HALF * BK * 2  , STAGE_BYTES = 8 * HTB, NXCD = 8, WGM = 8;

__host__ __device__ __forceinline__ int lds_byte(int r, int c) { const int st = (r >> 4) * 2 + (c >> 5), rr = r & 15, cc = c & 31, ob = rr * 64 + cc * 2; return st * 1024 + (ob ^ (((ob >> 9) & 1) << 5)); }
__host__ __device__ __forceinline__ void stage_rc(int b, int& R, int& C) { const int st = b / 1024, sb = b % 1024, swz = sb ^ (((sb >> 9) & 1) << 5); R = (st >> 1) * 16 + swz / 64; C = (st & 1) * 32 + (swz % 64) / 2; }
__host__ __device__ __forceinline__ int perm32(int rho) { const int n = rho >> 4, i = rho & 15; return 8 * (i >> 2) + 4 * n + (i & 3); }

struct Unit { int pm, pn; };
struct Gemm { const bf16_t* A; const bf16_t* Bt; int M, N, K; };

struct StaticOrder {
    int nM, nN, nwg, G, c, rep;
    __host__ __device__ void init(int M, int N, int G_, int c_, int rep_ = 1) { nM = M / BM; nN = N / BM; nwg = nM * nN; G = G_; c = c_; rep = rep_; }
    __host__ __device__ bool next(int i, Unit& u) const {
        const long L = (long)i * G + c; if (L >= (long)nwg * rep) return false;
        int wgid = (int)(L % nwg); { const int q = nwg / NXCD, r = nwg % NXCD, xcd = wgid % NXCD, off = wgid / NXCD; wgid = (xcd < r ? xcd * (q + 1) : r * (q + 1) + (xcd - r) * q) + off; }
        const int nig = WGM * nN, gid = wgid / nig, fm = gid * WGM, gsz = (nM - fm) < WGM ? (nM - fm) : WGM;
        u.pm = fm + ((wgid % nig) % gsz); u.pn = (wgid % nig) / gsz; return true;
    }
    static constexpr bool GATHER = false;
    __device__ __forceinline__ void a_ready(const Unit&) const {}
    __device__ __forceinline__ void done(const Unit&) const {}
};
__device__ __forceinline__ unsigned cvt_pk_bf16(float lo, float hi) { unsigned r; asm volatile("v_cvt_pk_bf16_f32 %0, %1, %2" : "=v"(r) : "v"(lo), "v"(hi)); return r; }
template <class Epi, class Sched, bool ALIGN_EPI = false, bool SP2 = false>
__device__ __forceinline__ void gemm_phase(PG8_LAS unsigned char* lds, const Gemm g, const Sched& S, const Epi& E) {
    int tid_ = threadIdx.x; asm volatile("" : "+v"(tid_));
    const int tid = tid_, wid = __builtin_amdgcn_readfirstlane(tid >> 6), lane = tid & 63, wr = wid >> 2, wc = wid & 3, fr = lane & 15, fq = lane >> 4;
    const int K = g.K, nt = K / BK;
    unsigned voffA[2], voffB[2];
#pragma unroll
    for (int i = 0; i < 2; ++i) { int R, C; stage_rc(tid * 16 + i * 8192, R, C); const int Rb = Epi::PERM ? ((R & ~31) + perm32(R & 31)) : R;
        voffA[i] = (unsigned)(R * K + C) * 2u; voffB[i] = (unsigned)(Rb * K + C) * 2u; }
    constexpr bool GATH = Sched::GATHER;
    unsigned vg[2] = {0u, 0u}, vn[2] = {0u, 0u}; int gR = 0; unsigned gC = 0u;
    if constexpr (GATH) { int R, C; stage_rc(tid * 16, R, C); gR = R; gC = (unsigned)C * 2u; }
#define PG8_GOFF(v, u) do { _Pragma("unroll") for (int h_ = 0; h_ < 2; ++h_) { const int* q_ = S.s2t + (u).pm * 256 + h_ * 128 + gR; v[h_] = (unsigned)q_[0] | ((unsigned)q_[64] << 16); } } while (0)
#define PG8_STAGE_G(bufoff, gbase, pk) do { const unsigned pk_ = (pk); \
        __builtin_amdgcn_global_load_lds((const unsigned*)((const char*)(gbase) + ((pk_ & 0xffffu) * (unsigned)(K * 2) + gC)), (PG8_LAS unsigned*)(lds + (bufoff) + ldsw), 16, 0, 0); \
        __builtin_amdgcn_global_load_lds((const unsigned*)((const char*)(gbase) + ((pk_ >> 16) * (unsigned)(K * 2) + gC)), (PG8_LAS unsigned*)(lds + (bufoff) + ldsw + 8192), 16, 0, 0); } while (0)
    const size_t kstep = (size_t)(BK * 2);
    const size_t hstep = (size_t)HALF * K * 2;
    const size_t tstep = 2 * hstep;
    const unsigned ldsw = (unsigned)wid * 1024u;
    const int aoff = lds_byte(wr * 64 + fr, fq * 8), boff = lds_byte(wc * 32 + fr, fq * 8);
#define PG8_SA(b, h) (((b) * 2 + (h)) * HTB)
#define PG8_SB(b, h) ((4 + (b) * 2 + (h)) * HTB)
#define PG8_STAGE(bufoff, gbase, voff) do { _Pragma("unroll") for (int _i = 0; _i < 2; ++_i) \
        __builtin_amdgcn_global_load_lds((const unsigned*)((const char*)(gbase) + (voff)[_i]), (PG8_LAS unsigned*)(lds + (bufoff) + ldsw + _i * 8192), 16, 0, 0); } while (0)
#define PG8_STAGE_A(bufoff, gbase, h, vv) do { if constexpr (GATH) PG8_STAGE_G(bufoff, gbase, vv[h]); else PG8_STAGE(bufoff, (gbase) + (h) * hstep, voffA); } while (0)
#define PG8_STAGE_A2(bufoff, gbase, h) do { if constexpr (GATH) PG8_STAGE_G(bufoff, gbase, last ? vn[h] : vg[h]); else PG8_STAGE(bufoff, (gbase) + (h) * hstep, voffA); } while (0)
#define PG8_LDA(dst, b, h) do { _Pragma("unroll") for (int m = 0; m < 4; ++m) _Pragma("unroll") for (int k = 0; k < 2; ++k) dst[m][k] = *(const PG8_LAS bf16x8*)(lds + PG8_SA(b, h) + aoff + m * 2048 + k * 1024); } while (0)
#define PG8_LDB(dst, b, h) do { _Pragma("unroll") for (int n = 0; n < 2; ++n) _Pragma("unroll") for (int k = 0; k < 2; ++k) dst[n][k] = *(const PG8_LAS bf16x8*)(lds + PG8_SB(b, h) + boff + n * 2048 + k * 1024); } while (0)
#define PG8_MMA(ai, bj, At, Bt) do { __builtin_amdgcn_s_setprio(1); _Pragma("unroll") for (int m = 0; m < 4; ++m) _Pragma("unroll") for (int n = 0; n < 2; ++n) _Pragma("unroll") for (int k = 0; k < 2; ++k) \
        acc[ai][bj][m][n] = __builtin_amdgcn_mfma_f32_16x16x32_bf16(Bt[n][k], At[m][k], acc[ai][bj][m][n], 0, 0, 0); __builtin_amdgcn_s_setprio(0); } while (0)
#define PG8_WAIT_V(n) asm volatile("s_waitcnt vmcnt(" #n ")" ::: "memory")
#define PG8_WAIT_L(n) asm volatile("s_waitcnt lgkmcnt(" #n ")" ::: "memory")
#define PG8_BAR __builtin_amdgcn_s_barrier()
#define PG8_SCHED __builtin_amdgcn_sched_barrier(0)
    Unit cur, nxt; int ui = 0;
    if (!S.next(0, cur)) return;
    f32x4 acc[2][2][4][2];
#pragma unroll
    for (int a = 0; a < 2; ++a)
#pragma unroll
        for (int b = 0; b < 2; ++b)
#pragma unroll
            for (int m = 0; m < 4; ++m)
#pragma unroll
                for (int n = 0; n < 2; ++n) acc[a][b][m][n] = (f32x4){0.f, 0.f, 0.f, 0.f};
    bf16x8 At[4][2], B0[2][2], B1[2][2];
    const char* cA = GATH ? (const char*)g.A : (const char*)g.A + (size_t)cur.pm * tstep; const char* cB = (const char*)g.Bt + (size_t)cur.pn * tstep;
    S.a_ready(cur);
    if constexpr (GATH) PG8_GOFF(vg, cur);
    if constexpr (SP2) {
        PG8_STAGE(PG8_SB(0, 0), cB, voffB); PG8_STAGE(PG8_SB(0, 1), cB + hstep, voffB); PG8_STAGE_A(PG8_SA(0, 0), cA, 0, vg); PG8_STAGE_A(PG8_SA(0, 1), cA, 1, vg);
        if (wr == 1) PG8_BAR;
        PG8_WAIT_V(2); PG8_BAR;
        PG8_STAGE(PG8_SB(1, 0), cB + kstep, voffB); PG8_STAGE_A(PG8_SA(1, 0), cA + kstep, 0, vg); PG8_STAGE(PG8_SB(1, 1), cB + hstep + kstep, voffB);
        PG8_WAIT_V(6); PG8_BAR;
    } else {
        PG8_STAGE(PG8_SB(0, 0), cB, voffB); PG8_STAGE(PG8_SA(0, 0), cA, voffA); PG8_STAGE(PG8_SB(0, 1), cB + hstep, voffB); PG8_STAGE(PG8_SA(0, 1), cA + hstep, voffA);
        if (wr == 1) PG8_BAR;
        PG8_WAIT_V(4); PG8_BAR;
        PG8_STAGE(PG8_SB(1, 0), cB + kstep, voffB); PG8_STAGE(PG8_SA(1, 0), cA + kstep, voffA); PG8_STAGE(PG8_SB(1, 1), cB + hstep + kstep, voffB);
        PG8_WAIT_V(6); PG8_BAR;
    }
    for (;;) {
        const bool has_next = S.next(ui + 1, nxt);
        const char* nA = (has_next && !GATH) ? (const char*)g.A + (size_t)nxt.pm * tstep : cA;
        if constexpr (GATH) { if (has_next) PG8_GOFF(vn, nxt); else { vn[0] = vg[0]; vn[1] = vg[1]; } } const char* nB = has_next ? (const char*)g.Bt + (size_t)nxt.pn * tstep : cB;
        for (int t = 0; t < nt; t += 2) {
            const bool last = (t == nt - 2);
            const char* a1 = cA + (size_t)(t + 1) * kstep;
            const char* a2 = last ? nA : cA + (size_t)(t + 2) * kstep; const char* b2 = last ? nB : cB + (size_t)(t + 2) * kstep;
            const char* a3 = a2 + kstep; const char* b3 = b2 + kstep;
            if (last && has_next) S.a_ready(nxt);
            if constexpr (SP2) {
            PG8_LDB(B0, 0, 0); PG8_LDB(B1, 0, 1); PG8_SCHED; PG8_LDA(At, 0, 0); PG8_STAGE_A(PG8_SA(1, 1), a1, 1, vg);
            PG8_WAIT_V(8); PG8_WAIT_L(0); PG8_BAR; PG8_MMA(0, 0, At, B0); PG8_MMA(0, 1, At, B1); PG8_BAR; PG8_SCHED;
            PG8_LDA(At, 0, 1); PG8_STAGE(PG8_SB(0, 0), b2, voffB); PG8_STAGE(PG8_SB(0, 1), b2 + hstep, voffB); PG8_STAGE_A2(PG8_SA(0, 0), a2, 0);
            PG8_WAIT_V(8); PG8_WAIT_L(0); PG8_BAR; PG8_MMA(1, 0, At, B0); PG8_MMA(1, 1, At, B1); PG8_BAR; PG8_SCHED;
            PG8_LDB(B0, 1, 0); PG8_LDB(B1, 1, 1); PG8_SCHED; PG8_LDA(At, 1, 0); PG8_STAGE_A2(PG8_SA(0, 1), a2, 1);
            PG8_WAIT_V(8); PG8_WAIT_L(0); PG8_BAR; PG8_MMA(0, 0, At, B0); PG8_MMA(0, 1, At, B1); PG8_BAR; PG8_SCHED;
            PG8_LDA(At, 1, 1); PG8_STAGE(PG8_SB(1, 0), b3, voffB); PG8_STAGE(PG8_SB(1, 1), b3 + hstep, voffB); PG8_STAGE_A2(PG8_SA(1, 0), a3, 0);
            PG8_WAIT_V(8); PG8_WAIT_L(0); PG8_BAR; PG8_MMA(1, 0, At, B0); PG8_MMA(1, 1, At, B1); PG8_BAR; PG8_SCHED;
            } else {
            static_assert(SP2 || !GATH, "gather needs the SP2 schedule");
            PG8_LDB(B0, 0, 0); PG8_SCHED; PG8_LDA(At, 0, 0); PG8_STAGE(PG8_SA(1, 1), a1 + hstep, voffA);
            PG8_WAIT_L(8); PG8_BAR; PG8_WAIT_L(0); PG8_MMA(0, 0, At, B0); PG8_BAR; PG8_SCHED;
            PG8_LDB(B1, 0, 1); PG8_STAGE(PG8_SB(0, 0), b2, voffB);
            PG8_BAR; PG8_WAIT_L(0); PG8_MMA(0, 1, At, B1); PG8_BAR;
            PG8_LDA(At, 0, 1); PG8_STAGE(PG8_SA(0, 0), a2, voffA);
            PG8_BAR; PG8_WAIT_L(0); PG8_MMA(1, 0, At, B0); PG8_BAR; PG8_SCHED;
            PG8_STAGE(PG8_SB(0, 1), b2 + hstep, voffB);
            PG8_WAIT_V(6); PG8_BAR; PG8_MMA(1, 1, At, B1); PG8_BAR;
            PG8_LDB(B0, 1, 0); PG8_SCHED; PG8_LDA(At, 1, 0); PG8_STAGE(PG8_SA(0, 1), a2 + hstep, voffA);
            PG8_WAIT_L(8); PG8_BAR; PG8_WAIT_L(0); PG8_MMA(0, 0, At, B0); PG8_BAR; PG8_SCHED;
            PG8_LDB(B1, 1, 1); PG8_STAGE(PG8_SB(1, 0), b3, voffB);
            PG8_BAR; PG8_WAIT_L(0); PG8_MMA(0, 1, At, B1); PG8_BAR;
            PG8_LDA(At, 1, 1); PG8_STAGE(PG8_SA(1, 0), a3, voffA);
            PG8_BAR; PG8_WAIT_L(0); PG8_MMA(1, 0, At, B0); PG8_BAR; PG8_SCHED;
            PG8_STAGE(PG8_SB(1, 1), b3 + hstep, voffB);
            PG8_WAIT_V(6); PG8_BAR; PG8_MMA(1, 1, At, B1); PG8_BAR;
            }
            if constexpr (Epi::MIDHOOK) { if (t + 2 == 6 || t + 2 == 12) E.mid(acc, cur, wr, wc, fr, fq, (t + 2) / 6); }
        }
        if constexpr (ALIGN_EPI) { if (wr == 0) PG8_BAR; }
        if constexpr (!Epi::AFTER_DRAIN) { E(acc, cur, wr, wc, fr, fq); S.done(cur); }
        if (!has_next) break;
#pragma unroll
        for (int a = 0; a < 2; ++a)
#pragma unroll
            for (int b = 0; b < 2; ++b)
#pragma unroll
                for (int m = 0; m < 4; ++m)
#pragma unroll
                    for (int n = 0; n < 2; ++n) acc[a][b][m][n] = (f32x4){0.f, 0.f, 0.f, 0.f};
        cur = nxt; cA = nA; cB = nB; ++ui;
        if constexpr (GATH) { vg[0] = vn[0]; vg[1] = vn[1]; }
        if constexpr (ALIGN_EPI) { if (wr == 1) PG8_BAR; }
    }
    PG8_WAIT_V(0);
    if constexpr (!ALIGN_EPI) { if (wr == 0) PG8_BAR; }
    PG8_BAR;
    if constexpr (Epi::AFTER_DRAIN) { E.fused(acc, cur, wr, wc, fr, fq, lds, wid, lane); S.done(cur); }
#undef PG8_SA
#undef PG8_SB
#undef PG8_STAGE
#undef PG8_STAGE_A
#undef PG8_STAGE_A2
#undef PG8_STAGE_G
#undef PG8_GOFF
#undef PG8_LDA
#undef PG8_LDB
#undef PG8_MMA
#undef PG8_WAIT_V
#undef PG8_WAIT_L
#undef PG8_BAR
#undef PG8_SCHED
}
}

constexpr int D = 1024, NB = 2, SEQ = 16384, NMETA = 16, LTOK = SEQ + NMETA  , PADR = 112, T = PADR + LTOK  ;
constexpr int M = NB * T;
constexpr int DEPTH = 2, HD = 64, RW_H = 6, SB_H = 5, FX_H = 5, RW_W = 384, SHIFT_W = 1280, D_IN = 6277;
constexpr int YC_W = 1152;
constexpr int QKV_W = 1920;
constexpr int N1 = 3328;
constexpr int FCOL = 3200, GCOL = 3205;
constexpr int NEXP = 16, DEXP = 256;
constexpr int MS = 70144;
constexpr int LCH = 32, LPADDED = 16448;
constexpr int KBP = 16896;
constexpr float C2 = 0.125f * 1.4426950408889634f;
constexpr float LOG2E = 1.4426950408889634f;
constexpr int NWAVES = 8, NTHR = 512;

constexpr size_t MiB = 1u << 20;
constexpr size_t WS_CTL = 0, CTL_ZERO_BYTES = 131072;
constexpr size_t WS_HM = 1 * MiB;
constexpr size_t WS_LOGF = WS_HM + 131072;
constexpr size_t WS_KB2 = WS_LOGF + (size_t)M * 32;
constexpr size_t WS_TOK = WS_KB2 + (size_t)10 * KBP * 4;
constexpr size_t WS_SLOT = WS_TOK + (size_t)M * 32;
constexpr size_t WS_CWS = WS_SLOT + (size_t)M * 8;
constexpr size_t WS_WGCNT = WS_CWS + (size_t)MS * 4;
constexpr size_t WS_S2T = WS_WGCNT + 256 * 16 * 4;
constexpr size_t WS_SMALL_END = WS_S2T + (size_t)MS * 4;
static_assert(WS_SMALL_END <= 8 * MiB, "small buffers");
constexpr size_t WS_WIN = 8 * MiB;
constexpr size_t WS_WG = WS_WIN + (size_t)N1 * 1024 * 2;
constexpr size_t WS_WP = WS_WG + (size_t)3072 * 1024 * 2;
constexpr size_t WS_WO = WS_WP + (size_t)3072 * 384 * 2;
constexpr size_t WS_WGU = WS_WO + (size_t)1024 * 1024 * 2;
constexpr size_t WS_WD = WS_WGU + (size_t)8192 * 1024 * 2;
constexpr size_t WS_W_END = WS_WD + (size_t)16384 * 256 * 2;
static_assert(WS_W_END <= 49 * MiB, "weights");
constexpr size_t WS_HB = 49 * MiB;
constexpr size_t WS_BIG = 115 * MiB;
constexpr size_t WS_USH = WS_BIG;
constexpr size_t WS_YCAT = WS_BIG;
constexpr size_t WS_QKV = WS_BIG + 82 * MiB;
constexpr size_t WS_RW = WS_BIG + 204 * MiB;
constexpr size_t WS_BN = WS_BIG + 349 * MiB;
constexpr size_t WS_GATES = WS_BIG + 82 * MiB;
constexpr size_t WS_MERGED = WS_BIG + 276 * MiB;
constexpr size_t WS_AS = WS_BIG;
constexpr size_t WS_HS = WS_BIG + 137 * MiB;
constexpr size_t WS_Y = WS_BIG + 172 * MiB;
constexpr size_t WS_END = WS_BIG + 374 * MiB;
static_assert((size_t)(M + 256) * 1280 * 2 <= 82 * MiB && (size_t)3 * M * 384 * 2 <= 82 * MiB && (size_t)(M + 256) * 1920 * 2 <= 122 * MiB, "big map 1");
static_assert((size_t)12 * LPADDED * 768 <= 145 * MiB && (size_t)M * 384 * 2 <= 25 * MiB && (size_t)M * 3072 * 2 <= 194 * MiB && (size_t)M * 2048 <= 65 * MiB, "big map 2");
static_assert((size_t)MS * 2048 <= 137 * MiB && (size_t)MS * 512 <= 35 * MiB && WS_END <= 489 * MiB, "big map 3");

constexpr int CW_BAR = 0;
constexpr int CW_QUEUE = 4096;
constexpr int CW_ECNT = 4352;
constexpr int CW_CHAIN = 8192, CH_STRIDE = 32;
static_assert((CW_ECNT + 128) <= CW_CHAIN && (CW_CHAIN + DEPTH * 2 * 129 * CH_STRIDE) * 4 <= (int)CTL_ZERO_BYTES, "ctl");

constexpr int RING_BYTES = 131072, MISC_OFF = RING_BYTES, LDS_BYTES = 163840;

typedef unsigned short bf16_t;
typedef float f32x4 __attribute__((ext_vector_type(4)));
typedef float f32x2 __attribute__((ext_vector_type(2)));
typedef float f32x16 __attribute__((ext_vector_type(16)));
typedef unsigned u32x4 __attribute__((ext_vector_type(4)));
typedef unsigned u32x2 __attribute__((ext_vector_type(2)));
typedef short bf16x8 __attribute__((ext_vector_type(8)));
typedef short s16x4 __attribute__((ext_vector_type(4)));
typedef _Float16 f16x4 __attribute__((ext_vector_type(4)));
typedef __bf16 bf16x2_t __attribute__((ext_vector_type(2)));

__device__ __forceinline__ unsigned pk2(float lo, float hi) { f32x2 v = {lo, hi}; bf16x2_t b = __builtin_convertvector(v, bf16x2_t); return __builtin_bit_cast(unsigned, b); }
__device__ __forceinline__ unsigned short f2bf(float f) { return (unsigned short)(pk2(f, 0.f) & 0xffffu); }
__device__ __forceinline__ float bf_lo(unsigned u) { return __uint_as_float(u << 16); }
__device__ __forceinline__ float bf_hi(unsigned u) { return __uint_as_float(u & 0xffff0000u); }
__device__ __forceinline__ float bf2f(unsigned short h) { return __uint_as_float((unsigned)h << 16); }
template <int CTRL> __device__ __forceinline__ float dpp_f(float x) { return __int_as_float(__builtin_amdgcn_update_dpp(0, __float_as_int(x), CTRL, 0xF, 0xF, false)); }
__device__ __forceinline__ float allred16(float p) { p += dpp_f<0x128>(p); p += dpp_f<0x124>(p); p += dpp_f<0x122>(p); p += dpp_f<0x121>(p); return p; }
__device__ __forceinline__ float wave_sum(float v) {
    v = allred16(v);
    { auto sw = __builtin_amdgcn_permlane16_swap(__float_as_uint(v), __float_as_uint(v), false, false); v = __uint_as_float(sw[0]) + __uint_as_float(sw[1]); }
    { auto sw = __builtin_amdgcn_permlane32_swap(__float_as_uint(v), __float_as_uint(v), false, false); v = __uint_as_float(sw[0]) + __uint_as_float(sw[1]); }
    return v;
}
__device__ __forceinline__ float fast_exp(float x) { return __builtin_amdgcn_exp2f(x * LOG2E); }
__device__ __forceinline__ float fast_log(float x) { return __builtin_amdgcn_logf(x) * 0.6931471805599453f; }
__device__ __forceinline__ float softplus_f(float z) { return fmaxf(z, 0.f) + fast_log(1.f + fast_exp(-fabsf(z))); }

#define XB_TMO      128
#define XB_XCNT(j)  (256  + 64 * (j))
#define XB_XSUB(j)  (1280 + 64 * (j))
#define XB_XGEN(j)  (2304 + 64 * (j))
#define XB_TOP      3328
#define XB_TOPGEN   3392
#define XCD_BAR_WORDS 3456
#define XB_SPIN_CAP (1u << 20)
__device__ __forceinline__ unsigned xb_ld(unsigned* p)              { return __hip_atomic_load(p, __ATOMIC_RELAXED, __HIP_MEMORY_SCOPE_AGENT); }
__device__ __forceinline__ unsigned xb_add(unsigned* p, unsigned v) { return __hip_atomic_fetch_add(p, v, __ATOMIC_RELAXED, __HIP_MEMORY_SCOPE_AGENT); }
__device__ __forceinline__ unsigned xb_xcc_id() { return (unsigned)__builtin_amdgcn_s_getreg((3 << 11) | 20) & 0xFu; }
#define XB_SPIN(cond, bar) do { unsigned _sp = 0; while (cond) { __builtin_amdgcn_s_sleep(1); \
    if ((++_sp & 255u) == 0u) { if (xb_ld(&(bar)[XB_TMO])) break; if (_sp > XB_SPIN_CAP) { atomicAdd(&(bar)[XB_TMO], 1u); break; } } } } while (0)

struct XcdBarrier {
    unsigned* bar; unsigned x;
    volatile LAS unsigned* st;
};

__device__ __forceinline__ XcdBarrier xcd_barrier_post(unsigned* bar, volatile LAS unsigned* st) {
    XcdBarrier b; b.bar = bar; b.x = xb_xcc_id(); b.st = st;
    if (threadIdx.x == 0) (void)xb_add(&bar[XB_XCNT(b.x)], 1u);
    return b;
}
__device__ __forceinline__ void xcd_barrier_complete(unsigned* bar, unsigned x, unsigned& nloc, unsigned& nx) {
    const unsigned G = gridDim.x * gridDim.y * gridDim.z;
    unsigned sum, cnt, mine, sp = 0u;
    for (;;) {
        sum = 0u; cnt = 0u; mine = 0u;
#pragma unroll
        for (unsigned j = 0; j < 16; ++j) { const unsigned c = xb_ld(&bar[XB_XCNT(j)]); sum += c; cnt += (c > 0u) ? 1u : 0u; mine = (j == x) ? c : mine; }
        if (sum == G) break;
        __builtin_amdgcn_s_sleep(1);
        if ((++sp & 255u) == 0u) { if (xb_ld(&bar[XB_TMO])) break; if (sp > XB_SPIN_CAP) { atomicAdd(&bar[XB_TMO], 1u); break; } }
    }
    nloc = mine > 0u ? mine : 1u; nx = cnt > 0u ? cnt : 1u;
}

__device__ __forceinline__ void xcd_barrier(const XcdBarrier& b) {
    asm volatile("s_waitcnt vmcnt(0)" ::: "memory");
    __syncthreads();
    if (threadIdx.x == 0) {
        unsigned* bar = b.bar;
        __builtin_amdgcn_s_waitcnt(0);
        unsigned nloc = b.st[0], nx = b.st[1];
        if (nloc == 0u) { xcd_barrier_complete(bar, b.x, nloc, nx); b.st[0] = nloc; b.st[1] = nx; }
        const unsigned old = xb_add(&bar[XB_XSUB(b.x)], 1u);
        const unsigned gen = old / nloc;
        if (old + 1u == (gen + 1u) * nloc) {
            __builtin_amdgcn_fence(__ATOMIC_RELEASE, "agent");
            asm volatile("s_waitcnt vmcnt(0)" ::: "memory");
            const unsigned og = xb_add(&bar[XB_TOP], 1u);
            const unsigned tg = og / nx;
            if (og + 1u == (tg + 1u) * nx) xb_add(&bar[XB_TOPGEN], 1u);
            else XB_SPIN(xb_ld(&bar[XB_TOPGEN]) == tg, bar);
            __builtin_amdgcn_fence(__ATOMIC_ACQUIRE, "agent");
            xb_add(&bar[XB_XGEN(b.x)], 1u);
            asm volatile("s_waitcnt vmcnt(0)" ::: "memory");
        } else {
            XB_SPIN(xb_ld(&bar[XB_XGEN(b.x)]) == gen, bar);
            __builtin_amdgcn_fence(__ATOMIC_ACQUIRE, "agent");
            asm volatile("s_waitcnt vmcnt(0)" ::: "memory");
        }
    }
    __syncthreads();
}

struct Args { const float* in[29]; float* out; unsigned char* ws; };
enum { I_X = 0, I_META, I_N1G, I_WIN, I_MU, I_WUP, I_W0, I_AUP, I_A0, I_KK, I_KA, I_RK, I_LNG, I_LNB, I_FB, I_QG, I_KG, I_WPR, I_WPS, I_WPF, I_WOUT, I_N2G, I_MWG, I_MBG, I_MWE, I_MBE, I_MGATE, I_MUP, I_MDOWN };
struct ArgsL { volatile LAS unsigned* tab; float* out; unsigned char* ws;
    __device__ __forceinline__ const float* in(int i) const { const unsigned lo = tab[2 * i], hi = tab[2 * i + 1];
        return (const float*)(((unsigned long long)(unsigned)__builtin_amdgcn_readfirstlane((int)hi) << 32) | (unsigned long long)(unsigned)__builtin_amdgcn_readfirstlane((int)lo)); }
};
struct Frame { LAS unsigned char* lds; volatile LAS unsigned* MISC; int tid, lane, wave, bx; };

__device__ __forceinline__ float* hrow(const ArgsL& a, int b, int l) {
    return l < NMETA ? (float*)(a.ws + WS_HM) + (size_t)(b * NMETA + l) * D : a.out + ((size_t)b * SEQ + (l - NMETA)) * D;
}
#define LDS_WAIT() asm volatile("s_waitcnt lgkmcnt(0)" ::: "memory")
#define HB_PTR(a) ((bf16_t*)((a).ws + WS_HB))
#define A_PTR(a) ((bf16_t*)((a).out))

__device__ __forceinline__ void tr_item(const float* W, int ldw, int sc0, int nvalid, int k0, int kvalid, bf16_t* WT, int Kd, int r0, LAS float* scr, int lane) {
    float tv[32];
#pragma unroll
    for (int i = 0; i < 32; ++i) { const int kk = 2 * i + (lane >> 5), n = lane & 31; tv[i] = 0.f;
        if (n < nvalid && k0 + kk < kvalid) tv[i] = W[(size_t)(k0 + kk) * ldw + sc0 + n]; }
#pragma unroll
    for (int i = 0; i < 32; ++i) { const int kk = 2 * i + (lane >> 5), n = lane & 31; scr[kk * 33 + n] = tv[i]; }
    LDS_WAIT();
    const int c = lane & 7;
#pragma unroll
    for (int j = 0; j < 4; ++j) { const int n = (lane >> 3) + 8 * j; const LAS float* s = scr + (8 * c) * 33 + n;
        u32x4 o; o.x = pk2(s[0 * 33], s[1 * 33]); o.y = pk2(s[2 * 33], s[3 * 33]); o.z = pk2(s[4 * 33], s[5 * 33]); o.w = pk2(s[6 * 33], s[7 * 33]);
        *(u32x4*)(WT + (size_t)(r0 + n) * Kd + k0 + 8 * c) = o; }
    LDS_WAIT();
}
__device__ __forceinline__ void tr_item2(const float* W, int ldw, int sc0, int nvalid, int k0, int kvalid, bf16_t* WT, int Kd, int r0, int kd0, LAS float* scr, int lane) {
    float tv[32];
#pragma unroll
    for (int i = 0; i < 32; ++i) { const int kk = 2 * i + (lane >> 5), n = lane & 31; tv[i] = 0.f;
        if (n < nvalid && k0 + kk < kvalid) tv[i] = W[(size_t)(k0 + kk) * ldw + sc0 + n]; }
#pragma unroll
    for (int i = 0; i < 32; ++i) { const int kk = 2 * i + (lane >> 5), n = lane & 31; scr[kk * 33 + n] = tv[i]; }
    LDS_WAIT();
    const int c = lane & 7;
#pragma unroll
    for (int j = 0; j < 4; ++j) { const int n = (lane >> 3) + 8 * j; const LAS float* s = scr + (8 * c) * 33 + n;
        u32x4 o; o.x = pk2(s[0 * 33], s[1 * 33]); o.y = pk2(s[2 * 33], s[3 * 33]); o.z = pk2(s[4 * 33], s[5 * 33]); o.w = pk2(s[6 * 33], s[7 * 33]);
        *(u32x4*)(WT + (size_t)(r0 + n) * Kd + kd0 + 8 * c) = o; }
    LDS_WAIT();
}
__device__ __forceinline__ void phase_wconv(const ArgsL& a, Frame& F, int layer) {
    LAS float* scr = (LAS float*)(F.lds + F.wave * 8448);
    const int gw = F.bx * NWAVES + F.wave, NGW = gridDim.x * NWAVES;
    constexpr int C1 = 16 * 104, C2_ = C1 + 16 * 96, C3 = C2_ + 6 * 96, C4 = C3 + 16 * 32, C5 = C4 + 16 * 256, C6 = C5 + 4 * 512;
    unsigned char* ws = a.ws;
    for (int it = gw; it < C6; it += NGW) {
        if (it < C1) { const int kb = it / 104, nb = it % 104, r0 = nb * 32;
            tr_item(a.in(I_WIN) + (size_t)layer * D * D_IN, D_IN, r0, r0 < FCOL ? 32 : 0, kb * 64, 1024, (bf16_t*)(ws + WS_WIN), 1024, r0, scr, F.lane); }
        else if (it < C2_) { const int r = it - C1, kb = r / 96, nb = r % 96, r0 = nb * 32;
            tr_item(a.in(I_WIN) + (size_t)layer * D * D_IN, D_IN, GCOL + r0, 32, kb * 64, 1024, (bf16_t*)(ws + WS_WG), 1024, r0, scr, F.lane); }
        else if (it < C3) { const int r = it - C2_, kb = r / 32, nb = r % 32, r0 = nb * 32, br = kb / 6, k0 = (kb % 6) * 64;
            const float* W = (br == 0 ? a.in(I_WPR) + (size_t)layer * 384 * D : br == 1 ? a.in(I_WPS) + (size_t)layer * 320 * D : a.in(I_WPF) + (size_t)layer * 320 * D);
            tr_item2(W, D, r0, 32, k0, br == 0 ? 384 : 320, (bf16_t*)(ws + WS_WP), YC_W, r0, br * 384 + k0, scr, F.lane); }
        else if (it < C4) { const int r = it - C3, kb = r / 32, nb = r % 32, r0 = nb * 32;
            tr_item(a.in(I_WOUT) + (size_t)layer * D * D, D, r0, 32, kb * 64, 1024, (bf16_t*)(ws + WS_WO), 1024, r0, scr, F.lane); }
        else if (it < C5) { const int r = it - C4, kb = r / 256, nb = r % 256, r0 = nb * 32, e = r0 >> 9, rr = r0 & 511, j = rr >> 8, q = rr & 255;
            const float* W = (q >= 128 ? a.in(I_MUP) : a.in(I_MGATE)) + ((size_t)layer * NEXP + e) * D * DEXP;
            tr_item(W, DEXP, j * 128 + (q & 127), 32, kb * 64, 1024, (bf16_t*)(ws + WS_WGU), 1024, r0, scr, F.lane); }
        else { const int r = it - C5, kb = r / 512, nb = r % 512, r0 = nb * 32, e = r0 >> 10;
            tr_item(a.in(I_MDOWN) + ((size_t)layer * NEXP + e) * DEXP * D, D, r0 & 1023, 32, kb * 64, 256, (bf16_t*)(ws + WS_WD), 256, r0, scr, F.lane); }
    }
}

__device__ __forceinline__ void add_y_row(f32x4 (&v)[4], const bf16_t* Y, int slot, int lane) {
    const u32x2* y = (const u32x2*)(Y + (size_t)slot * D) + lane;
#pragma unroll
    for (int j = 0; j < 4; ++j) { const u32x2 t = y[64 * j]; v[j].x += bf_lo(t.x); v[j].y += bf_hi(t.x); v[j].z += bf_lo(t.y); v[j].w += bf_hi(t.y); }
}
template <int MODE>
__device__ __forceinline__ void phase_norm(const ArgsL& a, Frame& F, int layer, const bool dry = false) {
    const int lane = F.lane;
    LAS float* wl = (LAS float*)F.lds;
    LAS int* lcnt = (LAS int*)(F.lds + 20 * 4096);
    unsigned char* ws = a.ws;
    if (MODE == 1) {
        const float* win = a.in(I_WIN) + (size_t)layer * D * D_IN;
        for (int idx = F.tid; idx < 5 * 1024; idx += NTHR) { const int j = idx >> 10, k = idx & 1023; wl[j * 1024 + k] = win[(size_t)k * D_IN + FCOL + j]; }
    }
    if (MODE == 2) {
        const float* wg = a.in(I_MWG) + (size_t)layer * D * 4; const float* we = a.in(I_MWE) + (size_t)layer * D * 16;
        for (int i4 = F.tid; i4 < 1024; i4 += NTHR) { const f32x4 f = *(const f32x4*)(wg + 4 * i4); wl[i4] = f.x; wl[1024 + i4] = f.y; wl[2048 + i4] = f.z; wl[3072 + i4] = f.w; }
        for (int i4 = F.tid; i4 < 4096; i4 += NTHR) { const int k = i4 >> 2, c = i4 & 3; const f32x4 f = *(const f32x4*)(we + 4 * i4); LAS float* d = wl + (4 + 4 * c) * 1024 + k;
            d[0] = f.x; d[1024] = f.y; d[2048] = f.z; d[3072] = f.w; }
        if (F.tid < 16) lcnt[F.tid] = 0;
    }
    __syncthreads();
    const int gw = F.bx * NWAVES + F.wave, NGW = gridDim.x * NWAVES;
    const float* gsrc = (MODE == 2 ? a.in(I_N2G) : a.in(I_N1G)) + layer * D;
    f32x4 gv[4];
#pragma unroll
    for (int j = 0; j < 4; ++j) gv[j] = (MODE == 0) ? (f32x4){0.f, 0.f, 0.f, 0.f} : *(const f32x4*)(gsrc + 4 * lane + 256 * j);
    bf16_t* A = A_PTR(a); bf16_t* HB = HB_PTR(a);
    const bf16_t* Y = (const bf16_t*)(ws + WS_Y);
    const int* SLOT = (const int*)(ws + WS_SLOT);
    constexpr bool COMB0 = (MODE == 0);
    const bool comb = COMB0 || (MODE == 1 && layer > 0);
    f32x4 vn[4]; u32x2 yan[4], ybn[4];
#pragma unroll
    for (int j = 0; j < 4; ++j) { vn[j] = (f32x4){0.f, 0.f, 0.f, 0.f}; yan[j] = (u32x2){0u, 0u}; ybn[j] = (u32x2){0u, 0u}; }
#define NRM_VALID(mm) ((mm) < M && ((mm) % T) - PADR >= (MODE == 0 ? NMETA : 0))
#define NRM_LOAD(mm, s0_, s1_) do { if (NRM_VALID(mm)) { const int bb_ = (mm) / T, ll_ = (mm) - bb_ * T - PADR; \
        if (MODE == 1 && layer == 0) { const float* src_ = (ll_ < NMETA) ? a.in(I_META) + (size_t)ll_ * D : a.in(I_X) + ((size_t)bb_ * SEQ + (ll_ - NMETA)) * D; \
            _Pragma("unroll") for (int j = 0; j < 4; ++j) vn[j] = *(const f32x4*)(src_ + 4 * lane + 256 * j); } \
        else { const u32x2* hs_ = (const u32x2*)(HB + (size_t)(mm) * D) + lane; \
            _Pragma("unroll") for (int j = 0; j < 4; ++j) { const u32x2 t_ = hs_[64 * j]; vn[j] = (f32x4){bf_lo(t_.x), bf_hi(t_.x), bf_lo(t_.y), bf_hi(t_.y)}; } } \
        if (comb) { const u32x2* y0_ = (const u32x2*)(Y + (size_t)(s0_) * D) + lane; const u32x2* y1_ = (const u32x2*)(Y + (size_t)(s1_) * D) + lane; \
            _Pragma("unroll") for (int j = 0; j < 4; ++j) { yan[j] = y0_[64 * j]; ybn[j] = y1_[64 * j]; } } } } while (0)
    int sa1 = 0, sb1 = 0, sa2 = 0, sb2 = 0;
    if (comb) { if (NRM_VALID(gw)) { sa1 = SLOT[2 * gw]; sb1 = SLOT[2 * gw + 1]; } if (NRM_VALID(gw + NGW)) { sa2 = SLOT[2 * (gw + NGW)]; sb2 = SLOT[2 * (gw + NGW) + 1]; } }
    NRM_LOAD(gw, sa1, sb1);
    for (int m = gw; m < M; m += NGW) {
        f32x4 v[4]; u32x2 ya[4], yb[4];
#pragma unroll
        for (int j = 0; j < 4; ++j) { v[j] = vn[j]; ya[j] = yan[j]; yb[j] = ybn[j]; }
        int sa3 = 0, sb3 = 0;
        if (comb && NRM_VALID(m + 2 * NGW)) { sa3 = SLOT[2 * (m + 2 * NGW)]; sb3 = SLOT[2 * (m + 2 * NGW) + 1]; }
        NRM_LOAD(m + NGW, sa2, sb2);
        sa2 = sa3; sb2 = sb3;
        const int b = m / T, p = m - b * T, l = p - PADR;
        if (l < 0) {
            if (MODE == 1 && !dry) {
                u32x2* o = (u32x2*)(A + (size_t)m * D) + lane;
#pragma unroll
                for (int j = 0; j < 4; ++j) o[64 * j] = (u32x2){0u, 0u};
                if (lane < 8) ((float*)(ws + WS_LOGF))[(size_t)m * 8 + lane] = 0.f;
            }
            continue;
        }
        if (MODE == 0 && l < NMETA) continue;
        if (comb) {
#pragma unroll
            for (int j = 0; j < 4; ++j) { v[j].x += bf_lo(ya[j].x) + bf_lo(yb[j].x); v[j].y += bf_hi(ya[j].x) + bf_hi(yb[j].x); v[j].z += bf_lo(ya[j].y) + bf_lo(yb[j].y); v[j].w += bf_hi(ya[j].y) + bf_hi(yb[j].y); }
        }
        if (MODE == 0 && !dry) { float* op = a.out + ((size_t)b * SEQ + (l - NMETA)) * D;
#pragma unroll
            for (int j = 0; j < 4; ++j) *(f32x4*)(op + 4 * lane + 256 * j) = v[j]; }
        if (MODE == 1 && !dry) { u32x2* hd = (u32x2*)(HB + (size_t)m * D) + lane;
#pragma unroll
            for (int j = 0; j < 4; ++j) hd[64 * j] = (u32x2){pk2(v[j].x, v[j].y), pk2(v[j].z, v[j].w)};
        }
        if (MODE == 0) continue;
        float ss = 0.f;
#pragma unroll
        for (int j = 0; j < 4; ++j) ss += (v[j].x * v[j].x + v[j].y * v[j].y) + (v[j].z * v[j].z + v[j].w * v[j].w);
        const float r = 1.0f / sqrtf(wave_sum(ss) * (1.0f / D) + 1e-6f);
#pragma unroll
        for (int j = 0; j < 4; ++j) v[j] = v[j] * r * gv[j];
        u32x2* o = (u32x2*)(A + (size_t)m * D) + lane;
        if (!dry) {
#pragma unroll
        for (int j = 0; j < 4; ++j) o[64 * j] = (u32x2){pk2(v[j].x, v[j].y), pk2(v[j].z, v[j].w)}; }
        else { float sink = v[0].x + v[1].y + v[2].z + v[3].w; asm volatile("" :: "v"(sink)); }
        if (MODE == 1) {
            float dsum[5];
#pragma unroll
            for (int q = 0; q < 5; ++q) { float d = 0.f;
#pragma unroll
                for (int j = 0; j < 4; ++j) { const f32x4 w = *(const LAS f32x4*)(wl + q * 1024 + 4 * lane + 256 * j); d += (v[j].x * w.x + v[j].y * w.y) + (v[j].z * w.z + v[j].w * w.w); }
                dsum[q] = wave_sum(d); }
            float mine = dsum[0];
            mine = lane == 1 ? dsum[1] : mine; mine = lane == 2 ? dsum[2] : mine; mine = lane == 3 ? dsum[3] : mine; mine = lane == 4 ? dsum[4] : mine;
            if (lane < 8 && !dry) { float lf = 0.f;
                if (lane < 5) { const float xx = mine + a.in(I_FB)[layer * 5 + lane]; lf = fminf(xx, 0.f) - fast_log(1.f + fast_exp(-fabsf(xx))); }
                ((float*)(ws + WS_LOGF))[(size_t)m * 8 + lane] = lf; }
        }
        if (MODE == 2) {
            float dp[20];
#pragma unroll
            for (int q = 0; q < 20; ++q) { float d = 0.f;
#pragma unroll
                for (int j = 0; j < 4; ++j) { const f32x4 w = *(const LAS f32x4*)(wl + q * 1024 + 4 * lane + 256 * j); d += (v[j].x * w.x + v[j].y * w.y) + (v[j].z * w.z + v[j].w * w.w); }
                dp[q] = d; }
            float sA[10], sB[5];
#pragma unroll
            for (int i = 0; i < 10; ++i) { auto sw = __builtin_amdgcn_permlane32_swap(__float_as_uint(dp[2 * i]), __float_as_uint(dp[2 * i + 1]), false, false); sA[i] = __uint_as_float(sw[0]) + __uint_as_float(sw[1]); }
#pragma unroll
            for (int i = 0; i < 5; ++i) { auto sw = __builtin_amdgcn_permlane16_swap(__float_as_uint(sA[2 * i]), __float_as_uint(sA[2 * i + 1]), false, false); sB[i] = allred16(__uint_as_float(sw[0]) + __uint_as_float(sw[1])); }
            LAS float* red = (LAS float*)(F.lds + 81920 + 256) + F.wave * 32;
            { const int rho = lane >> 4, vsel = ((rho & 1) << 1) | (rho >> 1);
              if ((lane & 15) == 0) {
#pragma unroll
                  for (int i = 0; i < 5; ++i) red[4 * i + vsel] = sB[i]; } }
            LDS_WAIT();
            float ds[20];
#pragma unroll
            for (int i = 0; i < 5; ++i) { const f32x4 t4 = *(const LAS f32x4*)(red + 4 * i); ds[4 * i] = t4.x; ds[4 * i + 1] = t4.y; ds[4 * i + 2] = t4.z; ds[4 * i + 3] = t4.w; }
            LDS_WAIT();
            const float* bg = a.in(I_MBG) + layer * 4; const float* be = a.in(I_MBE) + layer * 16;
            float lg0 = ds[0] + bg[0], lg1 = ds[1] + bg[1], lg2 = ds[2] + bg[2], lg3 = ds[3] + bg[3];
            int g = 0; float mx = lg0;
            if (lg1 > mx) { mx = lg1; g = 1; } if (lg2 > mx) { mx = lg2; g = 2; } if (lg3 > mx) { mx = lg3; g = 3; }
            const float den = fast_exp(lg0 - mx) + fast_exp(lg1 - mx) + fast_exp(lg2 - mx) + fast_exp(lg3 - mx);
            const float pgrp = 1.0f / den;
            float s0 = g == 0 ? ds[4] : g == 1 ? ds[8] : g == 2 ? ds[12] : ds[16];
            float s1 = g == 0 ? ds[5] : g == 1 ? ds[9] : g == 2 ? ds[13] : ds[17];
            float s2 = g == 0 ? ds[6] : g == 1 ? ds[10] : g == 2 ? ds[14] : ds[18];
            float s3 = g == 0 ? ds[7] : g == 1 ? ds[11] : g == 2 ? ds[15] : ds[19];
            s0 += be[g * 4 + 0]; s1 += be[g * 4 + 1]; s2 += be[g * 4 + 2]; s3 += be[g * 4 + 3];
            int i0 = 0; float v0 = s0;
            if (s1 > v0) { v0 = s1; i0 = 1; } if (s2 > v0) { v0 = s2; i0 = 2; } if (s3 > v0) { v0 = s3; i0 = 3; }
            int i1 = -1; float v1 = -3.0e38f;
            if (i0 != 0 && s0 > v1) { v1 = s0; i1 = 0; } if (i0 != 1 && s1 > v1) { v1 = s1; i1 = 1; } if (i0 != 2 && s2 > v1) { v1 = s2; i1 = 2; } if (i0 != 3 && s3 > v1) { v1 = s3; i1 = 3; }
            const float e1 = fast_exp(v1 - v0), pt0 = 1.0f / (1.0f + e1), pt1 = e1 * pt0;
            if (dry) { float sink = pgrp * pt0 + pt1; asm volatile("" :: "v"(sink)); }
            if (lane == 0 && !dry) {
                const int ea = g * 4 + i0, eb = g * 4 + i1;
                const int la = atomicAdd((int*)&lcnt[ea], 1), lb = atomicAdd((int*)&lcnt[eb], 1);
                int* tk = (int*)(ws + WS_TOK) + (size_t)m * 8;
                tk[0] = ea; tk[1] = eb; tk[2] = __float_as_int(pgrp * pt0); tk[3] = __float_as_int(pgrp * pt1); tk[4] = la; tk[5] = lb;
            }
        }
    }
    __syncthreads();
#undef NRM_LOAD
#undef NRM_VALID
    if (MODE == 2 && F.tid < 16 && !dry) {
        const int c = lcnt[F.tid];
        ((int*)(ws + WS_WGCNT))[F.bx * 16 + F.tid] = c;
        atomicAdd((int*)(ws + WS_CTL) + CW_ECNT + 64 * layer + F.tid, c);
    }
    __syncthreads();
}

__device__ __forceinline__ void phase_norm2(const ArgsL& a, Frame& F, int layer, const bool dry = false) {
    const int lane = F.lane;
    LAS float* wl = (LAS float*)F.lds;
    LAS int* lcnt = (LAS int*)(F.lds + 20 * 4096);
    unsigned char* ws = a.ws;
    {
        const float* wg = a.in(I_MWG) + (size_t)layer * D * 4; const float* we = a.in(I_MWE) + (size_t)layer * D * 16;
        for (int i4 = F.tid; i4 < 1024; i4 += NTHR) { const f32x4 f = *(const f32x4*)(wg + 4 * i4); wl[i4] = f.x; wl[1024 + i4] = f.y; wl[2048 + i4] = f.z; wl[3072 + i4] = f.w; }
        for (int i4 = F.tid; i4 < 4096; i4 += NTHR) { const int k = i4 >> 2, c = i4 & 3; const f32x4 f = *(const f32x4*)(we + 4 * i4); LAS float* d = wl + (4 + 4 * c) * 1024 + k;
            d[0] = f.x; d[1024] = f.y; d[2048] = f.z; d[3072] = f.w; }
        if (F.tid < 16) lcnt[F.tid] = 0;
    }
    __syncthreads();
    const int gw = F.bx * NWAVES + F.wave, NGW = gridDim.x * NWAVES;
    LAS float* gl = (LAS float*)(F.lds + 86016);
    LAS float* bl = (LAS float*)(F.lds + 90112);
    for (int i = F.tid; i < 1024; i += NTHR) gl[i] = a.in(I_N2G)[layer * D + i];
    if (F.tid < 4) bl[F.tid] = a.in(I_MBG)[layer * 4 + F.tid];
    if (F.tid >= 64 && F.tid < 80) bl[4 + F.tid - 64] = a.in(I_MBE)[layer * 16 + F.tid - 64];
    __syncthreads();
    bf16_t* A = A_PTR(a); const bf16_t* HB = HB_PTR(a);
    LAS float* red = (LAS float*)(F.lds + 81920 + 256) + F.wave * 96;
#define N2_VALID(mm) ((mm) < M && ((mm) % T) >= PADR)
    constexpr int NR = 2;
    for (int m0 = gw; m0 < M; m0 += NR * NGW) {
        f32x4 v[NR][4];
#pragma unroll
        for (int rr = 0; rr < NR; ++rr) { const int mm_ = m0 + rr * NGW;
            if (N2_VALID(mm_)) { const u32x2* hs_ = (const u32x2*)(HB + (size_t)mm_ * D) + lane;
#pragma unroll
                for (int j = 0; j < 4; ++j) { const u32x2 t = hs_[64 * j]; v[rr][j] = (f32x4){bf_lo(t.x), bf_hi(t.x), bf_lo(t.y), bf_hi(t.y)}; } }
            else {
#pragma unroll
                for (int j = 0; j < 4; ++j) v[rr][j] = (f32x4){0.f, 0.f, 0.f, 0.f}; } }
        float ss[NR];
#pragma unroll
        for (int rr = 0; rr < NR; ++rr) { float s_ = 0.f;
#pragma unroll
            for (int j = 0; j < 4; ++j) s_ += (v[rr][j].x * v[rr][j].x + v[rr][j].y * v[rr][j].y) + (v[rr][j].z * v[rr][j].z + v[rr][j].w * v[rr][j].w);
            ss[rr] = s_; }
#pragma unroll
        for (int rr = 0; rr < NR; ++rr) ss[rr] = wave_sum(ss[rr]);
#pragma unroll
        for (int rr = 0; rr < NR; ++rr) { const int mm = m0 + rr * NGW; const float r = 1.0f / sqrtf(ss[rr] * (1.0f / D) + 1e-6f);
#pragma unroll
            for (int j = 0; j < 4; ++j) v[rr][j] = v[rr][j] * r * *(const LAS f32x4*)(gl + 4 * lane + 256 * j);
            if (N2_VALID(mm) && !dry) { u32x2* o = (u32x2*)(A + (size_t)mm * D) + lane;
#pragma unroll
                for (int j = 0; j < 4; ++j) o[64 * j] = (u32x2){pk2(v[rr][j].x, v[rr][j].y), pk2(v[rr][j].z, v[rr][j].w)}; } }
        { const int rho = lane >> 4, vsel = ((rho & 1) << 1) | (rho >> 1);
#pragma unroll
          for (int qh = 0; qh < 2; ++qh) {
            float dp[NR][10];
#pragma unroll
            for (int q = 0; q < 10; ++q) { f32x4 w[4];
#pragma unroll
                for (int j = 0; j < 4; ++j) w[j] = *(const LAS f32x4*)(wl + (qh * 10 + q) * 1024 + 4 * lane + 256 * j);
#pragma unroll
                for (int rr = 0; rr < NR; ++rr) { float d = 0.f;
#pragma unroll
                    for (int j = 0; j < 4; ++j) d += (v[rr][j].x * w[j].x + v[rr][j].y * w[j].y) + (v[rr][j].z * w[j].z + v[rr][j].w * w[j].w);
                    dp[rr][q] = d; }
                if (q & 1) __builtin_amdgcn_sched_barrier(0); }
#pragma unroll
            for (int rr = 0; rr < NR; ++rr) { float sA[6], sB[3]; sA[5] = 0.f;
#pragma unroll
                for (int i = 0; i < 5; ++i) { auto sw = __builtin_amdgcn_permlane32_swap(__float_as_uint(dp[rr][2 * i]), __float_as_uint(dp[rr][2 * i + 1]), false, false); sA[i] = __uint_as_float(sw[0]) + __uint_as_float(sw[1]); }
#pragma unroll
                for (int k = 0; k < 3; ++k) { auto sw = __builtin_amdgcn_permlane16_swap(__float_as_uint(sA[2 * k]), __float_as_uint(sA[2 * k + 1]), false, false); sB[k] = allred16(__uint_as_float(sw[0]) + __uint_as_float(sw[1])); }
                if ((lane & 15) == 0) {
#pragma unroll
                    for (int k = 0; k < 3; ++k) red[rr * 24 + qh * 10 + 4 * k + vsel] = sB[k]; } }
            __builtin_amdgcn_sched_barrier(0);
          } }
        LDS_WAIT();
        if (lane < NR) {
            const int mm = m0 + lane * NGW;
            float ds[20];
#pragma unroll
            for (int i = 0; i < 5; ++i) { const f32x4 t4 = *(const LAS f32x4*)(red + lane * 24 + 4 * i); ds[4 * i] = t4.x; ds[4 * i + 1] = t4.y; ds[4 * i + 2] = t4.z; ds[4 * i + 3] = t4.w; }
            const float lg0 = ds[0] + bl[0], lg1 = ds[1] + bl[1], lg2 = ds[2] + bl[2], lg3 = ds[3] + bl[3];
            int g = 0; float mx = lg0;
            if (lg1 > mx) { mx = lg1; g = 1; } if (lg2 > mx) { mx = lg2; g = 2; } if (lg3 > mx) { mx = lg3; g = 3; }
            const float den = fast_exp(lg0 - mx) + fast_exp(lg1 - mx) + fast_exp(lg2 - mx) + fast_exp(lg3 - mx);
            const float pgrp = 1.0f / den;
            const f32x4 be4 = *(const LAS f32x4*)(bl + 4 + 4 * g);
            float s0 = (g == 0 ? ds[4] : g == 1 ? ds[8] : g == 2 ? ds[12] : ds[16]) + be4.x;
            float s1 = (g == 0 ? ds[5] : g == 1 ? ds[9] : g == 2 ? ds[13] : ds[17]) + be4.y;
            float s2 = (g == 0 ? ds[6] : g == 1 ? ds[10] : g == 2 ? ds[14] : ds[18]) + be4.z;
            float s3 = (g == 0 ? ds[7] : g == 1 ? ds[11] : g == 2 ? ds[15] : ds[19]) + be4.w;
            int i0 = 0; float v0 = s0;
            if (s1 > v0) { v0 = s1; i0 = 1; } if (s2 > v0) { v0 = s2; i0 = 2; } if (s3 > v0) { v0 = s3; i0 = 3; }
            int i1 = -1; float v1 = -3.0e38f;
            if (i0 != 0 && s0 > v1) { v1 = s0; i1 = 0; } if (i0 != 1 && s1 > v1) { v1 = s1; i1 = 1; } if (i0 != 2 && s2 > v1) { v1 = s2; i1 = 2; } if (i0 != 3 && s3 > v1) { v1 = s3; i1 = 3; }
            const float e1 = fast_exp(v1 - v0), pt0 = 1.0f / (1.0f + e1), pt1 = e1 * pt0;
            if (N2_VALID(mm) && !dry) {
                const int ea = g * 4 + i0, eb = g * 4 + i1;
                const int la = atomicAdd((int*)&lcnt[ea], 1), lb = atomicAdd((int*)&lcnt[eb], 1);
                int* tk = (int*)(ws + WS_TOK) + (size_t)mm * 8;
                tk[0] = ea; tk[1] = eb; tk[2] = __float_as_int(pgrp * pt0); tk[3] = __float_as_int(pgrp * pt1); tk[4] = la; tk[5] = lb;
            } else { float sink = pgrp * pt0 + pt1; asm volatile("" :: "v"(sink)); }
        }
        LDS_WAIT();
    }
#undef N2_VALID
    __syncthreads();
    if (F.tid < 16 && !dry) {
        const int c = lcnt[F.tid];
        ((int*)(ws + WS_WGCNT))[F.bx * 16 + F.tid] = c;
        atomicAdd((int*)(ws + WS_CTL) + CW_ECNT + 64 * layer + F.tid, c);
    }
    __syncthreads();
}

__device__ __forceinline__ void phase_route(const ArgsL& a, Frame& F, int layer) {
    unsigned char* ws = a.ws;
    LAS int* tbl = (LAS int*)F.lds;
    LAS int* part = tbl + 16;
    {
        const int e = F.tid & 15, q = F.tid >> 4; const int* wc = (const int*)(ws + WS_WGCNT); int acc = 0;
#pragma unroll
        for (int i = 0; i < 8; ++i) { const int w = q + 32 * i; if (w < (int)F.bx) acc += wc[w * 16 + e]; }
        part[q * 16 + e] = acc;
    }
    __syncthreads();
    if (F.tid < 16) {
        const int* cnt = (const int*)(ws + WS_CTL) + CW_ECNT + 64 * layer;
        int cv[16];
#pragma unroll
        for (int e = 0; e < 16; ++e) cv[e] = __hip_atomic_load(cnt + e, __ATOMIC_RELAXED, __HIP_MEMORY_SCOPE_AGENT);
        int base = 0;
#pragma unroll
        for (int e = 0; e < 16; ++e) if (e < F.tid) base += ((cv[e] + 255) >> 8) << 8;
#pragma unroll
        for (int q = 0; q < 32; ++q) base += part[q * 16 + F.tid];
        tbl[F.tid] = base; tbl[16 + 512 + F.tid] = __hip_atomic_load(cnt + F.tid, __ATOMIC_RELAXED, __HIP_MEMORY_SCOPE_AGENT);
    }
    __syncthreads();
    if (F.bx == 0) {
        int* s2t = (int*)(ws + WS_S2T);
        for (int e = 0; e < 16; ++e) { const int n = tbl[16 + 512 + e], b0 = tbl[e] + n, pad = (((n + 255) >> 8) << 8) - n;
            for (int i = F.tid; i < pad; i += NTHR) s2t[b0 + i] = 0; }
    }
    int* s2t = (int*)(ws + WS_S2T);
    for (int j = F.tid; j < 8 * ((M + 2047) / 2048); j += NTHR) {
        const int m = (j >> 3) * 2048 + (int)F.bx * 8 + (j & 7);
        if (m >= M) continue;
        const int b = m / T, p = m - b * T;
        if (p < PADR) continue;
        const int* tk_ = (const int*)(ws + WS_TOK) + (size_t)m * 8;
        const u32x4 t4 = *(const u32x4*)tk_; const u32x2 t2 = *(const u32x2*)(tk_ + 4);
        const int ea = (int)t4.x, eb = (int)t4.y, sa = tbl[ea] + (int)t2.x, sb = tbl[eb] + (int)t2.y;
        s2t[sa] = m; s2t[sb] = m;
        int* sl = (int*)(ws + WS_SLOT) + 2 * m; sl[0] = sa; sl[1] = sb;
        float* cw = (float*)(ws + WS_CWS); cw[sa] = __uint_as_float(t4.z); cw[sb] = __uint_as_float(t4.w);
    }
    __syncthreads();
}

#ifndef PR_STAGES
#define PR_STAGES 15
#endif
__device__ __forceinline__ void phase_prep(const ArgsL& a, Frame& F, int layer, const bool dry = false) {
    unsigned char* ws = a.ws;
    LAS float* xs = (LAS float*)F.lds;
    const int wave = F.wave, lane = F.lane, tid = F.tid;
    const int m0 = F.bx * 129;
    const bf16_t* USH = (const bf16_t*)(ws + WS_USH);
    bf16_t* QKV = (bf16_t*)(ws + WS_QKV);
    if (F.bx < 10 && (!dry || (PR_STAGES & 8))) {
        const int bh = F.bx, b = bh / 5, h = bh % 5;
        const float* LOGF = (const float*)(ws + WS_LOGF) + (size_t)(b * T + PADR) * 8 + h;
        float* kb = (float*)(ws + WS_KB2) + (size_t)bh * KBP;
        LAS float* wtot = (LAS float*)F.lds;
        float v[33];
        const int l0 = tid * 33;
#pragma unroll
        for (int i = 0; i < 33; ++i) v[i] = (l0 + i < LTOK) ? LOGF[(size_t)(l0 + i) * 8] : 0.f;
#pragma unroll
        for (int i = 1; i < 33; ++i) v[i] += v[i - 1];
        float incl = v[32];
#pragma unroll
        for (int o = 1; o < 64; o <<= 1) { const float t = __shfl_up(incl, o); if (lane >= o) incl += t; }
        if (lane == 63) wtot[wave] = incl;
        __syncthreads();
        float off = incl - v[32];
        for (int w = 0; w < wave; ++w) off += wtot[w];
#pragma unroll
        for (int i = 0; i < 33; ++i) if (l0 + i < LTOK && !dry) kb[PADR + l0 + i] = -(off + v[i]) * LOG2E;
        for (int p = tid; p < PADR; p += NTHR) kb[p] = 0.f;
        for (int p = T + tid; p < KBP; p += NTHR) kb[p] = 0.f;
        __syncthreads();
    }
    if (F.bx >= 16 && F.bx < 28) {
        unsigned* z = (unsigned*)(ws + WS_RW + ((size_t)(F.bx - 16) * LPADDED + LTOK) * 768);
        for (int i = tid; i < (LPADDED - LTOK) * 192; i += NTHR) z[i] = 0u;
    }
    const int r16 = lane & 15, q4 = lane >> 4, hh = wave < 6 ? wave : 0;
    bf16x8 bw[2][4][2];
    float cw0[4], ca0[4], ckk[4], cka[4], crk[4];
    {
        const float* WUp = a.in(I_WUP) + (size_t)layer * 64 * RW_W + hh * 64 + r16; const float* AUp = a.in(I_AUP) + (size_t)layer * 64 * RW_W + hh * 64 + r16;
#pragma unroll
        for (int mtx = 0; mtx < 2; ++mtx)
#pragma unroll
            for (int blk = 0; blk < 4; ++blk)
#pragma unroll
                for (int ks = 0; ks < 2; ++ks) { const float* p_ = (mtx ? AUp : WUp) + (size_t)(32 * ks + 8 * q4) * RW_W + blk * 16;
                    const float f0 = p_[0], f1 = p_[RW_W], f2 = p_[2 * RW_W], f3 = p_[3 * RW_W], f4 = p_[4 * RW_W], f5 = p_[5 * RW_W], f6 = p_[6 * RW_W], f7 = p_[7 * RW_W];
                    bw[mtx][blk][ks] = __builtin_bit_cast(bf16x8, (u32x4){pk2(f0, f1), pk2(f2, f3), pk2(f4, f5), pk2(f6, f7)}); }
#pragma unroll
        for (int blk = 0; blk < 4; ++blk) { const int ch = layer * RW_W + hh * 64 + blk * 16 + r16;
            cw0[blk] = a.in(I_W0)[ch]; ca0[blk] = a.in(I_A0)[ch]; ckk[blk] = a.in(I_KK)[ch]; cka[blk] = a.in(I_KA)[ch]; crk[blk] = a.in(I_RK)[ch]; }
    }
    const float* mu = a.in(I_MU) + layer * SHIFT_W;
    f32x4 gq4 = *(const f32x4*)(a.in(I_QG) + layer * 64 + (lane & 15) * 4) * C2; const f32x4 gk4 = *(const f32x4*)(a.in(I_KG) + layer * 64 + (lane & 15) * 4);
    _Float16* RW = (_Float16*)(ws + WS_RW);
    bf16_t* BN = (bf16_t*)(ws + WS_BN);
    for (int t0 = 0; t0 < 129; t0 += 16) {
        const int nt = (129 - t0) < 16 ? (129 - t0) : 16;
        if (!dry || (PR_STAGES & 1)) {
            int tid = F.tid; asm volatile("" : "+v"(tid));
            u32x4 uu4[5], pp4[5];
#pragma unroll
            for (int q5 = 0; q5 < 5; ++q5) { const int item = tid + q5 * NTHR; uu4[q5] = (u32x4){0u, 0u, 0u, 0u}; pp4[q5] = (u32x4){0u, 0u, 0u, 0u};
                if (item < nt * 160) { const int tok = item / 160, ch = item - tok * 160, m = m0 + t0 + tok;
                    uu4[q5] = *(const u32x4*)(USH + (size_t)m * SHIFT_W + ch * 8);
                    if (m > 0) pp4[q5] = *(const u32x4*)(USH + (size_t)(m - 1) * SHIFT_W + ch * 8); } }
#pragma unroll
            for (int q5 = 0; q5 < 5; ++q5) { const int item = tid + q5 * NTHR;
                if (item < nt * 160) { const int tok = item / 160, ch = item - tok * 160;
                    const u32x4 u = uu4[q5], pv = pp4[q5];
                    const f32x4 mu0 = *(const f32x4*)(mu + ch * 8), mu1 = *(const f32x4*)(mu + ch * 8 + 4);
                    float x[8];
                    { float uu, pp;
                      uu = bf_lo(u.x); pp = bf_lo(pv.x); x[0] = uu + (pp - uu) * mu0.x;  uu = bf_hi(u.x); pp = bf_hi(pv.x); x[1] = uu + (pp - uu) * mu0.y;
                      uu = bf_lo(u.y); pp = bf_lo(pv.y); x[2] = uu + (pp - uu) * mu0.z;  uu = bf_hi(u.y); pp = bf_hi(pv.y); x[3] = uu + (pp - uu) * mu0.w;
                      uu = bf_lo(u.z); pp = bf_lo(pv.z); x[4] = uu + (pp - uu) * mu1.x;  uu = bf_hi(u.z); pp = bf_hi(pv.z); x[5] = uu + (pp - uu) * mu1.y;
                      uu = bf_lo(u.w); pp = bf_lo(pv.w); x[6] = uu + (pp - uu) * mu1.z;  uu = bf_hi(u.w); pp = bf_hi(pv.w); x[7] = uu + (pp - uu) * mu1.w; }
                    if (ch >= 144 && ch < 152) {
#pragma unroll
                        for (int q = 0; q < 8; ++q) { const float e = fast_exp(-2.f * fabsf(x[q])); const float th = (1.f - e) / (1.f + e); x[q] = x[q] < 0.f ? -th : th; }
                    }
                    LAS f32x4* d = (LAS f32x4*)(xs + tok * SHIFT_W + ch * 8);
                    d[0] = (f32x4){x[0], x[1], x[2], x[3]}; d[1] = (f32x4){x[4], x[5], x[6], x[7]}; } }
        }
        __syncthreads();
        if (wave < 6) { if (!dry || (PR_STAGES & 2)) {
            f32x4 acc[2][4];
#pragma unroll
            for (int mtx = 0; mtx < 2; ++mtx) {
                bf16x8 af[2];
#pragma unroll
                for (int ks = 0; ks < 2; ++ks) { const LAS float* xp = xs + r16 * SHIFT_W + 1152 + 64 * mtx + 32 * ks + 8 * q4;
                    const f32x4 u0 = *(const LAS f32x4*)xp, u1 = *(const LAS f32x4*)(xp + 4);
                    af[ks] = __builtin_bit_cast(bf16x8, (u32x4){pk2(u0.x, u0.y), pk2(u0.z, u0.w), pk2(u1.x, u1.y), pk2(u1.z, u1.w)}); }
#pragma unroll
                for (int blk = 0; blk < 4; ++blk) { f32x4 c4 = {0.f, 0.f, 0.f, 0.f};
                    c4 = __builtin_amdgcn_mfma_f32_16x16x32_bf16(af[0], bw[mtx][blk][0], c4, 0, 0, 0);
                    c4 = __builtin_amdgcn_mfma_f32_16x16x32_bf16(af[1], bw[mtx][blk][1], c4, 0, 0, 0);
                    acc[mtx][blk] = c4; }
            }
#pragma unroll
            for (int i = 0; i < 4; ++i) {
                const int tok = 4 * q4 + i, m = m0 + t0 + tok, b = m / T, p = m - b * T, l = p - PADR;
                const bool ok = (tok < nt) && (l >= 0);
                const LAS float* xr = xs + (tok < 16 ? tok : 0) * SHIFT_W + hh * 64 + r16;
                float kkr[4], kpv[4], avv4[4], omv[4], rv4[4], vv4[4];
                float ssq = 0.f, cf = 0.f;
#pragma unroll
                for (int blk = 0; blk < 4; ++blk) {
                    const float wlv = cw0[blk] + acc[0][blk][i], alv = ca0[blk] + acc[1][blk][i];
                    const float r = xr[blk * 16], k = xr[384 + blk * 16], v = xr[768 + blk * 16];
                    const float logw = -softplus_f(-wlv) - 0.5f;
                    const float xw = fast_exp(logw);
                    omv[blk] = xw < 0.02f ? xw * (1.f - 0.5f * xw + xw * xw * (1.f / 6.f)) : 1.f - fast_exp(-xw);
                    const float av = 1.f / (1.f + fast_exp(-alv));
                    kkr[blk] = k * ckk[blk]; kpv[blk] = k * (1.f + (av - 1.f) * cka[blk]); avv4[blk] = av; rv4[blk] = r; vv4[blk] = v;
                    ssq += kkr[blk] * kkr[blk]; cf += r * kpv[blk] * crk[blk];
                }
                ssq = allred16(ssq); cf = allred16(cf);
                const float inv = 1.0f / fmaxf(sqrtf(ssq), 1e-12f);
                if (ok && !dry) {
                    _Float16* o = RW + ((size_t)(b * RW_H + hh) * LPADDED + l) * 384 + r16;
#pragma unroll
                    for (int blk = 0; blk < 4; ++blk) { const float kk = kkr[blk] * inv, bb = kk * avv4[blk];
                        o[blk * 16] = (_Float16)kk; o[64 + blk * 16] = (_Float16)(-omv[blk]); o[128 + blk * 16] = (_Float16)(-bb); o[192 + blk * 16] = (_Float16)kpv[blk];
                        o[256 + blk * 16] = (_Float16)rv4[blk]; o[320 + blk * 16] = (_Float16)vv4[blk];
                        BN[(size_t)m * RW_W + hh * 64 + blk * 16 + r16] = f2bf(cf * vv4[blk]); }
                } else { float sink = ssq + cf + inv + omv[0] + kpv[1]; asm volatile("" :: "v"(sink)); }
            } }
        }
        if (!dry || (PR_STAGES & 4)) {
            const int it4 = lane >> 4, e4 = lane & 15;
            u32x2 xv[5]; bf16_t* qp5[5]; bool okv[5];
#pragma unroll
            for (int ps = 0; ps < 5; ++ps) { const int item = (ps * 8 + wave) * 4 + it4, tok = item / 10, hq = item - tok * 10;
                const int m = m0 + t0 + tok, p = m % T;
                okv[ps] = (tok < nt) && (p >= PADR);
                qp5[ps] = QKV + (size_t)m * QKV_W + 960 + hq * 64 + e4 * 4;
                xv[ps] = okv[ps] ? *(const u32x2*)qp5[ps] : (u32x2){0u, 0u}; }
#pragma unroll
            for (int ps = 0; ps < 5; ++ps) { const int item = (ps * 8 + wave) * 4 + it4, hq = item % 10;
                const float x0 = bf_lo(xv[ps].x), x1 = bf_hi(xv[ps].x), x2 = bf_lo(xv[ps].y), x3 = bf_hi(xv[ps].y);
                const float ss = allred16((x0 * x0 + x1 * x1) + (x2 * x2 + x3 * x3));
                const float rs = 1.0f / sqrtf(ss * (1.0f / 64.f) + 1e-6f);
                const f32x4 gg = hq < 5 ? gq4 : gk4;
                const u32x2 w = {pk2(x0 * rs * gg.x, x1 * rs * gg.y), pk2(x2 * rs * gg.z, x3 * rs * gg.w)};
                if (okv[ps] && !dry) *(u32x2*)qp5[ps] = w; else asm volatile("" :: "v"(w.x), "v"(w.y)); }
        }
        __syncthreads();
    }
}


constexpr int SCH = 16;
static_assert(LTOK % SCH == 0, "whole chunks");
__device__ __forceinline__ void rwkv_scan(const ArgsL& a, Frame& F, int wgi, int dry = 0) {
    const int bh = wgi >> 4, q8 = wgi & 15, b = bh / RW_H, h = bh % RW_H;
    const int tid = F.tid, wave = F.wave, lane = F.lane;
    const unsigned char* rw = a.ws + WS_RW + (size_t)bh * LPADDED * 768;
    LAS float* ring = (LAS float*)F.lds;
    LAS float* ypart = (LAS float*)(F.lds + 49152);
    LAS unsigned char* stg = F.lds + 81920;
    bf16_t* y0 = (bf16_t*)(a.ws + WS_YCAT);
    constexpr int NCH = LTOK / SCH;
    const bool isld = (wave & 2) != 0; const int lw = (wave & 1) + ((wave >> 2) << 1), tl = lw * 64 + lane;
    float s0 = 0.f, s1 = 0.f;
    const int i32 = lane & 31, rsel = lane >> 5, rloc = 2 * wave + rsel;
#define RW_BAR() asm volatile("s_waitcnt lgkmcnt(0)\n\ts_barrier" ::: "memory")
#define RW_ISSUE(cc) do { const unsigned char* src_ = rw + (size_t)(cc) * SCH * 768 + (size_t)tl * 16; LAS unsigned char* d_ = stg + ((cc) & 3) * 12288 + lw * 1024; \
        _Pragma("unroll") for (int k_ = 0; k_ < 3; ++k_) __builtin_amdgcn_global_load_lds((const unsigned*)(src_ + k_ * 4096), (LAS unsigned*)(d_ + k_ * 4096), 16, 0, 0); } while (0)
#define RW_CONVERT(cc) do { const LAS unsigned char* s_ = stg + ((cc) & 3) * 12288 + tl * 16; LAS float* rb_ = ring + ((cc) & 1) * 6144; \
        _Pragma("unroll") for (int k_ = 0; k_ < 3; ++k_) { const int pc_ = tl + 256 * k_; const int t_ = pc_ / 48, q_ = pc_ - t_ * 48, vec_ = q_ >> 3, e0_ = (q_ & 7) * 8; \
            const u32x4 w_ = *(const LAS u32x4*)(s_ + k_ * 4096); \
            const f16x4 lo_ = __builtin_bit_cast(f16x4, (u32x2){w_.x, w_.y}), hi_ = __builtin_bit_cast(f16x4, (u32x2){w_.z, w_.w}); \
            const float f0 = (float)lo_.x, f1 = (float)lo_.y, f2 = (float)lo_.z, f3 = (float)lo_.w, f4 = (float)hi_.x, f5 = (float)hi_.y, f6 = (float)hi_.z, f7 = (float)hi_.w; \
            if (vec_ < 4) { LAS float* d_ = rb_ + t_ * 384 + (vec_ >> 1) * 128 + (e0_ >> 1) * 4 + (vec_ & 1) * 2; \
                *(LAS f32x2*)(d_) = (f32x2){f0, f1}; *(LAS f32x2*)(d_ + 4) = (f32x2){f2, f3}; *(LAS f32x2*)(d_ + 8) = (f32x2){f4, f5}; *(LAS f32x2*)(d_ + 12) = (f32x2){f6, f7}; } \
            else { LAS f32x4* d_ = (LAS f32x4*)(rb_ + t_ * 384 + (vec_ == 4 ? 256 : 320) + e0_); d_[0] = (f32x4){f0, f1, f2, f3}; d_[1] = (f32x4){f4, f5, f6, f7}; } } } while (0)
#define RW_STORE_Y(cc) do { if (tl < 32) { const LAS float* yb_ = ypart + ((cc) & 1) * 4096; const int t_ = tl >> 1, pr_ = tl & 1; const int l_ = (cc) * SCH + t_; \
        const LAS f32x4* q_ = (const LAS f32x4*)(yb_ + t_ * 128 + pr_ * 64); f32x4 sa_ = q_[0], sb_ = q_[8]; \
        _Pragma("unroll") for (int k_ = 1; k_ < 8; ++k_) { sa_ = sa_ + q_[k_]; sb_ = sb_ + q_[8 + k_]; } \
        *(unsigned*)(y0 + (size_t)(b * T + PADR + l_) * RW_W + h * 64 + q8 * 4 + 2 * pr_) = pk2((sa_.x + sa_.y) + (sa_.z + sa_.w), (sb_.x + sb_.y) + (sb_.z + sb_.w)); } } while (0)
    if (isld) {
        RW_ISSUE(0); asm volatile("s_waitcnt vmcnt(0)" ::: "memory"); RW_CONVERT(0);
        RW_ISSUE(1); RW_ISSUE(2);
    }
    RW_BAR();
    for (int c = 0; c < NCH; ++c) {
        if (isld) {
            if (c + 2 < NCH) { asm volatile("s_waitcnt vmcnt(3)" ::: "memory"); RW_CONVERT(c + 1); }
            else if (c + 1 < NCH) { asm volatile("s_waitcnt vmcnt(0)" ::: "memory"); RW_CONVERT(c + 1); }
            if (c > 0 && !dry) RW_STORE_Y(c - 1);
            if (c + 3 < NCH) RW_ISSUE(c + 3);
        } else if (dry != 1 && wave < 2) {
            const unsigned ba = (unsigned)(uintptr_t)(ring + (c & 1) * 6144) + i32 * 16, ca = (unsigned)(uintptr_t)(ring + (c & 1) * 6144) + 1024 + i32 * 8,
                           va = (unsigned)(uintptr_t)(ring + (c & 1) * 6144) + 1280 + (q8 * 4 + rloc) * 4, ya = (unsigned)(uintptr_t)(ypart + (c & 1) * 4096 + rloc * 32 + i32);
            f32x4 OA[4], OB[4]; f32x2 OC[4]; float OV[4];
            OC[3] = (f32x2){0.f, 0.f};
#define RW_FETCH(tt, sl) asm volatile("ds_read_b128 %0, %4 offset:%c7\n\tds_read_b128 %1, %4 offset:%c8\n\tds_read_b64 %2, %5 offset:%c7\n\tds_read_b32 %3, %6 offset:%c7" \
                : "=&v"(OA[sl]), "=&v"(OB[sl]), "=&v"(OC[sl]), "=&v"(OV[sl]) : "v"(ba), "v"(ca), "v"(va), "i"((tt) * 1536), "i"((tt) * 1536 + 512) : "memory")
            RW_FETCH(0, 0); RW_FETCH(1, 1);
            float p, p2, y;
#define RW_STEP(t, WAITN, YL1, YL2, YW, FETCHL) asm volatile( \
                "s_waitcnt lgkmcnt(" WAITN ")\n\t" \
                "v_mul_f32 %[p], %[s0], %[kk0]\n\t" \
                "v_fmac_f32 %[p], %[s1], %[kk1]\n\t" \
                YL1 "\n\t" YL2 "\n\t" \
                XL8 "\n\t" \
                "v_fmac_f32 %[s0], %[s0], %[om0]\n\t" \
                "v_fmac_f32 %[s1], %[s1], %[om1]\n\t" \
                XL4 "\n\t" \
                "v_fmac_f32 %[s0], %[vf], %[kv0]\n\t" \
                "v_fmac_f32 %[s1], %[vf], %[kv1]\n\t" \
                XL2 "\n\t" \
                YW "\n\t" \
                FETCHL \
                : [p] "=&v"(p), [p2] "=&v"(p2), [y] "=&v"(y), [s0] "+v"(s0), [s1] "+v"(s1), [nA] "=&v"(OA[((t) + 2) & 3]), [nB] "=&v"(OB[((t) + 2) & 3]), [nC] "=&v"(OC[((t) + 2) & 3]), [nV] "=&v"(OV[((t) + 2) & 3]) \
                : [kk0] "v"(OA[(t) & 3].x), [kk1] "v"(OA[(t) & 3].y), [om0] "v"(OA[(t) & 3].z), [om1] "v"(OA[(t) & 3].w), [bb0] "v"(OB[(t) & 3].x), [bb1] "v"(OB[(t) & 3].y), [kv0] "v"(OB[(t) & 3].z), [kv1] "v"(OB[(t) & 3].w), \
                  [vf] "v"(OV[(t) & 3]), [rp0] "v"(OC[((t) + 3) & 3].x), [rp1] "v"(OC[((t) + 3) & 3].y), [ba] "v"(ba), [ca] "v"(ca), [va] "v"(va), [ya] "v"(ya), \
                  [oa] "i"(((t) + 2) * 1536), [ob] "i"(((t) + 2) * 1536 + 512), [oy] "i"(((t) - 1) * 512) : "memory")
#define RW_YL1 "v_mul_f32 %[y], %[s0], %[rp0]"
#define RW_YL2 "v_fmac_f32 %[y], %[s1], %[rp1]"
#define RW_YW  "ds_write_b32 %[ya], %[y] offset:%c[oy]"
#define RW_NOP "s_nop 0"
#define RW_TAIL_F "ds_read_b128 %[nA], %[ba] offset:%c[oa]\n\t" \
                XL1 "\n\t" \
                "ds_read_b128 %[nB], %[ba] offset:%c[ob]\n\t" \
                "ds_read_b64 %[nC], %[ca] offset:%c[oa]\n\t" \
                "v_mov_b32 %[p2], %[p]\n\t" \
                "ds_read_b32 %[nV], %[va] offset:%c[oa]\n\t" \
                "s_nop 0\n\t" \
                XSW "\n\t" \
                "v_add_f32 %[p], %[p], %[p2]\n\t" \
                "v_fmac_f32 %[s0], %[p], %[bb0]\n\t" \
                "v_fmac_f32 %[s1], %[p], %[bb1]"
#define RW_TAIL_N "s_nop 0\n\t" \
                XL1 "\n\t" \
                "s_nop 1\n\t" \
                "v_mov_b32 %[p2], %[p]\n\t" \
                "s_nop 1\n\t" \
                XSW "\n\t" \
                "v_add_f32 %[p], %[p], %[p2]\n\t" \
                "v_fmac_f32 %[s0], %[p], %[bb0]\n\t" \
                "v_fmac_f32 %[s1], %[p], %[bb1]"
#define RW_ALLSTEPS() do { \
            RW_STEP(0, "4", RW_NOP, RW_NOP, RW_NOP, RW_TAIL_F); \
            RW_STEP(1, "4", RW_YL1, RW_YL2, RW_YW, RW_TAIL_F); \
            RW_STEP(2, "5", RW_YL1, RW_YL2, RW_YW, RW_TAIL_F);  RW_STEP(3, "5", RW_YL1, RW_YL2, RW_YW, RW_TAIL_F);  RW_STEP(4, "5", RW_YL1, RW_YL2, RW_YW, RW_TAIL_F); \
            RW_STEP(5, "5", RW_YL1, RW_YL2, RW_YW, RW_TAIL_F);  RW_STEP(6, "5", RW_YL1, RW_YL2, RW_YW, RW_TAIL_F);  RW_STEP(7, "5", RW_YL1, RW_YL2, RW_YW, RW_TAIL_F); \
            RW_STEP(8, "5", RW_YL1, RW_YL2, RW_YW, RW_TAIL_F);  RW_STEP(9, "5", RW_YL1, RW_YL2, RW_YW, RW_TAIL_F);  RW_STEP(10, "5", RW_YL1, RW_YL2, RW_YW, RW_TAIL_F); \
            RW_STEP(11, "5", RW_YL1, RW_YL2, RW_YW, RW_TAIL_F); RW_STEP(12, "5", RW_YL1, RW_YL2, RW_YW, RW_TAIL_F); RW_STEP(13, "5", RW_YL1, RW_YL2, RW_YW, RW_TAIL_F); \
            RW_STEP(14, "5", RW_YL1, RW_YL2, RW_YW, RW_TAIL_N); \
            RW_STEP(15, "1", RW_YL1, RW_YL2, RW_YW, RW_TAIL_N); \
            asm volatile("v_mul_f32 %[y], %[s0], %[r0]\n\tv_fmac_f32 %[y], %[s1], %[r1]\n\tds_write_b32 %[ya], %[y] offset:7680" : [y] "=&v"(y) : [s0] "v"(s0), [s1] "v"(s1), [r0] "v"(OC[3].x), [r1] "v"(OC[3].y), [ya] "v"(ya) : "memory"); \
 } while (0)
#ifdef SCAN_PROBE_NOXL
            if (dry == 2) {
#define XL8 "v_add_f32 %[p], %[p], %[p]"
#define XL4 "v_add_f32 %[p], %[p], %[p]"
#define XL2 "v_add_f32 %[p], %[p], %[p]"
#define XL1 "v_add_f32 %[p], %[p], %[p]"
#define XSW "v_add_f32 %[p], %[p], %[p2]"
                RW_ALLSTEPS();
#undef XL8
#undef XL4
#undef XL2
#undef XL1
#undef XSW
            } else
#endif
            {
#define XL8 "v_add_f32_dpp %[p], %[p], %[p] row_ror:8 row_mask:0xf bank_mask:0xf bound_ctrl:1"
#define XL4 "v_add_f32_dpp %[p], %[p], %[p] row_ror:4 row_mask:0xf bank_mask:0xf bound_ctrl:1"
#define XL2 "v_add_f32_dpp %[p], %[p], %[p] row_ror:2 row_mask:0xf bank_mask:0xf bound_ctrl:1"
#define XL1 "v_add_f32_dpp %[p], %[p], %[p] row_ror:1 row_mask:0xf bank_mask:0xf bound_ctrl:1"
#define XSW "v_permlane16_swap_b32 %[p], %[p2]"
                RW_ALLSTEPS();
            }
#undef RW_ALLSTEPS
#undef RW_STEP
#undef XL8
#undef XL4
#undef XL2
#undef XL1
#undef XSW
#undef RW_YL1
#undef RW_YL2
#undef RW_YW
#undef RW_NOP
#undef RW_TAIL_F
#undef RW_TAIL_N
#undef RW_FETCH
        }
        RW_BAR();
    }
    if (isld && !dry) RW_STORE_Y(NCH - 1);
    asm volatile("s_waitcnt vmcnt(0) lgkmcnt(0)\n\ts_barrier" ::: "memory");
#undef RW_STORE_Y
#undef RW_ISSUE
#undef RW_CONVERT
#undef RW_BAR
}

__device__ __forceinline__ int crow(int r, int hi) { return (r & 3) + 8 * (r >> 2) + 4 * hi; }
__device__ __forceinline__ void glds16(const void* gsrc, unsigned lds_dst) { unsigned keep;
    asm volatile("s_mov_b32 %0, m0\n\ts_mov_b32 m0, %2\n\ts_nop 0\n\tglobal_load_lds_dwordx4 %1, off\n\ts_mov_b32 m0, %0" : "=&s"(keep) : "v"(gsrc), "s"(lds_dst) : "memory"); }
__device__ __forceinline__ void glds4(const void* gsrc, unsigned lds_dst) { unsigned keep;
    asm volatile("s_mov_b32 %0, m0\n\ts_mov_b32 m0, %2\n\ts_nop 0\n\tglobal_load_lds_dword %1, off\n\ts_mov_b32 m0, %0" : "=&s"(keep) : "v"(gsrc), "s"(lds_dst) : "memory"); }
typedef LAS const char* lds_cptr;
constexpr int FX_K = 0, FX_V = 24576, FX_WS = 49152, FX_OST = 51200, FX_FLG = 83968, FX_KB = 84224  ;

__device__ __forceinline__ void fx_pv(f32x16* o, int vb, bf16x8 pa0, bf16x8 pa1, bf16x8 pa2, bf16x8 pa3) {
#pragma unroll
    for (int d0 = 0; d0 < 2; ++d0) { s16x4 lo[4], hi[4];
#pragma unroll
        for (int ks = 0; ks < 4; ++ks) {
            asm volatile("ds_read_b64_tr_b16 %0,%1 offset:%c2" : "=&v"(lo[ks]) : "v"(vb), "i"(d0 * 4096 + ks * 1024) : "memory");
            asm volatile("ds_read_b64_tr_b16 %0,%1 offset:%c2" : "=&v"(hi[ks]) : "v"(vb), "i"(d0 * 4096 + ks * 1024 + 512) : "memory"); }
        asm volatile("s_waitcnt lgkmcnt(0)" ::: "memory"); __builtin_amdgcn_sched_barrier(0);
#define FX_PK(k) (bf16x8){lo[k][0], lo[k][1], lo[k][2], lo[k][3], hi[k][0], hi[k][1], hi[k][2], hi[k][3]}
        o[d0] = __builtin_amdgcn_mfma_f32_32x32x16_bf16(pa0, FX_PK(0), o[d0], 0, 0, 0);
        o[d0] = __builtin_amdgcn_mfma_f32_32x32x16_bf16(pa1, FX_PK(1), o[d0], 0, 0, 0);
        o[d0] = __builtin_amdgcn_mfma_f32_32x32x16_bf16(pa2, FX_PK(2), o[d0], 0, 0, 0);
        o[d0] = __builtin_amdgcn_mfma_f32_32x32x16_bf16(pa3, FX_PK(3), o[d0], 0, 0, 0);
#undef FX_PK
    }
}
__device__ __forceinline__ float halves_max(float m) { auto rr = __builtin_amdgcn_permlane32_swap(__float_as_uint(m), __float_as_uint(m), false, false); return fmaxf(__uint_as_float(rr[0]), __uint_as_float(rr[1])); }
__device__ __forceinline__ float halves_sum(float m) { auto rr = __builtin_amdgcn_permlane32_swap(__float_as_uint(m), __float_as_uint(m), false, false); return __uint_as_float(rr[0]) + __uint_as_float(rr[1]); }

constexpr float ATT_EXIT = -40.0f;
template <int KIND>
__device__ __forceinline__ void attn_unit(const ArgsL& a, Frame& F, int b, int h, int qb, float bound) {
    const int lane = F.lane, wave = F.wave, r32 = lane & 31, hi = lane >> 5;
    LAS unsigned char* lds = F.lds;
    const bf16_t* QKV = (const bf16_t*)(a.ws + WS_QKV);
    const size_t rowbase = (size_t)b * T;
    const int p0 = qb * 256;
    constexpr int QC = KIND ? 0 : 960, KC = KIND ? 320 : 1280, VC = KIND ? 640 : 1600;
    const bf16_t* Qw = QKV + (rowbase + p0 + wave * 32) * QKV_W + QC + h * 64;
    const bf16_t* Kh = QKV + rowbase * QKV_W + KC + h * 64;
    const bf16_t* Vh = QKV + rowbase * QKV_W + VC + h * 64;
    const float* kbias = (const float*)(a.ws + WS_KB2) + (size_t)(b * FX_H + h) * KBP;
    const unsigned lds0 = (unsigned)(uintptr_t)lds;
    bf16x8 qr[4];
#pragma unroll
    for (int d0 = 0; d0 < 4; ++d0) qr[d0] = *(const bf16x8*)(Qw + (size_t)r32 * QKV_W + d0 * 16 + hi * 8);
    const int qp = p0 + wave * 32 + r32;
    const bool qvalid = (qp >= PADR) && (qp < T);
    const int plast = (p0 + 255) < (T - 1) ? (p0 + 255) : (T - 1);
    const int jlast = plast >> 6, jfirst = PADR >> 6;
    const int jw = (p0 + wave * 32 + 31) >> 6;
    const bf16_t* ksrc = Kh + (size_t)lane * QKV_W + wave * 8;
    const bf16_t* vsrc = Vh + (size_t)(16 * (wave & 3) + (lane >> 2)) * QKV_W + (wave >> 2) * 32 + (lane & 3) * 8;
    const unsigned kdst = lds0 + FX_K + wave * 1024, vdst = lds0 + FX_V + wave * 1024;
#define FX_DMA(j, slot) do { glds16(ksrc + (size_t)(j) * 64 * QKV_W, (unsigned)__builtin_amdgcn_readfirstlane(kdst + (slot) * 8192)); \
                             glds16(vsrc + (size_t)(j) * 64 * QKV_W, (unsigned)__builtin_amdgcn_readfirstlane(vdst + (slot) * 8192)); \
                             if (KIND == 0) glds4(kbias + 64 * (j) + lane, (unsigned)__builtin_amdgcn_readfirstlane(lds0 + FX_KB + (slot) * 2048 + wave * 256)); } while (0)
    const int vb0 = (int)(lds0 + FX_V) + ((lane >> 4) & 1) * 32 + (lane & 3) * 8 + (4 * hi + ((lane & 15) >> 2)) * 64;
    const lds_cptr kp0 = (lds_cptr)lds + FX_K + hi * 1024 + r32 * 16;
    LAS float* wsf = (LAS float*)(lds + FX_WS) + wave * 64;
    LAS float* flg = (LAS float*)(lds + FX_FLG);
    float m_run = KIND ? 0.f : -1.0e30f, l_run = 0.f;
    f32x16 o[2]; o[0] = f32x16{}; o[1] = f32x16{};
    asm volatile("" : "+v"(qr[0]), "+v"(qr[1]), "+v"(qr[2]), "+v"(qr[3]));
    int slot = 0;
    FX_DMA(jlast, 0);
    if (jlast > jfirst) FX_DMA(jlast - 1, 1);
    for (int j = jlast; j >= jfirst; --j) {
        if (j > jfirst) { if (KIND == 0) asm volatile("s_waitcnt vmcnt(3) lgkmcnt(0)\n\ts_barrier" ::: "memory"); else asm volatile("s_waitcnt vmcnt(2) lgkmcnt(0)\n\ts_barrier" ::: "memory"); }
        else asm volatile("s_waitcnt vmcnt(0) lgkmcnt(0)\n\ts_barrier" ::: "memory");
        if (j < jlast) {
            const LAS float* fl = flg + ((j + 1) & 1) * 16;
            const f32x4 fa = *(const LAS f32x4*)(fl), fb = *(const LAS f32x4*)(fl + 4);
            bool stop;
            if constexpr (KIND == 0) {
                const float mmin = fminf(fminf(fminf(fa.x, fa.y), fminf(fa.z, fa.w)), fminf(fminf(fb.x, fb.y), fminf(fb.z, fb.w)));
                stop = (bound + fl[8] - mmin) < ATT_EXIT;
            } else {
                const float mmax = fmaxf(fmaxf(fmaxf(fa.x, fa.y), fmaxf(fa.z, fa.w)), fmaxf(fmaxf(fb.x, fb.y), fmaxf(fb.z, fb.w)));
                stop = mmax < ATT_EXIT;
            }
            if (stop) break;
        }
        { const int s2 = slot + 2 >= 3 ? slot - 1 : slot + 2; if (j - 2 >= jfirst) FX_DMA(j - 2, s2); }
        if (j <= jw) {
            f32x16 s0v = f32x16{}, s1v = f32x16{};
            const lds_cptr kp = kp0 + slot * 8192;
#pragma unroll
            for (int d0 = 0; d0 < 4; ++d0) {
                const bf16x8 b0 = *(const LAS bf16x8*)(kp + d0 * 2048);
                const bf16x8 b1 = *(const LAS bf16x8*)(kp + d0 * 2048 + 512);
                s0v = __builtin_amdgcn_mfma_f32_32x32x16_bf16(b0, qr[d0], s0v, 0, 0, 0);
                s1v = __builtin_amdgcn_mfma_f32_32x32x16_bf16(b1, qr[d0], s1v, 0, 0, 0);
            }
            const bool edge = (64 * j + 63 >= p0 + wave * 32) || (64 * j < PADR);
            if constexpr (KIND == 0) {
                const LAS float* kbj = (const LAS float*)(lds + FX_KB + slot * 2048 + wave * 256) + 4 * hi;
#pragma unroll
                for (int g = 0; g < 4; ++g) { const f32x4 t0 = *(const LAS f32x4*)(kbj + 8 * g), t1 = *(const LAS f32x4*)(kbj + 32 + 8 * g);
                    s0v[4 * g] += t0.x; s0v[4 * g + 1] += t0.y; s0v[4 * g + 2] += t0.z; s0v[4 * g + 3] += t0.w;
                    s1v[4 * g] += t1.x; s1v[4 * g + 1] += t1.y; s1v[4 * g + 2] += t1.z; s1v[4 * g + 3] += t1.w; }
                if (edge) {
#pragma unroll
                    for (int r = 0; r < 16; ++r) { const int key = 64 * j + crow(r, hi);
                        if (key > qp || key < PADR) s0v[r] = -INFINITY;
                        if (key + 32 > qp || key + 32 < PADR) s1v[r] = -INFINITY; }
                }
                float rm = fmaxf(s0v[0], s1v[0]);
#pragma unroll
                for (int r = 1; r < 16; ++r) rm = fmaxf(rm, fmaxf(s0v[r], s1v[r]));
                rm = halves_max(rm);
                const float m_new = fmaxf(m_run, rm);
                const float f = __builtin_amdgcn_exp2f(m_run - m_new);
                m_run = m_new;
                float rs = 0.f;
#pragma unroll
                for (int r = 0; r < 16; ++r) { s0v[r] = __builtin_amdgcn_exp2f(s0v[r] - m_new); s1v[r] = __builtin_amdgcn_exp2f(s1v[r] - m_new); rs += s0v[r] + s1v[r]; }
                rs = halves_sum(rs);
                l_run = l_run * f + rs;
                if (!__all(f == 1.0f)) {
                    if (hi == 0) wsf[r32] = f;
                    LDS_WAIT();
#pragma unroll
                    for (int d_ = 0; d_ < 2; ++d_)
#pragma unroll
                        for (int r = 0; r < 16; ++r) o[d_][r] *= wsf[crow(r, hi)];
                }
            } else {
                f32x16 l0, l1;
#pragma unroll
                for (int r = 0; r < 16; ++r) {
                    const float z0 = s0v[r], z1 = s1v[r];
                    float a0 = -(fmaxf(z0, 0.f) + __builtin_amdgcn_logf(1.f + __builtin_amdgcn_exp2f(-fabsf(z0))));
                    float a1 = -(fmaxf(z1, 0.f) + __builtin_amdgcn_logf(1.f + __builtin_amdgcn_exp2f(-fabsf(z1))));
                    if (edge) { const int key = 64 * j + crow(r, hi);
                        if (key >= qp || key < PADR) { a0 = 0.f; s0v[r] = -INFINITY; }
                        if (key + 32 >= qp || key + 32 < PADR) { a1 = 0.f; s1v[r] = -INFINITY; } }
                    l0[r] = a0; l1[r] = a1;
                }
                float A[8], SA[9], SO[9];
#pragma unroll
                for (int g = 0; g < 4; ++g) { A[g] = (l0[4 * g] + l0[4 * g + 1]) + (l0[4 * g + 2] + l0[4 * g + 3]); A[4 + g] = (l1[4 * g] + l1[4 * g + 1]) + (l1[4 * g + 2] + l1[4 * g + 3]); }
                SA[8] = 0.f; SO[8] = 0.f;
#pragma unroll
                for (int g = 7; g >= 0; --g) SA[g] = A[g] + SA[g + 1];
#pragma unroll
                for (int g = 0; g < 8; ++g) { auto rr = __builtin_amdgcn_permlane32_swap(__float_as_uint(SA[g]), __float_as_uint(SA[g]), false, false); SO[g] = __uint_as_float(hi ? rr[0] : rr[1]); }
                const float R = m_run;
#pragma unroll
                for (int g = 0; g < 8; ++g) {
                    const float E = SA[g + 1] + (hi ? SO[g + 1] : SO[g]) + R;
                    if (g < 4) { float t = E;
                        s0v[4 * g + 3] = __builtin_amdgcn_exp2f(s0v[4 * g + 3] + l0[4 * g + 3] + t); t += l0[4 * g + 3];
                        s0v[4 * g + 2] = __builtin_amdgcn_exp2f(s0v[4 * g + 2] + l0[4 * g + 2] + t); t += l0[4 * g + 2];
                        s0v[4 * g + 1] = __builtin_amdgcn_exp2f(s0v[4 * g + 1] + l0[4 * g + 1] + t); t += l0[4 * g + 1];
                        s0v[4 * g + 0] = __builtin_amdgcn_exp2f(s0v[4 * g + 0] + l0[4 * g + 0] + t);
                    } else { const int q = g - 4; float t = E;
                        s1v[4 * q + 3] = __builtin_amdgcn_exp2f(s1v[4 * q + 3] + l1[4 * q + 3] + t); t += l1[4 * q + 3];
                        s1v[4 * q + 2] = __builtin_amdgcn_exp2f(s1v[4 * q + 2] + l1[4 * q + 2] + t); t += l1[4 * q + 2];
                        s1v[4 * q + 1] = __builtin_amdgcn_exp2f(s1v[4 * q + 1] + l1[4 * q + 1] + t); t += l1[4 * q + 1];
                        s1v[4 * q + 0] = __builtin_amdgcn_exp2f(s1v[4 * q + 0] + l1[4 * q + 0] + t);
                    }
                }
                m_run = R + SA[0] + SO[0];
            }
            u32x4 pw0, pw1, pw2, pw3;
            pw0 = (u32x4){pk2(s0v[0], s0v[1]), pk2(s0v[2], s0v[3]), pk2(s0v[4], s0v[5]), pk2(s0v[6], s0v[7])};
            pw1 = (u32x4){pk2(s0v[8], s0v[9]), pk2(s0v[10], s0v[11]), pk2(s0v[12], s0v[13]), pk2(s0v[14], s0v[15])};
            pw2 = (u32x4){pk2(s1v[0], s1v[1]), pk2(s1v[2], s1v[3]), pk2(s1v[4], s1v[5]), pk2(s1v[6], s1v[7])};
            pw3 = (u32x4){pk2(s1v[8], s1v[9]), pk2(s1v[10], s1v[11]), pk2(s1v[12], s1v[13]), pk2(s1v[14], s1v[15])};
            fx_pv(o, vb0 + slot * 8192, __builtin_bit_cast(bf16x8, pw0), __builtin_bit_cast(bf16x8, pw1), __builtin_bit_cast(bf16x8, pw2), __builtin_bit_cast(bf16x8, pw3));
        }
        float mm = qvalid ? m_run : (KIND ? -3.0e38f : 3.0e38f);
        if constexpr (KIND == 0) { mm = fminf(mm, dpp_f<0x128>(mm)); mm = fminf(mm, dpp_f<0x124>(mm)); mm = fminf(mm, dpp_f<0x122>(mm)); mm = fminf(mm, dpp_f<0x121>(mm));
            { auto sw = __builtin_amdgcn_permlane16_swap(__float_as_uint(mm), __float_as_uint(mm), false, false); mm = fminf(__uint_as_float(sw[0]), __uint_as_float(sw[1])); }
            { auto sw = __builtin_amdgcn_permlane32_swap(__float_as_uint(mm), __float_as_uint(mm), false, false); mm = fminf(__uint_as_float(sw[0]), __uint_as_float(sw[1])); } }
        else { mm = fmaxf(mm, dpp_f<0x128>(mm)); mm = fmaxf(mm, dpp_f<0x124>(mm)); mm = fmaxf(mm, dpp_f<0x122>(mm)); mm = fmaxf(mm, dpp_f<0x121>(mm));
            { auto sw = __builtin_amdgcn_permlane16_swap(__float_as_uint(mm), __float_as_uint(mm), false, false); mm = fmaxf(__uint_as_float(sw[0]), __uint_as_float(sw[1])); }
            { auto sw = __builtin_amdgcn_permlane32_swap(__float_as_uint(mm), __float_as_uint(mm), false, false); mm = fmaxf(__uint_as_float(sw[0]), __uint_as_float(sw[1])); } }
        if (lane == 0) { flg[(j & 1) * 16 + wave] = mm;
            if (KIND == 0 && wave == 0) flg[(j & 1) * 16 + 8] = *(const LAS float*)(lds + FX_KB + slot * 2048); }
        slot = slot == 2 ? 0 : slot + 1;
    }
    asm volatile("s_waitcnt vmcnt(0) lgkmcnt(0)\n\ts_barrier" ::: "memory");
    float rli[16];
    if constexpr (KIND == 0) {
        if (hi == 0) wsf[32 + r32] = l_run;
        LDS_WAIT();
#pragma unroll
        for (int r = 0; r < 16; ++r) rli[r] = __builtin_amdgcn_rcpf(wsf[32 + crow(r, hi)]);
    } else {
#pragma unroll
        for (int r = 0; r < 16; ++r) rli[r] = 1.0f;
    }
    bf16_t* Ow = (bf16_t*)(a.ws + WS_YCAT) + (rowbase + p0 + wave * 32) * YC_W + (KIND ? 384 : 768) + h * 64;
    {
        LAS bf16_t* stg = (LAS bf16_t*)(lds + FX_OST) + wave * 2048;
#pragma unroll
        for (int r = 0; r < 16; ++r) { const int orow = crow(r, hi);
#pragma unroll
            for (int d0 = 0; d0 < 2; ++d0) stg[orow * 64 + d0 * 32 + r32] = f2bf(o[d0][r] * rli[r]); }
        LDS_WAIT();
#pragma unroll
        for (int i = 0; i < 4; ++i) { const int row = i * 8 + (lane >> 3), ch = lane & 7; const u32x4 v = *(const LAS u32x4*)(stg + row * 64 + ch * 8);
            const int pr = p0 + wave * 32 + row;
            if (pr >= PADR && pr < T) *(u32x4*)(Ow + (size_t)row * YC_W + ch * 8) = v; }
    }
    asm volatile("s_waitcnt lgkmcnt(0)\n\ts_barrier" ::: "memory");
#undef FX_DMA
}


constexpr int CK = 64, NCK = 257, CKB = 40960, CB_ZF = 147456  ;
static_assert(LPADDED == CK * NCK, "padded steps");
__device__ __forceinline__ int swz(int row, int chunk) { return row * 128 + ((chunk ^ (row & 7)) << 4); }
__device__ __forceinline__ void ck_mm(f32x16& acc, LAS unsigned char* A, LAS unsigned char* Bt, int m0, int n0, int r32, int hi) {
#pragma unroll
    for (int ks = 0; ks < 4; ++ks) {
        const bf16x8 av = *(const LAS bf16x8*)(A + swz(m0 + r32, 2 * ks + hi));
        const bf16x8 bv = *(const LAS bf16x8*)(Bt + swz(n0 + r32, 2 * ks + hi));
        acc = __builtin_amdgcn_mfma_f32_32x32x16_bf16(av, bv, acc, 0, 0, 0);
    }
}
__device__ __forceinline__ void ck_store_t(LAS unsigned char* dst, const f32x16& acc, int m0, int n0, int r32, int hi) {
#pragma unroll
    for (int g = 0; g < 4; ++g) { const u32x2 w = {pk2(acc[4 * g], acc[4 * g + 1]), pk2(acc[4 * g + 2], acc[4 * g + 3])};
        *(LAS u32x2*)(dst + swz(n0 + r32, (m0 >> 3) + g) + hi * 8) = w; }
}
constexpr int CA_KAP = 0, CA_BET = 8192, CA_CHI = 16384, CA_RHO = 24576, CA_VMT = 32768, CA_BHT = 40960, CA_KHT = 49152, CA_AK = 57344, CA_RB = 65536, CA_RK = 73728,
              CA_AB = 81920  , CA_RHS = 98304  , CA_G64 = MISC_OFF + 2048  , CA_SCR = MISC_OFF + 4096  ;

#ifndef CA_STAGES
#define CA_STAGES 15
#endif
__device__ __forceinline__ void phase_chunkA(const ArgsL& a, Frame& F, const bool dry = false) {
    const int wave = F.wave;
    LAS unsigned char* L = F.lds;
    u32x4 pre6[6];
    for (int id = F.bx; id < 12 * NCK; id += (int)gridDim.x) {
        int tid = F.tid, lane, r32, hi;
#define CK_FRESH() do { asm volatile("" : "+v"(tid)); lane = tid & 63; r32 = lane & 31; hi = lane >> 5; } while (0)
        CK_FRESH();
        const int bh = id / NCK, c = id - bh * NCK;
        unsigned char* blk = a.ws + WS_RW + ((size_t)bh * LPADDED + (size_t)c * CK) * 768;
        {
            if (id == F.bx) {
#pragma unroll
                for (int q6 = 0; q6 < 6; ++q6) pre6[q6] = *(const u32x4*)(blk + (size_t)(tid + q6 * NTHR) * 16);
            }
#pragma unroll
            for (int q6 = 0; q6 < 6; ++q6) *(LAS u32x4*)(L + CA_AB + (tid + q6 * NTHR) * 16) = pre6[q6];
            __syncthreads();
            const int k = tid & 63, tq = tid >> 6;
            const LAS _Float16* src = (const LAS _Float16*)(L + CA_AB) + (tq * 8) * 384 + k;
            float kk[8], w[8], bb[8], kp[8], rr[8], vv[8];
#pragma unroll
            for (int e = 0; e < 8; ++e) { kk[e] = (float)src[e * 384]; w[e] = 1.f + (float)src[e * 384 + 64]; bb[e] = -(float)src[e * 384 + 128];
                kp[e] = (float)src[e * 384 + 192]; rr[e] = (float)src[e * 384 + 256]; vv[e] = (float)src[e * 384 + 320]; }
            float g[8]; g[0] = w[0];
#pragma unroll
            for (int e = 1; e < 8; ++e) g[e] = g[e - 1] * w[e];
            LAS float* scr = (LAS float*)(L + CA_SCR);
            scr[tq * 64 + k] = g[7];
            __syncthreads();
            {
                const int idn = id + (int)gridDim.x;
                if (idn < 12 * NCK) { const int bhn = idn / NCK, cn = idn - bhn * NCK; const unsigned char* bn_ = a.ws + WS_RW + ((size_t)bhn * LPADDED + (size_t)cn * CK) * 768;
#pragma unroll
                    for (int q6 = 0; q6 < 6; ++q6) pre6[q6] = *(const u32x4*)(bn_ + (size_t)(tid + q6 * NTHR) * 16); }
            }
            float pre = 1.f, tot = 1.f;
#pragma unroll
            for (int q = 0; q < 8; ++q) { const float s = scr[q * 64 + k]; if (q < tq) pre *= s; tot *= s; }
            if (tq == 0) ((LAS float*)(L + CA_G64))[k] = tot;
            unsigned bh4[4], kh4[4], vm4[4];
            float Gp = pre;
#pragma unroll
            for (int e = 0; e < 8; ++e) {
                const int t = tq * 8 + e; const float G = pre * g[e], iG = __builtin_amdgcn_rcpf(G);
                const float kap = kk[e] * Gp, bet = bb[e] * iG, chi = kp[e] * iG, rho = rr[e] * G;
                const int o = swz(t, k >> 3) + (k & 7) * 2;
                *(LAS unsigned short*)(L + CA_KAP + o) = f2bf(kap); *(LAS unsigned short*)(L + CA_BET + o) = f2bf(bet);
                *(LAS unsigned short*)(L + CA_CHI + o) = f2bf(chi); *(LAS unsigned short*)(L + CA_RHO + o) = f2bf(rho);
                ((LAS float*)(L + CA_RHS))[t * 128 + k] = kap;
                const float bhv = bet * tot, khv = chi * tot;
                if (e & 1) { bh4[e >> 1] |= (unsigned)f2bf(bhv) << 16; kh4[e >> 1] |= (unsigned)f2bf(khv) << 16; vm4[e >> 1] |= (unsigned)f2bf(vv[e]) << 16; }
                else { bh4[e >> 1] = f2bf(bhv); kh4[e >> 1] = f2bf(khv); vm4[e >> 1] = f2bf(vv[e]); }
                Gp = G;
            }
            *(LAS u32x4*)(L + CA_BHT + swz(k, tq)) = (u32x4){bh4[0], bh4[1], bh4[2], bh4[3]};
            *(LAS u32x4*)(L + CA_KHT + swz(k, tq)) = (u32x4){kh4[0], kh4[1], kh4[2], kh4[3]};
            *(LAS u32x4*)(L + CA_VMT + swz(k, tq)) = (u32x4){vm4[0], vm4[1], vm4[2], vm4[3]};
        }
        __syncthreads();
        CK_FRESH();
        if (!dry || (CA_STAGES & 2)) {
            const int p = wave & 3, nb = wave >> 2;
            LAS unsigned char* Am = L + ((p & 1) ? CA_CHI : CA_BET);
            LAS unsigned char* Bm = L + ((p & 2) ? CA_RHO : CA_KAP);
#pragma unroll
            for (int mb = 0; mb < 2; ++mb) {
                f32x16 acc = f32x16{};
                if (!(mb == 1 && nb == 0)) ck_mm(acc, Am, Bm, mb * 32, nb * 32, r32, hi);
                const int t = nb * 32 + r32;
#pragma unroll
                for (int i = 0; i < 16; ++i) { const int j = mb * 32 + crow(i, hi); const bool keep = (p & 2) ? (j <= t) : (j < t); if (!keep) acc[i] = 0.f; }
                if (p == 0) {
#pragma unroll
                    for (int gq = 0; gq < 4; ++gq) { LAS float* ab_ = (LAS float*)(L + CA_AB) + t * 64 + (mb * 8 + 2 * gq + hi);
                        ab_[0] = acc[4 * gq]; ab_[16] = acc[4 * gq + 1]; ab_[32] = acc[4 * gq + 2]; ab_[48] = acc[4 * gq + 3]; }
                } else ck_store_t(L + (p == 1 ? CA_AK : p == 2 ? CA_RB : CA_RK), acc, mb * 32, nb * 32, r32, hi);
            }
        }
        __syncthreads();
        CK_FRESH();
        if (wave < 4 && (!dry || (CA_STAGES & 2))) {
            const int mb = wave >> 1, nb = wave & 1;
            f32x16 acc = f32x16{};
            ck_mm(acc, L + CA_AK, L + CA_VMT, mb * 32, nb * 32, r32, hi);
#pragma unroll
            for (int i = 0; i < 16; ++i) ((LAS float*)(L + CA_RHS))[(mb * 32 + crow(i, hi)) * 128 + 64 + nb * 32 + r32] = acc[i];
        }
        __syncthreads();
        CK_FRESH();
        if (!dry || (CA_STAGES & 4)) {
            const int col = tid >> 2, p = tid & 3;
            unsigned abv = (unsigned)(uintptr_t)(L + CA_AB) + p * 64; asm volatile("" : "+v"(abv));
            const LAS float* ab = (const LAS float*)(uintptr_t)abv;
            const LAS float* rhs = (const LAS float*)(L + CA_RHS) + col;
            float xo[16];
#pragma unroll
            for (int i = 0; i < 16; ++i) xo[i] = 0.f;
#pragma unroll
            for (int tg = 0; tg < 64; tg += 4) {
                f32x4 av[4][4]; float rv[4];
#pragma unroll
                for (int r = 0; r < 4; ++r) { rv[r] = rhs[(tg + r) * 128];
#pragma unroll
                    for (int i4 = 0; i4 < (tg + r + 15) / 16; ++i4) av[r][i4] = *(const LAS f32x4*)(ab + (tg + r) * 64 + 4 * i4); }
#pragma unroll
                for (int r = 0; r < 4; ++r) { const int t = tg + r;
                    float s0 = (p == 0) ? rv[r] : 0.f, s1 = 0.f;
#pragma unroll
                    for (int i4 = 0; i4 < (t + 15) / 16; ++i4) {
                        s0 -= av[r][i4].x * xo[4 * i4]; s1 -= av[r][i4].y * xo[4 * i4 + 1]; s0 -= av[r][i4].z * xo[4 * i4 + 2]; s1 -= av[r][i4].w * xo[4 * i4 + 3]; }
                    float sx = s0 + s1;
                    sx += dpp_f<0xB1>(sx);
                    sx += dpp_f<0x4E>(sx);
                    if ((t & 3) == p) xo[t >> 2] = sx;
                    asm volatile("" : "+v"(xo[t >> 2]));
                }
                __builtin_amdgcn_sched_barrier(0);
            }
            LAS unsigned char* dst = L + (col < 64 ? CA_KAP : CA_BET);
            const int rowc = col & 63;
#pragma unroll
            for (int i = 0; i < 16; ++i) { const int tt = 4 * i + p; *(LAS unsigned short*)(dst + swz(rowc, tt >> 3) + (tt & 7) * 2) = f2bf(-xo[i]); }
        }
        __syncthreads();
        CK_FRESH();
        if (!dry || (CA_STAGES & 8)) {
            const int ty = wave >> 1;
            LAS unsigned char* nW1 = L + CA_KAP; LAS unsigned char* nW2 = L + CA_BET;
#pragma unroll
            for (int qq = 0; qq < 2; ++qq) {
                const int q = (wave & 1) * 2 + qq, qa = q >> 1, qb = q & 1;
                f32x16 acc = f32x16{};
                if (ty == 0) {
                    const int t = qa * 32 + r32;
#pragma unroll
                    for (int gq = 0; gq < 4; ++gq) { const u32x2 rv = *(const LAS u32x2*)(L + CA_RHO + swz(t, qb * 4 + gq) + hi * 8);
                        acc[4 * gq] = bf_lo(rv.x); acc[4 * gq + 1] = bf_hi(rv.x); acc[4 * gq + 2] = bf_lo(rv.y); acc[4 * gq + 3] = bf_hi(rv.y); }
                    ck_mm(acc, nW1, L + CA_RB, qb * 32, qa * 32, r32, hi);
                } else if (ty == 1) {
                    ck_mm(acc, nW1, L + CA_BHT, qb * 32, qa * 32, r32, hi);
                    if (qa == qb) { const float g64 = ((const LAS float*)(L + CA_G64))[qa * 32 + r32];
#pragma unroll
                        for (int i = 0; i < 16; ++i) if (crow(i, hi) == r32) acc[i] += g64; }
                } else if (ty == 2) {
                    ck_mm(acc, L + CA_KHT, L + CA_VMT, qb * 32, qa * 32, r32, hi);
                    ck_mm(acc, L + CA_BHT, nW2, qb * 32, qa * 32, r32, hi);
                } else {
                    ck_mm(acc, L + CA_VMT, L + CA_RK, qa * 32, qb * 32, r32, hi);
                    ck_mm(acc, nW2, L + CA_RB, qa * 32, qb * 32, r32, hi);
                }
                if (dry) { float sink = acc[0] + acc[5] + acc[10] + acc[15]; asm volatile("" :: "v"(sink)); }
                else if (ty < 2) {
                    unsigned char* o = blk + (ty == 0 ? 8192 : 0) + (size_t)(((qa * 2 + qb) * 2) * 1024) + lane * 16;
#pragma unroll
                    for (int ks = 0; ks < 2; ++ks)
                        *(u32x4*)(o + ks * 1024) = (u32x4){pk2(acc[8 * ks], acc[8 * ks + 1]), pk2(acc[8 * ks + 2], acc[8 * ks + 3]), pk2(acc[8 * ks + 4], acc[8 * ks + 5]), pk2(acc[8 * ks + 6], acc[8 * ks + 7])};
                } else if (ty == 2) {
                    unsigned char* o = blk + 16384 + (qa * 2 + qb) * 4096 + lane * 16;
#pragma unroll
                    for (int g = 0; g < 4; ++g) *(f32x4*)(o + g * 1024) = (f32x4){acc[4 * g], acc[4 * g + 1], acc[4 * g + 2], acc[4 * g + 3]};
                } else {
                    unsigned char* o = blk + 32768 + (qa * 2 + qb) * 2048 + lane * 8;
#pragma unroll
                    for (int g = 0; g < 4; ++g) *(u32x2*)(o + g * 512) = (u32x2){pk2(acc[4 * g], acc[4 * g + 1]), pk2(acc[4 * g + 2], acc[4 * g + 3])};
                }
            }
        }
        __syncthreads();
    }
}

__device__ __forceinline__ void rwkv_chunkB(const ArgsL& a, Frame& F, int bh) {
    const int lane = F.lane, wave = F.wave, r32 = lane & 31, hi = lane >> 5;
    const int b = bh / RW_H, h = bh % RW_H;
    LAS unsigned char* L = F.lds;
    const unsigned char* base = a.ws + WS_RW + (size_t)bh * LPADDED * 768;
    bf16_t* y0 = (bf16_t*)(a.ws + WS_YCAT);
    const bool isld = (wave & 2) != 0; const int lw = (wave & 1) + ((wave >> 2) << 1);
    LAS unsigned char* yimg0 = L + 3 * CKB; LAS unsigned char* yimg1 = L + MISC_OFF + 8192;
    LAS unsigned char* zfb = L + CB_ZF;
#define CB_ISSUE(cc) do { const unsigned char* s_ = base + (size_t)(cc) * CK * 768 + (size_t)lw * 1024 + lane * 16; LAS unsigned char* d_ = L + ((cc) % 3) * CKB + lw * 1024; \
        _Pragma("unroll") for (int r_ = 0; r_ < 10; ++r_) __builtin_amdgcn_global_load_lds((const unsigned*)(s_ + r_ * 4096), (LAS unsigned*)(d_ + r_ * 4096), 16, 0, 0); } while (0)
#define CB_YOUT(cc) do { const LAS unsigned char* im_ = ((cc) & 1) ? yimg1 : yimg0; \
        _Pragma("unroll") for (int r_ = 0; r_ < 8; ++r_) { const int t_ = r_ * 8 + (lane >> 3), l_ = (cc) * CK + t_; const u32x4 v_ = *(const LAS u32x4*)(im_ + t_ * 128 + (((lane & 7) ^ (t_ & 7)) * 16)); \
            if (l_ < LTOK) *(u32x4*)(y0 + (size_t)(b * T + PADR + l_) * YC_W + h * 64 + (lane & 7) * 8) = v_; } } while (0)
    if (isld) { CB_ISSUE(0); CB_ISSUE(1); asm volatile("s_waitcnt vmcnt(10)" ::: "memory"); }
    bf16x8 zf[2][2];
#pragma unroll
    for (int q = 0; q < 4; ++q) zf[q >> 1][q & 1] = bf16x8{};
    if (wave < 2) {
#pragma unroll
        for (int q = 0; q < 4; ++q) *(LAS bf16x8*)(zfb + wave * 4096 + q * 1024 + lane * 16) = bf16x8{};
    }
    asm volatile("s_waitcnt lgkmcnt(0)\n\ts_barrier" ::: "memory");
    for (int c = 0; c < NCK; ++c) {
        const LAS unsigned char* S = L + (c % 3) * CKB;
        if (wave < 2) {
            const int vb = wave;
            f32x16 N0, N1;
            { const LAS unsigned char* n0 = S + 16384 + (vb * 2 + 0) * 4096 + lane * 16; const LAS unsigned char* n1 = S + 16384 + (vb * 2 + 1) * 4096 + lane * 16;
#pragma unroll
              for (int g = 0; g < 4; ++g) { const f32x4 u0 = *(const LAS f32x4*)(n0 + g * 1024), u1 = *(const LAS f32x4*)(n1 + g * 1024);
                  N0[4 * g] = u0.x; N0[4 * g + 1] = u0.y; N0[4 * g + 2] = u0.z; N0[4 * g + 3] = u0.w; N1[4 * g] = u1.x; N1[4 * g + 1] = u1.y; N1[4 * g + 2] = u1.z; N1[4 * g + 3] = u1.w; } }
#pragma unroll
            for (int kb2 = 0; kb2 < 2; ++kb2)
#pragma unroll
                for (int ks = 0; ks < 2; ++ks) {
                    const bf16x8 m0 = *(const LAS bf16x8*)(S + ((0 * 2 + kb2) * 2 + ks) * 1024 + lane * 16);
                    const bf16x8 m1 = *(const LAS bf16x8*)(S + ((1 * 2 + kb2) * 2 + ks) * 1024 + lane * 16);
                    N0 = __builtin_amdgcn_mfma_f32_32x32x16_bf16(m0, zf[kb2][ks], N0, 0, 0, 0);
                    N1 = __builtin_amdgcn_mfma_f32_32x32x16_bf16(m1, zf[kb2][ks], N1, 0, 0, 0);
                }
            LAS unsigned char* zo = zfb + ((c + 1) & 1) * 8192 + vb * 4096 + lane * 16;
#pragma unroll
            for (int ks = 0; ks < 2; ++ks) {
                zf[0][ks] = __builtin_bit_cast(bf16x8, (u32x4){pk2(N0[8 * ks], N0[8 * ks + 1]), pk2(N0[8 * ks + 2], N0[8 * ks + 3]), pk2(N0[8 * ks + 4], N0[8 * ks + 5]), pk2(N0[8 * ks + 6], N0[8 * ks + 7])});
                zf[1][ks] = __builtin_bit_cast(bf16x8, (u32x4){pk2(N1[8 * ks], N1[8 * ks + 1]), pk2(N1[8 * ks + 2], N1[8 * ks + 3]), pk2(N1[8 * ks + 4], N1[8 * ks + 5]), pk2(N1[8 * ks + 6], N1[8 * ks + 7])});
                *(LAS bf16x8*)(zo + (0 * 2 + ks) * 1024) = zf[0][ks]; *(LAS bf16x8*)(zo + (1 * 2 + ks) * 1024) = zf[1][ks];
            }
        } else if (isld) {
            if (wave == 6 && c > 0) CB_YOUT(c - 1);
            if (c + 2 < NCK) CB_ISSUE(c + 2);
            if (wave < 4) {
                const int vb = wave - 2;
                LAS unsigned char* yim = (c & 1) ? yimg1 : yimg0;
                const LAS unsigned char* zs = zfb + (c & 1) * 8192 + vb * 4096 + lane * 16;
                bf16x8 zq[2][2];
#pragma unroll
                for (int q = 0; q < 4; ++q) zq[q >> 1][q & 1] = *(const LAS bf16x8*)(zs + q * 1024);
#pragma unroll
                for (int tb = 0; tb < 2; ++tb) {
                    f32x16 acc;
                    const LAS unsigned char* yt = S + 32768 + (vb * 2 + tb) * 2048 + lane * 8;
#pragma unroll
                    for (int g = 0; g < 4; ++g) { const u32x2 w = *(const LAS u32x2*)(yt + g * 512); acc[4 * g] = bf_lo(w.x); acc[4 * g + 1] = bf_hi(w.x); acc[4 * g + 2] = bf_lo(w.y); acc[4 * g + 3] = bf_hi(w.y); }
#pragma unroll
                    for (int kb2 = 0; kb2 < 2; ++kb2)
#pragma unroll
                        for (int ks = 0; ks < 2; ++ks) { const bf16x8 pa = *(const LAS bf16x8*)(S + 8192 + ((tb * 2 + kb2) * 2 + ks) * 1024 + lane * 16);
                            acc = __builtin_amdgcn_mfma_f32_32x32x16_bf16(zq[kb2][ks], pa, acc, 0, 0, 0); }
                    const int t = tb * 32 + r32;
#pragma unroll
                    for (int g = 0; g < 4; ++g) { const u32x2 w = {pk2(acc[4 * g], acc[4 * g + 1]), pk2(acc[4 * g + 2], acc[4 * g + 3])};
                        *(LAS u32x2*)(yim + t * 128 + (((vb * 8 + 2 * g + hi) ^ (2 * (t & 7))) * 8)) = w; }
                }
            }
            if (c + 2 < NCK) asm volatile("s_waitcnt vmcnt(10)" ::: "memory"); else asm volatile("s_waitcnt vmcnt(0)" ::: "memory");
        }
        asm volatile("s_waitcnt lgkmcnt(0)\n\ts_barrier" ::: "memory");
    }
    if (wave == 6) CB_YOUT(NCK - 1);
    asm volatile("s_waitcnt vmcnt(0) lgkmcnt(0)\n\ts_barrier" ::: "memory");
#undef CB_ISSUE
#undef CB_YOUT
}

constexpr int N_FX_UNITS = 65 * 10, N_SB_UNITS = 65 * 10, N_RW_WG = 192;
#ifndef REP_SCAN
#define REP_SCAN 1
#endif
#ifndef REP_SCAN_DRY
#define REP_SCAN_DRY 0
#endif
#ifndef REP_FOX
#define REP_FOX 1
#endif
#ifndef REP_SB
#define REP_SB 1
#endif
__device__ __forceinline__ void phase_mix(const ArgsL& a, Frame& F, int layer) {
#ifdef SEQ_SCAN
    if (F.bx < N_RW_WG) { int nr = REP_SCAN; asm volatile("" : "+s"(nr)); for (int r = 0; r < nr; ++r) rwkv_scan(a, F, F.bx, (r + 1 < nr) ? REP_SCAN_DRY : 0); }
#else
#ifndef REP_CHB
#define REP_CHB 1
#endif
    if (F.bx < 12) { int nr = REP_CHB; asm volatile("" : "+s"(nr)); for (int r = 0; r < nr; ++r) rwkv_chunkB(a, F, F.bx); }
#endif
    float gqm = fabsf(a.in(I_QG)[layer * 64 + F.lane]), gkm = fabsf(a.in(I_KG)[layer * 64 + F.lane]);
#pragma unroll
    for (int off = 1; off < 64; off <<= 1) { gqm = fmaxf(gqm, __shfl_xor(gqm, off)); gkm = fmaxf(gkm, __shfl_xor(gkm, off)); }
    const float bound = 64.0f * C2 * gqm * gkm * 1.02f + 0.5f;
    unsigned* head = (unsigned*)(a.ws + WS_CTL) + CW_QUEUE + 64 * layer;
    for (;;) {
        if (F.tid == 0) F.MISC[16] = __hip_atomic_fetch_add(head, 1u, __ATOMIC_RELAXED, __HIP_MEMORY_SCOPE_AGENT);
        __syncthreads();
        const int u = (int)F.MISC[16];
        __syncthreads();
        if (u >= N_FX_UNITS + N_SB_UNITS) break;
        if (u < N_FX_UNITS) { const int qb = 64 - u / 10, bh = u % 10; int nr = REP_FOX; asm volatile("" : "+s"(nr)); for (int r = 0; r < nr; ++r) attn_unit<0>(a, F, bh / FX_H, bh % FX_H, qb, bound); }
        else { const int v = u - N_FX_UNITS; const int qb = 64 - v / 10, bh = v % 10; int nr = REP_SB; asm volatile("" : "+s"(nr)); for (int r = 0; r < nr; ++r) attn_unit<1>(a, F, bh / SB_H, bh % SB_H, qb, bound); }
    }
}

__device__ __forceinline__ void chain_publish(unsigned* cnt, int pm) {
    asm volatile("s_waitcnt vmcnt(0)" ::: "memory");
    if ((threadIdx.x & 63) == 0) __hip_atomic_fetch_add(cnt + CH_STRIDE * pm, 1u, __ATOMIC_RELAXED, __HIP_MEMORY_SCOPE_AGENT);
}
template <bool WAIT, bool PUB>
struct ChainOrder : pg8::StaticOrder {
    const unsigned* ready; unsigned need; unsigned* mine;
    __device__ __forceinline__ void a_ready(const pg8::Unit& u) const {
        if constexpr (WAIT) {
            if (threadIdx.x < 64) {
                const unsigned* w = ready + CH_STRIDE * u.pm; unsigned polls = 0;
                while ((unsigned)__builtin_amdgcn_readfirstlane(__hip_atomic_load(w, __ATOMIC_RELAXED, __HIP_MEMORY_SCOPE_AGENT)) < need) { if (++polls > (1u << 18)) break; __builtin_amdgcn_s_sleep(2); }
                __builtin_amdgcn_fence(__ATOMIC_ACQUIRE, "agent");
                asm volatile("s_waitcnt vmcnt(0)" ::: "memory");
            }
            asm volatile("" ::: "memory"); __builtin_amdgcn_s_barrier(); asm volatile("" ::: "memory");
        }
    }
    __device__ __forceinline__ void done(const pg8::Unit& u) const { if constexpr (PUB) chain_publish(mine, u.pm); }
};

__device__ __forceinline__ void phase_post(const ArgsL& a, Frame& F, int layer, unsigned* chain, const bool dry = false) {
    const int lane = F.lane, wave = F.wave, it4 = lane >> 4, e4 = lane & 15;
    bf16_t* Y0 = (bf16_t*)(a.ws + WS_YCAT); const bf16_t* BN = (const bf16_t*)(a.ws + WS_BN);
    const __amdgpu_buffer_rsrc_t yrs = __builtin_amdgcn_make_buffer_rsrc((void*)Y0, 0, (int)((size_t)M * YC_W * 2), 0x00020000);
    LAS float* lgl = (LAS float*)F.lds;
    for (int i = F.tid; i < 2 * RW_W; i += NTHR) lgl[i] = (i < RW_W) ? a.in(I_LNG)[layer * RW_W + i] : a.in(I_LNB)[layer * RW_W + i - RW_W];
    __syncthreads();
    unsigned* head = (unsigned*)(a.ws + WS_CTL) + CW_QUEUE + 64 * layer + 32 + (dry ? 8 : 0);
    for (;;) {
        if (F.tid == 0) F.MISC[17] = __hip_atomic_fetch_add(head, 1u, __ATOMIC_RELAXED, __HIP_MEMORY_SCOPE_AGENT);
        __syncthreads();
        const int ch = (int)F.MISC[17];
        __syncthreads();
        if (ch >= M / 64) break;
        u32x2 yn = {0u, 0u}, bn = {0u, 0u};
#define PP_ADDR(ps) const int item_ = (ps) * 32 + wave * 4 + it4, rw_ = item_ / 6, hh_ = item_ - rw_ * 6; const int m_ = ch * 64 + rw_; const size_t off_ = (size_t)m_ * RW_W + hh_ * 64 + e4 * 4, offy_ = (size_t)m_ * YC_W + hh_ * 64 + e4 * 4
        { PP_ADDR(0); yn = *(const u32x2*)(Y0 + offy_); bn = *(const u32x2*)(BN + off_); }
#pragma unroll 1
        for (int ps = 0; ps < 12; ++ps) {
            const u32x2 yv = yn, bv = bn;
            if (ps + 1 < 12) { PP_ADDR(ps + 1); yn = *(const u32x2*)(Y0 + offy_); bn = *(const u32x2*)(BN + off_); }
            PP_ADDR(ps);
            const int p = m_ % T;
            u32x2 w = {0u, 0u};
            if (p >= PADR) {
                const float y0 = bf_lo(yv.x), y1 = bf_hi(yv.x), y2 = bf_lo(yv.y), y3 = bf_hi(yv.y);
                const float mean = allred16((y0 + y1) + (y2 + y3)) * (1.f / 64.f);
                const float d0 = y0 - mean, d1 = y1 - mean, d2 = y2 - mean, d3 = y3 - mean;
                const float rs = 1.0f / sqrtf(allred16((d0 * d0 + d1 * d1) + (d2 * d2 + d3 * d3)) * (1.f / 64.f) + 64e-5f);
                const f32x4 g4 = *(const LAS f32x4*)(lgl + hh_ * 64 + e4 * 4), b4 = *(const LAS f32x4*)(lgl + RW_W + hh_ * 64 + e4 * 4);
                w = (u32x2){pk2(d0 * rs * g4.x + b4.x + bf_lo(bv.x), d1 * rs * g4.y + b4.y + bf_hi(bv.x)), pk2(d2 * rs * g4.z + b4.z + bf_lo(bv.y), d3 * rs * g4.w + b4.w + bf_hi(bv.y))};
            }
            if (!dry) __builtin_amdgcn_raw_buffer_store_b64(w, yrs, (int)(offy_ * 2), 0, 16); else asm volatile("" :: "v"(w.x), "v"(w.y));
        }
#undef PP_ADDR
        if (!dry) {
#pragma unroll 1
            for (int k = 0; k < 16; ++k) { const int pr = wave * 16 + k, sl = pr >> 6, m2 = ch * 64 + (pr & 63); const int p = m2 % T;
                const int rowb = (int)(((size_t)m2 * YC_W + 384 * (sl + 1)) * 2);
                if (p < PADR) { for (int c = lane; c < RW_W / 2; c += 64) __builtin_amdgcn_raw_buffer_store_b32(0u, yrs, rowb + 4 * c, 0, 16); }
                else if (lane < 32) __builtin_amdgcn_raw_buffer_store_b32(0u, yrs, rowb + 640 + 4 * lane, 0, 16); }
            chain_publish(chain, ch >> 2);
        }
    }
}

struct EpiInproj { static constexpr bool PERM = true, AFTER_DRAIN = false, MIDHOOK = false; bf16_t* ush; bf16_t* qkv;
    __device__ __forceinline__ void operator()(const f32x4 (&acc)[2][2][4][2], const pg8::Unit& u, int wr, int wc, int fr, int fq) const {
        asm volatile("" : "+v"(fr), "+v"(fq));
        const int row0 = u.pm * 256 + wr * 64 + fr, colt = u.pn * 256 + wc * 32 + 8 * fq;
#pragma unroll
        for (int ai = 0; ai < 2; ++ai)
#pragma unroll
            for (int m = 0; m < 4; ++m) { const size_t row = (size_t)(row0 + ai * 128 + m * 16);
#pragma unroll
                for (int bj = 0; bj < 2; ++bj) { const int col = colt + bj * 128; const f32x4 v0 = acc[ai][bj][m][0], v1 = acc[ai][bj][m][1];
                    const float sc = (col >= SHIFT_W && col < SHIFT_W + 320) ? C2 : 1.0f;
                    u32x4 w; w.x = pk2(v0[0] * sc, v0[1] * sc); w.y = pk2(v0[2] * sc, v0[3] * sc); w.z = pk2(v1[0] * sc, v1[1] * sc); w.w = pk2(v1[2] * sc, v1[3] * sc);
                    if (col < SHIFT_W) *(u32x4*)(ush + row * SHIFT_W + col) = w;
                    else if (col < SHIFT_W + QKV_W) *(u32x4*)(qkv + row * QKV_W + (col - SHIFT_W)) = w; } }
    }
};
struct EpiGates { static constexpr bool PERM = true, AFTER_DRAIN = false, MIDHOOK = false; bf16_t* gates;
    __device__ __forceinline__ void operator()(const f32x4 (&acc)[2][2][4][2], const pg8::Unit& u, int wr, int wc, int fr, int fq) const {
        asm volatile("" : "+v"(fr), "+v"(fq));
        const int row0 = u.pm * 256 + wr * 64 + fr, colt = u.pn * 256 + wc * 32 + 8 * fq;
        const __amdgpu_buffer_rsrc_t rs = __builtin_amdgcn_make_buffer_rsrc((void*)gates, 0, (int)((size_t)M * 3072 * 2), 0x00020000);
#pragma unroll
        for (int ai = 0; ai < 2; ++ai)
#pragma unroll
            for (int m = 0; m < 4; ++m) { const size_t row = (size_t)(row0 + ai * 128 + m * 16);
#pragma unroll
                for (int bj = 0; bj < 2; ++bj) { const int col = colt + bj * 128; f32x4 v0 = acc[ai][bj][m][0], v1 = acc[ai][bj][m][1];
#pragma unroll
                    for (int q = 0; q < 4; ++q) { v0[q] = __builtin_amdgcn_rcpf(1.f + __builtin_amdgcn_exp2f(-v0[q] * LOG2E)); v1[q] = __builtin_amdgcn_rcpf(1.f + __builtin_amdgcn_exp2f(-v1[q] * LOG2E)); }
                    u32x4 w; w.x = pk2(v0[0], v0[1]); w.y = pk2(v0[2], v0[3]); w.z = pk2(v1[0], v1[1]); w.w = pk2(v1[2], v1[3]);
                    __builtin_amdgcn_raw_buffer_store_b128(w, rs, (int)((row * 3072 + col) * 2), 0, 16); } }
    }
};
struct EpiMergeF { static constexpr bool PERM = true, AFTER_DRAIN = false, MIDHOOK = true; const bf16_t* gates; bf16_t* merged;
    __device__ __forceinline__ void mid(f32x4 (&acc)[2][2][4][2], const pg8::Unit& u, int wr, int wc, int fr, int fq, int seg) const {
        asm volatile("" : "+v"(fr), "+v"(fq));
        const int row0 = u.pm * 256 + wr * 64 + fr, colt = u.pn * 256 + wc * 32 + 8 * fq;
        u32x4 gpn[2], gnn[2];
#define MG_LOAD(q) do { const bf16_t* gpt_ = gates + (size_t)(row0 + ((q) >> 2) * 128 + ((q) & 3) * 16) * 3072 + (seg - 1) * 1024 + colt; \
            gpn[0] = *(const u32x4*)gpt_; gnn[0] = *(const u32x4*)(gpt_ + 1024); gpn[1] = *(const u32x4*)(gpt_ + 128); gnn[1] = *(const u32x4*)(gpt_ + 1024 + 128); } while (0)
        MG_LOAD(0);
#pragma unroll
        for (int q = 0; q < 8; ++q) { const int ai = q >> 2, m = q & 3;
            u32x4 gp[2], gn[2];
#pragma unroll
            for (int bj = 0; bj < 2; ++bj) { gp[bj] = gpn[bj]; gn[bj] = gnn[bj]; }
            if (q < 7) MG_LOAD(q + 1);
#pragma unroll
            for (int bj = 0; bj < 2; ++bj) { f32x4& v0 = acc[ai][bj][m][0]; f32x4& v1 = acc[ai][bj][m][1];
                v0[0] *= bf_lo(gp[bj].x) * __builtin_amdgcn_rcpf(bf_lo(gn[bj].x)); v0[1] *= bf_hi(gp[bj].x) * __builtin_amdgcn_rcpf(bf_hi(gn[bj].x));
                v0[2] *= bf_lo(gp[bj].y) * __builtin_amdgcn_rcpf(bf_lo(gn[bj].y)); v0[3] *= bf_hi(gp[bj].y) * __builtin_amdgcn_rcpf(bf_hi(gn[bj].y));
                v1[0] *= bf_lo(gp[bj].z) * __builtin_amdgcn_rcpf(bf_lo(gn[bj].z)); v1[1] *= bf_hi(gp[bj].z) * __builtin_amdgcn_rcpf(bf_hi(gn[bj].z));
                v1[2] *= bf_lo(gp[bj].w) * __builtin_amdgcn_rcpf(bf_lo(gn[bj].w)); v1[3] *= bf_hi(gp[bj].w) * __builtin_amdgcn_rcpf(bf_hi(gn[bj].w)); }
            __builtin_amdgcn_sched_barrier(0); }
#undef MG_LOAD
    }
    __device__ __forceinline__ void operator()(const f32x4 (&acc)[2][2][4][2], const pg8::Unit& u, int wr, int wc, int fr, int fq) const {
        asm volatile("" : "+v"(fr), "+v"(fq));
        const int row0 = u.pm * 256 + wr * 64 + fr, colt = u.pn * 256 + wc * 32 + 8 * fq;
        const __amdgpu_buffer_rsrc_t mrs = __builtin_amdgcn_make_buffer_rsrc((void*)merged, 0, (int)((size_t)M * D * 2), 0x00020000);
        u32x4 gnx[2];
#define MG_LOAD2(q) do { const bf16_t* gpt_ = gates + (size_t)(row0 + ((q) >> 2) * 128 + ((q) & 3) * 16) * 3072 + 2048 + colt; gnx[0] = *(const u32x4*)gpt_; gnx[1] = *(const u32x4*)(gpt_ + 128); } while (0)
        MG_LOAD2(0);
#pragma unroll
        for (int q = 0; q < 8; ++q) { const int ai = q >> 2, m = q & 3; const size_t row = (size_t)(row0 + ai * 128 + m * 16);
            u32x4 g[2];
#pragma unroll
            for (int bj = 0; bj < 2; ++bj) g[bj] = gnx[bj];
            if (q < 7) MG_LOAD2(q + 1);
#pragma unroll
            for (int bj = 0; bj < 2; ++bj) { const f32x4 v0 = acc[ai][bj][m][0], v1 = acc[ai][bj][m][1];
                u32x4 w;
                w.x = pk2(bf_lo(g[bj].x) * v0[0], bf_hi(g[bj].x) * v0[1]); w.y = pk2(bf_lo(g[bj].y) * v0[2], bf_hi(g[bj].y) * v0[3]);
                w.z = pk2(bf_lo(g[bj].z) * v1[0], bf_hi(g[bj].z) * v1[1]); w.w = pk2(bf_lo(g[bj].w) * v1[2], bf_hi(g[bj].w) * v1[3]);
                __builtin_amdgcn_raw_buffer_store_b128(w, mrs, (int)((row * D + colt + bj * 128) * 2), 0, 16); }
            __builtin_amdgcn_sched_barrier(0); }
#undef MG_LOAD2
    }
};
struct EpiOut { static constexpr bool PERM = true, AFTER_DRAIN = false, MIDHOOK = false; bf16_t* hb;
    __device__ __forceinline__ void operator()(const f32x4 (&acc)[2][2][4][2], const pg8::Unit& u, int wr, int wc, int fr, int fq) const {
        asm volatile("" : "+v"(fr), "+v"(fq));
        const int row0 = u.pm * 256 + wr * 64 + fr, colt = u.pn * 256 + wc * 32 + 8 * fq;
        u32x4 hn[2];
#define OUT_LOAD(q) do { const bf16_t* p_ = hb + (size_t)(row0 + ((q) >> 2) * 128 + ((q) & 3) * 16) * D + colt; hn[0] = *(const u32x4*)(p_); hn[1] = *(const u32x4*)(p_ + 128); } while (0)
        OUT_LOAD(0);
#pragma unroll
        for (int q = 0; q < 8; ++q) {
            const int ai = q >> 2, m = q & 3;
            bf16_t* hp = hb + (size_t)(row0 + ai * 128 + m * 16) * D + colt; const u32x4 h0 = hn[0], h1 = hn[1];
            if (q < 7) OUT_LOAD(q + 1);
#pragma unroll
            for (int bj = 0; bj < 2; ++bj) { const u32x4 hh = bj ? h1 : h0; const f32x4 v0 = acc[ai][bj][m][0], v1 = acc[ai][bj][m][1];
                u32x4 w; w.x = pk2(bf_lo(hh.x) + v0[0], bf_hi(hh.x) + v0[1]); w.y = pk2(bf_lo(hh.y) + v0[2], bf_hi(hh.y) + v0[3]);
                w.z = pk2(bf_lo(hh.z) + v1[0], bf_hi(hh.z) + v1[1]); w.w = pk2(bf_lo(hh.w) + v1[2], bf_hi(hh.w) + v1[3]);
                *(u32x4*)(hp + bj * 128) = w; }
            __builtin_amdgcn_sched_barrier(0);
        }
#undef OUT_LOAD
    }
};
template <bool GA> struct MoeOrderT { static constexpr bool GATHER = GA; const volatile LAS int* tb; int ntile, npt, G, c, rep; const int* s2t;
    __device__ __forceinline__ bool next(int i, pg8::Unit& u) const { long L = (long)i * G + c; if (L >= (long)ntile * npt * rep) return false; L %= (long)ntile * npt;
        const int tau = (int)(L / npt), j = (int)(L - (long)tau * npt); int e = 0;
#pragma unroll
        for (int k = 1; k < 16; ++k) e += (tau >= tb[k]) ? 1 : 0;
        u.pm = tau; u.pn = __builtin_amdgcn_readfirstlane(e) * npt + j; return true; }
    __device__ __forceinline__ void a_ready(const pg8::Unit&) const {}
    __device__ __forceinline__ void done(const pg8::Unit&) const {}
};
struct EpiMoeUp { static constexpr bool PERM = true, AFTER_DRAIN = false, MIDHOOK = false; bf16_t* hs;
    __device__ __forceinline__ void operator()(const f32x4 (&acc)[2][2][4][2], const pg8::Unit& u, int wr, int wc, int fr, int fq) const {
        asm volatile("" : "+v"(fr), "+v"(fq));
        const int row0 = u.pm * 256 + wr * 64 + fr, col = (u.pn & 1) * 128 + wc * 32 + 8 * fq;
#pragma unroll
        for (int ai = 0; ai < 2; ++ai)
#pragma unroll
            for (int m = 0; m < 4; ++m) { const size_t row = (size_t)(row0 + ai * 128 + m * 16); float r[8];
#pragma unroll
                for (int n = 0; n < 2; ++n)
#pragma unroll
                    for (int q = 0; q < 4; ++q) { const float gte = acc[ai][0][m][n][q], up = acc[ai][1][m][n][q]; r[4 * n + q] = gte * __builtin_amdgcn_rcpf(1.f + __builtin_amdgcn_exp2f(-gte * LOG2E)) * up; }
                u32x4 w; w.x = pk2(r[0], r[1]); w.y = pk2(r[2], r[3]); w.z = pk2(r[4], r[5]); w.w = pk2(r[6], r[7]);
                *(u32x4*)(hs + row * DEXP + col) = w; }
    }
};
struct EpiMoeDown { static constexpr bool PERM = true, AFTER_DRAIN = false, MIDHOOK = false; bf16_t* y; const float* cws;
    __device__ __forceinline__ void operator()(const f32x4 (&acc)[2][2][4][2], const pg8::Unit& u, int wr, int wc, int fr, int fq) const {
        asm volatile("" : "+v"(fr), "+v"(fq));
        const int row0 = u.pm * 256 + wr * 64 + fr, colt = (u.pn & 3) * 256 + wc * 32 + 8 * fq;
        float cw[8];
#pragma unroll
        for (int q = 0; q < 8; ++q) cw[q] = cws[row0 + (q >> 2) * 128 + (q & 3) * 16];
#pragma unroll
        for (int ai = 0; ai < 2; ++ai)
#pragma unroll
            for (int m = 0; m < 4; ++m) { const size_t row = (size_t)(row0 + ai * 128 + m * 16); const float cwv = cw[ai * 4 + m];
#pragma unroll
                for (int bj = 0; bj < 2; ++bj) { const int col = colt + bj * 128; const f32x4 v0 = acc[ai][bj][m][0] * cwv, v1 = acc[ai][bj][m][1] * cwv;
                    u32x4 w; w.x = pk2(v0[0], v0[1]); w.y = pk2(v0[2], v0[3]); w.z = pk2(v1[0], v1[1]); w.w = pk2(v1[2], v1[3]);
                    *(u32x4*)(y + row * D + col) = w; } }
    }
};


#ifndef PH_MASK
#define PH_MASK 0xFFFF
#endif
#define PH(k) ((PH_MASK >> (k)) & 1)
#ifndef PROBE_DUP
#define PROBE_DUP 0
#endif
#define DUPN(bit) (((PROBE_DUP >> (bit)) & 1) ? 2 : 1)
#ifndef PROBE_THIN
#define PROBE_THIN 0
#endif
#define THIN(bit) ((PROBE_THIN >> (bit)) & 1)
#define FRESH() do { asm volatile("" : "+v"(F.tid)); F.lane = F.tid & 63; F.wave = __builtin_amdgcn_readfirstlane(F.tid >> 6); { int bx_ = (int)blockIdx.x; asm volatile("" : "+s"(bx_)); F.bx = bx_; } { unsigned char* w_ = a.ws; asm volatile("" : "+s"(w_)); a.ws = w_; } } while (0)
__global__ void __launch_bounds__(NTHR, 2) hybrid_fwd(Args ka) {
    extern __shared__ __attribute__((aligned(16))) unsigned char lds_raw[];
    Frame F;
    F.lds = (LAS unsigned char*)lds_raw;
    F.MISC = (volatile LAS unsigned*)(F.lds + MISC_OFF);
    F.tid = threadIdx.x; F.lane = F.tid & 63; F.wave = __builtin_amdgcn_readfirstlane(F.tid >> 6); F.bx = (int)blockIdx.x;
    for (int u = F.tid; u < (LDS_BYTES - MISC_OFF) / 4; u += NTHR) ((LAS unsigned*)(F.lds + MISC_OFF))[u] = 0u;
    __syncthreads();
    if (F.tid < 29) { const unsigned long long p = (unsigned long long)ka.in[F.tid]; F.MISC[64 + 2 * F.tid] = (unsigned)p; F.MISC[65 + 2 * F.tid] = (unsigned)(p >> 32); }
    __syncthreads();
    ArgsL a; a.tab = F.MISC + 64; a.out = ka.out; a.ws = ka.ws;
    XcdBarrier bar = xcd_barrier_post((unsigned*)(a.ws + WS_CTL) + CW_BAR, F.MISC + 8);
    const int G = (int)gridDim.x, c = (int)blockIdx.x;
    PG8_LAS unsigned char* ring = (PG8_LAS unsigned char*)F.lds;

#ifdef PROF_K
    volatile LAS unsigned* tsl = F.MISC + 1536; int nts = 0;
    if (blockIdx.x == 0 && F.tid == 0) tsl[nts] = (unsigned)__builtin_amdgcn_s_memrealtime();
    ++nts;
#define BARX() do { xcd_barrier(bar); if (blockIdx.x == 0 && F.tid == 0) tsl[nts] = (unsigned)__builtin_amdgcn_s_memrealtime(); ++nts; } while (0)
#else
#define BARX() xcd_barrier(bar)
#endif
    for (int layer = 0; layer < DEPTH; ++layer) {
        for (int rep = 0; rep < DUPN(8); ++rep) { FRESH(); if (PH(0)) phase_wconv(a, F, layer); }
        __syncthreads();
        if (THIN(0)) { FRESH(); phase_norm<1>(a, F, layer, true); }
        FRESH(); if (PH(1)) phase_norm<1>(a, F, layer);
        BARX();
        FRESH(); if (PH(2)) {
            pg8::Gemm g{(const bf16_t*)A_PTR(a), (const bf16_t*)(a.ws + WS_WIN), M, N1, D}; pg8::StaticOrder S; S.init(M, N1, G, c, DUPN(3));
            EpiInproj E{(bf16_t*)(a.ws + WS_USH), (bf16_t*)(a.ws + WS_QKV)};
            pg8::gemm_phase<EpiInproj, pg8::StaticOrder, true, true>(ring, g, S, E);
        }
        BARX();
        if (THIN(1)) { FRESH(); phase_prep(a, F, layer, true); }
        FRESH(); if (PH(3)) phase_prep(a, F, layer);
        BARX();
#ifndef SEQ_SCAN
        if (THIN(2)) { FRESH(); phase_chunkA(a, F, true); }
        FRESH(); if (PH(4)) phase_chunkA(a, F);
        BARX();
#endif
        FRESH(); if (PH(4)) phase_mix(a, F, layer);
        BARX();
        unsigned* ch2 = (unsigned*)(a.ws + WS_CTL) + CW_CHAIN + (layer * 2) * 129 * CH_STRIDE; unsigned* ch3 = ch2 + 129 * CH_STRIDE;
        FRESH(); if (PH(6)) {
            pg8::Gemm g{(const bf16_t*)A_PTR(a), (const bf16_t*)(a.ws + WS_WG), M, 3072, D}; ChainOrder<false, true> S; S.init(M, 3072, G, c, 1); S.ready = nullptr; S.need = 0u; S.mine = ch2;
            EpiGates E{(bf16_t*)(a.ws + WS_GATES)};
            pg8::gemm_phase<EpiGates, ChainOrder<false, true>, true, true>(ring, g, S, E);
        }
        asm volatile("s_waitcnt vmcnt(0) lgkmcnt(0)" ::: "memory"); __syncthreads();
        if (THIN(3)) { FRESH(); phase_post(a, F, layer, ch2, true); }
        FRESH(); if (PH(5)) { if (!((c >= 16 && c < 20) || (c >= 32 && c < 36))) phase_post(a, F, layer, ch2); }
        __syncthreads();
        FRESH(); if (PH(7)) {
            pg8::Gemm g{(const bf16_t*)(a.ws + WS_YCAT), (const bf16_t*)(a.ws + WS_WP), M, D, YC_W}; ChainOrder<true, true> S; S.init(M, D, G, (c + G - 16) % G, 1); S.ready = ch2; S.need = 128u; S.mine = ch3;
            EpiMergeF E{(const bf16_t*)(a.ws + WS_GATES), (bf16_t*)(a.ws + WS_MERGED)};
            pg8::gemm_phase<EpiMergeF, ChainOrder<true, true>, true, true>(ring, g, S, E);
        }
        FRESH(); if (PH(8)) {
            pg8::Gemm g{(const bf16_t*)(a.ws + WS_MERGED), (const bf16_t*)(a.ws + WS_WO), M, D, D}; ChainOrder<true, false> S; S.init(M, D, G, (c + G - 32) % G, 1); S.ready = ch3; S.need = 32u; S.mine = nullptr;
            EpiOut E{HB_PTR(a)};
            pg8::gemm_phase<EpiOut, ChainOrder<true, false>, true, true>(ring, g, S, E);
        }
        BARX();
        if (THIN(4)) { FRESH(); phase_norm2(a, F, layer, true); }
        FRESH(); if (PH(9)) phase_norm2(a, F, layer);
        BARX();
        for (int rep = 0; rep < DUPN(7); ++rep) { FRESH(); if (PH(10)) phase_route(a, F, layer); }
        BARX();
        volatile LAS int* tb = (volatile LAS int*)(F.MISC + 32);
        if (F.tid <= 16) { const int* cnt = (const int*)(a.ws + WS_CTL) + CW_ECNT + 64 * layer; int t = 0;
            for (int e = 0; e < F.tid; ++e) t += (__hip_atomic_load(cnt + e, __ATOMIC_RELAXED, __HIP_MEMORY_SCOPE_AGENT) + 255) >> 8;
            tb[F.tid] = t; }
        __syncthreads();
        const int ntile = tb[16];
        FRESH(); if (PH(11)) {
            pg8::Gemm g{(const bf16_t*)A_PTR(a), (const bf16_t*)(a.ws + WS_WGU), MS, 8192, D}; MoeOrderT<true> S{tb, ntile, 2, G, c, DUPN(6), (const int*)(a.ws + WS_S2T)};
            EpiMoeUp E{(bf16_t*)(a.ws + WS_HS)};
            pg8::gemm_phase<EpiMoeUp, MoeOrderT<true>, true, true>(ring, g, S, E);
        }
        BARX();
        FRESH(); if (PH(12)) {
            int kdim = DEXP; asm volatile("" : "+s"(kdim));
            pg8::Gemm g{(const bf16_t*)(a.ws + WS_HS), (const bf16_t*)(a.ws + WS_WD), MS, 16384, kdim}; MoeOrderT<false> S{tb, ntile, 4, G, c, DUPN(6), nullptr};
            EpiMoeDown E{(bf16_t*)(a.ws + WS_Y), (const float*)(a.ws + WS_CWS)};
            pg8::gemm_phase<EpiMoeDown, MoeOrderT<false>, true, true>(ring, g, S, E);
        }
        BARX();
    }
    if (THIN(5)) { FRESH(); phase_norm<0>(a, F, DEPTH - 1, true); }
    FRESH(); if (PH(13)) phase_norm<0>(a, F, DEPTH - 1);
#ifdef PROF_K
    BARX();
    if (blockIdx.x == 0) {
        __syncthreads();
        float us;
        if (PROF_K < 0) us = 100.f;
        else if (PROF_K == 12) us = (float)(tsl[25] - tsl[24]) * 0.01f;
        else if (PROF_K == 13) us = (float)(tsl[25] - tsl[0]) * 0.01f;
        else us = ((float)(tsl[1 + PROF_K] - tsl[PROF_K]) + (float)(tsl[13 + PROF_K] - tsl[12 + PROF_K])) * 0.01f;
        us = 4.f * rintf(us * 0.25f);
        for (int i = F.tid; i < 16384; i += NTHR) a.out[i] = us;
    }
#endif
#ifdef CLOCK_PROBE
    if (blockIdx.x == 0 && F.wave == 0) {
        float c0 = 1.f, c1 = 2.f, c2 = 3.f, c3 = 4.f, c4 = 5.f, c5 = 6.f, c6 = 7.f, c7 = 8.f;
        for (int i = 0; i < CLOCK_PROBE; ++i) {
            asm volatile("v_fma_f32 %0, %0, %0, %0\n\tv_fma_f32 %1, %1, %1, %1\n\tv_fma_f32 %2, %2, %2, %2\n\tv_fma_f32 %3, %3, %3, %3\n\tv_fma_f32 %4, %4, %4, %4\n\tv_fma_f32 %5, %5, %5, %5\n\tv_fma_f32 %6, %6, %6, %6\n\tv_fma_f32 %7, %7, %7, %7"
                         : "+v"(c0), "+v"(c1), "+v"(c2), "+v"(c3), "+v"(c4), "+v"(c5), "+v"(c6), "+v"(c7));
        }
        asm volatile("" :: "v"(c0), "v"(c1), "v"(c2), "v"(c3), "v"(c4), "v"(c5), "v"(c6), "v"(c7));
    }
#endif
}

extern "C" void kernel_launch(void* const* d_in, const int* in_sizes, int n_in, void* d_out, int out_size, void* d_ws, size_t ws_size, hipStream_t stream) {
    static int ready = 0;
    if (ready == 0) {
        if (n_in != 29 || out_size != NB * SEQ * D || ws_size < WS_END) { fprintf(stderr, "kernel_launch: unexpected problem shape (n_in %d, out %d, ws %zu < %zu)\n", n_in, out_size, ws_size, (size_t)WS_END); ready = -1; return; }
        if (hipFuncSetAttribute((const void*)hybrid_fwd, hipFuncAttributeMaxDynamicSharedMemorySize, LDS_BYTES) != hipSuccess) { fprintf(stderr, "kernel_launch: hipFuncSetAttribute failed\n"); ready = -1; return; }
        int per_cu = 0;
        if (hipOccupancyMaxActiveBlocksPerMultiprocessor(&per_cu, (const void*)hybrid_fwd, NTHR, LDS_BYTES) != hipSuccess || per_cu < 1) fprintf(stderr, "kernel_launch: occupancy query says %d\n", per_cu);
        (void)hipGetLastError();
        ready = 1;
    }
    if (ready < 0) return;
    (void)in_sizes;
    if (hipMemsetAsync((char*)d_ws + WS_CTL, 0, CTL_ZERO_BYTES, stream) != hipSuccess) return;
    Args a{};
    for (int i = 0; i < 29; ++i) a.in[i] = (const float*)d_in[i];
    a.out = (float*)d_out; a.ws = (unsigned char*)d_ws;
    hipLaunchKernelGGL(hybrid_fwd, dim3(256), dim3(NTHR), LDS_BYTES, stream, a);
}
```

```cpp
#include <hip/hip_runtime.h>
#include <hip/hip_bf16.h>
#include <cstdio>
#include <cstdint>

#define GAS __attribute__((address_space(1)))
#define LAS __attribute__((address_space(3)))

namespace pg8 {
#define PG8_LAS __attribute__((address_space(3)))
typedef unsigned short bf16_t;
typedef short bf16x8 __attribute__((ext_vector_type(8)));
typedef float f32x4 __attribute__((ext_vector_type(4)));
typedef unsigned u32x4 __attribute__((ext_vector_type(4)));
constexpr int BM = 256, BK = 64, HALF = 128, HTB = HALF * BK * 2  , STAGE_BYTES = 8 * HTB, NXCD = 8, WGM = 8;

__host__ __device__ __forceinline__ int lds_byte(int r, int c) { const int st = (r >> 4) * 2 + (c >> 5), rr = r & 15, cc = c & 31, ob = rr * 64 + cc * 2; return st * 1024 + (ob ^ (((ob >> 9) & 1) << 5)); }
__host__ __device__ __forceinline__ void stage_rc(int b, int& R, int& C) { const int st = b / 1024, sb = b % 1024, swz = sb ^ (((sb >> 9) & 1) << 5); R = (st >> 1) * 16 + swz / 64; C = (st & 1) * 32 + (swz % 64) / 2; }
__host__ __device__ __forceinline__ int perm32(int rho) { const int n = rho >> 4, i = rho & 15; return 8 * (i >> 2) + 4 * n + (i & 3); }

struct Unit { int pm, pn; };
struct Gemm { const bf16_t* A; const bf16_t* Bt; int M, N, K; };

struct StaticOrder {
    int nM, nN, nwg, G, c, rep;
    __host__ __device__ void init(int M, int N, int G_, int c_, int rep_ = 1) { nM = M / BM; nN = N / BM; nwg = nM * nN; G = G_; c = c_; rep = rep_; }
    __host__ __device__ bool next(int i, Unit& u) const {
        const long L = (long)i * G + c; if (L >= (long)nwg * rep) return false;
        int wgid = (int)(L % nwg); { const int q = nwg / NXCD, r = nwg % NXCD, xcd = wgid % NXCD, off = wgid / NXCD; wgid = (xcd < r ? xcd * (q + 1) : r * (q + 1) + (xcd - r) * q) + off; }
        const int nig = WGM * nN, gid = wgid / nig, fm = gid * WGM, gsz = (nM - fm) < WGM ? (nM - fm) : WGM;
        u.pm = fm + ((wgid % nig) % gsz); u.pn = (wgid % nig) / gsz; return true;
    }
    static constexpr bool GATHER = false;
    __device__ __forceinline__ void a_ready(const Unit&) const {}
    __device__ __forceinline__ void done(const Unit&) const {}
};
__device__ __forceinline__ unsigned cvt_pk_bf16(float lo, float hi) { unsigned r; asm volatile("v_cvt_pk_bf16_f32 %0, %1, %2" : "=v"(r) : "v"(lo), "v"(hi)); return r; }
template <class Epi, class Sched, bool ALIGN_EPI = false, bool SP2 = false>
__device__ __forceinline__ void gemm_phase(PG8_LAS unsigned char* lds, const Gemm g, const Sched& S, const Epi& E) {
    int tid_ = threadIdx.x; asm volatile("" : "+v"(tid_));
    const int tid = tid_, wid = __builtin_amdgcn_readfirstlane(tid >> 6), lane = tid & 63, wr = wid >> 2, wc = wid & 3, fr = lane & 15, fq = lane >> 4;
    const int K = g.K, nt = K / BK;
    unsigned voffA[2], voffB[2];
#pragma unroll
    for (int i = 0; i < 2; ++i) { int R, C; stage_rc(tid * 16 + i * 8192, R, C); const int Rb = Epi::PERM ? ((R & ~31) + perm32(R & 31)) : R;
        voffA[i] = (unsigned)(R * K + C) * 2u; voffB[i] = (unsigned)(Rb * K + C) * 2u; }
    constexpr bool GATH = Sched::GATHER;
    unsigned vg[2] = {0u, 0u}, vn[2] = {0u, 0u}; int gR = 0; unsigned gC = 0u;
    if constexpr (GATH) { int R, C; stage_rc(tid * 16, R, C); gR = R; gC = (unsigned)C * 2u; }
#define PG8_GOFF(v, u) do { _Pragma("unroll") for (int h_ = 0; h_ < 2; ++h_) { const int* q_ = S.s2t + (u).pm * 256 + h_ * 128 + gR; v[h_] = (unsigned)q_[0] | ((unsigned)q_[64] << 16); } } while (0)
#define PG8_STAGE_G(bufoff, gbase, pk) do { const unsigned pk_ = (pk); \
        __builtin_amdgcn_global_load_lds((const unsigned*)((const char*)(gbase) + ((pk_ & 0xffffu) * (unsigned)(K * 2) + gC)), (PG8_LAS unsigned*)(lds + (bufoff) + ldsw), 16, 0, 0); \
        __builtin_amdgcn_global_load_lds((const unsigned*)((const char*)(gbase) + ((pk_ >> 16) * (unsigned)(K * 2) + gC)), (PG8_LAS unsigned*)(lds + (bufoff) + ldsw + 8192), 16, 0, 0); } while (0)
    const size_t kstep = (size_t)(BK * 2);
    const size_t hstep = (size_t)HALF * K * 2;
    const size_t tstep = 2 * hstep;
    const unsigned ldsw = (unsigned)wid * 1024u;
    const int aoff = lds_byte(wr * 64 + fr, fq * 8), boff = lds_byte(wc * 32 + fr, fq * 8);
#define PG8_SA(b, h) (((b) * 2 + (h)) * HTB)
#define PG8_SB(b, h) ((4 + (b) * 2 + (h)) * HTB)
#define PG8_STAGE(bufoff, gbase, voff) do { _Pragma("unroll") for (int _i = 0; _i < 2; ++_i) \
        __builtin_amdgcn_global_load_lds((const unsigned*)((const char*)(gbase) + (voff)[_i]), (PG8_LAS unsigned*)(lds + (bufoff) + ldsw + _i * 8192), 16, 0, 0); } while (0)
#define PG8_STAGE_A(bufoff, gbase, h, vv) do { if constexpr (GATH) PG8_STAGE_G(bufoff, gbase, vv[h]); else PG8_STAGE(bufoff, (gbase) + (h) * hstep, voffA); } while (0)
#define PG8_STAGE_A2(bufoff, gbase, h) do { if constexpr (GATH) PG8_STAGE_G(bufoff, gbase, last ? vn[h] : vg[h]); else PG8_STAGE(bufoff, (gbase) + (h) * hstep, voffA); } while (0)
#define PG8_LDA(dst, b, h) do { _Pragma("unroll") for (int m = 0; m < 4; ++m) _Pragma("unroll") for (int k = 0; k < 2; ++k) dst[m][k] = *(const PG8_LAS bf16x8*)(lds + PG8_SA(b, h) + aoff + m * 2048 + k * 1024); } while (0)
#define PG8_LDB(dst, b, h) do { _Pragma("unroll") for (int n = 0; n < 2; ++n) _Pragma("unroll") for (int k = 0; k < 2; ++k) dst[n][k] = *(const PG8_LAS bf16x8*)(lds + PG8_SB(b, h) + boff + n * 2048 + k * 1024); } while (0)
#define PG8_MMA(ai, bj, At, Bt) do { __builtin_amdgcn_s_setprio(1); _Pragma("unroll") for (int m = 0; m < 4; ++m) _Pragma("unroll") for (int n = 0; n < 2; ++n) _Pragma("unroll") for (int k = 0; k < 2; ++k) \
        acc[ai][bj][m][n] = __builtin_amdgcn_mfma_f32_16x16x32_bf16(Bt[n][k], At[m][k], acc[ai][bj][m][n], 0, 0, 0); __builtin_amdgcn_s_setprio(0); } while (0)
#define PG8_WAIT_V(n) asm volatile("s_waitcnt vmcnt(" #n ")" ::: "memory")
#define PG8_WAIT_L(n) asm volatile("s_waitcnt lgkmcnt(" #n ")" ::: "memory")
#define PG8_BAR __builtin_amdgcn_s_barrier()
#define PG8_SCHED __builtin_amdgcn_sched_barrier(0)
    Unit cur, nxt; int ui = 0;
    if (!S.next(0, cur)) return;
    f32x4 acc[2][2][4][2];
#pragma unroll
    for (int a = 0; a < 2; ++a)
#pragma unroll
        for (int b = 0; b < 2; ++b)
#pragma unroll
            for (int m = 0; m < 4; ++m)
#pragma unroll
                for (int n = 0; n < 2; ++n) acc[a][b][m][n] = (f32x4){0.f, 0.f, 0.f, 0.f};
    bf16x8 At[4][2], B0[2][2], B1[2][2];
    const char* cA = GATH ? (const char*)g.A : (const char*)g.A + (size_t)cur.pm * tstep; const char* cB = (const char*)g.Bt + (size_t)cur.pn * tstep;
    S.a_ready(cur);
    if constexpr (GATH) PG8_GOFF(vg, cur);
    if constexpr (SP2) {
        PG8_STAGE(PG8_SB(0, 0), cB, voffB); PG8_STAGE(PG8_SB(0, 1), cB + hstep, voffB); PG8_STAGE_A(PG8_SA(0, 0), cA, 0, vg); PG8_STAGE_A(PG8_SA(0, 1), cA, 1, vg);
        if (wr == 1) PG8_BAR;
        PG8_WAIT_V(2); PG8_BAR;
        PG8_STAGE(PG8_SB(1, 0), cB + kstep, voffB); PG8_STAGE_A(PG8_SA(1, 0), cA + kstep, 0, vg); PG8_STAGE(PG8_SB(1, 1), cB + hstep + kstep, voffB);
        PG8_WAIT_V(6); PG8_BAR;
    } else {
        PG8_STAGE(PG8_SB(0, 0), cB, voffB); PG8_STAGE(PG8_SA(0, 0), cA, voffA); PG8_STAGE(PG8_SB(0, 1), cB + hstep, voffB); PG8_STAGE(PG8_SA(0, 1), cA + hstep, voffA);
        if (wr == 1) PG8_BAR;
        PG8_WAIT_V(4); PG8_BAR;
        PG8_STAGE(PG8_SB(1, 0), cB + kstep, voffB); PG8_STAGE(PG8_SA(1, 0), cA + kstep, voffA); PG8_STAGE(PG8_SB(1, 1), cB + hstep + kstep, voffB);
        PG8_WAIT_V(6); PG8_BAR;
    }
    for (;;) {
        const bool has_next = S.next(ui + 1, nxt);
        const char* nA = (has_next && !GATH) ? (const char*)g.A + (size_t)nxt.pm * tstep : cA;
        if constexpr (GATH) { if (has_next) PG8_GOFF(vn, nxt); else { vn[0] = vg[0]; vn[1] = vg[1]; } } const char* nB = has_next ? (const char*)g.Bt + (size_t)nxt.pn * tstep : cB;
        for (int t = 0; t < nt; t += 2) {
            const bool last = (t == nt - 2);
            const char* a1 = cA + (size_t)(t + 1) * kstep;
            const char* a2 = last ? nA : cA + (size_t)(t + 2) * kstep; const char* b2 = last ? nB : cB + (size_t)(t + 2) * kstep;
            const char* a3 = a2 + kstep; const char* b3 = b2 + kstep;
            if (last && has_next) S.a_ready(nxt);
            if constexpr (SP2) {
            PG8_LDB(B0, 0, 0); PG8_LDB(B1, 0, 1); PG8_SCHED; PG8_LDA(At, 0, 0); PG8_STAGE_A(PG8_SA(1, 1), a1, 1, vg);
            PG8_WAIT_V(8); PG8_WAIT_L(0); PG8_BAR; PG8_MMA(0, 0, At, B0); PG8_MMA(0, 1, At, B1); PG8_BAR; PG8_SCHED;
            PG8_LDA(At, 0, 1); PG8_STAGE(PG8_SB(0, 0), b2, voffB); PG8_STAGE(PG8_SB(0, 1), b2 + hstep, voffB); PG8_STAGE_A2(PG8_SA(0, 0), a2, 0);
            PG8_WAIT_V(8); PG8_WAIT_L(0); PG8_BAR; PG8_MMA(1, 0, At, B0); PG8_MMA(1, 1, At, B1); PG8_BAR; PG8_SCHED;
            PG8_LDB(B0, 1, 0); PG8_LDB(B1, 1, 1); PG8_SCHED; PG8_LDA(At, 1, 0); PG8_STAGE_A2(PG8_SA(0, 1), a2, 1);
            PG8_WAIT_V(8); PG8_WAIT_L(0); PG8_BAR; PG8_MMA(0, 0, At, B0); PG8_MMA(0, 1, At, B1); PG8_BAR; PG8_SCHED;
            PG8_LDA(At, 1, 1); PG8_STAGE(PG8_SB(1, 0), b3, voffB); PG8_STAGE(PG8_SB(1, 1), b3 + hstep, voffB); PG8_STAGE_A2(PG8_SA(1, 0), a3, 0);
            PG8_WAIT_V(8); PG8_WAIT_L(0); PG8_BAR; PG8_MMA(1, 0, At, B0); PG8_MMA(1, 1, At, B1); PG8_BAR; PG8_SCHED;
            } else {
            static_assert(SP2 || !GATH, "gather needs the SP2 schedule");
            PG8_LDB(B0, 0, 0); PG8_SCHED; PG8_LDA(At, 0, 0); PG8_STAGE(PG8_SA(1, 1), a1 + hstep, voffA);
            PG8_WAIT_L(8); PG8_BAR; PG8_WAIT_L(0); PG8_MMA(0, 0, At, B0); PG8_BAR; PG8_SCHED;
            PG8_LDB(B1, 0, 1); PG8_STAGE(PG8_SB(0, 0), b2, voffB);
            PG8_BAR; PG8_WAIT_L(0); PG8_MMA(0, 1, At, B1); PG8_BAR;
            PG8_LDA(At, 0, 1); PG8_STAGE(PG8_SA(0, 0), a2, voffA);
            PG8_BAR; PG8_WAIT_L(0); PG8_MMA(1, 0, At, B0); PG8_BAR; PG8_SCHED;
            PG8_STAGE(PG8_SB(0, 1), b2 + hstep, voffB);
            PG8_WAIT_V(6); PG8_BAR; PG8_MMA(1, 1, At, B1); PG8_BAR;
            PG8_LDB(B0, 1, 0); PG8_SCHED; PG8_LDA(At, 1, 0); PG8_STAGE(PG8_SA(0, 1), a2 + hstep, voffA);
            PG8_WAIT_L(8); PG8_BAR; PG8_WAIT_L(0); PG8_MMA(0, 0, At, B0); PG8_BAR; PG8_SCHED;
            PG8_LDB(B1, 1, 1); PG8_STAGE(PG8_SB(1, 0), b3, voffB);
            PG8_BAR; PG8_WAIT_L(0); PG8_MMA(0, 1, At, B1); PG8_BAR;
            PG8_LDA(At, 1, 1); PG8_STAGE(PG8_SA(1, 0), a3, voffA);
            PG8_BAR; PG8_WAIT_L(0); PG8_MMA(1, 0, At, B0); PG8_BAR; PG8_SCHED;
            PG8_STAGE(PG8_SB(1, 1), b3 + hstep, voffB);
            PG8_WAIT_V(6); PG8_BAR; PG8_MMA(1, 1, At, B1); PG8_BAR;
            }
            if constexpr (Epi::MIDHOOK) { if (t + 2 == 6 || t + 2 == 12) E.mid(acc, cur, wr, wc, fr, fq, (t + 2) / 6); }
        }
        if constexpr (ALIGN_EPI) { if (wr == 0) PG8_BAR; }
        if constexpr (!Epi::AFTER_DRAIN) { E(acc, cur, wr, wc, fr, fq); S.done(cur); }
        if (!has_next) break;
#pragma unroll
        for (int a = 0; a < 2; ++a)
#pragma unroll
            for (int b = 0; b < 2; ++b)
#pragma unroll
                for (int m = 0; m < 4; ++m)
#pragma unroll
                    for (int n = 0; n < 2; ++n) acc[a][b][m][n] = (f32x4){0.f, 0.f, 0.f, 0.f};
        cur = nxt; cA = nA; cB = nB; ++ui;
        if constexpr (GATH) { vg[0] = vn[0]; vg[1] = vn[1]; }
        if constexpr (ALIGN_EPI) { if (wr == 1) PG8_BAR; }
    }
    PG8_WAIT_V(0);
    if constexpr (!ALIGN_EPI) { if (wr == 0) PG8_BAR; }
    PG8_BAR;
    if constexpr (Epi::AFTER_DRAIN) { E.fused(acc, cur, wr, wc, fr, fq, lds, wid, lane); S.done(cur); }
#undef PG8_SA
#undef PG8_SB
#undef PG8_STAGE
#undef PG8_STAGE_A
#undef PG8_STAGE_A2
#undef PG8_STAGE_G
#undef PG8_GOFF
#undef PG8_LDA
#undef PG8_LDB
#undef PG8_MMA
#undef PG8_WAIT_V
#undef PG8_WAIT_L
#undef PG8_BAR
#undef PG8_SCHED
}
}

constexpr int D = 1024, NB = 2, SEQ = 16384, NMETA = 16, LTOK = SEQ + NMETA  , PADR = 112, T = PADR + LTOK  ;
constexpr int M = NB * T;
constexpr int DEPTH = 2, HD = 64, RW_H = 6, SB_H = 5, FX_H = 5, RW_W = 384, SHIFT_W = 1280, D_IN = 6277;
constexpr int YC_W = 1152;
constexpr int QKV_W = 1920;
constexpr int N1 = 3328;
constexpr int FCOL = 3200, GCOL = 3205;
constexpr int NEXP = 16, DEXP = 256;
constexpr int MS = 70144;
constexpr int LCH = 32, LPADDED = 16448;
constexpr int KBP = 16896;
constexpr float C2 = 0.125f * 1.4426950408889634f;
constexpr float LOG2E = 1.4426950408889634f;
constexpr int NWAVES = 8, NTHR = 512;

constexpr size_t MiB = 1u << 20;
constexpr size_t WS_CTL = 0, CTL_ZERO_BYTES = 131072;
constexpr size_t WS_HM = 1 * MiB;
constexpr size_t WS_LOGF = WS_HM + 131072;
constexpr size_t WS_KB2 = WS_LOGF + (size_t)M * 32;
constexpr size_t WS_TOK = WS_KB2 + (size_t)10 * KBP * 4;
constexpr size_t WS_SLOT = WS_TOK + (size_t)M * 32;
constexpr size_t WS_CWS = WS_SLOT + (size_t)M * 8;
constexpr size_t WS_WGCNT = WS_CWS + (size_t)MS * 4;
constexpr size_t WS_S2T = WS_WGCNT + 256 * 16 * 4;
constexpr size_t WS_SMALL_END = WS_S2T + (size_t)MS * 4;
static_assert(WS_SMALL_END <= 8 * MiB, "small buffers");
constexpr size_t WS_WIN = 8 * MiB;
constexpr size_t WS_WG = WS_WIN + (size_t)N1 * 1024 * 2;
constexpr size_t WS_WP = WS_WG + (size_t)3072 * 1024 * 2;
constexpr size_t WS_WO = WS_WP + (size_t)3072 * 384 * 2;
constexpr size_t WS_WGU = WS_WO + (size_t)1024 * 1024 * 2;
constexpr size_t WS_WD = WS_WGU + (size_t)8192 * 1024 * 2;
constexpr size_t WS_W_END = WS_WD + (size_t)16384 * 256 * 2;
static_assert(WS_W_END <= 49 * MiB, "weights");
constexpr size_t WS_HB = 49 * MiB;
constexpr size_t WS_BIG = 115 * MiB;
constexpr size_t WS_USH = WS_BIG;
constexpr size_t WS_YCAT = WS_BIG;
constexpr size_t WS_QKV = WS_BIG + 82 * MiB;
constexpr size_t WS_RW = WS_BIG + 204 * MiB;
constexpr size_t WS_BN = WS_BIG + 349 * MiB;
constexpr size_t WS_GATES = WS_BIG + 82 * MiB;
constexpr size_t WS_MERGED = WS_BIG + 276 * MiB;
constexpr size_t WS_AS = WS_BIG;
constexpr size_t WS_HS = WS_BIG + 137 * MiB;
constexpr size_t WS_Y = WS_BIG + 172 * MiB;
constexpr size_t WS_END = WS_BIG + 374 * MiB;
static_assert((size_t)(M + 256) * 1280 * 2 <= 82 * MiB && (size_t)3 * M * 384 * 2 <= 82 * MiB && (size_t)(M + 256) * 1920 * 2 <= 122 * MiB, "big map 1");
static_assert((size_t)12 * LPADDED * 768 <= 145 * MiB && (size_t)M * 384 * 2 <= 25 * MiB && (size_t)M * 3072 * 2 <= 194 * MiB && (size_t)M * 2048 <= 65 * MiB, "big map 2");
static_assert((size_t)MS * 2048 <= 137 * MiB && (size_t)MS * 512 <= 35 * MiB && WS_END <= 489 * MiB, "big map 3");

constexpr int CW_BAR = 0;
constexpr int CW_QUEUE = 4096;
constexpr int CW_ECNT = 4352;
constexpr int CW_CADONE = 24832;
constexpr int CW_CHAIN = 8192, CH_STRIDE = 32;
static_assert((CW_ECNT + 128) <= CW_CHAIN && (CW_CHAIN + DEPTH * 2 * 129 * CH_STRIDE) <= CW_CADONE && (CW_CADONE + 128) * 4 <= (int)CTL_ZERO_BYTES, "ctl");

constexpr int RING_BYTES = 131072, MISC_OFF = RING_BYTES, LDS_BYTES = 163840;

typedef unsigned short bf16_t;
typedef float f32x4 __attribute__((ext_vector_type(4)));
typedef float f32x2 __attribute__((ext_vector_type(2)));
typedef float f32x16 __attribute__((ext_vector_type(16)));
typedef unsigned u32x4 __attribute__((ext_vector_type(4)));
typedef unsigned u32x2 __attribute__((ext_vector_type(2)));
typedef short bf16x8 __attribute__((ext_vector_type(8)));
typedef short s16x4 __attribute__((ext_vector_type(4)));
typedef _Float16 f16x4 __attribute__((ext_vector_type(4)));
typedef __bf16 bf16x2_t __attribute__((ext_vector_type(2)));

__device__ __forceinline__ unsigned pk2(float lo, float hi) { f32x2 v = {lo, hi}; bf16x2_t b = __builtin_convertvector(v, bf16x2_t); return __builtin_bit_cast(unsigned, b); }
__device__ __forceinline__ unsigned short f2bf(float f) { return (unsigned short)(pk2(f, 0.f) & 0xffffu); }
__device__ __forceinline__ float bf_lo(unsigned u) { return __uint_as_float(u << 16); }
__device__ __forceinline__ float bf_hi(unsigned u) { return __uint_as_float(u & 0xffff0000u); }
__device__ __forceinline__ float bf2f(unsigned short h) { return __uint_as_float((unsigned)h << 16); }
template <int CTRL> __device__ __forceinline__ float dpp_f(float x) { return __int_as_float(__builtin_amdgcn_update_dpp(0, __float_as_int(x), CTRL, 0xF, 0xF, false)); }
__device__ __forceinline__ float allred16(float p) { p += dpp_f<0x128>(p); p += dpp_f<0x124>(p); p += dpp_f<0x122>(p); p += dpp_f<0x121>(p); return p; }
__device__ __forceinline__ float wave_sum(float v) {
    v = allred16(v);
    { auto sw = __builtin_amdgcn_permlane16_swap(__float_as_uint(v), __float_as_uint(v), false, false); v = __uint_as_float(sw[0]) + __uint_as_float(sw[1]); }
    { auto sw = __builtin_amdgcn_permlane32_swap(__float_as_uint(v), __float_as_uint(v), false, false); v = __uint_as_float(sw[0]) + __uint_as_float(sw[1]); }
    return v;
}
__device__ __forceinline__ float fast_exp(float x) { return __builtin_amdgcn_exp2f(x * LOG2E); }
__device__ __forceinline__ float fast_log(float x) { return __builtin_amdgcn_logf(x) * 0.6931471805599453f; }
__device__ __forceinline__ float softplus_f(float z) { return fmaxf(z, 0.f) + fast_log(1.f + fast_exp(-fabsf(z))); }

#define XB_TMO      128
#define XB_XCNT(j)  (256  + 64 * (j))
#define XB_XSUB(j)  (1280 + 64 * (j))
#define XB_XGEN(j)  (2304 + 64 * (j))
#define XB_TOP      3328
#define XB_TOPGEN   3392
#define XCD_BAR_WORDS 3456
#define XB_SPIN_CAP (1u << 20)
__device__ __forceinline__ unsigned xb_ld(unsigned* p)              { return __hip_atomic_load(p, __ATOMIC_RELAXED, __HIP_MEMORY_SCOPE_AGENT); }
__device__ __forceinline__ unsigned xb_add(unsigned* p, unsigned v) { return __hip_atomic_fetch_add(p, v, __ATOMIC_RELAXED, __HIP_MEMORY_SCOPE_AGENT); }
__device__ __forceinline__ unsigned xb_xcc_id() { return (unsigned)__builtin_amdgcn_s_getreg((3 << 11) | 20) & 0xFu; }
#define XB_SPIN(cond, bar) do { unsigned _sp = 0; while (cond) { __builtin_amdgcn_s_sleep(1); \
    if ((++_sp & 255u) == 0u) { if (xb_ld(&(bar)[XB_TMO])) break; if (_sp > XB_SPIN_CAP) { atomicAdd(&(bar)[XB_TMO], 1u); break; } } } } while (0)

struct XcdBarrier {
    unsigned* bar; unsigned x;
    volatile LAS unsigned* st;
};

__device__ __forceinline__ XcdBarrier xcd_barrier_post(unsigned* bar, volatile LAS unsigned* st) {
    XcdBarrier b; b.bar = bar; b.x = xb_xcc_id(); b.st = st;
    if (threadIdx.x == 0) (void)xb_add(&bar[XB_XCNT(b.x)], 1u);
    return b;
}
__device__ __forceinline__ void xcd_barrier_complete(unsigned* bar, unsigned x, unsigned& nloc, unsigned& nx) {
    const unsigned G = gridDim.x * gridDim.y * gridDim.z;
    unsigned sum, cnt, mine, sp = 0u;
    for (;;) {
        sum = 0u; cnt = 0u; mine = 0u;
#pragma unroll
        for (unsigned j = 0; j < 16; ++j) { const unsigned c = xb_ld(&bar[XB_XCNT(j)]); sum += c; cnt += (c > 0u) ? 1u : 0u; mine = (j == x) ? c : mine; }
        if (sum == G) break;
        __builtin_amdgcn_s_sleep(1);
        if ((++sp & 255u) == 0u) { if (xb_ld(&bar[XB_TMO])) break; if (sp > XB_SPIN_CAP) { atomicAdd(&bar[XB_TMO], 1u); break; } }
    }
    nloc = mine > 0u ? mine : 1u; nx = cnt > 0u ? cnt : 1u;
}

__device__ __forceinline__ void xcd_barrier(const XcdBarrier& b) {
    asm volatile("s_waitcnt vmcnt(0)" ::: "memory");
    __syncthreads();
    if (threadIdx.x == 0) {
        unsigned* bar = b.bar;
        __builtin_amdgcn_s_waitcnt(0);
        unsigned nloc = b.st[0], nx = b.st[1];
        if (nloc == 0u) { xcd_barrier_complete(bar, b.x, nloc, nx); b.st[0] = nloc; b.st[1] = nx; }
        const unsigned old = xb_add(&bar[XB_XSUB(b.x)], 1u);
        const unsigned gen = old / nloc;
        if (old + 1u == (gen + 1u) * nloc) {
            __builtin_amdgcn_fence(__ATOMIC_RELEASE, "agent");
            asm volatile("s_waitcnt vmcnt(0)" ::: "memory");
            const unsigned og = xb_add(&bar[XB_TOP], 1u);
            const unsigned tg = og / nx;
            if (og + 1u == (tg + 1u) * nx) xb_add(&bar[XB_TOPGEN], 1u);
            else XB_SPIN(xb_ld(&bar[XB_TOPGEN]) == tg, bar);
            __builtin_amdgcn_fence(__ATOMIC_ACQUIRE, "agent");
            xb_add(&bar[XB_XGEN(b.x)], 1u);
            asm volatile("s_waitcnt vmcnt(0)" ::: "memory");
        } else {
            XB_SPIN(xb_ld(&bar[XB_XGEN(b.x)]) == gen, bar);
            __builtin_amdgcn_fence(__ATOMIC_ACQUIRE, "agent");
            asm volatile("s_waitcnt vmcnt(0)" ::: "memory");
        }
    }
    __syncthreads();
}

struct Args { const float* in[29]; float* out; unsigned char* ws; };
enum { I_X = 0, I_META, I_N1G, I_WIN, I_MU, I_WUP, I_W0, I_AUP, I_A0, I_KK, I_KA, I_RK, I_LNG, I_LNB, I_FB, I_QG, I_KG, I_WPR, I_WPS, I_WPF, I_WOUT, I_N2G, I_MWG, I_MBG, I_MWE, I_MBE, I_MGATE, I_MUP, I_MDOWN };
struct ArgsL { volatile LAS unsigned* tab; float* out; unsigned char* ws;
    __device__ __forceinline__ const float* in(int i) const { const unsigned lo = tab[2 * i], hi = tab[2 * i + 1];
        return (const float*)(((unsigned long long)(unsigned)__builtin_amdgcn_readfirstlane((int)hi) << 32) | (unsigned long long)(unsigned)__builtin_amdgcn_readfirstlane((int)lo)); }
};
struct Frame { LAS unsigned char* lds; volatile LAS unsigned* MISC; int tid, lane, wave, bx; };

__device__ __forceinline__ float* hrow(const ArgsL& a, int b, int l) {
    return l < NMETA ? (float*)(a.ws + WS_HM) + (size_t)(b * NMETA + l) * D : a.out + ((size_t)b * SEQ + (l - NMETA)) * D;
}
#define LDS_WAIT() asm volatile("s_waitcnt lgkmcnt(0)" ::: "memory")
#define HB_PTR(a) ((bf16_t*)((a).ws + WS_HB))
#define A_PTR(a) ((bf16_t*)((a).out))

__device__ __forceinline__ void tr_item(const float* W, int ldw, int sc0, int nvalid, int k0, int kvalid, bf16_t* WT, int Kd, int r0, LAS float* scr, int lane) {
    float tv[32];
#pragma unroll
    for (int i = 0; i < 32; ++i) { const int kk = 2 * i + (lane >> 5), n = lane & 31; tv[i] = 0.f;
        if (n < nvalid && k0 + kk < kvalid) tv[i] = W[(size_t)(k0 + kk) * ldw + sc0 + n]; }
#pragma unroll
    for (int i = 0; i < 32; ++i) { const int kk = 2 * i + (lane >> 5), n = lane & 31; scr[kk * 33 + n] = tv[i]; }
    LDS_WAIT();
    const int c = lane & 7;
#pragma unroll
    for (int j = 0; j < 4; ++j) { const int n = (lane >> 3) + 8 * j; const LAS float* s = scr + (8 * c) * 33 + n;
        u32x4 o; o.x = pk2(s[0 * 33], s[1 * 33]); o.y = pk2(s[2 * 33], s[3 * 33]); o.z = pk2(s[4 * 33], s[5 * 33]); o.w = pk2(s[6 * 33], s[7 * 33]);
        *(u32x4*)(WT + (size_t)(r0 + n) * Kd + k0 + 8 * c) = o; }
    LDS_WAIT();
}
__device__ __forceinline__ void tr_item2(const float* W, int ldw, int sc0, int nvalid, int k0, int kvalid, bf16_t* WT, int Kd, int r0, int kd0, LAS float* scr, int lane) {
    float tv[32];
#pragma unroll
    for (int i = 0; i < 32; ++i) { const int kk = 2 * i + (lane >> 5), n = lane & 31; tv[i] = 0.f;
        if (n < nvalid && k0 + kk < kvalid) tv[i] = W[(size_t)(k0 + kk) * ldw + sc0 + n]; }
#pragma unroll
    for (int i = 0; i < 32; ++i) { const int kk = 2 * i + (lane >> 5), n = lane & 31; scr[kk * 33 + n] = tv[i]; }
    LDS_WAIT();
    const int c = lane & 7;
#pragma unroll
    for (int j = 0; j < 4; ++j) { const int n = (lane >> 3) + 8 * j; const LAS float* s = scr + (8 * c) * 33 + n;
        u32x4 o; o.x = pk2(s[0 * 33], s[1 * 33]); o.y = pk2(s[2 * 33], s[3 * 33]); o.z = pk2(s[4 * 33], s[5 * 33]); o.w = pk2(s[6 * 33], s[7 * 33]);
        *(u32x4*)(WT + (size_t)(r0 + n) * Kd + kd0 + 8 * c) = o; }
    LDS_WAIT();
}
__device__ __forceinline__ void phase_wconv(const ArgsL& a, Frame& F, int layer) {
    LAS float* scr = (LAS float*)(F.lds + F.wave * 8448);
    const int gw = F.bx * NWAVES + F.wave, NGW = gridDim.x * NWAVES;
    constexpr int C1 = 16 * 104, C2_ = C1 + 16 * 96, C3 = C2_ + 6 * 96, C4 = C3 + 16 * 32, C5 = C4 + 16 * 256, C6 = C5 + 4 * 512;
    unsigned char* ws = a.ws;
    for (int it = gw; it < C6; it += NGW) {
        if (it < C1) { const int kb = it / 104, nb = it % 104, r0 = nb * 32;
            tr_item(a.in(I_WIN) + (size_t)layer * D * D_IN, D_IN, r0, r0 < FCOL ? 32 : 0, kb * 64, 1024, (bf16_t*)(ws + WS_WIN), 1024, r0, scr, F.lane); }
        else if (it < C2_) { const int r = it - C1, kb = r / 96, nb = r % 96, r0 = nb * 32;
            tr_item(a.in(I_WIN) + (size_t)layer * D * D_IN, D_IN, GCOL + r0, 32, kb * 64, 1024, (bf16_t*)(ws + WS_WG), 1024, r0, scr, F.lane); }
        else if (it < C3) { const int r = it - C2_, kb = r / 32, nb = r % 32, r0 = nb * 32, br = kb / 6, k0 = (kb % 6) * 64;
            const float* W = (br == 0 ? a.in(I_WPR) + (size_t)layer * 384 * D : br == 1 ? a.in(I_WPS) + (size_t)layer * 320 * D : a.in(I_WPF) + (size_t)layer * 320 * D);
            tr_item2(W, D, r0, 32, k0, br == 0 ? 384 : 320, (bf16_t*)(ws + WS_WP), YC_W, r0, br * 384 + k0, scr, F.lane); }
        else if (it < C4) { const int r = it - C3, kb = r / 32, nb = r % 32, r0 = nb * 32;
            tr_item(a.in(I_WOUT) + (size_t)layer * D * D, D, r0, 32, kb * 64, 1024, (bf16_t*)(ws + WS_WO), 1024, r0, scr, F.lane); }
        else if (it < C5) { const int r = it - C4, kb = r / 256, nb = r % 256, r0 = nb * 32, e = r0 >> 9, rr = r0 & 511, j = rr >> 8, q = rr & 255;
            const float* W = (q >= 128 ? a.in(I_MUP) : a.in(I_MGATE)) + ((size_t)layer * NEXP + e) * D * DEXP;
            tr_item(W, DEXP, j * 128 + (q & 127), 32, kb * 64, 1024, (bf16_t*)(ws + WS_WGU), 1024, r0, scr, F.lane); }
        else { const int r = it - C5, kb = r / 512, nb = r % 512, r0 = nb * 32, e = r0 >> 10;
            tr_item(a.in(I_MDOWN) + ((size_t)layer * NEXP + e) * DEXP * D, D, r0 & 1023, 32, kb * 64, 256, (bf16_t*)(ws + WS_WD), 256, r0, scr, F.lane); }
    }
}

__device__ __forceinline__ void add_y_row(f32x4 (&v)[4], const bf16_t* Y, int slot, int lane) {
    const u32x2* y = (const u32x2*)(Y + (size_t)slot * D) + lane;
#pragma unroll
    for (int j = 0; j < 4; ++j) { const u32x2 t = y[64 * j]; v[j].x += bf_lo(t.x); v[j].y += bf_hi(t.x); v[j].z += bf_lo(t.y); v[j].w += bf_hi(t.y); }
}
template <int MODE>
__device__ __forceinline__ void phase_norm(const ArgsL& a, Frame& F, int layer, const bool dry = false) {
    const int lane = F.lane;
    LAS float* wl = (LAS float*)F.lds;
    LAS int* lcnt = (LAS int*)(F.lds + 20 * 4096);
    unsigned char* ws = a.ws;
    if (MODE == 1) {
        const float* win = a.in(I_WIN) + (size_t)layer * D * D_IN;
        for (int idx = F.tid; idx < 5 * 1024; idx += NTHR) { const int j = idx >> 10, k = idx & 1023; wl[j * 1024 + k] = win[(size_t)k * D_IN + FCOL + j]; }
    }
    if (MODE == 2) {
        const float* wg = a.in(I_MWG) + (size_t)layer * D * 4; const float* we = a.in(I_MWE) + (size_t)layer * D * 16;
        for (int i4 = F.tid; i4 < 1024; i4 += NTHR) { const f32x4 f = *(const f32x4*)(wg + 4 * i4); wl[i4] = f.x; wl[1024 + i4] = f.y; wl[2048 + i4] = f.z; wl[3072 + i4] = f.w; }
        for (int i4 = F.tid; i4 < 4096; i4 += NTHR) { const int k = i4 >> 2, c = i4 & 3; const f32x4 f = *(const f32x4*)(we + 4 * i4); LAS float* d = wl + (4 + 4 * c) * 1024 + k;
            d[0] = f.x; d[1024] = f.y; d[2048] = f.z; d[3072] = f.w; }
        if (F.tid < 16) lcnt[F.tid] = 0;
    }
    __syncthreads();
    const int gw = F.bx * NWAVES + F.wave, NGW = gridDim.x * NWAVES;
    const float* gsrc = (MODE == 2 ? a.in(I_N2G) : a.in(I_N1G)) + layer * D;
    f32x4 gv[4];
#pragma unroll
    for (int j = 0; j < 4; ++j) gv[j] = (MODE == 0) ? (f32x4){0.f, 0.f, 0.f, 0.f} : *(const f32x4*)(gsrc + 4 * lane + 256 * j);
    bf16_t* A = A_PTR(a); bf16_t* HB = HB_PTR(a);
    const bf16_t* Y = (const bf16_t*)(ws + WS_Y);
    const int* SLOT = (const int*)(ws + WS_SLOT);
    constexpr bool COMB0 = (MODE == 0);
    const bool comb = COMB0 || (MODE == 1 && layer > 0);
    f32x4 vn[4]; u32x2 yan[4], ybn[4];
#pragma unroll
    for (int j = 0; j < 4; ++j) { vn[j] = (f32x4){0.f, 0.f, 0.f, 0.f}; yan[j] = (u32x2){0u, 0u}; ybn[j] = (u32x2){0u, 0u}; }
#define NRM_VALID(mm) ((mm) < M && ((mm) % T) - PADR >= (MODE == 0 ? NMETA : 0))
#define NRM_LOAD(mm, s0_, s1_) do { if (NRM_VALID(mm)) { const int bb_ = (mm) / T, ll_ = (mm) - bb_ * T - PADR; \
        if (MODE == 1 && layer == 0) { const float* src_ = (ll_ < NMETA) ? a.in(I_META) + (size_t)ll_ * D : a.in(I_X) + ((size_t)bb_ * SEQ + (ll_ - NMETA)) * D; \
            _Pragma("unroll") for (int j = 0; j < 4; ++j) vn[j] = *(const f32x4*)(src_ + 4 * lane + 256 * j); } \
        else { const u32x2* hs_ = (const u32x2*)(HB + (size_t)(mm) * D) + lane; \
            _Pragma("unroll") for (int j = 0; j < 4; ++j) { const u32x2 t_ = hs_[64 * j]; vn[j] = (f32x4){bf_lo(t_.x), bf_hi(t_.x), bf_lo(t_.y), bf_hi(t_.y)}; } } \
        if (comb) { const u32x2* y0_ = (const u32x2*)(Y + (size_t)(s0_) * D) + lane; const u32x2* y1_ = (const u32x2*)(Y + (size_t)(s1_) * D) + lane; \
            _Pragma("unroll") for (int j = 0; j < 4; ++j) { yan[j] = y0_[64 * j]; ybn[j] = y1_[64 * j]; } } } } while (0)
    int sa1 = 0, sb1 = 0, sa2 = 0, sb2 = 0;
    if (comb) { if (NRM_VALID(gw)) { sa1 = SLOT[2 * gw]; sb1 = SLOT[2 * gw + 1]; } if (NRM_VALID(gw + NGW)) { sa2 = SLOT[2 * (gw + NGW)]; sb2 = SLOT[2 * (gw + NGW) + 1]; } }
    NRM_LOAD(gw, sa1, sb1);
    for (int m = gw; m < M; m += NGW) {
        f32x4 v[4]; u32x2 ya[4], yb[4];
#pragma unroll
        for (int j = 0; j < 4; ++j) { v[j] = vn[j]; ya[j] = yan[j]; yb[j] = ybn[j]; }
        int sa3 = 0, sb3 = 0;
        if (comb && NRM_VALID(m + 2 * NGW)) { sa3 = SLOT[2 * (m + 2 * NGW)]; sb3 = SLOT[2 * (m + 2 * NGW) + 1]; }
        NRM_LOAD(m + NGW, sa2, sb2);
        sa2 = sa3; sb2 = sb3;
        const int b = m / T, p = m - b * T, l = p - PADR;
        if (l < 0) {
            if (MODE == 1 && !dry) {
                u32x2* o = (u32x2*)(A + (size_t)m * D) + lane;
#pragma unroll
                for (int j = 0; j < 4; ++j) o[64 * j] = (u32x2){0u, 0u};
                if (lane < 8) ((float*)(ws + WS_LOGF))[(size_t)m * 8 + lane] = 0.f;
            }
            continue;
        }
        if (MODE == 0 && l < NMETA) continue;
        if (comb) {
#pragma unroll
            for (int j = 0; j < 4; ++j) { v[j].x += bf_lo(ya[j].x) + bf_lo(yb[j].x); v[j].y += bf_hi(ya[j].x) + bf_hi(yb[j].x); v[j].z += bf_lo(ya[j].y) + bf_lo(yb[j].y); v[j].w += bf_hi(ya[j].y) + bf_hi(yb[j].y); }
        }
        if (MODE == 0 && !dry) { float* op = a.out + ((size_t)b * SEQ + (l - NMETA)) * D;
#pragma unroll
            for (int j = 0; j < 4; ++j) *(f32x4*)(op + 4 * lane + 256 * j) = v[j]; }
        if (MODE == 1 && !dry) { u32x2* hd = (u32x2*)(HB + (size_t)m * D) + lane;
#pragma unroll
            for (int j = 0; j < 4; ++j) hd[64 * j] = (u32x2){pk2(v[j].x, v[j].y), pk2(v[j].z, v[j].w)};
        }
        if (MODE == 0) continue;
        float ss = 0.f;
#pragma unroll
        for (int j = 0; j < 4; ++j) ss += (v[j].x * v[j].x + v[j].y * v[j].y) + (v[j].z * v[j].z + v[j].w * v[j].w);
        const float r = 1.0f / sqrtf(wave_sum(ss) * (1.0f / D) + 1e-6f);
#pragma unroll
        for (int j = 0; j < 4; ++j) v[j] = v[j] * r * gv[j];
        u32x2* o = (u32x2*)(A + (size_t)m * D) + lane;
        if (!dry) {
#pragma unroll
        for (int j = 0; j < 4; ++j) o[64 * j] = (u32x2){pk2(v[j].x, v[j].y), pk2(v[j].z, v[j].w)}; }
        else { float sink = v[0].x + v[1].y + v[2].z + v[3].w; asm volatile("" :: "v"(sink)); }
        if (MODE == 1) {
            float dsum[5];
#pragma unroll
            for (int q = 0; q < 5; ++q) { float d = 0.f;
#pragma unroll
                for (int j = 0; j < 4; ++j) { const f32x4 w = *(const LAS f32x4*)(wl + q * 1024 + 4 * lane + 256 * j); d += (v[j].x * w.x + v[j].y * w.y) + (v[j].z * w.z + v[j].w * w.w); }
                dsum[q] = wave_sum(d); }
            float mine = dsum[0];
            mine = lane == 1 ? dsum[1] : mine; mine = lane == 2 ? dsum[2] : mine; mine = lane == 3 ? dsum[3] : mine; mine = lane == 4 ? dsum[4] : mine;
            if (lane < 8 && !dry) { float lf = 0.f;
                if (lane < 5) { const float xx = mine + a.in(I_FB)[layer * 5 + lane]; lf = fminf(xx, 0.f) - fast_log(1.f + fast_exp(-fabsf(xx))); }
                ((float*)(ws + WS_LOGF))[(size_t)m * 8 + lane] = lf; }
        }
        if (MODE == 2) {
            float dp[20];
#pragma unroll
            for (int q = 0; q < 20; ++q) { float d = 0.f;
#pragma unroll
                for (int j = 0; j < 4; ++j) { const f32x4 w = *(const LAS f32x4*)(wl + q * 1024 + 4 * lane + 256 * j); d += (v[j].x * w.x + v[j].y * w.y) + (v[j].z * w.z + v[j].w * w.w); }
                dp[q] = d; }
            float sA[10], sB[5];
#pragma unroll
            for (int i = 0; i < 10; ++i) { auto sw = __builtin_amdgcn_permlane32_swap(__float_as_uint(dp[2 * i]), __float_as_uint(dp[2 * i + 1]), false, false); sA[i] = __uint_as_float(sw[0]) + __uint_as_float(sw[1]); }
#pragma unroll
            for (int i = 0; i < 5; ++i) { auto sw = __builtin_amdgcn_permlane16_swap(__float_as_uint(sA[2 * i]), __float_as_uint(sA[2 * i + 1]), false, false); sB[i] = allred16(__uint_as_float(sw[0]) + __uint_as_float(sw[1])); }
            LAS float* red = (LAS float*)(F.lds + 81920 + 256) + F.wave * 32;
            { const int rho = lane >> 4, vsel = ((rho & 1) << 1) | (rho >> 1);
              if ((lane & 15) == 0) {
#pragma unroll
                  for (int i = 0; i < 5; ++i) red[4 * i + vsel] = sB[i]; } }
            LDS_WAIT();
            float ds[20];
#pragma unroll
            for (int i = 0; i < 5; ++i) { const f32x4 t4 = *(const LAS f32x4*)(red + 4 * i); ds[4 * i] = t4.x; ds[4 * i + 1] = t4.y; ds[4 * i + 2] = t4.z; ds[4 * i + 3] = t4.w; }
            LDS_WAIT();
            const float* bg = a.in(I_MBG) + layer * 4; const float* be = a.in(I_MBE) + layer * 16;
            float lg0 = ds[0] + bg[0], lg1 = ds[1] + bg[1], lg2 = ds[2] + bg[2], lg3 = ds[3] + bg[3];
            int g = 0; float mx = lg0;
            if (lg1 > mx) { mx = lg1; g = 1; } if (lg2 > mx) { mx = lg2; g = 2; } if (lg3 > mx) { mx = lg3; g = 3; }
            const float den = fast_exp(lg0 - mx) + fast_exp(lg1 - mx) + fast_exp(lg2 - mx) + fast_exp(lg3 - mx);
            const float pgrp = 1.0f / den;
            float s0 = g == 0 ? ds[4] : g == 1 ? ds[8] : g == 2 ? ds[12] : ds[16];
            float s1 = g == 0 ? ds[5] : g == 1 ? ds[9] : g == 2 ? ds[13] : ds[17];
            float s2 = g == 0 ? ds[6] : g == 1 ? ds[10] : g == 2 ? ds[14] : ds[18];
            float s3 = g == 0 ? ds[7] : g == 1 ? ds[11] : g == 2 ? ds[15] : ds[19];
            s0 += be[g * 4 + 0]; s1 += be[g * 4 + 1]; s2 += be[g * 4 + 2]; s3 += be[g * 4 + 3];
            int i0 = 0; float v0 = s0;
            if (s1 > v0) { v0 = s1; i0 = 1; } if (s2 > v0) { v0 = s2; i0 = 2; } if (s3 > v0) { v0 = s3; i0 = 3; }
            int i1 = -1; float v1 = -3.0e38f;
            if (i0 != 0 && s0 > v1) { v1 = s0; i1 = 0; } if (i0 != 1 && s1 > v1) { v1 = s1; i1 = 1; } if (i0 != 2 && s2 > v1) { v1 = s2; i1 = 2; } if (i0 != 3 && s3 > v1) { v1 = s3; i1 = 3; }
            const float e1 = fast_exp(v1 - v0), pt0 = 1.0f / (1.0f + e1), pt1 = e1 * pt0;
            if (dry) { float sink = pgrp * pt0 + pt1; asm volatile("" :: "v"(sink)); }
            if (lane == 0 && !dry) {
                const int ea = g * 4 + i0, eb = g * 4 + i1;
                const int la = atomicAdd((int*)&lcnt[ea], 1), lb = atomicAdd((int*)&lcnt[eb], 1);
                int* tk = (int*)(ws + WS_TOK) + (size_t)m * 8;
                tk[0] = ea; tk[1] = eb; tk[2] = __float_as_int(pgrp * pt0); tk[3] = __float_as_int(pgrp * pt1); tk[4] = la; tk[5] = lb;
            }
        }
    }
    __syncthreads();
#undef NRM_LOAD
#undef NRM_VALID
    if (MODE == 2 && F.tid < 16 && !dry) {
        const int c = lcnt[F.tid];
        ((int*)(ws + WS_WGCNT))[F.bx * 16 + F.tid] = c;
        atomicAdd((int*)(ws + WS_CTL) + CW_ECNT + 64 * layer + F.tid, c);
    }
    __syncthreads();
}

__device__ __forceinline__ void phase_norm2(const ArgsL& a, Frame& F, int layer, const bool dry = false) {
    const int lane = F.lane;
    LAS float* wl = (LAS float*)F.lds;
    LAS int* lcnt = (LAS int*)(F.lds + 20 * 4096);
    unsigned char* ws = a.ws;
    {
        const float* wg = a.in(I_MWG) + (size_t)layer * D * 4; const float* we = a.in(I_MWE) + (size_t)layer * D * 16;
        for (int i4 = F.tid; i4 < 1024; i4 += NTHR) { const f32x4 f = *(const f32x4*)(wg + 4 * i4); wl[i4] = f.x; wl[1024 + i4] = f.y; wl[2048 + i4] = f.z; wl[3072 + i4] = f.w; }
        for (int i4 = F.tid; i4 < 4096; i4 += NTHR) { const int k = i4 >> 2, c = i4 & 3; const f32x4 f = *(const f32x4*)(we + 4 * i4); LAS float* d = wl + (4 + 4 * c) * 1024 + k;
            d[0] = f.x; d[1024] = f.y; d[2048] = f.z; d[3072] = f.w; }
        if (F.tid < 16) lcnt[F.tid] = 0;
    }
    __syncthreads();
    const int gw = F.bx * NWAVES + F.wave, NGW = gridDim.x * NWAVES;
    LAS float* gl = (LAS float*)(F.lds + 86016);
    LAS float* bl = (LAS float*)(F.lds + 90112);
    for (int i = F.tid; i < 1024; i += NTHR) gl[i] = a.in(I_N2G)[layer * D + i];
    if (F.tid < 4) bl[F.tid] = a.in(I_MBG)[layer * 4 + F.tid];
    if (F.tid >= 64 && F.tid < 80) bl[4 + F.tid - 64] = a.in(I_MBE)[layer * 16 + F.tid - 64];
    __syncthreads();
    bf16_t* A = A_PTR(a); const bf16_t* HB = HB_PTR(a);
    LAS float* red = (LAS float*)(F.lds + 81920 + 256) + F.wave * 96;
#define N2_VALID(mm) ((mm) < M && ((mm) % T) >= PADR)
    constexpr int NR = 2;
    for (int m0 = gw; m0 < M; m0 += NR * NGW) {
        f32x4 v[NR][4];
#pragma unroll
        for (int rr = 0; rr < NR; ++rr) { const int mm_ = m0 + rr * NGW;
            if (N2_VALID(mm_)) { const u32x2* hs_ = (const u32x2*)(HB + (size_t)mm_ * D) + lane;
#pragma unroll
                for (int j = 0; j < 4; ++j) { const u32x2 t = hs_[64 * j]; v[rr][j] = (f32x4){bf_lo(t.x), bf_hi(t.x), bf_lo(t.y), bf_hi(t.y)}; } }
            else {
#pragma unroll
                for (int j = 0; j < 4; ++j) v[rr][j] = (f32x4){0.f, 0.f, 0.f, 0.f}; } }
        float ss[NR];
#pragma unroll
        for (int rr = 0; rr < NR; ++rr) { float s_ = 0.f;
#pragma unroll
            for (int j = 0; j < 4; ++j) s_ += (v[rr][j].x * v[rr][j].x + v[rr][j].y * v[rr][j].y) + (v[rr][j].z * v[rr][j].z + v[rr][j].w * v[rr][j].w);
            ss[rr] = s_; }
#pragma unroll
        for (int rr = 0; rr < NR; ++rr) ss[rr] = wave_sum(ss[rr]);
#pragma unroll
        for (int rr = 0; rr < NR; ++rr) { const int mm = m0 + rr * NGW; const float r = 1.0f / sqrtf(ss[rr] * (1.0f / D) + 1e-6f);
#pragma unroll
            for (int j = 0; j < 4; ++j) v[rr][j] = v[rr][j] * r * *(const LAS f32x4*)(gl + 4 * lane + 256 * j);
            if (N2_VALID(mm) && !dry) { u32x2* o = (u32x2*)(A + (size_t)mm * D) + lane;
#pragma unroll
                for (int j = 0; j < 4; ++j) o[64 * j] = (u32x2){pk2(v[rr][j].x, v[rr][j].y), pk2(v[rr][j].z, v[rr][j].w)}; } }
        { const int rho = lane >> 4, vsel = ((rho & 1) << 1) | (rho >> 1);
#pragma unroll
          for (int qh = 0; qh < 2; ++qh) {
            float dp[NR][10];
#pragma unroll
            for (int q = 0; q < 10; ++q) { f32x4 w[4];
#pragma unroll
                for (int j = 0; j < 4; ++j) w[j] = *(const LAS f32x4*)(wl + (qh * 10 + q) * 1024 + 4 * lane + 256 * j);
#pragma unroll
                for (int rr = 0; rr < NR; ++rr) { float d = 0.f;
#pragma unroll
                    for (int j = 0; j < 4; ++j) d += (v[rr][j].x * w[j].x + v[rr][j].y * w[j].y) + (v[rr][j].z * w[j].z + v[rr][j].w * w[j].w);
                    dp[rr][q] = d; }
                if (q & 1) __builtin_amdgcn_sched_barrier(0); }
#pragma unroll
            for (int rr = 0; rr < NR; ++rr) { float sA[6], sB[3]; sA[5] = 0.f;
#pragma unroll
                for (int i = 0; i < 5; ++i) { auto sw = __builtin_amdgcn_permlane32_swap(__float_as_uint(dp[rr][2 * i]), __float_as_uint(dp[rr][2 * i + 1]), false, false); sA[i] = __uint_as_float(sw[0]) + __uint_as_float(sw[1]); }
#pragma unroll
                for (int k = 0; k < 3; ++k) { auto sw = __builtin_amdgcn_permlane16_swap(__float_as_uint(sA[2 * k]), __float_as_uint(sA[2 * k + 1]), false, false); sB[k] = allred16(__uint_as_float(sw[0]) + __uint_as_float(sw[1])); }
                if ((lane & 15) == 0) {
#pragma unroll
                    for (int k = 0; k < 3; ++k) red[rr * 24 + qh * 10 + 4 * k + vsel] = sB[k]; } }
            __builtin_amdgcn_sched_barrier(0);
          } }
        LDS_WAIT();
        if (lane < NR) {
            const int mm = m0 + lane * NGW;
            float ds[20];
#pragma unroll
            for (int i = 0; i < 5; ++i) { const f32x4 t4 = *(const LAS f32x4*)(red + lane * 24 + 4 * i); ds[4 * i] = t4.x; ds[4 * i + 1] = t4.y; ds[4 * i + 2] = t4.z; ds[4 * i + 3] = t4.w; }
            const float lg0 = ds[0] + bl[0], lg1 = ds[1] + bl[1], lg2 = ds[2] + bl[2], lg3 = ds[3] + bl[3];
            int g = 0; float mx = lg0;
            if (lg1 > mx) { mx = lg1; g = 1; } if (lg2 > mx) { mx = lg2; g = 2; } if (lg3 > mx) { mx = lg3; g = 3; }
            const float den = fast_exp(lg0 - mx) + fast_exp(lg1 - mx) + fast_exp(lg2 - mx) + fast_exp(lg3 - mx);
            const float pgrp = 1.0f / den;
            const f32x4 be4 = *(const LAS f32x4*)(bl + 4 + 4 * g);
            float s0 = (g == 0 ? ds[4] : g == 1 ? ds[8] : g == 2 ? ds[12] : ds[16]) + be4.x;
            float s1 = (g == 0 ? ds[5] : g == 1 ? ds[9] : g == 2 ? ds[13] : ds[17]) + be4.y;
            float s2 = (g == 0 ? ds[6] : g == 1 ? ds[10] : g == 2 ? ds[14] : ds[18]) + be4.z;
            float s3 = (g == 0 ? ds[7] : g == 1 ? ds[11] : g == 2 ? ds[15] : ds[19]) + be4.w;
            int i0 = 0; float v0 = s0;
            if (s1 > v0) { v0 = s1; i0 = 1; } if (s2 > v0) { v0 = s2; i0 = 2; } if (s3 > v0) { v0 = s3; i0 = 3; }
            int i1 = -1; float v1 = -3.0e38f;
            if (i0 != 0 && s0 > v1) { v1 = s0; i1 = 0; } if (i0 != 1 && s1 > v1) { v1 = s1; i1 = 1; } if (i0 != 2 && s2 > v1) { v1 = s2; i1 = 2; } if (i0 != 3 && s3 > v1) { v1 = s3; i1 = 3; }
            const float e1 = fast_exp(v1 - v0), pt0 = 1.0f / (1.0f + e1), pt1 = e1 * pt0;
            if (N2_VALID(mm) && !dry) {
                const int ea = g * 4 + i0, eb = g * 4 + i1;
                const int la = atomicAdd((int*)&lcnt[ea], 1), lb = atomicAdd((int*)&lcnt[eb], 1);
                int* tk = (int*)(ws + WS_TOK) + (size_t)mm * 8;
                tk[0] = ea; tk[1] = eb; tk[2] = __float_as_int(pgrp * pt0); tk[3] = __float_as_int(pgrp * pt1); tk[4] = la; tk[5] = lb;
            } else { float sink = pgrp * pt0 + pt1; asm volatile("" :: "v"(sink)); }
        }
        LDS_WAIT();
    }
#undef N2_VALID
    __syncthreads();
    if (F.tid < 16 && !dry) {
        const int c = lcnt[F.tid];
        ((int*)(ws + WS_WGCNT))[F.bx * 16 + F.tid] = c;
        atomicAdd((int*)(ws + WS_CTL) + CW_ECNT + 64 * layer + F.tid, c);
    }
    __syncthreads();
}

__device__ __forceinline__ void phase_route(const ArgsL& a, Frame& F, int layer) {
    unsigned char* ws = a.ws;
    LAS int* tbl = (LAS int*)F.lds;
    LAS int* part = tbl + 16;
    {
        const int e = F.tid & 15, q = F.tid >> 4; const int* wc = (const int*)(ws + WS_WGCNT); int acc = 0;
#pragma unroll
        for (int i = 0; i < 8; ++i) { const int w = q + 32 * i; if (w < (int)F.bx) acc += wc[w * 16 + e]; }
        part[q * 16 + e] = acc;
    }
    __syncthreads();
    if (F.tid < 16) {
        const int* cnt = (const int*)(ws + WS_CTL) + CW_ECNT + 64 * layer;
        int cv[16];
#pragma unroll
        for (int e = 0; e < 16; ++e) cv[e] = __hip_atomic_load(cnt + e, __ATOMIC_RELAXED, __HIP_MEMORY_SCOPE_AGENT);
        int base = 0;
#pragma unroll
        for (int e = 0; e < 16; ++e) if (e < F.tid) base += ((cv[e] + 255) >> 8) << 8;
#pragma unroll
        for (int q = 0; q < 32; ++q) base += part[q * 16 + F.tid];
        tbl[F.tid] = base; tbl[16 + 512 + F.tid] = __hip_atomic_load(cnt + F.tid, __ATOMIC_RELAXED, __HIP_MEMORY_SCOPE_AGENT);
    }
    __syncthreads();
    if (F.bx == 0) {
        int* s2t = (int*)(ws + WS_S2T);
        for (int e = 0; e < 16; ++e) { const int n = tbl[16 + 512 + e], b0 = tbl[e] + n, pad = (((n + 255) >> 8) << 8) - n;
            for (int i = F.tid; i < pad; i += NTHR) s2t[b0 + i] = 0; }
    }
    int* s2t = (int*)(ws + WS_S2T);
    for (int j = F.tid; j < 8 * ((M + 2047) / 2048); j += NTHR) {
        const int m = (j >> 3) * 2048 + (int)F.bx * 8 + (j & 7);
        if (m >= M) continue;
        const int b = m / T, p = m - b * T;
        if (p < PADR) continue;
        const int* tk_ = (const int*)(ws + WS_TOK) + (size_t)m * 8;
        const u32x4 t4 = *(const u32x4*)tk_; const u32x2 t2 = *(const u32x2*)(tk_ + 4);
        const int ea = (int)t4.x, eb = (int)t4.y, sa = tbl[ea] + (int)t2.x, sb = tbl[eb] + (int)t2.y;
        s2t[sa] = m; s2t[sb] = m;
        int* sl = (int*)(ws + WS_SLOT) + 2 * m; sl[0] = sa; sl[1] = sb;
        float* cw = (float*)(ws + WS_CWS); cw[sa] = __uint_as_float(t4.z); cw[sb] = __uint_as_float(t4.w);
    }
    __syncthreads();
}

#ifndef PR_STAGES
#define PR_STAGES 15
#endif
__device__ __forceinline__ void phase_prep(const ArgsL& a, Frame& F, int layer, const bool dry = false) {
    unsigned char* ws = a.ws;
    LAS float* xs = (LAS float*)F.lds;
    const int wave = F.wave, lane = F.lane, tid = F.tid;
    const int m0 = F.bx * 129;
    const bf16_t* USH = (const bf16_t*)(ws + WS_USH);
    bf16_t* QKV = (bf16_t*)(ws + WS_QKV);
    if (F.bx < 10 && (!dry || (PR_STAGES & 8))) {
        const int bh = F.bx, b = bh / 5, h = bh % 5;
        const float* LOGF = (const float*)(ws + WS_LOGF) + (size_t)(b * T + PADR) * 8 + h;
        float* kb = (float*)(ws + WS_KB2) + (size_t)bh * KBP;
        LAS float* wtot = (LAS float*)F.lds;
        float v[33];
        const int l0 = tid * 33;
#pragma unroll
        for (int i = 0; i < 33; ++i) v[i] = (l0 + i < LTOK) ? LOGF[(size_t)(l0 + i) * 8] : 0.f;
#pragma unroll
        for (int i = 1; i < 33; ++i) v[i] += v[i - 1];
        float incl = v[32];
#pragma unroll
        for (int o = 1; o < 64; o <<= 1) { const float t = __shfl_up(incl, o); if (lane >= o) incl += t; }
        if (lane == 63) wtot[wave] = incl;
        __syncthreads();
        float off = incl - v[32];
        for (int w = 0; w < wave; ++w) off += wtot[w];
#pragma unroll
        for (int i = 0; i < 33; ++i) if (l0 + i < LTOK && !dry) kb[PADR + l0 + i] = -(off + v[i]) * LOG2E;
        for (int p = tid; p < PADR; p += NTHR) kb[p] = 0.f;
        for (int p = T + tid; p < KBP; p += NTHR) kb[p] = 0.f;
        __syncthreads();
    }
    if (F.bx >= 16 && F.bx < 28) {
        unsigned* z = (unsigned*)(ws + WS_RW + ((size_t)(F.bx - 16) * LPADDED + LTOK) * 768);
        for (int i = tid; i < (LPADDED - LTOK) * 192; i += NTHR) z[i] = 0u;
    }
    const int r16 = lane & 15, q4 = lane >> 4, hh = wave < 6 ? wave : 0;
    bf16x8 bw[2][4][2];
    float cw0[4], ca0[4], ckk[4], cka[4], crk[4];
    {
        const float* WUp = a.in(I_WUP) + (size_t)layer * 64 * RW_W + hh * 64 + r16; const float* AUp = a.in(I_AUP) + (size_t)layer * 64 * RW_W + hh * 64 + r16;
#pragma unroll
        for (int mtx = 0; mtx < 2; ++mtx)
#pragma unroll
            for (int blk = 0; blk < 4; ++blk)
#pragma unroll
                for (int ks = 0; ks < 2; ++ks) { const float* p_ = (mtx ? AUp : WUp) + (size_t)(32 * ks + 8 * q4) * RW_W + blk * 16;
                    const float f0 = p_[0], f1 = p_[RW_W], f2 = p_[2 * RW_W], f3 = p_[3 * RW_W], f4 = p_[4 * RW_W], f5 = p_[5 * RW_W], f6 = p_[6 * RW_W], f7 = p_[7 * RW_W];
                    bw[mtx][blk][ks] = __builtin_bit_cast(bf16x8, (u32x4){pk2(f0, f1), pk2(f2, f3), pk2(f4, f5), pk2(f6, f7)}); }
#pragma unroll
        for (int blk = 0; blk < 4; ++blk) { const int ch = layer * RW_W + hh * 64 + blk * 16 + r16;
            cw0[blk] = a.in(I_W0)[ch]; ca0[blk] = a.in(I_A0)[ch]; ckk[blk] = a.in(I_KK)[ch]; cka[blk] = a.in(I_KA)[ch]; crk[blk] = a.in(I_RK)[ch]; }
    }
    const float* mu = a.in(I_MU) + layer * SHIFT_W;
    f32x4 gq4 = *(const f32x4*)(a.in(I_QG) + layer * 64 + (lane & 15) * 4) * C2; const f32x4 gk4 = *(const f32x4*)(a.in(I_KG) + layer * 64 + (lane & 15) * 4);
    _Float16* RW = (_Float16*)(ws + WS_RW);
    bf16_t* BN = (bf16_t*)(ws + WS_BN);
    for (int t0 = 0; t0 < 129; t0 += 16) {
        const int nt = (129 - t0) < 16 ? (129 - t0) : 16;
        if (!dry || (PR_STAGES & 1)) {
            int tid = F.tid; asm volatile("" : "+v"(tid));
            u32x4 uu4[5], pp4[5];
#pragma unroll
            for (int q5 = 0; q5 < 5; ++q5) { const int item = tid + q5 * NTHR; uu4[q5] = (u32x4){0u, 0u, 0u, 0u}; pp4[q5] = (u32x4){0u, 0u, 0u, 0u};
                if (item < nt * 160) { const int tok = item / 160, ch = item - tok * 160, m = m0 + t0 + tok;
                    uu4[q5] = *(const u32x4*)(USH + (size_t)m * SHIFT_W + ch * 8);
                    if (m > 0) pp4[q5] = *(const u32x4*)(USH + (size_t)(m - 1) * SHIFT_W + ch * 8); } }
#pragma unroll
            for (int q5 = 0; q5 < 5; ++q5) { const int item = tid + q5 * NTHR;
                if (item < nt * 160) { const int tok = item / 160, ch = item - tok * 160;
                    const u32x4 u = uu4[q5], pv = pp4[q5];
                    const f32x4 mu0 = *(const f32x4*)(mu + ch * 8), mu1 = *(const f32x4*)(mu + ch * 8 + 4);
                    float x[8];
                    { float uu, pp;
                      uu = bf_lo(u.x); pp = bf_lo(pv.x); x[0] = uu + (pp - uu) * mu0.x;  uu = bf_hi(u.x); pp = bf_hi(pv.x); x[1] = uu + (pp - uu) * mu0.y;
                      uu = bf_lo(u.y); pp = bf_lo(pv.y); x[2] = uu + (pp - uu) * mu0.z;  uu = bf_hi(u.y); pp = bf_hi(pv.y); x[3] = uu + (pp - uu) * mu0.w;
                      uu = bf_lo(u.z); pp = bf_lo(pv.z); x[4] = uu + (pp - uu) * mu1.x;  uu = bf_hi(u.z); pp = bf_hi(pv.z); x[5] = uu + (pp - uu) * mu1.y;
                      uu = bf_lo(u.w); pp = bf_lo(pv.w); x[6] = uu + (pp - uu) * mu1.z;  uu = bf_hi(u.w); pp = bf_hi(pv.w); x[7] = uu + (pp - uu) * mu1.w; }
                    if (ch >= 144 && ch < 152) {
#pragma unroll
                        for (int q = 0; q < 8; ++q) { const float e = fast_exp(-2.f * fabsf(x[q])); const float th = (1.f - e) / (1.f + e); x[q] = x[q] < 0.f ? -th : th; }
                    }
                    LAS f32x4* d = (LAS f32x4*)(xs + tok * SHIFT_W + ch * 8);
                    d[0] = (f32x4){x[0], x[1], x[2], x[3]}; d[1] = (f32x4){x[4], x[5], x[6], x[7]}; } }
        }
        __syncthreads();
        if (wave < 6) { if (!dry || (PR_STAGES & 2)) {
            f32x4 acc[2][4];
#pragma unroll
            for (int mtx = 0; mtx < 2; ++mtx) {
                bf16x8 af[2];
#pragma unroll
                for (int ks = 0; ks < 2; ++ks) { const LAS float* xp = xs + r16 * SHIFT_W + 1152 + 64 * mtx + 32 * ks + 8 * q4;
                    const f32x4 u0 = *(const LAS f32x4*)xp, u1 = *(const LAS f32x4*)(xp + 4);
                    af[ks] = __builtin_bit_cast(bf16x8, (u32x4){pk2(u0.x, u0.y), pk2(u0.z, u0.w), pk2(u1.x, u1.y), pk2(u1.z, u1.w)}); }
#pragma unroll
                for (int blk = 0; blk < 4; ++blk) { f32x4 c4 = {0.f, 0.f, 0.f, 0.f};
                    c4 = __builtin_amdgcn_mfma_f32_16x16x32_bf16(af[0], bw[mtx][blk][0], c4, 0, 0, 0);
                    c4 = __builtin_amdgcn_mfma_f32_16x16x32_bf16(af[1], bw[mtx][blk][1], c4, 0, 0, 0);
                    acc[mtx][blk] = c4; }
            }
#pragma unroll
            for (int i = 0; i < 4; ++i) {
                const int tok = 4 * q4 + i, m = m0 + t0 + tok, b = m / T, p = m - b * T, l = p - PADR;
                const bool ok = (tok < nt) && (l >= 0);
                const LAS float* xr = xs + (tok < 16 ? tok : 0) * SHIFT_W + hh * 64 + r16;
                float kkr[4], kpv[4], avv4[4], omv[4], rv4[4], vv4[4];
                float ssq = 0.f, cf = 0.f;
#pragma unroll
                for (int blk = 0; blk < 4; ++blk) {
                    const float wlv = cw0[blk] + acc[0][blk][i], alv = ca0[blk] + acc[1][blk][i];
                    const float r = xr[blk * 16], k = xr[384 + blk * 16], v = xr[768 + blk * 16];
                    const float logw = -softplus_f(-wlv) - 0.5f;
                    const float xw = fast_exp(logw);
                    omv[blk] = xw < 0.02f ? xw * (1.f - 0.5f * xw + xw * xw * (1.f / 6.f)) : 1.f - fast_exp(-xw);
                    const float av = 1.f / (1.f + fast_exp(-alv));
                    kkr[blk] = k * ckk[blk]; kpv[blk] = k * (1.f + (av - 1.f) * cka[blk]); avv4[blk] = av; rv4[blk] = r; vv4[blk] = v;
                    ssq += kkr[blk] * kkr[blk]; cf += r * kpv[blk] * crk[blk];
                }
                ssq = allred16(ssq); cf = allred16(cf);
                const float inv = 1.0f / fmaxf(sqrtf(ssq), 1e-12f);
                if (ok && !dry) {
                    _Float16* o = RW + ((size_t)(b * RW_H + hh) * LPADDED + l) * 384 + r16;
#pragma unroll
                    for (int blk = 0; blk < 4; ++blk) { const float kk = kkr[blk] * inv, bb = kk * avv4[blk];
                        o[blk * 16] = (_Float16)kk; o[64 + blk * 16] = (_Float16)(-omv[blk]); o[128 + blk * 16] = (_Float16)(-bb); o[192 + blk * 16] = (_Float16)kpv[blk];
                        o[256 + blk * 16] = (_Float16)rv4[blk]; o[320 + blk * 16] = (_Float16)vv4[blk];
                        BN[(size_t)m * RW_W + hh * 64 + blk * 16 + r16] = f2bf(cf * vv4[blk]); }
                } else { float sink = ssq + cf + inv + omv[0] + kpv[1]; asm volatile("" :: "v"(sink)); }
            } }
        }
        if (!dry || (PR_STAGES & 4)) {
            const int it4 = lane >> 4, e4 = lane & 15;
            u32x2 xv[5]; bf16_t* qp5[5]; bool okv[5];
#pragma unroll
            for (int ps = 0; ps < 5; ++ps) { const int item = (ps * 8 + wave) * 4 + it4, tok = item / 10, hq = item - tok * 10;
                const int m = m0 + t0 + tok, p = m % T;
                okv[ps] = (tok < nt) && (p >= PADR);
                qp5[ps] = QKV + (size_t)m * QKV_W + 960 + hq * 64 + e4 * 4;
                xv[ps] = okv[ps] ? *(const u32x2*)qp5[ps] : (u32x2){0u, 0u}; }
#pragma unroll
            for (int ps = 0; ps < 5; ++ps) { const int item = (ps * 8 + wave) * 4 + it4, hq = item % 10;
                const float x0 = bf_lo(xv[ps].x), x1 = bf_hi(xv[ps].x), x2 = bf_lo(xv[ps].y), x3 = bf_hi(xv[ps].y);
                const float ss = allred16((x0 * x0 + x1 * x1) + (x2 * x2 + x3 * x3));
                const float rs = 1.0f / sqrtf(ss * (1.0f / 64.f) + 1e-6f);
                const f32x4 gg = hq < 5 ? gq4 : gk4;
                const u32x2 w = {pk2(x0 * rs * gg.x, x1 * rs * gg.y), pk2(x2 * rs * gg.z, x3 * rs * gg.w)};
                if (okv[ps] && !dry) *(u32x2*)qp5[ps] = w; else asm volatile("" :: "v"(w.x), "v"(w.y)); }
        }
        __syncthreads();
    }
}


constexpr int SCH = 16;
static_assert(LTOK % SCH == 0, "whole chunks");
__device__ __forceinline__ void rwkv_scan(const ArgsL& a, Frame& F, int wgi, int dry = 0) {
    const int bh = wgi >> 4, q8 = wgi & 15, b = bh / RW_H, h = bh % RW_H;
    const int tid = F.tid, wave = F.wave, lane = F.lane;
    const unsigned char* rw = a.ws + WS_RW + (size_t)bh * LPADDED * 768;
    LAS float* ring = (LAS float*)F.lds;
    LAS float* ypart = (LAS float*)(F.lds + 49152);
    LAS unsigned char* stg = F.lds + 81920;
    bf16_t* y0 = (bf16_t*)(a.ws + WS_YCAT);
    constexpr int NCH = LTOK / SCH;
    const bool isld = (wave & 2) != 0; const int lw = (wave & 1) + ((wave >> 2) << 1), tl = lw * 64 + lane;
    float s0 = 0.f, s1 = 0.f;
    const int i32 = lane & 31, rsel = lane >> 5, rloc = 2 * wave + rsel;
#define RW_BAR() asm volatile("s_waitcnt lgkmcnt(0)\n\ts_barrier" ::: "memory")
#define RW_ISSUE(cc) do { const unsigned char* src_ = rw + (size_t)(cc) * SCH * 768 + (size_t)tl * 16; LAS unsigned char* d_ = stg + ((cc) & 3) * 12288 + lw * 1024; \
        _Pragma("unroll") for (int k_ = 0; k_ < 3; ++k_) __builtin_amdgcn_global_load_lds((const unsigned*)(src_ + k_ * 4096), (LAS unsigned*)(d_ + k_ * 4096), 16, 0, 0); } while (0)
#define RW_CONVERT(cc) do { const LAS unsigned char* s_ = stg + ((cc) & 3) * 12288 + tl * 16; LAS float* rb_ = ring + ((cc) & 1) * 6144; \
        _Pragma("unroll") for (int k_ = 0; k_ < 3; ++k_) { const int pc_ = tl + 256 * k_; const int t_ = pc_ / 48, q_ = pc_ - t_ * 48, vec_ = q_ >> 3, e0_ = (q_ & 7) * 8; \
            const u32x4 w_ = *(const LAS u32x4*)(s_ + k_ * 4096); \
            const f16x4 lo_ = __builtin_bit_cast(f16x4, (u32x2){w_.x, w_.y}), hi_ = __builtin_bit_cast(f16x4, (u32x2){w_.z, w_.w}); \
            const float f0 = (float)lo_.x, f1 = (float)lo_.y, f2 = (float)lo_.z, f3 = (float)lo_.w, f4 = (float)hi_.x, f5 = (float)hi_.y, f6 = (float)hi_.z, f7 = (float)hi_.w; \
            if (vec_ < 4) { LAS float* d_ = rb_ + t_ * 384 + (vec_ >> 1) * 128 + (e0_ >> 1) * 4 + (vec_ & 1) * 2; \
                *(LAS f32x2*)(d_) = (f32x2){f0, f1}; *(LAS f32x2*)(d_ + 4) = (f32x2){f2, f3}; *(LAS f32x2*)(d_ + 8) = (f32x2){f4, f5}; *(LAS f32x2*)(d_ + 12) = (f32x2){f6, f7}; } \
            else { LAS f32x4* d_ = (LAS f32x4*)(rb_ + t_ * 384 + (vec_ == 4 ? 256 : 320) + e0_); d_[0] = (f32x4){f0, f1, f2, f3}; d_[1] = (f32x4){f4, f5, f6, f7}; } } } while (0)
#define RW_STORE_Y(cc) do { if (tl < 32) { const LAS float* yb_ = ypart + ((cc) & 1) * 4096; const int t_ = tl >> 1, pr_ = tl & 1; const int l_ = (cc) * SCH + t_; \
        const LAS f32x4* q_ = (const LAS f32x4*)(yb_ + t_ * 128 + pr_ * 64); f32x4 sa_ = q_[0], sb_ = q_[8]; \
        _Pragma("unroll") for (int k_ = 1; k_ < 8; ++k_) { sa_ = sa_ + q_[k_]; sb_ = sb_ + q_[8 + k_]; } \
        *(unsigned*)(y0 + (size_t)(b * T + PADR + l_) * RW_W + h * 64 + q8 * 4 + 2 * pr_) = pk2((sa_.x + sa_.y) + (sa_.z + sa_.w), (sb_.x + sb_.y) + (sb_.z + sb_.w)); } } while (0)
    if (isld) {
        RW_ISSUE(0); asm volatile("s_waitcnt vmcnt(0)" ::: "memory"); RW_CONVERT(0);
        RW_ISSUE(1); RW_ISSUE(2);
    }
    RW_BAR();
    for (int c = 0; c < NCH; ++c) {
        if (isld) {
            if (c + 2 < NCH) { asm volatile("s_waitcnt vmcnt(3)" ::: "memory"); RW_CONVERT(c + 1); }
            else if (c + 1 < NCH) { asm volatile("s_waitcnt vmcnt(0)" ::: "memory"); RW_CONVERT(c + 1); }
            if (c > 0 && !dry) RW_STORE_Y(c - 1);
            if (c + 3 < NCH) RW_ISSUE(c + 3);
        } else if (dry != 1 && wave < 2) {
            const unsigned ba = (unsigned)(uintptr_t)(ring + (c & 1) * 6144) + i32 * 16, ca = (unsigned)(uintptr_t)(ring + (c & 1) * 6144) + 1024 + i32 * 8,
                           va = (unsigned)(uintptr_t)(ring + (c & 1) * 6144) + 1280 + (q8 * 4 + rloc) * 4, ya = (unsigned)(uintptr_t)(ypart + (c & 1) * 4096 + rloc * 32 + i32);
            f32x4 OA[4], OB[4]; f32x2 OC[4]; float OV[4];
            OC[3] = (f32x2){0.f, 0.f};
#define RW_FETCH(tt, sl) asm volatile("ds_read_b128 %0, %4 offset:%c7\n\tds_read_b128 %1, %4 offset:%c8\n\tds_read_b64 %2, %5 offset:%c7\n\tds_read_b32 %3, %6 offset:%c7" \
                : "=&v"(OA[sl]), "=&v"(OB[sl]), "=&v"(OC[sl]), "=&v"(OV[sl]) : "v"(ba), "v"(ca), "v"(va), "i"((tt) * 1536), "i"((tt) * 1536 + 512) : "memory")
            RW_FETCH(0, 0); RW_FETCH(1, 1);
            float p, p2, y;
#define RW_STEP(t, WAITN, YL1, YL2, YW, FETCHL) asm volatile( \
                "s_waitcnt lgkmcnt(" WAITN ")\n\t" \
                "v_mul_f32 %[p], %[s0], %[kk0]\n\t" \
                "v_fmac_f32 %[p], %[s1], %[kk1]\n\t" \
                YL1 "\n\t" YL2 "\n\t" \
                XL8 "\n\t" \
                "v_fmac_f32 %[s0], %[s0], %[om0]\n\t" \
                "v_fmac_f32 %[s1], %[s1], %[om1]\n\t" \
                XL4 "\n\t" \
                "v_fmac_f32 %[s0], %[vf], %[kv0]\n\t" \
                "v_fmac_f32 %[s1], %[vf], %[kv1]\n\t" \
                XL2 "\n\t" \
                YW "\n\t" \
                FETCHL \
                : [p] "=&v"(p), [p2] "=&v"(p2), [y] "=&v"(y), [s0] "+v"(s0), [s1] "+v"(s1), [nA] "=&v"(OA[((t) + 2) & 3]), [nB] "=&v"(OB[((t) + 2) & 3]), [nC] "=&v"(OC[((t) + 2) & 3]), [nV] "=&v"(OV[((t) + 2) & 3]) \
                : [kk0] "v"(OA[(t) & 3].x), [kk1] "v"(OA[(t) & 3].y), [om0] "v"(OA[(t) & 3].z), [om1] "v"(OA[(t) & 3].w), [bb0] "v"(OB[(t) & 3].x), [bb1] "v"(OB[(t) & 3].y), [kv0] "v"(OB[(t) & 3].z), [kv1] "v"(OB[(t) & 3].w), \
                  [vf] "v"(OV[(t) & 3]), [rp0] "v"(OC[((t) + 3) & 3].x), [rp1] "v"(OC[((t) + 3) & 3].y), [ba] "v"(ba), [ca] "v"(ca), [va] "v"(va), [ya] "v"(ya), \
                  [oa] "i"(((t) + 2) * 1536), [ob] "i"(((t) + 2) * 1536 + 512), [oy] "i"(((t) - 1) * 512) : "memory")
#define RW_YL1 "v_mul_f32 %[y], %[s0], %[rp0]"
#define RW_YL2 "v_fmac_f32 %[y], %[s1], %[rp1]"
#define RW_YW  "ds_write_b32 %[ya], %[y] offset:%c[oy]"
#define RW_NOP "s_nop 0"
#define RW_TAIL_F "ds_read_b128 %[nA], %[ba] offset:%c[oa]\n\t" \
                XL1 "\n\t" \
                "ds_read_b128 %[nB], %[ba] offset:%c[ob]\n\t" \
                "ds_read_b64 %[nC], %[ca] offset:%c[oa]\n\t" \
                "v_mov_b32 %[p2], %[p]\n\t" \
                "ds_read_b32 %[nV], %[va] offset:%c[oa]\n\t" \
                "s_nop 0\n\t" \
                XSW "\n\t" \
                "v_add_f32 %[p], %[p], %[p2]\n\t" \
                "v_fmac_f32 %[s0], %[p], %[bb0]\n\t" \
                "v_fmac_f32 %[s1], %[p], %[bb1]"
#define RW_TAIL_N "s_nop 0\n\t" \
                XL1 "\n\t" \
                "s_nop 1\n\t" \
                "v_mov_b32 %[p2], %[p]\n\t" \
                "s_nop 1\n\t" \
                XSW "\n\t" \
                "v_add_f32 %[p], %[p], %[p2]\n\t" \
                "v_fmac_f32 %[s0], %[p], %[bb0]\n\t" \
                "v_fmac_f32 %[s1], %[p], %[bb1]"
#define RW_ALLSTEPS() do { \
            RW_STEP(0, "4", RW_NOP, RW_NOP, RW_NOP, RW_TAIL_F); \
            RW_STEP(1, "4", RW_YL1, RW_YL2, RW_YW, RW_TAIL_F); \
            RW_STEP(2, "5", RW_YL1, RW_YL2, RW_YW, RW_TAIL_F);  RW_STEP(3, "5", RW_YL1, RW_YL2, RW_YW, RW_TAIL_F);  RW_STEP(4, "5", RW_YL1, RW_YL2, RW_YW, RW_TAIL_F); \
            RW_STEP(5, "5", RW_YL1, RW_YL2, RW_YW, RW_TAIL_F);  RW_STEP(6, "5", RW_YL1, RW_YL2, RW_YW, RW_TAIL_F);  RW_STEP(7, "5", RW_YL1, RW_YL2, RW_YW, RW_TAIL_F); \
            RW_STEP(8, "5", RW_YL1, RW_YL2, RW_YW, RW_TAIL_F);  RW_STEP(9, "5", RW_YL1, RW_YL2, RW_YW, RW_TAIL_F);  RW_STEP(10, "5", RW_YL1, RW_YL2, RW_YW, RW_TAIL_F); \
            RW_STEP(11, "5", RW_YL1, RW_YL2, RW_YW, RW_TAIL_F); RW_STEP(12, "5", RW_YL1, RW_YL2, RW_YW, RW_TAIL_F); RW_STEP(13, "5", RW_YL1, RW_YL2, RW_YW, RW_TAIL_F); \
            RW_STEP(14, "5", RW_YL1, RW_YL2, RW_YW, RW_TAIL_N); \
            RW_STEP(15, "1", RW_YL1, RW_YL2, RW_YW, RW_TAIL_N); \
            asm volatile("v_mul_f32 %[y], %[s0], %[r0]\n\tv_fmac_f32 %[y], %[s1], %[r1]\n\tds_write_b32 %[ya], %[y] offset:7680" : [y] "=&v"(y) : [s0] "v"(s0), [s1] "v"(s1), [r0] "v"(OC[3].x), [r1] "v"(OC[3].y), [ya] "v"(ya) : "memory"); \
 } while (0)
#ifdef SCAN_PROBE_NOXL
            if (dry == 2) {
#define XL8 "v_add_f32 %[p], %[p], %[p]"
#define XL4 "v_add_f32 %[p], %[p], %[p]"
#define XL2 "v_add_f32 %[p], %[p], %[p]"
#define XL1 "v_add_f32 %[p], %[p], %[p]"
#define XSW "v_add_f32 %[p], %[p], %[p2]"
                RW_ALLSTEPS();
#undef XL8
#undef XL4
#undef XL2
#undef XL1
#undef XSW
            } else
#endif
            {
#define XL8 "v_add_f32_dpp %[p], %[p], %[p] row_ror:8 row_mask:0xf bank_mask:0xf bound_ctrl:1"
#define XL4 "v_add_f32_dpp %[p], %[p], %[p] row_ror:4 row_mask:0xf bank_mask:0xf bound_ctrl:1"
#define XL2 "v_add_f32_dpp %[p], %[p], %[p] row_ror:2 row_mask:0xf bank_mask:0xf bound_ctrl:1"
#define XL1 "v_add_f32_dpp %[p], %[p], %[p] row_ror:1 row_mask:0xf bank_mask:0xf bound_ctrl:1"
#define XSW "v_permlane16_swap_b32 %[p], %[p2]"
                RW_ALLSTEPS();
            }
#undef RW_ALLSTEPS
#undef RW_STEP
#undef XL8
#undef XL4
#undef XL2
#undef XL1
#undef XSW
#undef RW_YL1
#undef RW_YL2
#undef RW_YW
#undef RW_NOP
#undef RW_TAIL_F
#undef RW_TAIL_N
#undef RW_FETCH
        }
        RW_BAR();
    }
    if (isld && !dry) RW_STORE_Y(NCH - 1);
    asm volatile("s_waitcnt vmcnt(0) lgkmcnt(0)\n\ts_barrier" ::: "memory");
#undef RW_STORE_Y
#undef RW_ISSUE
#undef RW_CONVERT
#undef RW_BAR
}

__device__ __forceinline__ int crow(int r, int hi) { return (r & 3) + 8 * (r >> 2) + 4 * hi; }
__device__ __forceinline__ void glds16(const void* gsrc, unsigned lds_dst) { unsigned keep;
    asm volatile("s_mov_b32 %0, m0\n\ts_mov_b32 m0, %2\n\ts_nop 0\n\tglobal_load_lds_dwordx4 %1, off\n\ts_mov_b32 m0, %0" : "=&s"(keep) : "v"(gsrc), "s"(lds_dst) : "memory"); }
__device__ __forceinline__ void glds4(const void* gsrc, unsigned lds_dst) { unsigned keep;
    asm volatile("s_mov_b32 %0, m0\n\ts_mov_b32 m0, %2\n\ts_nop 0\n\tglobal_load_lds_dword %1, off\n\ts_mov_b32 m0, %0" : "=&s"(keep) : "v"(gsrc), "s"(lds_dst) : "memory"); }
typedef LAS const char* lds_cptr;
constexpr int FX_K = 0, FX_V = 24576, FX_WS = 49152, FX_OST = 51200, FX_FLG = 83968, FX_KB = 84224  ;

__device__ __forceinline__ void fx_pv(f32x16* o, int vb, bf16x8 pa0, bf16x8 pa1, bf16x8 pa2, bf16x8 pa3) {
#pragma unroll
    for (int d0 = 0; d0 < 2; ++d0) { s16x4 lo[4], hi[4];
#pragma unroll
        for (int ks = 0; ks < 4; ++ks) {
            asm volatile("ds_read_b64_tr_b16 %0,%1 offset:%c2" : "=&v"(lo[ks]) : "v"(vb), "i"(d0 * 4096 + ks * 1024) : "memory");
            asm volatile("ds_read_b64_tr_b16 %0,%1 offset:%c2" : "=&v"(hi[ks]) : "v"(vb), "i"(d0 * 4096 + ks * 1024 + 512) : "memory"); }
        asm volatile("s_waitcnt lgkmcnt(0)" ::: "memory"); __builtin_amdgcn_sched_barrier(0);
#define FX_PK(k) (bf16x8){lo[k][0], lo[k][1], lo[k][2], lo[k][3], hi[k][0], hi[k][1], hi[k][2], hi[k][3]}
        o[d0] = __builtin_amdgcn_mfma_f32_32x32x16_bf16(pa0, FX_PK(0), o[d0], 0, 0, 0);
        o[d0] = __builtin_amdgcn_mfma_f32_32x32x16_bf16(pa1, FX_PK(1), o[d0], 0, 0, 0);
        o[d0] = __builtin_amdgcn_mfma_f32_32x32x16_bf16(pa2, FX_PK(2), o[d0], 0, 0, 0);
        o[d0] = __builtin_amdgcn_mfma_f32_32x32x16_bf16(pa3, FX_PK(3), o[d0], 0, 0, 0);
#undef FX_PK
    }
}
__device__ __forceinline__ float halves_max(float m) { auto rr = __builtin_amdgcn_permlane32_swap(__float_as_uint(m), __float_as_uint(m), false, false); return fmaxf(__uint_as_float(rr[0]), __uint_as_float(rr[1])); }
__device__ __forceinline__ float halves_sum(float m) { auto rr = __builtin_amdgcn_permlane32_swap(__float_as_uint(m), __float_as_uint(m), false, false); return __uint_as_float(rr[0]) + __uint_as_float(rr[1]); }

constexpr float ATT_EXIT = -40.0f;
template <int KIND>
__device__ __forceinline__ void attn_unit(const ArgsL& a, Frame& F, int b, int h, int qb, float bound) {
    const int lane = F.lane, wave = F.wave, r32 = lane & 31, hi = lane >> 5;
    LAS unsigned char* lds = F.lds;
    const bf16_t* QKV = (const bf16_t*)(a.ws + WS_QKV);
    const size_t rowbase = (size_t)b * T;
    const int p0 = qb * 256;
    constexpr int QC = KIND ? 0 : 960, KC = KIND ? 320 : 1280, VC = KIND ? 640 : 1600;
    const bf16_t* Qw = QKV + (rowbase + p0 + wave * 32) * QKV_W + QC + h * 64;
    const bf16_t* Kh = QKV + rowbase * QKV_W + KC + h * 64;
    const bf16_t* Vh = QKV + rowbase * QKV_W + VC + h * 64;
    const float* kbias = (const float*)(a.ws + WS_KB2) + (size_t)(b * FX_H + h) * KBP;
    const unsigned lds0 = (unsigned)(uintptr_t)lds;
    bf16x8 qr[4];
#pragma unroll
    for (int d0 = 0; d0 < 4; ++d0) qr[d0] = *(const bf16x8*)(Qw + (size_t)r32 * QKV_W + d0 * 16 + hi * 8);
    const int qp = p0 + wave * 32 + r32;
    const bool qvalid = (qp >= PADR) && (qp < T);
    const int plast = (p0 + 255) < (T - 1) ? (p0 + 255) : (T - 1);
    const int jlast = plast >> 6, jfirst = PADR >> 6;
    const int jw = (p0 + wave * 32 + 31) >> 6;
    const bf16_t* ksrc = Kh + (size_t)lane * QKV_W + wave * 8;
    const bf16_t* vsrc = Vh + (size_t)(16 * (wave & 3) + (lane >> 2)) * QKV_W + (wave >> 2) * 32 + (lane & 3) * 8;
    const unsigned kdst = lds0 + FX_K + wave * 1024, vdst = lds0 + FX_V + wave * 1024;
#define FX_DMA(j, slot) do { glds16(ksrc + (size_t)(j) * 64 * QKV_W, (unsigned)__builtin_amdgcn_readfirstlane(kdst + (slot) * 8192)); \
                             glds16(vsrc + (size_t)(j) * 64 * QKV_W, (unsigned)__builtin_amdgcn_readfirstlane(vdst + (slot) * 8192)); \
                             if (KIND == 0) glds4(kbias + 64 * (j) + lane, (unsigned)__builtin_amdgcn_readfirstlane(lds0 + FX_KB + (slot) * 2048 + wave * 256)); } while (0)
    const int vb0 = (int)(lds0 + FX_V) + ((lane >> 4) & 1) * 32 + (lane & 3) * 8 + (4 * hi + ((lane & 15) >> 2)) * 64;
    const lds_cptr kp0 = (lds_cptr)lds + FX_K + hi * 1024 + r32 * 16;
    LAS float* wsf = (LAS float*)(lds + FX_WS) + wave * 64;
    LAS float* flg = (LAS float*)(lds + FX_FLG);
    float m_run = KIND ? 0.f : -1.0e30f, l_run = 0.f;
    f32x16 o[2]; o[0] = f32x16{}; o[1] = f32x16{};
    asm volatile("" : "+v"(qr[0]), "+v"(qr[1]), "+v"(qr[2]), "+v"(qr[3]));
    int slot = 0;
    FX_DMA(jlast, 0);
    if (jlast > jfirst) FX_DMA(jlast - 1, 1);
    for (int j = jlast; j >= jfirst; --j) {
        if (j > jfirst) { if (KIND == 0) asm volatile("s_waitcnt vmcnt(3) lgkmcnt(0)\n\ts_barrier" ::: "memory"); else asm volatile("s_waitcnt vmcnt(2) lgkmcnt(0)\n\ts_barrier" ::: "memory"); }
        else asm volatile("s_waitcnt vmcnt(0) lgkmcnt(0)\n\ts_barrier" ::: "memory");
        if (j < jlast) {
            const LAS float* fl = flg + ((j + 1) & 1) * 16;
            const f32x4 fa = *(const LAS f32x4*)(fl), fb = *(const LAS f32x4*)(fl + 4);
            bool stop;
            if constexpr (KIND == 0) {
                const float mmin = fminf(fminf(fminf(fa.x, fa.y), fminf(fa.z, fa.w)), fminf(fminf(fb.x, fb.y), fminf(fb.z, fb.w)));
                stop = (bound + fl[8] - mmin) < ATT_EXIT;
            } else {
                const float mmax = fmaxf(fmaxf(fmaxf(fa.x, fa.y), fmaxf(fa.z, fa.w)), fmaxf(fmaxf(fb.x, fb.y), fmaxf(fb.z, fb.w)));
                stop = mmax < ATT_EXIT;
            }
            if (stop) break;
        }
        { const int s2 = slot + 2 >= 3 ? slot - 1 : slot + 2; if (j - 2 >= jfirst) FX_DMA(j - 2, s2); }
        if (j <= jw) {
            f32x16 s0v = f32x16{}, s1v = f32x16{};
            const lds_cptr kp = kp0 + slot * 8192;
#pragma unroll
            for (int d0 = 0; d0 < 4; ++d0) {
                const bf16x8 b0 = *(const LAS bf16x8*)(kp + d0 * 2048);
                const bf16x8 b1 = *(const LAS bf16x8*)(kp + d0 * 2048 + 512);
                s0v = __builtin_amdgcn_mfma_f32_32x32x16_bf16(b0, qr[d0], s0v, 0, 0, 0);
                s1v = __builtin_amdgcn_mfma_f32_32x32x16_bf16(b1, qr[d0], s1v, 0, 0, 0);
            }
            const bool edge = (64 * j + 63 >= p0 + wave * 32) || (64 * j < PADR);
            if constexpr (KIND == 0) {
                const LAS float* kbj = (const LAS float*)(lds + FX_KB + slot * 2048 + wave * 256) + 4 * hi;
#pragma unroll
                for (int g = 0; g < 4; ++g) { const f32x4 t0 = *(const LAS f32x4*)(kbj + 8 * g), t1 = *(const LAS f32x4*)(kbj + 32 + 8 * g);
                    s0v[4 * g] += t0.x; s0v[4 * g + 1] += t0.y; s0v[4 * g + 2] += t0.z; s0v[4 * g + 3] += t0.w;
                    s1v[4 * g] += t1.x; s1v[4 * g + 1] += t1.y; s1v[4 * g + 2] += t1.z; s1v[4 * g + 3] += t1.w; }
                if (edge) {
#pragma unroll
                    for (int r = 0; r < 16; ++r) { const int key = 64 * j + crow(r, hi);
                        if (key > qp || key < PADR) s0v[r] = -INFINITY;
                        if (key + 32 > qp || key + 32 < PADR) s1v[r] = -INFINITY; }
                }
                float rm = fmaxf(s0v[0], s1v[0]);
#pragma unroll
                for (int r = 1; r < 16; ++r) rm = fmaxf(rm, fmaxf(s0v[r], s1v[r]));
                rm = halves_max(rm);
                const float m_new = fmaxf(m_run, rm);
                const float f = __builtin_amdgcn_exp2f(m_run - m_new);
                m_run = m_new;
                float rs = 0.f;
#pragma unroll
                for (int r = 0; r < 16; ++r) { s0v[r] = __builtin_amdgcn_exp2f(s0v[r] - m_new); s1v[r] = __builtin_amdgcn_exp2f(s1v[r] - m_new); rs += s0v[r] + s1v[r]; }
                rs = halves_sum(rs);
                l_run = l_run * f + rs;
                if (!__all(f == 1.0f)) {
                    if (hi == 0) wsf[r32] = f;
                    LDS_WAIT();
#pragma unroll
                    for (int d_ = 0; d_ < 2; ++d_)
#pragma unroll
                        for (int r = 0; r < 16; ++r) o[d_][r] *= wsf[crow(r, hi)];
                }
            } else {
                f32x16 l0, l1;
#pragma unroll
                for (int r = 0; r < 16; ++r) {
                    const float z0 = s0v[r], z1 = s1v[r];
                    float a0 = -(fmaxf(z0, 0.f) + __builtin_amdgcn_logf(1.f + __builtin_amdgcn_exp2f(-fabsf(z0))));
                    float a1 = -(fmaxf(z1, 0.f) + __builtin_amdgcn_logf(1.f + __builtin_amdgcn_exp2f(-fabsf(z1))));
                    if (edge) { const int key = 64 * j + crow(r, hi);
                        if (key >= qp || key < PADR) { a0 = 0.f; s0v[r] = -INFINITY; }
                        if (key + 32 >= qp || key + 32 < PADR) { a1 = 0.f; s1v[r] = -INFINITY; } }
                    l0[r] = a0; l1[r] = a1;
                }
                float A[8], SA[9], SO[9];
#pragma unroll
                for (int g = 0; g < 4; ++g) { A[g] = (l0[4 * g] + l0[4 * g + 1]) + (l0[4 * g + 2] + l0[4 * g + 3]); A[4 + g] = (l1[4 * g] + l1[4 * g + 1]) + (l1[4 * g + 2] + l1[4 * g + 3]); }
                SA[8] = 0.f; SO[8] = 0.f;
#pragma unroll
                for (int g = 7; g >= 0; --g) SA[g] = A[g] + SA[g + 1];
#pragma unroll
                for (int g = 0; g < 8; ++g) { auto rr = __builtin_amdgcn_permlane32_swap(__float_as_uint(SA[g]), __float_as_uint(SA[g]), false, false); SO[g] = __uint_as_float(hi ? rr[0] : rr[1]); }
                const float R = m_run;
#pragma unroll
                for (int g = 0; g < 8; ++g) {
                    const float E = SA[g + 1] + (hi ? SO[g + 1] : SO[g]) + R;
                    if (g < 4) { float t = E;
                        s0v[4 * g + 3] = __builtin_amdgcn_exp2f(s0v[4 * g + 3] + l0[4 * g + 3] + t); t += l0[4 * g + 3];
                        s0v[4 * g + 2] = __builtin_amdgcn_exp2f(s0v[4 * g + 2] + l0[4 * g + 2] + t); t += l0[4 * g + 2];
                        s0v[4 * g + 1] = __builtin_amdgcn_exp2f(s0v[4 * g + 1] + l0[4 * g + 1] + t); t += l0[4 * g + 1];
                        s0v[4 * g + 0] = __builtin_amdgcn_exp2f(s0v[4 * g + 0] + l0[4 * g + 0] + t);
                    } else { const int q = g - 4; float t = E;
                        s1v[4 * q + 3] = __builtin_amdgcn_exp2f(s1v[4 * q + 3] + l1[4 * q + 3] + t); t += l1[4 * q + 3];
                        s1v[4 * q + 2] = __builtin_amdgcn_exp2f(s1v[4 * q + 2] + l1[4 * q + 2] + t); t += l1[4 * q + 2];
                        s1v[4 * q + 1] = __builtin_amdgcn_exp2f(s1v[4 * q + 1] + l1[4 * q + 1] + t); t += l1[4 * q + 1];
                        s1v[4 * q + 0] = __builtin_amdgcn_exp2f(s1v[4 * q + 0] + l1[4 * q + 0] + t);
                    }
                }
                m_run = R + SA[0] + SO[0];
            }
            u32x4 pw0, pw1, pw2, pw3;
            pw0 = (u32x4){pk2(s0v[0], s0v[1]), pk2(s0v[2], s0v[3]), pk2(s0v[4], s0v[5]), pk2(s0v[6], s0v[7])};
            pw1 = (u32x4){pk2(s0v[8], s0v[9]), pk2(s0v[10], s0v[11]), pk2(s0v[12], s0v[13]), pk2(s0v[14], s0v[15])};
            pw2 = (u32x4){pk2(s1v[0], s1v[1]), pk2(s1v[2], s1v[3]), pk2(s1v[4], s1v[5]), pk2(s1v[6], s1v[7])};
            pw3 = (u32x4){pk2(s1v[8], s1v[9]), pk2(s1v[10], s1v[11]), pk2(s1v[12], s1v[13]), pk2(s1v[14], s1v[15])};
            fx_pv(o, vb0 + slot * 8192, __builtin_bit_cast(bf16x8, pw0), __builtin_bit_cast(bf16x8, pw1), __builtin_bit_cast(bf16x8, pw2), __builtin_bit_cast(bf16x8, pw3));
        }
        float mm = qvalid ? m_run : (KIND ? -3.0e38f : 3.0e38f);
        if constexpr (KIND == 0) { mm = fminf(mm, dpp_f<0x128>(mm)); mm = fminf(mm, dpp_f<0x124>(mm)); mm = fminf(mm, dpp_f<0x122>(mm)); mm = fminf(mm, dpp_f<0x121>(mm));
            { auto sw = __builtin_amdgcn_permlane16_swap(__float_as_uint(mm), __float_as_uint(mm), false, false); mm = fminf(__uint_as_float(sw[0]), __uint_as_float(sw[1])); }
            { auto sw = __builtin_amdgcn_permlane32_swap(__float_as_uint(mm), __float_as_uint(mm), false, false); mm = fminf(__uint_as_float(sw[0]), __uint_as_float(sw[1])); } }
        else { mm = fmaxf(mm, dpp_f<0x128>(mm)); mm = fmaxf(mm, dpp_f<0x124>(mm)); mm = fmaxf(mm, dpp_f<0x122>(mm)); mm = fmaxf(mm, dpp_f<0x121>(mm));
            { auto sw = __builtin_amdgcn_permlane16_swap(__float_as_uint(mm), __float_as_uint(mm), false, false); mm = fmaxf(__uint_as_float(sw[0]), __uint_as_float(sw[1])); }
            { auto sw = __builtin_amdgcn_permlane32_swap(__float_as_uint(mm), __float_as_uint(mm), false, false); mm = fmaxf(__uint_as_float(sw[0]), __uint_as_float(sw[1])); } }
        if (lane == 0) { flg[(j & 1) * 16 + wave] = mm;
            if (KIND == 0 && wave == 0) flg[(j & 1) * 16 + 8] = *(const LAS float*)(lds + FX_KB + slot * 2048); }
        slot = slot == 2 ? 0 : slot + 1;
    }
    asm volatile("s_waitcnt vmcnt(0) lgkmcnt(0)\n\ts_barrier" ::: "memory");
    float rli[16];
    if constexpr (KIND == 0) {
        if (hi == 0) wsf[32 + r32] = l_run;
        LDS_WAIT();
#pragma unroll
        for (int r = 0; r < 16; ++r) rli[r] = __builtin_amdgcn_rcpf(wsf[32 + crow(r, hi)]);
    } else {
#pragma unroll
        for (int r = 0; r < 16; ++r) rli[r] = 1.0f;
    }
    bf16_t* Ow = (bf16_t*)(a.ws + WS_YCAT) + (rowbase + p0 + wave * 32) * YC_W + (KIND ? 384 : 768) + h * 64;
    {
        LAS bf16_t* stg = (LAS bf16_t*)(lds + FX_OST) + wave * 2048;
#pragma unroll
        for (int r = 0; r < 16; ++r) { const int orow = crow(r, hi);
#pragma unroll
            for (int d0 = 0; d0 < 2; ++d0) stg[orow * 64 + d0 * 32 + r32] = f2bf(o[d0][r] * rli[r]); }
        LDS_WAIT();
#pragma unroll
        for (int i = 0; i < 4; ++i) { const int row = i * 8 + (lane >> 3), ch = lane & 7; const u32x4 v = *(const LAS u32x4*)(stg + row * 64 + ch * 8);
            const int pr = p0 + wave * 32 + row;
            if (pr >= PADR && pr < T) *(u32x4*)(Ow + (size_t)row * YC_W + ch * 8) = v; }
    }
    asm volatile("s_waitcnt lgkmcnt(0)\n\ts_barrier" ::: "memory");
#undef FX_DMA
}


constexpr int CK = 64, NCK = 257, CKB = 40960, CB_ZF = 147456  ;
static_assert(LPADDED == CK * NCK, "padded steps");
__device__ __forceinline__ int swz(int row, int chunk) { return row * 128 + ((chunk ^ (row & 7)) << 4); }
__device__ __forceinline__ void ck_mm(f32x16& acc, LAS unsigned char* A, LAS unsigned char* Bt, int m0, int n0, int r32, int hi) {
#pragma unroll
    for (int ks = 0; ks < 4; ++ks) {
        const bf16x8 av = *(const LAS bf16x8*)(A + swz(m0 + r32, 2 * ks + hi));
        const bf16x8 bv = *(const LAS bf16x8*)(Bt + swz(n0 + r32, 2 * ks + hi));
        acc = __builtin_amdgcn_mfma_f32_32x32x16_bf16(av, bv, acc, 0, 0, 0);
    }
}
__device__ __forceinline__ void ck_store_t(LAS unsigned char* dst, const f32x16& acc, int m0, int n0, int r32, int hi) {
#pragma unroll
    for (int g = 0; g < 4; ++g) { const u32x2 w = {pk2(acc[4 * g], acc[4 * g + 1]), pk2(acc[4 * g + 2], acc[4 * g + 3])};
        *(LAS u32x2*)(dst + swz(n0 + r32, (m0 >> 3) + g) + hi * 8) = w; }
}
constexpr int CA_KAP = 0, CA_BET = 8192, CA_CHI = 16384, CA_RHO = 24576, CA_VMT = 32768, CA_BHT = 40960, CA_KHT = 49152, CA_AK = 57344, CA_RB = 65536, CA_RK = 73728,
              CA_AB = 81920  , CA_RHS = 98304  , CA_G64 = MISC_OFF + 2048  , CA_SCR = MISC_OFF + 4096  ;

#ifndef CA_STAGES
#define CA_STAGES 15
#endif
__device__ __forceinline__ void phase_chunkA(const ArgsL& a, Frame& F, const bool dry = false) {
    const int wave = F.wave;
    LAS unsigned char* L = F.lds;
    u32x4 pre6[6];
    for (int id = F.bx; id < 12 * NCK; id += (int)gridDim.x) {
        int tid = F.tid, lane, r32, hi;
#define CK_FRESH() do { asm volatile("" : "+v"(tid)); lane = tid & 63; r32 = lane & 31; hi = lane >> 5; } while (0)
        CK_FRESH();
        const int bh = id / NCK, c = id - bh * NCK;
        unsigned char* blk = a.ws + WS_RW + ((size_t)bh * LPADDED + (size_t)c * CK) * 768;
        const int blko = (int)(((size_t)bh * LPADDED + (size_t)c * CK) * 768);
        const __amdgpu_buffer_rsrc_t rwrs = __builtin_amdgcn_make_buffer_rsrc((void*)(a.ws + WS_RW), 0, (int)((size_t)12 * LPADDED * 768), 0x00020000);
        {
            if (id == F.bx) {
#pragma unroll
                for (int q6 = 0; q6 < 6; ++q6) pre6[q6] = *(const u32x4*)(blk + (size_t)(tid + q6 * NTHR) * 16);
            }
#pragma unroll
            for (int q6 = 0; q6 < 6; ++q6) *(LAS u32x4*)(L + CA_AB + (tid + q6 * NTHR) * 16) = pre6[q6];
            __syncthreads();
            const int k = tid & 63, tq = tid >> 6;
            const LAS _Float16* src = (const LAS _Float16*)(L + CA_AB) + (tq * 8) * 384 + k;
            float kk[8], w[8], bb[8], kp[8], rr[8], vv[8];
#pragma unroll
            for (int e = 0; e < 8; ++e) { kk[e] = (float)src[e * 384]; w[e] = 1.f + (float)src[e * 384 + 64]; bb[e] = -(float)src[e * 384 + 128];
                kp[e] = (float)src[e * 384 + 192]; rr[e] = (float)src[e * 384 + 256]; vv[e] = (float)src[e * 384 + 320]; }
            float g[8]; g[0] = w[0];
#pragma unroll
            for (int e = 1; e < 8; ++e) g[e] = g[e - 1] * w[e];
            LAS float* scr = (LAS float*)(L + CA_SCR);
            scr[tq * 64 + k] = g[7];
            __syncthreads();
            {
                const int idn = id + (int)gridDim.x;
                if (idn < 12 * NCK) { const int bhn = idn / NCK, cn = idn - bhn * NCK; const unsigned char* bn_ = a.ws + WS_RW + ((size_t)bhn * LPADDED + (size_t)cn * CK) * 768;
#pragma unroll
                    for (int q6 = 0; q6 < 6; ++q6) pre6[q6] = *(const u32x4*)(bn_ + (size_t)(tid + q6 * NTHR) * 16); }
            }
            float pre = 1.f, tot = 1.f;
#pragma unroll
            for (int q = 0; q < 8; ++q) { const float s = scr[q * 64 + k]; if (q < tq) pre *= s; tot *= s; }
            if (tq == 0) ((LAS float*)(L + CA_G64))[k] = tot;
            unsigned bh4[4], kh4[4], vm4[4];
            float Gp = pre;
#pragma unroll
            for (int e = 0; e < 8; ++e) {
                const int t = tq * 8 + e; const float G = pre * g[e], iG = __builtin_amdgcn_rcpf(G);
                const float kap = kk[e] * Gp, bet = bb[e] * iG, chi = kp[e] * iG, rho = rr[e] * G;
                const int o = swz(t, k >> 3) + (k & 7) * 2;
                *(LAS unsigned short*)(L + CA_KAP + o) = f2bf(kap); *(LAS unsigned short*)(L + CA_BET + o) = f2bf(bet);
                *(LAS unsigned short*)(L + CA_CHI + o) = f2bf(chi); *(LAS unsigned short*)(L + CA_RHO + o) = f2bf(rho);
                ((LAS float*)(L + CA_RHS))[t * 128 + k] = kap;
                const float bhv = bet * tot, khv = chi * tot;
                if (e & 1) { bh4[e >> 1] |= (unsigned)f2bf(bhv) << 16; kh4[e >> 1] |= (unsigned)f2bf(khv) << 16; vm4[e >> 1] |= (unsigned)f2bf(vv[e]) << 16; }
                else { bh4[e >> 1] = f2bf(bhv); kh4[e >> 1] = f2bf(khv); vm4[e >> 1] = f2bf(vv[e]); }
                Gp = G;
            }
            *(LAS u32x4*)(L + CA_BHT + swz(k, tq)) = (u32x4){bh4[0], bh4[1], bh4[2], bh4[3]};
            *(LAS u32x4*)(L + CA_KHT + swz(k, tq)) = (u32x4){kh4[0], kh4[1], kh4[2], kh4[3]};
            *(LAS u32x4*)(L + CA_VMT + swz(k, tq)) = (u32x4){vm4[0], vm4[1], vm4[2], vm4[3]};
        }
        __syncthreads();
        CK_FRESH();
        if (!dry || (CA_STAGES & 2)) {
            const int p = wave & 3, nb = wave >> 2;
            LAS unsigned char* Am = L + ((p & 1) ? CA_CHI : CA_BET);
            LAS unsigned char* Bm = L + ((p & 2) ? CA_RHO : CA_KAP);
#pragma unroll
            for (int mb = 0; mb < 2; ++mb) {
                f32x16 acc = f32x16{};
                if (!(mb == 1 && nb == 0)) ck_mm(acc, Am, Bm, mb * 32, nb * 32, r32, hi);
                const int t = nb * 32 + r32;
#pragma unroll
                for (int i = 0; i < 16; ++i) { const int j = mb * 32 + crow(i, hi); const bool keep = (p & 2) ? (j <= t) : (j < t); if (!keep) acc[i] = 0.f; }
                if (p == 0) {
#pragma unroll
                    for (int gq = 0; gq < 4; ++gq) { LAS float* ab_ = (LAS float*)(L + CA_AB) + t * 64 + (mb * 8 + 2 * gq + hi);
                        ab_[0] = acc[4 * gq]; ab_[16] = acc[4 * gq + 1]; ab_[32] = acc[4 * gq + 2]; ab_[48] = acc[4 * gq + 3]; }
                } else ck_store_t(L + (p == 1 ? CA_AK : p == 2 ? CA_RB : CA_RK), acc, mb * 32, nb * 32, r32, hi);
            }
        }
        __syncthreads();
        CK_FRESH();
        if (wave < 4 && (!dry || (CA_STAGES & 2))) {
            const int mb = wave >> 1, nb = wave & 1;
            f32x16 acc = f32x16{};
            ck_mm(acc, L + CA_AK, L + CA_VMT, mb * 32, nb * 32, r32, hi);
#pragma unroll
            for (int i = 0; i < 16; ++i) ((LAS float*)(L + CA_RHS))[(mb * 32 + crow(i, hi)) * 128 + 64 + nb * 32 + r32] = acc[i];
        }
        __syncthreads();
        CK_FRESH();
        if (!dry || (CA_STAGES & 4)) {
            const int col = tid >> 2, p = tid & 3;
            unsigned abv = (unsigned)(uintptr_t)(L + CA_AB) + p * 64; asm volatile("" : "+v"(abv));
            const LAS float* ab = (const LAS float*)(uintptr_t)abv;
            const LAS float* rhs = (const LAS float*)(L + CA_RHS) + col;
            float xo[16];
#pragma unroll
            for (int i = 0; i < 16; ++i) xo[i] = 0.f;
#pragma unroll
            for (int tg = 0; tg < 64; tg += 4) {
                f32x4 av[4][4]; float rv[4];
#pragma unroll
                for (int r = 0; r < 4; ++r) { rv[r] = rhs[(tg + r) * 128];
#pragma unroll
                    for (int i4 = 0; i4 < (tg + r + 15) / 16; ++i4) av[r][i4] = *(const LAS f32x4*)(ab + (tg + r) * 64 + 4 * i4); }
#pragma unroll
                for (int r = 0; r < 4; ++r) { const int t = tg + r;
                    float s0 = (p == 0) ? rv[r] : 0.f, s1 = 0.f;
#pragma unroll
                    for (int i4 = 0; i4 < (t + 15) / 16; ++i4) {
                        s0 -= av[r][i4].x * xo[4 * i4]; s1 -= av[r][i4].y * xo[4 * i4 + 1]; s0 -= av[r][i4].z * xo[4 * i4 + 2]; s1 -= av[r][i4].w * xo[4 * i4 + 3]; }
                    float sx = s0 + s1;
                    sx += dpp_f<0xB1>(sx);
                    sx += dpp_f<0x4E>(sx);
                    if ((t & 3) == p) xo[t >> 2] = sx;
                    asm volatile("" : "+v"(xo[t >> 2]));
                }
                __builtin_amdgcn_sched_barrier(0);
            }
            LAS unsigned char* dst = L + (col < 64 ? CA_KAP : CA_BET);
            const int rowc = col & 63;
#pragma unroll
            for (int i = 0; i < 16; ++i) { const int tt = 4 * i + p; *(LAS unsigned short*)(dst + swz(rowc, tt >> 3) + (tt & 7) * 2) = f2bf(-xo[i]); }
        }
        __syncthreads();
        CK_FRESH();
        if (!dry || (CA_STAGES & 8)) {
            const int ty = wave >> 1;
            LAS unsigned char* nW1 = L + CA_KAP; LAS unsigned char* nW2 = L + CA_BET;
#pragma unroll
            for (int qq = 0; qq < 2; ++qq) {
                const int q = (wave & 1) * 2 + qq, qa = q >> 1, qb = q & 1;
                f32x16 acc = f32x16{};
                if (ty == 0) {
                    const int t = qa * 32 + r32;
#pragma unroll
                    for (int gq = 0; gq < 4; ++gq) { const u32x2 rv = *(const LAS u32x2*)(L + CA_RHO + swz(t, qb * 4 + gq) + hi * 8);
                        acc[4 * gq] = bf_lo(rv.x); acc[4 * gq + 1] = bf_hi(rv.x); acc[4 * gq + 2] = bf_lo(rv.y); acc[4 * gq + 3] = bf_hi(rv.y); }
                    ck_mm(acc, nW1, L + CA_RB, qb * 32, qa * 32, r32, hi);
                } else if (ty == 1) {
                    ck_mm(acc, nW1, L + CA_BHT, qb * 32, qa * 32, r32, hi);
                    if (qa == qb) { const float g64 = ((const LAS float*)(L + CA_G64))[qa * 32 + r32];
#pragma unroll
                        for (int i = 0; i < 16; ++i) if (crow(i, hi) == r32) acc[i] += g64; }
                } else if (ty == 2) {
                    ck_mm(acc, L + CA_KHT, L + CA_VMT, qb * 32, qa * 32, r32, hi);
                    ck_mm(acc, L + CA_BHT, nW2, qb * 32, qa * 32, r32, hi);
                } else {
                    ck_mm(acc, L + CA_VMT, L + CA_RK, qa * 32, qb * 32, r32, hi);
                    ck_mm(acc, nW2, L + CA_RB, qa * 32, qb * 32, r32, hi);
                }
                if (dry) { float sink = acc[0] + acc[5] + acc[10] + acc[15]; asm volatile("" :: "v"(sink)); }
                else if (ty < 2) {
                    const int o = blko + (ty == 0 ? 8192 : 0) + ((qa * 2 + qb) * 2) * 1024 + lane * 16;
#pragma unroll
                    for (int ks = 0; ks < 2; ++ks)
                        __builtin_amdgcn_raw_buffer_store_b128((u32x4){pk2(acc[8 * ks], acc[8 * ks + 1]), pk2(acc[8 * ks + 2], acc[8 * ks + 3]), pk2(acc[8 * ks + 4], acc[8 * ks + 5]), pk2(acc[8 * ks + 6], acc[8 * ks + 7])}, rwrs, o + ks * 1024, 0, 16);
                } else if (ty == 2) {
                    const int o = blko + 16384 + (qa * 2 + qb) * 4096 + lane * 16;
#pragma unroll
                    for (int g = 0; g < 4; ++g) __builtin_amdgcn_raw_buffer_store_b128((u32x4){__float_as_uint(acc[4 * g]), __float_as_uint(acc[4 * g + 1]), __float_as_uint(acc[4 * g + 2]), __float_as_uint(acc[4 * g + 3])}, rwrs, o + g * 1024, 0, 16);
                } else {
                    const int o = blko + 32768 + (qa * 2 + qb) * 2048 + lane * 8;
#pragma unroll
                    for (int g = 0; g < 4; ++g) __builtin_amdgcn_raw_buffer_store_b64((u32x2){pk2(acc[4 * g], acc[4 * g + 1]), pk2(acc[4 * g + 2], acc[4 * g + 3])}, rwrs, o + g * 512, 0, 16);
                }
            }
        }
        __syncthreads();
    }
}

__device__ __forceinline__ void rwkv_chunkB(const ArgsL& a, Frame& F, int bh) {
    const int lane = F.lane, wave = F.wave, r32 = lane & 31, hi = lane >> 5;
    const int b = bh / RW_H, h = bh % RW_H;
    LAS unsigned char* L = F.lds;
    const unsigned char* base = a.ws + WS_RW + (size_t)bh * LPADDED * 768;
    bf16_t* y0 = (bf16_t*)(a.ws + WS_YCAT);
    const bool isld = (wave & 2) != 0; const int lw = (wave & 1) + ((wave >> 2) << 1);
    LAS unsigned char* yimg0 = L + 3 * CKB; LAS unsigned char* yimg1 = L + MISC_OFF + 8192;
    LAS unsigned char* zfb = L + CB_ZF;
#define CB_ISSUE(cc) do { const unsigned char* s_ = base + (size_t)(cc) * CK * 768 + (size_t)lw * 1024 + lane * 16; LAS unsigned char* d_ = L + ((cc) % 3) * CKB + lw * 1024; \
        _Pragma("unroll") for (int r_ = 0; r_ < 10; ++r_) __builtin_amdgcn_global_load_lds((const unsigned*)(s_ + r_ * 4096), (LAS unsigned*)(d_ + r_ * 4096), 16, 0, 0); } while (0)
#define CB_YOUT(cc) do { const LAS unsigned char* im_ = ((cc) & 1) ? yimg1 : yimg0; \
        _Pragma("unroll") for (int r_ = 0; r_ < 8; ++r_) { const int t_ = r_ * 8 + (lane >> 3), l_ = (cc) * CK + t_; const u32x4 v_ = *(const LAS u32x4*)(im_ + t_ * 128 + (((lane & 7) ^ (t_ & 7)) * 16)); \
            if (l_ < LTOK) *(u32x4*)(y0 + (size_t)(b * T + PADR + l_) * YC_W + h * 64 + (lane & 7) * 8) = v_; } } while (0)
    if (isld) { CB_ISSUE(0); CB_ISSUE(1); asm volatile("s_waitcnt vmcnt(10)" ::: "memory"); }
    bf16x8 zf[2][2];
#pragma unroll
    for (int q = 0; q < 4; ++q) zf[q >> 1][q & 1] = bf16x8{};
    if (wave < 2) {
#pragma unroll
        for (int q = 0; q < 4; ++q) *(LAS bf16x8*)(zfb + wave * 4096 + q * 1024 + lane * 16) = bf16x8{};
    }
    asm volatile("s_waitcnt lgkmcnt(0)\n\ts_barrier" ::: "memory");
    for (int c = 0; c < NCK; ++c) {
        const LAS unsigned char* S = L + (c % 3) * CKB;
        if (wave < 2) {
            const int vb = wave;
            f32x16 N0, N1;
            { const LAS unsigned char* n0 = S + 16384 + (vb * 2 + 0) * 4096 + lane * 16; const LAS unsigned char* n1 = S + 16384 + (vb * 2 + 1) * 4096 + lane * 16;
#pragma unroll
              for (int g = 0; g < 4; ++g) { const f32x4 u0 = *(const LAS f32x4*)(n0 + g * 1024), u1 = *(const LAS f32x4*)(n1 + g * 1024);
                  N0[4 * g] = u0.x; N0[4 * g + 1] = u0.y; N0[4 * g + 2] = u0.z; N0[4 * g + 3] = u0.w; N1[4 * g] = u1.x; N1[4 * g + 1] = u1.y; N1[4 * g + 2] = u1.z; N1[4 * g + 3] = u1.w; } }
#pragma unroll
            for (int kb2 = 0; kb2 < 2; ++kb2)
#pragma unroll
                for (int ks = 0; ks < 2; ++ks) {
                    const bf16x8 m0 = *(const LAS bf16x8*)(S + ((0 * 2 + kb2) * 2 + ks) * 1024 + lane * 16);
                    const bf16x8 m1 = *(const LAS bf16x8*)(S + ((1 * 2 + kb2) * 2 + ks) * 1024 + lane * 16);
                    N0 = __builtin_amdgcn_mfma_f32_32x32x16_bf16(m0, zf[kb2][ks], N0, 0, 0, 0);
                    N1 = __builtin_amdgcn_mfma_f32_32x32x16_bf16(m1, zf[kb2][ks], N1, 0, 0, 0);
                }
            LAS unsigned char* zo = zfb + ((c + 1) & 1) * 8192 + vb * 4096 + lane * 16;
#pragma unroll
            for (int ks = 0; ks < 2; ++ks) {
                zf[0][ks] = __builtin_bit_cast(bf16x8, (u32x4){pk2(N0[8 * ks], N0[8 * ks + 1]), pk2(N0[8 * ks + 2], N0[8 * ks + 3]), pk2(N0[8 * ks + 4], N0[8 * ks + 5]), pk2(N0[8 * ks + 6], N0[8 * ks + 7])});
                zf[1][ks] = __builtin_bit_cast(bf16x8, (u32x4){pk2(N1[8 * ks], N1[8 * ks + 1]), pk2(N1[8 * ks + 2], N1[8 * ks + 3]), pk2(N1[8 * ks + 4], N1[8 * ks + 5]), pk2(N1[8 * ks + 6], N1[8 * ks + 7])});
                *(LAS bf16x8*)(zo + (0 * 2 + ks) * 1024) = zf[0][ks]; *(LAS bf16x8*)(zo + (1 * 2 + ks) * 1024) = zf[1][ks];
            }
        } else if (isld) {
            if (wave == 6 && c > 0) CB_YOUT(c - 1);
            if (c + 2 < NCK) CB_ISSUE(c + 2);
            if (wave < 4) {
                const int vb = wave - 2;
                LAS unsigned char* yim = (c & 1) ? yimg1 : yimg0;
                const LAS unsigned char* zs = zfb + (c & 1) * 8192 + vb * 4096 + lane * 16;
                bf16x8 zq[2][2];
#pragma unroll
                for (int q = 0; q < 4; ++q) zq[q >> 1][q & 1] = *(const LAS bf16x8*)(zs + q * 1024);
#pragma unroll
                for (int tb = 0; tb < 2; ++tb) {
                    f32x16 acc;
                    const LAS unsigned char* yt = S + 32768 + (vb * 2 + tb) * 2048 + lane * 8;
#pragma unroll
                    for (int g = 0; g < 4; ++g) { const u32x2 w = *(const LAS u32x2*)(yt + g * 512); acc[4 * g] = bf_lo(w.x); acc[4 * g + 1] = bf_hi(w.x); acc[4 * g + 2] = bf_lo(w.y); acc[4 * g + 3] = bf_hi(w.y); }
#pragma unroll
                    for (int kb2 = 0; kb2 < 2; ++kb2)
#pragma unroll
                        for (int ks = 0; ks < 2; ++ks) { const bf16x8 pa = *(const LAS bf16x8*)(S + 8192 + ((tb * 2 + kb2) * 2 + ks) * 1024 + lane * 16);
                            acc = __builtin_amdgcn_mfma_f32_32x32x16_bf16(zq[kb2][ks], pa, acc, 0, 0, 0); }
                    const int t = tb * 32 + r32;
#pragma unroll
                    for (int g = 0; g < 4; ++g) { const u32x2 w = {pk2(acc[4 * g], acc[4 * g + 1]), pk2(acc[4 * g + 2], acc[4 * g + 3])};
                        *(LAS u32x2*)(yim + t * 128 + (((vb * 8 + 2 * g + hi) ^ (2 * (t & 7))) * 8)) = w; }
                }
            }
            if (c + 2 < NCK) asm volatile("s_waitcnt vmcnt(10)" ::: "memory"); else asm volatile("s_waitcnt vmcnt(0)" ::: "memory");
        }
        asm volatile("s_waitcnt lgkmcnt(0)\n\ts_barrier" ::: "memory");
    }
    if (wave == 6) CB_YOUT(NCK - 1);
    asm volatile("s_waitcnt vmcnt(0) lgkmcnt(0)\n\ts_barrier" ::: "memory");
#undef CB_ISSUE
#undef CB_YOUT
}

constexpr int N_FX_UNITS = 65 * 10, N_SB_UNITS = 65 * 10, N_RW_WG = 192;
#ifndef REP_SCAN
#define REP_SCAN 1
#endif
#ifndef REP_SCAN_DRY
#define REP_SCAN_DRY 0
#endif
#ifndef REP_FOX
#define REP_FOX 1
#endif
#ifndef REP_SB
#define REP_SB 1
#endif
__device__ __forceinline__ void wg_publish(unsigned* cnt) {
    asm volatile("s_waitcnt vmcnt(0)" ::: "memory");
    __syncthreads();
    if (threadIdx.x == 0) __hip_atomic_fetch_add(cnt, 1u, __ATOMIC_RELAXED, __HIP_MEMORY_SCOPE_AGENT);
}
__device__ __forceinline__ void wg_wait(const unsigned* cnt, unsigned n) {
    if (threadIdx.x == 0) { unsigned polls = 0;
        while (__hip_atomic_load(cnt, __ATOMIC_RELAXED, __HIP_MEMORY_SCOPE_AGENT) < n) { if (++polls > (1u << 18)) break; __builtin_amdgcn_s_sleep(2); }
        __builtin_amdgcn_fence(__ATOMIC_ACQUIRE, "agent"); asm volatile("s_waitcnt vmcnt(0)" ::: "memory"); }
    __syncthreads();
}
__device__ __forceinline__ void phase_mix(const ArgsL& a, Frame& F, int layer, const unsigned* ca_done) {
#ifdef SEQ_SCAN
    if (F.bx < N_RW_WG) { int nr = REP_SCAN; asm volatile("" : "+s"(nr)); for (int r = 0; r < nr; ++r) rwkv_scan(a, F, F.bx, (r + 1 < nr) ? REP_SCAN_DRY : 0); }
#else
#ifndef REP_CHB
#define REP_CHB 1
#endif
    if (F.bx < 12) { wg_wait(ca_done, gridDim.x);
        int nr = REP_CHB; asm volatile("" : "+s"(nr)); for (int r = 0; r < nr; ++r) rwkv_chunkB(a, F, F.bx); }
#endif
    float gqm = fabsf(a.in(I_QG)[layer * 64 + F.lane]), gkm = fabsf(a.in(I_KG)[layer * 64 + F.lane]);
#pragma unroll
    for (int off = 1; off < 64; off <<= 1) { gqm = fmaxf(gqm, __shfl_xor(gqm, off)); gkm = fmaxf(gkm, __shfl_xor(gkm, off)); }
    const float bound = 64.0f * C2 * gqm * gkm * 1.02f + 0.5f;
    unsigned* head = (unsigned*)(a.ws + WS_CTL) + CW_QUEUE + 64 * layer;
    for (;;) {
        if (F.tid == 0) F.MISC[16] = __hip_atomic_fetch_add(head, 1u, __ATOMIC_RELAXED, __HIP_MEMORY_SCOPE_AGENT);
        __syncthreads();
        const int u = (int)F.MISC[16];
        __syncthreads();
        if (u >= N_FX_UNITS + N_SB_UNITS) break;
        if (u < N_FX_UNITS) { const int qb = 64 - u / 10, bh = u % 10; int nr = REP_FOX; asm volatile("" : "+s"(nr)); for (int r = 0; r < nr; ++r) attn_unit<0>(a, F, bh / FX_H, bh % FX_H, qb, bound); }
        else { const int v = u - N_FX_UNITS; const int qb = 64 - v / 10, bh = v % 10; int nr = REP_SB; asm volatile("" : "+s"(nr)); for (int r = 0; r < nr; ++r) attn_unit<1>(a, F, bh / SB_H, bh % SB_H, qb, bound); }
    }
}

__device__ __forceinline__ void chain_publish(unsigned* cnt, int pm) {
    asm volatile("s_waitcnt vmcnt(0)" ::: "memory");
    if ((threadIdx.x & 63) == 0) __hip_atomic_fetch_add(cnt + CH_STRIDE * pm, 1u, __ATOMIC_RELAXED, __HIP_MEMORY_SCOPE_AGENT);
}
template <bool WAIT, bool PUB>
struct ChainOrder : pg8::StaticOrder {
    const unsigned* ready; unsigned need; unsigned* mine;
    __device__ __forceinline__ void a_ready(const pg8::Unit& u) const {
        if constexpr (WAIT) {
            if (threadIdx.x < 64) {
                const unsigned* w = ready + CH_STRIDE * u.pm; unsigned polls = 0;
                while ((unsigned)__builtin_amdgcn_readfirstlane(__hip_atomic_load(w, __ATOMIC_RELAXED, __HIP_MEMORY_SCOPE_AGENT)) < need) { if (++polls > (1u << 18)) break; __builtin_amdgcn_s_sleep(2); }
                __builtin_amdgcn_fence(__ATOMIC_ACQUIRE, "agent");
                asm volatile("s_waitcnt vmcnt(0)" ::: "memory");
            }
            asm volatile("" ::: "memory"); __builtin_amdgcn_s_barrier(); asm volatile("" ::: "memory");
        }
    }
    __device__ __forceinline__ void done(const pg8::Unit& u) const { if constexpr (PUB) chain_publish(mine, u.pm); }
};

__device__ __forceinline__ void phase_post(const ArgsL& a, Frame& F, int layer, unsigned* chain, const bool dry = false) {
    const int lane = F.lane, wave = F.wave, it4 = lane >> 4, e4 = lane & 15;
    bf16_t* Y0 = (bf16_t*)(a.ws + WS_YCAT); const bf16_t* BN = (const bf16_t*)(a.ws + WS_BN);
    const __amdgpu_buffer_rsrc_t yrs = __builtin_amdgcn_make_buffer_rsrc((void*)Y0, 0, (int)((size_t)M * YC_W * 2), 0x00020000);
    LAS float* lgl = (LAS float*)F.lds;
    for (int i = F.tid; i < 2 * RW_W; i += NTHR) lgl[i] = (i < RW_W) ? a.in(I_LNG)[layer * RW_W + i] : a.in(I_LNB)[layer * RW_W + i - RW_W];
    __syncthreads();
    unsigned* head = (unsigned*)(a.ws + WS_CTL) + CW_QUEUE + 64 * layer + 32 + (dry ? 8 : 0);
    for (;;) {
        if (F.tid == 0) F.MISC[17] = __hip_atomic_fetch_add(head, 1u, __ATOMIC_RELAXED, __HIP_MEMORY_SCOPE_AGENT);
        __syncthreads();
        const int ch = (int)F.MISC[17];
        __syncthreads();
        if (ch >= M / 64) break;
        u32x2 yn = {0u, 0u}, bn = {0u, 0u};
#define PP_ADDR(ps) const int item_ = (ps) * 32 + wave * 4 + it4, rw_ = item_ / 6, hh_ = item_ - rw_ * 6; const int m_ = ch * 64 + rw_; const size_t off_ = (size_t)m_ * RW_W + hh_ * 64 + e4 * 4, offy_ = (size_t)m_ * YC_W + hh_ * 64 + e4 * 4
        { PP_ADDR(0); yn = *(const u32x2*)(Y0 + offy_); bn = *(const u32x2*)(BN + off_); }
#pragma unroll 1
        for (int ps = 0; ps < 12; ++ps) {
            const u32x2 yv = yn, bv = bn;
            if (ps + 1 < 12) { PP_ADDR(ps + 1); yn = *(const u32x2*)(Y0 + offy_); bn = *(const u32x2*)(BN + off_); }
            PP_ADDR(ps);
            const int p = m_ % T;
            u32x2 w = {0u, 0u};
            if (p >= PADR) {
                const float y0 = bf_lo(yv.x), y1 = bf_hi(yv.x), y2 = bf_lo(yv.y), y3 = bf_hi(yv.y);
                const float mean = allred16((y0 + y1) + (y2 + y3)) * (1.f / 64.f);
                const float d0 = y0 - mean, d1 = y1 - mean, d2 = y2 - mean, d3 = y3 - mean;
                const float rs = 1.0f / sqrtf(allred16((d0 * d0 + d1 * d1) + (d2 * d2 + d3 * d3)) * (1.f / 64.f) + 64e-5f);
                const f32x4 g4 = *(const LAS f32x4*)(lgl + hh_ * 64 + e4 * 4), b4 = *(const LAS f32x4*)(lgl + RW_W + hh_ * 64 + e4 * 4);
                w = (u32x2){pk2(d0 * rs * g4.x + b4.x + bf_lo(bv.x), d1 * rs * g4.y + b4.y + bf_hi(bv.x)), pk2(d2 * rs * g4.z + b4.z + bf_lo(bv.y), d3 * rs * g4.w + b4.w + bf_hi(bv.y))};
            }
            if (!dry) __builtin_amdgcn_raw_buffer_store_b64(w, yrs, (int)(offy_ * 2), 0, 16); else asm volatile("" :: "v"(w.x), "v"(w.y));
        }
#undef PP_ADDR
        if (!dry) {
#pragma unroll 1
            for (int k = 0; k < 16; ++k) { const int pr = wave * 16 + k, sl = pr >> 6, m2 = ch * 64 + (pr & 63); const int p = m2 % T;
                const int rowb = (int)(((size_t)m2 * YC_W + 384 * (sl + 1)) * 2);
                if (p < PADR) { for (int c = lane; c < RW_W / 2; c += 64) __builtin_amdgcn_raw_buffer_store_b32(0u, yrs, rowb + 4 * c, 0, 16); }
                else if (lane < 32) __builtin_amdgcn_raw_buffer_store_b32(0u, yrs, rowb + 640 + 4 * lane, 0, 16); }
            chain_publish(chain, ch >> 2);
        }
    }
}

struct EpiInproj { static constexpr bool PERM = true, AFTER_DRAIN = false, MIDHOOK = false; bf16_t* ush; bf16_t* qkv;
    __device__ __forceinline__ void operator()(const f32x4 (&acc)[2][2][4][2], const pg8::Unit& u, int wr, int wc, int fr, int fq) const {
        asm volatile("" : "+v"(fr), "+v"(fq));
        const int row0 = u.pm * 256 + wr * 64 + fr, colt = u.pn * 256 + wc * 32 + 8 * fq;
#pragma unroll
        for (int ai = 0; ai < 2; ++ai)
#pragma unroll
            for (int m = 0; m < 4; ++m) { const size_t row = (size_t)(row0 + ai * 128 + m * 16);
#pragma unroll
                for (int bj = 0; bj < 2; ++bj) { const int col = colt + bj * 128; const f32x4 v0 = acc[ai][bj][m][0], v1 = acc[ai][bj][m][1];
                    const float sc = (col >= SHIFT_W && col < SHIFT_W + 320) ? C2 : 1.0f;
                    u32x4 w; w.x = pk2(v0[0] * sc, v0[1] * sc); w.y = pk2(v0[2] * sc, v0[3] * sc); w.z = pk2(v1[0] * sc, v1[1] * sc); w.w = pk2(v1[2] * sc, v1[3] * sc);
                    if (col < SHIFT_W) *(u32x4*)(ush + row * SHIFT_W + col) = w;
                    else if (col < SHIFT_W + QKV_W) *(u32x4*)(qkv + row * QKV_W + (col - SHIFT_W)) = w; } }
    }
};
struct EpiGates { static constexpr bool PERM = true, AFTER_DRAIN = false, MIDHOOK = false; bf16_t* gates;
    __device__ __forceinline__ void operator()(const f32x4 (&acc)[2][2][4][2], const pg8::Unit& u, int wr, int wc, int fr, int fq) const {
        asm volatile("" : "+v"(fr), "+v"(fq));
        const int row0 = u.pm * 256 + wr * 64 + fr, colt = u.pn * 256 + wc * 32 + 8 * fq;
        const __amdgpu_buffer_rsrc_t rs = __builtin_amdgcn_make_buffer_rsrc((void*)gates, 0, (int)((size_t)M * 3072 * 2), 0x00020000);
#pragma unroll
        for (int ai = 0; ai < 2; ++ai)
#pragma unroll
            for (int m = 0; m < 4; ++m) { const size_t row = (size_t)(row0 + ai * 128 + m * 16);
#pragma unroll
                for (int bj = 0; bj < 2; ++bj) { const int col = colt + bj * 128; f32x4 v0 = acc[ai][bj][m][0], v1 = acc[ai][bj][m][1];
#pragma unroll
                    for (int q = 0; q < 4; ++q) { v0[q] = __builtin_amdgcn_rcpf(1.f + __builtin_amdgcn_exp2f(-v0[q] * LOG2E)); v1[q] = __builtin_amdgcn_rcpf(1.f + __builtin_amdgcn_exp2f(-v1[q] * LOG2E)); }
                    u32x4 w; w.x = pk2(v0[0], v0[1]); w.y = pk2(v0[2], v0[3]); w.z = pk2(v1[0], v1[1]); w.w = pk2(v1[2], v1[3]);
                    __builtin_amdgcn_raw_buffer_store_b128(w, rs, (int)((row * 3072 + col) * 2), 0, 16); } }
    }
};
struct EpiMergeF { static constexpr bool PERM = true, AFTER_DRAIN = false, MIDHOOK = true; const bf16_t* gates; bf16_t* merged;
    __device__ __forceinline__ void mid(f32x4 (&acc)[2][2][4][2], const pg8::Unit& u, int wr, int wc, int fr, int fq, int seg) const {
        asm volatile("" : "+v"(fr), "+v"(fq));
        const int row0 = u.pm * 256 + wr * 64 + fr, colt = u.pn * 256 + wc * 32 + 8 * fq;
        u32x4 gpn[2], gnn[2];
#define MG_LOAD(q) do { const bf16_t* gpt_ = gates + (size_t)(row0 + ((q) >> 2) * 128 + ((q) & 3) * 16) * 3072 + (seg - 1) * 1024 + colt; \
            gpn[0] = *(const u32x4*)gpt_; gnn[0] = *(const u32x4*)(gpt_ + 1024); gpn[1] = *(const u32x4*)(gpt_ + 128); gnn[1] = *(const u32x4*)(gpt_ + 1024 + 128); } while (0)
        MG_LOAD(0);
#pragma unroll
        for (int q = 0; q < 8; ++q) { const int ai = q >> 2, m = q & 3;
            u32x4 gp[2], gn[2];
#pragma unroll
            for (int bj = 0; bj < 2; ++bj) { gp[bj] = gpn[bj]; gn[bj] = gnn[bj]; }
            if (q < 7) MG_LOAD(q + 1);
#pragma unroll
            for (int bj = 0; bj < 2; ++bj) { f32x4& v0 = acc[ai][bj][m][0]; f32x4& v1 = acc[ai][bj][m][1];
                v0[0] *= bf_lo(gp[bj].x) * __builtin_amdgcn_rcpf(bf_lo(gn[bj].x)); v0[1] *= bf_hi(gp[bj].x) * __builtin_amdgcn_rcpf(bf_hi(gn[bj].x));
                v0[2] *= bf_lo(gp[bj].y) * __builtin_amdgcn_rcpf(bf_lo(gn[bj].y)); v0[3] *= bf_hi(gp[bj].y) * __builtin_amdgcn_rcpf(bf_hi(gn[bj].y));
                v1[0] *= bf_lo(gp[bj].z) * __builtin_amdgcn_rcpf(bf_lo(gn[bj].z)); v1[1] *= bf_hi(gp[bj].z) * __builtin_amdgcn_rcpf(bf_hi(gn[bj].z));
                v1[2] *= bf_lo(gp[bj].w) * __builtin_amdgcn_rcpf(bf_lo(gn[bj].w)); v1[3] *= bf_hi(gp[bj].w) * __builtin_amdgcn_rcpf(bf_hi(gn[bj].w)); }
            __builtin_amdgcn_sched_barrier(0); }
#undef MG_LOAD
    }
    __device__ __forceinline__ void operator()(const f32x4 (&acc)[2][2][4][2], const pg8::Unit& u, int wr, int wc, int fr, int fq) const {
        asm volatile("" : "+v"(fr), "+v"(fq));
        const int row0 = u.pm * 256 + wr * 64 + fr, colt = u.pn * 256 + wc * 32 + 8 * fq;
        const __amdgpu_buffer_rsrc_t mrs = __builtin_amdgcn_make_buffer_rsrc((void*)merged, 0, (int)((size_t)M * D * 2), 0x00020000);
        u32x4 gnx[2];
#define MG_LOAD2(q) do { const bf16_t* gpt_ = gates + (size_t)(row0 + ((q) >> 2) * 128 + ((q) & 3) * 16) * 3072 + 2048 + colt; gnx[0] = *(const u32x4*)gpt_; gnx[1] = *(const u32x4*)(gpt_ + 128); } while (0)
        MG_LOAD2(0);
#pragma unroll
        for (int q = 0; q < 8; ++q) { const int ai = q >> 2, m = q & 3; const size_t row = (size_t)(row0 + ai * 128 + m * 16);
            u32x4 g[2];
#pragma unroll
            for (int bj = 0; bj < 2; ++bj) g[bj] = gnx[bj];
            if (q < 7) MG_LOAD2(q + 1);
#pragma unroll
            for (int bj = 0; bj < 2; ++bj) { const f32x4 v0 = acc[ai][bj][m][0], v1 = acc[ai][bj][m][1];
                u32x4 w;
                w.x = pk2(bf_lo(g[bj].x) * v0[0], bf_hi(g[bj].x) * v0[1]); w.y = pk2(bf_lo(g[bj].y) * v0[2], bf_hi(g[bj].y) * v0[3]);
                w.z = pk2(bf_lo(g[bj].z) * v1[0], bf_hi(g[bj].z) * v1[1]); w.w = pk2(bf_lo(g[bj].w) * v1[2], bf_hi(g[bj].w) * v1[3]);
                __builtin_amdgcn_raw_buffer_store_b128(w, mrs, (int)((row * D + colt + bj * 128) * 2), 0, 16); }
            __builtin_amdgcn_sched_barrier(0); }
#undef MG_LOAD2
    }
};
struct EpiOut { static constexpr bool PERM = true, AFTER_DRAIN = false, MIDHOOK = false; bf16_t* hb;
    __device__ __forceinline__ void operator()(const f32x4 (&acc)[2][2][4][2], const pg8::Unit& u, int wr, int wc, int fr, int fq) const {
        asm volatile("" : "+v"(fr), "+v"(fq));
        const int row0 = u.pm * 256 + wr * 64 + fr, colt = u.pn * 256 + wc * 32 + 8 * fq;
        u32x4 hn[2];
#define OUT_LOAD(q) do { const bf16_t* p_ = hb + (size_t)(row0 + ((q) >> 2) * 128 + ((q) & 3) * 16) * D + colt; hn[0] = *(const u32x4*)(p_); hn[1] = *(const u32x4*)(p_ + 128); } while (0)
        OUT_LOAD(0);
#pragma unroll
        for (int q = 0; q < 8; ++q) {
            const int ai = q >> 2, m = q & 3;
            bf16_t* hp = hb + (size_t)(row0 + ai * 128 + m * 16) * D + colt; const u32x4 h0 = hn[0], h1 = hn[1];
            if (q < 7) OUT_LOAD(q + 1);
#pragma unroll
            for (int bj = 0; bj < 2; ++bj) { const u32x4 hh = bj ? h1 : h0; const f32x4 v0 = acc[ai][bj][m][0], v1 = acc[ai][bj][m][1];
                u32x4 w; w.x = pk2(bf_lo(hh.x) + v0[0], bf_hi(hh.x) + v0[1]); w.y = pk2(bf_lo(hh.y) + v0[2], bf_hi(hh.y) + v0[3]);
                w.z = pk2(bf_lo(hh.z) + v1[0], bf_hi(hh.z) + v1[1]); w.w = pk2(bf_lo(hh.w) + v1[2], bf_hi(hh.w) + v1[3]);
                *(u32x4*)(hp + bj * 128) = w; }
            __builtin_amdgcn_sched_barrier(0);
        }
#undef OUT_LOAD
    }
};
template <bool GA> struct MoeOrderT { static constexpr bool GATHER = GA; const volatile LAS int* tb; int ntile, npt, G, c, rep; const int* s2t;
    __device__ __forceinline__ bool next(int i, pg8::Unit& u) const { long L = (long)i * G + c; if (L >= (long)ntile * npt * rep) return false; L %= (long)ntile * npt;
        const int tau = (int)(L / npt), j = (int)(L - (long)tau * npt); int e = 0;
#pragma unroll
        for (int k = 1; k < 16; ++k) e += (tau >= tb[k]) ? 1 : 0;
        u.pm = tau; u.pn = __builtin_amdgcn_readfirstlane(e) * npt + j; return true; }
    __device__ __forceinline__ void a_ready(const pg8::Unit&) const {}
    __device__ __forceinline__ void done(const pg8::Unit&) const {}
};
struct EpiMoeUp { static constexpr bool PERM = true, AFTER_DRAIN = false, MIDHOOK = false; bf16_t* hs;
    __device__ __forceinline__ void operator()(const f32x4 (&acc)[2][2][4][2], const pg8::Unit& u, int wr, int wc, int fr, int fq) const {
        asm volatile("" : "+v"(fr), "+v"(fq));
        const int row0 = u.pm * 256 + wr * 64 + fr, col = (u.pn & 1) * 128 + wc * 32 + 8 * fq;
#pragma unroll
        for (int ai = 0; ai < 2; ++ai)
#pragma unroll
            for (int m = 0; m < 4; ++m) { const size_t row = (size_t)(row0 + ai * 128 + m * 16); float r[8];
#pragma unroll
                for (int n = 0; n < 2; ++n)
#pragma unroll
                    for (int q = 0; q < 4; ++q) { const float gte = acc[ai][0][m][n][q], up = acc[ai][1][m][n][q]; r[4 * n + q] = gte * __builtin_amdgcn_rcpf(1.f + __builtin_amdgcn_exp2f(-gte * LOG2E)) * up; }
                u32x4 w; w.x = pk2(r[0], r[1]); w.y = pk2(r[2], r[3]); w.z = pk2(r[4], r[5]); w.w = pk2(r[6], r[7]);
                *(u32x4*)(hs + row * DEXP + col) = w; }
    }
};
struct EpiMoeDown { static constexpr bool PERM = true, AFTER_DRAIN = false, MIDHOOK = false; bf16_t* y; const float* cws;
    __device__ __forceinline__ void operator()(const f32x4 (&acc)[2][2][4][2], const pg8::Unit& u, int wr, int wc, int fr, int fq) const {
        asm volatile("" : "+v"(fr), "+v"(fq));
        const int row0 = u.pm * 256 + wr * 64 + fr, colt = (u.pn & 3) * 256 + wc * 32 + 8 * fq;
        float cw[8];
#pragma unroll
        for (int q = 0; q < 8; ++q) cw[q] = cws[row0 + (q >> 2) * 128 + (q & 3) * 16];
#pragma unroll
        for (int ai = 0; ai < 2; ++ai)
#pragma unroll
            for (int m = 0; m < 4; ++m) { const size_t row = (size_t)(row0 + ai * 128 + m * 16); const float cwv = cw[ai * 4 + m];
#pragma unroll
                for (int bj = 0; bj < 2; ++bj) { const int col = colt + bj * 128; const f32x4 v0 = acc[ai][bj][m][0] * cwv, v1 = acc[ai][bj][m][1] * cwv;
                    u32x4 w; w.x = pk2(v0[0], v0[1]); w.y = pk2(v0[2], v0[3]); w.z = pk2(v1[0], v1[1]); w.w = pk2(v1[2], v1[3]);
                    *(u32x4*)(y + row * D + col) = w; } }
    }
};


#ifndef PH_MASK
#define PH_MASK 0xFFFF
#endif
#define PH(k) ((PH_MASK >> (k)) & 1)
#ifndef PROBE_DUP
#define PROBE_DUP 0
#endif
#define DUPN(bit) (((PROBE_DUP >> (bit)) & 1) ? 2 : 1)
#ifndef PROBE_THIN
#define PROBE_THIN 0
#endif
#define THIN(bit) ((PROBE_THIN >> (bit)) & 1)
#define FRESH() do { asm volatile("" : "+v"(F.tid)); F.lane = F.tid & 63; F.wave = __builtin_amdgcn_readfirstlane(F.tid >> 6); { int bx_ = (int)blockIdx.x; asm volatile("" : "+s"(bx_)); F.bx = bx_; } { unsigned char* w_ = a.ws; asm volatile("" : "+s"(w_)); a.ws = w_; } } while (0)
__global__ void __launch_bounds__(NTHR, 2) hybrid_fwd(Args ka) {
    extern __shared__ __attribute__((aligned(16))) unsigned char lds_raw[];
    Frame F;
    F.lds = (LAS unsigned char*)lds_raw;
    F.MISC = (volatile LAS unsigned*)(F.lds + MISC_OFF);
    F.tid = threadIdx.x; F.lane = F.tid & 63; F.wave = __builtin_amdgcn_readfirstlane(F.tid >> 6); F.bx = (int)blockIdx.x;
    for (int u = F.tid; u < (LDS_BYTES - MISC_OFF) / 4; u += NTHR) ((LAS unsigned*)(F.lds + MISC_OFF))[u] = 0u;
    __syncthreads();
    if (F.tid < 29) { const unsigned long long p = (unsigned long long)ka.in[F.tid]; F.MISC[64 + 2 * F.tid] = (unsigned)p; F.MISC[65 + 2 * F.tid] = (unsigned)(p >> 32); }
    __syncthreads();
    ArgsL a; a.tab = F.MISC + 64; a.out = ka.out; a.ws = ka.ws;
    XcdBarrier bar = xcd_barrier_post((unsigned*)(a.ws + WS_CTL) + CW_BAR, F.MISC + 8);
    const int G = (int)gridDim.x, c = (int)blockIdx.x;
    PG8_LAS unsigned char* ring = (PG8_LAS unsigned char*)F.lds;

#ifdef PROF_K
    volatile LAS unsigned* tsl = F.MISC + 1536; int nts = 0;
    if (blockIdx.x == 0 && F.tid == 0) tsl[nts] = (unsigned)__builtin_amdgcn_s_memrealtime();
    ++nts;
#define BARX() do { xcd_barrier(bar); if (blockIdx.x == 0 && F.tid == 0) tsl[nts] = (unsigned)__builtin_amdgcn_s_memrealtime(); ++nts; } while (0)
#else
#define BARX() xcd_barrier(bar)
#endif
    for (int layer = 0; layer < DEPTH; ++layer) {
        for (int rep = 0; rep < DUPN(8); ++rep) { FRESH(); if (PH(0)) phase_wconv(a, F, layer); }
        __syncthreads();
        if (THIN(0)) { FRESH(); phase_norm<1>(a, F, layer, true); }
        FRESH(); if (PH(1)) phase_norm<1>(a, F, layer);
        BARX();
        FRESH(); if (PH(2)) {
            pg8::Gemm g{(const bf16_t*)A_PTR(a), (const bf16_t*)(a.ws + WS_WIN), M, N1, D}; pg8::StaticOrder S; S.init(M, N1, G, c, DUPN(3));
            EpiInproj E{(bf16_t*)(a.ws + WS_USH), (bf16_t*)(a.ws + WS_QKV)};
            pg8::gemm_phase<EpiInproj, pg8::StaticOrder, true, true>(ring, g, S, E);
        }
        BARX();
        if (THIN(1)) { FRESH(); phase_prep(a, F, layer, true); }
        FRESH(); if (PH(3)) phase_prep(a, F, layer);
        BARX();
#ifndef SEQ_SCAN
        if (THIN(2)) { FRESH(); phase_chunkA(a, F, true); }
        FRESH(); if (PH(4)) phase_chunkA(a, F);
        unsigned* ca_done = (unsigned*)(a.ws + WS_CTL) + CW_CADONE + 64 * layer;
        wg_publish(ca_done);
#endif
        FRESH(); if (PH(4)) phase_mix(a, F, layer, ca_done);
        BARX();
        unsigned* ch2 = (unsigned*)(a.ws + WS_CTL) + CW_CHAIN + (layer * 2) * 129 * CH_STRIDE; unsigned* ch3 = ch2 + 129 * CH_STRIDE;
        FRESH(); if (PH(6)) {
            pg8::Gemm g{(const bf16_t*)A_PTR(a), (const bf16_t*)(a.ws + WS_WG), M, 3072, D}; ChainOrder<false, true> S; S.init(M, 3072, G, c, 1); S.ready = nullptr; S.need = 0u; S.mine = ch2;
            EpiGates E{(bf16_t*)(a.ws + WS_GATES)};
            pg8::gemm_phase<EpiGates, ChainOrder<false, true>, true, true>(ring, g, S, E);
        }
        asm volatile("s_waitcnt vmcnt(0) lgkmcnt(0)" ::: "memory"); __syncthreads();
        if (THIN(3)) { FRESH(); phase_post(a, F, layer, ch2, true); }
        FRESH(); if (PH(5)) { if (!((c >= 16 && c < 20) || (c >= 32 && c < 36))) phase_post(a, F, layer, ch2); }
        __syncthreads();
        FRESH(); if (PH(7)) {
            pg8::Gemm g{(const bf16_t*)(a.ws + WS_YCAT), (const bf16_t*)(a.ws + WS_WP), M, D, YC_W}; ChainOrder<true, true> S; S.init(M, D, G, (c + G - 16) % G, 1); S.ready = ch2; S.need = 128u; S.mine = ch3;
            EpiMergeF E{(const bf16_t*)(a.ws + WS_GATES), (bf16_t*)(a.ws + WS_MERGED)};
            pg8::gemm_phase<EpiMergeF, ChainOrder<true, true>, true, true>(ring, g, S, E);
        }
        FRESH(); if (PH(8)) {
            pg8::Gemm g{(const bf16_t*)(a.ws + WS_MERGED), (const bf16_t*)(a.ws + WS_WO), M, D, D}; ChainOrder<true, false> S; S.init(M, D, G, (c + G - 32) % G, 1); S.ready = ch3; S.need = 32u; S.mine = nullptr;
            EpiOut E{HB_PTR(a)};
            pg8::gemm_phase<EpiOut, ChainOrder<true, false>, true, true>(ring, g, S, E);
        }
        BARX();
        if (THIN(4)) { FRESH(); phase_norm2(a, F, layer, true); }
        FRESH(); if (PH(9)) phase_norm2(a, F, layer);
        BARX();
        for (int rep = 0; rep < DUPN(7); ++rep) { FRESH(); if (PH(10)) phase_route(a, F, layer); }
        BARX();
        volatile LAS int* tb = (volatile LAS int*)(F.MISC + 32);
        if (F.tid <= 16) { const int* cnt = (const int*)(a.ws + WS_CTL) + CW_ECNT + 64 * layer; int t = 0;
            for (int e = 0; e < F.tid; ++e) t += (__hip_atomic_load(cnt + e, __ATOMIC_RELAXED, __HIP_MEMORY_SCOPE_AGENT) + 255) >> 8;
            tb[F.tid] = t; }
        __syncthreads();
        const int ntile = tb[16];
        FRESH(); if (PH(11)) {
            pg8::Gemm g{(const bf16_t*)A_PTR(a), (const bf16_t*)(a.ws + WS_WGU), MS, 8192, D}; MoeOrderT<true> S{tb, ntile, 2, G, c, DUPN(6), (const int*)(a.ws + WS_S2T)};
            EpiMoeUp E{(bf16_t*)(a.ws + WS_HS)};
            pg8::gemm_phase<EpiMoeUp, MoeOrderT<true>, true, true>(ring, g, S, E);
        }
        BARX();
        FRESH(); if (PH(12)) {
            int kdim = DEXP; asm volatile("" : "+s"(kdim));
            pg8::Gemm g{(const bf16_t*)(a.ws + WS_HS), (const bf16_t*)(a.ws + WS_WD), MS, 16384, kdim}; MoeOrderT<false> S{tb, ntile, 4, G, c, DUPN(6), nullptr};
            EpiMoeDown E{(bf16_t*)(a.ws + WS_Y), (const float*)(a.ws + WS_CWS)};
            pg8::gemm_phase<EpiMoeDown, MoeOrderT<false>, true, true>(ring, g, S, E);
        }
        BARX();
    }
    if (THIN(5)) { FRESH(); phase_norm<0>(a, F, DEPTH - 1, true); }
    FRESH(); if (PH(13)) phase_norm<0>(a, F, DEPTH - 1);
#ifdef PROF_K
    BARX();
    if (blockIdx.x == 0) {
        __syncthreads();
        float us;
        if (PROF_K < 0) us = 100.f;
        else if (PROF_K == 12) us = (float)(tsl[25] - tsl[24]) * 0.01f;
        else if (PROF_K == 13) us = (float)(tsl[25] - tsl[0]) * 0.01f;
        else us = ((float)(tsl[1 + PROF_K] - tsl[PROF_K]) + (float)(tsl[13 + PROF_K] - tsl[12 + PROF_K])) * 0.01f;
        us = 4.f * rintf(us * 0.25f);
        for (int i = F.tid; i < 16384; i += NTHR) a.out[i] = us;
    }
#endif
#ifdef CLOCK_PROBE
    if (blockIdx.x == 0 && F.wave == 0) {
        float c0 = 1.f, c1 = 2.f, c2 = 3.f, c3 = 4.f, c4 = 5.f, c5 = 6.f, c6 = 7.f, c7 = 8.f;
        for (int i = 0; i < CLOCK_PROBE; ++i) {
            asm volatile("v_fma_f32 %0, %0, %0, %0\n\tv_fma_f32 %1, %1, %1, %1\n\tv_fma_f32 %2, %2, %2, %2\n\tv_fma_f32 %3, %3, %3, %3\n\tv_fma_f32 %4, %4, %4, %4\n\tv_fma_f32 %5, %5, %5, %5\n\tv_fma_f32 %6, %6, %6, %6\n\tv_fma_f32 %7, %7, %7, %7"
                         : "+v"(c0), "+v"(c1), "+v"(c2), "+v"(c3), "+v"(c4), "+v"(c5), "+v"(c6), "+v"(c7));
        }
        asm volatile("" :: "v"(c0), "v"(c1), "v"(c2), "v"(c3), "v"(c4), "v"(c5), "v"(c6), "v"(c7));
    }
#endif
}

extern "C" void kernel_launch(void* const* d_in, const int* in_sizes, int n_in, void* d_out, int out_size, void* d_ws, size_t ws_size, hipStream_t stream) {
    static int ready = 0;
    if (ready == 0) {
        if (n_in != 29 || out_size != NB * SEQ * D || ws_size < WS_END) { fprintf(stderr, "kernel_launch: unexpected problem shape (n_in %d, out %d, ws %zu < %zu)\n", n_in, out_size, ws_size, (size_t)WS_END); ready = -1; return; }
        if (hipFuncSetAttribute((const void*)hybrid_fwd, hipFuncAttributeMaxDynamicSharedMemorySize, LDS_BYTES) != hipSuccess) { fprintf(stderr, "kernel_launch: hipFuncSetAttribute failed\n"); ready = -1; return; }
        int per_cu = 0;
        if (hipOccupancyMaxActiveBlocksPerMultiprocessor(&per_cu, (const void*)hybrid_fwd, NTHR, LDS_BYTES) != hipSuccess || per_cu < 1) fprintf(stderr, "kernel_launch: occupancy query says %d\n", per_cu);
        (void)hipGetLastError();
        ready = 1;
    }
    if (ready < 0) return;
    (void)in_sizes;
    if (hipMemsetAsync((char*)d_ws + WS_CTL, 0, CTL_ZERO_BYTES, stream) != hipSuccess) return;
    Args a{};
    for (int i = 0; i < 29; ++i) a.in[i] = (const float*)d_in[i];
    a.out = (float*)d_out; a.ws = (unsigned char*)d_ws;
    hipLaunchKernelGGL(hybrid_fwd, dim3(256), dim3(NTHR), LDS_BYTES, stream, a);
}
```

```cpp
#include <hip/hip_runtime.h>
#include <hip/hip_bf16.h>
#include <cstdio>
#include <cstdint>

#define GAS __attribute__((address_space(1)))
#define LAS __attribute__((address_space(3)))

namespace pg8 {
#define PG8_LAS __attribute__((address_space(3)))
typedef unsigned short bf16_t;
typedef short bf16x8 __attribute__((ext_vector_type(8)));
typedef float f32x4 __attribute__((ext_vector_type(4)));
typedef unsigned u32x4 __attribute__((ext_vector_type(4)));
constexpr int BM = 256, BK = 64, HALF = 128, HTB = HALF * BK * 2  , STAGE_BYTES = 8 * HTB, NXCD = 8, WGM = 8;

__host__ __device__ __forceinline__ int lds_byte(int r, int c) { const int st = (r >> 4) * 2 + (c >> 5), rr = r & 15, cc = c & 31, ob = rr * 64 + cc * 2; return st * 1024 + (ob ^ (((ob >> 9) & 1) << 5)); }
__host__ __device__ __forceinline__ void stage_rc(int b, int& R, int& C) { const int st = b / 1024, sb = b % 1024, swz = sb ^ (((sb >> 9) & 1) << 5); R = (st >> 1) * 16 + swz / 64; C = (st & 1) * 32 + (swz % 64) / 2; }
__host__ __device__ __forceinline__ int perm32(int rho) { const int n = rho >> 4, i = rho & 15; return 8 * (i >> 2) + 4 * n + (i & 3); }

struct Unit { int pm, pn; };
struct Gemm { const bf16_t* A; const bf16_t* Bt; int M, N, K; };

struct StaticOrder {
    int nM, nN, nwg, G, c, rep;
    __host__ __device__ void init(int M, int N, int G_, int c_, int rep_ = 1) { nM = M / BM; nN = N / BM; nwg = nM * nN; G = G_; c = c_; rep = rep_; }
    __host__ __device__ bool next(int i, Unit& u) const {
        const long L = (long)i * G + c; if (L >= (long)nwg * rep) return false;
        int wgid = (int)(L % nwg); { const int q = nwg / NXCD, r = nwg % NXCD, xcd = wgid % NXCD, off = wgid / NXCD; wgid = (xcd < r ? xcd * (q + 1) : r * (q + 1) + (xcd - r) * q) + off; }
        const int nig = WGM * nN, gid = wgid / nig, fm = gid * WGM, gsz = (nM - fm) < WGM ? (nM - fm) : WGM;
        u.pm = fm + ((wgid % nig) % gsz); u.pn = (wgid % nig) / gsz; return true;
    }
    static constexpr bool GATHER = false;
    __device__ __forceinline__ void a_ready(const Unit&) const {}
    __device__ __forceinline__ void done(const Unit&) const {}
};
__device__ __forceinline__ unsigned cvt_pk_bf16(float lo, float hi) { unsigned r; asm volatile("v_cvt_pk_bf16_f32 %0, %1, %2" : "=v"(r) : "v"(lo), "v"(hi)); return r; }
template <class Epi, class Sched, bool ALIGN_EPI = false, bool SP2 = false>
__device__ __forceinline__ void gemm_phase(PG8_LAS unsigned char* lds, const Gemm g, const Sched& S, const Epi& E) {
    int tid_ = threadIdx.x; asm volatile("" : "+v"(tid_));
    const int tid = tid_, wid = __builtin_amdgcn_readfirstlane(tid >> 6), lane = tid & 63, wr = wid >> 2, wc = wid & 3, fr = lane & 15, fq = lane >> 4;
    const int K = g.K, nt = K / BK;
    unsigned voffA[2], voffB[2];
#pragma unroll
    for (int i = 0; i < 2; ++i) { int R, C; stage_rc(tid * 16 + i * 8192, R, C); const int Rb = Epi::PERM ? ((R & ~31) + perm32(R & 31)) : R;
        voffA[i] = (unsigned)(R * K + C) * 2u; voffB[i] = (unsigned)(Rb * K + C) * 2u; }
    constexpr bool GATH = Sched::GATHER;
    unsigned vg[2] = {0u, 0u}, vn[2] = {0u, 0u}; int gR = 0; unsigned gC = 0u;
    if constexpr (GATH) { int R, C; stage_rc(tid * 16, R, C); gR = R; gC = (unsigned)C * 2u; }
#define PG8_GOFF(v, u) do { _Pragma("unroll") for (int h_ = 0; h_ < 2; ++h_) { const int* q_ = S.s2t + (u).pm * 256 + h_ * 128 + gR; v[h_] = (unsigned)q_[0] | ((unsigned)q_[64] << 16); } } while (0)
#define PG8_STAGE_G(bufoff, gbase, pk) do { const unsigned pk_ = (pk); \
        __builtin_amdgcn_global_load_lds((const unsigned*)((const char*)(gbase) + ((pk_ & 0xffffu) * (unsigned)(K * 2) + gC)), (PG8_LAS unsigned*)(lds + (bufoff) + ldsw), 16, 0, 0); \
        __builtin_amdgcn_global_load_lds((const unsigned*)((const char*)(gbase) + ((pk_ >> 16) * (unsigned)(K * 2) + gC)), (PG8_LAS unsigned*)(lds + (bufoff) + ldsw + 8192), 16, 0, 0); } while (0)
    const size_t kstep = (size_t)(BK * 2);
    const size_t hstep = (size_t)HALF * K * 2;
    const size_t tstep = 2 * hstep;
    const unsigned ldsw = (unsigned)wid * 1024u;
    const int aoff = lds_byte(wr * 64 + fr, fq * 8), boff = lds_byte(wc * 32 + fr, fq * 8);
#define PG8_SA(b, h) (((b) * 2 + (h)) * HTB)
#define PG8_SB(b, h) ((4 + (b) * 2 + (h)) * HTB)
#define PG8_STAGE(bufoff, gbase, voff) do { _Pragma("unroll") for (int _i = 0; _i < 2; ++_i) \
        __builtin_amdgcn_global_load_lds((const unsigned*)((const char*)(gbase) + (voff)[_i]), (PG8_LAS unsigned*)(lds + (bufoff) + ldsw + _i * 8192), 16, 0, 0); } while (0)
#define PG8_STAGE_A(bufoff, gbase, h, vv) do { if constexpr (GATH) PG8_STAGE_G(bufoff, gbase, vv[h]); else PG8_STAGE(bufoff, (gbase) + (h) * hstep, voffA); } while (0)
#define PG8_STAGE_A2(bufoff, gbase, h) do { if constexpr (GATH) PG8_STAGE_G(bufoff, gbase, last ? vn[h] : vg[h]); else PG8_STAGE(bufoff, (gbase) + (h) * hstep, voffA); } while (0)
#define PG8_LDA(dst, b, h) do { _Pragma("unroll") for (int m = 0; m < 4; ++m) _Pragma("unroll") for (int k = 0; k < 2; ++k) dst[m][k] = *(const PG8_LAS bf16x8*)(lds + PG8_SA(b, h) + aoff + m * 2048 + k * 1024); } while (0)
#define PG8_LDB(dst, b, h) do { _Pragma("unroll") for (int n = 0; n < 2; ++n) _Pragma("unroll") for (int k = 0; k < 2; ++k) dst[n][k] = *(const PG8_LAS bf16x8*)(lds + PG8_SB(b, h) + boff + n * 2048 + k * 1024); } while (0)
#define PG8_MMA(ai, bj, At, Bt) do { __builtin_amdgcn_s_setprio(1); _Pragma("unroll") for (int m = 0; m < 4; ++m) _Pragma("unroll") for (int n = 0; n < 2; ++n) _Pragma("unroll") for (int k = 0; k < 2; ++k) \
        acc[ai][bj][m][n] = __builtin_amdgcn_mfma_f32_16x16x32_bf16(Bt[n][k], At[m][k], acc[ai][bj][m][n], 0, 0, 0); __builtin_amdgcn_s_setprio(0); } while (0)
#define PG8_WAIT_V(n) asm volatile("s_waitcnt vmcnt(" #n ")" ::: "memory")
#define PG8_WAIT_L(n) asm volatile("s_waitcnt lgkmcnt(" #n ")" ::: "memory")
#define PG8_BAR __builtin_amdgcn_s_barrier()
#define PG8_SCHED __builtin_amdgcn_sched_barrier(0)
    Unit cur, nxt; int ui = 0;
    if (!S.next(0, cur)) return;
    f32x4 acc[2][2][4][2];
#pragma unroll
    for (int a = 0; a < 2; ++a)
#pragma unroll
        for (int b = 0; b < 2; ++b)
#pragma unroll
            for (int m = 0; m < 4; ++m)
#pragma unroll
                for (int n = 0; n < 2; ++n) acc[a][b][m][n] = (f32x4){0.f, 0.f, 0.f, 0.f};
    bf16x8 At[4][2], B0[2][2], B1[2][2];
    const char* cA = GATH ? (const char*)g.A : (const char*)g.A + (size_t)cur.pm * tstep; const char* cB = (const char*)g.Bt + (size_t)cur.pn * tstep;
    S.a_ready(cur);
    if constexpr (GATH) PG8_GOFF(vg, cur);
    if constexpr (SP2) {
        PG8_STAGE(PG8_SB(0, 0), cB, voffB); PG8_STAGE(PG8_SB(0, 1), cB + hstep, voffB); PG8_STAGE_A(PG8_SA(0, 0), cA, 0, vg); PG8_STAGE_A(PG8_SA(0, 1), cA, 1, vg);
        if (wr == 1) PG8_BAR;
        PG8_WAIT_V(2); PG8_BAR;
        PG8_STAGE(PG8_SB(1, 0), cB + kstep, voffB); PG8_STAGE_A(PG8_SA(1, 0), cA + kstep, 0, vg); PG8_STAGE(PG8_SB(1, 1), cB + hstep + kstep, voffB);
        PG8_WAIT_V(6); PG8_BAR;
    } else {
        PG8_STAGE(PG8_SB(0, 0), cB, voffB); PG8_STAGE(PG8_SA(0, 0), cA, voffA); PG8_STAGE(PG8_SB(0, 1), cB + hstep, voffB); PG8_STAGE(PG8_SA(0, 1), cA + hstep, voffA);
        if (wr == 1) PG8_BAR;
        PG8_WAIT_V(4); PG8_BAR;
        PG8_STAGE(PG8_SB(1, 0), cB + kstep, voffB); PG8_STAGE(PG8_SA(1, 0), cA + kstep, voffA); PG8_STAGE(PG8_SB(1, 1), cB + hstep + kstep, voffB);
        PG8_WAIT_V(6); PG8_BAR;
    }
    for (;;) {
        const bool has_next = S.next(ui + 1, nxt);
        const char* nA = (has_next && !GATH) ? (const char*)g.A + (size_t)nxt.pm * tstep : cA;
        if constexpr (GATH) { if (has_next) PG8_GOFF(vn, nxt); else { vn[0] = vg[0]; vn[1] = vg[1]; } } const char* nB = has_next ? (const char*)g.Bt + (size_t)nxt.pn * tstep : cB;
        for (int t = 0; t < nt; t += 2) {
            const bool last = (t == nt - 2);
            const char* a1 = cA + (size_t)(t + 1) * kstep;
            const char* a2 = last ? nA : cA + (size_t)(t + 2) * kstep; const char* b2 = last ? nB : cB + (size_t)(t + 2) * kstep;
            const char* a3 = a2 + kstep; const char* b3 = b2 + kstep;
            if (last && has_next) S.a_ready(nxt);
            if constexpr (SP2) {
            PG8_LDB(B0, 0, 0); PG8_LDB(B1, 0, 1); PG8_SCHED; PG8_LDA(At, 0, 0); PG8_STAGE_A(PG8_SA(1, 1), a1, 1, vg);
            PG8_WAIT_V(8); PG8_WAIT_L(0); PG8_BAR; PG8_MMA(0, 0, At, B0); PG8_MMA(0, 1, At, B1); PG8_BAR; PG8_SCHED;
            PG8_LDA(At, 0, 1); PG8_STAGE(PG8_SB(0, 0), b2, voffB); PG8_STAGE(PG8_SB(0, 1), b2 + hstep, voffB); PG8_STAGE_A2(PG8_SA(0, 0), a2, 0);
            PG8_WAIT_V(8); PG8_WAIT_L(0); PG8_BAR; PG8_MMA(1, 0, At, B0); PG8_MMA(1, 1, At, B1); PG8_BAR; PG8_SCHED;
            PG8_LDB(B0, 1, 0); PG8_LDB(B1, 1, 1); PG8_SCHED; PG8_LDA(At, 1, 0); PG8_STAGE_A2(PG8_SA(0, 1), a2, 1);
            PG8_WAIT_V(8); PG8_WAIT_L(0); PG8_BAR; PG8_MMA(0, 0, At, B0); PG8_MMA(0, 1, At, B1); PG8_BAR; PG8_SCHED;
            PG8_LDA(At, 1, 1); PG8_STAGE(PG8_SB(1, 0), b3, voffB); PG8_STAGE(PG8_SB(1, 1), b3 + hstep, voffB); PG8_STAGE_A2(PG8_SA(1, 0), a3, 0);
            PG8_WAIT_V(8); PG8_WAIT_L(0); PG8_BAR; PG8_MMA(1, 0, At, B0); PG8_MMA(1, 1, At, B1); PG8_BAR; PG8_SCHED;
            } else {
            static_assert(SP2 || !GATH, "gather needs the SP2 schedule");
            PG8_LDB(B0, 0, 0); PG8_SCHED; PG8_LDA(At, 0, 0); PG8_STAGE(PG8_SA(1, 1), a1 + hstep, voffA);
            PG8_WAIT_L(8); PG8_BAR; PG8_WAIT_L(0); PG8_MMA(0, 0, At, B0); PG8_BAR; PG8_SCHED;
            PG8_LDB(B1, 0, 1); PG8_STAGE(PG8_SB(0, 0), b2, voffB);
            PG8_BAR; PG8_WAIT_L(0); PG8_MMA(0, 1, At, B1); PG8_BAR;
            PG8_LDA(At, 0, 1); PG8_STAGE(PG8_SA(0, 0), a2, voffA);
            PG8_BAR; PG8_WAIT_L(0); PG8_MMA(1, 0, At, B0); PG8_BAR; PG8_SCHED;
            PG8_STAGE(PG8_SB(0, 1), b2 + hstep, voffB);
            PG8_WAIT_V(6); PG8_BAR; PG8_MMA(1, 1, At, B1); PG8_BAR;
            PG8_LDB(B0, 1, 0); PG8_SCHED; PG8_LDA(At, 1, 0); PG8_STAGE(PG8_SA(0, 1), a2 + hstep, voffA);
            PG8_WAIT_L(8); PG8_BAR; PG8_WAIT_L(0); PG8_MMA(0, 0, At, B0); PG8_BAR; PG8_SCHED;
            PG8_LDB(B1, 1, 1); PG8_STAGE(PG8_SB(1, 0), b3, voffB);
            PG8_BAR; PG8_WAIT_L(0); PG8_MMA(0, 1, At, B1); PG8_BAR;
            PG8_LDA(At, 1, 1); PG8_STAGE(PG8_SA(1, 0), a3, voffA);
            PG8_BAR; PG8_WAIT_L(0); PG8_MMA(1, 0, At, B0); PG8_BAR; PG8_SCHED;
            PG8_STAGE(PG8_SB(1, 1), b3 + hstep, voffB);
            PG8_WAIT_V(6); PG8_BAR; PG8_MMA(1, 1, At, B1); PG8_BAR;
            }
            if constexpr (Epi::MIDHOOK) { if (t + 2 == 6 || t + 2 == 12) E.mid(acc, cur, wr, wc, fr, fq, (t + 2) / 6); }
        }
        if constexpr (ALIGN_EPI) { if (wr == 0) PG8_BAR; }
        if constexpr (!Epi::AFTER_DRAIN) { E(acc, cur, wr, wc, fr, fq); S.done(cur); }
        if (!has_next) break;
#pragma unroll
        for (int a = 0; a < 2; ++a)
#pragma unroll
            for (int b = 0; b < 2; ++b)
#pragma unroll
                for (int m = 0; m < 4; ++m)
#pragma unroll
                    for (int n = 0; n < 2; ++n) acc[a][b][m][n] = (f32x4){0.f, 0.f, 0.f, 0.f};
        cur = nxt; cA = nA; cB = nB; ++ui;
        if constexpr (GATH) { vg[0] = vn[0]; vg[1] = vn[1]; }
        if constexpr (ALIGN_EPI) { if (wr == 1) PG8_BAR; }
    }
    PG8_WAIT_V(0);
    if constexpr (!ALIGN_EPI) { if (wr == 0) PG8_BAR; }
    PG8_BAR;
    if constexpr (Epi::AFTER_DRAIN) { E.fused(acc, cur, wr, wc, fr, fq, lds, wid, lane); S.done(cur); }
#undef PG8_SA
#undef PG8_SB
#undef PG8_STAGE
#undef PG8_STAGE_A
#undef PG8_STAGE_A2
#undef PG8_STAGE_G
#undef PG8_GOFF
#undef PG8_LDA
#undef PG8_LDB
#undef PG8_MMA
#undef PG8_WAIT_V
#undef PG8_WAIT_L
#undef PG8_BAR
#undef PG8_SCHED
}
}

constexpr int D = 1024, NB = 2, SEQ = 16384, NMETA = 16, LTOK = SEQ + NMETA  , PADR = 112, T = PADR + LTOK  ;
constexpr int M = NB * T;
constexpr int DEPTH = 2, HD = 64, RW_H = 6, SB_H = 5, FX_H = 5, RW_W = 384, SHIFT_W = 1280, D_IN = 6277;
constexpr int YC_W = 1152;
constexpr int QKV_W = 1920;
constexpr int N1 = 3328;
constexpr int FCOL = 3200, GCOL = 3205;
constexpr int NEXP = 16, DEXP = 256;
constexpr int MS = 70144;
constexpr int LCH = 32, LPADDED = 16448;
constexpr int KBP = 16896;
constexpr float C2 = 0.125f * 1.4426950408889634f;
constexpr float LOG2E = 1.4426950408889634f;
constexpr int NWAVES = 8, NTHR = 512;

constexpr size_t MiB = 1u << 20;
constexpr size_t WS_CTL = 0, CTL_ZERO_BYTES = 196608;
constexpr size_t WS_HM = 1 * MiB;
constexpr size_t WS_LOGF = WS_HM + 131072;
constexpr size_t WS_KB2 = WS_LOGF + (size_t)M * 32;
constexpr size_t WS_TOK = WS_KB2 + (size_t)10 * KBP * 4;
constexpr size_t WS_SLOT = WS_TOK + (size_t)M * 32;
constexpr size_t WS_CWS = WS_SLOT + (size_t)M * 8;
constexpr size_t WS_WGCNT = WS_CWS + (size_t)MS * 4;
constexpr size_t WS_S2T = WS_WGCNT + 256 * 16 * 4;
constexpr size_t WS_SMALL_END = WS_S2T + (size_t)MS * 4;
static_assert(WS_SMALL_END <= 8 * MiB, "small buffers");
constexpr size_t WS_WIN = 8 * MiB;
constexpr size_t WS_WG = WS_WIN + (size_t)N1 * 1024 * 2;
constexpr size_t WS_WP = WS_WG + (size_t)3072 * 1024 * 2;
constexpr size_t WS_WO = WS_WP + (size_t)3072 * 384 * 2;
constexpr size_t WS_WGU = WS_WO + (size_t)1024 * 1024 * 2;
constexpr size_t WS_WD = WS_WGU + (size_t)8192 * 1024 * 2;
constexpr size_t WS_W_END = WS_WD + (size_t)16384 * 256 * 2;
static_assert(WS_W_END <= 49 * MiB, "weights");
constexpr size_t WS_HB = 49 * MiB;
constexpr size_t WS_BIG = 115 * MiB;
constexpr size_t WS_USH = WS_BIG;
constexpr size_t WS_YCAT = WS_BIG;
constexpr size_t WS_QKV = WS_BIG + 82 * MiB;
constexpr size_t WS_RW = WS_BIG + 204 * MiB;
constexpr size_t WS_BN = WS_BIG + 349 * MiB;
constexpr size_t WS_GATES = WS_BIG + 82 * MiB;
constexpr size_t WS_MERGED = WS_BIG + 276 * MiB;
constexpr size_t WS_AS = WS_BIG;
constexpr size_t WS_HS = WS_BIG + 137 * MiB;
constexpr size_t WS_Y = WS_BIG + 172 * MiB;
constexpr size_t WS_END = WS_BIG + 374 * MiB;
static_assert((size_t)(M + 256) * 1280 * 2 <= 82 * MiB && (size_t)3 * M * 384 * 2 <= 82 * MiB && (size_t)(M + 256) * 1920 * 2 <= 122 * MiB, "big map 1");
static_assert((size_t)12 * LPADDED * 768 <= 145 * MiB && (size_t)M * 384 * 2 <= 25 * MiB && (size_t)M * 3072 * 2 <= 194 * MiB && (size_t)M * 2048 <= 65 * MiB, "big map 2");
static_assert((size_t)MS * 2048 <= 137 * MiB && (size_t)MS * 512 <= 35 * MiB && WS_END <= 489 * MiB, "big map 3");

constexpr int CW_BAR = 0;
constexpr int CW_QUEUE = 4096;
constexpr int CW_ECNT = 4352;
constexpr int CW_MOE = 24960;
constexpr int CW_CADONE = 24832;
constexpr int CW_CHAIN = 8192, CH_STRIDE = 32;
static_assert((CW_ECNT + 128) <= CW_CHAIN && (CW_CHAIN + DEPTH * 2 * 129 * CH_STRIDE) <= CW_CADONE && (CW_CADONE + 128) <= CW_MOE && (CW_MOE + DEPTH * (MS / 256) * 32) * 4 <= (int)CTL_ZERO_BYTES, "ctl");

constexpr int RING_BYTES = 131072, MISC_OFF = RING_BYTES, LDS_BYTES = 163840;

typedef unsigned short bf16_t;
typedef float f32x4 __attribute__((ext_vector_type(4)));
typedef float f32x2 __attribute__((ext_vector_type(2)));
typedef float f32x16 __attribute__((ext_vector_type(16)));
typedef unsigned u32x4 __attribute__((ext_vector_type(4)));
typedef unsigned u32x2 __attribute__((ext_vector_type(2)));
typedef short bf16x8 __attribute__((ext_vector_type(8)));
typedef short s16x4 __attribute__((ext_vector_type(4)));
typedef _Float16 f16x4 __attribute__((ext_vector_type(4)));
typedef __bf16 bf16x2_t __attribute__((ext_vector_type(2)));

__device__ __forceinline__ unsigned pk2(float lo, float hi) { f32x2 v = {lo, hi}; bf16x2_t b = __builtin_convertvector(v, bf16x2_t); return __builtin_bit_cast(unsigned, b); }
__device__ __forceinline__ unsigned short f2bf(float f) { return (unsigned short)(pk2(f, 0.f) & 0xffffu); }
__device__ __forceinline__ float bf_lo(unsigned u) { return __uint_as_float(u << 16); }
__device__ __forceinline__ float bf_hi(unsigned u) { return __uint_as_float(u & 0xffff0000u); }
__device__ __forceinline__ float bf2f(unsigned short h) { return __uint_as_float((unsigned)h << 16); }
template <int CTRL> __device__ __forceinline__ float dpp_f(float x) { return __int_as_float(__builtin_amdgcn_update_dpp(0, __float_as_int(x), CTRL, 0xF, 0xF, false)); }
__device__ __forceinline__ float allred16(float p) { p += dpp_f<0x128>(p); p += dpp_f<0x124>(p); p += dpp_f<0x122>(p); p += dpp_f<0x121>(p); return p; }
__device__ __forceinline__ float wave_sum(float v) {
    v = allred16(v);
    { auto sw = __builtin_amdgcn_permlane16_swap(__float_as_uint(v), __float_as_uint(v), false, false); v = __uint_as_float(sw[0]) + __uint_as_float(sw[1]); }
    { auto sw = __builtin_amdgcn_permlane32_swap(__float_as_uint(v), __float_as_uint(v), false, false); v = __uint_as_float(sw[0]) + __uint_as_float(sw[1]); }
    return v;
}
__device__ __forceinline__ float fast_exp(float x) { return __builtin_amdgcn_exp2f(x * LOG2E); }
__device__ __forceinline__ float fast_log(float x) { return __builtin_amdgcn_logf(x) * 0.6931471805599453f; }
__device__ __forceinline__ float softplus_f(float z) { return fmaxf(z, 0.f) + fast_log(1.f + fast_exp(-fabsf(z))); }

#define XB_TMO      128
#define XB_XCNT(j)  (256  + 64 * (j))
#define XB_XSUB(j)  (1280 + 64 * (j))
#define XB_XGEN(j)  (2304 + 64 * (j))
#define XB_TOP      3328
#define XB_TOPGEN   3392
#define XCD_BAR_WORDS 3456
#define XB_SPIN_CAP (1u << 20)
__device__ __forceinline__ unsigned xb_ld(unsigned* p)              { return __hip_atomic_load(p, __ATOMIC_RELAXED, __HIP_MEMORY_SCOPE_AGENT); }
__device__ __forceinline__ unsigned xb_add(unsigned* p, unsigned v) { return __hip_atomic_fetch_add(p, v, __ATOMIC_RELAXED, __HIP_MEMORY_SCOPE_AGENT); }
__device__ __forceinline__ unsigned xb_xcc_id() { return (unsigned)__builtin_amdgcn_s_getreg((3 << 11) | 20) & 0xFu; }
#define XB_SPIN(cond, bar) do { unsigned _sp = 0; while (cond) { __builtin_amdgcn_s_sleep(1); \
    if ((++_sp & 255u) == 0u) { if (xb_ld(&(bar)[XB_TMO])) break; if (_sp > XB_SPIN_CAP) { atomicAdd(&(bar)[XB_TMO], 1u); break; } } } } while (0)

struct XcdBarrier {
    unsigned* bar; unsigned x;
    volatile LAS unsigned* st;
};

__device__ __forceinline__ XcdBarrier xcd_barrier_post(unsigned* bar, volatile LAS unsigned* st) {
    XcdBarrier b; b.bar = bar; b.x = xb_xcc_id(); b.st = st;
    if (threadIdx.x == 0) (void)xb_add(&bar[XB_XCNT(b.x)], 1u);
    return b;
}
__device__ __forceinline__ void xcd_barrier_complete(unsigned* bar, unsigned x, unsigned& nloc, unsigned& nx) {
    const unsigned G = gridDim.x * gridDim.y * gridDim.z;
    unsigned sum, cnt, mine, sp = 0u;
    for (;;) {
        sum = 0u; cnt = 0u; mine = 0u;
#pragma unroll
        for (unsigned j = 0; j < 16; ++j) { const unsigned c = xb_ld(&bar[XB_XCNT(j)]); sum += c; cnt += (c > 0u) ? 1u : 0u; mine = (j == x) ? c : mine; }
        if (sum == G) break;
        __builtin_amdgcn_s_sleep(1);
        if ((++sp & 255u) == 0u) { if (xb_ld(&bar[XB_TMO])) break; if (sp > XB_SPIN_CAP) { atomicAdd(&bar[XB_TMO], 1u); break; } }
    }
    nloc = mine > 0u ? mine : 1u; nx = cnt > 0u ? cnt : 1u;
}

__device__ __forceinline__ void xcd_barrier(const XcdBarrier& b) {
    asm volatile("s_waitcnt vmcnt(0)" ::: "memory");
    __syncthreads();
    if (threadIdx.x == 0) {
        unsigned* bar = b.bar;
        __builtin_amdgcn_s_waitcnt(0);
        unsigned nloc = b.st[0], nx = b.st[1];
        if (nloc == 0u) { xcd_barrier_complete(bar, b.x, nloc, nx); b.st[0] = nloc; b.st[1] = nx; }
        const unsigned old = xb_add(&bar[XB_XSUB(b.x)], 1u);
        const unsigned gen = old / nloc;
        if (old + 1u == (gen + 1u) * nloc) {
            __builtin_amdgcn_fence(__ATOMIC_RELEASE, "agent");
            asm volatile("s_waitcnt vmcnt(0)" ::: "memory");
            const unsigned og = xb_add(&bar[XB_TOP], 1u);
            const unsigned tg = og / nx;
            if (og + 1u == (tg + 1u) * nx) xb_add(&bar[XB_TOPGEN], 1u);
            else XB_SPIN(xb_ld(&bar[XB_TOPGEN]) == tg, bar);
            __builtin_amdgcn_fence(__ATOMIC_ACQUIRE, "agent");
            xb_add(&bar[XB_XGEN(b.x)], 1u);
            asm volatile("s_waitcnt vmcnt(0)" ::: "memory");
        } else {
            XB_SPIN(xb_ld(&bar[XB_XGEN(b.x)]) == gen, bar);
            __builtin_amdgcn_fence(__ATOMIC_ACQUIRE, "agent");
            asm volatile("s_waitcnt vmcnt(0)" ::: "memory");
        }
    }
    __syncthreads();
}

struct Args { const float* in[29]; float* out; unsigned char* ws; };
enum { I_X = 0, I_META, I_N1G, I_WIN, I_MU, I_WUP, I_W0, I_AUP, I_A0, I_KK, I_KA, I_RK, I_LNG, I_LNB, I_FB, I_QG, I_KG, I_WPR, I_WPS, I_WPF, I_WOUT, I_N2G, I_MWG, I_MBG, I_MWE, I_MBE, I_MGATE, I_MUP, I_MDOWN };
struct ArgsL { volatile LAS unsigned* tab; float* out; unsigned char* ws;
    __device__ __forceinline__ const float* in(int i) const { const unsigned lo = tab[2 * i], hi = tab[2 * i + 1];
        return (const float*)(((unsigned long long)(unsigned)__builtin_amdgcn_readfirstlane((int)hi) << 32) | (unsigned long long)(unsigned)__builtin_amdgcn_readfirstlane((int)lo)); }
};
struct Frame { LAS unsigned char* lds; volatile LAS unsigned* MISC; int tid, lane, wave, bx; };

__device__ __forceinline__ float* hrow(const ArgsL& a, int b, int l) {
    return l < NMETA ? (float*)(a.ws + WS_HM) + (size_t)(b * NMETA + l) * D : a.out + ((size_t)b * SEQ + (l - NMETA)) * D;
}
#define LDS_WAIT() asm volatile("s_waitcnt lgkmcnt(0)" ::: "memory")
#define HB_PTR(a) ((bf16_t*)((a).ws + WS_HB))
#define A_PTR(a) ((bf16_t*)((a).out))

__device__ __forceinline__ void tr_item(const float* W, int ldw, int sc0, int nvalid, int k0, int kvalid, bf16_t* WT, int Kd, int r0, LAS float* scr, int lane) {
    float tv[32];
#pragma unroll
    for (int i = 0; i < 32; ++i) { const int kk = 2 * i + (lane >> 5), n = lane & 31; tv[i] = 0.f;
        if (n < nvalid && k0 + kk < kvalid) tv[i] = W[(size_t)(k0 + kk) * ldw + sc0 + n]; }
#pragma unroll
    for (int i = 0; i < 32; ++i) { const int kk = 2 * i + (lane >> 5), n = lane & 31; scr[kk * 33 + n] = tv[i]; }
    LDS_WAIT();
    const int c = lane & 7;
#pragma unroll
    for (int j = 0; j < 4; ++j) { const int n = (lane >> 3) + 8 * j; const LAS float* s = scr + (8 * c) * 33 + n;
        u32x4 o; o.x = pk2(s[0 * 33], s[1 * 33]); o.y = pk2(s[2 * 33], s[3 * 33]); o.z = pk2(s[4 * 33], s[5 * 33]); o.w = pk2(s[6 * 33], s[7 * 33]);
        *(u32x4*)(WT + (size_t)(r0 + n) * Kd + k0 + 8 * c) = o; }
    LDS_WAIT();
}
__device__ __forceinline__ void tr_item2(const float* W, int ldw, int sc0, int nvalid, int k0, int kvalid, bf16_t* WT, int Kd, int r0, int kd0, LAS float* scr, int lane) {
    float tv[32];
#pragma unroll
    for (int i = 0; i < 32; ++i) { const int kk = 2 * i + (lane >> 5), n = lane & 31; tv[i] = 0.f;
        if (n < nvalid && k0 + kk < kvalid) tv[i] = W[(size_t)(k0 + kk) * ldw + sc0 + n]; }
#pragma unroll
    for (int i = 0; i < 32; ++i) { const int kk = 2 * i + (lane >> 5), n = lane & 31; scr[kk * 33 + n] = tv[i]; }
    LDS_WAIT();
    const int c = lane & 7;
#pragma unroll
    for (int j = 0; j < 4; ++j) { const int n = (lane >> 3) + 8 * j; const LAS float* s = scr + (8 * c) * 33 + n;
        u32x4 o; o.x = pk2(s[0 * 33], s[1 * 33]); o.y = pk2(s[2 * 33], s[3 * 33]); o.z = pk2(s[4 * 33], s[5 * 33]); o.w = pk2(s[6 * 33], s[7 * 33]);
        *(u32x4*)(WT + (size_t)(r0 + n) * Kd + kd0 + 8 * c) = o; }
    LDS_WAIT();
}
__device__ __forceinline__ void phase_wconv(const ArgsL& a, Frame& F, int layer) {
    LAS float* scr = (LAS float*)(F.lds + F.wave * 8448);
    const int gw = F.bx * NWAVES + F.wave, NGW = gridDim.x * NWAVES;
    constexpr int C1 = 16 * 104, C2_ = C1 + 16 * 96, C3 = C2_ + 6 * 96, C4 = C3 + 16 * 32, C5 = C4 + 16 * 256, C6 = C5 + 4 * 512;
    unsigned char* ws = a.ws;
    for (int it = gw; it < C6; it += NGW) {
        if (it < C1) { const int kb = it / 104, nb = it % 104, r0 = nb * 32;
            tr_item(a.in(I_WIN) + (size_t)layer * D * D_IN, D_IN, r0, r0 < FCOL ? 32 : 0, kb * 64, 1024, (bf16_t*)(ws + WS_WIN), 1024, r0, scr, F.lane); }
        else if (it < C2_) { const int r = it - C1, kb = r / 96, nb = r % 96, r0 = nb * 32;
            tr_item(a.in(I_WIN) + (size_t)layer * D * D_IN, D_IN, GCOL + r0, 32, kb * 64, 1024, (bf16_t*)(ws + WS_WG), 1024, r0, scr, F.lane); }
        else if (it < C3) { const int r = it - C2_, kb = r / 32, nb = r % 32, r0 = nb * 32, br = kb / 6, k0 = (kb % 6) * 64;
            const float* W = (br == 0 ? a.in(I_WPR) + (size_t)layer * 384 * D : br == 1 ? a.in(I_WPS) + (size_t)layer * 320 * D : a.in(I_WPF) + (size_t)layer * 320 * D);
            tr_item2(W, D, r0, 32, k0, br == 0 ? 384 : 320, (bf16_t*)(ws + WS_WP), YC_W, r0, br * 384 + k0, scr, F.lane); }
        else if (it < C4) { const int r = it - C3, kb = r / 32, nb = r % 32, r0 = nb * 32;
            tr_item(a.in(I_WOUT) + (size_t)layer * D * D, D, r0, 32, kb * 64, 1024, (bf16_t*)(ws + WS_WO), 1024, r0, scr, F.lane); }
        else if (it < C5) { const int r = it - C4, kb = r / 256, nb = r % 256, r0 = nb * 32, e = r0 >> 9, rr = r0 & 511, j = rr >> 8, q = rr & 255;
            const float* W = (q >= 128 ? a.in(I_MUP) : a.in(I_MGATE)) + ((size_t)layer * NEXP + e) * D * DEXP;
            tr_item(W, DEXP, j * 128 + (q & 127), 32, kb * 64, 1024, (bf16_t*)(ws + WS_WGU), 1024, r0, scr, F.lane); }
        else { const int r = it - C5, kb = r / 512, nb = r % 512, r0 = nb * 32, e = r0 >> 10;
            tr_item(a.in(I_MDOWN) + ((size_t)layer * NEXP + e) * DEXP * D, D, r0 & 1023, 32, kb * 64, 256, (bf16_t*)(ws + WS_WD), 256, r0, scr, F.lane); }
    }
}

__device__ __forceinline__ void add_y_row(f32x4 (&v)[4], const bf16_t* Y, int slot, int lane) {
    const u32x2* y = (const u32x2*)(Y + (size_t)slot * D) + lane;
#pragma unroll
    for (int j = 0; j < 4; ++j) { const u32x2 t = y[64 * j]; v[j].x += bf_lo(t.x); v[j].y += bf_hi(t.x); v[j].z += bf_lo(t.y); v[j].w += bf_hi(t.y); }
}
template <int MODE>
__device__ __forceinline__ void phase_norm(const ArgsL& a, Frame& F, int layer, const bool dry = false) {
    const int lane = F.lane;
    LAS float* wl = (LAS float*)F.lds;
    LAS int* lcnt = (LAS int*)(F.lds + 20 * 4096);
    unsigned char* ws = a.ws;
    if (MODE == 1) {
        const float* win = a.in(I_WIN) + (size_t)layer * D * D_IN;
        for (int idx = F.tid; idx < 5 * 1024; idx += NTHR) { const int j = idx >> 10, k = idx & 1023; wl[j * 1024 + k] = win[(size_t)k * D_IN + FCOL + j]; }
    }
    if (MODE == 2) {
        const float* wg = a.in(I_MWG) + (size_t)layer * D * 4; const float* we = a.in(I_MWE) + (size_t)layer * D * 16;
        for (int i4 = F.tid; i4 < 1024; i4 += NTHR) { const f32x4 f = *(const f32x4*)(wg + 4 * i4); wl[i4] = f.x; wl[1024 + i4] = f.y; wl[2048 + i4] = f.z; wl[3072 + i4] = f.w; }
        for (int i4 = F.tid; i4 < 4096; i4 += NTHR) { const int k = i4 >> 2, c = i4 & 3; const f32x4 f = *(const f32x4*)(we + 4 * i4); LAS float* d = wl + (4 + 4 * c) * 1024 + k;
            d[0] = f.x; d[1024] = f.y; d[2048] = f.z; d[3072] = f.w; }
        if (F.tid < 16) lcnt[F.tid] = 0;
    }
    __syncthreads();
    const int gw = F.bx * NWAVES + F.wave, NGW = gridDim.x * NWAVES;
    const float* gsrc = (MODE == 2 ? a.in(I_N2G) : a.in(I_N1G)) + layer * D;
    f32x4 gv[4];
#pragma unroll
    for (int j = 0; j < 4; ++j) gv[j] = (MODE == 0) ? (f32x4){0.f, 0.f, 0.f, 0.f} : *(const f32x4*)(gsrc + 4 * lane + 256 * j);
    bf16_t* A = A_PTR(a); bf16_t* HB = HB_PTR(a);
    const bf16_t* Y = (const bf16_t*)(ws + WS_Y);
    const int* SLOT = (const int*)(ws + WS_SLOT);
    constexpr bool COMB0 = (MODE == 0);
    const bool comb = COMB0 || (MODE == 1 && layer > 0);
    f32x4 vn[4]; u32x2 yan[4], ybn[4];
#pragma unroll
    for (int j = 0; j < 4; ++j) { vn[j] = (f32x4){0.f, 0.f, 0.f, 0.f}; yan[j] = (u32x2){0u, 0u}; ybn[j] = (u32x2){0u, 0u}; }
#define NRM_VALID(mm) ((mm) < M && ((mm) % T) - PADR >= (MODE == 0 ? NMETA : 0))
#define NRM_LOAD(mm, s0_, s1_) do { if (NRM_VALID(mm)) { const int bb_ = (mm) / T, ll_ = (mm) - bb_ * T - PADR; \
        if (MODE == 1 && layer == 0) { const float* src_ = (ll_ < NMETA) ? a.in(I_META) + (size_t)ll_ * D : a.in(I_X) + ((size_t)bb_ * SEQ + (ll_ - NMETA)) * D; \
            _Pragma("unroll") for (int j = 0; j < 4; ++j) vn[j] = *(const f32x4*)(src_ + 4 * lane + 256 * j); } \
        else { const u32x2* hs_ = (const u32x2*)(HB + (size_t)(mm) * D) + lane; \
            _Pragma("unroll") for (int j = 0; j < 4; ++j) { const u32x2 t_ = hs_[64 * j]; vn[j] = (f32x4){bf_lo(t_.x), bf_hi(t_.x), bf_lo(t_.y), bf_hi(t_.y)}; } } \
        if (comb) { const u32x2* y0_ = (const u32x2*)(Y + (size_t)(s0_) * D) + lane; const u32x2* y1_ = (const u32x2*)(Y + (size_t)(s1_) * D) + lane; \
            _Pragma("unroll") for (int j = 0; j < 4; ++j) { yan[j] = y0_[64 * j]; ybn[j] = y1_[64 * j]; } } } } while (0)
    int sa1 = 0, sb1 = 0, sa2 = 0, sb2 = 0;
    if (comb) { if (NRM_VALID(gw)) { sa1 = SLOT[2 * gw]; sb1 = SLOT[2 * gw + 1]; } if (NRM_VALID(gw + NGW)) { sa2 = SLOT[2 * (gw + NGW)]; sb2 = SLOT[2 * (gw + NGW) + 1]; } }
    NRM_LOAD(gw, sa1, sb1);
    for (int m = gw; m < M; m += NGW) {
        f32x4 v[4]; u32x2 ya[4], yb[4];
#pragma unroll
        for (int j = 0; j < 4; ++j) { v[j] = vn[j]; ya[j] = yan[j]; yb[j] = ybn[j]; }
        int sa3 = 0, sb3 = 0;
        if (comb && NRM_VALID(m + 2 * NGW)) { sa3 = SLOT[2 * (m + 2 * NGW)]; sb3 = SLOT[2 * (m + 2 * NGW) + 1]; }
        NRM_LOAD(m + NGW, sa2, sb2);
        sa2 = sa3; sb2 = sb3;
        const int b = m / T, p = m - b * T, l = p - PADR;
        if (l < 0) {
            if (MODE == 1 && !dry) {
                u32x2* o = (u32x2*)(A + (size_t)m * D) + lane;
#pragma unroll
                for (int j = 0; j < 4; ++j) o[64 * j] = (u32x2){0u, 0u};
                if (lane < 8) ((float*)(ws + WS_LOGF))[(size_t)m * 8 + lane] = 0.f;
            }
            continue;
        }
        if (MODE == 0 && l < NMETA) continue;
        if (comb) {
#pragma unroll
            for (int j = 0; j < 4; ++j) { v[j].x += bf_lo(ya[j].x) + bf_lo(yb[j].x); v[j].y += bf_hi(ya[j].x) + bf_hi(yb[j].x); v[j].z += bf_lo(ya[j].y) + bf_lo(yb[j].y); v[j].w += bf_hi(ya[j].y) + bf_hi(yb[j].y); }
        }
        if (MODE == 0 && !dry) { float* op = a.out + ((size_t)b * SEQ + (l - NMETA)) * D;
#pragma unroll
            for (int j = 0; j < 4; ++j) *(f32x4*)(op + 4 * lane + 256 * j) = v[j]; }
        if (MODE == 1 && !dry) { u32x2* hd = (u32x2*)(HB + (size_t)m * D) + lane;
#pragma unroll
            for (int j = 0; j < 4; ++j) hd[64 * j] = (u32x2){pk2(v[j].x, v[j].y), pk2(v[j].z, v[j].w)};
        }
        if (MODE == 0) continue;
        float ss = 0.f;
#pragma unroll
        for (int j = 0; j < 4; ++j) ss += (v[j].x * v[j].x + v[j].y * v[j].y) + (v[j].z * v[j].z + v[j].w * v[j].w);
        const float r = 1.0f / sqrtf(wave_sum(ss) * (1.0f / D) + 1e-6f);
#pragma unroll
        for (int j = 0; j < 4; ++j) v[j] = v[j] * r * gv[j];
        u32x2* o = (u32x2*)(A + (size_t)m * D) + lane;
        if (!dry) {
#pragma unroll
        for (int j = 0; j < 4; ++j) o[64 * j] = (u32x2){pk2(v[j].x, v[j].y), pk2(v[j].z, v[j].w)}; }
        else { float sink = v[0].x + v[1].y + v[2].z + v[3].w; asm volatile("" :: "v"(sink)); }
        if (MODE == 1) {
            float dsum[5];
#pragma unroll
            for (int q = 0; q < 5; ++q) { float d = 0.f;
#pragma unroll
                for (int j = 0; j < 4; ++j) { const f32x4 w = *(const LAS f32x4*)(wl + q * 1024 + 4 * lane + 256 * j); d += (v[j].x * w.x + v[j].y * w.y) + (v[j].z * w.z + v[j].w * w.w); }
                dsum[q] = wave_sum(d); }
            float mine = dsum[0];
            mine = lane == 1 ? dsum[1] : mine; mine = lane == 2 ? dsum[2] : mine; mine = lane == 3 ? dsum[3] : mine; mine = lane == 4 ? dsum[4] : mine;
            if (lane < 8 && !dry) { float lf = 0.f;
                if (lane < 5) { const float xx = mine + a.in(I_FB)[layer * 5 + lane]; lf = fminf(xx, 0.f) - fast_log(1.f + fast_exp(-fabsf(xx))); }
                ((float*)(ws + WS_LOGF))[(size_t)m * 8 + lane] = lf; }
        }
        if (MODE == 2) {
            float dp[20];
#pragma unroll
            for (int q = 0; q < 20; ++q) { float d = 0.f;
#pragma unroll
                for (int j = 0; j < 4; ++j) { const f32x4 w = *(const LAS f32x4*)(wl + q * 1024 + 4 * lane + 256 * j); d += (v[j].x * w.x + v[j].y * w.y) + (v[j].z * w.z + v[j].w * w.w); }
                dp[q] = d; }
            float sA[10], sB[5];
#pragma unroll
            for (int i = 0; i < 10; ++i) { auto sw = __builtin_amdgcn_permlane32_swap(__float_as_uint(dp[2 * i]), __float_as_uint(dp[2 * i + 1]), false, false); sA[i] = __uint_as_float(sw[0]) + __uint_as_float(sw[1]); }
#pragma unroll
            for (int i = 0; i < 5; ++i) { auto sw = __builtin_amdgcn_permlane16_swap(__float_as_uint(sA[2 * i]), __float_as_uint(sA[2 * i + 1]), false, false); sB[i] = allred16(__uint_as_float(sw[0]) + __uint_as_float(sw[1])); }
            LAS float* red = (LAS float*)(F.lds + 81920 + 256) + F.wave * 32;
            { const int rho = lane >> 4, vsel = ((rho & 1) << 1) | (rho >> 1);
              if ((lane & 15) == 0) {
#pragma unroll
                  for (int i = 0; i < 5; ++i) red[4 * i + vsel] = sB[i]; } }
            LDS_WAIT();
            float ds[20];
#pragma unroll
            for (int i = 0; i < 5; ++i) { const f32x4 t4 = *(const LAS f32x4*)(red + 4 * i); ds[4 * i] = t4.x; ds[4 * i + 1] = t4.y; ds[4 * i + 2] = t4.z; ds[4 * i + 3] = t4.w; }
            LDS_WAIT();
            const float* bg = a.in(I_MBG) + layer * 4; const float* be = a.in(I_MBE) + layer * 16;
            float lg0 = ds[0] + bg[0], lg1 = ds[1] + bg[1], lg2 = ds[2] + bg[2], lg3 = ds[3] + bg[3];
            int g = 0; float mx = lg0;
            if (lg1 > mx) { mx = lg1; g = 1; } if (lg2 > mx) { mx = lg2; g = 2; } if (lg3 > mx) { mx = lg3; g = 3; }
            const float den = fast_exp(lg0 - mx) + fast_exp(lg1 - mx) + fast_exp(lg2 - mx) + fast_exp(lg3 - mx);
            const float pgrp = 1.0f / den;
            float s0 = g == 0 ? ds[4] : g == 1 ? ds[8] : g == 2 ? ds[12] : ds[16];
            float s1 = g == 0 ? ds[5] : g == 1 ? ds[9] : g == 2 ? ds[13] : ds[17];
            float s2 = g == 0 ? ds[6] : g == 1 ? ds[10] : g == 2 ? ds[14] : ds[18];
            float s3 = g == 0 ? ds[7] : g == 1 ? ds[11] : g == 2 ? ds[15] : ds[19];
            s0 += be[g * 4 + 0]; s1 += be[g * 4 + 1]; s2 += be[g * 4 + 2]; s3 += be[g * 4 + 3];
            int i0 = 0; float v0 = s0;
            if (s1 > v0) { v0 = s1; i0 = 1; } if (s2 > v0) { v0 = s2; i0 = 2; } if (s3 > v0) { v0 = s3; i0 = 3; }
            int i1 = -1; float v1 = -3.0e38f;
            if (i0 != 0 && s0 > v1) { v1 = s0; i1 = 0; } if (i0 != 1 && s1 > v1) { v1 = s1; i1 = 1; } if (i0 != 2 && s2 > v1) { v1 = s2; i1 = 2; } if (i0 != 3 && s3 > v1) { v1 = s3; i1 = 3; }
            const float e1 = fast_exp(v1 - v0), pt0 = 1.0f / (1.0f + e1), pt1 = e1 * pt0;
            if (dry) { float sink = pgrp * pt0 + pt1; asm volatile("" :: "v"(sink)); }
            if (lane == 0 && !dry) {
                const int ea = g * 4 + i0, eb = g * 4 + i1;
                const int la = atomicAdd((int*)&lcnt[ea], 1), lb = atomicAdd((int*)&lcnt[eb], 1);
                int* tk = (int*)(ws + WS_TOK) + (size_t)m * 8;
                tk[0] = ea; tk[1] = eb; tk[2] = __float_as_int(pgrp * pt0); tk[3] = __float_as_int(pgrp * pt1); tk[4] = la; tk[5] = lb;
            }
        }
    }
    __syncthreads();
#undef NRM_LOAD
#undef NRM_VALID
    if (MODE == 2 && F.tid < 16 && !dry) {
        const int c = lcnt[F.tid];
        ((int*)(ws + WS_WGCNT))[F.bx * 16 + F.tid] = c;
        atomicAdd((int*)(ws + WS_CTL) + CW_ECNT + 64 * layer + F.tid, c);
    }
    __syncthreads();
}

__device__ __forceinline__ void phase_norm2(const ArgsL& a, Frame& F, int layer, const bool dry = false) {
    const int lane = F.lane;
    LAS float* wl = (LAS float*)F.lds;
    LAS int* lcnt = (LAS int*)(F.lds + 20 * 4096);
    unsigned char* ws = a.ws;
    {
        const float* wg = a.in(I_MWG) + (size_t)layer * D * 4; const float* we = a.in(I_MWE) + (size_t)layer * D * 16;
        for (int i4 = F.tid; i4 < 1024; i4 += NTHR) { const f32x4 f = *(const f32x4*)(wg + 4 * i4); wl[i4] = f.x; wl[1024 + i4] = f.y; wl[2048 + i4] = f.z; wl[3072 + i4] = f.w; }
        for (int i4 = F.tid; i4 < 4096; i4 += NTHR) { const int k = i4 >> 2, c = i4 & 3; const f32x4 f = *(const f32x4*)(we + 4 * i4); LAS float* d = wl + (4 + 4 * c) * 1024 + k;
            d[0] = f.x; d[1024] = f.y; d[2048] = f.z; d[3072] = f.w; }
        if (F.tid < 16) lcnt[F.tid] = 0;
    }
    __syncthreads();
    const int gw = F.bx * NWAVES + F.wave, NGW = gridDim.x * NWAVES;
    LAS float* gl = (LAS float*)(F.lds + 86016);
    LAS float* bl = (LAS float*)(F.lds + 90112);
    for (int i = F.tid; i < 1024; i += NTHR) gl[i] = a.in(I_N2G)[layer * D + i];
    if (F.tid < 4) bl[F.tid] = a.in(I_MBG)[layer * 4 + F.tid];
    if (F.tid >= 64 && F.tid < 80) bl[4 + F.tid - 64] = a.in(I_MBE)[layer * 16 + F.tid - 64];
    __syncthreads();
    bf16_t* A = A_PTR(a); const bf16_t* HB = HB_PTR(a);
    LAS float* red = (LAS float*)(F.lds + 81920 + 256) + F.wave * 96;
#define N2_VALID(mm) ((mm) < M && ((mm) % T) >= PADR)
    constexpr int NR = 2;
    for (int m0 = gw; m0 < M; m0 += NR * NGW) {
        f32x4 v[NR][4];
#pragma unroll
        for (int rr = 0; rr < NR; ++rr) { const int mm_ = m0 + rr * NGW;
            if (N2_VALID(mm_)) { const u32x2* hs_ = (const u32x2*)(HB + (size_t)mm_ * D) + lane;
#pragma unroll
                for (int j = 0; j < 4; ++j) { const u32x2 t = hs_[64 * j]; v[rr][j] = (f32x4){bf_lo(t.x), bf_hi(t.x), bf_lo(t.y), bf_hi(t.y)}; } }
            else {
#pragma unroll
                for (int j = 0; j < 4; ++j) v[rr][j] = (f32x4){0.f, 0.f, 0.f, 0.f}; } }
        float ss[NR];
#pragma unroll
        for (int rr = 0; rr < NR; ++rr) { float s_ = 0.f;
#pragma unroll
            for (int j = 0; j < 4; ++j) s_ += (v[rr][j].x * v[rr][j].x + v[rr][j].y * v[rr][j].y) + (v[rr][j].z * v[rr][j].z + v[rr][j].w * v[rr][j].w);
            ss[rr] = s_; }
#pragma unroll
        for (int rr = 0; rr < NR; ++rr) ss[rr] = wave_sum(ss[rr]);
#pragma unroll
        for (int rr = 0; rr < NR; ++rr) { const int mm = m0 + rr * NGW; const float r = 1.0f / sqrtf(ss[rr] * (1.0f / D) + 1e-6f);
#pragma unroll
            for (int j = 0; j < 4; ++j) v[rr][j] = v[rr][j] * r * *(const LAS f32x4*)(gl + 4 * lane + 256 * j);
            if (N2_VALID(mm) && !dry) { u32x2* o = (u32x2*)(A + (size_t)mm * D) + lane;
#pragma unroll
                for (int j = 0; j < 4; ++j) o[64 * j] = (u32x2){pk2(v[rr][j].x, v[rr][j].y), pk2(v[rr][j].z, v[rr][j].w)}; } }
        { const int rho = lane >> 4, vsel = ((rho & 1) << 1) | (rho >> 1);
#pragma unroll
          for (int qh = 0; qh < 2; ++qh) {
            float dp[NR][10];
#pragma unroll
            for (int q = 0; q < 10; ++q) { f32x4 w[4];
#pragma unroll
                for (int j = 0; j < 4; ++j) w[j] = *(const LAS f32x4*)(wl + (qh * 10 + q) * 1024 + 4 * lane + 256 * j);
#pragma unroll
                for (int rr = 0; rr < NR; ++rr) { float d = 0.f;
#pragma unroll
                    for (int j = 0; j < 4; ++j) d += (v[rr][j].x * w[j].x + v[rr][j].y * w[j].y) + (v[rr][j].z * w[j].z + v[rr][j].w * w[j].w);
                    dp[rr][q] = d; }
                if (q & 1) __builtin_amdgcn_sched_barrier(0); }
#pragma unroll
            for (int rr = 0; rr < NR; ++rr) { float sA[6], sB[3]; sA[5] = 0.f;
#pragma unroll
                for (int i = 0; i < 5; ++i) { auto sw = __builtin_amdgcn_permlane32_swap(__float_as_uint(dp[rr][2 * i]), __float_as_uint(dp[rr][2 * i + 1]), false, false); sA[i] = __uint_as_float(sw[0]) + __uint_as_float(sw[1]); }
#pragma unroll
                for (int k = 0; k < 3; ++k) { auto sw = __builtin_amdgcn_permlane16_swap(__float_as_uint(sA[2 * k]), __float_as_uint(sA[2 * k + 1]), false, false); sB[k] = allred16(__uint_as_float(sw[0]) + __uint_as_float(sw[1])); }
                if ((lane & 15) == 0) {
#pragma unroll
                    for (int k = 0; k < 3; ++k) red[rr * 24 + qh * 10 + 4 * k + vsel] = sB[k]; } }
            __builtin_amdgcn_sched_barrier(0);
          } }
        LDS_WAIT();
        if (lane < NR) {
            const int mm = m0 + lane * NGW;
            float ds[20];
#pragma unroll
            for (int i = 0; i < 5; ++i) { const f32x4 t4 = *(const LAS f32x4*)(red + lane * 24 + 4 * i); ds[4 * i] = t4.x; ds[4 * i + 1] = t4.y; ds[4 * i + 2] = t4.z; ds[4 * i + 3] = t4.w; }
            const float lg0 = ds[0] + bl[0], lg1 = ds[1] + bl[1], lg2 = ds[2] + bl[2], lg3 = ds[3] + bl[3];
            int g = 0; float mx = lg0;
            if (lg1 > mx) { mx = lg1; g = 1; } if (lg2 > mx) { mx = lg2; g = 2; } if (lg3 > mx) { mx = lg3; g = 3; }
            const float den = fast_exp(lg0 - mx) + fast_exp(lg1 - mx) + fast_exp(lg2 - mx) + fast_exp(lg3 - mx);
            const float pgrp = 1.0f / den;
            const f32x4 be4 = *(const LAS f32x4*)(bl + 4 + 4 * g);
            float s0 = (g == 0 ? ds[4] : g == 1 ? ds[8] : g == 2 ? ds[12] : ds[16]) + be4.x;
            float s1 = (g == 0 ? ds[5] : g == 1 ? ds[9] : g == 2 ? ds[13] : ds[17]) + be4.y;
            float s2 = (g == 0 ? ds[6] : g == 1 ? ds[10] : g == 2 ? ds[14] : ds[18]) + be4.z;
            float s3 = (g == 0 ? ds[7] : g == 1 ? ds[11] : g == 2 ? ds[15] : ds[19]) + be4.w;
            int i0 = 0; float v0 = s0;
            if (s1 > v0) { v0 = s1; i0 = 1; } if (s2 > v0) { v0 = s2; i0 = 2; } if (s3 > v0) { v0 = s3; i0 = 3; }
            int i1 = -1; float v1 = -3.0e38f;
            if (i0 != 0 && s0 > v1) { v1 = s0; i1 = 0; } if (i0 != 1 && s1 > v1) { v1 = s1; i1 = 1; } if (i0 != 2 && s2 > v1) { v1 = s2; i1 = 2; } if (i0 != 3 && s3 > v1) { v1 = s3; i1 = 3; }
            const float e1 = fast_exp(v1 - v0), pt0 = 1.0f / (1.0f + e1), pt1 = e1 * pt0;
            if (N2_VALID(mm) && !dry) {
                const int ea = g * 4 + i0, eb = g * 4 + i1;
                const int la = atomicAdd((int*)&lcnt[ea], 1), lb = atomicAdd((int*)&lcnt[eb], 1);
                int* tk = (int*)(ws + WS_TOK) + (size_t)mm * 8;
                tk[0] = ea; tk[1] = eb; tk[2] = __float_as_int(pgrp * pt0); tk[3] = __float_as_int(pgrp * pt1); tk[4] = la; tk[5] = lb;
            } else { float sink = pgrp * pt0 + pt1; asm volatile("" :: "v"(sink)); }
        }
        LDS_WAIT();
    }
#undef N2_VALID
    __syncthreads();
    if (F.tid < 16 && !dry) {
        const int c = lcnt[F.tid];
        ((int*)(ws + WS_WGCNT))[F.bx * 16 + F.tid] = c;
        atomicAdd((int*)(ws + WS_CTL) + CW_ECNT + 64 * layer + F.tid, c);
    }
    __syncthreads();
}

__device__ __forceinline__ void phase_route(const ArgsL& a, Frame& F, int layer) {
    unsigned char* ws = a.ws;
    LAS int* tbl = (LAS int*)F.lds;
    LAS int* part = tbl + 16;
    {
        const int e = F.tid & 15, q = F.tid >> 4; const int* wc = (const int*)(ws + WS_WGCNT); int acc = 0;
#pragma unroll
        for (int i = 0; i < 8; ++i) { const int w = q + 32 * i; if (w < (int)F.bx) acc += wc[w * 16 + e]; }
        part[q * 16 + e] = acc;
    }
    __syncthreads();
    if (F.tid < 16) {
        const int* cnt = (const int*)(ws + WS_CTL) + CW_ECNT + 64 * layer;
        int cv[16];
#pragma unroll
        for (int e = 0; e < 16; ++e) cv[e] = __hip_atomic_load(cnt + e, __ATOMIC_RELAXED, __HIP_MEMORY_SCOPE_AGENT);
        int base = 0;
#pragma unroll
        for (int e = 0; e < 16; ++e) if (e < F.tid) base += ((cv[e] + 255) >> 8) << 8;
#pragma unroll
        for (int q = 0; q < 32; ++q) base += part[q * 16 + F.tid];
        tbl[F.tid] = base; tbl[16 + 512 + F.tid] = __hip_atomic_load(cnt + F.tid, __ATOMIC_RELAXED, __HIP_MEMORY_SCOPE_AGENT);
    }
    __syncthreads();
    if (F.bx == 0) {
        int* s2t = (int*)(ws + WS_S2T);
        for (int e = 0; e < 16; ++e) { const int n = tbl[16 + 512 + e], b0 = tbl[e] + n, pad = (((n + 255) >> 8) << 8) - n;
            for (int i = F.tid; i < pad; i += NTHR) s2t[b0 + i] = 0; }
    }
    int* s2t = (int*)(ws + WS_S2T);
    for (int j = F.tid; j < 8 * ((M + 2047) / 2048); j += NTHR) {
        const int m = (j >> 3) * 2048 + (int)F.bx * 8 + (j & 7);
        if (m >= M) continue;
        const int b = m / T, p = m - b * T;
        if (p < PADR) continue;
        const int* tk_ = (const int*)(ws + WS_TOK) + (size_t)m * 8;
        const u32x4 t4 = *(const u32x4*)tk_; const u32x2 t2 = *(const u32x2*)(tk_ + 4);
        const int ea = (int)t4.x, eb = (int)t4.y, sa = tbl[ea] + (int)t2.x, sb = tbl[eb] + (int)t2.y;
        s2t[sa] = m; s2t[sb] = m;
        int* sl = (int*)(ws + WS_SLOT) + 2 * m; sl[0] = sa; sl[1] = sb;
        float* cw = (float*)(ws + WS_CWS); cw[sa] = __uint_as_float(t4.z); cw[sb] = __uint_as_float(t4.w);
    }
    __syncthreads();
}

#ifndef PR_STAGES
#define PR_STAGES 15
#endif
__device__ __forceinline__ void phase_prep(const ArgsL& a, Frame& F, int layer, const bool dry = false) {
    unsigned char* ws = a.ws;
    LAS float* xs = (LAS float*)F.lds;
    const int wave = F.wave, lane = F.lane, tid = F.tid;
    const int m0 = F.bx * 129;
    const bf16_t* USH = (const bf16_t*)(ws + WS_USH);
    bf16_t* QKV = (bf16_t*)(ws + WS_QKV);
    if (F.bx < 10 && (!dry || (PR_STAGES & 8))) {
        const int bh = F.bx, b = bh / 5, h = bh % 5;
        const float* LOGF = (const float*)(ws + WS_LOGF) + (size_t)(b * T + PADR) * 8 + h;
        float* kb = (float*)(ws + WS_KB2) + (size_t)bh * KBP;
        LAS float* wtot = (LAS float*)F.lds;
        float v[33];
        const int l0 = tid * 33;
#pragma unroll
        for (int i = 0; i < 33; ++i) v[i] = (l0 + i < LTOK) ? LOGF[(size_t)(l0 + i) * 8] : 0.f;
#pragma unroll
        for (int i = 1; i < 33; ++i) v[i] += v[i - 1];
        float incl = v[32];
#pragma unroll
        for (int o = 1; o < 64; o <<= 1) { const float t = __shfl_up(incl, o); if (lane >= o) incl += t; }
        if (lane == 63) wtot[wave] = incl;
        __syncthreads();
        float off = incl - v[32];
        for (int w = 0; w < wave; ++w) off += wtot[w];
#pragma unroll
        for (int i = 0; i < 33; ++i) if (l0 + i < LTOK && !dry) kb[PADR + l0 + i] = -(off + v[i]) * LOG2E;
        for (int p = tid; p < PADR; p += NTHR) kb[p] = 0.f;
        for (int p = T + tid; p < KBP; p += NTHR) kb[p] = 0.f;
        __syncthreads();
    }
    if (F.bx >= 16 && F.bx < 28) {
        unsigned* z = (unsigned*)(ws + WS_RW + ((size_t)(F.bx - 16) * LPADDED + LTOK) * 768);
        for (int i = tid; i < (LPADDED - LTOK) * 192; i += NTHR) z[i] = 0u;
    }
    const int r16 = lane & 15, q4 = lane >> 4, hh = wave < 6 ? wave : 0;
    bf16x8 bw[2][4][2];
    float cw0[4], ca0[4], ckk[4], cka[4], crk[4];
    {
        const float* WUp = a.in(I_WUP) + (size_t)layer * 64 * RW_W + hh * 64 + r16; const float* AUp = a.in(I_AUP) + (size_t)layer * 64 * RW_W + hh * 64 + r16;
#pragma unroll
        for (int mtx = 0; mtx < 2; ++mtx)
#pragma unroll
            for (int blk = 0; blk < 4; ++blk)
#pragma unroll
                for (int ks = 0; ks < 2; ++ks) { const float* p_ = (mtx ? AUp : WUp) + (size_t)(32 * ks + 8 * q4) * RW_W + blk * 16;
                    const float f0 = p_[0], f1 = p_[RW_W], f2 = p_[2 * RW_W], f3 = p_[3 * RW_W], f4 = p_[4 * RW_W], f5 = p_[5 * RW_W], f6 = p_[6 * RW_W], f7 = p_[7 * RW_W];
                    bw[mtx][blk][ks] = __builtin_bit_cast(bf16x8, (u32x4){pk2(f0, f1), pk2(f2, f3), pk2(f4, f5), pk2(f6, f7)}); }
#pragma unroll
        for (int blk = 0; blk < 4; ++blk) { const int ch = layer * RW_W + hh * 64 + blk * 16 + r16;
            cw0[blk] = a.in(I_W0)[ch]; ca0[blk] = a.in(I_A0)[ch]; ckk[blk] = a.in(I_KK)[ch]; cka[blk] = a.in(I_KA)[ch]; crk[blk] = a.in(I_RK)[ch]; }
    }
    const float* mu = a.in(I_MU) + layer * SHIFT_W;
    f32x4 gq4 = *(const f32x4*)(a.in(I_QG) + layer * 64 + (lane & 15) * 4) * C2; const f32x4 gk4 = *(const f32x4*)(a.in(I_KG) + layer * 64 + (lane & 15) * 4);
    _Float16* RW = (_Float16*)(ws + WS_RW);
    bf16_t* BN = (bf16_t*)(ws + WS_BN);
    for (int t0 = 0; t0 < 129; t0 += 16) {
        const int nt = (129 - t0) < 16 ? (129 - t0) : 16;
        if (!dry || (PR_STAGES & 1)) {
            int tid = F.tid; asm volatile("" : "+v"(tid));
            u32x4 uu4[5], pp4[5];
#pragma unroll
            for (int q5 = 0; q5 < 5; ++q5) { const int item = tid + q5 * NTHR; uu4[q5] = (u32x4){0u, 0u, 0u, 0u}; pp4[q5] = (u32x4){0u, 0u, 0u, 0u};
                if (item < nt * 160) { const int tok = item / 160, ch = item - tok * 160, m = m0 + t0 + tok;
                    uu4[q5] = *(const u32x4*)(USH + (size_t)m * SHIFT_W + ch * 8);
                    if (m > 0) pp4[q5] = *(const u32x4*)(USH + (size_t)(m - 1) * SHIFT_W + ch * 8); } }
#pragma unroll
            for (int q5 = 0; q5 < 5; ++q5) { const int item = tid + q5 * NTHR;
                if (item < nt * 160) { const int tok = item / 160, ch = item - tok * 160;
                    const u32x4 u = uu4[q5], pv = pp4[q5];
                    const f32x4 mu0 = *(const f32x4*)(mu + ch * 8), mu1 = *(const f32x4*)(mu + ch * 8 + 4);
                    float x[8];
                    { float uu, pp;
                      uu = bf_lo(u.x); pp = bf_lo(pv.x); x[0] = uu + (pp - uu) * mu0.x;  uu = bf_hi(u.x); pp = bf_hi(pv.x); x[1] = uu + (pp - uu) * mu0.y;
                      uu = bf_lo(u.y); pp = bf_lo(pv.y); x[2] = uu + (pp - uu) * mu0.z;  uu = bf_hi(u.y); pp = bf_hi(pv.y); x[3] = uu + (pp - uu) * mu0.w;
                      uu = bf_lo(u.z); pp = bf_lo(pv.z); x[4] = uu + (pp - uu) * mu1.x;  uu = bf_hi(u.z); pp = bf_hi(pv.z); x[5] = uu + (pp - uu) * mu1.y;
                      uu = bf_lo(u.w); pp = bf_lo(pv.w); x[6] = uu + (pp - uu) * mu1.z;  uu = bf_hi(u.w); pp = bf_hi(pv.w); x[7] = uu + (pp - uu) * mu1.w; }
                    if (ch >= 144 && ch < 152) {
#pragma unroll
                        for (int q = 0; q < 8; ++q) { const float e = fast_exp(-2.f * fabsf(x[q])); const float th = (1.f - e) / (1.f + e); x[q] = x[q] < 0.f ? -th : th; }
                    }
                    LAS f32x4* d = (LAS f32x4*)(xs + tok * SHIFT_W + ch * 8);
                    d[0] = (f32x4){x[0], x[1], x[2], x[3]}; d[1] = (f32x4){x[4], x[5], x[6], x[7]}; } }
        }
        __syncthreads();
        if (wave < 6) { if (!dry || (PR_STAGES & 2)) {
            f32x4 acc[2][4];
#pragma unroll
            for (int mtx = 0; mtx < 2; ++mtx) {
                bf16x8 af[2];
#pragma unroll
                for (int ks = 0; ks < 2; ++ks) { const LAS float* xp = xs + r16 * SHIFT_W + 1152 + 64 * mtx + 32 * ks + 8 * q4;
                    const f32x4 u0 = *(const LAS f32x4*)xp, u1 = *(const LAS f32x4*)(xp + 4);
                    af[ks] = __builtin_bit_cast(bf16x8, (u32x4){pk2(u0.x, u0.y), pk2(u0.z, u0.w), pk2(u1.x, u1.y), pk2(u1.z, u1.w)}); }
#pragma unroll
                for (int blk = 0; blk < 4; ++blk) { f32x4 c4 = {0.f, 0.f, 0.f, 0.f};
                    c4 = __builtin_amdgcn_mfma_f32_16x16x32_bf16(af[0], bw[mtx][blk][0], c4, 0, 0, 0);
                    c4 = __builtin_amdgcn_mfma_f32_16x16x32_bf16(af[1], bw[mtx][blk][1], c4, 0, 0, 0);
                    acc[mtx][blk] = c4; }
            }
#pragma unroll
            for (int i = 0; i < 4; ++i) {
                const int tok = 4 * q4 + i, m = m0 + t0 + tok, b = m / T, p = m - b * T, l = p - PADR;
                const bool ok = (tok < nt) && (l >= 0);
                const LAS float* xr = xs + (tok < 16 ? tok : 0) * SHIFT_W + hh * 64 + r16;
                float kkr[4], kpv[4], avv4[4], omv[4], rv4[4], vv4[4];
                float ssq = 0.f, cf = 0.f;
#pragma unroll
                for (int blk = 0; blk < 4; ++blk) {
                    const float wlv = cw0[blk] + acc[0][blk][i], alv = ca0[blk] + acc[1][blk][i];
                    const float r = xr[blk * 16], k = xr[384 + blk * 16], v = xr[768 + blk * 16];
                    const float logw = -softplus_f(-wlv) - 0.5f;
                    const float xw = fast_exp(logw);
                    omv[blk] = xw < 0.02f ? xw * (1.f - 0.5f * xw + xw * xw * (1.f / 6.f)) : 1.f - fast_exp(-xw);
                    const float av = 1.f / (1.f + fast_exp(-alv));
                    kkr[blk] = k * ckk[blk]; kpv[blk] = k * (1.f + (av - 1.f) * cka[blk]); avv4[blk] = av; rv4[blk] = r; vv4[blk] = v;
                    ssq += kkr[blk] * kkr[blk]; cf += r * kpv[blk] * crk[blk];
                }
                ssq = allred16(ssq); cf = allred16(cf);
                const float inv = 1.0f / fmaxf(sqrtf(ssq), 1e-12f);
                if (ok && !dry) {
                    _Float16* o = RW + ((size_t)(b * RW_H + hh) * LPADDED + l) * 384 + r16;
#pragma unroll
                    for (int blk = 0; blk < 4; ++blk) { const float kk = kkr[blk] * inv, bb = kk * avv4[blk];
                        o[blk * 16] = (_Float16)kk; o[64 + blk * 16] = (_Float16)(-omv[blk]); o[128 + blk * 16] = (_Float16)(-bb); o[192 + blk * 16] = (_Float16)kpv[blk];
                        o[256 + blk * 16] = (_Float16)rv4[blk]; o[320 + blk * 16] = (_Float16)vv4[blk];
                        BN[(size_t)m * RW_W + hh * 64 + blk * 16 + r16] = f2bf(cf * vv4[blk]); }
                } else { float sink = ssq + cf + inv + omv[0] + kpv[1]; asm volatile("" :: "v"(sink)); }
            } }
        }
        if (!dry || (PR_STAGES & 4)) {
            const int it4 = lane >> 4, e4 = lane & 15;
            u32x2 xv[5]; bf16_t* qp5[5]; bool okv[5];
#pragma unroll
            for (int ps = 0; ps < 5; ++ps) { const int item = (ps * 8 + wave) * 4 + it4, tok = item / 10, hq = item - tok * 10;
                const int m = m0 + t0 + tok, p = m % T;
                okv[ps] = (tok < nt) && (p >= PADR);
                qp5[ps] = QKV + (size_t)m * QKV_W + 960 + hq * 64 + e4 * 4;
                xv[ps] = okv[ps] ? *(const u32x2*)qp5[ps] : (u32x2){0u, 0u}; }
#pragma unroll
            for (int ps = 0; ps < 5; ++ps) { const int item = (ps * 8 + wave) * 4 + it4, hq = item % 10;
                const float x0 = bf_lo(xv[ps].x), x1 = bf_hi(xv[ps].x), x2 = bf_lo(xv[ps].y), x3 = bf_hi(xv[ps].y);
                const float ss = allred16((x0 * x0 + x1 * x1) + (x2 * x2 + x3 * x3));
                const float rs = 1.0f / sqrtf(ss * (1.0f / 64.f) + 1e-6f);
                const f32x4 gg = hq < 5 ? gq4 : gk4;
                const u32x2 w = {pk2(x0 * rs * gg.x, x1 * rs * gg.y), pk2(x2 * rs * gg.z, x3 * rs * gg.w)};
                if (okv[ps] && !dry) *(u32x2*)qp5[ps] = w; else asm volatile("" :: "v"(w.x), "v"(w.y)); }
        }
        __syncthreads();
    }
}


constexpr int SCH = 16;
static_assert(LTOK % SCH == 0, "whole chunks");
__device__ __forceinline__ void rwkv_scan(const ArgsL& a, Frame& F, int wgi, int dry = 0) {
    const int bh = wgi >> 4, q8 = wgi & 15, b = bh / RW_H, h = bh % RW_H;
    const int tid = F.tid, wave = F.wave, lane = F.lane;
    const unsigned char* rw = a.ws + WS_RW + (size_t)bh * LPADDED * 768;
    LAS float* ring = (LAS float*)F.lds;
    LAS float* ypart = (LAS float*)(F.lds + 49152);
    LAS unsigned char* stg = F.lds + 81920;
    bf16_t* y0 = (bf16_t*)(a.ws + WS_YCAT);
    constexpr int NCH = LTOK / SCH;
    const bool isld = (wave & 2) != 0; const int lw = (wave & 1) + ((wave >> 2) << 1), tl = lw * 64 + lane;
    float s0 = 0.f, s1 = 0.f;
    const int i32 = lane & 31, rsel = lane >> 5, rloc = 2 * wave + rsel;
#define RW_BAR() asm volatile("s_waitcnt lgkmcnt(0)\n\ts_barrier" ::: "memory")
#define RW_ISSUE(cc) do { const unsigned char* src_ = rw + (size_t)(cc) * SCH * 768 + (size_t)tl * 16; LAS unsigned char* d_ = stg + ((cc) & 3) * 12288 + lw * 1024; \
        _Pragma("unroll") for (int k_ = 0; k_ < 3; ++k_) __builtin_amdgcn_global_load_lds((const unsigned*)(src_ + k_ * 4096), (LAS unsigned*)(d_ + k_ * 4096), 16, 0, 0); } while (0)
#define RW_CONVERT(cc) do { const LAS unsigned char* s_ = stg + ((cc) & 3) * 12288 + tl * 16; LAS float* rb_ = ring + ((cc) & 1) * 6144; \
        _Pragma("unroll") for (int k_ = 0; k_ < 3; ++k_) { const int pc_ = tl + 256 * k_; const int t_ = pc_ / 48, q_ = pc_ - t_ * 48, vec_ = q_ >> 3, e0_ = (q_ & 7) * 8; \
            const u32x4 w_ = *(const LAS u32x4*)(s_ + k_ * 4096); \
            const f16x4 lo_ = __builtin_bit_cast(f16x4, (u32x2){w_.x, w_.y}), hi_ = __builtin_bit_cast(f16x4, (u32x2){w_.z, w_.w}); \
            const float f0 = (float)lo_.x, f1 = (float)lo_.y, f2 = (float)lo_.z, f3 = (float)lo_.w, f4 = (float)hi_.x, f5 = (float)hi_.y, f6 = (float)hi_.z, f7 = (float)hi_.w; \
            if (vec_ < 4) { LAS float* d_ = rb_ + t_ * 384 + (vec_ >> 1) * 128 + (e0_ >> 1) * 4 + (vec_ & 1) * 2; \
                *(LAS f32x2*)(d_) = (f32x2){f0, f1}; *(LAS f32x2*)(d_ + 4) = (f32x2){f2, f3}; *(LAS f32x2*)(d_ + 8) = (f32x2){f4, f5}; *(LAS f32x2*)(d_ + 12) = (f32x2){f6, f7}; } \
            else { LAS f32x4* d_ = (LAS f32x4*)(rb_ + t_ * 384 + (vec_ == 4 ? 256 : 320) + e0_); d_[0] = (f32x4){f0, f1, f2, f3}; d_[1] = (f32x4){f4, f5, f6, f7}; } } } while (0)
#define RW_STORE_Y(cc) do { if (tl < 32) { const LAS float* yb_ = ypart + ((cc) & 1) * 4096; const int t_ = tl >> 1, pr_ = tl & 1; const int l_ = (cc) * SCH + t_; \
        const LAS f32x4* q_ = (const LAS f32x4*)(yb_ + t_ * 128 + pr_ * 64); f32x4 sa_ = q_[0], sb_ = q_[8]; \
        _Pragma("unroll") for (int k_ = 1; k_ < 8; ++k_) { sa_ = sa_ + q_[k_]; sb_ = sb_ + q_[8 + k_]; } \
        *(unsigned*)(y0 + (size_t)(b * T + PADR + l_) * RW_W + h * 64 + q8 * 4 + 2 * pr_) = pk2((sa_.x + sa_.y) + (sa_.z + sa_.w), (sb_.x + sb_.y) + (sb_.z + sb_.w)); } } while (0)
    if (isld) {
        RW_ISSUE(0); asm volatile("s_waitcnt vmcnt(0)" ::: "memory"); RW_CONVERT(0);
        RW_ISSUE(1); RW_ISSUE(2);
    }
    RW_BAR();
    for (int c = 0; c < NCH; ++c) {
        if (isld) {
            if (c + 2 < NCH) { asm volatile("s_waitcnt vmcnt(3)" ::: "memory"); RW_CONVERT(c + 1); }
            else if (c + 1 < NCH) { asm volatile("s_waitcnt vmcnt(0)" ::: "memory"); RW_CONVERT(c + 1); }
            if (c > 0 && !dry) RW_STORE_Y(c - 1);
            if (c + 3 < NCH) RW_ISSUE(c + 3);
        } else if (dry != 1 && wave < 2) {
            const unsigned ba = (unsigned)(uintptr_t)(ring + (c & 1) * 6144) + i32 * 16, ca = (unsigned)(uintptr_t)(ring + (c & 1) * 6144) + 1024 + i32 * 8,
                           va = (unsigned)(uintptr_t)(ring + (c & 1) * 6144) + 1280 + (q8 * 4 + rloc) * 4, ya = (unsigned)(uintptr_t)(ypart + (c & 1) * 4096 + rloc * 32 + i32);
            f32x4 OA[4], OB[4]; f32x2 OC[4]; float OV[4];
            OC[3] = (f32x2){0.f, 0.f};
#define RW_FETCH(tt, sl) asm volatile("ds_read_b128 %0, %4 offset:%c7\n\tds_read_b128 %1, %4 offset:%c8\n\tds_read_b64 %2, %5 offset:%c7\n\tds_read_b32 %3, %6 offset:%c7" \
                : "=&v"(OA[sl]), "=&v"(OB[sl]), "=&v"(OC[sl]), "=&v"(OV[sl]) : "v"(ba), "v"(ca), "v"(va), "i"((tt) * 1536), "i"((tt) * 1536 + 512) : "memory")
            RW_FETCH(0, 0); RW_FETCH(1, 1);
            float p, p2, y;
#define RW_STEP(t, WAITN, YL1, YL2, YW, FETCHL) asm volatile( \
                "s_waitcnt lgkmcnt(" WAITN ")\n\t" \
                "v_mul_f32 %[p], %[s0], %[kk0]\n\t" \
                "v_fmac_f32 %[p], %[s1], %[kk1]\n\t" \
                YL1 "\n\t" YL2 "\n\t" \
                XL8 "\n\t" \
                "v_fmac_f32 %[s0], %[s0], %[om0]\n\t" \
                "v_fmac_f32 %[s1], %[s1], %[om1]\n\t" \
                XL4 "\n\t" \
                "v_fmac_f32 %[s0], %[vf], %[kv0]\n\t" \
                "v_fmac_f32 %[s1], %[vf], %[kv1]\n\t" \
                XL2 "\n\t" \
                YW "\n\t" \
                FETCHL \
                : [p] "=&v"(p), [p2] "=&v"(p2), [y] "=&v"(y), [s0] "+v"(s0), [s1] "+v"(s1), [nA] "=&v"(OA[((t) + 2) & 3]), [nB] "=&v"(OB[((t) + 2) & 3]), [nC] "=&v"(OC[((t) + 2) & 3]), [nV] "=&v"(OV[((t) + 2) & 3]) \
                : [kk0] "v"(OA[(t) & 3].x), [kk1] "v"(OA[(t) & 3].y), [om0] "v"(OA[(t) & 3].z), [om1] "v"(OA[(t) & 3].w), [bb0] "v"(OB[(t) & 3].x), [bb1] "v"(OB[(t) & 3].y), [kv0] "v"(OB[(t) & 3].z), [kv1] "v"(OB[(t) & 3].w), \
                  [vf] "v"(OV[(t) & 3]), [rp0] "v"(OC[((t) + 3) & 3].x), [rp1] "v"(OC[((t) + 3) & 3].y), [ba] "v"(ba), [ca] "v"(ca), [va] "v"(va), [ya] "v"(ya), \
                  [oa] "i"(((t) + 2) * 1536), [ob] "i"(((t) + 2) * 1536 + 512), [oy] "i"(((t) - 1) * 512) : "memory")
#define RW_YL1 "v_mul_f32 %[y], %[s0], %[rp0]"
#define RW_YL2 "v_fmac_f32 %[y], %[s1], %[rp1]"
#define RW_YW  "ds_write_b32 %[ya], %[y] offset:%c[oy]"
#define RW_NOP "s_nop 0"
#define RW_TAIL_F "ds_read_b128 %[nA], %[ba] offset:%c[oa]\n\t" \
                XL1 "\n\t" \
                "ds_read_b128 %[nB], %[ba] offset:%c[ob]\n\t" \
                "ds_read_b64 %[nC], %[ca] offset:%c[oa]\n\t" \
                "v_mov_b32 %[p2], %[p]\n\t" \
                "ds_read_b32 %[nV], %[va] offset:%c[oa]\n\t" \
                "s_nop 0\n\t" \
                XSW "\n\t" \
                "v_add_f32 %[p], %[p], %[p2]\n\t" \
                "v_fmac_f32 %[s0], %[p], %[bb0]\n\t" \
                "v_fmac_f32 %[s1], %[p], %[bb1]"
#define RW_TAIL_N "s_nop 0\n\t" \
                XL1 "\n\t" \
                "s_nop 1\n\t" \
                "v_mov_b32 %[p2], %[p]\n\t" \
                "s_nop 1\n\t" \
                XSW "\n\t" \
                "v_add_f32 %[p], %[p], %[p2]\n\t" \
                "v_fmac_f32 %[s0], %[p], %[bb0]\n\t" \
                "v_fmac_f32 %[s1], %[p], %[bb1]"
#define RW_ALLSTEPS() do { \
            RW_STEP(0, "4", RW_NOP, RW_NOP, RW_NOP, RW_TAIL_F); \
            RW_STEP(1, "4", RW_YL1, RW_YL2, RW_YW, RW_TAIL_F); \
            RW_STEP(2, "5", RW_YL1, RW_YL2, RW_YW, RW_TAIL_F);  RW_STEP(3, "5", RW_YL1, RW_YL2, RW_YW, RW_TAIL_F);  RW_STEP(4, "5", RW_YL1, RW_YL2, RW_YW, RW_TAIL_F); \
            RW_STEP(5, "5", RW_YL1, RW_YL2, RW_YW, RW_TAIL_F);  RW_STEP(6, "5", RW_YL1, RW_YL2, RW_YW, RW_TAIL_F);  RW_STEP(7, "5", RW_YL1, RW_YL2, RW_YW, RW_TAIL_F); \
            RW_STEP(8, "5", RW_YL1, RW_YL2, RW_YW, RW_TAIL_F);  RW_STEP(9, "5", RW_YL1, RW_YL2, RW_YW, RW_TAIL_F);  RW_STEP(10, "5", RW_YL1, RW_YL2, RW_YW, RW_TAIL_F); \
            RW_STEP(11, "5", RW_YL1, RW_YL2, RW_YW, RW_TAIL_F); RW_STEP(12, "5", RW_YL1, RW_YL2, RW_YW, RW_TAIL_F); RW_STEP(13, "5", RW_YL1, RW_YL2, RW_YW, RW_TAIL_F); \
            RW_STEP(14, "5", RW_YL1, RW_YL2, RW_YW, RW_TAIL_N); \
            RW_STEP(15, "1", RW_YL1, RW_YL2, RW_YW, RW_TAIL_N); \
            asm volatile("v_mul_f32 %[y], %[s0], %[r0]\n\tv_fmac_f32 %[y], %[s1], %[r1]\n\tds_write_b32 %[ya], %[y] offset:7680" : [y] "=&v"(y) : [s0] "v"(s0), [s1] "v"(s1), [r0] "v"(OC[3].x), [r1] "v"(OC[3].y), [ya] "v"(ya) : "memory"); \
 } while (0)
#ifdef SCAN_PROBE_NOXL
            if (dry == 2) {
#define XL8 "v_add_f32 %[p], %[p], %[p]"
#define XL4 "v_add_f32 %[p], %[p], %[p]"
#define XL2 "v_add_f32 %[p], %[p], %[p]"
#define XL1 "v_add_f32 %[p], %[p], %[p]"
#define XSW "v_add_f32 %[p], %[p], %[p2]"
                RW_ALLSTEPS();
#undef XL8
#undef XL4
#undef XL2
#undef XL1
#undef XSW
            } else
#endif
            {
#define XL8 "v_add_f32_dpp %[p], %[p], %[p] row_ror:8 row_mask:0xf bank_mask:0xf bound_ctrl:1"
#define XL4 "v_add_f32_dpp %[p], %[p], %[p] row_ror:4 row_mask:0xf bank_mask:0xf bound_ctrl:1"
#define XL2 "v_add_f32_dpp %[p], %[p], %[p] row_ror:2 row_mask:0xf bank_mask:0xf bound_ctrl:1"
#define XL1 "v_add_f32_dpp %[p], %[p], %[p] row_ror:1 row_mask:0xf bank_mask:0xf bound_ctrl:1"
#define XSW "v_permlane16_swap_b32 %[p], %[p2]"
                RW_ALLSTEPS();
            }
#undef RW_ALLSTEPS
#undef RW_STEP
#undef XL8
#undef XL4
#undef XL2
#undef XL1
#undef XSW
#undef RW_YL1
#undef RW_YL2
#undef RW_YW
#undef RW_NOP
#undef RW_TAIL_F
#undef RW_TAIL_N
#undef RW_FETCH
        }
        RW_BAR();
    }
    if (isld && !dry) RW_STORE_Y(NCH - 1);
    asm volatile("s_waitcnt vmcnt(0) lgkmcnt(0)\n\ts_barrier" ::: "memory");
#undef RW_STORE_Y
#undef RW_ISSUE
#undef RW_CONVERT
#undef RW_BAR
}

__device__ __forceinline__ int crow(int r, int hi) { return (r & 3) + 8 * (r >> 2) + 4 * hi; }
__device__ __forceinline__ void glds16(const void* gsrc, unsigned lds_dst) { unsigned keep;
    asm volatile("s_mov_b32 %0, m0\n\ts_mov_b32 m0, %2\n\ts_nop 0\n\tglobal_load_lds_dwordx4 %1, off\n\ts_mov_b32 m0, %0" : "=&s"(keep) : "v"(gsrc), "s"(lds_dst) : "memory"); }
__device__ __forceinline__ void glds4(const void* gsrc, unsigned lds_dst) { unsigned keep;
    asm volatile("s_mov_b32 %0, m0\n\ts_mov_b32 m0, %2\n\ts_nop 0\n\tglobal_load_lds_dword %1, off\n\ts_mov_b32 m0, %0" : "=&s"(keep) : "v"(gsrc), "s"(lds_dst) : "memory"); }
typedef LAS const char* lds_cptr;
constexpr int FX_K = 0, FX_V = 24576, FX_WS = 49152, FX_OST = 51200, FX_FLG = 83968, FX_KB = 84224  ;

__device__ __forceinline__ void fx_pv(f32x16* o, int vb, bf16x8 pa0, bf16x8 pa1, bf16x8 pa2, bf16x8 pa3) {
#pragma unroll
    for (int d0 = 0; d0 < 2; ++d0) { s16x4 lo[4], hi[4];
#pragma unroll
        for (int ks = 0; ks < 4; ++ks) {
            asm volatile("ds_read_b64_tr_b16 %0,%1 offset:%c2" : "=&v"(lo[ks]) : "v"(vb), "i"(d0 * 4096 + ks * 1024) : "memory");
            asm volatile("ds_read_b64_tr_b16 %0,%1 offset:%c2" : "=&v"(hi[ks]) : "v"(vb), "i"(d0 * 4096 + ks * 1024 + 512) : "memory"); }
        asm volatile("s_waitcnt lgkmcnt(0)" ::: "memory"); __builtin_amdgcn_sched_barrier(0);
#define FX_PK(k) (bf16x8){lo[k][0], lo[k][1], lo[k][2], lo[k][3], hi[k][0], hi[k][1], hi[k][2], hi[k][3]}
        o[d0] = __builtin_amdgcn_mfma_f32_32x32x16_bf16(pa0, FX_PK(0), o[d0], 0, 0, 0);
        o[d0] = __builtin_amdgcn_mfma_f32_32x32x16_bf16(pa1, FX_PK(1), o[d0], 0, 0, 0);
        o[d0] = __builtin_amdgcn_mfma_f32_32x32x16_bf16(pa2, FX_PK(2), o[d0], 0, 0, 0);
        o[d0] = __builtin_amdgcn_mfma_f32_32x32x16_bf16(pa3, FX_PK(3), o[d0], 0, 0, 0);
#undef FX_PK
    }
}
__device__ __forceinline__ float halves_max(float m) { auto rr = __builtin_amdgcn_permlane32_swap(__float_as_uint(m), __float_as_uint(m), false, false); return fmaxf(__uint_as_float(rr[0]), __uint_as_float(rr[1])); }
__device__ __forceinline__ float halves_sum(float m) { auto rr = __builtin_amdgcn_permlane32_swap(__float_as_uint(m), __float_as_uint(m), false, false); return __uint_as_float(rr[0]) + __uint_as_float(rr[1]); }

constexpr float ATT_EXIT = -40.0f;
template <int KIND>
__device__ __forceinline__ void attn_unit(const ArgsL& a, Frame& F, int b, int h, int qb, float bound) {
    const int lane = F.lane, wave = F.wave, r32 = lane & 31, hi = lane >> 5;
    LAS unsigned char* lds = F.lds;
    const bf16_t* QKV = (const bf16_t*)(a.ws + WS_QKV);
    const size_t rowbase = (size_t)b * T;
    const int p0 = qb * 256;
    constexpr int QC = KIND ? 0 : 960, KC = KIND ? 320 : 1280, VC = KIND ? 640 : 1600;
    const bf16_t* Qw = QKV + (rowbase + p0 + wave * 32) * QKV_W + QC + h * 64;
    const bf16_t* Kh = QKV + rowbase * QKV_W + KC + h * 64;
    const bf16_t* Vh = QKV + rowbase * QKV_W + VC + h * 64;
    const float* kbias = (const float*)(a.ws + WS_KB2) + (size_t)(b * FX_H + h) * KBP;
    const unsigned lds0 = (unsigned)(uintptr_t)lds;
    bf16x8 qr[4];
#pragma unroll
    for (int d0 = 0; d0 < 4; ++d0) qr[d0] = *(const bf16x8*)(Qw + (size_t)r32 * QKV_W + d0 * 16 + hi * 8);
    const int qp = p0 + wave * 32 + r32;
    const bool qvalid = (qp >= PADR) && (qp < T);
    const int plast = (p0 + 255) < (T - 1) ? (p0 + 255) : (T - 1);
    const int jlast = plast >> 6, jfirst = PADR >> 6;
    const int jw = (p0 + wave * 32 + 31) >> 6;
    const bf16_t* ksrc = Kh + (size_t)lane * QKV_W + wave * 8;
    const bf16_t* vsrc = Vh + (size_t)(16 * (wave & 3) + (lane >> 2)) * QKV_W + (wave >> 2) * 32 + (lane & 3) * 8;
    const unsigned kdst = lds0 + FX_K + wave * 1024, vdst = lds0 + FX_V + wave * 1024;
#define FX_DMA(j, slot) do { glds16(ksrc + (size_t)(j) * 64 * QKV_W, (unsigned)__builtin_amdgcn_readfirstlane(kdst + (slot) * 8192)); \
                             glds16(vsrc + (size_t)(j) * 64 * QKV_W, (unsigned)__builtin_amdgcn_readfirstlane(vdst + (slot) * 8192)); \
                             if (KIND == 0) glds4(kbias + 64 * (j) + lane, (unsigned)__builtin_amdgcn_readfirstlane(lds0 + FX_KB + (slot) * 2048 + wave * 256)); } while (0)
    const int vb0 = (int)(lds0 + FX_V) + ((lane >> 4) & 1) * 32 + (lane & 3) * 8 + (4 * hi + ((lane & 15) >> 2)) * 64;
    const lds_cptr kp0 = (lds_cptr)lds + FX_K + hi * 1024 + r32 * 16;
    LAS float* wsf = (LAS float*)(lds + FX_WS) + wave * 64;
    LAS float* flg = (LAS float*)(lds + FX_FLG);
    float m_run = KIND ? 0.f : -1.0e30f, l_run = 0.f;
    f32x16 o[2]; o[0] = f32x16{}; o[1] = f32x16{};
    asm volatile("" : "+v"(qr[0]), "+v"(qr[1]), "+v"(qr[2]), "+v"(qr[3]));
    int slot = 0;
    FX_DMA(jlast, 0);
    if (jlast > jfirst) FX_DMA(jlast - 1, 1);
    for (int j = jlast; j >= jfirst; --j) {
        if (j > jfirst) { if (KIND == 0) asm volatile("s_waitcnt vmcnt(3) lgkmcnt(0)\n\ts_barrier" ::: "memory"); else asm volatile("s_waitcnt vmcnt(2) lgkmcnt(0)\n\ts_barrier" ::: "memory"); }
        else asm volatile("s_waitcnt vmcnt(0) lgkmcnt(0)\n\ts_barrier" ::: "memory");
        if (j < jlast) {
            const LAS float* fl = flg + ((j + 1) & 1) * 16;
            const f32x4 fa = *(const LAS f32x4*)(fl), fb = *(const LAS f32x4*)(fl + 4);
            bool stop;
            if constexpr (KIND == 0) {
                const float mmin = fminf(fminf(fminf(fa.x, fa.y), fminf(fa.z, fa.w)), fminf(fminf(fb.x, fb.y), fminf(fb.z, fb.w)));
                stop = (bound + fl[8] - mmin) < ATT_EXIT;
            } else {
                const float mmax = fmaxf(fmaxf(fmaxf(fa.x, fa.y), fmaxf(fa.z, fa.w)), fmaxf(fmaxf(fb.x, fb.y), fmaxf(fb.z, fb.w)));
                stop = mmax < ATT_EXIT;
            }
            if (stop) break;
        }
        { const int s2 = slot + 2 >= 3 ? slot - 1 : slot + 2; if (j - 2 >= jfirst) FX_DMA(j - 2, s2); }
        if (j <= jw) {
            f32x16 s0v = f32x16{}, s1v = f32x16{};
            const lds_cptr kp = kp0 + slot * 8192;
#pragma unroll
            for (int d0 = 0; d0 < 4; ++d0) {
                const bf16x8 b0 = *(const LAS bf16x8*)(kp + d0 * 2048);
                const bf16x8 b1 = *(const LAS bf16x8*)(kp + d0 * 2048 + 512);
                s0v = __builtin_amdgcn_mfma_f32_32x32x16_bf16(b0, qr[d0], s0v, 0, 0, 0);
                s1v = __builtin_amdgcn_mfma_f32_32x32x16_bf16(b1, qr[d0], s1v, 0, 0, 0);
            }
            const bool edge = (64 * j + 63 >= p0 + wave * 32) || (64 * j < PADR);
            if constexpr (KIND == 0) {
                const LAS float* kbj = (const LAS float*)(lds + FX_KB + slot * 2048 + wave * 256) + 4 * hi;
#pragma unroll
                for (int g = 0; g < 4; ++g) { const f32x4 t0 = *(const LAS f32x4*)(kbj + 8 * g), t1 = *(const LAS f32x4*)(kbj + 32 + 8 * g);
                    s0v[4 * g] += t0.x; s0v[4 * g + 1] += t0.y; s0v[4 * g + 2] += t0.z; s0v[4 * g + 3] += t0.w;
                    s1v[4 * g] += t1.x; s1v[4 * g + 1] += t1.y; s1v[4 * g + 2] += t1.z; s1v[4 * g + 3] += t1.w; }
                if (edge) {
#pragma unroll
                    for (int r = 0; r < 16; ++r) { const int key = 64 * j + crow(r, hi);
                        if (key > qp || key < PADR) s0v[r] = -INFINITY;
                        if (key + 32 > qp || key + 32 < PADR) s1v[r] = -INFINITY; }
                }
                float rm = fmaxf(s0v[0], s1v[0]);
#pragma unroll
                for (int r = 1; r < 16; ++r) rm = fmaxf(rm, fmaxf(s0v[r], s1v[r]));
                rm = halves_max(rm);
                const float m_new = fmaxf(m_run, rm);
                const float f = __builtin_amdgcn_exp2f(m_run - m_new);
                m_run = m_new;
                float rs = 0.f;
#pragma unroll
                for (int r = 0; r < 16; ++r) { s0v[r] = __builtin_amdgcn_exp2f(s0v[r] - m_new); s1v[r] = __builtin_amdgcn_exp2f(s1v[r] - m_new); rs += s0v[r] + s1v[r]; }
                rs = halves_sum(rs);
                l_run = l_run * f + rs;
                if (!__all(f == 1.0f)) {
                    if (hi == 0) wsf[r32] = f;
                    LDS_WAIT();
#pragma unroll
                    for (int d_ = 0; d_ < 2; ++d_)
#pragma unroll
                        for (int r = 0; r < 16; ++r) o[d_][r] *= wsf[crow(r, hi)];
                }
            } else {
                f32x16 l0, l1;
#pragma unroll
                for (int r = 0; r < 16; ++r) {
                    const float z0 = s0v[r], z1 = s1v[r];
                    float a0 = -(fmaxf(z0, 0.f) + __builtin_amdgcn_logf(1.f + __builtin_amdgcn_exp2f(-fabsf(z0))));
                    float a1 = -(fmaxf(z1, 0.f) + __builtin_amdgcn_logf(1.f + __builtin_amdgcn_exp2f(-fabsf(z1))));
                    if (edge) { const int key = 64 * j + crow(r, hi);
                        if (key >= qp || key < PADR) { a0 = 0.f; s0v[r] = -INFINITY; }
                        if (key + 32 >= qp || key + 32 < PADR) { a1 = 0.f; s1v[r] = -INFINITY; } }
                    l0[r] = a0; l1[r] = a1;
                }
                float A[8], SA[9], SO[9];
#pragma unroll
                for (int g = 0; g < 4; ++g) { A[g] = (l0[4 * g] + l0[4 * g + 1]) + (l0[4 * g + 2] + l0[4 * g + 3]); A[4 + g] = (l1[4 * g] + l1[4 * g + 1]) + (l1[4 * g + 2] + l1[4 * g + 3]); }
                SA[8] = 0.f; SO[8] = 0.f;
#pragma unroll
                for (int g = 7; g >= 0; --g) SA[g] = A[g] + SA[g + 1];
#pragma unroll
                for (int g = 0; g < 8; ++g) { auto rr = __builtin_amdgcn_permlane32_swap(__float_as_uint(SA[g]), __float_as_uint(SA[g]), false, false); SO[g] = __uint_as_float(hi ? rr[0] : rr[1]); }
                const float R = m_run;
#pragma unroll
                for (int g = 0; g < 8; ++g) {
                    const float E = SA[g + 1] + (hi ? SO[g + 1] : SO[g]) + R;
                    if (g < 4) { float t = E;
                        s0v[4 * g + 3] = __builtin_amdgcn_exp2f(s0v[4 * g + 3] + l0[4 * g + 3] + t); t += l0[4 * g + 3];
                        s0v[4 * g + 2] = __builtin_amdgcn_exp2f(s0v[4 * g + 2] + l0[4 * g + 2] + t); t += l0[4 * g + 2];
                        s0v[4 * g + 1] = __builtin_amdgcn_exp2f(s0v[4 * g + 1] + l0[4 * g + 1] + t); t += l0[4 * g + 1];
                        s0v[4 * g + 0] = __builtin_amdgcn_exp2f(s0v[4 * g + 0] + l0[4 * g + 0] + t);
                    } else { const int q = g - 4; float t = E;
                        s1v[4 * q + 3] = __builtin_amdgcn_exp2f(s1v[4 * q + 3] + l1[4 * q + 3] + t); t += l1[4 * q + 3];
                        s1v[4 * q + 2] = __builtin_amdgcn_exp2f(s1v[4 * q + 2] + l1[4 * q + 2] + t); t += l1[4 * q + 2];
                        s1v[4 * q + 1] = __builtin_amdgcn_exp2f(s1v[4 * q + 1] + l1[4 * q + 1] + t); t += l1[4 * q + 1];
                        s1v[4 * q + 0] = __builtin_amdgcn_exp2f(s1v[4 * q + 0] + l1[4 * q + 0] + t);
                    }
                }
                m_run = R + SA[0] + SO[0];
            }
            u32x4 pw0, pw1, pw2, pw3;
            pw0 = (u32x4){pk2(s0v[0], s0v[1]), pk2(s0v[2], s0v[3]), pk2(s0v[4], s0v[5]), pk2(s0v[6], s0v[7])};
            pw1 = (u32x4){pk2(s0v[8], s0v[9]), pk2(s0v[10], s0v[11]), pk2(s0v[12], s0v[13]), pk2(s0v[14], s0v[15])};
            pw2 = (u32x4){pk2(s1v[0], s1v[1]), pk2(s1v[2], s1v[3]), pk2(s1v[4], s1v[5]), pk2(s1v[6], s1v[7])};
            pw3 = (u32x4){pk2(s1v[8], s1v[9]), pk2(s1v[10], s1v[11]), pk2(s1v[12], s1v[13]), pk2(s1v[14], s1v[15])};
            fx_pv(o, vb0 + slot * 8192, __builtin_bit_cast(bf16x8, pw0), __builtin_bit_cast(bf16x8, pw1), __builtin_bit_cast(bf16x8, pw2), __builtin_bit_cast(bf16x8, pw3));
        }
        float mm = qvalid ? m_run : (KIND ? -3.0e38f : 3.0e38f);
        if constexpr (KIND == 0) { mm = fminf(mm, dpp_f<0x128>(mm)); mm = fminf(mm, dpp_f<0x124>(mm)); mm = fminf(mm, dpp_f<0x122>(mm)); mm = fminf(mm, dpp_f<0x121>(mm));
            { auto sw = __builtin_amdgcn_permlane16_swap(__float_as_uint(mm), __float_as_uint(mm), false, false); mm = fminf(__uint_as_float(sw[0]), __uint_as_float(sw[1])); }
            { auto sw = __builtin_amdgcn_permlane32_swap(__float_as_uint(mm), __float_as_uint(mm), false, false); mm = fminf(__uint_as_float(sw[0]), __uint_as_float(sw[1])); } }
        else { mm = fmaxf(mm, dpp_f<0x128>(mm)); mm = fmaxf(mm, dpp_f<0x124>(mm)); mm = fmaxf(mm, dpp_f<0x122>(mm)); mm = fmaxf(mm, dpp_f<0x121>(mm));
            { auto sw = __builtin_amdgcn_permlane16_swap(__float_as_uint(mm), __float_as_uint(mm), false, false); mm = fmaxf(__uint_as_float(sw[0]), __uint_as_float(sw[1])); }
            { auto sw = __builtin_amdgcn_permlane32_swap(__float_as_uint(mm), __float_as_uint(mm), false, false); mm = fmaxf(__uint_as_float(sw[0]), __uint_as_float(sw[1])); } }
        if (lane == 0) { flg[(j & 1) * 16 + wave] = mm;
            if (KIND == 0 && wave == 0) flg[(j & 1) * 16 + 8] = *(const LAS float*)(lds + FX_KB + slot * 2048); }
        slot = slot == 2 ? 0 : slot + 1;
    }
    asm volatile("s_waitcnt vmcnt(0) lgkmcnt(0)\n\ts_barrier" ::: "memory");
    float rli[16];
    if constexpr (KIND == 0) {
        if (hi == 0) wsf[32 + r32] = l_run;
        LDS_WAIT();
#pragma unroll
        for (int r = 0; r < 16; ++r) rli[r] = __builtin_amdgcn_rcpf(wsf[32 + crow(r, hi)]);
    } else {
#pragma unroll
        for (int r = 0; r < 16; ++r) rli[r] = 1.0f;
    }
    bf16_t* Ow = (bf16_t*)(a.ws + WS_YCAT) + (rowbase + p0 + wave * 32) * YC_W + (KIND ? 384 : 768) + h * 64;
    {
        LAS bf16_t* stg = (LAS bf16_t*)(lds + FX_OST) + wave * 2048;
#pragma unroll
        for (int r = 0; r < 16; ++r) { const int orow = crow(r, hi);
#pragma unroll
            for (int d0 = 0; d0 < 2; ++d0) stg[orow * 64 + d0 * 32 + r32] = f2bf(o[d0][r] * rli[r]); }
        LDS_WAIT();
#pragma unroll
        for (int i = 0; i < 4; ++i) { const int row = i * 8 + (lane >> 3), ch = lane & 7; const u32x4 v = *(const LAS u32x4*)(stg + row * 64 + ch * 8);
            const int pr = p0 + wave * 32 + row;
            if (pr >= PADR && pr < T) *(u32x4*)(Ow + (size_t)row * YC_W + ch * 8) = v; }
    }
    asm volatile("s_waitcnt lgkmcnt(0)\n\ts_barrier" ::: "memory");
#undef FX_DMA
}


constexpr int CK = 64, NCK = 257, CKB = 40960, CB_ZF = 147456  ;
static_assert(LPADDED == CK * NCK, "padded steps");
__device__ __forceinline__ int swz(int row, int chunk) { return row * 128 + ((chunk ^ (row & 7)) << 4); }
__device__ __forceinline__ void ck_mm(f32x16& acc, LAS unsigned char* A, LAS unsigned char* Bt, int m0, int n0, int r32, int hi) {
#pragma unroll
    for (int ks = 0; ks < 4; ++ks) {
        const bf16x8 av = *(const LAS bf16x8*)(A + swz(m0 + r32, 2 * ks + hi));
        const bf16x8 bv = *(const LAS bf16x8*)(Bt + swz(n0 + r32, 2 * ks + hi));
        acc = __builtin_amdgcn_mfma_f32_32x32x16_bf16(av, bv, acc, 0, 0, 0);
    }
}
__device__ __forceinline__ void ck_store_t(LAS unsigned char* dst, const f32x16& acc, int m0, int n0, int r32, int hi) {
#pragma unroll
    for (int g = 0; g < 4; ++g) { const u32x2 w = {pk2(acc[4 * g], acc[4 * g + 1]), pk2(acc[4 * g + 2], acc[4 * g + 3])};
        *(LAS u32x2*)(dst + swz(n0 + r32, (m0 >> 3) + g) + hi * 8) = w; }
}
constexpr int CA_KAP = 0, CA_BET = 8192, CA_CHI = 16384, CA_RHO = 24576, CA_VMT = 32768, CA_BHT = 40960, CA_KHT = 49152, CA_AK = 57344, CA_RB = 65536, CA_RK = 73728,
              CA_AB = 81920  , CA_RHS = 98304  , CA_G64 = MISC_OFF + 2048  , CA_SCR = MISC_OFF + 4096  ;

#ifndef CA_STAGES
#define CA_STAGES 15
#endif
__device__ __forceinline__ void phase_chunkA(const ArgsL& a, Frame& F, const bool dry = false) {
    const int wave = F.wave;
    LAS unsigned char* L = F.lds;
    u32x4 pre6[6];
    for (int id = F.bx; id < 12 * NCK; id += (int)gridDim.x) {
        int tid = F.tid, lane, r32, hi;
#define CK_FRESH() do { asm volatile("" : "+v"(tid)); lane = tid & 63; r32 = lane & 31; hi = lane >> 5; } while (0)
        CK_FRESH();
        const int bh = id / NCK, c = id - bh * NCK;
        unsigned char* blk = a.ws + WS_RW + ((size_t)bh * LPADDED + (size_t)c * CK) * 768;
        const int blko = (int)(((size_t)bh * LPADDED + (size_t)c * CK) * 768);
        const __amdgpu_buffer_rsrc_t rwrs = __builtin_amdgcn_make_buffer_rsrc((void*)(a.ws + WS_RW), 0, (int)((size_t)12 * LPADDED * 768), 0x00020000);
        {
            if (id == F.bx) {
#pragma unroll
                for (int q6 = 0; q6 < 6; ++q6) pre6[q6] = *(const u32x4*)(blk + (size_t)(tid + q6 * NTHR) * 16);
            }
#pragma unroll
            for (int q6 = 0; q6 < 6; ++q6) *(LAS u32x4*)(L + CA_AB + (tid + q6 * NTHR) * 16) = pre6[q6];
            __syncthreads();
            const int k = tid & 63, tq = tid >> 6;
            const LAS _Float16* src = (const LAS _Float16*)(L + CA_AB) + (tq * 8) * 384 + k;
            float kk[8], w[8], bb[8], kp[8], rr[8], vv[8];
#pragma unroll
            for (int e = 0; e < 8; ++e) { kk[e] = (float)src[e * 384]; w[e] = 1.f + (float)src[e * 384 + 64]; bb[e] = -(float)src[e * 384 + 128];
                kp[e] = (float)src[e * 384 + 192]; rr[e] = (float)src[e * 384 + 256]; vv[e] = (float)src[e * 384 + 320]; }
            float g[8]; g[0] = w[0];
#pragma unroll
            for (int e = 1; e < 8; ++e) g[e] = g[e - 1] * w[e];
            LAS float* scr = (LAS float*)(L + CA_SCR);
            scr[tq * 64 + k] = g[7];
            __syncthreads();
            {
                const int idn = id + (int)gridDim.x;
                if (idn < 12 * NCK) { const int bhn = idn / NCK, cn = idn - bhn * NCK; const unsigned char* bn_ = a.ws + WS_RW + ((size_t)bhn * LPADDED + (size_t)cn * CK) * 768;
#pragma unroll
                    for (int q6 = 0; q6 < 6; ++q6) pre6[q6] = *(const u32x4*)(bn_ + (size_t)(tid + q6 * NTHR) * 16); }
            }
            float pre = 1.f, tot = 1.f;
#pragma unroll
            for (int q = 0; q < 8; ++q) { const float s = scr[q * 64 + k]; if (q < tq) pre *= s; tot *= s; }
            if (tq == 0) ((LAS float*)(L + CA_G64))[k] = tot;
            unsigned bh4[4], kh4[4], vm4[4];
            float Gp = pre;
#pragma unroll
            for (int e = 0; e < 8; ++e) {
                const int t = tq * 8 + e; const float G = pre * g[e], iG = __builtin_amdgcn_rcpf(G);
                const float kap = kk[e] * Gp, bet = bb[e] * iG, chi = kp[e] * iG, rho = rr[e] * G;
                const int o = swz(t, k >> 3) + (k & 7) * 2;
                *(LAS unsigned short*)(L + CA_KAP + o) = f2bf(kap); *(LAS unsigned short*)(L + CA_BET + o) = f2bf(bet);
                *(LAS unsigned short*)(L + CA_CHI + o) = f2bf(chi); *(LAS unsigned short*)(L + CA_RHO + o) = f2bf(rho);
                ((LAS float*)(L + CA_RHS))[t * 128 + k] = kap;
                const float bhv = bet * tot, khv = chi * tot;
                if (e & 1) { bh4[e >> 1] |= (unsigned)f2bf(bhv) << 16; kh4[e >> 1] |= (unsigned)f2bf(khv) << 16; vm4[e >> 1] |= (unsigned)f2bf(vv[e]) << 16; }
                else { bh4[e >> 1] = f2bf(bhv); kh4[e >> 1] = f2bf(khv); vm4[e >> 1] = f2bf(vv[e]); }
                Gp = G;
            }
            *(LAS u32x4*)(L + CA_BHT + swz(k, tq)) = (u32x4){bh4[0], bh4[1], bh4[2], bh4[3]};
            *(LAS u32x4*)(L + CA_KHT + swz(k, tq)) = (u32x4){kh4[0], kh4[1], kh4[2], kh4[3]};
            *(LAS u32x4*)(L + CA_VMT + swz(k, tq)) = (u32x4){vm4[0], vm4[1], vm4[2], vm4[3]};
        }
        __syncthreads();
        CK_FRESH();
        if (!dry || (CA_STAGES & 2)) {
            const int p = wave & 3, nb = wave >> 2;
            LAS unsigned char* Am = L + ((p & 1) ? CA_CHI : CA_BET);
            LAS unsigned char* Bm = L + ((p & 2) ? CA_RHO : CA_KAP);
#pragma unroll
            for (int mb = 0; mb < 2; ++mb) {
                f32x16 acc = f32x16{};
                if (!(mb == 1 && nb == 0)) ck_mm(acc, Am, Bm, mb * 32, nb * 32, r32, hi);
                const int t = nb * 32 + r32;
#pragma unroll
                for (int i = 0; i < 16; ++i) { const int j = mb * 32 + crow(i, hi); const bool keep = (p & 2) ? (j <= t) : (j < t); if (!keep) acc[i] = 0.f; }
                if (p == 0) {
#pragma unroll
                    for (int gq = 0; gq < 4; ++gq) { LAS float* ab_ = (LAS float*)(L + CA_AB) + t * 64 + (mb * 8 + 2 * gq + hi);
                        ab_[0] = acc[4 * gq]; ab_[16] = acc[4 * gq + 1]; ab_[32] = acc[4 * gq + 2]; ab_[48] = acc[4 * gq + 3]; }
                } else ck_store_t(L + (p == 1 ? CA_AK : p == 2 ? CA_RB : CA_RK), acc, mb * 32, nb * 32, r32, hi);
            }
        }
        __syncthreads();
        CK_FRESH();
        if (wave < 4 && (!dry || (CA_STAGES & 2))) {
            const int mb = wave >> 1, nb = wave & 1;
            f32x16 acc = f32x16{};
            ck_mm(acc, L + CA_AK, L + CA_VMT, mb * 32, nb * 32, r32, hi);
#pragma unroll
            for (int i = 0; i < 16; ++i) ((LAS float*)(L + CA_RHS))[(mb * 32 + crow(i, hi)) * 128 + 64 + nb * 32 + r32] = acc[i];
        }
        __syncthreads();
        CK_FRESH();
        if (!dry || (CA_STAGES & 4)) {
            const int col = tid >> 2, p = tid & 3;
            unsigned abv = (unsigned)(uintptr_t)(L + CA_AB) + p * 64; asm volatile("" : "+v"(abv));
            const LAS float* ab = (const LAS float*)(uintptr_t)abv;
            const LAS float* rhs = (const LAS float*)(L + CA_RHS) + col;
            float xo[16];
#pragma unroll
            for (int i = 0; i < 16; ++i) xo[i] = 0.f;
#pragma unroll
            for (int tg = 0; tg < 64; tg += 4) {
                f32x4 av[4][4]; float rv[4];
#pragma unroll
                for (int r = 0; r < 4; ++r) { rv[r] = rhs[(tg + r) * 128];
#pragma unroll
                    for (int i4 = 0; i4 < (tg + r + 15) / 16; ++i4) av[r][i4] = *(const LAS f32x4*)(ab + (tg + r) * 64 + 4 * i4); }
#pragma unroll
                for (int r = 0; r < 4; ++r) { const int t = tg + r;
                    float s0 = (p == 0) ? rv[r] : 0.f, s1 = 0.f;
#pragma unroll
                    for (int i4 = 0; i4 < (t + 15) / 16; ++i4) {
                        s0 -= av[r][i4].x * xo[4 * i4]; s1 -= av[r][i4].y * xo[4 * i4 + 1]; s0 -= av[r][i4].z * xo[4 * i4 + 2]; s1 -= av[r][i4].w * xo[4 * i4 + 3]; }
                    float sx = s0 + s1;
                    sx += dpp_f<0xB1>(sx);
                    sx += dpp_f<0x4E>(sx);
                    if ((t & 3) == p) xo[t >> 2] = sx;
                    asm volatile("" : "+v"(xo[t >> 2]));
                }
                __builtin_amdgcn_sched_barrier(0);
            }
            LAS unsigned char* dst = L + (col < 64 ? CA_KAP : CA_BET);
            const int rowc = col & 63;
#pragma unroll
            for (int i = 0; i < 16; ++i) { const int tt = 4 * i + p; *(LAS unsigned short*)(dst + swz(rowc, tt >> 3) + (tt & 7) * 2) = f2bf(-xo[i]); }
        }
        __syncthreads();
        CK_FRESH();
        if (!dry || (CA_STAGES & 8)) {
            const int ty = wave >> 1;
            LAS unsigned char* nW1 = L + CA_KAP; LAS unsigned char* nW2 = L + CA_BET;
#pragma unroll
            for (int qq = 0; qq < 2; ++qq) {
                const int q = (wave & 1) * 2 + qq, qa = q >> 1, qb = q & 1;
                f32x16 acc = f32x16{};
                if (ty == 0) {
                    const int t = qa * 32 + r32;
#pragma unroll
                    for (int gq = 0; gq < 4; ++gq) { const u32x2 rv = *(const LAS u32x2*)(L + CA_RHO + swz(t, qb * 4 + gq) + hi * 8);
                        acc[4 * gq] = bf_lo(rv.x); acc[4 * gq + 1] = bf_hi(rv.x); acc[4 * gq + 2] = bf_lo(rv.y); acc[4 * gq + 3] = bf_hi(rv.y); }
                    ck_mm(acc, nW1, L + CA_RB, qb * 32, qa * 32, r32, hi);
                } else if (ty == 1) {
                    ck_mm(acc, nW1, L + CA_BHT, qb * 32, qa * 32, r32, hi);
                    if (qa == qb) { const float g64 = ((const LAS float*)(L + CA_G64))[qa * 32 + r32];
#pragma unroll
                        for (int i = 0; i < 16; ++i) if (crow(i, hi) == r32) acc[i] += g64; }
                } else if (ty == 2) {
                    ck_mm(acc, L + CA_KHT, L + CA_VMT, qb * 32, qa * 32, r32, hi);
                    ck_mm(acc, L + CA_BHT, nW2, qb * 32, qa * 32, r32, hi);
                } else {
                    ck_mm(acc, L + CA_VMT, L + CA_RK, qa * 32, qb * 32, r32, hi);
                    ck_mm(acc, nW2, L + CA_RB, qa * 32, qb * 32, r32, hi);
                }
                if (dry) { float sink = acc[0] + acc[5] + acc[10] + acc[15]; asm volatile("" :: "v"(sink)); }
                else if (ty < 2) {
                    const int o = blko + (ty == 0 ? 8192 : 0) + ((qa * 2 + qb) * 2) * 1024 + lane * 16;
#pragma unroll
                    for (int ks = 0; ks < 2; ++ks)
                        __builtin_amdgcn_raw_buffer_store_b128((u32x4){pk2(acc[8 * ks], acc[8 * ks + 1]), pk2(acc[8 * ks + 2], acc[8 * ks + 3]), pk2(acc[8 * ks + 4], acc[8 * ks + 5]), pk2(acc[8 * ks + 6], acc[8 * ks + 7])}, rwrs, o + ks * 1024, 0, 16);
                } else if (ty == 2) {
                    const int o = blko + 16384 + (qa * 2 + qb) * 4096 + lane * 16;
#pragma unroll
                    for (int g = 0; g < 4; ++g) __builtin_amdgcn_raw_buffer_store_b128((u32x4){__float_as_uint(acc[4 * g]), __float_as_uint(acc[4 * g + 1]), __float_as_uint(acc[4 * g + 2]), __float_as_uint(acc[4 * g + 3])}, rwrs, o + g * 1024, 0, 16);
                } else {
                    const int o = blko + 32768 + (qa * 2 + qb) * 2048 + lane * 8;
#pragma unroll
                    for (int g = 0; g < 4; ++g) __builtin_amdgcn_raw_buffer_store_b64((u32x2){pk2(acc[4 * g], acc[4 * g + 1]), pk2(acc[4 * g + 2], acc[4 * g + 3])}, rwrs, o + g * 512, 0, 16);
                }
            }
        }
        __syncthreads();
    }
}

__device__ __forceinline__ void rwkv_chunkB(const ArgsL& a, Frame& F, int bh) {
    const int lane = F.lane, wave = F.wave, r32 = lane & 31, hi = lane >> 5;
    const int b = bh / RW_H, h = bh % RW_H;
    LAS unsigned char* L = F.lds;
    const unsigned char* base = a.ws + WS_RW + (size_t)bh * LPADDED * 768;
    bf16_t* y0 = (bf16_t*)(a.ws + WS_YCAT);
    const bool isld = (wave & 2) != 0; const int lw = (wave & 1) + ((wave >> 2) << 1);
    LAS unsigned char* yimg0 = L + 3 * CKB; LAS unsigned char* yimg1 = L + MISC_OFF + 8192;
    LAS unsigned char* zfb = L + CB_ZF;
#define CB_ISSUE(cc) do { const unsigned char* s_ = base + (size_t)(cc) * CK * 768 + (size_t)lw * 1024 + lane * 16; LAS unsigned char* d_ = L + ((cc) % 3) * CKB + lw * 1024; \
        _Pragma("unroll") for (int r_ = 0; r_ < 10; ++r_) __builtin_amdgcn_global_load_lds((const unsigned*)(s_ + r_ * 4096), (LAS unsigned*)(d_ + r_ * 4096), 16, 0, 0); } while (0)
#define CB_YOUT(cc) do { const LAS unsigned char* im_ = ((cc) & 1) ? yimg1 : yimg0; \
        _Pragma("unroll") for (int r_ = 0; r_ < 8; ++r_) { const int t_ = r_ * 8 + (lane >> 3), l_ = (cc) * CK + t_; const u32x4 v_ = *(const LAS u32x4*)(im_ + t_ * 128 + (((lane & 7) ^ (t_ & 7)) * 16)); \
            if (l_ < LTOK) *(u32x4*)(y0 + (size_t)(b * T + PADR + l_) * YC_W + h * 64 + (lane & 7) * 8) = v_; } } while (0)
    if (isld) { CB_ISSUE(0); CB_ISSUE(1); asm volatile("s_waitcnt vmcnt(10)" ::: "memory"); }
    bf16x8 zf[2][2];
#pragma unroll
    for (int q = 0; q < 4; ++q) zf[q >> 1][q & 1] = bf16x8{};
    if (wave < 2) {
#pragma unroll
        for (int q = 0; q < 4; ++q) *(LAS bf16x8*)(zfb + wave * 4096 + q * 1024 + lane * 16) = bf16x8{};
    }
    asm volatile("s_waitcnt lgkmcnt(0)\n\ts_barrier" ::: "memory");
    for (int c = 0; c < NCK; ++c) {
        const LAS unsigned char* S = L + (c % 3) * CKB;
        if (wave < 2) {
            const int vb = wave;
            f32x16 N0, N1;
            { const LAS unsigned char* n0 = S + 16384 + (vb * 2 + 0) * 4096 + lane * 16; const LAS unsigned char* n1 = S + 16384 + (vb * 2 + 1) * 4096 + lane * 16;
#pragma unroll
              for (int g = 0; g < 4; ++g) { const f32x4 u0 = *(const LAS f32x4*)(n0 + g * 1024), u1 = *(const LAS f32x4*)(n1 + g * 1024);
                  N0[4 * g] = u0.x; N0[4 * g + 1] = u0.y; N0[4 * g + 2] = u0.z; N0[4 * g + 3] = u0.w; N1[4 * g] = u1.x; N1[4 * g + 1] = u1.y; N1[4 * g + 2] = u1.z; N1[4 * g + 3] = u1.w; } }
#pragma unroll
            for (int kb2 = 0; kb2 < 2; ++kb2)
#pragma unroll
                for (int ks = 0; ks < 2; ++ks) {
                    const bf16x8 m0 = *(const LAS bf16x8*)(S + ((0 * 2 + kb2) * 2 + ks) * 1024 + lane * 16);
                    const bf16x8 m1 = *(const LAS bf16x8*)(S + ((1 * 2 + kb2) * 2 + ks) * 1024 + lane * 16);
                    N0 = __builtin_amdgcn_mfma_f32_32x32x16_bf16(m0, zf[kb2][ks], N0, 0, 0, 0);
                    N1 = __builtin_amdgcn_mfma_f32_32x32x16_bf16(m1, zf[kb2][ks], N1, 0, 0, 0);
                }
            LAS unsigned char* zo = zfb + ((c + 1) & 1) * 8192 + vb * 4096 + lane * 16;
#pragma unroll
            for (int ks = 0; ks < 2; ++ks) {
                zf[0][ks] = __builtin_bit_cast(bf16x8, (u32x4){pk2(N0[8 * ks], N0[8 * ks + 1]), pk2(N0[8 * ks + 2], N0[8 * ks + 3]), pk2(N0[8 * ks + 4], N0[8 * ks + 5]), pk2(N0[8 * ks + 6], N0[8 * ks + 7])});
                zf[1][ks] = __builtin_bit_cast(bf16x8, (u32x4){pk2(N1[8 * ks], N1[8 * ks + 1]), pk2(N1[8 * ks + 2], N1[8 * ks + 3]), pk2(N1[8 * ks + 4], N1[8 * ks + 5]), pk2(N1[8 * ks + 6], N1[8 * ks + 7])});
                *(LAS bf16x8*)(zo + (0 * 2 + ks) * 1024) = zf[0][ks]; *(LAS bf16x8*)(zo + (1 * 2 + ks) * 1024) = zf[1][ks];
            }
        } else if (isld) {
            if (wave == 6 && c > 0) CB_YOUT(c - 1);
            if (c + 2 < NCK) CB_ISSUE(c + 2);
            if (wave < 4) {
                const int vb = wave - 2;
                LAS unsigned char* yim = (c & 1) ? yimg1 : yimg0;
                const LAS unsigned char* zs = zfb + (c & 1) * 8192 + vb * 4096 + lane * 16;
                bf16x8 zq[2][2];
#pragma unroll
                for (int q = 0; q < 4; ++q) zq[q >> 1][q & 1] = *(const LAS bf16x8*)(zs + q * 1024);
#pragma unroll
                for (int tb = 0; tb < 2; ++tb) {
                    f32x16 acc;
                    const LAS unsigned char* yt = S + 32768 + (vb * 2 + tb) * 2048 + lane * 8;
#pragma unroll
                    for (int g = 0; g < 4; ++g) { const u32x2 w = *(const LAS u32x2*)(yt + g * 512); acc[4 * g] = bf_lo(w.x); acc[4 * g + 1] = bf_hi(w.x); acc[4 * g + 2] = bf_lo(w.y); acc[4 * g + 3] = bf_hi(w.y); }
#pragma unroll
                    for (int kb2 = 0; kb2 < 2; ++kb2)
#pragma unroll
                        for (int ks = 0; ks < 2; ++ks) { const bf16x8 pa = *(const LAS bf16x8*)(S + 8192 + ((tb * 2 + kb2) * 2 + ks) * 1024 + lane * 16);
                            acc = __builtin_amdgcn_mfma_f32_32x32x16_bf16(zq[kb2][ks], pa, acc, 0, 0, 0); }
                    const int t = tb * 32 + r32;
#pragma unroll
                    for (int g = 0; g < 4; ++g) { const u32x2 w = {pk2(acc[4 * g], acc[4 * g + 1]), pk2(acc[4 * g + 2], acc[4 * g + 3])};
                        *(LAS u32x2*)(yim + t * 128 + (((vb * 8 + 2 * g + hi) ^ (2 * (t & 7))) * 8)) = w; }
                }
            }
            if (c + 2 < NCK) asm volatile("s_waitcnt vmcnt(10)" ::: "memory"); else asm volatile("s_waitcnt vmcnt(0)" ::: "memory");
        }
        asm volatile("s_waitcnt lgkmcnt(0)\n\ts_barrier" ::: "memory");
    }
    if (wave == 6) CB_YOUT(NCK - 1);
    asm volatile("s_waitcnt vmcnt(0) lgkmcnt(0)\n\ts_barrier" ::: "memory");
#undef CB_ISSUE
#undef CB_YOUT
}

constexpr int N_FX_UNITS = 65 * 10, N_SB_UNITS = 65 * 10, N_RW_WG = 192;
#ifndef REP_SCAN
#define REP_SCAN 1
#endif
#ifndef REP_SCAN_DRY
#define REP_SCAN_DRY 0
#endif
#ifndef REP_FOX
#define REP_FOX 1
#endif
#ifndef REP_SB
#define REP_SB 1
#endif
__device__ __forceinline__ void wg_publish(unsigned* cnt) {
    asm volatile("s_waitcnt vmcnt(0)" ::: "memory");
    __syncthreads();
    if (threadIdx.x == 0) __hip_atomic_fetch_add(cnt, 1u, __ATOMIC_RELAXED, __HIP_MEMORY_SCOPE_AGENT);
}
__device__ __forceinline__ void wg_wait(const unsigned* cnt, unsigned n) {
    if (threadIdx.x == 0) { unsigned polls = 0;
        while (__hip_atomic_load(cnt, __ATOMIC_RELAXED, __HIP_MEMORY_SCOPE_AGENT) < n) { if (++polls > (1u << 18)) break; __builtin_amdgcn_s_sleep(2); }
        __builtin_amdgcn_fence(__ATOMIC_ACQUIRE, "agent"); asm volatile("s_waitcnt vmcnt(0)" ::: "memory"); }
    __syncthreads();
}
__device__ __forceinline__ void phase_mix(const ArgsL& a, Frame& F, int layer, const unsigned* ca_done) {
#ifdef SEQ_SCAN
    if (F.bx < N_RW_WG) { int nr = REP_SCAN; asm volatile("" : "+s"(nr)); for (int r = 0; r < nr; ++r) rwkv_scan(a, F, F.bx, (r + 1 < nr) ? REP_SCAN_DRY : 0); }
#else
#ifndef REP_CHB
#define REP_CHB 1
#endif
    if (F.bx < 12) { wg_wait(ca_done, gridDim.x);
        int nr = REP_CHB; asm volatile("" : "+s"(nr)); for (int r = 0; r < nr; ++r) rwkv_chunkB(a, F, F.bx); }
#endif
    float gqm = fabsf(a.in(I_QG)[layer * 64 + F.lane]), gkm = fabsf(a.in(I_KG)[layer * 64 + F.lane]);
#pragma unroll
    for (int off = 1; off < 64; off <<= 1) { gqm = fmaxf(gqm, __shfl_xor(gqm, off)); gkm = fmaxf(gkm, __shfl_xor(gkm, off)); }
    const float bound = 64.0f * C2 * gqm * gkm * 1.02f + 0.5f;
    unsigned* head = (unsigned*)(a.ws + WS_CTL) + CW_QUEUE + 64 * layer;
    for (;;) {
        if (F.tid == 0) F.MISC[16] = __hip_atomic_fetch_add(head, 1u, __ATOMIC_RELAXED, __HIP_MEMORY_SCOPE_AGENT);
        __syncthreads();
        const int u = (int)F.MISC[16];
        __syncthreads();
        if (u >= N_FX_UNITS + N_SB_UNITS) break;
        if (u < N_FX_UNITS) { const int qb = 64 - u / 10, bh = u % 10; int nr = REP_FOX; asm volatile("" : "+s"(nr)); for (int r = 0; r < nr; ++r) attn_unit<0>(a, F, bh / FX_H, bh % FX_H, qb, bound); }
        else { const int v = u - N_FX_UNITS; const int qb = 64 - v / 10, bh = v % 10; int nr = REP_SB; asm volatile("" : "+s"(nr)); for (int r = 0; r < nr; ++r) attn_unit<1>(a, F, bh / SB_H, bh % SB_H, qb, bound); }
    }
}

__device__ __forceinline__ void chain_publish(unsigned* cnt, int pm) {
    asm volatile("s_waitcnt vmcnt(0)" ::: "memory");
    if ((threadIdx.x & 63) == 0) __hip_atomic_fetch_add(cnt + CH_STRIDE * pm, 1u, __ATOMIC_RELAXED, __HIP_MEMORY_SCOPE_AGENT);
}
struct GatesOrder : pg8::StaticOrder {
    unsigned* mine;
    __device__ bool next(int i, pg8::Unit& u) const {
        long L;
        if (i < 5) L = (long)i * 256 + c;
        else if (i == 5) { if (c >= 16 && c < 20) return false; L = 1280 + c; }
        else if (i == 6) { if (c < 12) L = 1536 + c; else if (c < 16) L = 1280 + 16 + (c - 12); else return false; }
        else return false;
        int wgid = (int)L; { const int q = nwg / pg8::NXCD, r = nwg % pg8::NXCD, xcd = wgid % pg8::NXCD, off = wgid / pg8::NXCD; wgid = (xcd < r ? xcd * (q + 1) : r * (q + 1) + (xcd - r) * q) + off; }
        const int nig = pg8::WGM * nN, gid = wgid / nig, fm = gid * pg8::WGM, gsz = (nM - fm) < pg8::WGM ? (nM - fm) : pg8::WGM;
        u.pm = fm + ((wgid % nig) % gsz); u.pn = (wgid % nig) / gsz; return true;
    }
    __device__ __forceinline__ void a_ready(const pg8::Unit&) const {}
    __device__ __forceinline__ void done(const pg8::Unit& u) const { chain_publish(mine, u.pm); }
};
template <bool WAIT, bool PUB>
struct ChainOrder : pg8::StaticOrder {
    const unsigned* ready; unsigned need; unsigned* mine;
    __device__ __forceinline__ void a_ready(const pg8::Unit& u) const {
        if constexpr (WAIT) {
            if (threadIdx.x < 64) {
                const unsigned* w = ready + CH_STRIDE * u.pm; unsigned polls = 0;
                while ((unsigned)__builtin_amdgcn_readfirstlane(__hip_atomic_load(w, __ATOMIC_RELAXED, __HIP_MEMORY_SCOPE_AGENT)) < need) { if (++polls > (1u << 18)) break; __builtin_amdgcn_s_sleep(2); }
                __builtin_amdgcn_fence(__ATOMIC_ACQUIRE, "agent");
                asm volatile("s_waitcnt vmcnt(0)" ::: "memory");
            }
            asm volatile("" ::: "memory"); __builtin_amdgcn_s_barrier(); asm volatile("" ::: "memory");
        }
    }
    __device__ __forceinline__ void done(const pg8::Unit& u) const { if constexpr (PUB) chain_publish(mine, u.pm); }
};

__device__ __forceinline__ void phase_post(const ArgsL& a, Frame& F, int layer, unsigned* chain, const bool dry = false) {
    const int lane = F.lane, wave = F.wave, it4 = lane >> 4, e4 = lane & 15;
    bf16_t* Y0 = (bf16_t*)(a.ws + WS_YCAT); const bf16_t* BN = (const bf16_t*)(a.ws + WS_BN);
    const __amdgpu_buffer_rsrc_t yrs = __builtin_amdgcn_make_buffer_rsrc((void*)Y0, 0, (int)((size_t)M * YC_W * 2), 0x00020000);
    LAS float* lgl = (LAS float*)F.lds;
    for (int i = F.tid; i < 2 * RW_W; i += NTHR) lgl[i] = (i < RW_W) ? a.in(I_LNG)[layer * RW_W + i] : a.in(I_LNB)[layer * RW_W + i - RW_W];
    __syncthreads();
    unsigned* head = (unsigned*)(a.ws + WS_CTL) + CW_QUEUE + 64 * layer + 32 + (dry ? 8 : 0);
    for (;;) {
        if (F.tid == 0) F.MISC[17] = __hip_atomic_fetch_add(head, 1u, __ATOMIC_RELAXED, __HIP_MEMORY_SCOPE_AGENT);
        __syncthreads();
        const int ch = (int)F.MISC[17];
        __syncthreads();
        if (ch >= M / 64) break;
        u32x2 yn = {0u, 0u}, bn = {0u, 0u};
#define PP_ADDR(ps) const int item_ = (ps) * 32 + wave * 4 + it4, rw_ = item_ / 6, hh_ = item_ - rw_ * 6; const int m_ = ch * 64 + rw_; const size_t off_ = (size_t)m_ * RW_W + hh_ * 64 + e4 * 4, offy_ = (size_t)m_ * YC_W + hh_ * 64 + e4 * 4
        { PP_ADDR(0); yn = *(const u32x2*)(Y0 + offy_); bn = *(const u32x2*)(BN + off_); }
#pragma unroll 1
        for (int ps = 0; ps < 12; ++ps) {
            const u32x2 yv = yn, bv = bn;
            if (ps + 1 < 12) { PP_ADDR(ps + 1); yn = *(const u32x2*)(Y0 + offy_); bn = *(const u32x2*)(BN + off_); }
            PP_ADDR(ps);
            const int p = m_ % T;
            u32x2 w = {0u, 0u};
            if (p >= PADR) {
                const float y0 = bf_lo(yv.x), y1 = bf_hi(yv.x), y2 = bf_lo(yv.y), y3 = bf_hi(yv.y);
                const float mean = allred16((y0 + y1) + (y2 + y3)) * (1.f / 64.f);
                const float d0 = y0 - mean, d1 = y1 - mean, d2 = y2 - mean, d3 = y3 - mean;
                const float rs = 1.0f / sqrtf(allred16((d0 * d0 + d1 * d1) + (d2 * d2 + d3 * d3)) * (1.f / 64.f) + 64e-5f);
                const f32x4 g4 = *(const LAS f32x4*)(lgl + hh_ * 64 + e4 * 4), b4 = *(const LAS f32x4*)(lgl + RW_W + hh_ * 64 + e4 * 4);
                w = (u32x2){pk2(d0 * rs * g4.x + b4.x + bf_lo(bv.x), d1 * rs * g4.y + b4.y + bf_hi(bv.x)), pk2(d2 * rs * g4.z + b4.z + bf_lo(bv.y), d3 * rs * g4.w + b4.w + bf_hi(bv.y))};
            }
            if (!dry) __builtin_amdgcn_raw_buffer_store_b64(w, yrs, (int)(offy_ * 2), 0, 16); else asm volatile("" :: "v"(w.x), "v"(w.y));
        }
#undef PP_ADDR
        if (!dry) {
#pragma unroll 1
            for (int k = 0; k < 16; ++k) { const int pr = wave * 16 + k, sl = pr >> 6, m2 = ch * 64 + (pr & 63); const int p = m2 % T;
                const int rowb = (int)(((size_t)m2 * YC_W + 384 * (sl + 1)) * 2);
                if (p < PADR) { for (int c = lane; c < RW_W / 2; c += 64) __builtin_amdgcn_raw_buffer_store_b32(0u, yrs, rowb + 4 * c, 0, 16); }
                else if (lane < 32) __builtin_amdgcn_raw_buffer_store_b32(0u, yrs, rowb + 640 + 4 * lane, 0, 16); }
            chain_publish(chain, ch >> 2);
        }
    }
}

struct EpiInproj { static constexpr bool PERM = true, AFTER_DRAIN = false, MIDHOOK = false; bf16_t* ush; bf16_t* qkv;
    __device__ __forceinline__ void operator()(const f32x4 (&acc)[2][2][4][2], const pg8::Unit& u, int wr, int wc, int fr, int fq) const {
        asm volatile("" : "+v"(fr), "+v"(fq));
        const int row0 = u.pm * 256 + wr * 64 + fr, colt = u.pn * 256 + wc * 32 + 8 * fq;
#pragma unroll
        for (int ai = 0; ai < 2; ++ai)
#pragma unroll
            for (int m = 0; m < 4; ++m) { const size_t row = (size_t)(row0 + ai * 128 + m * 16);
#pragma unroll
                for (int bj = 0; bj < 2; ++bj) { const int col = colt + bj * 128; const f32x4 v0 = acc[ai][bj][m][0], v1 = acc[ai][bj][m][1];
                    const float sc = (col >= SHIFT_W && col < SHIFT_W + 320) ? C2 : 1.0f;
                    u32x4 w; w.x = pk2(v0[0] * sc, v0[1] * sc); w.y = pk2(v0[2] * sc, v0[3] * sc); w.z = pk2(v1[0] * sc, v1[1] * sc); w.w = pk2(v1[2] * sc, v1[3] * sc);
                    if (col < SHIFT_W) *(u32x4*)(ush + row * SHIFT_W + col) = w;
                    else if (col < SHIFT_W + QKV_W) *(u32x4*)(qkv + row * QKV_W + (col - SHIFT_W)) = w; } }
    }
};
struct EpiGates { static constexpr bool PERM = true, AFTER_DRAIN = false, MIDHOOK = false; bf16_t* gates;
    __device__ __forceinline__ void operator()(const f32x4 (&acc)[2][2][4][2], const pg8::Unit& u, int wr, int wc, int fr, int fq) const {
        asm volatile("" : "+v"(fr), "+v"(fq));
        const int row0 = u.pm * 256 + wr * 64 + fr, colt = u.pn * 256 + wc * 32 + 8 * fq;
        const __amdgpu_buffer_rsrc_t rs = __builtin_amdgcn_make_buffer_rsrc((void*)gates, 0, (int)((size_t)M * 3072 * 2), 0x00020000);
#pragma unroll
        for (int ai = 0; ai < 2; ++ai)
#pragma unroll
            for (int m = 0; m < 4; ++m) { const size_t row = (size_t)(row0 + ai * 128 + m * 16);
#pragma unroll
                for (int bj = 0; bj < 2; ++bj) { const int col = colt + bj * 128; f32x4 v0 = acc[ai][bj][m][0], v1 = acc[ai][bj][m][1];
#pragma unroll
                    for (int q = 0; q < 4; ++q) { v0[q] = __builtin_amdgcn_rcpf(1.f + __builtin_amdgcn_exp2f(-v0[q] * LOG2E)); v1[q] = __builtin_amdgcn_rcpf(1.f + __builtin_amdgcn_exp2f(-v1[q] * LOG2E)); }
                    u32x4 w; w.x = pk2(v0[0], v0[1]); w.y = pk2(v0[2], v0[3]); w.z = pk2(v1[0], v1[1]); w.w = pk2(v1[2], v1[3]);
                    __builtin_amdgcn_raw_buffer_store_b128(w, rs, (int)((row * 3072 + col) * 2), 0, 16); } }
    }
};
struct EpiMergeF { static constexpr bool PERM = true, AFTER_DRAIN = false, MIDHOOK = true; const bf16_t* gates; bf16_t* merged;
    __device__ __forceinline__ void mid(f32x4 (&acc)[2][2][4][2], const pg8::Unit& u, int wr, int wc, int fr, int fq, int seg) const {
        asm volatile("" : "+v"(fr), "+v"(fq));
        const int row0 = u.pm * 256 + wr * 64 + fr, colt = u.pn * 256 + wc * 32 + 8 * fq;
        u32x4 gpn[2], gnn[2];
#define MG_LOAD(q) do { const bf16_t* gpt_ = gates + (size_t)(row0 + ((q) >> 2) * 128 + ((q) & 3) * 16) * 3072 + (seg - 1) * 1024 + colt; \
            gpn[0] = *(const u32x4*)gpt_; gnn[0] = *(const u32x4*)(gpt_ + 1024); gpn[1] = *(const u32x4*)(gpt_ + 128); gnn[1] = *(const u32x4*)(gpt_ + 1024 + 128); } while (0)
        MG_LOAD(0);
#pragma unroll
        for (int q = 0; q < 8; ++q) { const int ai = q >> 2, m = q & 3;
            u32x4 gp[2], gn[2];
#pragma unroll
            for (int bj = 0; bj < 2; ++bj) { gp[bj] = gpn[bj]; gn[bj] = gnn[bj]; }
            if (q < 7) MG_LOAD(q + 1);
#pragma unroll
            for (int bj = 0; bj < 2; ++bj) { f32x4& v0 = acc[ai][bj][m][0]; f32x4& v1 = acc[ai][bj][m][1];
                v0[0] *= bf_lo(gp[bj].x) * __builtin_amdgcn_rcpf(bf_lo(gn[bj].x)); v0[1] *= bf_hi(gp[bj].x) * __builtin_amdgcn_rcpf(bf_hi(gn[bj].x));
                v0[2] *= bf_lo(gp[bj].y) * __builtin_amdgcn_rcpf(bf_lo(gn[bj].y)); v0[3] *= bf_hi(gp[bj].y) * __builtin_amdgcn_rcpf(bf_hi(gn[bj].y));
                v1[0] *= bf_lo(gp[bj].z) * __builtin_amdgcn_rcpf(bf_lo(gn[bj].z)); v1[1] *= bf_hi(gp[bj].z) * __builtin_amdgcn_rcpf(bf_hi(gn[bj].z));
                v1[2] *= bf_lo(gp[bj].w) * __builtin_amdgcn_rcpf(bf_lo(gn[bj].w)); v1[3] *= bf_hi(gp[bj].w) * __builtin_amdgcn_rcpf(bf_hi(gn[bj].w)); }
            __builtin_amdgcn_sched_barrier(0); }
#undef MG_LOAD
    }
    __device__ __forceinline__ void operator()(const f32x4 (&acc)[2][2][4][2], const pg8::Unit& u, int wr, int wc, int fr, int fq) const {
        asm volatile("" : "+v"(fr), "+v"(fq));
        const int row0 = u.pm * 256 + wr * 64 + fr, colt = u.pn * 256 + wc * 32 + 8 * fq;
        const __amdgpu_buffer_rsrc_t mrs = __builtin_amdgcn_make_buffer_rsrc((void*)merged, 0, (int)((size_t)M * D * 2), 0x00020000);
        u32x4 gnx[2];
#define MG_LOAD2(q) do { const bf16_t* gpt_ = gates + (size_t)(row0 + ((q) >> 2) * 128 + ((q) & 3) * 16) * 3072 + 2048 + colt; gnx[0] = *(const u32x4*)gpt_; gnx[1] = *(const u32x4*)(gpt_ + 128); } while (0)
        MG_LOAD2(0);
#pragma unroll
        for (int q = 0; q < 8; ++q) { const int ai = q >> 2, m = q & 3; const size_t row = (size_t)(row0 + ai * 128 + m * 16);
            u32x4 g[2];
#pragma unroll
            for (int bj = 0; bj < 2; ++bj) g[bj] = gnx[bj];
            if (q < 7) MG_LOAD2(q + 1);
#pragma unroll
            for (int bj = 0; bj < 2; ++bj) { const f32x4 v0 = acc[ai][bj][m][0], v1 = acc[ai][bj][m][1];
                u32x4 w;
                w.x = pk2(bf_lo(g[bj].x) * v0[0], bf_hi(g[bj].x) * v0[1]); w.y = pk2(bf_lo(g[bj].y) * v0[2], bf_hi(g[bj].y) * v0[3]);
                w.z = pk2(bf_lo(g[bj].z) * v1[0], bf_hi(g[bj].z) * v1[1]); w.w = pk2(bf_lo(g[bj].w) * v1[2], bf_hi(g[bj].w) * v1[3]);
                __builtin_amdgcn_raw_buffer_store_b128(w, mrs, (int)((row * D + colt + bj * 128) * 2), 0, 16); }
            __builtin_amdgcn_sched_barrier(0); }
#undef MG_LOAD2
    }
};
struct EpiOut { static constexpr bool PERM = true, AFTER_DRAIN = false, MIDHOOK = false; bf16_t* hb;
    __device__ __forceinline__ void operator()(const f32x4 (&acc)[2][2][4][2], const pg8::Unit& u, int wr, int wc, int fr, int fq) const {
        asm volatile("" : "+v"(fr), "+v"(fq));
        const int row0 = u.pm * 256 + wr * 64 + fr, colt = u.pn * 256 + wc * 32 + 8 * fq;
        u32x4 hn[2];
#define OUT_LOAD(q) do { const bf16_t* p_ = hb + (size_t)(row0 + ((q) >> 2) * 128 + ((q) & 3) * 16) * D + colt; hn[0] = *(const u32x4*)(p_); hn[1] = *(const u32x4*)(p_ + 128); } while (0)
        OUT_LOAD(0);
#pragma unroll
        for (int q = 0; q < 8; ++q) {
            const int ai = q >> 2, m = q & 3;
            bf16_t* hp = hb + (size_t)(row0 + ai * 128 + m * 16) * D + colt; const u32x4 h0 = hn[0], h1 = hn[1];
            if (q < 7) OUT_LOAD(q + 1);
#pragma unroll
            for (int bj = 0; bj < 2; ++bj) { const u32x4 hh = bj ? h1 : h0; const f32x4 v0 = acc[ai][bj][m][0], v1 = acc[ai][bj][m][1];
                u32x4 w; w.x = pk2(bf_lo(hh.x) + v0[0], bf_hi(hh.x) + v0[1]); w.y = pk2(bf_lo(hh.y) + v0[2], bf_hi(hh.y) + v0[3]);
                w.z = pk2(bf_lo(hh.z) + v1[0], bf_hi(hh.z) + v1[1]); w.w = pk2(bf_lo(hh.w) + v1[2], bf_hi(hh.w) + v1[3]);
                *(u32x4*)(hp + bj * 128) = w; }
            __builtin_amdgcn_sched_barrier(0);
        }
#undef OUT_LOAD
    }
};
template <bool GA, bool WAIT, bool PUB, bool REV> struct MoeOrderT { static constexpr bool GATHER = GA; const volatile LAS int* tb; int ntile, npt, G, c, rep; const int* s2t; unsigned* cnt; unsigned need;
    __device__ __forceinline__ bool next(int i, pg8::Unit& u) const { long L = (long)i * G + (REV ? G - 1 - c : c); if (L >= (long)ntile * npt * rep) return false; L %= (long)ntile * npt;
        const int tau = (int)(L / npt), j = (int)(L - (long)tau * npt); int e = 0;
#pragma unroll
        for (int k = 1; k < 16; ++k) e += (tau >= tb[k]) ? 1 : 0;
        u.pm = tau; u.pn = __builtin_amdgcn_readfirstlane(e) * npt + j; return true; }
    __device__ __forceinline__ void a_ready(const pg8::Unit& u) const {
        if constexpr (WAIT) {
            if (threadIdx.x < 64) {
                const unsigned* w = cnt + CH_STRIDE * u.pm; unsigned polls = 0;
                while ((unsigned)__builtin_amdgcn_readfirstlane(__hip_atomic_load(w, __ATOMIC_RELAXED, __HIP_MEMORY_SCOPE_AGENT)) < need) { if (++polls > (1u << 18)) break; __builtin_amdgcn_s_sleep(2); }
                __builtin_amdgcn_fence(__ATOMIC_ACQUIRE, "agent");
                asm volatile("s_waitcnt vmcnt(0)" ::: "memory");
            }
            asm volatile("" ::: "memory"); __builtin_amdgcn_s_barrier(); asm volatile("" ::: "memory");
        }
    }
    __device__ __forceinline__ void done(const pg8::Unit& u) const { if constexpr (PUB) chain_publish(cnt, u.pm); }
};
struct EpiMoeUp { static constexpr bool PERM = true, AFTER_DRAIN = false, MIDHOOK = false; bf16_t* hs;
    __device__ __forceinline__ void operator()(const f32x4 (&acc)[2][2][4][2], const pg8::Unit& u, int wr, int wc, int fr, int fq) const {
        asm volatile("" : "+v"(fr), "+v"(fq));
        const int row0 = u.pm * 256 + wr * 64 + fr, col = (u.pn & 1) * 128 + wc * 32 + 8 * fq;
        const __amdgpu_buffer_rsrc_t hrs = __builtin_amdgcn_make_buffer_rsrc((void*)hs, 0, (int)((size_t)MS * DEXP * 2), 0x00020000);
#pragma unroll
        for (int ai = 0; ai < 2; ++ai)
#pragma unroll
            for (int m = 0; m < 4; ++m) { const size_t row = (size_t)(row0 + ai * 128 + m * 16); float r[8];
#pragma unroll
                for (int n = 0; n < 2; ++n)
#pragma unroll
                    for (int q = 0; q < 4; ++q) { const float gte = acc[ai][0][m][n][q], up = acc[ai][1][m][n][q]; r[4 * n + q] = gte * __builtin_amdgcn_rcpf(1.f + __builtin_amdgcn_exp2f(-gte * LOG2E)) * up; }
                u32x4 w; w.x = pk2(r[0], r[1]); w.y = pk2(r[2], r[3]); w.z = pk2(r[4], r[5]); w.w = pk2(r[6], r[7]);
                __builtin_amdgcn_raw_buffer_store_b128(w, hrs, (int)((row * DEXP + col) * 2), 0, 16); }
    }
};
struct EpiMoeDown { static constexpr bool PERM = true, AFTER_DRAIN = false, MIDHOOK = false; bf16_t* y; const float* cws;
    __device__ __forceinline__ void operator()(const f32x4 (&acc)[2][2][4][2], const pg8::Unit& u, int wr, int wc, int fr, int fq) const {
        asm volatile("" : "+v"(fr), "+v"(fq));
        const int row0 = u.pm * 256 + wr * 64 + fr, colt = (u.pn & 3) * 256 + wc * 32 + 8 * fq;
        float cw[8];
#pragma unroll
        for (int q = 0; q < 8; ++q) cw[q] = cws[row0 + (q >> 2) * 128 + (q & 3) * 16];
#pragma unroll
        for (int ai = 0; ai < 2; ++ai)
#pragma unroll
            for (int m = 0; m < 4; ++m) { const size_t row = (size_t)(row0 + ai * 128 + m * 16); const float cwv = cw[ai * 4 + m];
#pragma unroll
                for (int bj = 0; bj < 2; ++bj) { const int col = colt + bj * 128; const f32x4 v0 = acc[ai][bj][m][0] * cwv, v1 = acc[ai][bj][m][1] * cwv;
                    u32x4 w; w.x = pk2(v0[0], v0[1]); w.y = pk2(v0[2], v0[3]); w.z = pk2(v1[0], v1[1]); w.w = pk2(v1[2], v1[3]);
                    *(u32x4*)(y + row * D + col) = w; } }
    }
};


#ifndef PH_MASK
#define PH_MASK 0xFFFF
#endif
#define PH(k) ((PH_MASK >> (k)) & 1)
#ifndef PROBE_DUP
#define PROBE_DUP 0
#endif
#define DUPN(bit) (((PROBE_DUP >> (bit)) & 1) ? 2 : 1)
#ifndef PROBE_THIN
#define PROBE_THIN 0
#endif
#define THIN(bit) ((PROBE_THIN >> (bit)) & 1)
#define FRESH() do { asm volatile("" : "+v"(F.tid)); F.lane = F.tid & 63; F.wave = __builtin_amdgcn_readfirstlane(F.tid >> 6); { int bx_ = (int)blockIdx.x; asm volatile("" : "+s"(bx_)); F.bx = bx_; } { unsigned char* w_ = a.ws; asm volatile("" : "+s"(w_)); a.ws = w_; } } while (0)
__global__ void __launch_bounds__(NTHR, 2) hybrid_fwd(Args ka) {
    extern __shared__ __attribute__((aligned(16))) unsigned char lds_raw[];
    Frame F;
    F.lds = (LAS unsigned char*)lds_raw;
    F.MISC = (volatile LAS unsigned*)(F.lds + MISC_OFF);
    F.tid = threadIdx.x; F.lane = F.tid & 63; F.wave = __builtin_amdgcn_readfirstlane(F.tid >> 6); F.bx = (int)blockIdx.x;
    for (int u = F.tid; u < (LDS_BYTES - MISC_OFF) / 4; u += NTHR) ((LAS unsigned*)(F.lds + MISC_OFF))[u] = 0u;
    __syncthreads();
    if (F.tid < 29) { const unsigned long long p = (unsigned long long)ka.in[F.tid]; F.MISC[64 + 2 * F.tid] = (unsigned)p; F.MISC[65 + 2 * F.tid] = (unsigned)(p >> 32); }
    __syncthreads();
    ArgsL a; a.tab = F.MISC + 64; a.out = ka.out; a.ws = ka.ws;
    XcdBarrier bar = xcd_barrier_post((unsigned*)(a.ws + WS_CTL) + CW_BAR, F.MISC + 8);
    const int G = (int)gridDim.x, c = (int)blockIdx.x;
    PG8_LAS unsigned char* ring = (PG8_LAS unsigned char*)F.lds;

#ifdef PROF_K
    volatile LAS unsigned* tsl = F.MISC + 1536; int nts = 0;
    if (blockIdx.x == 0 && F.tid == 0) tsl[nts] = (unsigned)__builtin_amdgcn_s_memrealtime();
    ++nts;
#define BARX() do { xcd_barrier(bar); if (blockIdx.x == 0 && F.tid == 0) tsl[nts] = (unsigned)__builtin_amdgcn_s_memrealtime(); ++nts; } while (0)
#else
#define BARX() xcd_barrier(bar)
#endif
    for (int layer = 0; layer < DEPTH; ++layer) {
        for (int rep = 0; rep < DUPN(8); ++rep) { FRESH(); if (PH(0)) phase_wconv(a, F, layer); }
        __syncthreads();
        if (THIN(0)) { FRESH(); phase_norm<1>(a, F, layer, true); }
        FRESH(); if (PH(1)) phase_norm<1>(a, F, layer);
        BARX();
        FRESH(); if (PH(2)) {
            pg8::Gemm g{(const bf16_t*)A_PTR(a), (const bf16_t*)(a.ws + WS_WIN), M, N1, D}; pg8::StaticOrder S; S.init(M, N1, G, c, DUPN(3));
            EpiInproj E{(bf16_t*)(a.ws + WS_USH), (bf16_t*)(a.ws + WS_QKV)};
            pg8::gemm_phase<EpiInproj, pg8::StaticOrder, true, true>(ring, g, S, E);
        }
        BARX();
        if (THIN(1)) { FRESH(); phase_prep(a, F, layer, true); }
        FRESH(); if (PH(3)) phase_prep(a, F, layer);
        BARX();
#ifndef SEQ_SCAN
        if (THIN(2)) { FRESH(); phase_chunkA(a, F, true); }
        FRESH(); if (PH(4)) phase_chunkA(a, F);
        unsigned* ca_done = (unsigned*)(a.ws + WS_CTL) + CW_CADONE + 64 * layer;
        wg_publish(ca_done);
#endif
        FRESH(); if (PH(4)) phase_mix(a, F, layer, ca_done);
        BARX();
        unsigned* ch2 = (unsigned*)(a.ws + WS_CTL) + CW_CHAIN + (layer * 2) * 129 * CH_STRIDE; unsigned* ch3 = ch2 + 129 * CH_STRIDE;
        FRESH(); if (PH(6)) {
            pg8::Gemm g{(const bf16_t*)A_PTR(a), (const bf16_t*)(a.ws + WS_WG), M, 3072, D}; GatesOrder S; S.init(M, 3072, G, c, 1); S.mine = ch2;
            EpiGates E{(bf16_t*)(a.ws + WS_GATES)};
            pg8::gemm_phase<EpiGates, GatesOrder, true, true>(ring, g, S, E);
        }
        asm volatile("s_waitcnt vmcnt(0) lgkmcnt(0)" ::: "memory"); __syncthreads();
        if (THIN(3)) { FRESH(); phase_post(a, F, layer, ch2, true); }
        FRESH(); if (PH(5)) { if (!(c < 20 || (c >= 32 && c < 36))) phase_post(a, F, layer, ch2); }
        __syncthreads();
        FRESH(); if (PH(7)) {
            pg8::Gemm g{(const bf16_t*)(a.ws + WS_YCAT), (const bf16_t*)(a.ws + WS_WP), M, D, YC_W}; ChainOrder<true, true> S; S.init(M, D, G, (c + G - 16) % G, 1); S.ready = ch2; S.need = 128u; S.mine = ch3;
            EpiMergeF E{(const bf16_t*)(a.ws + WS_GATES), (bf16_t*)(a.ws + WS_MERGED)};
            pg8::gemm_phase<EpiMergeF, ChainOrder<true, true>, true, true>(ring, g, S, E);
        }
        FRESH(); if (PH(8)) {
            pg8::Gemm g{(const bf16_t*)(a.ws + WS_MERGED), (const bf16_t*)(a.ws + WS_WO), M, D, D}; ChainOrder<true, false> S; S.init(M, D, G, (c + G - 32) % G, 1); S.ready = ch3; S.need = 32u; S.mine = nullptr;
            EpiOut E{HB_PTR(a)};
            pg8::gemm_phase<EpiOut, ChainOrder<true, false>, true, true>(ring, g, S, E);
        }
        BARX();
        if (THIN(4)) { FRESH(); phase_norm2(a, F, layer, true); }
        FRESH(); if (PH(9)) phase_norm2(a, F, layer);
        BARX();
        for (int rep = 0; rep < DUPN(7); ++rep) { FRESH(); if (PH(10)) phase_route(a, F, layer); }
        BARX();
        volatile LAS int* tb = (volatile LAS int*)(F.MISC + 32);
        if (F.tid <= 16) { const int* cnt = (const int*)(a.ws + WS_CTL) + CW_ECNT + 64 * layer; int t = 0;
            for (int e = 0; e < F.tid; ++e) t += (__hip_atomic_load(cnt + e, __ATOMIC_RELAXED, __HIP_MEMORY_SCOPE_AGENT) + 255) >> 8;
            tb[F.tid] = t; }
        __syncthreads();
        const int ntile = tb[16];
        unsigned* chm = (unsigned*)(a.ws + WS_CTL) + CW_MOE + layer * (MS / 256) * CH_STRIDE;
        FRESH(); if (PH(11)) {
            pg8::Gemm g{(const bf16_t*)A_PTR(a), (const bf16_t*)(a.ws + WS_WGU), MS, 8192, D}; MoeOrderT<true, false, true, false> S{tb, ntile, 2, G, c, 1, (const int*)(a.ws + WS_S2T), chm, 0u};
            EpiMoeUp E{(bf16_t*)(a.ws + WS_HS)};
            pg8::gemm_phase<EpiMoeUp, MoeOrderT<true, false, true, false>, true, true>(ring, g, S, E);
        }
        FRESH(); if (PH(12)) {
            int kdim = DEXP; asm volatile("" : "+s"(kdim));
            pg8::Gemm g{(const bf16_t*)(a.ws + WS_HS), (const bf16_t*)(a.ws + WS_WD), MS, 16384, kdim}; MoeOrderT<false, true, false, true> S{tb, ntile, 4, G, c, 1, nullptr, chm, 16u};
            EpiMoeDown E{(bf16_t*)(a.ws + WS_Y), (const float*)(a.ws + WS_CWS)};
            pg8::gemm_phase<EpiMoeDown, MoeOrderT<false, true, false, true>, true, true>(ring, g, S, E);
        }
        BARX();
    }
    if (THIN(5)) { FRESH(); phase_norm<0>(a, F, DEPTH - 1, true); }
    FRESH(); if (PH(13)) phase_norm<0>(a, F, DEPTH - 1);
#ifdef PROF_K
    BARX();
    if (blockIdx.x == 0) {
        __syncthreads();
        float us;
        if (PROF_K < 0) us = 100.f;
        else if (PROF_K == 12) us = (float)(tsl[25] - tsl[24]) * 0.01f;
        else if (PROF_K == 13) us = (float)(tsl[25] - tsl[0]) * 0.01f;
        else us = ((float)(tsl[1 + PROF_K] - tsl[PROF_K]) + (float)(tsl[13 + PROF_K] - tsl[12 + PROF_K])) * 0.01f;
        us = 4.f * rintf(us * 0.25f);
        for (int i = F.tid; i < 16384; i += NTHR) a.out[i] = us;
    }
#endif
#ifdef CLOCK_PROBE
    if (blockIdx.x == 0 && F.wave == 0) {
        float c0 = 1.f, c1 = 2.f, c2 = 3.f, c3 = 4.f, c4 = 5.f, c5 = 6.f, c6 = 7.f, c7 = 8.f;
        for (int i = 0; i < CLOCK_PROBE; ++i) {
            asm volatile("v_fma_f32 %0, %0, %0, %0\n\tv_fma_f32 %1, %1, %1, %1\n\tv_fma_f32 %2, %2, %2, %2\n\tv_fma_f32 %3, %3, %3, %3\n\tv_fma_f32 %4, %4, %4, %4\n\tv_fma_f32 %5, %5, %5, %5\n\tv_fma_f32 %6, %6, %6, %6\n\tv_fma_f32 %7, %7, %7, %7"
                         : "+v"(c0), "+v"(c1), "+v"(c2), "+v"(c3), "+v"(c4), "+v"(c5), "+v"(c6), "+v"(c7));
        }
        asm volatile("" :: "v"(c0), "v"(c1), "v"(c2), "v"(c3), "v"(c4), "v"(c5), "v"(c6), "v"(c7));
    }
#endif
}

extern "C" void kernel_launch(void* const* d_in, const int* in_sizes, int n_in, void* d_out, int out_size, void* d_ws, size_t ws_size, hipStream_t stream) {
    static int ready = 0;
    if (ready == 0) {
        if (n_in != 29 || out_size != NB * SEQ * D || ws_size < WS_END) { fprintf(stderr, "kernel_launch: unexpected problem shape (n_in %d, out %d, ws %zu < %zu)\n", n_in, out_size, ws_size, (size_t)WS_END); ready = -1; return; }
        if (hipFuncSetAttribute((const void*)hybrid_fwd, hipFuncAttributeMaxDynamicSharedMemorySize, LDS_BYTES) != hipSuccess) { fprintf(stderr, "kernel_launch: hipFuncSetAttribute failed\n"); ready = -1; return; }
        int per_cu = 0;
        if (hipOccupancyMaxActiveBlocksPerMultiprocessor(&per_cu, (const void*)hybrid_fwd, NTHR, LDS_BYTES) != hipSuccess || per_cu < 1) fprintf(stderr, "kernel_launch: occupancy query says %d\n", per_cu);
        (void)hipGetLastError();
        ready = 1;
    }
    if (ready < 0) return;
    (void)in_sizes;
    if (hipMemsetAsync((char*)d_ws + WS_CTL, 0, CTL_ZERO_BYTES, stream) != hipSuccess) return;
    Args a{};
    for (int i = 0; i < 29; ++i) a.in[i] = (const float*)d_in[i];
    a.out = (float*)d_out; a.ws = (unsigned char*)d_ws;
    hipLaunchKernelGGL(hybrid_fwd, dim3(256), dim3(NTHR), LDS_BYTES, stream, a);
}
```

```cpp
#include <hip/hip_runtime.h>
#include <hip/hip_bf16.h>
#include <cstdio>
#include <cstdint>

#define GAS __attribute__((address_space(1)))
#define LAS __attribute__((address_space(3)))

namespace pg8 {
#define PG8_LAS __attribute__((address_space(3)))
typedef unsigned short bf16_t;
typedef short bf16x8 __attribute__((ext_vector_type(8)));
typedef float f32x4 __attribute__((ext_vector_type(4)));
typedef unsigned u32x4 __attribute__((ext_vector_type(4)));
constexpr int BM = 256, BK = 64, HALF = 128, HTB = HALF * BK * 2  , STAGE_BYTES = 8 * HTB, NXCD = 8, WGM = 8;

__host__ __device__ __forceinline__ int lds_byte(int r, int c) { const int st = (r >> 4) * 2 + (c >> 5), rr = r & 15, cc = c & 31, ob = rr * 64 + cc * 2; return st * 1024 + (ob ^ (((ob >> 9) & 1) << 5)); }
__host__ __device__ __forceinline__ void stage_rc(int b, int& R, int& C) { const int st = b / 1024, sb = b % 1024, swz = sb ^ (((sb >> 9) & 1) << 5); R = (st >> 1) * 16 + swz / 64; C = (st & 1) * 32 + (swz % 64) / 2; }
__host__ __device__ __forceinline__ int perm32(int rho) { const int n = rho >> 4, i = rho & 15; return 8 * (i >> 2) + 4 * n + (i & 3); }

struct Unit { int pm, pn; };
struct Gemm { const bf16_t* A; const bf16_t* Bt; int M, N, K; };

struct StaticOrder {
    int nM, nN, nwg, G, c, rep;
    __host__ __device__ void init(int M, int N, int G_, int c_, int rep_ = 1) { nM = M / BM; nN = N / BM; nwg = nM * nN; G = G_; c = c_; rep = rep_; }
    __host__ __device__ bool next(int i, Unit& u) const {
        const long L = (long)i * G + c; if (L >= (long)nwg * rep) return false;
        int wgid = (int)(L % nwg); { const int q = nwg / NXCD, r = nwg % NXCD, xcd = wgid % NXCD, off = wgid / NXCD; wgid = (xcd < r ? xcd * (q + 1) : r * (q + 1) + (xcd - r) * q) + off; }
        const int nig = WGM * nN, gid = wgid / nig, fm = gid * WGM, gsz = (nM - fm) < WGM ? (nM - fm) : WGM;
        u.pm = fm + ((wgid % nig) % gsz); u.pn = (wgid % nig) / gsz; return true;
    }
    static constexpr bool GATHER = false;
    __device__ __forceinline__ void a_ready(const Unit&) const {}
    __device__ __forceinline__ void done(const Unit&) const {}
};
__device__ __forceinline__ unsigned cvt_pk_bf16(float lo, float hi) { unsigned r; asm volatile("v_cvt_pk_bf16_f32 %0, %1, %2" : "=v"(r) : "v"(lo), "v"(hi)); return r; }
template <class Epi, class Sched, bool ALIGN_EPI = false, bool SP2 = false>
__device__ __forceinline__ void gemm_phase(PG8_LAS unsigned char* lds, const Gemm g, const Sched& S, const Epi& E) {
    int tid_ = threadIdx.x; asm volatile("" : "+v"(tid_));
    const int tid = tid_, wid = __builtin_amdgcn_readfirstlane(tid >> 6), lane = tid & 63, wr = wid >> 2, wc = wid & 3, fr = lane & 15, fq = lane >> 4;
    const int K = g.K, nt = K / BK;
    unsigned voffA[2], voffB[2];
#pragma unroll
    for (int i = 0; i < 2; ++i) { int R, C; stage_rc(tid * 16 + i * 8192, R, C); const int Rb = Epi::PERM ? ((R & ~31) + perm32(R & 31)) : R;
        voffA[i] = (unsigned)(R * K + C) * 2u; voffB[i] = (unsigned)(Rb * K + C) * 2u; }
    constexpr bool GATH = Sched::GATHER;
    unsigned vg[2] = {0u, 0u}, vn[2] = {0u, 0u}; int gR = 0; unsigned gC = 0u;
    if constexpr (GATH) { int R, C; stage_rc(tid * 16, R, C); gR = R; gC = (unsigned)C * 2u; }
#define PG8_GOFF(v, u) do { _Pragma("unroll") for (int h_ = 0; h_ < 2; ++h_) { const int* q_ = S.s2t + (u).pm * 256 + h_ * 128 + gR; v[h_] = (unsigned)q_[0] | ((unsigned)q_[64] << 16); } } while (0)
#define PG8_STAGE_G(bufoff, gbase, pk) do { const unsigned pk_ = (pk); \
        __builtin_amdgcn_global_load_lds((const unsigned*)((const char*)(gbase) + ((pk_ & 0xffffu) * (unsigned)(K * 2) + gC)), (PG8_LAS unsigned*)(lds + (bufoff) + ldsw), 16, 0, 0); \
        __builtin_amdgcn_global_load_lds((const unsigned*)((const char*)(gbase) + ((pk_ >> 16) * (unsigned)(K * 2) + gC)), (PG8_LAS unsigned*)(lds + (bufoff) + ldsw + 8192), 16, 0, 0); } while (0)
    const size_t kstep = (size_t)(BK * 2);
    const size_t hstep = (size_t)HALF * K * 2;
    const size_t tstep = 2 * hstep;
    const unsigned ldsw = (unsigned)wid * 1024u;
    const int aoff = lds_byte(wr * 64 + fr, fq * 8), boff = lds_byte(wc * 32 + fr, fq * 8);
#define PG8_SA(b, h) (((b) * 2 + (h)) * HTB)
#define PG8_SB(b, h) ((4 + (b) * 2 + (h)) * HTB)
#define PG8_STAGE(bufoff, gbase, voff) do { _Pragma("unroll") for (int _i = 0; _i < 2; ++_i) \
        __builtin_amdgcn_global_load_lds((const unsigned*)((const char*)(gbase) + (voff)[_i]), (PG8_LAS unsigned*)(lds + (bufoff) + ldsw + _i * 8192), 16, 0, 0); } while (0)
#define PG8_STAGE_A(bufoff, gbase, h, vv) do { if constexpr (GATH) PG8_STAGE_G(bufoff, gbase, vv[h]); else PG8_STAGE(bufoff, (gbase) + (h) * hstep, voffA); } while (0)
#define PG8_STAGE_A2(bufoff, gbase, h) do { if constexpr (GATH) PG8_STAGE_G(bufoff, gbase, last ? vn[h] : vg[h]); else PG8_STAGE(bufoff, (gbase) + (h) * hstep, voffA); } while (0)
#define PG8_LDA(dst, b, h) do { _Pragma("unroll") for (int m = 0; m < 4; ++m) _Pragma("unroll") for (int k = 0; k < 2; ++k) dst[m][k] = *(const PG8_LAS bf16x8*)(lds + PG8_SA(b, h) + aoff + m * 2048 + k * 1024); } while (0)
#define PG8_LDB(dst, b, h) do { _Pragma("unroll") for (int n = 0; n < 2; ++n) _Pragma("unroll") for (int k = 0; k < 2; ++k) dst[n][k] = *(const PG8_LAS bf16x8*)(lds + PG8_SB(b, h) + boff + n * 2048 + k * 1024); } while (0)
#define PG8_MMA(ai, bj, At, Bt) do { __builtin_amdgcn_s_setprio(1); _Pragma("unroll") for (int m = 0; m < 4; ++m) _Pragma("unroll") for (int n = 0; n < 2; ++n) _Pragma("unroll") for (int k = 0; k < 2; ++k) \
        acc[ai][bj][m][n] = __builtin_amdgcn_mfma_f32_16x16x32_bf16(Bt[n][k], At[m][k], acc[ai][bj][m][n], 0, 0, 0); __builtin_amdgcn_s_setprio(0); } while (0)
#define PG8_WAIT_V(n) asm volatile("s_waitcnt vmcnt(" #n ")" ::: "memory")
#define PG8_WAIT_L(n) asm volatile("s_waitcnt lgkmcnt(" #n ")" ::: "memory")
#define PG8_BAR __builtin_amdgcn_s_barrier()
#define PG8_SCHED __builtin_amdgcn_sched_barrier(0)
    Unit cur, nxt; int ui = 0;
    if (!S.next(0, cur)) return;
    f32x4 acc[2][2][4][2];
#pragma unroll
    for (int a = 0; a < 2; ++a)
#pragma unroll
        for (int b = 0; b < 2; ++b)
#pragma unroll
            for (int m = 0; m < 4; ++m)
#pragma unroll
                for (int n = 0; n < 2; ++n) acc[a][b][m][n] = (f32x4){0.f, 0.f, 0.f, 0.f};
    bf16x8 At[4][2], B0[2][2], B1[2][2];
    const char* cA = GATH ? (const char*)g.A : (const char*)g.A + (size_t)cur.pm * tstep; const char* cB = (const char*)g.Bt + (size_t)cur.pn * tstep;
    S.a_ready(cur);
    if constexpr (GATH) PG8_GOFF(vg, cur);
    if constexpr (SP2) {
        PG8_STAGE(PG8_SB(0, 0), cB, voffB); PG8_STAGE(PG8_SB(0, 1), cB + hstep, voffB); PG8_STAGE_A(PG8_SA(0, 0), cA, 0, vg); PG8_STAGE_A(PG8_SA(0, 1), cA, 1, vg);
        if (wr == 1) PG8_BAR;
        PG8_WAIT_V(2); PG8_BAR;
        PG8_STAGE(PG8_SB(1, 0), cB + kstep, voffB); PG8_STAGE_A(PG8_SA(1, 0), cA + kstep, 0, vg); PG8_STAGE(PG8_SB(1, 1), cB + hstep + kstep, voffB);
        PG8_WAIT_V(6); PG8_BAR;
    } else {
        PG8_STAGE(PG8_SB(0, 0), cB, voffB); PG8_STAGE(PG8_SA(0, 0), cA, voffA); PG8_STAGE(PG8_SB(0, 1), cB + hstep, voffB); PG8_STAGE(PG8_SA(0, 1), cA + hstep, voffA);
        if (wr == 1) PG8_BAR;
        PG8_WAIT_V(4); PG8_BAR;
        PG8_STAGE(PG8_SB(1, 0), cB + kstep, voffB); PG8_STAGE(PG8_SA(1, 0), cA + kstep, voffA); PG8_STAGE(PG8_SB(1, 1), cB + hstep + kstep, voffB);
        PG8_WAIT_V(6); PG8_BAR;
    }
    for (;;) {
        const bool has_next = S.next(ui + 1, nxt);
        const char* nA = (has_next && !GATH) ? (const char*)g.A + (size_t)nxt.pm * tstep : cA;
        if constexpr (GATH) { if (has_next) PG8_GOFF(vn, nxt); else { vn[0] = vg[0]; vn[1] = vg[1]; } } const char* nB = has_next ? (const char*)g.Bt + (size_t)nxt.pn * tstep : cB;
        for (int t = 0; t < nt; t += 2) {
            const bool last = (t == nt - 2);
            const char* a1 = cA + (size_t)(t + 1) * kstep;
            const char* a2 = last ? nA : cA + (size_t)(t + 2) * kstep; const char* b2 = last ? nB : cB + (size_t)(t + 2) * kstep;
            const char* a3 = a2 + kstep; const char* b3 = b2 + kstep;
            if (last && has_next) S.a_ready(nxt);
            if constexpr (SP2) {
            PG8_LDB(B0, 0, 0); PG8_LDB(B1, 0, 1); PG8_SCHED; PG8_LDA(At, 0, 0); PG8_STAGE_A(PG8_SA(1, 1), a1, 1, vg);
            PG8_WAIT_V(8); PG8_WAIT_L(0); PG8_BAR; PG8_MMA(0, 0, At, B0); PG8_MMA(0, 1, At, B1); PG8_BAR; PG8_SCHED;
            PG8_LDA(At, 0, 1); PG8_STAGE(PG8_SB(0, 0), b2, voffB); PG8_STAGE(PG8_SB(0, 1), b2 + hstep, voffB); PG8_STAGE_A2(PG8_SA(0, 0), a2, 0);
            PG8_WAIT_V(8); PG8_WAIT_L(0); PG8_BAR; PG8_MMA(1, 0, At, B0); PG8_MMA(1, 1, At, B1); PG8_BAR; PG8_SCHED;
            PG8_LDB(B0, 1, 0); PG8_LDB(B1, 1, 1); PG8_SCHED; PG8_LDA(At, 1, 0); PG8_STAGE_A2(PG8_SA(0, 1), a2, 1);
            PG8_WAIT_V(8); PG8_WAIT_L(0); PG8_BAR; PG8_MMA(0, 0, At, B0); PG8_MMA(0, 1, At, B1); PG8_BAR; PG8_SCHED;
            PG8_LDA(At, 1, 1); PG8_STAGE(PG8_SB(1, 0), b3, voffB); PG8_STAGE(PG8_SB(1, 1), b3 + hstep, voffB); PG8_STAGE_A2(PG8_SA(1, 0), a3, 0);
            PG8_WAIT_V(8); PG8_WAIT_L(0); PG8_BAR; PG8_MMA(1, 0, At, B0); PG8_MMA(1, 1, At, B1); PG8_BAR; PG8_SCHED;
            } else {
            static_assert(SP2 || !GATH, "gather needs the SP2 schedule");
            PG8_LDB(B0, 0, 0); PG8_SCHED; PG8_LDA(At, 0, 0); PG8_STAGE(PG8_SA(1, 1), a1 + hstep, voffA);
            PG8_WAIT_L(8); PG8_BAR; PG8_WAIT_L(0); PG8_MMA(0, 0, At, B0); PG8_BAR; PG8_SCHED;
            PG8_LDB(B1, 0, 1); PG8_STAGE(PG8_SB(0, 0), b2, voffB);
            PG8_BAR; PG8_WAIT_L(0); PG8_MMA(0, 1, At, B1); PG8_BAR;
            PG8_LDA(At, 0, 1); PG8_STAGE(PG8_SA(0, 0), a2, voffA);
            PG8_BAR; PG8_WAIT_L(0); PG8_MMA(1, 0, At, B0); PG8_BAR; PG8_SCHED;
            PG8_STAGE(PG8_SB(0, 1), b2 + hstep, voffB);
            PG8_WAIT_V(6); PG8_BAR; PG8_MMA(1, 1, At, B1); PG8_BAR;
            PG8_LDB(B0, 1, 0); PG8_SCHED; PG8_LDA(At, 1, 0); PG8_STAGE(PG8_SA(0, 1), a2 + hstep, voffA);
            PG8_WAIT_L(8); PG8_BAR; PG8_WAIT_L(0); PG8_MMA(0, 0, At, B0); PG8_BAR; PG8_SCHED;
            PG8_LDB(B1, 1, 1); PG8_STAGE(PG8_SB(1, 0), b3, voffB);
            PG8_BAR; PG8_WAIT_L(0); PG8_MMA(0, 1, At, B1); PG8_BAR;
            PG8_LDA(At, 1, 1); PG8_STAGE(PG8_SA(1, 0), a3, voffA);
            PG8_BAR; PG8_WAIT_L(0); PG8_MMA(1, 0, At, B0); PG8_BAR; PG8_SCHED;
            PG8_STAGE(PG8_SB(1, 1), b3 + hstep, voffB);
            PG8_WAIT_V(6); PG8_BAR; PG8_MMA(1, 1, At, B1); PG8_BAR;
            }
            if constexpr (Epi::MIDHOOK) { if (t + 2 == 6 || t + 2 == 12) E.mid(acc, cur, wr, wc, fr, fq, (t + 2) / 6); }
        }
        if constexpr (ALIGN_EPI) { if (wr == 0) PG8_BAR; }
        if constexpr (!Epi::AFTER_DRAIN) { E(acc, cur, wr, wc, fr, fq); S.done(cur); }
        if (!has_next) break;
#pragma unroll
        for (int a = 0; a < 2; ++a)
#pragma unroll
            for (int b = 0; b < 2; ++b)
#pragma unroll
                for (int m = 0; m < 4; ++m)
#pragma unroll
                    for (int n = 0; n < 2; ++n) acc[a][b][m][n] = (f32x4){0.f, 0.f, 0.f, 0.f};
        cur = nxt; cA = nA; cB = nB; ++ui;
        if constexpr (GATH) { vg[0] = vn[0]; vg[1] = vn[1]; }
        if constexpr (ALIGN_EPI) { if (wr == 1) PG8_BAR; }
    }
    PG8_WAIT_V(0);
    if constexpr (!ALIGN_EPI) { if (wr == 0) PG8_BAR; }
    PG8_BAR;
    if constexpr (Epi::AFTER_DRAIN) { E.fused(acc, cur, wr, wc, fr, fq, lds, wid, lane); S.done(cur); }
#undef PG8_SA
#undef PG8_SB
#undef PG8_STAGE
#undef PG8_STAGE_A
#undef PG8_STAGE_A2
#undef PG8_STAGE_G
#undef PG8_GOFF
#undef PG8_LDA
#undef PG8_LDB
#undef PG8_MMA
#undef PG8_WAIT_V
#undef PG8_WAIT_L
#undef PG8_BAR
#undef PG8_SCHED
}
}

constexpr int D = 1024, NB = 2, SEQ = 16384, NMETA = 16, LTOK = SEQ + NMETA  , PADR = 112, T = PADR + LTOK  ;
constexpr int M = NB * T;
constexpr int DEPTH = 2, HD = 64, RW_H = 6, SB_H = 5, FX_H = 5, RW_W = 384, SHIFT_W = 1280, D_IN = 6277;
constexpr int YC_W = 1152;
constexpr int QKV_W = 1920;
constexpr int N1 = 3328;
constexpr int FCOL = 3200, GCOL = 3205;
constexpr int NEXP = 16, DEXP = 256;
constexpr int MS = 70144;
constexpr int LCH = 32, LPADDED = 16448;
constexpr int KBP = 16896;
constexpr float C2 = 0.125f * 1.4426950408889634f;
constexpr float LOG2E = 1.4426950408889634f;
constexpr int NWAVES = 8, NTHR = 512;

constexpr size_t MiB = 1u << 20;
constexpr size_t WS_CTL = 0, CTL_ZERO_BYTES = 212992;
constexpr size_t WS_HM = 1 * MiB;
constexpr size_t WS_LOGF = WS_HM + 131072;
constexpr size_t WS_KB2 = WS_LOGF + (size_t)M * 32;
constexpr size_t WS_TOK = WS_KB2 + (size_t)10 * KBP * 4;
constexpr size_t WS_SLOT = WS_TOK + (size_t)M * 32;
constexpr size_t WS_CWS = WS_SLOT + (size_t)M * 8;
constexpr size_t WS_WGCNT = WS_CWS + (size_t)MS * 4;
constexpr size_t WS_S2T = WS_WGCNT + 256 * 16 * 4;
constexpr size_t WS_SMALL_END = WS_S2T + (size_t)MS * 4;
static_assert(WS_SMALL_END <= 8 * MiB, "small buffers");
constexpr size_t WS_WIN = 8 * MiB;
constexpr size_t WS_WG = WS_WIN + (size_t)N1 * 1024 * 2;
constexpr size_t WS_WP = WS_WG + (size_t)3072 * 1024 * 2;
constexpr size_t WS_WO = WS_WP + (size_t)3072 * 384 * 2;
constexpr size_t WS_WGU = WS_WO + (size_t)1024 * 1024 * 2;
constexpr size_t WS_WD = WS_WGU + (size_t)8192 * 1024 * 2;
constexpr size_t WS_W_END = WS_WD + (size_t)16384 * 256 * 2;
static_assert(WS_W_END <= 49 * MiB, "weights");
constexpr size_t WS_HB = 49 * MiB;
constexpr size_t WS_BIG = 115 * MiB;
constexpr size_t WS_USH = WS_BIG;
constexpr size_t WS_YCAT = WS_BIG;
constexpr size_t WS_QKV = WS_BIG + 82 * MiB;
constexpr size_t WS_RW = WS_BIG + 204 * MiB;
constexpr size_t WS_BN = WS_BIG + 349 * MiB;
constexpr size_t WS_GATES = WS_BIG + 82 * MiB;
constexpr size_t WS_MERGED = WS_BIG + 276 * MiB;
constexpr size_t WS_AS = WS_BIG;
constexpr size_t WS_HS = WS_BIG + 137 * MiB;
constexpr size_t WS_Y = WS_BIG + 172 * MiB;
constexpr size_t WS_END = WS_BIG + 374 * MiB;
static_assert((size_t)(M + 256) * 1280 * 2 <= 82 * MiB && (size_t)3 * M * 384 * 2 <= 82 * MiB && (size_t)(M + 256) * 1920 * 2 <= 122 * MiB, "big map 1");
static_assert((size_t)12 * LPADDED * 768 <= 145 * MiB && (size_t)M * 384 * 2 <= 25 * MiB && (size_t)M * 3072 * 2 <= 194 * MiB && (size_t)M * 2048 <= 65 * MiB, "big map 2");
static_assert((size_t)MS * 2048 <= 137 * MiB && (size_t)MS * 512 <= 35 * MiB && WS_END <= 489 * MiB, "big map 3");

constexpr int CW_BAR = 0;
constexpr int CW_QUEUE = 4096;
constexpr int CW_ECNT = 4352;
constexpr int CW_G1 = 42496;
constexpr int CW_MOE = 24960;
constexpr int CW_CADONE = 24832;
constexpr int CW_CHAIN = 8192, CH_STRIDE = 32;
static_assert((CW_ECNT + 128) <= CW_CHAIN && (CW_CHAIN + DEPTH * 2 * 129 * CH_STRIDE) <= CW_CADONE && (CW_CADONE + 128) <= CW_MOE && (CW_MOE + DEPTH * (MS / 256) * 32) <= CW_G1 && (CW_G1 + DEPTH * 129 * 32) * 4 <= (int)CTL_ZERO_BYTES, "ctl");

constexpr int RING_BYTES = 131072, MISC_OFF = RING_BYTES, LDS_BYTES = 163840;

typedef unsigned short bf16_t;
typedef float f32x4 __attribute__((ext_vector_type(4)));
typedef float f32x2 __attribute__((ext_vector_type(2)));
typedef float f32x16 __attribute__((ext_vector_type(16)));
typedef unsigned u32x4 __attribute__((ext_vector_type(4)));
typedef unsigned u32x2 __attribute__((ext_vector_type(2)));
typedef short bf16x8 __attribute__((ext_vector_type(8)));
typedef short s16x4 __attribute__((ext_vector_type(4)));
typedef _Float16 f16x4 __attribute__((ext_vector_type(4)));
typedef __bf16 bf16x2_t __attribute__((ext_vector_type(2)));

__device__ __forceinline__ unsigned pk2(float lo, float hi) { f32x2 v = {lo, hi}; bf16x2_t b = __builtin_convertvector(v, bf16x2_t); return __builtin_bit_cast(unsigned, b); }
__device__ __forceinline__ unsigned short f2bf(float f) { return (unsigned short)(pk2(f, 0.f) & 0xffffu); }
__device__ __forceinline__ float bf_lo(unsigned u) { return __uint_as_float(u << 16); }
__device__ __forceinline__ float bf_hi(unsigned u) { return __uint_as_float(u & 0xffff0000u); }
__device__ __forceinline__ float bf2f(unsigned short h) { return __uint_as_float((unsigned)h << 16); }
template <int CTRL> __device__ __forceinline__ float dpp_f(float x) { return __int_as_float(__builtin_amdgcn_update_dpp(0, __float_as_int(x), CTRL, 0xF, 0xF, false)); }
__device__ __forceinline__ float allred16(float p) { p += dpp_f<0x128>(p); p += dpp_f<0x124>(p); p += dpp_f<0x122>(p); p += dpp_f<0x121>(p); return p; }
__device__ __forceinline__ float wave_sum(float v) {
    v = allred16(v);
    { auto sw = __builtin_amdgcn_permlane16_swap(__float_as_uint(v), __float_as_uint(v), false, false); v = __uint_as_float(sw[0]) + __uint_as_float(sw[1]); }
    { auto sw = __builtin_amdgcn_permlane32_swap(__float_as_uint(v), __float_as_uint(v), false, false); v = __uint_as_float(sw[0]) + __uint_as_float(sw[1]); }
    return v;
}
__device__ __forceinline__ float fast_exp(float x) { return __builtin_amdgcn_exp2f(x * LOG2E); }
__device__ __forceinline__ float fast_log(float x) { return __builtin_amdgcn_logf(x) * 0.6931471805599453f; }
__device__ __forceinline__ float softplus_f(float z) { return fmaxf(z, 0.f) + fast_log(1.f + fast_exp(-fabsf(z))); }

#define XB_TMO      128
#define XB_XCNT(j)  (256  + 64 * (j))
#define XB_XSUB(j)  (1280 + 64 * (j))
#define XB_XGEN(j)  (2304 + 64 * (j))
#define XB_TOP      3328
#define XB_TOPGEN   3392
#define XCD_BAR_WORDS 3456
#define XB_SPIN_CAP (1u << 20)
__device__ __forceinline__ unsigned xb_ld(unsigned* p)              { return __hip_atomic_load(p, __ATOMIC_RELAXED, __HIP_MEMORY_SCOPE_AGENT); }
__device__ __forceinline__ unsigned xb_add(unsigned* p, unsigned v) { return __hip_atomic_fetch_add(p, v, __ATOMIC_RELAXED, __HIP_MEMORY_SCOPE_AGENT); }
__device__ __forceinline__ unsigned xb_xcc_id() { return (unsigned)__builtin_amdgcn_s_getreg((3 << 11) | 20) & 0xFu; }
#define XB_SPIN(cond, bar) do { unsigned _sp = 0; while (cond) { __builtin_amdgcn_s_sleep(1); \
    if ((++_sp & 255u) == 0u) { if (xb_ld(&(bar)[XB_TMO])) break; if (_sp > XB_SPIN_CAP) { atomicAdd(&(bar)[XB_TMO], 1u); break; } } } } while (0)

struct XcdBarrier {
    unsigned* bar; unsigned x;
    volatile LAS unsigned* st;
};

__device__ __forceinline__ XcdBarrier xcd_barrier_post(unsigned* bar, volatile LAS unsigned* st) {
    XcdBarrier b; b.bar = bar; b.x = xb_xcc_id(); b.st = st;
    if (threadIdx.x == 0) (void)xb_add(&bar[XB_XCNT(b.x)], 1u);
    return b;
}
__device__ __forceinline__ void xcd_barrier_complete(unsigned* bar, unsigned x, unsigned& nloc, unsigned& nx) {
    const unsigned G = gridDim.x * gridDim.y * gridDim.z;
    unsigned sum, cnt, mine, sp = 0u;
    for (;;) {
        sum = 0u; cnt = 0u; mine = 0u;
#pragma unroll
        for (unsigned j = 0; j < 16; ++j) { const unsigned c = xb_ld(&bar[XB_XCNT(j)]); sum += c; cnt += (c > 0u) ? 1u : 0u; mine = (j == x) ? c : mine; }
        if (sum == G) break;
        __builtin_amdgcn_s_sleep(1);
        if ((++sp & 255u) == 0u) { if (xb_ld(&bar[XB_TMO])) break; if (sp > XB_SPIN_CAP) { atomicAdd(&bar[XB_TMO], 1u); break; } }
    }
    nloc = mine > 0u ? mine : 1u; nx = cnt > 0u ? cnt : 1u;
}

__device__ __forceinline__ void xcd_barrier(const XcdBarrier& b) {
    asm volatile("s_waitcnt vmcnt(0)" ::: "memory");
    __syncthreads();
    if (threadIdx.x == 0) {
        unsigned* bar = b.bar;
        __builtin_amdgcn_s_waitcnt(0);
        unsigned nloc = b.st[0], nx = b.st[1];
        if (nloc == 0u) { xcd_barrier_complete(bar, b.x, nloc, nx); b.st[0] = nloc; b.st[1] = nx; }
        const unsigned old = xb_add(&bar[XB_XSUB(b.x)], 1u);
        const unsigned gen = old / nloc;
        if (old + 1u == (gen + 1u) * nloc) {
            __builtin_amdgcn_fence(__ATOMIC_RELEASE, "agent");
            asm volatile("s_waitcnt vmcnt(0)" ::: "memory");
            const unsigned og = xb_add(&bar[XB_TOP], 1u);
            const unsigned tg = og / nx;
            if (og + 1u == (tg + 1u) * nx) xb_add(&bar[XB_TOPGEN], 1u);
            else XB_SPIN(xb_ld(&bar[XB_TOPGEN]) == tg, bar);
            __builtin_amdgcn_fence(__ATOMIC_ACQUIRE, "agent");
            xb_add(&bar[XB_XGEN(b.x)], 1u);
            asm volatile("s_waitcnt vmcnt(0)" ::: "memory");
        } else {
            XB_SPIN(xb_ld(&bar[XB_XGEN(b.x)]) == gen, bar);
            __builtin_amdgcn_fence(__ATOMIC_ACQUIRE, "agent");
            asm volatile("s_waitcnt vmcnt(0)" ::: "memory");
        }
    }
    __syncthreads();
}

struct Args { const float* in[29]; float* out; unsigned char* ws; };
enum { I_X = 0, I_META, I_N1G, I_WIN, I_MU, I_WUP, I_W0, I_AUP, I_A0, I_KK, I_KA, I_RK, I_LNG, I_LNB, I_FB, I_QG, I_KG, I_WPR, I_WPS, I_WPF, I_WOUT, I_N2G, I_MWG, I_MBG, I_MWE, I_MBE, I_MGATE, I_MUP, I_MDOWN };
struct ArgsL { volatile LAS unsigned* tab; float* out; unsigned char* ws;
    __device__ __forceinline__ const float* in(int i) const { const unsigned lo = tab[2 * i], hi = tab[2 * i + 1];
        return (const float*)(((unsigned long long)(unsigned)__builtin_amdgcn_readfirstlane((int)hi) << 32) | (unsigned long long)(unsigned)__builtin_amdgcn_readfirstlane((int)lo)); }
};
struct Frame { LAS unsigned char* lds; volatile LAS unsigned* MISC; int tid, lane, wave, bx; };

__device__ __forceinline__ float* hrow(const ArgsL& a, int b, int l) {
    return l < NMETA ? (float*)(a.ws + WS_HM) + (size_t)(b * NMETA + l) * D : a.out + ((size_t)b * SEQ + (l - NMETA)) * D;
}
#define LDS_WAIT() asm volatile("s_waitcnt lgkmcnt(0)" ::: "memory")
#define HB_PTR(a) ((bf16_t*)((a).ws + WS_HB))
#define A_PTR(a) ((bf16_t*)((a).out))

__device__ __forceinline__ void tr_item(const float* W, int ldw, int sc0, int nvalid, int k0, int kvalid, bf16_t* WT, int Kd, int r0, LAS float* scr, int lane) {
    float tv[32];
#pragma unroll
    for (int i = 0; i < 32; ++i) { const int kk = 2 * i + (lane >> 5), n = lane & 31; tv[i] = 0.f;
        if (n < nvalid && k0 + kk < kvalid) tv[i] = W[(size_t)(k0 + kk) * ldw + sc0 + n]; }
#pragma unroll
    for (int i = 0; i < 32; ++i) { const int kk = 2 * i + (lane >> 5), n = lane & 31; scr[kk * 33 + n] = tv[i]; }
    LDS_WAIT();
    const int c = lane & 7;
#pragma unroll
    for (int j = 0; j < 4; ++j) { const int n = (lane >> 3) + 8 * j; const LAS float* s = scr + (8 * c) * 33 + n;
        u32x4 o; o.x = pk2(s[0 * 33], s[1 * 33]); o.y = pk2(s[2 * 33], s[3 * 33]); o.z = pk2(s[4 * 33], s[5 * 33]); o.w = pk2(s[6 * 33], s[7 * 33]);
        *(u32x4*)(WT + (size_t)(r0 + n) * Kd + k0 + 8 * c) = o; }
    LDS_WAIT();
}
__device__ __forceinline__ void tr_item2(const float* W, int ldw, int sc0, int nvalid, int k0, int kvalid, bf16_t* WT, int Kd, int r0, int kd0, LAS float* scr, int lane) {
    float tv[32];
#pragma unroll
    for (int i = 0; i < 32; ++i) { const int kk = 2 * i + (lane >> 5), n = lane & 31; tv[i] = 0.f;
        if (n < nvalid && k0 + kk < kvalid) tv[i] = W[(size_t)(k0 + kk) * ldw + sc0 + n]; }
#pragma unroll
    for (int i = 0; i < 32; ++i) { const int kk = 2 * i + (lane >> 5), n = lane & 31; scr[kk * 33 + n] = tv[i]; }
    LDS_WAIT();
    const int c = lane & 7;
#pragma unroll
    for (int j = 0; j < 4; ++j) { const int n = (lane >> 3) + 8 * j; const LAS float* s = scr + (8 * c) * 33 + n;
        u32x4 o; o.x = pk2(s[0 * 33], s[1 * 33]); o.y = pk2(s[2 * 33], s[3 * 33]); o.z = pk2(s[4 * 33], s[5 * 33]); o.w = pk2(s[6 * 33], s[7 * 33]);
        *(u32x4*)(WT + (size_t)(r0 + n) * Kd + kd0 + 8 * c) = o; }
    LDS_WAIT();
}
__device__ __forceinline__ void phase_wconv(const ArgsL& a, Frame& F, int layer) {
    LAS float* scr = (LAS float*)(F.lds + F.wave * 8448);
    const int gw = F.bx * NWAVES + F.wave, NGW = gridDim.x * NWAVES;
    constexpr int C1 = 16 * 104, C2_ = C1 + 16 * 96, C3 = C2_ + 6 * 96, C4 = C3 + 16 * 32, C5 = C4 + 16 * 256, C6 = C5 + 4 * 512;
    unsigned char* ws = a.ws;
    for (int it = gw; it < C6; it += NGW) {
        if (it < C1) { const int kb = it / 104, nb = it % 104, r0 = nb * 32;
            tr_item(a.in(I_WIN) + (size_t)layer * D * D_IN, D_IN, r0, r0 < FCOL ? 32 : 0, kb * 64, 1024, (bf16_t*)(ws + WS_WIN), 1024, r0, scr, F.lane); }
        else if (it < C2_) { const int r = it - C1, kb = r / 96, nb = r % 96, r0 = nb * 32;
            tr_item(a.in(I_WIN) + (size_t)layer * D * D_IN, D_IN, GCOL + r0, 32, kb * 64, 1024, (bf16_t*)(ws + WS_WG), 1024, r0, scr, F.lane); }
        else if (it < C3) { const int r = it - C2_, kb = r / 32, nb = r % 32, r0 = nb * 32, br = kb / 6, k0 = (kb % 6) * 64;
            const float* W = (br == 0 ? a.in(I_WPR) + (size_t)layer * 384 * D : br == 1 ? a.in(I_WPS) + (size_t)layer * 320 * D : a.in(I_WPF) + (size_t)layer * 320 * D);
            tr_item2(W, D, r0, 32, k0, br == 0 ? 384 : 320, (bf16_t*)(ws + WS_WP), YC_W, r0, br * 384 + k0, scr, F.lane); }
        else if (it < C4) { const int r = it - C3, kb = r / 32, nb = r % 32, r0 = nb * 32;
            tr_item(a.in(I_WOUT) + (size_t)layer * D * D, D, r0, 32, kb * 64, 1024, (bf16_t*)(ws + WS_WO), 1024, r0, scr, F.lane); }
        else if (it < C5) { const int r = it - C4, kb = r / 256, nb = r % 256, r0 = nb * 32, e = r0 >> 9, rr = r0 & 511, j = rr >> 8, q = rr & 255;
            const float* W = (q >= 128 ? a.in(I_MUP) : a.in(I_MGATE)) + ((size_t)layer * NEXP + e) * D * DEXP;
            tr_item(W, DEXP, j * 128 + (q & 127), 32, kb * 64, 1024, (bf16_t*)(ws + WS_WGU), 1024, r0, scr, F.lane); }
        else { const int r = it - C5, kb = r / 512, nb = r % 512, r0 = nb * 32, e = r0 >> 10;
            tr_item(a.in(I_MDOWN) + ((size_t)layer * NEXP + e) * DEXP * D, D, r0 & 1023, 32, kb * 64, 256, (bf16_t*)(ws + WS_WD), 256, r0, scr, F.lane); }
    }
}

__device__ __forceinline__ void add_y_row(f32x4 (&v)[4], const bf16_t* Y, int slot, int lane) {
    const u32x2* y = (const u32x2*)(Y + (size_t)slot * D) + lane;
#pragma unroll
    for (int j = 0; j < 4; ++j) { const u32x2 t = y[64 * j]; v[j].x += bf_lo(t.x); v[j].y += bf_hi(t.x); v[j].z += bf_lo(t.y); v[j].w += bf_hi(t.y); }
}
template <int MODE>
__device__ __forceinline__ void phase_norm(const ArgsL& a, Frame& F, int layer, const bool dry = false) {
    const int lane = F.lane;
    LAS float* wl = (LAS float*)F.lds;
    LAS int* lcnt = (LAS int*)(F.lds + 20 * 4096);
    unsigned char* ws = a.ws;
    if (MODE == 1) {
        const float* win = a.in(I_WIN) + (size_t)layer * D * D_IN;
        for (int idx = F.tid; idx < 5 * 1024; idx += NTHR) { const int j = idx >> 10, k = idx & 1023; wl[j * 1024 + k] = win[(size_t)k * D_IN + FCOL + j]; }
    }
    if (MODE == 2) {
        const float* wg = a.in(I_MWG) + (size_t)layer * D * 4; const float* we = a.in(I_MWE) + (size_t)layer * D * 16;
        for (int i4 = F.tid; i4 < 1024; i4 += NTHR) { const f32x4 f = *(const f32x4*)(wg + 4 * i4); wl[i4] = f.x; wl[1024 + i4] = f.y; wl[2048 + i4] = f.z; wl[3072 + i4] = f.w; }
        for (int i4 = F.tid; i4 < 4096; i4 += NTHR) { const int k = i4 >> 2, c = i4 & 3; const f32x4 f = *(const f32x4*)(we + 4 * i4); LAS float* d = wl + (4 + 4 * c) * 1024 + k;
            d[0] = f.x; d[1024] = f.y; d[2048] = f.z; d[3072] = f.w; }
        if (F.tid < 16) lcnt[F.tid] = 0;
    }
    __syncthreads();
    const int gw = F.bx * NWAVES + F.wave, NGW = gridDim.x * NWAVES;
    const float* gsrc = (MODE == 2 ? a.in(I_N2G) : a.in(I_N1G)) + layer * D;
    f32x4 gv[4];
#pragma unroll
    for (int j = 0; j < 4; ++j) gv[j] = (MODE == 0) ? (f32x4){0.f, 0.f, 0.f, 0.f} : *(const f32x4*)(gsrc + 4 * lane + 256 * j);
    bf16_t* A = A_PTR(a); bf16_t* HB = HB_PTR(a);
    const bf16_t* Y = (const bf16_t*)(ws + WS_Y);
    const int* SLOT = (const int*)(ws + WS_SLOT);
    constexpr bool COMB0 = (MODE == 0);
    const bool comb = COMB0 || (MODE == 1 && layer > 0);
    f32x4 vn[4]; u32x2 yan[4], ybn[4];
#pragma unroll
    for (int j = 0; j < 4; ++j) { vn[j] = (f32x4){0.f, 0.f, 0.f, 0.f}; yan[j] = (u32x2){0u, 0u}; ybn[j] = (u32x2){0u, 0u}; }
#define NRM_VALID(mm) ((mm) < M && ((mm) % T) - PADR >= (MODE == 0 ? NMETA : 0))
#define NRM_LOAD(mm, s0_, s1_) do { if (NRM_VALID(mm)) { const int bb_ = (mm) / T, ll_ = (mm) - bb_ * T - PADR; \
        if (MODE == 1 && layer == 0) { const float* src_ = (ll_ < NMETA) ? a.in(I_META) + (size_t)ll_ * D : a.in(I_X) + ((size_t)bb_ * SEQ + (ll_ - NMETA)) * D; \
            _Pragma("unroll") for (int j = 0; j < 4; ++j) vn[j] = *(const f32x4*)(src_ + 4 * lane + 256 * j); } \
        else { const u32x2* hs_ = (const u32x2*)(HB + (size_t)(mm) * D) + lane; \
            _Pragma("unroll") for (int j = 0; j < 4; ++j) { const u32x2 t_ = hs_[64 * j]; vn[j] = (f32x4){bf_lo(t_.x), bf_hi(t_.x), bf_lo(t_.y), bf_hi(t_.y)}; } } \
        if (comb) { const u32x2* y0_ = (const u32x2*)(Y + (size_t)(s0_) * D) + lane; const u32x2* y1_ = (const u32x2*)(Y + (size_t)(s1_) * D) + lane; \
            _Pragma("unroll") for (int j = 0; j < 4; ++j) { yan[j] = y0_[64 * j]; ybn[j] = y1_[64 * j]; } } } } while (0)
    int sa1 = 0, sb1 = 0, sa2 = 0, sb2 = 0;
    if (comb) { if (NRM_VALID(gw)) { sa1 = SLOT[2 * gw]; sb1 = SLOT[2 * gw + 1]; } if (NRM_VALID(gw + NGW)) { sa2 = SLOT[2 * (gw + NGW)]; sb2 = SLOT[2 * (gw + NGW) + 1]; } }
    NRM_LOAD(gw, sa1, sb1);
    for (int m = gw; m < M; m += NGW) {
        f32x4 v[4]; u32x2 ya[4], yb[4];
#pragma unroll
        for (int j = 0; j < 4; ++j) { v[j] = vn[j]; ya[j] = yan[j]; yb[j] = ybn[j]; }
        int sa3 = 0, sb3 = 0;
        if (comb && NRM_VALID(m + 2 * NGW)) { sa3 = SLOT[2 * (m + 2 * NGW)]; sb3 = SLOT[2 * (m + 2 * NGW) + 1]; }
        NRM_LOAD(m + NGW, sa2, sb2);
        sa2 = sa3; sb2 = sb3;
        const int b = m / T, p = m - b * T, l = p - PADR;
        if (l < 0) {
            if (MODE == 1 && !dry) {
                u32x2* o = (u32x2*)(A + (size_t)m * D) + lane;
#pragma unroll
                for (int j = 0; j < 4; ++j) o[64 * j] = (u32x2){0u, 0u};
                if (lane < 8) ((float*)(ws + WS_LOGF))[(size_t)m * 8 + lane] = 0.f;
            }
            continue;
        }
        if (MODE == 0 && l < NMETA) continue;
        if (comb) {
#pragma unroll
            for (int j = 0; j < 4; ++j) { v[j].x += bf_lo(ya[j].x) + bf_lo(yb[j].x); v[j].y += bf_hi(ya[j].x) + bf_hi(yb[j].x); v[j].z += bf_lo(ya[j].y) + bf_lo(yb[j].y); v[j].w += bf_hi(ya[j].y) + bf_hi(yb[j].y); }
        }
        if (MODE == 0 && !dry) { float* op = a.out + ((size_t)b * SEQ + (l - NMETA)) * D;
#pragma unroll
            for (int j = 0; j < 4; ++j) *(f32x4*)(op + 4 * lane + 256 * j) = v[j]; }
        if (MODE == 1 && !dry) { u32x2* hd = (u32x2*)(HB + (size_t)m * D) + lane;
#pragma unroll
            for (int j = 0; j < 4; ++j) hd[64 * j] = (u32x2){pk2(v[j].x, v[j].y), pk2(v[j].z, v[j].w)};
        }
        if (MODE == 0) continue;
        float ss = 0.f;
#pragma unroll
        for (int j = 0; j < 4; ++j) ss += (v[j].x * v[j].x + v[j].y * v[j].y) + (v[j].z * v[j].z + v[j].w * v[j].w);
        const float r = 1.0f / sqrtf(wave_sum(ss) * (1.0f / D) + 1e-6f);
#pragma unroll
        for (int j = 0; j < 4; ++j) v[j] = v[j] * r * gv[j];
        u32x2* o = (u32x2*)(A + (size_t)m * D) + lane;
        if (!dry) {
#pragma unroll
        for (int j = 0; j < 4; ++j) o[64 * j] = (u32x2){pk2(v[j].x, v[j].y), pk2(v[j].z, v[j].w)}; }
        else { float sink = v[0].x + v[1].y + v[2].z + v[3].w; asm volatile("" :: "v"(sink)); }
        if (MODE == 1) {
            float dsum[5];
#pragma unroll
            for (int q = 0; q < 5; ++q) { float d = 0.f;
#pragma unroll
                for (int j = 0; j < 4; ++j) { const f32x4 w = *(const LAS f32x4*)(wl + q * 1024 + 4 * lane + 256 * j); d += (v[j].x * w.x + v[j].y * w.y) + (v[j].z * w.z + v[j].w * w.w); }
                dsum[q] = wave_sum(d); }
            float mine = dsum[0];
            mine = lane == 1 ? dsum[1] : mine; mine = lane == 2 ? dsum[2] : mine; mine = lane == 3 ? dsum[3] : mine; mine = lane == 4 ? dsum[4] : mine;
            if (lane < 8 && !dry) { float lf = 0.f;
                if (lane < 5) { const float xx = mine + a.in(I_FB)[layer * 5 + lane]; lf = fminf(xx, 0.f) - fast_log(1.f + fast_exp(-fabsf(xx))); }
                ((float*)(ws + WS_LOGF))[(size_t)m * 8 + lane] = lf; }
        }
        if (MODE == 2) {
            float dp[20];
#pragma unroll
            for (int q = 0; q < 20; ++q) { float d = 0.f;
#pragma unroll
                for (int j = 0; j < 4; ++j) { const f32x4 w = *(const LAS f32x4*)(wl + q * 1024 + 4 * lane + 256 * j); d += (v[j].x * w.x + v[j].y * w.y) + (v[j].z * w.z + v[j].w * w.w); }
                dp[q] = d; }
            float sA[10], sB[5];
#pragma unroll
            for (int i = 0; i < 10; ++i) { auto sw = __builtin_amdgcn_permlane32_swap(__float_as_uint(dp[2 * i]), __float_as_uint(dp[2 * i + 1]), false, false); sA[i] = __uint_as_float(sw[0]) + __uint_as_float(sw[1]); }
#pragma unroll
            for (int i = 0; i < 5; ++i) { auto sw = __builtin_amdgcn_permlane16_swap(__float_as_uint(sA[2 * i]), __float_as_uint(sA[2 * i + 1]), false, false); sB[i] = allred16(__uint_as_float(sw[0]) + __uint_as_float(sw[1])); }
            LAS float* red = (LAS float*)(F.lds + 81920 + 256) + F.wave * 32;
            { const int rho = lane >> 4, vsel = ((rho & 1) << 1) | (rho >> 1);
              if ((lane & 15) == 0) {
#pragma unroll
                  for (int i = 0; i < 5; ++i) red[4 * i + vsel] = sB[i]; } }
            LDS_WAIT();
            float ds[20];
#pragma unroll
            for (int i = 0; i < 5; ++i) { const f32x4 t4 = *(const LAS f32x4*)(red + 4 * i); ds[4 * i] = t4.x; ds[4 * i + 1] = t4.y; ds[4 * i + 2] = t4.z; ds[4 * i + 3] = t4.w; }
            LDS_WAIT();
            const float* bg = a.in(I_MBG) + layer * 4; const float* be = a.in(I_MBE) + layer * 16;
            float lg0 = ds[0] + bg[0], lg1 = ds[1] + bg[1], lg2 = ds[2] + bg[2], lg3 = ds[3] + bg[3];
            int g = 0; float mx = lg0;
            if (lg1 > mx) { mx = lg1; g = 1; } if (lg2 > mx) { mx = lg2; g = 2; } if (lg3 > mx) { mx = lg3; g = 3; }
            const float den = fast_exp(lg0 - mx) + fast_exp(lg1 - mx) + fast_exp(lg2 - mx) + fast_exp(lg3 - mx);
            const float pgrp = 1.0f / den;
            float s0 = g == 0 ? ds[4] : g == 1 ? ds[8] : g == 2 ? ds[12] : ds[16];
            float s1 = g == 0 ? ds[5] : g == 1 ? ds[9] : g == 2 ? ds[13] : ds[17];
            float s2 = g == 0 ? ds[6] : g == 1 ? ds[10] : g == 2 ? ds[14] : ds[18];
            float s3 = g == 0 ? ds[7] : g == 1 ? ds[11] : g == 2 ? ds[15] : ds[19];
            s0 += be[g * 4 + 0]; s1 += be[g * 4 + 1]; s2 += be[g * 4 + 2]; s3 += be[g * 4 + 3];
            int i0 = 0; float v0 = s0;
            if (s1 > v0) { v0 = s1; i0 = 1; } if (s2 > v0) { v0 = s2; i0 = 2; } if (s3 > v0) { v0 = s3; i0 = 3; }
            int i1 = -1; float v1 = -3.0e38f;
            if (i0 != 0 && s0 > v1) { v1 = s0; i1 = 0; } if (i0 != 1 && s1 > v1) { v1 = s1; i1 = 1; } if (i0 != 2 && s2 > v1) { v1 = s2; i1 = 2; } if (i0 != 3 && s3 > v1) { v1 = s3; i1 = 3; }
            const float e1 = fast_exp(v1 - v0), pt0 = 1.0f / (1.0f + e1), pt1 = e1 * pt0;
            if (dry) { float sink = pgrp * pt0 + pt1; asm volatile("" :: "v"(sink)); }
            if (lane == 0 && !dry) {
                const int ea = g * 4 + i0, eb = g * 4 + i1;
                const int la = atomicAdd((int*)&lcnt[ea], 1), lb = atomicAdd((int*)&lcnt[eb], 1);
                int* tk = (int*)(ws + WS_TOK) + (size_t)m * 8;
                tk[0] = ea; tk[1] = eb; tk[2] = __float_as_int(pgrp * pt0); tk[3] = __float_as_int(pgrp * pt1); tk[4] = la; tk[5] = lb;
            }
        }
    }
    __syncthreads();
#undef NRM_LOAD
#undef NRM_VALID
    if (MODE == 2 && F.tid < 16 && !dry) {
        const int c = lcnt[F.tid];
        ((int*)(ws + WS_WGCNT))[F.bx * 16 + F.tid] = c;
        atomicAdd((int*)(ws + WS_CTL) + CW_ECNT + 64 * layer + F.tid, c);
    }
    __syncthreads();
}

__device__ __forceinline__ void phase_norm2(const ArgsL& a, Frame& F, int layer, const bool dry = false) {
    const int lane = F.lane;
    LAS float* wl = (LAS float*)F.lds;
    LAS int* lcnt = (LAS int*)(F.lds + 20 * 4096);
    unsigned char* ws = a.ws;
    {
        const float* wg = a.in(I_MWG) + (size_t)layer * D * 4; const float* we = a.in(I_MWE) + (size_t)layer * D * 16;
        for (int i4 = F.tid; i4 < 1024; i4 += NTHR) { const f32x4 f = *(const f32x4*)(wg + 4 * i4); wl[i4] = f.x; wl[1024 + i4] = f.y; wl[2048 + i4] = f.z; wl[3072 + i4] = f.w; }
        for (int i4 = F.tid; i4 < 4096; i4 += NTHR) { const int k = i4 >> 2, c = i4 & 3; const f32x4 f = *(const f32x4*)(we + 4 * i4); LAS float* d = wl + (4 + 4 * c) * 1024 + k;
            d[0] = f.x; d[1024] = f.y; d[2048] = f.z; d[3072] = f.w; }
        if (F.tid < 16) lcnt[F.tid] = 0;
    }
    __syncthreads();
    const int gw = F.bx * NWAVES + F.wave, NGW = gridDim.x * NWAVES;
    LAS float* gl = (LAS float*)(F.lds + 86016);
    LAS float* bl = (LAS float*)(F.lds + 90112);
    for (int i = F.tid; i < 1024; i += NTHR) gl[i] = a.in(I_N2G)[layer * D + i];
    if (F.tid < 4) bl[F.tid] = a.in(I_MBG)[layer * 4 + F.tid];
    if (F.tid >= 64 && F.tid < 80) bl[4 + F.tid - 64] = a.in(I_MBE)[layer * 16 + F.tid - 64];
    __syncthreads();
    bf16_t* A = A_PTR(a); const bf16_t* HB = HB_PTR(a);
    LAS float* red = (LAS float*)(F.lds + 81920 + 256) + F.wave * 96;
#define N2_VALID(mm) ((mm) < M && ((mm) % T) >= PADR)
    constexpr int NR = 2;
    for (int m0 = gw; m0 < M; m0 += NR * NGW) {
        f32x4 v[NR][4];
#pragma unroll
        for (int rr = 0; rr < NR; ++rr) { const int mm_ = m0 + rr * NGW;
            if (N2_VALID(mm_)) { const u32x2* hs_ = (const u32x2*)(HB + (size_t)mm_ * D) + lane;
#pragma unroll
                for (int j = 0; j < 4; ++j) { const u32x2 t = hs_[64 * j]; v[rr][j] = (f32x4){bf_lo(t.x), bf_hi(t.x), bf_lo(t.y), bf_hi(t.y)}; } }
            else {
#pragma unroll
                for (int j = 0; j < 4; ++j) v[rr][j] = (f32x4){0.f, 0.f, 0.f, 0.f}; } }
        float ss[NR];
#pragma unroll
        for (int rr = 0; rr < NR; ++rr) { float s_ = 0.f;
#pragma unroll
            for (int j = 0; j < 4; ++j) s_ += (v[rr][j].x * v[rr][j].x + v[rr][j].y * v[rr][j].y) + (v[rr][j].z * v[rr][j].z + v[rr][j].w * v[rr][j].w);
            ss[rr] = s_; }
#pragma unroll
        for (int rr = 0; rr < NR; ++rr) ss[rr] = wave_sum(ss[rr]);
#pragma unroll
        for (int rr = 0; rr < NR; ++rr) { const int mm = m0 + rr * NGW; const float r = 1.0f / sqrtf(ss[rr] * (1.0f / D) + 1e-6f);
#pragma unroll
            for (int j = 0; j < 4; ++j) v[rr][j] = v[rr][j] * r * *(const LAS f32x4*)(gl + 4 * lane + 256 * j);
            if (N2_VALID(mm) && !dry) { u32x2* o = (u32x2*)(A + (size_t)mm * D) + lane;
#pragma unroll
                for (int j = 0; j < 4; ++j) o[64 * j] = (u32x2){pk2(v[rr][j].x, v[rr][j].y), pk2(v[rr][j].z, v[rr][j].w)}; } }
        { const int rho = lane >> 4, vsel = ((rho & 1) << 1) | (rho >> 1);
#pragma unroll
          for (int qh = 0; qh < 2; ++qh) {
            float dp[NR][10];
#pragma unroll
            for (int q = 0; q < 10; ++q) { f32x4 w[4];
#pragma unroll
                for (int j = 0; j < 4; ++j) w[j] = *(const LAS f32x4*)(wl + (qh * 10 + q) * 1024 + 4 * lane + 256 * j);
#pragma unroll
                for (int rr = 0; rr < NR; ++rr) { float d = 0.f;
#pragma unroll
                    for (int j = 0; j < 4; ++j) d += (v[rr][j].x * w[j].x + v[rr][j].y * w[j].y) + (v[rr][j].z * w[j].z + v[rr][j].w * w[j].w);
                    dp[rr][q] = d; }
                if (q & 1) __builtin_amdgcn_sched_barrier(0); }
#pragma unroll
            for (int rr = 0; rr < NR; ++rr) { float sA[6], sB[3]; sA[5] = 0.f;
#pragma unroll
                for (int i = 0; i < 5; ++i) { auto sw = __builtin_amdgcn_permlane32_swap(__float_as_uint(dp[rr][2 * i]), __float_as_uint(dp[rr][2 * i + 1]), false, false); sA[i] = __uint_as_float(sw[0]) + __uint_as_float(sw[1]); }
#pragma unroll
                for (int k = 0; k < 3; ++k) { auto sw = __builtin_amdgcn_permlane16_swap(__float_as_uint(sA[2 * k]), __float_as_uint(sA[2 * k + 1]), false, false); sB[k] = allred16(__uint_as_float(sw[0]) + __uint_as_float(sw[1])); }
                if ((lane & 15) == 0) {
#pragma unroll
                    for (int k = 0; k < 3; ++k) red[rr * 24 + qh * 10 + 4 * k + vsel] = sB[k]; } }
            __builtin_amdgcn_sched_barrier(0);
          } }
        LDS_WAIT();
        if (lane < NR) {
            const int mm = m0 + lane * NGW;
            float ds[20];
#pragma unroll
            for (int i = 0; i < 5; ++i) { const f32x4 t4 = *(const LAS f32x4*)(red + lane * 24 + 4 * i); ds[4 * i] = t4.x; ds[4 * i + 1] = t4.y; ds[4 * i + 2] = t4.z; ds[4 * i + 3] = t4.w; }
            const float lg0 = ds[0] + bl[0], lg1 = ds[1] + bl[1], lg2 = ds[2] + bl[2], lg3 = ds[3] + bl[3];
            int g = 0; float mx = lg0;
            if (lg1 > mx) { mx = lg1; g = 1; } if (lg2 > mx) { mx = lg2; g = 2; } if (lg3 > mx) { mx = lg3; g = 3; }
            const float den = fast_exp(lg0 - mx) + fast_exp(lg1 - mx) + fast_exp(lg2 - mx) + fast_exp(lg3 - mx);
            const float pgrp = 1.0f / den;
            const f32x4 be4 = *(const LAS f32x4*)(bl + 4 + 4 * g);
            float s0 = (g == 0 ? ds[4] : g == 1 ? ds[8] : g == 2 ? ds[12] : ds[16]) + be4.x;
            float s1 = (g == 0 ? ds[5] : g == 1 ? ds[9] : g == 2 ? ds[13] : ds[17]) + be4.y;
            float s2 = (g == 0 ? ds[6] : g == 1 ? ds[10] : g == 2 ? ds[14] : ds[18]) + be4.z;
            float s3 = (g == 0 ? ds[7] : g == 1 ? ds[11] : g == 2 ? ds[15] : ds[19]) + be4.w;
            int i0 = 0; float v0 = s0;
            if (s1 > v0) { v0 = s1; i0 = 1; } if (s2 > v0) { v0 = s2; i0 = 2; } if (s3 > v0) { v0 = s3; i0 = 3; }
            int i1 = -1; float v1 = -3.0e38f;
            if (i0 != 0 && s0 > v1) { v1 = s0; i1 = 0; } if (i0 != 1 && s1 > v1) { v1 = s1; i1 = 1; } if (i0 != 2 && s2 > v1) { v1 = s2; i1 = 2; } if (i0 != 3 && s3 > v1) { v1 = s3; i1 = 3; }
            const float e1 = fast_exp(v1 - v0), pt0 = 1.0f / (1.0f + e1), pt1 = e1 * pt0;
            if (N2_VALID(mm) && !dry) {
                const int ea = g * 4 + i0, eb = g * 4 + i1;
                const int la = atomicAdd((int*)&lcnt[ea], 1), lb = atomicAdd((int*)&lcnt[eb], 1);
                int* tk = (int*)(ws + WS_TOK) + (size_t)mm * 8;
                tk[0] = ea; tk[1] = eb; tk[2] = __float_as_int(pgrp * pt0); tk[3] = __float_as_int(pgrp * pt1); tk[4] = la; tk[5] = lb;
            } else { float sink = pgrp * pt0 + pt1; asm volatile("" :: "v"(sink)); }
        }
        LDS_WAIT();
    }
#undef N2_VALID
    __syncthreads();
    if (F.tid < 16 && !dry) {
        const int c = lcnt[F.tid];
        ((int*)(ws + WS_WGCNT))[F.bx * 16 + F.tid] = c;
        atomicAdd((int*)(ws + WS_CTL) + CW_ECNT + 64 * layer + F.tid, c);
    }
    __syncthreads();
}

__device__ __forceinline__ void phase_route(const ArgsL& a, Frame& F, int layer) {
    unsigned char* ws = a.ws;
    LAS int* tbl = (LAS int*)F.lds;
    LAS int* part = tbl + 16;
    {
        const int e = F.tid & 15, q = F.tid >> 4; const int* wc = (const int*)(ws + WS_WGCNT); int acc = 0;
#pragma unroll
        for (int i = 0; i < 8; ++i) { const int w = q + 32 * i; if (w < (int)F.bx) acc += wc[w * 16 + e]; }
        part[q * 16 + e] = acc;
    }
    __syncthreads();
    if (F.tid < 16) {
        const int* cnt = (const int*)(ws + WS_CTL) + CW_ECNT + 64 * layer;
        int cv[16];
#pragma unroll
        for (int e = 0; e < 16; ++e) cv[e] = __hip_atomic_load(cnt + e, __ATOMIC_RELAXED, __HIP_MEMORY_SCOPE_AGENT);
        int base = 0;
#pragma unroll
        for (int e = 0; e < 16; ++e) if (e < F.tid) base += ((cv[e] + 255) >> 8) << 8;
#pragma unroll
        for (int q = 0; q < 32; ++q) base += part[q * 16 + F.tid];
        tbl[F.tid] = base; tbl[16 + 512 + F.tid] = __hip_atomic_load(cnt + F.tid, __ATOMIC_RELAXED, __HIP_MEMORY_SCOPE_AGENT);
    }
    __syncthreads();
    if (F.bx == 0) {
        int* s2t = (int*)(ws + WS_S2T);
        for (int e = 0; e < 16; ++e) { const int n = tbl[16 + 512 + e], b0 = tbl[e] + n, pad = (((n + 255) >> 8) << 8) - n;
            for (int i = F.tid; i < pad; i += NTHR) s2t[b0 + i] = 0; }
    }
    int* s2t = (int*)(ws + WS_S2T);
    for (int j = F.tid; j < 8 * ((M + 2047) / 2048); j += NTHR) {
        const int m = (j >> 3) * 2048 + (int)F.bx * 8 + (j & 7);
        if (m >= M) continue;
        const int b = m / T, p = m - b * T;
        if (p < PADR) continue;
        const int* tk_ = (const int*)(ws + WS_TOK) + (size_t)m * 8;
        const u32x4 t4 = *(const u32x4*)tk_; const u32x2 t2 = *(const u32x2*)(tk_ + 4);
        const int ea = (int)t4.x, eb = (int)t4.y, sa = tbl[ea] + (int)t2.x, sb = tbl[eb] + (int)t2.y;
        s2t[sa] = m; s2t[sb] = m;
        int* sl = (int*)(ws + WS_SLOT) + 2 * m; sl[0] = sa; sl[1] = sb;
        float* cw = (float*)(ws + WS_CWS); cw[sa] = __uint_as_float(t4.z); cw[sb] = __uint_as_float(t4.w);
    }
    __syncthreads();
}

#ifndef PR_STAGES
#define PR_STAGES 15
#endif
__device__ __forceinline__ void phase_prep(const ArgsL& a, Frame& F, int layer, const unsigned* g1cnt, unsigned* qhead, const bool dry = false) {
    unsigned char* ws = a.ws;
    LAS float* xs = (LAS float*)F.lds;
    const int wave = F.wave, lane = F.lane, tid = F.tid;
    const bf16_t* USH = (const bf16_t*)(ws + WS_USH);
    bf16_t* QKV = (bf16_t*)(ws + WS_QKV);
    if (F.bx < 10 && (!dry || (PR_STAGES & 8))) {
        const int bh = F.bx, b = bh / 5, h = bh % 5;
        const float* LOGF = (const float*)(ws + WS_LOGF) + (size_t)(b * T + PADR) * 8 + h;
        float* kb = (float*)(ws + WS_KB2) + (size_t)bh * KBP;
        LAS float* wtot = (LAS float*)F.lds;
        float v[33];
        const int l0 = tid * 33;
#pragma unroll
        for (int i = 0; i < 33; ++i) v[i] = (l0 + i < LTOK) ? LOGF[(size_t)(l0 + i) * 8] : 0.f;
#pragma unroll
        for (int i = 1; i < 33; ++i) v[i] += v[i - 1];
        float incl = v[32];
#pragma unroll
        for (int o = 1; o < 64; o <<= 1) { const float t = __shfl_up(incl, o); if (lane >= o) incl += t; }
        if (lane == 63) wtot[wave] = incl;
        __syncthreads();
        float off = incl - v[32];
        for (int w = 0; w < wave; ++w) off += wtot[w];
#pragma unroll
        for (int i = 0; i < 33; ++i) if (l0 + i < LTOK && !dry) kb[PADR + l0 + i] = -(off + v[i]) * LOG2E;
        for (int p = tid; p < PADR; p += NTHR) kb[p] = 0.f;
        for (int p = T + tid; p < KBP; p += NTHR) kb[p] = 0.f;
        __syncthreads();
    }
    if (F.bx >= 16 && F.bx < 28) {
        unsigned* z = (unsigned*)(ws + WS_RW + ((size_t)(F.bx - 16) * LPADDED + LTOK) * 768);
        for (int i = tid; i < (LPADDED - LTOK) * 192; i += NTHR) z[i] = 0u;
    }
    const int r16 = lane & 15, q4 = lane >> 4, hh = wave < 6 ? wave : 0;
    bf16x8 bw[2][4][2];
    float cw0[4], ca0[4], ckk[4], cka[4], crk[4];
    {
        const float* WUp = a.in(I_WUP) + (size_t)layer * 64 * RW_W + hh * 64 + r16; const float* AUp = a.in(I_AUP) + (size_t)layer * 64 * RW_W + hh * 64 + r16;
#pragma unroll
        for (int mtx = 0; mtx < 2; ++mtx)
#pragma unroll
            for (int blk = 0; blk < 4; ++blk)
#pragma unroll
                for (int ks = 0; ks < 2; ++ks) { const float* p_ = (mtx ? AUp : WUp) + (size_t)(32 * ks + 8 * q4) * RW_W + blk * 16;
                    const float f0 = p_[0], f1 = p_[RW_W], f2 = p_[2 * RW_W], f3 = p_[3 * RW_W], f4 = p_[4 * RW_W], f5 = p_[5 * RW_W], f6 = p_[6 * RW_W], f7 = p_[7 * RW_W];
                    bw[mtx][blk][ks] = __builtin_bit_cast(bf16x8, (u32x4){pk2(f0, f1), pk2(f2, f3), pk2(f4, f5), pk2(f6, f7)}); }
#pragma unroll
        for (int blk = 0; blk < 4; ++blk) { const int ch = layer * RW_W + hh * 64 + blk * 16 + r16;
            cw0[blk] = a.in(I_W0)[ch]; ca0[blk] = a.in(I_A0)[ch]; ckk[blk] = a.in(I_KK)[ch]; cka[blk] = a.in(I_KA)[ch]; crk[blk] = a.in(I_RK)[ch]; }
    }
    const float* mu = a.in(I_MU) + layer * SHIFT_W;
    f32x4 gq4 = *(const f32x4*)(a.in(I_QG) + layer * 64 + (lane & 15) * 4) * C2; const f32x4 gk4 = *(const f32x4*)(a.in(I_KG) + layer * 64 + (lane & 15) * 4);
    _Float16* RW = (_Float16*)(ws + WS_RW);
    bf16_t* BN = (bf16_t*)(ws + WS_BN);
    constexpr int nt = 16, t0 = 0;
    for (;;) {
        if (F.tid == 0) {
            const int j = (int)__hip_atomic_fetch_add(qhead, 1u, __ATOMIC_RELAXED, __HIP_MEMORY_SCOPE_AGENT);
            int bt = -1;
            if (j < 2064) { int p; if (j < 1024) { const int e = j >> 4; p = (e >> 3) * 16 + (e & 7); } else { const int l = (j - 1024) >> 4; p = l < 64 ? (l >> 3) * 16 + 8 + (l & 7) : 128; }
                bt = p * 16 + (j & 15);
                if (bt < 7 || (bt >= 1032 && bt < 1039)) bt = -2;
                else if (!dry) { unsigned polls = 0;
                    while (__hip_atomic_load(g1cnt + CH_STRIDE * p, __ATOMIC_RELAXED, __HIP_MEMORY_SCOPE_AGENT) < 104u) { if (++polls > (1u << 18)) break; __builtin_amdgcn_s_sleep(2); }
                    if ((bt & 15) == 0 && p > 0) { polls = 0;
                        while (__hip_atomic_load(g1cnt + CH_STRIDE * (p - 1), __ATOMIC_RELAXED, __HIP_MEMORY_SCOPE_AGENT) < 104u) { if (++polls > (1u << 18)) break; __builtin_amdgcn_s_sleep(2); } }
                    __builtin_amdgcn_fence(__ATOMIC_ACQUIRE, "agent"); asm volatile("s_waitcnt vmcnt(0)" ::: "memory"); } }
            F.MISC[18] = (unsigned)bt; }
        __syncthreads();
        const int bt_ = (int)F.MISC[18];
        __syncthreads();
        if (bt_ == -1) break;
        if (bt_ == -2) continue;
        const int m0 = bt_ * 16;
        if (!dry || (PR_STAGES & 1)) {
            int tid = F.tid; asm volatile("" : "+v"(tid));
            u32x4 uu4[5], pp4[5];
#pragma unroll
            for (int q5 = 0; q5 < 5; ++q5) { const int item = tid + q5 * NTHR; uu4[q5] = (u32x4){0u, 0u, 0u, 0u}; pp4[q5] = (u32x4){0u, 0u, 0u, 0u};
                if (item < nt * 160) { const int tok = item / 160, ch = item - tok * 160, m = m0 + t0 + tok;
                    uu4[q5] = *(const u32x4*)(USH + (size_t)m * SHIFT_W + ch * 8);
                    if (m > 0) pp4[q5] = *(const u32x4*)(USH + (size_t)(m - 1) * SHIFT_W + ch * 8); } }
#pragma unroll
            for (int q5 = 0; q5 < 5; ++q5) { const int item = tid + q5 * NTHR;
                if (item < nt * 160) { const int tok = item / 160, ch = item - tok * 160;
                    const u32x4 u = uu4[q5], pv = pp4[q5];
                    const f32x4 mu0 = *(const f32x4*)(mu + ch * 8), mu1 = *(const f32x4*)(mu + ch * 8 + 4);
                    float x[8];
                    { float uu, pp;
                      uu = bf_lo(u.x); pp = bf_lo(pv.x); x[0] = uu + (pp - uu) * mu0.x;  uu = bf_hi(u.x); pp = bf_hi(pv.x); x[1] = uu + (pp - uu) * mu0.y;
                      uu = bf_lo(u.y); pp = bf_lo(pv.y); x[2] = uu + (pp - uu) * mu0.z;  uu = bf_hi(u.y); pp = bf_hi(pv.y); x[3] = uu + (pp - uu) * mu0.w;
                      uu = bf_lo(u.z); pp = bf_lo(pv.z); x[4] = uu + (pp - uu) * mu1.x;  uu = bf_hi(u.z); pp = bf_hi(pv.z); x[5] = uu + (pp - uu) * mu1.y;
                      uu = bf_lo(u.w); pp = bf_lo(pv.w); x[6] = uu + (pp - uu) * mu1.z;  uu = bf_hi(u.w); pp = bf_hi(pv.w); x[7] = uu + (pp - uu) * mu1.w; }
                    if (ch >= 144 && ch < 152) {
#pragma unroll
                        for (int q = 0; q < 8; ++q) { const float e = fast_exp(-2.f * fabsf(x[q])); const float th = (1.f - e) / (1.f + e); x[q] = x[q] < 0.f ? -th : th; }
                    }
                    LAS f32x4* d = (LAS f32x4*)(xs + tok * SHIFT_W + ch * 8);
                    d[0] = (f32x4){x[0], x[1], x[2], x[3]}; d[1] = (f32x4){x[4], x[5], x[6], x[7]}; } }
        }
        __syncthreads();
        if (wave < 6) { if (!dry || (PR_STAGES & 2)) {
            f32x4 acc[2][4];
#pragma unroll
            for (int mtx = 0; mtx < 2; ++mtx) {
                bf16x8 af[2];
#pragma unroll
                for (int ks = 0; ks < 2; ++ks) { const LAS float* xp = xs + r16 * SHIFT_W + 1152 + 64 * mtx + 32 * ks + 8 * q4;
                    const f32x4 u0 = *(const LAS f32x4*)xp, u1 = *(const LAS f32x4*)(xp + 4);
                    af[ks] = __builtin_bit_cast(bf16x8, (u32x4){pk2(u0.x, u0.y), pk2(u0.z, u0.w), pk2(u1.x, u1.y), pk2(u1.z, u1.w)}); }
#pragma unroll
                for (int blk = 0; blk < 4; ++blk) { f32x4 c4 = {0.f, 0.f, 0.f, 0.f};
                    c4 = __builtin_amdgcn_mfma_f32_16x16x32_bf16(af[0], bw[mtx][blk][0], c4, 0, 0, 0);
                    c4 = __builtin_amdgcn_mfma_f32_16x16x32_bf16(af[1], bw[mtx][blk][1], c4, 0, 0, 0);
                    acc[mtx][blk] = c4; }
            }
#pragma unroll
            for (int i = 0; i < 4; ++i) {
                const int tok = 4 * q4 + i, m = m0 + t0 + tok, b = m / T, p = m - b * T, l = p - PADR;
                const bool ok = (tok < nt) && (l >= 0);
                const LAS float* xr = xs + (tok < 16 ? tok : 0) * SHIFT_W + hh * 64 + r16;
                float kkr[4], kpv[4], avv4[4], omv[4], rv4[4], vv4[4];
                float ssq = 0.f, cf = 0.f;
#pragma unroll
                for (int blk = 0; blk < 4; ++blk) {
                    const float wlv = cw0[blk] + acc[0][blk][i], alv = ca0[blk] + acc[1][blk][i];
                    const float r = xr[blk * 16], k = xr[384 + blk * 16], v = xr[768 + blk * 16];
                    const float logw = -softplus_f(-wlv) - 0.5f;
                    const float xw = fast_exp(logw);
                    omv[blk] = xw < 0.02f ? xw * (1.f - 0.5f * xw + xw * xw * (1.f / 6.f)) : 1.f - fast_exp(-xw);
                    const float av = 1.f / (1.f + fast_exp(-alv));
                    kkr[blk] = k * ckk[blk]; kpv[blk] = k * (1.f + (av - 1.f) * cka[blk]); avv4[blk] = av; rv4[blk] = r; vv4[blk] = v;
                    ssq += kkr[blk] * kkr[blk]; cf += r * kpv[blk] * crk[blk];
                }
                ssq = allred16(ssq); cf = allred16(cf);
                const float inv = 1.0f / fmaxf(sqrtf(ssq), 1e-12f);
                if (ok && !dry) {
                    _Float16* o = RW + ((size_t)(b * RW_H + hh) * LPADDED + l) * 384 + r16;
#pragma unroll
                    for (int blk = 0; blk < 4; ++blk) { const float kk = kkr[blk] * inv, bb = kk * avv4[blk];
                        o[blk * 16] = (_Float16)kk; o[64 + blk * 16] = (_Float16)(-omv[blk]); o[128 + blk * 16] = (_Float16)(-bb); o[192 + blk * 16] = (_Float16)kpv[blk];
                        o[256 + blk * 16] = (_Float16)rv4[blk]; o[320 + blk * 16] = (_Float16)vv4[blk];
                        BN[(size_t)m * RW_W + hh * 64 + blk * 16 + r16] = f2bf(cf * vv4[blk]); }
                } else { float sink = ssq + cf + inv + omv[0] + kpv[1]; asm volatile("" :: "v"(sink)); }
            } }
        }
        if (!dry || (PR_STAGES & 4)) {
            const int it4 = lane >> 4, e4 = lane & 15;
            u32x2 xv[5]; bf16_t* qp5[5]; bool okv[5];
#pragma unroll
            for (int ps = 0; ps < 5; ++ps) { const int item = (ps * 8 + wave) * 4 + it4, tok = item / 10, hq = item - tok * 10;
                const int m = m0 + t0 + tok, p = m % T;
                okv[ps] = (tok < nt) && (p >= PADR);
                qp5[ps] = QKV + (size_t)m * QKV_W + 960 + hq * 64 + e4 * 4;
                xv[ps] = okv[ps] ? *(const u32x2*)qp5[ps] : (u32x2){0u, 0u}; }
#pragma unroll
            for (int ps = 0; ps < 5; ++ps) { const int item = (ps * 8 + wave) * 4 + it4, hq = item % 10;
                const float x0 = bf_lo(xv[ps].x), x1 = bf_hi(xv[ps].x), x2 = bf_lo(xv[ps].y), x3 = bf_hi(xv[ps].y);
                const float ss = allred16((x0 * x0 + x1 * x1) + (x2 * x2 + x3 * x3));
                const float rs = 1.0f / sqrtf(ss * (1.0f / 64.f) + 1e-6f);
                const f32x4 gg = hq < 5 ? gq4 : gk4;
                const u32x2 w = {pk2(x0 * rs * gg.x, x1 * rs * gg.y), pk2(x2 * rs * gg.z, x3 * rs * gg.w)};
                if (okv[ps] && !dry) *(u32x2*)qp5[ps] = w; else asm volatile("" :: "v"(w.x), "v"(w.y)); }
        }
        __syncthreads();
    }
}


constexpr int SCH = 16;
static_assert(LTOK % SCH == 0, "whole chunks");
__device__ __forceinline__ void rwkv_scan(const ArgsL& a, Frame& F, int wgi, int dry = 0) {
    const int bh = wgi >> 4, q8 = wgi & 15, b = bh / RW_H, h = bh % RW_H;
    const int tid = F.tid, wave = F.wave, lane = F.lane;
    const unsigned char* rw = a.ws + WS_RW + (size_t)bh * LPADDED * 768;
    LAS float* ring = (LAS float*)F.lds;
    LAS float* ypart = (LAS float*)(F.lds + 49152);
    LAS unsigned char* stg = F.lds + 81920;
    bf16_t* y0 = (bf16_t*)(a.ws + WS_YCAT);
    constexpr int NCH = LTOK / SCH;
    const bool isld = (wave & 2) != 0; const int lw = (wave & 1) + ((wave >> 2) << 1), tl = lw * 64 + lane;
    float s0 = 0.f, s1 = 0.f;
    const int i32 = lane & 31, rsel = lane >> 5, rloc = 2 * wave + rsel;
#define RW_BAR() asm volatile("s_waitcnt lgkmcnt(0)\n\ts_barrier" ::: "memory")
#define RW_ISSUE(cc) do { const unsigned char* src_ = rw + (size_t)(cc) * SCH * 768 + (size_t)tl * 16; LAS unsigned char* d_ = stg + ((cc) & 3) * 12288 + lw * 1024; \
        _Pragma("unroll") for (int k_ = 0; k_ < 3; ++k_) __builtin_amdgcn_global_load_lds((const unsigned*)(src_ + k_ * 4096), (LAS unsigned*)(d_ + k_ * 4096), 16, 0, 0); } while (0)
#define RW_CONVERT(cc) do { const LAS unsigned char* s_ = stg + ((cc) & 3) * 12288 + tl * 16; LAS float* rb_ = ring + ((cc) & 1) * 6144; \
        _Pragma("unroll") for (int k_ = 0; k_ < 3; ++k_) { const int pc_ = tl + 256 * k_; const int t_ = pc_ / 48, q_ = pc_ - t_ * 48, vec_ = q_ >> 3, e0_ = (q_ & 7) * 8; \
            const u32x4 w_ = *(const LAS u32x4*)(s_ + k_ * 4096); \
            const f16x4 lo_ = __builtin_bit_cast(f16x4, (u32x2){w_.x, w_.y}), hi_ = __builtin_bit_cast(f16x4, (u32x2){w_.z, w_.w}); \
            const float f0 = (float)lo_.x, f1 = (float)lo_.y, f2 = (float)lo_.z, f3 = (float)lo_.w, f4 = (float)hi_.x, f5 = (float)hi_.y, f6 = (float)hi_.z, f7 = (float)hi_.w; \
            if (vec_ < 4) { LAS float* d_ = rb_ + t_ * 384 + (vec_ >> 1) * 128 + (e0_ >> 1) * 4 + (vec_ & 1) * 2; \
                *(LAS f32x2*)(d_) = (f32x2){f0, f1}; *(LAS f32x2*)(d_ + 4) = (f32x2){f2, f3}; *(LAS f32x2*)(d_ + 8) = (f32x2){f4, f5}; *(LAS f32x2*)(d_ + 12) = (f32x2){f6, f7}; } \
            else { LAS f32x4* d_ = (LAS f32x4*)(rb_ + t_ * 384 + (vec_ == 4 ? 256 : 320) + e0_); d_[0] = (f32x4){f0, f1, f2, f3}; d_[1] = (f32x4){f4, f5, f6, f7}; } } } while (0)
#define RW_STORE_Y(cc) do { if (tl < 32) { const LAS float* yb_ = ypart + ((cc) & 1) * 4096; const int t_ = tl >> 1, pr_ = tl & 1; const int l_ = (cc) * SCH + t_; \
        const LAS f32x4* q_ = (const LAS f32x4*)(yb_ + t_ * 128 + pr_ * 64); f32x4 sa_ = q_[0], sb_ = q_[8]; \
        _Pragma("unroll") for (int k_ = 1; k_ < 8; ++k_) { sa_ = sa_ + q_[k_]; sb_ = sb_ + q_[8 + k_]; } \
        *(unsigned*)(y0 + (size_t)(b * T + PADR + l_) * RW_W + h * 64 + q8 * 4 + 2 * pr_) = pk2((sa_.x + sa_.y) + (sa_.z + sa_.w), (sb_.x + sb_.y) + (sb_.z + sb_.w)); } } while (0)
    if (isld) {
        RW_ISSUE(0); asm volatile("s_waitcnt vmcnt(0)" ::: "memory"); RW_CONVERT(0);
        RW_ISSUE(1); RW_ISSUE(2);
    }
    RW_BAR();
    for (int c = 0; c < NCH; ++c) {
        if (isld) {
            if (c + 2 < NCH) { asm volatile("s_waitcnt vmcnt(3)" ::: "memory"); RW_CONVERT(c + 1); }
            else if (c + 1 < NCH) { asm volatile("s_waitcnt vmcnt(0)" ::: "memory"); RW_CONVERT(c + 1); }
            if (c > 0 && !dry) RW_STORE_Y(c - 1);
            if (c + 3 < NCH) RW_ISSUE(c + 3);
        } else if (dry != 1 && wave < 2) {
            const unsigned ba = (unsigned)(uintptr_t)(ring + (c & 1) * 6144) + i32 * 16, ca = (unsigned)(uintptr_t)(ring + (c & 1) * 6144) + 1024 + i32 * 8,
                           va = (unsigned)(uintptr_t)(ring + (c & 1) * 6144) + 1280 + (q8 * 4 + rloc) * 4, ya = (unsigned)(uintptr_t)(ypart + (c & 1) * 4096 + rloc * 32 + i32);
            f32x4 OA[4], OB[4]; f32x2 OC[4]; float OV[4];
            OC[3] = (f32x2){0.f, 0.f};
#define RW_FETCH(tt, sl) asm volatile("ds_read_b128 %0, %4 offset:%c7\n\tds_read_b128 %1, %4 offset:%c8\n\tds_read_b64 %2, %5 offset:%c7\n\tds_read_b32 %3, %6 offset:%c7" \
                : "=&v"(OA[sl]), "=&v"(OB[sl]), "=&v"(OC[sl]), "=&v"(OV[sl]) : "v"(ba), "v"(ca), "v"(va), "i"((tt) * 1536), "i"((tt) * 1536 + 512) : "memory")
            RW_FETCH(0, 0); RW_FETCH(1, 1);
            float p, p2, y;
#define RW_STEP(t, WAITN, YL1, YL2, YW, FETCHL) asm volatile( \
                "s_waitcnt lgkmcnt(" WAITN ")\n\t" \
                "v_mul_f32 %[p], %[s0], %[kk0]\n\t" \
                "v_fmac_f32 %[p], %[s1], %[kk1]\n\t" \
                YL1 "\n\t" YL2 "\n\t" \
                XL8 "\n\t" \
                "v_fmac_f32 %[s0], %[s0], %[om0]\n\t" \
                "v_fmac_f32 %[s1], %[s1], %[om1]\n\t" \
                XL4 "\n\t" \
                "v_fmac_f32 %[s0], %[vf], %[kv0]\n\t" \
                "v_fmac_f32 %[s1], %[vf], %[kv1]\n\t" \
                XL2 "\n\t" \
                YW "\n\t" \
                FETCHL \
                : [p] "=&v"(p), [p2] "=&v"(p2), [y] "=&v"(y), [s0] "+v"(s0), [s1] "+v"(s1), [nA] "=&v"(OA[((t) + 2) & 3]), [nB] "=&v"(OB[((t) + 2) & 3]), [nC] "=&v"(OC[((t) + 2) & 3]), [nV] "=&v"(OV[((t) + 2) & 3]) \
                : [kk0] "v"(OA[(t) & 3].x), [kk1] "v"(OA[(t) & 3].y), [om0] "v"(OA[(t) & 3].z), [om1] "v"(OA[(t) & 3].w), [bb0] "v"(OB[(t) & 3].x), [bb1] "v"(OB[(t) & 3].y), [kv0] "v"(OB[(t) & 3].z), [kv1] "v"(OB[(t) & 3].w), \
                  [vf] "v"(OV[(t) & 3]), [rp0] "v"(OC[((t) + 3) & 3].x), [rp1] "v"(OC[((t) + 3) & 3].y), [ba] "v"(ba), [ca] "v"(ca), [va] "v"(va), [ya] "v"(ya), \
                  [oa] "i"(((t) + 2) * 1536), [ob] "i"(((t) + 2) * 1536 + 512), [oy] "i"(((t) - 1) * 512) : "memory")
#define RW_YL1 "v_mul_f32 %[y], %[s0], %[rp0]"
#define RW_YL2 "v_fmac_f32 %[y], %[s1], %[rp1]"
#define RW_YW  "ds_write_b32 %[ya], %[y] offset:%c[oy]"
#define RW_NOP "s_nop 0"
#define RW_TAIL_F "ds_read_b128 %[nA], %[ba] offset:%c[oa]\n\t" \
                XL1 "\n\t" \
                "ds_read_b128 %[nB], %[ba] offset:%c[ob]\n\t" \
                "ds_read_b64 %[nC], %[ca] offset:%c[oa]\n\t" \
                "v_mov_b32 %[p2], %[p]\n\t" \
                "ds_read_b32 %[nV], %[va] offset:%c[oa]\n\t" \
                "s_nop 0\n\t" \
                XSW "\n\t" \
                "v_add_f32 %[p], %[p], %[p2]\n\t" \
                "v_fmac_f32 %[s0], %[p], %[bb0]\n\t" \
                "v_fmac_f32 %[s1], %[p], %[bb1]"
#define RW_TAIL_N "s_nop 0\n\t" \
                XL1 "\n\t" \
                "s_nop 1\n\t" \
                "v_mov_b32 %[p2], %[p]\n\t" \
                "s_nop 1\n\t" \
                XSW "\n\t" \
                "v_add_f32 %[p], %[p], %[p2]\n\t" \
                "v_fmac_f32 %[s0], %[p], %[bb0]\n\t" \
                "v_fmac_f32 %[s1], %[p], %[bb1]"
#define RW_ALLSTEPS() do { \
            RW_STEP(0, "4", RW_NOP, RW_NOP, RW_NOP, RW_TAIL_F); \
            RW_STEP(1, "4", RW_YL1, RW_YL2, RW_YW, RW_TAIL_F); \
            RW_STEP(2, "5", RW_YL1, RW_YL2, RW_YW, RW_TAIL_F);  RW_STEP(3, "5", RW_YL1, RW_YL2, RW_YW, RW_TAIL_F);  RW_STEP(4, "5", RW_YL1, RW_YL2, RW_YW, RW_TAIL_F); \
            RW_STEP(5, "5", RW_YL1, RW_YL2, RW_YW, RW_TAIL_F);  RW_STEP(6, "5", RW_YL1, RW_YL2, RW_YW, RW_TAIL_F);  RW_STEP(7, "5", RW_YL1, RW_YL2, RW_YW, RW_TAIL_F); \
            RW_STEP(8, "5", RW_YL1, RW_YL2, RW_YW, RW_TAIL_F);  RW_STEP(9, "5", RW_YL1, RW_YL2, RW_YW, RW_TAIL_F);  RW_STEP(10, "5", RW_YL1, RW_YL2, RW_YW, RW_TAIL_F); \
            RW_STEP(11, "5", RW_YL1, RW_YL2, RW_YW, RW_TAIL_F); RW_STEP(12, "5", RW_YL1, RW_YL2, RW_YW, RW_TAIL_F); RW_STEP(13, "5", RW_YL1, RW_YL2, RW_YW, RW_TAIL_F); \
            RW_STEP(14, "5", RW_YL1, RW_YL2, RW_YW, RW_TAIL_N); \
            RW_STEP(15, "1", RW_YL1, RW_YL2, RW_YW, RW_TAIL_N); \
            asm volatile("v_mul_f32 %[y], %[s0], %[r0]\n\tv_fmac_f32 %[y], %[s1], %[r1]\n\tds_write_b32 %[ya], %[y] offset:7680" : [y] "=&v"(y) : [s0] "v"(s0), [s1] "v"(s1), [r0] "v"(OC[3].x), [r1] "v"(OC[3].y), [ya] "v"(ya) : "memory"); \
 } while (0)
#ifdef SCAN_PROBE_NOXL
            if (dry == 2) {
#define XL8 "v_add_f32 %[p], %[p], %[p]"
#define XL4 "v_add_f32 %[p], %[p], %[p]"
#define XL2 "v_add_f32 %[p], %[p], %[p]"
#define XL1 "v_add_f32 %[p], %[p], %[p]"
#define XSW "v_add_f32 %[p], %[p], %[p2]"
                RW_ALLSTEPS();
#undef XL8
#undef XL4
#undef XL2
#undef XL1
#undef XSW
            } else
#endif
            {
#define XL8 "v_add_f32_dpp %[p], %[p], %[p] row_ror:8 row_mask:0xf bank_mask:0xf bound_ctrl:1"
#define XL4 "v_add_f32_dpp %[p], %[p], %[p] row_ror:4 row_mask:0xf bank_mask:0xf bound_ctrl:1"
#define XL2 "v_add_f32_dpp %[p], %[p], %[p] row_ror:2 row_mask:0xf bank_mask:0xf bound_ctrl:1"
#define XL1 "v_add_f32_dpp %[p], %[p], %[p] row_ror:1 row_mask:0xf bank_mask:0xf bound_ctrl:1"
#define XSW "v_permlane16_swap_b32 %[p], %[p2]"
                RW_ALLSTEPS();
            }
#undef RW_ALLSTEPS
#undef RW_STEP
#undef XL8
#undef XL4
#undef XL2
#undef XL1
#undef XSW
#undef RW_YL1
#undef RW_YL2
#undef RW_YW
#undef RW_NOP
#undef RW_TAIL_F
#undef RW_TAIL_N
#undef RW_FETCH
        }
        RW_BAR();
    }
    if (isld && !dry) RW_STORE_Y(NCH - 1);
    asm volatile("s_waitcnt vmcnt(0) lgkmcnt(0)\n\ts_barrier" ::: "memory");
#undef RW_STORE_Y
#undef RW_ISSUE
#undef RW_CONVERT
#undef RW_BAR
}

__device__ __forceinline__ int crow(int r, int hi) { return (r & 3) + 8 * (r >> 2) + 4 * hi; }
__device__ __forceinline__ void glds16(const void* gsrc, unsigned lds_dst) { unsigned keep;
    asm volatile("s_mov_b32 %0, m0\n\ts_mov_b32 m0, %2\n\ts_nop 0\n\tglobal_load_lds_dwordx4 %1, off\n\ts_mov_b32 m0, %0" : "=&s"(keep) : "v"(gsrc), "s"(lds_dst) : "memory"); }
__device__ __forceinline__ void glds4(const void* gsrc, unsigned lds_dst) { unsigned keep;
    asm volatile("s_mov_b32 %0, m0\n\ts_mov_b32 m0, %2\n\ts_nop 0\n\tglobal_load_lds_dword %1, off\n\ts_mov_b32 m0, %0" : "=&s"(keep) : "v"(gsrc), "s"(lds_dst) : "memory"); }
typedef LAS const char* lds_cptr;
constexpr int FX_K = 0, FX_V = 24576, FX_WS = 49152, FX_OST = 51200, FX_FLG = 83968, FX_KB = 84224  ;

__device__ __forceinline__ void fx_pv(f32x16* o, int vb, bf16x8 pa0, bf16x8 pa1, bf16x8 pa2, bf16x8 pa3) {
#pragma unroll
    for (int d0 = 0; d0 < 2; ++d0) { s16x4 lo[4], hi[4];
#pragma unroll
        for (int ks = 0; ks < 4; ++ks) {
            asm volatile("ds_read_b64_tr_b16 %0,%1 offset:%c2" : "=&v"(lo[ks]) : "v"(vb), "i"(d0 * 4096 + ks * 1024) : "memory");
            asm volatile("ds_read_b64_tr_b16 %0,%1 offset:%c2" : "=&v"(hi[ks]) : "v"(vb), "i"(d0 * 4096 + ks * 1024 + 512) : "memory"); }
        asm volatile("s_waitcnt lgkmcnt(0)" ::: "memory"); __builtin_amdgcn_sched_barrier(0);
#define FX_PK(k) (bf16x8){lo[k][0], lo[k][1], lo[k][2], lo[k][3], hi[k][0], hi[k][1], hi[k][2], hi[k][3]}
        o[d0] = __builtin_amdgcn_mfma_f32_32x32x16_bf16(pa0, FX_PK(0), o[d0], 0, 0, 0);
        o[d0] = __builtin_amdgcn_mfma_f32_32x32x16_bf16(pa1, FX_PK(1), o[d0], 0, 0, 0);
        o[d0] = __builtin_amdgcn_mfma_f32_32x32x16_bf16(pa2, FX_PK(2), o[d0], 0, 0, 0);
        o[d0] = __builtin_amdgcn_mfma_f32_32x32x16_bf16(pa3, FX_PK(3), o[d0], 0, 0, 0);
#undef FX_PK
    }
}
__device__ __forceinline__ float halves_max(float m) { auto rr = __builtin_amdgcn_permlane32_swap(__float_as_uint(m), __float_as_uint(m), false, false); return fmaxf(__uint_as_float(rr[0]), __uint_as_float(rr[1])); }
__device__ __forceinline__ float halves_sum(float m) { auto rr = __builtin_amdgcn_permlane32_swap(__float_as_uint(m), __float_as_uint(m), false, false); return __uint_as_float(rr[0]) + __uint_as_float(rr[1]); }

constexpr float ATT_EXIT = -40.0f;
template <int KIND>
__device__ __forceinline__ void attn_unit(const ArgsL& a, Frame& F, int b, int h, int qb, float bound) {
    const int lane = F.lane, wave = F.wave, r32 = lane & 31, hi = lane >> 5;
    LAS unsigned char* lds = F.lds;
    const bf16_t* QKV = (const bf16_t*)(a.ws + WS_QKV);
    const size_t rowbase = (size_t)b * T;
    const int p0 = qb * 256;
    constexpr int QC = KIND ? 0 : 960, KC = KIND ? 320 : 1280, VC = KIND ? 640 : 1600;
    const bf16_t* Qw = QKV + (rowbase + p0 + wave * 32) * QKV_W + QC + h * 64;
    const bf16_t* Kh = QKV + rowbase * QKV_W + KC + h * 64;
    const bf16_t* Vh = QKV + rowbase * QKV_W + VC + h * 64;
    const float* kbias = (const float*)(a.ws + WS_KB2) + (size_t)(b * FX_H + h) * KBP;
    const unsigned lds0 = (unsigned)(uintptr_t)lds;
    bf16x8 qr[4];
#pragma unroll
    for (int d0 = 0; d0 < 4; ++d0) qr[d0] = *(const bf16x8*)(Qw + (size_t)r32 * QKV_W + d0 * 16 + hi * 8);
    const int qp = p0 + wave * 32 + r32;
    const bool qvalid = (qp >= PADR) && (qp < T);
    const int plast = (p0 + 255) < (T - 1) ? (p0 + 255) : (T - 1);
    const int jlast = plast >> 6, jfirst = PADR >> 6;
    const int jw = (p0 + wave * 32 + 31) >> 6;
    const bf16_t* ksrc = Kh + (size_t)lane * QKV_W + wave * 8;
    const bf16_t* vsrc = Vh + (size_t)(16 * (wave & 3) + (lane >> 2)) * QKV_W + (wave >> 2) * 32 + (lane & 3) * 8;
    const unsigned kdst = lds0 + FX_K + wave * 1024, vdst = lds0 + FX_V + wave * 1024;
#define FX_DMA(j, slot) do { glds16(ksrc + (size_t)(j) * 64 * QKV_W, (unsigned)__builtin_amdgcn_readfirstlane(kdst + (slot) * 8192)); \
                             glds16(vsrc + (size_t)(j) * 64 * QKV_W, (unsigned)__builtin_amdgcn_readfirstlane(vdst + (slot) * 8192)); \
                             if (KIND == 0) glds4(kbias + 64 * (j) + lane, (unsigned)__builtin_amdgcn_readfirstlane(lds0 + FX_KB + (slot) * 2048 + wave * 256)); } while (0)
    const int vb0 = (int)(lds0 + FX_V) + ((lane >> 4) & 1) * 32 + (lane & 3) * 8 + (4 * hi + ((lane & 15) >> 2)) * 64;
    const lds_cptr kp0 = (lds_cptr)lds + FX_K + hi * 1024 + r32 * 16;
    LAS float* wsf = (LAS float*)(lds + FX_WS) + wave * 64;
    LAS float* flg = (LAS float*)(lds + FX_FLG);
    float m_run = KIND ? 0.f : -1.0e30f, l_run = 0.f;
    f32x16 o[2]; o[0] = f32x16{}; o[1] = f32x16{};
    asm volatile("" : "+v"(qr[0]), "+v"(qr[1]), "+v"(qr[2]), "+v"(qr[3]));
    int slot = 0;
    FX_DMA(jlast, 0);
    if (jlast > jfirst) FX_DMA(jlast - 1, 1);
    for (int j = jlast; j >= jfirst; --j) {
        if (j > jfirst) { if (KIND == 0) asm volatile("s_waitcnt vmcnt(3) lgkmcnt(0)\n\ts_barrier" ::: "memory"); else asm volatile("s_waitcnt vmcnt(2) lgkmcnt(0)\n\ts_barrier" ::: "memory"); }
        else asm volatile("s_waitcnt vmcnt(0) lgkmcnt(0)\n\ts_barrier" ::: "memory");
        if (j < jlast) {
            const LAS float* fl = flg + ((j + 1) & 1) * 16;
            const f32x4 fa = *(const LAS f32x4*)(fl), fb = *(const LAS f32x4*)(fl + 4);
            bool stop;
            if constexpr (KIND == 0) {
                const float mmin = fminf(fminf(fminf(fa.x, fa.y), fminf(fa.z, fa.w)), fminf(fminf(fb.x, fb.y), fminf(fb.z, fb.w)));
                stop = (bound + fl[8] - mmin) < ATT_EXIT;
            } else {
                const float mmax = fmaxf(fmaxf(fmaxf(fa.x, fa.y), fmaxf(fa.z, fa.w)), fmaxf(fmaxf(fb.x, fb.y), fmaxf(fb.z, fb.w)));
                stop = mmax < ATT_EXIT;
            }
            if (stop) break;
        }
        { const int s2 = slot + 2 >= 3 ? slot - 1 : slot + 2; if (j - 2 >= jfirst) FX_DMA(j - 2, s2); }
        if (j <= jw) {
            f32x16 s0v = f32x16{}, s1v = f32x16{};
            const lds_cptr kp = kp0 + slot * 8192;
#pragma unroll
            for (int d0 = 0; d0 < 4; ++d0) {
                const bf16x8 b0 = *(const LAS bf16x8*)(kp + d0 * 2048);
                const bf16x8 b1 = *(const LAS bf16x8*)(kp + d0 * 2048 + 512);
                s0v = __builtin_amdgcn_mfma_f32_32x32x16_bf16(b0, qr[d0], s0v, 0, 0, 0);
                s1v = __builtin_amdgcn_mfma_f32_32x32x16_bf16(b1, qr[d0], s1v, 0, 0, 0);
            }
            const bool edge = (64 * j + 63 >= p0 + wave * 32) || (64 * j < PADR);
            if constexpr (KIND == 0) {
                const LAS float* kbj = (const LAS float*)(lds + FX_KB + slot * 2048 + wave * 256) + 4 * hi;
#pragma unroll
                for (int g = 0; g < 4; ++g) { const f32x4 t0 = *(const LAS f32x4*)(kbj + 8 * g), t1 = *(const LAS f32x4*)(kbj + 32 + 8 * g);
                    s0v[4 * g] += t0.x; s0v[4 * g + 1] += t0.y; s0v[4 * g + 2] += t0.z; s0v[4 * g + 3] += t0.w;
                    s1v[4 * g] += t1.x; s1v[4 * g + 1] += t1.y; s1v[4 * g + 2] += t1.z; s1v[4 * g + 3] += t1.w; }
                if (edge) {
#pragma unroll
                    for (int r = 0; r < 16; ++r) { const int key = 64 * j + crow(r, hi);
                        if (key > qp || key < PADR) s0v[r] = -INFINITY;
                        if (key + 32 > qp || key + 32 < PADR) s1v[r] = -INFINITY; }
                }
                float rm = fmaxf(s0v[0], s1v[0]);
#pragma unroll
                for (int r = 1; r < 16; ++r) rm = fmaxf(rm, fmaxf(s0v[r], s1v[r]));
                rm = halves_max(rm);
                const float m_new = fmaxf(m_run, rm);
                const float f = __builtin_amdgcn_exp2f(m_run - m_new);
                m_run = m_new;
                float rs = 0.f;
#pragma unroll
                for (int r = 0; r < 16; ++r) { s0v[r] = __builtin_amdgcn_exp2f(s0v[r] - m_new); s1v[r] = __builtin_amdgcn_exp2f(s1v[r] - m_new); rs += s0v[r] + s1v[r]; }
                rs = halves_sum(rs);
                l_run = l_run * f + rs;
                if (!__all(f == 1.0f)) {
                    if (hi == 0) wsf[r32] = f;
                    LDS_WAIT();
#pragma unroll
                    for (int d_ = 0; d_ < 2; ++d_)
#pragma unroll
                        for (int r = 0; r < 16; ++r) o[d_][r] *= wsf[crow(r, hi)];
                }
            } else {
                f32x16 l0, l1;
#pragma unroll
                for (int r = 0; r < 16; ++r) {
                    const float z0 = s0v[r], z1 = s1v[r];
                    float a0 = -(fmaxf(z0, 0.f) + __builtin_amdgcn_logf(1.f + __builtin_amdgcn_exp2f(-fabsf(z0))));
                    float a1 = -(fmaxf(z1, 0.f) + __builtin_amdgcn_logf(1.f + __builtin_amdgcn_exp2f(-fabsf(z1))));
                    if (edge) { const int key = 64 * j + crow(r, hi);
                        if (key >= qp || key < PADR) { a0 = 0.f; s0v[r] = -INFINITY; }
                        if (key + 32 >= qp || key + 32 < PADR) { a1 = 0.f; s1v[r] = -INFINITY; } }
                    l0[r] = a0; l1[r] = a1;
                }
                float A[8], SA[9], SO[9];
#pragma unroll
                for (int g = 0; g < 4; ++g) { A[g] = (l0[4 * g] + l0[4 * g + 1]) + (l0[4 * g + 2] + l0[4 * g + 3]); A[4 + g] = (l1[4 * g] + l1[4 * g + 1]) + (l1[4 * g + 2] + l1[4 * g + 3]); }
                SA[8] = 0.f; SO[8] = 0.f;
#pragma unroll
                for (int g = 7; g >= 0; --g) SA[g] = A[g] + SA[g + 1];
#pragma unroll
                for (int g = 0; g < 8; ++g) { auto rr = __builtin_amdgcn_permlane32_swap(__float_as_uint(SA[g]), __float_as_uint(SA[g]), false, false); SO[g] = __uint_as_float(hi ? rr[0] : rr[1]); }
                const float R = m_run;
#pragma unroll
                for (int g = 0; g < 8; ++g) {
                    const float E = SA[g + 1] + (hi ? SO[g + 1] : SO[g]) + R;
                    if (g < 4) { float t = E;
                        s0v[4 * g + 3] = __builtin_amdgcn_exp2f(s0v[4 * g + 3] + l0[4 * g + 3] + t); t += l0[4 * g + 3];
                        s0v[4 * g + 2] = __builtin_amdgcn_exp2f(s0v[4 * g + 2] + l0[4 * g + 2] + t); t += l0[4 * g + 2];
                        s0v[4 * g + 1] = __builtin_amdgcn_exp2f(s0v[4 * g + 1] + l0[4 * g + 1] + t); t += l0[4 * g + 1];
                        s0v[4 * g + 0] = __builtin_amdgcn_exp2f(s0v[4 * g + 0] + l0[4 * g + 0] + t);
                    } else { const int q = g - 4; float t = E;
                        s1v[4 * q + 3] = __builtin_amdgcn_exp2f(s1v[4 * q + 3] + l1[4 * q + 3] + t); t += l1[4 * q + 3];
                        s1v[4 * q + 2] = __builtin_amdgcn_exp2f(s1v[4 * q + 2] + l1[4 * q + 2] + t); t += l1[4 * q + 2];
                        s1v[4 * q + 1] = __builtin_amdgcn_exp2f(s1v[4 * q + 1] + l1[4 * q + 1] + t); t += l1[4 * q + 1];
                        s1v[4 * q + 0] = __builtin_amdgcn_exp2f(s1v[4 * q + 0] + l1[4 * q + 0] + t);
                    }
                }
                m_run = R + SA[0] + SO[0];
            }
            u32x4 pw0, pw1, pw2, pw3;
            pw0 = (u32x4){pk2(s0v[0], s0v[1]), pk2(s0v[2], s0v[3]), pk2(s0v[4], s0v[5]), pk2(s0v[6], s0v[7])};
            pw1 = (u32x4){pk2(s0v[8], s0v[9]), pk2(s0v[10], s0v[11]), pk2(s0v[12], s0v[13]), pk2(s0v[14], s0v[15])};
            pw2 = (u32x4){pk2(s1v[0], s1v[1]), pk2(s1v[2], s1v[3]), pk2(s1v[4], s1v[5]), pk2(s1v[6], s1v[7])};
            pw3 = (u32x4){pk2(s1v[8], s1v[9]), pk2(s1v[10], s1v[11]), pk2(s1v[12], s1v[13]), pk2(s1v[14], s1v[15])};
            fx_pv(o, vb0 + slot * 8192, __builtin_bit_cast(bf16x8, pw0), __builtin_bit_cast(bf16x8, pw1), __builtin_bit_cast(bf16x8, pw2), __builtin_bit_cast(bf16x8, pw3));
        }
        float mm = qvalid ? m_run : (KIND ? -3.0e38f : 3.0e38f);
        if constexpr (KIND == 0) { mm = fminf(mm, dpp_f<0x128>(mm)); mm = fminf(mm, dpp_f<0x124>(mm)); mm = fminf(mm, dpp_f<0x122>(mm)); mm = fminf(mm, dpp_f<0x121>(mm));
            { auto sw = __builtin_amdgcn_permlane16_swap(__float_as_uint(mm), __float_as_uint(mm), false, false); mm = fminf(__uint_as_float(sw[0]), __uint_as_float(sw[1])); }
            { auto sw = __builtin_amdgcn_permlane32_swap(__float_as_uint(mm), __float_as_uint(mm), false, false); mm = fminf(__uint_as_float(sw[0]), __uint_as_float(sw[1])); } }
        else { mm = fmaxf(mm, dpp_f<0x128>(mm)); mm = fmaxf(mm, dpp_f<0x124>(mm)); mm = fmaxf(mm, dpp_f<0x122>(mm)); mm = fmaxf(mm, dpp_f<0x121>(mm));
            { auto sw = __builtin_amdgcn_permlane16_swap(__float_as_uint(mm), __float_as_uint(mm), false, false); mm = fmaxf(__uint_as_float(sw[0]), __uint_as_float(sw[1])); }
            { auto sw = __builtin_amdgcn_permlane32_swap(__float_as_uint(mm), __float_as_uint(mm), false, false); mm = fmaxf(__uint_as_float(sw[0]), __uint_as_float(sw[1])); } }
        if (lane == 0) { flg[(j & 1) * 16 + wave] = mm;
            if (KIND == 0 && wave == 0) flg[(j & 1) * 16 + 8] = *(const LAS float*)(lds + FX_KB + slot * 2048); }
        slot = slot == 2 ? 0 : slot + 1;
    }
    asm volatile("s_waitcnt vmcnt(0) lgkmcnt(0)\n\ts_barrier" ::: "memory");
    float rli[16];
    if constexpr (KIND == 0) {
        if (hi == 0) wsf[32 + r32] = l_run;
        LDS_WAIT();
#pragma unroll
        for (int r = 0; r < 16; ++r) rli[r] = __builtin_amdgcn_rcpf(wsf[32 + crow(r, hi)]);
    } else {
#pragma unroll
        for (int r = 0; r < 16; ++r) rli[r] = 1.0f;
    }
    bf16_t* Ow = (bf16_t*)(a.ws + WS_YCAT) + (rowbase + p0 + wave * 32) * YC_W + (KIND ? 384 : 768) + h * 64;
    {
        LAS bf16_t* stg = (LAS bf16_t*)(lds + FX_OST) + wave * 2048;
#pragma unroll
        for (int r = 0; r < 16; ++r) { const int orow = crow(r, hi);
#pragma unroll
            for (int d0 = 0; d0 < 2; ++d0) stg[orow * 64 + d0 * 32 + r32] = f2bf(o[d0][r] * rli[r]); }
        LDS_WAIT();
#pragma unroll
        for (int i = 0; i < 4; ++i) { const int row = i * 8 + (lane >> 3), ch = lane & 7; const u32x4 v = *(const LAS u32x4*)(stg + row * 64 + ch * 8);
            const int pr = p0 + wave * 32 + row;
            if (pr >= PADR && pr < T) *(u32x4*)(Ow + (size_t)row * YC_W + ch * 8) = v; }
    }
    asm volatile("s_waitcnt lgkmcnt(0)\n\ts_barrier" ::: "memory");
#undef FX_DMA
}


constexpr int CK = 64, NCK = 257, CKB = 40960, CB_ZF = 147456  ;
static_assert(LPADDED == CK * NCK, "padded steps");
__device__ __forceinline__ int swz(int row, int chunk) { return row * 128 + ((chunk ^ (row & 7)) << 4); }
__device__ __forceinline__ void ck_mm(f32x16& acc, LAS unsigned char* A, LAS unsigned char* Bt, int m0, int n0, int r32, int hi) {
#pragma unroll
    for (int ks = 0; ks < 4; ++ks) {
        const bf16x8 av = *(const LAS bf16x8*)(A + swz(m0 + r32, 2 * ks + hi));
        const bf16x8 bv = *(const LAS bf16x8*)(Bt + swz(n0 + r32, 2 * ks + hi));
        acc = __builtin_amdgcn_mfma_f32_32x32x16_bf16(av, bv, acc, 0, 0, 0);
    }
}
__device__ __forceinline__ void ck_store_t(LAS unsigned char* dst, const f32x16& acc, int m0, int n0, int r32, int hi) {
#pragma unroll
    for (int g = 0; g < 4; ++g) { const u32x2 w = {pk2(acc[4 * g], acc[4 * g + 1]), pk2(acc[4 * g + 2], acc[4 * g + 3])};
        *(LAS u32x2*)(dst + swz(n0 + r32, (m0 >> 3) + g) + hi * 8) = w; }
}
constexpr int CA_KAP = 0, CA_BET = 8192, CA_CHI = 16384, CA_RHO = 24576, CA_VMT = 32768, CA_BHT = 40960, CA_KHT = 49152, CA_AK = 57344, CA_RB = 65536, CA_RK = 73728,
              CA_AB = 81920  , CA_RHS = 98304  , CA_G64 = MISC_OFF + 2048  , CA_SCR = MISC_OFF + 4096  ;

#ifndef CA_STAGES
#define CA_STAGES 15
#endif
__device__ __forceinline__ void phase_chunkA(const ArgsL& a, Frame& F, const bool dry = false) {
    const int wave = F.wave;
    LAS unsigned char* L = F.lds;
    u32x4 pre6[6];
    for (int id = F.bx; id < 12 * NCK; id += (int)gridDim.x) {
        int tid = F.tid, lane, r32, hi;
#define CK_FRESH() do { asm volatile("" : "+v"(tid)); lane = tid & 63; r32 = lane & 31; hi = lane >> 5; } while (0)
        CK_FRESH();
        const int bh = id / NCK, c = id - bh * NCK;
        unsigned char* blk = a.ws + WS_RW + ((size_t)bh * LPADDED + (size_t)c * CK) * 768;
        const int blko = (int)(((size_t)bh * LPADDED + (size_t)c * CK) * 768);
        const __amdgpu_buffer_rsrc_t rwrs = __builtin_amdgcn_make_buffer_rsrc((void*)(a.ws + WS_RW), 0, (int)((size_t)12 * LPADDED * 768), 0x00020000);
        {
            if (id == F.bx) {
#pragma unroll
                for (int q6 = 0; q6 < 6; ++q6) pre6[q6] = *(const u32x4*)(blk + (size_t)(tid + q6 * NTHR) * 16);
            }
#pragma unroll
            for (int q6 = 0; q6 < 6; ++q6) *(LAS u32x4*)(L + CA_AB + (tid + q6 * NTHR) * 16) = pre6[q6];
            __syncthreads();
            const int k = tid & 63, tq = tid >> 6;
            const LAS _Float16* src = (const LAS _Float16*)(L + CA_AB) + (tq * 8) * 384 + k;
            float kk[8], w[8], bb[8], kp[8], rr[8], vv[8];
#pragma unroll
            for (int e = 0; e < 8; ++e) { kk[e] = (float)src[e * 384]; w[e] = 1.f + (float)src[e * 384 + 64]; bb[e] = -(float)src[e * 384 + 128];
                kp[e] = (float)src[e * 384 + 192]; rr[e] = (float)src[e * 384 + 256]; vv[e] = (float)src[e * 384 + 320]; }
            float g[8]; g[0] = w[0];
#pragma unroll
            for (int e = 1; e < 8; ++e) g[e] = g[e - 1] * w[e];
            LAS float* scr = (LAS float*)(L + CA_SCR);
            scr[tq * 64 + k] = g[7];
            __syncthreads();
            {
                const int idn = id + (int)gridDim.x;
                if (idn < 12 * NCK) { const int bhn = idn / NCK, cn = idn - bhn * NCK; const unsigned char* bn_ = a.ws + WS_RW + ((size_t)bhn * LPADDED + (size_t)cn * CK) * 768;
#pragma unroll
                    for (int q6 = 0; q6 < 6; ++q6) pre6[q6] = *(const u32x4*)(bn_ + (size_t)(tid + q6 * NTHR) * 16); }
            }
            float pre = 1.f, tot = 1.f;
#pragma unroll
            for (int q = 0; q < 8; ++q) { const float s = scr[q * 64 + k]; if (q < tq) pre *= s; tot *= s; }
            if (tq == 0) ((LAS float*)(L + CA_G64))[k] = tot;
            unsigned bh4[4], kh4[4], vm4[4];
            float Gp = pre;
#pragma unroll
            for (int e = 0; e < 8; ++e) {
                const int t = tq * 8 + e; const float G = pre * g[e], iG = __builtin_amdgcn_rcpf(G);
                const float kap = kk[e] * Gp, bet = bb[e] * iG, chi = kp[e] * iG, rho = rr[e] * G;
                const int o = swz(t, k >> 3) + (k & 7) * 2;
                *(LAS unsigned short*)(L + CA_KAP + o) = f2bf(kap); *(LAS unsigned short*)(L + CA_BET + o) = f2bf(bet);
                *(LAS unsigned short*)(L + CA_CHI + o) = f2bf(chi); *(LAS unsigned short*)(L + CA_RHO + o) = f2bf(rho);
                ((LAS float*)(L + CA_RHS))[t * 128 + k] = kap;
                const float bhv = bet * tot, khv = chi * tot;
                if (e & 1) { bh4[e >> 1] |= (unsigned)f2bf(bhv) << 16; kh4[e >> 1] |= (unsigned)f2bf(khv) << 16; vm4[e >> 1] |= (unsigned)f2bf(vv[e]) << 16; }
                else { bh4[e >> 1] = f2bf(bhv); kh4[e >> 1] = f2bf(khv); vm4[e >> 1] = f2bf(vv[e]); }
                Gp = G;
            }
            *(LAS u32x4*)(L + CA_BHT + swz(k, tq)) = (u32x4){bh4[0], bh4[1], bh4[2], bh4[3]};
            *(LAS u32x4*)(L + CA_KHT + swz(k, tq)) = (u32x4){kh4[0], kh4[1], kh4[2], kh4[3]};
            *(LAS u32x4*)(L + CA_VMT + swz(k, tq)) = (u32x4){vm4[0], vm4[1], vm4[2], vm4[3]};
        }
        __syncthreads();
        CK_FRESH();
        if (!dry || (CA_STAGES & 2)) {
            const int p = wave & 3, nb = wave >> 2;
            LAS unsigned char* Am = L + ((p & 1) ? CA_CHI : CA_BET);
            LAS unsigned char* Bm = L + ((p & 2) ? CA_RHO : CA_KAP);
#pragma unroll
            for (int mb = 0; mb < 2; ++mb) {
                f32x16 acc = f32x16{};
                if (!(mb == 1 && nb == 0)) ck_mm(acc, Am, Bm, mb * 32, nb * 32, r32, hi);
                const int t = nb * 32 + r32;
#pragma unroll
                for (int i = 0; i < 16; ++i) { const int j = mb * 32 + crow(i, hi); const bool keep = (p & 2) ? (j <= t) : (j < t); if (!keep) acc[i] = 0.f; }
                if (p == 0) {
#pragma unroll
                    for (int gq = 0; gq < 4; ++gq) { LAS float* ab_ = (LAS float*)(L + CA_AB) + t * 64 + (mb * 8 + 2 * gq + hi);
                        ab_[0] = acc[4 * gq]; ab_[16] = acc[4 * gq + 1]; ab_[32] = acc[4 * gq + 2]; ab_[48] = acc[4 * gq + 3]; }
                } else ck_store_t(L + (p == 1 ? CA_AK : p == 2 ? CA_RB : CA_RK), acc, mb * 32, nb * 32, r32, hi);
            }
        }
        __syncthreads();
        CK_FRESH();
        if (wave < 4 && (!dry || (CA_STAGES & 2))) {
            const int mb = wave >> 1, nb = wave & 1;
            f32x16 acc = f32x16{};
            ck_mm(acc, L + CA_AK, L + CA_VMT, mb * 32, nb * 32, r32, hi);
#pragma unroll
            for (int i = 0; i < 16; ++i) ((LAS float*)(L + CA_RHS))[(mb * 32 + crow(i, hi)) * 128 + 64 + nb * 32 + r32] = acc[i];
        }
        __syncthreads();
        CK_FRESH();
        if (!dry || (CA_STAGES & 4)) {
            const int col = tid >> 2, p = tid & 3;
            unsigned abv = (unsigned)(uintptr_t)(L + CA_AB) + p * 64; asm volatile("" : "+v"(abv));
            const LAS float* ab = (const LAS float*)(uintptr_t)abv;
            const LAS float* rhs = (const LAS float*)(L + CA_RHS) + col;
            float xo[16];
#pragma unroll
            for (int i = 0; i < 16; ++i) xo[i] = 0.f;
#pragma unroll
            for (int tg = 0; tg < 64; tg += 4) {
                f32x4 av[4][4]; float rv[4];
#pragma unroll
                for (int r = 0; r < 4; ++r) { rv[r] = rhs[(tg + r) * 128];
#pragma unroll
                    for (int i4 = 0; i4 < (tg + r + 15) / 16; ++i4) av[r][i4] = *(const LAS f32x4*)(ab + (tg + r) * 64 + 4 * i4); }
#pragma unroll
                for (int r = 0; r < 4; ++r) { const int t = tg + r;
                    float s0 = (p == 0) ? rv[r] : 0.f, s1 = 0.f;
#pragma unroll
                    for (int i4 = 0; i4 < (t + 15) / 16; ++i4) {
                        s0 -= av[r][i4].x * xo[4 * i4]; s1 -= av[r][i4].y * xo[4 * i4 + 1]; s0 -= av[r][i4].z * xo[4 * i4 + 2]; s1 -= av[r][i4].w * xo[4 * i4 + 3]; }
                    float sx = s0 + s1;
                    sx += dpp_f<0xB1>(sx);
                    sx += dpp_f<0x4E>(sx);
                    if ((t & 3) == p) xo[t >> 2] = sx;
                    asm volatile("" : "+v"(xo[t >> 2]));
                }
                __builtin_amdgcn_sched_barrier(0);
            }
            LAS unsigned char* dst = L + (col < 64 ? CA_KAP : CA_BET);
            const int rowc = col & 63;
#pragma unroll
            for (int i = 0; i < 16; ++i) { const int tt = 4 * i + p; *(LAS unsigned short*)(dst + swz(rowc, tt >> 3) + (tt & 7) * 2) = f2bf(-xo[i]); }
        }
        __syncthreads();
        CK_FRESH();
        if (!dry || (CA_STAGES & 8)) {
            const int ty = wave >> 1;
            LAS unsigned char* nW1 = L + CA_KAP; LAS unsigned char* nW2 = L + CA_BET;
#pragma unroll
            for (int qq = 0; qq < 2; ++qq) {
                const int q = (wave & 1) * 2 + qq, qa = q >> 1, qb = q & 1;
                f32x16 acc = f32x16{};
                if (ty == 0) {
                    const int t = qa * 32 + r32;
#pragma unroll
                    for (int gq = 0; gq < 4; ++gq) { const u32x2 rv = *(const LAS u32x2*)(L + CA_RHO + swz(t, qb * 4 + gq) + hi * 8);
                        acc[4 * gq] = bf_lo(rv.x); acc[4 * gq + 1] = bf_hi(rv.x); acc[4 * gq + 2] = bf_lo(rv.y); acc[4 * gq + 3] = bf_hi(rv.y); }
                    ck_mm(acc, nW1, L + CA_RB, qb * 32, qa * 32, r32, hi);
                } else if (ty == 1) {
                    ck_mm(acc, nW1, L + CA_BHT, qb * 32, qa * 32, r32, hi);
                    if (qa == qb) { const float g64 = ((const LAS float*)(L + CA_G64))[qa * 32 + r32];
#pragma unroll
                        for (int i = 0; i < 16; ++i) if (crow(i, hi) == r32) acc[i] += g64; }
                } else if (ty == 2) {
                    ck_mm(acc, L + CA_KHT, L + CA_VMT, qb * 32, qa * 32, r32, hi);
                    ck_mm(acc, L + CA_BHT, nW2, qb * 32, qa * 32, r32, hi);
                } else {
                    ck_mm(acc, L + CA_VMT, L + CA_RK, qa * 32, qb * 32, r32, hi);
                    ck_mm(acc, nW2, L + CA_RB, qa * 32, qb * 32, r32, hi);
                }
                if (dry) { float sink = acc[0] + acc[5] + acc[10] + acc[15]; asm volatile("" :: "v"(sink)); }
                else if (ty < 2) {
                    const int o = blko + (ty == 0 ? 8192 : 0) + ((qa * 2 + qb) * 2) * 1024 + lane * 16;
#pragma unroll
                    for (int ks = 0; ks < 2; ++ks)
                        __builtin_amdgcn_raw_buffer_store_b128((u32x4){pk2(acc[8 * ks], acc[8 * ks + 1]), pk2(acc[8 * ks + 2], acc[8 * ks + 3]), pk2(acc[8 * ks + 4], acc[8 * ks + 5]), pk2(acc[8 * ks + 6], acc[8 * ks + 7])}, rwrs, o + ks * 1024, 0, 16);
                } else if (ty == 2) {
                    const int o = blko + 16384 + (qa * 2 + qb) * 4096 + lane * 16;
#pragma unroll
                    for (int g = 0; g < 4; ++g) __builtin_amdgcn_raw_buffer_store_b128((u32x4){__float_as_uint(acc[4 * g]), __float_as_uint(acc[4 * g + 1]), __float_as_uint(acc[4 * g + 2]), __float_as_uint(acc[4 * g + 3])}, rwrs, o + g * 1024, 0, 16);
                } else {
                    const int o = blko + 32768 + (qa * 2 + qb) * 2048 + lane * 8;
#pragma unroll
                    for (int g = 0; g < 4; ++g) __builtin_amdgcn_raw_buffer_store_b64((u32x2){pk2(acc[4 * g], acc[4 * g + 1]), pk2(acc[4 * g + 2], acc[4 * g + 3])}, rwrs, o + g * 512, 0, 16);
                }
            }
        }
        __syncthreads();
    }
}

__device__ __forceinline__ void rwkv_chunkB(const ArgsL& a, Frame& F, int bh) {
    const int lane = F.lane, wave = F.wave, r32 = lane & 31, hi = lane >> 5;
    const int b = bh / RW_H, h = bh % RW_H;
    LAS unsigned char* L = F.lds;
    const unsigned char* base = a.ws + WS_RW + (size_t)bh * LPADDED * 768;
    bf16_t* y0 = (bf16_t*)(a.ws + WS_YCAT);
    const bool isld = (wave & 2) != 0; const int lw = (wave & 1) + ((wave >> 2) << 1);
    LAS unsigned char* yimg0 = L + 3 * CKB; LAS unsigned char* yimg1 = L + MISC_OFF + 8192;
    LAS unsigned char* zfb = L + CB_ZF;
#define CB_ISSUE(cc) do { const unsigned char* s_ = base + (size_t)(cc) * CK * 768 + (size_t)lw * 1024 + lane * 16; LAS unsigned char* d_ = L + ((cc) % 3) * CKB + lw * 1024; \
        _Pragma("unroll") for (int r_ = 0; r_ < 10; ++r_) __builtin_amdgcn_global_load_lds((const unsigned*)(s_ + r_ * 4096), (LAS unsigned*)(d_ + r_ * 4096), 16, 0, 0); } while (0)
#define CB_YOUT(cc) do { const LAS unsigned char* im_ = ((cc) & 1) ? yimg1 : yimg0; \
        _Pragma("unroll") for (int r_ = 0; r_ < 8; ++r_) { const int t_ = r_ * 8 + (lane >> 3), l_ = (cc) * CK + t_; const u32x4 v_ = *(const LAS u32x4*)(im_ + t_ * 128 + (((lane & 7) ^ (t_ & 7)) * 16)); \
            if (l_ < LTOK) *(u32x4*)(y0 + (size_t)(b * T + PADR + l_) * YC_W + h * 64 + (lane & 7) * 8) = v_; } } while (0)
    if (isld) { CB_ISSUE(0); CB_ISSUE(1); asm volatile("s_waitcnt vmcnt(10)" ::: "memory"); }
    bf16x8 zf[2][2];
#pragma unroll
    for (int q = 0; q < 4; ++q) zf[q >> 1][q & 1] = bf16x8{};
    if (wave < 2) {
#pragma unroll
        for (int q = 0; q < 4; ++q) *(LAS bf16x8*)(zfb + wave * 4096 + q * 1024 + lane * 16) = bf16x8{};
    }
    asm volatile("s_waitcnt lgkmcnt(0)\n\ts_barrier" ::: "memory");
    for (int c = 0; c < NCK; ++c) {
        const LAS unsigned char* S = L + (c % 3) * CKB;
        if (wave < 2) {
            const int vb = wave;
            f32x16 N0, N1;
            { const LAS unsigned char* n0 = S + 16384 + (vb * 2 + 0) * 4096 + lane * 16; const LAS unsigned char* n1 = S + 16384 + (vb * 2 + 1) * 4096 + lane * 16;
#pragma unroll
              for (int g = 0; g < 4; ++g) { const f32x4 u0 = *(const LAS f32x4*)(n0 + g * 1024), u1 = *(const LAS f32x4*)(n1 + g * 1024);
                  N0[4 * g] = u0.x; N0[4 * g + 1] = u0.y; N0[4 * g + 2] = u0.z; N0[4 * g + 3] = u0.w; N1[4 * g] = u1.x; N1[4 * g + 1] = u1.y; N1[4 * g + 2] = u1.z; N1[4 * g + 3] = u1.w; } }
#pragma unroll
            for (int kb2 = 0; kb2 < 2; ++kb2)
#pragma unroll
                for (int ks = 0; ks < 2; ++ks) {
                    const bf16x8 m0 = *(const LAS bf16x8*)(S + ((0 * 2 + kb2) * 2 + ks) * 1024 + lane * 16);
                    const bf16x8 m1 = *(const LAS bf16x8*)(S + ((1 * 2 + kb2) * 2 + ks) * 1024 + lane * 16);
                    N0 = __builtin_amdgcn_mfma_f32_32x32x16_bf16(m0, zf[kb2][ks], N0, 0, 0, 0);
                    N1 = __builtin_amdgcn_mfma_f32_32x32x16_bf16(m1, zf[kb2][ks], N1, 0, 0, 0);
                }
            LAS unsigned char* zo = zfb + ((c + 1) & 1) * 8192 + vb * 4096 + lane * 16;
#pragma unroll
            for (int ks = 0; ks < 2; ++ks) {
                zf[0][ks] = __builtin_bit_cast(bf16x8, (u32x4){pk2(N0[8 * ks], N0[8 * ks + 1]), pk2(N0[8 * ks + 2], N0[8 * ks + 3]), pk2(N0[8 * ks + 4], N0[8 * ks + 5]), pk2(N0[8 * ks + 6], N0[8 * ks + 7])});
                zf[1][ks] = __builtin_bit_cast(bf16x8, (u32x4){pk2(N1[8 * ks], N1[8 * ks + 1]), pk2(N1[8 * ks + 2], N1[8 * ks + 3]), pk2(N1[8 * ks + 4], N1[8 * ks + 5]), pk2(N1[8 * ks + 6], N1[8 * ks + 7])});
                *(LAS bf16x8*)(zo + (0 * 2 + ks) * 1024) = zf[0][ks]; *(LAS bf16x8*)(zo + (1 * 2 + ks) * 1024) = zf[1][ks];
            }
        } else if (isld) {
            if (wave == 6 && c > 0) CB_YOUT(c - 1);
            if (c + 2 < NCK) CB_ISSUE(c + 2);
            if (wave < 4) {
                const int vb = wave - 2;
                LAS unsigned char* yim = (c & 1) ? yimg1 : yimg0;
                const LAS unsigned char* zs = zfb + (c & 1) * 8192 + vb * 4096 + lane * 16;
                bf16x8 zq[2][2];
#pragma unroll
                for (int q = 0; q < 4; ++q) zq[q >> 1][q & 1] = *(const LAS bf16x8*)(zs + q * 1024);
#pragma unroll
                for (int tb = 0; tb < 2; ++tb) {
                    f32x16 acc;
                    const LAS unsigned char* yt = S + 32768 + (vb * 2 + tb) * 2048 + lane * 8;
#pragma unroll
                    for (int g = 0; g < 4; ++g) { const u32x2 w = *(const LAS u32x2*)(yt + g * 512); acc[4 * g] = bf_lo(w.x); acc[4 * g + 1] = bf_hi(w.x); acc[4 * g + 2] = bf_lo(w.y); acc[4 * g + 3] = bf_hi(w.y); }
#pragma unroll
                    for (int kb2 = 0; kb2 < 2; ++kb2)
#pragma unroll
                        for (int ks = 0; ks < 2; ++ks) { const bf16x8 pa = *(const LAS bf16x8*)(S + 8192 + ((tb * 2 + kb2) * 2 + ks) * 1024 + lane * 16);
                            acc = __builtin_amdgcn_mfma_f32_32x32x16_bf16(zq[kb2][ks], pa, acc, 0, 0, 0); }
                    const int t = tb * 32 + r32;
#pragma unroll
                    for (int g = 0; g < 4; ++g) { const u32x2 w = {pk2(acc[4 * g], acc[4 * g + 1]), pk2(acc[4 * g + 2], acc[4 * g + 3])};
                        *(LAS u32x2*)(yim + t * 128 + (((vb * 8 + 2 * g + hi) ^ (2 * (t & 7))) * 8)) = w; }
                }
            }
            if (c + 2 < NCK) asm volatile("s_waitcnt vmcnt(10)" ::: "memory"); else asm volatile("s_waitcnt vmcnt(0)" ::: "memory");
        }
        asm volatile("s_waitcnt lgkmcnt(0)\n\ts_barrier" ::: "memory");
    }
    if (wave == 6) CB_YOUT(NCK - 1);
    asm volatile("s_waitcnt vmcnt(0) lgkmcnt(0)\n\ts_barrier" ::: "memory");
#undef CB_ISSUE
#undef CB_YOUT
}

constexpr int N_FX_UNITS = 65 * 10, N_SB_UNITS = 65 * 10, N_RW_WG = 192;
#ifndef REP_SCAN
#define REP_SCAN 1
#endif
#ifndef REP_SCAN_DRY
#define REP_SCAN_DRY 0
#endif
#ifndef REP_FOX
#define REP_FOX 1
#endif
#ifndef REP_SB
#define REP_SB 1
#endif
__device__ __forceinline__ void wg_publish(unsigned* cnt) {
    asm volatile("s_waitcnt vmcnt(0)" ::: "memory");
    __syncthreads();
    if (threadIdx.x == 0) __hip_atomic_fetch_add(cnt, 1u, __ATOMIC_RELAXED, __HIP_MEMORY_SCOPE_AGENT);
}
__device__ __forceinline__ void wg_wait(const unsigned* cnt, unsigned n) {
    if (threadIdx.x == 0) { unsigned polls = 0;
        while (__hip_atomic_load(cnt, __ATOMIC_RELAXED, __HIP_MEMORY_SCOPE_AGENT) < n) { if (++polls > (1u << 18)) break; __builtin_amdgcn_s_sleep(2); }
        __builtin_amdgcn_fence(__ATOMIC_ACQUIRE, "agent"); asm volatile("s_waitcnt vmcnt(0)" ::: "memory"); }
    __syncthreads();
}
__device__ __forceinline__ void phase_mix(const ArgsL& a, Frame& F, int layer, const unsigned* ca_done) {
#ifdef SEQ_SCAN
    if (F.bx < N_RW_WG) { int nr = REP_SCAN; asm volatile("" : "+s"(nr)); for (int r = 0; r < nr; ++r) rwkv_scan(a, F, F.bx, (r + 1 < nr) ? REP_SCAN_DRY : 0); }
#else
#ifndef REP_CHB
#define REP_CHB 1
#endif
    if (F.bx < 12) { wg_wait(ca_done, gridDim.x);
        int nr = REP_CHB; asm volatile("" : "+s"(nr)); for (int r = 0; r < nr; ++r) rwkv_chunkB(a, F, F.bx); }
#endif
    float gqm = fabsf(a.in(I_QG)[layer * 64 + F.lane]), gkm = fabsf(a.in(I_KG)[layer * 64 + F.lane]);
#pragma unroll
    for (int off = 1; off < 64; off <<= 1) { gqm = fmaxf(gqm, __shfl_xor(gqm, off)); gkm = fmaxf(gkm, __shfl_xor(gkm, off)); }
    const float bound = 64.0f * C2 * gqm * gkm * 1.02f + 0.5f;
    unsigned* head = (unsigned*)(a.ws + WS_CTL) + CW_QUEUE + 64 * layer;
    for (;;) {
        if (F.tid == 0) F.MISC[16] = __hip_atomic_fetch_add(head, 1u, __ATOMIC_RELAXED, __HIP_MEMORY_SCOPE_AGENT);
        __syncthreads();
        const int u = (int)F.MISC[16];
        __syncthreads();
        if (u >= N_FX_UNITS + N_SB_UNITS) break;
        if (u < N_FX_UNITS) { const int qb = 64 - u / 10, bh = u % 10; int nr = REP_FOX; asm volatile("" : "+s"(nr)); for (int r = 0; r < nr; ++r) attn_unit<0>(a, F, bh / FX_H, bh % FX_H, qb, bound); }
        else { const int v = u - N_FX_UNITS; const int qb = 64 - v / 10, bh = v % 10; int nr = REP_SB; asm volatile("" : "+s"(nr)); for (int r = 0; r < nr; ++r) attn_unit<1>(a, F, bh / SB_H, bh % SB_H, qb, bound); }
    }
}

__device__ __forceinline__ void chain_publish(unsigned* cnt, int pm) {
    asm volatile("s_waitcnt vmcnt(0)" ::: "memory");
    if ((threadIdx.x & 63) == 0) __hip_atomic_fetch_add(cnt + CH_STRIDE * pm, 1u, __ATOMIC_RELAXED, __HIP_MEMORY_SCOPE_AGENT);
}
struct GatesOrder : pg8::StaticOrder {
    unsigned* mine;
    __device__ bool next(int i, pg8::Unit& u) const {
        long L;
        if (i < 5) L = (long)i * 256 + c;
        else if (i == 5) { if (c >= 16 && c < 20) return false; L = 1280 + c; }
        else if (i == 6) { if (c < 12) L = 1536 + c; else if (c < 16) L = 1280 + 16 + (c - 12); else return false; }
        else return false;
        int wgid = (int)L; { const int q = nwg / pg8::NXCD, r = nwg % pg8::NXCD, xcd = wgid % pg8::NXCD, off = wgid / pg8::NXCD; wgid = (xcd < r ? xcd * (q + 1) : r * (q + 1) + (xcd - r) * q) + off; }
        const int nig = pg8::WGM * nN, gid = wgid / nig, fm = gid * pg8::WGM, gsz = (nM - fm) < pg8::WGM ? (nM - fm) : pg8::WGM;
        u.pm = fm + ((wgid % nig) % gsz); u.pn = (wgid % nig) / gsz; return true;
    }
    __device__ __forceinline__ void a_ready(const pg8::Unit&) const {}
    __device__ __forceinline__ void done(const pg8::Unit& u) const { chain_publish(mine, u.pm); }
};
template <bool WAIT, bool PUB>
struct ChainOrder : pg8::StaticOrder {
    const unsigned* ready; unsigned need; unsigned* mine;
    __device__ __forceinline__ void a_ready(const pg8::Unit& u) const {
        if constexpr (WAIT) {
            if (threadIdx.x < 64) {
                const unsigned* w = ready + CH_STRIDE * u.pm; unsigned polls = 0;
                while ((unsigned)__builtin_amdgcn_readfirstlane(__hip_atomic_load(w, __ATOMIC_RELAXED, __HIP_MEMORY_SCOPE_AGENT)) < need) { if (++polls > (1u << 18)) break; __builtin_amdgcn_s_sleep(2); }
                __builtin_amdgcn_fence(__ATOMIC_ACQUIRE, "agent");
                asm volatile("s_waitcnt vmcnt(0)" ::: "memory");
            }
            asm volatile("" ::: "memory"); __builtin_amdgcn_s_barrier(); asm volatile("" ::: "memory");
        }
    }
    __device__ __forceinline__ void done(const pg8::Unit& u) const { if constexpr (PUB) chain_publish(mine, u.pm); }
};

__device__ __forceinline__ void phase_post(const ArgsL& a, Frame& F, int layer, unsigned* chain, const bool dry = false) {
    const int lane = F.lane, wave = F.wave, it4 = lane >> 4, e4 = lane & 15;
    bf16_t* Y0 = (bf16_t*)(a.ws + WS_YCAT); const bf16_t* BN = (const bf16_t*)(a.ws + WS_BN);
    const __amdgpu_buffer_rsrc_t yrs = __builtin_amdgcn_make_buffer_rsrc((void*)Y0, 0, (int)((size_t)M * YC_W * 2), 0x00020000);
    LAS float* lgl = (LAS float*)F.lds;
    for (int i = F.tid; i < 2 * RW_W; i += NTHR) lgl[i] = (i < RW_W) ? a.in(I_LNG)[layer * RW_W + i] : a.in(I_LNB)[layer * RW_W + i - RW_W];
    __syncthreads();
    unsigned* head = (unsigned*)(a.ws + WS_CTL) + CW_QUEUE + 64 * layer + 32 + (dry ? 8 : 0);
    for (;;) {
        if (F.tid == 0) F.MISC[17] = __hip_atomic_fetch_add(head, 1u, __ATOMIC_RELAXED, __HIP_MEMORY_SCOPE_AGENT);
        __syncthreads();
        const int ch = (int)F.MISC[17];
        __syncthreads();
        if (ch >= M / 64) break;
        u32x2 yn = {0u, 0u}, bn = {0u, 0u};
#define PP_ADDR(ps) const int item_ = (ps) * 32 + wave * 4 + it4, rw_ = item_ / 6, hh_ = item_ - rw_ * 6; const int m_ = ch * 64 + rw_; const size_t off_ = (size_t)m_ * RW_W + hh_ * 64 + e4 * 4, offy_ = (size_t)m_ * YC_W + hh_ * 64 + e4 * 4
        { PP_ADDR(0); yn = *(const u32x2*)(Y0 + offy_); bn = *(const u32x2*)(BN + off_); }
#pragma unroll 1
        for (int ps = 0; ps < 12; ++ps) {
            const u32x2 yv = yn, bv = bn;
            if (ps + 1 < 12) { PP_ADDR(ps + 1); yn = *(const u32x2*)(Y0 + offy_); bn = *(const u32x2*)(BN + off_); }
            PP_ADDR(ps);
            const int p = m_ % T;
            u32x2 w = {0u, 0u};
            if (p >= PADR) {
                const float y0 = bf_lo(yv.x), y1 = bf_hi(yv.x), y2 = bf_lo(yv.y), y3 = bf_hi(yv.y);
                const float mean = allred16((y0 + y1) + (y2 + y3)) * (1.f / 64.f);
                const float d0 = y0 - mean, d1 = y1 - mean, d2 = y2 - mean, d3 = y3 - mean;
                const float rs = 1.0f / sqrtf(allred16((d0 * d0 + d1 * d1) + (d2 * d2 + d3 * d3)) * (1.f / 64.f) + 64e-5f);
                const f32x4 g4 = *(const LAS f32x4*)(lgl + hh_ * 64 + e4 * 4), b4 = *(const LAS f32x4*)(lgl + RW_W + hh_ * 64 + e4 * 4);
                w = (u32x2){pk2(d0 * rs * g4.x + b4.x + bf_lo(bv.x), d1 * rs * g4.y + b4.y + bf_hi(bv.x)), pk2(d2 * rs * g4.z + b4.z + bf_lo(bv.y), d3 * rs * g4.w + b4.w + bf_hi(bv.y))};
            }
            if (!dry) __builtin_amdgcn_raw_buffer_store_b64(w, yrs, (int)(offy_ * 2), 0, 16); else asm volatile("" :: "v"(w.x), "v"(w.y));
        }
#undef PP_ADDR
        if (!dry) {
#pragma unroll 1
            for (int k = 0; k < 16; ++k) { const int pr = wave * 16 + k, sl = pr >> 6, m2 = ch * 64 + (pr & 63); const int p = m2 % T;
                const int rowb = (int)(((size_t)m2 * YC_W + 384 * (sl + 1)) * 2);
                if (p < PADR) { for (int c = lane; c < RW_W / 2; c += 64) __builtin_amdgcn_raw_buffer_store_b32(0u, yrs, rowb + 4 * c, 0, 16); }
                else if (lane < 32) __builtin_amdgcn_raw_buffer_store_b32(0u, yrs, rowb + 640 + 4 * lane, 0, 16); }
            chain_publish(chain, ch >> 2);
        }
    }
}

struct EpiInproj { static constexpr bool PERM = true, AFTER_DRAIN = false, MIDHOOK = false; bf16_t* ush; bf16_t* qkv;
    __device__ __forceinline__ void operator()(const f32x4 (&acc)[2][2][4][2], const pg8::Unit& u, int wr, int wc, int fr, int fq) const {
        asm volatile("" : "+v"(fr), "+v"(fq));
        const int row0 = u.pm * 256 + wr * 64 + fr, colt = u.pn * 256 + wc * 32 + 8 * fq;
        const __amdgpu_buffer_rsrc_t urs = __builtin_amdgcn_make_buffer_rsrc((void*)ush, 0, (int)((size_t)(M + 256) * SHIFT_W * 2), 0x00020000);
        const __amdgpu_buffer_rsrc_t qrs = __builtin_amdgcn_make_buffer_rsrc((void*)qkv, 0, (int)((size_t)(M + 256) * QKV_W * 2), 0x00020000);
#pragma unroll
        for (int ai = 0; ai < 2; ++ai)
#pragma unroll
            for (int m = 0; m < 4; ++m) { const size_t row = (size_t)(row0 + ai * 128 + m * 16);
#pragma unroll
                for (int bj = 0; bj < 2; ++bj) { const int col = colt + bj * 128; const f32x4 v0 = acc[ai][bj][m][0], v1 = acc[ai][bj][m][1];
                    const float sc = (col >= SHIFT_W && col < SHIFT_W + 320) ? C2 : 1.0f;
                    u32x4 w; w.x = pk2(v0[0] * sc, v0[1] * sc); w.y = pk2(v0[2] * sc, v0[3] * sc); w.z = pk2(v1[0] * sc, v1[1] * sc); w.w = pk2(v1[2] * sc, v1[3] * sc);
                    if (col < SHIFT_W) __builtin_amdgcn_raw_buffer_store_b128(w, urs, (int)((row * SHIFT_W + col) * 2), 0, 16);
                    else if (col < SHIFT_W + QKV_W) __builtin_amdgcn_raw_buffer_store_b128(w, qrs, (int)((row * QKV_W + (col - SHIFT_W)) * 2), 0, 16); } }
    }
};
struct EpiGates { static constexpr bool PERM = true, AFTER_DRAIN = false, MIDHOOK = false; bf16_t* gates;
    __device__ __forceinline__ void operator()(const f32x4 (&acc)[2][2][4][2], const pg8::Unit& u, int wr, int wc, int fr, int fq) const {
        asm volatile("" : "+v"(fr), "+v"(fq));
        const int row0 = u.pm * 256 + wr * 64 + fr, colt = u.pn * 256 + wc * 32 + 8 * fq;
        const __amdgpu_buffer_rsrc_t rs = __builtin_amdgcn_make_buffer_rsrc((void*)gates, 0, (int)((size_t)M * 3072 * 2), 0x00020000);
#pragma unroll
        for (int ai = 0; ai < 2; ++ai)
#pragma unroll
            for (int m = 0; m < 4; ++m) { const size_t row = (size_t)(row0 + ai * 128 + m * 16);
#pragma unroll
                for (int bj = 0; bj < 2; ++bj) { const int col = colt + bj * 128; f32x4 v0 = acc[ai][bj][m][0], v1 = acc[ai][bj][m][1];
#pragma unroll
                    for (int q = 0; q < 4; ++q) { v0[q] = __builtin_amdgcn_rcpf(1.f + __builtin_amdgcn_exp2f(-v0[q] * LOG2E)); v1[q] = __builtin_amdgcn_rcpf(1.f + __builtin_amdgcn_exp2f(-v1[q] * LOG2E)); }
                    u32x4 w; w.x = pk2(v0[0], v0[1]); w.y = pk2(v0[2], v0[3]); w.z = pk2(v1[0], v1[1]); w.w = pk2(v1[2], v1[3]);
                    __builtin_amdgcn_raw_buffer_store_b128(w, rs, (int)((row * 3072 + col) * 2), 0, 16); } }
    }
};
struct EpiMergeF { static constexpr bool PERM = true, AFTER_DRAIN = false, MIDHOOK = true; const bf16_t* gates; bf16_t* merged;
    __device__ __forceinline__ void mid(f32x4 (&acc)[2][2][4][2], const pg8::Unit& u, int wr, int wc, int fr, int fq, int seg) const {
        asm volatile("" : "+v"(fr), "+v"(fq));
        const int row0 = u.pm * 256 + wr * 64 + fr, colt = u.pn * 256 + wc * 32 + 8 * fq;
        u32x4 gpn[2], gnn[2];
#define MG_LOAD(q) do { const bf16_t* gpt_ = gates + (size_t)(row0 + ((q) >> 2) * 128 + ((q) & 3) * 16) * 3072 + (seg - 1) * 1024 + colt; \
            gpn[0] = *(const u32x4*)gpt_; gnn[0] = *(const u32x4*)(gpt_ + 1024); gpn[1] = *(const u32x4*)(gpt_ + 128); gnn[1] = *(const u32x4*)(gpt_ + 1024 + 128); } while (0)
        MG_LOAD(0);
#pragma unroll
        for (int q = 0; q < 8; ++q) { const int ai = q >> 2, m = q & 3;
            u32x4 gp[2], gn[2];
#pragma unroll
            for (int bj = 0; bj < 2; ++bj) { gp[bj] = gpn[bj]; gn[bj] = gnn[bj]; }
            if (q < 7) MG_LOAD(q + 1);
#pragma unroll
            for (int bj = 0; bj < 2; ++bj) { f32x4& v0 = acc[ai][bj][m][0]; f32x4& v1 = acc[ai][bj][m][1];
                v0[0] *= bf_lo(gp[bj].x) * __builtin_amdgcn_rcpf(bf_lo(gn[bj].x)); v0[1] *= bf_hi(gp[bj].x) * __builtin_amdgcn_rcpf(bf_hi(gn[bj].x));
                v0[2] *= bf_lo(gp[bj].y) * __builtin_amdgcn_rcpf(bf_lo(gn[bj].y)); v0[3] *= bf_hi(gp[bj].y) * __builtin_amdgcn_rcpf(bf_hi(gn[bj].y));
                v1[0] *= bf_lo(gp[bj].z) * __builtin_amdgcn_rcpf(bf_lo(gn[bj].z)); v1[1] *= bf_hi(gp[bj].z) * __builtin_amdgcn_rcpf(bf_hi(gn[bj].z));
                v1[2] *= bf_lo(gp[bj].w) * __builtin_amdgcn_rcpf(bf_lo(gn[bj].w)); v1[3] *= bf_hi(gp[bj].w) * __builtin_amdgcn_rcpf(bf_hi(gn[bj].w)); }
            __builtin_amdgcn_sched_barrier(0); }
#undef MG_LOAD
    }
    __device__ __forceinline__ void operator()(const f32x4 (&acc)[2][2][4][2], const pg8::Unit& u, int wr, int wc, int fr, int fq) const {
        asm volatile("" : "+v"(fr), "+v"(fq));
        const int row0 = u.pm * 256 + wr * 64 + fr, colt = u.pn * 256 + wc * 32 + 8 * fq;
        const __amdgpu_buffer_rsrc_t mrs = __builtin_amdgcn_make_buffer_rsrc((void*)merged, 0, (int)((size_t)M * D * 2), 0x00020000);
        u32x4 gnx[2];
#define MG_LOAD2(q) do { const bf16_t* gpt_ = gates + (size_t)(row0 + ((q) >> 2) * 128 + ((q) & 3) * 16) * 3072 + 2048 + colt; gnx[0] = *(const u32x4*)gpt_; gnx[1] = *(const u32x4*)(gpt_ + 128); } while (0)
        MG_LOAD2(0);
#pragma unroll
        for (int q = 0; q < 8; ++q) { const int ai = q >> 2, m = q & 3; const size_t row = (size_t)(row0 + ai * 128 + m * 16);
            u32x4 g[2];
#pragma unroll
            for (int bj = 0; bj < 2; ++bj) g[bj] = gnx[bj];
            if (q < 7) MG_LOAD2(q + 1);
#pragma unroll
            for (int bj = 0; bj < 2; ++bj) { const f32x4 v0 = acc[ai][bj][m][0], v1 = acc[ai][bj][m][1];
                u32x4 w;
                w.x = pk2(bf_lo(g[bj].x) * v0[0], bf_hi(g[bj].x) * v0[1]); w.y = pk2(bf_lo(g[bj].y) * v0[2], bf_hi(g[bj].y) * v0[3]);
                w.z = pk2(bf_lo(g[bj].z) * v1[0], bf_hi(g[bj].z) * v1[1]); w.w = pk2(bf_lo(g[bj].w) * v1[2], bf_hi(g[bj].w) * v1[3]);
                __builtin_amdgcn_raw_buffer_store_b128(w, mrs, (int)((row * D + colt + bj * 128) * 2), 0, 16); }
            __builtin_amdgcn_sched_barrier(0); }
#undef MG_LOAD2
    }
};
struct EpiOut { static constexpr bool PERM = true, AFTER_DRAIN = false, MIDHOOK = false; bf16_t* hb;
    __device__ __forceinline__ void operator()(const f32x4 (&acc)[2][2][4][2], const pg8::Unit& u, int wr, int wc, int fr, int fq) const {
        asm volatile("" : "+v"(fr), "+v"(fq));
        const int row0 = u.pm * 256 + wr * 64 + fr, colt = u.pn * 256 + wc * 32 + 8 * fq;
        u32x4 hn[2];
#define OUT_LOAD(q) do { const bf16_t* p_ = hb + (size_t)(row0 + ((q) >> 2) * 128 + ((q) & 3) * 16) * D + colt; hn[0] = *(const u32x4*)(p_); hn[1] = *(const u32x4*)(p_ + 128); } while (0)
        OUT_LOAD(0);
#pragma unroll
        for (int q = 0; q < 8; ++q) {
            const int ai = q >> 2, m = q & 3;
            bf16_t* hp = hb + (size_t)(row0 + ai * 128 + m * 16) * D + colt; const u32x4 h0 = hn[0], h1 = hn[1];
            if (q < 7) OUT_LOAD(q + 1);
#pragma unroll
            for (int bj = 0; bj < 2; ++bj) { const u32x4 hh = bj ? h1 : h0; const f32x4 v0 = acc[ai][bj][m][0], v1 = acc[ai][bj][m][1];
                u32x4 w; w.x = pk2(bf_lo(hh.x) + v0[0], bf_hi(hh.x) + v0[1]); w.y = pk2(bf_lo(hh.y) + v0[2], bf_hi(hh.y) + v0[3]);
                w.z = pk2(bf_lo(hh.z) + v1[0], bf_hi(hh.z) + v1[1]); w.w = pk2(bf_lo(hh.w) + v1[2], bf_hi(hh.w) + v1[3]);
                *(u32x4*)(hp + bj * 128) = w; }
            __builtin_amdgcn_sched_barrier(0);
        }
#undef OUT_LOAD
    }
};
template <bool GA, bool WAIT, bool PUB, bool REV> struct MoeOrderT { static constexpr bool GATHER = GA; const volatile LAS int* tb; int ntile, npt, G, c, rep; const int* s2t; unsigned* cnt; unsigned need;
    __device__ __forceinline__ bool next(int i, pg8::Unit& u) const { long L = (long)i * G + (REV ? G - 1 - c : c); if (L >= (long)ntile * npt * rep) return false; L %= (long)ntile * npt;
        const int tau = (int)(L / npt), j = (int)(L - (long)tau * npt); int e = 0;
#pragma unroll
        for (int k = 1; k < 16; ++k) e += (tau >= tb[k]) ? 1 : 0;
        u.pm = tau; u.pn = __builtin_amdgcn_readfirstlane(e) * npt + j; return true; }
    __device__ __forceinline__ void a_ready(const pg8::Unit& u) const {
        if constexpr (WAIT) {
            if (threadIdx.x < 64) {
                const unsigned* w = cnt + CH_STRIDE * u.pm; unsigned polls = 0;
                while ((unsigned)__builtin_amdgcn_readfirstlane(__hip_atomic_load(w, __ATOMIC_RELAXED, __HIP_MEMORY_SCOPE_AGENT)) < need) { if (++polls > (1u << 18)) break; __builtin_amdgcn_s_sleep(2); }
                __builtin_amdgcn_fence(__ATOMIC_ACQUIRE, "agent");
                asm volatile("s_waitcnt vmcnt(0)" ::: "memory");
            }
            asm volatile("" ::: "memory"); __builtin_amdgcn_s_barrier(); asm volatile("" ::: "memory");
        }
    }
    __device__ __forceinline__ void done(const pg8::Unit& u) const { if constexpr (PUB) chain_publish(cnt, u.pm); }
};
struct EpiMoeUp { static constexpr bool PERM = true, AFTER_DRAIN = false, MIDHOOK = false; bf16_t* hs;
    __device__ __forceinline__ void operator()(const f32x4 (&acc)[2][2][4][2], const pg8::Unit& u, int wr, int wc, int fr, int fq) const {
        asm volatile("" : "+v"(fr), "+v"(fq));
        const int row0 = u.pm * 256 + wr * 64 + fr, col = (u.pn & 1) * 128 + wc * 32 + 8 * fq;
        const __amdgpu_buffer_rsrc_t hrs = __builtin_amdgcn_make_buffer_rsrc((void*)hs, 0, (int)((size_t)MS * DEXP * 2), 0x00020000);
#pragma unroll
        for (int ai = 0; ai < 2; ++ai)
#pragma unroll
            for (int m = 0; m < 4; ++m) { const size_t row = (size_t)(row0 + ai * 128 + m * 16); float r[8];
#pragma unroll
                for (int n = 0; n < 2; ++n)
#pragma unroll
                    for (int q = 0; q < 4; ++q) { const float gte = acc[ai][0][m][n][q], up = acc[ai][1][m][n][q]; r[4 * n + q] = gte * __builtin_amdgcn_rcpf(1.f + __builtin_amdgcn_exp2f(-gte * LOG2E)) * up; }
                u32x4 w; w.x = pk2(r[0], r[1]); w.y = pk2(r[2], r[3]); w.z = pk2(r[4], r[5]); w.w = pk2(r[6], r[7]);
                __builtin_amdgcn_raw_buffer_store_b128(w, hrs, (int)((row * DEXP + col) * 2), 0, 16); }
    }
};
struct EpiMoeDown { static constexpr bool PERM = true, AFTER_DRAIN = false, MIDHOOK = false; bf16_t* y; const float* cws;
    __device__ __forceinline__ void operator()(const f32x4 (&acc)[2][2][4][2], const pg8::Unit& u, int wr, int wc, int fr, int fq) const {
        asm volatile("" : "+v"(fr), "+v"(fq));
        const int row0 = u.pm * 256 + wr * 64 + fr, colt = (u.pn & 3) * 256 + wc * 32 + 8 * fq;
        float cw[8];
#pragma unroll
        for (int q = 0; q < 8; ++q) cw[q] = cws[row0 + (q >> 2) * 128 + (q & 3) * 16];
#pragma unroll
        for (int ai = 0; ai < 2; ++ai)
#pragma unroll
            for (int m = 0; m < 4; ++m) { const size_t row = (size_t)(row0 + ai * 128 + m * 16); const float cwv = cw[ai * 4 + m];
#pragma unroll
                for (int bj = 0; bj < 2; ++bj) { const int col = colt + bj * 128; const f32x4 v0 = acc[ai][bj][m][0] * cwv, v1 = acc[ai][bj][m][1] * cwv;
                    u32x4 w; w.x = pk2(v0[0], v0[1]); w.y = pk2(v0[2], v0[3]); w.z = pk2(v1[0], v1[1]); w.w = pk2(v1[2], v1[3]);
                    *(u32x4*)(y + row * D + col) = w; } }
    }
};


#ifndef PH_MASK
#define PH_MASK 0xFFFF
#endif
#define PH(k) ((PH_MASK >> (k)) & 1)
#ifndef PROBE_DUP
#define PROBE_DUP 0
#endif
#define DUPN(bit) (((PROBE_DUP >> (bit)) & 1) ? 2 : 1)
#ifndef PROBE_THIN
#define PROBE_THIN 0
#endif
#define THIN(bit) ((PROBE_THIN >> (bit)) & 1)
#define FRESH() do { asm volatile("" : "+v"(F.tid)); F.lane = F.tid & 63; F.wave = __builtin_amdgcn_readfirstlane(F.tid >> 6); { int bx_ = (int)blockIdx.x; asm volatile("" : "+s"(bx_)); F.bx = bx_; } { unsigned char* w_ = a.ws; asm volatile("" : "+s"(w_)); a.ws = w_; } } while (0)
__global__ void __launch_bounds__(NTHR, 2) hybrid_fwd(Args ka) {
    extern __shared__ __attribute__((aligned(16))) unsigned char lds_raw[];
    Frame F;
    F.lds = (LAS unsigned char*)lds_raw;
    F.MISC = (volatile LAS unsigned*)(F.lds + MISC_OFF);
    F.tid = threadIdx.x; F.lane = F.tid & 63; F.wave = __builtin_amdgcn_readfirstlane(F.tid >> 6); F.bx = (int)blockIdx.x;
    for (int u = F.tid; u < (LDS_BYTES - MISC_OFF) / 4; u += NTHR) ((LAS unsigned*)(F.lds + MISC_OFF))[u] = 0u;
    __syncthreads();
    if (F.tid < 29) { const unsigned long long p = (unsigned long long)ka.in[F.tid]; F.MISC[64 + 2 * F.tid] = (unsigned)p; F.MISC[65 + 2 * F.tid] = (unsigned)(p >> 32); }
    __syncthreads();
    ArgsL a; a.tab = F.MISC + 64; a.out = ka.out; a.ws = ka.ws;
    XcdBarrier bar = xcd_barrier_post((unsigned*)(a.ws + WS_CTL) + CW_BAR, F.MISC + 8);
    const int G = (int)gridDim.x, c = (int)blockIdx.x;
    PG8_LAS unsigned char* ring = (PG8_LAS unsigned char*)F.lds;

#ifdef PROF_K
    volatile LAS unsigned* tsl = F.MISC + 1536; int nts = 0;
    if (blockIdx.x == 0 && F.tid == 0) tsl[nts] = (unsigned)__builtin_amdgcn_s_memrealtime();
    ++nts;
#define BARX() do { xcd_barrier(bar); if (blockIdx.x == 0 && F.tid == 0) tsl[nts] = (unsigned)__builtin_amdgcn_s_memrealtime(); ++nts; } while (0)
#else
#define BARX() xcd_barrier(bar)
#endif
    for (int layer = 0; layer < DEPTH; ++layer) {
        for (int rep = 0; rep < DUPN(8); ++rep) { FRESH(); if (PH(0)) phase_wconv(a, F, layer); }
        __syncthreads();
        if (THIN(0)) { FRESH(); phase_norm<1>(a, F, layer, true); }
        FRESH(); if (PH(1)) phase_norm<1>(a, F, layer);
        BARX();
        unsigned* ch1 = (unsigned*)(a.ws + WS_CTL) + CW_G1 + layer * 129 * CH_STRIDE;
        FRESH(); if (PH(2)) {
            pg8::Gemm g{(const bf16_t*)A_PTR(a), (const bf16_t*)(a.ws + WS_WIN), M, N1, D}; ChainOrder<false, true> S; S.init(M, N1, G, c, 1); S.ready = nullptr; S.need = 0u; S.mine = ch1;
            EpiInproj E{(bf16_t*)(a.ws + WS_USH), (bf16_t*)(a.ws + WS_QKV)};
            pg8::gemm_phase<EpiInproj, ChainOrder<false, true>, true, true>(ring, g, S, E);
        }
        asm volatile("s_waitcnt vmcnt(0) lgkmcnt(0)" ::: "memory"); __syncthreads();
        FRESH(); if (PH(3)) phase_prep(a, F, layer, ch1, (unsigned*)(a.ws + WS_CTL) + CW_QUEUE + 64 * layer + 48);
        BARX();
#ifndef SEQ_SCAN
        if (THIN(2)) { FRESH(); phase_chunkA(a, F, true); }
        FRESH(); if (PH(4)) phase_chunkA(a, F);
        unsigned* ca_done = (unsigned*)(a.ws + WS_CTL) + CW_CADONE + 64 * layer;
        wg_publish(ca_done);
#endif
        FRESH(); if (PH(4)) phase_mix(a, F, layer, ca_done);
        BARX();
        unsigned* ch2 = (unsigned*)(a.ws + WS_CTL) + CW_CHAIN + (layer * 2) * 129 * CH_STRIDE; unsigned* ch3 = ch2 + 129 * CH_STRIDE;
        FRESH(); if (PH(6)) {
            pg8::Gemm g{(const bf16_t*)A_PTR(a), (const bf16_t*)(a.ws + WS_WG), M, 3072, D}; GatesOrder S; S.init(M, 3072, G, c, 1); S.mine = ch2;
            EpiGates E{(bf16_t*)(a.ws + WS_GATES)};
            pg8::gemm_phase<EpiGates, GatesOrder, true, true>(ring, g, S, E);
        }
        asm volatile("s_waitcnt vmcnt(0) lgkmcnt(0)" ::: "memory"); __syncthreads();
        if (THIN(3)) { FRESH(); phase_post(a, F, layer, ch2, true); }
        FRESH(); if (PH(5)) { if (!(c < 20 || (c >= 32 && c < 36))) phase_post(a, F, layer, ch2); }
        __syncthreads();
        FRESH(); if (PH(7)) {
            pg8::Gemm g{(const bf16_t*)(a.ws + WS_YCAT), (const bf16_t*)(a.ws + WS_WP), M, D, YC_W}; ChainOrder<true, true> S; S.init(M, D, G, (c + G - 16) % G, 1); S.ready = ch2; S.need = 128u; S.mine = ch3;
            EpiMergeF E{(const bf16_t*)(a.ws + WS_GATES), (bf16_t*)(a.ws + WS_MERGED)};
            pg8::gemm_phase<EpiMergeF, ChainOrder<true, true>, true, true>(ring, g, S, E);
        }
        FRESH(); if (PH(8)) {
            pg8::Gemm g{(const bf16_t*)(a.ws + WS_MERGED), (const bf16_t*)(a.ws + WS_WO), M, D, D}; ChainOrder<true, false> S; S.init(M, D, G, (c + G - 32) % G, 1); S.ready = ch3; S.need = 32u; S.mine = nullptr;
            EpiOut E{HB_PTR(a)};
            pg8::gemm_phase<EpiOut, ChainOrder<true, false>, true, true>(ring, g, S, E);
        }
        BARX();
        if (THIN(4)) { FRESH(); phase_norm2(a, F, layer, true); }
        FRESH(); if (PH(9)) phase_norm2(a, F, layer);
        BARX();
        for (int rep = 0; rep < DUPN(7); ++rep) { FRESH(); if (PH(10)) phase_route(a, F, layer); }
        BARX();
        volatile LAS int* tb = (volatile LAS int*)(F.MISC + 32);
        if (F.tid <= 16) { const int* cnt = (const int*)(a.ws + WS_CTL) + CW_ECNT + 64 * layer; int t = 0;
            for (int e = 0; e < F.tid; ++e) t += (__hip_atomic_load(cnt + e, __ATOMIC_RELAXED, __HIP_MEMORY_SCOPE_AGENT) + 255) >> 8;
            tb[F.tid] = t; }
        __syncthreads();
        const int ntile = tb[16];
        unsigned* chm = (unsigned*)(a.ws + WS_CTL) + CW_MOE + layer * (MS / 256) * CH_STRIDE;
        FRESH(); if (PH(11)) {
            pg8::Gemm g{(const bf16_t*)A_PTR(a), (const bf16_t*)(a.ws + WS_WGU), MS, 8192, D}; MoeOrderT<true, false, true, false> S{tb, ntile, 2, G, c, 1, (const int*)(a.ws + WS_S2T), chm, 0u};
            EpiMoeUp E{(bf16_t*)(a.ws + WS_HS)};
            pg8::gemm_phase<EpiMoeUp, MoeOrderT<true, false, true, false>, true, true>(ring, g, S, E);
        }
        FRESH(); if (PH(12)) {
            int kdim = DEXP; asm volatile("" : "+s"(kdim));
            pg8::Gemm g{(const bf16_t*)(a.ws + WS_HS), (const bf16_t*)(a.ws + WS_WD), MS, 16384, kdim}; MoeOrderT<false, true, false, true> S{tb, ntile, 4, G, c, 1, nullptr, chm, 16u};
            EpiMoeDown E{(bf16_t*)(a.ws + WS_Y), (const float*)(a.ws + WS_CWS)};
            pg8::gemm_phase<EpiMoeDown, MoeOrderT<false, true, false, true>, true, true>(ring, g, S, E);
        }
        BARX();
    }
    if (THIN(5)) { FRESH(); phase_norm<0>(a, F, DEPTH - 1, true); }
    FRESH(); if (PH(13)) phase_norm<0>(a, F, DEPTH - 1);
#ifdef PROF_K
    BARX();
    if (blockIdx.x == 0) {
        __syncthreads();
        float us;
        if (PROF_K < 0) us = 100.f;
        else if (PROF_K == 12) us = (float)(tsl[25] - tsl[24]) * 0.01f;
        else if (PROF_K == 13) us = (float)(tsl[25] - tsl[0]) * 0.01f;
        else us = ((float)(tsl[1 + PROF_K] - tsl[PROF_K]) + (float)(tsl[13 + PROF_K] - tsl[12 + PROF_K])) * 0.01f;
        us = 4.f * rintf(us * 0.25f);
        for (int i = F.tid; i < 16384; i += NTHR) a.out[i] = us;
    }
#endif
#ifdef CLOCK_PROBE
    if (blockIdx.x == 0 && F.wave == 0) {
        float c0 = 1.f, c1 = 2.f, c2 = 3.f, c3 = 4.f, c4 = 5.f, c5 = 6.f, c6 = 7.f, c7 = 8.f;
        for (int i = 0; i < CLOCK_PROBE; ++i) {
            asm volatile("v_fma_f32 %0, %0, %0, %0\n\tv_fma_f32 %1, %1, %1, %1\n\tv_fma_f32 %2, %2, %2, %2\n\tv_fma_f32 %3, %3, %3, %3\n\tv_fma_f32 %4, %4, %4, %4\n\tv_fma_f32 %5, %5, %5, %5\n\tv_fma_f32 %6, %6, %6, %6\n\tv_fma_f32 %7, %7, %7, %7"
                         : "+v"(c0), "+v"(c1), "+v"(c2), "+v"(c3), "+v"(c4), "+v"(c5), "+v"(c6), "+v"(c7));
        }
        asm volatile("" :: "v"(c0), "v"(c1), "v"(c2), "v"(c3), "v"(c4), "v"(c5), "v"(c6), "v"(c7));
    }
#endif
}

extern "C" void kernel_launch(void* const* d_in, const int* in_sizes, int n_in, void* d_out, int out_size, void* d_ws, size_t ws_size, hipStream_t stream) {
    static int ready = 0;
    if (ready == 0) {
        if (n_in != 29 || out_size != NB * SEQ * D || ws_size < WS_END) { fprintf(stderr, "kernel_launch: unexpected problem shape (n_in %d, out %d, ws %zu < %zu)\n", n_in, out_size, ws_size, (size_t)WS_END); ready = -1; return; }
        if (hipFuncSetAttribute((const void*)hybrid_fwd, hipFuncAttributeMaxDynamicSharedMemorySize, LDS_BYTES) != hipSuccess) { fprintf(stderr, "kernel_launch: hipFuncSetAttribute failed\n"); ready = -1; return; }
        int per_cu = 0;
        if (hipOccupancyMaxActiveBlocksPerMultiprocessor(&per_cu, (const void*)hybrid_fwd, NTHR, LDS_BYTES) != hipSuccess || per_cu < 1) fprintf(stderr, "kernel_launch: occupancy query says %d\n", per_cu);
        (void)hipGetLastError();
        ready = 1;
    }
    if (ready < 0) return;
    (void)in_sizes;
    if (hipMemsetAsync((char*)d_ws + WS_CTL, 0, CTL_ZERO_BYTES, stream) != hipSuccess) return;
    Args a{};
    for (int i = 0; i < 29; ++i) a.in[i] = (const float*)d_in[i];
    a.out = (float*)d_out; a.ws = (unsigned char*)d_ws;
    hipLaunchKernelGGL(hybrid_fwd, dim3(256), dim3(NTHR), LDS_BYTES, stream, a);
}
```

```cpp
#include <hip/hip_runtime.h>
#include <hip/hip_bf16.h>
#include <cstdio>
#include <cstdint>

#define GAS __attribute__((address_space(1)))
#define LAS __attribute__((address_space(3)))

namespace pg8 {
#define PG8_LAS __attribute__((address_space(3)))
typedef unsigned short bf16_t;
typedef short bf16x8 __attribute__((ext_vector_type(8)));
typedef float f32x4 __attribute__((ext_vector_type(4)));
typedef unsigned u32x4 __attribute__((ext_vector_type(4)));
constexpr int BM = 256, BK = 64, HALF = 128, HTB = HALF * BK * 2  , STAGE_BYTES = 8 * HTB, NXCD = 8, WGM = 8;

__host__ __device__ __forceinline__ int lds_byte(int r, int c) { const int st = (r >> 4) * 2 + (c >> 5), rr = r & 15, cc = c & 31, ob = rr * 64 + cc * 2; return st * 1024 + (ob ^ (((ob >> 9) & 1) << 5)); }
__host__ __device__ __forceinline__ void stage_rc(int b, int& R, int& C) { const int st = b / 1024, sb = b % 1024, swz = sb ^ (((sb >> 9) & 1) << 5); R = (st >> 1) * 16 + swz / 64; C = (st & 1) * 32 + (swz % 64) / 2; }
__host__ __device__ __forceinline__ int perm32(int rho) { const int n = rho >> 4, i = rho & 15; return 8 * (i >> 2) + 4 * n + (i & 3); }

struct Unit { int pm, pn; };
struct Gemm { const bf16_t* A; const bf16_t* Bt; int M, N, K; };

struct StaticOrder {
    int nM, nN, nwg, G, c, rep;
    __host__ __device__ void init(int M, int N, int G_, int c_, int rep_ = 1) { nM = M / BM; nN = N / BM; nwg = nM * nN; G = G_; c = c_; rep = rep_; }
    __host__ __device__ bool next(int i, Unit& u) const {
        const long L = (long)i * G + c; if (L >= (long)nwg * rep) return false;
        int wgid = (int)(L % nwg); { const int q = nwg / NXCD, r = nwg % NXCD, xcd = wgid % NXCD, off = wgid / NXCD; wgid = (xcd < r ? xcd * (q + 1) : r * (q + 1) + (xcd - r) * q) + off; }
        const int nig = WGM * nN, gid = wgid / nig, fm = gid * WGM, gsz = (nM - fm) < WGM ? (nM - fm) : WGM;
        u.pm = fm + ((wgid % nig) % gsz); u.pn = (wgid % nig) / gsz; return true;
    }
    static constexpr bool GATHER = false;
    __device__ __forceinline__ void a_ready(const Unit&) const {}
    __device__ __forceinline__ void done(const Unit&) const {}
};
__device__ __forceinline__ unsigned cvt_pk_bf16(float lo, float hi) { unsigned r; asm volatile("v_cvt_pk_bf16_f32 %0, %1, %2" : "=v"(r) : "v"(lo), "v"(hi)); return r; }
template <class Epi, class Sched, bool ALIGN_EPI = false, bool SP2 = false>
__device__ __forceinline__ void gemm_phase(PG8_LAS unsigned char* lds, const Gemm g, const Sched& S, const Epi& E) {
    int tid_ = threadIdx.x; asm volatile("" : "+v"(tid_));
    const int tid = tid_, wid = __builtin_amdgcn_readfirstlane(tid >> 6), lane = tid & 63, wr = wid >> 2, wc = wid & 3, fr = lane & 15, fq = lane >> 4;
    const int K = g.K, nt = K / BK;
    unsigned voffA[2], voffB[2];
#pragma unroll
    for (int i = 0; i < 2; ++i) { int R, C; stage_rc(tid * 16 + i * 8192, R, C); const int Rb = Epi::PERM ? ((R & ~31) + perm32(R & 31)) : R;
        voffA[i] = (unsigned)(R * K + C) * 2u; voffB[i] = (unsigned)(Rb * K + C) * 2u; }
    constexpr bool GATH = Sched::GATHER;
    unsigned vg[2] = {0u, 0u}, vn[2] = {0u, 0u}; int gR = 0; unsigned gC = 0u;
    if constexpr (GATH) { int R, C; stage_rc(tid * 16, R, C); gR = R; gC = (unsigned)C * 2u; }
#define PG8_GOFF(v, u) do { _Pragma("unroll") for (int h_ = 0; h_ < 2; ++h_) { const int* q_ = S.s2t + (u).pm * 256 + h_ * 128 + gR; v[h_] = (unsigned)q_[0] | ((unsigned)q_[64] << 16); } } while (0)
#define PG8_STAGE_G(bufoff, gbase, pk) do { const unsigned pk_ = (pk); \
        __builtin_amdgcn_global_load_lds((const unsigned*)((const char*)(gbase) + ((pk_ & 0xffffu) * (unsigned)(K * 2) + gC)), (PG8_LAS unsigned*)(lds + (bufoff) + ldsw), 16, 0, 0); \
        __builtin_amdgcn_global_load_lds((const unsigned*)((const char*)(gbase) + ((pk_ >> 16) * (unsigned)(K * 2) + gC)), (PG8_LAS unsigned*)(lds + (bufoff) + ldsw + 8192), 16, 0, 0); } while (0)
    const size_t kstep = (size_t)(BK * 2);
    const size_t hstep = (size_t)HALF * K * 2;
    const size_t tstep = 2 * hstep;
    const unsigned ldsw = (unsigned)wid * 1024u;
    const int aoff = lds_byte(wr * 64 + fr, fq * 8), boff = lds_byte(wc * 32 + fr, fq * 8);
#define PG8_SA(b, h) (((b) * 2 + (h)) * HTB)
#define PG8_SB(b, h) ((4 + (b) * 2 + (h)) * HTB)
#define PG8_STAGE(bufoff, gbase, voff) do { _Pragma("unroll") for (int _i = 0; _i < 2; ++_i) \
        __builtin_amdgcn_global_load_lds((const unsigned*)((const char*)(gbase) + (voff)[_i]), (PG8_LAS unsigned*)(lds + (bufoff) + ldsw + _i * 8192), 16, 0, 0); } while (0)
#define PG8_STAGE_A(bufoff, gbase, h, vv) do { if constexpr (GATH) PG8_STAGE_G(bufoff, gbase, vv[h]); else PG8_STAGE(bufoff, (gbase) + (h) * hstep, voffA); } while (0)
#define PG8_STAGE_A2(bufoff, gbase, h) do { if constexpr (GATH) PG8_STAGE_G(bufoff, gbase, last ? vn[h] : vg[h]); else PG8_STAGE(bufoff, (gbase) + (h) * hstep, voffA); } while (0)
#define PG8_LDA(dst, b, h) do { _Pragma("unroll") for (int m = 0; m < 4; ++m) _Pragma("unroll") for (int k = 0; k < 2; ++k) dst[m][k] = *(const PG8_LAS bf16x8*)(lds + PG8_SA(b, h) + aoff + m * 2048 + k * 1024); } while (0)
#define PG8_LDB(dst, b, h) do { _Pragma("unroll") for (int n = 0; n < 2; ++n) _Pragma("unroll") for (int k = 0; k < 2; ++k) dst[n][k] = *(const PG8_LAS bf16x8*)(lds + PG8_SB(b, h) + boff + n * 2048 + k * 1024); } while (0)
#define PG8_MMA(ai, bj, At, Bt) do { __builtin_amdgcn_s_setprio(1); _Pragma("unroll") for (int m = 0; m < 4; ++m) _Pragma("unroll") for (int n = 0; n < 2; ++n) _Pragma("unroll") for (int k = 0; k < 2; ++k) \
        acc[ai][bj][m][n] = __builtin_amdgcn_mfma_f32_16x16x32_bf16(Bt[n][k], At[m][k], acc[ai][bj][m][n], 0, 0, 0); __builtin_amdgcn_s_setprio(0); } while (0)
#define PG8_WAIT_V(n) asm volatile("s_waitcnt vmcnt(" #n ")" ::: "memory")
#define PG8_WAIT_L(n) asm volatile("s_waitcnt lgkmcnt(" #n ")" ::: "memory")
#define PG8_BAR __builtin_amdgcn_s_barrier()
#define PG8_SCHED __builtin_amdgcn_sched_barrier(0)
    Unit cur, nxt; int ui = 0;
    if (!S.next(0, cur)) return;
    f32x4 acc[2][2][4][2];
#pragma unroll
    for (int a = 0; a < 2; ++a)
#pragma unroll
        for (int b = 0; b < 2; ++b)
#pragma unroll
            for (int m = 0; m < 4; ++m)
#pragma unroll
                for (int n = 0; n < 2; ++n) acc[a][b][m][n] = (f32x4){0.f, 0.f, 0.f, 0.f};
    bf16x8 At[4][2], B0[2][2], B1[2][2];
    const char* cA = GATH ? (const char*)g.A : (const char*)g.A + (size_t)cur.pm * tstep; const char* cB = (const char*)g.Bt + (size_t)cur.pn * tstep;
    S.a_ready(cur);
    if constexpr (GATH) PG8_GOFF(vg, cur);
    if constexpr (SP2) {
        PG8_STAGE(PG8_SB(0, 0), cB, voffB); PG8_STAGE(PG8_SB(0, 1), cB + hstep, voffB); PG8_STAGE_A(PG8_SA(0, 0), cA, 0, vg); PG8_STAGE_A(PG8_SA(0, 1), cA, 1, vg);
        if (wr == 1) PG8_BAR;
        PG8_WAIT_V(2); PG8_BAR;
        PG8_STAGE(PG8_SB(1, 0), cB + kstep, voffB); PG8_STAGE_A(PG8_SA(1, 0), cA + kstep, 0, vg); PG8_STAGE(PG8_SB(1, 1), cB + hstep + kstep, voffB);
        PG8_WAIT_V(6); PG8_BAR;
    } else {
        PG8_STAGE(PG8_SB(0, 0), cB, voffB); PG8_STAGE(PG8_SA(0, 0), cA, voffA); PG8_STAGE(PG8_SB(0, 1), cB + hstep, voffB); PG8_STAGE(PG8_SA(0, 1), cA + hstep, voffA);
        if (wr == 1) PG8_BAR;
        PG8_WAIT_V(4); PG8_BAR;
        PG8_STAGE(PG8_SB(1, 0), cB + kstep, voffB); PG8_STAGE(PG8_SA(1, 0), cA + kstep, voffA); PG8_STAGE(PG8_SB(1, 1), cB + hstep + kstep, voffB);
        PG8_WAIT_V(6); PG8_BAR;
    }
    for (;;) {
        const bool has_next = S.next(ui + 1, nxt);
        const char* nA = (has_next && !GATH) ? (const char*)g.A + (size_t)nxt.pm * tstep : cA;
        if constexpr (GATH) { if (has_next) PG8_GOFF(vn, nxt); else { vn[0] = vg[0]; vn[1] = vg[1]; } } const char* nB = has_next ? (const char*)g.Bt + (size_t)nxt.pn * tstep : cB;
        for (int t = 0; t < nt; t += 2) {
            const bool last = (t == nt - 2);
            const char* a1 = cA + (size_t)(t + 1) * kstep;
            const char* a2 = last ? nA : cA + (size_t)(t + 2) * kstep; const char* b2 = last ? nB : cB + (size_t)(t + 2) * kstep;
            const char* a3 = a2 + kstep; const char* b3 = b2 + kstep;
            if (last && has_next) S.a_ready(nxt);
            if constexpr (SP2) {
            PG8_LDB(B0, 0, 0); PG8_LDB(B1, 0, 1); PG8_SCHED; PG8_LDA(At, 0, 0); PG8_STAGE_A(PG8_SA(1, 1), a1, 1, vg);
            PG8_WAIT_V(8); PG8_WAIT_L(0); PG8_BAR; PG8_MMA(0, 0, At, B0); PG8_MMA(0, 1, At, B1); PG8_BAR; PG8_SCHED;
            PG8_LDA(At, 0, 1); PG8_STAGE(PG8_SB(0, 0), b2, voffB); PG8_STAGE(PG8_SB(0, 1), b2 + hstep, voffB); PG8_STAGE_A2(PG8_SA(0, 0), a2, 0);
            PG8_WAIT_V(8); PG8_WAIT_L(0); PG8_BAR; PG8_MMA(1, 0, At, B0); PG8_MMA(1, 1, At, B1); PG8_BAR; PG8_SCHED;
            PG8_LDB(B0, 1, 0); PG8_LDB(B1, 1, 1); PG8_SCHED; PG8_LDA(At, 1, 0); PG8_STAGE_A2(PG8_SA(0, 1), a2, 1);
            PG8_WAIT_V(8); PG8_WAIT_L(0); PG8_BAR; PG8_MMA(0, 0, At, B0); PG8_MMA(0, 1, At, B1); PG8_BAR; PG8_SCHED;
            PG8_LDA(At, 1, 1); PG8_STAGE(PG8_SB(1, 0), b3, voffB); PG8_STAGE(PG8_SB(1, 1), b3 + hstep, voffB); PG8_STAGE_A2(PG8_SA(1, 0), a3, 0);
            PG8_WAIT_V(8); PG8_WAIT_L(0); PG8_BAR; PG8_MMA(1, 0, At, B0); PG8_MMA(1, 1, At, B1); PG8_BAR; PG8_SCHED;
            } else {
            static_assert(SP2 || !GATH, "gather needs the SP2 schedule");
            PG8_LDB(B0, 0, 0); PG8_SCHED; PG8_LDA(At, 0, 0); PG8_STAGE(PG8_SA(1, 1), a1 + hstep, voffA);
            PG8_WAIT_L(8); PG8_BAR; PG8_WAIT_L(0); PG8_MMA(0, 0, At, B0); PG8_BAR; PG8_SCHED;
            PG8_LDB(B1, 0, 1); PG8_STAGE(PG8_SB(0, 0), b2, voffB);
            PG8_BAR; PG8_WAIT_L(0); PG8_MMA(0, 1, At, B1); PG8_BAR;
            PG8_LDA(At, 0, 1); PG8_STAGE(PG8_SA(0, 0), a2, voffA);
            PG8_BAR; PG8_WAIT_L(0); PG8_MMA(1, 0, At, B0); PG8_BAR; PG8_SCHED;
            PG8_STAGE(PG8_SB(0, 1), b2 + hstep, voffB);
            PG8_WAIT_V(6); PG8_BAR; PG8_MMA(1, 1, At, B1); PG8_BAR;
            PG8_LDB(B0, 1, 0); PG8_SCHED; PG8_LDA(At, 1, 0); PG8_STAGE(PG8_SA(0, 1), a2 + hstep, voffA);
            PG8_WAIT_L(8); PG8_BAR; PG8_WAIT_L(0); PG8_MMA(0, 0, At, B0); PG8_BAR; PG8_SCHED;
            PG8_LDB(B1, 1, 1); PG8_STAGE(PG8_SB(1, 0), b3, voffB);
            PG8_BAR; PG8_WAIT_L(0); PG8_MMA(0, 1, At, B1); PG8_BAR;
            PG8_LDA(At, 1, 1); PG8_STAGE(PG8_SA(1, 0), a3, voffA);
            PG8_BAR; PG8_WAIT_L(0); PG8_MMA(1, 0, At, B0); PG8_BAR; PG8_SCHED;
            PG8_STAGE(PG8_SB(1, 1), b3 + hstep, voffB);
            PG8_WAIT_V(6); PG8_BAR; PG8_MMA(1, 1, At, B1); PG8_BAR;
            }
            if constexpr (Epi::MIDHOOK) { if (t + 2 == 6 || t + 2 == 12) E.mid(acc, cur, wr, wc, fr, fq, (t + 2) / 6); }
        }
        if constexpr (ALIGN_EPI) { if (wr == 0) PG8_BAR; }
        if constexpr (!Epi::AFTER_DRAIN) { E(acc, cur, wr, wc, fr, fq); S.done(cur); }
        if (!has_next) break;
#pragma unroll
        for (int a = 0; a < 2; ++a)
#pragma unroll
            for (int b = 0; b < 2; ++b)
#pragma unroll
                for (int m = 0; m < 4; ++m)
#pragma unroll
                    for (int n = 0; n < 2; ++n) acc[a][b][m][n] = (f32x4){0.f, 0.f, 0.f, 0.f};
        cur = nxt; cA = nA; cB = nB; ++ui;
        if constexpr (GATH) { vg[0] = vn[0]; vg[1] = vn[1]; }
        if constexpr (ALIGN_EPI) { if (wr == 1) PG8_BAR; }
    }
    PG8_WAIT_V(0);
    if constexpr (!ALIGN_EPI) { if (wr == 0) PG8_BAR; }
    PG8_BAR;
    if constexpr (Epi::AFTER_DRAIN) { E.fused(acc, cur, wr, wc, fr, fq, lds, wid, lane); S.done(cur); }
#undef PG8_SA
#undef PG8_SB
#undef PG8_STAGE
#undef PG8_STAGE_A
#undef PG8_STAGE_A2
#undef PG8_STAGE_G
#undef PG8_GOFF
#undef PG8_LDA
#undef PG8_LDB
#undef PG8_MMA
#undef PG8_WAIT_V
#undef PG8_WAIT_L
#undef PG8_BAR
#undef PG8_SCHED
}
}

constexpr int D = 1024, NB = 2, SEQ = 16384, NMETA = 16, LTOK = SEQ + NMETA  , PADR = 112, T = PADR + LTOK  ;
constexpr int M = NB * T;
constexpr int DEPTH = 2, HD = 64, RW_H = 6, SB_H = 5, FX_H = 5, RW_W = 384, SHIFT_W = 1280, D_IN = 6277;
constexpr int YC_W = 1152;
constexpr int QKV_W = 1920;
constexpr int N1 = 3328;
constexpr int FCOL = 3200, GCOL = 3205;
constexpr int NEXP = 16, DEXP = 256;
constexpr int MS = 70144;
constexpr int LCH = 32, LPADDED = 16448;
constexpr int KBP = 16896;
constexpr float C2 = 0.125f * 1.4426950408889634f;
constexpr float LOG2E = 1.4426950408889634f;
constexpr int NWAVES = 8, NTHR = 512;

constexpr size_t MiB = 1u << 20;
constexpr size_t WS_CTL = 0, CTL_ZERO_BYTES = 212992;
constexpr size_t WS_HM = 1 * MiB;
constexpr size_t WS_LOGF = WS_HM + 131072;
constexpr size_t WS_KB2 = WS_LOGF + (size_t)M * 32;
constexpr size_t WS_TOK = WS_KB2 + (size_t)10 * KBP * 4;
constexpr size_t WS_SLOT = WS_TOK + (size_t)M * 32;
constexpr size_t WS_CWS = WS_SLOT + (size_t)M * 8;
constexpr size_t WS_WGCNT = WS_CWS + (size_t)MS * 4;
constexpr size_t WS_S2T = WS_WGCNT + 256 * 16 * 4;
constexpr size_t WS_SMALL_END = WS_S2T + (size_t)MS * 4;
static_assert(WS_SMALL_END <= 8 * MiB, "small buffers");
constexpr size_t WS_WIN = 8 * MiB;
constexpr size_t WS_WG = WS_WIN + (size_t)N1 * 1024 * 2;
constexpr size_t WS_WP = WS_WG + (size_t)3072 * 1024 * 2;
constexpr size_t WS_WO = WS_WP + (size_t)3072 * 384 * 2;
constexpr size_t WS_WGU = WS_WO + (size_t)1024 * 1024 * 2;
constexpr size_t WS_WD = WS_WGU + (size_t)8192 * 1024 * 2;
constexpr size_t WS_W_END = WS_WD + (size_t)16384 * 256 * 2;
static_assert(WS_W_END <= 49 * MiB, "weights");
constexpr size_t WS_HB = 49 * MiB;
constexpr size_t WS_BIG = 115 * MiB;
constexpr size_t WS_USH = WS_BIG;
constexpr size_t WS_YCAT = WS_BIG;
constexpr size_t WS_QKV = WS_BIG + 82 * MiB;
constexpr size_t WS_RW = WS_BIG + 204 * MiB;
constexpr size_t WS_BN = WS_BIG + 349 * MiB;
constexpr size_t WS_GATES = WS_BIG + 82 * MiB;
constexpr size_t WS_MERGED = WS_BIG + 276 * MiB;
constexpr size_t WS_AS = WS_BIG;
constexpr size_t WS_HS = WS_BIG + 137 * MiB;
constexpr size_t WS_Y = WS_BIG + 172 * MiB;
constexpr size_t WS_END = WS_BIG + 374 * MiB;
static_assert((size_t)(M + 256) * 1280 * 2 <= 82 * MiB && (size_t)3 * M * 384 * 2 <= 82 * MiB && (size_t)(M + 256) * 1920 * 2 <= 122 * MiB, "big map 1");
static_assert((size_t)12 * LPADDED * 768 <= 145 * MiB && (size_t)M * 384 * 2 <= 25 * MiB && (size_t)M * 3072 * 2 <= 194 * MiB && (size_t)M * 2048 <= 65 * MiB, "big map 2");
static_assert((size_t)MS * 2048 <= 137 * MiB && (size_t)MS * 512 <= 35 * MiB && WS_END <= 489 * MiB, "big map 3");

constexpr int CW_BAR = 0;
constexpr int CW_QUEUE = 4096;
constexpr int CW_ECNT = 4352;
constexpr int CW_G1 = 42496;
constexpr int CW_MOE = 24960;
constexpr int CW_CADONE = 24832;
constexpr int CW_CHAIN = 8192, CH_STRIDE = 32;
static_assert((CW_ECNT + 128) <= CW_CHAIN && (CW_CHAIN + DEPTH * 2 * 129 * CH_STRIDE) <= CW_CADONE && (CW_CADONE + 128) <= CW_MOE && (CW_MOE + DEPTH * (MS / 256) * 32) <= CW_G1 && (CW_G1 + DEPTH * 129 * 32) * 4 <= (int)CTL_ZERO_BYTES, "ctl");

constexpr int RING_BYTES = 131072, MISC_OFF = RING_BYTES, LDS_BYTES = 163840;

typedef unsigned short bf16_t;
typedef float f32x4 __attribute__((ext_vector_type(4)));
typedef float f32x2 __attribute__((ext_vector_type(2)));
typedef float f32x16 __attribute__((ext_vector_type(16)));
typedef unsigned u32x4 __attribute__((ext_vector_type(4)));
typedef unsigned u32x2 __attribute__((ext_vector_type(2)));
typedef short bf16x8 __attribute__((ext_vector_type(8)));
typedef short s16x4 __attribute__((ext_vector_type(4)));
typedef _Float16 f16x4 __attribute__((ext_vector_type(4)));
typedef __bf16 bf16x2_t __attribute__((ext_vector_type(2)));

__device__ __forceinline__ unsigned pk2(float lo, float hi) { f32x2 v = {lo, hi}; bf16x2_t b = __builtin_convertvector(v, bf16x2_t); return __builtin_bit_cast(unsigned, b); }
__device__ __forceinline__ unsigned short f2bf(float f) { return (unsigned short)(pk2(f, 0.f) & 0xffffu); }
__device__ __forceinline__ float bf_lo(unsigned u) { return __uint_as_float(u << 16); }
__device__ __forceinline__ float bf_hi(unsigned u) { return __uint_as_float(u & 0xffff0000u); }
__device__ __forceinline__ float bf2f(unsigned short h) { return __uint_as_float((unsigned)h << 16); }
template <int CTRL> __device__ __forceinline__ float dpp_f(float x) { return __int_as_float(__builtin_amdgcn_update_dpp(0, __float_as_int(x), CTRL, 0xF, 0xF, false)); }
__device__ __forceinline__ float allred16(float p) { p += dpp_f<0x128>(p); p += dpp_f<0x124>(p); p += dpp_f<0x122>(p); p += dpp_f<0x121>(p); return p; }
__device__ __forceinline__ float wave_sum(float v) {
    v = allred16(v);
    { auto sw = __builtin_amdgcn_permlane16_swap(__float_as_uint(v), __float_as_uint(v), false, false); v = __uint_as_float(sw[0]) + __uint_as_float(sw[1]); }
    { auto sw = __builtin_amdgcn_permlane32_swap(__float_as_uint(v), __float_as_uint(v), false, false); v = __uint_as_float(sw[0]) + __uint_as_float(sw[1]); }
    return v;
}
__device__ __forceinline__ float fast_exp(float x) { return __builtin_amdgcn_exp2f(x * LOG2E); }
__device__ __forceinline__ float fast_log(float x) { return __builtin_amdgcn_logf(x) * 0.6931471805599453f; }
__device__ __forceinline__ float softplus_f(float z) { return fmaxf(z, 0.f) + fast_log(1.f + fast_exp(-fabsf(z))); }

#define XB_TMO      128
#define XB_XCNT(j)  (256  + 64 * (j))
#define XB_XSUB(j)  (1280 + 64 * (j))
#define XB_XGEN(j)  (2304 + 64 * (j))
#define XB_TOP      3328
#define XB_TOPGEN   3392
#define XCD_BAR_WORDS 3456
#define XB_SPIN_CAP (1u << 20)
__device__ __forceinline__ unsigned xb_ld(unsigned* p)              { return __hip_atomic_load(p, __ATOMIC_RELAXED, __HIP_MEMORY_SCOPE_AGENT); }
__device__ __forceinline__ unsigned xb_add(unsigned* p, unsigned v) { return __hip_atomic_fetch_add(p, v, __ATOMIC_RELAXED, __HIP_MEMORY_SCOPE_AGENT); }
__device__ __forceinline__ unsigned xb_xcc_id() { return (unsigned)__builtin_amdgcn_s_getreg((3 << 11) | 20) & 0xFu; }
#define XB_SPIN(cond, bar) do { unsigned _sp = 0; while (cond) { __builtin_amdgcn_s_sleep(1); \
    if ((++_sp & 255u) == 0u) { if (xb_ld(&(bar)[XB_TMO])) break; if (_sp > XB_SPIN_CAP) { atomicAdd(&(bar)[XB_TMO], 1u); break; } } } } while (0)

struct XcdBarrier {
    unsigned* bar; unsigned x;
    volatile LAS unsigned* st;
};

__device__ __forceinline__ XcdBarrier xcd_barrier_post(unsigned* bar, volatile LAS unsigned* st) {
    XcdBarrier b; b.bar = bar; b.x = xb_xcc_id(); b.st = st;
    if (threadIdx.x == 0) (void)xb_add(&bar[XB_XCNT(b.x)], 1u);
    return b;
}
__device__ __forceinline__ void xcd_barrier_complete(unsigned* bar, unsigned x, unsigned& nloc, unsigned& nx) {
    const unsigned G = gridDim.x * gridDim.y * gridDim.z;
    unsigned sum, cnt, mine, sp = 0u;
    for (;;) {
        sum = 0u; cnt = 0u; mine = 0u;
#pragma unroll
        for (unsigned j = 0; j < 16; ++j) { const unsigned c = xb_ld(&bar[XB_XCNT(j)]); sum += c; cnt += (c > 0u) ? 1u : 0u; mine = (j == x) ? c : mine; }
        if (sum == G) break;
        __builtin_amdgcn_s_sleep(1);
        if ((++sp & 255u) == 0u) { if (xb_ld(&bar[XB_TMO])) break; if (sp > XB_SPIN_CAP) { atomicAdd(&bar[XB_TMO], 1u); break; } }
    }
    nloc = mine > 0u ? mine : 1u; nx = cnt > 0u ? cnt : 1u;
}

__device__ __forceinline__ void xcd_barrier(const XcdBarrier& b) {
    asm volatile("s_waitcnt vmcnt(0)" ::: "memory");
    __syncthreads();
    if (threadIdx.x == 0) {
        unsigned* bar = b.bar;
        __builtin_amdgcn_s_waitcnt(0);
        unsigned nloc = b.st[0], nx = b.st[1];
        if (nloc == 0u) { xcd_barrier_complete(bar, b.x, nloc, nx); b.st[0] = nloc; b.st[1] = nx; }
        const unsigned old = xb_add(&bar[XB_XSUB(b.x)], 1u);
        const unsigned gen = old / nloc;
        if (old + 1u == (gen + 1u) * nloc) {
            __builtin_amdgcn_fence(__ATOMIC_RELEASE, "agent");
            asm volatile("s_waitcnt vmcnt(0)" ::: "memory");
            const unsigned og = xb_add(&bar[XB_TOP], 1u);
            const unsigned tg = og / nx;
            if (og + 1u == (tg + 1u) * nx) xb_add(&bar[XB_TOPGEN], 1u);
            else XB_SPIN(xb_ld(&bar[XB_TOPGEN]) == tg, bar);
            __builtin_amdgcn_fence(__ATOMIC_ACQUIRE, "agent");
            xb_add(&bar[XB_XGEN(b.x)], 1u);
            asm volatile("s_waitcnt vmcnt(0)" ::: "memory");
        } else {
            XB_SPIN(xb_ld(&bar[XB_XGEN(b.x)]) == gen, bar);
            __builtin_amdgcn_fence(__ATOMIC_ACQUIRE, "agent");
            asm volatile("s_waitcnt vmcnt(0)" ::: "memory");
        }
    }
    __syncthreads();
}

struct Args { const float* in[29]; float* out; unsigned char* ws; };
enum { I_X = 0, I_META, I_N1G, I_WIN, I_MU, I_WUP, I_W0, I_AUP, I_A0, I_KK, I_KA, I_RK, I_LNG, I_LNB, I_FB, I_QG, I_KG, I_WPR, I_WPS, I_WPF, I_WOUT, I_N2G, I_MWG, I_MBG, I_MWE, I_MBE, I_MGATE, I_MUP, I_MDOWN };
struct ArgsL { volatile LAS unsigned* tab; float* out; unsigned char* ws;
    __device__ __forceinline__ const float* in(int i) const { const unsigned lo = tab[2 * i], hi = tab[2 * i + 1];
        return (const float*)(((unsigned long long)(unsigned)__builtin_amdgcn_readfirstlane((int)hi) << 32) | (unsigned long long)(unsigned)__builtin_amdgcn_readfirstlane((int)lo)); }
};
struct Frame { LAS unsigned char* lds; volatile LAS unsigned* MISC; int tid, lane, wave, bx; };

__device__ __forceinline__ float* hrow(const ArgsL& a, int b, int l) {
    return l < NMETA ? (float*)(a.ws + WS_HM) + (size_t)(b * NMETA + l) * D : a.out + ((size_t)b * SEQ + (l - NMETA)) * D;
}
#define LDS_WAIT() asm volatile("s_waitcnt lgkmcnt(0)" ::: "memory")
#define HB_PTR(a) ((bf16_t*)((a).ws + WS_HB))
#define A_PTR(a) ((bf16_t*)((a).out))

__device__ __forceinline__ void tr_item(const float* W, int ldw, int sc0, int nvalid, int k0, int kvalid, bf16_t* WT, int Kd, int r0, LAS float* scr, int lane) {
    float tv[32];
#pragma unroll
    for (int i = 0; i < 32; ++i) { const int kk = 2 * i + (lane >> 5), n = lane & 31; tv[i] = 0.f;
        if (n < nvalid && k0 + kk < kvalid) tv[i] = W[(size_t)(k0 + kk) * ldw + sc0 + n]; }
#pragma unroll
    for (int i = 0; i < 32; ++i) { const int kk = 2 * i + (lane >> 5), n = lane & 31; scr[kk * 33 + n] = tv[i]; }
    LDS_WAIT();
    const int c = lane & 7;
#pragma unroll
    for (int j = 0; j < 4; ++j) { const int n = (lane >> 3) + 8 * j; const LAS float* s = scr + (8 * c) * 33 + n;
        u32x4 o; o.x = pk2(s[0 * 33], s[1 * 33]); o.y = pk2(s[2 * 33], s[3 * 33]); o.z = pk2(s[4 * 33], s[5 * 33]); o.w = pk2(s[6 * 33], s[7 * 33]);
        *(u32x4*)(WT + (size_t)(r0 + n) * Kd + k0 + 8 * c) = o; }
    LDS_WAIT();
}
__device__ __forceinline__ void tr_item2(const float* W, int ldw, int sc0, int nvalid, int k0, int kvalid, bf16_t* WT, int Kd, int r0, int kd0, LAS float* scr, int lane) {
    float tv[32];
#pragma unroll
    for (int i = 0; i < 32; ++i) { const int kk = 2 * i + (lane >> 5), n = lane & 31; tv[i] = 0.f;
        if (n < nvalid && k0 + kk < kvalid) tv[i] = W[(size_t)(k0 + kk) * ldw + sc0 + n]; }
#pragma unroll
    for (int i = 0; i < 32; ++i) { const int kk = 2 * i + (lane >> 5), n = lane & 31; scr[kk * 33 + n] = tv[i]; }
    LDS_WAIT();
    const int c = lane & 7;
#pragma unroll
    for (int j = 0; j < 4; ++j) { const int n = (lane >> 3) + 8 * j; const LAS float* s = scr + (8 * c) * 33 + n;
        u32x4 o; o.x = pk2(s[0 * 33], s[1 * 33]); o.y = pk2(s[2 * 33], s[3 * 33]); o.z = pk2(s[4 * 33], s[5 * 33]); o.w = pk2(s[6 * 33], s[7 * 33]);
        *(u32x4*)(WT + (size_t)(r0 + n) * Kd + kd0 + 8 * c) = o; }
    LDS_WAIT();
}
__device__ __forceinline__ void phase_wconv(const ArgsL& a, Frame& F, int layer) {
    LAS float* scr = (LAS float*)(F.lds + F.wave * 8448);
    const int gw = F.bx * NWAVES + F.wave, NGW = gridDim.x * NWAVES;
    constexpr int C1 = 16 * 104, C2_ = C1 + 16 * 96, C3 = C2_ + 6 * 96, C4 = C3 + 16 * 32, C5 = C4 + 16 * 256, C6 = C5 + 4 * 512;
    unsigned char* ws = a.ws;
    for (int it = gw; it < C6; it += NGW) {
        if (it < C1) { const int kb = it / 104, nb = it % 104, r0 = nb * 32;
            tr_item(a.in(I_WIN) + (size_t)layer * D * D_IN, D_IN, r0, r0 < FCOL ? 32 : 0, kb * 64, 1024, (bf16_t*)(ws + WS_WIN), 1024, r0, scr, F.lane); }
        else if (it < C2_) { const int r = it - C1, kb = r / 96, nb = r % 96, r0 = nb * 32;
            tr_item(a.in(I_WIN) + (size_t)layer * D * D_IN, D_IN, GCOL + r0, 32, kb * 64, 1024, (bf16_t*)(ws + WS_WG), 1024, r0, scr, F.lane); }
        else if (it < C3) { const int r = it - C2_, kb = r / 32, nb = r % 32, r0 = nb * 32, br = kb / 6, k0 = (kb % 6) * 64;
            const float* W = (br == 0 ? a.in(I_WPR) + (size_t)layer * 384 * D : br == 1 ? a.in(I_WPS) + (size_t)layer * 320 * D : a.in(I_WPF) + (size_t)layer * 320 * D);
            tr_item2(W, D, r0, 32, k0, br == 0 ? 384 : 320, (bf16_t*)(ws + WS_WP), YC_W, r0, br * 384 + k0, scr, F.lane); }
        else if (it < C4) { const int r = it - C3, kb = r / 32, nb = r % 32, r0 = nb * 32;
            tr_item(a.in(I_WOUT) + (size_t)layer * D * D, D, r0, 32, kb * 64, 1024, (bf16_t*)(ws + WS_WO), 1024, r0, scr, F.lane); }
        else if (it < C5) { const int r = it - C4, kb = r / 256, nb = r % 256, r0 = nb * 32, e = r0 >> 9, rr = r0 & 511, j = rr >> 8, q = rr & 255;
            const float* W = (q >= 128 ? a.in(I_MUP) : a.in(I_MGATE)) + ((size_t)layer * NEXP + e) * D * DEXP;
            tr_item(W, DEXP, j * 128 + (q & 127), 32, kb * 64, 1024, (bf16_t*)(ws + WS_WGU), 1024, r0, scr, F.lane); }
        else { const int r = it - C5, kb = r / 512, nb = r % 512, r0 = nb * 32, e = r0 >> 10;
            tr_item(a.in(I_MDOWN) + ((size_t)layer * NEXP + e) * DEXP * D, D, r0 & 1023, 32, kb * 64, 256, (bf16_t*)(ws + WS_WD), 256, r0, scr, F.lane); }
    }
}

__device__ __forceinline__ void add_y_row(f32x4 (&v)[4], const bf16_t* Y, int slot, int lane) {
    const u32x2* y = (const u32x2*)(Y + (size_t)slot * D) + lane;
#pragma unroll
    for (int j = 0; j < 4; ++j) { const u32x2 t = y[64 * j]; v[j].x += bf_lo(t.x); v[j].y += bf_hi(t.x); v[j].z += bf_lo(t.y); v[j].w += bf_hi(t.y); }
}
template <int MODE>
__device__ __forceinline__ void phase_norm(const ArgsL& a, Frame& F, int layer, const bool dry = false) {
    const int lane = F.lane;
    LAS float* wl = (LAS float*)F.lds;
    LAS int* lcnt = (LAS int*)(F.lds + 20 * 4096);
    unsigned char* ws = a.ws;
    if (MODE == 1) {
        const float* win = a.in(I_WIN) + (size_t)layer * D * D_IN;
        for (int idx = F.tid; idx < 5 * 1024; idx += NTHR) { const int j = idx >> 10, k = idx & 1023; wl[j * 1024 + k] = win[(size_t)k * D_IN + FCOL + j]; }
    }
    if (MODE == 2) {
        const float* wg = a.in(I_MWG) + (size_t)layer * D * 4; const float* we = a.in(I_MWE) + (size_t)layer * D * 16;
        for (int i4 = F.tid; i4 < 1024; i4 += NTHR) { const f32x4 f = *(const f32x4*)(wg + 4 * i4); wl[i4] = f.x; wl[1024 + i4] = f.y; wl[2048 + i4] = f.z; wl[3072 + i4] = f.w; }
        for (int i4 = F.tid; i4 < 4096; i4 += NTHR) { const int k = i4 >> 2, c = i4 & 3; const f32x4 f = *(const f32x4*)(we + 4 * i4); LAS float* d = wl + (4 + 4 * c) * 1024 + k;
            d[0] = f.x; d[1024] = f.y; d[2048] = f.z; d[3072] = f.w; }
        if (F.tid < 16) lcnt[F.tid] = 0;
    }
    __syncthreads();
    const int gw = F.bx * NWAVES + F.wave, NGW = gridDim.x * NWAVES;
    const float* gsrc = (MODE == 2 ? a.in(I_N2G) : a.in(I_N1G)) + layer * D;
    f32x4 gv[4];
#pragma unroll
    for (int j = 0; j < 4; ++j) gv[j] = (MODE == 0) ? (f32x4){0.f, 0.f, 0.f, 0.f} : *(const f32x4*)(gsrc + 4 * lane + 256 * j);
    bf16_t* A = A_PTR(a); bf16_t* HB = HB_PTR(a);
    const bf16_t* Y = (const bf16_t*)(ws + WS_Y);
    const int* SLOT = (const int*)(ws + WS_SLOT);
    constexpr bool COMB0 = (MODE == 0);
    const bool comb = COMB0 || (MODE == 1 && layer > 0);
    f32x4 vn[4]; u32x2 yan[4], ybn[4];
#pragma unroll
    for (int j = 0; j < 4; ++j) { vn[j] = (f32x4){0.f, 0.f, 0.f, 0.f}; yan[j] = (u32x2){0u, 0u}; ybn[j] = (u32x2){0u, 0u}; }
#define NRM_VALID(mm) ((mm) < M && ((mm) % T) - PADR >= (MODE == 0 ? NMETA : 0))
#define NRM_LOAD(mm, s0_, s1_) do { if (NRM_VALID(mm)) { const int bb_ = (mm) / T, ll_ = (mm) - bb_ * T - PADR; \
        if (MODE == 1 && layer == 0) { const float* src_ = (ll_ < NMETA) ? a.in(I_META) + (size_t)ll_ * D : a.in(I_X) + ((size_t)bb_ * SEQ + (ll_ - NMETA)) * D; \
            _Pragma("unroll") for (int j = 0; j < 4; ++j) vn[j] = *(const f32x4*)(src_ + 4 * lane + 256 * j); } \
        else { const u32x2* hs_ = (const u32x2*)(HB + (size_t)(mm) * D) + lane; \
            _Pragma("unroll") for (int j = 0; j < 4; ++j) { const u32x2 t_ = hs_[64 * j]; vn[j] = (f32x4){bf_lo(t_.x), bf_hi(t_.x), bf_lo(t_.y), bf_hi(t_.y)}; } } \
        if (comb) { const u32x2* y0_ = (const u32x2*)(Y + (size_t)(s0_) * D) + lane; const u32x2* y1_ = (const u32x2*)(Y + (size_t)(s1_) * D) + lane; \
            _Pragma("unroll") for (int j = 0; j < 4; ++j) { yan[j] = y0_[64 * j]; ybn[j] = y1_[64 * j]; } } } } while (0)
    int sa1 = 0, sb1 = 0, sa2 = 0, sb2 = 0;
    if (comb) { if (NRM_VALID(gw)) { sa1 = SLOT[2 * gw]; sb1 = SLOT[2 * gw + 1]; } if (NRM_VALID(gw + NGW)) { sa2 = SLOT[2 * (gw + NGW)]; sb2 = SLOT[2 * (gw + NGW) + 1]; } }
    NRM_LOAD(gw, sa1, sb1);
    for (int m = gw; m < M; m += NGW) {
        f32x4 v[4]; u32x2 ya[4], yb[4];
#pragma unroll
        for (int j = 0; j < 4; ++j) { v[j] = vn[j]; ya[j] = yan[j]; yb[j] = ybn[j]; }
        int sa3 = 0, sb3 = 0;
        if (comb && NRM_VALID(m + 2 * NGW)) { sa3 = SLOT[2 * (m + 2 * NGW)]; sb3 = SLOT[2 * (m + 2 * NGW) + 1]; }
        NRM_LOAD(m + NGW, sa2, sb2);
        sa2 = sa3; sb2 = sb3;
        const int b = m / T, p = m - b * T, l = p - PADR;
        if (l < 0) {
            if (MODE == 1 && !dry) {
                u32x2* o = (u32x2*)(A + (size_t)m * D) + lane;
#pragma unroll
                for (int j = 0; j < 4; ++j) o[64 * j] = (u32x2){0u, 0u};
                if (lane < 8) ((float*)(ws + WS_LOGF))[(size_t)m * 8 + lane] = 0.f;
            }
            continue;
        }
        if (MODE == 0 && l < NMETA) continue;
        if (comb) {
#pragma unroll
            for (int j = 0; j < 4; ++j) { v[j].x += bf_lo(ya[j].x) + bf_lo(yb[j].x); v[j].y += bf_hi(ya[j].x) + bf_hi(yb[j].x); v[j].z += bf_lo(ya[j].y) + bf_lo(yb[j].y); v[j].w += bf_hi(ya[j].y) + bf_hi(yb[j].y); }
        }
        if (MODE == 0 && !dry) { float* op = a.out + ((size_t)b * SEQ + (l - NMETA)) * D;
#pragma unroll
            for (int j = 0; j < 4; ++j) *(f32x4*)(op + 4 * lane + 256 * j) = v[j]; }
        if (MODE == 1 && !dry) { u32x2* hd = (u32x2*)(HB + (size_t)m * D) + lane;
#pragma unroll
            for (int j = 0; j < 4; ++j) hd[64 * j] = (u32x2){pk2(v[j].x, v[j].y), pk2(v[j].z, v[j].w)};
        }
        if (MODE == 0) continue;
        float ss = 0.f;
#pragma unroll
        for (int j = 0; j < 4; ++j) ss += (v[j].x * v[j].x + v[j].y * v[j].y) + (v[j].z * v[j].z + v[j].w * v[j].w);
        const float r = 1.0f / sqrtf(wave_sum(ss) * (1.0f / D) + 1e-6f);
#pragma unroll
        for (int j = 0; j < 4; ++j) v[j] = v[j] * r * gv[j];
        u32x2* o = (u32x2*)(A + (size_t)m * D) + lane;
        if (!dry) {
#pragma unroll
        for (int j = 0; j < 4; ++j) o[64 * j] = (u32x2){pk2(v[j].x, v[j].y), pk2(v[j].z, v[j].w)}; }
        else { float sink = v[0].x + v[1].y + v[2].z + v[3].w; asm volatile("" :: "v"(sink)); }
        if (MODE == 1) {
            float dsum[5];
#pragma unroll
            for (int q = 0; q < 5; ++q) { float d = 0.f;
#pragma unroll
                for (int j = 0; j < 4; ++j) { const f32x4 w = *(const LAS f32x4*)(wl + q * 1024 + 4 * lane + 256 * j); d += (v[j].x * w.x + v[j].y * w.y) + (v[j].z * w.z + v[j].w * w.w); }
                dsum[q] = wave_sum(d); }
            float mine = dsum[0];
            mine = lane == 1 ? dsum[1] : mine; mine = lane == 2 ? dsum[2] : mine; mine = lane == 3 ? dsum[3] : mine; mine = lane == 4 ? dsum[4] : mine;
            if (lane < 8 && !dry) { float lf = 0.f;
                if (lane < 5) { const float xx = mine + a.in(I_FB)[layer * 5 + lane]; lf = fminf(xx, 0.f) - fast_log(1.f + fast_exp(-fabsf(xx))); }
                ((float*)(ws + WS_LOGF))[(size_t)m * 8 + lane] = lf; }
        }
        if (MODE == 2) {
            float dp[20];
#pragma unroll
            for (int q = 0; q < 20; ++q) { float d = 0.f;
#pragma unroll
                for (int j = 0; j < 4; ++j) { const f32x4 w = *(const LAS f32x4*)(wl + q * 1024 + 4 * lane + 256 * j); d += (v[j].x * w.x + v[j].y * w.y) + (v[j].z * w.z + v[j].w * w.w); }
                dp[q] = d; }
            float sA[10], sB[5];
#pragma unroll
            for (int i = 0; i < 10; ++i) { auto sw = __builtin_amdgcn_permlane32_swap(__float_as_uint(dp[2 * i]), __float_as_uint(dp[2 * i + 1]), false, false); sA[i] = __uint_as_float(sw[0]) + __uint_as_float(sw[1]); }
#pragma unroll
            for (int i = 0; i < 5; ++i) { auto sw = __builtin_amdgcn_permlane16_swap(__float_as_uint(sA[2 * i]), __float_as_uint(sA[2 * i + 1]), false, false); sB[i] = allred16(__uint_as_float(sw[0]) + __uint_as_float(sw[1])); }
            LAS float* red = (LAS float*)(F.lds + 81920 + 256) + F.wave * 32;
            { const int rho = lane >> 4, vsel = ((rho & 1) << 1) | (rho >> 1);
              if ((lane & 15) == 0) {
#pragma unroll
                  for (int i = 0; i < 5; ++i) red[4 * i + vsel] = sB[i]; } }
            LDS_WAIT();
            float ds[20];
#pragma unroll
            for (int i = 0; i < 5; ++i) { const f32x4 t4 = *(const LAS f32x4*)(red + 4 * i); ds[4 * i] = t4.x; ds[4 * i + 1] = t4.y; ds[4 * i + 2] = t4.z; ds[4 * i + 3] = t4.w; }
            LDS_WAIT();
            const float* bg = a.in(I_MBG) + layer * 4; const float* be = a.in(I_MBE) + layer * 16;
            float lg0 = ds[0] + bg[0], lg1 = ds[1] + bg[1], lg2 = ds[2] + bg[2], lg3 = ds[3] + bg[3];
            int g = 0; float mx = lg0;
            if (lg1 > mx) { mx = lg1; g = 1; } if (lg2 > mx) { mx = lg2; g = 2; } if (lg3 > mx) { mx = lg3; g = 3; }
            const float den = fast_exp(lg0 - mx) + fast_exp(lg1 - mx) + fast_exp(lg2 - mx) + fast_exp(lg3 - mx);
            const float pgrp = 1.0f / den;
            float s0 = g == 0 ? ds[4] : g == 1 ? ds[8] : g == 2 ? ds[12] : ds[16];
            float s1 = g == 0 ? ds[5] : g == 1 ? ds[9] : g == 2 ? ds[13] : ds[17];
            float s2 = g == 0 ? ds[6] : g == 1 ? ds[10] : g == 2 ? ds[14] : ds[18];
            float s3 = g == 0 ? ds[7] : g == 1 ? ds[11] : g == 2 ? ds[15] : ds[19];
            s0 += be[g * 4 + 0]; s1 += be[g * 4 + 1]; s2 += be[g * 4 + 2]; s3 += be[g * 4 + 3];
            int i0 = 0; float v0 = s0;
            if (s1 > v0) { v0 = s1; i0 = 1; } if (s2 > v0) { v0 = s2; i0 = 2; } if (s3 > v0) { v0 = s3; i0 = 3; }
            int i1 = -1; float v1 = -3.0e38f;
            if (i0 != 0 && s0 > v1) { v1 = s0; i1 = 0; } if (i0 != 1 && s1 > v1) { v1 = s1; i1 = 1; } if (i0 != 2 && s2 > v1) { v1 = s2; i1 = 2; } if (i0 != 3 && s3 > v1) { v1 = s3; i1 = 3; }
            const float e1 = fast_exp(v1 - v0), pt0 = 1.0f / (1.0f + e1), pt1 = e1 * pt0;
            if (dry) { float sink = pgrp * pt0 + pt1; asm volatile("" :: "v"(sink)); }
            if (lane == 0 && !dry) {
                const int ea = g * 4 + i0, eb = g * 4 + i1;
                const int la = atomicAdd((int*)&lcnt[ea], 1), lb = atomicAdd((int*)&lcnt[eb], 1);
                int* tk = (int*)(ws + WS_TOK) + (size_t)m * 8;
                tk[0] = ea; tk[1] = eb; tk[2] = __float_as_int(pgrp * pt0); tk[3] = __float_as_int(pgrp * pt1); tk[4] = la; tk[5] = lb;
            }
        }
    }
    __syncthreads();
#undef NRM_LOAD
#undef NRM_VALID
    if (MODE == 2 && F.tid < 16 && !dry) {
        const int c = lcnt[F.tid];
        ((int*)(ws + WS_WGCNT))[F.bx * 16 + F.tid] = c;
        atomicAdd((int*)(ws + WS_CTL) + CW_ECNT + 64 * layer + F.tid, c);
    }
    __syncthreads();
}

__device__ __forceinline__ void phase_norm2(const ArgsL& a, Frame& F, int layer, const bool dry = false) {
    const int lane = F.lane;
    LAS float* wl = (LAS float*)F.lds;
    LAS int* lcnt = (LAS int*)(F.lds + 20 * 4096);
    unsigned char* ws = a.ws;
    {
        const float* wg = a.in(I_MWG) + (size_t)layer * D * 4; const float* we = a.in(I_MWE) + (size_t)layer * D * 16;
        for (int i4 = F.tid; i4 < 1024; i4 += NTHR) { const f32x4 f = *(const f32x4*)(wg + 4 * i4); wl[i4] = f.x; wl[1024 + i4] = f.y; wl[2048 + i4] = f.z; wl[3072 + i4] = f.w; }
        for (int i4 = F.tid; i4 < 4096; i4 += NTHR) { const int k = i4 >> 2, c = i4 & 3; const f32x4 f = *(const f32x4*)(we + 4 * i4); LAS float* d = wl + (4 + 4 * c) * 1024 + k;
            d[0] = f.x; d[1024] = f.y; d[2048] = f.z; d[3072] = f.w; }
        if (F.tid < 16) lcnt[F.tid] = 0;
    }
    __syncthreads();
    const int gw = F.bx * NWAVES + F.wave, NGW = gridDim.x * NWAVES;
    LAS float* gl = (LAS float*)(F.lds + 86016);
    LAS float* bl = (LAS float*)(F.lds + 90112);
    for (int i = F.tid; i < 1024; i += NTHR) gl[i] = a.in(I_N2G)[layer * D + i];
    if (F.tid < 4) bl[F.tid] = a.in(I_MBG)[layer * 4 + F.tid];
    if (F.tid >= 64 && F.tid < 80) bl[4 + F.tid - 64] = a.in(I_MBE)[layer * 16 + F.tid - 64];
    __syncthreads();
    bf16_t* A = A_PTR(a); const bf16_t* HB = HB_PTR(a);
    LAS float* red = (LAS float*)(F.lds + 81920 + 256) + F.wave * 96;
#define N2_VALID(mm) ((mm) < M && ((mm) % T) >= PADR)
    constexpr int NR = 2;
    for (int m0 = gw; m0 < M; m0 += NR * NGW) {
        f32x4 v[NR][4];
#pragma unroll
        for (int rr = 0; rr < NR; ++rr) { const int mm_ = m0 + rr * NGW;
            if (N2_VALID(mm_)) { const u32x2* hs_ = (const u32x2*)(HB + (size_t)mm_ * D) + lane;
#pragma unroll
                for (int j = 0; j < 4; ++j) { const u32x2 t = hs_[64 * j]; v[rr][j] = (f32x4){bf_lo(t.x), bf_hi(t.x), bf_lo(t.y), bf_hi(t.y)}; } }
            else {
#pragma unroll
                for (int j = 0; j < 4; ++j) v[rr][j] = (f32x4){0.f, 0.f, 0.f, 0.f}; } }
        float ss[NR];
#pragma unroll
        for (int rr = 0; rr < NR; ++rr) { float s_ = 0.f;
#pragma unroll
            for (int j = 0; j < 4; ++j) s_ += (v[rr][j].x * v[rr][j].x + v[rr][j].y * v[rr][j].y) + (v[rr][j].z * v[rr][j].z + v[rr][j].w * v[rr][j].w);
            ss[rr] = s_; }
#pragma unroll
        for (int rr = 0; rr < NR; ++rr) ss[rr] = wave_sum(ss[rr]);
#pragma unroll
        for (int rr = 0; rr < NR; ++rr) { const int mm = m0 + rr * NGW; const float r = 1.0f / sqrtf(ss[rr] * (1.0f / D) + 1e-6f);
#pragma unroll
            for (int j = 0; j < 4; ++j) v[rr][j] = v[rr][j] * r * *(const LAS f32x4*)(gl + 4 * lane + 256 * j);
            if (N2_VALID(mm) && !dry) { u32x2* o = (u32x2*)(A + (size_t)mm * D) + lane;
#pragma unroll
                for (int j = 0; j < 4; ++j) o[64 * j] = (u32x2){pk2(v[rr][j].x, v[rr][j].y), pk2(v[rr][j].z, v[rr][j].w)}; } }
        { const int rho = lane >> 4, vsel = ((rho & 1) << 1) | (rho >> 1);
#pragma unroll
          for (int qh = 0; qh < 2; ++qh) {
            float dp[NR][10];
#pragma unroll
            for (int q = 0; q < 10; ++q) { f32x4 w[4];
#pragma unroll
                for (int j = 0; j < 4; ++j) w[j] = *(const LAS f32x4*)(wl + (qh * 10 + q) * 1024 + 4 * lane + 256 * j);
#pragma unroll
                for (int rr = 0; rr < NR; ++rr) { float d = 0.f;
#pragma unroll
                    for (int j = 0; j < 4; ++j) d += (v[rr][j].x * w[j].x + v[rr][j].y * w[j].y) + (v[rr][j].z * w[j].z + v[rr][j].w * w[j].w);
                    dp[rr][q] = d; }
                if (q & 1) __builtin_amdgcn_sched_barrier(0); }
#pragma unroll
            for (int rr = 0; rr < NR; ++rr) { float sA[6], sB[3]; sA[5] = 0.f;
#pragma unroll
                for (int i = 0; i < 5; ++i) { auto sw = __builtin_amdgcn_permlane32_swap(__float_as_uint(dp[rr][2 * i]), __float_as_uint(dp[rr][2 * i + 1]), false, false); sA[i] = __uint_as_float(sw[0]) + __uint_as_float(sw[1]); }
#pragma unroll
                for (int k = 0; k < 3; ++k) { auto sw = __builtin_amdgcn_permlane16_swap(__float_as_uint(sA[2 * k]), __float_as_uint(sA[2 * k + 1]), false, false); sB[k] = allred16(__uint_as_float(sw[0]) + __uint_as_float(sw[1])); }
                if ((lane & 15) == 0) {
#pragma unroll
                    for (int k = 0; k < 3; ++k) red[rr * 24 + qh * 10 + 4 * k + vsel] = sB[k]; } }
            __builtin_amdgcn_sched_barrier(0);
          } }
        LDS_WAIT();
        if (lane < NR) {
            const int mm = m0 + lane * NGW;
            float ds[20];
#pragma unroll
            for (int i = 0; i < 5; ++i) { const f32x4 t4 = *(const LAS f32x4*)(red + lane * 24 + 4 * i); ds[4 * i] = t4.x; ds[4 * i + 1] = t4.y; ds[4 * i + 2] = t4.z; ds[4 * i + 3] = t4.w; }
            const float lg0 = ds[0] + bl[0], lg1 = ds[1] + bl[1], lg2 = ds[2] + bl[2], lg3 = ds[3] + bl[3];
            int g = 0; float mx = lg0;
            if (lg1 > mx) { mx = lg1; g = 1; } if (lg2 > mx) { mx = lg2; g = 2; } if (lg3 > mx) { mx = lg3; g = 3; }
            const float den = fast_exp(lg0 - mx) + fast_exp(lg1 - mx) + fast_exp(lg2 - mx) + fast_exp(lg3 - mx);
            const float pgrp = 1.0f / den;
            const f32x4 be4 = *(const LAS f32x4*)(bl + 4 + 4 * g);
            float s0 = (g == 0 ? ds[4] : g == 1 ? ds[8] : g == 2 ? ds[12] : ds[16]) + be4.x;
            float s1 = (g == 0 ? ds[5] : g == 1 ? ds[9] : g == 2 ? ds[13] : ds[17]) + be4.y;
            float s2 = (g == 0 ? ds[6] : g == 1 ? ds[10] : g == 2 ? ds[14] : ds[18]) + be4.z;
            float s3 = (g == 0 ? ds[7] : g == 1 ? ds[11] : g == 2 ? ds[15] : ds[19]) + be4.w;
            int i0 = 0; float v0 = s0;
            if (s1 > v0) { v0 = s1; i0 = 1; } if (s2 > v0) { v0 = s2; i0 = 2; } if (s3 > v0) { v0 = s3; i0 = 3; }
            int i1 = -1; float v1 = -3.0e38f;
            if (i0 != 0 && s0 > v1) { v1 = s0; i1 = 0; } if (i0 != 1 && s1 > v1) { v1 = s1; i1 = 1; } if (i0 != 2 && s2 > v1) { v1 = s2; i1 = 2; } if (i0 != 3 && s3 > v1) { v1 = s3; i1 = 3; }
            const float e1 = fast_exp(v1 - v0), pt0 = 1.0f / (1.0f + e1), pt1 = e1 * pt0;
            if (N2_VALID(mm) && !dry) {
                const int ea = g * 4 + i0, eb = g * 4 + i1;
                const int la = atomicAdd((int*)&lcnt[ea], 1), lb = atomicAdd((int*)&lcnt[eb], 1);
                int* tk = (int*)(ws + WS_TOK) + (size_t)mm * 8;
                tk[0] = ea; tk[1] = eb; tk[2] = __float_as_int(pgrp * pt0); tk[3] = __float_as_int(pgrp * pt1); tk[4] = la; tk[5] = lb;
            } else { float sink = pgrp * pt0 + pt1; asm volatile("" :: "v"(sink)); }
        }
        LDS_WAIT();
    }
#undef N2_VALID
    __syncthreads();
    if (F.tid < 16 && !dry) {
        const int c = lcnt[F.tid];
        ((int*)(ws + WS_WGCNT))[F.bx * 16 + F.tid] = c;
        atomicAdd((int*)(ws + WS_CTL) + CW_ECNT + 64 * layer + F.tid, c);
    }
    __syncthreads();
}

__device__ __forceinline__ void phase_route(const ArgsL& a, Frame& F, int layer) {
    unsigned char* ws = a.ws;
    LAS int* tbl = (LAS int*)F.lds;
    LAS int* part = tbl + 16;
    {
        const int e = F.tid & 15, q = F.tid >> 4; const int* wc = (const int*)(ws + WS_WGCNT); int acc = 0;
#pragma unroll
        for (int i = 0; i < 8; ++i) { const int w = q + 32 * i; if (w < (int)F.bx) acc += wc[w * 16 + e]; }
        part[q * 16 + e] = acc;
    }
    __syncthreads();
    if (F.tid < 16) {
        const int* cnt = (const int*)(ws + WS_CTL) + CW_ECNT + 64 * layer;
        int cv[16];
#pragma unroll
        for (int e = 0; e < 16; ++e) cv[e] = __hip_atomic_load(cnt + e, __ATOMIC_RELAXED, __HIP_MEMORY_SCOPE_AGENT);
        int base = 0;
#pragma unroll
        for (int e = 0; e < 16; ++e) if (e < F.tid) base += ((cv[e] + 255) >> 8) << 8;
#pragma unroll
        for (int q = 0; q < 32; ++q) base += part[q * 16 + F.tid];
        tbl[F.tid] = base; tbl[16 + 512 + F.tid] = __hip_atomic_load(cnt + F.tid, __ATOMIC_RELAXED, __HIP_MEMORY_SCOPE_AGENT);
    }
    __syncthreads();
    if (F.bx == 0) {
        int* s2t = (int*)(ws + WS_S2T);
        for (int e = 0; e < 16; ++e) { const int n = tbl[16 + 512 + e], b0 = tbl[e] + n, pad = (((n + 255) >> 8) << 8) - n;
            for (int i = F.tid; i < pad; i += NTHR) s2t[b0 + i] = 0; }
    }
    int* s2t = (int*)(ws + WS_S2T);
    for (int j = F.tid; j < 8 * ((M + 2047) / 2048); j += NTHR) {
        const int m = (j >> 3) * 2048 + (int)F.bx * 8 + (j & 7);
        if (m >= M) continue;
        const int b = m / T, p = m - b * T;
        if (p < PADR) continue;
        const int* tk_ = (const int*)(ws + WS_TOK) + (size_t)m * 8;
        const u32x4 t4 = *(const u32x4*)tk_; const u32x2 t2 = *(const u32x2*)(tk_ + 4);
        const int ea = (int)t4.x, eb = (int)t4.y, sa = tbl[ea] + (int)t2.x, sb = tbl[eb] + (int)t2.y;
        s2t[sa] = m; s2t[sb] = m;
        int* sl = (int*)(ws + WS_SLOT) + 2 * m; sl[0] = sa; sl[1] = sb;
        float* cw = (float*)(ws + WS_CWS); cw[sa] = __uint_as_float(t4.z); cw[sb] = __uint_as_float(t4.w);
    }
    __syncthreads();
}

#ifndef PR_STAGES
#define PR_STAGES 15
#endif
__device__ __forceinline__ void phase_prep(const ArgsL& a, Frame& F, int layer, const unsigned* g1cnt, unsigned* qhead, const bool dry = false) {
    unsigned char* ws = a.ws;
    LAS float* xs = (LAS float*)F.lds;
    const int wave = F.wave, lane = F.lane, tid = F.tid;
    const bf16_t* USH = (const bf16_t*)(ws + WS_USH);
    bf16_t* QKV = (bf16_t*)(ws + WS_QKV);
    if (F.bx < 10 && (!dry || (PR_STAGES & 8))) {
        const int bh = F.bx, b = bh / 5, h = bh % 5;
        const float* LOGF = (const float*)(ws + WS_LOGF) + (size_t)(b * T + PADR) * 8 + h;
        float* kb = (float*)(ws + WS_KB2) + (size_t)bh * KBP;
        LAS float* wtot = (LAS float*)F.lds;
        float v[33];
        const int l0 = tid * 33;
#pragma unroll
        for (int i = 0; i < 33; ++i) v[i] = (l0 + i < LTOK) ? LOGF[(size_t)(l0 + i) * 8] : 0.f;
#pragma unroll
        for (int i = 1; i < 33; ++i) v[i] += v[i - 1];
        float incl = v[32];
#pragma unroll
        for (int o = 1; o < 64; o <<= 1) { const float t = __shfl_up(incl, o); if (lane >= o) incl += t; }
        if (lane == 63) wtot[wave] = incl;
        __syncthreads();
        float off = incl - v[32];
        for (int w = 0; w < wave; ++w) off += wtot[w];
#pragma unroll
        for (int i = 0; i < 33; ++i) if (l0 + i < LTOK && !dry) kb[PADR + l0 + i] = -(off + v[i]) * LOG2E;
        for (int p = tid; p < PADR; p += NTHR) kb[p] = 0.f;
        for (int p = T + tid; p < KBP; p += NTHR) kb[p] = 0.f;
        __syncthreads();
    }
    if (F.bx >= 16 && F.bx < 28) {
        unsigned* z = (unsigned*)(ws + WS_RW + ((size_t)(F.bx - 16) * LPADDED + LTOK) * 768);
        for (int i = tid; i < (LPADDED - LTOK) * 192; i += NTHR) z[i] = 0u;
    }
    const int r16 = lane & 15, q4 = lane >> 4, hh = wave < 6 ? wave : 0;
    bf16x8 bw[2][4][2];
    float cw0[4], ca0[4], ckk[4], cka[4], crk[4];
    {
        const float* WUp = a.in(I_WUP) + (size_t)layer * 64 * RW_W + hh * 64 + r16; const float* AUp = a.in(I_AUP) + (size_t)layer * 64 * RW_W + hh * 64 + r16;
#pragma unroll
        for (int mtx = 0; mtx < 2; ++mtx)
#pragma unroll
            for (int blk = 0; blk < 4; ++blk)
#pragma unroll
                for (int ks = 0; ks < 2; ++ks) { const float* p_ = (mtx ? AUp : WUp) + (size_t)(32 * ks + 8 * q4) * RW_W + blk * 16;
                    const float f0 = p_[0], f1 = p_[RW_W], f2 = p_[2 * RW_W], f3 = p_[3 * RW_W], f4 = p_[4 * RW_W], f5 = p_[5 * RW_W], f6 = p_[6 * RW_W], f7 = p_[7 * RW_W];
                    bw[mtx][blk][ks] = __builtin_bit_cast(bf16x8, (u32x4){pk2(f0, f1), pk2(f2, f3), pk2(f4, f5), pk2(f6, f7)}); }
#pragma unroll
        for (int blk = 0; blk < 4; ++blk) { const int ch = layer * RW_W + hh * 64 + blk * 16 + r16;
            cw0[blk] = a.in(I_W0)[ch]; ca0[blk] = a.in(I_A0)[ch]; ckk[blk] = a.in(I_KK)[ch]; cka[blk] = a.in(I_KA)[ch]; crk[blk] = a.in(I_RK)[ch]; }
    }
    const float* mu = a.in(I_MU) + layer * SHIFT_W;
    f32x4 gq4 = *(const f32x4*)(a.in(I_QG) + layer * 64 + (lane & 15) * 4) * C2; const f32x4 gk4 = *(const f32x4*)(a.in(I_KG) + layer * 64 + (lane & 15) * 4);
    _Float16* RW = (_Float16*)(ws + WS_RW);
    bf16_t* BN = (bf16_t*)(ws + WS_BN);
    constexpr int nt = 16, t0 = 0;
    for (;;) {
        if (F.tid == 0) {
            const int j = (int)__hip_atomic_fetch_add(qhead, 1u, __ATOMIC_RELAXED, __HIP_MEMORY_SCOPE_AGENT);
            int bt = -1;
            if (j < 2064) { int p; if (j < 1024) { const int e = j >> 4; p = (e >> 3) * 16 + (e & 7); } else { const int l = (j - 1024) >> 4; p = l < 64 ? (l >> 3) * 16 + 8 + (l & 7) : 128; }
                bt = p * 16 + (j & 15);
                if (bt < 7 || (bt >= 1032 && bt < 1039)) bt = -2;
                else if (!dry) { unsigned polls = 0;
                    while (__hip_atomic_load(g1cnt + CH_STRIDE * p, __ATOMIC_RELAXED, __HIP_MEMORY_SCOPE_AGENT) < 104u) { if (++polls > (1u << 18)) break; __builtin_amdgcn_s_sleep(2); }
                    if ((bt & 15) == 0 && p > 0) { polls = 0;
                        while (__hip_atomic_load(g1cnt + CH_STRIDE * (p - 1), __ATOMIC_RELAXED, __HIP_MEMORY_SCOPE_AGENT) < 104u) { if (++polls > (1u << 18)) break; __builtin_amdgcn_s_sleep(2); } }
                    __builtin_amdgcn_fence(__ATOMIC_ACQUIRE, "agent"); asm volatile("s_waitcnt vmcnt(0)" ::: "memory"); } }
            F.MISC[18] = (unsigned)bt; }
        __syncthreads();
        const int bt_ = (int)F.MISC[18];
        __syncthreads();
        if (bt_ == -1) break;
        if (bt_ == -2) continue;
        const int m0 = bt_ * 16;
        if (!dry || (PR_STAGES & 1)) {
            int tid = F.tid; asm volatile("" : "+v"(tid));
            u32x4 uu4[5], pp4[5];
#pragma unroll
            for (int q5 = 0; q5 < 5; ++q5) { const int item = tid + q5 * NTHR; uu4[q5] = (u32x4){0u, 0u, 0u, 0u}; pp4[q5] = (u32x4){0u, 0u, 0u, 0u};
                if (item < nt * 160) { const int tok = item / 160, ch = item - tok * 160, m = m0 + t0 + tok;
                    uu4[q5] = *(const u32x4*)(USH + (size_t)m * SHIFT_W + ch * 8);
                    if (m > 0) pp4[q5] = *(const u32x4*)(USH + (size_t)(m - 1) * SHIFT_W + ch * 8); } }
#pragma unroll
            for (int q5 = 0; q5 < 5; ++q5) { const int item = tid + q5 * NTHR;
                if (item < nt * 160) { const int tok = item / 160, ch = item - tok * 160;
                    const u32x4 u = uu4[q5], pv = pp4[q5];
                    const f32x4 mu0 = *(const f32x4*)(mu + ch * 8), mu1 = *(const f32x4*)(mu + ch * 8 + 4);
                    float x[8];
                    { float uu, pp;
                      uu = bf_lo(u.x); pp = bf_lo(pv.x); x[0] = uu + (pp - uu) * mu0.x;  uu = bf_hi(u.x); pp = bf_hi(pv.x); x[1] = uu + (pp - uu) * mu0.y;
                      uu = bf_lo(u.y); pp = bf_lo(pv.y); x[2] = uu + (pp - uu) * mu0.z;  uu = bf_hi(u.y); pp = bf_hi(pv.y); x[3] = uu + (pp - uu) * mu0.w;
                      uu = bf_lo(u.z); pp = bf_lo(pv.z); x[4] = uu + (pp - uu) * mu1.x;  uu = bf_hi(u.z); pp = bf_hi(pv.z); x[5] = uu + (pp - uu) * mu1.y;
                      uu = bf_lo(u.w); pp = bf_lo(pv.w); x[6] = uu + (pp - uu) * mu1.z;  uu = bf_hi(u.w); pp = bf_hi(pv.w); x[7] = uu + (pp - uu) * mu1.w; }
                    if (ch >= 144 && ch < 152) {
#pragma unroll
                        for (int q = 0; q < 8; ++q) { const float e = fast_exp(-2.f * fabsf(x[q])); const float th = (1.f - e) / (1.f + e); x[q] = x[q] < 0.f ? -th : th; }
                    }
                    LAS f32x4* d = (LAS f32x4*)(xs + tok * SHIFT_W + ch * 8);
                    d[0] = (f32x4){x[0], x[1], x[2], x[3]}; d[1] = (f32x4){x[4], x[5], x[6], x[7]}; } }
        }
        __syncthreads();
        if (wave < 6) { if (!dry || (PR_STAGES & 2)) {
            f32x4 acc[2][4];
#pragma unroll
            for (int mtx = 0; mtx < 2; ++mtx) {
                bf16x8 af[2];
#pragma unroll
                for (int ks = 0; ks < 2; ++ks) { const LAS float* xp = xs + r16 * SHIFT_W + 1152 + 64 * mtx + 32 * ks + 8 * q4;
                    const f32x4 u0 = *(const LAS f32x4*)xp, u1 = *(const LAS f32x4*)(xp + 4);
                    af[ks] = __builtin_bit_cast(bf16x8, (u32x4){pk2(u0.x, u0.y), pk2(u0.z, u0.w), pk2(u1.x, u1.y), pk2(u1.z, u1.w)}); }
#pragma unroll
                for (int blk = 0; blk < 4; ++blk) { f32x4 c4 = {0.f, 0.f, 0.f, 0.f};
                    c4 = __builtin_amdgcn_mfma_f32_16x16x32_bf16(af[0], bw[mtx][blk][0], c4, 0, 0, 0);
                    c4 = __builtin_amdgcn_mfma_f32_16x16x32_bf16(af[1], bw[mtx][blk][1], c4, 0, 0, 0);
                    acc[mtx][blk] = c4; }
            }
#pragma unroll
            for (int i = 0; i < 4; ++i) {
                const int tok = 4 * q4 + i, m = m0 + t0 + tok, b = m / T, p = m - b * T, l = p - PADR;
                const bool ok = (tok < nt) && (l >= 0);
                const LAS float* xr = xs + (tok < 16 ? tok : 0) * SHIFT_W + hh * 64 + r16;
                float kkr[4], kpv[4], avv4[4], omv[4], rv4[4], vv4[4];
                float ssq = 0.f, cf = 0.f;
#pragma unroll
                for (int blk = 0; blk < 4; ++blk) {
                    const float wlv = cw0[blk] + acc[0][blk][i], alv = ca0[blk] + acc[1][blk][i];
                    const float r = xr[blk * 16], k = xr[384 + blk * 16], v = xr[768 + blk * 16];
                    const float logw = -softplus_f(-wlv) - 0.5f;
                    const float xw = fast_exp(logw);
                    omv[blk] = xw < 0.02f ? xw * (1.f - 0.5f * xw + xw * xw * (1.f / 6.f)) : 1.f - fast_exp(-xw);
                    const float av = 1.f / (1.f + fast_exp(-alv));
                    kkr[blk] = k * ckk[blk]; kpv[blk] = k * (1.f + (av - 1.f) * cka[blk]); avv4[blk] = av; rv4[blk] = r; vv4[blk] = v;
                    ssq += kkr[blk] * kkr[blk]; cf += r * kpv[blk] * crk[blk];
                }
                ssq = allred16(ssq); cf = allred16(cf);
                const float inv = 1.0f / fmaxf(sqrtf(ssq), 1e-12f);
                if (ok && !dry) {
                    _Float16* o = RW + ((size_t)(b * RW_H + hh) * LPADDED + l) * 384 + r16;
#pragma unroll
                    for (int blk = 0; blk < 4; ++blk) { const float kk = kkr[blk] * inv, bb = kk * avv4[blk];
                        o[blk * 16] = (_Float16)kk; o[64 + blk * 16] = (_Float16)(-omv[blk]); o[128 + blk * 16] = (_Float16)(-bb); o[192 + blk * 16] = (_Float16)kpv[blk];
                        o[256 + blk * 16] = (_Float16)rv4[blk]; o[320 + blk * 16] = (_Float16)vv4[blk];
                        BN[(size_t)m * RW_W + hh * 64 + blk * 16 + r16] = f2bf(cf * vv4[blk]); }
                } else { float sink = ssq + cf + inv + omv[0] + kpv[1]; asm volatile("" :: "v"(sink)); }
            } }
        }
        if (!dry || (PR_STAGES & 4)) {
            const int it4 = lane >> 4, e4 = lane & 15;
            u32x2 xv[5]; bf16_t* qp5[5]; bool okv[5];
#pragma unroll
            for (int ps = 0; ps < 5; ++ps) { const int item = (ps * 8 + wave) * 4 + it4, tok = item / 10, hq = item - tok * 10;
                const int m = m0 + t0 + tok, p = m % T;
                okv[ps] = (tok < nt) && (p >= PADR);
                qp5[ps] = QKV + (size_t)m * QKV_W + 960 + hq * 64 + e4 * 4;
                xv[ps] = okv[ps] ? *(const u32x2*)qp5[ps] : (u32x2){0u, 0u}; }
#pragma unroll
            for (int ps = 0; ps < 5; ++ps) { const int item = (ps * 8 + wave) * 4 + it4, hq = item % 10;
                const float x0 = bf_lo(xv[ps].x), x1 = bf_hi(xv[ps].x), x2 = bf_lo(xv[ps].y), x3 = bf_hi(xv[ps].y);
                const float ss = allred16((x0 * x0 + x1 * x1) + (x2 * x2 + x3 * x3));
                const float rs = 1.0f / sqrtf(ss * (1.0f / 64.f) + 1e-6f);
                const f32x4 gg = hq < 5 ? gq4 : gk4;
                const u32x2 w = {pk2(x0 * rs * gg.x, x1 * rs * gg.y), pk2(x2 * rs * gg.z, x3 * rs * gg.w)};
                if (okv[ps] && !dry) *(u32x2*)qp5[ps] = w; else asm volatile("" :: "v"(w.x), "v"(w.y)); }
        }
        __syncthreads();
    }
}


constexpr int SCH = 16;
static_assert(LTOK % SCH == 0, "whole chunks");
__device__ __forceinline__ void rwkv_scan(const ArgsL& a, Frame& F, int wgi, int dry = 0) {
    const int bh = wgi >> 4, q8 = wgi & 15, b = bh / RW_H, h = bh % RW_H;
    const int tid = F.tid, wave = F.wave, lane = F.lane;
    const unsigned char* rw = a.ws + WS_RW + (size_t)bh * LPADDED * 768;
    LAS float* ring = (LAS float*)F.lds;
    LAS float* ypart = (LAS float*)(F.lds + 49152);
    LAS unsigned char* stg = F.lds + 81920;
    bf16_t* y0 = (bf16_t*)(a.ws + WS_YCAT);
    constexpr int NCH = LTOK / SCH;
    const bool isld = (wave & 2) != 0; const int lw = (wave & 1) + ((wave >> 2) << 1), tl = lw * 64 + lane;
    float s0 = 0.f, s1 = 0.f;
    const int i32 = lane & 31, rsel = lane >> 5, rloc = 2 * wave + rsel;
#define RW_BAR() asm volatile("s_waitcnt lgkmcnt(0)\n\ts_barrier" ::: "memory")
#define RW_ISSUE(cc) do { const unsigned char* src_ = rw + (size_t)(cc) * SCH * 768 + (size_t)tl * 16; LAS unsigned char* d_ = stg + ((cc) & 3) * 12288 + lw * 1024; \
        _Pragma("unroll") for (int k_ = 0; k_ < 3; ++k_) __builtin_amdgcn_global_load_lds((const unsigned*)(src_ + k_ * 4096), (LAS unsigned*)(d_ + k_ * 4096), 16, 0, 0); } while (0)
#define RW_CONVERT(cc) do { const LAS unsigned char* s_ = stg + ((cc) & 3) * 12288 + tl * 16; LAS float* rb_ = ring + ((cc) & 1) * 6144; \
        _Pragma("unroll") for (int k_ = 0; k_ < 3; ++k_) { const int pc_ = tl + 256 * k_; const int t_ = pc_ / 48, q_ = pc_ - t_ * 48, vec_ = q_ >> 3, e0_ = (q_ & 7) * 8; \
            const u32x4 w_ = *(const LAS u32x4*)(s_ + k_ * 4096); \
            const f16x4 lo_ = __builtin_bit_cast(f16x4, (u32x2){w_.x, w_.y}), hi_ = __builtin_bit_cast(f16x4, (u32x2){w_.z, w_.w}); \
            const float f0 = (float)lo_.x, f1 = (float)lo_.y, f2 = (float)lo_.z, f3 = (float)lo_.w, f4 = (float)hi_.x, f5 = (float)hi_.y, f6 = (float)hi_.z, f7 = (float)hi_.w; \
            if (vec_ < 4) { LAS float* d_ = rb_ + t_ * 384 + (vec_ >> 1) * 128 + (e0_ >> 1) * 4 + (vec_ & 1) * 2; \
                *(LAS f32x2*)(d_) = (f32x2){f0, f1}; *(LAS f32x2*)(d_ + 4) = (f32x2){f2, f3}; *(LAS f32x2*)(d_ + 8) = (f32x2){f4, f5}; *(LAS f32x2*)(d_ + 12) = (f32x2){f6, f7}; } \
            else { LAS f32x4* d_ = (LAS f32x4*)(rb_ + t_ * 384 + (vec_ == 4 ? 256 : 320) + e0_); d_[0] = (f32x4){f0, f1, f2, f3}; d_[1] = (f32x4){f4, f5, f6, f7}; } } } while (0)
#define RW_STORE_Y(cc) do { if (tl < 32) { const LAS float* yb_ = ypart + ((cc) & 1) * 4096; const int t_ = tl >> 1, pr_ = tl & 1; const int l_ = (cc) * SCH + t_; \
        const LAS f32x4* q_ = (const LAS f32x4*)(yb_ + t_ * 128 + pr_ * 64); f32x4 sa_ = q_[0], sb_ = q_[8]; \
        _Pragma("unroll") for (int k_ = 1; k_ < 8; ++k_) { sa_ = sa_ + q_[k_]; sb_ = sb_ + q_[8 + k_]; } \
        *(unsigned*)(y0 + (size_t)(b * T + PADR + l_) * RW_W + h * 64 + q8 * 4 + 2 * pr_) = pk2((sa_.x + sa_.y) + (sa_.z + sa_.w), (sb_.x + sb_.y) + (sb_.z + sb_.w)); } } while (0)
    if (isld) {
        RW_ISSUE(0); asm volatile("s_waitcnt vmcnt(0)" ::: "memory"); RW_CONVERT(0);
        RW_ISSUE(1); RW_ISSUE(2);
    }
    RW_BAR();
    for (int c = 0; c < NCH; ++c) {
        if (isld) {
            if (c + 2 < NCH) { asm volatile("s_waitcnt vmcnt(3)" ::: "memory"); RW_CONVERT(c + 1); }
            else if (c + 1 < NCH) { asm volatile("s_waitcnt vmcnt(0)" ::: "memory"); RW_CONVERT(c + 1); }
            if (c > 0 && !dry) RW_STORE_Y(c - 1);
            if (c + 3 < NCH) RW_ISSUE(c + 3);
        } else if (dry != 1 && wave < 2) {
            const unsigned ba = (unsigned)(uintptr_t)(ring + (c & 1) * 6144) + i32 * 16, ca = (unsigned)(uintptr_t)(ring + (c & 1) * 6144) + 1024 + i32 * 8,
                           va = (unsigned)(uintptr_t)(ring + (c & 1) * 6144) + 1280 + (q8 * 4 + rloc) * 4, ya = (unsigned)(uintptr_t)(ypart + (c & 1) * 4096 + rloc * 32 + i32);
            f32x4 OA[4], OB[4]; f32x2 OC[4]; float OV[4];
            OC[3] = (f32x2){0.f, 0.f};
#define RW_FETCH(tt, sl) asm volatile("ds_read_b128 %0, %4 offset:%c7\n\tds_read_b128 %1, %4 offset:%c8\n\tds_read_b64 %2, %5 offset:%c7\n\tds_read_b32 %3, %6 offset:%c7" \
                : "=&v"(OA[sl]), "=&v"(OB[sl]), "=&v"(OC[sl]), "=&v"(OV[sl]) : "v"(ba), "v"(ca), "v"(va), "i"((tt) * 1536), "i"((tt) * 1536 + 512) : "memory")
            RW_FETCH(0, 0); RW_FETCH(1, 1);
            float p, p2, y;
#define RW_STEP(t, WAITN, YL1, YL2, YW, FETCHL) asm volatile( \
                "s_waitcnt lgkmcnt(" WAITN ")\n\t" \
                "v_mul_f32 %[p], %[s0], %[kk0]\n\t" \
                "v_fmac_f32 %[p], %[s1], %[kk1]\n\t" \
                YL1 "\n\t" YL2 "\n\t" \
                XL8 "\n\t" \
                "v_fmac_f32 %[s0], %[s0], %[om0]\n\t" \
                "v_fmac_f32 %[s1], %[s1], %[om1]\n\t" \
                XL4 "\n\t" \
                "v_fmac_f32 %[s0], %[vf], %[kv0]\n\t" \
                "v_fmac_f32 %[s1], %[vf], %[kv1]\n\t" \
                XL2 "\n\t" \
                YW "\n\t" \
                FETCHL \
                : [p] "=&v"(p), [p2] "=&v"(p2), [y] "=&v"(y), [s0] "+v"(s0), [s1] "+v"(s1), [nA] "=&v"(OA[((t) + 2) & 3]), [nB] "=&v"(OB[((t) + 2) & 3]), [nC] "=&v"(OC[((t) + 2) & 3]), [nV] "=&v"(OV[((t) + 2) & 3]) \
                : [kk0] "v"(OA[(t) & 3].x), [kk1] "v"(OA[(t) & 3].y), [om0] "v"(OA[(t) & 3].z), [om1] "v"(OA[(t) & 3].w), [bb0] "v"(OB[(t) & 3].x), [bb1] "v"(OB[(t) & 3].y), [kv0] "v"(OB[(t) & 3].z), [kv1] "v"(OB[(t) & 3].w), \
                  [vf] "v"(OV[(t) & 3]), [rp0] "v"(OC[((t) + 3) & 3].x), [rp1] "v"(OC[((t) + 3) & 3].y), [ba] "v"(ba), [ca] "v"(ca), [va] "v"(va), [ya] "v"(ya), \
                  [oa] "i"(((t) + 2) * 1536), [ob] "i"(((t) + 2) * 1536 + 512), [oy] "i"(((t) - 1) * 512) : "memory")
#define RW_YL1 "v_mul_f32 %[y], %[s0], %[rp0]"
#define RW_YL2 "v_fmac_f32 %[y], %[s1], %[rp1]"
#define RW_YW  "ds_write_b32 %[ya], %[y] offset:%c[oy]"
#define RW_NOP "s_nop 0"
#define RW_TAIL_F "ds_read_b128 %[nA], %[ba] offset:%c[oa]\n\t" \
                XL1 "\n\t" \
                "ds_read_b128 %[nB], %[ba] offset:%c[ob]\n\t" \
                "ds_read_b64 %[nC], %[ca] offset:%c[oa]\n\t" \
                "v_mov_b32 %[p2], %[p]\n\t" \
                "ds_read_b32 %[nV], %[va] offset:%c[oa]\n\t" \
                "s_nop 0\n\t" \
                XSW "\n\t" \
                "v_add_f32 %[p], %[p], %[p2]\n\t" \
                "v_fmac_f32 %[s0], %[p], %[bb0]\n\t" \
                "v_fmac_f32 %[s1], %[p], %[bb1]"
#define RW_TAIL_N "s_nop 0\n\t" \
                XL1 "\n\t" \
                "s_nop 1\n\t" \
                "v_mov_b32 %[p2], %[p]\n\t" \
                "s_nop 1\n\t" \
                XSW "\n\t" \
                "v_add_f32 %[p], %[p], %[p2]\n\t" \
                "v_fmac_f32 %[s0], %[p], %[bb0]\n\t" \
                "v_fmac_f32 %[s1], %[p], %[bb1]"
#define RW_ALLSTEPS() do { \
            RW_STEP(0, "4", RW_NOP, RW_NOP, RW_NOP, RW_TAIL_F); \
            RW_STEP(1, "4", RW_YL1, RW_YL2, RW_YW, RW_TAIL_F); \
            RW_STEP(2, "5", RW_YL1, RW_YL2, RW_YW, RW_TAIL_F);  RW_STEP(3, "5", RW_YL1, RW_YL2, RW_YW, RW_TAIL_F);  RW_STEP(4, "5", RW_YL1, RW_YL2, RW_YW, RW_TAIL_F); \
            RW_STEP(5, "5", RW_YL1, RW_YL2, RW_YW, RW_TAIL_F);  RW_STEP(6, "5", RW_YL1, RW_YL2, RW_YW, RW_TAIL_F);  RW_STEP(7, "5", RW_YL1, RW_YL2, RW_YW, RW_TAIL_F); \
            RW_STEP(8, "5", RW_YL1, RW_YL2, RW_YW, RW_TAIL_F);  RW_STEP(9, "5", RW_YL1, RW_YL2, RW_YW, RW_TAIL_F);  RW_STEP(10, "5", RW_YL1, RW_YL2, RW_YW, RW_TAIL_F); \
            RW_STEP(11, "5", RW_YL1, RW_YL2, RW_YW, RW_TAIL_F); RW_STEP(12, "5", RW_YL1, RW_YL2, RW_YW, RW_TAIL_F); RW_STEP(13, "5", RW_YL1, RW_YL2, RW_YW, RW_TAIL_F); \
            RW_STEP(14, "5", RW_YL1, RW_YL2, RW_YW, RW_TAIL_N); \
            RW_STEP(15, "1", RW_YL1, RW_YL2, RW_YW, RW_TAIL_N); \
            asm volatile("v_mul_f32 %[y], %[s0], %[r0]\n\tv_fmac_f32 %[y], %[s1], %[r1]\n\tds_write_b32 %[ya], %[y] offset:7680" : [y] "=&v"(y) : [s0] "v"(s0), [s1] "v"(s1), [r0] "v"(OC[3].x), [r1] "v"(OC[3].y), [ya] "v"(ya) : "memory"); \
 } while (0)
#ifdef SCAN_PROBE_NOXL
            if (dry == 2) {
#define XL8 "v_add_f32 %[p], %[p], %[p]"
#define XL4 "v_add_f32 %[p], %[p], %[p]"
#define XL2 "v_add_f32 %[p], %[p], %[p]"
#define XL1 "v_add_f32 %[p], %[p], %[p]"
#define XSW "v_add_f32 %[p], %[p], %[p2]"
                RW_ALLSTEPS();
#undef XL8
#undef XL4
#undef XL2
#undef XL1
#undef XSW
            } else
#endif
            {
#define XL8 "v_add_f32_dpp %[p], %[p], %[p] row_ror:8 row_mask:0xf bank_mask:0xf bound_ctrl:1"
#define XL4 "v_add_f32_dpp %[p], %[p], %[p] row_ror:4 row_mask:0xf bank_mask:0xf bound_ctrl:1"
#define XL2 "v_add_f32_dpp %[p], %[p], %[p] row_ror:2 row_mask:0xf bank_mask:0xf bound_ctrl:1"
#define XL1 "v_add_f32_dpp %[p], %[p], %[p] row_ror:1 row_mask:0xf bank_mask:0xf bound_ctrl:1"
#define XSW "v_permlane16_swap_b32 %[p], %[p2]"
                RW_ALLSTEPS();
            }
#undef RW_ALLSTEPS
#undef RW_STEP
#undef XL8
#undef XL4
#undef XL2
#undef XL1
#undef XSW
#undef RW_YL1
#undef RW_YL2
#undef RW_YW
#undef RW_NOP
#undef RW_TAIL_F
#undef RW_TAIL_N
#undef RW_FETCH
        }
        RW_BAR();
    }
    if (isld && !dry) RW_STORE_Y(NCH - 1);
    asm volatile("s_waitcnt vmcnt(0) lgkmcnt(0)\n\ts_barrier" ::: "memory");
#undef RW_STORE_Y
#undef RW_ISSUE
#undef RW_CONVERT
#undef RW_BAR
}

__device__ __forceinline__ int crow(int r, int hi) { return (r & 3) + 8 * (r >> 2) + 4 * hi; }
__device__ __forceinline__ void glds16(const void* gsrc, unsigned lds_dst) { unsigned keep;
    asm volatile("s_mov_b32 %0, m0\n\ts_mov_b32 m0, %2\n\ts_nop 0\n\tglobal_load_lds_dwordx4 %1, off\n\ts_mov_b32 m0, %0" : "=&s"(keep) : "v"(gsrc), "s"(lds_dst) : "memory"); }
__device__ __forceinline__ void glds4(const void* gsrc, unsigned lds_dst) { unsigned keep;
    asm volatile("s_mov_b32 %0, m0\n\ts_mov_b32 m0, %2\n\ts_nop 0\n\tglobal_load_lds_dword %1, off\n\ts_mov_b32 m0, %0" : "=&s"(keep) : "v"(gsrc), "s"(lds_dst) : "memory"); }
typedef LAS const char* lds_cptr;
constexpr int FX_K = 0, FX_V = 24576, FX_WS = 49152, FX_OST = 51200, FX_FLG = 83968, FX_KB = 84224  ;

__device__ __forceinline__ void fx_pv(f32x16* o, int vb, bf16x8 pa0, bf16x8 pa1, bf16x8 pa2, bf16x8 pa3) {
#pragma unroll
    for (int d0 = 0; d0 < 2; ++d0) { s16x4 lo[4], hi[4];
#pragma unroll
        for (int ks = 0; ks < 4; ++ks) {
            asm volatile("ds_read_b64_tr_b16 %0,%1 offset:%c2" : "=&v"(lo[ks]) : "v"(vb), "i"(d0 * 4096 + ks * 1024) : "memory");
            asm volatile("ds_read_b64_tr_b16 %0,%1 offset:%c2" : "=&v"(hi[ks]) : "v"(vb), "i"(d0 * 4096 + ks * 1024 + 512) : "memory"); }
        asm volatile("s_waitcnt lgkmcnt(0)" ::: "memory"); __builtin_amdgcn_sched_barrier(0);
#define FX_PK(k) (bf16x8){lo[k][0], lo[k][1], lo[k][2], lo[k][3], hi[k][0], hi[k][1], hi[k][2], hi[k][3]}
        o[d0] = __builtin_amdgcn_mfma_f32_32x32x16_bf16(pa0, FX_PK(0), o[d0], 0, 0, 0);
        o[d0] = __builtin_amdgcn_mfma_f32_32x32x16_bf16(pa1, FX_PK(1), o[d0], 0, 0, 0);
        o[d0] = __builtin_amdgcn_mfma_f32_32x32x16_bf16(pa2, FX_PK(2), o[d0], 0, 0, 0);
        o[d0] = __builtin_amdgcn_mfma_f32_32x32x16_bf16(pa3, FX_PK(3), o[d0], 0, 0, 0);
#undef FX_PK
    }
}
__device__ __forceinline__ float halves_max(float m) { auto rr = __builtin_amdgcn_permlane32_swap(__float_as_uint(m), __float_as_uint(m), false, false); return fmaxf(__uint_as_float(rr[0]), __uint_as_float(rr[1])); }
__device__ __forceinline__ float halves_sum(float m) { auto rr = __builtin_amdgcn_permlane32_swap(__float_as_uint(m), __float_as_uint(m), false, false); return __uint_as_float(rr[0]) + __uint_as_float(rr[1]); }

constexpr float ATT_EXIT = -40.0f;
template <int KIND>
__device__ __forceinline__ void attn_unit(const ArgsL& a, Frame& F, int b, int h, int qb, float bound) {
    const int lane = F.lane, wave = F.wave, r32 = lane & 31, hi = lane >> 5;
    LAS unsigned char* lds = F.lds;
    const bf16_t* QKV = (const bf16_t*)(a.ws + WS_QKV);
    const size_t rowbase = (size_t)b * T;
    const int p0 = qb * 256;
    constexpr int QC = KIND ? 0 : 960, KC = KIND ? 320 : 1280, VC = KIND ? 640 : 1600;
    const bf16_t* Qw = QKV + (rowbase + p0 + wave * 32) * QKV_W + QC + h * 64;
    const bf16_t* Kh = QKV + rowbase * QKV_W + KC + h * 64;
    const bf16_t* Vh = QKV + rowbase * QKV_W + VC + h * 64;
    const float* kbias = (const float*)(a.ws + WS_KB2) + (size_t)(b * FX_H + h) * KBP;
    const unsigned lds0 = (unsigned)(uintptr_t)lds;
    bf16x8 qr[4];
#pragma unroll
    for (int d0 = 0; d0 < 4; ++d0) qr[d0] = *(const bf16x8*)(Qw + (size_t)r32 * QKV_W + d0 * 16 + hi * 8);
    const int qp = p0 + wave * 32 + r32;
    const bool qvalid = (qp >= PADR) && (qp < T);
    const int plast = (p0 + 255) < (T - 1) ? (p0 + 255) : (T - 1);
    const int jlast = plast >> 6, jfirst = PADR >> 6;
    const int jw = (p0 + wave * 32 + 31) >> 6;
    const bf16_t* ksrc = Kh + (size_t)lane * QKV_W + wave * 8;
    const bf16_t* vsrc = Vh + (size_t)(16 * (wave & 3) + (lane >> 2)) * QKV_W + (wave >> 2) * 32 + (lane & 3) * 8;
    const unsigned kdst = lds0 + FX_K + wave * 1024, vdst = lds0 + FX_V + wave * 1024;
#define FX_DMA(j, slot) do { glds16(ksrc + (size_t)(j) * 64 * QKV_W, (unsigned)__builtin_amdgcn_readfirstlane(kdst + (slot) * 8192)); \
                             glds16(vsrc + (size_t)(j) * 64 * QKV_W, (unsigned)__builtin_amdgcn_readfirstlane(vdst + (slot) * 8192)); \
                             if (KIND == 0) glds4(kbias + 64 * (j) + lane, (unsigned)__builtin_amdgcn_readfirstlane(lds0 + FX_KB + (slot) * 2048 + wave * 256)); } while (0)
    const int vb0 = (int)(lds0 + FX_V) + ((lane >> 4) & 1) * 32 + (lane & 3) * 8 + (4 * hi + ((lane & 15) >> 2)) * 64;
    const lds_cptr kp0 = (lds_cptr)lds + FX_K + hi * 1024 + r32 * 16;
    LAS float* wsf = (LAS float*)(lds + FX_WS) + wave * 64;
    LAS float* flg = (LAS float*)(lds + FX_FLG);
    float m_run = KIND ? 0.f : -1.0e30f;
    f32x16 lacc = f32x16{};
    f32x16 o[2]; o[0] = f32x16{}; o[1] = f32x16{};
    asm volatile("" : "+v"(qr[0]), "+v"(qr[1]), "+v"(qr[2]), "+v"(qr[3]));
    int slot = 0;
    FX_DMA(jlast, 0);
    if (jlast > jfirst) FX_DMA(jlast - 1, 1);
    for (int j = jlast; j >= jfirst; --j) {
        if (j > jfirst) { if (KIND == 0) asm volatile("s_waitcnt vmcnt(3) lgkmcnt(0)\n\ts_barrier" ::: "memory"); else asm volatile("s_waitcnt vmcnt(2) lgkmcnt(0)\n\ts_barrier" ::: "memory"); }
        else asm volatile("s_waitcnt vmcnt(0) lgkmcnt(0)\n\ts_barrier" ::: "memory");
        if (j < jlast) {
            const LAS float* fl = flg + ((j + 1) & 1) * 16;
            const f32x4 fa = *(const LAS f32x4*)(fl), fb = *(const LAS f32x4*)(fl + 4);
            bool stop;
            if constexpr (KIND == 0) {
                const float mmin = fminf(fminf(fminf(fa.x, fa.y), fminf(fa.z, fa.w)), fminf(fminf(fb.x, fb.y), fminf(fb.z, fb.w)));
                stop = (bound + fl[8] - mmin) < ATT_EXIT;
            } else {
                const float mmax = fmaxf(fmaxf(fmaxf(fa.x, fa.y), fmaxf(fa.z, fa.w)), fmaxf(fmaxf(fb.x, fb.y), fmaxf(fb.z, fb.w)));
                stop = mmax < ATT_EXIT;
            }
            if (stop) break;
        }
        { const int s2 = slot + 2 >= 3 ? slot - 1 : slot + 2; if (j - 2 >= jfirst) FX_DMA(j - 2, s2); }
        if (j <= jw) {
            f32x16 s0v = f32x16{}, s1v = f32x16{};
            const lds_cptr kp = kp0 + slot * 8192;
#pragma unroll
            for (int d0 = 0; d0 < 4; ++d0) {
                const bf16x8 b0 = *(const LAS bf16x8*)(kp + d0 * 2048);
                const bf16x8 b1 = *(const LAS bf16x8*)(kp + d0 * 2048 + 512);
                s0v = __builtin_amdgcn_mfma_f32_32x32x16_bf16(b0, qr[d0], s0v, 0, 0, 0);
                s1v = __builtin_amdgcn_mfma_f32_32x32x16_bf16(b1, qr[d0], s1v, 0, 0, 0);
            }
            const bool edge = (64 * j + 63 >= p0 + wave * 32) || (64 * j < PADR);
            if constexpr (KIND == 0) {
                const LAS float* kbj = (const LAS float*)(lds + FX_KB + slot * 2048 + wave * 256) + 4 * hi;
#pragma unroll
                for (int g = 0; g < 4; ++g) { const f32x4 t0 = *(const LAS f32x4*)(kbj + 8 * g), t1 = *(const LAS f32x4*)(kbj + 32 + 8 * g);
                    s0v[4 * g] += t0.x; s0v[4 * g + 1] += t0.y; s0v[4 * g + 2] += t0.z; s0v[4 * g + 3] += t0.w;
                    s1v[4 * g] += t1.x; s1v[4 * g + 1] += t1.y; s1v[4 * g + 2] += t1.z; s1v[4 * g + 3] += t1.w; }
                if (edge) {
#pragma unroll
                    for (int r = 0; r < 16; ++r) { const int key = 64 * j + crow(r, hi);
                        if (key > qp || key < PADR) s0v[r] = -INFINITY;
                        if (key + 32 > qp || key + 32 < PADR) s1v[r] = -INFINITY; }
                }
                float rm = fmaxf(s0v[0], s1v[0]);
#pragma unroll
                for (int r = 1; r < 16; ++r) rm = fmaxf(rm, fmaxf(s0v[r], s1v[r]));
                rm = halves_max(rm);
                const float m_new = fmaxf(m_run, rm);
                const float f = __builtin_amdgcn_exp2f(m_run - m_new);
                m_run = m_new;
#pragma unroll
                for (int r = 0; r < 16; ++r) { s0v[r] = __builtin_amdgcn_exp2f(s0v[r] - m_new); s1v[r] = __builtin_amdgcn_exp2f(s1v[r] - m_new); }
                if (!__all(f == 1.0f)) {
                    if (hi == 0) wsf[r32] = f;
                    LDS_WAIT();
#pragma unroll
                    for (int r = 0; r < 16; ++r) { const float fr_ = wsf[crow(r, hi)]; o[0][r] *= fr_; o[1][r] *= fr_; lacc[r] *= fr_; }
                }
            } else {
                f32x16 l0, l1;
#pragma unroll
                for (int r = 0; r < 16; ++r) {
                    const float z0 = s0v[r], z1 = s1v[r];
                    float a0 = -(fmaxf(z0, 0.f) + __builtin_amdgcn_logf(1.f + __builtin_amdgcn_exp2f(-fabsf(z0))));
                    float a1 = -(fmaxf(z1, 0.f) + __builtin_amdgcn_logf(1.f + __builtin_amdgcn_exp2f(-fabsf(z1))));
                    if (edge) { const int key = 64 * j + crow(r, hi);
                        if (key >= qp || key < PADR) { a0 = 0.f; s0v[r] = -INFINITY; }
                        if (key + 32 >= qp || key + 32 < PADR) { a1 = 0.f; s1v[r] = -INFINITY; } }
                    l0[r] = a0; l1[r] = a1;
                }
                float A[8], SA[9], SO[9];
#pragma unroll
                for (int g = 0; g < 4; ++g) { A[g] = (l0[4 * g] + l0[4 * g + 1]) + (l0[4 * g + 2] + l0[4 * g + 3]); A[4 + g] = (l1[4 * g] + l1[4 * g + 1]) + (l1[4 * g + 2] + l1[4 * g + 3]); }
                SA[8] = 0.f; SO[8] = 0.f;
#pragma unroll
                for (int g = 7; g >= 0; --g) SA[g] = A[g] + SA[g + 1];
#pragma unroll
                for (int g = 0; g < 8; ++g) { auto rr = __builtin_amdgcn_permlane32_swap(__float_as_uint(SA[g]), __float_as_uint(SA[g]), false, false); SO[g] = __uint_as_float(hi ? rr[0] : rr[1]); }
                const float R = m_run;
#pragma unroll
                for (int g = 0; g < 8; ++g) {
                    const float E = SA[g + 1] + (hi ? SO[g + 1] : SO[g]) + R;
                    if (g < 4) { float t = E;
                        s0v[4 * g + 3] = __builtin_amdgcn_exp2f(s0v[4 * g + 3] + l0[4 * g + 3] + t); t += l0[4 * g + 3];
                        s0v[4 * g + 2] = __builtin_amdgcn_exp2f(s0v[4 * g + 2] + l0[4 * g + 2] + t); t += l0[4 * g + 2];
                        s0v[4 * g + 1] = __builtin_amdgcn_exp2f(s0v[4 * g + 1] + l0[4 * g + 1] + t); t += l0[4 * g + 1];
                        s0v[4 * g + 0] = __builtin_amdgcn_exp2f(s0v[4 * g + 0] + l0[4 * g + 0] + t);
                    } else { const int q = g - 4; float t = E;
                        s1v[4 * q + 3] = __builtin_amdgcn_exp2f(s1v[4 * q + 3] + l1[4 * q + 3] + t); t += l1[4 * q + 3];
                        s1v[4 * q + 2] = __builtin_amdgcn_exp2f(s1v[4 * q + 2] + l1[4 * q + 2] + t); t += l1[4 * q + 2];
                        s1v[4 * q + 1] = __builtin_amdgcn_exp2f(s1v[4 * q + 1] + l1[4 * q + 1] + t); t += l1[4 * q + 1];
                        s1v[4 * q + 0] = __builtin_amdgcn_exp2f(s1v[4 * q + 0] + l1[4 * q + 0] + t);
                    }
                }
                m_run = R + SA[0] + SO[0];
            }
            u32x4 pw0, pw1, pw2, pw3;
            pw0 = (u32x4){pk2(s0v[0], s0v[1]), pk2(s0v[2], s0v[3]), pk2(s0v[4], s0v[5]), pk2(s0v[6], s0v[7])};
            pw1 = (u32x4){pk2(s0v[8], s0v[9]), pk2(s0v[10], s0v[11]), pk2(s0v[12], s0v[13]), pk2(s0v[14], s0v[15])};
            pw2 = (u32x4){pk2(s1v[0], s1v[1]), pk2(s1v[2], s1v[3]), pk2(s1v[4], s1v[5]), pk2(s1v[6], s1v[7])};
            pw3 = (u32x4){pk2(s1v[8], s1v[9]), pk2(s1v[10], s1v[11]), pk2(s1v[12], s1v[13]), pk2(s1v[14], s1v[15])};
            if constexpr (KIND == 0) { const bf16x8 ones = __builtin_bit_cast(bf16x8, (u32x4){0x3F803F80u, 0x3F803F80u, 0x3F803F80u, 0x3F803F80u});
                lacc = __builtin_amdgcn_mfma_f32_32x32x16_bf16(__builtin_bit_cast(bf16x8, pw0), ones, lacc, 0, 0, 0); lacc = __builtin_amdgcn_mfma_f32_32x32x16_bf16(__builtin_bit_cast(bf16x8, pw1), ones, lacc, 0, 0, 0);
                lacc = __builtin_amdgcn_mfma_f32_32x32x16_bf16(__builtin_bit_cast(bf16x8, pw2), ones, lacc, 0, 0, 0); lacc = __builtin_amdgcn_mfma_f32_32x32x16_bf16(__builtin_bit_cast(bf16x8, pw3), ones, lacc, 0, 0, 0); }
            fx_pv(o, vb0 + slot * 8192, __builtin_bit_cast(bf16x8, pw0), __builtin_bit_cast(bf16x8, pw1), __builtin_bit_cast(bf16x8, pw2), __builtin_bit_cast(bf16x8, pw3));
        }
        float mm = qvalid ? m_run : (KIND ? -3.0e38f : 3.0e38f);
        if constexpr (KIND == 0) { mm = fminf(mm, dpp_f<0x128>(mm)); mm = fminf(mm, dpp_f<0x124>(mm)); mm = fminf(mm, dpp_f<0x122>(mm)); mm = fminf(mm, dpp_f<0x121>(mm));
            { auto sw = __builtin_amdgcn_permlane16_swap(__float_as_uint(mm), __float_as_uint(mm), false, false); mm = fminf(__uint_as_float(sw[0]), __uint_as_float(sw[1])); }
            { auto sw = __builtin_amdgcn_permlane32_swap(__float_as_uint(mm), __float_as_uint(mm), false, false); mm = fminf(__uint_as_float(sw[0]), __uint_as_float(sw[1])); } }
        else { mm = fmaxf(mm, dpp_f<0x128>(mm)); mm = fmaxf(mm, dpp_f<0x124>(mm)); mm = fmaxf(mm, dpp_f<0x122>(mm)); mm = fmaxf(mm, dpp_f<0x121>(mm));
            { auto sw = __builtin_amdgcn_permlane16_swap(__float_as_uint(mm), __float_as_uint(mm), false, false); mm = fmaxf(__uint_as_float(sw[0]), __uint_as_float(sw[1])); }
            { auto sw = __builtin_amdgcn_permlane32_swap(__float_as_uint(mm), __float_as_uint(mm), false, false); mm = fmaxf(__uint_as_float(sw[0]), __uint_as_float(sw[1])); } }
        if (lane == 0) { flg[(j & 1) * 16 + wave] = mm;
            if (KIND == 0 && wave == 0) flg[(j & 1) * 16 + 8] = *(const LAS float*)(lds + FX_KB + slot * 2048); }
        slot = slot == 2 ? 0 : slot + 1;
    }
    asm volatile("s_waitcnt vmcnt(0) lgkmcnt(0)\n\ts_barrier" ::: "memory");
    float rli[16];
    if constexpr (KIND == 0) {
#pragma unroll
        for (int r = 0; r < 16; ++r) rli[r] = __builtin_amdgcn_rcpf(lacc[r]);
    } else {
#pragma unroll
        for (int r = 0; r < 16; ++r) rli[r] = 1.0f;
    }
    bf16_t* Ow = (bf16_t*)(a.ws + WS_YCAT) + (rowbase + p0 + wave * 32) * YC_W + (KIND ? 384 : 768) + h * 64;
    {
        LAS bf16_t* stg = (LAS bf16_t*)(lds + FX_OST) + wave * 2048;
#pragma unroll
        for (int r = 0; r < 16; ++r) { const int orow = crow(r, hi);
#pragma unroll
            for (int d0 = 0; d0 < 2; ++d0) stg[orow * 64 + d0 * 32 + r32] = f2bf(o[d0][r] * rli[r]); }
        LDS_WAIT();
#pragma unroll
        for (int i = 0; i < 4; ++i) { const int row = i * 8 + (lane >> 3), ch = lane & 7; const u32x4 v = *(const LAS u32x4*)(stg + row * 64 + ch * 8);
            const int pr = p0 + wave * 32 + row;
            if (pr >= PADR && pr < T) *(u32x4*)(Ow + (size_t)row * YC_W + ch * 8) = v; }
    }
    asm volatile("s_waitcnt lgkmcnt(0)\n\ts_barrier" ::: "memory");
#undef FX_DMA
}


constexpr int CK = 64, NCK = 257, CKB = 40960, CB_ZF = 147456  ;
static_assert(LPADDED == CK * NCK, "padded steps");
__device__ __forceinline__ int swz(int row, int chunk) { return row * 128 + ((chunk ^ (row & 7)) << 4); }
__device__ __forceinline__ void ck_mm(f32x16& acc, LAS unsigned char* A, LAS unsigned char* Bt, int m0, int n0, int r32, int hi) {
#pragma unroll
    for (int ks = 0; ks < 4; ++ks) {
        const bf16x8 av = *(const LAS bf16x8*)(A + swz(m0 + r32, 2 * ks + hi));
        const bf16x8 bv = *(const LAS bf16x8*)(Bt + swz(n0 + r32, 2 * ks + hi));
        acc = __builtin_amdgcn_mfma_f32_32x32x16_bf16(av, bv, acc, 0, 0, 0);
    }
}
__device__ __forceinline__ void ck_store_t(LAS unsigned char* dst, const f32x16& acc, int m0, int n0, int r32, int hi) {
#pragma unroll
    for (int g = 0; g < 4; ++g) { const u32x2 w = {pk2(acc[4 * g], acc[4 * g + 1]), pk2(acc[4 * g + 2], acc[4 * g + 3])};
        *(LAS u32x2*)(dst + swz(n0 + r32, (m0 >> 3) + g) + hi * 8) = w; }
}
constexpr int CA_KAP = 0, CA_BET = 8192, CA_CHI = 16384, CA_RHO = 24576, CA_VMT = 32768, CA_BHT = 40960, CA_KHT = 49152, CA_AK = 57344, CA_RB = 65536, CA_RK = 73728,
              CA_AB = 81920  , CA_RHS = 98304  , CA_G64 = MISC_OFF + 2048  , CA_SCR = MISC_OFF + 4096  ;

#ifndef CA_STAGES
#define CA_STAGES 15
#endif
__device__ __forceinline__ void wg_publish(unsigned* cnt) {
    asm volatile("s_waitcnt vmcnt(0)" ::: "memory");
    __syncthreads();
    if (threadIdx.x == 0) __hip_atomic_fetch_add(cnt, 1u, __ATOMIC_RELAXED, __HIP_MEMORY_SCOPE_AGENT);
}
__device__ __forceinline__ void wg_wait(const unsigned* cnt, unsigned n) {
    if (threadIdx.x == 0) { unsigned polls = 0;
        while (__hip_atomic_load(cnt, __ATOMIC_RELAXED, __HIP_MEMORY_SCOPE_AGENT) < n) { if (++polls > (1u << 18)) break; __builtin_amdgcn_s_sleep(2); }
        __builtin_amdgcn_fence(__ATOMIC_ACQUIRE, "agent"); asm volatile("s_waitcnt vmcnt(0)" ::: "memory"); }
    __syncthreads();
}
__device__ __forceinline__ void phase_chunkA(const ArgsL& a, Frame& F, unsigned* ca_done, const bool dry = false) {
    const int wave = F.wave;
    LAS unsigned char* L = F.lds;
    u32x4 pre6[6];
#define CA_ID(r) ((r) < 12 ? (int)F.bx + 256 * (r) : ((r) == 12 && F.bx >= 12 && F.bx < 24) ? 3072 + (int)F.bx - 12 : -1)
    for (int rnd = 0; rnd < 13; ++rnd) {
        const int id = CA_ID(rnd);
        if (id < 0) break;
        int tid = F.tid, lane, r32, hi;
#define CK_FRESH() do { asm volatile("" : "+v"(tid)); lane = tid & 63; r32 = lane & 31; hi = lane >> 5; } while (0)
        CK_FRESH();
        const int bh = id / NCK, c = id - bh * NCK;
        unsigned char* blk = a.ws + WS_RW + ((size_t)bh * LPADDED + (size_t)c * CK) * 768;
        const int blko = (int)(((size_t)bh * LPADDED + (size_t)c * CK) * 768);
        const __amdgpu_buffer_rsrc_t rwrs = __builtin_amdgcn_make_buffer_rsrc((void*)(a.ws + WS_RW), 0, (int)((size_t)12 * LPADDED * 768), 0x00020000);
        {
            if (rnd == 0) {
#pragma unroll
                for (int q6 = 0; q6 < 6; ++q6) pre6[q6] = *(const u32x4*)(blk + (size_t)(tid + q6 * NTHR) * 16);
            }
#pragma unroll
            for (int q6 = 0; q6 < 6; ++q6) *(LAS u32x4*)(L + CA_AB + (tid + q6 * NTHR) * 16) = pre6[q6];
            __syncthreads();
            const int k = tid & 63, tq = tid >> 6;
            const LAS _Float16* src = (const LAS _Float16*)(L + CA_AB) + (tq * 8) * 384 + k;
            float kk[8], w[8], bb[8], kp[8], rr[8], vv[8];
#pragma unroll
            for (int e = 0; e < 8; ++e) { kk[e] = (float)src[e * 384]; w[e] = 1.f + (float)src[e * 384 + 64]; bb[e] = -(float)src[e * 384 + 128];
                kp[e] = (float)src[e * 384 + 192]; rr[e] = (float)src[e * 384 + 256]; vv[e] = (float)src[e * 384 + 320]; }
            float g[8]; g[0] = w[0];
#pragma unroll
            for (int e = 1; e < 8; ++e) g[e] = g[e - 1] * w[e];
            LAS float* scr = (LAS float*)(L + CA_SCR);
            scr[tq * 64 + k] = g[7];
            __syncthreads();
            {
                const int idn = CA_ID(rnd + 1);
                if (idn >= 0) { const int bhn = idn / NCK, cn = idn - bhn * NCK; const unsigned char* bn_ = a.ws + WS_RW + ((size_t)bhn * LPADDED + (size_t)cn * CK) * 768;
#pragma unroll
                    for (int q6 = 0; q6 < 6; ++q6) pre6[q6] = *(const u32x4*)(bn_ + (size_t)(tid + q6 * NTHR) * 16); }
            }
            float pre = 1.f, tot = 1.f;
#pragma unroll
            for (int q = 0; q < 8; ++q) { const float s = scr[q * 64 + k]; if (q < tq) pre *= s; tot *= s; }
            if (tq == 0) ((LAS float*)(L + CA_G64))[k] = tot;
            unsigned bh4[4], kh4[4], vm4[4];
            float Gp = pre;
#pragma unroll
            for (int e = 0; e < 8; ++e) {
                const int t = tq * 8 + e; const float G = pre * g[e], iG = __builtin_amdgcn_rcpf(G);
                const float kap = kk[e] * Gp, bet = bb[e] * iG, chi = kp[e] * iG, rho = rr[e] * G;
                const int o = swz(t, k >> 3) + (k & 7) * 2;
                *(LAS unsigned short*)(L + CA_KAP + o) = f2bf(kap); *(LAS unsigned short*)(L + CA_BET + o) = f2bf(bet);
                *(LAS unsigned short*)(L + CA_CHI + o) = f2bf(chi); *(LAS unsigned short*)(L + CA_RHO + o) = f2bf(rho);
                ((LAS float*)(L + CA_RHS))[t * 128 + k] = kap;
                const float bhv = bet * tot, khv = chi * tot;
                if (e & 1) { bh4[e >> 1] |= (unsigned)f2bf(bhv) << 16; kh4[e >> 1] |= (unsigned)f2bf(khv) << 16; vm4[e >> 1] |= (unsigned)f2bf(vv[e]) << 16; }
                else { bh4[e >> 1] = f2bf(bhv); kh4[e >> 1] = f2bf(khv); vm4[e >> 1] = f2bf(vv[e]); }
                Gp = G;
            }
            *(LAS u32x4*)(L + CA_BHT + swz(k, tq)) = (u32x4){bh4[0], bh4[1], bh4[2], bh4[3]};
            *(LAS u32x4*)(L + CA_KHT + swz(k, tq)) = (u32x4){kh4[0], kh4[1], kh4[2], kh4[3]};
            *(LAS u32x4*)(L + CA_VMT + swz(k, tq)) = (u32x4){vm4[0], vm4[1], vm4[2], vm4[3]};
        }
        __syncthreads();
        CK_FRESH();
        if (!dry || (CA_STAGES & 2)) {
            const int p = wave & 3, nb = wave >> 2;
            LAS unsigned char* Am = L + ((p & 1) ? CA_CHI : CA_BET);
            LAS unsigned char* Bm = L + ((p & 2) ? CA_RHO : CA_KAP);
#pragma unroll
            for (int mb = 0; mb < 2; ++mb) {
                f32x16 acc = f32x16{};
                if (!(mb == 1 && nb == 0)) ck_mm(acc, Am, Bm, mb * 32, nb * 32, r32, hi);
                const int t = nb * 32 + r32;
#pragma unroll
                for (int i = 0; i < 16; ++i) { const int j = mb * 32 + crow(i, hi); const bool keep = (p & 2) ? (j <= t) : (j < t); if (!keep) acc[i] = 0.f; }
                if (p == 0) {
#pragma unroll
                    for (int gq = 0; gq < 4; ++gq) { LAS float* ab_ = (LAS float*)(L + CA_AB) + t * 64 + (mb * 8 + 2 * gq + hi);
                        ab_[0] = acc[4 * gq]; ab_[16] = acc[4 * gq + 1]; ab_[32] = acc[4 * gq + 2]; ab_[48] = acc[4 * gq + 3]; }
                } else ck_store_t(L + (p == 1 ? CA_AK : p == 2 ? CA_RB : CA_RK), acc, mb * 32, nb * 32, r32, hi);
            }
        }
        __syncthreads();
        CK_FRESH();
        if (wave < 4 && (!dry || (CA_STAGES & 2))) {
            const int mb = wave >> 1, nb = wave & 1;
            f32x16 acc = f32x16{};
            ck_mm(acc, L + CA_AK, L + CA_VMT, mb * 32, nb * 32, r32, hi);
#pragma unroll
            for (int i = 0; i < 16; ++i) ((LAS float*)(L + CA_RHS))[(mb * 32 + crow(i, hi)) * 128 + 64 + nb * 32 + r32] = acc[i];
        }
        __syncthreads();
        CK_FRESH();
        if (!dry || (CA_STAGES & 4)) {
            const int col = tid >> 2, p = tid & 3;
            unsigned abv = (unsigned)(uintptr_t)(L + CA_AB) + p * 64; asm volatile("" : "+v"(abv));
            const LAS float* ab = (const LAS float*)(uintptr_t)abv;
            const LAS float* rhs = (const LAS float*)(L + CA_RHS) + col;
            float xo[16];
#pragma unroll
            for (int i = 0; i < 16; ++i) xo[i] = 0.f;
#pragma unroll
            for (int tg = 0; tg < 64; tg += 4) {
                f32x4 av[4][4]; float rv[4];
#pragma unroll
                for (int r = 0; r < 4; ++r) { rv[r] = rhs[(tg + r) * 128];
#pragma unroll
                    for (int i4 = 0; i4 < (tg + r + 15) / 16; ++i4) av[r][i4] = *(const LAS f32x4*)(ab + (tg + r) * 64 + 4 * i4); }
#pragma unroll
                for (int r = 0; r < 4; ++r) { const int t = tg + r;
                    float s0 = (p == 0) ? rv[r] : 0.f, s1 = 0.f;
#pragma unroll
                    for (int i4 = 0; i4 < (t + 15) / 16; ++i4) {
                        s0 -= av[r][i4].x * xo[4 * i4]; s1 -= av[r][i4].y * xo[4 * i4 + 1]; s0 -= av[r][i4].z * xo[4 * i4 + 2]; s1 -= av[r][i4].w * xo[4 * i4 + 3]; }
                    float sx = s0 + s1;
                    sx += dpp_f<0xB1>(sx);
                    sx += dpp_f<0x4E>(sx);
                    if ((t & 3) == p) xo[t >> 2] = sx;
                    asm volatile("" : "+v"(xo[t >> 2]));
                }
                __builtin_amdgcn_sched_barrier(0);
            }
            LAS unsigned char* dst = L + (col < 64 ? CA_KAP : CA_BET);
            const int rowc = col & 63;
#pragma unroll
            for (int i = 0; i < 16; ++i) { const int tt = 4 * i + p; *(LAS unsigned short*)(dst + swz(rowc, tt >> 3) + (tt & 7) * 2) = f2bf(-xo[i]); }
        }
        __syncthreads();
        CK_FRESH();
        if (!dry || (CA_STAGES & 8)) {
            const int ty = wave >> 1;
            LAS unsigned char* nW1 = L + CA_KAP; LAS unsigned char* nW2 = L + CA_BET;
#pragma unroll
            for (int qq = 0; qq < 2; ++qq) {
                const int q = (wave & 1) * 2 + qq, qa = q >> 1, qb = q & 1;
                f32x16 acc = f32x16{};
                if (ty == 0) {
                    const int t = qa * 32 + r32;
#pragma unroll
                    for (int gq = 0; gq < 4; ++gq) { const u32x2 rv = *(const LAS u32x2*)(L + CA_RHO + swz(t, qb * 4 + gq) + hi * 8);
                        acc[4 * gq] = bf_lo(rv.x); acc[4 * gq + 1] = bf_hi(rv.x); acc[4 * gq + 2] = bf_lo(rv.y); acc[4 * gq + 3] = bf_hi(rv.y); }
                    ck_mm(acc, nW1, L + CA_RB, qb * 32, qa * 32, r32, hi);
                } else if (ty == 1) {
                    ck_mm(acc, nW1, L + CA_BHT, qb * 32, qa * 32, r32, hi);
                    if (qa == qb) { const float g64 = ((const LAS float*)(L + CA_G64))[qa * 32 + r32];
#pragma unroll
                        for (int i = 0; i < 16; ++i) if (crow(i, hi) == r32) acc[i] += g64; }
                } else if (ty == 2) {
                    ck_mm(acc, L + CA_KHT, L + CA_VMT, qb * 32, qa * 32, r32, hi);
                    ck_mm(acc, L + CA_BHT, nW2, qb * 32, qa * 32, r32, hi);
                } else {
                    ck_mm(acc, L + CA_VMT, L + CA_RK, qa * 32, qb * 32, r32, hi);
                    ck_mm(acc, nW2, L + CA_RB, qa * 32, qb * 32, r32, hi);
                }
                if (dry) { float sink = acc[0] + acc[5] + acc[10] + acc[15]; asm volatile("" :: "v"(sink)); }
                else if (ty < 2) {
                    const int o = blko + (ty == 0 ? 8192 : 0) + ((qa * 2 + qb) * 2) * 1024 + lane * 16;
#pragma unroll
                    for (int ks = 0; ks < 2; ++ks)
                        __builtin_amdgcn_raw_buffer_store_b128((u32x4){pk2(acc[8 * ks], acc[8 * ks + 1]), pk2(acc[8 * ks + 2], acc[8 * ks + 3]), pk2(acc[8 * ks + 4], acc[8 * ks + 5]), pk2(acc[8 * ks + 6], acc[8 * ks + 7])}, rwrs, o + ks * 1024, 0, 16);
                } else if (ty == 2) {
                    const int o = blko + 16384 + (qa * 2 + qb) * 4096 + lane * 16;
#pragma unroll
                    for (int g = 0; g < 4; ++g) __builtin_amdgcn_raw_buffer_store_b128((u32x4){__float_as_uint(acc[4 * g]), __float_as_uint(acc[4 * g + 1]), __float_as_uint(acc[4 * g + 2]), __float_as_uint(acc[4 * g + 3])}, rwrs, o + g * 1024, 0, 16);
                } else {
                    const int o = blko + 32768 + (qa * 2 + qb) * 2048 + lane * 8;
#pragma unroll
                    for (int g = 0; g < 4; ++g) __builtin_amdgcn_raw_buffer_store_b64((u32x2){pk2(acc[4 * g], acc[4 * g + 1]), pk2(acc[4 * g + 2], acc[4 * g + 3])}, rwrs, o + g * 512, 0, 16);
                }
            }
        }
        __syncthreads();
        if (rnd == 11 && !dry) wg_publish(ca_done);
    }
    if (F.bx >= 12 && F.bx < 24 && !dry) wg_publish(ca_done + 16);
#undef CA_ID
}

__device__ __forceinline__ void rwkv_chunkB(const ArgsL& a, Frame& F, int bh, const unsigned* ca_done) {
    const int lane = F.lane, wave = F.wave, r32 = lane & 31, hi = lane >> 5;
    const int b = bh / RW_H, h = bh % RW_H;
    LAS unsigned char* L = F.lds;
    const unsigned char* base = a.ws + WS_RW + (size_t)bh * LPADDED * 768;
    bf16_t* y0 = (bf16_t*)(a.ws + WS_YCAT);
    const bool isld = (wave & 2) != 0; const int lw = (wave & 1) + ((wave >> 2) << 1);
    LAS unsigned char* yimg0 = L + 3 * CKB; LAS unsigned char* yimg1 = L + MISC_OFF + 8192;
    LAS unsigned char* zfb = L + CB_ZF;
#define CB_ISSUE(cc) do { const unsigned char* s_ = base + (size_t)(cc) * CK * 768 + (size_t)lw * 1024 + lane * 16; LAS unsigned char* d_ = L + ((cc) % 3) * CKB + lw * 1024; \
        _Pragma("unroll") for (int r_ = 0; r_ < 10; ++r_) __builtin_amdgcn_global_load_lds((const unsigned*)(s_ + r_ * 4096), (LAS unsigned*)(d_ + r_ * 4096), 16, 0, 0); } while (0)
#define CB_YOUT(cc) do { const LAS unsigned char* im_ = ((cc) & 1) ? yimg1 : yimg0; \
        _Pragma("unroll") for (int r_ = 0; r_ < 8; ++r_) { const int t_ = r_ * 8 + (lane >> 3), l_ = (cc) * CK + t_; const u32x4 v_ = *(const LAS u32x4*)(im_ + t_ * 128 + (((lane & 7) ^ (t_ & 7)) * 16)); \
            if (l_ < LTOK) *(u32x4*)(y0 + (size_t)(b * T + PADR + l_) * YC_W + h * 64 + (lane & 7) * 8) = v_; } } while (0)
    if (isld) { CB_ISSUE(0); CB_ISSUE(1); asm volatile("s_waitcnt vmcnt(10)" ::: "memory"); }
    bf16x8 zf[2][2];
#pragma unroll
    for (int q = 0; q < 4; ++q) zf[q >> 1][q & 1] = bf16x8{};
    if (wave < 2) {
#pragma unroll
        for (int q = 0; q < 4; ++q) *(LAS bf16x8*)(zfb + wave * 4096 + q * 1024 + lane * 16) = bf16x8{};
    }
    asm volatile("s_waitcnt lgkmcnt(0)\n\ts_barrier" ::: "memory");
    for (int c = 0; c < NCK; ++c) {
        if (bh == 11 && c == 240) wg_wait(ca_done + 16, 12u);
        const LAS unsigned char* S = L + (c % 3) * CKB;
        if (wave < 2) {
            const int vb = wave;
            f32x16 N0, N1;
            { const LAS unsigned char* n0 = S + 16384 + (vb * 2 + 0) * 4096 + lane * 16; const LAS unsigned char* n1 = S + 16384 + (vb * 2 + 1) * 4096 + lane * 16;
#pragma unroll
              for (int g = 0; g < 4; ++g) { const f32x4 u0 = *(const LAS f32x4*)(n0 + g * 1024), u1 = *(const LAS f32x4*)(n1 + g * 1024);
                  N0[4 * g] = u0.x; N0[4 * g + 1] = u0.y; N0[4 * g + 2] = u0.z; N0[4 * g + 3] = u0.w; N1[4 * g] = u1.x; N1[4 * g + 1] = u1.y; N1[4 * g + 2] = u1.z; N1[4 * g + 3] = u1.w; } }
#pragma unroll
            for (int kb2 = 0; kb2 < 2; ++kb2)
#pragma unroll
                for (int ks = 0; ks < 2; ++ks) {
                    const bf16x8 m0 = *(const LAS bf16x8*)(S + ((0 * 2 + kb2) * 2 + ks) * 1024 + lane * 16);
                    const bf16x8 m1 = *(const LAS bf16x8*)(S + ((1 * 2 + kb2) * 2 + ks) * 1024 + lane * 16);
                    N0 = __builtin_amdgcn_mfma_f32_32x32x16_bf16(m0, zf[kb2][ks], N0, 0, 0, 0);
                    N1 = __builtin_amdgcn_mfma_f32_32x32x16_bf16(m1, zf[kb2][ks], N1, 0, 0, 0);
                }
            LAS unsigned char* zo = zfb + ((c + 1) & 1) * 8192 + vb * 4096 + lane * 16;
#pragma unroll
            for (int ks = 0; ks < 2; ++ks) {
                zf[0][ks] = __builtin_bit_cast(bf16x8, (u32x4){pk2(N0[8 * ks], N0[8 * ks + 1]), pk2(N0[8 * ks + 2], N0[8 * ks + 3]), pk2(N0[8 * ks + 4], N0[8 * ks + 5]), pk2(N0[8 * ks + 6], N0[8 * ks + 7])});
                zf[1][ks] = __builtin_bit_cast(bf16x8, (u32x4){pk2(N1[8 * ks], N1[8 * ks + 1]), pk2(N1[8 * ks + 2], N1[8 * ks + 3]), pk2(N1[8 * ks + 4], N1[8 * ks + 5]), pk2(N1[8 * ks + 6], N1[8 * ks + 7])});
                *(LAS bf16x8*)(zo + (0 * 2 + ks) * 1024) = zf[0][ks]; *(LAS bf16x8*)(zo + (1 * 2 + ks) * 1024) = zf[1][ks];
            }
        } else if (isld) {
            if (wave == 6 && c > 0) CB_YOUT(c - 1);
            if (c + 2 < NCK) CB_ISSUE(c + 2);
            if (wave < 4) {
                const int vb = wave - 2;
                LAS unsigned char* yim = (c & 1) ? yimg1 : yimg0;
                const LAS unsigned char* zs = zfb + (c & 1) * 8192 + vb * 4096 + lane * 16;
                bf16x8 zq[2][2];
#pragma unroll
                for (int q = 0; q < 4; ++q) zq[q >> 1][q & 1] = *(const LAS bf16x8*)(zs + q * 1024);
#pragma unroll
                for (int tb = 0; tb < 2; ++tb) {
                    f32x16 acc;
                    const LAS unsigned char* yt = S + 32768 + (vb * 2 + tb) * 2048 + lane * 8;
#pragma unroll
                    for (int g = 0; g < 4; ++g) { const u32x2 w = *(const LAS u32x2*)(yt + g * 512); acc[4 * g] = bf_lo(w.x); acc[4 * g + 1] = bf_hi(w.x); acc[4 * g + 2] = bf_lo(w.y); acc[4 * g + 3] = bf_hi(w.y); }
#pragma unroll
                    for (int kb2 = 0; kb2 < 2; ++kb2)
#pragma unroll
                        for (int ks = 0; ks < 2; ++ks) { const bf16x8 pa = *(const LAS bf16x8*)(S + 8192 + ((tb * 2 + kb2) * 2 + ks) * 1024 + lane * 16);
                            acc = __builtin_amdgcn_mfma_f32_32x32x16_bf16(zq[kb2][ks], pa, acc, 0, 0, 0); }
                    const int t = tb * 32 + r32;
#pragma unroll
                    for (int g = 0; g < 4; ++g) { const u32x2 w = {pk2(acc[4 * g], acc[4 * g + 1]), pk2(acc[4 * g + 2], acc[4 * g + 3])};
                        *(LAS u32x2*)(yim + t * 128 + (((vb * 8 + 2 * g + hi) ^ (2 * (t & 7))) * 8)) = w; }
                }
            }
            if (c + 2 < NCK) asm volatile("s_waitcnt vmcnt(10)" ::: "memory"); else asm volatile("s_waitcnt vmcnt(0)" ::: "memory");
        }
        asm volatile("s_waitcnt lgkmcnt(0)\n\ts_barrier" ::: "memory");
    }
    if (wave == 6) CB_YOUT(NCK - 1);
    asm volatile("s_waitcnt vmcnt(0) lgkmcnt(0)\n\ts_barrier" ::: "memory");
#undef CB_ISSUE
#undef CB_YOUT
}

constexpr int N_FX_UNITS = 65 * 10, N_SB_UNITS = 65 * 10, N_RW_WG = 192;
#ifndef REP_SCAN
#define REP_SCAN 1
#endif
#ifndef REP_SCAN_DRY
#define REP_SCAN_DRY 0
#endif
#ifndef REP_FOX
#define REP_FOX 1
#endif
#ifndef REP_SB
#define REP_SB 1
#endif
__device__ __forceinline__ void phase_mix(const ArgsL& a, Frame& F, int layer, const unsigned* ca_done) {
#ifdef SEQ_SCAN
    if (F.bx < N_RW_WG) { int nr = REP_SCAN; asm volatile("" : "+s"(nr)); for (int r = 0; r < nr; ++r) rwkv_scan(a, F, F.bx, (r + 1 < nr) ? REP_SCAN_DRY : 0); }
#else
#ifndef REP_CHB
#define REP_CHB 1
#endif
    if (F.bx < 12) { wg_wait(ca_done, gridDim.x);
        int nr = REP_CHB; asm volatile("" : "+s"(nr)); for (int r = 0; r < nr; ++r) rwkv_chunkB(a, F, F.bx, ca_done); }
#endif
    float gqm = fabsf(a.in(I_QG)[layer * 64 + F.lane]), gkm = fabsf(a.in(I_KG)[layer * 64 + F.lane]);
#pragma unroll
    for (int off = 1; off < 64; off <<= 1) { gqm = fmaxf(gqm, __shfl_xor(gqm, off)); gkm = fmaxf(gkm, __shfl_xor(gkm, off)); }
    const float bound = 64.0f * C2 * gqm * gkm * 1.02f + 0.5f;
    unsigned* head = (unsigned*)(a.ws + WS_CTL) + CW_QUEUE + 64 * layer;
    for (;;) {
        if (F.tid == 0) F.MISC[16] = __hip_atomic_fetch_add(head, 1u, __ATOMIC_RELAXED, __HIP_MEMORY_SCOPE_AGENT);
        __syncthreads();
        const int u = (int)F.MISC[16];
        __syncthreads();
        if (u >= N_FX_UNITS + N_SB_UNITS) break;
        if (u < N_FX_UNITS) { const int qb = 64 - u / 10, bh = u % 10; int nr = REP_FOX; asm volatile("" : "+s"(nr)); for (int r = 0; r < nr; ++r) attn_unit<0>(a, F, bh / FX_H, bh % FX_H, qb, bound); }
        else { const int v = u - N_FX_UNITS; const int qb = 64 - v / 10, bh = v % 10; int nr = REP_SB; asm volatile("" : "+s"(nr)); for (int r = 0; r < nr; ++r) attn_unit<1>(a, F, bh / SB_H, bh % SB_H, qb, bound); }
    }
}

__device__ __forceinline__ void chain_publish(unsigned* cnt, int pm) {
    asm volatile("s_waitcnt vmcnt(0)" ::: "memory");
    if ((threadIdx.x & 63) == 0) __hip_atomic_fetch_add(cnt + CH_STRIDE * pm, 1u, __ATOMIC_RELAXED, __HIP_MEMORY_SCOPE_AGENT);
}
struct GatesOrder : pg8::StaticOrder {
    unsigned* mine;
    __device__ bool next(int i, pg8::Unit& u) const {
        long L;
        if (i < 5) L = (long)i * 256 + c;
        else if (i == 5) { if (c >= 16 && c < 20) return false; L = 1280 + c; }
        else if (i == 6) { if (c < 12) L = 1536 + c; else if (c < 16) L = 1280 + 16 + (c - 12); else return false; }
        else return false;
        int wgid = (int)L; { const int q = nwg / pg8::NXCD, r = nwg % pg8::NXCD, xcd = wgid % pg8::NXCD, off = wgid / pg8::NXCD; wgid = (xcd < r ? xcd * (q + 1) : r * (q + 1) + (xcd - r) * q) + off; }
        const int nig = pg8::WGM * nN, gid = wgid / nig, fm = gid * pg8::WGM, gsz = (nM - fm) < pg8::WGM ? (nM - fm) : pg8::WGM;
        u.pm = fm + ((wgid % nig) % gsz); u.pn = (wgid % nig) / gsz; return true;
    }
    __device__ __forceinline__ void a_ready(const pg8::Unit&) const {}
    __device__ __forceinline__ void done(const pg8::Unit& u) const { chain_publish(mine, u.pm); }
};
template <bool WAIT, bool PUB>
struct ChainOrder : pg8::StaticOrder {
    const unsigned* ready; unsigned need; unsigned* mine;
    __device__ __forceinline__ void a_ready(const pg8::Unit& u) const {
        if constexpr (WAIT) {
            if (threadIdx.x < 64) {
                const unsigned* w = ready + CH_STRIDE * u.pm; unsigned polls = 0;
                while ((unsigned)__builtin_amdgcn_readfirstlane(__hip_atomic_load(w, __ATOMIC_RELAXED, __HIP_MEMORY_SCOPE_AGENT)) < need) { if (++polls > (1u << 18)) break; __builtin_amdgcn_s_sleep(2); }
                __builtin_amdgcn_fence(__ATOMIC_ACQUIRE, "agent");
                asm volatile("s_waitcnt vmcnt(0)" ::: "memory");
            }
            asm volatile("" ::: "memory"); __builtin_amdgcn_s_barrier(); asm volatile("" ::: "memory");
        }
    }
    __device__ __forceinline__ void done(const pg8::Unit& u) const { if constexpr (PUB) chain_publish(mine, u.pm); }
};

__device__ __forceinline__ void phase_post(const ArgsL& a, Frame& F, int layer, unsigned* chain, const bool dry = false) {
    const int lane = F.lane, wave = F.wave, it4 = lane >> 4, e4 = lane & 15;
    bf16_t* Y0 = (bf16_t*)(a.ws + WS_YCAT); const bf16_t* BN = (const bf16_t*)(a.ws + WS_BN);
    const __amdgpu_buffer_rsrc_t yrs = __builtin_amdgcn_make_buffer_rsrc((void*)Y0, 0, (int)((size_t)M * YC_W * 2), 0x00020000);
    LAS float* lgl = (LAS float*)F.lds;
    for (int i = F.tid; i < 2 * RW_W; i += NTHR) lgl[i] = (i < RW_W) ? a.in(I_LNG)[layer * RW_W + i] : a.in(I_LNB)[layer * RW_W + i - RW_W];
    __syncthreads();
    unsigned* head = (unsigned*)(a.ws + WS_CTL) + CW_QUEUE + 64 * layer + 32 + (dry ? 8 : 0);
    for (;;) {
        if (F.tid == 0) F.MISC[17] = __hip_atomic_fetch_add(head, 1u, __ATOMIC_RELAXED, __HIP_MEMORY_SCOPE_AGENT);
        __syncthreads();
        const int ch = (int)F.MISC[17];
        __syncthreads();
        if (ch >= M / 64) break;
        u32x2 yn = {0u, 0u}, bn = {0u, 0u};
#define PP_ADDR(ps) const int item_ = (ps) * 32 + wave * 4 + it4, rw_ = item_ / 6, hh_ = item_ - rw_ * 6; const int m_ = ch * 64 + rw_; const size_t off_ = (size_t)m_ * RW_W + hh_ * 64 + e4 * 4, offy_ = (size_t)m_ * YC_W + hh_ * 64 + e4 * 4
        { PP_ADDR(0); yn = *(const u32x2*)(Y0 + offy_); bn = *(const u32x2*)(BN + off_); }
#pragma unroll 1
        for (int ps = 0; ps < 12; ++ps) {
            const u32x2 yv = yn, bv = bn;
            if (ps + 1 < 12) { PP_ADDR(ps + 1); yn = *(const u32x2*)(Y0 + offy_); bn = *(const u32x2*)(BN + off_); }
            PP_ADDR(ps);
            const int p = m_ % T;
            u32x2 w = {0u, 0u};
            if (p >= PADR) {
                const float y0 = bf_lo(yv.x), y1 = bf_hi(yv.x), y2 = bf_lo(yv.y), y3 = bf_hi(yv.y);
                const float mean = allred16((y0 + y1) + (y2 + y3)) * (1.f / 64.f);
                const float d0 = y0 - mean, d1 = y1 - mean, d2 = y2 - mean, d3 = y3 - mean;
                const float rs = 1.0f / sqrtf(allred16((d0 * d0 + d1 * d1) + (d2 * d2 + d3 * d3)) * (1.f / 64.f) + 64e-5f);
                const f32x4 g4 = *(const LAS f32x4*)(lgl + hh_ * 64 + e4 * 4), b4 = *(const LAS f32x4*)(lgl + RW_W + hh_ * 64 + e4 * 4);
                w = (u32x2){pk2(d0 * rs * g4.x + b4.x + bf_lo(bv.x), d1 * rs * g4.y + b4.y + bf_hi(bv.x)), pk2(d2 * rs * g4.z + b4.z + bf_lo(bv.y), d3 * rs * g4.w + b4.w + bf_hi(bv.y))};
            }
            if (!dry) __builtin_amdgcn_raw_buffer_store_b64(w, yrs, (int)(offy_ * 2), 0, 16); else asm volatile("" :: "v"(w.x), "v"(w.y));
        }
#undef PP_ADDR
        if (!dry) {
#pragma unroll 1
            for (int k = 0; k < 16; ++k) { const int pr = wave * 16 + k, sl = pr >> 6, m2 = ch * 64 + (pr & 63); const int p = m2 % T;
                const int rowb = (int)(((size_t)m2 * YC_W + 384 * (sl + 1)) * 2);
                if (p < PADR) { for (int c = lane; c < RW_W / 2; c += 64) __builtin_amdgcn_raw_buffer_store_b32(0u, yrs, rowb + 4 * c, 0, 16); }
                else if (lane < 32) __builtin_amdgcn_raw_buffer_store_b32(0u, yrs, rowb + 640 + 4 * lane, 0, 16); }
            chain_publish(chain, ch >> 2);
        }
    }
}

struct EpiInproj { static constexpr bool PERM = true, AFTER_DRAIN = false, MIDHOOK = false; bf16_t* ush; bf16_t* qkv;
    __device__ __forceinline__ void operator()(const f32x4 (&acc)[2][2][4][2], const pg8::Unit& u, int wr, int wc, int fr, int fq) const {
        asm volatile("" : "+v"(fr), "+v"(fq));
        const int row0 = u.pm * 256 + wr * 64 + fr, colt = u.pn * 256 + wc * 32 + 8 * fq;
        const __amdgpu_buffer_rsrc_t urs = __builtin_amdgcn_make_buffer_rsrc((void*)ush, 0, (int)((size_t)(M + 256) * SHIFT_W * 2), 0x00020000);
        const __amdgpu_buffer_rsrc_t qrs = __builtin_amdgcn_make_buffer_rsrc((void*)qkv, 0, (int)((size_t)(M + 256) * QKV_W * 2), 0x00020000);
#pragma unroll
        for (int ai = 0; ai < 2; ++ai)
#pragma unroll
            for (int m = 0; m < 4; ++m) { const size_t row = (size_t)(row0 + ai * 128 + m * 16);
#pragma unroll
                for (int bj = 0; bj < 2; ++bj) { const int col = colt + bj * 128; const f32x4 v0 = acc[ai][bj][m][0], v1 = acc[ai][bj][m][1];
                    const float sc = (col >= SHIFT_W && col < SHIFT_W + 320) ? C2 : 1.0f;
                    u32x4 w; w.x = pk2(v0[0] * sc, v0[1] * sc); w.y = pk2(v0[2] * sc, v0[3] * sc); w.z = pk2(v1[0] * sc, v1[1] * sc); w.w = pk2(v1[2] * sc, v1[3] * sc);
                    if (col < SHIFT_W) __builtin_amdgcn_raw_buffer_store_b128(w, urs, (int)((row * SHIFT_W + col) * 2), 0, 16);
                    else if (col < SHIFT_W + QKV_W) __builtin_amdgcn_raw_buffer_store_b128(w, qrs, (int)((row * QKV_W + (col - SHIFT_W)) * 2), 0, 16); } }
    }
};
struct EpiGates { static constexpr bool PERM = true, AFTER_DRAIN = false, MIDHOOK = false; bf16_t* gates;
    __device__ __forceinline__ void operator()(const f32x4 (&acc)[2][2][4][2], const pg8::Unit& u, int wr, int wc, int fr, int fq) const {
        asm volatile("" : "+v"(fr), "+v"(fq));
        const int row0 = u.pm * 256 + wr * 64 + fr, colt = u.pn * 256 + wc * 32 + 8 * fq;
        const __amdgpu_buffer_rsrc_t rs = __builtin_amdgcn_make_buffer_rsrc((void*)gates, 0, (int)((size_t)M * 3072 * 2), 0x00020000);
#pragma unroll
        for (int ai = 0; ai < 2; ++ai)
#pragma unroll
            for (int m = 0; m < 4; ++m) { const size_t row = (size_t)(row0 + ai * 128 + m * 16);
#pragma unroll
                for (int bj = 0; bj < 2; ++bj) { const int col = colt + bj * 128; f32x4 v0 = acc[ai][bj][m][0], v1 = acc[ai][bj][m][1];
#pragma unroll
                    for (int q = 0; q < 4; ++q) { v0[q] = __builtin_amdgcn_rcpf(1.f + __builtin_amdgcn_exp2f(-v0[q] * LOG2E)); v1[q] = __builtin_amdgcn_rcpf(1.f + __builtin_amdgcn_exp2f(-v1[q] * LOG2E)); }
                    u32x4 w; w.x = pk2(v0[0], v0[1]); w.y = pk2(v0[2], v0[3]); w.z = pk2(v1[0], v1[1]); w.w = pk2(v1[2], v1[3]);
                    __builtin_amdgcn_raw_buffer_store_b128(w, rs, (int)((row * 3072 + col) * 2), 0, 16); } }
    }
};
struct EpiMergeF { static constexpr bool PERM = true, AFTER_DRAIN = false, MIDHOOK = true; const bf16_t* gates; bf16_t* merged;
    __device__ __forceinline__ void mid(f32x4 (&acc)[2][2][4][2], const pg8::Unit& u, int wr, int wc, int fr, int fq, int seg) const {
        asm volatile("" : "+v"(fr), "+v"(fq));
        const int row0 = u.pm * 256 + wr * 64 + fr, colt = u.pn * 256 + wc * 32 + 8 * fq;
        u32x4 gpn[2], gnn[2];
#define MG_LOAD(q) do { const bf16_t* gpt_ = gates + (size_t)(row0 + ((q) >> 2) * 128 + ((q) & 3) * 16) * 3072 + (seg - 1) * 1024 + colt; \
            gpn[0] = *(const u32x4*)gpt_; gnn[0] = *(const u32x4*)(gpt_ + 1024); gpn[1] = *(const u32x4*)(gpt_ + 128); gnn[1] = *(const u32x4*)(gpt_ + 1024 + 128); } while (0)
        MG_LOAD(0);
#pragma unroll
        for (int q = 0; q < 8; ++q) { const int ai = q >> 2, m = q & 3;
            u32x4 gp[2], gn[2];
#pragma unroll
            for (int bj = 0; bj < 2; ++bj) { gp[bj] = gpn[bj]; gn[bj] = gnn[bj]; }
            if (q < 7) MG_LOAD(q + 1);
#pragma unroll
            for (int bj = 0; bj < 2; ++bj) { f32x4& v0 = acc[ai][bj][m][0]; f32x4& v1 = acc[ai][bj][m][1];
                v0[0] *= bf_lo(gp[bj].x) * __builtin_amdgcn_rcpf(bf_lo(gn[bj].x)); v0[1] *= bf_hi(gp[bj].x) * __builtin_amdgcn_rcpf(bf_hi(gn[bj].x));
                v0[2] *= bf_lo(gp[bj].y) * __builtin_amdgcn_rcpf(bf_lo(gn[bj].y)); v0[3] *= bf_hi(gp[bj].y) * __builtin_amdgcn_rcpf(bf_hi(gn[bj].y));
                v1[0] *= bf_lo(gp[bj].z) * __builtin_amdgcn_rcpf(bf_lo(gn[bj].z)); v1[1] *= bf_hi(gp[bj].z) * __builtin_amdgcn_rcpf(bf_hi(gn[bj].z));
                v1[2] *= bf_lo(gp[bj].w) * __builtin_amdgcn_rcpf(bf_lo(gn[bj].w)); v1[3] *= bf_hi(gp[bj].w) * __builtin_amdgcn_rcpf(bf_hi(gn[bj].w)); }
            __builtin_amdgcn_sched_barrier(0); }
#undef MG_LOAD
    }
    __device__ __forceinline__ void operator()(const f32x4 (&acc)[2][2][4][2], const pg8::Unit& u, int wr, int wc, int fr, int fq) const {
        asm volatile("" : "+v"(fr), "+v"(fq));
        const int row0 = u.pm * 256 + wr * 64 + fr, colt = u.pn * 256 + wc * 32 + 8 * fq;
        const __amdgpu_buffer_rsrc_t mrs = __builtin_amdgcn_make_buffer_rsrc((void*)merged, 0, (int)((size_t)M * D * 2), 0x00020000);
        u32x4 gnx[2];
#define MG_LOAD2(q) do { const bf16_t* gpt_ = gates + (size_t)(row0 + ((q) >> 2) * 128 + ((q) & 3) * 16) * 3072 + 2048 + colt; gnx[0] = *(const u32x4*)gpt_; gnx[1] = *(const u32x4*)(gpt_ + 128); } while (0)
        MG_LOAD2(0);
#pragma unroll
        for (int q = 0; q < 8; ++q) { const int ai = q >> 2, m = q & 3; const size_t row = (size_t)(row0 + ai * 128 + m * 16);
            u32x4 g[2];
#pragma unroll
            for (int bj = 0; bj < 2; ++bj) g[bj] = gnx[bj];
            if (q < 7) MG_LOAD2(q + 1);
#pragma unroll
            for (int bj = 0; bj < 2; ++bj) { const f32x4 v0 = acc[ai][bj][m][0], v1 = acc[ai][bj][m][1];
                u32x4 w;
                w.x = pk2(bf_lo(g[bj].x) * v0[0], bf_hi(g[bj].x) * v0[1]); w.y = pk2(bf_lo(g[bj].y) * v0[2], bf_hi(g[bj].y) * v0[3]);
                w.z = pk2(bf_lo(g[bj].z) * v1[0], bf_hi(g[bj].z) * v1[1]); w.w = pk2(bf_lo(g[bj].w) * v1[2], bf_hi(g[bj].w) * v1[3]);
                __builtin_amdgcn_raw_buffer_store_b128(w, mrs, (int)((row * D + colt + bj * 128) * 2), 0, 16); }
            __builtin_amdgcn_sched_barrier(0); }
#undef MG_LOAD2
    }
};
struct EpiOut { static constexpr bool PERM = true, AFTER_DRAIN = false, MIDHOOK = false; bf16_t* hb;
    __device__ __forceinline__ void operator()(const f32x4 (&acc)[2][2][4][2], const pg8::Unit& u, int wr, int wc, int fr, int fq) const {
        asm volatile("" : "+v"(fr), "+v"(fq));
        const int row0 = u.pm * 256 + wr * 64 + fr, colt = u.pn * 256 + wc * 32 + 8 * fq;
        u32x4 hn[2];
#define OUT_LOAD(q) do { const bf16_t* p_ = hb + (size_t)(row0 + ((q) >> 2) * 128 + ((q) & 3) * 16) * D + colt; hn[0] = *(const u32x4*)(p_); hn[1] = *(const u32x4*)(p_ + 128); } while (0)
        OUT_LOAD(0);
#pragma unroll
        for (int q = 0; q < 8; ++q) {
            const int ai = q >> 2, m = q & 3;
            bf16_t* hp = hb + (size_t)(row0 + ai * 128 + m * 16) * D + colt; const u32x4 h0 = hn[0], h1 = hn[1];
            if (q < 7) OUT_LOAD(q + 1);
#pragma unroll
            for (int bj = 0; bj < 2; ++bj) { const u32x4 hh = bj ? h1 : h0; const f32x4 v0 = acc[ai][bj][m][0], v1 = acc[ai][bj][m][1];
                u32x4 w; w.x = pk2(bf_lo(hh.x) + v0[0], bf_hi(hh.x) + v0[1]); w.y = pk2(bf_lo(hh.y) + v0[2], bf_hi(hh.y) + v0[3]);
                w.z = pk2(bf_lo(hh.z) + v1[0], bf_hi(hh.z) + v1[1]); w.w = pk2(bf_lo(hh.w) + v1[2], bf_hi(hh.w) + v1[3]);
                *(u32x4*)(hp + bj * 128) = w; }
            __builtin_amdgcn_sched_barrier(0);
        }
#undef OUT_LOAD
    }
};
template <bool GA, bool WAIT, bool PUB, bool REV> struct MoeOrderT { static constexpr bool GATHER = GA; const volatile LAS int* tb; int ntile, npt, G, c, rep; const int* s2t; unsigned* cnt; unsigned need;
    __device__ __forceinline__ bool next(int i, pg8::Unit& u) const { long L = (long)i * G + (REV ? G - 1 - c : c); if (L >= (long)ntile * npt * rep) return false; L %= (long)ntile * npt;
        const int tau = (int)(L / npt), j = (int)(L - (long)tau * npt); int e = 0;
#pragma unroll
        for (int k = 1; k < 16; ++k) e += (tau >= tb[k]) ? 1 : 0;
        u.pm = tau; u.pn = __builtin_amdgcn_readfirstlane(e) * npt + j; return true; }
    __device__ __forceinline__ void a_ready(const pg8::Unit& u) const {
        if constexpr (WAIT) {
            if (threadIdx.x < 64) {
                const unsigned* w = cnt + CH_STRIDE * u.pm; unsigned polls = 0;
                while ((unsigned)__builtin_amdgcn_readfirstlane(__hip_atomic_load(w, __ATOMIC_RELAXED, __HIP_MEMORY_SCOPE_AGENT)) < need) { if (++polls > (1u << 18)) break; __builtin_amdgcn_s_sleep(2); }
                __builtin_amdgcn_fence(__ATOMIC_ACQUIRE, "agent");
                asm volatile("s_waitcnt vmcnt(0)" ::: "memory");
            }
            asm volatile("" ::: "memory"); __builtin_amdgcn_s_barrier(); asm volatile("" ::: "memory");
        }
    }
    __device__ __forceinline__ void done(const pg8::Unit& u) const { if constexpr (PUB) chain_publish(cnt, u.pm); }
};
struct EpiMoeUp { static constexpr bool PERM = true, AFTER_DRAIN = false, MIDHOOK = false; bf16_t* hs;
    __device__ __forceinline__ void operator()(const f32x4 (&acc)[2][2][4][2], const pg8::Unit& u, int wr, int wc, int fr, int fq) const {
        asm volatile("" : "+v"(fr), "+v"(fq));
        const int row0 = u.pm * 256 + wr * 64 + fr, col = (u.pn & 1) * 128 + wc * 32 + 8 * fq;
        const __amdgpu_buffer_rsrc_t hrs = __builtin_amdgcn_make_buffer_rsrc((void*)hs, 0, (int)((size_t)MS * DEXP * 2), 0x00020000);
#pragma unroll
        for (int ai = 0; ai < 2; ++ai)
#pragma unroll
            for (int m = 0; m < 4; ++m) { const size_t row = (size_t)(row0 + ai * 128 + m * 16); float r[8];
#pragma unroll
                for (int n = 0; n < 2; ++n)
#pragma unroll
                    for (int q = 0; q < 4; ++q) { const float gte = acc[ai][0][m][n][q], up = acc[ai][1][m][n][q]; r[4 * n + q] = gte * __builtin_amdgcn_rcpf(1.f + __builtin_amdgcn_exp2f(-gte * LOG2E)) * up; }
                u32x4 w; w.x = pk2(r[0], r[1]); w.y = pk2(r[2], r[3]); w.z = pk2(r[4], r[5]); w.w = pk2(r[6], r[7]);
                __builtin_amdgcn_raw_buffer_store_b128(w, hrs, (int)((row * DEXP + col) * 2), 0, 16); }
    }
};
struct EpiMoeDown { static constexpr bool PERM = true, AFTER_DRAIN = false, MIDHOOK = false; bf16_t* y; const float* cws;
    __device__ __forceinline__ void operator()(const f32x4 (&acc)[2][2][4][2], const pg8::Unit& u, int wr, int wc, int fr, int fq) const {
        asm volatile("" : "+v"(fr), "+v"(fq));
        const int row0 = u.pm * 256 + wr * 64 + fr, colt = (u.pn & 3) * 256 + wc * 32 + 8 * fq;
        float cw[8];
#pragma unroll
        for (int q = 0; q < 8; ++q) cw[q] = cws[row0 + (q >> 2) * 128 + (q & 3) * 16];
#pragma unroll
        for (int ai = 0; ai < 2; ++ai)
#pragma unroll
            for (int m = 0; m < 4; ++m) { const size_t row = (size_t)(row0 + ai * 128 + m * 16); const float cwv = cw[ai * 4 + m];
#pragma unroll
                for (int bj = 0; bj < 2; ++bj) { const int col = colt + bj * 128; const f32x4 v0 = acc[ai][bj][m][0] * cwv, v1 = acc[ai][bj][m][1] * cwv;
                    u32x4 w; w.x = pk2(v0[0], v0[1]); w.y = pk2(v0[2], v0[3]); w.z = pk2(v1[0], v1[1]); w.w = pk2(v1[2], v1[3]);
                    *(u32x4*)(y + row * D + col) = w; } }
    }
};


#ifndef PH_MASK
#define PH_MASK 0xFFFF
#endif
#define PH(k) ((PH_MASK >> (k)) & 1)
#ifndef PROBE_DUP
#define PROBE_DUP 0
#endif
#define DUPN(bit) (((PROBE_DUP >> (bit)) & 1) ? 2 : 1)
#ifndef PROBE_THIN
#define PROBE_THIN 0
#endif
#define THIN(bit) ((PROBE_THIN >> (bit)) & 1)
#define FRESH() do { asm volatile("" : "+v"(F.tid)); F.lane = F.tid & 63; F.wave = __builtin_amdgcn_readfirstlane(F.tid >> 6); { int bx_ = (int)blockIdx.x; asm volatile("" : "+s"(bx_)); F.bx = bx_; } { unsigned char* w_ = a.ws; asm volatile("" : "+s"(w_)); a.ws = w_; } } while (0)
__global__ void __launch_bounds__(NTHR, 2) hybrid_fwd(Args ka) {
    extern __shared__ __attribute__((aligned(16))) unsigned char lds_raw[];
    Frame F;
    F.lds = (LAS unsigned char*)lds_raw;
    F.MISC = (volatile LAS unsigned*)(F.lds + MISC_OFF);
    F.tid = threadIdx.x; F.lane = F.tid & 63; F.wave = __builtin_amdgcn_readfirstlane(F.tid >> 6); F.bx = (int)blockIdx.x;
    for (int u = F.tid; u < (LDS_BYTES - MISC_OFF) / 4; u += NTHR) ((LAS unsigned*)(F.lds + MISC_OFF))[u] = 0u;
    __syncthreads();
    if (F.tid < 29) { const unsigned long long p = (unsigned long long)ka.in[F.tid]; F.MISC[64 + 2 * F.tid] = (unsigned)p; F.MISC[65 + 2 * F.tid] = (unsigned)(p >> 32); }
    __syncthreads();
    ArgsL a; a.tab = F.MISC + 64; a.out = ka.out; a.ws = ka.ws;
    XcdBarrier bar = xcd_barrier_post((unsigned*)(a.ws + WS_CTL) + CW_BAR, F.MISC + 8);
    const int G = (int)gridDim.x, c = (int)blockIdx.x;
    PG8_LAS unsigned char* ring = (PG8_LAS unsigned char*)F.lds;

#ifdef PROF_K
    volatile LAS unsigned* tsl = F.MISC + 1536; int nts = 0;
    if (blockIdx.x == 0 && F.tid == 0) tsl[nts] = (unsigned)__builtin_amdgcn_s_memrealtime();
    ++nts;
#define BARX() do { xcd_barrier(bar); if (blockIdx.x == 0 && F.tid == 0) tsl[nts] = (unsigned)__builtin_amdgcn_s_memrealtime(); ++nts; } while (0)
#else
#define BARX() xcd_barrier(bar)
#endif
    for (int layer = 0; layer < DEPTH; ++layer) {
        for (int rep = 0; rep < DUPN(8); ++rep) { FRESH(); if (PH(0)) phase_wconv(a, F, layer); }
        __syncthreads();
        if (THIN(0)) { FRESH(); phase_norm<1>(a, F, layer, true); }
        FRESH(); if (PH(1)) phase_norm<1>(a, F, layer);
        BARX();
        unsigned* ch1 = (unsigned*)(a.ws + WS_CTL) + CW_G1 + layer * 129 * CH_STRIDE;
        FRESH(); if (PH(2)) {
            pg8::Gemm g{(const bf16_t*)A_PTR(a), (const bf16_t*)(a.ws + WS_WIN), M, N1, D}; ChainOrder<false, true> S; S.init(M, N1, G, c, 1); S.ready = nullptr; S.need = 0u; S.mine = ch1;
            EpiInproj E{(bf16_t*)(a.ws + WS_USH), (bf16_t*)(a.ws + WS_QKV)};
            pg8::gemm_phase<EpiInproj, ChainOrder<false, true>, true, true>(ring, g, S, E);
        }
        asm volatile("s_waitcnt vmcnt(0) lgkmcnt(0)" ::: "memory"); __syncthreads();
        FRESH(); if (PH(3)) phase_prep(a, F, layer, ch1, (unsigned*)(a.ws + WS_CTL) + CW_QUEUE + 64 * layer + 48);
        BARX();
#ifndef SEQ_SCAN
        unsigned* ca_done = (unsigned*)(a.ws + WS_CTL) + CW_CADONE + 64 * layer;
        FRESH(); if (PH(4)) phase_chunkA(a, F, ca_done);
#endif
        FRESH(); if (PH(4)) phase_mix(a, F, layer, ca_done);
        BARX();
        unsigned* ch2 = (unsigned*)(a.ws + WS_CTL) + CW_CHAIN + (layer * 2) * 129 * CH_STRIDE; unsigned* ch3 = ch2 + 129 * CH_STRIDE;
        FRESH(); if (PH(6)) {
            pg8::Gemm g{(const bf16_t*)A_PTR(a), (const bf16_t*)(a.ws + WS_WG), M, 3072, D}; GatesOrder S; S.init(M, 3072, G, c, 1); S.mine = ch2;
            EpiGates E{(bf16_t*)(a.ws + WS_GATES)};
            pg8::gemm_phase<EpiGates, GatesOrder, true, true>(ring, g, S, E);
        }
        asm volatile("s_waitcnt vmcnt(0) lgkmcnt(0)" ::: "memory"); __syncthreads();
        if (THIN(3)) { FRESH(); phase_post(a, F, layer, ch2, true); }
        FRESH(); if (PH(5)) { if (!(c < 20 || (c >= 32 && c < 36))) phase_post(a, F, layer, ch2); }
        __syncthreads();
        FRESH(); if (PH(7)) {
            pg8::Gemm g{(const bf16_t*)(a.ws + WS_YCAT), (const bf16_t*)(a.ws + WS_WP), M, D, YC_W}; ChainOrder<true, true> S; S.init(M, D, G, (c + G - 16) % G, 1); S.ready = ch2; S.need = 128u; S.mine = ch3;
            EpiMergeF E{(const bf16_t*)(a.ws + WS_GATES), (bf16_t*)(a.ws + WS_MERGED)};
            pg8::gemm_phase<EpiMergeF, ChainOrder<true, true>, true, true>(ring, g, S, E);
        }
        FRESH(); if (PH(8)) {
            pg8::Gemm g{(const bf16_t*)(a.ws + WS_MERGED), (const bf16_t*)(a.ws + WS_WO), M, D, D}; ChainOrder<true, false> S; S.init(M, D, G, (c + G - 32) % G, 1); S.ready = ch3; S.need = 32u; S.mine = nullptr;
            EpiOut E{HB_PTR(a)};
            pg8::gemm_phase<EpiOut, ChainOrder<true, false>, true, true>(ring, g, S, E);
        }
        BARX();
        if (THIN(4)) { FRESH(); phase_norm2(a, F, layer, true); }
        FRESH(); if (PH(9)) phase_norm2(a, F, layer);
        BARX();
        for (int rep = 0; rep < DUPN(7); ++rep) { FRESH(); if (PH(10)) phase_route(a, F, layer); }
        BARX();
        volatile LAS int* tb = (volatile LAS int*)(F.MISC + 32);
        if (F.tid <= 16) { const int* cnt = (const int*)(a.ws + WS_CTL) + CW_ECNT + 64 * layer; int t = 0;
            for (int e = 0; e < F.tid; ++e) t += (__hip_atomic_load(cnt + e, __ATOMIC_RELAXED, __HIP_MEMORY_SCOPE_AGENT) + 255) >> 8;
            tb[F.tid] = t; }
        __syncthreads();
        const int ntile = tb[16];
        unsigned* chm = (unsigned*)(a.ws + WS_CTL) + CW_MOE + layer * (MS / 256) * CH_STRIDE;
        FRESH(); if (PH(11)) {
            pg8::Gemm g{(const bf16_t*)A_PTR(a), (const bf16_t*)(a.ws + WS_WGU), MS, 8192, D}; MoeOrderT<true, false, true, false> S{tb, ntile, 2, G, c, 1, (const int*)(a.ws + WS_S2T), chm, 0u};
            EpiMoeUp E{(bf16_t*)(a.ws + WS_HS)};
            pg8::gemm_phase<EpiMoeUp, MoeOrderT<true, false, true, false>, true, true>(ring, g, S, E);
        }
        FRESH(); if (PH(12)) {
            int kdim = DEXP; asm volatile("" : "+s"(kdim));
            pg8::Gemm g{(const bf16_t*)(a.ws + WS_HS), (const bf16_t*)(a.ws + WS_WD), MS, 16384, kdim}; MoeOrderT<false, true, false, true> S{tb, ntile, 4, G, c, 1, nullptr, chm, 16u};
            EpiMoeDown E{(bf16_t*)(a.ws + WS_Y), (const float*)(a.ws + WS_CWS)};
            pg8::gemm_phase<EpiMoeDown, MoeOrderT<false, true, false, true>, true, true>(ring, g, S, E);
        }
        BARX();
    }
    if (THIN(5)) { FRESH(); phase_norm<0>(a, F, DEPTH - 1, true); }
    FRESH(); if (PH(13)) phase_norm<0>(a, F, DEPTH - 1);
#ifdef PROF_K
    BARX();
    if (blockIdx.x == 0) {
        __syncthreads();
        float us;
        if (PROF_K < 0) us = 100.f;
        else if (PROF_K == 12) us = (float)(tsl[25] - tsl[24]) * 0.01f;
        else if (PROF_K == 13) us = (float)(tsl[25] - tsl[0]) * 0.01f;
        else us = ((float)(tsl[1 + PROF_K] - tsl[PROF_K]) + (float)(tsl[13 + PROF_K] - tsl[12 + PROF_K])) * 0.01f;
        us = 4.f * rintf(us * 0.25f);
        for (int i = F.tid; i < 16384; i += NTHR) a.out[i] = us;
    }
#endif
#ifdef CLOCK_PROBE
    if (blockIdx.x == 0 && F.wave == 0) {
        float c0 = 1.f, c1 = 2.f, c2 = 3.f, c3 = 4.f, c4 = 5.f, c5 = 6.f, c6 = 7.f, c7 = 8.f;
        for (int i = 0; i < CLOCK_PROBE; ++i) {
            asm volatile("v_fma_f32 %0, %0, %0, %0\n\tv_fma_f32 %1, %1, %1, %1\n\tv_fma_f32 %2, %2, %2, %2\n\tv_fma_f32 %3, %3, %3, %3\n\tv_fma_f32 %4, %4, %4, %4\n\tv_fma_f32 %5, %5, %5, %5\n\tv_fma_f32 %6, %6, %6, %6\n\tv_fma_f32 %7, %7, %7, %7"
                         : "+v"(c0), "+v"(c1), "+v"(c2), "+v"(c3), "+v"(c4), "+v"(c5), "+v"(c6), "+v"(c7));
        }
        asm volatile("" :: "v"(c0), "v"(c1), "v"(c2), "v"(c3), "v"(c4), "v"(c5), "v"(c6), "v"(c7));
    }
#endif
}

extern "C" void kernel_launch(void* const* d_in, const int* in_sizes, int n_in, void* d_out, int out_size, void* d_ws, size_t ws_size, hipStream_t stream) {
    static int ready = 0;
    if (ready == 0) {
        if (n_in != 29 || out_size != NB * SEQ * D || ws_size < WS_END) { fprintf(stderr, "kernel_launch: unexpected problem shape (n_in %d, out %d, ws %zu < %zu)\n", n_in, out_size, ws_size, (size_t)WS_END); ready = -1; return; }
        if (hipFuncSetAttribute((const void*)hybrid_fwd, hipFuncAttributeMaxDynamicSharedMemorySize, LDS_BYTES) != hipSuccess) { fprintf(stderr, "kernel_launch: hipFuncSetAttribute failed\n"); ready = -1; return; }
        int per_cu = 0;
        if (hipOccupancyMaxActiveBlocksPerMultiprocessor(&per_cu, (const void*)hybrid_fwd, NTHR, LDS_BYTES) != hipSuccess || per_cu < 1) fprintf(stderr, "kernel_launch: occupancy query says %d\n", per_cu);
        (void)hipGetLastError();
        ready = 1;
    }
    if (ready < 0) return;
    (void)in_sizes;
    if (hipMemsetAsync((char*)d_ws + WS_CTL, 0, CTL_ZERO_BYTES, stream) != hipSuccess) return;
    Args a{};
    for (int i = 0; i < 29; ++i) a.in[i] = (const float*)d_in[i];
    a.out = (float*)d_out; a.ws = (unsigned char*)d_ws;
    hipLaunchKernelGGL(hybrid_fwd, dim3(256), dim3(NTHR), LDS_BYTES, stream, a);
}
```

```cpp
#include <hip/hip_runtime.h>
#include <hip/hip_bf16.h>
#include <cstdio>
#include <cstdint>

#define GAS __attribute__((address_space(1)))
#define LAS __attribute__((address_space(3)))

namespace pg8 {
#define PG8_LAS __attribute__((address_space(3)))
typedef unsigned short bf16_t;
typedef short bf16x8 __attribute__((ext_vector_type(8)));
typedef float f32x4 __attribute__((ext_vector_type(4)));
typedef unsigned u32x4 __attribute__((ext_vector_type(4)));
constexpr int BM = 256, BK = 64, HALF = 128, HTB = HALF * BK * 2  , STAGE_BYTES = 8 * HTB, NXCD = 8, WGM = 8;

__host__ __device__ __forceinline__ int lds_byte(int r, int c) { const int st = (r >> 4) * 2 + (c >> 5), rr = r & 15, cc = c & 31, ob = rr * 64 + cc * 2; return st * 1024 + (ob ^ (((ob >> 9) & 1) << 5)); }
__host__ __device__ __forceinline__ void stage_rc(int b, int& R, int& C) { const int st = b / 1024, sb = b % 1024, swz = sb ^ (((sb >> 9) & 1) << 5); R = (st >> 1) * 16 + swz / 64; C = (st & 1) * 32 + (swz % 64) / 2; }
__host__ __device__ __forceinline__ int perm32(int rho) { const int n = rho >> 4, i = rho & 15; return 8 * (i >> 2) + 4 * n + (i & 3); }

struct Unit { int pm, pn; };
struct Gemm { const bf16_t* A; const bf16_t* Bt; int M, N, K; };

struct StaticOrder {
    int nM, nN, nwg, G, c, rep;
    __host__ __device__ void init(int M, int N, int G_, int c_, int rep_ = 1) { nM = M / BM; nN = N / BM; nwg = nM * nN; G = G_; c = c_; rep = rep_; }
    __host__ __device__ bool next(int i, Unit& u) const {
        const long L = (long)i * G + c; if (L >= (long)nwg * rep) return false;
        int wgid = (int)(L % nwg); { const int q = nwg / NXCD, r = nwg % NXCD, xcd = wgid % NXCD, off = wgid / NXCD; wgid = (xcd < r ? xcd * (q + 1) : r * (q + 1) + (xcd - r) * q) + off; }
        const int nig = WGM * nN, gid = wgid / nig, fm = gid * WGM, gsz = (nM - fm) < WGM ? (nM - fm) : WGM;
        u.pm = fm + ((wgid % nig) % gsz); u.pn = (wgid % nig) / gsz; return true;
    }
    static constexpr bool GATHER = false;
    __device__ __forceinline__ void a_ready(const Unit&) const {}
    __device__ __forceinline__ void done(const Unit&) const {}
};
__device__ __forceinline__ unsigned cvt_pk_bf16(float lo, float hi) { unsigned r; asm volatile("v_cvt_pk_bf16_f32 %0, %1, %2" : "=v"(r) : "v"(lo), "v"(hi)); return r; }
template <class Epi, class Sched, bool ALIGN_EPI = false, bool SP2 = false>
__device__ __forceinline__ void gemm_phase(PG8_LAS unsigned char* lds, const Gemm g, const Sched& S, const Epi& E) {
    int tid_ = threadIdx.x; asm volatile("" : "+v"(tid_));
    const int tid = tid_, wid = __builtin_amdgcn_readfirstlane(tid >> 6), lane = tid & 63, wr = wid >> 2, wc = wid & 3, fr = lane & 15, fq = lane >> 4;
    const int K = g.K, nt = K / BK;
    unsigned voffA[2], voffB[2];
#pragma unroll
    for (int i = 0; i < 2; ++i) { int R, C; stage_rc(tid * 16 + i * 8192, R, C); const int Rb = Epi::PERM ? ((R & ~31) + perm32(R & 31)) : R;
        voffA[i] = (unsigned)(R * K + C) * 2u; voffB[i] = (unsigned)(Rb * K + C) * 2u; }
    constexpr bool GATH = Sched::GATHER;
    unsigned vg[2] = {0u, 0u}, vn[2] = {0u, 0u}; int gR = 0; unsigned gC = 0u;
    if constexpr (GATH) { int R, C; stage_rc(tid * 16, R, C); gR = R; gC = (unsigned)C * 2u; }
#define PG8_GOFF(v, u) do { _Pragma("unroll") for (int h_ = 0; h_ < 2; ++h_) { const int* q_ = S.s2t + (u).pm * 256 + h_ * 128 + gR; v[h_] = (unsigned)q_[0] | ((unsigned)q_[64] << 16); } } while (0)
#define PG8_STAGE_G(bufoff, gbase, pk) do { const unsigned pk_ = (pk); \
        __builtin_amdgcn_global_load_lds((const unsigned*)((const char*)(gbase) + ((pk_ & 0xffffu) * (unsigned)(K * 2) + gC)), (PG8_LAS unsigned*)(lds + (bufoff) + ldsw), 16, 0, 0); \
        __builtin_amdgcn_global_load_lds((const unsigned*)((const char*)(gbase) + ((pk_ >> 16) * (unsigned)(K * 2) + gC)), (PG8_LAS unsigned*)(lds + (bufoff) + ldsw + 8192), 16, 0, 0); } while (0)
    const size_t kstep = (size_t)(BK * 2);
    const size_t hstep = (size_t)HALF * K * 2;
    const size_t tstep = 2 * hstep;
    const unsigned ldsw = (unsigned)wid * 1024u;
    const int aoff = lds_byte(wr * 64 + fr, fq * 8), boff = lds_byte(wc * 32 + fr, fq * 8);
#define PG8_SA(b, h) (((b) * 2 + (h)) * HTB)
#define PG8_SB(b, h) ((4 + (b) * 2 + (h)) * HTB)
#define PG8_STAGE(bufoff, gbase, voff) do { _Pragma("unroll") for (int _i = 0; _i < 2; ++_i) \
        __builtin_amdgcn_global_load_lds((const unsigned*)((const char*)(gbase) + (voff)[_i]), (PG8_LAS unsigned*)(lds + (bufoff) + ldsw + _i * 8192), 16, 0, 0); } while (0)
#define PG8_STAGE_A(bufoff, gbase, h, vv) do { if constexpr (GATH) PG8_STAGE_G(bufoff, gbase, vv[h]); else PG8_STAGE(bufoff, (gbase) + (h) * hstep, voffA); } while (0)
#define PG8_STAGE_A2(bufoff, gbase, h) do { if constexpr (GATH) PG8_STAGE_G(bufoff, gbase, last ? vn[h] : vg[h]); else PG8_STAGE(bufoff, (gbase) + (h) * hstep, voffA); } while (0)
#define PG8_LDA(dst, b, h) do { _Pragma("unroll") for (int m = 0; m < 4; ++m) _Pragma("unroll") for (int k = 0; k < 2; ++k) dst[m][k] = *(const PG8_LAS bf16x8*)(lds + PG8_SA(b, h) + aoff + m * 2048 + k * 1024); } while (0)
#define PG8_LDB(dst, b, h) do { _Pragma("unroll") for (int n = 0; n < 2; ++n) _Pragma("unroll") for (int k = 0; k < 2; ++k) dst[n][k] = *(const PG8_LAS bf16x8*)(lds + PG8_SB(b, h) + boff + n * 2048 + k * 1024); } while (0)
#define PG8_MMA(ai, bj, At, Bt) do { __builtin_amdgcn_s_setprio(1); _Pragma("unroll") for (int m = 0; m < 4; ++m) _Pragma("unroll") for (int n = 0; n < 2; ++n) _Pragma("unroll") for (int k = 0; k < 2; ++k) \
        acc[ai][bj][m][n] = __builtin_amdgcn_mfma_f32_16x16x32_bf16(Bt[n][k], At[m][k], acc[ai][bj][m][n], 0, 0, 0); __builtin_amdgcn_s_setprio(0); } while (0)
#define PG8_WAIT_V(n) asm volatile("s_waitcnt vmcnt(" #n ")" ::: "memory")
#define PG8_WAIT_L(n) asm volatile("s_waitcnt lgkmcnt(" #n ")" ::: "memory")
#define PG8_BAR __builtin_amdgcn_s_barrier()
#define PG8_SCHED __builtin_amdgcn_sched_barrier(0)
    Unit cur, nxt; int ui = 0;
    if (!S.next(0, cur)) return;
    f32x4 acc[2][2][4][2];
#pragma unroll
    for (int a = 0; a < 2; ++a)
#pragma unroll
        for (int b = 0; b < 2; ++b)
#pragma unroll
            for (int m = 0; m < 4; ++m)
#pragma unroll
                for (int n = 0; n < 2; ++n) acc[a][b][m][n] = (f32x4){0.f, 0.f, 0.f, 0.f};
    bf16x8 At[4][2], B0[2][2], B1[2][2];
    const char* cA = GATH ? (const char*)g.A : (const char*)g.A + (size_t)cur.pm * tstep; const char* cB = (const char*)g.Bt + (size_t)cur.pn * tstep;
    S.a_ready(cur);
    if constexpr (GATH) PG8_GOFF(vg, cur);
    if constexpr (SP2) {
        PG8_STAGE(PG8_SB(0, 0), cB, voffB); PG8_STAGE(PG8_SB(0, 1), cB + hstep, voffB); PG8_STAGE_A(PG8_SA(0, 0), cA, 0, vg); PG8_STAGE_A(PG8_SA(0, 1), cA, 1, vg);
        if (wr == 1) PG8_BAR;
        PG8_WAIT_V(2); PG8_BAR;
        PG8_STAGE(PG8_SB(1, 0), cB + kstep, voffB); PG8_STAGE_A(PG8_SA(1, 0), cA + kstep, 0, vg); PG8_STAGE(PG8_SB(1, 1), cB + hstep + kstep, voffB);
        PG8_WAIT_V(6); PG8_BAR;
    } else {
        PG8_STAGE(PG8_SB(0, 0), cB, voffB); PG8_STAGE(PG8_SA(0, 0), cA, voffA); PG8_STAGE(PG8_SB(0, 1), cB + hstep, voffB); PG8_STAGE(PG8_SA(0, 1), cA + hstep, voffA);
        if (wr == 1) PG8_BAR;
        PG8_WAIT_V(4); PG8_BAR;
        PG8_STAGE(PG8_SB(1, 0), cB + kstep, voffB); PG8_STAGE(PG8_SA(1, 0), cA + kstep, voffA); PG8_STAGE(PG8_SB(1, 1), cB + hstep + kstep, voffB);
        PG8_WAIT_V(6); PG8_BAR;
    }
    for (;;) {
        const bool has_next = S.next(ui + 1, nxt);
        const char* nA = (has_next && !GATH) ? (const char*)g.A + (size_t)nxt.pm * tstep : cA;
        if constexpr (GATH) { if (has_next) PG8_GOFF(vn, nxt); else { vn[0] = vg[0]; vn[1] = vg[1]; } } const char* nB = has_next ? (const char*)g.Bt + (size_t)nxt.pn * tstep : cB;
        for (int t = 0; t < nt; t += 2) {
            const bool last = (t == nt - 2);
            const char* a1 = cA + (size_t)(t + 1) * kstep;
            const char* a2 = last ? nA : cA + (size_t)(t + 2) * kstep; const char* b2 = last ? nB : cB + (size_t)(t + 2) * kstep;
            const char* a3 = a2 + kstep; const char* b3 = b2 + kstep;
            if (last && has_next) S.a_ready(nxt);
            if constexpr (SP2) {
            PG8_LDB(B0, 0, 0); PG8_LDB(B1, 0, 1); PG8_SCHED; PG8_LDA(At, 0, 0); PG8_STAGE_A(PG8_SA(1, 1), a1, 1, vg);
            PG8_WAIT_V(8); PG8_WAIT_L(0); PG8_BAR; PG8_MMA(0, 0, At, B0); PG8_MMA(0, 1, At, B1); PG8_BAR; PG8_SCHED;
            PG8_LDA(At, 0, 1); PG8_STAGE(PG8_SB(0, 0), b2, voffB); PG8_STAGE(PG8_SB(0, 1), b2 + hstep, voffB); PG8_STAGE_A2(PG8_SA(0, 0), a2, 0);
            PG8_WAIT_V(8); PG8_WAIT_L(0); PG8_BAR; PG8_MMA(1, 0, At, B0); PG8_MMA(1, 1, At, B1); PG8_BAR; PG8_SCHED;
            PG8_LDB(B0, 1, 0); PG8_LDB(B1, 1, 1); PG8_SCHED; PG8_LDA(At, 1, 0); PG8_STAGE_A2(PG8_SA(0, 1), a2, 1);
            PG8_WAIT_V(8); PG8_WAIT_L(0); PG8_BAR; PG8_MMA(0, 0, At, B0); PG8_MMA(0, 1, At, B1); PG8_BAR; PG8_SCHED;
            PG8_LDA(At, 1, 1); PG8_STAGE(PG8_SB(1, 0), b3, voffB); PG8_STAGE(PG8_SB(1, 1), b3 + hstep, voffB); PG8_STAGE_A2(PG8_SA(1, 0), a3, 0);
            PG8_WAIT_V(8); PG8_WAIT_L(0); PG8_BAR; PG8_MMA(1, 0, At, B0); PG8_MMA(1, 1, At, B1); PG8_BAR; PG8_SCHED;
            } else {
            static_assert(SP2 || !GATH, "gather needs the SP2 schedule");
            PG8_LDB(B0, 0, 0); PG8_SCHED; PG8_LDA(At, 0, 0); PG8_STAGE(PG8_SA(1, 1), a1 + hstep, voffA);
            PG8_WAIT_L(8); PG8_BAR; PG8_WAIT_L(0); PG8_MMA(0, 0, At, B0); PG8_BAR; PG8_SCHED;
            PG8_LDB(B1, 0, 1); PG8_STAGE(PG8_SB(0, 0), b2, voffB);
            PG8_BAR; PG8_WAIT_L(0); PG8_MMA(0, 1, At, B1); PG8_BAR;
            PG8_LDA(At, 0, 1); PG8_STAGE(PG8_SA(0, 0), a2, voffA);
            PG8_BAR; PG8_WAIT_L(0); PG8_MMA(1, 0, At, B0); PG8_BAR; PG8_SCHED;
            PG8_STAGE(PG8_SB(0, 1), b2 + hstep, voffB);
            PG8_WAIT_V(6); PG8_BAR; PG8_MMA(1, 1, At, B1); PG8_BAR;
            PG8_LDB(B0, 1, 0); PG8_SCHED; PG8_LDA(At, 1, 0); PG8_STAGE(PG8_SA(0, 1), a2 + hstep, voffA);
            PG8_WAIT_L(8); PG8_BAR; PG8_WAIT_L(0); PG8_MMA(0, 0, At, B0); PG8_BAR; PG8_SCHED;
            PG8_LDB(B1, 1, 1); PG8_STAGE(PG8_SB(1, 0), b3, voffB);
            PG8_BAR; PG8_WAIT_L(0); PG8_MMA(0, 1, At, B1); PG8_BAR;
            PG8_LDA(At, 1, 1); PG8_STAGE(PG8_SA(1, 0), a3, voffA);
            PG8_BAR; PG8_WAIT_L(0); PG8_MMA(1, 0, At, B0); PG8_BAR; PG8_SCHED;
            PG8_STAGE(PG8_SB(1, 1), b3 + hstep, voffB);
            PG8_WAIT_V(6); PG8_BAR; PG8_MMA(1, 1, At, B1); PG8_BAR;
            }
            if constexpr (Epi::MIDHOOK) { if (t + 2 == 6 || t + 2 == 12) E.mid(acc, cur, wr, wc, fr, fq, (t + 2) / 6); }
        }
        if constexpr (ALIGN_EPI) { if (wr == 0) PG8_BAR; }
        if constexpr (!Epi::AFTER_DRAIN) { E(acc, cur, wr, wc, fr, fq); S.done(cur); }
        if (!has_next) break;
#pragma unroll
        for (int a = 0; a < 2; ++a)
#pragma unroll
            for (int b = 0; b < 2; ++b)
#pragma unroll
                for (int m = 0; m < 4; ++m)
#pragma unroll
                    for (int n = 0; n < 2; ++n) acc[a][b][m][n] = (f32x4){0.f, 0.f, 0.f, 0.f};
        cur = nxt; cA = nA; cB = nB; ++ui;
        if constexpr (GATH) { vg[0] = vn[0]; vg[1] = vn[1]; }
        if constexpr (ALIGN_EPI) { if (wr == 1) PG8_BAR; }
    }
    PG8_WAIT_V(0);
    if constexpr (!ALIGN_EPI) { if (wr == 0) PG8_BAR; }
    PG8_BAR;
    if constexpr (Epi::AFTER_DRAIN) { E.fused(acc, cur, wr, wc, fr, fq, lds, wid, lane); S.done(cur); }
#undef PG8_SA
#undef PG8_SB
#undef PG8_STAGE
#undef PG8_STAGE_A
#undef PG8_STAGE_A2
#undef PG8_STAGE_G
#undef PG8_GOFF
#undef PG8_LDA
#undef PG8_LDB
#undef PG8_MMA
#undef PG8_WAIT_V
#undef PG8_WAIT_L
#undef PG8_BAR
#undef PG8_SCHED
}
}

constexpr int D = 1024, NB = 2, SEQ = 16384, NMETA = 16, LTOK = SEQ + NMETA  , PADR = 112, T = PADR + LTOK  ;
constexpr int M = NB * T;
constexpr int DEPTH = 2, HD = 64, RW_H = 6, SB_H = 5, FX_H = 5, RW_W = 384, SHIFT_W = 1280, D_IN = 6277;
constexpr int YC_W = 1152;
constexpr int QKV_W = 1920;
constexpr int N1 = 3328;
constexpr int FCOL = 3200, GCOL = 3205;
constexpr int NEXP = 16, DEXP = 256;
constexpr int MS = 70144;
constexpr int LCH = 32, LPADDED = 16448;
constexpr int KBP = 16896;
constexpr float C2 = 0.125f * 1.4426950408889634f;
constexpr float LOG2E = 1.4426950408889634f;
constexpr int NWAVES = 8, NTHR = 512;

constexpr size_t MiB = 1u << 20;
constexpr size_t WS_CTL = 0, CTL_ZERO_BYTES = 212992;
constexpr size_t WS_HM = 1 * MiB;
constexpr size_t WS_LOGF = WS_HM + 131072;
constexpr size_t WS_KB2 = WS_LOGF + (size_t)M * 32;
constexpr size_t WS_TOK = WS_KB2 + (size_t)10 * KBP * 4;
constexpr size_t WS_SLOT = WS_TOK + (size_t)M * 32;
constexpr size_t WS_CWS = WS_SLOT + (size_t)M * 8;
constexpr size_t WS_WGCNT = WS_CWS + (size_t)MS * 4;
constexpr size_t WS_S2T = WS_WGCNT + 256 * 16 * 4;
constexpr size_t WS_SMALL_END = WS_S2T + (size_t)MS * 4;
static_assert(WS_SMALL_END <= 8 * MiB, "small buffers");
constexpr size_t WS_WIN = 8 * MiB;
constexpr size_t WS_WG = WS_WIN + (size_t)N1 * 1024 * 2;
constexpr size_t WS_WP = WS_WG + (size_t)3072 * 1024 * 2;
constexpr size_t WS_WO = WS_WP + (size_t)3072 * 384 * 2;
constexpr size_t WS_WGU = WS_WO + (size_t)1024 * 1024 * 2;
constexpr size_t WS_WD = WS_WGU + (size_t)8192 * 1024 * 2;
constexpr size_t WS_W_END = WS_WD + (size_t)16384 * 256 * 2;
static_assert(WS_W_END <= 49 * MiB, "weights");
constexpr size_t WS_HB = 49 * MiB;
constexpr size_t WS_BIG = 115 * MiB;
constexpr size_t WS_USH = WS_BIG;
constexpr size_t WS_YCAT = WS_BIG;
constexpr size_t WS_QKV = WS_BIG + 82 * MiB;
constexpr size_t WS_RW = WS_BIG + 204 * MiB;
constexpr size_t WS_BN = WS_BIG + 349 * MiB;
constexpr size_t WS_GATES = WS_BIG + 82 * MiB;
constexpr size_t WS_MERGED = WS_BIG + 276 * MiB;
constexpr size_t WS_AS = WS_BIG;
constexpr size_t WS_HS = WS_BIG + 137 * MiB;
constexpr size_t WS_Y = WS_BIG + 172 * MiB;
constexpr size_t WS_END = WS_BIG + 374 * MiB;
static_assert((size_t)(M + 256) * 1280 * 2 <= 82 * MiB && (size_t)3 * M * 384 * 2 <= 82 * MiB && (size_t)(M + 256) * 1920 * 2 <= 122 * MiB, "big map 1");
static_assert((size_t)12 * LPADDED * 768 <= 145 * MiB && (size_t)M * 384 * 2 <= 25 * MiB && (size_t)M * 3072 * 2 <= 194 * MiB && (size_t)M * 2048 <= 65 * MiB, "big map 2");
static_assert((size_t)MS * 2048 <= 137 * MiB && (size_t)MS * 512 <= 35 * MiB && WS_END <= 489 * MiB, "big map 3");

constexpr int CW_BAR = 0;
constexpr int CW_QUEUE = 4096;
constexpr int CW_ECNT = 4352;
constexpr int CW_G1 = 42496;
constexpr int CW_MOE = 24960;
constexpr int CW_CADONE = 24832;
constexpr int CW_CHAIN = 8192, CH_STRIDE = 32;
static_assert((CW_ECNT + 128) <= CW_CHAIN && (CW_CHAIN + DEPTH * 2 * 129 * CH_STRIDE) <= CW_CADONE && (CW_CADONE + 128) <= CW_MOE && (CW_MOE + DEPTH * (MS / 256) * 32) <= CW_G1 && (CW_G1 + DEPTH * 129 * 32) * 4 <= (int)CTL_ZERO_BYTES, "ctl");

constexpr int RING_BYTES = 131072, MISC_OFF = RING_BYTES, LDS_BYTES = 163840;

typedef unsigned short bf16_t;
typedef float f32x4 __attribute__((ext_vector_type(4)));
typedef float f32x2 __attribute__((ext_vector_type(2)));
typedef float f32x16 __attribute__((ext_vector_type(16)));
typedef unsigned u32x4 __attribute__((ext_vector_type(4)));
typedef unsigned u32x2 __attribute__((ext_vector_type(2)));
typedef short bf16x8 __attribute__((ext_vector_type(8)));
typedef short s16x4 __attribute__((ext_vector_type(4)));
typedef _Float16 f16x4 __attribute__((ext_vector_type(4)));
typedef __bf16 bf16x2_t __attribute__((ext_vector_type(2)));

__device__ __forceinline__ unsigned pk2(float lo, float hi) { f32x2 v = {lo, hi}; bf16x2_t b = __builtin_convertvector(v, bf16x2_t); return __builtin_bit_cast(unsigned, b); }
__device__ __forceinline__ unsigned short f2bf(float f) { return (unsigned short)(pk2(f, 0.f) & 0xffffu); }
__device__ __forceinline__ float bf_lo(unsigned u) { return __uint_as_float(u << 16); }
__device__ __forceinline__ float bf_hi(unsigned u) { return __uint_as_float(u & 0xffff0000u); }
__device__ __forceinline__ float bf2f(unsigned short h) { return __uint_as_float((unsigned)h << 16); }
template <int CTRL> __device__ __forceinline__ float dpp_f(float x) { return __int_as_float(__builtin_amdgcn_update_dpp(0, __float_as_int(x), CTRL, 0xF, 0xF, false)); }
__device__ __forceinline__ float allred16(float p) { p += dpp_f<0x128>(p); p += dpp_f<0x124>(p); p += dpp_f<0x122>(p); p += dpp_f<0x121>(p); return p; }
__device__ __forceinline__ float wave_sum(float v) {
    v = allred16(v);
    { auto sw = __builtin_amdgcn_permlane16_swap(__float_as_uint(v), __float_as_uint(v), false, false); v = __uint_as_float(sw[0]) + __uint_as_float(sw[1]); }
    { auto sw = __builtin_amdgcn_permlane32_swap(__float_as_uint(v), __float_as_uint(v), false, false); v = __uint_as_float(sw[0]) + __uint_as_float(sw[1]); }
    return v;
}
__device__ __forceinline__ float fast_exp(float x) { return __builtin_amdgcn_exp2f(x * LOG2E); }
__device__ __forceinline__ float fast_log(float x) { return __builtin_amdgcn_logf(x) * 0.6931471805599453f; }
__device__ __forceinline__ float softplus_f(float z) { return fmaxf(z, 0.f) + fast_log(1.f + fast_exp(-fabsf(z))); }

#define XB_TMO      128
#define XB_XCNT(j)  (256  + 64 * (j))
#define XB_XSUB(j)  (1280 + 64 * (j))
#define XB_XGEN(j)  (2304 + 64 * (j))
#define XB_TOP      3328
#define XB_TOPGEN   3392
#define XCD_BAR_WORDS 3456
#define XB_SPIN_CAP (1u << 20)
__device__ __forceinline__ unsigned xb_ld(unsigned* p)              { return __hip_atomic_load(p, __ATOMIC_RELAXED, __HIP_MEMORY_SCOPE_AGENT); }
__device__ __forceinline__ unsigned xb_add(unsigned* p, unsigned v) { return __hip_atomic_fetch_add(p, v, __ATOMIC_RELAXED, __HIP_MEMORY_SCOPE_AGENT); }
__device__ __forceinline__ unsigned xb_xcc_id() { return (unsigned)__builtin_amdgcn_s_getreg((3 << 11) | 20) & 0xFu; }
#define XB_SPIN(cond, bar) do { unsigned _sp = 0; while (cond) { __builtin_amdgcn_s_sleep(1); \
    if ((++_sp & 255u) == 0u) { if (xb_ld(&(bar)[XB_TMO])) break; if (_sp > XB_SPIN_CAP) { atomicAdd(&(bar)[XB_TMO], 1u); break; } } } } while (0)

struct XcdBarrier {
    unsigned* bar; unsigned x;
    volatile LAS unsigned* st;
};

__device__ __forceinline__ XcdBarrier xcd_barrier_post(unsigned* bar, volatile LAS unsigned* st) {
    XcdBarrier b; b.bar = bar; b.x = xb_xcc_id(); b.st = st;
    if (threadIdx.x == 0) (void)xb_add(&bar[XB_XCNT(b.x)], 1u);
    return b;
}
__device__ __forceinline__ void xcd_barrier_complete(unsigned* bar, unsigned x, unsigned& nloc, unsigned& nx) {
    const unsigned G = gridDim.x * gridDim.y * gridDim.z;
    unsigned sum, cnt, mine, sp = 0u;
    for (;;) {
        sum = 0u; cnt = 0u; mine = 0u;
#pragma unroll
        for (unsigned j = 0; j < 16; ++j) { const unsigned c = xb_ld(&bar[XB_XCNT(j)]); sum += c; cnt += (c > 0u) ? 1u : 0u; mine = (j == x) ? c : mine; }
        if (sum == G) break;
        __builtin_amdgcn_s_sleep(1);
        if ((++sp & 255u) == 0u) { if (xb_ld(&bar[XB_TMO])) break; if (sp > XB_SPIN_CAP) { atomicAdd(&bar[XB_TMO], 1u); break; } }
    }
    nloc = mine > 0u ? mine : 1u; nx = cnt > 0u ? cnt : 1u;
}

__device__ __forceinline__ void xcd_barrier(const XcdBarrier& b) {
    asm volatile("s_waitcnt vmcnt(0)" ::: "memory");
    __syncthreads();
    if (threadIdx.x == 0) {
        unsigned* bar = b.bar;
        __builtin_amdgcn_s_waitcnt(0);
        unsigned nloc = b.st[0], nx = b.st[1];
        if (nloc == 0u) { xcd_barrier_complete(bar, b.x, nloc, nx); b.st[0] = nloc; b.st[1] = nx; }
        const unsigned old = xb_add(&bar[XB_XSUB(b.x)], 1u);
        const unsigned gen = old / nloc;
        if (old + 1u == (gen + 1u) * nloc) {
            __builtin_amdgcn_fence(__ATOMIC_RELEASE, "agent");
            asm volatile("s_waitcnt vmcnt(0)" ::: "memory");
            const unsigned og = xb_add(&bar[XB_TOP], 1u);
            const unsigned tg = og / nx;
            if (og + 1u == (tg + 1u) * nx) xb_add(&bar[XB_TOPGEN], 1u);
            else XB_SPIN(xb_ld(&bar[XB_TOPGEN]) == tg, bar);
            __builtin_amdgcn_fence(__ATOMIC_ACQUIRE, "agent");
            xb_add(&bar[XB_XGEN(b.x)], 1u);
            asm volatile("s_waitcnt vmcnt(0)" ::: "memory");
        } else {
            XB_SPIN(xb_ld(&bar[XB_XGEN(b.x)]) == gen, bar);
            __builtin_amdgcn_fence(__ATOMIC_ACQUIRE, "agent");
            asm volatile("s_waitcnt vmcnt(0)" ::: "memory");
        }
    }
    __syncthreads();
}

struct Args { const float* in[29]; float* out; unsigned char* ws; };
enum { I_X = 0, I_META, I_N1G, I_WIN, I_MU, I_WUP, I_W0, I_AUP, I_A0, I_KK, I_KA, I_RK, I_LNG, I_LNB, I_FB, I_QG, I_KG, I_WPR, I_WPS, I_WPF, I_WOUT, I_N2G, I_MWG, I_MBG, I_MWE, I_MBE, I_MGATE, I_MUP, I_MDOWN };
struct ArgsL { volatile LAS unsigned* tab; float* out; unsigned char* ws;
    __device__ __forceinline__ const float* in(int i) const { const unsigned lo = tab[2 * i], hi = tab[2 * i + 1];
        return (const float*)(((unsigned long long)(unsigned)__builtin_amdgcn_readfirstlane((int)hi) << 32) | (unsigned long long)(unsigned)__builtin_amdgcn_readfirstlane((int)lo)); }
};
struct Frame { LAS unsigned char* lds; volatile LAS unsigned* MISC; int tid, lane, wave, bx; };

__device__ __forceinline__ float* hrow(const ArgsL& a, int b, int l) {
    return l < NMETA ? (float*)(a.ws + WS_HM) + (size_t)(b * NMETA + l) * D : a.out + ((size_t)b * SEQ + (l - NMETA)) * D;
}
#define LDS_WAIT() asm volatile("s_waitcnt lgkmcnt(0)" ::: "memory")
#define HB_PTR(a) ((bf16_t*)((a).ws + WS_HB))
#define A_PTR(a) ((bf16_t*)((a).out))

__device__ __forceinline__ void tr_item(const float* W, int ldw, int sc0, int nvalid, int k0, int kvalid, bf16_t* WT, int Kd, int r0, LAS float* scr, int lane) {
    float tv[32];
#pragma unroll
    for (int i = 0; i < 32; ++i) { const int kk = 2 * i + (lane >> 5), n = lane & 31; tv[i] = 0.f;
        if (n < nvalid && k0 + kk < kvalid) tv[i] = W[(size_t)(k0 + kk) * ldw + sc0 + n]; }
#pragma unroll
    for (int i = 0; i < 32; ++i) { const int kk = 2 * i + (lane >> 5), n = lane & 31; scr[kk * 33 + n] = tv[i]; }
    LDS_WAIT();
    const int c = lane & 7;
#pragma unroll
    for (int j = 0; j < 4; ++j) { const int n = (lane >> 3) + 8 * j; const LAS float* s = scr + (8 * c) * 33 + n;
        u32x4 o; o.x = pk2(s[0 * 33], s[1 * 33]); o.y = pk2(s[2 * 33], s[3 * 33]); o.z = pk2(s[4 * 33], s[5 * 33]); o.w = pk2(s[6 * 33], s[7 * 33]);
        *(u32x4*)(WT + (size_t)(r0 + n) * Kd + k0 + 8 * c) = o; }
    LDS_WAIT();
}
__device__ __forceinline__ void tr_item2(const float* W, int ldw, int sc0, int nvalid, int k0, int kvalid, bf16_t* WT, int Kd, int r0, int kd0, LAS float* scr, int lane) {
    float tv[32];
#pragma unroll
    for (int i = 0; i < 32; ++i) { const int kk = 2 * i + (lane >> 5), n = lane & 31; tv[i] = 0.f;
        if (n < nvalid && k0 + kk < kvalid) tv[i] = W[(size_t)(k0 + kk) * ldw + sc0 + n]; }
#pragma unroll
    for (int i = 0; i < 32; ++i) { const int kk = 2 * i + (lane >> 5), n = lane & 31; scr[kk * 33 + n] = tv[i]; }
    LDS_WAIT();
    const int c = lane & 7;
#pragma unroll
    for (int j = 0; j < 4; ++j) { const int n = (lane >> 3) + 8 * j; const LAS float* s = scr + (8 * c) * 33 + n;
        u32x4 o; o.x = pk2(s[0 * 33], s[1 * 33]); o.y = pk2(s[2 * 33], s[3 * 33]); o.z = pk2(s[4 * 33], s[5 * 33]); o.w = pk2(s[6 * 33], s[7 * 33]);
        *(u32x4*)(WT + (size_t)(r0 + n) * Kd + kd0 + 8 * c) = o; }
    LDS_WAIT();
}
__device__ __forceinline__ void phase_wconv(const ArgsL& a, Frame& F, int layer) {
    LAS float* scr = (LAS float*)(F.lds + F.wave * 8448);
    const int gw = F.bx * NWAVES + F.wave, NGW = gridDim.x * NWAVES;
    constexpr int C1 = 16 * 104, C2_ = C1 + 16 * 96, C3 = C2_ + 6 * 96, C4 = C3 + 16 * 32, C5 = C4 + 16 * 256, C6 = C5 + 4 * 512;
    unsigned char* ws = a.ws;
    for (int it = gw; it < C6; it += NGW) {
        if (it < C1) { const int kb = it / 104, nb = it % 104, r0 = nb * 32;
            tr_item(a.in(I_WIN) + (size_t)layer * D * D_IN, D_IN, r0, r0 < FCOL ? 32 : 0, kb * 64, 1024, (bf16_t*)(ws + WS_WIN), 1024, r0, scr, F.lane); }
        else if (it < C2_) { const int r = it - C1, kb = r / 96, nb = r % 96, r0 = nb * 32;
            tr_item(a.in(I_WIN) + (size_t)layer * D * D_IN, D_IN, GCOL + r0, 32, kb * 64, 1024, (bf16_t*)(ws + WS_WG), 1024, r0, scr, F.lane); }
        else if (it < C3) { const int r = it - C2_, kb = r / 32, nb = r % 32, r0 = nb * 32, br = kb / 6, k0 = (kb % 6) * 64;
            const float* W = (br == 0 ? a.in(I_WPR) + (size_t)layer * 384 * D : br == 1 ? a.in(I_WPS) + (size_t)layer * 320 * D : a.in(I_WPF) + (size_t)layer * 320 * D);
            tr_item2(W, D, r0, 32, k0, br == 0 ? 384 : 320, (bf16_t*)(ws + WS_WP), YC_W, r0, br * 384 + k0, scr, F.lane); }
        else if (it < C4) { const int r = it - C3, kb = r / 32, nb = r % 32, r0 = nb * 32;
            tr_item(a.in(I_WOUT) + (size_t)layer * D * D, D, r0, 32, kb * 64, 1024, (bf16_t*)(ws + WS_WO), 1024, r0, scr, F.lane); }
        else if (it < C5) { const int r = it - C4, kb = r / 256, nb = r % 256, r0 = nb * 32, e = r0 >> 9, rr = r0 & 511, j = rr >> 8, q = rr & 255;
            const float* W = (q >= 128 ? a.in(I_MUP) : a.in(I_MGATE)) + ((size_t)layer * NEXP + e) * D * DEXP;
            tr_item(W, DEXP, j * 128 + (q & 127), 32, kb * 64, 1024, (bf16_t*)(ws + WS_WGU), 1024, r0, scr, F.lane); }
        else { const int r = it - C5, kb = r / 512, nb = r % 512, r0 = nb * 32, e = r0 >> 10;
            tr_item(a.in(I_MDOWN) + ((size_t)layer * NEXP + e) * DEXP * D, D, r0 & 1023, 32, kb * 64, 256, (bf16_t*)(ws + WS_WD), 256, r0, scr, F.lane); }
    }
}

__device__ __forceinline__ void add_y_row(f32x4 (&v)[4], const bf16_t* Y, int slot, int lane) {
    const u32x2* y = (const u32x2*)(Y + (size_t)slot * D) + lane;
#pragma unroll
    for (int j = 0; j < 4; ++j) { const u32x2 t = y[64 * j]; v[j].x += bf_lo(t.x); v[j].y += bf_hi(t.x); v[j].z += bf_lo(t.y); v[j].w += bf_hi(t.y); }
}
template <int MODE>
__device__ __forceinline__ void phase_norm(const ArgsL& a, Frame& F, int layer, const bool dry = false) {
    const int lane = F.lane;
    LAS float* wl = (LAS float*)F.lds;
    LAS int* lcnt = (LAS int*)(F.lds + 20 * 4096);
    unsigned char* ws = a.ws;
    if (MODE == 1) {
        const float* win = a.in(I_WIN) + (size_t)layer * D * D_IN;
        for (int idx = F.tid; idx < 5 * 1024; idx += NTHR) { const int j = idx >> 10, k = idx & 1023; wl[j * 1024 + k] = win[(size_t)k * D_IN + FCOL + j]; }
    }
    if (MODE == 2) {
        const float* wg = a.in(I_MWG) + (size_t)layer * D * 4; const float* we = a.in(I_MWE) + (size_t)layer * D * 16;
        for (int i4 = F.tid; i4 < 1024; i4 += NTHR) { const f32x4 f = *(const f32x4*)(wg + 4 * i4); wl[i4] = f.x; wl[1024 + i4] = f.y; wl[2048 + i4] = f.z; wl[3072 + i4] = f.w; }
        for (int i4 = F.tid; i4 < 4096; i4 += NTHR) { const int k = i4 >> 2, c = i4 & 3; const f32x4 f = *(const f32x4*)(we + 4 * i4); LAS float* d = wl + (4 + 4 * c) * 1024 + k;
            d[0] = f.x; d[1024] = f.y; d[2048] = f.z; d[3072] = f.w; }
        if (F.tid < 16) lcnt[F.tid] = 0;
    }
    __syncthreads();
    const int gw = F.bx * NWAVES + F.wave, NGW = gridDim.x * NWAVES;
    const float* gsrc = (MODE == 2 ? a.in(I_N2G) : a.in(I_N1G)) + layer * D;
    f32x4 gv[4];
#pragma unroll
    for (int j = 0; j < 4; ++j) gv[j] = (MODE == 0) ? (f32x4){0.f, 0.f, 0.f, 0.f} : *(const f32x4*)(gsrc + 4 * lane + 256 * j);
    bf16_t* A = A_PTR(a); bf16_t* HB = HB_PTR(a);
    const bf16_t* Y = (const bf16_t*)(ws + WS_Y);
    const int* SLOT = (const int*)(ws + WS_SLOT);
    constexpr bool COMB0 = (MODE == 0);
    const bool comb = COMB0 || (MODE == 1 && layer > 0);
    f32x4 vn[4]; u32x2 yan[4], ybn[4];
#pragma unroll
    for (int j = 0; j < 4; ++j) { vn[j] = (f32x4){0.f, 0.f, 0.f, 0.f}; yan[j] = (u32x2){0u, 0u}; ybn[j] = (u32x2){0u, 0u}; }
#define NRM_VALID(mm) ((mm) < M && ((mm) % T) - PADR >= (MODE == 0 ? NMETA : 0))
#define NRM_LOAD(mm, s0_, s1_) do { if (NRM_VALID(mm)) { const int bb_ = (mm) / T, ll_ = (mm) - bb_ * T - PADR; \
        if (MODE == 1 && layer == 0) { const float* src_ = (ll_ < NMETA) ? a.in(I_META) + (size_t)ll_ * D : a.in(I_X) + ((size_t)bb_ * SEQ + (ll_ - NMETA)) * D; \
            _Pragma("unroll") for (int j = 0; j < 4; ++j) vn[j] = *(const f32x4*)(src_ + 4 * lane + 256 * j); } \
        else { const u32x2* hs_ = (const u32x2*)(HB + (size_t)(mm) * D) + lane; \
            _Pragma("unroll") for (int j = 0; j < 4; ++j) { const u32x2 t_ = hs_[64 * j]; vn[j] = (f32x4){bf_lo(t_.x), bf_hi(t_.x), bf_lo(t_.y), bf_hi(t_.y)}; } } \
        if (comb) { const u32x2* y0_ = (const u32x2*)(Y + (size_t)(s0_) * D) + lane; const u32x2* y1_ = (const u32x2*)(Y + (size_t)(s1_) * D) + lane; \
            _Pragma("unroll") for (int j = 0; j < 4; ++j) { yan[j] = y0_[64 * j]; ybn[j] = y1_[64 * j]; } } } } while (0)
    int sa1 = 0, sb1 = 0, sa2 = 0, sb2 = 0;
    if (comb) { if (NRM_VALID(gw)) { sa1 = SLOT[2 * gw]; sb1 = SLOT[2 * gw + 1]; } if (NRM_VALID(gw + NGW)) { sa2 = SLOT[2 * (gw + NGW)]; sb2 = SLOT[2 * (gw + NGW) + 1]; } }
    NRM_LOAD(gw, sa1, sb1);
    for (int m = gw; m < M; m += NGW) {
        f32x4 v[4]; u32x2 ya[4], yb[4];
#pragma unroll
        for (int j = 0; j < 4; ++j) { v[j] = vn[j]; ya[j] = yan[j]; yb[j] = ybn[j]; }
        int sa3 = 0, sb3 = 0;
        if (comb && NRM_VALID(m + 2 * NGW)) { sa3 = SLOT[2 * (m + 2 * NGW)]; sb3 = SLOT[2 * (m + 2 * NGW) + 1]; }
        NRM_LOAD(m + NGW, sa2, sb2);
        sa2 = sa3; sb2 = sb3;
        const int b = m / T, p = m - b * T, l = p - PADR;
        if (l < 0) {
            if (MODE == 1 && !dry) {
                u32x2* o = (u32x2*)(A + (size_t)m * D) + lane;
#pragma unroll
                for (int j = 0; j < 4; ++j) o[64 * j] = (u32x2){0u, 0u};
                if (lane < 8) ((float*)(ws + WS_LOGF))[(size_t)m * 8 + lane] = 0.f;
            }
            continue;
        }
        if (MODE == 0 && l < NMETA) continue;
        if (comb) {
#pragma unroll
            for (int j = 0; j < 4; ++j) { v[j].x += bf_lo(ya[j].x) + bf_lo(yb[j].x); v[j].y += bf_hi(ya[j].x) + bf_hi(yb[j].x); v[j].z += bf_lo(ya[j].y) + bf_lo(yb[j].y); v[j].w += bf_hi(ya[j].y) + bf_hi(yb[j].y); }
        }
        if (MODE == 0 && !dry) { float* op = a.out + ((size_t)b * SEQ + (l - NMETA)) * D;
#pragma unroll
            for (int j = 0; j < 4; ++j) *(f32x4*)(op + 4 * lane + 256 * j) = v[j]; }
        if (MODE == 1 && !dry) { u32x2* hd = (u32x2*)(HB + (size_t)m * D) + lane;
#pragma unroll
            for (int j = 0; j < 4; ++j) hd[64 * j] = (u32x2){pk2(v[j].x, v[j].y), pk2(v[j].z, v[j].w)};
        }
        if (MODE == 0) continue;
        float ss = 0.f;
#pragma unroll
        for (int j = 0; j < 4; ++j) ss += (v[j].x * v[j].x + v[j].y * v[j].y) + (v[j].z * v[j].z + v[j].w * v[j].w);
        const float r = 1.0f / sqrtf(wave_sum(ss) * (1.0f / D) + 1e-6f);
#pragma unroll
        for (int j = 0; j < 4; ++j) v[j] = v[j] * r * gv[j];
        u32x2* o = (u32x2*)(A + (size_t)m * D) + lane;
        if (!dry) {
#pragma unroll
        for (int j = 0; j < 4; ++j) o[64 * j] = (u32x2){pk2(v[j].x, v[j].y), pk2(v[j].z, v[j].w)}; }
        else { float sink = v[0].x + v[1].y + v[2].z + v[3].w; asm volatile("" :: "v"(sink)); }
        if (MODE == 1) {
            float dsum[5];
#pragma unroll
            for (int q = 0; q < 5; ++q) { float d = 0.f;
#pragma unroll
                for (int j = 0; j < 4; ++j) { const f32x4 w = *(const LAS f32x4*)(wl + q * 1024 + 4 * lane + 256 * j); d += (v[j].x * w.x + v[j].y * w.y) + (v[j].z * w.z + v[j].w * w.w); }
                dsum[q] = wave_sum(d); }
            float mine = dsum[0];
            mine = lane == 1 ? dsum[1] : mine; mine = lane == 2 ? dsum[2] : mine; mine = lane == 3 ? dsum[3] : mine; mine = lane == 4 ? dsum[4] : mine;
            if (lane < 8 && !dry) { float lf = 0.f;
                if (lane < 5) { const float xx = mine + a.in(I_FB)[layer * 5 + lane]; lf = fminf(xx, 0.f) - fast_log(1.f + fast_exp(-fabsf(xx))); }
                ((float*)(ws + WS_LOGF))[(size_t)m * 8 + lane] = lf; }
        }
        if (MODE == 2) {
            float dp[20];
#pragma unroll
            for (int q = 0; q < 20; ++q) { float d = 0.f;
#pragma unroll
                for (int j = 0; j < 4; ++j) { const f32x4 w = *(const LAS f32x4*)(wl + q * 1024 + 4 * lane + 256 * j); d += (v[j].x * w.x + v[j].y * w.y) + (v[j].z * w.z + v[j].w * w.w); }
                dp[q] = d; }
            float sA[10], sB[5];
#pragma unroll
            for (int i = 0; i < 10; ++i) { auto sw = __builtin_amdgcn_permlane32_swap(__float_as_uint(dp[2 * i]), __float_as_uint(dp[2 * i + 1]), false, false); sA[i] = __uint_as_float(sw[0]) + __uint_as_float(sw[1]); }
#pragma unroll
            for (int i = 0; i < 5; ++i) { auto sw = __builtin_amdgcn_permlane16_swap(__float_as_uint(sA[2 * i]), __float_as_uint(sA[2 * i + 1]), false, false); sB[i] = allred16(__uint_as_float(sw[0]) + __uint_as_float(sw[1])); }
            LAS float* red = (LAS float*)(F.lds + 81920 + 256) + F.wave * 32;
            { const int rho = lane >> 4, vsel = ((rho & 1) << 1) | (rho >> 1);
              if ((lane & 15) == 0) {
#pragma unroll
                  for (int i = 0; i < 5; ++i) red[4 * i + vsel] = sB[i]; } }
            LDS_WAIT();
            float ds[20];
#pragma unroll
            for (int i = 0; i < 5; ++i) { const f32x4 t4 = *(const LAS f32x4*)(red + 4 * i); ds[4 * i] = t4.x; ds[4 * i + 1] = t4.y; ds[4 * i + 2] = t4.z; ds[4 * i + 3] = t4.w; }
            LDS_WAIT();
            const float* bg = a.in(I_MBG) + layer * 4; const float* be = a.in(I_MBE) + layer * 16;
            float lg0 = ds[0] + bg[0], lg1 = ds[1] + bg[1], lg2 = ds[2] + bg[2], lg3 = ds[3] + bg[3];
            int g = 0; float mx = lg0;
            if (lg1 > mx) { mx = lg1; g = 1; } if (lg2 > mx) { mx = lg2; g = 2; } if (lg3 > mx) { mx = lg3; g = 3; }
            const float den = fast_exp(lg0 - mx) + fast_exp(lg1 - mx) + fast_exp(lg2 - mx) + fast_exp(lg3 - mx);
            const float pgrp = 1.0f / den;
            float s0 = g == 0 ? ds[4] : g == 1 ? ds[8] : g == 2 ? ds[12] : ds[16];
            float s1 = g == 0 ? ds[5] : g == 1 ? ds[9] : g == 2 ? ds[13] : ds[17];
            float s2 = g == 0 ? ds[6] : g == 1 ? ds[10] : g == 2 ? ds[14] : ds[18];
            float s3 = g == 0 ? ds[7] : g == 1 ? ds[11] : g == 2 ? ds[15] : ds[19];
            s0 += be[g * 4 + 0]; s1 += be[g * 4 + 1]; s2 += be[g * 4 + 2]; s3 += be[g * 4 + 3];
            int i0 = 0; float v0 = s0;
            if (s1 > v0) { v0 = s1; i0 = 1; } if (s2 > v0) { v0 = s2; i0 = 2; } if (s3 > v0) { v0 = s3; i0 = 3; }
            int i1 = -1; float v1 = -3.0e38f;
            if (i0 != 0 && s0 > v1) { v1 = s0; i1 = 0; } if (i0 != 1 && s1 > v1) { v1 = s1; i1 = 1; } if (i0 != 2 && s2 > v1) { v1 = s2; i1 = 2; } if (i0 != 3 && s3 > v1) { v1 = s3; i1 = 3; }
            const float e1 = fast_exp(v1 - v0), pt0 = 1.0f / (1.0f + e1), pt1 = e1 * pt0;
            if (dry) { float sink = pgrp * pt0 + pt1; asm volatile("" :: "v"(sink)); }
            if (lane == 0 && !dry) {
                const int ea = g * 4 + i0, eb = g * 4 + i1;
                const int la = atomicAdd((int*)&lcnt[ea], 1), lb = atomicAdd((int*)&lcnt[eb], 1);
                int* tk = (int*)(ws + WS_TOK) + (size_t)m * 8;
                tk[0] = ea; tk[1] = eb; tk[2] = __float_as_int(pgrp * pt0); tk[3] = __float_as_int(pgrp * pt1); tk[4] = la; tk[5] = lb;
            }
        }
    }
    __syncthreads();
#undef NRM_LOAD
#undef NRM_VALID
    if (MODE == 2 && F.tid < 16 && !dry) {
        const int c = lcnt[F.tid];
        ((int*)(ws + WS_WGCNT))[F.bx * 16 + F.tid] = c;
        atomicAdd((int*)(ws + WS_CTL) + CW_ECNT + 64 * layer + F.tid, c);
    }
    __syncthreads();
}

__device__ __forceinline__ void phase_norm2(const ArgsL& a, Frame& F, int layer, const bool dry = false) {
    const int lane = F.lane, wave = F.wave;
    constexpr int TP = 2064;
    LAS unsigned char* TH = F.lds;
    LAS unsigned char* TLo = F.lds + 16 * TP;
    LAS float* PS = (LAS float*)(F.lds + 66048);
    LAS float* LG = (LAS float*)(F.lds + 82432);
    LAS int* lcnt = (LAS int*)(F.lds + 84480);
    LAS float* gl = (LAS float*)(F.lds + 86016);
    LAS float* bl = (LAS float*)(F.lds + 90112);
    unsigned char* ws = a.ws;
    bf16x8 bh_[4][2], bo_[4][2];
    {
        const float* wg = a.in(I_MWG) + (size_t)layer * D * 4; const float* we = a.in(I_MWE) + (size_t)layer * D * 16;
        const int q = lane >> 4, c16 = lane & 15, k0 = wave * 128;
#pragma unroll
        for (int ks = 0; ks < 4; ++ks)
#pragma unroll
            for (int ct = 0; ct < 2; ++ct) { float f[8];
#pragma unroll
                for (int j = 0; j < 8; ++j) { const int k = k0 + 32 * ks + 8 * q + j, col = 16 * ct + c16;
                    f[j] = col < 4 ? wg[(size_t)k * 4 + col] : col < 20 ? we[(size_t)k * 16 + (col - 4)] : 0.f; }
                unsigned hp[4], lp[4];
#pragma unroll
                for (int j2 = 0; j2 < 4; ++j2) { hp[j2] = pk2(f[2 * j2], f[2 * j2 + 1]); lp[j2] = pk2(f[2 * j2] - bf_lo(hp[j2]), f[2 * j2 + 1] - bf_hi(hp[j2])); }
                bh_[ks][ct] = __builtin_bit_cast(bf16x8, (u32x4){hp[0], hp[1], hp[2], hp[3]}); bo_[ks][ct] = __builtin_bit_cast(bf16x8, (u32x4){lp[0], lp[1], lp[2], lp[3]}); }
    }
    if (F.tid < 16) lcnt[F.tid] = 0;
    for (int i = F.tid; i < 1024; i += NTHR) gl[i] = a.in(I_N2G)[layer * D + i];
    if (F.tid < 4) bl[F.tid] = a.in(I_MBG)[layer * 4 + F.tid];
    if (F.tid >= 64 && F.tid < 80) bl[4 + F.tid - 64] = a.in(I_MBE)[layer * 16 + F.tid - 64];
    __syncthreads();
    const int gw = F.bx * NWAVES + wave, NGW = gridDim.x * NWAVES;
    bf16_t* A = A_PTR(a); const bf16_t* HB = HB_PTR(a);
#define N2_VALID(mm) ((mm) < M && ((mm) % T) >= PADR)
    constexpr int NR = 2;
    for (int m0 = gw; m0 < M; m0 += NR * NGW) {
        f32x4 v[NR][4];
#pragma unroll
        for (int rr = 0; rr < NR; ++rr) { const int mm_ = m0 + rr * NGW;
            if (N2_VALID(mm_)) { const u32x2* hs_ = (const u32x2*)(HB + (size_t)mm_ * D) + lane;
#pragma unroll
                for (int j = 0; j < 4; ++j) { const u32x2 t = hs_[64 * j]; v[rr][j] = (f32x4){bf_lo(t.x), bf_hi(t.x), bf_lo(t.y), bf_hi(t.y)}; } }
            else {
#pragma unroll
                for (int j = 0; j < 4; ++j) v[rr][j] = (f32x4){0.f, 0.f, 0.f, 0.f}; } }
        float ss[NR];
#pragma unroll
        for (int rr = 0; rr < NR; ++rr) { float s_ = 0.f;
#pragma unroll
            for (int j = 0; j < 4; ++j) s_ += (v[rr][j].x * v[rr][j].x + v[rr][j].y * v[rr][j].y) + (v[rr][j].z * v[rr][j].z + v[rr][j].w * v[rr][j].w);
            ss[rr] = s_; }
#pragma unroll
        for (int rr = 0; rr < NR; ++rr) ss[rr] = wave_sum(ss[rr]);
#pragma unroll
        for (int rr = 0; rr < NR; ++rr) { const int mm = m0 + rr * NGW; const float r = 1.0f / sqrtf(ss[rr] * (1.0f / D) + 1e-6f);
            LAS unsigned char* th = TH + (2 * wave + rr) * TP + lane * 8; LAS unsigned char* tl = TLo + (2 * wave + rr) * TP + lane * 8;
#pragma unroll
            for (int j = 0; j < 4; ++j) { v[rr][j] = v[rr][j] * r * *(const LAS f32x4*)(gl + 4 * lane + 256 * j);
                const u32x2 hp = {pk2(v[rr][j].x, v[rr][j].y), pk2(v[rr][j].z, v[rr][j].w)};
                const u32x2 lp = {pk2(v[rr][j].x - bf_lo(hp.x), v[rr][j].y - bf_hi(hp.x)), pk2(v[rr][j].z - bf_lo(hp.y), v[rr][j].w - bf_hi(hp.y))};
                *(LAS u32x2*)(th + 512 * j) = hp; *(LAS u32x2*)(tl + 512 * j) = lp;
                if (N2_VALID(mm) && !dry) ((u32x2*)(A + (size_t)mm * D) + lane)[64 * j] = hp; } }
        __syncthreads();
        { const int q = lane >> 4, c16 = lane & 15;
          f32x4 acc[2] = {{0.f, 0.f, 0.f, 0.f}, {0.f, 0.f, 0.f, 0.f}};
#pragma unroll
          for (int ks = 0; ks < 4; ++ks) { const int ko = (wave * 128 + 32 * ks + 8 * q) * 2;
              const bf16x8 ah = *(const LAS bf16x8*)(TH + c16 * TP + ko), al = *(const LAS bf16x8*)(TLo + c16 * TP + ko);
#pragma unroll
              for (int ct = 0; ct < 2; ++ct) {
                  acc[ct] = __builtin_amdgcn_mfma_f32_16x16x32_bf16(ah, bh_[ks][ct], acc[ct], 0, 0, 0);
                  acc[ct] = __builtin_amdgcn_mfma_f32_16x16x32_bf16(al, bh_[ks][ct], acc[ct], 0, 0, 0);
                  acc[ct] = __builtin_amdgcn_mfma_f32_16x16x32_bf16(ah, bo_[ks][ct], acc[ct], 0, 0, 0); } }
#pragma unroll
          for (int ct = 0; ct < 2; ++ct)
#pragma unroll
              for (int rg = 0; rg < 4; ++rg) PS[(wave * 16 + 4 * q + rg) * 32 + 16 * ct + c16] = acc[ct][rg]; }
        __syncthreads();
        { const int t_ = F.tid; float s_ = 0.f;
#pragma unroll
          for (int w = 0; w < 8; ++w) s_ += PS[w * 512 + t_];
          LG[t_] = s_; }
        __syncthreads();
        if (F.tid < 16) {
            const int t = F.tid, mm = (int)F.bx * NWAVES + (t >> 1) + ((m0 - gw) + (t & 1) * NGW);
            float ds[20];
#pragma unroll
            for (int i = 0; i < 5; ++i) { const f32x4 t4 = *(const LAS f32x4*)(LG + t * 32 + 4 * i); ds[4 * i] = t4.x; ds[4 * i + 1] = t4.y; ds[4 * i + 2] = t4.z; ds[4 * i + 3] = t4.w; }
            const float lg0 = ds[0] + bl[0], lg1 = ds[1] + bl[1], lg2 = ds[2] + bl[2], lg3 = ds[3] + bl[3];
            int g = 0; float mx = lg0;
            if (lg1 > mx) { mx = lg1; g = 1; } if (lg2 > mx) { mx = lg2; g = 2; } if (lg3 > mx) { mx = lg3; g = 3; }
            const float den = fast_exp(lg0 - mx) + fast_exp(lg1 - mx) + fast_exp(lg2 - mx) + fast_exp(lg3 - mx);
            const float pgrp = 1.0f / den;
            const f32x4 be4 = *(const LAS f32x4*)(bl + 4 + 4 * g);
            float s0 = (g == 0 ? ds[4] : g == 1 ? ds[8] : g == 2 ? ds[12] : ds[16]) + be4.x;
            float s1 = (g == 0 ? ds[5] : g == 1 ? ds[9] : g == 2 ? ds[13] : ds[17]) + be4.y;
            float s2 = (g == 0 ? ds[6] : g == 1 ? ds[10] : g == 2 ? ds[14] : ds[18]) + be4.z;
            float s3 = (g == 0 ? ds[7] : g == 1 ? ds[11] : g == 2 ? ds[15] : ds[19]) + be4.w;
            int i0 = 0; float v0 = s0;
            if (s1 > v0) { v0 = s1; i0 = 1; } if (s2 > v0) { v0 = s2; i0 = 2; } if (s3 > v0) { v0 = s3; i0 = 3; }
            int i1 = -1; float v1 = -3.0e38f;
            if (i0 != 0 && s0 > v1) { v1 = s0; i1 = 0; } if (i0 != 1 && s1 > v1) { v1 = s1; i1 = 1; } if (i0 != 2 && s2 > v1) { v1 = s2; i1 = 2; } if (i0 != 3 && s3 > v1) { v1 = s3; i1 = 3; }
            const float e1 = fast_exp(v1 - v0), pt0 = 1.0f / (1.0f + e1), pt1 = e1 * pt0;
            if (N2_VALID(mm) && !dry) {
                const int ea = g * 4 + i0, eb = g * 4 + i1;
                const int la = atomicAdd((int*)&lcnt[ea], 1), lb = atomicAdd((int*)&lcnt[eb], 1);
                int* tk = (int*)(ws + WS_TOK) + (size_t)mm * 8;
                tk[0] = ea; tk[1] = eb; tk[2] = __float_as_int(pgrp * pt0); tk[3] = __float_as_int(pgrp * pt1); tk[4] = la; tk[5] = lb;
            }
        }
    }
#undef N2_VALID
    __syncthreads();
    if (F.tid < 16 && !dry) {
        const int c = lcnt[F.tid];
        ((int*)(ws + WS_WGCNT))[F.bx * 16 + F.tid] = c;
        atomicAdd((int*)(ws + WS_CTL) + CW_ECNT + 64 * layer + F.tid, c);
    }
    __syncthreads();
}

__device__ __forceinline__ void phase_route(const ArgsL& a, Frame& F, int layer) {
    unsigned char* ws = a.ws;
    LAS int* tbl = (LAS int*)F.lds;
    LAS int* part = tbl + 16;
    {
        const int e = F.tid & 15, q = F.tid >> 4; const int* wc = (const int*)(ws + WS_WGCNT); int acc = 0;
#pragma unroll
        for (int i = 0; i < 8; ++i) { const int w = q + 32 * i; if (w < (int)F.bx) acc += wc[w * 16 + e]; }
        part[q * 16 + e] = acc;
    }
    __syncthreads();
    if (F.tid < 16) {
        const int* cnt = (const int*)(ws + WS_CTL) + CW_ECNT + 64 * layer;
        int cv[16];
#pragma unroll
        for (int e = 0; e < 16; ++e) cv[e] = __hip_atomic_load(cnt + e, __ATOMIC_RELAXED, __HIP_MEMORY_SCOPE_AGENT);
        int base = 0;
#pragma unroll
        for (int e = 0; e < 16; ++e) if (e < F.tid) base += ((cv[e] + 255) >> 8) << 8;
#pragma unroll
        for (int q = 0; q < 32; ++q) base += part[q * 16 + F.tid];
        tbl[F.tid] = base; tbl[16 + 512 + F.tid] = __hip_atomic_load(cnt + F.tid, __ATOMIC_RELAXED, __HIP_MEMORY_SCOPE_AGENT);
    }
    __syncthreads();
    if (F.bx == 0) {
        int* s2t = (int*)(ws + WS_S2T);
        for (int e = 0; e < 16; ++e) { const int n = tbl[16 + 512 + e], b0 = tbl[e] + n, pad = (((n + 255) >> 8) << 8) - n;
            for (int i = F.tid; i < pad; i += NTHR) s2t[b0 + i] = 0; }
    }
    int* s2t = (int*)(ws + WS_S2T);
    for (int j = F.tid; j < 8 * ((M + 2047) / 2048); j += NTHR) {
        const int m = (j >> 3) * 2048 + (int)F.bx * 8 + (j & 7);
        if (m >= M) continue;
        const int b = m / T, p = m - b * T;
        if (p < PADR) continue;
        const int* tk_ = (const int*)(ws + WS_TOK) + (size_t)m * 8;
        const u32x4 t4 = *(const u32x4*)tk_; const u32x2 t2 = *(const u32x2*)(tk_ + 4);
        const int ea = (int)t4.x, eb = (int)t4.y, sa = tbl[ea] + (int)t2.x, sb = tbl[eb] + (int)t2.y;
        s2t[sa] = m; s2t[sb] = m;
        int* sl = (int*)(ws + WS_SLOT) + 2 * m; sl[0] = sa; sl[1] = sb;
        float* cw = (float*)(ws + WS_CWS); cw[sa] = __uint_as_float(t4.z); cw[sb] = __uint_as_float(t4.w);
    }
    __syncthreads();
}

#ifndef PR_STAGES
#define PR_STAGES 15
#endif
__device__ __forceinline__ void phase_prep(const ArgsL& a, Frame& F, int layer, const unsigned* g1cnt, unsigned* qhead, const bool dry = false) {
    unsigned char* ws = a.ws;
    LAS float* xs = (LAS float*)F.lds;
    const int wave = F.wave, lane = F.lane, tid = F.tid;
    const bf16_t* USH = (const bf16_t*)(ws + WS_USH);
    bf16_t* QKV = (bf16_t*)(ws + WS_QKV);
    if (F.bx < 10 && (!dry || (PR_STAGES & 8))) {
        const int bh = F.bx, b = bh / 5, h = bh % 5;
        const float* LOGF = (const float*)(ws + WS_LOGF) + (size_t)(b * T + PADR) * 8 + h;
        float* kb = (float*)(ws + WS_KB2) + (size_t)bh * KBP;
        LAS float* wtot = (LAS float*)F.lds;
        float v[33];
        const int l0 = tid * 33;
#pragma unroll
        for (int i = 0; i < 33; ++i) v[i] = (l0 + i < LTOK) ? LOGF[(size_t)(l0 + i) * 8] : 0.f;
#pragma unroll
        for (int i = 1; i < 33; ++i) v[i] += v[i - 1];
        float incl = v[32];
#pragma unroll
        for (int o = 1; o < 64; o <<= 1) { const float t = __shfl_up(incl, o); if (lane >= o) incl += t; }
        if (lane == 63) wtot[wave] = incl;
        __syncthreads();
        float off = incl - v[32];
        for (int w = 0; w < wave; ++w) off += wtot[w];
#pragma unroll
        for (int i = 0; i < 33; ++i) if (l0 + i < LTOK && !dry) kb[PADR + l0 + i] = -(off + v[i]) * LOG2E;
        for (int p = tid; p < PADR; p += NTHR) kb[p] = 0.f;
        for (int p = T + tid; p < KBP; p += NTHR) kb[p] = 0.f;
        __syncthreads();
    }
    if (F.bx >= 16 && F.bx < 28) {
        unsigned* z = (unsigned*)(ws + WS_RW + ((size_t)(F.bx - 16) * LPADDED + LTOK) * 768);
        for (int i = tid; i < (LPADDED - LTOK) * 192; i += NTHR) z[i] = 0u;
    }
    const int r16 = lane & 15, q4 = lane >> 4, hh = wave < 6 ? wave : 0;
    bf16x8 bw[2][4][2];
    float cw0[4], ca0[4], ckk[4], cka[4], crk[4];
    {
        const float* WUp = a.in(I_WUP) + (size_t)layer * 64 * RW_W + hh * 64 + r16; const float* AUp = a.in(I_AUP) + (size_t)layer * 64 * RW_W + hh * 64 + r16;
#pragma unroll
        for (int mtx = 0; mtx < 2; ++mtx)
#pragma unroll
            for (int blk = 0; blk < 4; ++blk)
#pragma unroll
                for (int ks = 0; ks < 2; ++ks) { const float* p_ = (mtx ? AUp : WUp) + (size_t)(32 * ks + 8 * q4) * RW_W + blk * 16;
                    const float f0 = p_[0], f1 = p_[RW_W], f2 = p_[2 * RW_W], f3 = p_[3 * RW_W], f4 = p_[4 * RW_W], f5 = p_[5 * RW_W], f6 = p_[6 * RW_W], f7 = p_[7 * RW_W];
                    bw[mtx][blk][ks] = __builtin_bit_cast(bf16x8, (u32x4){pk2(f0, f1), pk2(f2, f3), pk2(f4, f5), pk2(f6, f7)}); }
#pragma unroll
        for (int blk = 0; blk < 4; ++blk) { const int ch = layer * RW_W + hh * 64 + blk * 16 + r16;
            cw0[blk] = a.in(I_W0)[ch]; ca0[blk] = a.in(I_A0)[ch]; ckk[blk] = a.in(I_KK)[ch]; cka[blk] = a.in(I_KA)[ch]; crk[blk] = a.in(I_RK)[ch]; }
    }
    const float* mu = a.in(I_MU) + layer * SHIFT_W;
    f32x4 gq4 = *(const f32x4*)(a.in(I_QG) + layer * 64 + (lane & 15) * 4) * C2; const f32x4 gk4 = *(const f32x4*)(a.in(I_KG) + layer * 64 + (lane & 15) * 4);
    _Float16* RW = (_Float16*)(ws + WS_RW);
    bf16_t* BN = (bf16_t*)(ws + WS_BN);
    constexpr int nt = 16, t0 = 0;
    for (;;) {
        if (F.tid == 0) {
            const int j = (int)__hip_atomic_fetch_add(qhead, 1u, __ATOMIC_RELAXED, __HIP_MEMORY_SCOPE_AGENT);
            int bt = -1;
            if (j < 2064) { int p; if (j < 1024) { const int e = j >> 4; p = (e >> 3) * 16 + (e & 7); } else { const int l = (j - 1024) >> 4; p = l < 64 ? (l >> 3) * 16 + 8 + (l & 7) : 128; }
                bt = p * 16 + (j & 15);
                if (bt < 7 || (bt >= 1032 && bt < 1039)) bt = -2;
                else if (!dry) { unsigned polls = 0;
                    while (__hip_atomic_load(g1cnt + CH_STRIDE * p, __ATOMIC_RELAXED, __HIP_MEMORY_SCOPE_AGENT) < 104u) { if (++polls > (1u << 18)) break; __builtin_amdgcn_s_sleep(2); }
                    if ((bt & 15) == 0 && p > 0) { polls = 0;
                        while (__hip_atomic_load(g1cnt + CH_STRIDE * (p - 1), __ATOMIC_RELAXED, __HIP_MEMORY_SCOPE_AGENT) < 104u) { if (++polls > (1u << 18)) break; __builtin_amdgcn_s_sleep(2); } }
                    __builtin_amdgcn_fence(__ATOMIC_ACQUIRE, "agent"); asm volatile("s_waitcnt vmcnt(0)" ::: "memory"); } }
            F.MISC[18] = (unsigned)bt; }
        __syncthreads();
        const int bt_ = (int)F.MISC[18];
        __syncthreads();
        if (bt_ == -1) break;
        if (bt_ == -2) continue;
        const int m0 = bt_ * 16;
        if (!dry || (PR_STAGES & 1)) {
            int tid = F.tid; asm volatile("" : "+v"(tid));
            u32x4 uu4[5], pp4[5];
#pragma unroll
            for (int q5 = 0; q5 < 5; ++q5) { const int item = tid + q5 * NTHR; uu4[q5] = (u32x4){0u, 0u, 0u, 0u}; pp4[q5] = (u32x4){0u, 0u, 0u, 0u};
                if (item < nt * 160) { const int tok = item / 160, ch = item - tok * 160, m = m0 + t0 + tok;
                    uu4[q5] = *(const u32x4*)(USH + (size_t)m * SHIFT_W + ch * 8);
                    if (m > 0) pp4[q5] = *(const u32x4*)(USH + (size_t)(m - 1) * SHIFT_W + ch * 8); } }
#pragma unroll
            for (int q5 = 0; q5 < 5; ++q5) { const int item = tid + q5 * NTHR;
                if (item < nt * 160) { const int tok = item / 160, ch = item - tok * 160;
                    const u32x4 u = uu4[q5], pv = pp4[q5];
                    const f32x4 mu0 = *(const f32x4*)(mu + ch * 8), mu1 = *(const f32x4*)(mu + ch * 8 + 4);
                    float x[8];
                    { float uu, pp;
                      uu = bf_lo(u.x); pp = bf_lo(pv.x); x[0] = uu + (pp - uu) * mu0.x;  uu = bf_hi(u.x); pp = bf_hi(pv.x); x[1] = uu + (pp - uu) * mu0.y;
                      uu = bf_lo(u.y); pp = bf_lo(pv.y); x[2] = uu + (pp - uu) * mu0.z;  uu = bf_hi(u.y); pp = bf_hi(pv.y); x[3] = uu + (pp - uu) * mu0.w;
                      uu = bf_lo(u.z); pp = bf_lo(pv.z); x[4] = uu + (pp - uu) * mu1.x;  uu = bf_hi(u.z); pp = bf_hi(pv.z); x[5] = uu + (pp - uu) * mu1.y;
                      uu = bf_lo(u.w); pp = bf_lo(pv.w); x[6] = uu + (pp - uu) * mu1.z;  uu = bf_hi(u.w); pp = bf_hi(pv.w); x[7] = uu + (pp - uu) * mu1.w; }
                    if (ch >= 144 && ch < 152) {
#pragma unroll
                        for (int q = 0; q < 8; ++q) { const float e = fast_exp(-2.f * fabsf(x[q])); const float th = (1.f - e) / (1.f + e); x[q] = x[q] < 0.f ? -th : th; }
                    }
                    LAS f32x4* d = (LAS f32x4*)(xs + tok * SHIFT_W + ch * 8);
                    d[0] = (f32x4){x[0], x[1], x[2], x[3]}; d[1] = (f32x4){x[4], x[5], x[6], x[7]}; } }
        }
        __syncthreads();
        if (wave < 6) { if (!dry || (PR_STAGES & 2)) {
            f32x4 acc[2][4];
#pragma unroll
            for (int mtx = 0; mtx < 2; ++mtx) {
                bf16x8 af[2];
#pragma unroll
                for (int ks = 0; ks < 2; ++ks) { const LAS float* xp = xs + r16 * SHIFT_W + 1152 + 64 * mtx + 32 * ks + 8 * q4;
                    const f32x4 u0 = *(const LAS f32x4*)xp, u1 = *(const LAS f32x4*)(xp + 4);
                    af[ks] = __builtin_bit_cast(bf16x8, (u32x4){pk2(u0.x, u0.y), pk2(u0.z, u0.w), pk2(u1.x, u1.y), pk2(u1.z, u1.w)}); }
#pragma unroll
                for (int blk = 0; blk < 4; ++blk) { f32x4 c4 = {0.f, 0.f, 0.f, 0.f};
                    c4 = __builtin_amdgcn_mfma_f32_16x16x32_bf16(af[0], bw[mtx][blk][0], c4, 0, 0, 0);
                    c4 = __builtin_amdgcn_mfma_f32_16x16x32_bf16(af[1], bw[mtx][blk][1], c4, 0, 0, 0);
                    acc[mtx][blk] = c4; }
            }
#pragma unroll
            for (int i = 0; i < 4; ++i) {
                const int tok = 4 * q4 + i, m = m0 + t0 + tok, b = m / T, p = m - b * T, l = p - PADR;
                const bool ok = (tok < nt) && (l >= 0);
                const LAS float* xr = xs + (tok < 16 ? tok : 0) * SHIFT_W + hh * 64 + r16;
                float kkr[4], kpv[4], avv4[4], omv[4], rv4[4], vv4[4];
                float ssq = 0.f, cf = 0.f;
#pragma unroll
                for (int blk = 0; blk < 4; ++blk) {
                    const float wlv = cw0[blk] + acc[0][blk][i], alv = ca0[blk] + acc[1][blk][i];
                    const float r = xr[blk * 16], k = xr[384 + blk * 16], v = xr[768 + blk * 16];
                    const float logw = -softplus_f(-wlv) - 0.5f;
                    const float xw = fast_exp(logw);
                    omv[blk] = xw < 0.02f ? xw * (1.f - 0.5f * xw + xw * xw * (1.f / 6.f)) : 1.f - fast_exp(-xw);
                    const float av = 1.f / (1.f + fast_exp(-alv));
                    kkr[blk] = k * ckk[blk]; kpv[blk] = k * (1.f + (av - 1.f) * cka[blk]); avv4[blk] = av; rv4[blk] = r; vv4[blk] = v;
                    ssq += kkr[blk] * kkr[blk]; cf += r * kpv[blk] * crk[blk];
                }
                ssq = allred16(ssq); cf = allred16(cf);
                const float inv = 1.0f / fmaxf(sqrtf(ssq), 1e-12f);
                if (ok && !dry) {
                    _Float16* o = RW + ((size_t)(b * RW_H + hh) * LPADDED + l) * 384 + r16;
#pragma unroll
                    for (int blk = 0; blk < 4; ++blk) { const float kk = kkr[blk] * inv, bb = kk * avv4[blk];
                        o[blk * 16] = (_Float16)kk; o[64 + blk * 16] = (_Float16)(-omv[blk]); o[128 + blk * 16] = (_Float16)(-bb); o[192 + blk * 16] = (_Float16)kpv[blk];
                        o[256 + blk * 16] = (_Float16)rv4[blk]; o[320 + blk * 16] = (_Float16)vv4[blk];
                        BN[(size_t)m * RW_W + hh * 64 + blk * 16 + r16] = f2bf(cf * vv4[blk]); }
                } else { float sink = ssq + cf + inv + omv[0] + kpv[1]; asm volatile("" :: "v"(sink)); }
            } }
        }
        if (!dry || (PR_STAGES & 4)) {
            const int it4 = lane >> 4, e4 = lane & 15;
            u32x2 xv[5]; bf16_t* qp5[5]; bool okv[5];
#pragma unroll
            for (int ps = 0; ps < 5; ++ps) { const int item = (ps * 8 + wave) * 4 + it4, tok = item / 10, hq = item - tok * 10;
                const int m = m0 + t0 + tok, p = m % T;
                okv[ps] = (tok < nt) && (p >= PADR);
                qp5[ps] = QKV + (size_t)m * QKV_W + 960 + hq * 64 + e4 * 4;
                xv[ps] = okv[ps] ? *(const u32x2*)qp5[ps] : (u32x2){0u, 0u}; }
#pragma unroll
            for (int ps = 0; ps < 5; ++ps) { const int item = (ps * 8 + wave) * 4 + it4, hq = item % 10;
                const float x0 = bf_lo(xv[ps].x), x1 = bf_hi(xv[ps].x), x2 = bf_lo(xv[ps].y), x3 = bf_hi(xv[ps].y);
                const float ss = allred16((x0 * x0 + x1 * x1) + (x2 * x2 + x3 * x3));
                const float rs = 1.0f / sqrtf(ss * (1.0f / 64.f) + 1e-6f);
                const f32x4 gg = hq < 5 ? gq4 : gk4;
                const u32x2 w = {pk2(x0 * rs * gg.x, x1 * rs * gg.y), pk2(x2 * rs * gg.z, x3 * rs * gg.w)};
                if (okv[ps] && !dry) *(u32x2*)qp5[ps] = w; else asm volatile("" :: "v"(w.x), "v"(w.y)); }
        }
        __syncthreads();
    }
}


constexpr int SCH = 16;
static_assert(LTOK % SCH == 0, "whole chunks");
__device__ __forceinline__ void rwkv_scan(const ArgsL& a, Frame& F, int wgi, int dry = 0) {
    const int bh = wgi >> 4, q8 = wgi & 15, b = bh / RW_H, h = bh % RW_H;
    const int tid = F.tid, wave = F.wave, lane = F.lane;
    const unsigned char* rw = a.ws + WS_RW + (size_t)bh * LPADDED * 768;
    LAS float* ring = (LAS float*)F.lds;
    LAS float* ypart = (LAS float*)(F.lds + 49152);
    LAS unsigned char* stg = F.lds + 81920;
    bf16_t* y0 = (bf16_t*)(a.ws + WS_YCAT);
    constexpr int NCH = LTOK / SCH;
    const bool isld = (wave & 2) != 0; const int lw = (wave & 1) + ((wave >> 2) << 1), tl = lw * 64 + lane;
    float s0 = 0.f, s1 = 0.f;
    const int i32 = lane & 31, rsel = lane >> 5, rloc = 2 * wave + rsel;
#define RW_BAR() asm volatile("s_waitcnt lgkmcnt(0)\n\ts_barrier" ::: "memory")
#define RW_ISSUE(cc) do { const unsigned char* src_ = rw + (size_t)(cc) * SCH * 768 + (size_t)tl * 16; LAS unsigned char* d_ = stg + ((cc) & 3) * 12288 + lw * 1024; \
        _Pragma("unroll") for (int k_ = 0; k_ < 3; ++k_) __builtin_amdgcn_global_load_lds((const unsigned*)(src_ + k_ * 4096), (LAS unsigned*)(d_ + k_ * 4096), 16, 0, 0); } while (0)
#define RW_CONVERT(cc) do { const LAS unsigned char* s_ = stg + ((cc) & 3) * 12288 + tl * 16; LAS float* rb_ = ring + ((cc) & 1) * 6144; \
        _Pragma("unroll") for (int k_ = 0; k_ < 3; ++k_) { const int pc_ = tl + 256 * k_; const int t_ = pc_ / 48, q_ = pc_ - t_ * 48, vec_ = q_ >> 3, e0_ = (q_ & 7) * 8; \
            const u32x4 w_ = *(const LAS u32x4*)(s_ + k_ * 4096); \
            const f16x4 lo_ = __builtin_bit_cast(f16x4, (u32x2){w_.x, w_.y}), hi_ = __builtin_bit_cast(f16x4, (u32x2){w_.z, w_.w}); \
            const float f0 = (float)lo_.x, f1 = (float)lo_.y, f2 = (float)lo_.z, f3 = (float)lo_.w, f4 = (float)hi_.x, f5 = (float)hi_.y, f6 = (float)hi_.z, f7 = (float)hi_.w; \
            if (vec_ < 4) { LAS float* d_ = rb_ + t_ * 384 + (vec_ >> 1) * 128 + (e0_ >> 1) * 4 + (vec_ & 1) * 2; \
                *(LAS f32x2*)(d_) = (f32x2){f0, f1}; *(LAS f32x2*)(d_ + 4) = (f32x2){f2, f3}; *(LAS f32x2*)(d_ + 8) = (f32x2){f4, f5}; *(LAS f32x2*)(d_ + 12) = (f32x2){f6, f7}; } \
            else { LAS f32x4* d_ = (LAS f32x4*)(rb_ + t_ * 384 + (vec_ == 4 ? 256 : 320) + e0_); d_[0] = (f32x4){f0, f1, f2, f3}; d_[1] = (f32x4){f4, f5, f6, f7}; } } } while (0)
#define RW_STORE_Y(cc) do { if (tl < 32) { const LAS float* yb_ = ypart + ((cc) & 1) * 4096; const int t_ = tl >> 1, pr_ = tl & 1; const int l_ = (cc) * SCH + t_; \
        const LAS f32x4* q_ = (const LAS f32x4*)(yb_ + t_ * 128 + pr_ * 64); f32x4 sa_ = q_[0], sb_ = q_[8]; \
        _Pragma("unroll") for (int k_ = 1; k_ < 8; ++k_) { sa_ = sa_ + q_[k_]; sb_ = sb_ + q_[8 + k_]; } \
        *(unsigned*)(y0 + (size_t)(b * T + PADR + l_) * RW_W + h * 64 + q8 * 4 + 2 * pr_) = pk2((sa_.x + sa_.y) + (sa_.z + sa_.w), (sb_.x + sb_.y) + (sb_.z + sb_.w)); } } while (0)
    if (isld) {
        RW_ISSUE(0); asm volatile("s_waitcnt vmcnt(0)" ::: "memory"); RW_CONVERT(0);
        RW_ISSUE(1); RW_ISSUE(2);
    }
    RW_BAR();
    for (int c = 0; c < NCH; ++c) {
        if (isld) {
            if (c + 2 < NCH) { asm volatile("s_waitcnt vmcnt(3)" ::: "memory"); RW_CONVERT(c + 1); }
            else if (c + 1 < NCH) { asm volatile("s_waitcnt vmcnt(0)" ::: "memory"); RW_CONVERT(c + 1); }
            if (c > 0 && !dry) RW_STORE_Y(c - 1);
            if (c + 3 < NCH) RW_ISSUE(c + 3);
        } else if (dry != 1 && wave < 2) {
            const unsigned ba = (unsigned)(uintptr_t)(ring + (c & 1) * 6144) + i32 * 16, ca = (unsigned)(uintptr_t)(ring + (c & 1) * 6144) + 1024 + i32 * 8,
                           va = (unsigned)(uintptr_t)(ring + (c & 1) * 6144) + 1280 + (q8 * 4 + rloc) * 4, ya = (unsigned)(uintptr_t)(ypart + (c & 1) * 4096 + rloc * 32 + i32);
            f32x4 OA[4], OB[4]; f32x2 OC[4]; float OV[4];
            OC[3] = (f32x2){0.f, 0.f};
#define RW_FETCH(tt, sl) asm volatile("ds_read_b128 %0, %4 offset:%c7\n\tds_read_b128 %1, %4 offset:%c8\n\tds_read_b64 %2, %5 offset:%c7\n\tds_read_b32 %3, %6 offset:%c7" \
                : "=&v"(OA[sl]), "=&v"(OB[sl]), "=&v"(OC[sl]), "=&v"(OV[sl]) : "v"(ba), "v"(ca), "v"(va), "i"((tt) * 1536), "i"((tt) * 1536 + 512) : "memory")
            RW_FETCH(0, 0); RW_FETCH(1, 1);
            float p, p2, y;
#define RW_STEP(t, WAITN, YL1, YL2, YW, FETCHL) asm volatile( \
                "s_waitcnt lgkmcnt(" WAITN ")\n\t" \
                "v_mul_f32 %[p], %[s0], %[kk0]\n\t" \
                "v_fmac_f32 %[p], %[s1], %[kk1]\n\t" \
                YL1 "\n\t" YL2 "\n\t" \
                XL8 "\n\t" \
                "v_fmac_f32 %[s0], %[s0], %[om0]\n\t" \
                "v_fmac_f32 %[s1], %[s1], %[om1]\n\t" \
                XL4 "\n\t" \
                "v_fmac_f32 %[s0], %[vf], %[kv0]\n\t" \
                "v_fmac_f32 %[s1], %[vf], %[kv1]\n\t" \
                XL2 "\n\t" \
                YW "\n\t" \
                FETCHL \
                : [p] "=&v"(p), [p2] "=&v"(p2), [y] "=&v"(y), [s0] "+v"(s0), [s1] "+v"(s1), [nA] "=&v"(OA[((t) + 2) & 3]), [nB] "=&v"(OB[((t) + 2) & 3]), [nC] "=&v"(OC[((t) + 2) & 3]), [nV] "=&v"(OV[((t) + 2) & 3]) \
                : [kk0] "v"(OA[(t) & 3].x), [kk1] "v"(OA[(t) & 3].y), [om0] "v"(OA[(t) & 3].z), [om1] "v"(OA[(t) & 3].w), [bb0] "v"(OB[(t) & 3].x), [bb1] "v"(OB[(t) & 3].y), [kv0] "v"(OB[(t) & 3].z), [kv1] "v"(OB[(t) & 3].w), \
                  [vf] "v"(OV[(t) & 3]), [rp0] "v"(OC[((t) + 3) & 3].x), [rp1] "v"(OC[((t) + 3) & 3].y), [ba] "v"(ba), [ca] "v"(ca), [va] "v"(va), [ya] "v"(ya), \
                  [oa] "i"(((t) + 2) * 1536), [ob] "i"(((t) + 2) * 1536 + 512), [oy] "i"(((t) - 1) * 512) : "memory")
#define RW_YL1 "v_mul_f32 %[y], %[s0], %[rp0]"
#define RW_YL2 "v_fmac_f32 %[y], %[s1], %[rp1]"
#define RW_YW  "ds_write_b32 %[ya], %[y] offset:%c[oy]"
#define RW_NOP "s_nop 0"
#define RW_TAIL_F "ds_read_b128 %[nA], %[ba] offset:%c[oa]\n\t" \
                XL1 "\n\t" \
                "ds_read_b128 %[nB], %[ba] offset:%c[ob]\n\t" \
                "ds_read_b64 %[nC], %[ca] offset:%c[oa]\n\t" \
                "v_mov_b32 %[p2], %[p]\n\t" \
                "ds_read_b32 %[nV], %[va] offset:%c[oa]\n\t" \
                "s_nop 0\n\t" \
                XSW "\n\t" \
                "v_add_f32 %[p], %[p], %[p2]\n\t" \
                "v_fmac_f32 %[s0], %[p], %[bb0]\n\t" \
                "v_fmac_f32 %[s1], %[p], %[bb1]"
#define RW_TAIL_N "s_nop 0\n\t" \
                XL1 "\n\t" \
                "s_nop 1\n\t" \
                "v_mov_b32 %[p2], %[p]\n\t" \
                "s_nop 1\n\t" \
                XSW "\n\t" \
                "v_add_f32 %[p], %[p], %[p2]\n\t" \
                "v_fmac_f32 %[s0], %[p], %[bb0]\n\t" \
                "v_fmac_f32 %[s1], %[p], %[bb1]"
#define RW_ALLSTEPS() do { \
            RW_STEP(0, "4", RW_NOP, RW_NOP, RW_NOP, RW_TAIL_F); \
            RW_STEP(1, "4", RW_YL1, RW_YL2, RW_YW, RW_TAIL_F); \
            RW_STEP(2, "5", RW_YL1, RW_YL2, RW_YW, RW_TAIL_F);  RW_STEP(3, "5", RW_YL1, RW_YL2, RW_YW, RW_TAIL_F);  RW_STEP(4, "5", RW_YL1, RW_YL2, RW_YW, RW_TAIL_F); \
            RW_STEP(5, "5", RW_YL1, RW_YL2, RW_YW, RW_TAIL_F);  RW_STEP(6, "5", RW_YL1, RW_YL2, RW_YW, RW_TAIL_F);  RW_STEP(7, "5", RW_YL1, RW_YL2, RW_YW, RW_TAIL_F); \
            RW_STEP(8, "5", RW_YL1, RW_YL2, RW_YW, RW_TAIL_F);  RW_STEP(9, "5", RW_YL1, RW_YL2, RW_YW, RW_TAIL_F);  RW_STEP(10, "5", RW_YL1, RW_YL2, RW_YW, RW_TAIL_F); \
            RW_STEP(11, "5", RW_YL1, RW_YL2, RW_YW, RW_TAIL_F); RW_STEP(12, "5", RW_YL1, RW_YL2, RW_YW, RW_TAIL_F); RW_STEP(13, "5", RW_YL1, RW_YL2, RW_YW, RW_TAIL_F); \
            RW_STEP(14, "5", RW_YL1, RW_YL2, RW_YW, RW_TAIL_N); \
            RW_STEP(15, "1", RW_YL1, RW_YL2, RW_YW, RW_TAIL_N); \
            asm volatile("v_mul_f32 %[y], %[s0], %[r0]\n\tv_fmac_f32 %[y], %[s1], %[r1]\n\tds_write_b32 %[ya], %[y] offset:7680" : [y] "=&v"(y) : [s0] "v"(s0), [s1] "v"(s1), [r0] "v"(OC[3].x), [r1] "v"(OC[3].y), [ya] "v"(ya) : "memory"); \
 } while (0)
#ifdef SCAN_PROBE_NOXL
            if (dry == 2) {
#define XL8 "v_add_f32 %[p], %[p], %[p]"
#define XL4 "v_add_f32 %[p], %[p], %[p]"
#define XL2 "v_add_f32 %[p], %[p], %[p]"
#define XL1 "v_add_f32 %[p], %[p], %[p]"
#define XSW "v_add_f32 %[p], %[p], %[p2]"
                RW_ALLSTEPS();
#undef XL8
#undef XL4
#undef XL2
#undef XL1
#undef XSW
            } else
#endif
            {
#define XL8 "v_add_f32_dpp %[p], %[p], %[p] row_ror:8 row_mask:0xf bank_mask:0xf bound_ctrl:1"
#define XL4 "v_add_f32_dpp %[p], %[p], %[p] row_ror:4 row_mask:0xf bank_mask:0xf bound_ctrl:1"
#define XL2 "v_add_f32_dpp %[p], %[p], %[p] row_ror:2 row_mask:0xf bank_mask:0xf bound_ctrl:1"
#define XL1 "v_add_f32_dpp %[p], %[p], %[p] row_ror:1 row_mask:0xf bank_mask:0xf bound_ctrl:1"
#define XSW "v_permlane16_swap_b32 %[p], %[p2]"
                RW_ALLSTEPS();
            }
#undef RW_ALLSTEPS
#undef RW_STEP
#undef XL8
#undef XL4
#undef XL2
#undef XL1
#undef XSW
#undef RW_YL1
#undef RW_YL2
#undef RW_YW
#undef RW_NOP
#undef RW_TAIL_F
#undef RW_TAIL_N
#undef RW_FETCH
        }
        RW_BAR();
    }
    if (isld && !dry) RW_STORE_Y(NCH - 1);
    asm volatile("s_waitcnt vmcnt(0) lgkmcnt(0)\n\ts_barrier" ::: "memory");
#undef RW_STORE_Y
#undef RW_ISSUE
#undef RW_CONVERT
#undef RW_BAR
}

__device__ __forceinline__ int crow(int r, int hi) { return (r & 3) + 8 * (r >> 2) + 4 * hi; }
__device__ __forceinline__ void glds16(const void* gsrc, unsigned lds_dst) { unsigned keep;
    asm volatile("s_mov_b32 %0, m0\n\ts_mov_b32 m0, %2\n\ts_nop 0\n\tglobal_load_lds_dwordx4 %1, off\n\ts_mov_b32 m0, %0" : "=&s"(keep) : "v"(gsrc), "s"(lds_dst) : "memory"); }
__device__ __forceinline__ void glds4(const void* gsrc, unsigned lds_dst) { unsigned keep;
    asm volatile("s_mov_b32 %0, m0\n\ts_mov_b32 m0, %2\n\ts_nop 0\n\tglobal_load_lds_dword %1, off\n\ts_mov_b32 m0, %0" : "=&s"(keep) : "v"(gsrc), "s"(lds_dst) : "memory"); }
typedef LAS const char* lds_cptr;
constexpr int FX_K = 0, FX_V = 24576, FX_WS = 49152, FX_OST = 51200, FX_FLG = 83968, FX_KB = 84224  ;

__device__ __forceinline__ void fx_pv(f32x16* o, int vb, bf16x8 pa0, bf16x8 pa1, bf16x8 pa2, bf16x8 pa3) {
#pragma unroll
    for (int d0 = 0; d0 < 2; ++d0) { s16x4 lo[4], hi[4];
#pragma unroll
        for (int ks = 0; ks < 4; ++ks) {
            asm volatile("ds_read_b64_tr_b16 %0,%1 offset:%c2" : "=&v"(lo[ks]) : "v"(vb), "i"(d0 * 4096 + ks * 1024) : "memory");
            asm volatile("ds_read_b64_tr_b16 %0,%1 offset:%c2" : "=&v"(hi[ks]) : "v"(vb), "i"(d0 * 4096 + ks * 1024 + 512) : "memory"); }
        asm volatile("s_waitcnt lgkmcnt(0)" ::: "memory"); __builtin_amdgcn_sched_barrier(0);
#define FX_PK(k) (bf16x8){lo[k][0], lo[k][1], lo[k][2], lo[k][3], hi[k][0], hi[k][1], hi[k][2], hi[k][3]}
        o[d0] = __builtin_amdgcn_mfma_f32_32x32x16_bf16(pa0, FX_PK(0), o[d0], 0, 0, 0);
        o[d0] = __builtin_amdgcn_mfma_f32_32x32x16_bf16(pa1, FX_PK(1), o[d0], 0, 0, 0);
        o[d0] = __builtin_amdgcn_mfma_f32_32x32x16_bf16(pa2, FX_PK(2), o[d0], 0, 0, 0);
        o[d0] = __builtin_amdgcn_mfma_f32_32x32x16_bf16(pa3, FX_PK(3), o[d0], 0, 0, 0);
#undef FX_PK
    }
}
__device__ __forceinline__ float halves_max(float m) { auto rr = __builtin_amdgcn_permlane32_swap(__float_as_uint(m), __float_as_uint(m), false, false); return fmaxf(__uint_as_float(rr[0]), __uint_as_float(rr[1])); }
__device__ __forceinline__ float halves_sum(float m) { auto rr = __builtin_amdgcn_permlane32_swap(__float_as_uint(m), __float_as_uint(m), false, false); return __uint_as_float(rr[0]) + __uint_as_float(rr[1]); }

constexpr float ATT_EXIT = -40.0f;
template <int KIND>
__device__ __forceinline__ void attn_unit(const ArgsL& a, Frame& F, int b, int h, int qb, float bound) {
    const int lane = F.lane, wave = F.wave, r32 = lane & 31, hi = lane >> 5;
    LAS unsigned char* lds = F.lds;
    const bf16_t* QKV = (const bf16_t*)(a.ws + WS_QKV);
    const size_t rowbase = (size_t)b * T;
    const int p0 = qb * 256;
    constexpr int QC = KIND ? 0 : 960, KC = KIND ? 320 : 1280, VC = KIND ? 640 : 1600;
    const bf16_t* Qw = QKV + (rowbase + p0 + wave * 32) * QKV_W + QC + h * 64;
    const bf16_t* Kh = QKV + rowbase * QKV_W + KC + h * 64;
    const bf16_t* Vh = QKV + rowbase * QKV_W + VC + h * 64;
    const float* kbias = (const float*)(a.ws + WS_KB2) + (size_t)(b * FX_H + h) * KBP;
    const unsigned lds0 = (unsigned)(uintptr_t)lds;
    bf16x8 qr[4];
#pragma unroll
    for (int d0 = 0; d0 < 4; ++d0) qr[d0] = *(const bf16x8*)(Qw + (size_t)r32 * QKV_W + d0 * 16 + hi * 8);
    const int qp = p0 + wave * 32 + r32;
    const bool qvalid = (qp >= PADR) && (qp < T);
    const int plast = (p0 + 255) < (T - 1) ? (p0 + 255) : (T - 1);
    const int jlast = plast >> 6, jfirst = PADR >> 6;
    const int jw = (p0 + wave * 32 + 31) >> 6;
    const bf16_t* ksrc = Kh + (size_t)lane * QKV_W + wave * 8;
    const bf16_t* vsrc = Vh + (size_t)(16 * (wave & 3) + (lane >> 2)) * QKV_W + (wave >> 2) * 32 + (lane & 3) * 8;
    const unsigned kdst = lds0 + FX_K + wave * 1024, vdst = lds0 + FX_V + wave * 1024;
#define FX_DMA(j, slot) do { glds16(ksrc + (size_t)(j) * 64 * QKV_W, (unsigned)__builtin_amdgcn_readfirstlane(kdst + (slot) * 8192)); \
                             glds16(vsrc + (size_t)(j) * 64 * QKV_W, (unsigned)__builtin_amdgcn_readfirstlane(vdst + (slot) * 8192)); \
                             if (KIND == 0) glds4(kbias + 64 * (j) + lane, (unsigned)__builtin_amdgcn_readfirstlane(lds0 + FX_KB + (slot) * 2048 + wave * 256)); } while (0)
    const int vb0 = (int)(lds0 + FX_V) + ((lane >> 4) & 1) * 32 + (lane & 3) * 8 + (4 * hi + ((lane & 15) >> 2)) * 64;
    const lds_cptr kp0 = (lds_cptr)lds + FX_K + hi * 1024 + r32 * 16;
    LAS float* wsf = (LAS float*)(lds + FX_WS) + wave * 64;
    LAS float* flg = (LAS float*)(lds + FX_FLG);
    float m_run = KIND ? 0.f : -1.0e30f;
    f32x16 lacc = f32x16{};
    f32x16 o[2]; o[0] = f32x16{}; o[1] = f32x16{};
    asm volatile("" : "+v"(qr[0]), "+v"(qr[1]), "+v"(qr[2]), "+v"(qr[3]));
    int slot = 0;
    FX_DMA(jlast, 0);
    if (jlast > jfirst) FX_DMA(jlast - 1, 1);
    for (int j = jlast; j >= jfirst; --j) {
        if (j > jfirst) { if (KIND == 0) asm volatile("s_waitcnt vmcnt(3) lgkmcnt(0)\n\ts_barrier" ::: "memory"); else asm volatile("s_waitcnt vmcnt(2) lgkmcnt(0)\n\ts_barrier" ::: "memory"); }
        else asm volatile("s_waitcnt vmcnt(0) lgkmcnt(0)\n\ts_barrier" ::: "memory");
        if (j < jlast) {
            const LAS float* fl = flg + ((j + 1) & 1) * 16;
            const f32x4 fa = *(const LAS f32x4*)(fl), fb = *(const LAS f32x4*)(fl + 4);
            bool stop;
            if constexpr (KIND == 0) {
                const float mmin = fminf(fminf(fminf(fa.x, fa.y), fminf(fa.z, fa.w)), fminf(fminf(fb.x, fb.y), fminf(fb.z, fb.w)));
                stop = (bound + fl[8] - mmin) < ATT_EXIT;
            } else {
                const float mmax = fmaxf(fmaxf(fmaxf(fa.x, fa.y), fmaxf(fa.z, fa.w)), fmaxf(fmaxf(fb.x, fb.y), fmaxf(fb.z, fb.w)));
                stop = mmax < ATT_EXIT;
            }
            if (stop) break;
        }
        { const int s2 = slot + 2 >= 3 ? slot - 1 : slot + 2; if (j - 2 >= jfirst) FX_DMA(j - 2, s2); }
        if (j <= jw) {
            f32x16 s0v = f32x16{}, s1v = f32x16{};
            const lds_cptr kp = kp0 + slot * 8192;
#pragma unroll
            for (int d0 = 0; d0 < 4; ++d0) {
                const bf16x8 b0 = *(const LAS bf16x8*)(kp + d0 * 2048);
                const bf16x8 b1 = *(const LAS bf16x8*)(kp + d0 * 2048 + 512);
                s0v = __builtin_amdgcn_mfma_f32_32x32x16_bf16(b0, qr[d0], s0v, 0, 0, 0);
                s1v = __builtin_amdgcn_mfma_f32_32x32x16_bf16(b1, qr[d0], s1v, 0, 0, 0);
            }
            const bool edge = (64 * j + 63 >= p0 + wave * 32) || (64 * j < PADR);
            if constexpr (KIND == 0) {
                const LAS float* kbj = (const LAS float*)(lds + FX_KB + slot * 2048 + wave * 256) + 4 * hi;
#pragma unroll
                for (int g = 0; g < 4; ++g) { const f32x4 t0 = *(const LAS f32x4*)(kbj + 8 * g), t1 = *(const LAS f32x4*)(kbj + 32 + 8 * g);
                    s0v[4 * g] += t0.x; s0v[4 * g + 1] += t0.y; s0v[4 * g + 2] += t0.z; s0v[4 * g + 3] += t0.w;
                    s1v[4 * g] += t1.x; s1v[4 * g + 1] += t1.y; s1v[4 * g + 2] += t1.z; s1v[4 * g + 3] += t1.w; }
                if (edge) {
#pragma unroll
                    for (int r = 0; r < 16; ++r) { const int key = 64 * j + crow(r, hi);
                        if (key > qp || key < PADR) s0v[r] = -INFINITY;
                        if (key + 32 > qp || key + 32 < PADR) s1v[r] = -INFINITY; }
                }
                float rm = fmaxf(s0v[0], s1v[0]);
#pragma unroll
                for (int r = 1; r < 16; ++r) rm = fmaxf(rm, fmaxf(s0v[r], s1v[r]));
                rm = halves_max(rm);
                const float m_new = fmaxf(m_run, rm);
                const float f = __builtin_amdgcn_exp2f(m_run - m_new);
                m_run = m_new;
#pragma unroll
                for (int r = 0; r < 16; ++r) { s0v[r] = __builtin_amdgcn_exp2f(s0v[r] - m_new); s1v[r] = __builtin_amdgcn_exp2f(s1v[r] - m_new); }
                if (!__all(f == 1.0f)) {
                    if (hi == 0) wsf[r32] = f;
                    LDS_WAIT();
#pragma unroll
                    for (int r = 0; r < 16; ++r) { const float fr_ = wsf[crow(r, hi)]; o[0][r] *= fr_; o[1][r] *= fr_; lacc[r] *= fr_; }
                }
            } else {
                f32x16 l0, l1;
#pragma unroll
                for (int r = 0; r < 16; ++r) {
                    const float z0 = s0v[r], z1 = s1v[r];
                    float a0 = -(fmaxf(z0, 0.f) + __builtin_amdgcn_logf(1.f + __builtin_amdgcn_exp2f(-fabsf(z0))));
                    float a1 = -(fmaxf(z1, 0.f) + __builtin_amdgcn_logf(1.f + __builtin_amdgcn_exp2f(-fabsf(z1))));
                    if (edge) { const int key = 64 * j + crow(r, hi);
                        if (key >= qp || key < PADR) { a0 = 0.f; s0v[r] = -INFINITY; }
                        if (key + 32 >= qp || key + 32 < PADR) { a1 = 0.f; s1v[r] = -INFINITY; } }
                    l0[r] = a0; l1[r] = a1;
                }
                float A[8], SA[9], SO[9];
#pragma unroll
                for (int g = 0; g < 4; ++g) { A[g] = (l0[4 * g] + l0[4 * g + 1]) + (l0[4 * g + 2] + l0[4 * g + 3]); A[4 + g] = (l1[4 * g] + l1[4 * g + 1]) + (l1[4 * g + 2] + l1[4 * g + 3]); }
                SA[8] = 0.f; SO[8] = 0.f;
#pragma unroll
                for (int g = 7; g >= 0; --g) SA[g] = A[g] + SA[g + 1];
#pragma unroll
                for (int g = 0; g < 8; ++g) { auto rr = __builtin_amdgcn_permlane32_swap(__float_as_uint(SA[g]), __float_as_uint(SA[g]), false, false); SO[g] = __uint_as_float(hi ? rr[0] : rr[1]); }
                const float R = m_run;
#pragma unroll
                for (int g = 0; g < 8; ++g) {
                    const float E = SA[g + 1] + (hi ? SO[g + 1] : SO[g]) + R;
                    if (g < 4) { float t = E;
                        s0v[4 * g + 3] = __builtin_amdgcn_exp2f(s0v[4 * g + 3] + l0[4 * g + 3] + t); t += l0[4 * g + 3];
                        s0v[4 * g + 2] = __builtin_amdgcn_exp2f(s0v[4 * g + 2] + l0[4 * g + 2] + t); t += l0[4 * g + 2];
                        s0v[4 * g + 1] = __builtin_amdgcn_exp2f(s0v[4 * g + 1] + l0[4 * g + 1] + t); t += l0[4 * g + 1];
                        s0v[4 * g + 0] = __builtin_amdgcn_exp2f(s0v[4 * g + 0] + l0[4 * g + 0] + t);
                    } else { const int q = g - 4; float t = E;
                        s1v[4 * q + 3] = __builtin_amdgcn_exp2f(s1v[4 * q + 3] + l1[4 * q + 3] + t); t += l1[4 * q + 3];
                        s1v[4 * q + 2] = __builtin_amdgcn_exp2f(s1v[4 * q + 2] + l1[4 * q + 2] + t); t += l1[4 * q + 2];
                        s1v[4 * q + 1] = __builtin_amdgcn_exp2f(s1v[4 * q + 1] + l1[4 * q + 1] + t); t += l1[4 * q + 1];
                        s1v[4 * q + 0] = __builtin_amdgcn_exp2f(s1v[4 * q + 0] + l1[4 * q + 0] + t);
                    }
                }
                m_run = R + SA[0] + SO[0];
            }
            u32x4 pw0, pw1, pw2, pw3;
            pw0 = (u32x4){pk2(s0v[0], s0v[1]), pk2(s0v[2], s0v[3]), pk2(s0v[4], s0v[5]), pk2(s0v[6], s0v[7])};
            pw1 = (u32x4){pk2(s0v[8], s0v[9]), pk2(s0v[10], s0v[11]), pk2(s0v[12], s0v[13]), pk2(s0v[14], s0v[15])};
            pw2 = (u32x4){pk2(s1v[0], s1v[1]), pk2(s1v[2], s1v[3]), pk2(s1v[4], s1v[5]), pk2(s1v[6], s1v[7])};
            pw3 = (u32x4){pk2(s1v[8], s1v[9]), pk2(s1v[10], s1v[11]), pk2(s1v[12], s1v[13]), pk2(s1v[14], s1v[15])};
            if constexpr (KIND == 0) { const bf16x8 ones = __builtin_bit_cast(bf16x8, (u32x4){0x3F803F80u, 0x3F803F80u, 0x3F803F80u, 0x3F803F80u});
                lacc = __builtin_amdgcn_mfma_f32_32x32x16_bf16(__builtin_bit_cast(bf16x8, pw0), ones, lacc, 0, 0, 0); lacc = __builtin_amdgcn_mfma_f32_32x32x16_bf16(__builtin_bit_cast(bf16x8, pw1), ones, lacc, 0, 0, 0);
                lacc = __builtin_amdgcn_mfma_f32_32x32x16_bf16(__builtin_bit_cast(bf16x8, pw2), ones, lacc, 0, 0, 0); lacc = __builtin_amdgcn_mfma_f32_32x32x16_bf16(__builtin_bit_cast(bf16x8, pw3), ones, lacc, 0, 0, 0); }
            fx_pv(o, vb0 + slot * 8192, __builtin_bit_cast(bf16x8, pw0), __builtin_bit_cast(bf16x8, pw1), __builtin_bit_cast(bf16x8, pw2), __builtin_bit_cast(bf16x8, pw3));
        }
        float mm = qvalid ? m_run : (KIND ? -3.0e38f : 3.0e38f);
        if constexpr (KIND == 0) { mm = fminf(mm, dpp_f<0x128>(mm)); mm = fminf(mm, dpp_f<0x124>(mm)); mm = fminf(mm, dpp_f<0x122>(mm)); mm = fminf(mm, dpp_f<0x121>(mm));
            { auto sw = __builtin_amdgcn_permlane16_swap(__float_as_uint(mm), __float_as_uint(mm), false, false); mm = fminf(__uint_as_float(sw[0]), __uint_as_float(sw[1])); }
            { auto sw = __builtin_amdgcn_permlane32_swap(__float_as_uint(mm), __float_as_uint(mm), false, false); mm = fminf(__uint_as_float(sw[0]), __uint_as_float(sw[1])); } }
        else { mm = fmaxf(mm, dpp_f<0x128>(mm)); mm = fmaxf(mm, dpp_f<0x124>(mm)); mm = fmaxf(mm, dpp_f<0x122>(mm)); mm = fmaxf(mm, dpp_f<0x121>(mm));
            { auto sw = __builtin_amdgcn_permlane16_swap(__float_as_uint(mm), __float_as_uint(mm), false, false); mm = fmaxf(__uint_as_float(sw[0]), __uint_as_float(sw[1])); }
            { auto sw = __builtin_amdgcn_permlane32_swap(__float_as_uint(mm), __float_as_uint(mm), false, false); mm = fmaxf(__uint_as_float(sw[0]), __uint_as_float(sw[1])); } }
        if (lane == 0) { flg[(j & 1) * 16 + wave] = mm;
            if (KIND == 0 && wave == 0) flg[(j & 1) * 16 + 8] = *(const LAS float*)(lds + FX_KB + slot * 2048); }
        slot = slot == 2 ? 0 : slot + 1;
    }
    asm volatile("s_waitcnt vmcnt(0) lgkmcnt(0)\n\ts_barrier" ::: "memory");
    float rli[16];
    if constexpr (KIND == 0) {
#pragma unroll
        for (int r = 0; r < 16; ++r) rli[r] = __builtin_amdgcn_rcpf(lacc[r]);
    } else {
#pragma unroll
        for (int r = 0; r < 16; ++r) rli[r] = 1.0f;
    }
    bf16_t* Ow = (bf16_t*)(a.ws + WS_YCAT) + (rowbase + p0 + wave * 32) * YC_W + (KIND ? 384 : 768) + h * 64;
    {
        LAS bf16_t* stg = (LAS bf16_t*)(lds + FX_OST) + wave * 2048;
#pragma unroll
        for (int r = 0; r < 16; ++r) { const int orow = crow(r, hi);
#pragma unroll
            for (int d0 = 0; d0 < 2; ++d0) stg[orow * 64 + d0 * 32 + r32] = f2bf(o[d0][r] * rli[r]); }
        LDS_WAIT();
#pragma unroll
        for (int i = 0; i < 4; ++i) { const int row = i * 8 + (lane >> 3), ch = lane & 7; const u32x4 v = *(const LAS u32x4*)(stg + row * 64 + ch * 8);
            const int pr = p0 + wave * 32 + row;
            if (pr >= PADR && pr < T) *(u32x4*)(Ow + (size_t)row * YC_W + ch * 8) = v; }
    }
    asm volatile("s_waitcnt lgkmcnt(0)\n\ts_barrier" ::: "memory");
#undef FX_DMA
}


constexpr int CK = 64, NCK = 257, CKB = 40960, CB_ZF = 147456  ;
static_assert(LPADDED == CK * NCK, "padded steps");
__device__ __forceinline__ int swz(int row, int chunk) { return row * 128 + ((chunk ^ (row & 7)) << 4); }
__device__ __forceinline__ void ck_mm(f32x16& acc, LAS unsigned char* A, LAS unsigned char* Bt, int m0, int n0, int r32, int hi) {
#pragma unroll
    for (int ks = 0; ks < 4; ++ks) {
        const bf16x8 av = *(const LAS bf16x8*)(A + swz(m0 + r32, 2 * ks + hi));
        const bf16x8 bv = *(const LAS bf16x8*)(Bt + swz(n0 + r32, 2 * ks + hi));
        acc = __builtin_amdgcn_mfma_f32_32x32x16_bf16(av, bv, acc, 0, 0, 0);
    }
}
__device__ __forceinline__ void ck_store_t(LAS unsigned char* dst, const f32x16& acc, int m0, int n0, int r32, int hi) {
#pragma unroll
    for (int g = 0; g < 4; ++g) { const u32x2 w = {pk2(acc[4 * g], acc[4 * g + 1]), pk2(acc[4 * g + 2], acc[4 * g + 3])};
        *(LAS u32x2*)(dst + swz(n0 + r32, (m0 >> 3) + g) + hi * 8) = w; }
}
constexpr int CA_KAP = 0, CA_BET = 8192, CA_CHI = 16384, CA_RHO = 24576, CA_VMT = 32768, CA_BHT = 40960, CA_KHT = 49152, CA_AK = 57344, CA_RB = 65536, CA_RK = 73728,
              CA_AB = 81920  , CA_RHS = 98304  , CA_G64 = MISC_OFF + 2048  , CA_SCR = MISC_OFF + 4096  ;

#ifndef CA_STAGES
#define CA_STAGES 15
#endif
__device__ __forceinline__ void wg_publish(unsigned* cnt) {
    asm volatile("s_waitcnt vmcnt(0)" ::: "memory");
    __syncthreads();
    if (threadIdx.x == 0) __hip_atomic_fetch_add(cnt, 1u, __ATOMIC_RELAXED, __HIP_MEMORY_SCOPE_AGENT);
}
__device__ __forceinline__ void wg_wait(const unsigned* cnt, unsigned n) {
    if (threadIdx.x == 0) { unsigned polls = 0;
        while (__hip_atomic_load(cnt, __ATOMIC_RELAXED, __HIP_MEMORY_SCOPE_AGENT) < n) { if (++polls > (1u << 18)) break; __builtin_amdgcn_s_sleep(2); }
        __builtin_amdgcn_fence(__ATOMIC_ACQUIRE, "agent"); asm volatile("s_waitcnt vmcnt(0)" ::: "memory"); }
    __syncthreads();
}
__device__ __forceinline__ void phase_chunkA(const ArgsL& a, Frame& F, unsigned* ca_done, const bool dry = false) {
    const int wave = F.wave;
    LAS unsigned char* L = F.lds;
    u32x4 pre6[6];
#define CA_ID(r) ((r) < 12 ? (int)F.bx + 256 * (r) : ((r) == 12 && F.bx >= 12 && F.bx < 24) ? 3072 + (int)F.bx - 12 : -1)
    for (int rnd = 0; rnd < 13; ++rnd) {
        const int id = CA_ID(rnd);
        if (id < 0) break;
        int tid = F.tid, lane, r32, hi;
#define CK_FRESH() do { asm volatile("" : "+v"(tid)); lane = tid & 63; r32 = lane & 31; hi = lane >> 5; } while (0)
        CK_FRESH();
        const int bh = id / NCK, c = id - bh * NCK;
        unsigned char* blk = a.ws + WS_RW + ((size_t)bh * LPADDED + (size_t)c * CK) * 768;
        const int blko = (int)(((size_t)bh * LPADDED + (size_t)c * CK) * 768);
        const __amdgpu_buffer_rsrc_t rwrs = __builtin_amdgcn_make_buffer_rsrc((void*)(a.ws + WS_RW), 0, (int)((size_t)12 * LPADDED * 768), 0x00020000);
        {
            if (rnd == 0) {
#pragma unroll
                for (int q6 = 0; q6 < 6; ++q6) pre6[q6] = *(const u32x4*)(blk + (size_t)(tid + q6 * NTHR) * 16);
            }
#pragma unroll
            for (int q6 = 0; q6 < 6; ++q6) *(LAS u32x4*)(L + CA_AB + (tid + q6 * NTHR) * 16) = pre6[q6];
            __syncthreads();
            const int k = tid & 63, tq = tid >> 6;
            const LAS _Float16* src = (const LAS _Float16*)(L + CA_AB) + (tq * 8) * 384 + k;
            float kk[8], w[8], bb[8], kp[8], rr[8], vv[8];
#pragma unroll
            for (int e = 0; e < 8; ++e) { kk[e] = (float)src[e * 384]; w[e] = 1.f + (float)src[e * 384 + 64]; bb[e] = -(float)src[e * 384 + 128];
                kp[e] = (float)src[e * 384 + 192]; rr[e] = (float)src[e * 384 + 256]; vv[e] = (float)src[e * 384 + 320]; }
            float g[8]; g[0] = w[0];
#pragma unroll
            for (int e = 1; e < 8; ++e) g[e] = g[e - 1] * w[e];
            LAS float* scr = (LAS float*)(L + CA_SCR);
            scr[tq * 64 + k] = g[7];
            __syncthreads();
            {
                const int idn = CA_ID(rnd + 1);
                if (idn >= 0) { const int bhn = idn / NCK, cn = idn - bhn * NCK; const unsigned char* bn_ = a.ws + WS_RW + ((size_t)bhn * LPADDED + (size_t)cn * CK) * 768;
#pragma unroll
                    for (int q6 = 0; q6 < 6; ++q6) pre6[q6] = *(const u32x4*)(bn_ + (size_t)(tid + q6 * NTHR) * 16); }
            }
            float pre = 1.f, tot = 1.f;
#pragma unroll
            for (int q = 0; q < 8; ++q) { const float s = scr[q * 64 + k]; if (q < tq) pre *= s; tot *= s; }
            if (tq == 0) ((LAS float*)(L + CA_G64))[k] = tot;
            unsigned bh4[4], kh4[4], vm4[4];
            float Gp = pre;
#pragma unroll
            for (int e = 0; e < 8; ++e) {
                const int t = tq * 8 + e; const float G = pre * g[e], iG = __builtin_amdgcn_rcpf(G);
                const float kap = kk[e] * Gp, bet = bb[e] * iG, chi = kp[e] * iG, rho = rr[e] * G;
                const int o = swz(t, k >> 3) + (k & 7) * 2;
                *(LAS unsigned short*)(L + CA_KAP + o) = f2bf(kap); *(LAS unsigned short*)(L + CA_BET + o) = f2bf(bet);
                *(LAS unsigned short*)(L + CA_CHI + o) = f2bf(chi); *(LAS unsigned short*)(L + CA_RHO + o) = f2bf(rho);
                ((LAS float*)(L + CA_RHS))[t * 128 + k] = kap;
                const float bhv = bet * tot, khv = chi * tot;
                if (e & 1) { bh4[e >> 1] |= (unsigned)f2bf(bhv) << 16; kh4[e >> 1] |= (unsigned)f2bf(khv) << 16; vm4[e >> 1] |= (unsigned)f2bf(vv[e]) << 16; }
                else { bh4[e >> 1] = f2bf(bhv); kh4[e >> 1] = f2bf(khv); vm4[e >> 1] = f2bf(vv[e]); }
                Gp = G;
            }
            *(LAS u32x4*)(L + CA_BHT + swz(k, tq)) = (u32x4){bh4[0], bh4[1], bh4[2], bh4[3]};
            *(LAS u32x4*)(L + CA_KHT + swz(k, tq)) = (u32x4){kh4[0], kh4[1], kh4[2], kh4[3]};
            *(LAS u32x4*)(L + CA_VMT + swz(k, tq)) = (u32x4){vm4[0], vm4[1], vm4[2], vm4[3]};
        }
        __syncthreads();
        CK_FRESH();
        if (!dry || (CA_STAGES & 2)) {
            const int p = wave & 3, nb = wave >> 2;
            LAS unsigned char* Am = L + ((p & 1) ? CA_CHI : CA_BET);
            LAS unsigned char* Bm = L + ((p & 2) ? CA_RHO : CA_KAP);
#pragma unroll
            for (int mb = 0; mb < 2; ++mb) {
                f32x16 acc = f32x16{};
                if (!(mb == 1 && nb == 0)) ck_mm(acc, Am, Bm, mb * 32, nb * 32, r32, hi);
                const int t = nb * 32 + r32;
#pragma unroll
                for (int i = 0; i < 16; ++i) { const int j = mb * 32 + crow(i, hi); const bool keep = (p & 2) ? (j <= t) : (j < t); if (!keep) acc[i] = 0.f; }
                if (p == 0) {
#pragma unroll
                    for (int gq = 0; gq < 4; ++gq) { LAS float* ab_ = (LAS float*)(L + CA_AB) + t * 64 + (mb * 8 + 2 * gq + hi);
                        ab_[0] = acc[4 * gq]; ab_[16] = acc[4 * gq + 1]; ab_[32] = acc[4 * gq + 2]; ab_[48] = acc[4 * gq + 3]; }
                } else ck_store_t(L + (p == 1 ? CA_AK : p == 2 ? CA_RB : CA_RK), acc, mb * 32, nb * 32, r32, hi);
            }
        }
        __syncthreads();
        CK_FRESH();
        if (wave < 4 && (!dry || (CA_STAGES & 2))) {
            const int mb = wave >> 1, nb = wave & 1;
            f32x16 acc = f32x16{};
            ck_mm(acc, L + CA_AK, L + CA_VMT, mb * 32, nb * 32, r32, hi);
#pragma unroll
            for (int i = 0; i < 16; ++i) ((LAS float*)(L + CA_RHS))[(mb * 32 + crow(i, hi)) * 128 + 64 + nb * 32 + r32] = acc[i];
        }
        __syncthreads();
        CK_FRESH();
        if (!dry || (CA_STAGES & 4)) {
            const int col = tid >> 2, p = tid & 3;
            unsigned abv = (unsigned)(uintptr_t)(L + CA_AB) + p * 64; asm volatile("" : "+v"(abv));
            const LAS float* ab = (const LAS float*)(uintptr_t)abv;
            const LAS float* rhs = (const LAS float*)(L + CA_RHS) + col;
            float xo[16];
#pragma unroll
            for (int i = 0; i < 16; ++i) xo[i] = 0.f;
#pragma unroll
            for (int tg = 0; tg < 64; tg += 4) {
                f32x4 av[4][4]; float rv[4];
#pragma unroll
                for (int r = 0; r < 4; ++r) { rv[r] = rhs[(tg + r) * 128];
#pragma unroll
                    for (int i4 = 0; i4 < (tg + r + 15) / 16; ++i4) av[r][i4] = *(const LAS f32x4*)(ab + (tg + r) * 64 + 4 * i4); }
#pragma unroll
                for (int r = 0; r < 4; ++r) { const int t = tg + r;
                    float s0 = (p == 0) ? rv[r] : 0.f, s1 = 0.f;
#pragma unroll
                    for (int i4 = 0; i4 < (t + 15) / 16; ++i4) {
                        s0 -= av[r][i4].x * xo[4 * i4]; s1 -= av[r][i4].y * xo[4 * i4 + 1]; s0 -= av[r][i4].z * xo[4 * i4 + 2]; s1 -= av[r][i4].w * xo[4 * i4 + 3]; }
                    float sx = s0 + s1;
                    sx += dpp_f<0xB1>(sx);
                    sx += dpp_f<0x4E>(sx);
                    if ((t & 3) == p) xo[t >> 2] = sx;
                    asm volatile("" : "+v"(xo[t >> 2]));
                }
                __builtin_amdgcn_sched_barrier(0);
            }
            LAS unsigned char* dst = L + (col < 64 ? CA_KAP : CA_BET);
            const int rowc = col & 63;
#pragma unroll
            for (int i = 0; i < 16; ++i) { const int tt = 4 * i + p; *(LAS unsigned short*)(dst + swz(rowc, tt >> 3) + (tt & 7) * 2) = f2bf(-xo[i]); }
        }
        __syncthreads();
        CK_FRESH();
        if (!dry || (CA_STAGES & 8)) {
            const int ty = wave >> 1;
            LAS unsigned char* nW1 = L + CA_KAP; LAS unsigned char* nW2 = L + CA_BET;
#pragma unroll
            for (int qq = 0; qq < 2; ++qq) {
                const int q = (wave & 1) * 2 + qq, qa = q >> 1, qb = q & 1;
                f32x16 acc = f32x16{};
                if (ty == 0) {
                    const int t = qa * 32 + r32;
#pragma unroll
                    for (int gq = 0; gq < 4; ++gq) { const u32x2 rv = *(const LAS u32x2*)(L + CA_RHO + swz(t, qb * 4 + gq) + hi * 8);
                        acc[4 * gq] = bf_lo(rv.x); acc[4 * gq + 1] = bf_hi(rv.x); acc[4 * gq + 2] = bf_lo(rv.y); acc[4 * gq + 3] = bf_hi(rv.y); }
                    ck_mm(acc, nW1, L + CA_RB, qb * 32, qa * 32, r32, hi);
                } else if (ty == 1) {
                    ck_mm(acc, nW1, L + CA_BHT, qb * 32, qa * 32, r32, hi);
                    if (qa == qb) { const float g64 = ((const LAS float*)(L + CA_G64))[qa * 32 + r32];
#pragma unroll
                        for (int i = 0; i < 16; ++i) if (crow(i, hi) == r32) acc[i] += g64; }
                } else if (ty == 2) {
                    ck_mm(acc, L + CA_KHT, L + CA_VMT, qb * 32, qa * 32, r32, hi);
                    ck_mm(acc, L + CA_BHT, nW2, qb * 32, qa * 32, r32, hi);
                } else {
                    ck_mm(acc, L + CA_VMT, L + CA_RK, qa * 32, qb * 32, r32, hi);
                    ck_mm(acc, nW2, L + CA_RB, qa * 32, qb * 32, r32, hi);
                }
                if (dry) { float sink = acc[0] + acc[5] + acc[10] + acc[15]; asm volatile("" :: "v"(sink)); }
                else if (ty < 2) {
                    const int o = blko + (ty == 0 ? 8192 : 0) + ((qa * 2 + qb) * 2) * 1024 + lane * 16;
#pragma unroll
                    for (int ks = 0; ks < 2; ++ks)
                        __builtin_amdgcn_raw_buffer_store_b128((u32x4){pk2(acc[8 * ks], acc[8 * ks + 1]), pk2(acc[8 * ks + 2], acc[8 * ks + 3]), pk2(acc[8 * ks + 4], acc[8 * ks + 5]), pk2(acc[8 * ks + 6], acc[8 * ks + 7])}, rwrs, o + ks * 1024, 0, 16);
                } else if (ty == 2) {
                    const int o = blko + 16384 + (qa * 2 + qb) * 4096 + lane * 16;
#pragma unroll
                    for (int g = 0; g < 4; ++g) __builtin_amdgcn_raw_buffer_store_b128((u32x4){__float_as_uint(acc[4 * g]), __float_as_uint(acc[4 * g + 1]), __float_as_uint(acc[4 * g + 2]), __float_as_uint(acc[4 * g + 3])}, rwrs, o + g * 1024, 0, 16);
                } else {
                    const int o = blko + 32768 + (qa * 2 + qb) * 2048 + lane * 8;
#pragma unroll
                    for (int g = 0; g < 4; ++g) __builtin_amdgcn_raw_buffer_store_b64((u32x2){pk2(acc[4 * g], acc[4 * g + 1]), pk2(acc[4 * g + 2], acc[4 * g + 3])}, rwrs, o + g * 512, 0, 16);
                }
            }
        }
        __syncthreads();
        if (rnd == 11 && !dry) wg_publish(ca_done);
    }
    if (F.bx >= 12 && F.bx < 24 && !dry) wg_publish(ca_done + 16);
#undef CA_ID
}

__device__ __forceinline__ void rwkv_chunkB(const ArgsL& a, Frame& F, int bh, const unsigned* ca_done) {
    const int lane = F.lane, wave = F.wave, r32 = lane & 31, hi = lane >> 5;
    const int b = bh / RW_H, h = bh % RW_H;
    LAS unsigned char* L = F.lds;
    const unsigned char* base = a.ws + WS_RW + (size_t)bh * LPADDED * 768;
    bf16_t* y0 = (bf16_t*)(a.ws + WS_YCAT);
    const bool isld = (wave & 2) != 0; const int lw = (wave & 1) + ((wave >> 2) << 1);
    LAS unsigned char* yimg0 = L + 3 * CKB; LAS unsigned char* yimg1 = L + MISC_OFF + 8192;
    LAS unsigned char* zfb = L + CB_ZF;
#define CB_ISSUE(cc) do { const unsigned char* s_ = base + (size_t)(cc) * CK * 768 + (size_t)lw * 1024 + lane * 16; LAS unsigned char* d_ = L + ((cc) % 3) * CKB + lw * 1024; \
        _Pragma("unroll") for (int r_ = 0; r_ < 10; ++r_) __builtin_amdgcn_global_load_lds((const unsigned*)(s_ + r_ * 4096), (LAS unsigned*)(d_ + r_ * 4096), 16, 0, 0); } while (0)
#define CB_YOUT(cc) do { const LAS unsigned char* im_ = ((cc) & 1) ? yimg1 : yimg0; \
        _Pragma("unroll") for (int r_ = 0; r_ < 8; ++r_) { const int t_ = r_ * 8 + (lane >> 3), l_ = (cc) * CK + t_; const u32x4 v_ = *(const LAS u32x4*)(im_ + t_ * 128 + (((lane & 7) ^ (t_ & 7)) * 16)); \
            if (l_ < LTOK) *(u32x4*)(y0 + (size_t)(b * T + PADR + l_) * YC_W + h * 64 + (lane & 7) * 8) = v_; } } while (0)
    if (isld) { CB_ISSUE(0); CB_ISSUE(1); asm volatile("s_waitcnt vmcnt(10)" ::: "memory"); }
    bf16x8 zf[2][2];
#pragma unroll
    for (int q = 0; q < 4; ++q) zf[q >> 1][q & 1] = bf16x8{};
    if (wave < 2) {
#pragma unroll
        for (int q = 0; q < 4; ++q) *(LAS bf16x8*)(zfb + wave * 4096 + q * 1024 + lane * 16) = bf16x8{};
    }
    asm volatile("s_waitcnt lgkmcnt(0)\n\ts_barrier" ::: "memory");
    for (int c = 0; c < NCK; ++c) {
        if (bh == 11 && c == 240) wg_wait(ca_done + 16, 12u);
        const LAS unsigned char* S = L + (c % 3) * CKB;
        if (wave < 2) {
            const int vb = wave;
            f32x16 N0, N1;
            { const LAS unsigned char* n0 = S + 16384 + (vb * 2 + 0) * 4096 + lane * 16; const LAS unsigned char* n1 = S + 16384 + (vb * 2 + 1) * 4096 + lane * 16;
#pragma unroll
              for (int g = 0; g < 4; ++g) { const f32x4 u0 = *(const LAS f32x4*)(n0 + g * 1024), u1 = *(const LAS f32x4*)(n1 + g * 1024);
                  N0[4 * g] = u0.x; N0[4 * g + 1] = u0.y; N0[4 * g + 2] = u0.z; N0[4 * g + 3] = u0.w; N1[4 * g] = u1.x; N1[4 * g + 1] = u1.y; N1[4 * g + 2] = u1.z; N1[4 * g + 3] = u1.w; } }
#pragma unroll
            for (int kb2 = 0; kb2 < 2; ++kb2)
#pragma unroll
                for (int ks = 0; ks < 2; ++ks) {
                    const bf16x8 m0 = *(const LAS bf16x8*)(S + ((0 * 2 + kb2) * 2 + ks) * 1024 + lane * 16);
                    const bf16x8 m1 = *(const LAS bf16x8*)(S + ((1 * 2 + kb2) * 2 + ks) * 1024 + lane * 16);
                    N0 = __builtin_amdgcn_mfma_f32_32x32x16_bf16(m0, zf[kb2][ks], N0, 0, 0, 0);
                    N1 = __builtin_amdgcn_mfma_f32_32x32x16_bf16(m1, zf[kb2][ks], N1, 0, 0, 0);
                }
            LAS unsigned char* zo = zfb + ((c + 1) & 1) * 8192 + vb * 4096 + lane * 16;
#pragma unroll
            for (int ks = 0; ks < 2; ++ks) {
                zf[0][ks] = __builtin_bit_cast(bf16x8, (u32x4){pk2(N0[8 * ks], N0[8 * ks + 1]), pk2(N0[8 * ks + 2], N0[8 * ks + 3]), pk2(N0[8 * ks + 4], N0[8 * ks + 5]), pk2(N0[8 * ks + 6], N0[8 * ks + 7])});
                zf[1][ks] = __builtin_bit_cast(bf16x8, (u32x4){pk2(N1[8 * ks], N1[8 * ks + 1]), pk2(N1[8 * ks + 2], N1[8 * ks + 3]), pk2(N1[8 * ks + 4], N1[8 * ks + 5]), pk2(N1[8 * ks + 6], N1[8 * ks + 7])});
                *(LAS bf16x8*)(zo + (0 * 2 + ks) * 1024) = zf[0][ks]; *(LAS bf16x8*)(zo + (1 * 2 + ks) * 1024) = zf[1][ks];
            }
        } else if (isld) {
            if (wave == 6 && c > 0) CB_YOUT(c - 1);
            if (c + 2 < NCK) CB_ISSUE(c + 2);
            if (wave < 4) {
                const int vb = wave - 2;
                LAS unsigned char* yim = (c & 1) ? yimg1 : yimg0;
                const LAS unsigned char* zs = zfb + (c & 1) * 8192 + vb * 4096 + lane * 16;
                bf16x8 zq[2][2];
#pragma unroll
                for (int q = 0; q < 4; ++q) zq[q >> 1][q & 1] = *(const LAS bf16x8*)(zs + q * 1024);
#pragma unroll
                for (int tb = 0; tb < 2; ++tb) {
                    f32x16 acc;
                    const LAS unsigned char* yt = S + 32768 + (vb * 2 + tb) * 2048 + lane * 8;
#pragma unroll
                    for (int g = 0; g < 4; ++g) { const u32x2 w = *(const LAS u32x2*)(yt + g * 512); acc[4 * g] = bf_lo(w.x); acc[4 * g + 1] = bf_hi(w.x); acc[4 * g + 2] = bf_lo(w.y); acc[4 * g + 3] = bf_hi(w.y); }
#pragma unroll
                    for (int kb2 = 0; kb2 < 2; ++kb2)
#pragma unroll
                        for (int ks = 0; ks < 2; ++ks) { const bf16x8 pa = *(const LAS bf16x8*)(S + 8192 + ((tb * 2 + kb2) * 2 + ks) * 1024 + lane * 16);
                            acc = __builtin_amdgcn_mfma_f32_32x32x16_bf16(zq[kb2][ks], pa, acc, 0, 0, 0); }
                    const int t = tb * 32 + r32;
#pragma unroll
                    for (int g = 0; g < 4; ++g) { const u32x2 w = {pk2(acc[4 * g], acc[4 * g + 1]), pk2(acc[4 * g + 2], acc[4 * g + 3])};
                        *(LAS u32x2*)(yim + t * 128 + (((vb * 8 + 2 * g + hi) ^ (2 * (t & 7))) * 8)) = w; }
                }
            }
            if (c + 2 < NCK) asm volatile("s_waitcnt vmcnt(10)" ::: "memory"); else asm volatile("s_waitcnt vmcnt(0)" ::: "memory");
        }
        asm volatile("s_waitcnt lgkmcnt(0)\n\ts_barrier" ::: "memory");
    }
    if (wave == 6) CB_YOUT(NCK - 1);
    asm volatile("s_waitcnt vmcnt(0) lgkmcnt(0)\n\ts_barrier" ::: "memory");
#undef CB_ISSUE
#undef CB_YOUT
}

constexpr int N_FX_UNITS = 65 * 10, N_SB_UNITS = 65 * 10, N_RW_WG = 192;
#ifndef REP_SCAN
#define REP_SCAN 1
#endif
#ifndef REP_SCAN_DRY
#define REP_SCAN_DRY 0
#endif
#ifndef REP_FOX
#define REP_FOX 1
#endif
#ifndef REP_SB
#define REP_SB 1
#endif
__device__ __forceinline__ void phase_mix(const ArgsL& a, Frame& F, int layer, const unsigned* ca_done) {
#ifdef SEQ_SCAN
    if (F.bx < N_RW_WG) { int nr = REP_SCAN; asm volatile("" : "+s"(nr)); for (int r = 0; r < nr; ++r) rwkv_scan(a, F, F.bx, (r + 1 < nr) ? REP_SCAN_DRY : 0); }
#else
#ifndef REP_CHB
#define REP_CHB 1
#endif
    if (F.bx < 12) { wg_wait(ca_done, gridDim.x);
        int nr = REP_CHB; asm volatile("" : "+s"(nr)); for (int r = 0; r < nr; ++r) rwkv_chunkB(a, F, F.bx, ca_done); }
#endif
    float gqm = fabsf(a.in(I_QG)[layer * 64 + F.lane]), gkm = fabsf(a.in(I_KG)[layer * 64 + F.lane]);
#pragma unroll
    for (int off = 1; off < 64; off <<= 1) { gqm = fmaxf(gqm, __shfl_xor(gqm, off)); gkm = fmaxf(gkm, __shfl_xor(gkm, off)); }
    const float bound = 64.0f * C2 * gqm * gkm * 1.02f + 0.5f;
    unsigned* head = (unsigned*)(a.ws + WS_CTL) + CW_QUEUE + 64 * layer;
    for (;;) {
        if (F.tid == 0) F.MISC[16] = __hip_atomic_fetch_add(head, 1u, __ATOMIC_RELAXED, __HIP_MEMORY_SCOPE_AGENT);
        __syncthreads();
        const int u = (int)F.MISC[16];
        __syncthreads();
        if (u >= N_FX_UNITS + N_SB_UNITS) break;
        if (u < N_FX_UNITS) { const int qb = 64 - u / 10, bh = u % 10; int nr = REP_FOX; asm volatile("" : "+s"(nr)); for (int r = 0; r < nr; ++r) attn_unit<0>(a, F, bh / FX_H, bh % FX_H, qb, bound); }
        else { const int v = u - N_FX_UNITS; const int qb = 64 - v / 10, bh = v % 10; int nr = REP_SB; asm volatile("" : "+s"(nr)); for (int r = 0; r < nr; ++r) attn_unit<1>(a, F, bh / SB_H, bh % SB_H, qb, bound); }
    }
}

__device__ __forceinline__ void chain_publish(unsigned* cnt, int pm) {
    asm volatile("s_waitcnt vmcnt(0)" ::: "memory");
    if ((threadIdx.x & 63) == 0) __hip_atomic_fetch_add(cnt + CH_STRIDE * pm, 1u, __ATOMIC_RELAXED, __HIP_MEMORY_SCOPE_AGENT);
}
struct GatesOrder : pg8::StaticOrder {
    unsigned* mine;
    __device__ bool next(int i, pg8::Unit& u) const {
        long L;
        if (i < 5) L = (long)i * 256 + c;
        else if (i == 5) { if (c >= 16 && c < 20) return false; L = 1280 + c; }
        else if (i == 6) { if (c < 12) L = 1536 + c; else if (c < 16) L = 1280 + 16 + (c - 12); else return false; }
        else return false;
        int wgid = (int)L; { const int q = nwg / pg8::NXCD, r = nwg % pg8::NXCD, xcd = wgid % pg8::NXCD, off = wgid / pg8::NXCD; wgid = (xcd < r ? xcd * (q + 1) : r * (q + 1) + (xcd - r) * q) + off; }
        const int nig = pg8::WGM * nN, gid = wgid / nig, fm = gid * pg8::WGM, gsz = (nM - fm) < pg8::WGM ? (nM - fm) : pg8::WGM;
        u.pm = fm + ((wgid % nig) % gsz); u.pn = (wgid % nig) / gsz; return true;
    }
    __device__ __forceinline__ void a_ready(const pg8::Unit&) const {}
    __device__ __forceinline__ void done(const pg8::Unit& u) const { chain_publish(mine, u.pm); }
};
template <bool WAIT, bool PUB>
struct ChainOrder : pg8::StaticOrder {
    const unsigned* ready; unsigned need; unsigned* mine;
    __device__ __forceinline__ void a_ready(const pg8::Unit& u) const {
        if constexpr (WAIT) {
            if (threadIdx.x < 64) {
                const unsigned* w = ready + CH_STRIDE * u.pm; unsigned polls = 0;
                while ((unsigned)__builtin_amdgcn_readfirstlane(__hip_atomic_load(w, __ATOMIC_RELAXED, __HIP_MEMORY_SCOPE_AGENT)) < need) { if (++polls > (1u << 18)) break; __builtin_amdgcn_s_sleep(2); }
                __builtin_amdgcn_fence(__ATOMIC_ACQUIRE, "agent");
                asm volatile("s_waitcnt vmcnt(0)" ::: "memory");
            }
            asm volatile("" ::: "memory"); __builtin_amdgcn_s_barrier(); asm volatile("" ::: "memory");
        }
    }
    __device__ __forceinline__ void done(const pg8::Unit& u) const { if constexpr (PUB) chain_publish(mine, u.pm); }
};

__device__ __forceinline__ void phase_post(const ArgsL& a, Frame& F, int layer, unsigned* chain, const bool dry = false) {
    const int lane = F.lane, wave = F.wave, it4 = lane >> 4, e4 = lane & 15;
    bf16_t* Y0 = (bf16_t*)(a.ws + WS_YCAT); const bf16_t* BN = (const bf16_t*)(a.ws + WS_BN);
    const __amdgpu_buffer_rsrc_t yrs = __builtin_amdgcn_make_buffer_rsrc((void*)Y0, 0, (int)((size_t)M * YC_W * 2), 0x00020000);
    LAS float* lgl = (LAS float*)F.lds;
    for (int i = F.tid; i < 2 * RW_W; i += NTHR) lgl[i] = (i < RW_W) ? a.in(I_LNG)[layer * RW_W + i] : a.in(I_LNB)[layer * RW_W + i - RW_W];
    __syncthreads();
    unsigned* head = (unsigned*)(a.ws + WS_CTL) + CW_QUEUE + 64 * layer + 32 + (dry ? 8 : 0);
    for (;;) {
        if (F.tid == 0) F.MISC[17] = __hip_atomic_fetch_add(head, 1u, __ATOMIC_RELAXED, __HIP_MEMORY_SCOPE_AGENT);
        __syncthreads();
        const int ch = (int)F.MISC[17];
        __syncthreads();
        if (ch >= M / 64) break;
        u32x2 yn = {0u, 0u}, bn = {0u, 0u};
#define PP_ADDR(ps) const int item_ = (ps) * 32 + wave * 4 + it4, rw_ = item_ / 6, hh_ = item_ - rw_ * 6; const int m_ = ch * 64 + rw_; const size_t off_ = (size_t)m_ * RW_W + hh_ * 64 + e4 * 4, offy_ = (size_t)m_ * YC_W + hh_ * 64 + e4 * 4
        { PP_ADDR(0); yn = *(const u32x2*)(Y0 + offy_); bn = *(const u32x2*)(BN + off_); }
#pragma unroll 1
        for (int ps = 0; ps < 12; ++ps) {
            const u32x2 yv = yn, bv = bn;
            if (ps + 1 < 12) { PP_ADDR(ps + 1); yn = *(const u32x2*)(Y0 + offy_); bn = *(const u32x2*)(BN + off_); }
            PP_ADDR(ps);
            const int p = m_ % T;
            u32x2 w = {0u, 0u};
            if (p >= PADR) {
                const float y0 = bf_lo(yv.x), y1 = bf_hi(yv.x), y2 = bf_lo(yv.y), y3 = bf_hi(yv.y);
                const float mean = allred16((y0 + y1) + (y2 + y3)) * (1.f / 64.f);
                const float d0 = y0 - mean, d1 = y1 - mean, d2 = y2 - mean, d3 = y3 - mean;
                const float rs = 1.0f / sqrtf(allred16((d0 * d0 + d1 * d1) + (d2 * d2 + d3 * d3)) * (1.f / 64.f) + 64e-5f);
                const f32x4 g4 = *(const LAS f32x4*)(lgl + hh_ * 64 + e4 * 4), b4 = *(const LAS f32x4*)(lgl + RW_W + hh_ * 64 + e4 * 4);
                w = (u32x2){pk2(d0 * rs * g4.x + b4.x + bf_lo(bv.x), d1 * rs * g4.y + b4.y + bf_hi(bv.x)), pk2(d2 * rs * g4.z + b4.z + bf_lo(bv.y), d3 * rs * g4.w + b4.w + bf_hi(bv.y))};
            }
            if (!dry) __builtin_amdgcn_raw_buffer_store_b64(w, yrs, (int)(offy_ * 2), 0, 16); else asm volatile("" :: "v"(w.x), "v"(w.y));
        }
#undef PP_ADDR
        if (!dry) {
#pragma unroll 1
            for (int k = 0; k < 16; ++k) { const int pr = wave * 16 + k, sl = pr >> 6, m2 = ch * 64 + (pr & 63); const int p = m2 % T;
                const int rowb = (int)(((size_t)m2 * YC_W + 384 * (sl + 1)) * 2);
                if (p < PADR) { for (int c = lane; c < RW_W / 2; c += 64) __builtin_amdgcn_raw_buffer_store_b32(0u, yrs, rowb + 4 * c, 0, 16); }
                else if (lane < 32) __builtin_amdgcn_raw_buffer_store_b32(0u, yrs, rowb + 640 + 4 * lane, 0, 16); }
            chain_publish(chain, ch >> 2);
        }
    }
}

struct EpiInproj { static constexpr bool PERM = true, AFTER_DRAIN = false, MIDHOOK = false; bf16_t* ush; bf16_t* qkv;
    __device__ __forceinline__ void operator()(const f32x4 (&acc)[2][2][4][2], const pg8::Unit& u, int wr, int wc, int fr, int fq) const {
        asm volatile("" : "+v"(fr), "+v"(fq));
        const int row0 = u.pm * 256 + wr * 64 + fr, colt = u.pn * 256 + wc * 32 + 8 * fq;
        const __amdgpu_buffer_rsrc_t urs = __builtin_amdgcn_make_buffer_rsrc((void*)ush, 0, (int)((size_t)(M + 256) * SHIFT_W * 2), 0x00020000);
        const __amdgpu_buffer_rsrc_t qrs = __builtin_amdgcn_make_buffer_rsrc((void*)qkv, 0, (int)((size_t)(M + 256) * QKV_W * 2), 0x00020000);
#pragma unroll
        for (int ai = 0; ai < 2; ++ai)
#pragma unroll
            for (int m = 0; m < 4; ++m) { const size_t row = (size_t)(row0 + ai * 128 + m * 16);
#pragma unroll
                for (int bj = 0; bj < 2; ++bj) { const int col = colt + bj * 128; const f32x4 v0 = acc[ai][bj][m][0], v1 = acc[ai][bj][m][1];
                    const float sc = (col >= SHIFT_W && col < SHIFT_W + 320) ? C2 : 1.0f;
                    u32x4 w; w.x = pk2(v0[0] * sc, v0[1] * sc); w.y = pk2(v0[2] * sc, v0[3] * sc); w.z = pk2(v1[0] * sc, v1[1] * sc); w.w = pk2(v1[2] * sc, v1[3] * sc);
                    if (col < SHIFT_W) __builtin_amdgcn_raw_buffer_store_b128(w, urs, (int)((row * SHIFT_W + col) * 2), 0, 16);
                    else if (col < SHIFT_W + QKV_W) __builtin_amdgcn_raw_buffer_store_b128(w, qrs, (int)((row * QKV_W + (col - SHIFT_W)) * 2), 0, 16); } }
    }
};
struct EpiGates { static constexpr bool PERM = true, AFTER_DRAIN = false, MIDHOOK = false; bf16_t* gates;
    __device__ __forceinline__ void operator()(const f32x4 (&acc)[2][2][4][2], const pg8::Unit& u, int wr, int wc, int fr, int fq) const {
        asm volatile("" : "+v"(fr), "+v"(fq));
        const int row0 = u.pm * 256 + wr * 64 + fr, colt = u.pn * 256 + wc * 32 + 8 * fq;
        const __amdgpu_buffer_rsrc_t rs = __builtin_amdgcn_make_buffer_rsrc((void*)gates, 0, (int)((size_t)M * 3072 * 2), 0x00020000);
#pragma unroll
        for (int ai = 0; ai < 2; ++ai)
#pragma unroll
            for (int m = 0; m < 4; ++m) { const size_t row = (size_t)(row0 + ai * 128 + m * 16);
#pragma unroll
                for (int bj = 0; bj < 2; ++bj) { const int col = colt + bj * 128; f32x4 v0 = acc[ai][bj][m][0], v1 = acc[ai][bj][m][1];
#pragma unroll
                    for (int q = 0; q < 4; ++q) { v0[q] = __builtin_amdgcn_rcpf(1.f + __builtin_amdgcn_exp2f(-v0[q] * LOG2E)); v1[q] = __builtin_amdgcn_rcpf(1.f + __builtin_amdgcn_exp2f(-v1[q] * LOG2E)); }
                    u32x4 w; w.x = pk2(v0[0], v0[1]); w.y = pk2(v0[2], v0[3]); w.z = pk2(v1[0], v1[1]); w.w = pk2(v1[2], v1[3]);
                    __builtin_amdgcn_raw_buffer_store_b128(w, rs, (int)((row * 3072 + col) * 2), 0, 16); } }
    }
};
struct EpiMergeF { static constexpr bool PERM = true, AFTER_DRAIN = false, MIDHOOK = true; const bf16_t* gates; bf16_t* merged;
    __device__ __forceinline__ void mid(f32x4 (&acc)[2][2][4][2], const pg8::Unit& u, int wr, int wc, int fr, int fq, int seg) const {
        asm volatile("" : "+v"(fr), "+v"(fq));
        const int row0 = u.pm * 256 + wr * 64 + fr, colt = u.pn * 256 + wc * 32 + 8 * fq;
        u32x4 gpn[2], gnn[2];
#define MG_LOAD(q) do { const bf16_t* gpt_ = gates + (size_t)(row0 + ((q) >> 2) * 128 + ((q) & 3) * 16) * 3072 + (seg - 1) * 1024 + colt; \
            gpn[0] = *(const u32x4*)gpt_; gnn[0] = *(const u32x4*)(gpt_ + 1024); gpn[1] = *(const u32x4*)(gpt_ + 128); gnn[1] = *(const u32x4*)(gpt_ + 1024 + 128); } while (0)
        MG_LOAD(0);
#pragma unroll
        for (int q = 0; q < 8; ++q) { const int ai = q >> 2, m = q & 3;
            u32x4 gp[2], gn[2];
#pragma unroll
            for (int bj = 0; bj < 2; ++bj) { gp[bj] = gpn[bj]; gn[bj] = gnn[bj]; }
            if (q < 7) MG_LOAD(q + 1);
#pragma unroll
            for (int bj = 0; bj < 2; ++bj) { f32x4& v0 = acc[ai][bj][m][0]; f32x4& v1 = acc[ai][bj][m][1];
                v0[0] *= bf_lo(gp[bj].x) * __builtin_amdgcn_rcpf(bf_lo(gn[bj].x)); v0[1] *= bf_hi(gp[bj].x) * __builtin_amdgcn_rcpf(bf_hi(gn[bj].x));
                v0[2] *= bf_lo(gp[bj].y) * __builtin_amdgcn_rcpf(bf_lo(gn[bj].y)); v0[3] *= bf_hi(gp[bj].y) * __builtin_amdgcn_rcpf(bf_hi(gn[bj].y));
                v1[0] *= bf_lo(gp[bj].z) * __builtin_amdgcn_rcpf(bf_lo(gn[bj].z)); v1[1] *= bf_hi(gp[bj].z) * __builtin_amdgcn_rcpf(bf_hi(gn[bj].z));
                v1[2] *= bf_lo(gp[bj].w) * __builtin_amdgcn_rcpf(bf_lo(gn[bj].w)); v1[3] *= bf_hi(gp[bj].w) * __builtin_amdgcn_rcpf(bf_hi(gn[bj].w)); }
            __builtin_amdgcn_sched_barrier(0); }
#undef MG_LOAD
    }
    __device__ __forceinline__ void operator()(const f32x4 (&acc)[2][2][4][2], const pg8::Unit& u, int wr, int wc, int fr, int fq) const {
        asm volatile("" : "+v"(fr), "+v"(fq));
        const int row0 = u.pm * 256 + wr * 64 + fr, colt = u.pn * 256 + wc * 32 + 8 * fq;
        const __amdgpu_buffer_rsrc_t mrs = __builtin_amdgcn_make_buffer_rsrc((void*)merged, 0, (int)((size_t)M * D * 2), 0x00020000);
        u32x4 gnx[2];
#define MG_LOAD2(q) do { const bf16_t* gpt_ = gates + (size_t)(row0 + ((q) >> 2) * 128 + ((q) & 3) * 16) * 3072 + 2048 + colt; gnx[0] = *(const u32x4*)gpt_; gnx[1] = *(const u32x4*)(gpt_ + 128); } while (0)
        MG_LOAD2(0);
#pragma unroll
        for (int q = 0; q < 8; ++q) { const int ai = q >> 2, m = q & 3; const size_t row = (size_t)(row0 + ai * 128 + m * 16);
            u32x4 g[2];
#pragma unroll
            for (int bj = 0; bj < 2; ++bj) g[bj] = gnx[bj];
            if (q < 7) MG_LOAD2(q + 1);
#pragma unroll
            for (int bj = 0; bj < 2; ++bj) { const f32x4 v0 = acc[ai][bj][m][0], v1 = acc[ai][bj][m][1];
                u32x4 w;
                w.x = pk2(bf_lo(g[bj].x) * v0[0], bf_hi(g[bj].x) * v0[1]); w.y = pk2(bf_lo(g[bj].y) * v0[2], bf_hi(g[bj].y) * v0[3]);
                w.z = pk2(bf_lo(g[bj].z) * v1[0], bf_hi(g[bj].z) * v1[1]); w.w = pk2(bf_lo(g[bj].w) * v1[2], bf_hi(g[bj].w) * v1[3]);
                __builtin_amdgcn_raw_buffer_store_b128(w, mrs, (int)((row * D + colt + bj * 128) * 2), 0, 16); }
            __builtin_amdgcn_sched_barrier(0); }
#undef MG_LOAD2
    }
};
struct EpiOut { static constexpr bool PERM = true, AFTER_DRAIN = false, MIDHOOK = false; bf16_t* hb;
    __device__ __forceinline__ void operator()(const f32x4 (&acc)[2][2][4][2], const pg8::Unit& u, int wr, int wc, int fr, int fq) const {
        asm volatile("" : "+v"(fr), "+v"(fq));
        const int row0 = u.pm * 256 + wr * 64 + fr, colt = u.pn * 256 + wc * 32 + 8 * fq;
        u32x4 hn[2];
#define OUT_LOAD(q) do { const bf16_t* p_ = hb + (size_t)(row0 + ((q) >> 2) * 128 + ((q) & 3) * 16) * D + colt; hn[0] = *(const u32x4*)(p_); hn[1] = *(const u32x4*)(p_ + 128); } while (0)
        OUT_LOAD(0);
#pragma unroll
        for (int q = 0; q < 8; ++q) {
            const int ai = q >> 2, m = q & 3;
            bf16_t* hp = hb + (size_t)(row0 + ai * 128 + m * 16) * D + colt; const u32x4 h0 = hn[0], h1 = hn[1];
            if (q < 7) OUT_LOAD(q + 1);
#pragma unroll
            for (int bj = 0; bj < 2; ++bj) { const u32x4 hh = bj ? h1 : h0; const f32x4 v0 = acc[ai][bj][m][0], v1 = acc[ai][bj][m][1];
                u32x4 w; w.x = pk2(bf_lo(hh.x) + v0[0], bf_hi(hh.x) + v0[1]); w.y = pk2(bf_lo(hh.y) + v0[2], bf_hi(hh.y) + v0[3]);
                w.z = pk2(bf_lo(hh.z) + v1[0], bf_hi(hh.z) + v1[1]); w.w = pk2(bf_lo(hh.w) + v1[2], bf_hi(hh.w) + v1[3]);
                *(u32x4*)(hp + bj * 128) = w; }
            __builtin_amdgcn_sched_barrier(0);
        }
#undef OUT_LOAD
    }
};
template <bool GA, bool WAIT, bool PUB, bool REV> struct MoeOrderT { static constexpr bool GATHER = GA; const volatile LAS int* tb; int ntile, npt, G, c, rep; const int* s2t; unsigned* cnt; unsigned need;
    __device__ __forceinline__ bool next(int i, pg8::Unit& u) const { long L = (long)i * G + (REV ? G - 1 - c : c); if (L >= (long)ntile * npt * rep) return false; L %= (long)ntile * npt;
        const int tau = (int)(L / npt), j = (int)(L - (long)tau * npt); int e = 0;
#pragma unroll
        for (int k = 1; k < 16; ++k) e += (tau >= tb[k]) ? 1 : 0;
        u.pm = tau; u.pn = __builtin_amdgcn_readfirstlane(e) * npt + j; return true; }
    __device__ __forceinline__ void a_ready(const pg8::Unit& u) const {
        if constexpr (WAIT) {
            if (threadIdx.x < 64) {
                const unsigned* w = cnt + CH_STRIDE * u.pm; unsigned polls = 0;
                while ((unsigned)__builtin_amdgcn_readfirstlane(__hip_atomic_load(w, __ATOMIC_RELAXED, __HIP_MEMORY_SCOPE_AGENT)) < need) { if (++polls > (1u << 18)) break; __builtin_amdgcn_s_sleep(2); }
                __builtin_amdgcn_fence(__ATOMIC_ACQUIRE, "agent");
                asm volatile("s_waitcnt vmcnt(0)" ::: "memory");
            }
            asm volatile("" ::: "memory"); __builtin_amdgcn_s_barrier(); asm volatile("" ::: "memory");
        }
    }
    __device__ __forceinline__ void done(const pg8::Unit& u) const { if constexpr (PUB) chain_publish(cnt, u.pm); }
};
struct EpiMoeUp { static constexpr bool PERM = true, AFTER_DRAIN = false, MIDHOOK = false; bf16_t* hs;
    __device__ __forceinline__ void operator()(const f32x4 (&acc)[2][2][4][2], const pg8::Unit& u, int wr, int wc, int fr, int fq) const {
        asm volatile("" : "+v"(fr), "+v"(fq));
        const int row0 = u.pm * 256 + wr * 64 + fr, col = (u.pn & 1) * 128 + wc * 32 + 8 * fq;
        const __amdgpu_buffer_rsrc_t hrs = __builtin_amdgcn_make_buffer_rsrc((void*)hs, 0, (int)((size_t)MS * DEXP * 2), 0x00020000);
#pragma unroll
        for (int ai = 0; ai < 2; ++ai)
#pragma unroll
            for (int m = 0; m < 4; ++m) { const size_t row = (size_t)(row0 + ai * 128 + m * 16); float r[8];
#pragma unroll
                for (int n = 0; n < 2; ++n)
#pragma unroll
                    for (int q = 0; q < 4; ++q) { const float gte = acc[ai][0][m][n][q], up = acc[ai][1][m][n][q]; r[4 * n + q] = gte * __builtin_amdgcn_rcpf(1.f + __builtin_amdgcn_exp2f(-gte * LOG2E)) * up; }
                u32x4 w; w.x = pk2(r[0], r[1]); w.y = pk2(r[2], r[3]); w.z = pk2(r[4], r[5]); w.w = pk2(r[6], r[7]);
                __builtin_amdgcn_raw_buffer_store_b128(w, hrs, (int)((row * DEXP + col) * 2), 0, 16); }
    }
};
struct EpiMoeDown { static constexpr bool PERM = true, AFTER_DRAIN = false, MIDHOOK = false; bf16_t* y; const float* cws;
    __device__ __forceinline__ void operator()(const f32x4 (&acc)[2][2][4][2], const pg8::Unit& u, int wr, int wc, int fr, int fq) const {
        asm volatile("" : "+v"(fr), "+v"(fq));
        const int row0 = u.pm * 256 + wr * 64 + fr, colt = (u.pn & 3) * 256 + wc * 32 + 8 * fq;
        float cw[8];
#pragma unroll
        for (int q = 0; q < 8; ++q) cw[q] = cws[row0 + (q >> 2) * 128 + (q & 3) * 16];
#pragma unroll
        for (int ai = 0; ai < 2; ++ai)
#pragma unroll
            for (int m = 0; m < 4; ++m) { const size_t row = (size_t)(row0 + ai * 128 + m * 16); const float cwv = cw[ai * 4 + m];
#pragma unroll
                for (int bj = 0; bj < 2; ++bj) { const int col = colt + bj * 128; const f32x4 v0 = acc[ai][bj][m][0] * cwv, v1 = acc[ai][bj][m][1] * cwv;
                    u32x4 w; w.x = pk2(v0[0], v0[1]); w.y = pk2(v0[2], v0[3]); w.z = pk2(v1[0], v1[1]); w.w = pk2(v1[2], v1[3]);
                    *(u32x4*)(y + row * D + col) = w; } }
    }
};


#ifndef PH_MASK
#define PH_MASK 0xFFFF
#endif
#define PH(k) ((PH_MASK >> (k)) & 1)
#ifndef PROBE_DUP
#define PROBE_DUP 0
#endif
#define DUPN(bit) (((PROBE_DUP >> (bit)) & 1) ? 2 : 1)
#ifndef PROBE_THIN
#define PROBE_THIN 0
#endif
#define THIN(bit) ((PROBE_THIN >> (bit)) & 1)
#define FRESH() do { asm volatile("" : "+v"(F.tid)); F.lane = F.tid & 63; F.wave = __builtin_amdgcn_readfirstlane(F.tid >> 6); { int bx_ = (int)blockIdx.x; asm volatile("" : "+s"(bx_)); F.bx = bx_; } { unsigned char* w_ = a.ws; asm volatile("" : "+s"(w_)); a.ws = w_; } } while (0)
__global__ void __launch_bounds__(NTHR, 2) hybrid_fwd(Args ka) {
    extern __shared__ __attribute__((aligned(16))) unsigned char lds_raw[];
    Frame F;
    F.lds = (LAS unsigned char*)lds_raw;
    F.MISC = (volatile LAS unsigned*)(F.lds + MISC_OFF);
    F.tid = threadIdx.x; F.lane = F.tid & 63; F.wave = __builtin_amdgcn_readfirstlane(F.tid >> 6); F.bx = (int)blockIdx.x;
    for (int u = F.tid; u < (LDS_BYTES - MISC_OFF) / 4; u += NTHR) ((LAS unsigned*)(F.lds + MISC_OFF))[u] = 0u;
    __syncthreads();
    if (F.tid < 29) { const unsigned long long p = (unsigned long long)ka.in[F.tid]; F.MISC[64 + 2 * F.tid] = (unsigned)p; F.MISC[65 + 2 * F.tid] = (unsigned)(p >> 32); }
    __syncthreads();
    ArgsL a; a.tab = F.MISC + 64; a.out = ka.out; a.ws = ka.ws;
    XcdBarrier bar = xcd_barrier_post((unsigned*)(a.ws + WS_CTL) + CW_BAR, F.MISC + 8);
    const int G = (int)gridDim.x, c = (int)blockIdx.x;
    PG8_LAS unsigned char* ring = (PG8_LAS unsigned char*)F.lds;

#ifdef PROF_K
    volatile LAS unsigned* tsl = F.MISC + 1536; int nts = 0;
    if (blockIdx.x == 0 && F.tid == 0) tsl[nts] = (unsigned)__builtin_amdgcn_s_memrealtime();
    ++nts;
#define BARX() do { xcd_barrier(bar); if (blockIdx.x == 0 && F.tid == 0) tsl[nts] = (unsigned)__builtin_amdgcn_s_memrealtime(); ++nts; } while (0)
#else
#define BARX() xcd_barrier(bar)
#endif
    for (int layer = 0; layer < DEPTH; ++layer) {
        for (int rep = 0; rep < DUPN(8); ++rep) { FRESH(); if (PH(0)) phase_wconv(a, F, layer); }
        __syncthreads();
        if (THIN(0)) { FRESH(); phase_norm<1>(a, F, layer, true); }
        FRESH(); if (PH(1)) phase_norm<1>(a, F, layer);
        BARX();
        unsigned* ch1 = (unsigned*)(a.ws + WS_CTL) + CW_G1 + layer * 129 * CH_STRIDE;
        FRESH(); if (PH(2)) {
            pg8::Gemm g{(const bf16_t*)A_PTR(a), (const bf16_t*)(a.ws + WS_WIN), M, N1, D}; ChainOrder<false, true> S; S.init(M, N1, G, c, 1); S.ready = nullptr; S.need = 0u; S.mine = ch1;
            EpiInproj E{(bf16_t*)(a.ws + WS_USH), (bf16_t*)(a.ws + WS_QKV)};
            pg8::gemm_phase<EpiInproj, ChainOrder<false, true>, true, true>(ring, g, S, E);
        }
        asm volatile("s_waitcnt vmcnt(0) lgkmcnt(0)" ::: "memory"); __syncthreads();
        FRESH(); if (PH(3)) phase_prep(a, F, layer, ch1, (unsigned*)(a.ws + WS_CTL) + CW_QUEUE + 64 * layer + 48);
        BARX();
#ifndef SEQ_SCAN
        unsigned* ca_done = (unsigned*)(a.ws + WS_CTL) + CW_CADONE + 64 * layer;
        FRESH(); if (PH(4)) phase_chunkA(a, F, ca_done);
#endif
        FRESH(); if (PH(4)) phase_mix(a, F, layer, ca_done);
        BARX();
        unsigned* ch2 = (unsigned*)(a.ws + WS_CTL) + CW_CHAIN + (layer * 2) * 129 * CH_STRIDE; unsigned* ch3 = ch2 + 129 * CH_STRIDE;
        FRESH(); if (PH(6)) {
            pg8::Gemm g{(const bf16_t*)A_PTR(a), (const bf16_t*)(a.ws + WS_WG), M, 3072, D}; GatesOrder S; S.init(M, 3072, G, c, 1); S.mine = ch2;
            EpiGates E{(bf16_t*)(a.ws + WS_GATES)};
            pg8::gemm_phase<EpiGates, GatesOrder, true, true>(ring, g, S, E);
        }
        asm volatile("s_waitcnt vmcnt(0) lgkmcnt(0)" ::: "memory"); __syncthreads();
        if (THIN(3)) { FRESH(); phase_post(a, F, layer, ch2, true); }
        FRESH(); if (PH(5)) { if (!(c < 20 || (c >= 32 && c < 36))) phase_post(a, F, layer, ch2); }
        __syncthreads();
        FRESH(); if (PH(7)) {
            pg8::Gemm g{(const bf16_t*)(a.ws + WS_YCAT), (const bf16_t*)(a.ws + WS_WP), M, D, YC_W}; ChainOrder<true, true> S; S.init(M, D, G, (c + G - 16) % G, 1); S.ready = ch2; S.need = 128u; S.mine = ch3;
            EpiMergeF E{(const bf16_t*)(a.ws + WS_GATES), (bf16_t*)(a.ws + WS_MERGED)};
            pg8::gemm_phase<EpiMergeF, ChainOrder<true, true>, true, true>(ring, g, S, E);
        }
        FRESH(); if (PH(8)) {
            pg8::Gemm g{(const bf16_t*)(a.ws + WS_MERGED), (const bf16_t*)(a.ws + WS_WO), M, D, D}; ChainOrder<true, false> S; S.init(M, D, G, (c + G - 32) % G, 1); S.ready = ch3; S.need = 32u; S.mine = nullptr;
            EpiOut E{HB_PTR(a)};
            pg8::gemm_phase<EpiOut, ChainOrder<true, false>, true, true>(ring, g, S, E);
        }
        BARX();
        if (THIN(4)) { FRESH(); phase_norm2(a, F, layer, true); }
        FRESH(); if (PH(9)) phase_norm2(a, F, layer);
        BARX();
        for (int rep = 0; rep < DUPN(7); ++rep) { FRESH(); if (PH(10)) phase_route(a, F, layer); }
        BARX();
        volatile LAS int* tb = (volatile LAS int*)(F.MISC + 32);
        if (F.tid <= 16) { const int* cnt = (const int*)(a.ws + WS_CTL) + CW_ECNT + 64 * layer; int t = 0;
            for (int e = 0; e < F.tid; ++e) t += (__hip_atomic_load(cnt + e, __ATOMIC_RELAXED, __HIP_MEMORY_SCOPE_AGENT) + 255) >> 8;
            tb[F.tid] = t; }
        __syncthreads();
        const int ntile = tb[16];
        unsigned* chm = (unsigned*)(a.ws + WS_CTL) + CW_MOE + layer * (MS / 256) * CH_STRIDE;
        FRESH(); if (PH(11)) {
            pg8::Gemm g{(const bf16_t*)A_PTR(a), (const bf16_t*)(a.ws + WS_WGU), MS, 8192, D}; MoeOrderT<true, false, true, false> S{tb, ntile, 2, G, c, 1, (const int*)(a.ws + WS_S2T), chm, 0u};
            EpiMoeUp E{(bf16_t*)(a.ws + WS_HS)};
            pg8::gemm_phase<EpiMoeUp, MoeOrderT<true, false, true, false>, true, true>(ring, g, S, E);
        }
        FRESH(); if (PH(12)) {
            int kdim = DEXP; asm volatile("" : "+s"(kdim));
            pg8::Gemm g{(const bf16_t*)(a.ws + WS_HS), (const bf16_t*)(a.ws + WS_WD), MS, 16384, kdim}; MoeOrderT<false, true, false, true> S{tb, ntile, 4, G, c, 1, nullptr, chm, 16u};
            EpiMoeDown E{(bf16_t*)(a.ws + WS_Y), (const float*)(a.ws + WS_CWS)};
            pg8::gemm_phase<EpiMoeDown, MoeOrderT<false, true, false, true>, true, true>(ring, g, S, E);
        }
        BARX();
    }
    if (THIN(5)) { FRESH(); phase_norm<0>(a, F, DEPTH - 1, true); }
    FRESH(); if (PH(13)) phase_norm<0>(a, F, DEPTH - 1);
#ifdef PROF_K
    BARX();
    if (blockIdx.x == 0) {
        __syncthreads();
        float us;
        if (PROF_K < 0) us = 100.f;
        else if (PROF_K == 12) us = (float)(tsl[25] - tsl[24]) * 0.01f;
        else if (PROF_K == 13) us = (float)(tsl[25] - tsl[0]) * 0.01f;
        else us = ((float)(tsl[1 + PROF_K] - tsl[PROF_K]) + (float)(tsl[13 + PROF_K] - tsl[12 + PROF_K])) * 0.01f;
        us = 4.f * rintf(us * 0.25f);
        for (int i = F.tid; i < 16384; i += NTHR) a.out[i] = us;
    }
#endif
#ifdef CLOCK_PROBE
    if (blockIdx.x == 0 && F.wave == 0) {
        float c0 = 1.f, c1 = 2.f, c2 = 3.f, c3 = 4.f, c4 = 5.f, c5 = 6.f, c6 = 7.f, c7 = 8.f;
        for (int i = 0; i < CLOCK_PROBE; ++i) {
            asm volatile("v_fma_f32 %0, %0, %0, %0\n\tv_fma_f32 %1, %1, %1, %1\n\tv_fma_f32 %2, %2, %2, %2\n\tv_fma_f32 %3, %3, %3, %3\n\tv_fma_f32 %4, %4, %4, %4\n\tv_fma_f32 %5, %5, %5, %5\n\tv_fma_f32 %6, %6, %6, %6\n\tv_fma_f32 %7, %7, %7, %7"
                         : "+v"(c0), "+v"(c1), "+v"(c2), "+v"(c3), "+v"(c4), "+v"(c5), "+v"(c6), "+v"(c7));
        }
        asm volatile("" :: "v"(c0), "v"(c1), "v"(c2), "v"(c3), "v"(c4), "v"(c5), "v"(c6), "v"(c7));
    }
#endif
}

extern "C" void kernel_launch(void* const* d_in, const int* in_sizes, int n_in, void* d_out, int out_size, void* d_ws, size_t ws_size, hipStream_t stream) {
    static int ready = 0;
    if (ready == 0) {
        if (n_in != 29 || out_size != NB * SEQ * D || ws_size < WS_END) { fprintf(stderr, "kernel_launch: unexpected problem shape (n_in %d, out %d, ws %zu < %zu)\n", n_in, out_size, ws_size, (size_t)WS_END); ready = -1; return; }
        if (hipFuncSetAttribute((const void*)hybrid_fwd, hipFuncAttributeMaxDynamicSharedMemorySize, LDS_BYTES) != hipSuccess) { fprintf(stderr, "kernel_launch: hipFuncSetAttribute failed\n"); ready = -1; return; }
        int per_cu = 0;
        if (hipOccupancyMaxActiveBlocksPerMultiprocessor(&per_cu, (const void*)hybrid_fwd, NTHR, LDS_BYTES) != hipSuccess || per_cu < 1) fprintf(stderr, "kernel_launch: occupancy query says %d\n", per_cu);
        (void)hipGetLastError();
        ready = 1;
    }
    if (ready < 0) return;
    (void)in_sizes;
    if (hipMemsetAsync((char*)d_ws + WS_CTL, 0, CTL_ZERO_BYTES, stream) != hipSuccess) return;
    Args a{};
    for (int i = 0; i < 29; ++i) a.in[i] = (const float*)d_in[i];
    a.out = (float*)d_out; a.ws = (unsigned char*)d_ws;
    hipLaunchKernelGGL(hybrid_fwd, dim3(256), dim3(NTHR), LDS_BYTES, stream, a);
}
```
